# Optimizing an MI355X kernel written in HIP

```python
import jax
import jax.numpy as jnp
from jax import lax
import numpy as np

D_MODEL = 1024
BATCH = 8
SEQ = 4096
DEPTH = 1

LRU_WIDTH = D_MODEL
LRU_BLOCK_W = 256
LRU_BLOCKS = LRU_WIDTH // LRU_BLOCK_W
CONV_W = 4
LRU_C = 8.0
N_HEADS = 8
HEAD_DIM = D_MODEL // N_HEADS
ATTN_WIDTH = N_HEADS * HEAD_DIM
Q_BLOCK = 128
N_GROUPS = 4
EXPERTS_PER_GROUP = 8
N_EXPERTS = N_GROUPS * EXPERTS_PER_GROUP
TOP_K = 2
D_EXPERT = D_MODEL // 2
ROUTE_BLOCK = 128
EPS = 1e-6
IN_WIDTHS = (LRU_WIDTH, LRU_WIDTH, ATTN_WIDTH, ATTN_WIDTH, ATTN_WIDTH, N_HEADS, D_MODEL, D_MODEL)
IN_WIDTH = sum(IN_WIDTHS)

kernel_name = 'hybrid_rglru_fox_hmoe'


def rms_norm(x, g):
    x32 = x.astype(jnp.float32)
    y = x32 * lax.rsqrt(jnp.mean(x32 * x32, axis=-1, keepdims=True) + EPS)
    return (y * g.astype(jnp.float32)).astype(x.dtype)


def causal_depthwise_conv(x, w, b):
    y = lax.conv_general_dilated(
        x, w[:, None, :].astype(x.dtype), window_strides=(1,),
        padding=[(CONV_W - 1, 0)], dimension_numbers=('NWC', 'WIO', 'NWC'),
        feature_group_count=x.shape[-1])
    return y + b.astype(x.dtype)


def _linear_recurrence_combine(e1, e2):
    a1, b1 = e1
    a2, b2 = e2
    return a1 * a2, a2 * b1 + b2


def rg_lru(xc, w_a, b_a, w_x, b_x, lam):
    B, S, C = xc.shape
    xb = xc.reshape(B, S, LRU_BLOCKS, LRU_BLOCK_W)
    r = jax.nn.sigmoid(jnp.einsum('bsnc,ncd->bsnd', xb, w_a).reshape(B, S, C).astype(jnp.float32) + b_a.astype(jnp.float32))
    i = jax.nn.sigmoid(jnp.einsum('bsnc,ncd->bsnd', xb, w_x).reshape(B, S, C).astype(jnp.float32) + b_x.astype(jnp.float32))
    log_a = -LRU_C * r * jax.nn.softplus(-lam.astype(jnp.float32))
    a = jnp.exp(log_a)
    mult = jnp.sqrt(-jnp.expm1(2.0 * log_a))
    b = mult * i * xc.astype(jnp.float32)
    _, h = lax.associative_scan(_linear_recurrence_combine, (a, b), axis=1)
    return h.astype(xc.dtype)


def forgetting_attention(q, k, v, log_f):
    B, S, H, Dh = q.shape
    scale = Dh ** -0.5
    c = jnp.cumsum(log_f, axis=1).transpose(0, 2, 1)
    outs = []
    for qb in range(S // Q_BLOCK):
        lo = qb * Q_BLOCK
        hi = lo + Q_BLOCK
        s = jnp.einsum('bqhd,bkhd->bhqk', q[:, lo:hi], k[:, :hi], preferred_element_type=jnp.float32) * scale
        s = s + c[:, :, lo:hi, None] - c[:, :, None, :hi]
        causal = jnp.arange(hi)[None, :] <= (lo + jnp.arange(Q_BLOCK))[:, None]
        s = jnp.where(causal, s, -jnp.inf)
        p = jax.nn.softmax(s, axis=-1)
        outs.append(jnp.einsum('bhqk,bkhd->bqhd', p.astype(v.dtype), v[:, :hi]))
    return jnp.concatenate(outs, axis=1).reshape(B, S, H * Dh)


def parallel_mixer(u, w_in, conv_w, conv_b, w_rg_a, b_rg_a, w_rg_x, b_rg_x, lam, b_forget,
                   w_lru_out, w_attn_out, w_out):
    B, S, _ = u.shape
    z = u @ w_in
    split_points = np.cumsum(IN_WIDTHS)[:-1].tolist()
    xr, gr, q, k, v, fl, m_lru, m_attn = jnp.split(z, split_points, axis=-1)
    h = rg_lru(causal_depthwise_conv(xr, conv_w, conv_b), w_rg_a, b_rg_a, w_rg_x, b_rg_x, lam)
    y_lru = (h * jax.nn.gelu(gr)) @ w_lru_out
    log_f = jax.nn.log_sigmoid(fl.astype(jnp.float32) + b_forget.astype(jnp.float32))
    o = forgetting_attention(q.reshape(B, S, N_HEADS, HEAD_DIM), k.reshape(B, S, N_HEADS, HEAD_DIM),
                             v.reshape(B, S, N_HEADS, HEAD_DIM), log_f)
    y_attn = o @ w_attn_out
    merged = jax.nn.sigmoid(m_lru) * y_lru + jax.nn.sigmoid(m_attn) * y_attn
    return merged @ w_out


def hierarchical_moe(xn, w_rg, b_rg, w_re, b_re, w1, w3, w2):
    B, S, D = xn.shape
    T = B * S
    xt = xn.reshape(T, D)
    g_logits = (xt @ w_rg).astype(jnp.float32) + b_rg.astype(jnp.float32)
    g_prob = jax.nn.softmax(g_logits, axis=-1)
    _, g_sel = lax.top_k(g_logits, 1)
    p_group = jnp.take_along_axis(g_prob, g_sel, axis=1)
    e_logits = ((xt @ w_re).astype(jnp.float32) + b_re.astype(jnp.float32)).reshape(T, N_GROUPS, EXPERTS_PER_GROUP)
    e_in_group = jnp.take_along_axis(e_logits, g_sel[:, :, None], axis=1)[:, 0]
    top_v, top_i = lax.top_k(e_in_group, TOP_K)
    comb_w = p_group * jax.nn.softmax(top_v, axis=-1)
    expert = g_sel * EXPERTS_PER_GROUP + top_i
    N = T * TOP_K
    flat_e = expert.reshape(N)
    flat_w = comb_w.reshape(N)
    flat_t = jnp.arange(N) // TOP_K
    order = jnp.argsort(flat_e, stable=True)
    sorted_e = flat_e[order]
    counts = jnp.bincount(flat_e, length=N_EXPERTS)
    padded = ((counts + ROUTE_BLOCK - 1) // ROUTE_BLOCK) * ROUTE_BLOCK
    pad_end = jnp.cumsum(padded)
    pad_start = pad_end - padded
    seg_start = jnp.cumsum(counts) - counts
    dest = pad_start[sorted_e] + jnp.arange(N) - seg_start[sorted_e]
    n_blocks = (N + N_EXPERTS * (ROUTE_BLOCK - 1) + ROUTE_BLOCK - 1) // ROUTE_BLOCK
    P = n_blocks * ROUTE_BLOCK
    slot_tok = jnp.full((P,), T, dtype=jnp.int32).at[dest].set(flat_t[order].astype(jnp.int32))
    slot_w = jnp.zeros((P,), xn.dtype).at[dest].set(flat_w[order].astype(xn.dtype))
    blk_expert = jnp.minimum(jnp.searchsorted(pad_end, jnp.arange(n_blocks) * ROUTE_BLOCK, side='right'), N_EXPERTS - 1)
    x_pad = jnp.concatenate([xt, jnp.zeros((1, D), xt.dtype)], axis=0)

    def expert_block(args):
        tok, e = args
        xb = x_pad[tok]
        hb = jax.nn.silu(xb @ w1[e]) * (xb @ w3[e])
        return hb @ w2[e]

    y = lax.map(expert_block, (slot_tok.reshape(n_blocks, ROUTE_BLOCK), blk_expert)).reshape(P, D)
    out = jnp.zeros((T + 1, D), xn.dtype).at[slot_tok].add(y * slot_w[:, None])[:T]
    return out.reshape(B, S, D)


def setup_inputs(seed: int = 0) -> dict:
    key = jax.random.key(seed)
    ks = jax.random.split(key, 23)
    f32 = jnp.float32

    def nrm(k, shape, fan_in):
        return jax.random.normal(k, shape, f32) * (fan_in ** -0.5)

    u = jax.random.uniform(ks[9], (DEPTH, LRU_WIDTH), f32, minval=0.9, maxval=0.999)
    a0 = u ** (1.0 / LRU_C)
    return {
        'x': jax.random.normal(ks[0], (BATCH, SEQ, D_MODEL), f32),
        'g_mix': 1.0 + 0.05 * jax.random.normal(ks[1], (DEPTH, D_MODEL), f32),
        'w_in': nrm(ks[2], (DEPTH, D_MODEL, IN_WIDTH), D_MODEL),
        'conv_w': nrm(ks[3], (DEPTH, CONV_W, LRU_WIDTH), CONV_W),
        'conv_b': 0.02 * jax.random.normal(ks[4], (DEPTH, LRU_WIDTH), f32),
        'w_rg_a': nrm(ks[5], (DEPTH, LRU_BLOCKS, LRU_BLOCK_W, LRU_BLOCK_W), LRU_BLOCK_W),
        'b_rg_a': 0.02 * jax.random.normal(ks[6], (DEPTH, LRU_WIDTH), f32),
        'w_rg_x': nrm(ks[7], (DEPTH, LRU_BLOCKS, LRU_BLOCK_W, LRU_BLOCK_W), LRU_BLOCK_W),
        'b_rg_x': 0.02 * jax.random.normal(ks[8], (DEPTH, LRU_WIDTH), f32),
        'lru_lambda': jnp.log(a0) - jnp.log1p(-a0),
        'b_forget': 2.0 + 0.1 * jax.random.normal(ks[10], (DEPTH, N_HEADS), f32),
        'w_lru_out': nrm(ks[11], (DEPTH, LRU_WIDTH, D_MODEL), LRU_WIDTH),
        'w_attn_out': nrm(ks[12], (DEPTH, ATTN_WIDTH, D_MODEL), ATTN_WIDTH),
        'w_out': nrm(ks[13], (DEPTH, D_MODEL, D_MODEL), D_MODEL),
        'g_ffn': 1.0 + 0.05 * jax.random.normal(ks[14], (DEPTH, D_MODEL), f32),
        'w_route_group': nrm(ks[15], (DEPTH, D_MODEL, N_GROUPS), D_MODEL),
        'b_route_group': 0.01 * jax.random.normal(ks[16], (DEPTH, N_GROUPS), f32),
        'w_route_expert': nrm(ks[17], (DEPTH, D_MODEL, N_EXPERTS), D_MODEL),
        'b_route_expert': 0.01 * jax.random.normal(ks[18], (DEPTH, N_EXPERTS), f32),
        'w_exp_gate': nrm(ks[19], (DEPTH, N_EXPERTS, D_MODEL, D_EXPERT), D_MODEL),
        'w_exp_up': nrm(ks[20], (DEPTH, N_EXPERTS, D_MODEL, D_EXPERT), D_MODEL),
        'w_exp_down': nrm(ks[21], (DEPTH, N_EXPERTS, D_EXPERT, D_MODEL), D_EXPERT),
        'g_final': 1.0 + 0.05 * jax.random.normal(ks[22], (D_MODEL,), f32),
    }


def reference(x, g_mix, w_in, conv_w, conv_b, w_rg_a, b_rg_a, w_rg_x, b_rg_x, lru_lambda, b_forget,
              w_lru_out, w_attn_out, w_out, g_ffn, w_route_group, b_route_group, w_route_expert,
              b_route_expert, w_exp_gate, w_exp_up, w_exp_down, g_final):
    for l in range(DEPTH):
        u = rms_norm(x, g_mix[l])
        x = x + parallel_mixer(u, w_in[l], conv_w[l], conv_b[l], w_rg_a[l], b_rg_a[l], w_rg_x[l], b_rg_x[l],
                               lru_lambda[l], b_forget[l], w_lru_out[l], w_attn_out[l], w_out[l])
        v = rms_norm(x, g_ffn[l])
        x = x + hierarchical_moe(v, w_route_group[l], b_route_group[l], w_route_expert[l], b_route_expert[l],
                                 w_exp_gate[l], w_exp_up[l], w_exp_down[l])
    return rms_norm(x, g_final)
```

```cpp
#include <hip/hip_runtime.h>
#include <cstdio>
#include <cstdint>

#ifndef MK_ONE_LAUNCH
#define MK_ONE_LAUNCH 0
#endif
namespace pg8 {
#define PG8_LAS __attribute__((address_space(3)))
typedef unsigned short bf16_t;
typedef short bf16x8 __attribute__((ext_vector_type(8)));
typedef float f32x4 __attribute__((ext_vector_type(4)));
typedef unsigned u32x4 __attribute__((ext_vector_type(4)));
constexpr int BM = 256, BK = 64, HALF = 128, HTB = HALF * BK * 2  , STAGE_BYTES = 8 * HTB, NXCD = 8, WGM = 8;

__host__ __device__ __forceinline__ int lds_byte(int r, int c) { const int st = (r >> 4) * 2 + (c >> 5), rr = r & 15, cc = c & 31, ob = rr * 64 + cc * 2; return st * 1024 + (ob ^ (((ob >> 9) & 1) << 5)); }
__host__ __device__ __forceinline__ void stage_rc(int b, int& R, int& C) { const int st = b / 1024, sb = b % 1024, swz = sb ^ (((sb >> 9) & 1) << 5); R = (st >> 1) * 16 + swz / 64; C = (st & 1) * 32 + (swz % 64) / 2; }
__host__ __device__ __forceinline__ int perm32(int rho) { const int n = rho >> 4, i = rho & 15; return 8 * (i >> 2) + 4 * n + (i & 3); }

struct Unit { int pm, pn; };
struct Gemm { const bf16_t* A; const bf16_t* Bt; int M, N, K; };

struct StaticOrder {
    int nM, nN, nwg, G, c;
    __host__ __device__ void init(int M, int N, int G_, int c_) { nM = M / BM; nN = N / BM; nwg = nM * nN; G = G_; c = c_; }
    __host__ __device__ bool next(int i, Unit& u) const {
        const long L = (long)i * G + c; if (L >= nwg) return false;
        int wgid = (int)L; { const int q = nwg / NXCD, r = nwg % NXCD, xcd = wgid % NXCD, off = wgid / NXCD; wgid = (xcd < r ? xcd * (q + 1) : r * (q + 1) + (xcd - r) * q) + off; }
        const int nig = WGM * nN, gid = wgid / nig, fm = gid * WGM, gsz = (nM - fm) < WGM ? (nM - fm) : WGM;
        u.pm = fm + ((wgid % nig) % gsz); u.pn = (wgid % nig) / gsz; return true;
    }
    __device__ __forceinline__ void a_ready(const Unit&) const {}
    __device__ __forceinline__ void done(const Unit&) const {}
};

__device__ __forceinline__ unsigned cvt_pk_bf16(float lo, float hi) { unsigned r; asm volatile("v_cvt_pk_bf16_f32 %0, %1, %2" : "=v"(r) : "v"(lo), "v"(hi)); return r; }
typedef float f32x2 __attribute__((ext_vector_type(2)));
__device__ __forceinline__ float sigmoid_f(float x) { return __builtin_amdgcn_rcpf(1.0f + __builtin_amdgcn_exp2f(-1.4426950408889634f * x)); }
__device__ __forceinline__ float gelu_tanh_f(float x) { const float u = x * (1.0f + 0.044715f * x * x); return x * __builtin_amdgcn_rcpf(1.0f + __builtin_amdgcn_exp2f(-2.3022081981f * u)); }
__device__ __forceinline__ float bf_lo(unsigned w) { return __builtin_bit_cast(float, w << 16); }
__device__ __forceinline__ float bf_hi(unsigned w) { return __builtin_bit_cast(float, w & 0xffff0000u); }
constexpr size_t SEGE = (size_t)32768 * 1024;

struct EpiZ {
    static constexpr bool PERM = true, AFTER_DRAIN = false;
    bf16_t* ws5; bf16_t* out2; const float* rs;
    __device__ __forceinline__ void operator()(const f32x4 (&acc)[2][2][4][2], const Unit& u, int wr, int wc, int fr, int fq) const {
        const int seg = u.pn >> 2;
        bf16_t* O = seg < 5 ? ws5 + (size_t)seg * SEGE : out2 + (size_t)(seg - 5) * SEGE;
        const int row0 = u.pm * BM + wr * 64 + fr, col0 = (u.pn & 3) * BM + wc * 32 + 8 * fq;
        float sv[2][4];
#pragma unroll
        for (int ai = 0; ai < 2; ++ai)
#pragma unroll
            for (int m = 0; m < 4; ++m) sv[ai][m] = rs[row0 + ai * HALF + m * 16];
#pragma unroll
        for (int ai = 0; ai < 2; ++ai)
#pragma unroll
            for (int m = 0; m < 4; ++m) { const int row = row0 + ai * HALF + m * 16; const float s = sv[ai][m]; bf16_t* rowp = O + (size_t)row * 1024 + col0;
#pragma unroll
                for (int bj = 0; bj < 2; ++bj) { f32x4 v0 = acc[ai][bj][m][0] * s, v1 = acc[ai][bj][m][1] * s;
                    if (seg == 1) {
#pragma unroll
                        for (int i = 0; i < 4; ++i) { v0[i] = gelu_tanh_f(v0[i]); v1[i] = gelu_tanh_f(v1[i]); } }
                    else if (seg >= 5) {
#pragma unroll
                        for (int i = 0; i < 4; ++i) { v0[i] = sigmoid_f(v0[i]); v1[i] = sigmoid_f(v1[i]); } }
                    u32x4 w; w.x = cvt_pk_bf16(v0[0], v0[1]); w.y = cvt_pk_bf16(v0[2], v0[3]); w.z = cvt_pk_bf16(v1[0], v1[1]); w.w = cvt_pk_bf16(v1[2], v1[3]);
                    *(u32x4*)(rowp + bj * HALF) = w; } }
    }
};
template <int MODE> struct EpiGate {
    static constexpr bool PERM = true, AFTER_DRAIN = false;
    const bf16_t* G; bf16_t* O;
    __device__ __forceinline__ void operator()(const f32x4 (&acc)[2][2][4][2], const Unit& u, int wr, int wc, int fr, int fq) const {
        const int row0 = u.pm * BM + wr * 64 + fr, col0 = u.pn * BM + wc * 32 + 8 * fq;
#pragma unroll
        for (int ai = 0; ai < 2; ++ai) {
            u32x4 gv[4][2], pv[4][2];
#pragma unroll
            for (int m = 0; m < 4; ++m)
#pragma unroll
                for (int bj = 0; bj < 2; ++bj) { const size_t off = (size_t)(row0 + ai * HALF + m * 16) * 1024 + col0 + bj * HALF; gv[m][bj] = *(const u32x4*)(G + off); if (MODE == 1) pv[m][bj] = *(const u32x4*)(O + off); }
#pragma unroll
            for (int m = 0; m < 4; ++m) { const size_t off = (size_t)(row0 + ai * HALF + m * 16) * 1024 + col0;
#pragma unroll
                for (int bj = 0; bj < 2; ++bj) { const u32x4 g = gv[m][bj];
                    f32x4 v0 = acc[ai][bj][m][0], v1 = acc[ai][bj][m][1];
                    v0[0] *= bf_lo(g.x); v0[1] *= bf_hi(g.x); v0[2] *= bf_lo(g.y); v0[3] *= bf_hi(g.y); v1[0] *= bf_lo(g.z); v1[1] *= bf_hi(g.z); v1[2] *= bf_lo(g.w); v1[3] *= bf_hi(g.w);
                    if (MODE == 1) { const u32x4 p = pv[m][bj];
                        v0[0] += bf_lo(p.x); v0[1] += bf_hi(p.x); v0[2] += bf_lo(p.y); v0[3] += bf_hi(p.y); v1[0] += bf_lo(p.z); v1[1] += bf_hi(p.z); v1[2] += bf_lo(p.w); v1[3] += bf_hi(p.w); }
                    u32x4 w; w.x = cvt_pk_bf16(v0[0], v0[1]); w.y = cvt_pk_bf16(v0[2], v0[3]); w.z = cvt_pk_bf16(v1[0], v1[1]); w.w = cvt_pk_bf16(v1[2], v1[3]);
                    *(u32x4*)(O + off + bj * HALF) = w; } } }
    }
};
struct EpiX1 {
    static constexpr bool PERM = false, AFTER_DRAIN = false;
    const float* X; float* O;
    __device__ __forceinline__ void operator()(const f32x4 (&acc)[2][2][4][2], const Unit& u, int wr, int wc, int fr, int fq) const {
        const int row0 = u.pm * BM + wr * 64 + fr, col0 = u.pn * BM + wc * 32 + 4 * fq;
#pragma unroll
        for (int ai = 0; ai < 2; ++ai)
#pragma unroll
            for (int mp = 0; mp < 2; ++mp) { f32x4 xv[2][2][2];
#pragma unroll
                for (int mm = 0; mm < 2; ++mm)
#pragma unroll
                    for (int bj = 0; bj < 2; ++bj)
#pragma unroll
                        for (int n = 0; n < 2; ++n) xv[mm][bj][n] = *(const f32x4*)(X + (size_t)(row0 + ai * HALF + (2 * mp + mm) * 16) * 1024 + col0 + bj * HALF + n * 16);
#pragma unroll
                for (int mm = 0; mm < 2; ++mm)
#pragma unroll
                    for (int bj = 0; bj < 2; ++bj)
#pragma unroll
                        for (int n = 0; n < 2; ++n) *(f32x4*)(O + (size_t)(row0 + ai * HALF + (2 * mp + mm) * 16) * 1024 + col0 + bj * HALF + n * 16) = xv[mm][bj][n] + acc[ai][bj][2 * mp + mm][n]; }
    }
};
struct EpiSwiGLU {
    static constexpr bool PERM = true, AFTER_DRAIN = false;
    bf16_t* HB; const float* srs;
    __device__ __forceinline__ void operator()(const f32x4 (&acc)[2][2][4][2], const Unit& u, int wr, int wc, int fr, int fq) const {
        const int row0 = u.pm * BM + wr * 64 + fr, col0 = (u.pn & 3) * HALF + wc * 32 + 8 * fq;
        float sv[2][4];
#pragma unroll
        for (int ai = 0; ai < 2; ++ai)
#pragma unroll
            for (int m = 0; m < 4; ++m) sv[ai][m] = srs[row0 + ai * HALF + m * 16];
#pragma unroll
        for (int ai = 0; ai < 2; ++ai)
#pragma unroll
            for (int m = 0; m < 4; ++m) { const int row = row0 + ai * HALF + m * 16; const float s = sv[ai][m];
                float o[8];
#pragma unroll
                for (int n = 0; n < 2; ++n)
#pragma unroll
                    for (int i = 0; i < 4; ++i) { const float g = acc[ai][0][m][n][i] * s, uu = acc[ai][1][m][n][i] * s; o[n * 4 + i] = g * sigmoid_f(g) * uu; }
                u32x4 w; w.x = cvt_pk_bf16(o[0], o[1]); w.y = cvt_pk_bf16(o[2], o[3]); w.z = cvt_pk_bf16(o[4], o[5]); w.w = cvt_pk_bf16(o[6], o[7]);
                *(u32x4*)(HB + (size_t)row * 512 + col0) = w; }
    }
};
struct EpiY {
    static constexpr bool PERM = true, AFTER_DRAIN = false;
    bf16_t* Y; const float* sw;
    __device__ __forceinline__ void operator()(const f32x4 (&acc)[2][2][4][2], const Unit& u, int wr, int wc, int fr, int fq) const {
        const int row0 = u.pm * BM + wr * 64 + fr, col0 = (u.pn & 3) * BM + wc * 32 + 8 * fq;
        float sv[2][4];
#pragma unroll
        for (int ai = 0; ai < 2; ++ai)
#pragma unroll
            for (int m = 0; m < 4; ++m) sv[ai][m] = sw[row0 + ai * HALF + m * 16];
#pragma unroll
        for (int ai = 0; ai < 2; ++ai)
#pragma unroll
            for (int m = 0; m < 4; ++m) { const int row = row0 + ai * HALF + m * 16; const float s = sv[ai][m]; bf16_t* rowp = Y + (size_t)row * 1024 + col0;
#pragma unroll
                for (int bj = 0; bj < 2; ++bj) { const f32x4 v0 = acc[ai][bj][m][0] * s, v1 = acc[ai][bj][m][1] * s;
                    u32x4 w; w.x = cvt_pk_bf16(v0[0], v0[1]); w.y = cvt_pk_bf16(v0[2], v0[3]); w.z = cvt_pk_bf16(v1[0], v1[1]); w.w = cvt_pk_bf16(v1[2], v1[3]);
                    *(u32x4*)(rowp + bj * HALF) = w; } }
    }
};
struct GroupedOrder {
    const PG8_LAS int* tile_e; int nunits, G, c;
    __device__ __forceinline__ bool next(int i, Unit& u) const { const int L = i * G + c; if (L >= nunits) return false; u.pm = L >> 2; u.pn = tile_e[u.pm] * 4 + (L & 3); return true; }
    __device__ __forceinline__ void a_ready(const Unit&) const {}
    __device__ __forceinline__ void done(const Unit&) const {}
};
template <class Epi, class Sched, bool ALIGN_EPI = false, bool SP2 = false>
__device__ __forceinline__ void gemm_phase(PG8_LAS unsigned char* lds, const Gemm g, const Sched& S, const Epi& E) {
    const int tid = threadIdx.x, wid = __builtin_amdgcn_readfirstlane(tid >> 6), lane = tid & 63, wr = wid >> 2, wc = wid & 3, fr = lane & 15, fq = lane >> 4;
    const int K = g.K, nt = K / BK;
    unsigned voffA[2], voffB[2];
#pragma unroll
    for (int i = 0; i < 2; ++i) { int R, C; stage_rc(tid * 16 + i * 8192, R, C); const int Rb = Epi::PERM ? ((R & ~31) + perm32(R & 31)) : R;
        voffA[i] = (unsigned)(R * K + C) * 2u; voffB[i] = (unsigned)(Rb * K + C) * 2u; }
    const size_t kstep = (size_t)(BK * 2);
    const size_t hstep = (size_t)HALF * K * 2;
    const size_t tstep = 2 * hstep;
    const unsigned ldsw = (unsigned)wid * 1024u;
    const int aoff = lds_byte(wr * 64 + fr, fq * 8), boff = lds_byte(wc * 32 + fr, fq * 8);
#define PG8_SA(b, h) (((b) * 2 + (h)) * HTB)
#define PG8_SB(b, h) ((4 + (b) * 2 + (h)) * HTB)
#define PG8_STAGE(bufoff, gbase, voff) do { _Pragma("unroll") for (int _i = 0; _i < 2; ++_i) \
        __builtin_amdgcn_global_load_lds((const unsigned*)((const char*)(gbase) + (voff)[_i]), (PG8_LAS unsigned*)(lds + (bufoff) + ldsw + _i * 8192), 16, 0, 0); } while (0)
#define PG8_LDA(dst, b, h) do { _Pragma("unroll") for (int m = 0; m < 4; ++m) _Pragma("unroll") for (int k = 0; k < 2; ++k) dst[m][k] = *(const PG8_LAS bf16x8*)(lds + PG8_SA(b, h) + aoff + m * 2048 + k * 1024); } while (0)
#define PG8_LDB(dst, b, h) do { _Pragma("unroll") for (int n = 0; n < 2; ++n) _Pragma("unroll") for (int k = 0; k < 2; ++k) dst[n][k] = *(const PG8_LAS bf16x8*)(lds + PG8_SB(b, h) + boff + n * 2048 + k * 1024); } while (0)
#define PG8_MMA(ai, bj, At, Bt) do { __builtin_amdgcn_s_setprio(1); _Pragma("unroll") for (int m = 0; m < 4; ++m) _Pragma("unroll") for (int n = 0; n < 2; ++n) _Pragma("unroll") for (int k = 0; k < 2; ++k) \
        acc[ai][bj][m][n] = __builtin_amdgcn_mfma_f32_16x16x32_bf16(Bt[n][k], At[m][k], acc[ai][bj][m][n], 0, 0, 0); __builtin_amdgcn_s_setprio(0); } while (0)
#define PG8_WAIT_V(n) asm volatile("s_waitcnt vmcnt(" #n ")" ::: "memory")
#define PG8_WAIT_L(n) asm volatile("s_waitcnt lgkmcnt(" #n ")" ::: "memory")
#define PG8_BAR __builtin_amdgcn_s_barrier()
#define PG8_SCHED __builtin_amdgcn_sched_barrier(0)
    Unit cur, nxt; int ui = 0;
    if (!S.next(0, cur)) return;
    f32x4 acc[2][2][4][2];
#pragma unroll
    for (int a = 0; a < 2; ++a)
#pragma unroll
        for (int b = 0; b < 2; ++b)
#pragma unroll
            for (int m = 0; m < 4; ++m)
#pragma unroll
                for (int n = 0; n < 2; ++n) acc[a][b][m][n] = (f32x4){0.f, 0.f, 0.f, 0.f};
    bf16x8 At[4][2], B0[2][2], B1[2][2];
    const char* cA = (const char*)g.A + (size_t)cur.pm * tstep; const char* cB = (const char*)g.Bt + (size_t)cur.pn * tstep;
    S.a_ready(cur);
    if constexpr (SP2) {
        PG8_STAGE(PG8_SB(0, 0), cB, voffB); PG8_STAGE(PG8_SB(0, 1), cB + hstep, voffB); PG8_STAGE(PG8_SA(0, 0), cA, voffA); PG8_STAGE(PG8_SA(0, 1), cA + hstep, voffA);
        if (wr == 1) PG8_BAR;
        PG8_WAIT_V(2); PG8_BAR;
        PG8_STAGE(PG8_SB(1, 0), cB + kstep, voffB); PG8_STAGE(PG8_SA(1, 0), cA + kstep, voffA); PG8_STAGE(PG8_SB(1, 1), cB + hstep + kstep, voffB);
        PG8_WAIT_V(6); PG8_BAR;
    } else {
        PG8_STAGE(PG8_SB(0, 0), cB, voffB); PG8_STAGE(PG8_SA(0, 0), cA, voffA); PG8_STAGE(PG8_SB(0, 1), cB + hstep, voffB); PG8_STAGE(PG8_SA(0, 1), cA + hstep, voffA);
        if (wr == 1) PG8_BAR;
        PG8_WAIT_V(4); PG8_BAR;
        PG8_STAGE(PG8_SB(1, 0), cB + kstep, voffB); PG8_STAGE(PG8_SA(1, 0), cA + kstep, voffA); PG8_STAGE(PG8_SB(1, 1), cB + hstep + kstep, voffB);
        PG8_WAIT_V(6); PG8_BAR;
    }
    for (;;) {
        const bool has_next = S.next(ui + 1, nxt);
        const char* nA = has_next ? (const char*)g.A + (size_t)nxt.pm * tstep : cA; const char* nB = has_next ? (const char*)g.Bt + (size_t)nxt.pn * tstep : cB;
        for (int t = 0; t < nt; t += 2) {
            const bool last = (t == nt - 2);
            const char* a1 = cA + (size_t)(t + 1) * kstep;
            const char* a2 = last ? nA : cA + (size_t)(t + 2) * kstep; const char* b2 = last ? nB : cB + (size_t)(t + 2) * kstep;
            const char* a3 = a2 + kstep; const char* b3 = b2 + kstep;
            if (last && has_next) S.a_ready(nxt);
            if constexpr (SP2) {
            PG8_LDB(B0, 0, 0); PG8_LDB(B1, 0, 1); PG8_SCHED; PG8_LDA(At, 0, 0); PG8_STAGE(PG8_SA(1, 1), a1 + hstep, voffA);
            PG8_WAIT_V(8); PG8_WAIT_L(0); PG8_BAR; PG8_MMA(0, 0, At, B0); PG8_MMA(0, 1, At, B1); PG8_BAR; PG8_SCHED;
            PG8_LDA(At, 0, 1); PG8_STAGE(PG8_SB(0, 0), b2, voffB); PG8_STAGE(PG8_SB(0, 1), b2 + hstep, voffB); PG8_STAGE(PG8_SA(0, 0), a2, voffA);
            PG8_WAIT_V(8); PG8_WAIT_L(0); PG8_BAR; PG8_MMA(1, 0, At, B0); PG8_MMA(1, 1, At, B1); PG8_BAR; PG8_SCHED;
            PG8_LDB(B0, 1, 0); PG8_LDB(B1, 1, 1); PG8_SCHED; PG8_LDA(At, 1, 0); PG8_STAGE(PG8_SA(0, 1), a2 + hstep, voffA);
            PG8_WAIT_V(8); PG8_WAIT_L(0); PG8_BAR; PG8_MMA(0, 0, At, B0); PG8_MMA(0, 1, At, B1); PG8_BAR; PG8_SCHED;
            PG8_LDA(At, 1, 1); PG8_STAGE(PG8_SB(1, 0), b3, voffB); PG8_STAGE(PG8_SB(1, 1), b3 + hstep, voffB); PG8_STAGE(PG8_SA(1, 0), a3, voffA);
            PG8_WAIT_V(8); PG8_WAIT_L(0); PG8_BAR; PG8_MMA(1, 0, At, B0); PG8_MMA(1, 1, At, B1); PG8_BAR; PG8_SCHED;
            } else {
            PG8_LDB(B0, 0, 0); PG8_SCHED; PG8_LDA(At, 0, 0); PG8_STAGE(PG8_SA(1, 1), a1 + hstep, voffA);
            PG8_WAIT_L(8); PG8_BAR; PG8_WAIT_L(0); PG8_MMA(0, 0, At, B0); PG8_BAR; PG8_SCHED;
            PG8_LDB(B1, 0, 1); PG8_STAGE(PG8_SB(0, 0), b2, voffB);
            PG8_BAR; PG8_WAIT_L(0); PG8_MMA(0, 1, At, B1); PG8_BAR;
            PG8_LDA(At, 0, 1); PG8_STAGE(PG8_SA(0, 0), a2, voffA);
            PG8_BAR; PG8_WAIT_L(0); PG8_MMA(1, 0, At, B0); PG8_BAR; PG8_SCHED;
            PG8_STAGE(PG8_SB(0, 1), b2 + hstep, voffB);
            PG8_WAIT_V(6); PG8_BAR; PG8_MMA(1, 1, At, B1); PG8_BAR;
            PG8_LDB(B0, 1, 0); PG8_SCHED; PG8_LDA(At, 1, 0); PG8_STAGE(PG8_SA(0, 1), a2 + hstep, voffA);
            PG8_WAIT_L(8); PG8_BAR; PG8_WAIT_L(0); PG8_MMA(0, 0, At, B0); PG8_BAR; PG8_SCHED;
            PG8_LDB(B1, 1, 1); PG8_STAGE(PG8_SB(1, 0), b3, voffB);
            PG8_BAR; PG8_WAIT_L(0); PG8_MMA(0, 1, At, B1); PG8_BAR;
            PG8_LDA(At, 1, 1); PG8_STAGE(PG8_SA(1, 0), a3, voffA);
            PG8_BAR; PG8_WAIT_L(0); PG8_MMA(1, 0, At, B0); PG8_BAR; PG8_SCHED;
            PG8_STAGE(PG8_SB(1, 1), b3 + hstep, voffB);
            PG8_WAIT_V(6); PG8_BAR; PG8_MMA(1, 1, At, B1); PG8_BAR;
            }
        }
        if constexpr (ALIGN_EPI) { if (wr == 0) PG8_BAR; }
        if constexpr (!Epi::AFTER_DRAIN) { E(acc, cur, wr, wc, fr, fq); S.done(cur); }
        if (!has_next) break;
#pragma unroll
        for (int a = 0; a < 2; ++a)
#pragma unroll
            for (int b = 0; b < 2; ++b)
#pragma unroll
                for (int m = 0; m < 4; ++m)
#pragma unroll
                    for (int n = 0; n < 2; ++n) acc[a][b][m][n] = (f32x4){0.f, 0.f, 0.f, 0.f};
        cur = nxt; cA = nA; cB = nB; ++ui;
        if constexpr (ALIGN_EPI) { if (wr == 1) PG8_BAR; }
    }
    PG8_WAIT_V(0);
    if constexpr (!ALIGN_EPI) { if (wr == 0) PG8_BAR; }
    PG8_BAR;
    if constexpr (Epi::AFTER_DRAIN) { E.fused(acc, cur, wr, wc, fr, fq, lds, wid, lane); S.done(cur); }
#undef PG8_SA
#undef PG8_SB
#undef PG8_STAGE
#undef PG8_LDA
#undef PG8_LDB
#undef PG8_MMA
#undef PG8_WAIT_V
#undef PG8_WAIT_L
#undef PG8_BAR
#undef PG8_SCHED
}
}
#define GAS __attribute__((address_space(1)))
#define LAS __attribute__((address_space(3)))
typedef unsigned short bf16;
typedef unsigned v4u __attribute__((ext_vector_type(4)));
typedef float f32x4 __attribute__((ext_vector_type(4)));
typedef short bf16x8 __attribute__((ext_vector_type(8)));
typedef GAS unsigned gu32;
typedef GAS unsigned long long gu64;
#define RLX_AGENT __ATOMIC_RELAXED, __HIP_MEMORY_SCOPE_AGENT
#define LDS_WAIT() asm volatile("s_waitcnt lgkmcnt(0)" ::: "memory")
#define VM_WAIT() asm volatile("s_waitcnt vmcnt(0)" ::: "memory")
__device__ __forceinline__ unsigned long long rt() { return __builtin_amdgcn_s_memrealtime(); }
__device__ __forceinline__ unsigned f2bf(float f) { unsigned u = __builtin_bit_cast(unsigned, f); return (u + 0x7fffu + ((u >> 16) & 1u)) >> 16; }
__device__ __forceinline__ unsigned pk2(float lo, float hi) { return f2bf(lo) | (f2bf(hi) << 16); }
#define XB_TMO      128
#define XB_XCNT(j)  (256  + 64 * (j))
#define XB_XSUB(j)  (1280 + 64 * (j))
#define XB_XGEN(j)  (2304 + 64 * (j))
#define XB_TOP      3328
#define XB_TOPGEN   3392
#define XCD_BAR_WORDS 3456
#define XB_SPIN_CAP (1u << 18)

__device__ __forceinline__ unsigned xb_ld(unsigned* p)              { return __hip_atomic_load(p, __ATOMIC_RELAXED, __HIP_MEMORY_SCOPE_AGENT); }
__device__ __forceinline__ unsigned xb_add(unsigned* p, unsigned v) { return __hip_atomic_fetch_add(p, v, __ATOMIC_RELAXED, __HIP_MEMORY_SCOPE_AGENT); }
__device__ __forceinline__ unsigned xb_xcc_id() { return (unsigned)__builtin_amdgcn_s_getreg((3 << 11) | 20) & 0xFu; }
#define XB_SPIN(cond, bar) do { unsigned _sp = 0; while (cond) { __builtin_amdgcn_s_sleep(1); \
    if ((++_sp & 255u) == 0u) { if (xb_ld(&(bar)[XB_TMO])) break; if (_sp > XB_SPIN_CAP) { atomicAdd(&(bar)[XB_TMO], 1u); break; } } } } while (0)

struct XcdBarrier {
    unsigned* bar; unsigned x;
    volatile LAS unsigned* st;
};

__device__ __forceinline__ XcdBarrier xcd_barrier_post(unsigned* bar, volatile LAS unsigned* st) {
    XcdBarrier b; b.bar = bar; b.x = xb_xcc_id(); b.st = st;
    if (threadIdx.x == 0) (void)xb_add(&bar[XB_XCNT(b.x)], 1u);
    return b;
}
__device__ __forceinline__ void xcd_barrier_complete(unsigned* bar, unsigned x, unsigned& nloc, unsigned& nx) {
    const unsigned G = gridDim.x * gridDim.y * gridDim.z;
    unsigned sum, cnt, mine, sp = 0u;
    for (;;) {
        sum = 0u; cnt = 0u; mine = 0u;
#pragma unroll
        for (unsigned j = 0; j < 16; ++j) { const unsigned c = xb_ld(&bar[XB_XCNT(j)]); sum += c; cnt += (c > 0u) ? 1u : 0u; mine = (j == x) ? c : mine; }
        if (sum == G) break;
        __builtin_amdgcn_s_sleep(1);
        if ((++sp & 255u) == 0u) { if (xb_ld(&bar[XB_TMO])) break; if (sp > XB_SPIN_CAP) { atomicAdd(&bar[XB_TMO], 1u); break; } }
    }
    nloc = mine > 0u ? mine : 1u; nx = cnt > 0u ? cnt : 1u;
}

__device__ __forceinline__ void xcd_barrier(const XcdBarrier& b) {
    asm volatile("s_waitcnt vmcnt(0)" ::: "memory");
    __syncthreads();
    if (threadIdx.x == 0) {
        unsigned* bar = b.bar;
        __builtin_amdgcn_s_waitcnt(0);
        unsigned nloc = b.st[0], nx = b.st[1];
        if (nloc == 0u) { xcd_barrier_complete(bar, b.x, nloc, nx); b.st[0] = nloc; b.st[1] = nx; }
        const unsigned old = xb_add(&bar[XB_XSUB(b.x)], 1u);
        const unsigned gen = old / nloc;
        if (old + 1u == (gen + 1u) * nloc) {
            __builtin_amdgcn_fence(__ATOMIC_RELEASE, "agent");
            asm volatile("s_waitcnt vmcnt(0)" ::: "memory");
            const unsigned og = xb_add(&bar[XB_TOP], 1u);
            const unsigned tg = og / nx;
            if (og + 1u == (tg + 1u) * nx) xb_add(&bar[XB_TOPGEN], 1u);
            else XB_SPIN(xb_ld(&bar[XB_TOPGEN]) == tg, bar);
            __builtin_amdgcn_fence(__ATOMIC_ACQUIRE, "agent");
            xb_add(&bar[XB_XGEN(b.x)], 1u);
            asm volatile("s_waitcnt vmcnt(0)" ::: "memory");
        } else {
            XB_SPIN(xb_ld(&bar[XB_XGEN(b.x)]) == gen, bar);
            __builtin_amdgcn_fence(__ATOMIC_ACQUIRE, "agent");
            asm volatile("s_waitcnt vmcnt(0)" ::: "memory");
        }
    }
    __syncthreads();
}
namespace fattn {
typedef unsigned short bf16;
typedef short bf16x8 __attribute__((ext_vector_type(8)));
typedef short s16x4 __attribute__((ext_vector_type(4)));
typedef float f32x16 __attribute__((ext_vector_type(16)));
typedef float f32x4 __attribute__((ext_vector_type(4)));
typedef unsigned u32x4 __attribute__((ext_vector_type(4)));
constexpr int D = 128, LD = 1024, SEQ = 4096;
constexpr float THR = 8.f;
constexpr float SCALE = 0.08838834764831845f;
constexpr int NW = 8, QBLK = 32, KVBLK = 64, QB = NW * QBLK;
constexpr int SHM_V = KVBLK * D * 2, SHM_K = KVBLK * D * 2;
constexpr int OFF_WS = 2 * SHM_V + 2 * SHM_K, OFF_BIAS = OFF_WS + NW * 64 * 4, LDS_BYTES = OFF_BIAS + 2 * 64 * 4;

#define KSWZ(row, colB) ((row) * 256 + ((colB) ^ (((row) & 7) << 4)))
#define SBAR() __builtin_amdgcn_sched_barrier(0)
__device__ __forceinline__ int v_st(int k, int c) { const int kk = (k & ~0xC) | ((k & 4) << 1) | ((k & 8) >> 1); return ((kk >> 3) * 4 + (c >> 5)) * 512 + ((kk & 7) * 32 + (c & 31)) * 2; }
__device__ __forceinline__ int v_rd_base(int lane) { return ((lane & 3) << 3) | (((lane >> 2) & 3) << 6) | (((lane >> 4) & 1) << 5) | (((lane >> 5) & 1) << 8); }
constexpr int v_rd_off(int d0, int ks, int half) { return d0 * 512 + ks * 4096 + half * 2048; }
__device__ __forceinline__ int crow(int r, int hi) { return (r & 3) + 8 * (r >> 2) + 4 * hi; }
__device__ __forceinline__ unsigned cvtpk(float lo, float hi) { unsigned r; asm volatile("v_cvt_pk_bf16_f32 %0, %1, %2" : "=v"(r) : "v"(lo), "v"(hi)); return r; }
__device__ __forceinline__ bf16x8 load8(const bf16* p) { return *reinterpret_cast<const bf16x8*>(p); }
__device__ __forceinline__ void mask_tile(f32x16& p0, f32x16& p1, int dq) {
    const float NEG = -__builtin_inff();
#pragma unroll
    for (int r = 0; r < 16; ++r) {
        const int c = (r & 3) + 8 * (r >> 2);
        if (dq - c < 0) p0[r] = NEG;
        if (dq - c - 32 < 0) p1[r] = NEG;
    }
}
__device__ __forceinline__ void partialSM(f32x16& p0, f32x16& p1, float& m_reg, float& mn, float& alpha) {
    float pmax = p0[0]; for (int r = 1; r < 16; ++r) pmax = fmaxf(pmax, p0[r]); for (int r = 0; r < 16; ++r) pmax = fmaxf(pmax, p1[r]);
    { auto rr = __builtin_amdgcn_permlane32_swap(__float_as_uint(pmax), __float_as_uint(pmax), false, false);
      pmax = fmaxf(__uint_as_float(rr[0]), __uint_as_float(rr[1])); }
    constexpr float C2 = 1.4426950408889634f * SCALE;
    if (__builtin_expect(__all((pmax - m_reg) * SCALE <= THR), 1)) { mn = m_reg; alpha = 1.f; }
    else { mn = fmaxf(m_reg, pmax); alpha = __builtin_amdgcn_exp2f((m_reg - mn) * C2); m_reg = mn; }
    const float mnL = -mn * C2;
    for (int r = 0; r < 16; ++r) p0[r] = fmaf(p0[r], C2, mnL); for (int r = 0; r < 16; ++r) p1[r] = fmaf(p1[r], C2, mnL);
    for (int r = 0; r < 16; ++r) p0[r] = __builtin_amdgcn_exp2f(p0[r]);
}
__device__ __forceinline__ void finishSM(f32x16& p0, f32x16& p1, float alpha, float& l_reg, bf16x8& pa0, bf16x8& pa1, bf16x8& pa2, bf16x8& pa3) {
    for (int r = 0; r < 16; ++r) p1[r] = __builtin_amdgcn_exp2f(p1[r]);
    float ps = 0; for (int r = 0; r < 16; ++r) ps += p0[r]; for (int r = 0; r < 16; ++r) ps += p1[r];
    { auto rr = __builtin_amdgcn_permlane32_swap(__float_as_uint(ps), __float_as_uint(ps), false, false);
      ps = __uint_as_float(rr[0]) + __uint_as_float(rr[1]); }
    l_reg = l_reg * alpha + ps;
#define PK4(P, B_, OUT) do { unsigned a0 = cvtpk(P[B_+0], P[B_+1]), a1 = cvtpk(P[B_+2], P[B_+3]);                          \
        unsigned b0 = cvtpk(P[B_+4], P[B_+5]), b1 = cvtpk(P[B_+6], P[B_+7]);                                             \
        auto r0 = __builtin_amdgcn_permlane32_swap(a0, b0, false, false); auto r1 = __builtin_amdgcn_permlane32_swap(a1, b1, false, false); \
        u32x4 w = {r0[0], r1[0], r0[1], r1[1]}; OUT = *reinterpret_cast<bf16x8*>(&w); } while (0)
    PK4(p0, 0, pa0); PK4(p0, 8, pa1); PK4(p1, 0, pa2); PK4(p1, 8, pa3);
#undef PK4
}
template <int KB>
__device__ __forceinline__ void qkt(f32x16& p0, f32x16& p1, const char* K_lds, const char* Bias_lds, int r32, int hi, const bf16x8* qr) {
    { const f32x4* bb = reinterpret_cast<const f32x4*>(Bias_lds + KB * 256 + hi * 16);
      const f32x4 a0 = bb[0], a1 = bb[2], a2 = bb[4], a3 = bb[6], c0 = bb[8], c1 = bb[10], c2 = bb[12], c3 = bb[14];
      p0 = (f32x16){a0[0], a0[1], a0[2], a0[3], a1[0], a1[1], a1[2], a1[3], a2[0], a2[1], a2[2], a2[3], a3[0], a3[1], a3[2], a3[3]};
      p1 = (f32x16){c0[0], c0[1], c0[2], c0[3], c1[0], c1[1], c1[2], c1[3], c2[0], c2[1], c2[2], c2[3], c3[0], c3[1], c3[2], c3[3]}; }
    const char* kb[4];
#pragma unroll
    for (int dd = 0; dd < 4; ++dd) kb[dd] = K_lds + KB * SHM_K + KSWZ(r32, (dd * 16 + hi * 8) * 2);
#pragma unroll
    for (int d0 = 0; d0 < 8; ++d0) { const char* a = kb[d0 & 3] + (d0 >> 2) * 128;
        bf16x8 b0 = *reinterpret_cast<const bf16x8*>(a);
        bf16x8 b1 = *reinterpret_cast<const bf16x8*>(a + 32 * 256);
        p0 = __builtin_amdgcn_mfma_f32_32x32x16_bf16(b0, qr[d0], p0, 0, 0, 0);
        p1 = __builtin_amdgcn_mfma_f32_32x32x16_bf16(b1, qr[d0], p1, 0, 0, 0); }
}
template <int VB>
__device__ __forceinline__ void pv_tile(f32x16* o, int vb0, bf16x8 pa0, bf16x8 pa1, bf16x8 pa2, bf16x8 pa3) {
#define TRRD(dst, off) asm volatile("ds_read_b64_tr_b16 %0, %1 offset:%2" : "=&v"(dst) : "v"(vb0), "i"(off) : "memory")
#define PV_D0(d0) do { s16x4 l0, l1, l2, l3, h0, h1, h2, h3; constexpr int b_ = VB * SHM_V + v_rd_off(d0, 0, 0);   \
        TRRD(l0, b_); TRRD(h0, b_ + 2048); TRRD(l1, b_ + 4096); TRRD(h1, b_ + 6144); TRRD(l2, b_ + 8192); TRRD(h2, b_ + 10240); TRRD(l3, b_ + 12288); TRRD(h3, b_ + 14336); \
        asm volatile("s_waitcnt lgkmcnt(0)" ::: "memory"); SBAR();                                                    \
        o[d0] = __builtin_amdgcn_mfma_f32_32x32x16_bf16(pa0, (bf16x8){l0[0], l0[1], l0[2], l0[3], h0[0], h0[1], h0[2], h0[3]}, o[d0], 0, 0, 0);   \
        o[d0] = __builtin_amdgcn_mfma_f32_32x32x16_bf16(pa1, (bf16x8){l1[0], l1[1], l1[2], l1[3], h1[0], h1[1], h1[2], h1[3]}, o[d0], 0, 0, 0);   \
        o[d0] = __builtin_amdgcn_mfma_f32_32x32x16_bf16(pa2, (bf16x8){l2[0], l2[1], l2[2], l2[3], h2[0], h2[1], h2[2], h2[3]}, o[d0], 0, 0, 0);   \
        o[d0] = __builtin_amdgcn_mfma_f32_32x32x16_bf16(pa3, (bf16x8){l3[0], l3[1], l3[2], l3[3], h3[0], h3[1], h3[2], h3[3]}, o[d0], 0, 0, 0); } while (0)
    PV_D0(0); PV_D0(1); PV_D0(2); PV_D0(3);
#undef PV_D0
#undef TRRD
}

struct Bases { bf16* Q; const bf16* K; const bf16* V; const float* CB; };
struct BlockRef { unsigned qo, kvo, cbo; int P0; };
struct Seam { bf16x8 qr[8]; bf16x8 st_v0, st_v1, st_k0, st_k1; float st_b; };
#define ROW(p, k0, rr) ((p) + (unsigned)(((k0) + (rr)) * LD + sc))
#define VMW() asm volatile("s_waitcnt vmcnt(0)" ::: "memory")
#define VMWN(n) asm volatile("s_waitcnt vmcnt(%0)" :: "i"(n) : "memory")
#define SLOAD_H(Kp, Vp, CBp, k0) do { S.st_v0 = load8(ROW(Vp, k0, sr)); S.st_v1 = load8(ROW(Vp, k0, 32 + sr));              \
                         S.st_k0 = load8(ROW(Kp, k0, sr)); S.st_k1 = load8(ROW(Kp, k0, 32 + sr)); S.st_b = (CBp)[(unsigned)((k0) + lane)]; } while (0)
#define SWRITE_HK(bf, cref_) do { *(bf16x8*)(K_lds + (bf) * SHM_K + kws) = S.st_k0; *(bf16x8*)(K_lds + (bf) * SHM_K + kws + 32 * 256) = S.st_k1; \
                           if (wid == 0) *(float*)(B_lds + (bf) * 256 + lane * 4) = S.st_b; } while (0)
#define SWRITE_HV(bf) do { *(bf16x8*)(V_lds + (bf) * SHM_V + vst0) = S.st_v0; *(bf16x8*)(V_lds + (bf) * SHM_V + vst1) = S.st_v1; } while (0)
#define SWRITE_H(bf) do { SWRITE_HV(bf); SWRITE_HK(bf, cref); } while (0)
__device__ __forceinline__ void prime(const Bases& G, const BlockRef& cur, char* lds, Seam& S) {
    const int tid = threadIdx.x, wid = __builtin_amdgcn_readfirstlane(tid >> 6), lane = tid & 63, r32 = lane & 31, hi = lane >> 5;
    const int sr = tid >> 4, sc = (tid & 15) * 8, kws = KSWZ(sr, sc * 2); char* K_lds = lds + 2 * SHM_V; char* B_lds = lds + OFF_BIAS;
    for (int d0 = 0; d0 < 8; ++d0) S.qr[d0] = load8(G.Q + (cur.qo + (unsigned)((wid * QBLK + r32) * LD + d0 * 16 + hi * 8)));
    const float cref = 0.f; (void)cref;
    SLOAD_H(G.K + cur.kvo, G.V + cur.kvo, G.CB + cur.cbo, 0); VMW(); SWRITE_HK(0, cref);
    __syncthreads();
}
__device__ __forceinline__ void block(const Bases& G, const BlockRef& cur, const BlockRef& nxt, char* lds, Seam& S) {
    const int tid = threadIdx.x, wid = __builtin_amdgcn_readfirstlane(tid >> 6), lane = tid & 63, r32 = lane & 31, hi = lane >> 5;
    const int NT = (cur.P0 + QB - 1) / KVBLK + 1;
    const int qlo = cur.P0 + wid * QBLK, qm = qlo + r32 - 4 * hi;
    char* V_lds = lds; char* K_lds = lds + 2 * SHM_V; char* B_lds = lds + OFF_BIAS;
    float* ws = (float*)(lds + OFF_WS) + wid * 64; float* li_l = ws, * al_l = ws + 32;
    float m_reg = -1e30f, l_reg = 0; f32x16 o[4] = {};
    const int sr = tid >> 4, sc = (tid & 15) * 8, vst0 = v_st(sr, sc), vst1 = v_st(32 + sr, sc), kws = KSWZ(sr, sc * 2);
    const int vb0 = (int)(uintptr_t)V_lds + v_rd_base(lane);
    const bf16* Kh = G.K + cur.kvo; const bf16* Vh = G.V + cur.kvo; const float* CBh = G.CB + cur.cbo;
    const float cref = 0.f, crefn = 0.f; (void)cref; (void)crefn;
#define RESC(a) do { if (__any((a) < 1.f)) { if (hi == 0) al_l[r32] = (a); asm volatile("s_waitcnt lgkmcnt(0)" ::: "memory");              \
                     for (int d_ = 0; d_ < 4; ++d_) for (int r = 0; r < 16; ++r) o[d_][r] *= al_l[crow(r, hi)]; } } while (0)
#define KBASE(t) ((t) * KVBLK)
#define MASKT(P0_, P1_, t) do { const int kb_ = KBASE(t); if (kb_ + KVBLK - 1 > qlo) mask_tile(P0_, P1_, qm - kb_); } while (0)
    constexpr int NQL = 8;
#define SEAM_K0() do { VMWN(NQL); SWRITE_HK(0, crefn); SBAR(); } while (0)
    f32x16 pA0, pA1, pB0, pB1; float mnA, mnB, alA, alB; bf16x8 pa0, pa1, pa2, pa3;
    SWRITE_HV(0); SBAR();
    if (NT > 1) { SLOAD_H(Kh, Vh, CBh, KBASE(1)); }
    SBAR(); qkt<0>(pA0, pA1, K_lds, B_lds, r32, hi, S.qr);
    MASKT(pA0, pA1, 0); partialSM(pA0, pA1, m_reg, mnA, alA);
    if (NT > 1) { VMW(); SWRITE_H(1); }
    __syncthreads();
#define HALF_STEP(PX0, PX1, mnX, alX, PY0, PY1, alY, t, KB, VB, SB) do {                                                      \
        SBAR(); qkt<KB>(PX0, PX1, K_lds, B_lds, r32, hi, S.qr);                                                                \
        finishSM(PY0, PY1, alY, l_reg, pa0, pa1, pa2, pa3); SBAR();                                                           \
        if ((t) + 1 < NT) { SLOAD_H(Kh, Vh, CBh, KBASE((t) + 1)); SBAR(); }                                              \
        pv_tile<VB>(o, vb0, pa0, pa1, pa2, pa3); MASKT(PX0, PX1, (t)); partialSM(PX0, PX1, m_reg, mnX, alX);                   \
        __syncthreads();                                                                                                      \
        if ((t) + 1 < NT) { VMW(); SWRITE_H(SB); }                                                                            \
        RESC(alX); __syncthreads(); } while (0)
    for (int t = 1; t + 1 < NT; t += 2) {
        HALF_STEP(pB0, pB1, mnB, alB, pA0, pA1, alA, t, 1, 0, 0);
        HALF_STEP(pA0, pA1, mnA, alA, pB0, pB1, alB, t + 1, 0, 1, 1);
    }
    constexpr bool even = true;
    if (even) { SBAR(); qkt<1>(pB0, pB1, K_lds, B_lds, r32, hi, S.qr); SBAR(); }
    { SLOAD_H(G.K + nxt.kvo, G.V + nxt.kvo, G.CB + nxt.cbo, 0); SBAR();
#pragma unroll
      for (int d0 = 0; d0 < 8; ++d0) S.qr[d0] = load8(G.Q + (nxt.qo + (unsigned)((wid * QBLK + r32) * LD + d0 * 16 + hi * 8))); }
    SBAR();
    finishSM(pA0, pA1, alA, l_reg, pa0, pa1, pa2, pa3); SBAR();
    pv_tile<0>(o, vb0, pa0, pa1, pa2, pa3);
    if (even) { MASKT(pB0, pB1, NT - 1); partialSM(pB0, pB1, m_reg, mnB, alB); __syncthreads(); RESC(alB);
        finishSM(pB0, pB1, alB, l_reg, pa0, pa1, pa2, pa3); SBAR(); pv_tile<1>(o, vb0, pa0, pa1, pa2, pa3); }
    SBAR(); SEAM_K0();
    if (hi == 0) li_l[r32] = l_reg; asm volatile("s_waitcnt lgkmcnt(0)" ::: "memory");
    float rli[16];
#pragma unroll
    for (int r = 0; r < 16; ++r) rli[r] = __builtin_amdgcn_rcpf(li_l[crow(r, hi)]);
    bf16* Ow = G.Q + (cur.qo + (unsigned)(wid * QBLK * LD));
#pragma unroll
    for (int r = 0; r < 16; ++r) { const int orow = crow(r, hi);
#pragma unroll
        for (int d0 = 0; d0 < 4; ++d0) { const float v = o[d0][r] * rli[r];
            const float vn = __shfl_xor(v, 1);
            if ((r32 & 1) == 0) *(unsigned*)(Ow + (unsigned)(orow * LD + d0 * 32 + r32)) = cvtpk(v, vn); } }
    __syncthreads();
#undef RESC
#undef KBASE
#undef MASKT
#undef SEAM_K0
#undef HALF_STEP
}
#undef ROW
#undef VMW
#undef VMWN
#undef SLOAD_H
#undef SWRITE_HK
#undef SWRITE_HV
#undef SWRITE_H
#undef KSWZ
#undef SBAR
}
constexpr int NB = 8, SEQ = 4096, T = NB * SEQ, DM = 1024, NH = 8, HD = 128, INW = 7176, NZ = 7168;
constexpr int NE = 32, DE = 512;
constexpr float EPS = 1e-6f;
constexpr int PMAX = 73728;
constexpr int NWAVES = 8;
constexpr size_t MiB = 1u << 20;
constexpr size_t WS_CTL = 0, CTL_ZERO_BYTES = 1 * MiB;
constexpr size_t WS_RS1 = 1 * MiB, WS_RS2 = 1 * MiB + 256 * 1024;
constexpr size_t WS_LF = 1 * MiB + 512 * 1024;
constexpr size_t WS_CB = 2 * MiB + 512 * 1024;
constexpr size_t WS_TOK = 3 * MiB + 512 * 1024;
constexpr size_t WS_LISTS = 5 * MiB;
constexpr size_t WS_WRT = 9 * MiB;
constexpr size_t WS_SRS = 9 * MiB + 512 * 1024, WS_SW = 10 * MiB;
constexpr size_t WS_WIN = 16 * MiB;
constexpr size_t WS_WL = 30 * MiB, WS_WA = 32 * MiB, WS_WO = 34 * MiB;
constexpr size_t WS_WRG = 36 * MiB;
constexpr size_t WS_XB = 40 * MiB;
constexpr size_t WS_XR = 104 * MiB;
constexpr size_t WS_GG = 168 * MiB;
constexpr size_t WS_Q = 232 * MiB, WS_K = 296 * MiB, WS_V = 360 * MiB;
constexpr size_t WS_W13 = 296 * MiB;
constexpr size_t WS_W2 = 360 * MiB;
constexpr size_t WS_XG = 104 * MiB;
constexpr size_t WS_HB = 424 * MiB;
constexpr size_t WS_END = 512 * MiB;
static_assert(WS_XG + (size_t)PMAX * 2048 <= WS_K && WS_HB + (size_t)PMAX * 1024 <= WS_END && WS_W2 + 32u * 1024 * 512 * 2 <= WS_HB, "d_ws map");
constexpr int CW_TMO = 0, CW_CODE = 1, CW_BAR = 4096, CW_CNT = 8192;
constexpr int RING_OFF = 0, RING_BYTES = 131072;
constexpr int LDSCTL_OFF = RING_BYTES, MISC_OFF = LDSCTL_OFF + 320;
constexpr int TBL_OFF = RING_BYTES + 1024;
constexpr int TBL_PS = TBL_OFF, TBL_CN = TBL_OFF + 256, TBL_TE = TBL_OFF + 512;
constexpr int RG_TOT = RING_BYTES + 4096, RG_CAR = RG_TOT + 4096;
constexpr int LDS_BYTES = 147456;

#include <cmath>
using pg8::bf_lo; using pg8::bf_hi; using pg8::sigmoid_f;

struct Frame {
    LAS unsigned char* lds;
    int tid, lane, wave, vcu, G;
};
__device__ __forceinline__ float wave_sum(float v) {
#pragma unroll
    for (int o = 1; o < 64; o <<= 1) v += __shfl_xor(v, o);
    return v;
}
__device__ __forceinline__ void transpose_tile(const float* src, int ld, bf16* dst, int ldd, const float* kscale, LAS float* scr, int lane) {
#pragma unroll 8
    for (int i = 0; i < 32; ++i) { const int kk = 2 * i + (lane >> 5); float v = src[(size_t)kk * ld + (lane & 31)]; if (kscale) v *= kscale[kk]; scr[kk * 33 + (lane & 31)] = v; }
    LDS_WAIT(); asm volatile("" ::: "memory");
    const int c = lane & 7;
#pragma unroll
    for (int j = 0; j < 4; ++j) { const int n = (lane >> 3) + 8 * j; const LAS float* s = scr + (8 * c) * 33 + n;
        v4u o; o.x = pk2(s[0 * 33], s[1 * 33]); o.y = pk2(s[2 * 33], s[3 * 33]); o.z = pk2(s[4 * 33], s[5 * 33]); o.w = pk2(s[6 * 33], s[7 * 33]);
        *(GAS v4u*)(dst + (size_t)n * ldd + 8 * c) = o; }
    LDS_WAIT(); asm volatile("" ::: "memory");
}

struct P0Args { const float *x, *g_mix, *w_in, *w_rg_a, *w_rg_x, *b_forget, *w_lru_out, *w_attn_out, *w_out, *g_ffn, *w_rgrp, *w_rexp;
                bf16 *Win, *Wl, *Wa, *Wo, *Wrg, *XB; float *RS1, *LF, *WRT; };
__device__ __forceinline__ void p0_prologue(const Frame& F, const P0Args& a) {
    LAS float* scr = (LAS float*)(F.lds + RING_OFF + F.wave * 16384);
    const int gw = F.vcu * NWAVES + F.wave, NGW = F.G * NWAVES;
    const float* const p_wl = a.w_lru_out; const float* const p_wa = a.w_attn_out; const float* const p_wo = a.w_out; const float* const p_rga = a.w_rg_a; const float* const p_rgx = a.w_rg_x;
    bf16* const q_wl = a.Wl; bf16* const q_wa = a.Wa; bf16* const q_wo = a.Wo;
    constexpr int I_IN = 16 * 224, I_SQ = 16 * 32, I_RG = 2 * 4 * 4 * 8, NITEMS = I_IN + 3 * I_SQ + I_RG;
    for (int it = gw; it < NITEMS; it += NGW) {
        int r = it;
        if (r < I_IN) { const int kb = r / 224, nb = r % 224, n0 = 32 * nb, sc = n0 < 5120 ? n0 : n0 + 8;
            transpose_tile(a.w_in + (size_t)(64 * kb) * INW + sc, INW, a.Win + (size_t)n0 * DM + 64 * kb, DM, a.g_mix + 64 * kb, scr, F.lane); continue; }
        r -= I_IN;
        if (r < 3 * I_SQ) { const int w = r / I_SQ, q = r % I_SQ, kb = q / 32, nb = q % 32; const float* W = w == 0 ? p_wl : (w == 1 ? p_wa : p_wo); bf16* Wt = w == 0 ? q_wl : (w == 1 ? q_wa : q_wo);
            transpose_tile(W + (size_t)(64 * kb) * DM + 32 * nb, DM, Wt + (size_t)(32 * nb) * DM + 64 * kb, DM, nullptr, scr, F.lane); continue; }
        r -= 3 * I_SQ;
        { const int gb = r / 32, q = r % 32, kb = q / 8, nb = q % 8; const float* W = (gb < 4 ? p_rga : p_rgx) + (size_t)(gb & 3) * 65536;
            transpose_tile(W + (size_t)(64 * kb) * 256 + 32 * nb, 256, a.Wrg + (size_t)gb * 65536 + (size_t)(32 * nb) * 256 + 64 * kb, 256, nullptr, scr, F.lane); }
    }
    for (int i = (F.vcu * NWAVES + F.wave) * 64 + F.lane; i < 64 * DM; i += NGW * 64) { const int n = i >> 10, k = i & 1023;
        float v = 0.f; if (n < 32) v = a.w_rexp[k * 32 + n]; else if (n < 36) v = a.w_rgrp[k * 4 + (n - 32)];
        a.WRT[i] = v * a.g_ffn[k]; }
    float wf[4][4][8];
#pragma unroll
    for (int j = 0; j < 4; ++j)
#pragma unroll
        for (int i = 0; i < 4; ++i) { const int k = 256 * j + 4 * F.lane + i; const float g = a.g_mix[k];
            const f32x4 w0 = *(const f32x4*)(a.w_in + (size_t)k * INW + 5120), w1 = *(const f32x4*)(a.w_in + (size_t)k * INW + 5124);
#pragma unroll
            for (int h = 0; h < 4; ++h) { wf[j][i][h] = w0[h] * g; wf[j][i][4 + h] = w1[h] * g; } }
    const float bfg = a.b_forget[F.lane & 7];
    for (int m = gw; m < T; m += NGW) {
        const GAS f32x4* xr = (const GAS f32x4*)(a.x + (size_t)m * DM) + F.lane;
        f32x4 v[4]; float s = 0.f, d[8] = {0.f, 0.f, 0.f, 0.f, 0.f, 0.f, 0.f, 0.f};
#pragma unroll
        for (int j = 0; j < 4; ++j) { v[j] = xr[64 * j]; s += (v[j].x * v[j].x + v[j].y * v[j].y) + (v[j].z * v[j].z + v[j].w * v[j].w);
#pragma unroll
            for (int i = 0; i < 4; ++i)
#pragma unroll
                for (int h = 0; h < 8; ++h) d[h] = fmaf(v[j][i], wf[j][i][h], d[h]); }
        s = wave_sum(s);
#pragma unroll
        for (int h = 0; h < 8; ++h) d[h] = wave_sum(d[h]);
        const float rs = 1.0f / sqrtf(s * (1.0f / DM) + EPS);
        GAS unsigned long long* o8 = (GAS unsigned long long*)(a.XB + (size_t)m * DM) + F.lane;
#pragma unroll
        for (int j = 0; j < 4; ++j) o8[64 * j] = (unsigned long long)pk2(v[j].x, v[j].y) | ((unsigned long long)pk2(v[j].z, v[j].w) << 32);
        if (F.lane == 0) a.RS1[m] = rs;
        if (F.lane < 8) { const int h = F.lane; float dh = d[0]; dh = h == 1 ? d[1] : dh; dh = h == 2 ? d[2] : dh; dh = h == 3 ? d[3] : dh; dh = h == 4 ? d[4] : dh; dh = h == 5 ? d[5] : dh; dh = h == 6 ? d[6] : dh; dh = h == 7 ? d[7] : dh;
            const float fl = dh * rs + bfg; a.LF[(size_t)m * 8 + h] = fminf(fl, 0.f) - log1pf(expf(-fabsf(fl))); }
    }
}
__device__ __forceinline__ void cumsum_bias(const Frame& F, const float* LF, float* CB) {
    LAS float* wt = (LAS float*)(F.lds + RING_OFF);
    for (int bh = blockIdx.x; bh < NB * NH; bh += F.G) {
        const int b = bh >> 3, h = bh & 7, s0 = F.tid * 8;
        float v[8], run = 0.f;
#pragma unroll
        for (int j = 0; j < 8; ++j) { run += LF[((size_t)(b * SEQ + s0 + j)) * 8 + h]; v[j] = run; }
        float inc = run;
#pragma unroll
        for (int o = 1; o < 64; o <<= 1) { const float t = __shfl_up(inc, o); if (F.lane >= o) inc += t; }
        if (F.lane == 63) wt[F.wave] = inc;
        __syncthreads();
        float pre = inc - run;
        for (int w = 0; w < F.wave; ++w) pre += wt[w];
#pragma unroll
        for (int j = 0; j < 8; ++j) CB[(size_t)bh * SEQ + s0 + j] = -(pre + v[j]) * 11.313708498984761f;
        __syncthreads();
    }
}
struct RgArgs { const bf16* XR; bf16* GG; const bf16* Wrg; const float *conv_w, *conv_b, *b_a, *b_x, *lam; };
__device__ __forceinline__ float bfx(const v4u& v, int i) { const unsigned w = i < 2 ? v.x : (i < 4 ? v.y : (i < 6 ? v.z : v.w)); return (i & 1) ? bf_hi(w) : bf_lo(w); }
__device__ __forceinline__ void rglru_unit(const Frame& F, const RgArgs& a, int unit) {
    const int tid = F.tid, lane = F.lane, wid = F.wave, fr = lane & 15, fq = lane >> 4;
    const int b = unit >> 5, n = (unit >> 3) & 3, g = unit & 7, cbase = 256 * n, cown = cbase + 32 * g;
    LAS unsigned char* A_l = F.lds + RING_OFF; LAS unsigned char* B_l = F.lds + RING_OFF + 65536;
    LAS float* a_l = (LAS float*)(F.lds + RING_OFF + 98304); LAS float* b_l = a_l + 4096;
    LAS float* tot = (LAS float*)(F.lds + RG_TOT); LAS float* car = (LAS float*)(F.lds + RG_CAR);
#pragma unroll
    for (int i = 0; i < 4; ++i) { const int q = tid + 512 * i, row = q >> 5, ch = q & 31;
        const v4u w = *(const GAS v4u*)(a.Wrg + ((size_t)((row >> 5) * 4 + n) * 256 + 32 * g + (row & 31)) * 256 + ch * 8);
        *(LAS v4u*)(B_l + row * 512 + ((ch ^ (row & 15)) << 4)) = w; }
    const int cg = tid & 31, rg = tid >> 5;
    float cw[4][8], cbv[8];
#pragma unroll
    for (int i = 0; i < 8; ++i) { const int c = cbase + 8 * cg + i; cbv[i] = a.conv_b[c];
#pragma unroll
        for (int j = 0; j < 4; ++j) cw[j][i] = a.conv_w[j * DM + c]; }
    float ba[2], bx[2], sp8[2];
#pragma unroll
    for (int t2 = 0; t2 < 2; ++t2) { const int c = cown + 16 * t2 + fr; ba[t2] = a.b_a[c]; bx[t2] = a.b_x[c]; sp8[t2] = 8.0f * log1pf(expf(-a.lam[c])); }
    if (tid < 32) car[tid] = 0.f;
    const int sc_c = tid & 31, sc_s = tid >> 5;
    const unsigned xoff = (unsigned)(b * SEQ) * DM + cbase + 8 * cg;
    const unsigned goff = (unsigned)(b * SEQ) * DM + cown + sc_c;
    const bf16* const XRb = a.XR; bf16* const GGb = a.GG;
    v4u raw[11];
#pragma unroll
    for (int i = 0; i < 11; ++i) { const int t = 8 * rg - 3 + i; const int tc = t < 0 ? 0 : t; const v4u w = *(const GAS v4u*)(XRb + (xoff + (unsigned)(tc * DM)));
        raw[i].x = t < 0 ? 0u : w.x; raw[i].y = t < 0 ? 0u : w.y; raw[i].z = t < 0 ? 0u : w.z; raw[i].w = t < 0 ? 0u : w.w; }
    __syncthreads();
    for (int ci = 0; ci < SEQ / 128; ++ci) {
        const int t0 = 128 * ci;
#pragma unroll
        for (int r = 0; r < 8; ++r) { float y[8];
#pragma unroll
            for (int i = 0; i < 8; ++i) { float s = cbv[i];
#pragma unroll
                for (int j = 0; j < 4; ++j) s = fmaf(cw[j][i], bfx(raw[r + j], i), s);
                y[i] = s; }
            v4u o; o.x = pk2(y[0], y[1]); o.y = pk2(y[2], y[3]); o.z = pk2(y[4], y[5]); o.w = pk2(y[6], y[7]);
            const int row = 8 * rg + r; *(LAS v4u*)(A_l + row * 512 + ((cg ^ (row & 15)) << 4)) = o; }
        if (ci + 1 < SEQ / 128) {
#pragma unroll
            for (int i = 0; i < 11; ++i) raw[i] = *(const GAS v4u*)(XRb + (xoff + (unsigned)((t0 + 125 + 8 * rg + i) * DM))); }
        unsigned short ggv[8];
#pragma unroll
        for (int j = 0; j < 8; ++j) ggv[j] = GGb[goff + (unsigned)((t0 + 8 * sc_s + j) * DM)];
        __syncthreads();
        f32x4 acc[4];
#pragma unroll
        for (int nt = 0; nt < 4; ++nt) acc[nt] = (f32x4){0.f, 0.f, 0.f, 0.f};
        const int arow = 16 * wid + fr;
#pragma unroll
        for (int ks = 0; ks < 8; ++ks) { const int ch = 4 * ks + fq;
            const bf16x8 af = *(const LAS bf16x8*)(A_l + arow * 512 + ((ch ^ (arow & 15)) << 4));
#pragma unroll
            for (int nt = 0; nt < 4; ++nt) { const int brow = 16 * nt + fr; const bf16x8 bfv = *(const LAS bf16x8*)(B_l + brow * 512 + ((ch ^ (brow & 15)) << 4));
                acc[nt] = __builtin_amdgcn_mfma_f32_16x16x32_bf16(af, bfv, acc[nt], 0, 0, 0); } }
#pragma unroll
        for (int t2 = 0; t2 < 2; ++t2)
#pragma unroll
            for (int j = 0; j < 4; ++j) { const int row = 16 * wid + 4 * fq + j, cl = 16 * t2 + fr, kx = 32 * g + cl;
                const unsigned short xb16 = *(const LAS unsigned short*)(A_l + row * 512 + ((((kx >> 3) ^ (row & 15))) << 4) + (kx & 7) * 2);
                const float xc = __builtin_bit_cast(float, (unsigned)xb16 << 16);
                const float r_ = sigmoid_f(acc[t2][j] + ba[t2]), i_ = sigmoid_f(acc[2 + t2][j] + bx[t2]);
                const float la = -sp8[t2] * r_, av = __builtin_amdgcn_exp2f(la * 1.4426950408889634f);
                const float mult = sqrtf(fmaxf(fmaf(-av, av, 1.0f), 0.f));
                a_l[row * 32 + cl] = av; b_l[row * 32 + cl] = mult * i_ * xc; }
        __syncthreads();
        float sa_[8], sb_[8]; float A = 1.f, Bv = 0.f;
#pragma unroll
        for (int j = 0; j < 8; ++j) { sa_[j] = a_l[(8 * sc_s + j) * 32 + sc_c]; sb_[j] = b_l[(8 * sc_s + j) * 32 + sc_c]; Bv = fmaf(sa_[j], Bv, sb_[j]); A *= sa_[j]; }
        tot[(sc_s * 32 + sc_c) * 2] = A; tot[(sc_s * 32 + sc_c) * 2 + 1] = Bv;
        __syncthreads();
        float h = car[(ci & 1) * 32 + sc_c];
        for (int s = 0; s < sc_s; ++s) h = fmaf(tot[(s * 32 + sc_c) * 2], h, tot[(s * 32 + sc_c) * 2 + 1]);
#pragma unroll
        for (int j = 0; j < 8; ++j) { h = fmaf(sa_[j], h, sb_[j]);
            const float gv = __builtin_bit_cast(float, (unsigned)ggv[j] << 16);
            GGb[goff + (unsigned)((t0 + 8 * sc_s + j) * DM)] = (bf16)f2bf(h * gv); }
        if (sc_s == 15) car[((ci + 1) & 1) * 32 + sc_c] = h;
    }
    __syncthreads();
}
__device__ __forceinline__ fattn::BlockRef attn_ref(int bh, int qb) {
    const int b = bh >> 3, h = bh & 7; const unsigned rowbase = (unsigned)b * SEQ;
    fattn::BlockRef r; r.qo = (rowbase + (unsigned)qb * 256u) * DM + h * HD; r.kvo = rowbase * DM + h * HD; r.cbo = (unsigned)bh * SEQ; r.P0 = qb * 256; return r;
}
__device__ __forceinline__ void attn_phase(const Frame& F, char* lds, bf16* Qb, const bf16* Kb, const bf16* Vb, const float* CB) {
    constexpr int NX = 8, TOTAL = NB * NH * NX;
    int L = F.vcu; if (L >= TOTAL) return;
    int pass = 0;
    const fattn::Bases G{Qb, Kb, Vb, CB};
    fattn::BlockRef cur = attn_ref(L / NX, L % NX);
    fattn::Seam S;
    fattn::prime(G, cur, lds, S);
    for (;;) {
        const bool more_pass = pass == 0, more_item = L + F.G < TOTAL, last = !more_pass && !more_item;
        int passn = pass + 1, Ln = L;
        if (!more_pass) { passn = 0; Ln = more_item ? L + F.G : L; }
        const int xn = Ln % NX;
        const fattn::BlockRef nxt = last ? cur : attn_ref(Ln / NX, passn ? 15 - xn : xn);
        fattn::block(G, cur, nxt, lds, S);
        if (last) break;
        cur = nxt; pass = passn; L = Ln;
    }
}
typedef float f32x16 __attribute__((ext_vector_type(16)));
struct P5Args { const float *X1, *WRT, *b_rgrp, *b_rexp, *g_ffn, *w_gate, *w_up, *w_down; bf16 *X1B, *W13, *W2; float* RS2; int* LISTS; unsigned* TOK; gu32* CNT; };
__device__ __forceinline__ void p5_route(const Frame& F, const P5Args& a) {
    const int tid = F.tid, lane = F.lane, wid = F.wave;
    LAS float* LG = (LAS float*)(F.lds + RING_OFF);
    LAS float* rs_l = (LAS float*)(F.lds + RING_OFF + 20480);
    LAS int* hist = (LAS int*)(F.lds + RING_OFF + 21504);
    LAS int* base_l = (LAS int*)(F.lds + RING_OFF + 21760);
    if (wid >= 4) {
        LAS float* scr = (LAS float*)(F.lds + RING_OFF + 32768 + (wid - 4) * 8704);
        const int gw4 = F.vcu * 4 + (wid - 4), NG4 = F.G * 4;
        const float* const p_gate = a.w_gate; const float* const p_up = a.w_up;
        for (int it = gw4; it < 3 * 8192; it += NG4) {
            const int w = it >> 13, r = it & 8191;
            if (w < 2) { const int e = r >> 8, kb = (r >> 4) & 15, nb = r & 15; const float* W = (w == 0 ? p_gate : p_up) + (size_t)e * DM * DE;
                const int drow = e * 1024 + (nb >> 2) * 256 + (nb & 3) * 32 + (w == 1 ? 128 : 0);
                transpose_tile(W + (size_t)(64 * kb) * DE + 32 * nb, DE, a.W13 + (size_t)drow * DM + 64 * kb, DM, a.g_ffn + 64 * kb, scr, lane); }
            else { const int e = r >> 8, kb = (r >> 5) & 7, nb = r & 31; const float* W = a.w_down + (size_t)e * DE * DM;
                transpose_tile(W + (size_t)(64 * kb) * DM + 32 * nb, DM, a.W2 + (size_t)(e * 1024 + 32 * nb) * DE + 64 * kb, DE, nullptr, scr, lane); }
        }
    }
    for (int rb = blockIdx.x; rb < T / 128; rb += F.G) {
        const int R0 = rb * 128;
        if (tid < 32) hist[tid] = 0;
        if (wid < 4) {
            const int i = lane & 31, h = lane >> 5, row = R0 + 32 * wid + i;
            const float* xrow = a.X1 + (size_t)row * DM + 4 * h; const float* we = a.WRT + (size_t)i * DM + 4 * h; const float* wg = a.WRT + (size_t)(32 + i) * DM + 4 * h;
            bf16* xbrow = a.X1B + (size_t)row * DM + 4 * h;
            f32x16 accE = {}, accG = {}; float ss = 0.f;
#pragma unroll 4
            for (int jj = 0; jj < 128; ++jj) {
                const f32x4 av = *(const f32x4*)(xrow + 8 * jj), be = *(const f32x4*)(we + 8 * jj), bg = *(const f32x4*)(wg + 8 * jj);
                ss += (av[0] * av[0] + av[1] * av[1]) + (av[2] * av[2] + av[3] * av[3]);
                *(unsigned long long*)(xbrow + 8 * jj) = (unsigned long long)pk2(av[0], av[1]) | ((unsigned long long)pk2(av[2], av[3]) << 32);
#pragma unroll
                for (int s = 0; s < 4; ++s) { accE = __builtin_amdgcn_mfma_f32_32x32x2f32(av[s], be[s], accE, 0, 0, 0); accG = __builtin_amdgcn_mfma_f32_32x32x2f32(av[s], bg[s], accG, 0, 0, 0); }
            }
            ss += __shfl_xor(ss, 32);
            const float rs = 1.0f / sqrtf(ss * (1.0f / DM) + EPS);
            if (h == 0) { a.RS2[row] = rs; rs_l[32 * wid + i] = rs; }
#pragma unroll
            for (int r = 0; r < 16; ++r) { const int rl = 32 * wid + (r & 3) + 8 * (r >> 2) + 4 * h; LG[rl * 37 + i] = accE[r]; if (i < 4) LG[rl * 37 + 32 + i] = accG[r]; }
        }
        __syncthreads();
        int e0 = 0, e1 = 0, k0 = 0, k1 = 0; float w0 = 0.f, w1 = 0.f;
        if (tid < 128) {
            const float rs = rs_l[tid]; const LAS float* lg = LG + tid * 37;
            float gl[4];
#pragma unroll
            for (int q = 0; q < 4; ++q) gl[q] = lg[32 + q] * rs + a.b_rgrp[q];
            int gs = 0; float gm = gl[0];
#pragma unroll
            for (int q = 1; q < 4; ++q) if (gl[q] > gm) { gm = gl[q]; gs = q; }
            float den = 0.f;
#pragma unroll
            for (int q = 0; q < 4; ++q) den += expf(gl[q] - gm);
            const float pg = 1.0f / den;
            float el[8];
#pragma unroll
            for (int q = 0; q < 8; ++q) el[q] = lg[8 * gs + q] * rs + a.b_rexp[8 * gs + q];
            int i0 = 0; float v0 = el[0];
#pragma unroll
            for (int q = 1; q < 8; ++q) if (el[q] > v0) { v0 = el[q]; i0 = q; }
            int i1 = -1; float v1 = -INFINITY;
#pragma unroll
            for (int q = 0; q < 8; ++q) if (q != i0 && el[q] > v1) { v1 = el[q]; i1 = q; }
            const float ex = expf(v1 - v0);
            w0 = pg / (1.0f + ex); w1 = pg * ex / (1.0f + ex);
            e0 = 8 * gs + i0; e1 = 8 * gs + i1;
            k0 = atomicAdd((int*)(hist + e0), 1); k1 = atomicAdd((int*)(hist + e1), 1);
        }
        __syncthreads();
        if (tid < 32) base_l[tid] = (int)__hip_atomic_fetch_add(a.CNT + tid, (unsigned)hist[tid], __ATOMIC_RELAXED, __HIP_MEMORY_SCOPE_AGENT);
        __syncthreads();
        if (tid < 128) { const int tok = R0 + tid, s0 = base_l[e0] + k0, s1 = base_l[e1] + k1;
            a.LISTS[(size_t)e0 * T + s0] = tok; a.LISTS[(size_t)e1 * T + s1] = tok;
            v4u i0v = {(unsigned)e0, (unsigned)s0, (unsigned)e1, (unsigned)s1}, i1v = {__float_as_uint(w0), __float_as_uint(w1), 0u, 0u};
            *(GAS v4u*)(a.TOK + (size_t)tok * 8) = i0v; *(GAS v4u*)(a.TOK + (size_t)tok * 8 + 4) = i1v; }
        __syncthreads();
    }
}
__device__ __forceinline__ void build_tables(const Frame& F, const gu32* CNT) {
    LAS int* ps = (LAS int*)(F.lds + TBL_PS); LAS int* cn = (LAS int*)(F.lds + TBL_CN); LAS int* te = (LAS int*)(F.lds + TBL_TE);
    __syncthreads();
    if (F.tid < 32) { int c = (int)__hip_atomic_load(CNT + F.tid, __ATOMIC_RELAXED, __HIP_MEMORY_SCOPE_AGENT); c = c < 0 ? 0 : (c > T ? T : c); cn[F.tid] = c; }
    __syncthreads();
    if (F.tid == 0) { int run = 0; for (int e = 0; e < 32; ++e) { ps[e] = run; run += (cn[e] + 255) & ~255; } if (run > PMAX) run = PMAX; ps[32] = run; }
    __syncthreads();
    if (F.tid < 288) { const int p = F.tid * 256; int e = 0; for (int q = 1; q < 32; ++q) if (p >= ps[q]) e = q; te[F.tid] = e; }
    __syncthreads();
}
__device__ __forceinline__ void p6_gather(const Frame& F, const bf16* X1B, const float* RS2, const int* LISTS, const unsigned* TOK, bf16* XG, float* SRS, float* SW) {
    const LAS int* ps = (const LAS int*)(F.lds + TBL_PS); const LAS int* cn = (const LAS int*)(F.lds + TBL_CN); const LAS int* te = (const LAS int*)(F.lds + TBL_TE);
    const int gw = F.vcu * NWAVES + F.wave, NGW = F.G * NWAVES, P = ps[32];
    for (int p = gw; p < P; p += NGW) {
        const int e = te[p >> 8], local = p - ps[e];
        v4u v0 = {0u, 0u, 0u, 0u}, v1 = {0u, 0u, 0u, 0u}; float rs = 0.f, w = 0.f;
        if (local < cn[e]) { const int tok = LISTS[(size_t)e * T + local];
            const GAS v4u* src = (const GAS v4u*)(X1B + (size_t)tok * DM) + F.lane; v0 = src[0]; v1 = src[64];
            const v4u ia = *(const GAS v4u*)(TOK + (size_t)tok * 8), ib = *(const GAS v4u*)(TOK + (size_t)tok * 8 + 4);
            rs = RS2[tok]; w = __uint_as_float((int)ia.x == e ? ib.x : ib.y); }
        GAS v4u* dst = (GAS v4u*)(XG + (size_t)p * DM) + F.lane; dst[0] = v0; dst[64] = v1;
        if (F.lane == 0) { SRS[p] = rs; SW[p] = w; }
    }
}
__device__ __forceinline__ void p9_final(const Frame& F, float* OUT  , const bf16* Y, const unsigned* TOK, const float* g_final) {
    const LAS int* ps = (const LAS int*)(F.lds + TBL_PS);
    const int gw = F.vcu * NWAVES + F.wave, NGW = F.G * NWAVES;
    f32x4 gf[4];
#pragma unroll
    for (int j = 0; j < 4; ++j) gf[j] = *((const f32x4*)g_final + F.lane + 64 * j);
    for (int m = gw; m < T; m += NGW) {
        const v4u ia = *(const GAS v4u*)(TOK + (size_t)m * 8);
        const int e0 = (int)(ia.x & 31u), e1 = (int)(ia.z & 31u);
        const size_t p0 = (size_t)(ps[e0] + (int)ia.y), p1 = (size_t)(ps[e1] + (int)ia.w);
        GAS f32x4* xr = (GAS f32x4*)(OUT + (size_t)m * DM) + F.lane;
        const GAS unsigned long long* y0 = (const GAS unsigned long long*)(Y + p0 * DM) + F.lane; const GAS unsigned long long* y1 = (const GAS unsigned long long*)(Y + p1 * DM) + F.lane;
        f32x4 v[4]; float s = 0.f;
#pragma unroll
        for (int j = 0; j < 4; ++j) { v[j] = xr[64 * j]; const unsigned long long a = y0[64 * j], b = y1[64 * j];
            v[j].x += bf_lo((unsigned)a) + bf_lo((unsigned)b); v[j].y += bf_hi((unsigned)a) + bf_hi((unsigned)b);
            v[j].z += bf_lo((unsigned)(a >> 32)) + bf_lo((unsigned)(b >> 32)); v[j].w += bf_hi((unsigned)(a >> 32)) + bf_hi((unsigned)(b >> 32));
            s += (v[j].x * v[j].x + v[j].y * v[j].y) + (v[j].z * v[j].z + v[j].w * v[j].w); }
        s = wave_sum(s);
        const float rs = 1.0f / sqrtf(s * (1.0f / DM) + EPS);
#pragma unroll
        for (int j = 0; j < 4; ++j) xr[64 * j] = v[j] * rs * gf[j];
    }
}

constexpr int N_PHASES = 10;
typedef __attribute__((address_space(4))) const unsigned char* karg_ptr;
__device__ __forceinline__ const float* arg_in(int k) { karg_ptr base = (karg_ptr)__builtin_amdgcn_kernarg_segment_ptr(); const unsigned long long v = *(const unsigned long long volatile __attribute__((address_space(4)))*)(base + 8 * k); return (const float*)(const GAS float*)v; }
struct Args { const float* in[23]; float* out; unsigned char* ws; int ph_lo, ph_hi; };
__global__ void __launch_bounds__(NWAVES * 64, 2) fwd_kernel(Args args) {
    extern __shared__ __attribute__((aligned(16))) unsigned char lds[];
    Frame F;
    F.lds = (LAS unsigned char*)lds;
    F.tid = threadIdx.x; F.lane = F.tid & 63; F.wave = __builtin_amdgcn_readfirstlane(F.tid >> 6);
    F.G = gridDim.x; { const int bx = blockIdx.x; F.vcu = (F.G % 8 == 0) ? (bx % 8) * (F.G / 8) + bx / 8 : bx; }
    unsigned char* ws = args.ws;
    gu32* ctl = (gu32*)(ws + WS_CTL);
    volatile LAS unsigned* MISC = (volatile LAS unsigned*)(F.lds + MISC_OFF);
    for (int u = F.tid; u < (LDS_BYTES - LDSCTL_OFF) / 4; u += NWAVES * 64) ((LAS unsigned*)(F.lds + LDSCTL_OFF))[u] = 0u;
    __syncthreads();
#if MK_ONE_LAUNCH
    XcdBarrier bar = xcd_barrier_post((unsigned*)(ctl + CW_BAR), MISC + 8);
#define GRID_BAR() xcd_barrier(bar)
#else
#define GRID_BAR() do { } while (0)
#endif
    const int lo = args.ph_lo, hi = args.ph_hi;
#ifndef PH_MASK
#define PH_MASK 0x3ff
#endif
#define IN(k) (((PH_MASK >> (k)) & 1) && lo <= (k) && (k) < hi)
#define BOTH(k) (IN(k) && IN((k) + 1))
    float* out = args.out;
    bf16* Win = (bf16*)(ws + WS_WIN); bf16* Wl = (bf16*)(ws + WS_WL); bf16* Wa = (bf16*)(ws + WS_WA); bf16* Wo = (bf16*)(ws + WS_WO); bf16* Wrg = (bf16*)(ws + WS_WRG);
    bf16* XB = (bf16*)(ws + WS_XB); bf16* XR = (bf16*)(ws + WS_XR); bf16* GG = (bf16*)(ws + WS_GG); bf16* Qb = (bf16*)(ws + WS_Q); bf16* Kb = (bf16*)(ws + WS_K); bf16* Vb = (bf16*)(ws + WS_V);
    bf16* SL = (bf16*)out; bf16* SA = (bf16*)out + pg8::SEGE;
    float* RS1 = (float*)(ws + WS_RS1); float* RS2 = (float*)(ws + WS_RS2); float* LF = (float*)(ws + WS_LF); float* CB = (float*)(ws + WS_CB);
    unsigned* TOK = (unsigned*)(ws + WS_TOK); int* LISTS = (int*)(ws + WS_LISTS); float* WRT = (float*)(ws + WS_WRT); float* SRS = (float*)(ws + WS_SRS); float* SW = (float*)(ws + WS_SW);
    bf16* W13 = (bf16*)(ws + WS_W13); bf16* W2 = (bf16*)(ws + WS_W2); bf16* XG = (bf16*)(ws + WS_XG); bf16* HB = (bf16*)(ws + WS_HB);
    gu32* CNT = ctl + CW_CNT;

    if (IN(0)) {
        P0Args a{arg_in(0), arg_in(1), arg_in(2), arg_in(5), arg_in(7), arg_in(10), arg_in(11), arg_in(12), arg_in(13), arg_in(14), arg_in(15), arg_in(17), Win, Wl, Wa, Wo, Wrg, XB, RS1, LF, WRT};
        p0_prologue(F, a);
        if (BOTH(0)) GRID_BAR();
    }
    if (IN(1)) {
        cumsum_bias(F, LF, CB);
        pg8::Gemm g{XB, Win, T, NZ, DM}; pg8::StaticOrder S; S.init(T, NZ, F.G, (int)blockIdx.x);
        pg8::EpiZ E{XR, SL, RS1};
        pg8::gemm_phase<pg8::EpiZ, pg8::StaticOrder, true, true>(F.lds + RING_OFF, g, S, E);
        if (BOTH(1)) GRID_BAR();
    }
    if (IN(2)) {
        RgArgs ra{XR, GG, Wrg, arg_in(3), arg_in(4), arg_in(6), arg_in(8), arg_in(9)};
#ifndef NO_RGLRU
        for (int u = F.vcu; u < 256; u += F.G) rglru_unit(F, ra, u);
#endif
#ifndef NO_ATTN
        attn_phase(F, (char*)lds + RING_OFF, Qb, Kb, Vb, CB);
#endif
        if (BOTH(2)) GRID_BAR();
    }
    if (IN(3)) {
        { pg8::Gemm g{GG, Wl, T, DM, DM}; pg8::StaticOrder S; S.init(T, DM, F.G, (int)blockIdx.x);
          pg8::EpiGate<0> E{SL, XB};
          pg8::gemm_phase<pg8::EpiGate<0>, pg8::StaticOrder, true, true>(F.lds + RING_OFF, g, S, E); }
        { pg8::Gemm g{Qb, Wa, T, DM, DM}; pg8::StaticOrder S; S.init(T, DM, F.G, (int)blockIdx.x);
          pg8::EpiGate<1> E{SA, XB};
          pg8::gemm_phase<pg8::EpiGate<1>, pg8::StaticOrder, true, true>(F.lds + RING_OFF, g, S, E); }
        if (BOTH(3)) GRID_BAR();
    }
    if (IN(4)) {
        pg8::Gemm g{XB, Wo, T, DM, DM}; pg8::StaticOrder S; S.init(T, DM, F.G, (int)blockIdx.x);
        pg8::EpiX1 E{arg_in(0), out};
        pg8::gemm_phase<pg8::EpiX1, pg8::StaticOrder, true, true>(F.lds + RING_OFF, g, S, E);
        if (BOTH(4)) GRID_BAR();
    }
    if (IN(5)) {
        P5Args a{out, WRT, arg_in(16), arg_in(18), arg_in(14), arg_in(19), arg_in(20), arg_in(21), XB, W13, W2, RS2, LISTS, TOK, CNT};
        p5_route(F, a);
        if (BOTH(5)) GRID_BAR();
    }
    if (IN(6)) {
        build_tables(F, CNT);
        p6_gather(F, XB, RS2, LISTS, TOK, XG, SRS, SW);
        if (BOTH(6)) GRID_BAR();
    }
    if (IN(7)) {
        build_tables(F, CNT);
        const int ntiles = ((const LAS int*)(F.lds + TBL_PS))[32] >> 8;
        pg8::Gemm g{XG, W13, ntiles * 256, 32 * 1024, DM}; pg8::GroupedOrder S{(const LAS int*)(F.lds + TBL_TE), ntiles * 4, F.G, F.vcu};
        pg8::EpiSwiGLU E{HB, SRS};
        pg8::gemm_phase<pg8::EpiSwiGLU, pg8::GroupedOrder, true, true>(F.lds + RING_OFF, g, S, E);
        if (BOTH(7)) GRID_BAR();
    }
    if (IN(8)) {
        build_tables(F, CNT);
        const int ntiles = ((const LAS int*)(F.lds + TBL_PS))[32] >> 8;
        pg8::Gemm g{HB, W2, ntiles * 256, 32 * 1024, DE}; pg8::GroupedOrder S{(const LAS int*)(F.lds + TBL_TE), ntiles * 4, F.G, F.vcu};
        pg8::EpiY E{XG, SW};
        pg8::gemm_phase<pg8::EpiY, pg8::GroupedOrder, true, true>(F.lds + RING_OFF, g, S, E);
        if (BOTH(8)) GRID_BAR();
    }
    if (IN(9)) {
        build_tables(F, CNT);
        p9_final(F, out, XG, TOK, arg_in(22));
    }
#undef IN
#undef BOTH
}

extern "C" void kernel_launch(void* const* d_in, const int* in_sizes, int n_in, void* d_out, int out_size, void* d_ws, size_t ws_size, hipStream_t stream) {
    static int grid = 0;
    if (grid == 0) {
        if (n_in != 23 || in_sizes[0] != T * DM || out_size != T * DM || ws_size < WS_END) { fprintf(stderr, "kernel_launch: unexpected shapes (n_in %d, in0 %d, out %d, ws %zu); nothing launched\n", n_in, n_in > 0 ? in_sizes[0] : -1, out_size, ws_size); grid = -1; return; }
        int dev = 0, cus = 0;
        if (hipGetDevice(&dev) != hipSuccess || hipDeviceGetAttribute(&cus, hipDeviceAttributeMultiprocessorCount, dev) != hipSuccess) { grid = -1; return; }
        if (hipFuncSetAttribute((const void*)fwd_kernel, hipFuncAttributeMaxDynamicSharedMemorySize, LDS_BYTES) != hipSuccess) { fprintf(stderr, "kernel_launch: hipFuncSetAttribute failed\n"); grid = -1; return; }
        int per_cu = 0;
        if (hipOccupancyMaxActiveBlocksPerMultiprocessor(&per_cu, (const void*)fwd_kernel, NWAVES * 64, LDS_BYTES) != hipSuccess || per_cu < 1) { fprintf(stderr, "kernel_launch: occupancy query reports %d\n", per_cu); }
        (void)hipGetLastError();
        grid = cus;
    }
    if (grid < 0) return;
    if (hipMemsetAsync((char*)d_ws + WS_CTL, 0, CTL_ZERO_BYTES, stream) != hipSuccess) return;
    Args a{};
    for (int i = 0; i < 23; ++i) a.in[i] = (const float*)d_in[i];
    a.out = (float*)d_out; a.ws = (unsigned char*)d_ws;
#if MK_ONE_LAUNCH
    a.ph_lo = 0; a.ph_hi = N_PHASES;
    hipLaunchKernelGGL(fwd_kernel, dim3(grid), dim3(NWAVES * 64), LDS_BYTES, stream, a);
#else
    for (int ph = 0; ph < N_PHASES; ++ph) { a.ph_lo = ph; a.ph_hi = ph + 1; hipLaunchKernelGGL(fwd_kernel, dim3(grid), dim3(NWAVES * 64), LDS_BYTES, stream, a); }
#endif
}
```

```cpp
#include <hip/hip_runtime.h>
#include <cstdio>
#include <cstdint>

#ifndef MK_ONE_LAUNCH
#define MK_ONE_LAUNCH 1
#endif
namespace pg8 {
#define PG8_LAS __attribute__((address_space(3)))
typedef unsigned short bf16_t;
typedef short bf16x8 __attribute__((ext_vector_type(8)));
typedef float f32x4 __attribute__((ext_vector_type(4)));
typedef unsigned u32x4 __attribute__((ext_vector_type(4)));
constexpr int BM = 256, BK = 64, HALF = 128, HTB = HALF * BK * 2  , STAGE_BYTES = 8 * HTB, NXCD = 8, WGM = 8;

__host__ __device__ __forceinline__ int lds_byte(int r, int c) { const int st = (r >> 4) * 2 + (c >> 5), rr = r & 15, cc = c & 31, ob = rr * 64 + cc * 2; return st * 1024 + (ob ^ (((ob >> 9) & 1) << 5)); }
__host__ __device__ __forceinline__ void stage_rc(int b, int& R, int& C) { const int st = b / 1024, sb = b % 1024, swz = sb ^ (((sb >> 9) & 1) << 5); R = (st >> 1) * 16 + swz / 64; C = (st & 1) * 32 + (swz % 64) / 2; }
__host__ __device__ __forceinline__ int perm32(int rho) { const int n = rho >> 4, i = rho & 15; return 8 * (i >> 2) + 4 * n + (i & 3); }

struct Unit { int pm, pn; };
struct Gemm { const bf16_t* A; const bf16_t* Bt; int M, N, K; };

struct StaticOrder {
    int nM, nN, nwg, G, c;
    __host__ __device__ void init(int M, int N, int G_, int c_) { nM = M / BM; nN = N / BM; nwg = nM * nN; G = G_; c = c_; }
    __host__ __device__ bool next(int i, Unit& u) const {
        const long L = (long)i * G + c; if (L >= nwg) return false;
        int wgid = (int)L; { const int q = nwg / NXCD, r = nwg % NXCD, xcd = wgid % NXCD, off = wgid / NXCD; wgid = (xcd < r ? xcd * (q + 1) : r * (q + 1) + (xcd - r) * q) + off; }
        const int nig = WGM * nN, gid = wgid / nig, fm = gid * WGM, gsz = (nM - fm) < WGM ? (nM - fm) : WGM;
        u.pm = fm + ((wgid % nig) % gsz); u.pn = (wgid % nig) / gsz; return true;
    }
    __device__ __forceinline__ void a_ready(const Unit&) const {}
    __device__ __forceinline__ void done(const Unit&) const {}
};

__device__ __forceinline__ unsigned cvt_pk_bf16(float lo, float hi) { unsigned r; asm volatile("v_cvt_pk_bf16_f32 %0, %1, %2" : "=v"(r) : "v"(lo), "v"(hi)); return r; }
typedef float f32x2 __attribute__((ext_vector_type(2)));
__device__ __forceinline__ int lane_now() { int l; asm volatile("v_mbcnt_lo_u32_b32 %0, -1, 0\n\tv_mbcnt_hi_u32_b32 %0, -1, %0" : "=v"(l)); return l; }
typedef int v4i_t __attribute__((ext_vector_type(4)));
typedef int v8i_t __attribute__((ext_vector_type(8)));
__device__ __forceinline__ v8i_t cat8(bf16x8 a, bf16x8 b) { const v4i_t x = __builtin_bit_cast(v4i_t, a), y = __builtin_bit_cast(v4i_t, b); return __builtin_shufflevector(x, y, 0, 1, 2, 3, 4, 5, 6, 7); }
__device__ __forceinline__ void glds_sv(const char* base, unsigned voff, unsigned lds_dst) { unsigned keep;
    asm volatile("s_mov_b32 %0, m0\n\ts_mov_b32 m0, %3\n\ts_nop 0\n\tglobal_load_lds_dwordx4 %1, %2\n\ts_mov_b32 m0, %0" : "=&s"(keep) : "v"(voff), "s"(base), "s"(lds_dst) : "memory"); }
__device__ __forceinline__ float sat8(float x) { return __builtin_amdgcn_fmed3f(x, -448.0f, 448.0f); }
__device__ __forceinline__ unsigned pack4_fp8(float a, float b, float c, float d) { unsigned w = 0u; w = __builtin_amdgcn_cvt_pk_fp8_f32(sat8(a), sat8(b), w, false); w = __builtin_amdgcn_cvt_pk_fp8_f32(sat8(c), sat8(d), w, true); return w; }
constexpr float W13_SCALE = 64.0f, HB_SCALE = 8.0f, W2_SCALE = 32.0f;
__device__ __forceinline__ float sigmoid_f(float x) { return __builtin_amdgcn_rcpf(1.0f + __builtin_amdgcn_exp2f(-1.4426950408889634f * x)); }
__device__ __forceinline__ float gelu_tanh_f(float x) { const float u = x * (1.0f + 0.044715f * x * x); return x * __builtin_amdgcn_rcpf(1.0f + __builtin_amdgcn_exp2f(-2.3022081981f * u)); }
__device__ __forceinline__ float bf_lo(unsigned w) { return __builtin_bit_cast(float, w << 16); }
__device__ __forceinline__ float bf_hi(unsigned w) { return __builtin_bit_cast(float, w & 0xffff0000u); }
constexpr size_t SEGE = (size_t)32768 * 1024;

struct EpiZ {
    static constexpr bool PERM = true, AFTER_DRAIN = false; static constexpr int NSTORES = 16;
    bf16_t* ws5; bf16_t* out2; const float* rs; unsigned* norm; int probe;
    __device__ __forceinline__ void operator()(const f32x4 (&acc)[2][2][4][2], const Unit& u, int wr, int wc, int fr, int fq) const {
        const int seg = probe ? 0 : (u.pn >> 2); float nm[2] = {0.f, 0.f};
        const int sgo = u.pn >> 2; bf16_t* O = sgo < 5 ? ws5 + (size_t)sgo * SEGE : out2 + (size_t)(sgo - 5) * SEGE;
        const int row0 = u.pm * BM + wr * 64 + fr, col0 = (u.pn & 3) * BM + wc * 32 + 8 * fq;
#pragma unroll
        for (int ai = 0; ai < 2; ++ai)
#pragma unroll
            for (int m = 0; m < 4; ++m) { const int row = row0 + ai * HALF + m * 16; bf16_t* rowp = O + (size_t)row * 1024 + col0;
                const bool hm = (sgo >= 2 && sgo <= 4); bf16_t* rowh = O + ((size_t)((row >> 12) * 8 + 2 * (u.pn & 3)) * 4096 + (row & 4095)) * 128 + wc * 32 + 8 * fq;
#pragma unroll
                for (int bj = 0; bj < 2; ++bj) { f32x4 v0 = acc[ai][bj][m][0], v1 = acc[ai][bj][m][1];
                    if (seg == 1) {
#pragma unroll
                        for (int i = 0; i < 4; ++i) { v0[i] = gelu_tanh_f(v0[i]); v1[i] = gelu_tanh_f(v1[i]); } }
                    else if (seg >= 5) {
#pragma unroll
                        for (int i = 0; i < 4; ++i) { v0[i] = sigmoid_f(v0[i]); v1[i] = sigmoid_f(v1[i]); } }
                    if (seg == 2 || seg == 3) { float q = (v0[0] * v0[0] + v0[1] * v0[1]) + (v0[2] * v0[2] + v0[3] * v0[3]) + (v1[0] * v1[0] + v1[1] * v1[1]) + (v1[2] * v1[2] + v1[3] * v1[3]);
                        q += __shfl_xor(q, 16); q += __shfl_xor(q, 32); nm[bj] = fmaxf(nm[bj], q); }
                    u32x4 w; w.x = cvt_pk_bf16(v0[0], v0[1]); w.y = cvt_pk_bf16(v0[2], v0[3]); w.z = cvt_pk_bf16(v1[0], v1[1]); w.w = cvt_pk_bf16(v1[2], v1[3]);
                    *(u32x4*)(hm ? rowh + (size_t)bj * 4096 * 128 : rowp + bj * HALF) = w; } }
        if (seg == 2 || seg == 3) {
#pragma unroll
            for (int bj = 0; bj < 2; ++bj) { float q = nm[bj];
#pragma unroll
                for (int o = 1; o < 16; o <<= 1) q = fmaxf(q, __shfl_xor(q, o));
                if (fr == 0 && fq == 0) atomicMax(norm + ((((seg - 2) * 8 + (u.pm >> 4)) * 8 + 2 * (u.pn & 3) + bj) * 4 + wc), __float_as_uint(q)); }
        }
    }
};
template <int MODE> struct EpiGate {
    static constexpr bool PERM = true, AFTER_DRAIN = false; static constexpr int NSTORES = 16;
    const bf16_t* G; bf16_t* O;
    __device__ __forceinline__ void operator()(const f32x4 (&acc)[2][2][4][2], const Unit& u, int wr, int wc, int fr, int fq) const {
        const int row0 = u.pm * BM + wr * 64 + fr, col0 = u.pn * BM + wc * 32 + 8 * fq;
        u32x4 gv[2][2][2], pv[2][2][2];
#define EG_LOAD(st_, b_) do { _Pragma("unroll") for (int mm = 0; mm < 2; ++mm) _Pragma("unroll") for (int bj = 0; bj < 2; ++bj) { \
            const size_t off_ = (size_t)(row0 + ((st_) >> 1) * HALF + (2 * ((st_) & 1) + mm) * 16) * 1024 + col0 + bj * HALF; gv[b_][mm][bj] = *(const u32x4*)(G + off_); if (MODE == 1) pv[b_][mm][bj] = *(const u32x4*)(O + off_); } } while (0)
#define EG_DO(st_, b_) do { _Pragma("unroll") for (int mm = 0; mm < 2; ++mm) _Pragma("unroll") for (int bj = 0; bj < 2; ++bj) { const int ai = (st_) >> 1, m = 2 * ((st_) & 1) + mm; \
            const size_t off_ = (size_t)(row0 + ai * HALF + m * 16) * 1024 + col0 + bj * HALF; const u32x4 g = gv[b_][mm][bj]; \
            f32x4 v0 = acc[ai][bj][m][0], v1 = acc[ai][bj][m][1]; \
            v0[0] *= bf_lo(g.x); v0[1] *= bf_hi(g.x); v0[2] *= bf_lo(g.y); v0[3] *= bf_hi(g.y); v1[0] *= bf_lo(g.z); v1[1] *= bf_hi(g.z); v1[2] *= bf_lo(g.w); v1[3] *= bf_hi(g.w); \
            if (MODE == 1) { const u32x4 p = pv[b_][mm][bj]; \
                v0[0] += bf_lo(p.x); v0[1] += bf_hi(p.x); v0[2] += bf_lo(p.y); v0[3] += bf_hi(p.y); v1[0] += bf_lo(p.z); v1[1] += bf_hi(p.z); v1[2] += bf_lo(p.w); v1[3] += bf_hi(p.w); } \
            u32x4 w; w.x = cvt_pk_bf16(v0[0], v0[1]); w.y = cvt_pk_bf16(v0[2], v0[3]); w.z = cvt_pk_bf16(v1[0], v1[1]); w.w = cvt_pk_bf16(v1[2], v1[3]); \
            *(u32x4*)(O + off_) = w; } } while (0)
        EG_LOAD(0, 0); EG_LOAD(1, 1); EG_DO(0, 0); EG_LOAD(2, 0); EG_DO(1, 1); EG_LOAD(3, 1); EG_DO(2, 0); EG_DO(3, 1);
#undef EG_LOAD
#undef EG_DO
    }
};
struct TwoGemmOrder {
    StaticOrder base; int n1;
    __device__ void init(int M, int N, int G_, int c_) { base.init(M, N, G_, c_); n1 = (base.nwg - c_ + G_ - 1) / G_; if (n1 < 0) n1 = 0; }
    __device__ __forceinline__ bool next(int i, Unit& u) const { if (i >= 2 * n1) return false; const bool second = i >= n1; base.next(second ? i - n1 : i, u); if (second) { u.pm += 128; u.pn += 4; } return true; }
    __device__ __forceinline__ void a_ready(const Unit&) const {}
    __device__ __forceinline__ void done(const Unit&) const {}
};
struct EpiGate2 {
    static constexpr bool PERM = true, AFTER_DRAIN = false; static constexpr int NSTORES = 16;
    const bf16_t* G0; const bf16_t* G1; bf16_t* O;
    __device__ __forceinline__ void operator()(const f32x4 (&acc)[2][2][4][2], const Unit& u, int wr, int wc, int fr, int fq) const {
        Unit v; v.pm = u.pm & 127; v.pn = u.pn & 3;
        if (u.pm >= 128) { EpiGate<1> e{G1, O}; e(acc, v, wr, wc, fr, fq); } else { EpiGate<0> e{G0, O}; e(acc, v, wr, wc, fr, fq); }
    }
};
struct EpiDelta {
    static constexpr bool PERM = true, AFTER_DRAIN = false; static constexpr int NSTORES = 16;
    bf16_t* O;
    __device__ __forceinline__ void operator()(const f32x4 (&acc)[2][2][4][2], const Unit& u, int wr, int wc, int fr, int fq) const {
        const int row0 = u.pm * BM + wr * 64 + fr, col0 = u.pn * BM + wc * 32 + 8 * fq;
#pragma unroll
        for (int ai = 0; ai < 2; ++ai)
#pragma unroll
            for (int m = 0; m < 4; ++m) { bf16_t* rowp = O + (size_t)(row0 + ai * HALF + m * 16) * 1024 + col0;
#pragma unroll
                for (int bj = 0; bj < 2; ++bj) { const f32x4 v0 = acc[ai][bj][m][0], v1 = acc[ai][bj][m][1];
                    u32x4 w; w.x = cvt_pk_bf16(v0[0], v0[1]); w.y = cvt_pk_bf16(v0[2], v0[3]); w.z = cvt_pk_bf16(v1[0], v1[1]); w.w = cvt_pk_bf16(v1[2], v1[3]);
                    *(u32x4*)(rowp + bj * HALF) = w; } }
    }
};
struct EpiSwiGLU {
    static constexpr bool PERM = true, AFTER_DRAIN = false; static constexpr int NSTORES = 8;
    unsigned char* HB;
    __device__ __forceinline__ void operator()(const f32x4 (&acc)[2][2][4][2], const Unit& u, int wr, int wc, int fr, int fq, const PG8_LAS int* rows) const {
        const int row0 = u.pm * BM + wr * 64 + fr, col0 = (u.pn & 3) * HALF + wc * 32 + 8 * fq;
        float sv[2][4];
#pragma unroll
        for (int ai = 0; ai < 2; ++ai)
#pragma unroll
            for (int m = 0; m < 4; ++m) sv[ai][m] = ((const PG8_LAS float*)rows)[6 * 256 + wr * 64 + fr + ai * HALF + m * 16] * (1.0f / W13_SCALE);
#pragma unroll
        for (int ai = 0; ai < 2; ++ai)
#pragma unroll
            for (int m = 0; m < 4; ++m) { const int row = row0 + ai * HALF + m * 16; const float s = sv[ai][m];
                float o[8];
#pragma unroll
                for (int n = 0; n < 2; ++n)
#pragma unroll
                    for (int i = 0; i < 4; ++i) { const float g = acc[ai][0][m][n][i] * s, uu = acc[ai][1][m][n][i] * s; o[n * 4 + i] = g * sigmoid_f(g) * uu * HB_SCALE; }
                unsigned long long w = (unsigned long long)pack4_fp8(o[0], o[1], o[2], o[3]) | ((unsigned long long)pack4_fp8(o[4], o[5], o[6], o[7]) << 32);
                *(unsigned long long*)(HB + (size_t)row * 512 + col0) = w; }
    }
};
constexpr float Y_SCALE = 0.25f;
struct EpiY {
    static constexpr bool PERM = true, AFTER_DRAIN = false; static constexpr int NSTORES = 16;
    unsigned char* Y;
    __device__ __forceinline__ void operator()(const f32x4 (&acc)[2][2][4][2], const Unit& u, int wr, int wc, int fr, int fq) const {
        const int row0 = u.pm * BM + wr * 64 + fr, col0 = (u.pn & 3) * BM + wc * 32 + 8 * fq;
#pragma unroll
        for (int ai = 0; ai < 2; ++ai)
#pragma unroll
            for (int m = 0; m < 4; ++m) { const int row = row0 + ai * HALF + m * 16; unsigned char* rowp = Y + (size_t)row * 1024 + col0;
#pragma unroll
                for (int bj = 0; bj < 2; ++bj) { const f32x4 v0 = acc[ai][bj][m][0] * Y_SCALE, v1 = acc[ai][bj][m][1] * Y_SCALE;
                    *(unsigned long long*)(rowp + bj * HALF) = (unsigned long long)pack4_fp8(v0[0], v0[1], v0[2], v0[3]) | ((unsigned long long)pack4_fp8(v1[0], v1[1], v1[2], v1[3]) << 32); } }
    }
};
struct GroupedOrder {
    const PG8_LAS int* tile_e; int nunits, G, c;
    __device__ __forceinline__ bool next(int i, Unit& u) const { const int L = i * G + c; if (L >= nunits) return false; u.pm = L >> 2; u.pn = __builtin_amdgcn_readfirstlane(tile_e[u.pm]) * 4 + (L & 3); return true; }
    __device__ __forceinline__ void a_ready(const Unit&) const {}
    __device__ __forceinline__ void done(const Unit&) const {}
};
template <class Epi, class Sched, bool ALIGN_EPI = false, bool SP2 = false, bool F8 = false>
__device__ __forceinline__ void gemm_phase(PG8_LAS unsigned char* lds, const Gemm g, const Sched& S, const Epi& E, const int wid) {
    const int lane = lane_now(), tid = wid * 64 + lane, wr = wid >> 2, wc = wid & 3, fr = lane & 15, fq = lane >> 4;
    const int K = g.K, nt = K / BK;
    unsigned voffA[2], voffB[2];
#pragma unroll
    for (int i = 0; i < 2; ++i) { int R, C; stage_rc(tid * 16 + i * 8192, R, C); const int Rb = Epi::PERM ? ((R & ~31) + perm32(R & 31)) : R;
        voffA[i] = (unsigned)(R * K + C) * 2u; voffB[i] = (unsigned)(Rb * K + C) * 2u; }
    const size_t kstep = (size_t)(BK * 2);
    const size_t hstep = (size_t)HALF * K * 2;
    const size_t tstep = 2 * hstep;
    const unsigned ldsw = (unsigned)wid * 1024u;
    const unsigned ldsbase = (unsigned)__builtin_amdgcn_readfirstlane((int)((unsigned)(uintptr_t)lds + ldsw));
    const int aoff = lds_byte(wr * 64 + fr, fq * 8), boff = lds_byte(wc * 32 + fr, fq * 8);
#define PG8_SA(b, h) (((b) * 2 + (h)) * HTB)
#define PG8_SB(b, h) ((4 + (b) * 2 + (h)) * HTB)
#define PG8_STAGE(bufoff, gbase, voff) do { _Pragma("unroll") for (int _i = 0; _i < 2; ++_i) { \
        if constexpr (F8) glds_sv((const char*)(gbase), (voff)[_i], ldsbase + (unsigned)((bufoff) + _i * 8192)); \
        else __builtin_amdgcn_global_load_lds((const unsigned*)((const char*)(gbase) + (voff)[_i]), (PG8_LAS unsigned*)(lds + (bufoff) + ldsw + _i * 8192), 16, 0, 0); } } while (0)
#define PG8_LDA(dst, b, h) do { _Pragma("unroll") for (int m = 0; m < 4; ++m) { \
        if constexpr (F8) { dst##8[m] = cat8(*(const PG8_LAS bf16x8*)(lds + PG8_SA(b, h) + aoff + m * 2048), *(const PG8_LAS bf16x8*)(lds + PG8_SA(b, h) + aoff + m * 2048 + 1024)); } \
        else { _Pragma("unroll") for (int k = 0; k < 2; ++k) dst[m][k] = *(const PG8_LAS bf16x8*)(lds + PG8_SA(b, h) + aoff + m * 2048 + k * 1024); } } } while (0)
#define PG8_LDB(dst, b, h) do { _Pragma("unroll") for (int n = 0; n < 2; ++n) { \
        if constexpr (F8) { dst##8[n] = cat8(*(const PG8_LAS bf16x8*)(lds + PG8_SB(b, h) + boff + n * 2048), *(const PG8_LAS bf16x8*)(lds + PG8_SB(b, h) + boff + n * 2048 + 1024)); } \
        else { _Pragma("unroll") for (int k = 0; k < 2; ++k) dst[n][k] = *(const PG8_LAS bf16x8*)(lds + PG8_SB(b, h) + boff + n * 2048 + k * 1024); } } } while (0)
#define PG8_MMA(ai, bj, At, Bt) do { __builtin_amdgcn_s_setprio(1); _Pragma("unroll") for (int m = 0; m < 4; ++m) _Pragma("unroll") for (int n = 0; n < 2; ++n) { \
        if constexpr (F8) { acc[ai][bj][m][n] = __builtin_amdgcn_mfma_scale_f32_16x16x128_f8f6f4(Bt##8[n], At##8[m], acc[ai][bj][m][n], 0, 0, 0, 0, 0, 0); } \
        else { _Pragma("unroll") for (int k = 0; k < 2; ++k) acc[ai][bj][m][n] = __builtin_amdgcn_mfma_f32_16x16x32_bf16(Bt[n][k], At[m][k], acc[ai][bj][m][n], 0, 0, 0); } } \
        __builtin_amdgcn_s_setprio(0); } while (0)
#define PG8_WAIT_V(n) asm volatile("s_waitcnt vmcnt(" #n ")" ::: "memory")
#define PG8_WAIT_L(n) asm volatile("s_waitcnt lgkmcnt(" #n ")" ::: "memory")
#define PG8_BAR __builtin_amdgcn_s_barrier()
#define PG8_SCHED __builtin_amdgcn_sched_barrier(0)
    Unit cur, nxt; int ui = 0;
    if (!S.next(0, cur)) return;
    f32x4 acc[2][2][4][2];
#pragma unroll
    for (int a = 0; a < 2; ++a)
#pragma unroll
        for (int b = 0; b < 2; ++b)
#pragma unroll
            for (int m = 0; m < 4; ++m)
#pragma unroll
                for (int n = 0; n < 2; ++n) acc[a][b][m][n] = (f32x4){0.f, 0.f, 0.f, 0.f};
    bf16x8 At[4][2], B0[2][2], B1[2][2]; v8i_t At8[4], B08[2], B18[2];
    const char* cA = (const char*)g.A + (size_t)cur.pm * tstep; const char* cB = (const char*)g.Bt + (size_t)cur.pn * tstep;
    S.a_ready(cur);
    if constexpr (SP2) {
        PG8_STAGE(PG8_SB(0, 0), cB, voffB); PG8_STAGE(PG8_SB(0, 1), cB + hstep, voffB); PG8_STAGE(PG8_SA(0, 0), cA, voffA); PG8_STAGE(PG8_SA(0, 1), cA + hstep, voffA);
        if (wr == 1) PG8_BAR;
        PG8_WAIT_V(2); PG8_BAR;
        PG8_STAGE(PG8_SB(1, 0), cB + kstep, voffB); PG8_STAGE(PG8_SA(1, 0), cA + kstep, voffA); PG8_STAGE(PG8_SB(1, 1), cB + hstep + kstep, voffB);
        PG8_WAIT_V(6); PG8_BAR;
    } else {
        PG8_STAGE(PG8_SB(0, 0), cB, voffB); PG8_STAGE(PG8_SA(0, 0), cA, voffA); PG8_STAGE(PG8_SB(0, 1), cB + hstep, voffB); PG8_STAGE(PG8_SA(0, 1), cA + hstep, voffA);
        if (wr == 1) PG8_BAR;
        PG8_WAIT_V(4); PG8_BAR;
        PG8_STAGE(PG8_SB(1, 0), cB + kstep, voffB); PG8_STAGE(PG8_SA(1, 0), cA + kstep, voffA); PG8_STAGE(PG8_SB(1, 1), cB + hstep + kstep, voffB);
        PG8_WAIT_V(6); PG8_BAR;
    }
    for (;;) {
        const bool has_next = S.next(ui + 1, nxt);
        const char* nA = has_next ? (const char*)g.A + (size_t)nxt.pm * tstep : cA; const char* nB = has_next ? (const char*)g.Bt + (size_t)nxt.pn * tstep : cB;
#pragma clang loop unroll(disable)
        for (int t = 0; t < nt; t += 2) {
            const bool last = (t == nt - 2);
            const char* a1 = cA + (size_t)(t + 1) * kstep;
            const char* a2 = last ? nA : cA + (size_t)(t + 2) * kstep; const char* b2 = last ? nB : cB + (size_t)(t + 2) * kstep;
            const char* a3 = a2 + kstep; const char* b3 = b2 + kstep;
            if (last && has_next) S.a_ready(nxt);
            if constexpr (SP2) {
            PG8_LDB(B0, 0, 0); PG8_LDB(B1, 0, 1); PG8_SCHED; PG8_LDA(At, 0, 0); PG8_STAGE(PG8_SA(1, 1), a1 + hstep, voffA);
            PG8_WAIT_V(8); PG8_WAIT_L(0); PG8_BAR; PG8_MMA(0, 0, At, B0); PG8_MMA(0, 1, At, B1); PG8_BAR; PG8_SCHED;
            PG8_LDA(At, 0, 1); PG8_STAGE(PG8_SB(0, 0), b2, voffB); PG8_STAGE(PG8_SB(0, 1), b2 + hstep, voffB); PG8_STAGE(PG8_SA(0, 0), a2, voffA);
            PG8_WAIT_V(8); PG8_WAIT_L(0); PG8_BAR; PG8_MMA(1, 0, At, B0); PG8_MMA(1, 1, At, B1); PG8_BAR; PG8_SCHED;
            PG8_LDB(B0, 1, 0); PG8_LDB(B1, 1, 1); PG8_SCHED; PG8_LDA(At, 1, 0); PG8_STAGE(PG8_SA(0, 1), a2 + hstep, voffA);
            PG8_WAIT_V(8); PG8_WAIT_L(0); PG8_BAR; PG8_MMA(0, 0, At, B0); PG8_MMA(0, 1, At, B1); PG8_BAR; PG8_SCHED;
            PG8_LDA(At, 1, 1); PG8_STAGE(PG8_SB(1, 0), b3, voffB); PG8_STAGE(PG8_SB(1, 1), b3 + hstep, voffB); PG8_STAGE(PG8_SA(1, 0), a3, voffA);
            PG8_WAIT_V(8); PG8_WAIT_L(0); PG8_BAR; PG8_MMA(1, 0, At, B0); PG8_MMA(1, 1, At, B1); PG8_BAR; PG8_SCHED;
            } else {
            PG8_LDB(B0, 0, 0); PG8_SCHED; PG8_LDA(At, 0, 0); PG8_STAGE(PG8_SA(1, 1), a1 + hstep, voffA);
            PG8_WAIT_L(8); PG8_BAR; PG8_WAIT_L(0); PG8_MMA(0, 0, At, B0); PG8_BAR; PG8_SCHED;
            PG8_LDB(B1, 0, 1); PG8_STAGE(PG8_SB(0, 0), b2, voffB);
            PG8_BAR; PG8_WAIT_L(0); PG8_MMA(0, 1, At, B1); PG8_BAR;
            PG8_LDA(At, 0, 1); PG8_STAGE(PG8_SA(0, 0), a2, voffA);
            PG8_BAR; PG8_WAIT_L(0); PG8_MMA(1, 0, At, B0); PG8_BAR; PG8_SCHED;
            PG8_STAGE(PG8_SB(0, 1), b2 + hstep, voffB);
            PG8_WAIT_V(6); PG8_BAR; PG8_MMA(1, 1, At, B1); PG8_BAR;
            PG8_LDB(B0, 1, 0); PG8_SCHED; PG8_LDA(At, 1, 0); PG8_STAGE(PG8_SA(0, 1), a2 + hstep, voffA);
            PG8_WAIT_L(8); PG8_BAR; PG8_WAIT_L(0); PG8_MMA(0, 0, At, B0); PG8_BAR; PG8_SCHED;
            PG8_LDB(B1, 1, 1); PG8_STAGE(PG8_SB(1, 0), b3, voffB);
            PG8_BAR; PG8_WAIT_L(0); PG8_MMA(0, 1, At, B1); PG8_BAR;
            PG8_LDA(At, 1, 1); PG8_STAGE(PG8_SA(1, 0), a3, voffA);
            PG8_BAR; PG8_WAIT_L(0); PG8_MMA(1, 0, At, B0); PG8_BAR; PG8_SCHED;
            PG8_STAGE(PG8_SB(1, 1), b3 + hstep, voffB);
            PG8_WAIT_V(6); PG8_BAR; PG8_MMA(1, 1, At, B1); PG8_BAR;
            }
        }
        if constexpr (ALIGN_EPI) { if (wr == 0) PG8_BAR; }
        if constexpr (!Epi::AFTER_DRAIN) { const int l2 = lane_now(); E(acc, cur, wr, wc, l2 & 15, l2 >> 4); S.done(cur); }
        if (!has_next) break;
#pragma unroll
        for (int a = 0; a < 2; ++a)
#pragma unroll
            for (int b = 0; b < 2; ++b)
#pragma unroll
                for (int m = 0; m < 4; ++m)
#pragma unroll
                    for (int n = 0; n < 2; ++n) acc[a][b][m][n] = (f32x4){0.f, 0.f, 0.f, 0.f};
        cur = nxt; cA = nA; cB = nB; ++ui;
        if constexpr (ALIGN_EPI) { if (wr == 1) PG8_BAR; }
    }
    PG8_WAIT_V(0);
    if constexpr (!ALIGN_EPI) { if (wr == 0) PG8_BAR; }
    PG8_BAR;
    if constexpr (Epi::AFTER_DRAIN) { E.fused(acc, cur, wr, wc, fr, fq, lds, wid, lane); S.done(cur); }
#undef PG8_SA
#undef PG8_SB
#undef PG8_STAGE
#undef PG8_LDA
#undef PG8_LDB
#undef PG8_MMA
#undef PG8_WAIT_V
#undef PG8_WAIT_L
#undef PG8_BAR
#undef PG8_SCHED
}
template <class Epi, class Sched, bool F8 = false>
__device__ __forceinline__ void gemm_phase_gather(PG8_LAS unsigned char* lds, const Gemm g, const Sched& S, const Epi& E, const PG8_LAS int* rowtab, const int wid) {
    constexpr bool ALIGN_EPI = true, SP2 = true;
    const int lane = lane_now(), tid = wid * 64 + lane, wr = wid >> 2, wc = wid & 3, fr = lane & 15, fq = lane >> 4;
    const int K = g.K, nt = K / BK;
    unsigned voffB[2], vAc[2][2];
#pragma unroll
    for (int i = 0; i < 2; ++i) { int R, C; stage_rc(tid * 16 + i * 8192, R, C); const int Rb = Epi::PERM ? ((R & ~31) + perm32(R & 31)) : R;
        voffB[i] = (unsigned)(Rb * K + C) * 2u; }
#define PG8_ROWS(dst, ui_) do { const int t_ = wid * 64 + lane_now(); _Pragma("unroll") for (int i_ = 0; i_ < 2; ++i_) { int R_, C_; stage_rc(t_ * 16 + i_ * 8192, R_, C_); \
        _Pragma("unroll") for (int h_ = 0; h_ < 2; ++h_) dst[h_][i_] = (unsigned)rowtab[(ui_) * 256 + h_ * HALF + R_] * (unsigned)(K * 2) + (unsigned)(C_ * 2); } } while (0)
#define PG8_STAGE_A(bufoff, v, kb) do { _Pragma("unroll") for (int _i = 0; _i < 2; ++_i) { \
        if constexpr (F8) glds_sv((const char*)g.A + (kb), (v)[_i], ldsbase + (unsigned)((bufoff) + _i * 8192)); \
        else __builtin_amdgcn_global_load_lds((const unsigned*)((const char*)g.A + (v)[_i] + (kb)), (PG8_LAS unsigned*)(lds + (bufoff) + ldsw + _i * 8192), 16, 0, 0); } } while (0)
    const size_t kstep = (size_t)(BK * 2);
    const size_t hstep = (size_t)HALF * K * 2;
    const size_t tstep = 2 * hstep;
    const unsigned ldsw = (unsigned)wid * 1024u;
    const unsigned ldsbase = (unsigned)__builtin_amdgcn_readfirstlane((int)((unsigned)(uintptr_t)lds + ldsw));
    const int aoff = lds_byte(wr * 64 + fr, fq * 8), boff = lds_byte(wc * 32 + fr, fq * 8);
#define PG8_SA(b, h) (((b) * 2 + (h)) * HTB)
#define PG8_SB(b, h) ((4 + (b) * 2 + (h)) * HTB)
#define PG8_STAGE(bufoff, gbase, voff) do { _Pragma("unroll") for (int _i = 0; _i < 2; ++_i) { \
        if constexpr (F8) glds_sv((const char*)(gbase), (voff)[_i], ldsbase + (unsigned)((bufoff) + _i * 8192)); \
        else __builtin_amdgcn_global_load_lds((const unsigned*)((const char*)(gbase) + (voff)[_i]), (PG8_LAS unsigned*)(lds + (bufoff) + ldsw + _i * 8192), 16, 0, 0); } } while (0)
#define PG8_LDA(dst, b, h) do { _Pragma("unroll") for (int m = 0; m < 4; ++m) { \
        if constexpr (F8) { dst##8[m] = cat8(*(const PG8_LAS bf16x8*)(lds + PG8_SA(b, h) + aoff + m * 2048), *(const PG8_LAS bf16x8*)(lds + PG8_SA(b, h) + aoff + m * 2048 + 1024)); } \
        else { _Pragma("unroll") for (int k = 0; k < 2; ++k) dst[m][k] = *(const PG8_LAS bf16x8*)(lds + PG8_SA(b, h) + aoff + m * 2048 + k * 1024); } } } while (0)
#define PG8_LDB(dst, b, h) do { _Pragma("unroll") for (int n = 0; n < 2; ++n) { \
        if constexpr (F8) { dst##8[n] = cat8(*(const PG8_LAS bf16x8*)(lds + PG8_SB(b, h) + boff + n * 2048), *(const PG8_LAS bf16x8*)(lds + PG8_SB(b, h) + boff + n * 2048 + 1024)); } \
        else { _Pragma("unroll") for (int k = 0; k < 2; ++k) dst[n][k] = *(const PG8_LAS bf16x8*)(lds + PG8_SB(b, h) + boff + n * 2048 + k * 1024); } } } while (0)
#define PG8_MMA(ai, bj, At, Bt) do { __builtin_amdgcn_s_setprio(1); _Pragma("unroll") for (int m = 0; m < 4; ++m) _Pragma("unroll") for (int n = 0; n < 2; ++n) { \
        if constexpr (F8) { acc[ai][bj][m][n] = __builtin_amdgcn_mfma_scale_f32_16x16x128_f8f6f4(Bt##8[n], At##8[m], acc[ai][bj][m][n], 0, 0, 0, 0, 0, 0); } \
        else { _Pragma("unroll") for (int k = 0; k < 2; ++k) acc[ai][bj][m][n] = __builtin_amdgcn_mfma_f32_16x16x32_bf16(Bt[n][k], At[m][k], acc[ai][bj][m][n], 0, 0, 0); } } \
        __builtin_amdgcn_s_setprio(0); } while (0)
#define PG8_WAIT_V(n) asm volatile("s_waitcnt vmcnt(" #n ")" ::: "memory")
#define PG8_WAIT_L(n) asm volatile("s_waitcnt lgkmcnt(" #n ")" ::: "memory")
#define PG8_BAR __builtin_amdgcn_s_barrier()
#define PG8_SCHED __builtin_amdgcn_sched_barrier(0)
    Unit cur, nxt; int ui = 0;
    if (!S.next(0, cur)) return;
    f32x4 acc[2][2][4][2];
#pragma unroll
    for (int a = 0; a < 2; ++a)
#pragma unroll
        for (int b = 0; b < 2; ++b)
#pragma unroll
            for (int m = 0; m < 4; ++m)
#pragma unroll
                for (int n = 0; n < 2; ++n) acc[a][b][m][n] = (f32x4){0.f, 0.f, 0.f, 0.f};
    bf16x8 At[4][2], B0[2][2], B1[2][2]; v8i_t At8[4], B08[2], B18[2];
    const char* cB = (const char*)g.Bt + (size_t)cur.pn * tstep;
    PG8_ROWS(vAc, 0);
    S.a_ready(cur);
    if constexpr (SP2) {
        PG8_STAGE(PG8_SB(0, 0), cB, voffB); PG8_STAGE(PG8_SB(0, 1), cB + hstep, voffB); PG8_STAGE_A(PG8_SA(0, 0), vAc[0], 0u); PG8_STAGE_A(PG8_SA(0, 1), vAc[1], 0u);
        if (wr == 1) PG8_BAR;
        PG8_WAIT_V(2); PG8_BAR;
        PG8_STAGE(PG8_SB(1, 0), cB + kstep, voffB); PG8_STAGE_A(PG8_SA(1, 0), vAc[0], (unsigned)kstep); PG8_STAGE(PG8_SB(1, 1), cB + hstep + kstep, voffB);
        PG8_WAIT_V(6); PG8_BAR;
    }
    for (;;) {
        const bool has_next = S.next(ui + 1, nxt);
        const char* nB = has_next ? (const char*)g.Bt + (size_t)nxt.pn * tstep : cB;
#pragma clang loop unroll(disable)
        for (int t = 0; t < nt; t += 2) {
            const bool last = (t == nt - 2);
            const unsigned k1 = (unsigned)((t + 1) * (int)kstep), k2 = last ? 0u : (unsigned)((t + 2) * (int)kstep), k3 = k2 + (unsigned)kstep;
            unsigned v2[2][2];
            if (last && has_next) { PG8_ROWS(v2, ui + 1); }
            else {
#pragma unroll
                for (int h_ = 0; h_ < 2; ++h_)
#pragma unroll
                    for (int i_ = 0; i_ < 2; ++i_) v2[h_][i_] = vAc[h_][i_]; }
            const char* b2 = last ? nB : cB + (size_t)(t + 2) * kstep; const char* b3 = b2 + kstep;
            if (last && has_next) S.a_ready(nxt);
            if constexpr (SP2) {
            PG8_LDB(B0, 0, 0); PG8_LDB(B1, 0, 1); PG8_SCHED; PG8_LDA(At, 0, 0); PG8_STAGE_A(PG8_SA(1, 1), vAc[1], k1);
            PG8_WAIT_V(8); PG8_WAIT_L(0); PG8_BAR; PG8_MMA(0, 0, At, B0); PG8_MMA(0, 1, At, B1); PG8_BAR; PG8_SCHED;
            PG8_LDA(At, 0, 1); PG8_STAGE(PG8_SB(0, 0), b2, voffB); PG8_STAGE(PG8_SB(0, 1), b2 + hstep, voffB); PG8_STAGE_A(PG8_SA(0, 0), v2[0], k2);
            PG8_WAIT_V(8); PG8_WAIT_L(0); PG8_BAR; PG8_MMA(1, 0, At, B0); PG8_MMA(1, 1, At, B1); PG8_BAR; PG8_SCHED;
            PG8_LDB(B0, 1, 0); PG8_LDB(B1, 1, 1); PG8_SCHED; PG8_LDA(At, 1, 0); PG8_STAGE_A(PG8_SA(0, 1), v2[1], k2);
            PG8_WAIT_V(8); PG8_WAIT_L(0); PG8_BAR; PG8_MMA(0, 0, At, B0); PG8_MMA(0, 1, At, B1); PG8_BAR; PG8_SCHED;
            PG8_LDA(At, 1, 1); PG8_STAGE(PG8_SB(1, 0), b3, voffB); PG8_STAGE(PG8_SB(1, 1), b3 + hstep, voffB); PG8_STAGE_A(PG8_SA(1, 0), v2[0], k3);
            PG8_WAIT_V(8); PG8_WAIT_L(0); PG8_BAR; PG8_MMA(1, 0, At, B0); PG8_MMA(1, 1, At, B1); PG8_BAR; PG8_SCHED;
            }
        }
        if constexpr (ALIGN_EPI) { if (wr == 0) PG8_BAR; }
        { const int l2 = lane_now(); E(acc, cur, wr, wc, l2 & 15, l2 >> 4, rowtab + ui * 256); } S.done(cur);
        if (!has_next) break;
#pragma unroll
        for (int a = 0; a < 2; ++a)
#pragma unroll
            for (int b = 0; b < 2; ++b)
#pragma unroll
                for (int m = 0; m < 4; ++m)
#pragma unroll
                    for (int n = 0; n < 2; ++n) acc[a][b][m][n] = (f32x4){0.f, 0.f, 0.f, 0.f};
        cur = nxt; cB = nB; ++ui;
        PG8_ROWS(vAc, ui);
        if constexpr (ALIGN_EPI) { if (wr == 1) PG8_BAR; }
    }
    PG8_WAIT_V(0);
    if constexpr (!ALIGN_EPI) { if (wr == 0) PG8_BAR; }
    PG8_BAR;
#undef PG8_ROWS
#undef PG8_STAGE_A
#undef PG8_SA
#undef PG8_SB
#undef PG8_STAGE
#undef PG8_LDA
#undef PG8_LDB
#undef PG8_MMA
#undef PG8_WAIT_V
#undef PG8_WAIT_L
#undef PG8_BAR
#undef PG8_SCHED
}
}
#define GAS __attribute__((address_space(1)))
#define LAS __attribute__((address_space(3)))
typedef unsigned short bf16;
typedef unsigned v4u __attribute__((ext_vector_type(4)));
typedef float f32x4 __attribute__((ext_vector_type(4)));
typedef short bf16x8 __attribute__((ext_vector_type(8)));
typedef GAS unsigned gu32;
typedef GAS unsigned long long gu64;
#define RLX_AGENT __ATOMIC_RELAXED, __HIP_MEMORY_SCOPE_AGENT
#define LDS_WAIT() asm volatile("s_waitcnt lgkmcnt(0)" ::: "memory")
#define VM_WAIT() asm volatile("s_waitcnt vmcnt(0)" ::: "memory")
__device__ __forceinline__ unsigned long long rt() { return __builtin_amdgcn_s_memrealtime(); }
__device__ __forceinline__ unsigned f2bf(float f) { unsigned u = __builtin_bit_cast(unsigned, f); return (u + 0x7fffu + ((u >> 16) & 1u)) >> 16; }
__device__ __forceinline__ unsigned pk2(float lo, float hi) { return f2bf(lo) | (f2bf(hi) << 16); }
#define XB_TMO      128
#define XB_XCNT(j)  (256  + 64 * (j))
#define XB_XSUB(j)  (1280 + 64 * (j))
#define XB_XGEN(j)  (2304 + 64 * (j))
#define XB_TOP      3328
#define XB_TOPGEN   3392
#define XCD_BAR_WORDS 3456
#define XB_SPIN_CAP (1u << 18)

__device__ __forceinline__ unsigned xb_ld(unsigned* p)              { return __hip_atomic_load(p, __ATOMIC_RELAXED, __HIP_MEMORY_SCOPE_AGENT); }
__device__ __forceinline__ unsigned xb_add(unsigned* p, unsigned v) { return __hip_atomic_fetch_add(p, v, __ATOMIC_RELAXED, __HIP_MEMORY_SCOPE_AGENT); }
__device__ __forceinline__ unsigned xb_xcc_id() { return (unsigned)__builtin_amdgcn_s_getreg((3 << 11) | 20) & 0xFu; }
#define XB_SPIN(cond, bar) do { unsigned _sp = 0; while (cond) { __builtin_amdgcn_s_sleep(1); \
    if ((++_sp & 255u) == 0u) { if (xb_ld(&(bar)[XB_TMO])) break; if (_sp > XB_SPIN_CAP) { atomicAdd(&(bar)[XB_TMO], 1u); break; } } } } while (0)

struct XcdBarrier {
    unsigned* bar; unsigned x;
    volatile LAS unsigned* st;
};

__device__ __forceinline__ XcdBarrier xcd_barrier_post(unsigned* bar, volatile LAS unsigned* st) {
    XcdBarrier b; b.bar = bar; b.x = xb_xcc_id(); b.st = st;
    if (threadIdx.x == 0) (void)xb_add(&bar[XB_XCNT(b.x)], 1u);
    return b;
}
__device__ __forceinline__ void xcd_barrier_complete(unsigned* bar, unsigned x, unsigned& nloc, unsigned& nx) {
    const unsigned G = gridDim.x * gridDim.y * gridDim.z;
    unsigned sum, cnt, mine, sp = 0u;
    for (;;) {
        sum = 0u; cnt = 0u; mine = 0u;
#pragma unroll
        for (unsigned j = 0; j < 16; ++j) { const unsigned c = xb_ld(&bar[XB_XCNT(j)]); sum += c; cnt += (c > 0u) ? 1u : 0u; mine = (j == x) ? c : mine; }
        if (sum == G) break;
        __builtin_amdgcn_s_sleep(1);
        if ((++sp & 255u) == 0u) { if (xb_ld(&bar[XB_TMO])) break; if (sp > XB_SPIN_CAP) { atomicAdd(&bar[XB_TMO], 1u); break; } }
    }
    nloc = mine > 0u ? mine : 1u; nx = cnt > 0u ? cnt : 1u;
}

__device__ __forceinline__ void xcd_barrier(const XcdBarrier& b) {
    asm volatile("s_waitcnt vmcnt(0)" ::: "memory");
    __syncthreads();
    if (threadIdx.x == 0) {
        unsigned* bar = b.bar;
        __builtin_amdgcn_s_waitcnt(0);
        unsigned nloc = b.st[0], nx = b.st[1];
        if (nloc == 0u) { xcd_barrier_complete(bar, b.x, nloc, nx); b.st[0] = nloc; b.st[1] = nx; }
        const unsigned old = xb_add(&bar[XB_XSUB(b.x)], 1u);
        const unsigned gen = old / nloc;
        if (old + 1u == (gen + 1u) * nloc) {
            __builtin_amdgcn_fence(__ATOMIC_RELEASE, "agent");
            asm volatile("s_waitcnt vmcnt(0)" ::: "memory");
            const unsigned og = xb_add(&bar[XB_TOP], 1u);
            const unsigned tg = og / nx;
            if (og + 1u == (tg + 1u) * nx) xb_add(&bar[XB_TOPGEN], 1u);
            else XB_SPIN(xb_ld(&bar[XB_TOPGEN]) == tg, bar);
            __builtin_amdgcn_fence(__ATOMIC_ACQUIRE, "agent");
            xb_add(&bar[XB_XGEN(b.x)], 1u);
            asm volatile("s_waitcnt vmcnt(0)" ::: "memory");
        } else {
            XB_SPIN(xb_ld(&bar[XB_XGEN(b.x)]) == gen, bar);
            __builtin_amdgcn_fence(__ATOMIC_ACQUIRE, "agent");
            asm volatile("s_waitcnt vmcnt(0)" ::: "memory");
        }
    }
    __syncthreads();
}
namespace fattn {
typedef unsigned short bf16;
typedef short bf16x8 __attribute__((ext_vector_type(8)));
typedef short s16x4 __attribute__((ext_vector_type(4)));
typedef float f32x16 __attribute__((ext_vector_type(16)));
typedef float f32x4 __attribute__((ext_vector_type(4)));
typedef unsigned u32x4 __attribute__((ext_vector_type(4)));
constexpr int D = 128, LD = 128, LDO = 1024, SEQ = 4096;
constexpr float THR = 8.f;
constexpr float SCALE = 0.08838834764831845f;
constexpr int NW = 8, QBLK = 32, KVBLK = 64, QB = NW * QBLK;
constexpr int SHM_V = KVBLK * D * 2, SHM_K = KVBLK * D * 2;
constexpr int OFF_WS = 2 * SHM_V + 2 * SHM_K, OFF_BIAS = OFF_WS + NW * 64 * 4, LDS_BYTES = OFF_BIAS + 2 * 64 * 4;

#define KSWZ(row, colB) ((row) * 256 + ((colB) ^ (((row) & 7) << 4)))
#define SBAR() __builtin_amdgcn_sched_barrier(0)
__device__ __forceinline__ int v_st(int k, int c) { const int kk = (k & ~0xC) | ((k & 4) << 1) | ((k & 8) >> 1); return ((kk >> 3) * 4 + (c >> 5)) * 512 + ((kk & 7) * 32 + (c & 31)) * 2; }
__device__ __forceinline__ int v_rd_base(int lane) { return ((lane & 3) << 3) | (((lane >> 2) & 3) << 6) | (((lane >> 4) & 1) << 5) | (((lane >> 5) & 1) << 8); }
constexpr int v_rd_off(int d0, int ks, int half) { return d0 * 512 + ks * 4096 + half * 2048; }
__device__ __forceinline__ int crow(int r, int hi) { return (r & 3) + 8 * (r >> 2) + 4 * hi; }
__device__ __forceinline__ unsigned cvtpk(float lo, float hi) { unsigned r; asm volatile("v_cvt_pk_bf16_f32 %0, %1, %2" : "=v"(r) : "v"(lo), "v"(hi)); return r; }
__device__ __forceinline__ bf16x8 load8(const bf16* p) { return *reinterpret_cast<const bf16x8*>(p); }
__device__ __forceinline__ void mask_tile(f32x16& p0, f32x16& p1, int dq) {
    const float NEG = -__builtin_inff();
#pragma unroll
    for (int r = 0; r < 16; ++r) {
        const int c = (r & 3) + 8 * (r >> 2);
        if (dq - c < 0) p0[r] = NEG;
        if (dq - c - 32 < 0) p1[r] = NEG;
    }
}
__device__ __forceinline__ void partialSM(f32x16& p0, f32x16& p1, float& m_reg, float& mn, float& alpha) {
    float pmax = p0[0]; for (int r = 1; r < 16; ++r) pmax = fmaxf(pmax, p0[r]); for (int r = 0; r < 16; ++r) pmax = fmaxf(pmax, p1[r]);
    { auto rr = __builtin_amdgcn_permlane32_swap(__float_as_uint(pmax), __float_as_uint(pmax), false, false);
      pmax = fmaxf(__uint_as_float(rr[0]), __uint_as_float(rr[1])); }
    constexpr float C2 = 1.4426950408889634f * SCALE;
    if (__builtin_expect(__all((pmax - m_reg) * SCALE <= THR), 1)) { mn = m_reg; alpha = 1.f; }
    else { mn = fmaxf(m_reg, pmax); alpha = __builtin_amdgcn_exp2f((m_reg - mn) * C2); m_reg = mn; }
    const float mnL = -mn * C2;
    for (int r = 0; r < 16; ++r) p0[r] = fmaf(p0[r], C2, mnL); for (int r = 0; r < 16; ++r) p1[r] = fmaf(p1[r], C2, mnL);
    for (int r = 0; r < 16; ++r) p0[r] = __builtin_amdgcn_exp2f(p0[r]);
}
__device__ __forceinline__ void finishSM(f32x16& p0, f32x16& p1, float alpha, float& l_reg, bf16x8& pa0, bf16x8& pa1, bf16x8& pa2, bf16x8& pa3) {
    for (int r = 0; r < 16; ++r) p1[r] = __builtin_amdgcn_exp2f(p1[r]);
    float ps = 0; for (int r = 0; r < 16; ++r) ps += p0[r]; for (int r = 0; r < 16; ++r) ps += p1[r];
    { auto rr = __builtin_amdgcn_permlane32_swap(__float_as_uint(ps), __float_as_uint(ps), false, false);
      ps = __uint_as_float(rr[0]) + __uint_as_float(rr[1]); }
    l_reg = l_reg * alpha + ps;
#define PK4(P, B_, OUT) do { unsigned a0 = cvtpk(P[B_+0], P[B_+1]), a1 = cvtpk(P[B_+2], P[B_+3]);                          \
        unsigned b0 = cvtpk(P[B_+4], P[B_+5]), b1 = cvtpk(P[B_+6], P[B_+7]);                                             \
        auto r0 = __builtin_amdgcn_permlane32_swap(a0, b0, false, false); auto r1 = __builtin_amdgcn_permlane32_swap(a1, b1, false, false); \
        u32x4 w = {r0[0], r1[0], r0[1], r1[1]}; OUT = *reinterpret_cast<bf16x8*>(&w); } while (0)
    PK4(p0, 0, pa0); PK4(p0, 8, pa1); PK4(p1, 0, pa2); PK4(p1, 8, pa3);
#undef PK4
}
template <int KB>
__device__ __forceinline__ void qkt(f32x16& p0, f32x16& p1, const char* K_lds, const char* Bias_lds, int r32, int hi, const bf16x8* qr) {
    { const f32x4* bb = reinterpret_cast<const f32x4*>(Bias_lds + KB * 256 + hi * 16);
      const f32x4 a0 = bb[0], a1 = bb[2], a2 = bb[4], a3 = bb[6], c0 = bb[8], c1 = bb[10], c2 = bb[12], c3 = bb[14];
      p0 = (f32x16){a0[0], a0[1], a0[2], a0[3], a1[0], a1[1], a1[2], a1[3], a2[0], a2[1], a2[2], a2[3], a3[0], a3[1], a3[2], a3[3]};
      p1 = (f32x16){c0[0], c0[1], c0[2], c0[3], c1[0], c1[1], c1[2], c1[3], c2[0], c2[1], c2[2], c2[3], c3[0], c3[1], c3[2], c3[3]}; }
    const char* kb[4];
#pragma unroll
    for (int dd = 0; dd < 4; ++dd) kb[dd] = K_lds + KB * SHM_K + KSWZ(r32, (dd * 16 + hi * 8) * 2);
#pragma unroll
    for (int d0 = 0; d0 < 8; ++d0) { const char* a = kb[d0 & 3] + (d0 >> 2) * 128;
        bf16x8 b0 = *reinterpret_cast<const bf16x8*>(a);
        bf16x8 b1 = *reinterpret_cast<const bf16x8*>(a + 32 * 256);
        p0 = __builtin_amdgcn_mfma_f32_32x32x16_bf16(b0, qr[d0], p0, 0, 0, 0);
        p1 = __builtin_amdgcn_mfma_f32_32x32x16_bf16(b1, qr[d0], p1, 0, 0, 0); }
}
template <int VB>
__device__ __forceinline__ void pv_tile(f32x16* o, int vb0, bf16x8 pa0, bf16x8 pa1, bf16x8 pa2, bf16x8 pa3) {
#define TRRD(dst, off) asm volatile("ds_read_b64_tr_b16 %0, %1 offset:%2" : "=&v"(dst) : "v"(vb0), "i"(off) : "memory")
#define PV_D0(d0) do { s16x4 l0, l1, l2, l3, h0, h1, h2, h3; constexpr int b_ = VB * SHM_V + v_rd_off(d0, 0, 0);   \
        TRRD(l0, b_); TRRD(h0, b_ + 2048); TRRD(l1, b_ + 4096); TRRD(h1, b_ + 6144); TRRD(l2, b_ + 8192); TRRD(h2, b_ + 10240); TRRD(l3, b_ + 12288); TRRD(h3, b_ + 14336); \
        asm volatile("s_waitcnt lgkmcnt(0)" ::: "memory"); SBAR();                                                    \
        o[d0] = __builtin_amdgcn_mfma_f32_32x32x16_bf16(pa0, (bf16x8){l0[0], l0[1], l0[2], l0[3], h0[0], h0[1], h0[2], h0[3]}, o[d0], 0, 0, 0);   \
        o[d0] = __builtin_amdgcn_mfma_f32_32x32x16_bf16(pa1, (bf16x8){l1[0], l1[1], l1[2], l1[3], h1[0], h1[1], h1[2], h1[3]}, o[d0], 0, 0, 0);   \
        o[d0] = __builtin_amdgcn_mfma_f32_32x32x16_bf16(pa2, (bf16x8){l2[0], l2[1], l2[2], l2[3], h2[0], h2[1], h2[2], h2[3]}, o[d0], 0, 0, 0);   \
        o[d0] = __builtin_amdgcn_mfma_f32_32x32x16_bf16(pa3, (bf16x8){l3[0], l3[1], l3[2], l3[3], h3[0], h3[1], h3[2], h3[3]}, o[d0], 0, 0, 0); } while (0)
    PV_D0(0); PV_D0(1); PV_D0(2); PV_D0(3);
#undef PV_D0
#undef TRRD
}

struct Bases { const bf16* Q; bf16* O; const bf16* K; const bf16* V; const float* CB; };
struct BlockRef { unsigned qo, oo, kvo, cbo; int P0, jlo; };
struct Seam { bf16x8 qr[8]; bf16x8 st_v0, st_v1, st_k0, st_k1; float st_b; };
#define ROW(p, k0, rr) ((p) + (unsigned)(((k0) + (rr)) * LD + sc))
#define VMW() asm volatile("s_waitcnt vmcnt(0)" ::: "memory")
#define VMWN(n) asm volatile("s_waitcnt vmcnt(%0)" :: "i"(n) : "memory")
#define SLOAD_H(Kp, Vp, CBp, k0) do { S.st_v0 = load8(ROW(Vp, k0, sr)); S.st_v1 = load8(ROW(Vp, k0, 32 + sr));              \
                         S.st_k0 = load8(ROW(Kp, k0, sr)); S.st_k1 = load8(ROW(Kp, k0, 32 + sr)); S.st_b = (CBp)[(unsigned)((k0) + lane)]; } while (0)
#define SWRITE_HK(bf, cref_) do { *(bf16x8*)(K_lds + (bf) * SHM_K + kws) = S.st_k0; *(bf16x8*)(K_lds + (bf) * SHM_K + kws + 32 * 256) = S.st_k1; \
                           if (wid == 0) *(float*)(B_lds + (bf) * 256 + lane * 4) = S.st_b; } while (0)
#define SWRITE_HV(bf) do { *(bf16x8*)(V_lds + (bf) * SHM_V + vst0) = S.st_v0; *(bf16x8*)(V_lds + (bf) * SHM_V + vst1) = S.st_v1; } while (0)
#define SWRITE_H(bf) do { SWRITE_HV(bf); SWRITE_HK(bf, cref); } while (0)
__device__ __forceinline__ void prime(const Bases& G, const BlockRef& cur, char* lds, Seam& S) {
    const int tid = threadIdx.x, wid = __builtin_amdgcn_readfirstlane(tid >> 6), lane = tid & 63, r32 = lane & 31, hi = lane >> 5;
    const int sr = tid >> 4, sc = (tid & 15) * 8, kws = KSWZ(sr, sc * 2); char* K_lds = lds + 2 * SHM_V; char* B_lds = lds + OFF_BIAS;
    for (int d0 = 0; d0 < 8; ++d0) S.qr[d0] = load8(G.Q + (cur.qo + (unsigned)((wid * QBLK + r32) * LD + d0 * 16 + hi * 8)));
    const float cref = 0.f; (void)cref;
    SLOAD_H(G.K + cur.kvo, G.V + cur.kvo, G.CB + cur.cbo, cur.jlo * KVBLK); VMW(); SWRITE_HK(0, cref);
    __syncthreads();
}
__device__ __forceinline__ void block(const Bases& G, const BlockRef& cur, const BlockRef& nxt, char* lds, Seam& S) {
    const int tid = threadIdx.x, wid = __builtin_amdgcn_readfirstlane(tid >> 6), lane = tid & 63, r32 = lane & 31, hi = lane >> 5;
    const int j_lo = cur.jlo, NT = (cur.P0 + QB - 1) / KVBLK + 1 - j_lo;
    const int qlo = cur.P0 + wid * QBLK, qm = qlo + r32 - 4 * hi;
    char* V_lds = lds; char* K_lds = lds + 2 * SHM_V; char* B_lds = lds + OFF_BIAS;
    float* ws = (float*)(lds + OFF_WS) + wid * 64; float* li_l = ws, * al_l = ws + 32;
    float m_reg = G.CB[cur.cbo + (unsigned)(cur.P0 + wid * QBLK + r32)], l_reg = 0; f32x16 o[4] = {};
    const int sr = tid >> 4, sc = (tid & 15) * 8, vst0 = v_st(sr, sc), vst1 = v_st(32 + sr, sc), kws = KSWZ(sr, sc * 2);
    const int vb0 = (int)(uintptr_t)V_lds + v_rd_base(lane);
    const bf16* Kh = G.K + cur.kvo; const bf16* Vh = G.V + cur.kvo; const float* CBh = G.CB + cur.cbo;
    const float cref = 0.f, crefn = 0.f; (void)cref; (void)crefn;
#define RESC(a) do { if (__any((a) < 1.f)) { if (hi == 0) al_l[r32] = (a); asm volatile("s_waitcnt lgkmcnt(0)" ::: "memory");              \
                     for (int d_ = 0; d_ < 4; ++d_) for (int r = 0; r < 16; ++r) o[d_][r] *= al_l[crow(r, hi)]; } } while (0)
#define KBASE(t) ((j_lo + (t)) * KVBLK)
#define MASKT(P0_, P1_, t) do { const int kb_ = KBASE(t); if (kb_ + KVBLK - 1 > qlo) mask_tile(P0_, P1_, qm - kb_); } while (0)
    constexpr int NQL = 8;
#define SEAM_K0() do { VMWN(NQL); SWRITE_HK(0, crefn); SBAR(); } while (0)
    f32x16 pA0, pA1, pB0, pB1; float mnA, mnB, alA, alB; bf16x8 pa0, pa1, pa2, pa3;
    SWRITE_HV(0); SBAR();
    if (NT > 1) { SLOAD_H(Kh, Vh, CBh, KBASE(1)); }
    SBAR(); qkt<0>(pA0, pA1, K_lds, B_lds, r32, hi, S.qr);
    MASKT(pA0, pA1, 0); partialSM(pA0, pA1, m_reg, mnA, alA);
    if (NT > 1) { VMW(); SWRITE_H(1); }
    __syncthreads();
#define HALF_STEP(PX0, PX1, mnX, alX, PY0, PY1, alY, t, KB, VB, SB) do {                                                      \
        SBAR(); qkt<KB>(PX0, PX1, K_lds, B_lds, r32, hi, S.qr);                                                                \
        finishSM(PY0, PY1, alY, l_reg, pa0, pa1, pa2, pa3); SBAR();                                                           \
        if ((t) + 1 < NT) { SLOAD_H(Kh, Vh, CBh, KBASE((t) + 1)); SBAR(); }                                              \
        pv_tile<VB>(o, vb0, pa0, pa1, pa2, pa3); MASKT(PX0, PX1, (t)); partialSM(PX0, PX1, m_reg, mnX, alX);                   \
        __syncthreads();                                                                                                      \
        if ((t) + 1 < NT) { VMW(); SWRITE_H(SB); }                                                                            \
        RESC(alX); __syncthreads(); } while (0)
    for (int t = 1; t + 1 < NT; t += 2) {
        HALF_STEP(pB0, pB1, mnB, alB, pA0, pA1, alA, t, 1, 0, 0);
        HALF_STEP(pA0, pA1, mnA, alA, pB0, pB1, alB, t + 1, 0, 1, 1);
    }
    constexpr bool even = true;
    if (even) { SBAR(); qkt<1>(pB0, pB1, K_lds, B_lds, r32, hi, S.qr); SBAR(); }
    { SLOAD_H(G.K + nxt.kvo, G.V + nxt.kvo, G.CB + nxt.cbo, nxt.jlo * KVBLK); SBAR();
#pragma unroll
      for (int d0 = 0; d0 < 8; ++d0) S.qr[d0] = load8(G.Q + (nxt.qo + (unsigned)((wid * QBLK + r32) * LD + d0 * 16 + hi * 8))); }
    SBAR();
    finishSM(pA0, pA1, alA, l_reg, pa0, pa1, pa2, pa3); SBAR();
    pv_tile<0>(o, vb0, pa0, pa1, pa2, pa3);
    if (even) { MASKT(pB0, pB1, NT - 1); partialSM(pB0, pB1, m_reg, mnB, alB); __syncthreads(); RESC(alB);
        finishSM(pB0, pB1, alB, l_reg, pa0, pa1, pa2, pa3); SBAR(); pv_tile<1>(o, vb0, pa0, pa1, pa2, pa3); }
    SBAR(); SEAM_K0();
    if (hi == 0) li_l[r32] = l_reg; asm volatile("s_waitcnt lgkmcnt(0)" ::: "memory");
    float rli[16];
#pragma unroll
    for (int r = 0; r < 16; ++r) rli[r] = __builtin_amdgcn_rcpf(li_l[crow(r, hi)]);
    bf16* Ow = G.O + (cur.oo + (unsigned)(wid * QBLK * LDO));
#pragma unroll
    for (int r = 0; r < 16; ++r) { const int orow = crow(r, hi);
#pragma unroll
        for (int d0 = 0; d0 < 4; ++d0) { const float v = o[d0][r] * rli[r];
            const float vn = __shfl_xor(v, 1);
            if ((r32 & 1) == 0) *(unsigned*)(Ow + (unsigned)(orow * LDO + d0 * 32 + r32)) = cvtpk(v, vn); } }
    __syncthreads();
#undef RESC
#undef KBASE
#undef MASKT
#undef SEAM_K0
#undef HALF_STEP
}
#undef ROW
#undef VMW
#undef VMWN
#undef SLOAD_H
#undef SWRITE_HK
#undef SWRITE_HV
#undef SWRITE_H
#undef KSWZ
#undef SBAR
}
constexpr int NB = 8, SEQ = 4096, T = NB * SEQ, DM = 1024, NH = 8, HD = 128, INW = 7176, NZ = 7168;
constexpr int NE = 32, DE = 512;
constexpr float EPS = 1e-6f;
constexpr int PMAX = 73728;
constexpr int NWAVES = 8;
constexpr size_t MiB = 1u << 20;
constexpr size_t WS_CTL = 0, CTL_ZERO_BYTES = 1 * MiB;
constexpr size_t WS_RS1 = 1 * MiB, WS_RS2 = 1 * MiB + 256 * 1024;
constexpr size_t WS_LF = 1 * MiB + 512 * 1024;
constexpr size_t WS_CB = 2 * MiB + 512 * 1024;
constexpr size_t WS_TOK = 3 * MiB + 512 * 1024;
constexpr size_t WS_LISTS = 5 * MiB;
constexpr size_t WS_WRT = 9 * MiB;
constexpr size_t WS_SRS = 9 * MiB + 512 * 1024, WS_SW = 10 * MiB;
constexpr size_t WS_WIN = 16 * MiB;
constexpr size_t WS_WA = 30 * MiB, WS_WL = 32 * MiB, WS_WO = 34 * MiB;
constexpr size_t WS_WRG = 36 * MiB;
constexpr size_t WS_XB = 40 * MiB;
constexpr size_t WS_XR = 104 * MiB;
constexpr size_t WS_GG = 168 * MiB;
constexpr size_t WS_Q = 232 * MiB, WS_K = 296 * MiB, WS_V = 360 * MiB;
constexpr size_t WS_W13 = 424 * MiB;
constexpr size_t WS_W2 = 392 * MiB;
constexpr size_t WS_XG = 168 * MiB;
constexpr size_t WS_HB = 296 * MiB;
constexpr size_t WS_END = 512 * MiB;
static_assert(WS_XG + (size_t)PMAX * 1024 <= WS_K && WS_HB + (size_t)PMAX * 1024 <= WS_W2 && WS_W2 + 32u * 1024 * 512 * 2 <= WS_W13 && WS_W13 + 64 * MiB <= WS_END, "d_ws map");
constexpr int CW_TMO = 0, CW_CODE = 1, CW_BAR = 4096, CW_CNT = 8192, CW_NORM = 8448, CW_QCTR = 12288;
constexpr int RING_OFF = 0, RING_BYTES = 131072;
constexpr int LDSCTL_OFF = RING_BYTES, MISC_OFF = LDSCTL_OFF + 320;
constexpr int TBL_OFF = RING_BYTES + 1024;
constexpr int TBL_PS = TBL_OFF, TBL_CN = TBL_OFF + 256, TBL_TE = TBL_OFF + 512;
constexpr int RG_TOT = RING_BYTES + 4096, RG_CAR = RG_TOT + 4096;
constexpr int LDS_BYTES = 147456;

#include <cmath>
using pg8::bf_lo; using pg8::bf_hi; using pg8::sigmoid_f;

struct Frame {
    LAS unsigned char* lds;
    int tid, lane, wave, vcu, G;
};
__device__ __forceinline__ float wave_sum(float v) {
#pragma unroll
    for (int o = 1; o < 64; o <<= 1) v += __shfl_xor(v, o);
    return v;
}
__device__ __forceinline__ void transpose_tile(const float* src, int ld, bf16* dst, int ldd, const float* kscale, LAS float* scr, int lane) {
    const int q = lane & 7, kr = lane >> 3;
    f32x4 v[8];
#pragma unroll
    for (int i = 0; i < 8; ++i) v[i] = *(const f32x4*)(src + (size_t)(kr + 8 * i) * ld + 4 * q);
#pragma unroll
    for (int i = 0; i < 8; ++i) { const int kk = kr + 8 * i; const float sc = kscale ? kscale[kk] : 1.0f;
#pragma unroll
        for (int c = 0; c < 4; ++c) scr[kk * 33 + 4 * q + c] = v[i][c] * sc; }
    LDS_WAIT(); asm volatile("" ::: "memory");
    const int c = lane & 7;
#pragma unroll
    for (int j = 0; j < 4; ++j) { const int n = (lane >> 3) + 8 * j; const LAS float* s = scr + (8 * c) * 33 + n;
        v4u o; o.x = pk2(s[0 * 33], s[1 * 33]); o.y = pk2(s[2 * 33], s[3 * 33]); o.z = pk2(s[4 * 33], s[5 * 33]); o.w = pk2(s[6 * 33], s[7 * 33]);
        *(GAS v4u*)(dst + (size_t)n * ldd + 8 * c) = o; }
    LDS_WAIT(); asm volatile("" ::: "memory");
}

__device__ __forceinline__ void transpose_tile8(const float* src, int ld, unsigned char* dst, int ldd, const float* kscale, float scale, LAS float* scr, int lane) {
    const int q = lane & 7, kr = lane >> 3;
    f32x4 v[8];
#pragma unroll
    for (int i = 0; i < 8; ++i) v[i] = *(const f32x4*)(src + (size_t)(kr + 8 * i) * ld + 4 * q);
#pragma unroll
    for (int i = 0; i < 8; ++i) { const int kk = kr + 8 * i; const float sc = kscale ? kscale[kk] * scale : scale;
#pragma unroll
        for (int c = 0; c < 4; ++c) scr[kk * 33 + 4 * q + c] = v[i][c] * sc; }
    LDS_WAIT(); asm volatile("" ::: "memory");
    const int c = lane & 3;
#pragma unroll
    for (int j = 0; j < 2; ++j) { const int n = (lane >> 2) + 16 * j; const LAS float* s = scr + (16 * c) * 33 + n;
        v4u o; o.x = pg8::pack4_fp8(s[0 * 33], s[1 * 33], s[2 * 33], s[3 * 33]); o.y = pg8::pack4_fp8(s[4 * 33], s[5 * 33], s[6 * 33], s[7 * 33]);
        o.z = pg8::pack4_fp8(s[8 * 33], s[9 * 33], s[10 * 33], s[11 * 33]); o.w = pg8::pack4_fp8(s[12 * 33], s[13 * 33], s[14 * 33], s[15 * 33]);
        *(GAS v4u*)(dst + (size_t)n * ldd + 16 * c) = o; }
    LDS_WAIT(); asm volatile("" ::: "memory");
}

struct P0Args { const float *x, *g_mix, *w_in, *w_rg_a, *w_rg_x, *b_forget, *w_lru_out, *w_attn_out, *w_out, *g_ffn, *w_rgrp, *w_rexp, *w_gate, *w_up;
                bf16 *Win, *Wl, *Wa, *Wo, *Wrg, *XB; unsigned char* W13; float *RS1, *LF, *WRT; };
struct TItem { const float* src; int ld; unsigned char* dst; int ldd; const float* ks; float scale; int f8; };
__device__ __forceinline__ void titem_load(const TItem& t, f32x4 (&v)[8], float (&sc)[8], int lane) {
    const int q = lane & 7, kr = lane >> 3;
#pragma unroll
    for (int i = 0; i < 8; ++i) { v[i] = *(const f32x4*)(t.src + (size_t)(kr + 8 * i) * t.ld + 4 * q); sc[i] = t.ks ? t.ks[kr + 8 * i] * t.scale : t.scale; }
}
__device__ __forceinline__ void titem_finish(const TItem& t, const f32x4 (&v)[8], const float (&sc)[8], LAS float* scr, int lane) {
    const int q = lane & 7, kr = lane >> 3;
#pragma unroll
    for (int i = 0; i < 8; ++i) { const int kk = kr + 8 * i;
#pragma unroll
        for (int c = 0; c < 4; ++c) scr[kk * 33 + 4 * q + c] = v[i][c] * sc[i]; }
    LDS_WAIT(); asm volatile("" ::: "memory");
    if (t.f8) { const int c = lane & 3;
#pragma unroll
        for (int j = 0; j < 2; ++j) { const int n = (lane >> 2) + 16 * j; const LAS float* s = scr + (16 * c) * 33 + n;
            v4u o; o.x = pg8::pack4_fp8(s[0 * 33], s[1 * 33], s[2 * 33], s[3 * 33]); o.y = pg8::pack4_fp8(s[4 * 33], s[5 * 33], s[6 * 33], s[7 * 33]);
            o.z = pg8::pack4_fp8(s[8 * 33], s[9 * 33], s[10 * 33], s[11 * 33]); o.w = pg8::pack4_fp8(s[12 * 33], s[13 * 33], s[14 * 33], s[15 * 33]);
            *(GAS v4u*)(t.dst + (size_t)n * t.ldd + 16 * c) = o; } }
    else { const int c = lane & 7;
#pragma unroll
        for (int j = 0; j < 4; ++j) { const int n = (lane >> 3) + 8 * j; const LAS float* s = scr + (8 * c) * 33 + n;
            v4u o; o.x = pk2(s[0 * 33], s[1 * 33]); o.y = pk2(s[2 * 33], s[3 * 33]); o.z = pk2(s[4 * 33], s[5 * 33]); o.w = pk2(s[6 * 33], s[7 * 33]);
            *(GAS v4u*)(t.dst + ((size_t)n * t.ldd + 8 * c) * 2) = o; } }
    LDS_WAIT(); asm volatile("" ::: "memory");
}
constexpr int P0_I_IN = 16 * 224, P0_I_SQ = 16 * 32, P0_I_RG = 2 * 4 * 4 * 8, P0_I_EX = 2 * 8192, P0_NITEMS = P0_I_IN + 3 * P0_I_SQ + P0_I_RG + P0_I_EX;
__device__ __forceinline__ void p0_items(const Frame& F, const P0Args& a, const int first, const int last, const int stride, const int offset) {
    LAS float* scr = (LAS float*)(F.lds + RING_OFF + F.wave * 16384);
    const float* const p_wl = a.w_lru_out; const float* const p_wa = a.w_attn_out; const float* const p_wo = a.w_out; const float* const p_rga = a.w_rg_a; const float* const p_rgx = a.w_rg_x;
    bf16* const q_wl = a.Wl; bf16* const q_wa = a.Wa; bf16* const q_wo = a.Wo;
    constexpr int I_IN = P0_I_IN, I_SQ = P0_I_SQ, I_EX = P0_I_EX, NITEMS = P0_NITEMS;
    const float* const p_gate = a.w_gate; const float* const p_up = a.w_up; const float* const p_win = a.w_in; const float* const p_gmix = a.g_mix; const float* const p_gffn = a.g_ffn;
    bf16* const q_win = a.Win; bf16* const q_wrg = a.Wrg; unsigned char* const q_w13 = a.W13;
#define P0_DECODE(it_, t_) do { int r = (it_); \
        if (r >= NITEMS - I_EX) { r -= NITEMS - I_EX;     \
            const int w = r >> 13, e = (r >> 8) & 31, kb = (r >> 4) & 15, nb = r & 15; const float* W = (w == 0 ? p_gate : p_up) + (size_t)e * DM * DE; \
            const int drow = e * 1024 + (nb >> 2) * 256 + (nb & 3) * 32 + (w == 1 ? 128 : 0); \
            t_.src = W + (size_t)(64 * kb) * DE + 32 * nb; t_.ld = DE; t_.dst = q_w13 + (size_t)drow * DM + 64 * kb; t_.ldd = DM; t_.ks = p_gffn + 64 * kb; t_.scale = pg8::W13_SCALE; t_.f8 = 1; } \
        else if (r < I_IN) { const int kb = r / 224, nb = r % 224, n0 = 32 * nb, sc_ = n0 < 5120 ? n0 : n0 + 8; \
            t_.src = p_win + (size_t)(64 * kb) * INW + sc_; t_.ld = INW; t_.dst = (unsigned char*)(q_win + (size_t)n0 * DM + 64 * kb); t_.ldd = DM; t_.ks = p_gmix + 64 * kb; t_.scale = 1.0f; t_.f8 = 0; } \
        else if (r < I_IN + 3 * I_SQ) { r -= I_IN; const int w = r / I_SQ, q = r % I_SQ, kb = q / 32, nb = q % 32; const float* W = w == 0 ? p_wl : (w == 1 ? p_wa : p_wo); bf16* Wt = w == 0 ? q_wl : (w == 1 ? q_wa : q_wo); \
            t_.src = W + (size_t)(64 * kb) * DM + 32 * nb; t_.ld = DM; t_.dst = (unsigned char*)(Wt + (size_t)(32 * nb) * DM + 64 * kb); t_.ldd = DM; t_.ks = nullptr; t_.scale = 1.0f; t_.f8 = 0; } \
        else { r -= I_IN + 3 * I_SQ; const int gb = r / 32, q = r % 32, kb = q / 8, nb = q % 8; const float* W = (gb < 4 ? p_rga : p_rgx) + (size_t)(gb & 3) * 65536; \
            t_.src = W + (size_t)(64 * kb) * 256 + 32 * nb; t_.ld = 256; t_.dst = (unsigned char*)(q_wrg + (size_t)gb * 65536 + (size_t)(32 * nb) * 256 + 64 * kb); t_.ldd = 256; t_.ks = nullptr; t_.scale = -1.4426950408889634f; t_.f8 = 0; }     } while (0)
    {
        int it = first + offset; TItem cur; f32x4 va[8]; float sa[8];
        if (it < last) { P0_DECODE(it, cur); titem_load(cur, va, sa, F.lane); }
        while (it < last) {
            const int nx = it + stride; TItem nt = cur; f32x4 vb[8]; float sb[8];
            if (nx < last) { P0_DECODE(nx, nt); titem_load(nt, vb, sb, F.lane); }
            titem_finish(cur, va, sa, scr, F.lane);
            if (nx < last) { cur = nt;
#pragma unroll
                for (int i = 0; i < 8; ++i) { va[i] = vb[i]; sa[i] = sb[i]; } }
            it = nx;
        }
    }
#undef P0_DECODE
}
__device__ __forceinline__ void p0_prologue(const Frame& F, const P0Args& a, const int part  ) {
    const int gw = F.vcu * NWAVES + F.wave, NGW = F.G * NWAVES;
    if (part != 2) p0_items(F, a, 0, P0_NITEMS, NGW, gw);
    if (part == 1) return;
    for (int i = (F.vcu * NWAVES + F.wave) * 64 + F.lane; i < 64 * DM; i += NGW * 64) { const int n = i >> 10, k = i & 1023;
        float v = 0.f; if (n < 32) v = a.w_rexp[k * 32 + n]; else if (n < 36) v = a.w_rgrp[k * 4 + (n - 32)];
        a.WRT[i] = v * a.g_ffn[k]; }
    LAS float* wfl = (LAS float*)(F.lds + RING_OFF);
    __syncthreads();
    for (int k = F.tid; k < DM; k += NWAVES * 64) { const float g = a.g_mix[k];
        const f32x4 w0 = *(const f32x4*)(a.w_in + (size_t)k * INW + 5120), w1 = *(const f32x4*)(a.w_in + (size_t)k * INW + 5124);
        *(LAS f32x4*)(wfl + k * 8) = w0 * g; *(LAS f32x4*)(wfl + k * 8 + 4) = w1 * g; }
    __syncthreads();
    float wf[4][4][8];
#pragma unroll
    for (int j = 0; j < 4; ++j)
#pragma unroll
        for (int i = 0; i < 4; ++i) { const int k = 256 * j + 4 * F.lane + i; const f32x4 w0 = *(const LAS f32x4*)(wfl + k * 8), w1 = *(const LAS f32x4*)(wfl + k * 8 + 4);
#pragma unroll
            for (int h = 0; h < 4; ++h) { wf[j][i][h] = w0[h]; wf[j][i][4 + h] = w1[h]; } }
    const float bfg = a.b_forget[F.lane & 7];
    f32x4 vn[4];
    if (gw < T) { const GAS f32x4* xr0 = (const GAS f32x4*)(a.x + (size_t)gw * DM) + F.lane;
#pragma unroll
        for (int j = 0; j < 4; ++j) vn[j] = xr0[64 * j]; }
    for (int m = gw; m < T; m += NGW) {
        f32x4 v[4]; float s = 0.f, d[8] = {0.f, 0.f, 0.f, 0.f, 0.f, 0.f, 0.f, 0.f};
#pragma unroll
        for (int j = 0; j < 4; ++j) v[j] = vn[j];
        if (m + NGW < T) { const GAS f32x4* xr1 = (const GAS f32x4*)(a.x + (size_t)(m + NGW) * DM) + F.lane;
#pragma unroll
            for (int j = 0; j < 4; ++j) vn[j] = xr1[64 * j]; }
#pragma unroll
        for (int j = 0; j < 4; ++j) { s += (v[j].x * v[j].x + v[j].y * v[j].y) + (v[j].z * v[j].z + v[j].w * v[j].w);
#pragma unroll
            for (int i = 0; i < 4; ++i)
#pragma unroll
                for (int h = 0; h < 8; ++h) d[h] = fmaf(v[j][i], wf[j][i][h], d[h]); }
        s = wave_sum(s);
#pragma unroll
        for (int h = 0; h < 8; ++h) d[h] = wave_sum(d[h]);
        const float rs = 1.0f / sqrtf(s * (1.0f / DM) + EPS);
        GAS unsigned long long* o8 = (GAS unsigned long long*)(a.XB + (size_t)m * DM) + F.lane;
#pragma unroll
        for (int j = 0; j < 4; ++j) o8[64 * j] = (unsigned long long)pk2(v[j].x * rs, v[j].y * rs) | ((unsigned long long)pk2(v[j].z * rs, v[j].w * rs) << 32);
        if (F.lane < 8) { const int h = F.lane; float dh = d[0]; dh = h == 1 ? d[1] : dh; dh = h == 2 ? d[2] : dh; dh = h == 3 ? d[3] : dh; dh = h == 4 ? d[4] : dh; dh = h == 5 ? d[5] : dh; dh = h == 6 ? d[6] : dh; dh = h == 7 ? d[7] : dh;
            const float fl = dh * rs + bfg; a.LF[(size_t)m * 8 + h] = fminf(fl, 0.f) - log1pf(expf(-fabsf(fl))); }
    }
}
__device__ __forceinline__ void cumsum_bias(const Frame& F, const float* LF, float* CB) {
    LAS float* wt = (LAS float*)(F.lds + RING_OFF);
    for (int bh = blockIdx.x; bh < NB * NH; bh += F.G) {
        const int b = bh >> 3, h = bh & 7, s0 = F.tid * 8;
        float v[8], run = 0.f;
#pragma unroll
        for (int j = 0; j < 8; ++j) { run += LF[((size_t)(b * SEQ + s0 + j)) * 8 + h]; v[j] = run; }
        float inc = run;
#pragma unroll
        for (int o = 1; o < 64; o <<= 1) { const float t = __shfl_up(inc, o); if (F.lane >= o) inc += t; }
        if (F.lane == 63) wt[F.wave] = inc;
        __syncthreads();
        float pre = inc - run;
        for (int w = 0; w < F.wave; ++w) pre += wt[w];
#pragma unroll
        for (int j = 0; j < 8; ++j) CB[(size_t)bh * SEQ + s0 + j] = -(pre + v[j]) * 11.313708498984761f;
        __syncthreads();
    }
}
struct RgArgs { const bf16* XC; const bf16* GG; bf16* GO; const bf16* Wrg; const float *b_a, *b_x, *lam; };
__device__ __forceinline__ float bfx(const v4u& v, int i) { const unsigned w = i < 2 ? v.x : (i < 4 ? v.y : (i < 6 ? v.z : v.w)); return (i & 1) ? bf_hi(w) : bf_lo(w); }
__device__ __forceinline__ unsigned cvtpk_bf16(float lo, float hi) { unsigned r; asm volatile("v_cvt_pk_bf16_f32 %0, %1, %2" : "=v"(r) : "v"(lo), "v"(hi)); return r; }
__device__ __forceinline__ void conv_prepass(const Frame& F, const bf16* XR, bf16* XC, const float* conv_w, const float* conv_b) {
    const int gw = F.vcu * NWAVES + F.wave, NGW = F.G * NWAVES;
    for (int it = gw; it < (T / 16) * 2; it += NGW) {
        const int r0 = (it >> 1) * 16, c0 = (it & 1) * 512 + 8 * F.lane, tq = r0 & (SEQ - 1);
        float cw[4][8], cbv[8];
#pragma unroll
        for (int j = 0; j < 4; ++j) { const f32x4 w0 = *(const f32x4*)(conv_w + j * DM + c0), w1 = *(const f32x4*)(conv_w + j * DM + c0 + 4);
#pragma unroll
            for (int i = 0; i < 4; ++i) { cw[j][i] = w0[i]; cw[j][4 + i] = w1[i]; } }
        { const f32x4 w0 = *(const f32x4*)(conv_b + c0), w1 = *(const f32x4*)(conv_b + c0 + 4);
#pragma unroll
          for (int i = 0; i < 4; ++i) { cbv[i] = w0[i]; cbv[4 + i] = w1[i]; } }
        v4u raw[19];
#pragma unroll
        for (int i = 0; i < 19; ++i) { const int rr = (i < 3 && tq == 0) ? r0 : r0 - 3 + i; const v4u w = *(const GAS v4u*)(XR + ((unsigned)rr * DM + c0));
            const bool z = i < 3 && tq == 0; raw[i].x = z ? 0u : w.x; raw[i].y = z ? 0u : w.y; raw[i].z = z ? 0u : w.z; raw[i].w = z ? 0u : w.w; }
#pragma unroll
        for (int r = 0; r < 16; ++r) { float y[8];
#pragma unroll
            for (int i = 0; i < 8; ++i) { float sacc = cbv[i];
#pragma unroll
                for (int j = 0; j < 4; ++j) sacc = fmaf(cw[j][i], bfx(raw[r + j], i), sacc);
                y[i] = sacc; }
            v4u o; o.x = cvtpk_bf16(y[0], y[1]); o.y = cvtpk_bf16(y[2], y[3]); o.z = cvtpk_bf16(y[4], y[5]); o.w = cvtpk_bf16(y[6], y[7]);
            *(GAS v4u*)(XC + ((unsigned)(r0 + r) * DM + c0)) = o; }
    }
}
__device__ __forceinline__ void rglru_unit(const Frame& F, const RgArgs& a, int unit) {
    const int tid = F.tid, lane = F.lane, wid = F.wave, fr = lane & 15, fq = lane >> 4, rq = wid >> 1, cp = wid & 1;
    const int b = unit >> 5, n = (unit >> 3) & 3, g = unit & 7, cbase = 256 * n, cown = cbase + 32 * g;
    LAS unsigned char* A_l = F.lds + RING_OFF;
    LAS float* tot = (LAS float*)(F.lds + RG_TOT);
    bf16x8 bfr[2][8];
#pragma unroll
    for (int gt = 0; gt < 2; ++gt)
#pragma unroll
        for (int ks = 0; ks < 8; ++ks) bfr[gt][ks] = *(const GAS bf16x8*)(a.Wrg + ((size_t)((gt * 4 + n) * 256 + 32 * g + 16 * cp + fr)) * 256 + 32 * ks + 8 * fq);
    const int cl = 16 * cp + fr, cch = cown + cl;
    const float ba = -1.4426950408889634f * a.b_a[cch], bx = -1.4426950408889634f * a.b_x[cch], sp8 = 8.0f * log1pf(expf(-a.lam[cch])) * 1.4426950408889634f;
    const unsigned goff = (unsigned)(b * SEQ + 32 * rq + 4 * fq) * DM + cch;
    const __amdgpu_buffer_rsrc_t GGr = __builtin_amdgcn_make_buffer_rsrc((void*)a.GG, 0, (int)((size_t)T * DM * 2), 0x00020000);
    const __amdgpu_buffer_rsrc_t GOr = __builtin_amdgcn_make_buffer_rsrc((void*)a.GO, 0, (int)((size_t)T * DM * 2), 0x00020000);
    const int gvo = (int)(goff * 2u);
    const unsigned dbase = ((unsigned)(b * SEQ + 16 * wid + (lane >> 5)) * DM + cbase) * 2u;
    const char* const XCb = (const char*)a.XC;
#define RG_DMA(ci_, buf_) do { _Pragma("unroll") for (int i_ = 0; i_ < 8; ++i_) { const unsigned so_ = dbase + (unsigned)(2 * i_) * (DM * 2u) + ((((unsigned)lane & 31u) ^ (unsigned)((2 * i_ + (lane >> 5)) & 15)) << 4); \
        __builtin_amdgcn_global_load_lds((const unsigned*)(XCb + so_ + (unsigned)(ci_) * (128u * DM * 2u)), (LAS unsigned*)(A_l + (buf_) * 65536 + (8 * wid + i_) * 1024), 16, 0, 0); } } while (0)
    float hc = 0.f;
    const int kx = 32 * g + cl;
#pragma unroll
    for (int gt = 0; gt < 2; ++gt)
#pragma unroll
        for (int ks = 0; ks < 8; ++ks) asm volatile("" : "+v"(bfr[gt][ks]));
    RG_DMA(0, 0); asm volatile("s_waitcnt vmcnt(0)" ::: "memory");
#define RG_CHUNK(BUF_, ci_) do { const int ci = (ci_); const int t0 = 128 * ci; LAS unsigned char* const Ab = A_l + (BUF_) * 65536; \
        __builtin_amdgcn_s_barrier(); asm volatile("" ::: "memory"); \
        unsigned short ggv[2][4]; \
        _Pragma("unroll") \
        for (int mt = 0; mt < 2; ++mt) \
        _Pragma("unroll") \
            for (int j = 0; j < 4; ++j) ggv[mt][j] = __builtin_amdgcn_raw_buffer_load_b16(GGr, gvo, (t0 + 16 * mt + j) * (DM * 2), 0); \
        if (ci + 1 < SEQ / 128) RG_DMA(ci + 1, BUF_ ^ 1); \
 \
        f32x4 acc[2][2]; \
        _Pragma("unroll") \
        for (int mt = 0; mt < 2; ++mt) { acc[mt][0] = (f32x4){ba, ba, ba, ba}; acc[mt][1] = (f32x4){bx, bx, bx, bx}; } \
        _Pragma("unroll") \
        for (int ks = 0; ks < 8; ++ks) { const int ch = 4 * ks + fq; \
        _Pragma("unroll") \
            for (int mt = 0; mt < 2; ++mt) { const int arow = 32 * rq + 16 * mt + fr; \
                const bf16x8 af = *(const LAS bf16x8*)(Ab + arow * 512 + ((ch ^ (arow & 15)) << 4)); \
                acc[mt][0] = __builtin_amdgcn_mfma_f32_16x16x32_bf16(af, bfr[0][ks], acc[mt][0], 0, 0, 0); \
                acc[mt][1] = __builtin_amdgcn_mfma_f32_16x16x32_bf16(af, bfr[1][ks], acc[mt][1], 0, 0, 0); } } \
 \
        float av[2][4], bv[2][4], sA[2], sB[2]; \
        _Pragma("unroll") \
        for (int mt = 0; mt < 2; ++mt) { float A = 1.f, Bv = 0.f; \
        _Pragma("unroll") \
            for (int j = 0; j < 4; ++j) { const int row = 32 * rq + 16 * mt + 4 * fq + j; \
                const unsigned short xb16 = *(const LAS unsigned short*)(Ab + row * 512 + ((((kx >> 3) ^ (row & 15))) << 4) + (kx & 7) * 2); \
                const float xc = __builtin_bit_cast(float, (unsigned)xb16 << 16); \
                const float r_ = __builtin_amdgcn_rcpf(1.0f + __builtin_amdgcn_exp2f(acc[mt][0][j])), i_ = __builtin_amdgcn_rcpf(1.0f + __builtin_amdgcn_exp2f(acc[mt][1][j])); \
                const float aa = __builtin_amdgcn_exp2f(-sp8 * r_); \
                const float mult = __builtin_amdgcn_sqrtf(fmaxf(fmaf(-aa, aa, 1.0f), 0.f)); \
                av[mt][j] = aa; bv[mt][j] = mult * i_ * xc; \
                Bv = fmaf(aa, Bv, bv[mt][j]); A *= aa; } \
            sA[mt] = A; sB[mt] = Bv; } \
 \
        float eA[2], eB[2], tA[2], tB[2]; \
        _Pragma("unroll") \
        for (int mt = 0; mt < 2; ++mt) { float A = sA[mt], Bv = sB[mt]; \
            { const float pA = __shfl_up(A, 16), pB = __shfl_up(Bv, 16); if (fq >= 1) { Bv = fmaf(A, pB, Bv); A *= pA; } } \
            { const float pA = __shfl_up(A, 32), pB = __shfl_up(Bv, 32); if (fq >= 2) { Bv = fmaf(A, pB, Bv); A *= pA; } } \
            const float xA = __shfl_up(A, 16), xB = __shfl_up(Bv, 16); eA[mt] = fq >= 1 ? xA : 1.f; eB[mt] = fq >= 1 ? xB : 0.f; \
            tA[mt] = __shfl(A, 48 + fr); tB[mt] = __shfl(Bv, 48 + fr); } \
        const float wA = tA[0] * tA[1], wB = fmaf(tA[1], tB[0], tB[1]); \
        if (fq == 0) { tot[(rq * 32 + cl) * 2] = wA; tot[(rq * 32 + cl) * 2 + 1] = wB; } \
        asm volatile("s_waitcnt lgkmcnt(0)" ::: "memory"); __builtin_amdgcn_s_barrier(); asm volatile("" ::: "memory"); \
        float hin = hc, hnew = hc; \
        _Pragma("unroll") \
        for (int q = 0; q < 4; ++q) { const float qA = tot[(q * 32 + cl) * 2], qB = tot[(q * 32 + cl) * 2 + 1]; hnew = fmaf(qA, hnew, qB); if (q < rq) hin = hnew; } \
        hc = hnew; \
        _Pragma("unroll") \
        for (int mt = 0; mt < 2; ++mt) { float h = mt == 0 ? hin : fmaf(tA[0], hin, tB[0]); \
            h = fmaf(eA[mt], h, eB[mt]); \
        _Pragma("unroll") \
            for (int j = 0; j < 4; ++j) { h = fmaf(av[mt][j], h, bv[mt][j]); \
                const float gv = __builtin_bit_cast(float, (unsigned)ggv[mt][j] << 16); \
                __builtin_amdgcn_raw_buffer_store_b16((unsigned short)cvtpk_bf16(h * gv, 0.f), GOr, gvo, (t0 + 16 * mt + j) * (DM * 2), 0); } } \
        asm volatile("s_waitcnt lgkmcnt(0)" ::: "memory"); \
        asm volatile("s_waitcnt vmcnt(8)" ::: "memory"); \
    } while (0)
    for (int cc = 0; cc < SEQ / 128; cc += 2) { RG_CHUNK(0, cc); RG_CHUNK(1, cc + 1); }
#undef RG_CHUNK
#undef RG_DMA
    asm volatile("s_waitcnt vmcnt(0) lgkmcnt(0)" ::: "memory"); __builtin_amdgcn_s_barrier(); asm volatile("" ::: "memory");
}
__device__ __forceinline__ int attn_jlo(const Frame& F, const float* CB, const unsigned* NORM, int bh, int qb) {
    float qs = 0.f, ks = 0.f;
#pragma unroll
    for (int w = 0; w < 4; ++w) { qs += __uint_as_float(NORM[(bh) * 4 + w]); ks += __uint_as_float(NORM[(64 + bh) * 4 + w]); }
    constexpr float C2 = 1.4426950408889634f * 0.08838834764831845f;
    const float th = 150.0f + 2.0f * 1.02f * sqrtf(qs * ks) * C2 + 4.0f;
    const float ref = CB[(size_t)bh * SEQ + qb * 256], v = CB[(size_t)bh * SEQ + 64 * F.lane + 63];
    const unsigned long long m = __ballot(F.lane < 4 * qb && (ref - v) * C2 > th);
    int j = __builtin_popcountll(m); if (m != ((j >= 64) ? ~0ull : ((1ull << j) - 1ull))) j = 0;
    return j & ~1;
}
__device__ __forceinline__ fattn::BlockRef attn_ref(int bh, int qb, int jlo) {
    const int b = bh >> 3, h = bh & 7;
    fattn::BlockRef r; r.qo = ((unsigned)bh * SEQ + (unsigned)qb * 256u) * HD; r.oo = ((unsigned)b * SEQ + (unsigned)qb * 256u) * DM + h * HD; r.kvo = (unsigned)bh * SEQ * HD; r.cbo = (unsigned)bh * SEQ; r.P0 = qb * 256; r.jlo = jlo; return r;
}
__device__ __forceinline__ void attn_phase(const Frame& F, char* lds, const bf16* Qb, bf16* Ob, const bf16* Kb, const bf16* Vb, const float* CB, const int* JLO, gu32* QCTR) {
    constexpr int NBLK = 128;
    const int M = F.G >> 3; if ((F.G & 7) || M > 64 || M < 1) return;
    const int x = F.vcu / M, r = F.vcu % M;
    volatile LAS int* tk_l = (volatile LAS int*)(F.lds + MISC_OFF + 64);
    gu32* qc = QCTR + 64 * x;
    const fattn::Bases G{Qb, Ob, Kb, Vb, CB};
#define ATT_DEC(k_, bh_, qb_) do { const int i_ = (k_) & 7; bh_ = (i_ < 4 ? 4 * x + i_ : 32 + 4 * x + (i_ - 4)); qb_ = 15 - ((k_) >> 3); } while (0)
    int bh, qb; ATT_DEC(r, bh, qb);
    fattn::BlockRef cur = attn_ref(bh, qb, __builtin_amdgcn_readfirstlane(JLO[bh * 16 + qb]));
    ATT_DEC(r + M, bh, qb);
    fattn::BlockRef nxt = attn_ref(bh, qb, __builtin_amdgcn_readfirstlane(JLO[bh * 16 + qb])); bool nxt_ok = (r + M) < NBLK;
    fattn::Seam S;
    fattn::prime(G, cur, lds, S);
    bool more = true;
    for (;;) {
        unsigned tkt = 0u;
        if (more && F.tid == 0) tkt = __hip_atomic_fetch_add(qc, 1u, __ATOMIC_RELAXED, __HIP_MEMORY_SCOPE_AGENT);
        const bool last = !nxt_ok;
        fattn::block(G, cur, last ? cur : nxt, lds, S);
        if (last) break;
        if (F.tid == 0) tk_l[0] = more ? (int)tkt + 2 * M : NBLK;
        __syncthreads();
        const int k2 = __builtin_amdgcn_readfirstlane(tk_l[0]);
        __syncthreads();
        cur = nxt;
        if (k2 < NBLK) { ATT_DEC(k2, bh, qb); nxt = attn_ref(bh, qb, __builtin_amdgcn_readfirstlane(JLO[bh * 16 + qb])); nxt_ok = true; } else { nxt_ok = false; more = false; }
    }
#undef ATT_DEC
}
typedef float f32x16 __attribute__((ext_vector_type(16)));
struct P5Args { const float *X, *WRT, *b_rgrp, *b_rexp, *w_down; const bf16* DL; bf16* X1B; unsigned char *X8, *W2; float* RS2; int* LISTS; unsigned* TOK; gu32* CNT; };
__device__ __forceinline__ void p5_route(const Frame& F, const P5Args& a) {
    const int tid = F.tid, lane = F.lane, wid = F.wave, i16 = lane & 15, h4 = lane >> 4;
    constexpr int LDA = 132;
    LAS float* A_l = (LAS float*)(F.lds + RING_OFF) + wid * 16 * LDA;
    LAS float* B_l = (LAS float*)(F.lds + RING_OFF + 67584);
    LAS float* LG = (LAS float*)(F.lds + RING_OFF + 94208);
    LAS float* rs_l = (LAS float*)(F.lds + RING_OFF + 113664);
    LAS int* hist = (LAS int*)(F.lds + RING_OFF + 114176);
    LAS int* base_l = (LAS int*)(F.lds + RING_OFF + 114432);
    {
        LAS float* scr = (LAS float*)(F.lds + RING_OFF + wid * 8704);
        const int gw = F.vcu * NWAVES + wid, NGW = F.G * NWAVES;
        for (int it = gw; it < 8192; it += NGW) { const int e = it >> 8, kb = (it >> 5) & 7, nb = it & 31; const float* W = a.w_down + (size_t)e * DE * DM;
            transpose_tile8(W + (size_t)(64 * kb) * DM + 32 * nb, DM, a.W2 + (size_t)(e * 1024 + 32 * nb) * DE + 64 * kb, DE, nullptr, pg8::W2_SCALE, scr, lane); }
    }
    __syncthreads();
    for (int rb = blockIdx.x; rb < T / 128; rb += F.G) {
        const int R0 = rb * 128;
        if (tid < 32) hist[tid] = 0;
        const int ar = lane >> 5, ac = 4 * (lane & 31);
        const size_t xo = (size_t)(R0 + 16 * wid + ar) * DM + ac; const float* xsrc = a.X + xo; const bf16* dsrc = a.DL + xo; unsigned char* xdst = a.X8 + xo; bf16* bdst = a.X1B + xo;
        f32x4 areg[8], breg[3]; unsigned long long dreg[8];
#define P5_LOAD(kc_) do { _Pragma("unroll") for (int i_ = 0; i_ < 8; ++i_) { areg[i_] = *(const f32x4*)(xsrc + (size_t)(2 * i_) * DM + (kc_) * 128); dreg[i_] = *(const unsigned long long*)(dsrc + (size_t)(2 * i_) * DM + (kc_) * 128); } \
        _Pragma("unroll") for (int q_ = 0; q_ < 3; ++q_) { const int idx_ = tid + 512 * q_; breg[q_] = *(const f32x4*)(a.WRT + (size_t)(idx_ >> 5) * DM + (kc_) * 128 + 4 * (idx_ & 31)); } } while (0)
        P5_LOAD(0);
        f32x4 acc[3] = {{0.f, 0.f, 0.f, 0.f}, {0.f, 0.f, 0.f, 0.f}, {0.f, 0.f, 0.f, 0.f}}; float ss = 0.f;
        for (int kc = 0; kc < 8; ++kc) {
#pragma unroll
            for (int i = 0; i < 8; ++i) { const unsigned dl = (unsigned)dreg[i], dh = (unsigned)(dreg[i] >> 32);
                areg[i][0] += bf_lo(dl); areg[i][1] += bf_hi(dl); areg[i][2] += bf_lo(dh); areg[i][3] += bf_hi(dh);
                *(unsigned*)(xdst + (size_t)(2 * i) * DM + kc * 128) = pg8::pack4_fp8(areg[i][0], areg[i][1], areg[i][2], areg[i][3]);
                *(unsigned long long*)(bdst + (size_t)(2 * i) * DM + kc * 128) = (unsigned long long)pg8::cvt_pk_bf16(areg[i][0], areg[i][1]) | ((unsigned long long)pg8::cvt_pk_bf16(areg[i][2], areg[i][3]) << 32);
                *(LAS f32x4*)(A_l + (2 * i + ar) * LDA + ac) = areg[i]; }
#pragma unroll
            for (int q = 0; q < 3; ++q) { const int idx = tid + 512 * q; *(LAS f32x4*)(B_l + (idx >> 5) * LDA + 4 * (idx & 31)) = breg[q]; }
            __syncthreads();
            if (kc + 1 < 8) P5_LOAD(kc + 1);
#pragma unroll
            for (int jj = 0; jj < 8; ++jj) {
                const f32x4 af = *(const LAS f32x4*)(A_l + i16 * LDA + 16 * jj + 4 * h4);
                f32x4 bfv[3];
#pragma unroll
                for (int nt = 0; nt < 3; ++nt) bfv[nt] = *(const LAS f32x4*)(B_l + (16 * nt + i16) * LDA + 16 * jj + 4 * h4);
                ss += (af[0] * af[0] + af[1] * af[1]) + (af[2] * af[2] + af[3] * af[3]);
#pragma unroll
                for (int s = 0; s < 4; ++s)
#pragma unroll
                    for (int nt = 0; nt < 3; ++nt) acc[nt] = __builtin_amdgcn_mfma_f32_16x16x4f32(af[s], bfv[nt][s], acc[nt], 0, 0, 0);
            }
            __syncthreads();
        }
#undef P5_LOAD
        ss += __shfl_xor(ss, 16); ss += __shfl_xor(ss, 32);
        const float rs = 1.0f / sqrtf(ss * (1.0f / DM) + EPS);
        if (h4 == 0) { a.RS2[R0 + 16 * wid + i16] = rs; rs_l[16 * wid + i16] = rs; }
#pragma unroll
        for (int r = 0; r < 4; ++r) { const int rl = 16 * wid + 4 * h4 + r; LG[rl * 37 + i16] = acc[0][r]; LG[rl * 37 + 16 + i16] = acc[1][r]; if (i16 < 4) LG[rl * 37 + 32 + i16] = acc[2][r]; }
        __syncthreads();
        int e0 = 0, e1 = 0, k0 = 0, k1 = 0; float w0 = 0.f, w1 = 0.f;
        if (tid < 128) {
            const float rsv = rs_l[tid]; const LAS float* lg = LG + tid * 37;
            float gl[4];
#pragma unroll
            for (int q = 0; q < 4; ++q) gl[q] = lg[32 + q] * rsv + a.b_rgrp[q];
            int gs = 0; float gm = gl[0];
#pragma unroll
            for (int q = 1; q < 4; ++q) if (gl[q] > gm) { gm = gl[q]; gs = q; }
            float den = 0.f;
#pragma unroll
            for (int q = 0; q < 4; ++q) den += expf(gl[q] - gm);
            const float pg = 1.0f / den;
            float el[8];
#pragma unroll
            for (int q = 0; q < 8; ++q) el[q] = lg[8 * gs + q] * rsv + a.b_rexp[8 * gs + q];
            int i0 = 0; float v0 = el[0];
#pragma unroll
            for (int q = 1; q < 8; ++q) if (el[q] > v0) { v0 = el[q]; i0 = q; }
            int i1 = -1; float v1 = -INFINITY;
#pragma unroll
            for (int q = 0; q < 8; ++q) if (q != i0 && el[q] > v1) { v1 = el[q]; i1 = q; }
            const float ex = expf(v1 - v0);
            w0 = pg / (1.0f + ex); w1 = pg * ex / (1.0f + ex);
            e0 = 8 * gs + i0; e1 = 8 * gs + i1;
            k0 = atomicAdd((int*)(hist + e0), 1); k1 = atomicAdd((int*)(hist + e1), 1);
        }
        __syncthreads();
        if (tid < 32) base_l[tid] = (int)__hip_atomic_fetch_add(a.CNT + tid, (unsigned)hist[tid], __ATOMIC_RELAXED, __HIP_MEMORY_SCOPE_AGENT);
        __syncthreads();
        if (tid < 128) { const int tok = R0 + tid, s0 = base_l[e0] + k0, s1 = base_l[e1] + k1;
            a.LISTS[(size_t)e0 * T + s0] = tok; a.LISTS[(size_t)e1 * T + s1] = tok;
            v4u i0v = {(unsigned)e0, (unsigned)s0, (unsigned)e1, (unsigned)s1}, i1v = {__float_as_uint(w0), __float_as_uint(w1), 0u, 0u};
            *(GAS v4u*)(a.TOK + (size_t)tok * 8) = i0v; *(GAS v4u*)(a.TOK + (size_t)tok * 8 + 4) = i1v; }
        __syncthreads();
    }
}
__device__ __forceinline__ void build_tables(const Frame& F, const gu32* CNT) {
    LAS int* ps = (LAS int*)(F.lds + TBL_PS); LAS int* cn = (LAS int*)(F.lds + TBL_CN); LAS int* te = (LAS int*)(F.lds + TBL_TE);
    __syncthreads();
    if (F.tid < 32) { int c = (int)__hip_atomic_load(CNT + F.tid, __ATOMIC_RELAXED, __HIP_MEMORY_SCOPE_AGENT); c = c < 0 ? 0 : (c > T ? T : c); cn[F.tid] = c; }
    __syncthreads();
    if (F.tid == 0) { int run = 0; for (int e = 0; e < 32; ++e) { ps[e] = run; run += (cn[e] + 255) & ~255; } if (run > PMAX) run = PMAX; ps[32] = run; }
    __syncthreads();
    if (F.tid < 288) { const int p = F.tid * 256; int e = 0; for (int q = 1; q < 32; ++q) if (p >= ps[q]) e = q; te[F.tid] = e; }
    __syncthreads();
}
__device__ __forceinline__ void build_rowtab(const Frame& F, const pg8::GroupedOrder& S, const int* LISTS, const float* RS2, LAS int* rowtab) {
    const LAS int* ps = (const LAS int*)(F.lds + TBL_PS); const LAS int* cn = (const LAS int*)(F.lds + TBL_CN); const LAS int* te = (const LAS int*)(F.lds + TBL_TE);
    pg8::Unit u;
    for (int ui = 0; ui < 6 && S.next(ui, u); ++ui)
        if (F.tid < 256) { const int p = u.pm * 256 + F.tid, e = te[u.pm], local = p - ps[e]; const int tok = local < cn[e] ? LISTS[(size_t)e * T + local] : 0; rowtab[ui * 256 + F.tid] = tok; ((LAS float*)rowtab)[(6 + ui) * 256 + F.tid] = RS2[tok]; }
    __syncthreads();
}
__device__ __forceinline__ float fp8_f32(unsigned w, int i) { return i == 0 ? __builtin_amdgcn_cvt_f32_fp8(w, 0) : (i == 1 ? __builtin_amdgcn_cvt_f32_fp8(w, 1) : (i == 2 ? __builtin_amdgcn_cvt_f32_fp8(w, 2) : __builtin_amdgcn_cvt_f32_fp8(w, 3))); }
__device__ __forceinline__ void p9_final(const Frame& F, const bf16* X1B, float* OUT, const unsigned char* Y, const unsigned* TOK, const float* g_final) {
    const LAS int* ps = (const LAS int*)(F.lds + TBL_PS);
    const int gw = F.vcu * NWAVES + F.wave, NGW = F.G * NWAVES;
    f32x4 gf[4];
#pragma unroll
    for (int j = 0; j < 4; ++j) gf[j] = *((const f32x4*)g_final + F.lane + 64 * j);
    constexpr float YS = 1.0f / (pg8::HB_SCALE * pg8::W2_SCALE * pg8::Y_SCALE);
    for (int m = gw; m < T; m += NGW) {
        const v4u ia = *(const GAS v4u*)(TOK + (size_t)m * 8), ib = *(const GAS v4u*)(TOK + (size_t)m * 8 + 4); const float w0 = __uint_as_float(ib.x) * YS, w1 = __uint_as_float(ib.y) * YS;
        const int e0 = (int)(ia.x & 31u), e1 = (int)(ia.z & 31u);
        const size_t p0 = (size_t)(ps[e0] + (int)ia.y), p1 = (size_t)(ps[e1] + (int)ia.w);
        const GAS unsigned long long* xr = (const GAS unsigned long long*)(X1B + (size_t)m * DM) + F.lane; GAS f32x4* orow = (GAS f32x4*)(OUT + (size_t)m * DM) + F.lane;
        const GAS unsigned* y0 = (const GAS unsigned*)(Y + p0 * DM) + F.lane; const GAS unsigned* y1 = (const GAS unsigned*)(Y + p1 * DM) + F.lane;
        f32x4 v[4]; float s = 0.f;
#pragma unroll
        for (int j = 0; j < 4; ++j) { const unsigned long long xw = xr[64 * j]; v[j] = (f32x4){bf_lo((unsigned)xw), bf_hi((unsigned)xw), bf_lo((unsigned)(xw >> 32)), bf_hi((unsigned)(xw >> 32))}; const unsigned a = y0[64 * j], b = y1[64 * j];
            v[j].x += w0 * fp8_f32(a, 0) + w1 * fp8_f32(b, 0); v[j].y += w0 * fp8_f32(a, 1) + w1 * fp8_f32(b, 1);
            v[j].z += w0 * fp8_f32(a, 2) + w1 * fp8_f32(b, 2); v[j].w += w0 * fp8_f32(a, 3) + w1 * fp8_f32(b, 3);
            s += (v[j].x * v[j].x + v[j].y * v[j].y) + (v[j].z * v[j].z + v[j].w * v[j].w); }
        s = wave_sum(s);
        const float rs = 1.0f / sqrtf(s * (1.0f / DM) + EPS);
#pragma unroll
        for (int j = 0; j < 4; ++j) orow[64 * j] = v[j] * rs * gf[j];
    }
}

constexpr int N_PHASES = 10;
#ifndef DUP_TRIVIAL
#define DUP_TRIVIAL 0
#endif
#ifndef DUP_PHASE
#define DUP_PHASE -1
#endif
typedef __attribute__((address_space(4))) const unsigned char* karg_ptr;
__device__ __forceinline__ const float* arg_in(int k) { karg_ptr base = (karg_ptr)__builtin_amdgcn_kernarg_segment_ptr(); const unsigned long long v = *(const unsigned long long volatile __attribute__((address_space(4)))*)(base + 8 * k); return (const float*)(const GAS float*)v; }
struct Args { const float* in[23]; float* out; unsigned char* ws; int ph_lo, ph_hi, mode, pad; };
__global__ void __launch_bounds__(NWAVES * 64, 2) fwd_kernel(Args args) {
    extern __shared__ __attribute__((aligned(16))) unsigned char lds[];
    Frame F;
    F.lds = (LAS unsigned char*)lds;
    F.wave = __builtin_amdgcn_readfirstlane((int)threadIdx.x >> 6); F.lane = pg8::lane_now(); F.tid = F.wave * 64 + F.lane;
    F.G = gridDim.x; { const int bx = blockIdx.x; F.vcu = (F.G % 8 == 0) ? (bx % 8) * (F.G / 8) + bx / 8 : bx; }
    unsigned char* ws = args.ws;
    gu32* ctl = (gu32*)(ws + WS_CTL);
    volatile LAS unsigned* MISC = (volatile LAS unsigned*)(F.lds + MISC_OFF);
    for (int u = F.tid; u < (LDS_BYTES - LDSCTL_OFF) / 4; u += NWAVES * 64) ((LAS unsigned*)(F.lds + LDSCTL_OFF))[u] = 0u;
    __syncthreads();
#if MK_ONE_LAUNCH
    XcdBarrier bar = xcd_barrier_post((unsigned*)(ctl + CW_BAR), MISC + 8);
#define GRID_BAR() xcd_barrier(bar)
#else
#define GRID_BAR() do { } while (0)
#endif
    const int lo = args.ph_lo, hi = args.ph_hi;
#ifndef PH_MASK
#define PH_MASK 0x3ff
#endif
#define IN(k) (((PH_MASK >> (k)) & 1) && lo <= (k) && (k) < hi)
#define BOTH(k) (IN(k) && IN((k) + 1))
    float* out = args.out;
    bf16* Win = (bf16*)(ws + WS_WIN); bf16* Wl = (bf16*)(ws + WS_WL); bf16* Wa = (bf16*)(ws + WS_WA); bf16* Wo = (bf16*)(ws + WS_WO); bf16* Wrg = (bf16*)(ws + WS_WRG);
    bf16* XB = (bf16*)(ws + WS_XB); bf16* XR = (bf16*)(ws + WS_XR); bf16* GG = (bf16*)(ws + WS_GG); bf16* Qb = (bf16*)(ws + WS_Q); bf16* Kb = (bf16*)(ws + WS_K); bf16* Vb = (bf16*)(ws + WS_V);
    bf16* SL = (bf16*)out; bf16* SA = (bf16*)out + pg8::SEGE;
    float* RS1 = (float*)(ws + WS_RS1); float* RS2 = (float*)(ws + WS_RS2); float* LF = (float*)(ws + WS_LF); float* CB = (float*)(ws + WS_CB);
    unsigned* TOK = (unsigned*)(ws + WS_TOK); int* LISTS = (int*)(ws + WS_LISTS); float* WRT = (float*)(ws + WS_WRT); int* JLO = (int*)(ws + WS_SRS);
    unsigned char* W13 = ws + WS_W13; unsigned char* W2 = ws + WS_W2; bf16* XG = (bf16*)(ws + WS_XG); unsigned char* HB = ws + WS_HB; unsigned char* X8 = ws + WS_XB;
    gu32* CNT = ctl + CW_CNT;

    if (IN(0)) { F.lane = pg8::lane_now(); F.tid = F.wave * 64 + F.lane;
        P0Args a{arg_in(0), arg_in(1), arg_in(2), arg_in(5), arg_in(7), arg_in(10), arg_in(11), arg_in(12), arg_in(13), arg_in(14), arg_in(15), arg_in(17), arg_in(19), arg_in(20), Win, Wl, Wa, Wo, Wrg, XB, W13, RS1, LF, WRT};
        p0_prologue(F, a, DUP_PHASE == 0 ? args.mode : 0);
        if (BOTH(0)) GRID_BAR();
    }
    if (IN(1)) { F.lane = pg8::lane_now(); F.tid = F.wave * 64 + F.lane;
        cumsum_bias(F, LF, CB);
        pg8::Gemm g{XB, Win, T, NZ, DM}; pg8::StaticOrder S; S.init(T, NZ, F.G, (int)blockIdx.x);
        pg8::EpiZ E{XR, SL, RS1, (unsigned*)(ctl + CW_NORM), args.mode};
        pg8::gemm_phase<pg8::EpiZ, pg8::StaticOrder, true, true>(F.lds + RING_OFF, g, S, E, F.wave);
        if (BOTH(1)) GRID_BAR();
    }
    if (IN(2)) { F.lane = pg8::lane_now(); F.tid = F.wave * 64 + F.lane;
        { const int gw = F.vcu * NWAVES + F.wave; if (gw < NB * NH * 16) { const int j = attn_jlo(F, CB, (const unsigned*)(ctl + CW_NORM), gw >> 4, gw & 15); if (F.lane == 0) JLO[gw] = j; } }
        conv_prepass(F, XR, XB, arg_in(3), arg_in(4));
        if (BOTH(2)) GRID_BAR();
    }
    if (IN(3)) { F.lane = pg8::lane_now(); F.tid = F.wave * 64 + F.lane;
        RgArgs ra{XB, GG, GG, Wrg, arg_in(6), arg_in(8), arg_in(9)};
#if DUP_PHASE >= 20
        const int mode = args.mode;
#else
        constexpr int mode = 0;
#endif
        if (mode != 2) { ra.GO = mode == 1 ? XR : GG; for (int u = F.vcu; u < 256; u += F.G) rglru_unit(F, ra, u); }
        if (mode != 1) attn_phase(F, (char*)lds + RING_OFF, Qb, XR, Kb, Vb, CB, JLO, ctl + CW_QCTR + (mode == 2 ? 1024 : 0));
        if (BOTH(3)) GRID_BAR();
    }
    if (IN(4)) { { F.lane = pg8::lane_now(); F.tid = F.wave * 64 + F.lane;
        static_assert(WS_GG - WS_XR == (size_t)128 * 256 * DM * 2 && WS_WL - WS_WA == (size_t)4 * 256 * DM * 2, "TwoGemmOrder: hg follows o by 128 row tiles, Wl follows Wa by 4 column tiles");
        pg8::Gemm g{XR, Wa, T, DM, DM}; pg8::TwoGemmOrder S; S.init(T, DM, F.G, (int)blockIdx.x);
        pg8::EpiGate2 E{SA, SL, XB};
        pg8::gemm_phase<pg8::EpiGate2, pg8::TwoGemmOrder, true, true>(F.lds + RING_OFF, g, S, E, F.wave); }
        if (BOTH(4)) GRID_BAR();
    }
    if (IN(5)) { F.lane = pg8::lane_now(); F.tid = F.wave * 64 + F.lane;
        pg8::Gemm g{XB, Wo, T, DM, DM}; pg8::StaticOrder S; S.init(T, DM, F.G, (int)blockIdx.x);
        pg8::EpiDelta E{(bf16*)out};
        pg8::gemm_phase<pg8::EpiDelta, pg8::StaticOrder, true, true>(F.lds + RING_OFF, g, S, E, F.wave);
        if (BOTH(5)) GRID_BAR();
    }
    if (IN(6)) { F.lane = pg8::lane_now(); F.tid = F.wave * 64 + F.lane;
        P5Args a{arg_in(0), WRT, arg_in(16), arg_in(18), arg_in(21), (const bf16*)out, XR, X8, W2, RS2, LISTS, TOK, args.mode ? CNT + 64 : CNT};
        p5_route(F, a);
        if (BOTH(6)) GRID_BAR();
    }
    if (IN(7)) { F.lane = pg8::lane_now(); F.tid = F.wave * 64 + F.lane;
        build_tables(F, CNT);
        const int ntiles = ((const LAS int*)(F.lds + TBL_PS))[32] >> 8;
        pg8::Gemm g{(const bf16*)X8, (const bf16*)W13, ntiles * 256, 32 * 1024, DM / 2}; pg8::GroupedOrder S{(const LAS int*)(F.lds + TBL_TE), ntiles * 4, F.G, F.vcu};
        LAS int* rowtab = (LAS int*)(F.lds + RG_TOT);
        build_rowtab(F, S, LISTS, RS2, rowtab);
        pg8::EpiSwiGLU E{HB};
        pg8::gemm_phase_gather<pg8::EpiSwiGLU, pg8::GroupedOrder, true>(F.lds + RING_OFF, g, S, E, rowtab, F.wave);
        if (BOTH(7)) GRID_BAR();
    }
    if (IN(8)) { F.lane = pg8::lane_now(); F.tid = F.wave * 64 + F.lane;
        build_tables(F, CNT);
        const int ntiles = ((const LAS int*)(F.lds + TBL_PS))[32] >> 8;
        pg8::Gemm g{(const bf16*)HB, (const bf16*)W2, ntiles * 256, 32 * 1024, DE / 2}; pg8::GroupedOrder S{(const LAS int*)(F.lds + TBL_TE), ntiles * 4, F.G, F.vcu};
        pg8::EpiY E{(unsigned char*)XG};
        pg8::gemm_phase<pg8::EpiY, pg8::GroupedOrder, true, true, true>(F.lds + RING_OFF, g, S, E, F.wave);
        if (BOTH(8)) GRID_BAR();
    }
    if (IN(9)) { F.lane = pg8::lane_now(); F.tid = F.wave * 64 + F.lane;
        build_tables(F, CNT);
        p9_final(F, XR, out, (const unsigned char*)XG, TOK, arg_in(22));
    }
#undef IN
#undef BOTH
}

extern "C" void kernel_launch(void* const* d_in, const int* in_sizes, int n_in, void* d_out, int out_size, void* d_ws, size_t ws_size, hipStream_t stream) {
    static int grid = 0;
    if (grid == 0) {
        if (n_in != 23 || in_sizes[0] != T * DM || out_size != T * DM || ws_size < WS_END) { fprintf(stderr, "kernel_launch: unexpected shapes (n_in %d, in0 %d, out %d, ws %zu); nothing launched\n", n_in, n_in > 0 ? in_sizes[0] : -1, out_size, ws_size); grid = -1; return; }
        int dev = 0, cus = 0;
        if (hipGetDevice(&dev) != hipSuccess || hipDeviceGetAttribute(&cus, hipDeviceAttributeMultiprocessorCount, dev) != hipSuccess) { grid = -1; return; }
        if (hipFuncSetAttribute((const void*)fwd_kernel, hipFuncAttributeMaxDynamicSharedMemorySize, LDS_BYTES) != hipSuccess) { fprintf(stderr, "kernel_launch: hipFuncSetAttribute failed\n"); grid = -1; return; }
        int per_cu = 0;
        if (hipOccupancyMaxActiveBlocksPerMultiprocessor(&per_cu, (const void*)fwd_kernel, NWAVES * 64, LDS_BYTES) != hipSuccess || per_cu < 1) { fprintf(stderr, "kernel_launch: occupancy query reports %d\n", per_cu); }
        (void)hipGetLastError();
        grid = cus;
    }
    if (grid < 0) return;
    if (hipMemsetAsync((char*)d_ws + WS_CTL, 0, CTL_ZERO_BYTES, stream) != hipSuccess) return;
    Args a{};
    for (int i = 0; i < 23; ++i) a.in[i] = (const float*)d_in[i];
    a.out = (float*)d_out; a.ws = (unsigned char*)d_ws;
#if MK_ONE_LAUNCH
    a.ph_lo = 0; a.ph_hi = N_PHASES;
    hipLaunchKernelGGL(fwd_kernel, dim3(grid), dim3(NWAVES * 64), LDS_BYTES, stream, a);
#else
    for (int ph = 0; ph < N_PHASES; ++ph) { a.ph_lo = ph; a.ph_hi = ph + 1;
        if (DUP_PHASE == ph || (ph == 3 && DUP_PHASE >= 20)) { a.mode = DUP_PHASE >= 20 ? DUP_PHASE - 19 : ((ph == 6 || (ph == 1 && DUP_TRIVIAL)) ? 1 : (ph == 0 ? DUP_TRIVIAL : 0)); hipLaunchKernelGGL(fwd_kernel, dim3(grid), dim3(NWAVES * 64), LDS_BYTES, stream, a); a.mode = 0; }
        hipLaunchKernelGGL(fwd_kernel, dim3(grid), dim3(NWAVES * 64), LDS_BYTES, stream, a); }
#endif
}
```

```cpp
#include <hip/hip_runtime.h>
#include <cstdio>
#include <cstdint>

#ifndef MK_ONE_LAUNCH
#define MK_ONE_LAUNCH 1
#endif
namespace pg8 {
#define PG8_LAS __attribute__((address_space(3)))
typedef unsigned short bf16_t;
typedef short bf16x8 __attribute__((ext_vector_type(8)));
typedef float f32x4 __attribute__((ext_vector_type(4)));
typedef unsigned u32x4 __attribute__((ext_vector_type(4)));
constexpr int BM = 256, BK = 64, HALF = 128, HTB = HALF * BK * 2  , STAGE_BYTES = 8 * HTB, NXCD = 8, WGM = 8;

__host__ __device__ __forceinline__ int lds_byte(int r, int c) { const int st = (r >> 4) * 2 + (c >> 5), rr = r & 15, cc = c & 31, ob = rr * 64 + cc * 2; return st * 1024 + (ob ^ (((ob >> 9) & 1) << 5)); }
__host__ __device__ __forceinline__ void stage_rc(int b, int& R, int& C) { const int st = b / 1024, sb = b % 1024, swz = sb ^ (((sb >> 9) & 1) << 5); R = (st >> 1) * 16 + swz / 64; C = (st & 1) * 32 + (swz % 64) / 2; }
__host__ __device__ __forceinline__ int perm32(int rho) { const int n = rho >> 4, i = rho & 15; return 8 * (i >> 2) + 4 * n + (i & 3); }

struct Unit { int pm, pn; };
struct Gemm { const bf16_t* A; const bf16_t* Bt; int M, N, K; };

struct StaticOrder {
    int nM, nN, nwg, G, c;
    __host__ __device__ void init(int M, int N, int G_, int c_) { nM = M / BM; nN = N / BM; nwg = nM * nN; G = G_; c = c_; }
    __host__ __device__ bool next(int i, Unit& u) const {
        const long L = (long)i * G + c; if (L >= nwg) return false;
        int wgid = (int)L; { const int q = nwg / NXCD, r = nwg % NXCD, xcd = wgid % NXCD, off = wgid / NXCD; wgid = (xcd < r ? xcd * (q + 1) : r * (q + 1) + (xcd - r) * q) + off; }
        const int nig = WGM * nN, gid = wgid / nig, fm = gid * WGM, gsz = (nM - fm) < WGM ? (nM - fm) : WGM;
        u.pm = fm + ((wgid % nig) % gsz); u.pn = (wgid % nig) / gsz; return true;
    }
    __device__ __forceinline__ void a_ready(const Unit&) const {}
    __device__ __forceinline__ void done(const Unit&) const {}
};

__device__ __forceinline__ unsigned cvt_pk_bf16(float lo, float hi) { unsigned r; asm volatile("v_cvt_pk_bf16_f32 %0, %1, %2" : "=v"(r) : "v"(lo), "v"(hi)); return r; }
typedef float f32x2 __attribute__((ext_vector_type(2)));
__device__ __forceinline__ int lane_now() { int l; asm volatile("v_mbcnt_lo_u32_b32 %0, -1, 0\n\tv_mbcnt_hi_u32_b32 %0, -1, %0" : "=v"(l)); return l; }
typedef int v4i_t __attribute__((ext_vector_type(4)));
typedef int v8i_t __attribute__((ext_vector_type(8)));
__device__ __forceinline__ v8i_t cat8(bf16x8 a, bf16x8 b) { const v4i_t x = __builtin_bit_cast(v4i_t, a), y = __builtin_bit_cast(v4i_t, b); return __builtin_shufflevector(x, y, 0, 1, 2, 3, 4, 5, 6, 7); }
__device__ __forceinline__ void glds_sv(const char* base, unsigned voff, unsigned lds_dst) { unsigned keep;
    asm volatile("s_mov_b32 %0, m0\n\ts_mov_b32 m0, %3\n\ts_nop 0\n\tglobal_load_lds_dwordx4 %1, %2\n\ts_mov_b32 m0, %0" : "=&s"(keep) : "v"(voff), "s"(base), "s"(lds_dst) : "memory"); }
__device__ __forceinline__ float sat8(float x) { return __builtin_amdgcn_fmed3f(x, -448.0f, 448.0f); }
__device__ __forceinline__ unsigned pack4_fp8(float a, float b, float c, float d) { unsigned w = 0u; w = __builtin_amdgcn_cvt_pk_fp8_f32(sat8(a), sat8(b), w, false); w = __builtin_amdgcn_cvt_pk_fp8_f32(sat8(c), sat8(d), w, true); return w; }
constexpr float W13_SCALE = 64.0f, HB_SCALE = 8.0f, W2_SCALE = 32.0f;
__device__ __forceinline__ float sigmoid_f(float x) { return __builtin_amdgcn_rcpf(1.0f + __builtin_amdgcn_exp2f(-1.4426950408889634f * x)); }
__device__ __forceinline__ float gelu_tanh_f(float x) { const float u = x * (1.0f + 0.044715f * x * x); return x * __builtin_amdgcn_rcpf(1.0f + __builtin_amdgcn_exp2f(-2.3022081981f * u)); }
__device__ __forceinline__ float bf_lo(unsigned w) { return __builtin_bit_cast(float, w << 16); }
__device__ __forceinline__ float bf_hi(unsigned w) { return __builtin_bit_cast(float, w & 0xffff0000u); }
constexpr size_t SEGE = (size_t)32768 * 1024;

struct EpiZ {
    static constexpr bool PERM = true, AFTER_DRAIN = false; static constexpr int NSTORES = 16;
    bf16_t* ws5; bf16_t* out2; const float* rs; unsigned* norm; int probe;
    __device__ __forceinline__ void operator()(const f32x4 (&acc)[2][2][4][2], const Unit& u, int wr, int wc, int fr, int fq) const {
        const int seg = probe ? 0 : (u.pn >> 2); float nm[2] = {0.f, 0.f};
        const int sgo = u.pn >> 2; bf16_t* O = sgo < 5 ? ws5 + (size_t)sgo * SEGE : out2 + (size_t)(sgo - 5) * SEGE;
        const int row0 = u.pm * BM + wr * 64 + fr, col0 = (u.pn & 3) * BM + wc * 32 + 8 * fq;
#pragma unroll
        for (int ai = 0; ai < 2; ++ai)
#pragma unroll
            for (int m = 0; m < 4; ++m) { const int row = row0 + ai * HALF + m * 16; bf16_t* rowp = O + (size_t)row * 1024 + col0;
                const bool hm = (sgo >= 2 && sgo <= 4); bf16_t* rowh = O + ((size_t)((row >> 12) * 8 + 2 * (u.pn & 3)) * 4096 + (row & 4095)) * 128 + wc * 32 + 8 * fq;
#pragma unroll
                for (int bj = 0; bj < 2; ++bj) { f32x4 v0 = acc[ai][bj][m][0], v1 = acc[ai][bj][m][1];
                    if (seg == 1) {
#pragma unroll
                        for (int i = 0; i < 4; ++i) { v0[i] = gelu_tanh_f(v0[i]); v1[i] = gelu_tanh_f(v1[i]); } }
                    else if (seg >= 5) {
#pragma unroll
                        for (int i = 0; i < 4; ++i) { v0[i] = sigmoid_f(v0[i]); v1[i] = sigmoid_f(v1[i]); } }
                    if (seg == 2 || seg == 3) { float q = (v0[0] * v0[0] + v0[1] * v0[1]) + (v0[2] * v0[2] + v0[3] * v0[3]) + (v1[0] * v1[0] + v1[1] * v1[1]) + (v1[2] * v1[2] + v1[3] * v1[3]);
                        q += __shfl_xor(q, 16); q += __shfl_xor(q, 32); nm[bj] = fmaxf(nm[bj], q); }
                    u32x4 w; w.x = cvt_pk_bf16(v0[0], v0[1]); w.y = cvt_pk_bf16(v0[2], v0[3]); w.z = cvt_pk_bf16(v1[0], v1[1]); w.w = cvt_pk_bf16(v1[2], v1[3]);
                    *(u32x4*)(hm ? rowh + (size_t)bj * 4096 * 128 : rowp + bj * HALF) = w; } }
        if (seg == 2 || seg == 3) {
#pragma unroll
            for (int bj = 0; bj < 2; ++bj) { float q = nm[bj];
#pragma unroll
                for (int o = 1; o < 16; o <<= 1) q = fmaxf(q, __shfl_xor(q, o));
                if (fr == 0 && fq == 0) atomicMax(norm + ((((seg - 2) * 8 + (u.pm >> 4)) * 8 + 2 * (u.pn & 3) + bj) * 4 + wc), __float_as_uint(q)); }
        }
    }
};
template <int MODE> struct EpiGate {
    static constexpr bool PERM = true, AFTER_DRAIN = false; static constexpr int NSTORES = 16;
    const bf16_t* G; bf16_t* O;
    __device__ __forceinline__ void operator()(const f32x4 (&acc)[2][2][4][2], const Unit& u, int wr, int wc, int fr, int fq) const {
        const int row0 = u.pm * BM + wr * 64 + fr, col0 = u.pn * BM + wc * 32 + 8 * fq;
        u32x4 gv[2][2][2], pv[2][2][2];
#define EG_LOAD(st_, b_) do { _Pragma("unroll") for (int mm = 0; mm < 2; ++mm) _Pragma("unroll") for (int bj = 0; bj < 2; ++bj) { \
            const size_t off_ = (size_t)(row0 + ((st_) >> 1) * HALF + (2 * ((st_) & 1) + mm) * 16) * 1024 + col0 + bj * HALF; gv[b_][mm][bj] = *(const u32x4*)(G + off_); if (MODE == 1) pv[b_][mm][bj] = *(const u32x4*)(O + off_); } } while (0)
#define EG_DO(st_, b_) do { _Pragma("unroll") for (int mm = 0; mm < 2; ++mm) _Pragma("unroll") for (int bj = 0; bj < 2; ++bj) { const int ai = (st_) >> 1, m = 2 * ((st_) & 1) + mm; \
            const size_t off_ = (size_t)(row0 + ai * HALF + m * 16) * 1024 + col0 + bj * HALF; const u32x4 g = gv[b_][mm][bj]; \
            f32x4 v0 = acc[ai][bj][m][0], v1 = acc[ai][bj][m][1]; \
            v0[0] *= bf_lo(g.x); v0[1] *= bf_hi(g.x); v0[2] *= bf_lo(g.y); v0[3] *= bf_hi(g.y); v1[0] *= bf_lo(g.z); v1[1] *= bf_hi(g.z); v1[2] *= bf_lo(g.w); v1[3] *= bf_hi(g.w); \
            if (MODE == 1) { const u32x4 p = pv[b_][mm][bj]; \
                v0[0] += bf_lo(p.x); v0[1] += bf_hi(p.x); v0[2] += bf_lo(p.y); v0[3] += bf_hi(p.y); v1[0] += bf_lo(p.z); v1[1] += bf_hi(p.z); v1[2] += bf_lo(p.w); v1[3] += bf_hi(p.w); } \
            u32x4 w; w.x = cvt_pk_bf16(v0[0], v0[1]); w.y = cvt_pk_bf16(v0[2], v0[3]); w.z = cvt_pk_bf16(v1[0], v1[1]); w.w = cvt_pk_bf16(v1[2], v1[3]); \
            *(u32x4*)(O + off_) = w; } } while (0)
        EG_LOAD(0, 0); EG_LOAD(1, 1); EG_DO(0, 0); EG_LOAD(2, 0); EG_DO(1, 1); EG_LOAD(3, 1); EG_DO(2, 0); EG_DO(3, 1);
#undef EG_LOAD
#undef EG_DO
    }
};
struct TwoGemmOrder {
    StaticOrder base; int n1;
    __device__ void init(int M, int N, int G_, int c_) { base.init(M, N, G_, c_); n1 = (base.nwg - c_ + G_ - 1) / G_; if (n1 < 0) n1 = 0; }
    __device__ __forceinline__ bool next(int i, Unit& u) const { if (i >= 2 * n1) return false; const bool second = i >= n1; base.next(second ? i - n1 : i, u); if (second) { u.pm += 128; u.pn += 4; } return true; }
    __device__ __forceinline__ void a_ready(const Unit&) const {}
    __device__ __forceinline__ void done(const Unit&) const {}
};
struct EpiGate2 {
    static constexpr bool PERM = true, AFTER_DRAIN = false; static constexpr int NSTORES = 16;
    const bf16_t* G0; const bf16_t* G1; bf16_t* O;
    __device__ __forceinline__ void operator()(const f32x4 (&acc)[2][2][4][2], const Unit& u, int wr, int wc, int fr, int fq) const {
        Unit v; v.pm = u.pm & 127; v.pn = u.pn & 3;
        if (u.pm >= 128) { EpiGate<1> e{G1, O}; e(acc, v, wr, wc, fr, fq); } else { EpiGate<0> e{G0, O}; e(acc, v, wr, wc, fr, fq); }
    }
};
struct EpiDelta {
    static constexpr bool PERM = true, AFTER_DRAIN = false; static constexpr int NSTORES = 16;
    bf16_t* O;
    __device__ __forceinline__ void operator()(const f32x4 (&acc)[2][2][4][2], const Unit& u, int wr, int wc, int fr, int fq) const {
        const int row0 = u.pm * BM + wr * 64 + fr, col0 = u.pn * BM + wc * 32 + 8 * fq;
#pragma unroll
        for (int ai = 0; ai < 2; ++ai)
#pragma unroll
            for (int m = 0; m < 4; ++m) { bf16_t* rowp = O + (size_t)(row0 + ai * HALF + m * 16) * 1024 + col0;
#pragma unroll
                for (int bj = 0; bj < 2; ++bj) { const f32x4 v0 = acc[ai][bj][m][0], v1 = acc[ai][bj][m][1];
                    u32x4 w; w.x = cvt_pk_bf16(v0[0], v0[1]); w.y = cvt_pk_bf16(v0[2], v0[3]); w.z = cvt_pk_bf16(v1[0], v1[1]); w.w = cvt_pk_bf16(v1[2], v1[3]);
                    *(u32x4*)(rowp + bj * HALF) = w; } }
    }
};
struct EpiSwiGLU {
    static constexpr bool PERM = true, AFTER_DRAIN = false; static constexpr int NSTORES = 8;
    unsigned char* HB;
    __device__ __forceinline__ void operator()(const f32x4 (&acc)[2][2][4][2], const Unit& u, int wr, int wc, int fr, int fq, const PG8_LAS int* rows) const {
        const int row0 = u.pm * BM + wr * 64 + fr, col0 = (u.pn & 3) * HALF + wc * 32 + 8 * fq;
        float sv[2][4];
#pragma unroll
        for (int ai = 0; ai < 2; ++ai)
#pragma unroll
            for (int m = 0; m < 4; ++m) sv[ai][m] = ((const PG8_LAS float*)rows)[6 * 256 + wr * 64 + fr + ai * HALF + m * 16] * (1.0f / W13_SCALE);
#pragma unroll
        for (int ai = 0; ai < 2; ++ai)
#pragma unroll
            for (int m = 0; m < 4; ++m) { const int row = row0 + ai * HALF + m * 16; const float s = sv[ai][m];
                float o[8];
#pragma unroll
                for (int n = 0; n < 2; ++n)
#pragma unroll
                    for (int i = 0; i < 4; ++i) { const float g = acc[ai][0][m][n][i] * s, uu = acc[ai][1][m][n][i] * s; o[n * 4 + i] = g * sigmoid_f(g) * uu * HB_SCALE; }
                unsigned long long w = (unsigned long long)pack4_fp8(o[0], o[1], o[2], o[3]) | ((unsigned long long)pack4_fp8(o[4], o[5], o[6], o[7]) << 32);
                *(unsigned long long*)(HB + (size_t)row * 512 + col0) = w; }
    }
};
constexpr float Y_SCALE = 0.25f;
struct EpiY {
    static constexpr bool PERM = true, AFTER_DRAIN = false; static constexpr int NSTORES = 16;
    unsigned char* Y;
    __device__ __forceinline__ void operator()(const f32x4 (&acc)[2][2][4][2], const Unit& u, int wr, int wc, int fr, int fq) const {
        const int row0 = u.pm * BM + wr * 64 + fr, col0 = (u.pn & 3) * BM + wc * 32 + 8 * fq;
#pragma unroll
        for (int ai = 0; ai < 2; ++ai)
#pragma unroll
            for (int m = 0; m < 4; ++m) { const int row = row0 + ai * HALF + m * 16; unsigned char* rowp = Y + (size_t)row * 1024 + col0;
#pragma unroll
                for (int bj = 0; bj < 2; ++bj) { const f32x4 v0 = acc[ai][bj][m][0] * Y_SCALE, v1 = acc[ai][bj][m][1] * Y_SCALE;
                    *(unsigned long long*)(rowp + bj * HALF) = (unsigned long long)pack4_fp8(v0[0], v0[1], v0[2], v0[3]) | ((unsigned long long)pack4_fp8(v1[0], v1[1], v1[2], v1[3]) << 32); } }
    }
};
struct GroupedOrder {
    const PG8_LAS int* tile_e; int nunits, G, c;
    __device__ __forceinline__ bool next(int i, Unit& u) const { const int L = i * G + c; if (L >= nunits) return false; u.pm = L >> 2; u.pn = __builtin_amdgcn_readfirstlane(tile_e[u.pm]) * 4 + (L & 3); return true; }
    __device__ __forceinline__ void a_ready(const Unit&) const {}
    __device__ __forceinline__ void done(const Unit&) const {}
};
template <class Epi, class Sched, bool ALIGN_EPI = false, bool SP2 = false, bool F8 = false>
__device__ __forceinline__ void gemm_phase(PG8_LAS unsigned char* lds, const Gemm g, const Sched& S, const Epi& E, const int wid) {
    const int lane = lane_now(), tid = wid * 64 + lane, wr = wid >> 2, wc = wid & 3, fr = lane & 15, fq = lane >> 4;
    const int K = g.K, nt = K / BK;
    unsigned voffA[2], voffB[2];
#pragma unroll
    for (int i = 0; i < 2; ++i) { int R, C; stage_rc(tid * 16 + i * 8192, R, C); const int Rb = Epi::PERM ? ((R & ~31) + perm32(R & 31)) : R;
        voffA[i] = (unsigned)(R * K + C) * 2u; voffB[i] = (unsigned)(Rb * K + C) * 2u; }
    const size_t kstep = (size_t)(BK * 2);
    const size_t hstep = (size_t)HALF * K * 2;
    const size_t tstep = 2 * hstep;
    const unsigned ldsw = (unsigned)wid * 1024u;
    const unsigned ldsbase = (unsigned)__builtin_amdgcn_readfirstlane((int)((unsigned)(uintptr_t)lds + ldsw));
    const int aoff = lds_byte(wr * 64 + fr, fq * 8), boff = lds_byte(wc * 32 + fr, fq * 8);
#define PG8_SA(b, h) (((b) * 2 + (h)) * HTB)
#define PG8_SB(b, h) ((4 + (b) * 2 + (h)) * HTB)
#define PG8_STAGE(bufoff, gbase, voff) do { _Pragma("unroll") for (int _i = 0; _i < 2; ++_i) { \
        if constexpr (F8) glds_sv((const char*)(gbase), (voff)[_i], ldsbase + (unsigned)((bufoff) + _i * 8192)); \
        else __builtin_amdgcn_global_load_lds((const unsigned*)((const char*)(gbase) + (voff)[_i]), (PG8_LAS unsigned*)(lds + (bufoff) + ldsw + _i * 8192), 16, 0, 0); } } while (0)
#define PG8_LDA(dst, b, h) do { _Pragma("unroll") for (int m = 0; m < 4; ++m) { \
        if constexpr (F8) { dst##8[m] = cat8(*(const PG8_LAS bf16x8*)(lds + PG8_SA(b, h) + aoff + m * 2048), *(const PG8_LAS bf16x8*)(lds + PG8_SA(b, h) + aoff + m * 2048 + 1024)); } \
        else { _Pragma("unroll") for (int k = 0; k < 2; ++k) dst[m][k] = *(const PG8_LAS bf16x8*)(lds + PG8_SA(b, h) + aoff + m * 2048 + k * 1024); } } } while (0)
#define PG8_LDB(dst, b, h) do { _Pragma("unroll") for (int n = 0; n < 2; ++n) { \
        if constexpr (F8) { dst##8[n] = cat8(*(const PG8_LAS bf16x8*)(lds + PG8_SB(b, h) + boff + n * 2048), *(const PG8_LAS bf16x8*)(lds + PG8_SB(b, h) + boff + n * 2048 + 1024)); } \
        else { _Pragma("unroll") for (int k = 0; k < 2; ++k) dst[n][k] = *(const PG8_LAS bf16x8*)(lds + PG8_SB(b, h) + boff + n * 2048 + k * 1024); } } } while (0)
#define PG8_MMA(ai, bj, At, Bt) do { __builtin_amdgcn_s_setprio(1); _Pragma("unroll") for (int m = 0; m < 4; ++m) _Pragma("unroll") for (int n = 0; n < 2; ++n) { \
        if constexpr (F8) { acc[ai][bj][m][n] = __builtin_amdgcn_mfma_scale_f32_16x16x128_f8f6f4(Bt##8[n], At##8[m], acc[ai][bj][m][n], 0, 0, 0, 0, 0, 0); } \
        else { _Pragma("unroll") for (int k = 0; k < 2; ++k) acc[ai][bj][m][n] = __builtin_amdgcn_mfma_f32_16x16x32_bf16(Bt[n][k], At[m][k], acc[ai][bj][m][n], 0, 0, 0); } } \
        __builtin_amdgcn_s_setprio(0); } while (0)
#define PG8_WAIT_V(n) asm volatile("s_waitcnt vmcnt(" #n ")" ::: "memory")
#define PG8_WAIT_L(n) asm volatile("s_waitcnt lgkmcnt(" #n ")" ::: "memory")
#define PG8_BAR __builtin_amdgcn_s_barrier()
#define PG8_SCHED __builtin_amdgcn_sched_barrier(0)
    Unit cur, nxt; int ui = 0;
    if (!S.next(0, cur)) return;
    f32x4 acc[2][2][4][2];
#pragma unroll
    for (int a = 0; a < 2; ++a)
#pragma unroll
        for (int b = 0; b < 2; ++b)
#pragma unroll
            for (int m = 0; m < 4; ++m)
#pragma unroll
                for (int n = 0; n < 2; ++n) acc[a][b][m][n] = (f32x4){0.f, 0.f, 0.f, 0.f};
    bf16x8 At[4][2], B0[2][2], B1[2][2]; v8i_t At8[4], B08[2], B18[2];
    const char* cA = (const char*)g.A + (size_t)cur.pm * tstep; const char* cB = (const char*)g.Bt + (size_t)cur.pn * tstep;
    S.a_ready(cur);
    if constexpr (SP2) {
        PG8_STAGE(PG8_SB(0, 0), cB, voffB); PG8_STAGE(PG8_SB(0, 1), cB + hstep, voffB); PG8_STAGE(PG8_SA(0, 0), cA, voffA); PG8_STAGE(PG8_SA(0, 1), cA + hstep, voffA);
        if (wr == 1) PG8_BAR;
        PG8_WAIT_V(2); PG8_BAR;
        PG8_STAGE(PG8_SB(1, 0), cB + kstep, voffB); PG8_STAGE(PG8_SA(1, 0), cA + kstep, voffA); PG8_STAGE(PG8_SB(1, 1), cB + hstep + kstep, voffB);
        PG8_WAIT_V(6); PG8_BAR;
    } else {
        PG8_STAGE(PG8_SB(0, 0), cB, voffB); PG8_STAGE(PG8_SA(0, 0), cA, voffA); PG8_STAGE(PG8_SB(0, 1), cB + hstep, voffB); PG8_STAGE(PG8_SA(0, 1), cA + hstep, voffA);
        if (wr == 1) PG8_BAR;
        PG8_WAIT_V(4); PG8_BAR;
        PG8_STAGE(PG8_SB(1, 0), cB + kstep, voffB); PG8_STAGE(PG8_SA(1, 0), cA + kstep, voffA); PG8_STAGE(PG8_SB(1, 1), cB + hstep + kstep, voffB);
        PG8_WAIT_V(6); PG8_BAR;
    }
    for (;;) {
        const bool has_next = S.next(ui + 1, nxt);
        const char* nA = has_next ? (const char*)g.A + (size_t)nxt.pm * tstep : cA; const char* nB = has_next ? (const char*)g.Bt + (size_t)nxt.pn * tstep : cB;
#pragma clang loop unroll(disable)
        for (int t = 0; t < nt; t += 2) {
            const bool last = (t == nt - 2);
            const char* a1 = cA + (size_t)(t + 1) * kstep;
            const char* a2 = last ? nA : cA + (size_t)(t + 2) * kstep; const char* b2 = last ? nB : cB + (size_t)(t + 2) * kstep;
            const char* a3 = a2 + kstep; const char* b3 = b2 + kstep;
            if (last && has_next) S.a_ready(nxt);
            if constexpr (SP2) {
            PG8_LDB(B0, 0, 0); PG8_LDB(B1, 0, 1); PG8_SCHED; PG8_LDA(At, 0, 0); PG8_STAGE(PG8_SA(1, 1), a1 + hstep, voffA);
            PG8_WAIT_V(8); PG8_WAIT_L(0); PG8_BAR; PG8_MMA(0, 0, At, B0); PG8_MMA(0, 1, At, B1); PG8_BAR; PG8_SCHED;
            PG8_LDA(At, 0, 1); PG8_STAGE(PG8_SB(0, 0), b2, voffB); PG8_STAGE(PG8_SB(0, 1), b2 + hstep, voffB); PG8_STAGE(PG8_SA(0, 0), a2, voffA);
            PG8_WAIT_V(8); PG8_WAIT_L(0); PG8_BAR; PG8_MMA(1, 0, At, B0); PG8_MMA(1, 1, At, B1); PG8_BAR; PG8_SCHED;
            PG8_LDB(B0, 1, 0); PG8_LDB(B1, 1, 1); PG8_SCHED; PG8_LDA(At, 1, 0); PG8_STAGE(PG8_SA(0, 1), a2 + hstep, voffA);
            PG8_WAIT_V(8); PG8_WAIT_L(0); PG8_BAR; PG8_MMA(0, 0, At, B0); PG8_MMA(0, 1, At, B1); PG8_BAR; PG8_SCHED;
            PG8_LDA(At, 1, 1); PG8_STAGE(PG8_SB(1, 0), b3, voffB); PG8_STAGE(PG8_SB(1, 1), b3 + hstep, voffB); PG8_STAGE(PG8_SA(1, 0), a3, voffA);
            PG8_WAIT_V(8); PG8_WAIT_L(0); PG8_BAR; PG8_MMA(1, 0, At, B0); PG8_MMA(1, 1, At, B1); PG8_BAR; PG8_SCHED;
            } else {
            PG8_LDB(B0, 0, 0); PG8_SCHED; PG8_LDA(At, 0, 0); PG8_STAGE(PG8_SA(1, 1), a1 + hstep, voffA);
            PG8_WAIT_L(8); PG8_BAR; PG8_WAIT_L(0); PG8_MMA(0, 0, At, B0); PG8_BAR; PG8_SCHED;
            PG8_LDB(B1, 0, 1); PG8_STAGE(PG8_SB(0, 0), b2, voffB);
            PG8_BAR; PG8_WAIT_L(0); PG8_MMA(0, 1, At, B1); PG8_BAR;
            PG8_LDA(At, 0, 1); PG8_STAGE(PG8_SA(0, 0), a2, voffA);
            PG8_BAR; PG8_WAIT_L(0); PG8_MMA(1, 0, At, B0); PG8_BAR; PG8_SCHED;
            PG8_STAGE(PG8_SB(0, 1), b2 + hstep, voffB);
            PG8_WAIT_V(6); PG8_BAR; PG8_MMA(1, 1, At, B1); PG8_BAR;
            PG8_LDB(B0, 1, 0); PG8_SCHED; PG8_LDA(At, 1, 0); PG8_STAGE(PG8_SA(0, 1), a2 + hstep, voffA);
            PG8_WAIT_L(8); PG8_BAR; PG8_WAIT_L(0); PG8_MMA(0, 0, At, B0); PG8_BAR; PG8_SCHED;
            PG8_LDB(B1, 1, 1); PG8_STAGE(PG8_SB(1, 0), b3, voffB);
            PG8_BAR; PG8_WAIT_L(0); PG8_MMA(0, 1, At, B1); PG8_BAR;
            PG8_LDA(At, 1, 1); PG8_STAGE(PG8_SA(1, 0), a3, voffA);
            PG8_BAR; PG8_WAIT_L(0); PG8_MMA(1, 0, At, B0); PG8_BAR; PG8_SCHED;
            PG8_STAGE(PG8_SB(1, 1), b3 + hstep, voffB);
            PG8_WAIT_V(6); PG8_BAR; PG8_MMA(1, 1, At, B1); PG8_BAR;
            }
        }
        if constexpr (ALIGN_EPI) { if (wr == 0) PG8_BAR; }
        if constexpr (!Epi::AFTER_DRAIN) { const int l2 = lane_now(); E(acc, cur, wr, wc, l2 & 15, l2 >> 4); S.done(cur); }
        if (!has_next) break;
#pragma unroll
        for (int a = 0; a < 2; ++a)
#pragma unroll
            for (int b = 0; b < 2; ++b)
#pragma unroll
                for (int m = 0; m < 4; ++m)
#pragma unroll
                    for (int n = 0; n < 2; ++n) acc[a][b][m][n] = (f32x4){0.f, 0.f, 0.f, 0.f};
        cur = nxt; cA = nA; cB = nB; ++ui;
        if constexpr (ALIGN_EPI) { if (wr == 1) PG8_BAR; }
    }
    PG8_WAIT_V(0);
    if constexpr (!ALIGN_EPI) { if (wr == 0) PG8_BAR; }
    PG8_BAR;
    if constexpr (Epi::AFTER_DRAIN) { E.fused(acc, cur, wr, wc, fr, fq, lds, wid, lane); S.done(cur); }
#undef PG8_SA
#undef PG8_SB
#undef PG8_STAGE
#undef PG8_LDA
#undef PG8_LDB
#undef PG8_MMA
#undef PG8_WAIT_V
#undef PG8_WAIT_L
#undef PG8_BAR
#undef PG8_SCHED
}
template <class Epi, class Sched, bool F8 = false>
__device__ __forceinline__ void gemm_phase_gather(PG8_LAS unsigned char* lds, const Gemm g, const Sched& S, const Epi& E, const PG8_LAS int* rowtab, const int wid) {
    constexpr bool ALIGN_EPI = true, SP2 = true;
    const int lane = lane_now(), tid = wid * 64 + lane, wr = wid >> 2, wc = wid & 3, fr = lane & 15, fq = lane >> 4;
    const int K = g.K, nt = K / BK;
    unsigned voffB[2], vAc[2][2];
#pragma unroll
    for (int i = 0; i < 2; ++i) { int R, C; stage_rc(tid * 16 + i * 8192, R, C); const int Rb = Epi::PERM ? ((R & ~31) + perm32(R & 31)) : R;
        voffB[i] = (unsigned)(Rb * K + C) * 2u; }
#define PG8_ROWS(dst, ui_) do { const int t_ = wid * 64 + lane_now(); _Pragma("unroll") for (int i_ = 0; i_ < 2; ++i_) { int R_, C_; stage_rc(t_ * 16 + i_ * 8192, R_, C_); \
        _Pragma("unroll") for (int h_ = 0; h_ < 2; ++h_) dst[h_][i_] = (unsigned)rowtab[(ui_) * 256 + h_ * HALF + R_] * (unsigned)(K * 2) + (unsigned)(C_ * 2); } } while (0)
#define PG8_STAGE_A(bufoff, v, kb) do { _Pragma("unroll") for (int _i = 0; _i < 2; ++_i) { \
        if constexpr (F8) glds_sv((const char*)g.A + (kb), (v)[_i], ldsbase + (unsigned)((bufoff) + _i * 8192)); \
        else __builtin_amdgcn_global_load_lds((const unsigned*)((const char*)g.A + (v)[_i] + (kb)), (PG8_LAS unsigned*)(lds + (bufoff) + ldsw + _i * 8192), 16, 0, 0); } } while (0)
    const size_t kstep = (size_t)(BK * 2);
    const size_t hstep = (size_t)HALF * K * 2;
    const size_t tstep = 2 * hstep;
    const unsigned ldsw = (unsigned)wid * 1024u;
    const unsigned ldsbase = (unsigned)__builtin_amdgcn_readfirstlane((int)((unsigned)(uintptr_t)lds + ldsw));
    const int aoff = lds_byte(wr * 64 + fr, fq * 8), boff = lds_byte(wc * 32 + fr, fq * 8);
#define PG8_SA(b, h) (((b) * 2 + (h)) * HTB)
#define PG8_SB(b, h) ((4 + (b) * 2 + (h)) * HTB)
#define PG8_STAGE(bufoff, gbase, voff) do { _Pragma("unroll") for (int _i = 0; _i < 2; ++_i) { \
        if constexpr (F8) glds_sv((const char*)(gbase), (voff)[_i], ldsbase + (unsigned)((bufoff) + _i * 8192)); \
        else __builtin_amdgcn_global_load_lds((const unsigned*)((const char*)(gbase) + (voff)[_i]), (PG8_LAS unsigned*)(lds + (bufoff) + ldsw + _i * 8192), 16, 0, 0); } } while (0)
#define PG8_LDA(dst, b, h) do { _Pragma("unroll") for (int m = 0; m < 4; ++m) { \
        if constexpr (F8) { dst##8[m] = cat8(*(const PG8_LAS bf16x8*)(lds + PG8_SA(b, h) + aoff + m * 2048), *(const PG8_LAS bf16x8*)(lds + PG8_SA(b, h) + aoff + m * 2048 + 1024)); } \
        else { _Pragma("unroll") for (int k = 0; k < 2; ++k) dst[m][k] = *(const PG8_LAS bf16x8*)(lds + PG8_SA(b, h) + aoff + m * 2048 + k * 1024); } } } while (0)
#define PG8_LDB(dst, b, h) do { _Pragma("unroll") for (int n = 0; n < 2; ++n) { \
        if constexpr (F8) { dst##8[n] = cat8(*(const PG8_LAS bf16x8*)(lds + PG8_SB(b, h) + boff + n * 2048), *(const PG8_LAS bf16x8*)(lds + PG8_SB(b, h) + boff + n * 2048 + 1024)); } \
        else { _Pragma("unroll") for (int k = 0; k < 2; ++k) dst[n][k] = *(const PG8_LAS bf16x8*)(lds + PG8_SB(b, h) + boff + n * 2048 + k * 1024); } } } while (0)
#define PG8_MMA(ai, bj, At, Bt) do { __builtin_amdgcn_s_setprio(1); _Pragma("unroll") for (int m = 0; m < 4; ++m) _Pragma("unroll") for (int n = 0; n < 2; ++n) { \
        if constexpr (F8) { acc[ai][bj][m][n] = __builtin_amdgcn_mfma_scale_f32_16x16x128_f8f6f4(Bt##8[n], At##8[m], acc[ai][bj][m][n], 0, 0, 0, 0, 0, 0); } \
        else { _Pragma("unroll") for (int k = 0; k < 2; ++k) acc[ai][bj][m][n] = __builtin_amdgcn_mfma_f32_16x16x32_bf16(Bt[n][k], At[m][k], acc[ai][bj][m][n], 0, 0, 0); } } \
        __builtin_amdgcn_s_setprio(0); } while (0)
#define PG8_WAIT_V(n) asm volatile("s_waitcnt vmcnt(" #n ")" ::: "memory")
#define PG8_WAIT_L(n) asm volatile("s_waitcnt lgkmcnt(" #n ")" ::: "memory")
#define PG8_BAR __builtin_amdgcn_s_barrier()
#define PG8_SCHED __builtin_amdgcn_sched_barrier(0)
    Unit cur, nxt; int ui = 0;
    if (!S.next(0, cur)) return;
    f32x4 acc[2][2][4][2];
#pragma unroll
    for (int a = 0; a < 2; ++a)
#pragma unroll
        for (int b = 0; b < 2; ++b)
#pragma unroll
            for (int m = 0; m < 4; ++m)
#pragma unroll
                for (int n = 0; n < 2; ++n) acc[a][b][m][n] = (f32x4){0.f, 0.f, 0.f, 0.f};
    bf16x8 At[4][2], B0[2][2], B1[2][2]; v8i_t At8[4], B08[2], B18[2];
    const char* cB = (const char*)g.Bt + (size_t)cur.pn * tstep;
    PG8_ROWS(vAc, 0);
    S.a_ready(cur);
    if constexpr (SP2) {
        PG8_STAGE(PG8_SB(0, 0), cB, voffB); PG8_STAGE(PG8_SB(0, 1), cB + hstep, voffB); PG8_STAGE_A(PG8_SA(0, 0), vAc[0], 0u); PG8_STAGE_A(PG8_SA(0, 1), vAc[1], 0u);
        if (wr == 1) PG8_BAR;
        PG8_WAIT_V(2); PG8_BAR;
        PG8_STAGE(PG8_SB(1, 0), cB + kstep, voffB); PG8_STAGE_A(PG8_SA(1, 0), vAc[0], (unsigned)kstep); PG8_STAGE(PG8_SB(1, 1), cB + hstep + kstep, voffB);
        PG8_WAIT_V(6); PG8_BAR;
    }
    for (;;) {
        const bool has_next = S.next(ui + 1, nxt);
        const char* nB = has_next ? (const char*)g.Bt + (size_t)nxt.pn * tstep : cB;
#pragma clang loop unroll(disable)
        for (int t = 0; t < nt; t += 2) {
            const bool last = (t == nt - 2);
            const unsigned k1 = (unsigned)((t + 1) * (int)kstep), k2 = last ? 0u : (unsigned)((t + 2) * (int)kstep), k3 = k2 + (unsigned)kstep;
            unsigned v2[2][2];
            if (last && has_next) { PG8_ROWS(v2, ui + 1); }
            else {
#pragma unroll
                for (int h_ = 0; h_ < 2; ++h_)
#pragma unroll
                    for (int i_ = 0; i_ < 2; ++i_) v2[h_][i_] = vAc[h_][i_]; }
            const char* b2 = last ? nB : cB + (size_t)(t + 2) * kstep; const char* b3 = b2 + kstep;
            if (last && has_next) S.a_ready(nxt);
            if constexpr (SP2) {
            PG8_LDB(B0, 0, 0); PG8_LDB(B1, 0, 1); PG8_SCHED; PG8_LDA(At, 0, 0); PG8_STAGE_A(PG8_SA(1, 1), vAc[1], k1);
            PG8_WAIT_V(8); PG8_WAIT_L(0); PG8_BAR; PG8_MMA(0, 0, At, B0); PG8_MMA(0, 1, At, B1); PG8_BAR; PG8_SCHED;
            PG8_LDA(At, 0, 1); PG8_STAGE(PG8_SB(0, 0), b2, voffB); PG8_STAGE(PG8_SB(0, 1), b2 + hstep, voffB); PG8_STAGE_A(PG8_SA(0, 0), v2[0], k2);
            PG8_WAIT_V(8); PG8_WAIT_L(0); PG8_BAR; PG8_MMA(1, 0, At, B0); PG8_MMA(1, 1, At, B1); PG8_BAR; PG8_SCHED;
            PG8_LDB(B0, 1, 0); PG8_LDB(B1, 1, 1); PG8_SCHED; PG8_LDA(At, 1, 0); PG8_STAGE_A(PG8_SA(0, 1), v2[1], k2);
            PG8_WAIT_V(8); PG8_WAIT_L(0); PG8_BAR; PG8_MMA(0, 0, At, B0); PG8_MMA(0, 1, At, B1); PG8_BAR; PG8_SCHED;
            PG8_LDA(At, 1, 1); PG8_STAGE(PG8_SB(1, 0), b3, voffB); PG8_STAGE(PG8_SB(1, 1), b3 + hstep, voffB); PG8_STAGE_A(PG8_SA(1, 0), v2[0], k3);
            PG8_WAIT_V(8); PG8_WAIT_L(0); PG8_BAR; PG8_MMA(1, 0, At, B0); PG8_MMA(1, 1, At, B1); PG8_BAR; PG8_SCHED;
            }
        }
        if constexpr (ALIGN_EPI) { if (wr == 0) PG8_BAR; }
        { const int l2 = lane_now(); E(acc, cur, wr, wc, l2 & 15, l2 >> 4, rowtab + ui * 256); } S.done(cur);
        if (!has_next) break;
#pragma unroll
        for (int a = 0; a < 2; ++a)
#pragma unroll
            for (int b = 0; b < 2; ++b)
#pragma unroll
                for (int m = 0; m < 4; ++m)
#pragma unroll
                    for (int n = 0; n < 2; ++n) acc[a][b][m][n] = (f32x4){0.f, 0.f, 0.f, 0.f};
        cur = nxt; cB = nB; ++ui;
        PG8_ROWS(vAc, ui);
        if constexpr (ALIGN_EPI) { if (wr == 1) PG8_BAR; }
    }
    PG8_WAIT_V(0);
    if constexpr (!ALIGN_EPI) { if (wr == 0) PG8_BAR; }
    PG8_BAR;
#undef PG8_ROWS
#undef PG8_STAGE_A
#undef PG8_SA
#undef PG8_SB
#undef PG8_STAGE
#undef PG8_LDA
#undef PG8_LDB
#undef PG8_MMA
#undef PG8_WAIT_V
#undef PG8_WAIT_L
#undef PG8_BAR
#undef PG8_SCHED
}
}
#define GAS __attribute__((address_space(1)))
#define LAS __attribute__((address_space(3)))
typedef unsigned short bf16;
typedef unsigned v4u __attribute__((ext_vector_type(4)));
typedef float f32x4 __attribute__((ext_vector_type(4)));
typedef short bf16x8 __attribute__((ext_vector_type(8)));
typedef GAS unsigned gu32;
typedef GAS unsigned long long gu64;
#define RLX_AGENT __ATOMIC_RELAXED, __HIP_MEMORY_SCOPE_AGENT
#define LDS_WAIT() asm volatile("s_waitcnt lgkmcnt(0)" ::: "memory")
#define VM_WAIT() asm volatile("s_waitcnt vmcnt(0)" ::: "memory")
__device__ __forceinline__ unsigned long long rt() { return __builtin_amdgcn_s_memrealtime(); }
__device__ __forceinline__ unsigned f2bf(float f) { unsigned u = __builtin_bit_cast(unsigned, f); return (u + 0x7fffu + ((u >> 16) & 1u)) >> 16; }
__device__ __forceinline__ unsigned pk2(float lo, float hi) { return f2bf(lo) | (f2bf(hi) << 16); }
#define XB_TMO      128
#define XB_XCNT(j)  (256  + 64 * (j))
#define XB_XSUB(j)  (1280 + 64 * (j))
#define XB_XGEN(j)  (2304 + 64 * (j))
#define XB_TOP      3328
#define XB_TOPGEN   3392
#define XCD_BAR_WORDS 3456
#define XB_SPIN_CAP (1u << 18)

__device__ __forceinline__ unsigned xb_ld(unsigned* p)              { return __hip_atomic_load(p, __ATOMIC_RELAXED, __HIP_MEMORY_SCOPE_AGENT); }
__device__ __forceinline__ unsigned xb_add(unsigned* p, unsigned v) { return __hip_atomic_fetch_add(p, v, __ATOMIC_RELAXED, __HIP_MEMORY_SCOPE_AGENT); }
__device__ __forceinline__ unsigned xb_xcc_id() { return (unsigned)__builtin_amdgcn_s_getreg((3 << 11) | 20) & 0xFu; }
#define XB_SPIN(cond, bar) do { unsigned _sp = 0; while (cond) { __builtin_amdgcn_s_sleep(1); \
    if ((++_sp & 255u) == 0u) { if (xb_ld(&(bar)[XB_TMO])) break; if (_sp > XB_SPIN_CAP) { atomicAdd(&(bar)[XB_TMO], 1u); break; } } } } while (0)

struct XcdBarrier {
    unsigned* bar; unsigned x;
    volatile LAS unsigned* st;
};

__device__ __forceinline__ XcdBarrier xcd_barrier_post(unsigned* bar, volatile LAS unsigned* st) {
    XcdBarrier b; b.bar = bar; b.x = xb_xcc_id(); b.st = st;
    if (threadIdx.x == 0) (void)xb_add(&bar[XB_XCNT(b.x)], 1u);
    return b;
}
__device__ __forceinline__ void xcd_barrier_complete(unsigned* bar, unsigned x, unsigned& nloc, unsigned& nx) {
    const unsigned G = gridDim.x * gridDim.y * gridDim.z;
    unsigned sum, cnt, mine, sp = 0u;
    for (;;) {
        sum = 0u; cnt = 0u; mine = 0u;
#pragma unroll
        for (unsigned j = 0; j < 16; ++j) { const unsigned c = xb_ld(&bar[XB_XCNT(j)]); sum += c; cnt += (c > 0u) ? 1u : 0u; mine = (j == x) ? c : mine; }
        if (sum == G) break;
        __builtin_amdgcn_s_sleep(1);
        if ((++sp & 255u) == 0u) { if (xb_ld(&bar[XB_TMO])) break; if (sp > XB_SPIN_CAP) { atomicAdd(&bar[XB_TMO], 1u); break; } }
    }
    nloc = mine > 0u ? mine : 1u; nx = cnt > 0u ? cnt : 1u;
}

__device__ __forceinline__ void xcd_barrier(const XcdBarrier& b) {
    asm volatile("s_waitcnt vmcnt(0)" ::: "memory");
    __syncthreads();
    if (threadIdx.x == 0) {
        unsigned* bar = b.bar;
        __builtin_amdgcn_s_waitcnt(0);
        unsigned nloc = b.st[0], nx = b.st[1];
        if (nloc == 0u) { xcd_barrier_complete(bar, b.x, nloc, nx); b.st[0] = nloc; b.st[1] = nx; }
        const unsigned old = xb_add(&bar[XB_XSUB(b.x)], 1u);
        const unsigned gen = old / nloc;
        if (old + 1u == (gen + 1u) * nloc) {
            __builtin_amdgcn_fence(__ATOMIC_RELEASE, "agent");
            asm volatile("s_waitcnt vmcnt(0)" ::: "memory");
            const unsigned og = xb_add(&bar[XB_TOP], 1u);
            const unsigned tg = og / nx;
            if (og + 1u == (tg + 1u) * nx) xb_add(&bar[XB_TOPGEN], 1u);
            else XB_SPIN(xb_ld(&bar[XB_TOPGEN]) == tg, bar);
            __builtin_amdgcn_fence(__ATOMIC_ACQUIRE, "agent");
            xb_add(&bar[XB_XGEN(b.x)], 1u);
            asm volatile("s_waitcnt vmcnt(0)" ::: "memory");
        } else {
            XB_SPIN(xb_ld(&bar[XB_XGEN(b.x)]) == gen, bar);
            __builtin_amdgcn_fence(__ATOMIC_ACQUIRE, "agent");
            asm volatile("s_waitcnt vmcnt(0)" ::: "memory");
        }
    }
    __syncthreads();
}
namespace fattn {
typedef unsigned short bf16;
typedef short bf16x8 __attribute__((ext_vector_type(8)));
typedef short s16x4 __attribute__((ext_vector_type(4)));
typedef float f32x16 __attribute__((ext_vector_type(16)));
typedef float f32x4 __attribute__((ext_vector_type(4)));
typedef unsigned u32x4 __attribute__((ext_vector_type(4)));
constexpr int D = 128, LD = 128, LDO = 1024, SEQ = 4096;
constexpr float THR = 8.f;
constexpr float SCALE = 0.08838834764831845f;
constexpr int NW = 8, QBLK = 32, KVBLK = 64, QB = NW * QBLK;
constexpr int SHM_V = KVBLK * D * 2, SHM_K = KVBLK * D * 2;
constexpr int OFF_WS = 2 * SHM_V + 2 * SHM_K, OFF_BIAS = OFF_WS + NW * 64 * 4, LDS_BYTES = OFF_BIAS + 2 * 64 * 4;

#define KSWZ(row, colB) ((row) * 256 + ((colB) ^ (((row) & 7) << 4)))
#define SBAR() __builtin_amdgcn_sched_barrier(0)
__device__ __forceinline__ int v_st(int k, int c) { const int kk = (k & ~0xC) | ((k & 4) << 1) | ((k & 8) >> 1); return ((kk >> 3) * 4 + (c >> 5)) * 512 + ((kk & 7) * 32 + (c & 31)) * 2; }
__device__ __forceinline__ int v_rd_base(int lane) { return ((lane & 3) << 3) | (((lane >> 2) & 3) << 6) | (((lane >> 4) & 1) << 5) | (((lane >> 5) & 1) << 8); }
constexpr int v_rd_off(int d0, int ks, int half) { return d0 * 512 + ks * 4096 + half * 2048; }
__device__ __forceinline__ int crow(int r, int hi) { return (r & 3) + 8 * (r >> 2) + 4 * hi; }
__device__ __forceinline__ unsigned cvtpk(float lo, float hi) { unsigned r; asm volatile("v_cvt_pk_bf16_f32 %0, %1, %2" : "=v"(r) : "v"(lo), "v"(hi)); return r; }
__device__ __forceinline__ bf16x8 load8(const bf16* p) { return *reinterpret_cast<const bf16x8*>(p); }
__device__ __forceinline__ void mask_tile(f32x16& p0, f32x16& p1, int dq) {
    const float NEG = -__builtin_inff();
#pragma unroll
    for (int r = 0; r < 16; ++r) {
        const int c = (r & 3) + 8 * (r >> 2);
        if (dq - c < 0) p0[r] = NEG;
        if (dq - c - 32 < 0) p1[r] = NEG;
    }
}
__device__ __forceinline__ void partialSM(f32x16& p0, f32x16& p1, float& m_reg, float& mn, float& alpha) {
    float pmax = p0[0]; for (int r = 1; r < 16; ++r) pmax = fmaxf(pmax, p0[r]); for (int r = 0; r < 16; ++r) pmax = fmaxf(pmax, p1[r]);
    { auto rr = __builtin_amdgcn_permlane32_swap(__float_as_uint(pmax), __float_as_uint(pmax), false, false);
      pmax = fmaxf(__uint_as_float(rr[0]), __uint_as_float(rr[1])); }
    constexpr float C2 = 1.4426950408889634f * SCALE;
    if (__builtin_expect(__all((pmax - m_reg) * SCALE <= THR), 1)) { mn = m_reg; alpha = 1.f; }
    else { mn = fmaxf(m_reg, pmax); alpha = __builtin_amdgcn_exp2f((m_reg - mn) * C2); m_reg = mn; }
    const float mnL = -mn * C2;
    for (int r = 0; r < 16; ++r) p0[r] = fmaf(p0[r], C2, mnL); for (int r = 0; r < 16; ++r) p1[r] = fmaf(p1[r], C2, mnL);
    for (int r = 0; r < 16; ++r) p0[r] = __builtin_amdgcn_exp2f(p0[r]);
}
__device__ __forceinline__ void finishSM(f32x16& p0, f32x16& p1, float alpha, float& l_reg, bf16x8& pa0, bf16x8& pa1, bf16x8& pa2, bf16x8& pa3) {
    for (int r = 0; r < 16; ++r) p1[r] = __builtin_amdgcn_exp2f(p1[r]);
    float ps = 0; for (int r = 0; r < 16; ++r) ps += p0[r]; for (int r = 0; r < 16; ++r) ps += p1[r];
    { auto rr = __builtin_amdgcn_permlane32_swap(__float_as_uint(ps), __float_as_uint(ps), false, false);
      ps = __uint_as_float(rr[0]) + __uint_as_float(rr[1]); }
    l_reg = l_reg * alpha + ps;
#define PK4(P, B_, OUT) do { unsigned a0 = cvtpk(P[B_+0], P[B_+1]), a1 = cvtpk(P[B_+2], P[B_+3]);                          \
        unsigned b0 = cvtpk(P[B_+4], P[B_+5]), b1 = cvtpk(P[B_+6], P[B_+7]);                                             \
        auto r0 = __builtin_amdgcn_permlane32_swap(a0, b0, false, false); auto r1 = __builtin_amdgcn_permlane32_swap(a1, b1, false, false); \
        u32x4 w = {r0[0], r1[0], r0[1], r1[1]}; OUT = *reinterpret_cast<bf16x8*>(&w); } while (0)
    PK4(p0, 0, pa0); PK4(p0, 8, pa1); PK4(p1, 0, pa2); PK4(p1, 8, pa3);
#undef PK4
}
template <int KB>
__device__ __forceinline__ void qkt(f32x16& p0, f32x16& p1, const char* K_lds, const char* Bias_lds, int r32, int hi, const bf16x8* qr) {
    { const f32x4* bb = reinterpret_cast<const f32x4*>(Bias_lds + KB * 256 + hi * 16);
      const f32x4 a0 = bb[0], a1 = bb[2], a2 = bb[4], a3 = bb[6], c0 = bb[8], c1 = bb[10], c2 = bb[12], c3 = bb[14];
      p0 = (f32x16){a0[0], a0[1], a0[2], a0[3], a1[0], a1[1], a1[2], a1[3], a2[0], a2[1], a2[2], a2[3], a3[0], a3[1], a3[2], a3[3]};
      p1 = (f32x16){c0[0], c0[1], c0[2], c0[3], c1[0], c1[1], c1[2], c1[3], c2[0], c2[1], c2[2], c2[3], c3[0], c3[1], c3[2], c3[3]}; }
    const char* kb[4];
#pragma unroll
    for (int dd = 0; dd < 4; ++dd) kb[dd] = K_lds + KB * SHM_K + KSWZ(r32, (dd * 16 + hi * 8) * 2);
#pragma unroll
    for (int d0 = 0; d0 < 8; ++d0) { const char* a = kb[d0 & 3] + (d0 >> 2) * 128;
        bf16x8 b0 = *reinterpret_cast<const bf16x8*>(a);
        bf16x8 b1 = *reinterpret_cast<const bf16x8*>(a + 32 * 256);
        p0 = __builtin_amdgcn_mfma_f32_32x32x16_bf16(b0, qr[d0], p0, 0, 0, 0);
        p1 = __builtin_amdgcn_mfma_f32_32x32x16_bf16(b1, qr[d0], p1, 0, 0, 0); }
}
template <int VB>
__device__ __forceinline__ void pv_tile(f32x16* o, int vb0, bf16x8 pa0, bf16x8 pa1, bf16x8 pa2, bf16x8 pa3) {
#define TRRD(dst, off) asm volatile("ds_read_b64_tr_b16 %0, %1 offset:%2" : "=&v"(dst) : "v"(vb0), "i"(off) : "memory")
#define PV_D0(d0) do { s16x4 l0, l1, l2, l3, h0, h1, h2, h3; constexpr int b_ = VB * SHM_V + v_rd_off(d0, 0, 0);   \
        TRRD(l0, b_); TRRD(h0, b_ + 2048); TRRD(l1, b_ + 4096); TRRD(h1, b_ + 6144); TRRD(l2, b_ + 8192); TRRD(h2, b_ + 10240); TRRD(l3, b_ + 12288); TRRD(h3, b_ + 14336); \
        asm volatile("s_waitcnt lgkmcnt(0)" ::: "memory"); SBAR();                                                    \
        o[d0] = __builtin_amdgcn_mfma_f32_32x32x16_bf16(pa0, (bf16x8){l0[0], l0[1], l0[2], l0[3], h0[0], h0[1], h0[2], h0[3]}, o[d0], 0, 0, 0);   \
        o[d0] = __builtin_amdgcn_mfma_f32_32x32x16_bf16(pa1, (bf16x8){l1[0], l1[1], l1[2], l1[3], h1[0], h1[1], h1[2], h1[3]}, o[d0], 0, 0, 0);   \
        o[d0] = __builtin_amdgcn_mfma_f32_32x32x16_bf16(pa2, (bf16x8){l2[0], l2[1], l2[2], l2[3], h2[0], h2[1], h2[2], h2[3]}, o[d0], 0, 0, 0);   \
        o[d0] = __builtin_amdgcn_mfma_f32_32x32x16_bf16(pa3, (bf16x8){l3[0], l3[1], l3[2], l3[3], h3[0], h3[1], h3[2], h3[3]}, o[d0], 0, 0, 0); } while (0)
    PV_D0(0); PV_D0(1); PV_D0(2); PV_D0(3);
#undef PV_D0
#undef TRRD
}

struct Bases { const bf16* Q; bf16* O; const bf16* K; const bf16* V; const float* CB; };
struct BlockRef { unsigned qo, oo, kvo, cbo; int P0, jlo; };
struct Seam { bf16x8 qr[8]; bf16x8 st_v0, st_v1, st_k0, st_k1; float st_b; };
#define ROW(p, k0, rr) ((p) + (unsigned)(((k0) + (rr)) * LD + sc))
#define VMW() asm volatile("s_waitcnt vmcnt(0)" ::: "memory")
#define VMWN(n) asm volatile("s_waitcnt vmcnt(%0)" :: "i"(n) : "memory")
#define SLOAD_H(Kp, Vp, CBp, k0) do { S.st_v0 = load8(ROW(Vp, k0, sr)); S.st_v1 = load8(ROW(Vp, k0, 32 + sr));              \
                         S.st_k0 = load8(ROW(Kp, k0, sr)); S.st_k1 = load8(ROW(Kp, k0, 32 + sr)); S.st_b = (CBp)[(unsigned)((k0) + lane)]; } while (0)
#define SWRITE_HK(bf, cref_) do { *(bf16x8*)(K_lds + (bf) * SHM_K + kws) = S.st_k0; *(bf16x8*)(K_lds + (bf) * SHM_K + kws + 32 * 256) = S.st_k1; \
                           if (wid == 0) *(float*)(B_lds + (bf) * 256 + lane * 4) = S.st_b; } while (0)
#define SWRITE_HV(bf) do { *(bf16x8*)(V_lds + (bf) * SHM_V + vst0) = S.st_v0; *(bf16x8*)(V_lds + (bf) * SHM_V + vst1) = S.st_v1; } while (0)
#define SWRITE_H(bf) do { SWRITE_HV(bf); SWRITE_HK(bf, cref); } while (0)
__device__ __forceinline__ void prime(const Bases& G, const BlockRef& cur, char* lds, Seam& S) {
    const int tid = threadIdx.x, wid = __builtin_amdgcn_readfirstlane(tid >> 6), lane = tid & 63, r32 = lane & 31, hi = lane >> 5;
    const int sr = tid >> 4, sc = (tid & 15) * 8, kws = KSWZ(sr, sc * 2); char* K_lds = lds + 2 * SHM_V; char* B_lds = lds + OFF_BIAS;
    for (int d0 = 0; d0 < 8; ++d0) S.qr[d0] = load8(G.Q + (cur.qo + (unsigned)((wid * QBLK + r32) * LD + d0 * 16 + hi * 8)));
    const float cref = 0.f; (void)cref;
    SLOAD_H(G.K + cur.kvo, G.V + cur.kvo, G.CB + cur.cbo, cur.jlo * KVBLK); VMW(); SWRITE_HK(0, cref);
    __syncthreads();
}
__device__ __forceinline__ void block(const Bases& G, const BlockRef& cur, const BlockRef& nxt, char* lds, Seam& S) {
    const int tid = threadIdx.x, wid = __builtin_amdgcn_readfirstlane(tid >> 6), lane = tid & 63, r32 = lane & 31, hi = lane >> 5;
    const int j_lo = cur.jlo, NT = (cur.P0 + QB - 1) / KVBLK + 1 - j_lo;
    const int qlo = cur.P0 + wid * QBLK, qm = qlo + r32 - 4 * hi;
    char* V_lds = lds; char* K_lds = lds + 2 * SHM_V; char* B_lds = lds + OFF_BIAS;
    float* ws = (float*)(lds + OFF_WS) + wid * 64; float* li_l = ws, * al_l = ws + 32;
    float m_reg = G.CB[cur.cbo + (unsigned)(cur.P0 + wid * QBLK + r32)], l_reg = 0; f32x16 o[4] = {};
    const int sr = tid >> 4, sc = (tid & 15) * 8, vst0 = v_st(sr, sc), vst1 = v_st(32 + sr, sc), kws = KSWZ(sr, sc * 2);
    const int vb0 = (int)(uintptr_t)V_lds + v_rd_base(lane);
    const bf16* Kh = G.K + cur.kvo; const bf16* Vh = G.V + cur.kvo; const float* CBh = G.CB + cur.cbo;
    const float cref = 0.f, crefn = 0.f; (void)cref; (void)crefn;
#define RESC(a) do { if (__any((a) < 1.f)) { if (hi == 0) al_l[r32] = (a); asm volatile("s_waitcnt lgkmcnt(0)" ::: "memory");              \
                     for (int d_ = 0; d_ < 4; ++d_) for (int r = 0; r < 16; ++r) o[d_][r] *= al_l[crow(r, hi)]; } } while (0)
#define KBASE(t) ((j_lo + (t)) * KVBLK)
#define MASKT(P0_, P1_, t) do { const int kb_ = KBASE(t); if (kb_ + KVBLK - 1 > qlo) mask_tile(P0_, P1_, qm - kb_); } while (0)
    constexpr int NQL = 8;
#define SEAM_K0() do { VMWN(NQL); SWRITE_HK(0, crefn); SBAR(); } while (0)
    f32x16 pA0, pA1, pB0, pB1; float mnA, mnB, alA, alB; bf16x8 pa0, pa1, pa2, pa3;
    SWRITE_HV(0); SBAR();
    if (NT > 1) { SLOAD_H(Kh, Vh, CBh, KBASE(1)); }
    SBAR(); qkt<0>(pA0, pA1, K_lds, B_lds, r32, hi, S.qr);
    MASKT(pA0, pA1, 0); partialSM(pA0, pA1, m_reg, mnA, alA);
    if (NT > 1) { VMW(); SWRITE_H(1); }
    __syncthreads();
#define HALF_STEP(PX0, PX1, mnX, alX, PY0, PY1, alY, t, KB, VB, SB) do {                                                      \
        SBAR(); qkt<KB>(PX0, PX1, K_lds, B_lds, r32, hi, S.qr);                                                                \
        finishSM(PY0, PY1, alY, l_reg, pa0, pa1, pa2, pa3); SBAR();                                                           \
        if ((t) + 1 < NT) { SLOAD_H(Kh, Vh, CBh, KBASE((t) + 1)); SBAR(); }                                              \
        pv_tile<VB>(o, vb0, pa0, pa1, pa2, pa3); MASKT(PX0, PX1, (t)); partialSM(PX0, PX1, m_reg, mnX, alX);                   \
        __syncthreads();                                                                                                      \
        if ((t) + 1 < NT) { VMW(); SWRITE_H(SB); }                                                                            \
        RESC(alX); __syncthreads(); } while (0)
    for (int t = 1; t + 1 < NT; t += 2) {
        HALF_STEP(pB0, pB1, mnB, alB, pA0, pA1, alA, t, 1, 0, 0);
        HALF_STEP(pA0, pA1, mnA, alA, pB0, pB1, alB, t + 1, 0, 1, 1);
    }
    constexpr bool even = true;
    if (even) { SBAR(); qkt<1>(pB0, pB1, K_lds, B_lds, r32, hi, S.qr); SBAR(); }
    { SLOAD_H(G.K + nxt.kvo, G.V + nxt.kvo, G.CB + nxt.cbo, nxt.jlo * KVBLK); SBAR();
#pragma unroll
      for (int d0 = 0; d0 < 8; ++d0) S.qr[d0] = load8(G.Q + (nxt.qo + (unsigned)((wid * QBLK + r32) * LD + d0 * 16 + hi * 8))); }
    SBAR();
    finishSM(pA0, pA1, alA, l_reg, pa0, pa1, pa2, pa3); SBAR();
    pv_tile<0>(o, vb0, pa0, pa1, pa2, pa3);
    if (even) { MASKT(pB0, pB1, NT - 1); partialSM(pB0, pB1, m_reg, mnB, alB); __syncthreads(); RESC(alB);
        finishSM(pB0, pB1, alB, l_reg, pa0, pa1, pa2, pa3); SBAR(); pv_tile<1>(o, vb0, pa0, pa1, pa2, pa3); }
    SBAR(); SEAM_K0();
    if (hi == 0) li_l[r32] = l_reg; asm volatile("s_waitcnt lgkmcnt(0)" ::: "memory");
    float rli[16];
#pragma unroll
    for (int r = 0; r < 16; ++r) rli[r] = __builtin_amdgcn_rcpf(li_l[crow(r, hi)]);
    bf16* Ow = G.O + (cur.oo + (unsigned)(wid * QBLK * LDO));
#pragma unroll
    for (int r = 0; r < 16; ++r) { const int orow = crow(r, hi);
#pragma unroll
        for (int d0 = 0; d0 < 4; ++d0) { const float v = o[d0][r] * rli[r];
            const float vn = __shfl_xor(v, 1);
            if ((r32 & 1) == 0) *(unsigned*)(Ow + (unsigned)(orow * LDO + d0 * 32 + r32)) = cvtpk(v, vn); } }
    __syncthreads();
#undef RESC
#undef KBASE
#undef MASKT
#undef SEAM_K0
#undef HALF_STEP
}
#undef ROW
#undef VMW
#undef VMWN
#undef SLOAD_H
#undef SWRITE_HK
#undef SWRITE_HV
#undef SWRITE_H
#undef KSWZ
#undef SBAR
}
constexpr int NB = 8, SEQ = 4096, T = NB * SEQ, DM = 1024, NH = 8, HD = 128, INW = 7176, NZ = 7168;
constexpr int NE = 32, DE = 512;
constexpr float EPS = 1e-6f;
constexpr int PMAX = 73728;
constexpr int NWAVES = 8;
constexpr size_t MiB = 1u << 20;
constexpr size_t WS_CTL = 0, CTL_ZERO_BYTES = 64 * 1024;
constexpr size_t WS_RS1 = 1 * MiB, WS_RS2 = 1 * MiB + 256 * 1024;
constexpr size_t WS_LF = 1 * MiB + 512 * 1024;
constexpr size_t WS_CB = 2 * MiB + 512 * 1024;
constexpr size_t WS_TOK = 3 * MiB + 512 * 1024;
constexpr size_t WS_LISTS = 5 * MiB;
constexpr size_t WS_WRT = 9 * MiB;
constexpr size_t WS_SRS = 9 * MiB + 512 * 1024, WS_SW = 10 * MiB;
constexpr size_t WS_WIN = 16 * MiB;
constexpr size_t WS_WA = 30 * MiB, WS_WL = 32 * MiB, WS_WO = 34 * MiB;
constexpr size_t WS_WRG = 36 * MiB;
constexpr size_t WS_XB = 40 * MiB;
constexpr size_t WS_XR = 104 * MiB;
constexpr size_t WS_GG = 168 * MiB;
constexpr size_t WS_Q = 232 * MiB, WS_K = 296 * MiB, WS_V = 360 * MiB;
constexpr size_t WS_W13 = 424 * MiB;
constexpr size_t WS_W2 = 392 * MiB;
constexpr size_t WS_XG = 168 * MiB;
constexpr size_t WS_HB = 296 * MiB;
constexpr size_t WS_END = 512 * MiB;
static_assert(WS_XG + (size_t)PMAX * 1024 <= WS_K && WS_HB + (size_t)PMAX * 1024 <= WS_W2 && WS_W2 + 32u * 1024 * 512 * 2 <= WS_W13 && WS_W13 + 64 * MiB <= WS_END, "d_ws map");
constexpr int CW_TMO = 0, CW_CODE = 1, CW_BAR = 4096, CW_CNT = 8192, CW_NORM = 8448, CW_QCTR = 12288;
constexpr int RING_OFF = 0, RING_BYTES = 131072;
constexpr int LDSCTL_OFF = RING_BYTES, MISC_OFF = LDSCTL_OFF + 320;
constexpr int TBL_OFF = RING_BYTES + 1024;
constexpr int TBL_PS = TBL_OFF, TBL_CN = TBL_OFF + 256, TBL_TE = TBL_OFF + 512;
constexpr int RG_TOT = RING_BYTES + 4096, RG_CAR = RG_TOT + 4096;
constexpr int LDS_BYTES = 147456;

#include <cmath>
using pg8::bf_lo; using pg8::bf_hi; using pg8::sigmoid_f;

struct Frame {
    LAS unsigned char* lds;
    int tid, lane, wave, vcu, G;
};
__device__ __forceinline__ float wave_sum(float v) {
#pragma unroll
    for (int o = 1; o < 64; o <<= 1) v += __shfl_xor(v, o);
    return v;
}
__device__ __forceinline__ void transpose_tile(const float* src, int ld, bf16* dst, int ldd, const float* kscale, LAS float* scr, int lane) {
    const int q = lane & 7, kr = lane >> 3;
    f32x4 v[8];
#pragma unroll
    for (int i = 0; i < 8; ++i) v[i] = *(const f32x4*)(src + (size_t)(kr + 8 * i) * ld + 4 * q);
#pragma unroll
    for (int i = 0; i < 8; ++i) { const int kk = kr + 8 * i; const float sc = kscale ? kscale[kk] : 1.0f;
#pragma unroll
        for (int c = 0; c < 4; ++c) scr[kk * 33 + 4 * q + c] = v[i][c] * sc; }
    LDS_WAIT(); asm volatile("" ::: "memory");
    const int c = lane & 7;
#pragma unroll
    for (int j = 0; j < 4; ++j) { const int n = (lane >> 3) + 8 * j; const LAS float* s = scr + (8 * c) * 33 + n;
        v4u o; o.x = pk2(s[0 * 33], s[1 * 33]); o.y = pk2(s[2 * 33], s[3 * 33]); o.z = pk2(s[4 * 33], s[5 * 33]); o.w = pk2(s[6 * 33], s[7 * 33]);
        *(GAS v4u*)(dst + (size_t)n * ldd + 8 * c) = o; }
    LDS_WAIT(); asm volatile("" ::: "memory");
}

__device__ __forceinline__ void transpose_tile8(const float* src, int ld, unsigned char* dst, int ldd, const float* kscale, float scale, LAS float* scr, int lane) {
    const int q = lane & 7, kr = lane >> 3;
    f32x4 v[8];
#pragma unroll
    for (int i = 0; i < 8; ++i) v[i] = *(const f32x4*)(src + (size_t)(kr + 8 * i) * ld + 4 * q);
#pragma unroll
    for (int i = 0; i < 8; ++i) { const int kk = kr + 8 * i; const float sc = kscale ? kscale[kk] * scale : scale;
#pragma unroll
        for (int c = 0; c < 4; ++c) scr[kk * 33 + 4 * q + c] = v[i][c] * sc; }
    LDS_WAIT(); asm volatile("" ::: "memory");
    const int c = lane & 3;
#pragma unroll
    for (int j = 0; j < 2; ++j) { const int n = (lane >> 2) + 16 * j; const LAS float* s = scr + (16 * c) * 33 + n;
        v4u o; o.x = pg8::pack4_fp8(s[0 * 33], s[1 * 33], s[2 * 33], s[3 * 33]); o.y = pg8::pack4_fp8(s[4 * 33], s[5 * 33], s[6 * 33], s[7 * 33]);
        o.z = pg8::pack4_fp8(s[8 * 33], s[9 * 33], s[10 * 33], s[11 * 33]); o.w = pg8::pack4_fp8(s[12 * 33], s[13 * 33], s[14 * 33], s[15 * 33]);
        *(GAS v4u*)(dst + (size_t)n * ldd + 16 * c) = o; }
    LDS_WAIT(); asm volatile("" ::: "memory");
}

struct P0Args { const float *x, *g_mix, *w_in, *w_rg_a, *w_rg_x, *b_forget, *w_lru_out, *w_attn_out, *w_out, *g_ffn, *w_rgrp, *w_rexp, *w_gate, *w_up;
                bf16 *Win, *Wl, *Wa, *Wo, *Wrg, *XB; unsigned char* W13; float *RS1, *LF, *WRT; };
struct TItem { const float* src; int ld; unsigned char* dst; int ldd; const float* ks; float scale; int f8; };
__device__ __forceinline__ void titem_load(const TItem& t, f32x4 (&v)[8], float (&sc)[8], int lane) {
    const int q = lane & 7, kr = lane >> 3;
#pragma unroll
    for (int i = 0; i < 8; ++i) { v[i] = *(const f32x4*)(t.src + (size_t)(kr + 8 * i) * t.ld + 4 * q); sc[i] = t.ks ? t.ks[kr + 8 * i] * t.scale : t.scale; }
}
__device__ __forceinline__ void titem_finish(const TItem& t, const f32x4 (&v)[8], const float (&sc)[8], LAS float* scr, int lane) {
    const int q = lane & 7, kr = lane >> 3;
#pragma unroll
    for (int i = 0; i < 8; ++i) { const int kk = kr + 8 * i;
#pragma unroll
        for (int c = 0; c < 4; ++c) scr[kk * 33 + 4 * q + c] = v[i][c] * sc[i]; }
    LDS_WAIT(); asm volatile("" ::: "memory");
    if (t.f8) { const int c = lane & 3;
#pragma unroll
        for (int j = 0; j < 2; ++j) { const int n = (lane >> 2) + 16 * j; const LAS float* s = scr + (16 * c) * 33 + n;
            v4u o; o.x = pg8::pack4_fp8(s[0 * 33], s[1 * 33], s[2 * 33], s[3 * 33]); o.y = pg8::pack4_fp8(s[4 * 33], s[5 * 33], s[6 * 33], s[7 * 33]);
            o.z = pg8::pack4_fp8(s[8 * 33], s[9 * 33], s[10 * 33], s[11 * 33]); o.w = pg8::pack4_fp8(s[12 * 33], s[13 * 33], s[14 * 33], s[15 * 33]);
            *(GAS v4u*)(t.dst + (size_t)n * t.ldd + 16 * c) = o; } }
    else { const int c = lane & 7;
#pragma unroll
        for (int j = 0; j < 4; ++j) { const int n = (lane >> 3) + 8 * j; const LAS float* s = scr + (8 * c) * 33 + n;
            v4u o; o.x = pk2(s[0 * 33], s[1 * 33]); o.y = pk2(s[2 * 33], s[3 * 33]); o.z = pk2(s[4 * 33], s[5 * 33]); o.w = pk2(s[6 * 33], s[7 * 33]);
            *(GAS v4u*)(t.dst + ((size_t)n * t.ldd + 8 * c) * 2) = o; } }
    LDS_WAIT(); asm volatile("" ::: "memory");
}
constexpr int P0_I_IN = 16 * 224, P0_I_SQ = 16 * 32, P0_I_RG = 2 * 4 * 4 * 8, P0_I_EX = 2 * 8192, P0_NITEMS = P0_I_IN + 3 * P0_I_SQ + P0_I_RG + P0_I_EX;
__device__ __forceinline__ void p0_items(const Frame& F, const P0Args& a, const int first, const int last, const int stride, const int offset) {
    LAS float* scr = (LAS float*)(F.lds + RING_OFF + F.wave * 16384);
    const float* const p_wl = a.w_lru_out; const float* const p_wa = a.w_attn_out; const float* const p_wo = a.w_out; const float* const p_rga = a.w_rg_a; const float* const p_rgx = a.w_rg_x;
    bf16* const q_wl = a.Wl; bf16* const q_wa = a.Wa; bf16* const q_wo = a.Wo;
    constexpr int I_IN = P0_I_IN, I_SQ = P0_I_SQ, I_EX = P0_I_EX, NITEMS = P0_NITEMS;
    const float* const p_gate = a.w_gate; const float* const p_up = a.w_up; const float* const p_win = a.w_in; const float* const p_gmix = a.g_mix; const float* const p_gffn = a.g_ffn;
    bf16* const q_win = a.Win; bf16* const q_wrg = a.Wrg; unsigned char* const q_w13 = a.W13;
#define P0_DECODE(it_, t_) do { int r = (it_); \
        if (r >= NITEMS - I_EX) { r -= NITEMS - I_EX;     \
            const int w = r >> 13, e = (r >> 8) & 31, kb = (r >> 4) & 15, nb = r & 15; const float* W = (w == 0 ? p_gate : p_up) + (size_t)e * DM * DE; \
            const int drow = e * 1024 + (nb >> 2) * 256 + (nb & 3) * 32 + (w == 1 ? 128 : 0); \
            t_.src = W + (size_t)(64 * kb) * DE + 32 * nb; t_.ld = DE; t_.dst = q_w13 + (size_t)drow * DM + 64 * kb; t_.ldd = DM; t_.ks = p_gffn + 64 * kb; t_.scale = pg8::W13_SCALE; t_.f8 = 1; } \
        else if (r < I_IN) { const int kb = r / 224, nb = r % 224, n0 = 32 * nb, sc_ = n0 < 5120 ? n0 : n0 + 8; \
            t_.src = p_win + (size_t)(64 * kb) * INW + sc_; t_.ld = INW; t_.dst = (unsigned char*)(q_win + (size_t)n0 * DM + 64 * kb); t_.ldd = DM; t_.ks = p_gmix + 64 * kb; t_.scale = 1.0f; t_.f8 = 0; } \
        else if (r < I_IN + 3 * I_SQ) { r -= I_IN; const int w = r / I_SQ, q = r % I_SQ, kb = q / 32, nb = q % 32; const float* W = w == 0 ? p_wl : (w == 1 ? p_wa : p_wo); bf16* Wt = w == 0 ? q_wl : (w == 1 ? q_wa : q_wo); \
            t_.src = W + (size_t)(64 * kb) * DM + 32 * nb; t_.ld = DM; t_.dst = (unsigned char*)(Wt + (size_t)(32 * nb) * DM + 64 * kb); t_.ldd = DM; t_.ks = nullptr; t_.scale = 1.0f; t_.f8 = 0; } \
        else { r -= I_IN + 3 * I_SQ; const int gb = r / 32, q = r % 32, kb = q / 8, nb = q % 8; const float* W = (gb < 4 ? p_rga : p_rgx) + (size_t)(gb & 3) * 65536; \
            t_.src = W + (size_t)(64 * kb) * 256 + 32 * nb; t_.ld = 256; t_.dst = (unsigned char*)(q_wrg + (size_t)gb * 65536 + (size_t)(32 * nb) * 256 + 64 * kb); t_.ldd = 256; t_.ks = nullptr; t_.scale = -1.4426950408889634f; t_.f8 = 0; }     } while (0)
    {
        int it = first + offset; TItem cur; f32x4 va[8]; float sa[8];
        if (it < last) { P0_DECODE(it, cur); titem_load(cur, va, sa, F.lane); }
        while (it < last) {
            const int nx = it + stride; TItem nt = cur; f32x4 vb[8]; float sb[8];
            if (nx < last) { P0_DECODE(nx, nt); titem_load(nt, vb, sb, F.lane); }
            titem_finish(cur, va, sa, scr, F.lane);
            if (nx < last) { cur = nt;
#pragma unroll
                for (int i = 0; i < 8; ++i) { va[i] = vb[i]; sa[i] = sb[i]; } }
            it = nx;
        }
    }
#undef P0_DECODE
}
__device__ __forceinline__ void p0_prologue(const Frame& F, const P0Args& a, const int part  ) {
    const int gw = F.vcu * NWAVES + F.wave, NGW = F.G * NWAVES;
    if (part != 2) p0_items(F, a, 0, P0_NITEMS, NGW, gw);
    if (part == 1) return;
    for (int i = (F.vcu * NWAVES + F.wave) * 64 + F.lane; i < 64 * DM; i += NGW * 64) { const int n = i >> 10, k = i & 1023;
        float v = 0.f; if (n < 32) v = a.w_rexp[k * 32 + n]; else if (n < 36) v = a.w_rgrp[k * 4 + (n - 32)];
        a.WRT[i] = v * a.g_ffn[k]; }
    LAS float* wfl = (LAS float*)(F.lds + RING_OFF);
    __syncthreads();
    for (int k = F.tid; k < DM; k += NWAVES * 64) { const float g = a.g_mix[k];
        const f32x4 w0 = *(const f32x4*)(a.w_in + (size_t)k * INW + 5120), w1 = *(const f32x4*)(a.w_in + (size_t)k * INW + 5124);
        *(LAS f32x4*)(wfl + k * 8) = w0 * g; *(LAS f32x4*)(wfl + k * 8 + 4) = w1 * g; }
    __syncthreads();
    float wf[4][4][8];
#pragma unroll
    for (int j = 0; j < 4; ++j)
#pragma unroll
        for (int i = 0; i < 4; ++i) { const int k = 256 * j + 4 * F.lane + i; const f32x4 w0 = *(const LAS f32x4*)(wfl + k * 8), w1 = *(const LAS f32x4*)(wfl + k * 8 + 4);
#pragma unroll
            for (int h = 0; h < 4; ++h) { wf[j][i][h] = w0[h]; wf[j][i][4 + h] = w1[h]; } }
    const float bfg = a.b_forget[F.lane & 7];
    f32x4 vn[4];
    if (gw < T) { const GAS f32x4* xr0 = (const GAS f32x4*)(a.x + (size_t)gw * DM) + F.lane;
#pragma unroll
        for (int j = 0; j < 4; ++j) vn[j] = xr0[64 * j]; }
    for (int m = gw; m < T; m += NGW) {
        f32x4 v[4]; float s = 0.f, d[8] = {0.f, 0.f, 0.f, 0.f, 0.f, 0.f, 0.f, 0.f};
#pragma unroll
        for (int j = 0; j < 4; ++j) v[j] = vn[j];
        if (m + NGW < T) { const GAS f32x4* xr1 = (const GAS f32x4*)(a.x + (size_t)(m + NGW) * DM) + F.lane;
#pragma unroll
            for (int j = 0; j < 4; ++j) vn[j] = xr1[64 * j]; }
#pragma unroll
        for (int j = 0; j < 4; ++j) { s += (v[j].x * v[j].x + v[j].y * v[j].y) + (v[j].z * v[j].z + v[j].w * v[j].w);
#pragma unroll
            for (int i = 0; i < 4; ++i)
#pragma unroll
                for (int h = 0; h < 8; ++h) d[h] = fmaf(v[j][i], wf[j][i][h], d[h]); }
        s = wave_sum(s);
#pragma unroll
        for (int h = 0; h < 8; ++h) d[h] = wave_sum(d[h]);
        const float rs = 1.0f / sqrtf(s * (1.0f / DM) + EPS);
        GAS unsigned long long* o8 = (GAS unsigned long long*)(a.XB + (size_t)m * DM) + F.lane;
#pragma unroll
        for (int j = 0; j < 4; ++j) o8[64 * j] = (unsigned long long)pk2(v[j].x * rs, v[j].y * rs) | ((unsigned long long)pk2(v[j].z * rs, v[j].w * rs) << 32);
        if (F.lane < 8) { const int h = F.lane; float dh = d[0]; dh = h == 1 ? d[1] : dh; dh = h == 2 ? d[2] : dh; dh = h == 3 ? d[3] : dh; dh = h == 4 ? d[4] : dh; dh = h == 5 ? d[5] : dh; dh = h == 6 ? d[6] : dh; dh = h == 7 ? d[7] : dh;
            const float fl = dh * rs + bfg; a.LF[(size_t)m * 8 + h] = fminf(fl, 0.f) - log1pf(expf(-fabsf(fl))); }
    }
}
__device__ __forceinline__ void cumsum_bias(const Frame& F, const float* LF, float* CB) {
    LAS float* wt = (LAS float*)(F.lds + RING_OFF);
    for (int bh = blockIdx.x; bh < NB * NH; bh += F.G) {
        const int b = bh >> 3, h = bh & 7, s0 = F.tid * 8;
        float v[8], run = 0.f;
#pragma unroll
        for (int j = 0; j < 8; ++j) { run += LF[((size_t)(b * SEQ + s0 + j)) * 8 + h]; v[j] = run; }
        float inc = run;
#pragma unroll
        for (int o = 1; o < 64; o <<= 1) { const float t = __shfl_up(inc, o); if (F.lane >= o) inc += t; }
        if (F.lane == 63) wt[F.wave] = inc;
        __syncthreads();
        float pre = inc - run;
        for (int w = 0; w < F.wave; ++w) pre += wt[w];
#pragma unroll
        for (int j = 0; j < 8; ++j) CB[(size_t)bh * SEQ + s0 + j] = -(pre + v[j]) * 11.313708498984761f;
        __syncthreads();
    }
}
struct RgArgs { const bf16* XC; const bf16* GG; bf16* GO; const bf16* Wrg; const float *b_a, *b_x, *lam; };
__device__ __forceinline__ float bfx(const v4u& v, int i) { const unsigned w = i < 2 ? v.x : (i < 4 ? v.y : (i < 6 ? v.z : v.w)); return (i & 1) ? bf_hi(w) : bf_lo(w); }
__device__ __forceinline__ unsigned cvtpk_bf16(float lo, float hi) { unsigned r; asm volatile("v_cvt_pk_bf16_f32 %0, %1, %2" : "=v"(r) : "v"(lo), "v"(hi)); return r; }
__device__ __forceinline__ void conv_prepass(const Frame& F, const bf16* XR, bf16* XC, const float* conv_w, const float* conv_b) {
    const int gw = F.vcu * NWAVES + F.wave, NGW = F.G * NWAVES;
    for (int it = gw; it < (T / 16) * 2; it += NGW) {
        const int r0 = (it >> 1) * 16, c0 = (it & 1) * 512 + 8 * F.lane, tq = r0 & (SEQ - 1);
        float cw[4][8], cbv[8];
#pragma unroll
        for (int j = 0; j < 4; ++j) { const f32x4 w0 = *(const f32x4*)(conv_w + j * DM + c0), w1 = *(const f32x4*)(conv_w + j * DM + c0 + 4);
#pragma unroll
            for (int i = 0; i < 4; ++i) { cw[j][i] = w0[i]; cw[j][4 + i] = w1[i]; } }
        { const f32x4 w0 = *(const f32x4*)(conv_b + c0), w1 = *(const f32x4*)(conv_b + c0 + 4);
#pragma unroll
          for (int i = 0; i < 4; ++i) { cbv[i] = w0[i]; cbv[4 + i] = w1[i]; } }
        v4u raw[19];
#pragma unroll
        for (int i = 0; i < 19; ++i) { const int rr = (i < 3 && tq == 0) ? r0 : r0 - 3 + i; const v4u w = *(const GAS v4u*)(XR + ((unsigned)rr * DM + c0));
            const bool z = i < 3 && tq == 0; raw[i].x = z ? 0u : w.x; raw[i].y = z ? 0u : w.y; raw[i].z = z ? 0u : w.z; raw[i].w = z ? 0u : w.w; }
#pragma unroll
        for (int r = 0; r < 16; ++r) { float y[8];
#pragma unroll
            for (int i = 0; i < 8; ++i) { float sacc = cbv[i];
#pragma unroll
                for (int j = 0; j < 4; ++j) sacc = fmaf(cw[j][i], bfx(raw[r + j], i), sacc);
                y[i] = sacc; }
            v4u o; o.x = cvtpk_bf16(y[0], y[1]); o.y = cvtpk_bf16(y[2], y[3]); o.z = cvtpk_bf16(y[4], y[5]); o.w = cvtpk_bf16(y[6], y[7]);
            *(GAS v4u*)(XC + ((unsigned)(r0 + r) * DM + c0)) = o; }
    }
}
__device__ __forceinline__ void rglru_unit(const Frame& F, const RgArgs& a, int unit) {
    const int tid = F.tid, lane = F.lane, wid = F.wave, fr = lane & 15, fq = lane >> 4, rq = wid >> 1, cp = wid & 1;
    const int b = unit >> 5, n = (unit >> 3) & 3, g = unit & 7, cbase = 256 * n, cown = cbase + 32 * g;
    LAS unsigned char* A_l = F.lds + RING_OFF;
    LAS float* tot = (LAS float*)(F.lds + RG_TOT);
    bf16x8 bfr[2][8];
#pragma unroll
    for (int gt = 0; gt < 2; ++gt)
#pragma unroll
        for (int ks = 0; ks < 8; ++ks) bfr[gt][ks] = *(const GAS bf16x8*)(a.Wrg + ((size_t)((gt * 4 + n) * 256 + 32 * g + 16 * cp + fr)) * 256 + 32 * ks + 8 * fq);
    const int cl = 16 * cp + fr, cch = cown + cl;
    const float ba = -1.4426950408889634f * a.b_a[cch], bx = -1.4426950408889634f * a.b_x[cch], sp8 = 8.0f * log1pf(expf(-a.lam[cch])) * 1.4426950408889634f;
    const unsigned goff = (unsigned)(b * SEQ + 32 * rq + 4 * fq) * DM + cch;
    const __amdgpu_buffer_rsrc_t GGr = __builtin_amdgcn_make_buffer_rsrc((void*)a.GG, 0, (int)((size_t)T * DM * 2), 0x00020000);
    const __amdgpu_buffer_rsrc_t GOr = __builtin_amdgcn_make_buffer_rsrc((void*)a.GO, 0, (int)((size_t)T * DM * 2), 0x00020000);
    const int gvo = (int)(goff * 2u);
    const unsigned dbase = ((unsigned)(b * SEQ + 16 * wid + (lane >> 5)) * DM + cbase) * 2u;
    const char* const XCb = (const char*)a.XC;
#define RG_DMA(ci_, buf_) do { _Pragma("unroll") for (int i_ = 0; i_ < 8; ++i_) { const unsigned so_ = dbase + (unsigned)(2 * i_) * (DM * 2u) + ((((unsigned)lane & 31u) ^ (unsigned)((2 * i_ + (lane >> 5)) & 15)) << 4); \
        __builtin_amdgcn_global_load_lds((const unsigned*)(XCb + so_ + (unsigned)(ci_) * (128u * DM * 2u)), (LAS unsigned*)(A_l + (buf_) * 65536 + (8 * wid + i_) * 1024), 16, 0, 0); } } while (0)
    float hc = 0.f;
    const int kx = 32 * g + cl;
#pragma unroll
    for (int gt = 0; gt < 2; ++gt)
#pragma unroll
        for (int ks = 0; ks < 8; ++ks) asm volatile("" : "+v"(bfr[gt][ks]));
    RG_DMA(0, 0); asm volatile("s_waitcnt vmcnt(0)" ::: "memory");
#define RG_CHUNK(BUF_, ci_) do { const int ci = (ci_); const int t0 = 128 * ci; LAS unsigned char* const Ab = A_l + (BUF_) * 65536; \
        __builtin_amdgcn_s_barrier(); asm volatile("" ::: "memory"); \
        unsigned short ggv[2][4]; \
        _Pragma("unroll") \
        for (int mt = 0; mt < 2; ++mt) \
        _Pragma("unroll") \
            for (int j = 0; j < 4; ++j) ggv[mt][j] = __builtin_amdgcn_raw_buffer_load_b16(GGr, gvo, (t0 + 16 * mt + j) * (DM * 2), 0); \
        if (ci + 1 < SEQ / 128) RG_DMA(ci + 1, BUF_ ^ 1); \
 \
        f32x4 acc[2][2]; \
        _Pragma("unroll") \
        for (int mt = 0; mt < 2; ++mt) { acc[mt][0] = (f32x4){ba, ba, ba, ba}; acc[mt][1] = (f32x4){bx, bx, bx, bx}; } \
        _Pragma("unroll") \
        for (int ks = 0; ks < 8; ++ks) { const int ch = 4 * ks + fq; \
        _Pragma("unroll") \
            for (int mt = 0; mt < 2; ++mt) { const int arow = 32 * rq + 16 * mt + fr; \
                const bf16x8 af = *(const LAS bf16x8*)(Ab + arow * 512 + ((ch ^ (arow & 15)) << 4)); \
                acc[mt][0] = __builtin_amdgcn_mfma_f32_16x16x32_bf16(af, bfr[0][ks], acc[mt][0], 0, 0, 0); \
                acc[mt][1] = __builtin_amdgcn_mfma_f32_16x16x32_bf16(af, bfr[1][ks], acc[mt][1], 0, 0, 0); } } \
 \
        float av[2][4], bv[2][4], sA[2], sB[2]; \
        _Pragma("unroll") \
        for (int mt = 0; mt < 2; ++mt) { float A = 1.f, Bv = 0.f; \
        _Pragma("unroll") \
            for (int j = 0; j < 4; ++j) { const int row = 32 * rq + 16 * mt + 4 * fq + j; \
                const unsigned short xb16 = *(const LAS unsigned short*)(Ab + row * 512 + ((((kx >> 3) ^ (row & 15))) << 4) + (kx & 7) * 2); \
                const float xc = __builtin_bit_cast(float, (unsigned)xb16 << 16); \
                const float r_ = __builtin_amdgcn_rcpf(1.0f + __builtin_amdgcn_exp2f(acc[mt][0][j])), i_ = __builtin_amdgcn_rcpf(1.0f + __builtin_amdgcn_exp2f(acc[mt][1][j])); \
                const float aa = __builtin_amdgcn_exp2f(-sp8 * r_); \
                const float mult = __builtin_amdgcn_sqrtf(fmaxf(fmaf(-aa, aa, 1.0f), 0.f)); \
                av[mt][j] = aa; bv[mt][j] = mult * i_ * xc; \
                Bv = fmaf(aa, Bv, bv[mt][j]); A *= aa; } \
            sA[mt] = A; sB[mt] = Bv; } \
 \
        float eA[2], eB[2], tA[2], tB[2]; \
        _Pragma("unroll") \
        for (int mt = 0; mt < 2; ++mt) { float A = sA[mt], Bv = sB[mt]; \
            { const float pA = __shfl_up(A, 16), pB = __shfl_up(Bv, 16); if (fq >= 1) { Bv = fmaf(A, pB, Bv); A *= pA; } } \
            { const float pA = __shfl_up(A, 32), pB = __shfl_up(Bv, 32); if (fq >= 2) { Bv = fmaf(A, pB, Bv); A *= pA; } } \
            const float xA = __shfl_up(A, 16), xB = __shfl_up(Bv, 16); eA[mt] = fq >= 1 ? xA : 1.f; eB[mt] = fq >= 1 ? xB : 0.f; \
            tA[mt] = __shfl(A, 48 + fr); tB[mt] = __shfl(Bv, 48 + fr); } \
        const float wA = tA[0] * tA[1], wB = fmaf(tA[1], tB[0], tB[1]); \
        if (fq == 0) { tot[(rq * 32 + cl) * 2] = wA; tot[(rq * 32 + cl) * 2 + 1] = wB; } \
        asm volatile("s_waitcnt lgkmcnt(0)" ::: "memory"); __builtin_amdgcn_s_barrier(); asm volatile("" ::: "memory"); \
        float hin = hc, hnew = hc; \
        _Pragma("unroll") \
        for (int q = 0; q < 4; ++q) { const float qA = tot[(q * 32 + cl) * 2], qB = tot[(q * 32 + cl) * 2 + 1]; hnew = fmaf(qA, hnew, qB); if (q < rq) hin = hnew; } \
        hc = hnew; \
        _Pragma("unroll") \
        for (int mt = 0; mt < 2; ++mt) { float h = mt == 0 ? hin : fmaf(tA[0], hin, tB[0]); \
            h = fmaf(eA[mt], h, eB[mt]); \
        _Pragma("unroll") \
            for (int j = 0; j < 4; ++j) { h = fmaf(av[mt][j], h, bv[mt][j]); \
                const float gv = __builtin_bit_cast(float, (unsigned)ggv[mt][j] << 16); \
                __builtin_amdgcn_raw_buffer_store_b16((unsigned short)cvtpk_bf16(h * gv, 0.f), GOr, gvo, (t0 + 16 * mt + j) * (DM * 2), 0); } } \
        asm volatile("s_waitcnt lgkmcnt(0)" ::: "memory"); \
        asm volatile("s_waitcnt vmcnt(8)" ::: "memory"); \
    } while (0)
    for (int cc = 0; cc < SEQ / 128; cc += 2) { RG_CHUNK(0, cc); RG_CHUNK(1, cc + 1); }
#undef RG_CHUNK
#undef RG_DMA
    asm volatile("s_waitcnt vmcnt(0) lgkmcnt(0)" ::: "memory"); __builtin_amdgcn_s_barrier(); asm volatile("" ::: "memory");
}
__device__ __forceinline__ int attn_jlo(const Frame& F, const float* CB, const unsigned* NORM, int bh, int qb) {
    float qs = 0.f, ks = 0.f;
#pragma unroll
    for (int w = 0; w < 4; ++w) { qs += __uint_as_float(NORM[(bh) * 4 + w]); ks += __uint_as_float(NORM[(64 + bh) * 4 + w]); }
    constexpr float C2 = 1.4426950408889634f * 0.08838834764831845f;
    const float th = 150.0f + 2.0f * 1.02f * sqrtf(qs * ks) * C2 + 4.0f;
    const float ref = CB[(size_t)bh * SEQ + qb * 256], v = CB[(size_t)bh * SEQ + 64 * F.lane + 63];
    const unsigned long long m = __ballot(F.lane < 4 * qb && (ref - v) * C2 > th);
    int j = __builtin_popcountll(m); if (m != ((j >= 64) ? ~0ull : ((1ull << j) - 1ull))) j = 0;
    return j & ~1;
}
__device__ __forceinline__ fattn::BlockRef attn_ref(int bh, int qb, int jlo) {
    const int b = bh >> 3, h = bh & 7;
    fattn::BlockRef r; r.qo = ((unsigned)bh * SEQ + (unsigned)qb * 256u) * HD; r.oo = ((unsigned)b * SEQ + (unsigned)qb * 256u) * DM + h * HD; r.kvo = (unsigned)bh * SEQ * HD; r.cbo = (unsigned)bh * SEQ; r.P0 = qb * 256; r.jlo = jlo; return r;
}
__device__ __forceinline__ void attn_phase(const Frame& F, char* lds, const bf16* Qb, bf16* Ob, const bf16* Kb, const bf16* Vb, const float* CB, const int* JLO, gu32* QCTR) {
    constexpr int NBLK = 128;
    const int M = F.G >> 3; if ((F.G & 7) || M > 64 || M < 1) return;
    const int x = F.vcu / M, r = F.vcu % M;
    volatile LAS int* tk_l = (volatile LAS int*)(F.lds + MISC_OFF + 64);
    gu32* qc = QCTR + 64 * x;
    const fattn::Bases G{Qb, Ob, Kb, Vb, CB};
#define ATT_DEC(k_, bh_, qb_) do { const int i_ = (k_) & 7; bh_ = (i_ < 4 ? 4 * x + i_ : 32 + 4 * x + (i_ - 4)); qb_ = 15 - ((k_) >> 3); } while (0)
    int bh, qb; ATT_DEC(r, bh, qb);
    fattn::BlockRef cur = attn_ref(bh, qb, __builtin_amdgcn_readfirstlane(JLO[bh * 16 + qb]));
    ATT_DEC(r + M, bh, qb);
    fattn::BlockRef nxt = attn_ref(bh, qb, __builtin_amdgcn_readfirstlane(JLO[bh * 16 + qb])); bool nxt_ok = (r + M) < NBLK;
    fattn::Seam S;
    fattn::prime(G, cur, lds, S);
    bool more = true;
    for (;;) {
        unsigned tkt = 0u;
        if (more && F.tid == 0) tkt = __hip_atomic_fetch_add(qc, 1u, __ATOMIC_RELAXED, __HIP_MEMORY_SCOPE_AGENT);
        const bool last = !nxt_ok;
        fattn::block(G, cur, last ? cur : nxt, lds, S);
        if (last) break;
        if (F.tid == 0) tk_l[0] = more ? (int)tkt + 2 * M : NBLK;
        __syncthreads();
        const int k2 = __builtin_amdgcn_readfirstlane(tk_l[0]);
        __syncthreads();
        cur = nxt;
        if (k2 < NBLK) { ATT_DEC(k2, bh, qb); nxt = attn_ref(bh, qb, __builtin_amdgcn_readfirstlane(JLO[bh * 16 + qb])); nxt_ok = true; } else { nxt_ok = false; more = false; }
    }
#undef ATT_DEC
}
typedef float f32x16 __attribute__((ext_vector_type(16)));
struct P5Args { const float *X, *WRT, *b_rgrp, *b_rexp, *w_down; const bf16* DL; bf16* X1B; unsigned char *X8, *W2; float* RS2; int* LISTS; unsigned* TOK; gu32* CNT; };
__device__ __forceinline__ void p5_route(const Frame& F, const P5Args& a) {
    const int tid = F.tid, lane = F.lane, wid = F.wave, i16 = lane & 15, h4 = lane >> 4;
    constexpr int LDA = 132;
    LAS float* A_l = (LAS float*)(F.lds + RING_OFF) + wid * 16 * LDA;
    LAS float* B_l = (LAS float*)(F.lds + RING_OFF + 67584);
    LAS float* LG = (LAS float*)(F.lds + RING_OFF + 94208);
    LAS float* rs_l = (LAS float*)(F.lds + RING_OFF + 113664);
    LAS int* hist = (LAS int*)(F.lds + RING_OFF + 114176);
    LAS int* base_l = (LAS int*)(F.lds + RING_OFF + 114432);
    {
        LAS float* scr = (LAS float*)(F.lds + RING_OFF + wid * 8704);
        const int gw = F.vcu * NWAVES + wid, NGW = F.G * NWAVES;
        for (int it = gw; it < 8192; it += NGW) { const int e = it >> 8, kb = (it >> 5) & 7, nb = it & 31; const float* W = a.w_down + (size_t)e * DE * DM;
            transpose_tile8(W + (size_t)(64 * kb) * DM + 32 * nb, DM, a.W2 + (size_t)(e * 1024 + 32 * nb) * DE + 64 * kb, DE, nullptr, pg8::W2_SCALE, scr, lane); }
    }
    __syncthreads();
    for (int rb = blockIdx.x; rb < T / 128; rb += F.G) {
        const int R0 = rb * 128;
        if (tid < 32) hist[tid] = 0;
        const int ar = lane >> 5, ac = 4 * (lane & 31);
        const size_t xo = (size_t)(R0 + 16 * wid + ar) * DM + ac; const float* xsrc = a.X + xo; const bf16* dsrc = a.DL + xo; unsigned char* xdst = a.X8 + xo; bf16* bdst = a.X1B + xo;
        f32x4 areg[8], breg[3]; unsigned long long dreg[8];
#define P5_LOAD(kc_) do { _Pragma("unroll") for (int i_ = 0; i_ < 8; ++i_) { areg[i_] = *(const f32x4*)(xsrc + (size_t)(2 * i_) * DM + (kc_) * 128); dreg[i_] = *(const unsigned long long*)(dsrc + (size_t)(2 * i_) * DM + (kc_) * 128); } \
        _Pragma("unroll") for (int q_ = 0; q_ < 3; ++q_) { const int idx_ = tid + 512 * q_; breg[q_] = *(const f32x4*)(a.WRT + (size_t)(idx_ >> 5) * DM + (kc_) * 128 + 4 * (idx_ & 31)); } } while (0)
        P5_LOAD(0);
        f32x4 acc[3] = {{0.f, 0.f, 0.f, 0.f}, {0.f, 0.f, 0.f, 0.f}, {0.f, 0.f, 0.f, 0.f}}; float ss = 0.f;
        for (int kc = 0; kc < 8; ++kc) {
#pragma unroll
            for (int i = 0; i < 8; ++i) { const unsigned dl = (unsigned)dreg[i], dh = (unsigned)(dreg[i] >> 32);
                areg[i][0] += bf_lo(dl); areg[i][1] += bf_hi(dl); areg[i][2] += bf_lo(dh); areg[i][3] += bf_hi(dh);
                *(unsigned*)(xdst + (size_t)(2 * i) * DM + kc * 128) = pg8::pack4_fp8(areg[i][0], areg[i][1], areg[i][2], areg[i][3]);
                *(unsigned long long*)(bdst + (size_t)(2 * i) * DM + kc * 128) = (unsigned long long)pg8::cvt_pk_bf16(areg[i][0], areg[i][1]) | ((unsigned long long)pg8::cvt_pk_bf16(areg[i][2], areg[i][3]) << 32);
                *(LAS f32x4*)(A_l + (2 * i + ar) * LDA + ac) = areg[i]; }
#pragma unroll
            for (int q = 0; q < 3; ++q) { const int idx = tid + 512 * q; *(LAS f32x4*)(B_l + (idx >> 5) * LDA + 4 * (idx & 31)) = breg[q]; }
            __syncthreads();
            if (kc + 1 < 8) P5_LOAD(kc + 1);
#pragma unroll
            for (int jj = 0; jj < 8; ++jj) {
                const f32x4 af = *(const LAS f32x4*)(A_l + i16 * LDA + 16 * jj + 4 * h4);
                f32x4 bfv[3];
#pragma unroll
                for (int nt = 0; nt < 3; ++nt) bfv[nt] = *(const LAS f32x4*)(B_l + (16 * nt + i16) * LDA + 16 * jj + 4 * h4);
                ss += (af[0] * af[0] + af[1] * af[1]) + (af[2] * af[2] + af[3] * af[3]);
#pragma unroll
                for (int s = 0; s < 4; ++s)
#pragma unroll
                    for (int nt = 0; nt < 3; ++nt) acc[nt] = __builtin_amdgcn_mfma_f32_16x16x4f32(af[s], bfv[nt][s], acc[nt], 0, 0, 0);
            }
            __syncthreads();
        }
#undef P5_LOAD
        ss += __shfl_xor(ss, 16); ss += __shfl_xor(ss, 32);
        const float rs = 1.0f / sqrtf(ss * (1.0f / DM) + EPS);
        if (h4 == 0) { a.RS2[R0 + 16 * wid + i16] = rs; rs_l[16 * wid + i16] = rs; }
#pragma unroll
        for (int r = 0; r < 4; ++r) { const int rl = 16 * wid + 4 * h4 + r; LG[rl * 37 + i16] = acc[0][r]; LG[rl * 37 + 16 + i16] = acc[1][r]; if (i16 < 4) LG[rl * 37 + 32 + i16] = acc[2][r]; }
        __syncthreads();
        int e0 = 0, e1 = 0, k0 = 0, k1 = 0; float w0 = 0.f, w1 = 0.f;
        if (tid < 128) {
            const float rsv = rs_l[tid]; const LAS float* lg = LG + tid * 37;
            float gl[4];
#pragma unroll
            for (int q = 0; q < 4; ++q) gl[q] = lg[32 + q] * rsv + a.b_rgrp[q];
            int gs = 0; float gm = gl[0];
#pragma unroll
            for (int q = 1; q < 4; ++q) if (gl[q] > gm) { gm = gl[q]; gs = q; }
            float den = 0.f;
#pragma unroll
            for (int q = 0; q < 4; ++q) den += expf(gl[q] - gm);
            const float pg = 1.0f / den;
            float el[8];
#pragma unroll
            for (int q = 0; q < 8; ++q) el[q] = lg[8 * gs + q] * rsv + a.b_rexp[8 * gs + q];
            int i0 = 0; float v0 = el[0];
#pragma unroll
            for (int q = 1; q < 8; ++q) if (el[q] > v0) { v0 = el[q]; i0 = q; }
            int i1 = -1; float v1 = -INFINITY;
#pragma unroll
            for (int q = 0; q < 8; ++q) if (q != i0 && el[q] > v1) { v1 = el[q]; i1 = q; }
            const float ex = expf(v1 - v0);
            w0 = pg / (1.0f + ex); w1 = pg * ex / (1.0f + ex);
            e0 = 8 * gs + i0; e1 = 8 * gs + i1;
            k0 = atomicAdd((int*)(hist + e0), 1); k1 = atomicAdd((int*)(hist + e1), 1);
        }
        __syncthreads();
        if (tid < 32) base_l[tid] = (int)__hip_atomic_fetch_add(a.CNT + tid, (unsigned)hist[tid], __ATOMIC_RELAXED, __HIP_MEMORY_SCOPE_AGENT);
        __syncthreads();
        if (tid < 128) { const int tok = R0 + tid, s0 = base_l[e0] + k0, s1 = base_l[e1] + k1;
            a.LISTS[(size_t)e0 * T + s0] = tok; a.LISTS[(size_t)e1 * T + s1] = tok;
            v4u i0v = {(unsigned)e0, (unsigned)s0, (unsigned)e1, (unsigned)s1}, i1v = {__float_as_uint(w0), __float_as_uint(w1), 0u, 0u};
            *(GAS v4u*)(a.TOK + (size_t)tok * 8) = i0v; *(GAS v4u*)(a.TOK + (size_t)tok * 8 + 4) = i1v; }
        __syncthreads();
    }
}
__device__ __forceinline__ void build_tables(const Frame& F, const gu32* CNT) {
    LAS int* ps = (LAS int*)(F.lds + TBL_PS); LAS int* cn = (LAS int*)(F.lds + TBL_CN); LAS int* te = (LAS int*)(F.lds + TBL_TE);
    __syncthreads();
    if (F.tid < 32) { int c = (int)__hip_atomic_load(CNT + F.tid, __ATOMIC_RELAXED, __HIP_MEMORY_SCOPE_AGENT); c = c < 0 ? 0 : (c > T ? T : c); cn[F.tid] = c; }
    __syncthreads();
    if (F.tid == 0) { int run = 0; for (int e = 0; e < 32; ++e) { ps[e] = run; run += (cn[e] + 255) & ~255; } if (run > PMAX) run = PMAX; ps[32] = run; }
    __syncthreads();
    if (F.tid < 288) { const int p = F.tid * 256; int e = 0; for (int q = 1; q < 32; ++q) if (p >= ps[q]) e = q; te[F.tid] = e; }
    __syncthreads();
}
__device__ __forceinline__ void build_rowtab(const Frame& F, const pg8::GroupedOrder& S, const int* LISTS, const float* RS2, LAS int* rowtab) {
    const LAS int* ps = (const LAS int*)(F.lds + TBL_PS); const LAS int* cn = (const LAS int*)(F.lds + TBL_CN); const LAS int* te = (const LAS int*)(F.lds + TBL_TE);
    pg8::Unit u;
    for (int ui = 0; ui < 6 && S.next(ui, u); ++ui)
        if (F.tid < 256) { const int p = u.pm * 256 + F.tid, e = te[u.pm], local = p - ps[e]; const int tok = local < cn[e] ? LISTS[(size_t)e * T + local] : 0; rowtab[ui * 256 + F.tid] = tok; ((LAS float*)rowtab)[(6 + ui) * 256 + F.tid] = RS2[tok]; }
    __syncthreads();
}
__device__ __forceinline__ float fp8_f32(unsigned w, int i) { return i == 0 ? __builtin_amdgcn_cvt_f32_fp8(w, 0) : (i == 1 ? __builtin_amdgcn_cvt_f32_fp8(w, 1) : (i == 2 ? __builtin_amdgcn_cvt_f32_fp8(w, 2) : __builtin_amdgcn_cvt_f32_fp8(w, 3))); }
__device__ __forceinline__ void p9_final(const Frame& F, const bf16* X1B, float* OUT, const unsigned char* Y, const unsigned* TOK, const float* g_final) {
    const LAS int* ps = (const LAS int*)(F.lds + TBL_PS);
    const int gw = F.vcu * NWAVES + F.wave, NGW = F.G * NWAVES;
    f32x4 gf[4];
#pragma unroll
    for (int j = 0; j < 4; ++j) gf[j] = *((const f32x4*)g_final + F.lane + 64 * j);
    constexpr float YS = 1.0f / (pg8::HB_SCALE * pg8::W2_SCALE * pg8::Y_SCALE);
    for (int m = gw; m < T; m += NGW) {
        const v4u ia = *(const GAS v4u*)(TOK + (size_t)m * 8), ib = *(const GAS v4u*)(TOK + (size_t)m * 8 + 4); const float w0 = __uint_as_float(ib.x) * YS, w1 = __uint_as_float(ib.y) * YS;
        const int e0 = (int)(ia.x & 31u), e1 = (int)(ia.z & 31u);
        const size_t p0 = (size_t)(ps[e0] + (int)ia.y), p1 = (size_t)(ps[e1] + (int)ia.w);
        const GAS unsigned long long* xr = (const GAS unsigned long long*)(X1B + (size_t)m * DM) + F.lane; GAS f32x4* orow = (GAS f32x4*)(OUT + (size_t)m * DM) + F.lane;
        const GAS unsigned* y0 = (const GAS unsigned*)(Y + p0 * DM) + F.lane; const GAS unsigned* y1 = (const GAS unsigned*)(Y + p1 * DM) + F.lane;
        f32x4 v[4]; float s = 0.f;
#pragma unroll
        for (int j = 0; j < 4; ++j) { const unsigned long long xw = xr[64 * j]; v[j] = (f32x4){bf_lo((unsigned)xw), bf_hi((unsigned)xw), bf_lo((unsigned)(xw >> 32)), bf_hi((unsigned)(xw >> 32))}; const unsigned a = y0[64 * j], b = y1[64 * j];
            v[j].x += w0 * fp8_f32(a, 0) + w1 * fp8_f32(b, 0); v[j].y += w0 * fp8_f32(a, 1) + w1 * fp8_f32(b, 1);
            v[j].z += w0 * fp8_f32(a, 2) + w1 * fp8_f32(b, 2); v[j].w += w0 * fp8_f32(a, 3) + w1 * fp8_f32(b, 3);
            s += (v[j].x * v[j].x + v[j].y * v[j].y) + (v[j].z * v[j].z + v[j].w * v[j].w); }
        s = wave_sum(s);
        const float rs = 1.0f / sqrtf(s * (1.0f / DM) + EPS);
#pragma unroll
        for (int j = 0; j < 4; ++j) orow[64 * j] = v[j] * rs * gf[j];
    }
}

constexpr int N_PHASES = 10;
#ifndef DUP_TRIVIAL
#define DUP_TRIVIAL 0
#endif
#ifndef DUP_PHASE
#define DUP_PHASE -1
#endif
typedef __attribute__((address_space(4))) const unsigned char* karg_ptr;
__device__ __forceinline__ const float* arg_in(int k) { karg_ptr base = (karg_ptr)__builtin_amdgcn_kernarg_segment_ptr(); const unsigned long long v = *(const unsigned long long volatile __attribute__((address_space(4)))*)(base + 8 * k); return (const float*)(const GAS float*)v; }
struct Args { const float* in[23]; float* out; unsigned char* ws; int ph_lo, ph_hi, mode, pad; };
__global__ void __launch_bounds__(NWAVES * 64, 2) fwd_kernel(Args args) {
    extern __shared__ __attribute__((aligned(16))) unsigned char lds[];
    Frame F;
    F.lds = (LAS unsigned char*)lds;
    F.wave = __builtin_amdgcn_readfirstlane((int)threadIdx.x >> 6); F.lane = pg8::lane_now(); F.tid = F.wave * 64 + F.lane;
    F.G = gridDim.x; { const int bx = blockIdx.x; F.vcu = (F.G % 8 == 0) ? (bx % 8) * (F.G / 8) + bx / 8 : bx; }
    unsigned char* ws = args.ws;
    gu32* ctl = (gu32*)(ws + WS_CTL);
    volatile LAS unsigned* MISC = (volatile LAS unsigned*)(F.lds + MISC_OFF);
    for (int u = F.tid; u < (LDS_BYTES - LDSCTL_OFF) / 4; u += NWAVES * 64) ((LAS unsigned*)(F.lds + LDSCTL_OFF))[u] = 0u;
    __syncthreads();
#if MK_ONE_LAUNCH
    XcdBarrier bar = xcd_barrier_post((unsigned*)(ctl + CW_BAR), MISC + 8);
#define GRID_BAR() xcd_barrier(bar)
#else
#define GRID_BAR() do { } while (0)
#endif
    const int lo = args.ph_lo, hi = args.ph_hi;
#ifndef PH_MASK
#define PH_MASK 0x3ff
#endif
#define IN(k) (((PH_MASK >> (k)) & 1) && lo <= (k) && (k) < hi)
#define BOTH(k) (IN(k) && IN((k) + 1))
    float* out = args.out;
    bf16* Win = (bf16*)(ws + WS_WIN); bf16* Wl = (bf16*)(ws + WS_WL); bf16* Wa = (bf16*)(ws + WS_WA); bf16* Wo = (bf16*)(ws + WS_WO); bf16* Wrg = (bf16*)(ws + WS_WRG);
    bf16* XB = (bf16*)(ws + WS_XB); bf16* XR = (bf16*)(ws + WS_XR); bf16* GG = (bf16*)(ws + WS_GG); bf16* Qb = (bf16*)(ws + WS_Q); bf16* Kb = (bf16*)(ws + WS_K); bf16* Vb = (bf16*)(ws + WS_V);
    bf16* SL = (bf16*)out; bf16* SA = (bf16*)out + pg8::SEGE;
    float* RS1 = (float*)(ws + WS_RS1); float* RS2 = (float*)(ws + WS_RS2); float* LF = (float*)(ws + WS_LF); float* CB = (float*)(ws + WS_CB);
    unsigned* TOK = (unsigned*)(ws + WS_TOK); int* LISTS = (int*)(ws + WS_LISTS); float* WRT = (float*)(ws + WS_WRT); int* JLO = (int*)(ws + WS_SRS);
    unsigned char* W13 = ws + WS_W13; unsigned char* W2 = ws + WS_W2; bf16* XG = (bf16*)(ws + WS_XG); unsigned char* HB = ws + WS_HB; unsigned char* X8 = ws + WS_XB;
    gu32* CNT = ctl + CW_CNT;

    if (IN(0)) { F.lane = pg8::lane_now(); F.tid = F.wave * 64 + F.lane;
        P0Args a{arg_in(0), arg_in(1), arg_in(2), arg_in(5), arg_in(7), arg_in(10), arg_in(11), arg_in(12), arg_in(13), arg_in(14), arg_in(15), arg_in(17), arg_in(19), arg_in(20), Win, Wl, Wa, Wo, Wrg, XB, W13, RS1, LF, WRT};
        p0_prologue(F, a, DUP_PHASE == 0 ? args.mode : 0);
        if (BOTH(0)) GRID_BAR();
    }
    if (IN(1)) { F.lane = pg8::lane_now(); F.tid = F.wave * 64 + F.lane;
        cumsum_bias(F, LF, CB);
        pg8::Gemm g{XB, Win, T, NZ, DM}; pg8::StaticOrder S; S.init(T, NZ, F.G, (int)blockIdx.x);
        pg8::EpiZ E{XR, SL, RS1, (unsigned*)(ctl + CW_NORM), args.mode};
        pg8::gemm_phase<pg8::EpiZ, pg8::StaticOrder, true, true>(F.lds + RING_OFF, g, S, E, F.wave);
        if (BOTH(1)) GRID_BAR();
    }
    if (IN(2)) { F.lane = pg8::lane_now(); F.tid = F.wave * 64 + F.lane;
        { const int gw = F.vcu * NWAVES + F.wave; if (gw < NB * NH * 16) { const int j = attn_jlo(F, CB, (const unsigned*)(ctl + CW_NORM), gw >> 4, gw & 15); if (F.lane == 0) JLO[gw] = j; } }
        conv_prepass(F, XR, XB, arg_in(3), arg_in(4));
        if (BOTH(2)) GRID_BAR();
    }
    if (IN(3)) { F.lane = pg8::lane_now(); F.tid = F.wave * 64 + F.lane;
        RgArgs ra{XB, GG, GG, Wrg, arg_in(6), arg_in(8), arg_in(9)};
#if DUP_PHASE >= 20
        const int mode = args.mode;
#else
        constexpr int mode = 0;
#endif
        if (mode != 2) { ra.GO = mode == 1 ? XR : GG; for (int u = F.vcu; u < 256; u += F.G) rglru_unit(F, ra, u); }
        if (mode != 1) attn_phase(F, (char*)lds + RING_OFF, Qb, XR, Kb, Vb, CB, JLO, ctl + CW_QCTR + (mode == 2 ? 1024 : 0));
        if (BOTH(3)) GRID_BAR();
    }
    if (IN(4)) { { F.lane = pg8::lane_now(); F.tid = F.wave * 64 + F.lane;
        static_assert(WS_GG - WS_XR == (size_t)128 * 256 * DM * 2 && WS_WL - WS_WA == (size_t)4 * 256 * DM * 2, "TwoGemmOrder: hg follows o by 128 row tiles, Wl follows Wa by 4 column tiles");
        pg8::Gemm g{XR, Wa, T, DM, DM}; pg8::TwoGemmOrder S; S.init(T, DM, F.G, (int)blockIdx.x);
        pg8::EpiGate2 E{SA, SL, XB};
        pg8::gemm_phase<pg8::EpiGate2, pg8::TwoGemmOrder, true, true>(F.lds + RING_OFF, g, S, E, F.wave); }
        if (BOTH(4)) GRID_BAR();
    }
    if (IN(5)) { F.lane = pg8::lane_now(); F.tid = F.wave * 64 + F.lane;
        pg8::Gemm g{XB, Wo, T, DM, DM}; pg8::StaticOrder S; S.init(T, DM, F.G, (int)blockIdx.x);
        pg8::EpiDelta E{(bf16*)out};
        pg8::gemm_phase<pg8::EpiDelta, pg8::StaticOrder, true, true>(F.lds + RING_OFF, g, S, E, F.wave);
        if (BOTH(5)) GRID_BAR();
    }
    if (IN(6)) { F.lane = pg8::lane_now(); F.tid = F.wave * 64 + F.lane;
        P5Args a{arg_in(0), WRT, arg_in(16), arg_in(18), arg_in(21), (const bf16*)out, XR, X8, W2, RS2, LISTS, TOK, args.mode ? CNT + 64 : CNT};
        p5_route(F, a);
        if (BOTH(6)) GRID_BAR();
    }
    if (IN(7)) { F.lane = pg8::lane_now(); F.tid = F.wave * 64 + F.lane;
        build_tables(F, CNT);
        const int ntiles = ((const LAS int*)(F.lds + TBL_PS))[32] >> 8;
        pg8::Gemm g{(const bf16*)X8, (const bf16*)W13, ntiles * 256, 32 * 1024, DM / 2}; pg8::GroupedOrder S{(const LAS int*)(F.lds + TBL_TE), ntiles * 4, F.G, F.vcu};
        LAS int* rowtab = (LAS int*)(F.lds + RG_TOT);
        build_rowtab(F, S, LISTS, RS2, rowtab);
        pg8::EpiSwiGLU E{HB};
        pg8::gemm_phase_gather<pg8::EpiSwiGLU, pg8::GroupedOrder, true>(F.lds + RING_OFF, g, S, E, rowtab, F.wave);
        if (BOTH(7)) GRID_BAR();
    }
    if (IN(8)) { F.lane = pg8::lane_now(); F.tid = F.wave * 64 + F.lane;
        build_tables(F, CNT);
        const int ntiles = ((const LAS int*)(F.lds + TBL_PS))[32] >> 8;
        pg8::Gemm g{(const bf16*)HB, (const bf16*)W2, ntiles * 256, 32 * 1024, DE / 2}; pg8::GroupedOrder S{(const LAS int*)(F.lds + TBL_TE), ntiles * 4, F.G, F.vcu};
        pg8::EpiY E{(unsigned char*)XG};
        pg8::gemm_phase<pg8::EpiY, pg8::GroupedOrder, true, true, true>(F.lds + RING_OFF, g, S, E, F.wave);
        if (BOTH(8)) GRID_BAR();
    }
    if (IN(9)) { F.lane = pg8::lane_now(); F.tid = F.wave * 64 + F.lane;
        build_tables(F, CNT);
        p9_final(F, XR, out, (const unsigned char*)XG, TOK, arg_in(22));
    }
#undef IN
#undef BOTH
}

extern "C" void kernel_launch(void* const* d_in, const int* in_sizes, int n_in, void* d_out, int out_size, void* d_ws, size_t ws_size, hipStream_t stream) {
    static int grid = 0;
    if (grid == 0) {
        if (n_in != 23 || in_sizes[0] != T * DM || out_size != T * DM || ws_size < WS_END) { fprintf(stderr, "kernel_launch: unexpected shapes (n_in %d, in0 %d, out %d, ws %zu); nothing launched\n", n_in, n_in > 0 ? in_sizes[0] : -1, out_size, ws_size); grid = -1; return; }
        int dev = 0, cus = 0;
        if (hipGetDevice(&dev) != hipSuccess || hipDeviceGetAttribute(&cus, hipDeviceAttributeMultiprocessorCount, dev) != hipSuccess) { grid = -1; return; }
        if (hipFuncSetAttribute((const void*)fwd_kernel, hipFuncAttributeMaxDynamicSharedMemorySize, LDS_BYTES) != hipSuccess) { fprintf(stderr, "kernel_launch: hipFuncSetAttribute failed\n"); grid = -1; return; }
        int per_cu = 0;
        if (hipOccupancyMaxActiveBlocksPerMultiprocessor(&per_cu, (const void*)fwd_kernel, NWAVES * 64, LDS_BYTES) != hipSuccess || per_cu < 1) { fprintf(stderr, "kernel_launch: occupancy query reports %d\n", per_cu); }
        (void)hipGetLastError();
        grid = cus;
    }
    if (grid < 0) return;
    if (hipMemsetAsync((char*)d_ws + WS_CTL, 0, CTL_ZERO_BYTES, stream) != hipSuccess) return;
    Args a{};
    for (int i = 0; i < 23; ++i) a.in[i] = (const float*)d_in[i];
    a.out = (float*)d_out; a.ws = (unsigned char*)d_ws;
#if MK_ONE_LAUNCH
    a.ph_lo = 0; a.ph_hi = N_PHASES;
    hipLaunchKernelGGL(fwd_kernel, dim3(grid), dim3(NWAVES * 64), LDS_BYTES, stream, a);
#else
    for (int ph = 0; ph < N_PHASES; ++ph) { a.ph_lo = ph; a.ph_hi = ph + 1;
        if (DUP_PHASE == ph || (ph == 3 && DUP_PHASE >= 20)) { a.mode = DUP_PHASE >= 20 ? DUP_PHASE - 19 : ((ph == 6 || (ph == 1 && DUP_TRIVIAL)) ? 1 : (ph == 0 ? DUP_TRIVIAL : 0)); hipLaunchKernelGGL(fwd_kernel, dim3(grid), dim3(NWAVES * 64), LDS_BYTES, stream, a); a.mode = 0; }
        hipLaunchKernelGGL(fwd_kernel, dim3(grid), dim3(NWAVES * 64), LDS_BYTES, stream, a); }
#endif
}
```

```cpp
#include <hip/hip_runtime.h>
#include <cstdio>
#include <cstdint>

#ifndef MK_ONE_LAUNCH
#define MK_ONE_LAUNCH 1
#endif
namespace pg8 {
#define PG8_LAS __attribute__((address_space(3)))
typedef unsigned short bf16_t;
typedef short bf16x8 __attribute__((ext_vector_type(8)));
typedef float f32x4 __attribute__((ext_vector_type(4)));
typedef unsigned u32x4 __attribute__((ext_vector_type(4)));
constexpr int BM = 256, BK = 64, HALF = 128, HTB = HALF * BK * 2  , STAGE_BYTES = 8 * HTB, NXCD = 8, WGM = 8;

__host__ __device__ __forceinline__ int lds_byte(int r, int c) { const int st = (r >> 4) * 2 + (c >> 5), rr = r & 15, cc = c & 31, ob = rr * 64 + cc * 2; return st * 1024 + (ob ^ (((ob >> 9) & 1) << 5)); }
__host__ __device__ __forceinline__ void stage_rc(int b, int& R, int& C) { const int st = b / 1024, sb = b % 1024, swz = sb ^ (((sb >> 9) & 1) << 5); R = (st >> 1) * 16 + swz / 64; C = (st & 1) * 32 + (swz % 64) / 2; }
__host__ __device__ __forceinline__ int perm32(int rho) { const int n = rho >> 4, i = rho & 15; return 8 * (i >> 2) + 4 * n + (i & 3); }

struct Unit { int pm, pn; };
struct Gemm { const bf16_t* A; const bf16_t* Bt; int M, N, K; };

struct StaticOrder {
    int nM, nN, nwg, G, c;
    __host__ __device__ void init(int M, int N, int G_, int c_) { nM = M / BM; nN = N / BM; nwg = nM * nN; G = G_; c = c_; }
    __host__ __device__ bool next(int i, Unit& u) const {
        const long L = (long)i * G + c; if (L >= nwg) return false;
        int wgid = (int)L; { const int q = nwg / NXCD, r = nwg % NXCD, xcd = wgid % NXCD, off = wgid / NXCD; wgid = (xcd < r ? xcd * (q + 1) : r * (q + 1) + (xcd - r) * q) + off; }
        const int nig = WGM * nN, gid = wgid / nig, fm = gid * WGM, gsz = (nM - fm) < WGM ? (nM - fm) : WGM;
        u.pm = fm + ((wgid % nig) % gsz); u.pn = (wgid % nig) / gsz; return true;
    }
    __device__ __forceinline__ void a_ready(const Unit&) const {}
    __device__ __forceinline__ void done(const Unit&) const {}
};

__device__ __forceinline__ unsigned cvt_pk_bf16(float lo, float hi) { unsigned r; asm volatile("v_cvt_pk_bf16_f32 %0, %1, %2" : "=v"(r) : "v"(lo), "v"(hi)); return r; }
typedef float f32x2 __attribute__((ext_vector_type(2)));
__device__ __forceinline__ int lane_now() { int l; asm volatile("v_mbcnt_lo_u32_b32 %0, -1, 0\n\tv_mbcnt_hi_u32_b32 %0, -1, %0" : "=v"(l)); return l; }
typedef int v4i_t __attribute__((ext_vector_type(4)));
typedef int v8i_t __attribute__((ext_vector_type(8)));
__device__ __forceinline__ v8i_t cat8(bf16x8 a, bf16x8 b) { const v4i_t x = __builtin_bit_cast(v4i_t, a), y = __builtin_bit_cast(v4i_t, b); return __builtin_shufflevector(x, y, 0, 1, 2, 3, 4, 5, 6, 7); }
__device__ __forceinline__ void glds_sv(const char* base, unsigned voff, unsigned lds_dst) { unsigned keep;
    asm volatile("s_mov_b32 %0, m0\n\ts_mov_b32 m0, %3\n\ts_nop 0\n\tglobal_load_lds_dwordx4 %1, %2\n\ts_mov_b32 m0, %0" : "=&s"(keep) : "v"(voff), "s"(base), "s"(lds_dst) : "memory"); }
__device__ __forceinline__ float sat8(float x) { return __builtin_amdgcn_fmed3f(x, -448.0f, 448.0f); }
__device__ __forceinline__ unsigned pack4_fp8(float a, float b, float c, float d) { unsigned w = 0u; w = __builtin_amdgcn_cvt_pk_fp8_f32(sat8(a), sat8(b), w, false); w = __builtin_amdgcn_cvt_pk_fp8_f32(sat8(c), sat8(d), w, true); return w; }
constexpr float W13_SCALE = 64.0f, HB_SCALE = 8.0f, W2_SCALE = 32.0f;
__device__ __forceinline__ float sigmoid_f(float x) { return __builtin_amdgcn_rcpf(1.0f + __builtin_amdgcn_exp2f(-1.4426950408889634f * x)); }
__device__ __forceinline__ float gelu_tanh_f(float x) { const float u = x * (1.0f + 0.044715f * x * x); return x * __builtin_amdgcn_rcpf(1.0f + __builtin_amdgcn_exp2f(-2.3022081981f * u)); }
__device__ __forceinline__ float bf_lo(unsigned w) { return __builtin_bit_cast(float, w << 16); }
__device__ __forceinline__ float bf_hi(unsigned w) { return __builtin_bit_cast(float, w & 0xffff0000u); }
constexpr size_t SEGE = (size_t)32768 * 1024;

struct EpiZ {
    static constexpr bool PERM = true, AFTER_DRAIN = false; static constexpr int NSTORES = 16;
    bf16_t* ws5; bf16_t* out2; const float* rs; unsigned* norm; int probe;
    __device__ __forceinline__ void operator()(const f32x4 (&acc)[2][2][4][2], const Unit& u, int wr, int wc, int fr, int fq) const {
        const int seg = probe ? 0 : (u.pn >> 2); float nm[2] = {0.f, 0.f};
        const int sgo = u.pn >> 2; bf16_t* O = sgo < 5 ? ws5 + (size_t)sgo * SEGE : out2 + (size_t)(sgo - 5) * SEGE;
        const int row0 = u.pm * BM + wr * 64 + fr, col0 = (u.pn & 3) * BM + wc * 32 + 8 * fq;
#pragma unroll
        for (int ai = 0; ai < 2; ++ai)
#pragma unroll
            for (int m = 0; m < 4; ++m) { const int row = row0 + ai * HALF + m * 16; bf16_t* rowp = O + (size_t)row * 1024 + col0;
                const bool hm = (sgo >= 2 && sgo <= 4); bf16_t* rowh = O + ((size_t)((row >> 12) * 8 + 2 * (u.pn & 3)) * 4096 + (row & 4095)) * 128 + wc * 32 + 8 * fq;
#pragma unroll
                for (int bj = 0; bj < 2; ++bj) { f32x4 v0 = acc[ai][bj][m][0], v1 = acc[ai][bj][m][1];
                    if (seg == 1) {
#pragma unroll
                        for (int i = 0; i < 4; ++i) { v0[i] = gelu_tanh_f(v0[i]); v1[i] = gelu_tanh_f(v1[i]); } }
                    else if (seg >= 5) {
#pragma unroll
                        for (int i = 0; i < 4; ++i) { v0[i] = sigmoid_f(v0[i]); v1[i] = sigmoid_f(v1[i]); } }
                    if (seg == 2 || seg == 3) { float q = (v0[0] * v0[0] + v0[1] * v0[1]) + (v0[2] * v0[2] + v0[3] * v0[3]) + (v1[0] * v1[0] + v1[1] * v1[1]) + (v1[2] * v1[2] + v1[3] * v1[3]);
                        q += __shfl_xor(q, 16); q += __shfl_xor(q, 32); nm[bj] = fmaxf(nm[bj], q); }
                    u32x4 w; w.x = cvt_pk_bf16(v0[0], v0[1]); w.y = cvt_pk_bf16(v0[2], v0[3]); w.z = cvt_pk_bf16(v1[0], v1[1]); w.w = cvt_pk_bf16(v1[2], v1[3]);
                    *(u32x4*)(hm ? rowh + (size_t)bj * 4096 * 128 : rowp + bj * HALF) = w; } }
        if (seg == 2 || seg == 3) {
#pragma unroll
            for (int bj = 0; bj < 2; ++bj) { float q = nm[bj];
#pragma unroll
                for (int o = 1; o < 16; o <<= 1) q = fmaxf(q, __shfl_xor(q, o));
                if (fr == 0 && fq == 0) atomicMax(norm + ((((seg - 2) * 8 + (u.pm >> 4)) * 8 + 2 * (u.pn & 3) + bj) * 4 + wc), __float_as_uint(q)); }
        }
    }
};
template <int MODE> struct EpiGate {
    static constexpr bool PERM = true, AFTER_DRAIN = false; static constexpr int NSTORES = 16;
    const bf16_t* G; bf16_t* O;
    __device__ __forceinline__ void operator()(const f32x4 (&acc)[2][2][4][2], const Unit& u, int wr, int wc, int fr, int fq) const {
        const int row0 = u.pm * BM + wr * 64 + fr, col0 = u.pn * BM + wc * 32 + 8 * fq;
        u32x4 gv[2][2][2], pv[2][2][2];
#define EG_LOAD(st_, b_) do { _Pragma("unroll") for (int mm = 0; mm < 2; ++mm) _Pragma("unroll") for (int bj = 0; bj < 2; ++bj) { \
            const size_t off_ = (size_t)(row0 + ((st_) >> 1) * HALF + (2 * ((st_) & 1) + mm) * 16) * 1024 + col0 + bj * HALF; gv[b_][mm][bj] = *(const u32x4*)(G + off_); if (MODE == 1) pv[b_][mm][bj] = *(const u32x4*)(O + off_); } } while (0)
#define EG_DO(st_, b_) do { _Pragma("unroll") for (int mm = 0; mm < 2; ++mm) _Pragma("unroll") for (int bj = 0; bj < 2; ++bj) { const int ai = (st_) >> 1, m = 2 * ((st_) & 1) + mm; \
            const size_t off_ = (size_t)(row0 + ai * HALF + m * 16) * 1024 + col0 + bj * HALF; const u32x4 g = gv[b_][mm][bj]; \
            f32x4 v0 = acc[ai][bj][m][0], v1 = acc[ai][bj][m][1]; \
            v0[0] *= bf_lo(g.x); v0[1] *= bf_hi(g.x); v0[2] *= bf_lo(g.y); v0[3] *= bf_hi(g.y); v1[0] *= bf_lo(g.z); v1[1] *= bf_hi(g.z); v1[2] *= bf_lo(g.w); v1[3] *= bf_hi(g.w); \
            if (MODE == 1) { const u32x4 p = pv[b_][mm][bj]; \
                v0[0] += bf_lo(p.x); v0[1] += bf_hi(p.x); v0[2] += bf_lo(p.y); v0[3] += bf_hi(p.y); v1[0] += bf_lo(p.z); v1[1] += bf_hi(p.z); v1[2] += bf_lo(p.w); v1[3] += bf_hi(p.w); } \
            u32x4 w; w.x = cvt_pk_bf16(v0[0], v0[1]); w.y = cvt_pk_bf16(v0[2], v0[3]); w.z = cvt_pk_bf16(v1[0], v1[1]); w.w = cvt_pk_bf16(v1[2], v1[3]); \
            *(u32x4*)(O + off_) = w; } } while (0)
        EG_LOAD(0, 0); EG_LOAD(1, 1); EG_DO(0, 0); EG_LOAD(2, 0); EG_DO(1, 1); EG_LOAD(3, 1); EG_DO(2, 0); EG_DO(3, 1);
#undef EG_LOAD
#undef EG_DO
    }
};
struct TwoGemmOrder {
    StaticOrder base; int n1;
    __device__ void init(int M, int N, int G_, int c_) { base.init(M, N, G_, c_); n1 = (base.nwg - c_ + G_ - 1) / G_; if (n1 < 0) n1 = 0; }
    __device__ __forceinline__ bool next(int i, Unit& u) const { if (i >= 2 * n1) return false; const bool second = i >= n1; base.next(second ? i - n1 : i, u); if (second) { u.pm += 128; u.pn += 4; } return true; }
    __device__ __forceinline__ void a_ready(const Unit&) const {}
    __device__ __forceinline__ void done(const Unit&) const {}
};
struct EpiGate2 {
    static constexpr bool PERM = true, AFTER_DRAIN = false; static constexpr int NSTORES = 16;
    const bf16_t* G0; const bf16_t* G1; bf16_t* O;
    __device__ __forceinline__ void operator()(const f32x4 (&acc)[2][2][4][2], const Unit& u, int wr, int wc, int fr, int fq) const {
        Unit v; v.pm = u.pm & 127; v.pn = u.pn & 3;
        if (u.pm >= 128) { EpiGate<1> e{G1, O}; e(acc, v, wr, wc, fr, fq); } else { EpiGate<0> e{G0, O}; e(acc, v, wr, wc, fr, fq); }
    }
};
struct EpiDelta {
    static constexpr bool PERM = true, AFTER_DRAIN = false; static constexpr int NSTORES = 16;
    bf16_t* O;
    __device__ __forceinline__ void operator()(const f32x4 (&acc)[2][2][4][2], const Unit& u, int wr, int wc, int fr, int fq) const {
        const int row0 = u.pm * BM + wr * 64 + fr, col0 = u.pn * BM + wc * 32 + 8 * fq;
#pragma unroll
        for (int ai = 0; ai < 2; ++ai)
#pragma unroll
            for (int m = 0; m < 4; ++m) { bf16_t* rowp = O + (size_t)(row0 + ai * HALF + m * 16) * 1024 + col0;
#pragma unroll
                for (int bj = 0; bj < 2; ++bj) { const f32x4 v0 = acc[ai][bj][m][0], v1 = acc[ai][bj][m][1];
                    u32x4 w; w.x = cvt_pk_bf16(v0[0], v0[1]); w.y = cvt_pk_bf16(v0[2], v0[3]); w.z = cvt_pk_bf16(v1[0], v1[1]); w.w = cvt_pk_bf16(v1[2], v1[3]);
                    *(u32x4*)(rowp + bj * HALF) = w; } }
    }
};
struct EpiSwiGLU {
    static constexpr bool PERM = true, AFTER_DRAIN = false; static constexpr int NSTORES = 8;
    unsigned char* HB;
    __device__ __forceinline__ void operator()(const f32x4 (&acc)[2][2][4][2], const Unit& u, int wr, int wc, int fr, int fq, const PG8_LAS int* rows) const {
        const int row0 = u.pm * BM + wr * 64 + fr, col0 = (u.pn & 3) * HALF + wc * 32 + 8 * fq;
        float sv[2][4];
#pragma unroll
        for (int ai = 0; ai < 2; ++ai)
#pragma unroll
            for (int m = 0; m < 4; ++m) sv[ai][m] = ((const PG8_LAS float*)rows)[6 * 256 + wr * 64 + fr + ai * HALF + m * 16] * (1.0f / W13_SCALE);
#pragma unroll
        for (int ai = 0; ai < 2; ++ai)
#pragma unroll
            for (int m = 0; m < 4; ++m) { const int row = row0 + ai * HALF + m * 16; const float s = sv[ai][m];
                float o[8];
#pragma unroll
                for (int n = 0; n < 2; ++n)
#pragma unroll
                    for (int i = 0; i < 4; ++i) { const float g = acc[ai][0][m][n][i] * s, uu = acc[ai][1][m][n][i] * s; o[n * 4 + i] = g * sigmoid_f(g) * uu * HB_SCALE; }
                unsigned long long w = (unsigned long long)pack4_fp8(o[0], o[1], o[2], o[3]) | ((unsigned long long)pack4_fp8(o[4], o[5], o[6], o[7]) << 32);
                *(unsigned long long*)(HB + (size_t)row * 512 + col0) = w; }
    }
};
constexpr float Y_SCALE = 0.25f;
struct EpiY {
    static constexpr bool PERM = true, AFTER_DRAIN = false; static constexpr int NSTORES = 16;
    unsigned char* Y;
    __device__ __forceinline__ void operator()(const f32x4 (&acc)[2][2][4][2], const Unit& u, int wr, int wc, int fr, int fq) const {
        const int row0 = u.pm * BM + wr * 64 + fr, col0 = (u.pn & 3) * BM + wc * 32 + 8 * fq;
#pragma unroll
        for (int ai = 0; ai < 2; ++ai)
#pragma unroll
            for (int m = 0; m < 4; ++m) { const int row = row0 + ai * HALF + m * 16; unsigned char* rowp = Y + (size_t)row * 1024 + col0;
#pragma unroll
                for (int bj = 0; bj < 2; ++bj) { const f32x4 v0 = acc[ai][bj][m][0] * Y_SCALE, v1 = acc[ai][bj][m][1] * Y_SCALE;
                    *(unsigned long long*)(rowp + bj * HALF) = (unsigned long long)pack4_fp8(v0[0], v0[1], v0[2], v0[3]) | ((unsigned long long)pack4_fp8(v1[0], v1[1], v1[2], v1[3]) << 32); } }
    }
};
struct GroupedOrder {
    const PG8_LAS int* tile_e; int nunits, G, c;
    __device__ __forceinline__ bool next(int i, Unit& u) const { const int L = i * G + c; if (L >= nunits) return false; u.pm = L >> 2; u.pn = __builtin_amdgcn_readfirstlane(tile_e[u.pm]) * 4 + (L & 3); return true; }
    __device__ __forceinline__ void a_ready(const Unit&) const {}
    __device__ __forceinline__ void done(const Unit&) const {}
};
template <class Epi, class Sched, bool ALIGN_EPI = false, bool SP2 = false, bool F8 = false>
__device__ __forceinline__ void gemm_phase(PG8_LAS unsigned char* lds, const Gemm g, const Sched& S, const Epi& E, const int wid) {
    const int lane = lane_now(), tid = wid * 64 + lane, wr = wid >> 2, wc = wid & 3, fr = lane & 15, fq = lane >> 4;
    const int K = g.K, nt = K / BK;
    unsigned voffA[2], voffB[2];
#pragma unroll
    for (int i = 0; i < 2; ++i) { int R, C; stage_rc(tid * 16 + i * 8192, R, C); const int Rb = Epi::PERM ? ((R & ~31) + perm32(R & 31)) : R;
        voffA[i] = (unsigned)(R * K + C) * 2u; voffB[i] = (unsigned)(Rb * K + C) * 2u; }
    const size_t kstep = (size_t)(BK * 2);
    const size_t hstep = (size_t)HALF * K * 2;
    const size_t tstep = 2 * hstep;
    const unsigned ldsw = (unsigned)wid * 1024u;
    const unsigned ldsbase = (unsigned)__builtin_amdgcn_readfirstlane((int)((unsigned)(uintptr_t)lds + ldsw));
    const int aoff = lds_byte(wr * 64 + fr, fq * 8), boff = lds_byte(wc * 32 + fr, fq * 8);
#define PG8_SA(b, h) (((b) * 2 + (h)) * HTB)
#define PG8_SB(b, h) ((4 + (b) * 2 + (h)) * HTB)
#define PG8_STAGE(bufoff, gbase, voff) do { _Pragma("unroll") for (int _i = 0; _i < 2; ++_i) { \
        if constexpr (F8) glds_sv((const char*)(gbase), (voff)[_i], ldsbase + (unsigned)((bufoff) + _i * 8192)); \
        else __builtin_amdgcn_global_load_lds((const unsigned*)((const char*)(gbase) + (voff)[_i]), (PG8_LAS unsigned*)(lds + (bufoff) + ldsw + _i * 8192), 16, 0, 0); } } while (0)
#define PG8_LDA(dst, b, h) do { _Pragma("unroll") for (int m = 0; m < 4; ++m) { \
        if constexpr (F8) { dst##8[m] = cat8(*(const PG8_LAS bf16x8*)(lds + PG8_SA(b, h) + aoff + m * 2048), *(const PG8_LAS bf16x8*)(lds + PG8_SA(b, h) + aoff + m * 2048 + 1024)); } \
        else { _Pragma("unroll") for (int k = 0; k < 2; ++k) dst[m][k] = *(const PG8_LAS bf16x8*)(lds + PG8_SA(b, h) + aoff + m * 2048 + k * 1024); } } } while (0)
#define PG8_LDB(dst, b, h) do { _Pragma("unroll") for (int n = 0; n < 2; ++n) { \
        if constexpr (F8) { dst##8[n] = cat8(*(const PG8_LAS bf16x8*)(lds + PG8_SB(b, h) + boff + n * 2048), *(const PG8_LAS bf16x8*)(lds + PG8_SB(b, h) + boff + n * 2048 + 1024)); } \
        else { _Pragma("unroll") for (int k = 0; k < 2; ++k) dst[n][k] = *(const PG8_LAS bf16x8*)(lds + PG8_SB(b, h) + boff + n * 2048 + k * 1024); } } } while (0)
#define PG8_MMA(ai, bj, At, Bt) do { __builtin_amdgcn_s_setprio(1); _Pragma("unroll") for (int m = 0; m < 4; ++m) _Pragma("unroll") for (int n = 0; n < 2; ++n) { \
        if constexpr (F8) { acc[ai][bj][m][n] = __builtin_amdgcn_mfma_scale_f32_16x16x128_f8f6f4(Bt##8[n], At##8[m], acc[ai][bj][m][n], 0, 0, 0, 0, 0, 0); } \
        else { _Pragma("unroll") for (int k = 0; k < 2; ++k) acc[ai][bj][m][n] = __builtin_amdgcn_mfma_f32_16x16x32_bf16(Bt[n][k], At[m][k], acc[ai][bj][m][n], 0, 0, 0); } } \
        __builtin_amdgcn_s_setprio(0); } while (0)
#define PG8_WAIT_V(n) asm volatile("s_waitcnt vmcnt(" #n ")" ::: "memory")
#define PG8_WAIT_L(n) asm volatile("s_waitcnt lgkmcnt(" #n ")" ::: "memory")
#define PG8_BAR __builtin_amdgcn_s_barrier()
#define PG8_SCHED __builtin_amdgcn_sched_barrier(0)
    Unit cur, nxt; int ui = 0;
    if (!S.next(0, cur)) return;
    f32x4 acc[2][2][4][2];
#pragma unroll
    for (int a = 0; a < 2; ++a)
#pragma unroll
        for (int b = 0; b < 2; ++b)
#pragma unroll
            for (int m = 0; m < 4; ++m)
#pragma unroll
                for (int n = 0; n < 2; ++n) acc[a][b][m][n] = (f32x4){0.f, 0.f, 0.f, 0.f};
    bf16x8 At[4][2], B0[2][2], B1[2][2]; v8i_t At8[4], B08[2], B18[2];
    const char* cA = (const char*)g.A + (size_t)cur.pm * tstep; const char* cB = (const char*)g.Bt + (size_t)cur.pn * tstep;
    S.a_ready(cur);
    if constexpr (SP2) {
        PG8_STAGE(PG8_SB(0, 0), cB, voffB); PG8_STAGE(PG8_SB(0, 1), cB + hstep, voffB); PG8_STAGE(PG8_SA(0, 0), cA, voffA); PG8_STAGE(PG8_SA(0, 1), cA + hstep, voffA);
        if (wr == 1) PG8_BAR;
        PG8_WAIT_V(2); PG8_BAR;
        PG8_STAGE(PG8_SB(1, 0), cB + kstep, voffB); PG8_STAGE(PG8_SA(1, 0), cA + kstep, voffA); PG8_STAGE(PG8_SB(1, 1), cB + hstep + kstep, voffB);
        PG8_WAIT_V(6); PG8_BAR;
    } else {
        PG8_STAGE(PG8_SB(0, 0), cB, voffB); PG8_STAGE(PG8_SA(0, 0), cA, voffA); PG8_STAGE(PG8_SB(0, 1), cB + hstep, voffB); PG8_STAGE(PG8_SA(0, 1), cA + hstep, voffA);
        if (wr == 1) PG8_BAR;
        PG8_WAIT_V(4); PG8_BAR;
        PG8_STAGE(PG8_SB(1, 0), cB + kstep, voffB); PG8_STAGE(PG8_SA(1, 0), cA + kstep, voffA); PG8_STAGE(PG8_SB(1, 1), cB + hstep + kstep, voffB);
        PG8_WAIT_V(6); PG8_BAR;
    }
    for (;;) {
        const bool has_next = S.next(ui + 1, nxt);
        const char* nA = has_next ? (const char*)g.A + (size_t)nxt.pm * tstep : cA; const char* nB = has_next ? (const char*)g.Bt + (size_t)nxt.pn * tstep : cB;
#pragma clang loop unroll(disable)
        for (int t = 0; t < nt; t += 2) {
            const bool last = (t == nt - 2);
            const char* a1 = cA + (size_t)(t + 1) * kstep;
            const char* a2 = last ? nA : cA + (size_t)(t + 2) * kstep; const char* b2 = last ? nB : cB + (size_t)(t + 2) * kstep;
            const char* a3 = a2 + kstep; const char* b3 = b2 + kstep;
            if (last && has_next) S.a_ready(nxt);
            if constexpr (SP2) {
            PG8_LDB(B0, 0, 0); PG8_LDB(B1, 0, 1); PG8_SCHED; PG8_LDA(At, 0, 0); PG8_STAGE(PG8_SA(1, 1), a1 + hstep, voffA);
            PG8_WAIT_V(8); PG8_WAIT_L(0); PG8_BAR; PG8_MMA(0, 0, At, B0); PG8_MMA(0, 1, At, B1); PG8_BAR; PG8_SCHED;
            PG8_LDA(At, 0, 1); PG8_STAGE(PG8_SB(0, 0), b2, voffB); PG8_STAGE(PG8_SB(0, 1), b2 + hstep, voffB); PG8_STAGE(PG8_SA(0, 0), a2, voffA);
            PG8_WAIT_V(8); PG8_WAIT_L(0); PG8_BAR; PG8_MMA(1, 0, At, B0); PG8_MMA(1, 1, At, B1); PG8_BAR; PG8_SCHED;
            PG8_LDB(B0, 1, 0); PG8_LDB(B1, 1, 1); PG8_SCHED; PG8_LDA(At, 1, 0); PG8_STAGE(PG8_SA(0, 1), a2 + hstep, voffA);
            PG8_WAIT_V(8); PG8_WAIT_L(0); PG8_BAR; PG8_MMA(0, 0, At, B0); PG8_MMA(0, 1, At, B1); PG8_BAR; PG8_SCHED;
            PG8_LDA(At, 1, 1); PG8_STAGE(PG8_SB(1, 0), b3, voffB); PG8_STAGE(PG8_SB(1, 1), b3 + hstep, voffB); PG8_STAGE(PG8_SA(1, 0), a3, voffA);
            PG8_WAIT_V(8); PG8_WAIT_L(0); PG8_BAR; PG8_MMA(1, 0, At, B0); PG8_MMA(1, 1, At, B1); PG8_BAR; PG8_SCHED;
            } else {
            PG8_LDB(B0, 0, 0); PG8_SCHED; PG8_LDA(At, 0, 0); PG8_STAGE(PG8_SA(1, 1), a1 + hstep, voffA);
            PG8_WAIT_L(8); PG8_BAR; PG8_WAIT_L(0); PG8_MMA(0, 0, At, B0); PG8_BAR; PG8_SCHED;
            PG8_LDB(B1, 0, 1); PG8_STAGE(PG8_SB(0, 0), b2, voffB);
            PG8_BAR; PG8_WAIT_L(0); PG8_MMA(0, 1, At, B1); PG8_BAR;
            PG8_LDA(At, 0, 1); PG8_STAGE(PG8_SA(0, 0), a2, voffA);
            PG8_BAR; PG8_WAIT_L(0); PG8_MMA(1, 0, At, B0); PG8_BAR; PG8_SCHED;
            PG8_STAGE(PG8_SB(0, 1), b2 + hstep, voffB);
            PG8_WAIT_V(6); PG8_BAR; PG8_MMA(1, 1, At, B1); PG8_BAR;
            PG8_LDB(B0, 1, 0); PG8_SCHED; PG8_LDA(At, 1, 0); PG8_STAGE(PG8_SA(0, 1), a2 + hstep, voffA);
            PG8_WAIT_L(8); PG8_BAR; PG8_WAIT_L(0); PG8_MMA(0, 0, At, B0); PG8_BAR; PG8_SCHED;
            PG8_LDB(B1, 1, 1); PG8_STAGE(PG8_SB(1, 0), b3, voffB);
            PG8_BAR; PG8_WAIT_L(0); PG8_MMA(0, 1, At, B1); PG8_BAR;
            PG8_LDA(At, 1, 1); PG8_STAGE(PG8_SA(1, 0), a3, voffA);
            PG8_BAR; PG8_WAIT_L(0); PG8_MMA(1, 0, At, B0); PG8_BAR; PG8_SCHED;
            PG8_STAGE(PG8_SB(1, 1), b3 + hstep, voffB);
            PG8_WAIT_V(6); PG8_BAR; PG8_MMA(1, 1, At, B1); PG8_BAR;
            }
        }
        if constexpr (ALIGN_EPI) { if (wr == 0) PG8_BAR; }
        if constexpr (!Epi::AFTER_DRAIN) { const int l2 = lane_now(); E(acc, cur, wr, wc, l2 & 15, l2 >> 4); S.done(cur); }
        if (!has_next) break;
#pragma unroll
        for (int a = 0; a < 2; ++a)
#pragma unroll
            for (int b = 0; b < 2; ++b)
#pragma unroll
                for (int m = 0; m < 4; ++m)
#pragma unroll
                    for (int n = 0; n < 2; ++n) acc[a][b][m][n] = (f32x4){0.f, 0.f, 0.f, 0.f};
        cur = nxt; cA = nA; cB = nB; ++ui;
        if constexpr (ALIGN_EPI) { if (wr == 1) PG8_BAR; }
    }
    PG8_WAIT_V(0);
    if constexpr (!ALIGN_EPI) { if (wr == 0) PG8_BAR; }
    PG8_BAR;
    if constexpr (Epi::AFTER_DRAIN) { E.fused(acc, cur, wr, wc, fr, fq, lds, wid, lane); S.done(cur); }
#undef PG8_SA
#undef PG8_SB
#undef PG8_STAGE
#undef PG8_LDA
#undef PG8_LDB
#undef PG8_MMA
#undef PG8_WAIT_V
#undef PG8_WAIT_L
#undef PG8_BAR
#undef PG8_SCHED
}
template <class Epi, class Sched, bool F8 = false>
__device__ __forceinline__ void gemm_phase_gather(PG8_LAS unsigned char* lds, const Gemm g, const Sched& S, const Epi& E, const PG8_LAS int* rowtab, const int wid) {
    constexpr bool ALIGN_EPI = true, SP2 = true;
    const int lane = lane_now(), tid = wid * 64 + lane, wr = wid >> 2, wc = wid & 3, fr = lane & 15, fq = lane >> 4;
    const int K = g.K, nt = K / BK;
    unsigned voffB[2], vAc[2][2];
#pragma unroll
    for (int i = 0; i < 2; ++i) { int R, C; stage_rc(tid * 16 + i * 8192, R, C); const int Rb = Epi::PERM ? ((R & ~31) + perm32(R & 31)) : R;
        voffB[i] = (unsigned)(Rb * K + C) * 2u; }
#define PG8_ROWS(dst, ui_) do { const int t_ = wid * 64 + lane_now(); _Pragma("unroll") for (int i_ = 0; i_ < 2; ++i_) { int R_, C_; stage_rc(t_ * 16 + i_ * 8192, R_, C_); \
        _Pragma("unroll") for (int h_ = 0; h_ < 2; ++h_) dst[h_][i_] = (unsigned)rowtab[(ui_) * 256 + h_ * HALF + R_] * (unsigned)(K * 2) + (unsigned)(C_ * 2); } } while (0)
#define PG8_STAGE_A(bufoff, v, kb) do { _Pragma("unroll") for (int _i = 0; _i < 2; ++_i) { \
        if constexpr (F8) glds_sv((const char*)g.A + (kb), (v)[_i], ldsbase + (unsigned)((bufoff) + _i * 8192)); \
        else __builtin_amdgcn_global_load_lds((const unsigned*)((const char*)g.A + (v)[_i] + (kb)), (PG8_LAS unsigned*)(lds + (bufoff) + ldsw + _i * 8192), 16, 0, 0); } } while (0)
    const size_t kstep = (size_t)(BK * 2);
    const size_t hstep = (size_t)HALF * K * 2;
    const size_t tstep = 2 * hstep;
    const unsigned ldsw = (unsigned)wid * 1024u;
    const unsigned ldsbase = (unsigned)__builtin_amdgcn_readfirstlane((int)((unsigned)(uintptr_t)lds + ldsw));
    const int aoff = lds_byte(wr * 64 + fr, fq * 8), boff = lds_byte(wc * 32 + fr, fq * 8);
#define PG8_SA(b, h) (((b) * 2 + (h)) * HTB)
#define PG8_SB(b, h) ((4 + (b) * 2 + (h)) * HTB)
#define PG8_STAGE(bufoff, gbase, voff) do { _Pragma("unroll") for (int _i = 0; _i < 2; ++_i) { \
        if constexpr (F8) glds_sv((const char*)(gbase), (voff)[_i], ldsbase + (unsigned)((bufoff) + _i * 8192)); \
        else __builtin_amdgcn_global_load_lds((const unsigned*)((const char*)(gbase) + (voff)[_i]), (PG8_LAS unsigned*)(lds + (bufoff) + ldsw + _i * 8192), 16, 0, 0); } } while (0)
#define PG8_LDA(dst, b, h) do { _Pragma("unroll") for (int m = 0; m < 4; ++m) { \
        if constexpr (F8) { dst##8[m] = cat8(*(const PG8_LAS bf16x8*)(lds + PG8_SA(b, h) + aoff + m * 2048), *(const PG8_LAS bf16x8*)(lds + PG8_SA(b, h) + aoff + m * 2048 + 1024)); } \
        else { _Pragma("unroll") for (int k = 0; k < 2; ++k) dst[m][k] = *(const PG8_LAS bf16x8*)(lds + PG8_SA(b, h) + aoff + m * 2048 + k * 1024); } } } while (0)
#define PG8_LDB(dst, b, h) do { _Pragma("unroll") for (int n = 0; n < 2; ++n) { \
        if constexpr (F8) { dst##8[n] = cat8(*(const PG8_LAS bf16x8*)(lds + PG8_SB(b, h) + boff + n * 2048), *(const PG8_LAS bf16x8*)(lds + PG8_SB(b, h) + boff + n * 2048 + 1024)); } \
        else { _Pragma("unroll") for (int k = 0; k < 2; ++k) dst[n][k] = *(const PG8_LAS bf16x8*)(lds + PG8_SB(b, h) + boff + n * 2048 + k * 1024); } } } while (0)
#define PG8_MMA(ai, bj, At, Bt) do { __builtin_amdgcn_s_setprio(1); _Pragma("unroll") for (int m = 0; m < 4; ++m) _Pragma("unroll") for (int n = 0; n < 2; ++n) { \
        if constexpr (F8) { acc[ai][bj][m][n] = __builtin_amdgcn_mfma_scale_f32_16x16x128_f8f6f4(Bt##8[n], At##8[m], acc[ai][bj][m][n], 0, 0, 0, 0, 0, 0); } \
        else { _Pragma("unroll") for (int k = 0; k < 2; ++k) acc[ai][bj][m][n] = __builtin_amdgcn_mfma_f32_16x16x32_bf16(Bt[n][k], At[m][k], acc[ai][bj][m][n], 0, 0, 0); } } \
        __builtin_amdgcn_s_setprio(0); } while (0)
#define PG8_WAIT_V(n) asm volatile("s_waitcnt vmcnt(" #n ")" ::: "memory")
#define PG8_WAIT_L(n) asm volatile("s_waitcnt lgkmcnt(" #n ")" ::: "memory")
#define PG8_BAR __builtin_amdgcn_s_barrier()
#define PG8_SCHED __builtin_amdgcn_sched_barrier(0)
    Unit cur, nxt; int ui = 0;
    if (!S.next(0, cur)) return;
    f32x4 acc[2][2][4][2];
#pragma unroll
    for (int a = 0; a < 2; ++a)
#pragma unroll
        for (int b = 0; b < 2; ++b)
#pragma unroll
            for (int m = 0; m < 4; ++m)
#pragma unroll
                for (int n = 0; n < 2; ++n) acc[a][b][m][n] = (f32x4){0.f, 0.f, 0.f, 0.f};
    bf16x8 At[4][2], B0[2][2], B1[2][2]; v8i_t At8[4], B08[2], B18[2];
    const char* cB = (const char*)g.Bt + (size_t)cur.pn * tstep;
    PG8_ROWS(vAc, 0);
    S.a_ready(cur);
    if constexpr (SP2) {
        PG8_STAGE(PG8_SB(0, 0), cB, voffB); PG8_STAGE(PG8_SB(0, 1), cB + hstep, voffB); PG8_STAGE_A(PG8_SA(0, 0), vAc[0], 0u); PG8_STAGE_A(PG8_SA(0, 1), vAc[1], 0u);
        if (wr == 1) PG8_BAR;
        PG8_WAIT_V(2); PG8_BAR;
        PG8_STAGE(PG8_SB(1, 0), cB + kstep, voffB); PG8_STAGE_A(PG8_SA(1, 0), vAc[0], (unsigned)kstep); PG8_STAGE(PG8_SB(1, 1), cB + hstep + kstep, voffB);
        PG8_WAIT_V(6); PG8_BAR;
    }
    for (;;) {
        const bool has_next = S.next(ui + 1, nxt);
        const char* nB = has_next ? (const char*)g.Bt + (size_t)nxt.pn * tstep : cB;
#pragma clang loop unroll(disable)
        for (int t = 0; t < nt; t += 2) {
            const bool last = (t == nt - 2);
            const unsigned k1 = (unsigned)((t + 1) * (int)kstep), k2 = last ? 0u : (unsigned)((t + 2) * (int)kstep), k3 = k2 + (unsigned)kstep;
            unsigned v2[2][2];
            if (last && has_next) { PG8_ROWS(v2, ui + 1); }
            else {
#pragma unroll
                for (int h_ = 0; h_ < 2; ++h_)
#pragma unroll
                    for (int i_ = 0; i_ < 2; ++i_) v2[h_][i_] = vAc[h_][i_]; }
            const char* b2 = last ? nB : cB + (size_t)(t + 2) * kstep; const char* b3 = b2 + kstep;
            if (last && has_next) S.a_ready(nxt);
            if constexpr (SP2) {
            PG8_LDB(B0, 0, 0); PG8_LDB(B1, 0, 1); PG8_SCHED; PG8_LDA(At, 0, 0); PG8_STAGE_A(PG8_SA(1, 1), vAc[1], k1);
            PG8_WAIT_V(8); PG8_WAIT_L(0); PG8_BAR; PG8_MMA(0, 0, At, B0); PG8_MMA(0, 1, At, B1); PG8_BAR; PG8_SCHED;
            PG8_LDA(At, 0, 1); PG8_STAGE(PG8_SB(0, 0), b2, voffB); PG8_STAGE(PG8_SB(0, 1), b2 + hstep, voffB); PG8_STAGE_A(PG8_SA(0, 0), v2[0], k2);
            PG8_WAIT_V(8); PG8_WAIT_L(0); PG8_BAR; PG8_MMA(1, 0, At, B0); PG8_MMA(1, 1, At, B1); PG8_BAR; PG8_SCHED;
            PG8_LDB(B0, 1, 0); PG8_LDB(B1, 1, 1); PG8_SCHED; PG8_LDA(At, 1, 0); PG8_STAGE_A(PG8_SA(0, 1), v2[1], k2);
            PG8_WAIT_V(8); PG8_WAIT_L(0); PG8_BAR; PG8_MMA(0, 0, At, B0); PG8_MMA(0, 1, At, B1); PG8_BAR; PG8_SCHED;
            PG8_LDA(At, 1, 1); PG8_STAGE(PG8_SB(1, 0), b3, voffB); PG8_STAGE(PG8_SB(1, 1), b3 + hstep, voffB); PG8_STAGE_A(PG8_SA(1, 0), v2[0], k3);
            PG8_WAIT_V(8); PG8_WAIT_L(0); PG8_BAR; PG8_MMA(1, 0, At, B0); PG8_MMA(1, 1, At, B1); PG8_BAR; PG8_SCHED;
            }
        }
        if constexpr (ALIGN_EPI) { if (wr == 0) PG8_BAR; }
        { const int l2 = lane_now(); E(acc, cur, wr, wc, l2 & 15, l2 >> 4, rowtab + ui * 256); } S.done(cur);
        if (!has_next) break;
#pragma unroll
        for (int a = 0; a < 2; ++a)
#pragma unroll
            for (int b = 0; b < 2; ++b)
#pragma unroll
                for (int m = 0; m < 4; ++m)
#pragma unroll
                    for (int n = 0; n < 2; ++n) acc[a][b][m][n] = (f32x4){0.f, 0.f, 0.f, 0.f};
        cur = nxt; cB = nB; ++ui;
        PG8_ROWS(vAc, ui);
        if constexpr (ALIGN_EPI) { if (wr == 1) PG8_BAR; }
    }
    PG8_WAIT_V(0);
    if constexpr (!ALIGN_EPI) { if (wr == 0) PG8_BAR; }
    PG8_BAR;
#undef PG8_ROWS
#undef PG8_STAGE_A
#undef PG8_SA
#undef PG8_SB
#undef PG8_STAGE
#undef PG8_LDA
#undef PG8_LDB
#undef PG8_MMA
#undef PG8_WAIT_V
#undef PG8_WAIT_L
#undef PG8_BAR
#undef PG8_SCHED
}
}
#define GAS __attribute__((address_space(1)))
#define LAS __attribute__((address_space(3)))
typedef unsigned short bf16;
typedef unsigned v4u __attribute__((ext_vector_type(4)));
typedef float f32x4 __attribute__((ext_vector_type(4)));
typedef short bf16x8 __attribute__((ext_vector_type(8)));
typedef GAS unsigned gu32;
typedef GAS unsigned long long gu64;
#define RLX_AGENT __ATOMIC_RELAXED, __HIP_MEMORY_SCOPE_AGENT
#define LDS_WAIT() asm volatile("s_waitcnt lgkmcnt(0)" ::: "memory")
#define VM_WAIT() asm volatile("s_waitcnt vmcnt(0)" ::: "memory")
__device__ __forceinline__ unsigned long long rt() { return __builtin_amdgcn_s_memrealtime(); }
__device__ __forceinline__ unsigned f2bf(float f) { unsigned u = __builtin_bit_cast(unsigned, f); return (u + 0x7fffu + ((u >> 16) & 1u)) >> 16; }
__device__ __forceinline__ unsigned pk2(float lo, float hi) { return f2bf(lo) | (f2bf(hi) << 16); }
#define XB_TMO      128
#define XB_XCNT(j)  (256  + 64 * (j))
#define XB_XSUB(j)  (1280 + 64 * (j))
#define XB_XGEN(j)  (2304 + 64 * (j))
#define XB_TOP      3328
#define XB_TOPGEN   3392
#define XCD_BAR_WORDS 3456
#define XB_SPIN_CAP (1u << 18)

__device__ __forceinline__ unsigned xb_ld(unsigned* p)              { return __hip_atomic_load(p, __ATOMIC_RELAXED, __HIP_MEMORY_SCOPE_AGENT); }
__device__ __forceinline__ unsigned xb_add(unsigned* p, unsigned v) { return __hip_atomic_fetch_add(p, v, __ATOMIC_RELAXED, __HIP_MEMORY_SCOPE_AGENT); }
__device__ __forceinline__ unsigned xb_xcc_id() { return (unsigned)__builtin_amdgcn_s_getreg((3 << 11) | 20) & 0xFu; }
#define XB_SPIN(cond, bar) do { unsigned _sp = 0; while (cond) { __builtin_amdgcn_s_sleep(1); \
    if ((++_sp & 255u) == 0u) { if (xb_ld(&(bar)[XB_TMO])) break; if (_sp > XB_SPIN_CAP) { atomicAdd(&(bar)[XB_TMO], 1u); break; } } } } while (0)

struct XcdBarrier {
    unsigned* bar; unsigned x;
    volatile LAS unsigned* st;
};

__device__ __forceinline__ XcdBarrier xcd_barrier_post(unsigned* bar, volatile LAS unsigned* st) {
    XcdBarrier b; b.bar = bar; b.x = xb_xcc_id(); b.st = st;
    if (threadIdx.x == 0) (void)xb_add(&bar[XB_XCNT(b.x)], 1u);
    return b;
}
__device__ __forceinline__ void xcd_barrier_complete(unsigned* bar, unsigned x, unsigned& nloc, unsigned& nx) {
    const unsigned G = gridDim.x * gridDim.y * gridDim.z;
    unsigned sum, cnt, mine, sp = 0u;
    for (;;) {
        sum = 0u; cnt = 0u; mine = 0u;
#pragma unroll
        for (unsigned j = 0; j < 16; ++j) { const unsigned c = xb_ld(&bar[XB_XCNT(j)]); sum += c; cnt += (c > 0u) ? 1u : 0u; mine = (j == x) ? c : mine; }
        if (sum == G) break;
        __builtin_amdgcn_s_sleep(1);
        if ((++sp & 255u) == 0u) { if (xb_ld(&bar[XB_TMO])) break; if (sp > XB_SPIN_CAP) { atomicAdd(&bar[XB_TMO], 1u); break; } }
    }
    nloc = mine > 0u ? mine : 1u; nx = cnt > 0u ? cnt : 1u;
}

__device__ __forceinline__ void xcd_barrier(const XcdBarrier& b) {
    asm volatile("s_waitcnt vmcnt(0)" ::: "memory");
    __syncthreads();
    if (threadIdx.x == 0) {
        unsigned* bar = b.bar;
        __builtin_amdgcn_s_waitcnt(0);
        unsigned nloc = b.st[0], nx = b.st[1];
        if (nloc == 0u) { xcd_barrier_complete(bar, b.x, nloc, nx); b.st[0] = nloc; b.st[1] = nx; }
        const unsigned old = xb_add(&bar[XB_XSUB(b.x)], 1u);
        const unsigned gen = old / nloc;
        if (old + 1u == (gen + 1u) * nloc) {
            __builtin_amdgcn_fence(__ATOMIC_RELEASE, "agent");
            asm volatile("s_waitcnt vmcnt(0)" ::: "memory");
            const unsigned og = xb_add(&bar[XB_TOP], 1u);
            const unsigned tg = og / nx;
            if (og + 1u == (tg + 1u) * nx) xb_add(&bar[XB_TOPGEN], 1u);
            else XB_SPIN(xb_ld(&bar[XB_TOPGEN]) == tg, bar);
            __builtin_amdgcn_fence(__ATOMIC_ACQUIRE, "agent");
            xb_add(&bar[XB_XGEN(b.x)], 1u);
            asm volatile("s_waitcnt vmcnt(0)" ::: "memory");
        } else {
            XB_SPIN(xb_ld(&bar[XB_XGEN(b.x)]) == gen, bar);
            __builtin_amdgcn_fence(__ATOMIC_ACQUIRE, "agent");
            asm volatile("s_waitcnt vmcnt(0)" ::: "memory");
        }
    }
    __syncthreads();
}
namespace fattn {
typedef unsigned short bf16;
typedef short bf16x8 __attribute__((ext_vector_type(8)));
typedef short s16x4 __attribute__((ext_vector_type(4)));
typedef float f32x16 __attribute__((ext_vector_type(16)));
typedef float f32x4 __attribute__((ext_vector_type(4)));
typedef unsigned u32x4 __attribute__((ext_vector_type(4)));
constexpr int D = 128, LD = 128, LDO = 1024, SEQ = 4096;
constexpr float THR = 8.f;
constexpr float SCALE = 0.08838834764831845f;
constexpr int NW = 8, QBLK = 32, KVBLK = 64, QB = NW * QBLK;
constexpr int SHM_V = KVBLK * D * 2, SHM_K = KVBLK * D * 2;
constexpr int OFF_WS = 2 * SHM_V + 2 * SHM_K, OFF_BIAS = OFF_WS + NW * 64 * 4, LDS_BYTES = OFF_BIAS + 2 * 64 * 4;

#define KSWZ(row, colB) ((row) * 256 + ((colB) ^ (((row) & 7) << 4)))
#define SBAR() __builtin_amdgcn_sched_barrier(0)
__device__ __forceinline__ int v_st(int k, int c) { const int kk = (k & ~0xC) | ((k & 4) << 1) | ((k & 8) >> 1); return ((kk >> 3) * 4 + (c >> 5)) * 512 + ((kk & 7) * 32 + (c & 31)) * 2; }
__device__ __forceinline__ int v_rd_base(int lane) { return ((lane & 3) << 3) | (((lane >> 2) & 3) << 6) | (((lane >> 4) & 1) << 5) | (((lane >> 5) & 1) << 8); }
constexpr int v_rd_off(int d0, int ks, int half) { return d0 * 512 + ks * 4096 + half * 2048; }
__device__ __forceinline__ int crow(int r, int hi) { return (r & 3) + 8 * (r >> 2) + 4 * hi; }
__device__ __forceinline__ unsigned cvtpk(float lo, float hi) { unsigned r; asm volatile("v_cvt_pk_bf16_f32 %0, %1, %2" : "=v"(r) : "v"(lo), "v"(hi)); return r; }
__device__ __forceinline__ bf16x8 load8(const bf16* p) { return *reinterpret_cast<const bf16x8*>(p); }
__device__ __forceinline__ void mask_tile(f32x16& p0, f32x16& p1, int dq) {
    const float NEG = -__builtin_inff();
#pragma unroll
    for (int r = 0; r < 16; ++r) {
        const int c = (r & 3) + 8 * (r >> 2);
        if (dq - c < 0) p0[r] = NEG;
        if (dq - c - 32 < 0) p1[r] = NEG;
    }
}
__device__ __forceinline__ void partialSM(f32x16& p0, f32x16& p1, float& m_reg, float& mn, float& alpha) {
    float pmax = p0[0]; for (int r = 1; r < 16; ++r) pmax = fmaxf(pmax, p0[r]); for (int r = 0; r < 16; ++r) pmax = fmaxf(pmax, p1[r]);
    { auto rr = __builtin_amdgcn_permlane32_swap(__float_as_uint(pmax), __float_as_uint(pmax), false, false);
      pmax = fmaxf(__uint_as_float(rr[0]), __uint_as_float(rr[1])); }
    constexpr float C2 = 1.4426950408889634f * SCALE;
    if (__builtin_expect(__all((pmax - m_reg) * SCALE <= THR), 1)) { mn = m_reg; alpha = 1.f; }
    else { mn = fmaxf(m_reg, pmax); alpha = __builtin_amdgcn_exp2f((m_reg - mn) * C2); m_reg = mn; }
    const float mnL = -mn * C2;
    for (int r = 0; r < 16; ++r) p0[r] = fmaf(p0[r], C2, mnL); for (int r = 0; r < 16; ++r) p1[r] = fmaf(p1[r], C2, mnL);
    for (int r = 0; r < 16; ++r) p0[r] = __builtin_amdgcn_exp2f(p0[r]);
}
__device__ __forceinline__ void finishSM(f32x16& p0, f32x16& p1, float alpha, float& l_reg, bf16x8& pa0, bf16x8& pa1, bf16x8& pa2, bf16x8& pa3) {
    for (int r = 0; r < 16; ++r) p1[r] = __builtin_amdgcn_exp2f(p1[r]);
    float ps = 0; for (int r = 0; r < 16; ++r) ps += p0[r]; for (int r = 0; r < 16; ++r) ps += p1[r];
    { auto rr = __builtin_amdgcn_permlane32_swap(__float_as_uint(ps), __float_as_uint(ps), false, false);
      ps = __uint_as_float(rr[0]) + __uint_as_float(rr[1]); }
    l_reg = l_reg * alpha + ps;
#define PK4(P, B_, OUT) do { unsigned a0 = cvtpk(P[B_+0], P[B_+1]), a1 = cvtpk(P[B_+2], P[B_+3]);                          \
        unsigned b0 = cvtpk(P[B_+4], P[B_+5]), b1 = cvtpk(P[B_+6], P[B_+7]);                                             \
        auto r0 = __builtin_amdgcn_permlane32_swap(a0, b0, false, false); auto r1 = __builtin_amdgcn_permlane32_swap(a1, b1, false, false); \
        u32x4 w = {r0[0], r1[0], r0[1], r1[1]}; OUT = *reinterpret_cast<bf16x8*>(&w); } while (0)
    PK4(p0, 0, pa0); PK4(p0, 8, pa1); PK4(p1, 0, pa2); PK4(p1, 8, pa3);
#undef PK4
}
template <int KB>
__device__ __forceinline__ void qkt(f32x16& p0, f32x16& p1, const char* K_lds, const char* Bias_lds, int r32, int hi, const bf16x8* qr) {
    { const f32x4* bb = reinterpret_cast<const f32x4*>(Bias_lds + KB * 256 + hi * 16);
      const f32x4 a0 = bb[0], a1 = bb[2], a2 = bb[4], a3 = bb[6], c0 = bb[8], c1 = bb[10], c2 = bb[12], c3 = bb[14];
      p0 = (f32x16){a0[0], a0[1], a0[2], a0[3], a1[0], a1[1], a1[2], a1[3], a2[0], a2[1], a2[2], a2[3], a3[0], a3[1], a3[2], a3[3]};
      p1 = (f32x16){c0[0], c0[1], c0[2], c0[3], c1[0], c1[1], c1[2], c1[3], c2[0], c2[1], c2[2], c2[3], c3[0], c3[1], c3[2], c3[3]}; }
    const char* kb[4];
#pragma unroll
    for (int dd = 0; dd < 4; ++dd) kb[dd] = K_lds + KB * SHM_K + KSWZ(r32, (dd * 16 + hi * 8) * 2);
#pragma unroll
    for (int d0 = 0; d0 < 8; ++d0) { const char* a = kb[d0 & 3] + (d0 >> 2) * 128;
        bf16x8 b0 = *reinterpret_cast<const bf16x8*>(a);
        bf16x8 b1 = *reinterpret_cast<const bf16x8*>(a + 32 * 256);
        p0 = __builtin_amdgcn_mfma_f32_32x32x16_bf16(b0, qr[d0], p0, 0, 0, 0);
        p1 = __builtin_amdgcn_mfma_f32_32x32x16_bf16(b1, qr[d0], p1, 0, 0, 0); }
}
template <int VB>
__device__ __forceinline__ void pv_tile(f32x16* o, int vb0, bf16x8 pa0, bf16x8 pa1, bf16x8 pa2, bf16x8 pa3) {
#define TRRD(dst, off) asm volatile("ds_read_b64_tr_b16 %0, %1 offset:%2" : "=&v"(dst) : "v"(vb0), "i"(off) : "memory")
#define PV_D0(d0) do { s16x4 l0, l1, l2, l3, h0, h1, h2, h3; constexpr int b_ = VB * SHM_V + v_rd_off(d0, 0, 0);   \
        TRRD(l0, b_); TRRD(h0, b_ + 2048); TRRD(l1, b_ + 4096); TRRD(h1, b_ + 6144); TRRD(l2, b_ + 8192); TRRD(h2, b_ + 10240); TRRD(l3, b_ + 12288); TRRD(h3, b_ + 14336); \
        asm volatile("s_waitcnt lgkmcnt(0)" ::: "memory"); SBAR();                                                    \
        o[d0] = __builtin_amdgcn_mfma_f32_32x32x16_bf16(pa0, (bf16x8){l0[0], l0[1], l0[2], l0[3], h0[0], h0[1], h0[2], h0[3]}, o[d0], 0, 0, 0);   \
        o[d0] = __builtin_amdgcn_mfma_f32_32x32x16_bf16(pa1, (bf16x8){l1[0], l1[1], l1[2], l1[3], h1[0], h1[1], h1[2], h1[3]}, o[d0], 0, 0, 0);   \
        o[d0] = __builtin_amdgcn_mfma_f32_32x32x16_bf16(pa2, (bf16x8){l2[0], l2[1], l2[2], l2[3], h2[0], h2[1], h2[2], h2[3]}, o[d0], 0, 0, 0);   \
        o[d0] = __builtin_amdgcn_mfma_f32_32x32x16_bf16(pa3, (bf16x8){l3[0], l3[1], l3[2], l3[3], h3[0], h3[1], h3[2], h3[3]}, o[d0], 0, 0, 0); } while (0)
    PV_D0(0); PV_D0(1); PV_D0(2); PV_D0(3);
#undef PV_D0
#undef TRRD
}

struct Bases { const bf16* Q; bf16* O; const bf16* K; const bf16* V; const float* CB; };
struct BlockRef { unsigned qo, oo, kvo, cbo; int P0, jlo; };
struct Seam { bf16x8 qr[8]; bf16x8 st_v0, st_v1, st_k0, st_k1; float st_b; };
#define ROW(p, k0, rr) ((p) + (unsigned)(((k0) + (rr)) * LD + sc))
#define VMW() asm volatile("s_waitcnt vmcnt(0)" ::: "memory")
#define VMWN(n) asm volatile("s_waitcnt vmcnt(%0)" :: "i"(n) : "memory")
#define SLOAD_H(Kp, Vp, CBp, k0) do { S.st_v0 = load8(ROW(Vp, k0, sr)); S.st_v1 = load8(ROW(Vp, k0, 32 + sr));              \
                         S.st_k0 = load8(ROW(Kp, k0, sr)); S.st_k1 = load8(ROW(Kp, k0, 32 + sr)); S.st_b = (CBp)[(unsigned)((k0) + lane)]; } while (0)
#define SWRITE_HK(bf, cref_) do { *(bf16x8*)(K_lds + (bf) * SHM_K + kws) = S.st_k0; *(bf16x8*)(K_lds + (bf) * SHM_K + kws + 32 * 256) = S.st_k1; \
                           if (wid == 0) *(float*)(B_lds + (bf) * 256 + lane * 4) = S.st_b; } while (0)
#define SWRITE_HV(bf) do { *(bf16x8*)(V_lds + (bf) * SHM_V + vst0) = S.st_v0; *(bf16x8*)(V_lds + (bf) * SHM_V + vst1) = S.st_v1; } while (0)
#define SWRITE_H(bf) do { SWRITE_HV(bf); SWRITE_HK(bf, cref); } while (0)
__device__ __forceinline__ void prime(const Bases& G, const BlockRef& cur, char* lds, Seam& S) {
    const int tid = threadIdx.x, wid = __builtin_amdgcn_readfirstlane(tid >> 6), lane = tid & 63, r32 = lane & 31, hi = lane >> 5;
    const int sr = tid >> 4, sc = (tid & 15) * 8, kws = KSWZ(sr, sc * 2); char* K_lds = lds + 2 * SHM_V; char* B_lds = lds + OFF_BIAS;
    for (int d0 = 0; d0 < 8; ++d0) S.qr[d0] = load8(G.Q + (cur.qo + (unsigned)((wid * QBLK + r32) * LD + d0 * 16 + hi * 8)));
    const float cref = 0.f; (void)cref;
    SLOAD_H(G.K + cur.kvo, G.V + cur.kvo, G.CB + cur.cbo, cur.jlo * KVBLK); VMW(); SWRITE_HK(0, cref);
    __syncthreads();
}
__device__ __forceinline__ void block(const Bases& G, const BlockRef& cur, const BlockRef& nxt, char* lds, Seam& S) {
    const int tid = threadIdx.x, wid = __builtin_amdgcn_readfirstlane(tid >> 6), lane = tid & 63, r32 = lane & 31, hi = lane >> 5;
    const int j_lo = cur.jlo, NT = (cur.P0 + QB - 1) / KVBLK + 1 - j_lo;
    const int qlo = cur.P0 + wid * QBLK, qm = qlo + r32 - 4 * hi;
    char* V_lds = lds; char* K_lds = lds + 2 * SHM_V; char* B_lds = lds + OFF_BIAS;
    float* ws = (float*)(lds + OFF_WS) + wid * 64; float* li_l = ws, * al_l = ws + 32;
    float m_reg = G.CB[cur.cbo + (unsigned)(cur.P0 + wid * QBLK + r32)], l_reg = 0; f32x16 o[4] = {};
    const int sr = tid >> 4, sc = (tid & 15) * 8, vst0 = v_st(sr, sc), vst1 = v_st(32 + sr, sc), kws = KSWZ(sr, sc * 2);
    const int vb0 = (int)(uintptr_t)V_lds + v_rd_base(lane);
    const bf16* Kh = G.K + cur.kvo; const bf16* Vh = G.V + cur.kvo; const float* CBh = G.CB + cur.cbo;
    const float cref = 0.f, crefn = 0.f; (void)cref; (void)crefn;
#define RESC(a) do { if (__any((a) < 1.f)) { if (hi == 0) al_l[r32] = (a); asm volatile("s_waitcnt lgkmcnt(0)" ::: "memory");              \
                     for (int d_ = 0; d_ < 4; ++d_) for (int r = 0; r < 16; ++r) o[d_][r] *= al_l[crow(r, hi)]; } } while (0)
#define KBASE(t) ((j_lo + (t)) * KVBLK)
#define MASKT(P0_, P1_, t) do { const int kb_ = KBASE(t); if (kb_ + KVBLK - 1 > qlo) mask_tile(P0_, P1_, qm - kb_); } while (0)
    constexpr int NQL = 8;
#define SEAM_K0() do { VMWN(NQL); SWRITE_HK(0, crefn); SBAR(); } while (0)
    f32x16 pA0, pA1, pB0, pB1; float mnA, mnB, alA, alB; bf16x8 pa0, pa1, pa2, pa3;
    SWRITE_HV(0); SBAR();
    if (NT > 1) { SLOAD_H(Kh, Vh, CBh, KBASE(1)); }
    SBAR(); qkt<0>(pA0, pA1, K_lds, B_lds, r32, hi, S.qr);
    MASKT(pA0, pA1, 0); partialSM(pA0, pA1, m_reg, mnA, alA);
    if (NT > 1) { VMW(); SWRITE_H(1); }
    __syncthreads();
#define HALF_STEP(PX0, PX1, mnX, alX, PY0, PY1, alY, t, KB, VB, SB) do {                                                      \
        SBAR(); qkt<KB>(PX0, PX1, K_lds, B_lds, r32, hi, S.qr);                                                                \
        finishSM(PY0, PY1, alY, l_reg, pa0, pa1, pa2, pa3); SBAR();                                                           \
        if ((t) + 1 < NT) { SLOAD_H(Kh, Vh, CBh, KBASE((t) + 1)); SBAR(); }                                              \
        pv_tile<VB>(o, vb0, pa0, pa1, pa2, pa3); MASKT(PX0, PX1, (t)); partialSM(PX0, PX1, m_reg, mnX, alX);                   \
        __syncthreads();                                                                                                      \
        if ((t) + 1 < NT) { VMW(); SWRITE_H(SB); }                                                                            \
        RESC(alX); __syncthreads(); } while (0)
    for (int t = 1; t + 1 < NT; t += 2) {
        HALF_STEP(pB0, pB1, mnB, alB, pA0, pA1, alA, t, 1, 0, 0);
        HALF_STEP(pA0, pA1, mnA, alA, pB0, pB1, alB, t + 1, 0, 1, 1);
    }
    constexpr bool even = true;
    if (even) { SBAR(); qkt<1>(pB0, pB1, K_lds, B_lds, r32, hi, S.qr); SBAR(); }
    { SLOAD_H(G.K + nxt.kvo, G.V + nxt.kvo, G.CB + nxt.cbo, nxt.jlo * KVBLK); SBAR();
#pragma unroll
      for (int d0 = 0; d0 < 8; ++d0) S.qr[d0] = load8(G.Q + (nxt.qo + (unsigned)((wid * QBLK + r32) * LD + d0 * 16 + hi * 8))); }
    SBAR();
    finishSM(pA0, pA1, alA, l_reg, pa0, pa1, pa2, pa3); SBAR();
    pv_tile<0>(o, vb0, pa0, pa1, pa2, pa3);
    if (even) { MASKT(pB0, pB1, NT - 1); partialSM(pB0, pB1, m_reg, mnB, alB); __syncthreads(); RESC(alB);
        finishSM(pB0, pB1, alB, l_reg, pa0, pa1, pa2, pa3); SBAR(); pv_tile<1>(o, vb0, pa0, pa1, pa2, pa3); }
    SBAR(); SEAM_K0();
    if (hi == 0) li_l[r32] = l_reg; asm volatile("s_waitcnt lgkmcnt(0)" ::: "memory");
    float rli[16];
#pragma unroll
    for (int r = 0; r < 16; ++r) rli[r] = __builtin_amdgcn_rcpf(li_l[crow(r, hi)]);
    bf16* Ow = G.O + (cur.oo + (unsigned)(wid * QBLK * LDO));
#pragma unroll
    for (int r = 0; r < 16; ++r) { const int orow = crow(r, hi);
#pragma unroll
        for (int d0 = 0; d0 < 4; ++d0) { const float v = o[d0][r] * rli[r];
            const float vn = __shfl_xor(v, 1);
            if ((r32 & 1) == 0) *(unsigned*)(Ow + (unsigned)(orow * LDO + d0 * 32 + r32)) = cvtpk(v, vn); } }
    __syncthreads();
#undef RESC
#undef KBASE
#undef MASKT
#undef SEAM_K0
#undef HALF_STEP
}
#undef ROW
#undef VMW
#undef VMWN
#undef SLOAD_H
#undef SWRITE_HK
#undef SWRITE_HV
#undef SWRITE_H
#undef KSWZ
#undef SBAR
}
constexpr int NB = 8, SEQ = 4096, T = NB * SEQ, DM = 1024, NH = 8, HD = 128, INW = 7176, NZ = 7168;
constexpr int NE = 32, DE = 512;
constexpr float EPS = 1e-6f;
constexpr int PMAX = 73728;
constexpr int NWAVES = 8;
constexpr size_t MiB = 1u << 20;
constexpr size_t WS_CTL = 0, CTL_ZERO_BYTES = 64 * 1024;
constexpr size_t WS_RS1 = 1 * MiB, WS_RS2 = 1 * MiB + 256 * 1024;
constexpr size_t WS_LF = 1 * MiB + 512 * 1024;
constexpr size_t WS_CB = 2 * MiB + 512 * 1024;
constexpr size_t WS_TOK = 3 * MiB + 512 * 1024;
constexpr size_t WS_LISTS = 5 * MiB;
constexpr size_t WS_WRT = 9 * MiB;
constexpr size_t WS_SRS = 9 * MiB + 512 * 1024, WS_SW = 10 * MiB;
constexpr size_t WS_WIN = 16 * MiB;
constexpr size_t WS_WA = 30 * MiB, WS_WL = 32 * MiB, WS_WO = 34 * MiB;
constexpr size_t WS_WRG = 36 * MiB;
constexpr size_t WS_XB = 40 * MiB;
constexpr size_t WS_XR = 104 * MiB;
constexpr size_t WS_GG = 168 * MiB;
constexpr size_t WS_Q = 232 * MiB, WS_K = 296 * MiB, WS_V = 360 * MiB;
constexpr size_t WS_W13 = 424 * MiB;
constexpr size_t WS_W2 = 392 * MiB;
constexpr size_t WS_XG = 168 * MiB;
constexpr size_t WS_HB = 296 * MiB;
constexpr size_t WS_END = 512 * MiB;
static_assert(WS_XG + (size_t)PMAX * 1024 <= WS_K && WS_HB + (size_t)PMAX * 1024 <= WS_W2 && WS_W2 + 32u * 1024 * 512 * 2 <= WS_W13 && WS_W13 + 64 * MiB <= WS_END, "d_ws map");
constexpr int CW_TMO = 0, CW_CODE = 1, CW_BAR = 4096, CW_CNT = 8192, CW_NORM = 8448, CW_QCTR = 12288;
constexpr int RING_OFF = 0, RING_BYTES = 131072;
constexpr int LDSCTL_OFF = RING_BYTES, MISC_OFF = LDSCTL_OFF + 320;
constexpr int TBL_OFF = RING_BYTES + 1024;
constexpr int TBL_PS = TBL_OFF, TBL_CN = TBL_OFF + 256, TBL_TE = TBL_OFF + 512;
constexpr int RG_TOT = RING_BYTES + 4096, RG_CAR = RG_TOT + 4096;
constexpr int LDS_BYTES = 147456;

#include <cmath>
using pg8::bf_lo; using pg8::bf_hi; using pg8::sigmoid_f;

struct Frame {
    LAS unsigned char* lds;
    int tid, lane, wave, vcu, G;
};
__device__ __forceinline__ float wave_sum(float v) {
#pragma unroll
    for (int o = 1; o < 64; o <<= 1) v += __shfl_xor(v, o);
    return v;
}
__device__ __forceinline__ void transpose_tile(const float* src, int ld, bf16* dst, int ldd, const float* kscale, LAS float* scr, int lane) {
    const int q = lane & 7, kr = lane >> 3;
    f32x4 v[8];
#pragma unroll
    for (int i = 0; i < 8; ++i) v[i] = *(const f32x4*)(src + (size_t)(kr + 8 * i) * ld + 4 * q);
#pragma unroll
    for (int i = 0; i < 8; ++i) { const int kk = kr + 8 * i; const float sc = kscale ? kscale[kk] : 1.0f;
#pragma unroll
        for (int c = 0; c < 4; ++c) scr[kk * 33 + 4 * q + c] = v[i][c] * sc; }
    LDS_WAIT(); asm volatile("" ::: "memory");
    const int c = lane & 7;
#pragma unroll
    for (int j = 0; j < 4; ++j) { const int n = (lane >> 3) + 8 * j; const LAS float* s = scr + (8 * c) * 33 + n;
        v4u o; o.x = pk2(s[0 * 33], s[1 * 33]); o.y = pk2(s[2 * 33], s[3 * 33]); o.z = pk2(s[4 * 33], s[5 * 33]); o.w = pk2(s[6 * 33], s[7 * 33]);
        *(GAS v4u*)(dst + (size_t)n * ldd + 8 * c) = o; }
    LDS_WAIT(); asm volatile("" ::: "memory");
}

__device__ __forceinline__ void transpose_tile8(const float* src, int ld, unsigned char* dst, int ldd, const float* kscale, float scale, LAS float* scr, int lane) {
    const int q = lane & 7, kr = lane >> 3;
    f32x4 v[8];
#pragma unroll
    for (int i = 0; i < 8; ++i) v[i] = *(const f32x4*)(src + (size_t)(kr + 8 * i) * ld + 4 * q);
#pragma unroll
    for (int i = 0; i < 8; ++i) { const int kk = kr + 8 * i; const float sc = kscale ? kscale[kk] * scale : scale;
#pragma unroll
        for (int c = 0; c < 4; ++c) scr[kk * 33 + 4 * q + c] = v[i][c] * sc; }
    LDS_WAIT(); asm volatile("" ::: "memory");
    const int c = lane & 3;
#pragma unroll
    for (int j = 0; j < 2; ++j) { const int n = (lane >> 2) + 16 * j; const LAS float* s = scr + (16 * c) * 33 + n;
        v4u o; o.x = pg8::pack4_fp8(s[0 * 33], s[1 * 33], s[2 * 33], s[3 * 33]); o.y = pg8::pack4_fp8(s[4 * 33], s[5 * 33], s[6 * 33], s[7 * 33]);
        o.z = pg8::pack4_fp8(s[8 * 33], s[9 * 33], s[10 * 33], s[11 * 33]); o.w = pg8::pack4_fp8(s[12 * 33], s[13 * 33], s[14 * 33], s[15 * 33]);
        *(GAS v4u*)(dst + (size_t)n * ldd + 16 * c) = o; }
    LDS_WAIT(); asm volatile("" ::: "memory");
}

struct P0Args { const float *x, *g_mix, *w_in, *w_rg_a, *w_rg_x, *b_forget, *w_lru_out, *w_attn_out, *w_out, *g_ffn, *w_rgrp, *w_rexp, *w_gate, *w_up;
                bf16 *Win, *Wl, *Wa, *Wo, *Wrg, *XB; unsigned char* W13; float *RS1, *LF, *WRT; };
struct TItem { const float* src; int ld; unsigned char* dst; int ldd; const float* ks; float scale; int f8; };
__device__ __forceinline__ void titem_load(const TItem& t, f32x4 (&v)[8], float (&sc)[8], int lane) {
    const int q = lane & 7, kr = lane >> 3;
#pragma unroll
    for (int i = 0; i < 8; ++i) { v[i] = __builtin_nontemporal_load((const f32x4*)(t.src + (size_t)(kr + 8 * i) * t.ld + 4 * q)); sc[i] = t.ks ? t.ks[kr + 8 * i] * t.scale : t.scale; }
}
__device__ __forceinline__ void titem_finish(const TItem& t, const f32x4 (&v)[8], const float (&sc)[8], LAS float* scr, int lane) {
    const int q = lane & 7, kr = lane >> 3;
#pragma unroll
    for (int i = 0; i < 8; ++i) { const int kk = kr + 8 * i;
#pragma unroll
        for (int c = 0; c < 4; ++c) scr[kk * 33 + 4 * q + c] = v[i][c] * sc[i]; }
    LDS_WAIT(); asm volatile("" ::: "memory");
    if (t.f8) { const int c = lane & 3;
#pragma unroll
        for (int j = 0; j < 2; ++j) { const int n = (lane >> 2) + 16 * j; const LAS float* s = scr + (16 * c) * 33 + n;
            v4u o; o.x = pg8::pack4_fp8(s[0 * 33], s[1 * 33], s[2 * 33], s[3 * 33]); o.y = pg8::pack4_fp8(s[4 * 33], s[5 * 33], s[6 * 33], s[7 * 33]);
            o.z = pg8::pack4_fp8(s[8 * 33], s[9 * 33], s[10 * 33], s[11 * 33]); o.w = pg8::pack4_fp8(s[12 * 33], s[13 * 33], s[14 * 33], s[15 * 33]);
            *(GAS v4u*)(t.dst + (size_t)n * t.ldd + 16 * c) = o; } }
    else { const int c = lane & 7;
#pragma unroll
        for (int j = 0; j < 4; ++j) { const int n = (lane >> 3) + 8 * j; const LAS float* s = scr + (8 * c) * 33 + n;
            v4u o; o.x = pk2(s[0 * 33], s[1 * 33]); o.y = pk2(s[2 * 33], s[3 * 33]); o.z = pk2(s[4 * 33], s[5 * 33]); o.w = pk2(s[6 * 33], s[7 * 33]);
            *(GAS v4u*)(t.dst + ((size_t)n * t.ldd + 8 * c) * 2) = o; } }
    LDS_WAIT(); asm volatile("" ::: "memory");
}
constexpr int P0_I_IN = 16 * 224, P0_I_SQ = 16 * 32, P0_I_RG = 2 * 4 * 4 * 8, P0_I_EX = 2 * 8192, P0_NITEMS = P0_I_IN + 3 * P0_I_SQ + P0_I_RG + P0_I_EX;
__device__ __forceinline__ void p0_items(const Frame& F, const P0Args& a, const int first, const int last, const int stride, const int offset) {
    LAS float* scr = (LAS float*)(F.lds + RING_OFF + F.wave * 16384);
    const float* const p_wl = a.w_lru_out; const float* const p_wa = a.w_attn_out; const float* const p_wo = a.w_out; const float* const p_rga = a.w_rg_a; const float* const p_rgx = a.w_rg_x;
    bf16* const q_wl = a.Wl; bf16* const q_wa = a.Wa; bf16* const q_wo = a.Wo;
    constexpr int I_IN = P0_I_IN, I_SQ = P0_I_SQ, I_EX = P0_I_EX, NITEMS = P0_NITEMS;
    const float* const p_gate = a.w_gate; const float* const p_up = a.w_up; const float* const p_win = a.w_in; const float* const p_gmix = a.g_mix; const float* const p_gffn = a.g_ffn;
    bf16* const q_win = a.Win; bf16* const q_wrg = a.Wrg; unsigned char* const q_w13 = a.W13;
#define P0_DECODE(it_, t_) do { int r = (it_); \
        if (r >= NITEMS - I_EX) { r -= NITEMS - I_EX;     \
            const int w = r >> 13, e = (r >> 8) & 31, kb = (r >> 4) & 15, nb = r & 15; const float* W = (w == 0 ? p_gate : p_up) + (size_t)e * DM * DE; \
            const int drow = e * 1024 + (nb >> 2) * 256 + (nb & 3) * 32 + (w == 1 ? 128 : 0); \
            t_.src = W + (size_t)(64 * kb) * DE + 32 * nb; t_.ld = DE; t_.dst = q_w13 + (size_t)drow * DM + 64 * kb; t_.ldd = DM; t_.ks = p_gffn + 64 * kb; t_.scale = pg8::W13_SCALE; t_.f8 = 1; } \
        else if (r < I_IN) { const int kb = r / 224, nb = r % 224, n0 = 32 * nb, sc_ = n0 < 5120 ? n0 : n0 + 8; \
            t_.src = p_win + (size_t)(64 * kb) * INW + sc_; t_.ld = INW; t_.dst = (unsigned char*)(q_win + (size_t)n0 * DM + 64 * kb); t_.ldd = DM; t_.ks = p_gmix + 64 * kb; t_.scale = 1.0f; t_.f8 = 0; } \
        else if (r < I_IN + 3 * I_SQ) { r -= I_IN; const int w = r / I_SQ, q = r % I_SQ, kb = q / 32, nb = q % 32; const float* W = w == 0 ? p_wl : (w == 1 ? p_wa : p_wo); bf16* Wt = w == 0 ? q_wl : (w == 1 ? q_wa : q_wo); \
            t_.src = W + (size_t)(64 * kb) * DM + 32 * nb; t_.ld = DM; t_.dst = (unsigned char*)(Wt + (size_t)(32 * nb) * DM + 64 * kb); t_.ldd = DM; t_.ks = nullptr; t_.scale = 1.0f; t_.f8 = 0; } \
        else { r -= I_IN + 3 * I_SQ; const int gb = r / 32, q = r % 32, kb = q / 8, nb = q % 8; const float* W = (gb < 4 ? p_rga : p_rgx) + (size_t)(gb & 3) * 65536; \
            t_.src = W + (size_t)(64 * kb) * 256 + 32 * nb; t_.ld = 256; t_.dst = (unsigned char*)(q_wrg + (size_t)gb * 65536 + (size_t)(32 * nb) * 256 + 64 * kb); t_.ldd = 256; t_.ks = nullptr; t_.scale = -1.4426950408889634f; t_.f8 = 0; }     } while (0)
    {
        int it = first + offset; TItem cur; f32x4 va[8]; float sa[8];
        if (it < last) { P0_DECODE(it, cur); titem_load(cur, va, sa, F.lane); }
        while (it < last) {
            const int nx = it + stride; TItem nt = cur; f32x4 vb[8]; float sb[8];
            if (nx < last) { P0_DECODE(nx, nt); titem_load(nt, vb, sb, F.lane); }
            titem_finish(cur, va, sa, scr, F.lane);
            if (nx < last) { cur = nt;
#pragma unroll
                for (int i = 0; i < 8; ++i) { va[i] = vb[i]; sa[i] = sb[i]; } }
            it = nx;
        }
    }
#undef P0_DECODE
}
__device__ __forceinline__ void p0_prologue(const Frame& F, const P0Args& a, const int part  ) {
    const int gw = F.vcu * NWAVES + F.wave, NGW = F.G * NWAVES;
    if (part != 2) p0_items(F, a, 0, P0_NITEMS, NGW, gw);
    if (part == 1) return;
    for (int i = (F.vcu * NWAVES + F.wave) * 64 + F.lane; i < 64 * DM; i += NGW * 64) { const int n = i >> 10, k = i & 1023;
        float v = 0.f; if (n < 32) v = a.w_rexp[k * 32 + n]; else if (n < 36) v = a.w_rgrp[k * 4 + (n - 32)];
        a.WRT[i] = v * a.g_ffn[k]; }
    LAS float* wfl = (LAS float*)(F.lds + RING_OFF);
    __syncthreads();
    for (int k = F.tid; k < DM; k += NWAVES * 64) { const float g = a.g_mix[k];
        const f32x4 w0 = *(const f32x4*)(a.w_in + (size_t)k * INW + 5120), w1 = *(const f32x4*)(a.w_in + (size_t)k * INW + 5124);
        *(LAS f32x4*)(wfl + k * 8) = w0 * g; *(LAS f32x4*)(wfl + k * 8 + 4) = w1 * g; }
    __syncthreads();
    float wf[4][4][8];
#pragma unroll
    for (int j = 0; j < 4; ++j)
#pragma unroll
        for (int i = 0; i < 4; ++i) { const int k = 256 * j + 4 * F.lane + i; const f32x4 w0 = *(const LAS f32x4*)(wfl + k * 8), w1 = *(const LAS f32x4*)(wfl + k * 8 + 4);
#pragma unroll
            for (int h = 0; h < 4; ++h) { wf[j][i][h] = w0[h]; wf[j][i][4 + h] = w1[h]; } }
    const float bfg = a.b_forget[F.lane & 7];
    f32x4 vn[4];
    if (gw < T) { const GAS f32x4* xr0 = (const GAS f32x4*)(a.x + (size_t)gw * DM) + F.lane;
#pragma unroll
        for (int j = 0; j < 4; ++j) vn[j] = __builtin_nontemporal_load((const f32x4*)xr0 + 64 * j); }
    for (int m = gw; m < T; m += NGW) {
        f32x4 v[4]; float s = 0.f, d[8] = {0.f, 0.f, 0.f, 0.f, 0.f, 0.f, 0.f, 0.f};
#pragma unroll
        for (int j = 0; j < 4; ++j) v[j] = vn[j];
        if (m + NGW < T) { const GAS f32x4* xr1 = (const GAS f32x4*)(a.x + (size_t)(m + NGW) * DM) + F.lane;
#pragma unroll
            for (int j = 0; j < 4; ++j) vn[j] = __builtin_nontemporal_load((const f32x4*)xr1 + 64 * j); }
#pragma unroll
        for (int j = 0; j < 4; ++j) { s += (v[j].x * v[j].x + v[j].y * v[j].y) + (v[j].z * v[j].z + v[j].w * v[j].w);
#pragma unroll
            for (int i = 0; i < 4; ++i)
#pragma unroll
                for (int h = 0; h < 8; ++h) d[h] = fmaf(v[j][i], wf[j][i][h], d[h]); }
        s = wave_sum(s);
#pragma unroll
        for (int h = 0; h < 8; ++h) d[h] = wave_sum(d[h]);
        const float rs = 1.0f / sqrtf(s * (1.0f / DM) + EPS);
        GAS unsigned long long* o8 = (GAS unsigned long long*)(a.XB + (size_t)m * DM) + F.lane;
#pragma unroll
        for (int j = 0; j < 4; ++j) o8[64 * j] = (unsigned long long)pk2(v[j].x * rs, v[j].y * rs) | ((unsigned long long)pk2(v[j].z * rs, v[j].w * rs) << 32);
        if (F.lane < 8) { const int h = F.lane; float dh = d[0]; dh = h == 1 ? d[1] : dh; dh = h == 2 ? d[2] : dh; dh = h == 3 ? d[3] : dh; dh = h == 4 ? d[4] : dh; dh = h == 5 ? d[5] : dh; dh = h == 6 ? d[6] : dh; dh = h == 7 ? d[7] : dh;
            const float fl = dh * rs + bfg; a.LF[(size_t)m * 8 + h] = fminf(fl, 0.f) - log1pf(expf(-fabsf(fl))); }
    }
}
__device__ __forceinline__ void cumsum_bias(const Frame& F, const float* LF, float* CB) {
    LAS float* wt = (LAS float*)(F.lds + RING_OFF);
    for (int bh = blockIdx.x; bh < NB * NH; bh += F.G) {
        const int b = bh >> 3, h = bh & 7, s0 = F.tid * 8;
        float v[8], run = 0.f;
#pragma unroll
        for (int j = 0; j < 8; ++j) { run += LF[((size_t)(b * SEQ + s0 + j)) * 8 + h]; v[j] = run; }
        float inc = run;
#pragma unroll
        for (int o = 1; o < 64; o <<= 1) { const float t = __shfl_up(inc, o); if (F.lane >= o) inc += t; }
        if (F.lane == 63) wt[F.wave] = inc;
        __syncthreads();
        float pre = inc - run;
        for (int w = 0; w < F.wave; ++w) pre += wt[w];
#pragma unroll
        for (int j = 0; j < 8; ++j) CB[(size_t)bh * SEQ + s0 + j] = -(pre + v[j]) * 11.313708498984761f;
        __syncthreads();
    }
}
struct RgArgs { const bf16* XC; const bf16* GG; bf16* GO; const bf16* Wrg; const float *b_a, *b_x, *lam; };
__device__ __forceinline__ float bfx(const v4u& v, int i) { const unsigned w = i < 2 ? v.x : (i < 4 ? v.y : (i < 6 ? v.z : v.w)); return (i & 1) ? bf_hi(w) : bf_lo(w); }
__device__ __forceinline__ unsigned cvtpk_bf16(float lo, float hi) { unsigned r; asm volatile("v_cvt_pk_bf16_f32 %0, %1, %2" : "=v"(r) : "v"(lo), "v"(hi)); return r; }
__device__ __forceinline__ void conv_prepass(const Frame& F, const bf16* XR, bf16* XC, const float* conv_w, const float* conv_b) {
    const int gw = F.vcu * NWAVES + F.wave, NGW = F.G * NWAVES;
    for (int it = gw; it < (T / 16) * 2; it += NGW) {
        const int r0 = (it >> 1) * 16, c0 = (it & 1) * 512 + 8 * F.lane, tq = r0 & (SEQ - 1);
        float cw[4][8], cbv[8];
#pragma unroll
        for (int j = 0; j < 4; ++j) { const f32x4 w0 = *(const f32x4*)(conv_w + j * DM + c0), w1 = *(const f32x4*)(conv_w + j * DM + c0 + 4);
#pragma unroll
            for (int i = 0; i < 4; ++i) { cw[j][i] = w0[i]; cw[j][4 + i] = w1[i]; } }
        { const f32x4 w0 = *(const f32x4*)(conv_b + c0), w1 = *(const f32x4*)(conv_b + c0 + 4);
#pragma unroll
          for (int i = 0; i < 4; ++i) { cbv[i] = w0[i]; cbv[4 + i] = w1[i]; } }
        v4u raw[19];
#pragma unroll
        for (int i = 0; i < 19; ++i) { const int rr = (i < 3 && tq == 0) ? r0 : r0 - 3 + i; const v4u w = *(const GAS v4u*)(XR + ((unsigned)rr * DM + c0));
            const bool z = i < 3 && tq == 0; raw[i].x = z ? 0u : w.x; raw[i].y = z ? 0u : w.y; raw[i].z = z ? 0u : w.z; raw[i].w = z ? 0u : w.w; }
#pragma unroll
        for (int r = 0; r < 16; ++r) { float y[8];
#pragma unroll
            for (int i = 0; i < 8; ++i) { float sacc = cbv[i];
#pragma unroll
                for (int j = 0; j < 4; ++j) sacc = fmaf(cw[j][i], bfx(raw[r + j], i), sacc);
                y[i] = sacc; }
            v4u o; o.x = cvtpk_bf16(y[0], y[1]); o.y = cvtpk_bf16(y[2], y[3]); o.z = cvtpk_bf16(y[4], y[5]); o.w = cvtpk_bf16(y[6], y[7]);
            *(GAS v4u*)(XC + ((unsigned)(r0 + r) * DM + c0)) = o; }
    }
}
__device__ __forceinline__ void rglru_unit(const Frame& F, const RgArgs& a, int unit) {
    const int tid = F.tid, lane = F.lane, wid = F.wave, fr = lane & 15, fq = lane >> 4, rq = wid >> 1, cp = wid & 1;
    const int b = unit >> 5, n = (unit >> 3) & 3, g = unit & 7, cbase = 256 * n, cown = cbase + 32 * g;
    LAS unsigned char* A_l = F.lds + RING_OFF;
    LAS float* tot = (LAS float*)(F.lds + RG_TOT);
    bf16x8 bfr[2][8];
#pragma unroll
    for (int gt = 0; gt < 2; ++gt)
#pragma unroll
        for (int ks = 0; ks < 8; ++ks) bfr[gt][ks] = *(const GAS bf16x8*)(a.Wrg + ((size_t)((gt * 4 + n) * 256 + 32 * g + 16 * cp + fr)) * 256 + 32 * ks + 8 * fq);
    const int cl = 16 * cp + fr, cch = cown + cl;
    const float ba = -1.4426950408889634f * a.b_a[cch], bx = -1.4426950408889634f * a.b_x[cch], sp8 = 8.0f * log1pf(expf(-a.lam[cch])) * 1.4426950408889634f;
    const unsigned goff = (unsigned)(b * SEQ + 32 * rq + 4 * fq) * DM + cch;
    const __amdgpu_buffer_rsrc_t GGr = __builtin_amdgcn_make_buffer_rsrc((void*)a.GG, 0, (int)((size_t)T * DM * 2), 0x00020000);
    const __amdgpu_buffer_rsrc_t GOr = __builtin_amdgcn_make_buffer_rsrc((void*)a.GO, 0, (int)((size_t)T * DM * 2), 0x00020000);
    const int gvo = (int)(goff * 2u);
    const unsigned dbase = ((unsigned)(b * SEQ + 16 * wid + (lane >> 5)) * DM + cbase) * 2u;
    const char* const XCb = (const char*)a.XC;
#define RG_DMA(ci_, buf_) do { _Pragma("unroll") for (int i_ = 0; i_ < 8; ++i_) { const unsigned so_ = dbase + (unsigned)(2 * i_) * (DM * 2u) + ((((unsigned)lane & 31u) ^ (unsigned)((2 * i_ + (lane >> 5)) & 15)) << 4); \
        __builtin_amdgcn_global_load_lds((const unsigned*)(XCb + so_ + (unsigned)(ci_) * (128u * DM * 2u)), (LAS unsigned*)(A_l + (buf_) * 65536 + (8 * wid + i_) * 1024), 16, 0, 0); } } while (0)
    float hc = 0.f;
    const int kx = 32 * g + cl;
#pragma unroll
    for (int gt = 0; gt < 2; ++gt)
#pragma unroll
        for (int ks = 0; ks < 8; ++ks) asm volatile("" : "+v"(bfr[gt][ks]));
    RG_DMA(0, 0); asm volatile("s_waitcnt vmcnt(0)" ::: "memory");
#define RG_CHUNK(BUF_, ci_) do { const int ci = (ci_); const int t0 = 128 * ci; LAS unsigned char* const Ab = A_l + (BUF_) * 65536; \
        __builtin_amdgcn_s_barrier(); asm volatile("" ::: "memory"); \
        unsigned short ggv[2][4]; \
        _Pragma("unroll") \
        for (int mt = 0; mt < 2; ++mt) \
        _Pragma("unroll") \
            for (int j = 0; j < 4; ++j) ggv[mt][j] = __builtin_amdgcn_raw_buffer_load_b16(GGr, gvo, (t0 + 16 * mt + j) * (DM * 2), 0); \
        if (ci + 1 < SEQ / 128) RG_DMA(ci + 1, BUF_ ^ 1); \
 \
        f32x4 acc[2][2]; \
        _Pragma("unroll") \
        for (int mt = 0; mt < 2; ++mt) { acc[mt][0] = (f32x4){ba, ba, ba, ba}; acc[mt][1] = (f32x4){bx, bx, bx, bx}; } \
        _Pragma("unroll") \
        for (int ks = 0; ks < 8; ++ks) { const int ch = 4 * ks + fq; \
        _Pragma("unroll") \
            for (int mt = 0; mt < 2; ++mt) { const int arow = 32 * rq + 16 * mt + fr; \
                const bf16x8 af = *(const LAS bf16x8*)(Ab + arow * 512 + ((ch ^ (arow & 15)) << 4)); \
                acc[mt][0] = __builtin_amdgcn_mfma_f32_16x16x32_bf16(af, bfr[0][ks], acc[mt][0], 0, 0, 0); \
                acc[mt][1] = __builtin_amdgcn_mfma_f32_16x16x32_bf16(af, bfr[1][ks], acc[mt][1], 0, 0, 0); } } \
 \
        float av[2][4], bv[2][4], sA[2], sB[2]; \
        _Pragma("unroll") \
        for (int mt = 0; mt < 2; ++mt) { float A = 1.f, Bv = 0.f; \
        _Pragma("unroll") \
            for (int j = 0; j < 4; ++j) { const int row = 32 * rq + 16 * mt + 4 * fq + j; \
                const unsigned short xb16 = *(const LAS unsigned short*)(Ab + row * 512 + ((((kx >> 3) ^ (row & 15))) << 4) + (kx & 7) * 2); \
                const float xc = __builtin_bit_cast(float, (unsigned)xb16 << 16); \
                const float r_ = __builtin_amdgcn_rcpf(1.0f + __builtin_amdgcn_exp2f(acc[mt][0][j])), i_ = __builtin_amdgcn_rcpf(1.0f + __builtin_amdgcn_exp2f(acc[mt][1][j])); \
                const float aa = __builtin_amdgcn_exp2f(-sp8 * r_); \
                const float mult = __builtin_amdgcn_sqrtf(fmaxf(fmaf(-aa, aa, 1.0f), 0.f)); \
                av[mt][j] = aa; bv[mt][j] = mult * i_ * xc; \
                Bv = fmaf(aa, Bv, bv[mt][j]); A *= aa; } \
            sA[mt] = A; sB[mt] = Bv; } \
 \
        float eA[2], eB[2], tA[2], tB[2]; \
        _Pragma("unroll") \
        for (int mt = 0; mt < 2; ++mt) { float A = sA[mt], Bv = sB[mt]; \
            { const float pA = __shfl_up(A, 16), pB = __shfl_up(Bv, 16); if (fq >= 1) { Bv = fmaf(A, pB, Bv); A *= pA; } } \
            { const float pA = __shfl_up(A, 32), pB = __shfl_up(Bv, 32); if (fq >= 2) { Bv = fmaf(A, pB, Bv); A *= pA; } } \
            const float xA = __shfl_up(A, 16), xB = __shfl_up(Bv, 16); eA[mt] = fq >= 1 ? xA : 1.f; eB[mt] = fq >= 1 ? xB : 0.f; \
            tA[mt] = __shfl(A, 48 + fr); tB[mt] = __shfl(Bv, 48 + fr); } \
        const float wA = tA[0] * tA[1], wB = fmaf(tA[1], tB[0], tB[1]); \
        if (fq == 0) { tot[(rq * 32 + cl) * 2] = wA; tot[(rq * 32 + cl) * 2 + 1] = wB; } \
        asm volatile("s_waitcnt lgkmcnt(0)" ::: "memory"); __builtin_amdgcn_s_barrier(); asm volatile("" ::: "memory"); \
        float hin = hc, hnew = hc; \
        _Pragma("unroll") \
        for (int q = 0; q < 4; ++q) { const float qA = tot[(q * 32 + cl) * 2], qB = tot[(q * 32 + cl) * 2 + 1]; hnew = fmaf(qA, hnew, qB); if (q < rq) hin = hnew; } \
        hc = hnew; \
        _Pragma("unroll") \
        for (int mt = 0; mt < 2; ++mt) { float h = mt == 0 ? hin : fmaf(tA[0], hin, tB[0]); \
            h = fmaf(eA[mt], h, eB[mt]); \
        _Pragma("unroll") \
            for (int j = 0; j < 4; ++j) { h = fmaf(av[mt][j], h, bv[mt][j]); \
                const float gv = __builtin_bit_cast(float, (unsigned)ggv[mt][j] << 16); \
                __builtin_amdgcn_raw_buffer_store_b16((unsigned short)cvtpk_bf16(h * gv, 0.f), GOr, gvo, (t0 + 16 * mt + j) * (DM * 2), 0); } } \
        asm volatile("s_waitcnt lgkmcnt(0)" ::: "memory"); \
        asm volatile("s_waitcnt vmcnt(8)" ::: "memory"); \
    } while (0)
    for (int cc = 0; cc < SEQ / 128; cc += 2) { RG_CHUNK(0, cc); RG_CHUNK(1, cc + 1); }
#undef RG_CHUNK
#undef RG_DMA
    asm volatile("s_waitcnt vmcnt(0) lgkmcnt(0)" ::: "memory"); __builtin_amdgcn_s_barrier(); asm volatile("" ::: "memory");
}
__device__ __forceinline__ int attn_jlo(const Frame& F, const float* CB, const unsigned* NORM, int bh, int qb) {
    float qs = 0.f, ks = 0.f;
#pragma unroll
    for (int w = 0; w < 4; ++w) { qs += __uint_as_float(NORM[(bh) * 4 + w]); ks += __uint_as_float(NORM[(64 + bh) * 4 + w]); }
    constexpr float C2 = 1.4426950408889634f * 0.08838834764831845f;
    const float th = 150.0f + 2.0f * 1.02f * sqrtf(qs * ks) * C2 + 4.0f;
    const float ref = CB[(size_t)bh * SEQ + qb * 256], v = CB[(size_t)bh * SEQ + 64 * F.lane + 63];
    const unsigned long long m = __ballot(F.lane < 4 * qb && (ref - v) * C2 > th);
    int j = __builtin_popcountll(m); if (m != ((j >= 64) ? ~0ull : ((1ull << j) - 1ull))) j = 0;
    return j & ~1;
}
__device__ __forceinline__ fattn::BlockRef attn_ref(int bh, int qb, int jlo) {
    const int b = bh >> 3, h = bh & 7;
    fattn::BlockRef r; r.qo = ((unsigned)bh * SEQ + (unsigned)qb * 256u) * HD; r.oo = ((unsigned)b * SEQ + (unsigned)qb * 256u) * DM + h * HD; r.kvo = (unsigned)bh * SEQ * HD; r.cbo = (unsigned)bh * SEQ; r.P0 = qb * 256; r.jlo = jlo; return r;
}
__device__ __forceinline__ void attn_phase(const Frame& F, char* lds, const bf16* Qb, bf16* Ob, const bf16* Kb, const bf16* Vb, const float* CB, const int* JLO, gu32* QCTR) {
    constexpr int NBLK = 128;
    const int M = F.G >> 3; if ((F.G & 7) || M > 64 || M < 1) return;
    const int x = F.vcu / M, r = F.vcu % M;
    volatile LAS int* tk_l = (volatile LAS int*)(F.lds + MISC_OFF + 64);
    gu32* qc = QCTR + 64 * x;
    const fattn::Bases G{Qb, Ob, Kb, Vb, CB};
#define ATT_DEC(k_, bh_, qb_) do { const int i_ = (k_) & 7; bh_ = (i_ < 4 ? 4 * x + i_ : 32 + 4 * x + (i_ - 4)); qb_ = 15 - ((k_) >> 3); } while (0)
    int bh, qb; ATT_DEC(r, bh, qb);
    fattn::BlockRef cur = attn_ref(bh, qb, __builtin_amdgcn_readfirstlane(JLO[bh * 16 + qb]));
    ATT_DEC(r + M, bh, qb);
    fattn::BlockRef nxt = attn_ref(bh, qb, __builtin_amdgcn_readfirstlane(JLO[bh * 16 + qb])); bool nxt_ok = (r + M) < NBLK;
    fattn::Seam S;
    fattn::prime(G, cur, lds, S);
    bool more = true;
    for (;;) {
        unsigned tkt = 0u;
        if (more && F.tid == 0) tkt = __hip_atomic_fetch_add(qc, 1u, __ATOMIC_RELAXED, __HIP_MEMORY_SCOPE_AGENT);
        const bool last = !nxt_ok;
        fattn::block(G, cur, last ? cur : nxt, lds, S);
        if (last) break;
        if (F.tid == 0) tk_l[0] = more ? (int)tkt + 2 * M : NBLK;
        __syncthreads();
        const int k2 = __builtin_amdgcn_readfirstlane(tk_l[0]);
        __syncthreads();
        cur = nxt;
        if (k2 < NBLK) { ATT_DEC(k2, bh, qb); nxt = attn_ref(bh, qb, __builtin_amdgcn_readfirstlane(JLO[bh * 16 + qb])); nxt_ok = true; } else { nxt_ok = false; more = false; }
    }
#undef ATT_DEC
}
typedef float f32x16 __attribute__((ext_vector_type(16)));
struct P5Args { const float *X, *WRT, *b_rgrp, *b_rexp, *w_down; const bf16* DL; bf16* X1B; unsigned char *X8, *W2; float* RS2; int* LISTS; unsigned* TOK; gu32* CNT; };
__device__ __forceinline__ void p5_route(const Frame& F, const P5Args& a) {
    const int tid = F.tid, lane = F.lane, wid = F.wave, i16 = lane & 15, h4 = lane >> 4;
    constexpr int LDA = 132;
    LAS float* A_l = (LAS float*)(F.lds + RING_OFF) + wid * 16 * LDA;
    LAS float* B_l = (LAS float*)(F.lds + RING_OFF + 67584);
    LAS float* LG = (LAS float*)(F.lds + RING_OFF + 94208);
    LAS float* rs_l = (LAS float*)(F.lds + RING_OFF + 113664);
    LAS int* hist = (LAS int*)(F.lds + RING_OFF + 114176);
    LAS int* base_l = (LAS int*)(F.lds + RING_OFF + 114432);
    {
        LAS float* scr = (LAS float*)(F.lds + RING_OFF + wid * 8704);
        const int gw = F.vcu * NWAVES + wid, NGW = F.G * NWAVES;
        for (int it = gw; it < 8192; it += NGW) { const int e = it >> 8, kb = (it >> 5) & 7, nb = it & 31; const float* W = a.w_down + (size_t)e * DE * DM;
            transpose_tile8(W + (size_t)(64 * kb) * DM + 32 * nb, DM, a.W2 + (size_t)(e * 1024 + 32 * nb) * DE + 64 * kb, DE, nullptr, pg8::W2_SCALE, scr, lane); }
    }
    __syncthreads();
    for (int rb = blockIdx.x; rb < T / 128; rb += F.G) {
        const int R0 = rb * 128;
        if (tid < 32) hist[tid] = 0;
        const int ar = lane >> 5, ac = 4 * (lane & 31);
        const size_t xo = (size_t)(R0 + 16 * wid + ar) * DM + ac; const float* xsrc = a.X + xo; const bf16* dsrc = a.DL + xo; unsigned char* xdst = a.X8 + xo; bf16* bdst = a.X1B + xo;
        f32x4 areg[8], breg[3]; unsigned long long dreg[8];
#define P5_LOAD(kc_) do { _Pragma("unroll") for (int i_ = 0; i_ < 8; ++i_) { areg[i_] = *(const f32x4*)(xsrc + (size_t)(2 * i_) * DM + (kc_) * 128); dreg[i_] = *(const unsigned long long*)(dsrc + (size_t)(2 * i_) * DM + (kc_) * 128); } \
        _Pragma("unroll") for (int q_ = 0; q_ < 3; ++q_) { const int idx_ = tid + 512 * q_; breg[q_] = *(const f32x4*)(a.WRT + (size_t)(idx_ >> 5) * DM + (kc_) * 128 + 4 * (idx_ & 31)); } } while (0)
        P5_LOAD(0);
        f32x4 acc[3] = {{0.f, 0.f, 0.f, 0.f}, {0.f, 0.f, 0.f, 0.f}, {0.f, 0.f, 0.f, 0.f}}; float ss = 0.f;
        for (int kc = 0; kc < 8; ++kc) {
#pragma unroll
            for (int i = 0; i < 8; ++i) { const unsigned dl = (unsigned)dreg[i], dh = (unsigned)(dreg[i] >> 32);
                areg[i][0] += bf_lo(dl); areg[i][1] += bf_hi(dl); areg[i][2] += bf_lo(dh); areg[i][3] += bf_hi(dh);
                *(unsigned*)(xdst + (size_t)(2 * i) * DM + kc * 128) = pg8::pack4_fp8(areg[i][0], areg[i][1], areg[i][2], areg[i][3]);
                *(unsigned long long*)(bdst + (size_t)(2 * i) * DM + kc * 128) = (unsigned long long)pg8::cvt_pk_bf16(areg[i][0], areg[i][1]) | ((unsigned long long)pg8::cvt_pk_bf16(areg[i][2], areg[i][3]) << 32);
                *(LAS f32x4*)(A_l + (2 * i + ar) * LDA + ac) = areg[i]; }
#pragma unroll
            for (int q = 0; q < 3; ++q) { const int idx = tid + 512 * q; *(LAS f32x4*)(B_l + (idx >> 5) * LDA + 4 * (idx & 31)) = breg[q]; }
            __syncthreads();
            if (kc + 1 < 8) P5_LOAD(kc + 1);
#pragma unroll
            for (int jj = 0; jj < 8; ++jj) {
                const f32x4 af = *(const LAS f32x4*)(A_l + i16 * LDA + 16 * jj + 4 * h4);
                f32x4 bfv[3];
#pragma unroll
                for (int nt = 0; nt < 3; ++nt) bfv[nt] = *(const LAS f32x4*)(B_l + (16 * nt + i16) * LDA + 16 * jj + 4 * h4);
                ss += (af[0] * af[0] + af[1] * af[1]) + (af[2] * af[2] + af[3] * af[3]);
#pragma unroll
                for (int s = 0; s < 4; ++s)
#pragma unroll
                    for (int nt = 0; nt < 3; ++nt) acc[nt] = __builtin_amdgcn_mfma_f32_16x16x4f32(af[s], bfv[nt][s], acc[nt], 0, 0, 0);
            }
            __syncthreads();
        }
#undef P5_LOAD
        ss += __shfl_xor(ss, 16); ss += __shfl_xor(ss, 32);
        const float rs = 1.0f / sqrtf(ss * (1.0f / DM) + EPS);
        if (h4 == 0) { a.RS2[R0 + 16 * wid + i16] = rs; rs_l[16 * wid + i16] = rs; }
#pragma unroll
        for (int r = 0; r < 4; ++r) { const int rl = 16 * wid + 4 * h4 + r; LG[rl * 37 + i16] = acc[0][r]; LG[rl * 37 + 16 + i16] = acc[1][r]; if (i16 < 4) LG[rl * 37 + 32 + i16] = acc[2][r]; }
        __syncthreads();
        int e0 = 0, e1 = 0, k0 = 0, k1 = 0; float w0 = 0.f, w1 = 0.f;
        if (tid < 128) {
            const float rsv = rs_l[tid]; const LAS float* lg = LG + tid * 37;
            float gl[4];
#pragma unroll
            for (int q = 0; q < 4; ++q) gl[q] = lg[32 + q] * rsv + a.b_rgrp[q];
            int gs = 0; float gm = gl[0];
#pragma unroll
            for (int q = 1; q < 4; ++q) if (gl[q] > gm) { gm = gl[q]; gs = q; }
            float den = 0.f;
#pragma unroll
            for (int q = 0; q < 4; ++q) den += expf(gl[q] - gm);
            const float pg = 1.0f / den;
            float el[8];
#pragma unroll
            for (int q = 0; q < 8; ++q) el[q] = lg[8 * gs + q] * rsv + a.b_rexp[8 * gs + q];
            int i0 = 0; float v0 = el[0];
#pragma unroll
            for (int q = 1; q < 8; ++q) if (el[q] > v0) { v0 = el[q]; i0 = q; }
            int i1 = -1; float v1 = -INFINITY;
#pragma unroll
            for (int q = 0; q < 8; ++q) if (q != i0 && el[q] > v1) { v1 = el[q]; i1 = q; }
            const float ex = expf(v1 - v0);
            w0 = pg / (1.0f + ex); w1 = pg * ex / (1.0f + ex);
            e0 = 8 * gs + i0; e1 = 8 * gs + i1;
            k0 = atomicAdd((int*)(hist + e0), 1); k1 = atomicAdd((int*)(hist + e1), 1);
        }
        __syncthreads();
        if (tid < 32) base_l[tid] = (int)__hip_atomic_fetch_add(a.CNT + tid, (unsigned)hist[tid], __ATOMIC_RELAXED, __HIP_MEMORY_SCOPE_AGENT);
        __syncthreads();
        if (tid < 128) { const int tok = R0 + tid, s0 = base_l[e0] + k0, s1 = base_l[e1] + k1;
            a.LISTS[(size_t)e0 * T + s0] = tok; a.LISTS[(size_t)e1 * T + s1] = tok;
            v4u i0v = {(unsigned)e0, (unsigned)s0, (unsigned)e1, (unsigned)s1}, i1v = {__float_as_uint(w0), __float_as_uint(w1), 0u, 0u};
            *(GAS v4u*)(a.TOK + (size_t)tok * 8) = i0v; *(GAS v4u*)(a.TOK + (size_t)tok * 8 + 4) = i1v; }
        __syncthreads();
    }
}
__device__ __forceinline__ void build_tables(const Frame& F, const gu32* CNT) {
    LAS int* ps = (LAS int*)(F.lds + TBL_PS); LAS int* cn = (LAS int*)(F.lds + TBL_CN); LAS int* te = (LAS int*)(F.lds + TBL_TE);
    __syncthreads();
    if (F.tid < 32) { int c = (int)__hip_atomic_load(CNT + F.tid, __ATOMIC_RELAXED, __HIP_MEMORY_SCOPE_AGENT); c = c < 0 ? 0 : (c > T ? T : c); cn[F.tid] = c; }
    __syncthreads();
    if (F.tid == 0) { int run = 0; for (int e = 0; e < 32; ++e) { ps[e] = run; run += (cn[e] + 255) & ~255; } if (run > PMAX) run = PMAX; ps[32] = run; }
    __syncthreads();
    if (F.tid < 288) { const int p = F.tid * 256; int e = 0; for (int q = 1; q < 32; ++q) if (p >= ps[q]) e = q; te[F.tid] = e; }
    __syncthreads();
}
__device__ __forceinline__ void build_rowtab(const Frame& F, const pg8::GroupedOrder& S, const int* LISTS, const float* RS2, LAS int* rowtab) {
    const LAS int* ps = (const LAS int*)(F.lds + TBL_PS); const LAS int* cn = (const LAS int*)(F.lds + TBL_CN); const LAS int* te = (const LAS int*)(F.lds + TBL_TE);
    pg8::Unit u;
    for (int ui = 0; ui < 6 && S.next(ui, u); ++ui)
        if (F.tid < 256) { const int p = u.pm * 256 + F.tid, e = te[u.pm], local = p - ps[e]; const int tok = local < cn[e] ? LISTS[(size_t)e * T + local] : 0; rowtab[ui * 256 + F.tid] = tok; ((LAS float*)rowtab)[(6 + ui) * 256 + F.tid] = RS2[tok]; }
    __syncthreads();
}
__device__ __forceinline__ float fp8_f32(unsigned w, int i) { return i == 0 ? __builtin_amdgcn_cvt_f32_fp8(w, 0) : (i == 1 ? __builtin_amdgcn_cvt_f32_fp8(w, 1) : (i == 2 ? __builtin_amdgcn_cvt_f32_fp8(w, 2) : __builtin_amdgcn_cvt_f32_fp8(w, 3))); }
__device__ __forceinline__ void p9_final(const Frame& F, const bf16* X1B, float* OUT, const unsigned char* Y, const unsigned* TOK, const float* g_final) {
    const LAS int* ps = (const LAS int*)(F.lds + TBL_PS);
    const int gw = F.vcu * NWAVES + F.wave, NGW = F.G * NWAVES;
    f32x4 gf[4];
#pragma unroll
    for (int j = 0; j < 4; ++j) gf[j] = *((const f32x4*)g_final + F.lane + 64 * j);
    constexpr float YS = 1.0f / (pg8::HB_SCALE * pg8::W2_SCALE * pg8::Y_SCALE);
    v4u ia_n = {0u, 0u, 0u, 0u}, ib_n = {0u, 0u, 0u, 0u}, ia_c = ia_n, ib_c = ib_n; unsigned long long xw_n[4]; unsigned ya_n[4], yb_n[4];
#define P9_TOK(m_, ia_, ib_) do { ia_ = *(const GAS v4u*)(TOK + (size_t)(m_) * 8); ib_ = *(const GAS v4u*)(TOK + (size_t)(m_) * 8 + 4); } while (0)
#define P9_ROW(m_, ia_) do { const size_t p0_ = (size_t)(ps[(int)(ia_.x & 31u)] + (int)ia_.y), p1_ = (size_t)(ps[(int)(ia_.z & 31u)] + (int)ia_.w); \
        const GAS unsigned long long* xr_ = (const GAS unsigned long long*)(X1B + (size_t)(m_) * DM) + F.lane; \
        const GAS unsigned* y0_ = (const GAS unsigned*)(Y + p0_ * DM) + F.lane; const GAS unsigned* y1_ = (const GAS unsigned*)(Y + p1_ * DM) + F.lane; \
        _Pragma("unroll") for (int j = 0; j < 4; ++j) { xw_n[j] = xr_[64 * j]; ya_n[j] = y0_[64 * j]; yb_n[j] = y1_[64 * j]; } } while (0)
    if (gw < T) { P9_TOK(gw, ia_c, ib_c); P9_ROW(gw, ia_c); if (gw + NGW < T) P9_TOK(gw + NGW, ia_n, ib_n); }
    for (int m = gw; m < T; m += NGW) {
        const float w0 = __uint_as_float(ib_c.x) * YS, w1 = __uint_as_float(ib_c.y) * YS;
        unsigned long long xw[4]; unsigned ya[4], yb[4];
#pragma unroll
        for (int j = 0; j < 4; ++j) { xw[j] = xw_n[j]; ya[j] = ya_n[j]; yb[j] = yb_n[j]; }
        if (m + NGW < T) { ia_c = ia_n; ib_c = ib_n; P9_ROW(m + NGW, ia_c); if (m + 2 * NGW < T) P9_TOK(m + 2 * NGW, ia_n, ib_n); }
        GAS f32x4* orow = (GAS f32x4*)(OUT + (size_t)m * DM) + F.lane;
        f32x4 v[4]; float s = 0.f;
#pragma unroll
        for (int j = 0; j < 4; ++j) { v[j] = (f32x4){bf_lo((unsigned)xw[j]), bf_hi((unsigned)xw[j]), bf_lo((unsigned)(xw[j] >> 32)), bf_hi((unsigned)(xw[j] >> 32))}; const unsigned a = ya[j], b = yb[j];
            v[j].x += w0 * fp8_f32(a, 0) + w1 * fp8_f32(b, 0); v[j].y += w0 * fp8_f32(a, 1) + w1 * fp8_f32(b, 1);
            v[j].z += w0 * fp8_f32(a, 2) + w1 * fp8_f32(b, 2); v[j].w += w0 * fp8_f32(a, 3) + w1 * fp8_f32(b, 3);
            s += (v[j].x * v[j].x + v[j].y * v[j].y) + (v[j].z * v[j].z + v[j].w * v[j].w); }
        s = wave_sum(s);
        const float rs = 1.0f / sqrtf(s * (1.0f / DM) + EPS);
#pragma unroll
        for (int j = 0; j < 4; ++j) orow[64 * j] = v[j] * rs * gf[j];
    }
#undef P9_TOK
#undef P9_ROW
}

constexpr int N_PHASES = 10;
#ifndef DUP_TRIVIAL
#define DUP_TRIVIAL 0
#endif
#ifndef DUP_PHASE
#define DUP_PHASE -1
#endif
typedef __attribute__((address_space(4))) const unsigned char* karg_ptr;
__device__ __forceinline__ const float* arg_in(int k) { karg_ptr base = (karg_ptr)__builtin_amdgcn_kernarg_segment_ptr(); const unsigned long long v = *(const unsigned long long volatile __attribute__((address_space(4)))*)(base + 8 * k); return (const float*)(const GAS float*)v; }
struct Args { const float* in[23]; float* out; unsigned char* ws; int ph_lo, ph_hi, mode, pad; };
__global__ void __launch_bounds__(NWAVES * 64, 2) fwd_kernel(Args args) {
    extern __shared__ __attribute__((aligned(16))) unsigned char lds[];
    Frame F;
    F.lds = (LAS unsigned char*)lds;
    F.wave = __builtin_amdgcn_readfirstlane((int)threadIdx.x >> 6); F.lane = pg8::lane_now(); F.tid = F.wave * 64 + F.lane;
    F.G = gridDim.x; { const int bx = blockIdx.x; F.vcu = (F.G % 8 == 0) ? (bx % 8) * (F.G / 8) + bx / 8 : bx; }
    unsigned char* ws = args.ws;
    gu32* ctl = (gu32*)(ws + WS_CTL);
    volatile LAS unsigned* MISC = (volatile LAS unsigned*)(F.lds + MISC_OFF);
    for (int u = F.tid; u < (LDS_BYTES - LDSCTL_OFF) / 4; u += NWAVES * 64) ((LAS unsigned*)(F.lds + LDSCTL_OFF))[u] = 0u;
    __syncthreads();
#if MK_ONE_LAUNCH
    XcdBarrier bar = xcd_barrier_post((unsigned*)(ctl + CW_BAR), MISC + 8);
#define GRID_BAR() xcd_barrier(bar)
#else
#define GRID_BAR() do { } while (0)
#endif
    const int lo = args.ph_lo, hi = args.ph_hi;
#ifndef PH_MASK
#define PH_MASK 0x3ff
#endif
#define IN(k) (((PH_MASK >> (k)) & 1) && lo <= (k) && (k) < hi)
#define BOTH(k) (IN(k) && IN((k) + 1))
    float* out = args.out;
    bf16* Win = (bf16*)(ws + WS_WIN); bf16* Wl = (bf16*)(ws + WS_WL); bf16* Wa = (bf16*)(ws + WS_WA); bf16* Wo = (bf16*)(ws + WS_WO); bf16* Wrg = (bf16*)(ws + WS_WRG);
    bf16* XB = (bf16*)(ws + WS_XB); bf16* XR = (bf16*)(ws + WS_XR); bf16* GG = (bf16*)(ws + WS_GG); bf16* Qb = (bf16*)(ws + WS_Q); bf16* Kb = (bf16*)(ws + WS_K); bf16* Vb = (bf16*)(ws + WS_V);
    bf16* SL = (bf16*)out; bf16* SA = (bf16*)out + pg8::SEGE;
    float* RS1 = (float*)(ws + WS_RS1); float* RS2 = (float*)(ws + WS_RS2); float* LF = (float*)(ws + WS_LF); float* CB = (float*)(ws + WS_CB);
    unsigned* TOK = (unsigned*)(ws + WS_TOK); int* LISTS = (int*)(ws + WS_LISTS); float* WRT = (float*)(ws + WS_WRT); int* JLO = (int*)(ws + WS_SRS);
    unsigned char* W13 = ws + WS_W13; unsigned char* W2 = ws + WS_W2; bf16* XG = (bf16*)(ws + WS_XG); unsigned char* HB = ws + WS_HB; unsigned char* X8 = ws + WS_XB;
    gu32* CNT = ctl + CW_CNT;

    if (IN(0)) { F.lane = pg8::lane_now(); F.tid = F.wave * 64 + F.lane;
        P0Args a{arg_in(0), arg_in(1), arg_in(2), arg_in(5), arg_in(7), arg_in(10), arg_in(11), arg_in(12), arg_in(13), arg_in(14), arg_in(15), arg_in(17), arg_in(19), arg_in(20), Win, Wl, Wa, Wo, Wrg, XB, W13, RS1, LF, WRT};
        p0_prologue(F, a, DUP_PHASE == 0 ? args.mode : 0);
        if (BOTH(0)) GRID_BAR();
    }
    if (IN(1)) { F.lane = pg8::lane_now(); F.tid = F.wave * 64 + F.lane;
        cumsum_bias(F, LF, CB);
        pg8::Gemm g{XB, Win, T, NZ, DM}; pg8::StaticOrder S; S.init(T, NZ, F.G, (int)blockIdx.x);
        pg8::EpiZ E{XR, SL, RS1, (unsigned*)(ctl + CW_NORM), args.mode};
        pg8::gemm_phase<pg8::EpiZ, pg8::StaticOrder, true, true>(F.lds + RING_OFF, g, S, E, F.wave);
        if (BOTH(1)) GRID_BAR();
    }
    if (IN(2)) { F.lane = pg8::lane_now(); F.tid = F.wave * 64 + F.lane;
        { const int gw = F.vcu * NWAVES + F.wave; if (gw < NB * NH * 16) { const int j = attn_jlo(F, CB, (const unsigned*)(ctl + CW_NORM), gw >> 4, gw & 15); if (F.lane == 0) JLO[gw] = j; } }
        conv_prepass(F, XR, XB, arg_in(3), arg_in(4));
        if (BOTH(2)) GRID_BAR();
    }
    if (IN(3)) { F.lane = pg8::lane_now(); F.tid = F.wave * 64 + F.lane;
        RgArgs ra{XB, GG, GG, Wrg, arg_in(6), arg_in(8), arg_in(9)};
#if DUP_PHASE >= 20
        const int mode = args.mode;
#else
        constexpr int mode = 0;
#endif
        if (mode != 2) { ra.GO = mode == 1 ? XR : GG; for (int u = F.vcu; u < 256; u += F.G) rglru_unit(F, ra, u); }
        if (mode != 1) attn_phase(F, (char*)lds + RING_OFF, Qb, XR, Kb, Vb, CB, JLO, ctl + CW_QCTR + (mode == 2 ? 1024 : 0));
        if (BOTH(3)) GRID_BAR();
    }
    if (IN(4)) { { F.lane = pg8::lane_now(); F.tid = F.wave * 64 + F.lane;
        static_assert(WS_GG - WS_XR == (size_t)128 * 256 * DM * 2 && WS_WL - WS_WA == (size_t)4 * 256 * DM * 2, "TwoGemmOrder: hg follows o by 128 row tiles, Wl follows Wa by 4 column tiles");
        pg8::Gemm g{XR, Wa, T, DM, DM}; pg8::TwoGemmOrder S; S.init(T, DM, F.G, (int)blockIdx.x);
        pg8::EpiGate2 E{SA, SL, XB};
        pg8::gemm_phase<pg8::EpiGate2, pg8::TwoGemmOrder, true, true>(F.lds + RING_OFF, g, S, E, F.wave); }
        if (BOTH(4)) GRID_BAR();
    }
    if (IN(5)) { F.lane = pg8::lane_now(); F.tid = F.wave * 64 + F.lane;
        pg8::Gemm g{XB, Wo, T, DM, DM}; pg8::StaticOrder S; S.init(T, DM, F.G, (int)blockIdx.x);
        pg8::EpiDelta E{(bf16*)out};
        pg8::gemm_phase<pg8::EpiDelta, pg8::StaticOrder, true, true>(F.lds + RING_OFF, g, S, E, F.wave);
        if (BOTH(5)) GRID_BAR();
    }
    if (IN(6)) { F.lane = pg8::lane_now(); F.tid = F.wave * 64 + F.lane;
        P5Args a{arg_in(0), WRT, arg_in(16), arg_in(18), arg_in(21), (const bf16*)out, XR, X8, W2, RS2, LISTS, TOK, args.mode ? CNT + 64 : CNT};
        p5_route(F, a);
        if (BOTH(6)) GRID_BAR();
    }
    if (IN(7)) { F.lane = pg8::lane_now(); F.tid = F.wave * 64 + F.lane;
        build_tables(F, CNT);
        const int ntiles = ((const LAS int*)(F.lds + TBL_PS))[32] >> 8;
        pg8::Gemm g{(const bf16*)X8, (const bf16*)W13, ntiles * 256, 32 * 1024, DM / 2}; pg8::GroupedOrder S{(const LAS int*)(F.lds + TBL_TE), ntiles * 4, F.G, F.vcu};
        LAS int* rowtab = (LAS int*)(F.lds + RG_TOT);
        build_rowtab(F, S, LISTS, RS2, rowtab);
        pg8::EpiSwiGLU E{HB};
        pg8::gemm_phase_gather<pg8::EpiSwiGLU, pg8::GroupedOrder, true>(F.lds + RING_OFF, g, S, E, rowtab, F.wave);
        if (BOTH(7)) GRID_BAR();
    }
    if (IN(8)) { F.lane = pg8::lane_now(); F.tid = F.wave * 64 + F.lane;
        build_tables(F, CNT);
        const int ntiles = ((const LAS int*)(F.lds + TBL_PS))[32] >> 8;
        pg8::Gemm g{(const bf16*)HB, (const bf16*)W2, ntiles * 256, 32 * 1024, DE / 2}; pg8::GroupedOrder S{(const LAS int*)(F.lds + TBL_TE), ntiles * 4, F.G, F.vcu};
        pg8::EpiY E{(unsigned char*)XG};
        pg8::gemm_phase<pg8::EpiY, pg8::GroupedOrder, true, true, true>(F.lds + RING_OFF, g, S, E, F.wave);
        if (BOTH(8)) GRID_BAR();
    }
    if (IN(9)) { F.lane = pg8::lane_now(); F.tid = F.wave * 64 + F.lane;
        build_tables(F, CNT);
        p9_final(F, XR, out, (const unsigned char*)XG, TOK, arg_in(22));
    }
#undef IN
#undef BOTH
}

extern "C" void kernel_launch(void* const* d_in, const int* in_sizes, int n_in, void* d_out, int out_size, void* d_ws, size_t ws_size, hipStream_t stream) {
    static int grid = 0;
    if (grid == 0) {
        if (n_in != 23 || in_sizes[0] != T * DM || out_size != T * DM || ws_size < WS_END) { fprintf(stderr, "kernel_launch: unexpected shapes (n_in %d, in0 %d, out %d, ws %zu); nothing launched\n", n_in, n_in > 0 ? in_sizes[0] : -1, out_size, ws_size); grid = -1; return; }
        int dev = 0, cus = 0;
        if (hipGetDevice(&dev) != hipSuccess || hipDeviceGetAttribute(&cus, hipDeviceAttributeMultiprocessorCount, dev) != hipSuccess) { grid = -1; return; }
        if (hipFuncSetAttribute((const void*)fwd_kernel, hipFuncAttributeMaxDynamicSharedMemorySize, LDS_BYTES) != hipSuccess) { fprintf(stderr, "kernel_launch: hipFuncSetAttribute failed\n"); grid = -1; return; }
        int per_cu = 0;
        if (hipOccupancyMaxActiveBlocksPerMultiprocessor(&per_cu, (const void*)fwd_kernel, NWAVES * 64, LDS_BYTES) != hipSuccess || per_cu < 1) { fprintf(stderr, "kernel_launch: occupancy query reports %d\n", per_cu); }
        (void)hipGetLastError();
        grid = cus;
    }
    if (grid < 0) return;
    if (hipMemsetAsync((char*)d_ws + WS_CTL, 0, CTL_ZERO_BYTES, stream) != hipSuccess) return;
    Args a{};
    for (int i = 0; i < 23; ++i) a.in[i] = (const float*)d_in[i];
    a.out = (float*)d_out; a.ws = (unsigned char*)d_ws;
#if MK_ONE_LAUNCH
    a.ph_lo = 0; a.ph_hi = N_PHASES;
    hipLaunchKernelGGL(fwd_kernel, dim3(grid), dim3(NWAVES * 64), LDS_BYTES, stream, a);
#else
    for (int ph = 0; ph < N_PHASES; ++ph) { a.ph_lo = ph; a.ph_hi = ph + 1;
        if (DUP_PHASE == ph || (ph == 3 && DUP_PHASE >= 20)) { a.mode = DUP_PHASE >= 20 ? DUP_PHASE - 19 : ((ph == 6 || (ph == 1 && DUP_TRIVIAL)) ? 1 : (ph == 0 ? DUP_TRIVIAL : 0)); hipLaunchKernelGGL(fwd_kernel, dim3(grid), dim3(NWAVES * 64), LDS_BYTES, stream, a); a.mode = 0; }
        hipLaunchKernelGGL(fwd_kernel, dim3(grid), dim3(NWAVES * 64), LDS_BYTES, stream, a); }
#endif
}
```

```cpp
#include <hip/hip_runtime.h>
#include <cstdio>
#include <cstdint>

#ifndef MK_ONE_LAUNCH
#define MK_ONE_LAUNCH 1
#endif
namespace pg8 {
#define PG8_LAS __attribute__((address_space(3)))
typedef unsigned short bf16_t;
typedef short bf16x8 __attribute__((ext_vector_type(8)));
typedef float f32x4 __attribute__((ext_vector_type(4)));
typedef unsigned u32x4 __attribute__((ext_vector_type(4)));
constexpr int BM = 256, BK = 64, HALF = 128, HTB = HALF * BK * 2  , STAGE_BYTES = 8 * HTB, NXCD = 8, WGM = 8;

__host__ __device__ __forceinline__ int lds_byte(int r, int c) { const int st = (r >> 4) * 2 + (c >> 5), rr = r & 15, cc = c & 31, ob = rr * 64 + cc * 2; return st * 1024 + (ob ^ (((ob >> 9) & 1) << 5)); }
__host__ __device__ __forceinline__ void stage_rc(int b, int& R, int& C) { const int st = b / 1024, sb = b % 1024, swz = sb ^ (((sb >> 9) & 1) << 5); R = (st >> 1) * 16 + swz / 64; C = (st & 1) * 32 + (swz % 64) / 2; }
__host__ __device__ __forceinline__ int perm32(int rho) { const int n = rho >> 4, i = rho & 15; return 8 * (i >> 2) + 4 * n + (i & 3); }

struct Unit { int pm, pn; };
struct Gemm { const bf16_t* A; const bf16_t* Bt; int M, N, K; };

struct StaticOrder {
    int nM, nN, nwg, G, c;
    __host__ __device__ void init(int M, int N, int G_, int c_) { nM = M / BM; nN = N / BM; nwg = nM * nN; G = G_; c = c_; }
    __host__ __device__ bool next(int i, Unit& u) const {
        const long L = (long)i * G + c; if (L >= nwg) return false;
        int wgid = (int)L; { const int q = nwg / NXCD, r = nwg % NXCD, xcd = wgid % NXCD, off = wgid / NXCD; wgid = (xcd < r ? xcd * (q + 1) : r * (q + 1) + (xcd - r) * q) + off; }
        const int nig = WGM * nN, gid = wgid / nig, fm = gid * WGM, gsz = (nM - fm) < WGM ? (nM - fm) : WGM;
        u.pm = fm + ((wgid % nig) % gsz); u.pn = (wgid % nig) / gsz; return true;
    }
    __device__ __forceinline__ void a_ready(const Unit&) const {}
    __device__ __forceinline__ void done(const Unit&) const {}
};

__device__ __forceinline__ unsigned cvt_pk_bf16(float lo, float hi) { unsigned r; asm volatile("v_cvt_pk_bf16_f32 %0, %1, %2" : "=v"(r) : "v"(lo), "v"(hi)); return r; }
typedef float f32x2 __attribute__((ext_vector_type(2)));
__device__ __forceinline__ int lane_now() { int l; asm volatile("v_mbcnt_lo_u32_b32 %0, -1, 0\n\tv_mbcnt_hi_u32_b32 %0, -1, %0" : "=v"(l)); return l; }
typedef int v4i_t __attribute__((ext_vector_type(4)));
typedef int v8i_t __attribute__((ext_vector_type(8)));
__device__ __forceinline__ v8i_t cat8(bf16x8 a, bf16x8 b) { const v4i_t x = __builtin_bit_cast(v4i_t, a), y = __builtin_bit_cast(v4i_t, b); return __builtin_shufflevector(x, y, 0, 1, 2, 3, 4, 5, 6, 7); }
__device__ __forceinline__ void glds_sv(const char* base, unsigned voff, unsigned lds_dst) { unsigned keep;
    asm volatile("s_mov_b32 %0, m0\n\ts_mov_b32 m0, %3\n\ts_nop 0\n\tglobal_load_lds_dwordx4 %1, %2\n\ts_mov_b32 m0, %0" : "=&s"(keep) : "v"(voff), "s"(base), "s"(lds_dst) : "memory"); }
__device__ __forceinline__ float sat8(float x) { return __builtin_amdgcn_fmed3f(x, -448.0f, 448.0f); }
__device__ __forceinline__ unsigned pack4_fp8(float a, float b, float c, float d) { unsigned w = 0u; w = __builtin_amdgcn_cvt_pk_fp8_f32(sat8(a), sat8(b), w, false); w = __builtin_amdgcn_cvt_pk_fp8_f32(sat8(c), sat8(d), w, true); return w; }
constexpr float W13_SCALE = 64.0f, HB_SCALE = 8.0f, W2_SCALE = 32.0f;
__device__ __forceinline__ float sigmoid_f(float x) { return __builtin_amdgcn_rcpf(1.0f + __builtin_amdgcn_exp2f(-1.4426950408889634f * x)); }
__device__ __forceinline__ float gelu_tanh_f(float x) { const float u = x * (1.0f + 0.044715f * x * x); return x * __builtin_amdgcn_rcpf(1.0f + __builtin_amdgcn_exp2f(-2.3022081981f * u)); }
__device__ __forceinline__ float bf_lo(unsigned w) { return __builtin_bit_cast(float, w << 16); }
__device__ __forceinline__ float bf_hi(unsigned w) { return __builtin_bit_cast(float, w & 0xffff0000u); }
constexpr size_t SEGE = (size_t)32768 * 1024;

struct EpiZ {
    static constexpr bool PERM = true, AFTER_DRAIN = false; static constexpr int NSTORES = 16;
    bf16_t* ws5; bf16_t* out2; const float* rs; unsigned* norm; int probe;
    __device__ __forceinline__ void operator()(const f32x4 (&acc)[2][2][4][2], const Unit& u, int wr, int wc, int fr, int fq) const {
        const int seg = probe ? 0 : (u.pn >> 2); float nm[2] = {0.f, 0.f};
        const int sgo = u.pn >> 2; bf16_t* O = sgo < 5 ? ws5 + (size_t)sgo * SEGE : out2 + (size_t)(sgo - 5) * SEGE;
        const int row0 = u.pm * BM + wr * 64 + fr, col0 = (u.pn & 3) * BM + wc * 32 + 8 * fq;
#pragma unroll
        for (int ai = 0; ai < 2; ++ai)
#pragma unroll
            for (int m = 0; m < 4; ++m) { const int row = row0 + ai * HALF + m * 16; bf16_t* rowp = O + (size_t)row * 1024 + col0;
                const bool hm = (sgo >= 2 && sgo <= 4); bf16_t* rowh = O + ((size_t)((row >> 12) * 8 + 2 * (u.pn & 3)) * 4096 + (row & 4095)) * 128 + wc * 32 + 8 * fq;
#pragma unroll
                for (int bj = 0; bj < 2; ++bj) { f32x4 v0 = acc[ai][bj][m][0], v1 = acc[ai][bj][m][1];
                    if (seg == 1) {
#pragma unroll
                        for (int i = 0; i < 4; ++i) { v0[i] = gelu_tanh_f(v0[i]); v1[i] = gelu_tanh_f(v1[i]); } }
                    else if (seg >= 5) {
#pragma unroll
                        for (int i = 0; i < 4; ++i) { v0[i] = sigmoid_f(v0[i]); v1[i] = sigmoid_f(v1[i]); } }
                    if (seg == 2 || seg == 3) { float q = (v0[0] * v0[0] + v0[1] * v0[1]) + (v0[2] * v0[2] + v0[3] * v0[3]) + (v1[0] * v1[0] + v1[1] * v1[1]) + (v1[2] * v1[2] + v1[3] * v1[3]);
                        q += __shfl_xor(q, 16); q += __shfl_xor(q, 32); nm[bj] = fmaxf(nm[bj], q); }
                    u32x4 w; w.x = cvt_pk_bf16(v0[0], v0[1]); w.y = cvt_pk_bf16(v0[2], v0[3]); w.z = cvt_pk_bf16(v1[0], v1[1]); w.w = cvt_pk_bf16(v1[2], v1[3]);
                    *(u32x4*)(hm ? rowh + (size_t)bj * 4096 * 128 : rowp + bj * HALF) = w; } }
        if (seg == 2 || seg == 3) {
#pragma unroll
            for (int bj = 0; bj < 2; ++bj) { float q = nm[bj];
#pragma unroll
                for (int o = 1; o < 16; o <<= 1) q = fmaxf(q, __shfl_xor(q, o));
                if (fr == 0 && fq == 0) atomicMax(norm + ((((seg - 2) * 8 + (u.pm >> 4)) * 8 + 2 * (u.pn & 3) + bj) * 4 + wc), __float_as_uint(q)); }
        }
    }
};
template <int MODE> struct EpiGate {
    static constexpr bool PERM = true, AFTER_DRAIN = false; static constexpr int NSTORES = 16;
    const bf16_t* G; bf16_t* O;
    __device__ __forceinline__ void operator()(const f32x4 (&acc)[2][2][4][2], const Unit& u, int wr, int wc, int fr, int fq) const {
        const int row0 = u.pm * BM + wr * 64 + fr, col0 = u.pn * BM + wc * 32 + 8 * fq;
        u32x4 gv[2][2][2], pv[2][2][2];
#define EG_LOAD(st_, b_) do { _Pragma("unroll") for (int mm = 0; mm < 2; ++mm) _Pragma("unroll") for (int bj = 0; bj < 2; ++bj) { \
            const size_t off_ = (size_t)(row0 + ((st_) >> 1) * HALF + (2 * ((st_) & 1) + mm) * 16) * 1024 + col0 + bj * HALF; gv[b_][mm][bj] = __builtin_nontemporal_load((const u32x4*)(G + off_)); if (MODE == 1) pv[b_][mm][bj] = __builtin_nontemporal_load((const u32x4*)(O + off_)); } } while (0)
#define EG_DO(st_, b_) do { _Pragma("unroll") for (int mm = 0; mm < 2; ++mm) _Pragma("unroll") for (int bj = 0; bj < 2; ++bj) { const int ai = (st_) >> 1, m = 2 * ((st_) & 1) + mm; \
            const size_t off_ = (size_t)(row0 + ai * HALF + m * 16) * 1024 + col0 + bj * HALF; const u32x4 g = gv[b_][mm][bj]; \
            f32x4 v0 = acc[ai][bj][m][0], v1 = acc[ai][bj][m][1]; \
            v0[0] *= bf_lo(g.x); v0[1] *= bf_hi(g.x); v0[2] *= bf_lo(g.y); v0[3] *= bf_hi(g.y); v1[0] *= bf_lo(g.z); v1[1] *= bf_hi(g.z); v1[2] *= bf_lo(g.w); v1[3] *= bf_hi(g.w); \
            if (MODE == 1) { const u32x4 p = pv[b_][mm][bj]; \
                v0[0] += bf_lo(p.x); v0[1] += bf_hi(p.x); v0[2] += bf_lo(p.y); v0[3] += bf_hi(p.y); v1[0] += bf_lo(p.z); v1[1] += bf_hi(p.z); v1[2] += bf_lo(p.w); v1[3] += bf_hi(p.w); } \
            u32x4 w; w.x = cvt_pk_bf16(v0[0], v0[1]); w.y = cvt_pk_bf16(v0[2], v0[3]); w.z = cvt_pk_bf16(v1[0], v1[1]); w.w = cvt_pk_bf16(v1[2], v1[3]); \
            *(u32x4*)(O + off_) = w; } } while (0)
        EG_LOAD(0, 0); EG_LOAD(1, 1); EG_DO(0, 0); EG_LOAD(2, 0); EG_DO(1, 1); EG_LOAD(3, 1); EG_DO(2, 0); EG_DO(3, 1);
#undef EG_LOAD
#undef EG_DO
    }
};
struct TwoGemmOrder {
    StaticOrder base; int n1;
    __device__ void init(int M, int N, int G_, int c_) { base.init(M, N, G_, c_); n1 = (base.nwg - c_ + G_ - 1) / G_; if (n1 < 0) n1 = 0; }
    __device__ __forceinline__ bool next(int i, Unit& u) const { if (i >= 2 * n1) return false; const bool second = i >= n1; base.next(second ? i - n1 : i, u); if (second) { u.pm += 128; u.pn += 4; } return true; }
    __device__ __forceinline__ void a_ready(const Unit&) const {}
    __device__ __forceinline__ void done(const Unit&) const {}
};
struct EpiGate2 {
    static constexpr bool PERM = true, AFTER_DRAIN = false; static constexpr int NSTORES = 16;
    const bf16_t* G0; const bf16_t* G1; bf16_t* O;
    __device__ __forceinline__ void operator()(const f32x4 (&acc)[2][2][4][2], const Unit& u, int wr, int wc, int fr, int fq) const {
        Unit v; v.pm = u.pm & 127; v.pn = u.pn & 3;
        if (u.pm >= 128) { EpiGate<1> e{G1, O}; e(acc, v, wr, wc, fr, fq); } else { EpiGate<0> e{G0, O}; e(acc, v, wr, wc, fr, fq); }
    }
};
struct EpiDelta {
    static constexpr bool PERM = true, AFTER_DRAIN = false; static constexpr int NSTORES = 16;
    bf16_t* O;
    __device__ __forceinline__ void operator()(const f32x4 (&acc)[2][2][4][2], const Unit& u, int wr, int wc, int fr, int fq) const {
        const int row0 = u.pm * BM + wr * 64 + fr, col0 = u.pn * BM + wc * 32 + 8 * fq;
#pragma unroll
        for (int ai = 0; ai < 2; ++ai)
#pragma unroll
            for (int m = 0; m < 4; ++m) { bf16_t* rowp = O + (size_t)(row0 + ai * HALF + m * 16) * 1024 + col0;
#pragma unroll
                for (int bj = 0; bj < 2; ++bj) { const f32x4 v0 = acc[ai][bj][m][0], v1 = acc[ai][bj][m][1];
                    u32x4 w; w.x = cvt_pk_bf16(v0[0], v0[1]); w.y = cvt_pk_bf16(v0[2], v0[3]); w.z = cvt_pk_bf16(v1[0], v1[1]); w.w = cvt_pk_bf16(v1[2], v1[3]);
                    *(u32x4*)(rowp + bj * HALF) = w; } }
    }
};
struct EpiSwiGLU {
    static constexpr bool PERM = true, AFTER_DRAIN = false; static constexpr int NSTORES = 8;
    unsigned char* HB;
    __device__ __forceinline__ void operator()(const f32x4 (&acc)[2][2][4][2], const Unit& u, int wr, int wc, int fr, int fq, const PG8_LAS int* rows) const {
        const int row0 = u.pm * BM + wr * 64 + fr, col0 = (u.pn & 3) * HALF + wc * 32 + 8 * fq;
        float sv[2][4];
#pragma unroll
        for (int ai = 0; ai < 2; ++ai)
#pragma unroll
            for (int m = 0; m < 4; ++m) sv[ai][m] = ((const PG8_LAS float*)rows)[6 * 256 + wr * 64 + fr + ai * HALF + m * 16] * (1.0f / W13_SCALE);
#pragma unroll
        for (int ai = 0; ai < 2; ++ai)
#pragma unroll
            for (int m = 0; m < 4; ++m) { const int row = row0 + ai * HALF + m * 16; const float s = sv[ai][m];
                float o[8];
#pragma unroll
                for (int n = 0; n < 2; ++n)
#pragma unroll
                    for (int i = 0; i < 4; ++i) { const float g = acc[ai][0][m][n][i] * s, uu = acc[ai][1][m][n][i] * s; o[n * 4 + i] = g * sigmoid_f(g) * uu * HB_SCALE; }
                unsigned long long w = (unsigned long long)pack4_fp8(o[0], o[1], o[2], o[3]) | ((unsigned long long)pack4_fp8(o[4], o[5], o[6], o[7]) << 32);
                *(unsigned long long*)(HB + (size_t)row * 512 + col0) = w; }
    }
};
constexpr float Y_SCALE = 0.25f;
struct EpiY {
    static constexpr bool PERM = true, AFTER_DRAIN = false; static constexpr int NSTORES = 16;
    unsigned char* Y;
    __device__ __forceinline__ void operator()(const f32x4 (&acc)[2][2][4][2], const Unit& u, int wr, int wc, int fr, int fq) const {
        const int row0 = u.pm * BM + wr * 64 + fr, col0 = (u.pn & 3) * BM + wc * 32 + 8 * fq;
#pragma unroll
        for (int ai = 0; ai < 2; ++ai)
#pragma unroll
            for (int m = 0; m < 4; ++m) { const int row = row0 + ai * HALF + m * 16; unsigned char* rowp = Y + (size_t)row * 1024 + col0;
#pragma unroll
                for (int bj = 0; bj < 2; ++bj) { const f32x4 v0 = acc[ai][bj][m][0] * Y_SCALE, v1 = acc[ai][bj][m][1] * Y_SCALE;
                    *(unsigned long long*)(rowp + bj * HALF) = (unsigned long long)pack4_fp8(v0[0], v0[1], v0[2], v0[3]) | ((unsigned long long)pack4_fp8(v1[0], v1[1], v1[2], v1[3]) << 32); } }
    }
};
struct GroupedOrder {
    const PG8_LAS int* tile_e; int nunits, G, c;
    __device__ __forceinline__ bool next(int i, Unit& u) const { const int L = i * G + c; if (L >= nunits) return false; u.pm = L >> 2; u.pn = __builtin_amdgcn_readfirstlane(tile_e[u.pm]) * 4 + (L & 3); return true; }
    __device__ __forceinline__ void a_ready(const Unit&) const {}
    __device__ __forceinline__ void done(const Unit&) const {}
};
template <class Epi, class Sched, bool ALIGN_EPI = false, bool SP2 = false, bool F8 = false>
__device__ __forceinline__ void gemm_phase(PG8_LAS unsigned char* lds, const Gemm g, const Sched& S, const Epi& E, const int wid) {
    const int lane = lane_now(), tid = wid * 64 + lane, wr = wid >> 2, wc = wid & 3, fr = lane & 15, fq = lane >> 4;
    const int K = g.K, nt = K / BK;
    unsigned voffA[2], voffB[2];
#pragma unroll
    for (int i = 0; i < 2; ++i) { int R, C; stage_rc(tid * 16 + i * 8192, R, C); const int Rb = Epi::PERM ? ((R & ~31) + perm32(R & 31)) : R;
        voffA[i] = (unsigned)(R * K + C) * 2u; voffB[i] = (unsigned)(Rb * K + C) * 2u; }
    const size_t kstep = (size_t)(BK * 2);
    const size_t hstep = (size_t)HALF * K * 2;
    const size_t tstep = 2 * hstep;
    const unsigned ldsw = (unsigned)wid * 1024u;
    const unsigned ldsbase = (unsigned)__builtin_amdgcn_readfirstlane((int)((unsigned)(uintptr_t)lds + ldsw));
    const int aoff = lds_byte(wr * 64 + fr, fq * 8), boff = lds_byte(wc * 32 + fr, fq * 8);
#define PG8_SA(b, h) (((b) * 2 + (h)) * HTB)
#define PG8_SB(b, h) ((4 + (b) * 2 + (h)) * HTB)
#define PG8_STAGE(bufoff, gbase, voff) do { _Pragma("unroll") for (int _i = 0; _i < 2; ++_i) { \
        if constexpr (F8) glds_sv((const char*)(gbase), (voff)[_i], ldsbase + (unsigned)((bufoff) + _i * 8192)); \
        else __builtin_amdgcn_global_load_lds((const unsigned*)((const char*)(gbase) + (voff)[_i]), (PG8_LAS unsigned*)(lds + (bufoff) + ldsw + _i * 8192), 16, 0, 0); } } while (0)
#define PG8_LDA(dst, b, h) do { _Pragma("unroll") for (int m = 0; m < 4; ++m) { \
        if constexpr (F8) { dst##8[m] = cat8(*(const PG8_LAS bf16x8*)(lds + PG8_SA(b, h) + aoff + m * 2048), *(const PG8_LAS bf16x8*)(lds + PG8_SA(b, h) + aoff + m * 2048 + 1024)); } \
        else { _Pragma("unroll") for (int k = 0; k < 2; ++k) dst[m][k] = *(const PG8_LAS bf16x8*)(lds + PG8_SA(b, h) + aoff + m * 2048 + k * 1024); } } } while (0)
#define PG8_LDB(dst, b, h) do { _Pragma("unroll") for (int n = 0; n < 2; ++n) { \
        if constexpr (F8) { dst##8[n] = cat8(*(const PG8_LAS bf16x8*)(lds + PG8_SB(b, h) + boff + n * 2048), *(const PG8_LAS bf16x8*)(lds + PG8_SB(b, h) + boff + n * 2048 + 1024)); } \
        else { _Pragma("unroll") for (int k = 0; k < 2; ++k) dst[n][k] = *(const PG8_LAS bf16x8*)(lds + PG8_SB(b, h) + boff + n * 2048 + k * 1024); } } } while (0)
#define PG8_MMA(ai, bj, At, Bt) do { __builtin_amdgcn_s_setprio(1); _Pragma("unroll") for (int m = 0; m < 4; ++m) _Pragma("unroll") for (int n = 0; n < 2; ++n) { \
        if constexpr (F8) { acc[ai][bj][m][n] = __builtin_amdgcn_mfma_scale_f32_16x16x128_f8f6f4(Bt##8[n], At##8[m], acc[ai][bj][m][n], 0, 0, 0, 0, 0, 0); } \
        else { _Pragma("unroll") for (int k = 0; k < 2; ++k) acc[ai][bj][m][n] = __builtin_amdgcn_mfma_f32_16x16x32_bf16(Bt[n][k], At[m][k], acc[ai][bj][m][n], 0, 0, 0); } } \
        __builtin_amdgcn_s_setprio(0); } while (0)
#define PG8_WAIT_V(n) asm volatile("s_waitcnt vmcnt(" #n ")" ::: "memory")
#define PG8_WAIT_L(n) asm volatile("s_waitcnt lgkmcnt(" #n ")" ::: "memory")
#define PG8_BAR __builtin_amdgcn_s_barrier()
#define PG8_SCHED __builtin_amdgcn_sched_barrier(0)
    Unit cur, nxt; int ui = 0;
    if (!S.next(0, cur)) return;
    f32x4 acc[2][2][4][2];
#pragma unroll
    for (int a = 0; a < 2; ++a)
#pragma unroll
        for (int b = 0; b < 2; ++b)
#pragma unroll
            for (int m = 0; m < 4; ++m)
#pragma unroll
                for (int n = 0; n < 2; ++n) acc[a][b][m][n] = (f32x4){0.f, 0.f, 0.f, 0.f};
    bf16x8 At[4][2], B0[2][2], B1[2][2]; v8i_t At8[4], B08[2], B18[2];
    const char* cA = (const char*)g.A + (size_t)cur.pm * tstep; const char* cB = (const char*)g.Bt + (size_t)cur.pn * tstep;
    S.a_ready(cur);
    if constexpr (SP2) {
        PG8_STAGE(PG8_SB(0, 0), cB, voffB); PG8_STAGE(PG8_SB(0, 1), cB + hstep, voffB); PG8_STAGE(PG8_SA(0, 0), cA, voffA); PG8_STAGE(PG8_SA(0, 1), cA + hstep, voffA);
        if (wr == 1) PG8_BAR;
        PG8_WAIT_V(2); PG8_BAR;
        PG8_STAGE(PG8_SB(1, 0), cB + kstep, voffB); PG8_STAGE(PG8_SA(1, 0), cA + kstep, voffA); PG8_STAGE(PG8_SB(1, 1), cB + hstep + kstep, voffB);
        PG8_WAIT_V(6); PG8_BAR;
    } else {
        PG8_STAGE(PG8_SB(0, 0), cB, voffB); PG8_STAGE(PG8_SA(0, 0), cA, voffA); PG8_STAGE(PG8_SB(0, 1), cB + hstep, voffB); PG8_STAGE(PG8_SA(0, 1), cA + hstep, voffA);
        if (wr == 1) PG8_BAR;
        PG8_WAIT_V(4); PG8_BAR;
        PG8_STAGE(PG8_SB(1, 0), cB + kstep, voffB); PG8_STAGE(PG8_SA(1, 0), cA + kstep, voffA); PG8_STAGE(PG8_SB(1, 1), cB + hstep + kstep, voffB);
        PG8_WAIT_V(6); PG8_BAR;
    }
    for (;;) {
        const bool has_next = S.next(ui + 1, nxt);
        const char* nA = has_next ? (const char*)g.A + (size_t)nxt.pm * tstep : cA; const char* nB = has_next ? (const char*)g.Bt + (size_t)nxt.pn * tstep : cB;
#pragma clang loop unroll(disable)
        for (int t = 0; t < nt; t += 2) {
            const bool last = (t == nt - 2);
            const char* a1 = cA + (size_t)(t + 1) * kstep;
            const char* a2 = last ? nA : cA + (size_t)(t + 2) * kstep; const char* b2 = last ? nB : cB + (size_t)(t + 2) * kstep;
            const char* a3 = a2 + kstep; const char* b3 = b2 + kstep;
            if (last && has_next) S.a_ready(nxt);
            if constexpr (SP2) {
            PG8_LDB(B0, 0, 0); PG8_LDB(B1, 0, 1); PG8_SCHED; PG8_LDA(At, 0, 0); PG8_STAGE(PG8_SA(1, 1), a1 + hstep, voffA);
            PG8_WAIT_V(8); PG8_WAIT_L(0); PG8_BAR; PG8_MMA(0, 0, At, B0); PG8_MMA(0, 1, At, B1); PG8_BAR; PG8_SCHED;
            PG8_LDA(At, 0, 1); PG8_STAGE(PG8_SB(0, 0), b2, voffB); PG8_STAGE(PG8_SB(0, 1), b2 + hstep, voffB); PG8_STAGE(PG8_SA(0, 0), a2, voffA);
            PG8_WAIT_V(8); PG8_WAIT_L(0); PG8_BAR; PG8_MMA(1, 0, At, B0); PG8_MMA(1, 1, At, B1); PG8_BAR; PG8_SCHED;
            PG8_LDB(B0, 1, 0); PG8_LDB(B1, 1, 1); PG8_SCHED; PG8_LDA(At, 1, 0); PG8_STAGE(PG8_SA(0, 1), a2 + hstep, voffA);
            PG8_WAIT_V(8); PG8_WAIT_L(0); PG8_BAR; PG8_MMA(0, 0, At, B0); PG8_MMA(0, 1, At, B1); PG8_BAR; PG8_SCHED;
            PG8_LDA(At, 1, 1); PG8_STAGE(PG8_SB(1, 0), b3, voffB); PG8_STAGE(PG8_SB(1, 1), b3 + hstep, voffB); PG8_STAGE(PG8_SA(1, 0), a3, voffA);
            PG8_WAIT_V(8); PG8_WAIT_L(0); PG8_BAR; PG8_MMA(1, 0, At, B0); PG8_MMA(1, 1, At, B1); PG8_BAR; PG8_SCHED;
            } else {
            PG8_LDB(B0, 0, 0); PG8_SCHED; PG8_LDA(At, 0, 0); PG8_STAGE(PG8_SA(1, 1), a1 + hstep, voffA);
            PG8_WAIT_L(8); PG8_BAR; PG8_WAIT_L(0); PG8_MMA(0, 0, At, B0); PG8_BAR; PG8_SCHED;
            PG8_LDB(B1, 0, 1); PG8_STAGE(PG8_SB(0, 0), b2, voffB);
            PG8_BAR; PG8_WAIT_L(0); PG8_MMA(0, 1, At, B1); PG8_BAR;
            PG8_LDA(At, 0, 1); PG8_STAGE(PG8_SA(0, 0), a2, voffA);
            PG8_BAR; PG8_WAIT_L(0); PG8_MMA(1, 0, At, B0); PG8_BAR; PG8_SCHED;
            PG8_STAGE(PG8_SB(0, 1), b2 + hstep, voffB);
            PG8_WAIT_V(6); PG8_BAR; PG8_MMA(1, 1, At, B1); PG8_BAR;
            PG8_LDB(B0, 1, 0); PG8_SCHED; PG8_LDA(At, 1, 0); PG8_STAGE(PG8_SA(0, 1), a2 + hstep, voffA);
            PG8_WAIT_L(8); PG8_BAR; PG8_WAIT_L(0); PG8_MMA(0, 0, At, B0); PG8_BAR; PG8_SCHED;
            PG8_LDB(B1, 1, 1); PG8_STAGE(PG8_SB(1, 0), b3, voffB);
            PG8_BAR; PG8_WAIT_L(0); PG8_MMA(0, 1, At, B1); PG8_BAR;
            PG8_LDA(At, 1, 1); PG8_STAGE(PG8_SA(1, 0), a3, voffA);
            PG8_BAR; PG8_WAIT_L(0); PG8_MMA(1, 0, At, B0); PG8_BAR; PG8_SCHED;
            PG8_STAGE(PG8_SB(1, 1), b3 + hstep, voffB);
            PG8_WAIT_V(6); PG8_BAR; PG8_MMA(1, 1, At, B1); PG8_BAR;
            }
        }
        if constexpr (ALIGN_EPI) { if (wr == 0) PG8_BAR; }
        if constexpr (!Epi::AFTER_DRAIN) { const int l2 = lane_now(); E(acc, cur, wr, wc, l2 & 15, l2 >> 4); S.done(cur); }
        if (!has_next) break;
#pragma unroll
        for (int a = 0; a < 2; ++a)
#pragma unroll
            for (int b = 0; b < 2; ++b)
#pragma unroll
                for (int m = 0; m < 4; ++m)
#pragma unroll
                    for (int n = 0; n < 2; ++n) acc[a][b][m][n] = (f32x4){0.f, 0.f, 0.f, 0.f};
        cur = nxt; cA = nA; cB = nB; ++ui;
        if constexpr (ALIGN_EPI) { if (wr == 1) PG8_BAR; }
    }
    PG8_WAIT_V(0);
    if constexpr (!ALIGN_EPI) { if (wr == 0) PG8_BAR; }
    PG8_BAR;
    if constexpr (Epi::AFTER_DRAIN) { E.fused(acc, cur, wr, wc, fr, fq, lds, wid, lane); S.done(cur); }
#undef PG8_SA
#undef PG8_SB
#undef PG8_STAGE
#undef PG8_LDA
#undef PG8_LDB
#undef PG8_MMA
#undef PG8_WAIT_V
#undef PG8_WAIT_L
#undef PG8_BAR
#undef PG8_SCHED
}
template <class Epi, class Sched, bool F8 = false>
__device__ __forceinline__ void gemm_phase_gather(PG8_LAS unsigned char* lds, const Gemm g, const Sched& S, const Epi& E, const PG8_LAS int* rowtab, const int wid) {
    constexpr bool ALIGN_EPI = true, SP2 = true;
    const int lane = lane_now(), tid = wid * 64 + lane, wr = wid >> 2, wc = wid & 3, fr = lane & 15, fq = lane >> 4;
    const int K = g.K, nt = K / BK;
    unsigned voffB[2], vAc[2][2];
#pragma unroll
    for (int i = 0; i < 2; ++i) { int R, C; stage_rc(tid * 16 + i * 8192, R, C); const int Rb = Epi::PERM ? ((R & ~31) + perm32(R & 31)) : R;
        voffB[i] = (unsigned)(Rb * K + C) * 2u; }
#define PG8_ROWS(dst, ui_) do { const int t_ = wid * 64 + lane_now(); _Pragma("unroll") for (int i_ = 0; i_ < 2; ++i_) { int R_, C_; stage_rc(t_ * 16 + i_ * 8192, R_, C_); \
        _Pragma("unroll") for (int h_ = 0; h_ < 2; ++h_) dst[h_][i_] = (unsigned)rowtab[(ui_) * 256 + h_ * HALF + R_] * (unsigned)(K * 2) + (unsigned)(C_ * 2); } } while (0)
#define PG8_STAGE_A(bufoff, v, kb) do { _Pragma("unroll") for (int _i = 0; _i < 2; ++_i) { \
        if constexpr (F8) glds_sv((const char*)g.A + (kb), (v)[_i], ldsbase + (unsigned)((bufoff) + _i * 8192)); \
        else __builtin_amdgcn_global_load_lds((const unsigned*)((const char*)g.A + (v)[_i] + (kb)), (PG8_LAS unsigned*)(lds + (bufoff) + ldsw + _i * 8192), 16, 0, 0); } } while (0)
    const size_t kstep = (size_t)(BK * 2);
    const size_t hstep = (size_t)HALF * K * 2;
    const size_t tstep = 2 * hstep;
    const unsigned ldsw = (unsigned)wid * 1024u;
    const unsigned ldsbase = (unsigned)__builtin_amdgcn_readfirstlane((int)((unsigned)(uintptr_t)lds + ldsw));
    const int aoff = lds_byte(wr * 64 + fr, fq * 8), boff = lds_byte(wc * 32 + fr, fq * 8);
#define PG8_SA(b, h) (((b) * 2 + (h)) * HTB)
#define PG8_SB(b, h) ((4 + (b) * 2 + (h)) * HTB)
#define PG8_STAGE(bufoff, gbase, voff) do { _Pragma("unroll") for (int _i = 0; _i < 2; ++_i) { \
        if constexpr (F8) glds_sv((const char*)(gbase), (voff)[_i], ldsbase + (unsigned)((bufoff) + _i * 8192)); \
        else __builtin_amdgcn_global_load_lds((const unsigned*)((const char*)(gbase) + (voff)[_i]), (PG8_LAS unsigned*)(lds + (bufoff) + ldsw + _i * 8192), 16, 0, 0); } } while (0)
#define PG8_LDA(dst, b, h) do { _Pragma("unroll") for (int m = 0; m < 4; ++m) { \
        if constexpr (F8) { dst##8[m] = cat8(*(const PG8_LAS bf16x8*)(lds + PG8_SA(b, h) + aoff + m * 2048), *(const PG8_LAS bf16x8*)(lds + PG8_SA(b, h) + aoff + m * 2048 + 1024)); } \
        else { _Pragma("unroll") for (int k = 0; k < 2; ++k) dst[m][k] = *(const PG8_LAS bf16x8*)(lds + PG8_SA(b, h) + aoff + m * 2048 + k * 1024); } } } while (0)
#define PG8_LDB(dst, b, h) do { _Pragma("unroll") for (int n = 0; n < 2; ++n) { \
        if constexpr (F8) { dst##8[n] = cat8(*(const PG8_LAS bf16x8*)(lds + PG8_SB(b, h) + boff + n * 2048), *(const PG8_LAS bf16x8*)(lds + PG8_SB(b, h) + boff + n * 2048 + 1024)); } \
        else { _Pragma("unroll") for (int k = 0; k < 2; ++k) dst[n][k] = *(const PG8_LAS bf16x8*)(lds + PG8_SB(b, h) + boff + n * 2048 + k * 1024); } } } while (0)
#define PG8_MMA(ai, bj, At, Bt) do { __builtin_amdgcn_s_setprio(1); _Pragma("unroll") for (int m = 0; m < 4; ++m) _Pragma("unroll") for (int n = 0; n < 2; ++n) { \
        if constexpr (F8) { acc[ai][bj][m][n] = __builtin_amdgcn_mfma_scale_f32_16x16x128_f8f6f4(Bt##8[n], At##8[m], acc[ai][bj][m][n], 0, 0, 0, 0, 0, 0); } \
        else { _Pragma("unroll") for (int k = 0; k < 2; ++k) acc[ai][bj][m][n] = __builtin_amdgcn_mfma_f32_16x16x32_bf16(Bt[n][k], At[m][k], acc[ai][bj][m][n], 0, 0, 0); } } \
        __builtin_amdgcn_s_setprio(0); } while (0)
#define PG8_WAIT_V(n) asm volatile("s_waitcnt vmcnt(" #n ")" ::: "memory")
#define PG8_WAIT_L(n) asm volatile("s_waitcnt lgkmcnt(" #n ")" ::: "memory")
#define PG8_BAR __builtin_amdgcn_s_barrier()
#define PG8_SCHED __builtin_amdgcn_sched_barrier(0)
    Unit cur, nxt; int ui = 0;
    if (!S.next(0, cur)) return;
    f32x4 acc[2][2][4][2];
#pragma unroll
    for (int a = 0; a < 2; ++a)
#pragma unroll
        for (int b = 0; b < 2; ++b)
#pragma unroll
            for (int m = 0; m < 4; ++m)
#pragma unroll
                for (int n = 0; n < 2; ++n) acc[a][b][m][n] = (f32x4){0.f, 0.f, 0.f, 0.f};
    bf16x8 At[4][2], B0[2][2], B1[2][2]; v8i_t At8[4], B08[2], B18[2];
    const char* cB = (const char*)g.Bt + (size_t)cur.pn * tstep;
    PG8_ROWS(vAc, 0);
    S.a_ready(cur);
    if constexpr (SP2) {
        PG8_STAGE(PG8_SB(0, 0), cB, voffB); PG8_STAGE(PG8_SB(0, 1), cB + hstep, voffB); PG8_STAGE_A(PG8_SA(0, 0), vAc[0], 0u); PG8_STAGE_A(PG8_SA(0, 1), vAc[1], 0u);
        if (wr == 1) PG8_BAR;
        PG8_WAIT_V(2); PG8_BAR;
        PG8_STAGE(PG8_SB(1, 0), cB + kstep, voffB); PG8_STAGE_A(PG8_SA(1, 0), vAc[0], (unsigned)kstep); PG8_STAGE(PG8_SB(1, 1), cB + hstep + kstep, voffB);
        PG8_WAIT_V(6); PG8_BAR;
    }
    for (;;) {
        const bool has_next = S.next(ui + 1, nxt);
        const char* nB = has_next ? (const char*)g.Bt + (size_t)nxt.pn * tstep : cB;
#pragma clang loop unroll(disable)
        for (int t = 0; t < nt; t += 2) {
            const bool last = (t == nt - 2);
            const unsigned k1 = (unsigned)((t + 1) * (int)kstep), k2 = last ? 0u : (unsigned)((t + 2) * (int)kstep), k3 = k2 + (unsigned)kstep;
            unsigned v2[2][2];
            if (last && has_next) { PG8_ROWS(v2, ui + 1); }
            else {
#pragma unroll
                for (int h_ = 0; h_ < 2; ++h_)
#pragma unroll
                    for (int i_ = 0; i_ < 2; ++i_) v2[h_][i_] = vAc[h_][i_]; }
            const char* b2 = last ? nB : cB + (size_t)(t + 2) * kstep; const char* b3 = b2 + kstep;
            if (last && has_next) S.a_ready(nxt);
            if constexpr (SP2) {
            PG8_LDB(B0, 0, 0); PG8_LDB(B1, 0, 1); PG8_SCHED; PG8_LDA(At, 0, 0); PG8_STAGE_A(PG8_SA(1, 1), vAc[1], k1);
            PG8_WAIT_V(8); PG8_WAIT_L(0); PG8_BAR; PG8_MMA(0, 0, At, B0); PG8_MMA(0, 1, At, B1); PG8_BAR; PG8_SCHED;
            PG8_LDA(At, 0, 1); PG8_STAGE(PG8_SB(0, 0), b2, voffB); PG8_STAGE(PG8_SB(0, 1), b2 + hstep, voffB); PG8_STAGE_A(PG8_SA(0, 0), v2[0], k2);
            PG8_WAIT_V(8); PG8_WAIT_L(0); PG8_BAR; PG8_MMA(1, 0, At, B0); PG8_MMA(1, 1, At, B1); PG8_BAR; PG8_SCHED;
            PG8_LDB(B0, 1, 0); PG8_LDB(B1, 1, 1); PG8_SCHED; PG8_LDA(At, 1, 0); PG8_STAGE_A(PG8_SA(0, 1), v2[1], k2);
            PG8_WAIT_V(8); PG8_WAIT_L(0); PG8_BAR; PG8_MMA(0, 0, At, B0); PG8_MMA(0, 1, At, B1); PG8_BAR; PG8_SCHED;
            PG8_LDA(At, 1, 1); PG8_STAGE(PG8_SB(1, 0), b3, voffB); PG8_STAGE(PG8_SB(1, 1), b3 + hstep, voffB); PG8_STAGE_A(PG8_SA(1, 0), v2[0], k3);
            PG8_WAIT_V(8); PG8_WAIT_L(0); PG8_BAR; PG8_MMA(1, 0, At, B0); PG8_MMA(1, 1, At, B1); PG8_BAR; PG8_SCHED;
            }
        }
        if constexpr (ALIGN_EPI) { if (wr == 0) PG8_BAR; }
        { const int l2 = lane_now(); E(acc, cur, wr, wc, l2 & 15, l2 >> 4, rowtab + ui * 256); } S.done(cur);
        if (!has_next) break;
#pragma unroll
        for (int a = 0; a < 2; ++a)
#pragma unroll
            for (int b = 0; b < 2; ++b)
#pragma unroll
                for (int m = 0; m < 4; ++m)
#pragma unroll
                    for (int n = 0; n < 2; ++n) acc[a][b][m][n] = (f32x4){0.f, 0.f, 0.f, 0.f};
        cur = nxt; cB = nB; ++ui;
        PG8_ROWS(vAc, ui);
        if constexpr (ALIGN_EPI) { if (wr == 1) PG8_BAR; }
    }
    PG8_WAIT_V(0);
    if constexpr (!ALIGN_EPI) { if (wr == 0) PG8_BAR; }
    PG8_BAR;
#undef PG8_ROWS
#undef PG8_STAGE_A
#undef PG8_SA
#undef PG8_SB
#undef PG8_STAGE
#undef PG8_LDA
#undef PG8_LDB
#undef PG8_MMA
#undef PG8_WAIT_V
#undef PG8_WAIT_L
#undef PG8_BAR
#undef PG8_SCHED
}
}
#define GAS __attribute__((address_space(1)))
#define LAS __attribute__((address_space(3)))
typedef unsigned short bf16;
typedef unsigned v4u __attribute__((ext_vector_type(4)));
typedef float f32x4 __attribute__((ext_vector_type(4)));
typedef short bf16x8 __attribute__((ext_vector_type(8)));
typedef GAS unsigned gu32;
typedef GAS unsigned long long gu64;
#define RLX_AGENT __ATOMIC_RELAXED, __HIP_MEMORY_SCOPE_AGENT
#define LDS_WAIT() asm volatile("s_waitcnt lgkmcnt(0)" ::: "memory")
#define VM_WAIT() asm volatile("s_waitcnt vmcnt(0)" ::: "memory")
__device__ __forceinline__ unsigned long long rt() { return __builtin_amdgcn_s_memrealtime(); }
__device__ __forceinline__ unsigned f2bf(float f) { unsigned u = __builtin_bit_cast(unsigned, f); return (u + 0x7fffu + ((u >> 16) & 1u)) >> 16; }
__device__ __forceinline__ unsigned pk2(float lo, float hi) { return f2bf(lo) | (f2bf(hi) << 16); }
#define XB_TMO      128
#define XB_XCNT(j)  (256  + 64 * (j))
#define XB_XSUB(j)  (1280 + 64 * (j))
#define XB_XGEN(j)  (2304 + 64 * (j))
#define XB_TOP      3328
#define XB_TOPGEN   3392
#define XCD_BAR_WORDS 3456
#define XB_SPIN_CAP (1u << 18)

__device__ __forceinline__ unsigned xb_ld(unsigned* p)              { return __hip_atomic_load(p, __ATOMIC_RELAXED, __HIP_MEMORY_SCOPE_AGENT); }
__device__ __forceinline__ unsigned xb_add(unsigned* p, unsigned v) { return __hip_atomic_fetch_add(p, v, __ATOMIC_RELAXED, __HIP_MEMORY_SCOPE_AGENT); }
__device__ __forceinline__ unsigned xb_xcc_id() { return (unsigned)__builtin_amdgcn_s_getreg((3 << 11) | 20) & 0xFu; }
#define XB_SPIN(cond, bar) do { unsigned _sp = 0; while (cond) { __builtin_amdgcn_s_sleep(1); \
    if ((++_sp & 255u) == 0u) { if (xb_ld(&(bar)[XB_TMO])) break; if (_sp > XB_SPIN_CAP) { atomicAdd(&(bar)[XB_TMO], 1u); break; } } } } while (0)

struct XcdBarrier {
    unsigned* bar; unsigned x;
    volatile LAS unsigned* st;
};

__device__ __forceinline__ XcdBarrier xcd_barrier_post(unsigned* bar, volatile LAS unsigned* st) {
    XcdBarrier b; b.bar = bar; b.x = xb_xcc_id(); b.st = st;
    if (threadIdx.x == 0) (void)xb_add(&bar[XB_XCNT(b.x)], 1u);
    return b;
}
__device__ __forceinline__ void xcd_barrier_complete(unsigned* bar, unsigned x, unsigned& nloc, unsigned& nx) {
    const unsigned G = gridDim.x * gridDim.y * gridDim.z;
    unsigned sum, cnt, mine, sp = 0u;
    for (;;) {
        sum = 0u; cnt = 0u; mine = 0u;
#pragma unroll
        for (unsigned j = 0; j < 16; ++j) { const unsigned c = xb_ld(&bar[XB_XCNT(j)]); sum += c; cnt += (c > 0u) ? 1u : 0u; mine = (j == x) ? c : mine; }
        if (sum == G) break;
        __builtin_amdgcn_s_sleep(1);
        if ((++sp & 255u) == 0u) { if (xb_ld(&bar[XB_TMO])) break; if (sp > XB_SPIN_CAP) { atomicAdd(&bar[XB_TMO], 1u); break; } }
    }
    nloc = mine > 0u ? mine : 1u; nx = cnt > 0u ? cnt : 1u;
}

__device__ __forceinline__ void xcd_barrier(const XcdBarrier& b) {
    asm volatile("s_waitcnt vmcnt(0)" ::: "memory");
    __syncthreads();
    if (threadIdx.x == 0) {
        unsigned* bar = b.bar;
        __builtin_amdgcn_s_waitcnt(0);
        unsigned nloc = b.st[0], nx = b.st[1];
        if (nloc == 0u) { xcd_barrier_complete(bar, b.x, nloc, nx); b.st[0] = nloc; b.st[1] = nx; }
        const unsigned old = xb_add(&bar[XB_XSUB(b.x)], 1u);
        const unsigned gen = old / nloc;
        if (old + 1u == (gen + 1u) * nloc) {
            __builtin_amdgcn_fence(__ATOMIC_RELEASE, "agent");
            asm volatile("s_waitcnt vmcnt(0)" ::: "memory");
            const unsigned og = xb_add(&bar[XB_TOP], 1u);
            const unsigned tg = og / nx;
            if (og + 1u == (tg + 1u) * nx) xb_add(&bar[XB_TOPGEN], 1u);
            else XB_SPIN(xb_ld(&bar[XB_TOPGEN]) == tg, bar);
            __builtin_amdgcn_fence(__ATOMIC_ACQUIRE, "agent");
            xb_add(&bar[XB_XGEN(b.x)], 1u);
            asm volatile("s_waitcnt vmcnt(0)" ::: "memory");
        } else {
            XB_SPIN(xb_ld(&bar[XB_XGEN(b.x)]) == gen, bar);
            __builtin_amdgcn_fence(__ATOMIC_ACQUIRE, "agent");
            asm volatile("s_waitcnt vmcnt(0)" ::: "memory");
        }
    }
    __syncthreads();
}
namespace fattn {
typedef unsigned short bf16;
typedef short bf16x8 __attribute__((ext_vector_type(8)));
typedef short s16x4 __attribute__((ext_vector_type(4)));
typedef float f32x16 __attribute__((ext_vector_type(16)));
typedef float f32x4 __attribute__((ext_vector_type(4)));
typedef unsigned u32x4 __attribute__((ext_vector_type(4)));
constexpr int D = 128, LD = 128, LDO = 1024, SEQ = 4096;
constexpr float THR = 8.f;
constexpr float SCALE = 0.08838834764831845f;
constexpr int NW = 8, QBLK = 32, KVBLK = 64, QB = NW * QBLK;
constexpr int SHM_V = KVBLK * D * 2, SHM_K = KVBLK * D * 2;
constexpr int OFF_WS = 2 * SHM_V + 2 * SHM_K, OFF_BIAS = OFF_WS + NW * 64 * 4, LDS_BYTES = OFF_BIAS + 2 * 64 * 4;

#define KSWZ(row, colB) ((row) * 256 + ((colB) ^ (((row) & 7) << 4)))
#define SBAR() __builtin_amdgcn_sched_barrier(0)
__device__ __forceinline__ int v_st(int k, int c) { const int kk = (k & ~0xC) | ((k & 4) << 1) | ((k & 8) >> 1); return ((kk >> 3) * 4 + (c >> 5)) * 512 + ((kk & 7) * 32 + (c & 31)) * 2; }
__device__ __forceinline__ int v_rd_base(int lane) { return ((lane & 3) << 3) | (((lane >> 2) & 3) << 6) | (((lane >> 4) & 1) << 5) | (((lane >> 5) & 1) << 8); }
constexpr int v_rd_off(int d0, int ks, int half) { return d0 * 512 + ks * 4096 + half * 2048; }
__device__ __forceinline__ int crow(int r, int hi) { return (r & 3) + 8 * (r >> 2) + 4 * hi; }
__device__ __forceinline__ unsigned cvtpk(float lo, float hi) { unsigned r; asm volatile("v_cvt_pk_bf16_f32 %0, %1, %2" : "=v"(r) : "v"(lo), "v"(hi)); return r; }
__device__ __forceinline__ bf16x8 load8(const bf16* p) { return *reinterpret_cast<const bf16x8*>(p); }
__device__ __forceinline__ void mask_tile(f32x16& p0, f32x16& p1, int dq) {
    const float NEG = -__builtin_inff();
#pragma unroll
    for (int r = 0; r < 16; ++r) {
        const int c = (r & 3) + 8 * (r >> 2);
        if (dq - c < 0) p0[r] = NEG;
        if (dq - c - 32 < 0) p1[r] = NEG;
    }
}
__device__ __forceinline__ void partialSM(f32x16& p0, f32x16& p1, float& m_reg, float& mn, float& alpha) {
    float pmax = p0[0]; for (int r = 1; r < 16; ++r) pmax = fmaxf(pmax, p0[r]); for (int r = 0; r < 16; ++r) pmax = fmaxf(pmax, p1[r]);
    { auto rr = __builtin_amdgcn_permlane32_swap(__float_as_uint(pmax), __float_as_uint(pmax), false, false);
      pmax = fmaxf(__uint_as_float(rr[0]), __uint_as_float(rr[1])); }
    constexpr float C2 = 1.4426950408889634f * SCALE;
    if (__builtin_expect(__all((pmax - m_reg) * SCALE <= THR), 1)) { mn = m_reg; alpha = 1.f; }
    else { mn = fmaxf(m_reg, pmax); alpha = __builtin_amdgcn_exp2f((m_reg - mn) * C2); m_reg = mn; }
    const float mnL = -mn * C2;
    for (int r = 0; r < 16; ++r) p0[r] = fmaf(p0[r], C2, mnL); for (int r = 0; r < 16; ++r) p1[r] = fmaf(p1[r], C2, mnL);
    for (int r = 0; r < 16; ++r) p0[r] = __builtin_amdgcn_exp2f(p0[r]);
}
__device__ __forceinline__ void finishSM(f32x16& p0, f32x16& p1, float alpha, float& l_reg, bf16x8& pa0, bf16x8& pa1, bf16x8& pa2, bf16x8& pa3) {
    for (int r = 0; r < 16; ++r) p1[r] = __builtin_amdgcn_exp2f(p1[r]);
    float ps = 0; for (int r = 0; r < 16; ++r) ps += p0[r]; for (int r = 0; r < 16; ++r) ps += p1[r];
    { auto rr = __builtin_amdgcn_permlane32_swap(__float_as_uint(ps), __float_as_uint(ps), false, false);
      ps = __uint_as_float(rr[0]) + __uint_as_float(rr[1]); }
    l_reg = l_reg * alpha + ps;
#define PK4(P, B_, OUT) do { unsigned a0 = cvtpk(P[B_+0], P[B_+1]), a1 = cvtpk(P[B_+2], P[B_+3]);                          \
        unsigned b0 = cvtpk(P[B_+4], P[B_+5]), b1 = cvtpk(P[B_+6], P[B_+7]);                                             \
        auto r0 = __builtin_amdgcn_permlane32_swap(a0, b0, false, false); auto r1 = __builtin_amdgcn_permlane32_swap(a1, b1, false, false); \
        u32x4 w = {r0[0], r1[0], r0[1], r1[1]}; OUT = *reinterpret_cast<bf16x8*>(&w); } while (0)
    PK4(p0, 0, pa0); PK4(p0, 8, pa1); PK4(p1, 0, pa2); PK4(p1, 8, pa3);
#undef PK4
}
template <int KB>
__device__ __forceinline__ void qkt(f32x16& p0, f32x16& p1, const char* K_lds, const char* Bias_lds, int r32, int hi, const bf16x8* qr) {
    { const f32x4* bb = reinterpret_cast<const f32x4*>(Bias_lds + KB * 256 + hi * 16);
      const f32x4 a0 = bb[0], a1 = bb[2], a2 = bb[4], a3 = bb[6], c0 = bb[8], c1 = bb[10], c2 = bb[12], c3 = bb[14];
      p0 = (f32x16){a0[0], a0[1], a0[2], a0[3], a1[0], a1[1], a1[2], a1[3], a2[0], a2[1], a2[2], a2[3], a3[0], a3[1], a3[2], a3[3]};
      p1 = (f32x16){c0[0], c0[1], c0[2], c0[3], c1[0], c1[1], c1[2], c1[3], c2[0], c2[1], c2[2], c2[3], c3[0], c3[1], c3[2], c3[3]}; }
    const char* kb[4];
#pragma unroll
    for (int dd = 0; dd < 4; ++dd) kb[dd] = K_lds + KB * SHM_K + KSWZ(r32, (dd * 16 + hi * 8) * 2);
#pragma unroll
    for (int d0 = 0; d0 < 8; ++d0) { const char* a = kb[d0 & 3] + (d0 >> 2) * 128;
        bf16x8 b0 = *reinterpret_cast<const bf16x8*>(a);
        bf16x8 b1 = *reinterpret_cast<const bf16x8*>(a + 32 * 256);
        p0 = __builtin_amdgcn_mfma_f32_32x32x16_bf16(b0, qr[d0], p0, 0, 0, 0);
        p1 = __builtin_amdgcn_mfma_f32_32x32x16_bf16(b1, qr[d0], p1, 0, 0, 0); }
}
template <int VB>
__device__ __forceinline__ void pv_tile(f32x16* o, int vb0, bf16x8 pa0, bf16x8 pa1, bf16x8 pa2, bf16x8 pa3) {
#define TRRD(dst, off) asm volatile("ds_read_b64_tr_b16 %0, %1 offset:%2" : "=&v"(dst) : "v"(vb0), "i"(off) : "memory")
#define PV_D0(d0) do { s16x4 l0, l1, l2, l3, h0, h1, h2, h3; constexpr int b_ = VB * SHM_V + v_rd_off(d0, 0, 0);   \
        TRRD(l0, b_); TRRD(h0, b_ + 2048); TRRD(l1, b_ + 4096); TRRD(h1, b_ + 6144); TRRD(l2, b_ + 8192); TRRD(h2, b_ + 10240); TRRD(l3, b_ + 12288); TRRD(h3, b_ + 14336); \
        asm volatile("s_waitcnt lgkmcnt(0)" ::: "memory"); SBAR();                                                    \
        o[d0] = __builtin_amdgcn_mfma_f32_32x32x16_bf16(pa0, (bf16x8){l0[0], l0[1], l0[2], l0[3], h0[0], h0[1], h0[2], h0[3]}, o[d0], 0, 0, 0);   \
        o[d0] = __builtin_amdgcn_mfma_f32_32x32x16_bf16(pa1, (bf16x8){l1[0], l1[1], l1[2], l1[3], h1[0], h1[1], h1[2], h1[3]}, o[d0], 0, 0, 0);   \
        o[d0] = __builtin_amdgcn_mfma_f32_32x32x16_bf16(pa2, (bf16x8){l2[0], l2[1], l2[2], l2[3], h2[0], h2[1], h2[2], h2[3]}, o[d0], 0, 0, 0);   \
        o[d0] = __builtin_amdgcn_mfma_f32_32x32x16_bf16(pa3, (bf16x8){l3[0], l3[1], l3[2], l3[3], h3[0], h3[1], h3[2], h3[3]}, o[d0], 0, 0, 0); } while (0)
    PV_D0(0); PV_D0(1); PV_D0(2); PV_D0(3);
#undef PV_D0
#undef TRRD
}

struct Bases { const bf16* Q; bf16* O; const bf16* K; const bf16* V; const float* CB; };
struct BlockRef { unsigned qo, oo, kvo, cbo; int P0, jlo; };
struct Seam { bf16x8 qr[8]; bf16x8 st_v0, st_v1, st_k0, st_k1; float st_b; };
#define ROW(p, k0, rr) ((p) + (unsigned)(((k0) + (rr)) * LD + sc))
#define VMW() asm volatile("s_waitcnt vmcnt(0)" ::: "memory")
#define VMWN(n) asm volatile("s_waitcnt vmcnt(%0)" :: "i"(n) : "memory")
#define SLOAD_H(Kp, Vp, CBp, k0) do { S.st_v0 = load8(ROW(Vp, k0, sr)); S.st_v1 = load8(ROW(Vp, k0, 32 + sr));              \
                         S.st_k0 = load8(ROW(Kp, k0, sr)); S.st_k1 = load8(ROW(Kp, k0, 32 + sr)); S.st_b = (CBp)[(unsigned)((k0) + lane)]; } while (0)
#define SWRITE_HK(bf, cref_) do { *(bf16x8*)(K_lds + (bf) * SHM_K + kws) = S.st_k0; *(bf16x8*)(K_lds + (bf) * SHM_K + kws + 32 * 256) = S.st_k1; \
                           if (wid == 0) *(float*)(B_lds + (bf) * 256 + lane * 4) = S.st_b; } while (0)
#define SWRITE_HV(bf) do { *(bf16x8*)(V_lds + (bf) * SHM_V + vst0) = S.st_v0; *(bf16x8*)(V_lds + (bf) * SHM_V + vst1) = S.st_v1; } while (0)
#define SWRITE_H(bf) do { SWRITE_HV(bf); SWRITE_HK(bf, cref); } while (0)
__device__ __forceinline__ void prime(const Bases& G, const BlockRef& cur, char* lds, Seam& S) {
    const int tid = threadIdx.x, wid = __builtin_amdgcn_readfirstlane(tid >> 6), lane = tid & 63, r32 = lane & 31, hi = lane >> 5;
    const int sr = tid >> 4, sc = (tid & 15) * 8, kws = KSWZ(sr, sc * 2); char* K_lds = lds + 2 * SHM_V; char* B_lds = lds + OFF_BIAS;
    for (int d0 = 0; d0 < 8; ++d0) S.qr[d0] = load8(G.Q + (cur.qo + (unsigned)((wid * QBLK + r32) * LD + d0 * 16 + hi * 8)));
    const float cref = 0.f; (void)cref;
    SLOAD_H(G.K + cur.kvo, G.V + cur.kvo, G.CB + cur.cbo, cur.jlo * KVBLK); VMW(); SWRITE_HK(0, cref);
    __syncthreads();
}
__device__ __forceinline__ void block(const Bases& G, const BlockRef& cur, const BlockRef& nxt, char* lds, Seam& S) {
    const int tid = threadIdx.x, wid = __builtin_amdgcn_readfirstlane(tid >> 6), lane = tid & 63, r32 = lane & 31, hi = lane >> 5;
    const int j_lo = cur.jlo, NT = (cur.P0 + QB - 1) / KVBLK + 1 - j_lo;
    const int qlo = cur.P0 + wid * QBLK, qm = qlo + r32 - 4 * hi;
    char* V_lds = lds; char* K_lds = lds + 2 * SHM_V; char* B_lds = lds + OFF_BIAS;
    float* ws = (float*)(lds + OFF_WS) + wid * 64; float* li_l = ws, * al_l = ws + 32;
    float m_reg = G.CB[cur.cbo + (unsigned)(cur.P0 + wid * QBLK + r32)], l_reg = 0; f32x16 o[4] = {};
    const int sr = tid >> 4, sc = (tid & 15) * 8, vst0 = v_st(sr, sc), vst1 = v_st(32 + sr, sc), kws = KSWZ(sr, sc * 2);
    const int vb0 = (int)(uintptr_t)V_lds + v_rd_base(lane);
    const bf16* Kh = G.K + cur.kvo; const bf16* Vh = G.V + cur.kvo; const float* CBh = G.CB + cur.cbo;
    const float cref = 0.f, crefn = 0.f; (void)cref; (void)crefn;
#define RESC(a) do { if (__any((a) < 1.f)) { if (hi == 0) al_l[r32] = (a); asm volatile("s_waitcnt lgkmcnt(0)" ::: "memory");              \
                     for (int d_ = 0; d_ < 4; ++d_) for (int r = 0; r < 16; ++r) o[d_][r] *= al_l[crow(r, hi)]; } } while (0)
#define KBASE(t) ((j_lo + (t)) * KVBLK)
#define MASKT(P0_, P1_, t) do { const int kb_ = KBASE(t); if (kb_ + KVBLK - 1 > qlo) mask_tile(P0_, P1_, qm - kb_); } while (0)
    constexpr int NQL = 8;
#define SEAM_K0() do { VMWN(NQL); SWRITE_HK(0, crefn); SBAR(); } while (0)
    f32x16 pA0, pA1, pB0, pB1; float mnA, mnB, alA, alB; bf16x8 pa0, pa1, pa2, pa3;
    SWRITE_HV(0); SBAR();
    if (NT > 1) { SLOAD_H(Kh, Vh, CBh, KBASE(1)); }
    SBAR(); qkt<0>(pA0, pA1, K_lds, B_lds, r32, hi, S.qr);
    MASKT(pA0, pA1, 0); partialSM(pA0, pA1, m_reg, mnA, alA);
    if (NT > 1) { VMW(); SWRITE_H(1); }
    __syncthreads();
#define HALF_STEP(PX0, PX1, mnX, alX, PY0, PY1, alY, t, KB, VB, SB) do {                                                      \
        SBAR(); qkt<KB>(PX0, PX1, K_lds, B_lds, r32, hi, S.qr);                                                                \
        finishSM(PY0, PY1, alY, l_reg, pa0, pa1, pa2, pa3); SBAR();                                                           \
        if ((t) + 1 < NT) { SLOAD_H(Kh, Vh, CBh, KBASE((t) + 1)); SBAR(); }                                              \
        pv_tile<VB>(o, vb0, pa0, pa1, pa2, pa3); MASKT(PX0, PX1, (t)); partialSM(PX0, PX1, m_reg, mnX, alX);                   \
        __syncthreads();                                                                                                      \
        if ((t) + 1 < NT) { VMW(); SWRITE_H(SB); }                                                                            \
        RESC(alX); __syncthreads(); } while (0)
    for (int t = 1; t + 1 < NT; t += 2) {
        HALF_STEP(pB0, pB1, mnB, alB, pA0, pA1, alA, t, 1, 0, 0);
        HALF_STEP(pA0, pA1, mnA, alA, pB0, pB1, alB, t + 1, 0, 1, 1);
    }
    constexpr bool even = true;
    if (even) { SBAR(); qkt<1>(pB0, pB1, K_lds, B_lds, r32, hi, S.qr); SBAR(); }
    { SLOAD_H(G.K + nxt.kvo, G.V + nxt.kvo, G.CB + nxt.cbo, nxt.jlo * KVBLK); SBAR();
#pragma unroll
      for (int d0 = 0; d0 < 8; ++d0) S.qr[d0] = load8(G.Q + (nxt.qo + (unsigned)((wid * QBLK + r32) * LD + d0 * 16 + hi * 8))); }
    SBAR();
    finishSM(pA0, pA1, alA, l_reg, pa0, pa1, pa2, pa3); SBAR();
    pv_tile<0>(o, vb0, pa0, pa1, pa2, pa3);
    if (even) { MASKT(pB0, pB1, NT - 1); partialSM(pB0, pB1, m_reg, mnB, alB); __syncthreads(); RESC(alB);
        finishSM(pB0, pB1, alB, l_reg, pa0, pa1, pa2, pa3); SBAR(); pv_tile<1>(o, vb0, pa0, pa1, pa2, pa3); }
    SBAR(); SEAM_K0();
    if (hi == 0) li_l[r32] = l_reg; asm volatile("s_waitcnt lgkmcnt(0)" ::: "memory");
    float rli[16];
#pragma unroll
    for (int r = 0; r < 16; ++r) rli[r] = __builtin_amdgcn_rcpf(li_l[crow(r, hi)]);
    bf16* Ow = G.O + (cur.oo + (unsigned)(wid * QBLK * LDO));
#pragma unroll
    for (int r = 0; r < 16; ++r) { const int orow = crow(r, hi);
#pragma unroll
        for (int d0 = 0; d0 < 4; ++d0) { const float v = o[d0][r] * rli[r];
            const float vn = __shfl_xor(v, 1);
            if ((r32 & 1) == 0) *(unsigned*)(Ow + (unsigned)(orow * LDO + d0 * 32 + r32)) = cvtpk(v, vn); } }
    __syncthreads();
#undef RESC
#undef KBASE
#undef MASKT
#undef SEAM_K0
#undef HALF_STEP
}
#undef ROW
#undef VMW
#undef VMWN
#undef SLOAD_H
#undef SWRITE_HK
#undef SWRITE_HV
#undef SWRITE_H
#undef KSWZ
#undef SBAR
}
constexpr int NB = 8, SEQ = 4096, T = NB * SEQ, DM = 1024, NH = 8, HD = 128, INW = 7176, NZ = 7168;
constexpr int NE = 32, DE = 512;
constexpr float EPS = 1e-6f;
constexpr int PMAX = 73728;
constexpr int NWAVES = 8;
constexpr size_t MiB = 1u << 20;
constexpr size_t WS_CTL = 0, CTL_ZERO_BYTES = 64 * 1024;
constexpr size_t WS_RS1 = 1 * MiB, WS_RS2 = 1 * MiB + 256 * 1024;
constexpr size_t WS_LF = 1 * MiB + 512 * 1024;
constexpr size_t WS_CB = 2 * MiB + 512 * 1024;
constexpr size_t WS_TOK = 3 * MiB + 512 * 1024;
constexpr size_t WS_LISTS = 5 * MiB;
constexpr size_t WS_WRT = 9 * MiB;
constexpr size_t WS_SRS = 9 * MiB + 512 * 1024, WS_SW = 10 * MiB;
constexpr size_t WS_WIN = 16 * MiB;
constexpr size_t WS_WA = 30 * MiB, WS_WL = 32 * MiB, WS_WO = 34 * MiB;
constexpr size_t WS_WRG = 36 * MiB;
constexpr size_t WS_XB = 40 * MiB;
constexpr size_t WS_XR = 104 * MiB;
constexpr size_t WS_GG = 168 * MiB;
constexpr size_t WS_Q = 232 * MiB, WS_K = 296 * MiB, WS_V = 360 * MiB;
constexpr size_t WS_W13 = 424 * MiB;
constexpr size_t WS_W2 = 392 * MiB;
constexpr size_t WS_XG = 168 * MiB;
constexpr size_t WS_HB = 296 * MiB;
constexpr size_t WS_END = 512 * MiB;
static_assert(WS_XG + (size_t)PMAX * 1024 <= WS_K && WS_HB + (size_t)PMAX * 1024 <= WS_W2 && WS_W2 + 32u * 1024 * 512 * 2 <= WS_W13 && WS_W13 + 64 * MiB <= WS_END, "d_ws map");
constexpr int CW_TMO = 0, CW_CODE = 1, CW_BAR = 4096, CW_CNT = 8192, CW_NORM = 8448, CW_QCTR = 12288;
constexpr int RING_OFF = 0, RING_BYTES = 131072;
constexpr int LDSCTL_OFF = RING_BYTES, MISC_OFF = LDSCTL_OFF + 320;
constexpr int TBL_OFF = RING_BYTES + 1024;
constexpr int TBL_PS = TBL_OFF, TBL_CN = TBL_OFF + 256, TBL_TE = TBL_OFF + 512;
constexpr int RG_TOT = RING_BYTES + 4096, RG_CAR = RG_TOT + 4096;
constexpr int LDS_BYTES = 147456;

#include <cmath>
using pg8::bf_lo; using pg8::bf_hi; using pg8::sigmoid_f;

struct Frame {
    LAS unsigned char* lds;
    int tid, lane, wave, vcu, G;
};
__device__ __forceinline__ float wave_sum(float v) {
#pragma unroll
    for (int o = 1; o < 64; o <<= 1) v += __shfl_xor(v, o);
    return v;
}
__device__ __forceinline__ void transpose_tile(const float* src, int ld, bf16* dst, int ldd, const float* kscale, LAS float* scr, int lane) {
    const int q = lane & 7, kr = lane >> 3;
    f32x4 v[8];
#pragma unroll
    for (int i = 0; i < 8; ++i) v[i] = __builtin_nontemporal_load((const f32x4*)(src + (size_t)(kr + 8 * i) * ld + 4 * q));
#pragma unroll
    for (int i = 0; i < 8; ++i) { const int kk = kr + 8 * i; const float sc = kscale ? kscale[kk] : 1.0f;
#pragma unroll
        for (int c = 0; c < 4; ++c) scr[kk * 33 + 4 * q + c] = v[i][c] * sc; }
    LDS_WAIT(); asm volatile("" ::: "memory");
    const int c = lane & 7;
#pragma unroll
    for (int j = 0; j < 4; ++j) { const int n = (lane >> 3) + 8 * j; const LAS float* s = scr + (8 * c) * 33 + n;
        v4u o; o.x = pk2(s[0 * 33], s[1 * 33]); o.y = pk2(s[2 * 33], s[3 * 33]); o.z = pk2(s[4 * 33], s[5 * 33]); o.w = pk2(s[6 * 33], s[7 * 33]);
        *(GAS v4u*)(dst + (size_t)n * ldd + 8 * c) = o; }
    LDS_WAIT(); asm volatile("" ::: "memory");
}

__device__ __forceinline__ void transpose_tile8(const float* src, int ld, unsigned char* dst, int ldd, const float* kscale, float scale, LAS float* scr, int lane) {
    const int q = lane & 7, kr = lane >> 3;
    f32x4 v[8];
#pragma unroll
    for (int i = 0; i < 8; ++i) v[i] = __builtin_nontemporal_load((const f32x4*)(src + (size_t)(kr + 8 * i) * ld + 4 * q));
#pragma unroll
    for (int i = 0; i < 8; ++i) { const int kk = kr + 8 * i; const float sc = kscale ? kscale[kk] * scale : scale;
#pragma unroll
        for (int c = 0; c < 4; ++c) scr[kk * 33 + 4 * q + c] = v[i][c] * sc; }
    LDS_WAIT(); asm volatile("" ::: "memory");
    const int c = lane & 3;
#pragma unroll
    for (int j = 0; j < 2; ++j) { const int n = (lane >> 2) + 16 * j; const LAS float* s = scr + (16 * c) * 33 + n;
        v4u o; o.x = pg8::pack4_fp8(s[0 * 33], s[1 * 33], s[2 * 33], s[3 * 33]); o.y = pg8::pack4_fp8(s[4 * 33], s[5 * 33], s[6 * 33], s[7 * 33]);
        o.z = pg8::pack4_fp8(s[8 * 33], s[9 * 33], s[10 * 33], s[11 * 33]); o.w = pg8::pack4_fp8(s[12 * 33], s[13 * 33], s[14 * 33], s[15 * 33]);
        *(GAS v4u*)(dst + (size_t)n * ldd + 16 * c) = o; }
    LDS_WAIT(); asm volatile("" ::: "memory");
}

struct P0Args { const float *x, *g_mix, *w_in, *w_rg_a, *w_rg_x, *b_forget, *w_lru_out, *w_attn_out, *w_out, *g_ffn, *w_rgrp, *w_rexp, *w_gate, *w_up;
                bf16 *Win, *Wl, *Wa, *Wo, *Wrg, *XB; unsigned char* W13; float *RS1, *LF, *WRT; };
struct TItem { const float* src; int ld; unsigned char* dst; int ldd; const float* ks; float scale; int f8; };
__device__ __forceinline__ void titem_load(const TItem& t, f32x4 (&v)[8], float (&sc)[8], int lane) {
    const int q = lane & 7, kr = lane >> 3;
#pragma unroll
    for (int i = 0; i < 8; ++i) { v[i] = __builtin_nontemporal_load((const f32x4*)(t.src + (size_t)(kr + 8 * i) * t.ld + 4 * q)); sc[i] = t.ks ? t.ks[kr + 8 * i] * t.scale : t.scale; }
}
__device__ __forceinline__ void titem_finish(const TItem& t, const f32x4 (&v)[8], const float (&sc)[8], LAS float* scr, int lane) {
    const int q = lane & 7, kr = lane >> 3;
#pragma unroll
    for (int i = 0; i < 8; ++i) { const int kk = kr + 8 * i;
#pragma unroll
        for (int c = 0; c < 4; ++c) scr[kk * 33 + 4 * q + c] = v[i][c] * sc[i]; }
    LDS_WAIT(); asm volatile("" ::: "memory");
    if (t.f8) { const int c = lane & 3;
#pragma unroll
        for (int j = 0; j < 2; ++j) { const int n = (lane >> 2) + 16 * j; const LAS float* s = scr + (16 * c) * 33 + n;
            v4u o; o.x = pg8::pack4_fp8(s[0 * 33], s[1 * 33], s[2 * 33], s[3 * 33]); o.y = pg8::pack4_fp8(s[4 * 33], s[5 * 33], s[6 * 33], s[7 * 33]);
            o.z = pg8::pack4_fp8(s[8 * 33], s[9 * 33], s[10 * 33], s[11 * 33]); o.w = pg8::pack4_fp8(s[12 * 33], s[13 * 33], s[14 * 33], s[15 * 33]);
            *(GAS v4u*)(t.dst + (size_t)n * t.ldd + 16 * c) = o; } }
    else { const int c = lane & 7;
#pragma unroll
        for (int j = 0; j < 4; ++j) { const int n = (lane >> 3) + 8 * j; const LAS float* s = scr + (8 * c) * 33 + n;
            v4u o; o.x = pk2(s[0 * 33], s[1 * 33]); o.y = pk2(s[2 * 33], s[3 * 33]); o.z = pk2(s[4 * 33], s[5 * 33]); o.w = pk2(s[6 * 33], s[7 * 33]);
            *(GAS v4u*)(t.dst + ((size_t)n * t.ldd + 8 * c) * 2) = o; } }
    LDS_WAIT(); asm volatile("" ::: "memory");
}
constexpr int P0_I_IN = 16 * 224, P0_I_SQ = 16 * 32, P0_I_RG = 2 * 4 * 4 * 8, P0_I_EX = 2 * 8192, P0_NITEMS = P0_I_IN + 3 * P0_I_SQ + P0_I_RG + P0_I_EX;
__device__ __forceinline__ void p0_items(const Frame& F, const P0Args& a, const int first, const int last, const int stride, const int offset) {
    LAS float* scr = (LAS float*)(F.lds + RING_OFF + F.wave * 16384);
    const float* const p_wl = a.w_lru_out; const float* const p_wa = a.w_attn_out; const float* const p_wo = a.w_out; const float* const p_rga = a.w_rg_a; const float* const p_rgx = a.w_rg_x;
    bf16* const q_wl = a.Wl; bf16* const q_wa = a.Wa; bf16* const q_wo = a.Wo;
    constexpr int I_IN = P0_I_IN, I_SQ = P0_I_SQ, I_EX = P0_I_EX, NITEMS = P0_NITEMS;
    const float* const p_gate = a.w_gate; const float* const p_up = a.w_up; const float* const p_win = a.w_in; const float* const p_gmix = a.g_mix; const float* const p_gffn = a.g_ffn;
    bf16* const q_win = a.Win; bf16* const q_wrg = a.Wrg; unsigned char* const q_w13 = a.W13;
#define P0_DECODE(it_, t_) do { int r = (it_); \
        if (r >= NITEMS - I_EX) { r -= NITEMS - I_EX;     \
            const int w = r >> 13, e = (r >> 8) & 31, kb = (r >> 4) & 15, nb = r & 15; const float* W = (w == 0 ? p_gate : p_up) + (size_t)e * DM * DE; \
            const int drow = e * 1024 + (nb >> 2) * 256 + (nb & 3) * 32 + (w == 1 ? 128 : 0); \
            t_.src = W + (size_t)(64 * kb) * DE + 32 * nb; t_.ld = DE; t_.dst = q_w13 + (size_t)drow * DM + 64 * kb; t_.ldd = DM; t_.ks = p_gffn + 64 * kb; t_.scale = pg8::W13_SCALE; t_.f8 = 1; } \
        else if (r < I_IN) { const int kb = r / 224, nb = r % 224, n0 = 32 * nb, sc_ = n0 < 5120 ? n0 : n0 + 8; \
            t_.src = p_win + (size_t)(64 * kb) * INW + sc_; t_.ld = INW; t_.dst = (unsigned char*)(q_win + (size_t)n0 * DM + 64 * kb); t_.ldd = DM; t_.ks = p_gmix + 64 * kb; t_.scale = 1.0f; t_.f8 = 0; } \
        else if (r < I_IN + 3 * I_SQ) { r -= I_IN; const int w = r / I_SQ, q = r % I_SQ, kb = q / 32, nb = q % 32; const float* W = w == 0 ? p_wl : (w == 1 ? p_wa : p_wo); bf16* Wt = w == 0 ? q_wl : (w == 1 ? q_wa : q_wo); \
            t_.src = W + (size_t)(64 * kb) * DM + 32 * nb; t_.ld = DM; t_.dst = (unsigned char*)(Wt + (size_t)(32 * nb) * DM + 64 * kb); t_.ldd = DM; t_.ks = nullptr; t_.scale = 1.0f; t_.f8 = 0; } \
        else { r -= I_IN + 3 * I_SQ; const int gb = r / 32, q = r % 32, kb = q / 8, nb = q % 8; const float* W = (gb < 4 ? p_rga : p_rgx) + (size_t)(gb & 3) * 65536; \
            t_.src = W + (size_t)(64 * kb) * 256 + 32 * nb; t_.ld = 256; t_.dst = (unsigned char*)(q_wrg + (size_t)gb * 65536 + (size_t)(32 * nb) * 256 + 64 * kb); t_.ldd = 256; t_.ks = nullptr; t_.scale = -1.4426950408889634f; t_.f8 = 0; }     } while (0)
    {
        int it = first + offset; TItem cur; f32x4 va[8]; float sa[8];
        if (it < last) { P0_DECODE(it, cur); titem_load(cur, va, sa, F.lane); }
        while (it < last) {
            const int nx = it + stride; TItem nt = cur; f32x4 vb[8]; float sb[8];
            if (nx < last) { P0_DECODE(nx, nt); titem_load(nt, vb, sb, F.lane); }
            titem_finish(cur, va, sa, scr, F.lane);
            if (nx < last) { cur = nt;
#pragma unroll
                for (int i = 0; i < 8; ++i) { va[i] = vb[i]; sa[i] = sb[i]; } }
            it = nx;
        }
    }
#undef P0_DECODE
}
__device__ __forceinline__ void p0_prologue(const Frame& F, const P0Args& a, const int part  ) {
    const int gw = F.vcu * NWAVES + F.wave, NGW = F.G * NWAVES;
    if (part != 2) p0_items(F, a, 0, P0_NITEMS, NGW, gw);
    if (part == 1) return;
    for (int i = (F.vcu * NWAVES + F.wave) * 64 + F.lane; i < 64 * DM; i += NGW * 64) { const int n = i >> 10, k = i & 1023;
        float v = 0.f; if (n < 32) v = a.w_rexp[k * 32 + n]; else if (n < 36) v = a.w_rgrp[k * 4 + (n - 32)];
        a.WRT[i] = v * a.g_ffn[k]; }
    LAS float* wfl = (LAS float*)(F.lds + RING_OFF);
    __syncthreads();
    for (int k = F.tid; k < DM; k += NWAVES * 64) { const float g = a.g_mix[k];
        const f32x4 w0 = *(const f32x4*)(a.w_in + (size_t)k * INW + 5120), w1 = *(const f32x4*)(a.w_in + (size_t)k * INW + 5124);
        *(LAS f32x4*)(wfl + k * 8) = w0 * g; *(LAS f32x4*)(wfl + k * 8 + 4) = w1 * g; }
    __syncthreads();
    float wf[4][4][8];
#pragma unroll
    for (int j = 0; j < 4; ++j)
#pragma unroll
        for (int i = 0; i < 4; ++i) { const int k = 256 * j + 4 * F.lane + i; const f32x4 w0 = *(const LAS f32x4*)(wfl + k * 8), w1 = *(const LAS f32x4*)(wfl + k * 8 + 4);
#pragma unroll
            for (int h = 0; h < 4; ++h) { wf[j][i][h] = w0[h]; wf[j][i][4 + h] = w1[h]; } }
    const float bfg = a.b_forget[F.lane & 7];
    f32x4 vn[4];
    if (gw < T) { const GAS f32x4* xr0 = (const GAS f32x4*)(a.x + (size_t)gw * DM) + F.lane;
#pragma unroll
        for (int j = 0; j < 4; ++j) vn[j] = __builtin_nontemporal_load((const f32x4*)xr0 + 64 * j); }
    for (int m = gw; m < T; m += NGW) {
        f32x4 v[4]; float s = 0.f, d[8] = {0.f, 0.f, 0.f, 0.f, 0.f, 0.f, 0.f, 0.f};
#pragma unroll
        for (int j = 0; j < 4; ++j) v[j] = vn[j];
        if (m + NGW < T) { const GAS f32x4* xr1 = (const GAS f32x4*)(a.x + (size_t)(m + NGW) * DM) + F.lane;
#pragma unroll
            for (int j = 0; j < 4; ++j) vn[j] = __builtin_nontemporal_load((const f32x4*)xr1 + 64 * j); }
#pragma unroll
        for (int j = 0; j < 4; ++j) { s += (v[j].x * v[j].x + v[j].y * v[j].y) + (v[j].z * v[j].z + v[j].w * v[j].w);
#pragma unroll
            for (int i = 0; i < 4; ++i)
#pragma unroll
                for (int h = 0; h < 8; ++h) d[h] = fmaf(v[j][i], wf[j][i][h], d[h]); }
        s = wave_sum(s);
#pragma unroll
        for (int h = 0; h < 8; ++h) d[h] = wave_sum(d[h]);
        const float rs = 1.0f / sqrtf(s * (1.0f / DM) + EPS);
        GAS unsigned long long* o8 = (GAS unsigned long long*)(a.XB + (size_t)m * DM) + F.lane;
#pragma unroll
        for (int j = 0; j < 4; ++j) o8[64 * j] = (unsigned long long)pk2(v[j].x * rs, v[j].y * rs) | ((unsigned long long)pk2(v[j].z * rs, v[j].w * rs) << 32);
        if (F.lane < 8) { const int h = F.lane; float dh = d[0]; dh = h == 1 ? d[1] : dh; dh = h == 2 ? d[2] : dh; dh = h == 3 ? d[3] : dh; dh = h == 4 ? d[4] : dh; dh = h == 5 ? d[5] : dh; dh = h == 6 ? d[6] : dh; dh = h == 7 ? d[7] : dh;
            const float fl = dh * rs + bfg; a.LF[(size_t)m * 8 + h] = fminf(fl, 0.f) - log1pf(expf(-fabsf(fl))); }
    }
}
__device__ __forceinline__ void cumsum_bias(const Frame& F, const float* LF, float* CB) {
    LAS float* wt = (LAS float*)(F.lds + RING_OFF);
    for (int bh = blockIdx.x; bh < NB * NH; bh += F.G) {
        const int b = bh >> 3, h = bh & 7, s0 = F.tid * 8;
        float v[8], run = 0.f;
#pragma unroll
        for (int j = 0; j < 8; ++j) { run += LF[((size_t)(b * SEQ + s0 + j)) * 8 + h]; v[j] = run; }
        float inc = run;
#pragma unroll
        for (int o = 1; o < 64; o <<= 1) { const float t = __shfl_up(inc, o); if (F.lane >= o) inc += t; }
        if (F.lane == 63) wt[F.wave] = inc;
        __syncthreads();
        float pre = inc - run;
        for (int w = 0; w < F.wave; ++w) pre += wt[w];
#pragma unroll
        for (int j = 0; j < 8; ++j) CB[(size_t)bh * SEQ + s0 + j] = -(pre + v[j]) * 11.313708498984761f;
        __syncthreads();
    }
}
struct RgArgs { const bf16* XC; const bf16* GG; bf16* GO; const bf16* Wrg; const float *b_a, *b_x, *lam; };
__device__ __forceinline__ float bfx(const v4u& v, int i) { const unsigned w = i < 2 ? v.x : (i < 4 ? v.y : (i < 6 ? v.z : v.w)); return (i & 1) ? bf_hi(w) : bf_lo(w); }
__device__ __forceinline__ unsigned cvtpk_bf16(float lo, float hi) { unsigned r; asm volatile("v_cvt_pk_bf16_f32 %0, %1, %2" : "=v"(r) : "v"(lo), "v"(hi)); return r; }
__device__ __forceinline__ void conv_prepass(const Frame& F, const bf16* XR, bf16* XC, const float* conv_w, const float* conv_b) {
    const int gw = F.vcu * NWAVES + F.wave, NGW = F.G * NWAVES;
    for (int it = gw; it < (T / 16) * 2; it += NGW) {
        const int r0 = (it >> 1) * 16, c0 = (it & 1) * 512 + 8 * F.lane, tq = r0 & (SEQ - 1);
        float cw[4][8], cbv[8];
#pragma unroll
        for (int j = 0; j < 4; ++j) { const f32x4 w0 = *(const f32x4*)(conv_w + j * DM + c0), w1 = *(const f32x4*)(conv_w + j * DM + c0 + 4);
#pragma unroll
            for (int i = 0; i < 4; ++i) { cw[j][i] = w0[i]; cw[j][4 + i] = w1[i]; } }
        { const f32x4 w0 = *(const f32x4*)(conv_b + c0), w1 = *(const f32x4*)(conv_b + c0 + 4);
#pragma unroll
          for (int i = 0; i < 4; ++i) { cbv[i] = w0[i]; cbv[4 + i] = w1[i]; } }
        v4u raw[19];
#pragma unroll
        for (int i = 0; i < 19; ++i) { const int rr = (i < 3 && tq == 0) ? r0 : r0 - 3 + i; const v4u w = __builtin_nontemporal_load((const v4u*)(XR + ((unsigned)rr * DM + c0)));
            const bool z = i < 3 && tq == 0; raw[i].x = z ? 0u : w.x; raw[i].y = z ? 0u : w.y; raw[i].z = z ? 0u : w.z; raw[i].w = z ? 0u : w.w; }
#pragma unroll
        for (int r = 0; r < 16; ++r) { float y[8];
#pragma unroll
            for (int i = 0; i < 8; ++i) { float sacc = cbv[i];
#pragma unroll
                for (int j = 0; j < 4; ++j) sacc = fmaf(cw[j][i], bfx(raw[r + j], i), sacc);
                y[i] = sacc; }
            v4u o; o.x = cvtpk_bf16(y[0], y[1]); o.y = cvtpk_bf16(y[2], y[3]); o.z = cvtpk_bf16(y[4], y[5]); o.w = cvtpk_bf16(y[6], y[7]);
            *(GAS v4u*)(XC + ((unsigned)(r0 + r) * DM + c0)) = o; }
    }
}
__device__ __forceinline__ void rglru_unit(const Frame& F, const RgArgs& a, int unit) {
    const int tid = F.tid, lane = F.lane, wid = F.wave, fr = lane & 15, fq = lane >> 4, rq = wid >> 1, cp = wid & 1;
    const int b = unit >> 5, n = (unit >> 3) & 3, g = unit & 7, cbase = 256 * n, cown = cbase + 32 * g;
    LAS unsigned char* A_l = F.lds + RING_OFF;
    LAS float* tot = (LAS float*)(F.lds + RG_TOT);
    bf16x8 bfr[2][8];
#pragma unroll
    for (int gt = 0; gt < 2; ++gt)
#pragma unroll
        for (int ks = 0; ks < 8; ++ks) bfr[gt][ks] = *(const GAS bf16x8*)(a.Wrg + ((size_t)((gt * 4 + n) * 256 + 32 * g + 16 * cp + fr)) * 256 + 32 * ks + 8 * fq);
    const int cl = 16 * cp + fr, cch = cown + cl;
    const float ba = -1.4426950408889634f * a.b_a[cch], bx = -1.4426950408889634f * a.b_x[cch], sp8 = 8.0f * log1pf(expf(-a.lam[cch])) * 1.4426950408889634f;
    const unsigned goff = (unsigned)(b * SEQ + 32 * rq + 4 * fq) * DM + cch;
    const __amdgpu_buffer_rsrc_t GGr = __builtin_amdgcn_make_buffer_rsrc((void*)a.GG, 0, (int)((size_t)T * DM * 2), 0x00020000);
    const __amdgpu_buffer_rsrc_t GOr = __builtin_amdgcn_make_buffer_rsrc((void*)a.GO, 0, (int)((size_t)T * DM * 2), 0x00020000);
    const int gvo = (int)(goff * 2u);
    const unsigned dbase = ((unsigned)(b * SEQ + 16 * wid + (lane >> 5)) * DM + cbase) * 2u;
    const char* const XCb = (const char*)a.XC;
#define RG_DMA(ci_, buf_) do { _Pragma("unroll") for (int i_ = 0; i_ < 8; ++i_) { const unsigned so_ = dbase + (unsigned)(2 * i_) * (DM * 2u) + ((((unsigned)lane & 31u) ^ (unsigned)((2 * i_ + (lane >> 5)) & 15)) << 4); \
        __builtin_amdgcn_global_load_lds((const unsigned*)(XCb + so_ + (unsigned)(ci_) * (128u * DM * 2u)), (LAS unsigned*)(A_l + (buf_) * 65536 + (8 * wid + i_) * 1024), 16, 0, 0); } } while (0)
    float hc = 0.f;
    const int kx = 32 * g + cl;
#pragma unroll
    for (int gt = 0; gt < 2; ++gt)
#pragma unroll
        for (int ks = 0; ks < 8; ++ks) asm volatile("" : "+v"(bfr[gt][ks]));
    RG_DMA(0, 0); asm volatile("s_waitcnt vmcnt(0)" ::: "memory");
#define RG_CHUNK(BUF_, ci_) do { const int ci = (ci_); const int t0 = 128 * ci; LAS unsigned char* const Ab = A_l + (BUF_) * 65536; \
        __builtin_amdgcn_s_barrier(); asm volatile("" ::: "memory"); \
        unsigned short ggv[2][4]; \
        _Pragma("unroll") \
        for (int mt = 0; mt < 2; ++mt) \
        _Pragma("unroll") \
            for (int j = 0; j < 4; ++j) ggv[mt][j] = __builtin_amdgcn_raw_buffer_load_b16(GGr, gvo, (t0 + 16 * mt + j) * (DM * 2), 0); \
        if (ci + 1 < SEQ / 128) RG_DMA(ci + 1, BUF_ ^ 1); \
 \
        f32x4 acc[2][2]; \
        _Pragma("unroll") \
        for (int mt = 0; mt < 2; ++mt) { acc[mt][0] = (f32x4){ba, ba, ba, ba}; acc[mt][1] = (f32x4){bx, bx, bx, bx}; } \
        _Pragma("unroll") \
        for (int ks = 0; ks < 8; ++ks) { const int ch = 4 * ks + fq; \
        _Pragma("unroll") \
            for (int mt = 0; mt < 2; ++mt) { const int arow = 32 * rq + 16 * mt + fr; \
                const bf16x8 af = *(const LAS bf16x8*)(Ab + arow * 512 + ((ch ^ (arow & 15)) << 4)); \
                acc[mt][0] = __builtin_amdgcn_mfma_f32_16x16x32_bf16(af, bfr[0][ks], acc[mt][0], 0, 0, 0); \
                acc[mt][1] = __builtin_amdgcn_mfma_f32_16x16x32_bf16(af, bfr[1][ks], acc[mt][1], 0, 0, 0); } } \
 \
        float av[2][4], bv[2][4], sA[2], sB[2]; \
        _Pragma("unroll") \
        for (int mt = 0; mt < 2; ++mt) { float A = 1.f, Bv = 0.f; \
        _Pragma("unroll") \
            for (int j = 0; j < 4; ++j) { const int row = 32 * rq + 16 * mt + 4 * fq + j; \
                const unsigned short xb16 = *(const LAS unsigned short*)(Ab + row * 512 + ((((kx >> 3) ^ (row & 15))) << 4) + (kx & 7) * 2); \
                const float xc = __builtin_bit_cast(float, (unsigned)xb16 << 16); \
                const float r_ = __builtin_amdgcn_rcpf(1.0f + __builtin_amdgcn_exp2f(acc[mt][0][j])), i_ = __builtin_amdgcn_rcpf(1.0f + __builtin_amdgcn_exp2f(acc[mt][1][j])); \
                const float aa = __builtin_amdgcn_exp2f(-sp8 * r_); \
                const float mult = __builtin_amdgcn_sqrtf(fmaxf(fmaf(-aa, aa, 1.0f), 0.f)); \
                av[mt][j] = aa; bv[mt][j] = mult * i_ * xc; \
                Bv = fmaf(aa, Bv, bv[mt][j]); A *= aa; } \
            sA[mt] = A; sB[mt] = Bv; } \
 \
        float eA[2], eB[2], tA[2], tB[2]; \
        _Pragma("unroll") \
        for (int mt = 0; mt < 2; ++mt) { float A = sA[mt], Bv = sB[mt]; \
            { const float pA = __shfl_up(A, 16), pB = __shfl_up(Bv, 16); if (fq >= 1) { Bv = fmaf(A, pB, Bv); A *= pA; } } \
            { const float pA = __shfl_up(A, 32), pB = __shfl_up(Bv, 32); if (fq >= 2) { Bv = fmaf(A, pB, Bv); A *= pA; } } \
            const float xA = __shfl_up(A, 16), xB = __shfl_up(Bv, 16); eA[mt] = fq >= 1 ? xA : 1.f; eB[mt] = fq >= 1 ? xB : 0.f; \
            tA[mt] = __shfl(A, 48 + fr); tB[mt] = __shfl(Bv, 48 + fr); } \
        const float wA = tA[0] * tA[1], wB = fmaf(tA[1], tB[0], tB[1]); \
        if (fq == 0) { tot[(rq * 32 + cl) * 2] = wA; tot[(rq * 32 + cl) * 2 + 1] = wB; } \
        asm volatile("s_waitcnt lgkmcnt(0)" ::: "memory"); __builtin_amdgcn_s_barrier(); asm volatile("" ::: "memory"); \
        float hin = hc, hnew = hc; \
        _Pragma("unroll") \
        for (int q = 0; q < 4; ++q) { const float qA = tot[(q * 32 + cl) * 2], qB = tot[(q * 32 + cl) * 2 + 1]; hnew = fmaf(qA, hnew, qB); if (q < rq) hin = hnew; } \
        hc = hnew; \
        _Pragma("unroll") \
        for (int mt = 0; mt < 2; ++mt) { float h = mt == 0 ? hin : fmaf(tA[0], hin, tB[0]); \
            h = fmaf(eA[mt], h, eB[mt]); \
        _Pragma("unroll") \
            for (int j = 0; j < 4; ++j) { h = fmaf(av[mt][j], h, bv[mt][j]); \
                const float gv = __builtin_bit_cast(float, (unsigned)ggv[mt][j] << 16); \
                __builtin_amdgcn_raw_buffer_store_b16((unsigned short)cvtpk_bf16(h * gv, 0.f), GOr, gvo, (t0 + 16 * mt + j) * (DM * 2), 0); } } \
        asm volatile("s_waitcnt lgkmcnt(0)" ::: "memory"); \
        asm volatile("s_waitcnt vmcnt(8)" ::: "memory"); \
    } while (0)
    for (int cc = 0; cc < SEQ / 128; cc += 2) { RG_CHUNK(0, cc); RG_CHUNK(1, cc + 1); }
#undef RG_CHUNK
#undef RG_DMA
    asm volatile("s_waitcnt vmcnt(0) lgkmcnt(0)" ::: "memory"); __builtin_amdgcn_s_barrier(); asm volatile("" ::: "memory");
}
__device__ __forceinline__ int attn_jlo(const Frame& F, const float* CB, const unsigned* NORM, int bh, int qb) {
    float qs = 0.f, ks = 0.f;
#pragma unroll
    for (int w = 0; w < 4; ++w) { qs += __uint_as_float(NORM[(bh) * 4 + w]); ks += __uint_as_float(NORM[(64 + bh) * 4 + w]); }
    constexpr float C2 = 1.4426950408889634f * 0.08838834764831845f;
    const float th = 150.0f + 2.0f * 1.02f * sqrtf(qs * ks) * C2 + 4.0f;
    const float ref = CB[(size_t)bh * SEQ + qb * 256], v = CB[(size_t)bh * SEQ + 64 * F.lane + 63];
    const unsigned long long m = __ballot(F.lane < 4 * qb && (ref - v) * C2 > th);
    int j = __builtin_popcountll(m); if (m != ((j >= 64) ? ~0ull : ((1ull << j) - 1ull))) j = 0;
    return j & ~1;
}
__device__ __forceinline__ fattn::BlockRef attn_ref(int bh, int qb, int jlo) {
    const int b = bh >> 3, h = bh & 7;
    fattn::BlockRef r; r.qo = ((unsigned)bh * SEQ + (unsigned)qb * 256u) * HD; r.oo = ((unsigned)b * SEQ + (unsigned)qb * 256u) * DM + h * HD; r.kvo = (unsigned)bh * SEQ * HD; r.cbo = (unsigned)bh * SEQ; r.P0 = qb * 256; r.jlo = jlo; return r;
}
__device__ __forceinline__ void attn_phase(const Frame& F, char* lds, const bf16* Qb, bf16* Ob, const bf16* Kb, const bf16* Vb, const float* CB, const int* JLO, gu32* QCTR) {
    constexpr int NBLK = 128;
    const int M = F.G >> 3; if ((F.G & 7) || M > 64 || M < 1) return;
    const int x = F.vcu / M, r = F.vcu % M;
    volatile LAS int* tk_l = (volatile LAS int*)(F.lds + MISC_OFF + 64);
    gu32* qc = QCTR + 64 * x;
    const fattn::Bases G{Qb, Ob, Kb, Vb, CB};
#define ATT_DEC(k_, bh_, qb_) do { const int i_ = (k_) & 7; bh_ = (i_ < 4 ? 4 * x + i_ : 32 + 4 * x + (i_ - 4)); qb_ = 15 - ((k_) >> 3); } while (0)
    int bh, qb; ATT_DEC(r, bh, qb);
    fattn::BlockRef cur = attn_ref(bh, qb, __builtin_amdgcn_readfirstlane(JLO[bh * 16 + qb]));
    ATT_DEC(r + M, bh, qb);
    fattn::BlockRef nxt = attn_ref(bh, qb, __builtin_amdgcn_readfirstlane(JLO[bh * 16 + qb])); bool nxt_ok = (r + M) < NBLK;
    fattn::Seam S;
    fattn::prime(G, cur, lds, S);
    bool more = true;
    for (;;) {
        unsigned tkt = 0u;
        if (more && F.tid == 0) tkt = __hip_atomic_fetch_add(qc, 1u, __ATOMIC_RELAXED, __HIP_MEMORY_SCOPE_AGENT);
        const bool last = !nxt_ok;
        fattn::block(G, cur, last ? cur : nxt, lds, S);
        if (last) break;
        if (F.tid == 0) tk_l[0] = more ? (int)tkt + 2 * M : NBLK;
        __syncthreads();
        const int k2 = __builtin_amdgcn_readfirstlane(tk_l[0]);
        __syncthreads();
        cur = nxt;
        if (k2 < NBLK) { ATT_DEC(k2, bh, qb); nxt = attn_ref(bh, qb, __builtin_amdgcn_readfirstlane(JLO[bh * 16 + qb])); nxt_ok = true; } else { nxt_ok = false; more = false; }
    }
#undef ATT_DEC
}
typedef float f32x16 __attribute__((ext_vector_type(16)));
struct P5Args { const float *X, *WRT, *b_rgrp, *b_rexp, *w_down; const bf16* DL; bf16* X1B; unsigned char *X8, *W2; float* RS2; int* LISTS; unsigned* TOK; gu32* CNT; };
__device__ __forceinline__ void p5_route(const Frame& F, const P5Args& a) {
    const int tid = F.tid, lane = F.lane, wid = F.wave, i16 = lane & 15, h4 = lane >> 4;
    constexpr int LDA = 132;
    LAS float* A_l = (LAS float*)(F.lds + RING_OFF) + wid * 16 * LDA;
    LAS float* B_l = (LAS float*)(F.lds + RING_OFF + 67584);
    LAS float* LG = (LAS float*)(F.lds + RING_OFF + 94208);
    LAS float* rs_l = (LAS float*)(F.lds + RING_OFF + 113664);
    LAS int* hist = (LAS int*)(F.lds + RING_OFF + 114176);
    LAS int* base_l = (LAS int*)(F.lds + RING_OFF + 114432);
    {
        LAS float* scr = (LAS float*)(F.lds + RING_OFF + wid * 8704);
        const int gw = F.vcu * NWAVES + wid, NGW = F.G * NWAVES;
        for (int it = gw; it < 8192; it += NGW) { const int e = it >> 8, kb = (it >> 5) & 7, nb = it & 31; const float* W = a.w_down + (size_t)e * DE * DM;
            transpose_tile8(W + (size_t)(64 * kb) * DM + 32 * nb, DM, a.W2 + (size_t)(e * 1024 + 32 * nb) * DE + 64 * kb, DE, nullptr, pg8::W2_SCALE, scr, lane); }
    }
    __syncthreads();
    for (int rb = blockIdx.x; rb < T / 128; rb += F.G) {
        const int R0 = rb * 128;
        if (tid < 32) hist[tid] = 0;
        const int ar = lane >> 5, ac = 4 * (lane & 31);
        const size_t xo = (size_t)(R0 + 16 * wid + ar) * DM + ac; const float* xsrc = a.X + xo; const bf16* dsrc = a.DL + xo; unsigned char* xdst = a.X8 + xo; bf16* bdst = a.X1B + xo;
        f32x4 areg[8], breg[3]; unsigned long long dreg[8];
#define P5_LOAD(kc_) do { _Pragma("unroll") for (int i_ = 0; i_ < 8; ++i_) { areg[i_] = __builtin_nontemporal_load((const f32x4*)(xsrc + (size_t)(2 * i_) * DM + (kc_) * 128)); dreg[i_] = __builtin_nontemporal_load((const unsigned long long*)(dsrc + (size_t)(2 * i_) * DM + (kc_) * 128)); } \
        _Pragma("unroll") for (int q_ = 0; q_ < 3; ++q_) { const int idx_ = tid + 512 * q_; breg[q_] = *(const f32x4*)(a.WRT + (size_t)(idx_ >> 5) * DM + (kc_) * 128 + 4 * (idx_ & 31)); } } while (0)
        P5_LOAD(0);
        f32x4 acc[3] = {{0.f, 0.f, 0.f, 0.f}, {0.f, 0.f, 0.f, 0.f}, {0.f, 0.f, 0.f, 0.f}}; float ss = 0.f;
        for (int kc = 0; kc < 8; ++kc) {
#pragma unroll
            for (int i = 0; i < 8; ++i) { const unsigned dl = (unsigned)dreg[i], dh = (unsigned)(dreg[i] >> 32);
                areg[i][0] += bf_lo(dl); areg[i][1] += bf_hi(dl); areg[i][2] += bf_lo(dh); areg[i][3] += bf_hi(dh);
                *(unsigned*)(xdst + (size_t)(2 * i) * DM + kc * 128) = pg8::pack4_fp8(areg[i][0], areg[i][1], areg[i][2], areg[i][3]);
                *(unsigned long long*)(bdst + (size_t)(2 * i) * DM + kc * 128) = (unsigned long long)pg8::cvt_pk_bf16(areg[i][0], areg[i][1]) | ((unsigned long long)pg8::cvt_pk_bf16(areg[i][2], areg[i][3]) << 32);
                *(LAS f32x4*)(A_l + (2 * i + ar) * LDA + ac) = areg[i]; }
#pragma unroll
            for (int q = 0; q < 3; ++q) { const int idx = tid + 512 * q; *(LAS f32x4*)(B_l + (idx >> 5) * LDA + 4 * (idx & 31)) = breg[q]; }
            __syncthreads();
            if (kc + 1 < 8) P5_LOAD(kc + 1);
#pragma unroll
            for (int jj = 0; jj < 8; ++jj) {
                const f32x4 af = *(const LAS f32x4*)(A_l + i16 * LDA + 16 * jj + 4 * h4);
                f32x4 bfv[3];
#pragma unroll
                for (int nt = 0; nt < 3; ++nt) bfv[nt] = *(const LAS f32x4*)(B_l + (16 * nt + i16) * LDA + 16 * jj + 4 * h4);
                ss += (af[0] * af[0] + af[1] * af[1]) + (af[2] * af[2] + af[3] * af[3]);
#pragma unroll
                for (int s = 0; s < 4; ++s)
#pragma unroll
                    for (int nt = 0; nt < 3; ++nt) acc[nt] = __builtin_amdgcn_mfma_f32_16x16x4f32(af[s], bfv[nt][s], acc[nt], 0, 0, 0);
            }
            __syncthreads();
        }
#undef P5_LOAD
        ss += __shfl_xor(ss, 16); ss += __shfl_xor(ss, 32);
        const float rs = 1.0f / sqrtf(ss * (1.0f / DM) + EPS);
        if (h4 == 0) { a.RS2[R0 + 16 * wid + i16] = rs; rs_l[16 * wid + i16] = rs; }
#pragma unroll
        for (int r = 0; r < 4; ++r) { const int rl = 16 * wid + 4 * h4 + r; LG[rl * 37 + i16] = acc[0][r]; LG[rl * 37 + 16 + i16] = acc[1][r]; if (i16 < 4) LG[rl * 37 + 32 + i16] = acc[2][r]; }
        __syncthreads();
        int e0 = 0, e1 = 0, k0 = 0, k1 = 0; float w0 = 0.f, w1 = 0.f;
        if (tid < 128) {
            const float rsv = rs_l[tid]; const LAS float* lg = LG + tid * 37;
            float gl[4];
#pragma unroll
            for (int q = 0; q < 4; ++q) gl[q] = lg[32 + q] * rsv + a.b_rgrp[q];
            int gs = 0; float gm = gl[0];
#pragma unroll
            for (int q = 1; q < 4; ++q) if (gl[q] > gm) { gm = gl[q]; gs = q; }
            float den = 0.f;
#pragma unroll
            for (int q = 0; q < 4; ++q) den += expf(gl[q] - gm);
            const float pg = 1.0f / den;
            float el[8];
#pragma unroll
            for (int q = 0; q < 8; ++q) el[q] = lg[8 * gs + q] * rsv + a.b_rexp[8 * gs + q];
            int i0 = 0; float v0 = el[0];
#pragma unroll
            for (int q = 1; q < 8; ++q) if (el[q] > v0) { v0 = el[q]; i0 = q; }
            int i1 = -1; float v1 = -INFINITY;
#pragma unroll
            for (int q = 0; q < 8; ++q) if (q != i0 && el[q] > v1) { v1 = el[q]; i1 = q; }
            const float ex = expf(v1 - v0);
            w0 = pg / (1.0f + ex); w1 = pg * ex / (1.0f + ex);
            e0 = 8 * gs + i0; e1 = 8 * gs + i1;
            k0 = atomicAdd((int*)(hist + e0), 1); k1 = atomicAdd((int*)(hist + e1), 1);
        }
        __syncthreads();
        if (tid < 32) base_l[tid] = (int)__hip_atomic_fetch_add(a.CNT + tid, (unsigned)hist[tid], __ATOMIC_RELAXED, __HIP_MEMORY_SCOPE_AGENT);
        __syncthreads();
        if (tid < 128) { const int tok = R0 + tid, s0 = base_l[e0] + k0, s1 = base_l[e1] + k1;
            a.LISTS[(size_t)e0 * T + s0] = tok; a.LISTS[(size_t)e1 * T + s1] = tok;
            v4u i0v = {(unsigned)e0, (unsigned)s0, (unsigned)e1, (unsigned)s1}, i1v = {__float_as_uint(w0), __float_as_uint(w1), 0u, 0u};
            *(GAS v4u*)(a.TOK + (size_t)tok * 8) = i0v; *(GAS v4u*)(a.TOK + (size_t)tok * 8 + 4) = i1v; }
        __syncthreads();
    }
}
__device__ __forceinline__ void build_tables(const Frame& F, const gu32* CNT) {
    LAS int* ps = (LAS int*)(F.lds + TBL_PS); LAS int* cn = (LAS int*)(F.lds + TBL_CN); LAS int* te = (LAS int*)(F.lds + TBL_TE);
    __syncthreads();
    if (F.tid < 32) { int c = (int)__hip_atomic_load(CNT + F.tid, __ATOMIC_RELAXED, __HIP_MEMORY_SCOPE_AGENT); c = c < 0 ? 0 : (c > T ? T : c); cn[F.tid] = c; }
    __syncthreads();
    if (F.tid == 0) { int run = 0; for (int e = 0; e < 32; ++e) { ps[e] = run; run += (cn[e] + 255) & ~255; } if (run > PMAX) run = PMAX; ps[32] = run; }
    __syncthreads();
    if (F.tid < 288) { const int p = F.tid * 256; int e = 0; for (int q = 1; q < 32; ++q) if (p >= ps[q]) e = q; te[F.tid] = e; }
    __syncthreads();
}
__device__ __forceinline__ void build_rowtab(const Frame& F, const pg8::GroupedOrder& S, const int* LISTS, const float* RS2, LAS int* rowtab) {
    const LAS int* ps = (const LAS int*)(F.lds + TBL_PS); const LAS int* cn = (const LAS int*)(F.lds + TBL_CN); const LAS int* te = (const LAS int*)(F.lds + TBL_TE);
    pg8::Unit u;
    for (int ui = 0; ui < 6 && S.next(ui, u); ++ui)
        if (F.tid < 256) { const int p = u.pm * 256 + F.tid, e = te[u.pm], local = p - ps[e]; const int tok = local < cn[e] ? LISTS[(size_t)e * T + local] : 0; rowtab[ui * 256 + F.tid] = tok; ((LAS float*)rowtab)[(6 + ui) * 256 + F.tid] = RS2[tok]; }
    __syncthreads();
}
__device__ __forceinline__ float fp8_f32(unsigned w, int i) { return i == 0 ? __builtin_amdgcn_cvt_f32_fp8(w, 0) : (i == 1 ? __builtin_amdgcn_cvt_f32_fp8(w, 1) : (i == 2 ? __builtin_amdgcn_cvt_f32_fp8(w, 2) : __builtin_amdgcn_cvt_f32_fp8(w, 3))); }
__device__ __forceinline__ void p9_final(const Frame& F, const bf16* X1B, float* OUT, const unsigned char* Y, const unsigned* TOK, const float* g_final) {
    const LAS int* ps = (const LAS int*)(F.lds + TBL_PS);
    const int gw = F.vcu * NWAVES + F.wave, NGW = F.G * NWAVES;
    f32x4 gf[4];
#pragma unroll
    for (int j = 0; j < 4; ++j) gf[j] = *((const f32x4*)g_final + F.lane + 64 * j);
    constexpr float YS = 1.0f / (pg8::HB_SCALE * pg8::W2_SCALE * pg8::Y_SCALE);
    v4u ia_n = {0u, 0u, 0u, 0u}, ib_n = {0u, 0u, 0u, 0u}, ia_c = ia_n, ib_c = ib_n; unsigned long long xw_n[4]; unsigned ya_n[4], yb_n[4];
#define P9_TOK(m_, ia_, ib_) do { ia_ = *(const GAS v4u*)(TOK + (size_t)(m_) * 8); ib_ = *(const GAS v4u*)(TOK + (size_t)(m_) * 8 + 4); } while (0)
#define P9_ROW(m_, ia_) do { const size_t p0_ = (size_t)(ps[(int)(ia_.x & 31u)] + (int)ia_.y), p1_ = (size_t)(ps[(int)(ia_.z & 31u)] + (int)ia_.w); \
        const GAS unsigned long long* xr_ = (const GAS unsigned long long*)(X1B + (size_t)(m_) * DM) + F.lane; \
        const GAS unsigned* y0_ = (const GAS unsigned*)(Y + p0_ * DM) + F.lane; const GAS unsigned* y1_ = (const GAS unsigned*)(Y + p1_ * DM) + F.lane; \
        _Pragma("unroll") for (int j = 0; j < 4; ++j) { xw_n[j] = __builtin_nontemporal_load((const unsigned long long*)xr_ + 64 * j); ya_n[j] = __builtin_nontemporal_load((const unsigned*)y0_ + 64 * j); yb_n[j] = __builtin_nontemporal_load((const unsigned*)y1_ + 64 * j); } } while (0)
    if (gw < T) { P9_TOK(gw, ia_c, ib_c); P9_ROW(gw, ia_c); if (gw + NGW < T) P9_TOK(gw + NGW, ia_n, ib_n); }
    for (int m = gw; m < T; m += NGW) {
        const float w0 = __uint_as_float(ib_c.x) * YS, w1 = __uint_as_float(ib_c.y) * YS;
        unsigned long long xw[4]; unsigned ya[4], yb[4];
#pragma unroll
        for (int j = 0; j < 4; ++j) { xw[j] = xw_n[j]; ya[j] = ya_n[j]; yb[j] = yb_n[j]; }
        if (m + NGW < T) { ia_c = ia_n; ib_c = ib_n; P9_ROW(m + NGW, ia_c); if (m + 2 * NGW < T) P9_TOK(m + 2 * NGW, ia_n, ib_n); }
        GAS f32x4* orow = (GAS f32x4*)(OUT + (size_t)m * DM) + F.lane;
        f32x4 v[4]; float s = 0.f;
#pragma unroll
        for (int j = 0; j < 4; ++j) { v[j] = (f32x4){bf_lo((unsigned)xw[j]), bf_hi((unsigned)xw[j]), bf_lo((unsigned)(xw[j] >> 32)), bf_hi((unsigned)(xw[j] >> 32))}; const unsigned a = ya[j], b = yb[j];
            v[j].x += w0 * fp8_f32(a, 0) + w1 * fp8_f32(b, 0); v[j].y += w0 * fp8_f32(a, 1) + w1 * fp8_f32(b, 1);
            v[j].z += w0 * fp8_f32(a, 2) + w1 * fp8_f32(b, 2); v[j].w += w0 * fp8_f32(a, 3) + w1 * fp8_f32(b, 3);
            s += (v[j].x * v[j].x + v[j].y * v[j].y) + (v[j].z * v[j].z + v[j].w * v[j].w); }
        s = wave_sum(s);
        const float rs = 1.0f / sqrtf(s * (1.0f / DM) + EPS);
#pragma unroll
        for (int j = 0; j < 4; ++j) orow[64 * j] = v[j] * rs * gf[j];
    }
#undef P9_TOK
#undef P9_ROW
}

constexpr int N_PHASES = 10;
#ifndef DUP_TRIVIAL
#define DUP_TRIVIAL 0
#endif
#ifndef DUP_PHASE
#define DUP_PHASE -1
#endif
typedef __attribute__((address_space(4))) const unsigned char* karg_ptr;
__device__ __forceinline__ const float* arg_in(int k) { karg_ptr base = (karg_ptr)__builtin_amdgcn_kernarg_segment_ptr(); const unsigned long long v = *(const unsigned long long volatile __attribute__((address_space(4)))*)(base + 8 * k); return (const float*)(const GAS float*)v; }
struct Args { const float* in[23]; float* out; unsigned char* ws; int ph_lo, ph_hi, mode, pad; };
__global__ void __launch_bounds__(NWAVES * 64, 2) fwd_kernel(Args args) {
    extern __shared__ __attribute__((aligned(16))) unsigned char lds[];
    Frame F;
    F.lds = (LAS unsigned char*)lds;
    F.wave = __builtin_amdgcn_readfirstlane((int)threadIdx.x >> 6); F.lane = pg8::lane_now(); F.tid = F.wave * 64 + F.lane;
    F.G = gridDim.x; { const int bx = blockIdx.x; F.vcu = (F.G % 8 == 0) ? (bx % 8) * (F.G / 8) + bx / 8 : bx; }
    unsigned char* ws = args.ws;
    gu32* ctl = (gu32*)(ws + WS_CTL);
    volatile LAS unsigned* MISC = (volatile LAS unsigned*)(F.lds + MISC_OFF);
    for (int u = F.tid; u < (LDS_BYTES - LDSCTL_OFF) / 4; u += NWAVES * 64) ((LAS unsigned*)(F.lds + LDSCTL_OFF))[u] = 0u;
    __syncthreads();
#if MK_ONE_LAUNCH
    XcdBarrier bar = xcd_barrier_post((unsigned*)(ctl + CW_BAR), MISC + 8);
#define GRID_BAR() xcd_barrier(bar)
#else
#define GRID_BAR() do { } while (0)
#endif
    const int lo = args.ph_lo, hi = args.ph_hi;
#ifndef PH_MASK
#define PH_MASK 0x3ff
#endif
#define IN(k) (((PH_MASK >> (k)) & 1) && lo <= (k) && (k) < hi)
#define BOTH(k) (IN(k) && IN((k) + 1))
    float* out = args.out;
    bf16* Win = (bf16*)(ws + WS_WIN); bf16* Wl = (bf16*)(ws + WS_WL); bf16* Wa = (bf16*)(ws + WS_WA); bf16* Wo = (bf16*)(ws + WS_WO); bf16* Wrg = (bf16*)(ws + WS_WRG);
    bf16* XB = (bf16*)(ws + WS_XB); bf16* XR = (bf16*)(ws + WS_XR); bf16* GG = (bf16*)(ws + WS_GG); bf16* Qb = (bf16*)(ws + WS_Q); bf16* Kb = (bf16*)(ws + WS_K); bf16* Vb = (bf16*)(ws + WS_V);
    bf16* SL = (bf16*)out; bf16* SA = (bf16*)out + pg8::SEGE;
    float* RS1 = (float*)(ws + WS_RS1); float* RS2 = (float*)(ws + WS_RS2); float* LF = (float*)(ws + WS_LF); float* CB = (float*)(ws + WS_CB);
    unsigned* TOK = (unsigned*)(ws + WS_TOK); int* LISTS = (int*)(ws + WS_LISTS); float* WRT = (float*)(ws + WS_WRT); int* JLO = (int*)(ws + WS_SRS);
    unsigned char* W13 = ws + WS_W13; unsigned char* W2 = ws + WS_W2; bf16* XG = (bf16*)(ws + WS_XG); unsigned char* HB = ws + WS_HB; unsigned char* X8 = ws + WS_XB;
    gu32* CNT = ctl + CW_CNT;

    if (IN(0)) { F.lane = pg8::lane_now(); F.tid = F.wave * 64 + F.lane;
        P0Args a{arg_in(0), arg_in(1), arg_in(2), arg_in(5), arg_in(7), arg_in(10), arg_in(11), arg_in(12), arg_in(13), arg_in(14), arg_in(15), arg_in(17), arg_in(19), arg_in(20), Win, Wl, Wa, Wo, Wrg, XB, W13, RS1, LF, WRT};
        p0_prologue(F, a, DUP_PHASE == 0 ? args.mode : 0);
        if (BOTH(0)) GRID_BAR();
    }
    if (IN(1)) { F.lane = pg8::lane_now(); F.tid = F.wave * 64 + F.lane;
        cumsum_bias(F, LF, CB);
        pg8::Gemm g{XB, Win, T, NZ, DM}; pg8::StaticOrder S; S.init(T, NZ, F.G, (int)blockIdx.x);
        pg8::EpiZ E{XR, SL, RS1, (unsigned*)(ctl + CW_NORM), args.mode};
        pg8::gemm_phase<pg8::EpiZ, pg8::StaticOrder, true, true>(F.lds + RING_OFF, g, S, E, F.wave);
        if (BOTH(1)) GRID_BAR();
    }
    if (IN(2)) { F.lane = pg8::lane_now(); F.tid = F.wave * 64 + F.lane;
        { const int gw = F.vcu * NWAVES + F.wave; if (gw < NB * NH * 16) { const int j = attn_jlo(F, CB, (const unsigned*)(ctl + CW_NORM), gw >> 4, gw & 15); if (F.lane == 0) JLO[gw] = j; } }
        conv_prepass(F, XR, XB, arg_in(3), arg_in(4));
        if (BOTH(2)) GRID_BAR();
    }
    if (IN(3)) { F.lane = pg8::lane_now(); F.tid = F.wave * 64 + F.lane;
        RgArgs ra{XB, GG, GG, Wrg, arg_in(6), arg_in(8), arg_in(9)};
#if DUP_PHASE >= 20
        const int mode = args.mode;
#else
        constexpr int mode = 0;
#endif
        if (mode != 2) { ra.GO = mode == 1 ? XR : GG; for (int u = F.vcu; u < 256; u += F.G) rglru_unit(F, ra, u); }
        if (mode != 1) attn_phase(F, (char*)lds + RING_OFF, Qb, XR, Kb, Vb, CB, JLO, ctl + CW_QCTR + (mode == 2 ? 1024 : 0));
        if (BOTH(3)) GRID_BAR();
    }
    if (IN(4)) { { F.lane = pg8::lane_now(); F.tid = F.wave * 64 + F.lane;
        static_assert(WS_GG - WS_XR == (size_t)128 * 256 * DM * 2 && WS_WL - WS_WA == (size_t)4 * 256 * DM * 2, "TwoGemmOrder: hg follows o by 128 row tiles, Wl follows Wa by 4 column tiles");
        pg8::Gemm g{XR, Wa, T, DM, DM}; pg8::TwoGemmOrder S; S.init(T, DM, F.G, (int)blockIdx.x);
        pg8::EpiGate2 E{SA, SL, XB};
        pg8::gemm_phase<pg8::EpiGate2, pg8::TwoGemmOrder, true, true>(F.lds + RING_OFF, g, S, E, F.wave); }
        if (BOTH(4)) GRID_BAR();
    }
    if (IN(5)) { F.lane = pg8::lane_now(); F.tid = F.wave * 64 + F.lane;
        pg8::Gemm g{XB, Wo, T, DM, DM}; pg8::StaticOrder S; S.init(T, DM, F.G, (int)blockIdx.x);
        pg8::EpiDelta E{(bf16*)out};
        pg8::gemm_phase<pg8::EpiDelta, pg8::StaticOrder, true, true>(F.lds + RING_OFF, g, S, E, F.wave);
        if (BOTH(5)) GRID_BAR();
    }
    if (IN(6)) { F.lane = pg8::lane_now(); F.tid = F.wave * 64 + F.lane;
        P5Args a{arg_in(0), WRT, arg_in(16), arg_in(18), arg_in(21), (const bf16*)out, XR, X8, W2, RS2, LISTS, TOK, args.mode ? CNT + 64 : CNT};
        p5_route(F, a);
        if (BOTH(6)) GRID_BAR();
    }
    if (IN(7)) { F.lane = pg8::lane_now(); F.tid = F.wave * 64 + F.lane;
        build_tables(F, CNT);
        const int ntiles = ((const LAS int*)(F.lds + TBL_PS))[32] >> 8;
        pg8::Gemm g{(const bf16*)X8, (const bf16*)W13, ntiles * 256, 32 * 1024, DM / 2}; pg8::GroupedOrder S{(const LAS int*)(F.lds + TBL_TE), ntiles * 4, F.G, F.vcu};
        LAS int* rowtab = (LAS int*)(F.lds + RG_TOT);
        build_rowtab(F, S, LISTS, RS2, rowtab);
        pg8::EpiSwiGLU E{HB};
        pg8::gemm_phase_gather<pg8::EpiSwiGLU, pg8::GroupedOrder, true>(F.lds + RING_OFF, g, S, E, rowtab, F.wave);
        if (BOTH(7)) GRID_BAR();
    }
    if (IN(8)) { F.lane = pg8::lane_now(); F.tid = F.wave * 64 + F.lane;
        build_tables(F, CNT);
        const int ntiles = ((const LAS int*)(F.lds + TBL_PS))[32] >> 8;
        pg8::Gemm g{(const bf16*)HB, (const bf16*)W2, ntiles * 256, 32 * 1024, DE / 2}; pg8::GroupedOrder S{(const LAS int*)(F.lds + TBL_TE), ntiles * 4, F.G, F.vcu};
        pg8::EpiY E{(unsigned char*)XG};
        pg8::gemm_phase<pg8::EpiY, pg8::GroupedOrder, true, true, true>(F.lds + RING_OFF, g, S, E, F.wave);
        if (BOTH(8)) GRID_BAR();
    }
    if (IN(9)) { F.lane = pg8::lane_now(); F.tid = F.wave * 64 + F.lane;
        build_tables(F, CNT);
        p9_final(F, XR, out, (const unsigned char*)XG, TOK, arg_in(22));
    }
#undef IN
#undef BOTH
}

extern "C" void kernel_launch(void* const* d_in, const int* in_sizes, int n_in, void* d_out, int out_size, void* d_ws, size_t ws_size, hipStream_t stream) {
    static int grid = 0;
    if (grid == 0) {
        if (n_in != 23 || in_sizes[0] != T * DM || out_size != T * DM || ws_size < WS_END) { fprintf(stderr, "kernel_launch: unexpected shapes (n_in %d, in0 %d, out %d, ws %zu); nothing launched\n", n_in, n_in > 0 ? in_sizes[0] : -1, out_size, ws_size); grid = -1; return; }
        int dev = 0, cus = 0;
        if (hipGetDevice(&dev) != hipSuccess || hipDeviceGetAttribute(&cus, hipDeviceAttributeMultiprocessorCount, dev) != hipSuccess) { grid = -1; return; }
        if (hipFuncSetAttribute((const void*)fwd_kernel, hipFuncAttributeMaxDynamicSharedMemorySize, LDS_BYTES) != hipSuccess) { fprintf(stderr, "kernel_launch: hipFuncSetAttribute failed\n"); grid = -1; return; }
        int per_cu = 0;
        if (hipOccupancyMaxActiveBlocksPerMultiprocessor(&per_cu, (const void*)fwd_kernel, NWAVES * 64, LDS_BYTES) != hipSuccess || per_cu < 1) { fprintf(stderr, "kernel_launch: occupancy query reports %d\n", per_cu); }
        (void)hipGetLastError();
        grid = cus;
    }
    if (grid < 0) return;
    if (hipMemsetAsync((char*)d_ws + WS_CTL, 0, CTL_ZERO_BYTES, stream) != hipSuccess) return;
    Args a{};
    for (int i = 0; i < 23; ++i) a.in[i] = (const float*)d_in[i];
    a.out = (float*)d_out; a.ws = (unsigned char*)d_ws;
#if MK_ONE_LAUNCH
    a.ph_lo = 0; a.ph_hi = N_PHASES;
    hipLaunchKernelGGL(fwd_kernel, dim3(grid), dim3(NWAVES * 64), LDS_BYTES, stream, a);
#else
    for (int ph = 0; ph < N_PHASES; ++ph) { a.ph_lo = ph; a.ph_hi = ph + 1;
        if (DUP_PHASE == ph || (ph == 3 && DUP_PHASE >= 20)) { a.mode = DUP_PHASE >= 20 ? DUP_PHASE - 19 : ((ph == 6 || (ph == 1 && DUP_TRIVIAL)) ? 1 : (ph == 0 ? DUP_TRIVIAL : 0)); hipLaunchKernelGGL(fwd_kernel, dim3(grid), dim3(NWAVES * 64), LDS_BYTES, stream, a); a.mode = 0; }
        hipLaunchKernelGGL(fwd_kernel, dim3(grid), dim3(NWAVES * 64), LDS_BYTES, stream, a); }
#endif
}
```

```cpp
#include <hip/hip_runtime.h>
#include <cstdio>
#include <cstdint>

#ifndef MK_ONE_LAUNCH
#define MK_ONE_LAUNCH 1
#endif
namespace pg8 {
#define PG8_LAS __attribute__((address_space(3)))
typedef unsigned short bf16_t;
typedef short bf16x8 __attribute__((ext_vector_type(8)));
typedef float f32x4 __attribute__((ext_vector_type(4)));
typedef unsigned u32x4 __attribute__((ext_vector_type(4)));
constexpr int BM = 256, BK = 64, HALF = 128, HTB = HALF * BK * 2  , STAGE_BYTES = 8 * HTB, NXCD = 8, WGM = 8;

__host__ __device__ __forceinline__ int lds_byte(int r, int c) { const int st = (r >> 4) * 2 + (c >> 5), rr = r & 15, cc = c & 31, ob = rr * 64 + cc * 2; return st * 1024 + (ob ^ (((ob >> 9) & 1) << 5)); }
__host__ __device__ __forceinline__ void stage_rc(int b, int& R, int& C) { const int st = b / 1024, sb = b % 1024, swz = sb ^ (((sb >> 9) & 1) << 5); R = (st >> 1) * 16 + swz / 64; C = (st & 1) * 32 + (swz % 64) / 2; }
__host__ __device__ __forceinline__ int perm32(int rho) { const int n = rho >> 4, i = rho & 15; return 8 * (i >> 2) + 4 * n + (i & 3); }

struct Unit { int pm, pn; };
struct Gemm { const bf16_t* A; const bf16_t* Bt; int M, N, K; };

struct StaticOrder {
    int nM, nN, nwg, G, c;
    __host__ __device__ void init(int M, int N, int G_, int c_) { nM = M / BM; nN = N / BM; nwg = nM * nN; G = G_; c = c_; }
    __host__ __device__ bool next(int i, Unit& u) const {
        const long L = (long)i * G + c; if (L >= nwg) return false;
        int wgid = (int)L; { const int q = nwg / NXCD, r = nwg % NXCD, xcd = wgid % NXCD, off = wgid / NXCD; wgid = (xcd < r ? xcd * (q + 1) : r * (q + 1) + (xcd - r) * q) + off; }
        const int nig = WGM * nN, gid = wgid / nig, fm = gid * WGM, gsz = (nM - fm) < WGM ? (nM - fm) : WGM;
        u.pm = fm + ((wgid % nig) % gsz); u.pn = (wgid % nig) / gsz; return true;
    }
    __device__ __forceinline__ void a_ready(const Unit&) const {}
    __device__ __forceinline__ void done(const Unit&) const {}
};

__device__ __forceinline__ unsigned cvt_pk_bf16(float lo, float hi) { unsigned r; asm volatile("v_cvt_pk_bf16_f32 %0, %1, %2" : "=v"(r) : "v"(lo), "v"(hi)); return r; }
typedef float f32x2 __attribute__((ext_vector_type(2)));
__device__ __forceinline__ int lane_now() { int l; asm volatile("v_mbcnt_lo_u32_b32 %0, -1, 0\n\tv_mbcnt_hi_u32_b32 %0, -1, %0" : "=v"(l)); return l; }
typedef int v4i_t __attribute__((ext_vector_type(4)));
typedef int v8i_t __attribute__((ext_vector_type(8)));
__device__ __forceinline__ v8i_t cat8(bf16x8 a, bf16x8 b) { const v4i_t x = __builtin_bit_cast(v4i_t, a), y = __builtin_bit_cast(v4i_t, b); return __builtin_shufflevector(x, y, 0, 1, 2, 3, 4, 5, 6, 7); }
__device__ __forceinline__ void glds_sv(const char* base, unsigned voff, unsigned lds_dst) { unsigned keep;
    asm volatile("s_mov_b32 %0, m0\n\ts_mov_b32 m0, %3\n\ts_nop 0\n\tglobal_load_lds_dwordx4 %1, %2\n\ts_mov_b32 m0, %0" : "=&s"(keep) : "v"(voff), "s"(base), "s"(lds_dst) : "memory"); }
__device__ __forceinline__ float sat8(float x) { return __builtin_amdgcn_fmed3f(x, -448.0f, 448.0f); }
__device__ __forceinline__ unsigned pack4_fp8(float a, float b, float c, float d) { unsigned w = 0u; w = __builtin_amdgcn_cvt_pk_fp8_f32(sat8(a), sat8(b), w, false); w = __builtin_amdgcn_cvt_pk_fp8_f32(sat8(c), sat8(d), w, true); return w; }
constexpr float W13_SCALE = 64.0f, HB_SCALE = 8.0f, W2_SCALE = 32.0f;
__device__ __forceinline__ float sigmoid_f(float x) { return __builtin_amdgcn_rcpf(1.0f + __builtin_amdgcn_exp2f(-1.4426950408889634f * x)); }
__device__ __forceinline__ float gelu_tanh_f(float x) { const float u = x * (1.0f + 0.044715f * x * x); return x * __builtin_amdgcn_rcpf(1.0f + __builtin_amdgcn_exp2f(-2.3022081981f * u)); }
__device__ __forceinline__ float bf_lo(unsigned w) { return __builtin_bit_cast(float, w << 16); }
__device__ __forceinline__ float bf_hi(unsigned w) { return __builtin_bit_cast(float, w & 0xffff0000u); }
constexpr size_t SEGE = (size_t)32768 * 1024;

struct EpiZ {
    static constexpr bool PERM = true, AFTER_DRAIN = false; static constexpr int NSTORES = 16;
    bf16_t* ws5; bf16_t* out2; const float* rs; unsigned* norm; int probe;
    __device__ __forceinline__ void operator()(const f32x4 (&acc)[2][2][4][2], const Unit& u, int wr, int wc, int fr, int fq) const {
        const int seg = probe ? 0 : (u.pn >> 2); float nm[2] = {0.f, 0.f};
        const int sgo = u.pn >> 2; bf16_t* O = sgo < 5 ? ws5 + (size_t)sgo * SEGE : out2 + (size_t)(sgo - 5) * SEGE;
        const int row0 = u.pm * BM + wr * 64 + fr, col0 = (u.pn & 3) * BM + wc * 32 + 8 * fq;
#pragma unroll
        for (int ai = 0; ai < 2; ++ai)
#pragma unroll
            for (int m = 0; m < 4; ++m) { const int row = row0 + ai * HALF + m * 16; bf16_t* rowp = O + (size_t)row * 1024 + col0;
                const bool hm = (sgo >= 2 && sgo <= 4); bf16_t* rowh = O + ((size_t)((row >> 12) * 8 + 2 * (u.pn & 3)) * 4096 + (row & 4095)) * 128 + wc * 32 + 8 * fq;
#pragma unroll
                for (int bj = 0; bj < 2; ++bj) { f32x4 v0 = acc[ai][bj][m][0], v1 = acc[ai][bj][m][1];
                    if (seg == 1) {
#pragma unroll
                        for (int i = 0; i < 4; ++i) { v0[i] = gelu_tanh_f(v0[i]); v1[i] = gelu_tanh_f(v1[i]); } }
                    else if (seg >= 5) {
#pragma unroll
                        for (int i = 0; i < 4; ++i) { v0[i] = sigmoid_f(v0[i]); v1[i] = sigmoid_f(v1[i]); } }
                    if (seg == 2 || seg == 3) { float q = (v0[0] * v0[0] + v0[1] * v0[1]) + (v0[2] * v0[2] + v0[3] * v0[3]) + (v1[0] * v1[0] + v1[1] * v1[1]) + (v1[2] * v1[2] + v1[3] * v1[3]);
                        q += __shfl_xor(q, 16); q += __shfl_xor(q, 32); nm[bj] = fmaxf(nm[bj], q); }
                    u32x4 w; w.x = cvt_pk_bf16(v0[0], v0[1]); w.y = cvt_pk_bf16(v0[2], v0[3]); w.z = cvt_pk_bf16(v1[0], v1[1]); w.w = cvt_pk_bf16(v1[2], v1[3]);
                    *(u32x4*)(hm ? rowh + (size_t)bj * 4096 * 128 : rowp + bj * HALF) = w; } }
        if (seg == 2 || seg == 3) {
#pragma unroll
            for (int bj = 0; bj < 2; ++bj) { float q = nm[bj];
#pragma unroll
                for (int o = 1; o < 16; o <<= 1) q = fmaxf(q, __shfl_xor(q, o));
                if (fr == 0 && fq == 0) atomicMax(norm + ((((seg - 2) * 8 + (u.pm >> 4)) * 8 + 2 * (u.pn & 3) + bj) * 4 + wc), __float_as_uint(q)); }
        }
    }
};
template <int MODE> struct EpiGate {
    static constexpr bool PERM = true, AFTER_DRAIN = false; static constexpr int NSTORES = 16;
    const bf16_t* G; bf16_t* O;
    __device__ __forceinline__ void operator()(const f32x4 (&acc)[2][2][4][2], const Unit& u, int wr, int wc, int fr, int fq) const {
        const int row0 = u.pm * BM + wr * 64 + fr, col0 = u.pn * BM + wc * 32 + 8 * fq;
        u32x4 gv[2][2][2], pv[2][2][2];
#define EG_LOAD(st_, b_) do { _Pragma("unroll") for (int mm = 0; mm < 2; ++mm) _Pragma("unroll") for (int bj = 0; bj < 2; ++bj) { \
            const size_t off_ = (size_t)(row0 + ((st_) >> 1) * HALF + (2 * ((st_) & 1) + mm) * 16) * 1024 + col0 + bj * HALF; gv[b_][mm][bj] = __builtin_nontemporal_load((const u32x4*)(G + off_)); if (MODE == 1) pv[b_][mm][bj] = __builtin_nontemporal_load((const u32x4*)(O + off_)); } } while (0)
#define EG_DO(st_, b_) do { _Pragma("unroll") for (int mm = 0; mm < 2; ++mm) _Pragma("unroll") for (int bj = 0; bj < 2; ++bj) { const int ai = (st_) >> 1, m = 2 * ((st_) & 1) + mm; \
            const size_t off_ = (size_t)(row0 + ai * HALF + m * 16) * 1024 + col0 + bj * HALF; const u32x4 g = gv[b_][mm][bj]; \
            f32x4 v0 = acc[ai][bj][m][0], v1 = acc[ai][bj][m][1]; \
            v0[0] *= bf_lo(g.x); v0[1] *= bf_hi(g.x); v0[2] *= bf_lo(g.y); v0[3] *= bf_hi(g.y); v1[0] *= bf_lo(g.z); v1[1] *= bf_hi(g.z); v1[2] *= bf_lo(g.w); v1[3] *= bf_hi(g.w); \
            if (MODE == 1) { const u32x4 p = pv[b_][mm][bj]; \
                v0[0] += bf_lo(p.x); v0[1] += bf_hi(p.x); v0[2] += bf_lo(p.y); v0[3] += bf_hi(p.y); v1[0] += bf_lo(p.z); v1[1] += bf_hi(p.z); v1[2] += bf_lo(p.w); v1[3] += bf_hi(p.w); } \
            u32x4 w; w.x = cvt_pk_bf16(v0[0], v0[1]); w.y = cvt_pk_bf16(v0[2], v0[3]); w.z = cvt_pk_bf16(v1[0], v1[1]); w.w = cvt_pk_bf16(v1[2], v1[3]); \
            *(u32x4*)(O + off_) = w; } } while (0)
        EG_LOAD(0, 0); EG_LOAD(1, 1); EG_DO(0, 0); EG_LOAD(2, 0); EG_DO(1, 1); EG_LOAD(3, 1); EG_DO(2, 0); EG_DO(3, 1);
#undef EG_LOAD
#undef EG_DO
    }
};
struct TwoGemmOrder {
    StaticOrder base; int n1;
    __device__ void init(int M, int N, int G_, int c_) { base.init(M, N, G_, c_); n1 = (base.nwg - c_ + G_ - 1) / G_; if (n1 < 0) n1 = 0; }
    __device__ __forceinline__ bool next(int i, Unit& u) const { if (i >= 2 * n1) return false; const bool second = i >= n1; base.next(second ? i - n1 : i, u); if (second) { u.pm += 128; u.pn += 4; } return true; }
    __device__ __forceinline__ void a_ready(const Unit&) const {}
    __device__ __forceinline__ void done(const Unit&) const {}
};
struct EpiGate2 {
    static constexpr bool PERM = true, AFTER_DRAIN = false; static constexpr int NSTORES = 16;
    const bf16_t* G0; const bf16_t* G1; bf16_t* O;
    __device__ __forceinline__ void operator()(const f32x4 (&acc)[2][2][4][2], const Unit& u, int wr, int wc, int fr, int fq) const {
        Unit v; v.pm = u.pm & 127; v.pn = u.pn & 3;
        if (u.pm >= 128) { EpiGate<1> e{G1, O}; e(acc, v, wr, wc, fr, fq); } else { EpiGate<0> e{G0, O}; e(acc, v, wr, wc, fr, fq); }
    }
};
struct EpiDelta {
    static constexpr bool PERM = true, AFTER_DRAIN = false; static constexpr int NSTORES = 16;
    bf16_t* O;
    __device__ __forceinline__ void operator()(const f32x4 (&acc)[2][2][4][2], const Unit& u, int wr, int wc, int fr, int fq) const {
        const int row0 = u.pm * BM + wr * 64 + fr, col0 = u.pn * BM + wc * 32 + 8 * fq;
#pragma unroll
        for (int ai = 0; ai < 2; ++ai)
#pragma unroll
            for (int m = 0; m < 4; ++m) { bf16_t* rowp = O + (size_t)(row0 + ai * HALF + m * 16) * 1024 + col0;
#pragma unroll
                for (int bj = 0; bj < 2; ++bj) { const f32x4 v0 = acc[ai][bj][m][0], v1 = acc[ai][bj][m][1];
                    u32x4 w; w.x = cvt_pk_bf16(v0[0], v0[1]); w.y = cvt_pk_bf16(v0[2], v0[3]); w.z = cvt_pk_bf16(v1[0], v1[1]); w.w = cvt_pk_bf16(v1[2], v1[3]);
                    *(u32x4*)(rowp + bj * HALF) = w; } }
    }
};
struct EpiSwiGLU {
    static constexpr bool PERM = true, AFTER_DRAIN = false; static constexpr int NSTORES = 8;
    unsigned char* HB;
    __device__ __forceinline__ void operator()(const f32x4 (&acc)[2][2][4][2], const Unit& u, int wr, int wc, int fr, int fq, const PG8_LAS int* rows) const {
        const int row0 = u.pm * BM + wr * 64 + fr, col0 = (u.pn & 3) * HALF + wc * 32 + 8 * fq;
        float sv[2][4];
#pragma unroll
        for (int ai = 0; ai < 2; ++ai)
#pragma unroll
            for (int m = 0; m < 4; ++m) sv[ai][m] = ((const PG8_LAS float*)rows)[6 * 256 + wr * 64 + fr + ai * HALF + m * 16] * (1.0f / W13_SCALE);
#pragma unroll
        for (int ai = 0; ai < 2; ++ai)
#pragma unroll
            for (int m = 0; m < 4; ++m) { const int row = row0 + ai * HALF + m * 16; const float s = sv[ai][m];
                float o[8];
#pragma unroll
                for (int n = 0; n < 2; ++n)
#pragma unroll
                    for (int i = 0; i < 4; ++i) { const float g = acc[ai][0][m][n][i] * s, uu = acc[ai][1][m][n][i] * s; o[n * 4 + i] = g * sigmoid_f(g) * uu * HB_SCALE; }
                unsigned long long w = (unsigned long long)pack4_fp8(o[0], o[1], o[2], o[3]) | ((unsigned long long)pack4_fp8(o[4], o[5], o[6], o[7]) << 32);
                *(unsigned long long*)(HB + (size_t)row * 512 + col0) = w; }
    }
};
constexpr float Y_SCALE = 0.25f;
struct EpiY {
    static constexpr bool PERM = true, AFTER_DRAIN = false; static constexpr int NSTORES = 16;
    unsigned char* Y;
    __device__ __forceinline__ void operator()(const f32x4 (&acc)[2][2][4][2], const Unit& u, int wr, int wc, int fr, int fq) const {
        const int row0 = u.pm * BM + wr * 64 + fr, col0 = (u.pn & 3) * BM + wc * 32 + 8 * fq;
#pragma unroll
        for (int ai = 0; ai < 2; ++ai)
#pragma unroll
            for (int m = 0; m < 4; ++m) { const int row = row0 + ai * HALF + m * 16; unsigned char* rowp = Y + (size_t)row * 1024 + col0;
#pragma unroll
                for (int bj = 0; bj < 2; ++bj) { const f32x4 v0 = acc[ai][bj][m][0] * Y_SCALE, v1 = acc[ai][bj][m][1] * Y_SCALE;
                    *(unsigned long long*)(rowp + bj * HALF) = (unsigned long long)pack4_fp8(v0[0], v0[1], v0[2], v0[3]) | ((unsigned long long)pack4_fp8(v1[0], v1[1], v1[2], v1[3]) << 32); } }
    }
};
struct GroupedOrder {
    const PG8_LAS int* tile_e; int nunits, G, c;
    __device__ __forceinline__ bool next(int i, Unit& u) const { const int L = i * G + c; if (L >= nunits) return false; u.pm = L >> 2; u.pn = __builtin_amdgcn_readfirstlane(tile_e[u.pm]) * 4 + (L & 3); return true; }
    __device__ __forceinline__ void a_ready(const Unit&) const {}
    __device__ __forceinline__ void done(const Unit&) const {}
};
template <class Epi, class Sched, bool ALIGN_EPI = false, bool SP2 = false, bool F8 = false>
__device__ __forceinline__ void gemm_phase(PG8_LAS unsigned char* lds, const Gemm g, const Sched& S, const Epi& E, const int wid) {
    const int lane = lane_now(), tid = wid * 64 + lane, wr = wid >> 2, wc = wid & 3, fr = lane & 15, fq = lane >> 4;
    const int K = g.K, nt = K / BK;
    unsigned voffA[2], voffB[2];
#pragma unroll
    for (int i = 0; i < 2; ++i) { int R, C; stage_rc(tid * 16 + i * 8192, R, C); const int Rb = Epi::PERM ? ((R & ~31) + perm32(R & 31)) : R;
        voffA[i] = (unsigned)(R * K + C) * 2u; voffB[i] = (unsigned)(Rb * K + C) * 2u; }
    const size_t kstep = (size_t)(BK * 2);
    const size_t hstep = (size_t)HALF * K * 2;
    const size_t tstep = 2 * hstep;
    const unsigned ldsw = (unsigned)wid * 1024u;
    const unsigned ldsbase = (unsigned)__builtin_amdgcn_readfirstlane((int)((unsigned)(uintptr_t)lds + ldsw));
    const int aoff = lds_byte(wr * 64 + fr, fq * 8), boff = lds_byte(wc * 32 + fr, fq * 8);
#define PG8_SA(b, h) (((b) * 2 + (h)) * HTB)
#define PG8_SB(b, h) ((4 + (b) * 2 + (h)) * HTB)
#define PG8_STAGE(bufoff, gbase, voff) do { _Pragma("unroll") for (int _i = 0; _i < 2; ++_i) { \
        if constexpr (F8) glds_sv((const char*)(gbase), (voff)[_i], ldsbase + (unsigned)((bufoff) + _i * 8192)); \
        else __builtin_amdgcn_global_load_lds((const unsigned*)((const char*)(gbase) + (voff)[_i]), (PG8_LAS unsigned*)(lds + (bufoff) + ldsw + _i * 8192), 16, 0, 0); } } while (0)
#define PG8_LDA(dst, b, h) do { _Pragma("unroll") for (int m = 0; m < 4; ++m) { \
        if constexpr (F8) { dst##8[m] = cat8(*(const PG8_LAS bf16x8*)(lds + PG8_SA(b, h) + aoff + m * 2048), *(const PG8_LAS bf16x8*)(lds + PG8_SA(b, h) + aoff + m * 2048 + 1024)); } \
        else { _Pragma("unroll") for (int k = 0; k < 2; ++k) dst[m][k] = *(const PG8_LAS bf16x8*)(lds + PG8_SA(b, h) + aoff + m * 2048 + k * 1024); } } } while (0)
#define PG8_LDB(dst, b, h) do { _Pragma("unroll") for (int n = 0; n < 2; ++n) { \
        if constexpr (F8) { dst##8[n] = cat8(*(const PG8_LAS bf16x8*)(lds + PG8_SB(b, h) + boff + n * 2048), *(const PG8_LAS bf16x8*)(lds + PG8_SB(b, h) + boff + n * 2048 + 1024)); } \
        else { _Pragma("unroll") for (int k = 0; k < 2; ++k) dst[n][k] = *(const PG8_LAS bf16x8*)(lds + PG8_SB(b, h) + boff + n * 2048 + k * 1024); } } } while (0)
#define PG8_MMA(ai, bj, At, Bt) do { __builtin_amdgcn_s_setprio(1); _Pragma("unroll") for (int m = 0; m < 4; ++m) _Pragma("unroll") for (int n = 0; n < 2; ++n) { \
        if constexpr (F8) { acc[ai][bj][m][n] = __builtin_amdgcn_mfma_scale_f32_16x16x128_f8f6f4(Bt##8[n], At##8[m], acc[ai][bj][m][n], 0, 0, 0, 0, 0, 0); } \
        else { _Pragma("unroll") for (int k = 0; k < 2; ++k) acc[ai][bj][m][n] = __builtin_amdgcn_mfma_f32_16x16x32_bf16(Bt[n][k], At[m][k], acc[ai][bj][m][n], 0, 0, 0); } } \
        __builtin_amdgcn_s_setprio(0); } while (0)
#define PG8_WAIT_V(n) asm volatile("s_waitcnt vmcnt(" #n ")" ::: "memory")
#define PG8_WAIT_L(n) asm volatile("s_waitcnt lgkmcnt(" #n ")" ::: "memory")
#define PG8_BAR __builtin_amdgcn_s_barrier()
#define PG8_SCHED __builtin_amdgcn_sched_barrier(0)
    Unit cur, nxt; int ui = 0;
    if (!S.next(0, cur)) return;
    f32x4 acc[2][2][4][2];
#pragma unroll
    for (int a = 0; a < 2; ++a)
#pragma unroll
        for (int b = 0; b < 2; ++b)
#pragma unroll
            for (int m = 0; m < 4; ++m)
#pragma unroll
                for (int n = 0; n < 2; ++n) acc[a][b][m][n] = (f32x4){0.f, 0.f, 0.f, 0.f};
    bf16x8 At[4][2], B0[2][2], B1[2][2]; v8i_t At8[4], B08[2], B18[2];
    const char* cA = (const char*)g.A + (size_t)cur.pm * tstep; const char* cB = (const char*)g.Bt + (size_t)cur.pn * tstep;
    S.a_ready(cur);
    if constexpr (SP2) {
        PG8_STAGE(PG8_SB(0, 0), cB, voffB); PG8_STAGE(PG8_SB(0, 1), cB + hstep, voffB); PG8_STAGE(PG8_SA(0, 0), cA, voffA); PG8_STAGE(PG8_SA(0, 1), cA + hstep, voffA);
        if (wr == 1) PG8_BAR;
        PG8_WAIT_V(2); PG8_BAR;
        PG8_STAGE(PG8_SB(1, 0), cB + kstep, voffB); PG8_STAGE(PG8_SA(1, 0), cA + kstep, voffA); PG8_STAGE(PG8_SB(1, 1), cB + hstep + kstep, voffB);
        PG8_WAIT_V(6); PG8_BAR;
    } else {
        PG8_STAGE(PG8_SB(0, 0), cB, voffB); PG8_STAGE(PG8_SA(0, 0), cA, voffA); PG8_STAGE(PG8_SB(0, 1), cB + hstep, voffB); PG8_STAGE(PG8_SA(0, 1), cA + hstep, voffA);
        if (wr == 1) PG8_BAR;
        PG8_WAIT_V(4); PG8_BAR;
        PG8_STAGE(PG8_SB(1, 0), cB + kstep, voffB); PG8_STAGE(PG8_SA(1, 0), cA + kstep, voffA); PG8_STAGE(PG8_SB(1, 1), cB + hstep + kstep, voffB);
        PG8_WAIT_V(6); PG8_BAR;
    }
    for (;;) {
        const bool has_next = S.next(ui + 1, nxt);
        const char* nA = has_next ? (const char*)g.A + (size_t)nxt.pm * tstep : cA; const char* nB = has_next ? (const char*)g.Bt + (size_t)nxt.pn * tstep : cB;
#pragma clang loop unroll(disable)
        for (int t = 0; t < nt; t += 2) {
            const bool last = (t == nt - 2);
            const char* a1 = cA + (size_t)(t + 1) * kstep;
            const char* a2 = last ? nA : cA + (size_t)(t + 2) * kstep; const char* b2 = last ? nB : cB + (size_t)(t + 2) * kstep;
            const char* a3 = a2 + kstep; const char* b3 = b2 + kstep;
            if (last && has_next) S.a_ready(nxt);
            if constexpr (SP2) {
            PG8_LDB(B0, 0, 0); PG8_LDB(B1, 0, 1); PG8_SCHED; PG8_LDA(At, 0, 0); PG8_STAGE(PG8_SA(1, 1), a1 + hstep, voffA);
            PG8_WAIT_V(8); PG8_WAIT_L(0); PG8_BAR; PG8_MMA(0, 0, At, B0); PG8_MMA(0, 1, At, B1); PG8_BAR; PG8_SCHED;
            PG8_LDA(At, 0, 1); PG8_STAGE(PG8_SB(0, 0), b2, voffB); PG8_STAGE(PG8_SB(0, 1), b2 + hstep, voffB); PG8_STAGE(PG8_SA(0, 0), a2, voffA);
            PG8_WAIT_V(8); PG8_WAIT_L(0); PG8_BAR; PG8_MMA(1, 0, At, B0); PG8_MMA(1, 1, At, B1); PG8_BAR; PG8_SCHED;
            PG8_LDB(B0, 1, 0); PG8_LDB(B1, 1, 1); PG8_SCHED; PG8_LDA(At, 1, 0); PG8_STAGE(PG8_SA(0, 1), a2 + hstep, voffA);
            PG8_WAIT_V(8); PG8_WAIT_L(0); PG8_BAR; PG8_MMA(0, 0, At, B0); PG8_MMA(0, 1, At, B1); PG8_BAR; PG8_SCHED;
            PG8_LDA(At, 1, 1); PG8_STAGE(PG8_SB(1, 0), b3, voffB); PG8_STAGE(PG8_SB(1, 1), b3 + hstep, voffB); PG8_STAGE(PG8_SA(1, 0), a3, voffA);
            PG8_WAIT_V(8); PG8_WAIT_L(0); PG8_BAR; PG8_MMA(1, 0, At, B0); PG8_MMA(1, 1, At, B1); PG8_BAR; PG8_SCHED;
            } else {
            PG8_LDB(B0, 0, 0); PG8_SCHED; PG8_LDA(At, 0, 0); PG8_STAGE(PG8_SA(1, 1), a1 + hstep, voffA);
            PG8_WAIT_L(8); PG8_BAR; PG8_WAIT_L(0); PG8_MMA(0, 0, At, B0); PG8_BAR; PG8_SCHED;
            PG8_LDB(B1, 0, 1); PG8_STAGE(PG8_SB(0, 0), b2, voffB);
            PG8_BAR; PG8_WAIT_L(0); PG8_MMA(0, 1, At, B1); PG8_BAR;
            PG8_LDA(At, 0, 1); PG8_STAGE(PG8_SA(0, 0), a2, voffA);
            PG8_BAR; PG8_WAIT_L(0); PG8_MMA(1, 0, At, B0); PG8_BAR; PG8_SCHED;
            PG8_STAGE(PG8_SB(0, 1), b2 + hstep, voffB);
            PG8_WAIT_V(6); PG8_BAR; PG8_MMA(1, 1, At, B1); PG8_BAR;
            PG8_LDB(B0, 1, 0); PG8_SCHED; PG8_LDA(At, 1, 0); PG8_STAGE(PG8_SA(0, 1), a2 + hstep, voffA);
            PG8_WAIT_L(8); PG8_BAR; PG8_WAIT_L(0); PG8_MMA(0, 0, At, B0); PG8_BAR; PG8_SCHED;
            PG8_LDB(B1, 1, 1); PG8_STAGE(PG8_SB(1, 0), b3, voffB);
            PG8_BAR; PG8_WAIT_L(0); PG8_MMA(0, 1, At, B1); PG8_BAR;
            PG8_LDA(At, 1, 1); PG8_STAGE(PG8_SA(1, 0), a3, voffA);
            PG8_BAR; PG8_WAIT_L(0); PG8_MMA(1, 0, At, B0); PG8_BAR; PG8_SCHED;
            PG8_STAGE(PG8_SB(1, 1), b3 + hstep, voffB);
            PG8_WAIT_V(6); PG8_BAR; PG8_MMA(1, 1, At, B1); PG8_BAR;
            }
        }
        if constexpr (ALIGN_EPI) { if (wr == 0) PG8_BAR; }
        if constexpr (!Epi::AFTER_DRAIN) { const int l2 = lane_now(); E(acc, cur, wr, wc, l2 & 15, l2 >> 4); S.done(cur); }
        if (!has_next) break;
#pragma unroll
        for (int a = 0; a < 2; ++a)
#pragma unroll
            for (int b = 0; b < 2; ++b)
#pragma unroll
                for (int m = 0; m < 4; ++m)
#pragma unroll
                    for (int n = 0; n < 2; ++n) acc[a][b][m][n] = (f32x4){0.f, 0.f, 0.f, 0.f};
        cur = nxt; cA = nA; cB = nB; ++ui;
        if constexpr (ALIGN_EPI) { if (wr == 1) PG8_BAR; }
    }
    PG8_WAIT_V(0);
    if constexpr (!ALIGN_EPI) { if (wr == 0) PG8_BAR; }
    PG8_BAR;
    if constexpr (Epi::AFTER_DRAIN) { E.fused(acc, cur, wr, wc, fr, fq, lds, wid, lane); S.done(cur); }
#undef PG8_SA
#undef PG8_SB
#undef PG8_STAGE
#undef PG8_LDA
#undef PG8_LDB
#undef PG8_MMA
#undef PG8_WAIT_V
#undef PG8_WAIT_L
#undef PG8_BAR
#undef PG8_SCHED
}
template <class Epi, class Sched, bool F8 = false>
__device__ __forceinline__ void gemm_phase_gather(PG8_LAS unsigned char* lds, const Gemm g, const Sched& S, const Epi& E, const PG8_LAS int* rowtab, const int wid) {
    constexpr bool ALIGN_EPI = true, SP2 = true;
    const int lane = lane_now(), tid = wid * 64 + lane, wr = wid >> 2, wc = wid & 3, fr = lane & 15, fq = lane >> 4;
    const int K = g.K, nt = K / BK;
    unsigned voffB[2], vAc[2][2];
#pragma unroll
    for (int i = 0; i < 2; ++i) { int R, C; stage_rc(tid * 16 + i * 8192, R, C); const int Rb = Epi::PERM ? ((R & ~31) + perm32(R & 31)) : R;
        voffB[i] = (unsigned)(Rb * K + C) * 2u; }
#define PG8_ROWS(dst, ui_) do { const int t_ = wid * 64 + lane_now(); _Pragma("unroll") for (int i_ = 0; i_ < 2; ++i_) { int R_, C_; stage_rc(t_ * 16 + i_ * 8192, R_, C_); \
        _Pragma("unroll") for (int h_ = 0; h_ < 2; ++h_) dst[h_][i_] = (unsigned)rowtab[(ui_) * 256 + h_ * HALF + R_] * (unsigned)(K * 2) + (unsigned)(C_ * 2); } } while (0)
#define PG8_STAGE_A(bufoff, v, kb) do { _Pragma("unroll") for (int _i = 0; _i < 2; ++_i) { \
        if constexpr (F8) glds_sv((const char*)g.A + (kb), (v)[_i], ldsbase + (unsigned)((bufoff) + _i * 8192)); \
        else __builtin_amdgcn_global_load_lds((const unsigned*)((const char*)g.A + (v)[_i] + (kb)), (PG8_LAS unsigned*)(lds + (bufoff) + ldsw + _i * 8192), 16, 0, 0); } } while (0)
    const size_t kstep = (size_t)(BK * 2);
    const size_t hstep = (size_t)HALF * K * 2;
    const size_t tstep = 2 * hstep;
    const unsigned ldsw = (unsigned)wid * 1024u;
    const unsigned ldsbase = (unsigned)__builtin_amdgcn_readfirstlane((int)((unsigned)(uintptr_t)lds + ldsw));
    const int aoff = lds_byte(wr * 64 + fr, fq * 8), boff = lds_byte(wc * 32 + fr, fq * 8);
#define PG8_SA(b, h) (((b) * 2 + (h)) * HTB)
#define PG8_SB(b, h) ((4 + (b) * 2 + (h)) * HTB)
#define PG8_STAGE(bufoff, gbase, voff) do { _Pragma("unroll") for (int _i = 0; _i < 2; ++_i) { \
        if constexpr (F8) glds_sv((const char*)(gbase), (voff)[_i], ldsbase + (unsigned)((bufoff) + _i * 8192)); \
        else __builtin_amdgcn_global_load_lds((const unsigned*)((const char*)(gbase) + (voff)[_i]), (PG8_LAS unsigned*)(lds + (bufoff) + ldsw + _i * 8192), 16, 0, 0); } } while (0)
#define PG8_LDA(dst, b, h) do { _Pragma("unroll") for (int m = 0; m < 4; ++m) { \
        if constexpr (F8) { dst##8[m] = cat8(*(const PG8_LAS bf16x8*)(lds + PG8_SA(b, h) + aoff + m * 2048), *(const PG8_LAS bf16x8*)(lds + PG8_SA(b, h) + aoff + m * 2048 + 1024)); } \
        else { _Pragma("unroll") for (int k = 0; k < 2; ++k) dst[m][k] = *(const PG8_LAS bf16x8*)(lds + PG8_SA(b, h) + aoff + m * 2048 + k * 1024); } } } while (0)
#define PG8_LDB(dst, b, h) do { _Pragma("unroll") for (int n = 0; n < 2; ++n) { \
        if constexpr (F8) { dst##8[n] = cat8(*(const PG8_LAS bf16x8*)(lds + PG8_SB(b, h) + boff + n * 2048), *(const PG8_LAS bf16x8*)(lds + PG8_SB(b, h) + boff + n * 2048 + 1024)); } \
        else { _Pragma("unroll") for (int k = 0; k < 2; ++k) dst[n][k] = *(const PG8_LAS bf16x8*)(lds + PG8_SB(b, h) + boff + n * 2048 + k * 1024); } } } while (0)
#define PG8_MMA(ai, bj, At, Bt) do { __builtin_amdgcn_s_setprio(1); _Pragma("unroll") for (int m = 0; m < 4; ++m) _Pragma("unroll") for (int n = 0; n < 2; ++n) { \
        if constexpr (F8) { acc[ai][bj][m][n] = __builtin_amdgcn_mfma_scale_f32_16x16x128_f8f6f4(Bt##8[n], At##8[m], acc[ai][bj][m][n], 0, 0, 0, 0, 0, 0); } \
        else { _Pragma("unroll") for (int k = 0; k < 2; ++k) acc[ai][bj][m][n] = __builtin_amdgcn_mfma_f32_16x16x32_bf16(Bt[n][k], At[m][k], acc[ai][bj][m][n], 0, 0, 0); } } \
        __builtin_amdgcn_s_setprio(0); } while (0)
#define PG8_WAIT_V(n) asm volatile("s_waitcnt vmcnt(" #n ")" ::: "memory")
#define PG8_WAIT_L(n) asm volatile("s_waitcnt lgkmcnt(" #n ")" ::: "memory")
#define PG8_BAR __builtin_amdgcn_s_barrier()
#define PG8_SCHED __builtin_amdgcn_sched_barrier(0)
    Unit cur, nxt; int ui = 0;
    if (!S.next(0, cur)) return;
    f32x4 acc[2][2][4][2];
#pragma unroll
    for (int a = 0; a < 2; ++a)
#pragma unroll
        for (int b = 0; b < 2; ++b)
#pragma unroll
            for (int m = 0; m < 4; ++m)
#pragma unroll
                for (int n = 0; n < 2; ++n) acc[a][b][m][n] = (f32x4){0.f, 0.f, 0.f, 0.f};
    bf16x8 At[4][2], B0[2][2], B1[2][2]; v8i_t At8[4], B08[2], B18[2];
    const char* cB = (const char*)g.Bt + (size_t)cur.pn * tstep;
    PG8_ROWS(vAc, 0);
    S.a_ready(cur);
    if constexpr (SP2) {
        PG8_STAGE(PG8_SB(0, 0), cB, voffB); PG8_STAGE(PG8_SB(0, 1), cB + hstep, voffB); PG8_STAGE_A(PG8_SA(0, 0), vAc[0], 0u); PG8_STAGE_A(PG8_SA(0, 1), vAc[1], 0u);
        if (wr == 1) PG8_BAR;
        PG8_WAIT_V(2); PG8_BAR;
        PG8_STAGE(PG8_SB(1, 0), cB + kstep, voffB); PG8_STAGE_A(PG8_SA(1, 0), vAc[0], (unsigned)kstep); PG8_STAGE(PG8_SB(1, 1), cB + hstep + kstep, voffB);
        PG8_WAIT_V(6); PG8_BAR;
    }
    for (;;) {
        const bool has_next = S.next(ui + 1, nxt);
        const char* nB = has_next ? (const char*)g.Bt + (size_t)nxt.pn * tstep : cB;
#pragma clang loop unroll(disable)
        for (int t = 0; t < nt; t += 2) {
            const bool last = (t == nt - 2);
            const unsigned k1 = (unsigned)((t + 1) * (int)kstep), k2 = last ? 0u : (unsigned)((t + 2) * (int)kstep), k3 = k2 + (unsigned)kstep;
            unsigned v2[2][2];
            if (last && has_next) { PG8_ROWS(v2, ui + 1); }
            else {
#pragma unroll
                for (int h_ = 0; h_ < 2; ++h_)
#pragma unroll
                    for (int i_ = 0; i_ < 2; ++i_) v2[h_][i_] = vAc[h_][i_]; }
            const char* b2 = last ? nB : cB + (size_t)(t + 2) * kstep; const char* b3 = b2 + kstep;
            if (last && has_next) S.a_ready(nxt);
            if constexpr (SP2) {
            PG8_LDB(B0, 0, 0); PG8_LDB(B1, 0, 1); PG8_SCHED; PG8_LDA(At, 0, 0); PG8_STAGE_A(PG8_SA(1, 1), vAc[1], k1);
            PG8_WAIT_V(8); PG8_WAIT_L(0); PG8_BAR; PG8_MMA(0, 0, At, B0); PG8_MMA(0, 1, At, B1); PG8_BAR; PG8_SCHED;
            PG8_LDA(At, 0, 1); PG8_STAGE(PG8_SB(0, 0), b2, voffB); PG8_STAGE(PG8_SB(0, 1), b2 + hstep, voffB); PG8_STAGE_A(PG8_SA(0, 0), v2[0], k2);
            PG8_WAIT_V(8); PG8_WAIT_L(0); PG8_BAR; PG8_MMA(1, 0, At, B0); PG8_MMA(1, 1, At, B1); PG8_BAR; PG8_SCHED;
            PG8_LDB(B0, 1, 0); PG8_LDB(B1, 1, 1); PG8_SCHED; PG8_LDA(At, 1, 0); PG8_STAGE_A(PG8_SA(0, 1), v2[1], k2);
            PG8_WAIT_V(8); PG8_WAIT_L(0); PG8_BAR; PG8_MMA(0, 0, At, B0); PG8_MMA(0, 1, At, B1); PG8_BAR; PG8_SCHED;
            PG8_LDA(At, 1, 1); PG8_STAGE(PG8_SB(1, 0), b3, voffB); PG8_STAGE(PG8_SB(1, 1), b3 + hstep, voffB); PG8_STAGE_A(PG8_SA(1, 0), v2[0], k3);
            PG8_WAIT_V(8); PG8_WAIT_L(0); PG8_BAR; PG8_MMA(1, 0, At, B0); PG8_MMA(1, 1, At, B1); PG8_BAR; PG8_SCHED;
            }
        }
        if constexpr (ALIGN_EPI) { if (wr == 0) PG8_BAR; }
        { const int l2 = lane_now(); E(acc, cur, wr, wc, l2 & 15, l2 >> 4, rowtab + ui * 256); } S.done(cur);
        if (!has_next) break;
#pragma unroll
        for (int a = 0; a < 2; ++a)
#pragma unroll
            for (int b = 0; b < 2; ++b)
#pragma unroll
                for (int m = 0; m < 4; ++m)
#pragma unroll
                    for (int n = 0; n < 2; ++n) acc[a][b][m][n] = (f32x4){0.f, 0.f, 0.f, 0.f};
        cur = nxt; cB = nB; ++ui;
        PG8_ROWS(vAc, ui);
        if constexpr (ALIGN_EPI) { if (wr == 1) PG8_BAR; }
    }
    PG8_WAIT_V(0);
    if constexpr (!ALIGN_EPI) { if (wr == 0) PG8_BAR; }
    PG8_BAR;
#undef PG8_ROWS
#undef PG8_STAGE_A
#undef PG8_SA
#undef PG8_SB
#undef PG8_STAGE
#undef PG8_LDA
#undef PG8_LDB
#undef PG8_MMA
#undef PG8_WAIT_V
#undef PG8_WAIT_L
#undef PG8_BAR
#undef PG8_SCHED
}
}
#define GAS __attribute__((address_space(1)))
#define LAS __attribute__((address_space(3)))
typedef unsigned short bf16;
typedef unsigned v4u __attribute__((ext_vector_type(4)));
typedef float f32x4 __attribute__((ext_vector_type(4)));
typedef short bf16x8 __attribute__((ext_vector_type(8)));
typedef GAS unsigned gu32;
typedef GAS unsigned long long gu64;
#define RLX_AGENT __ATOMIC_RELAXED, __HIP_MEMORY_SCOPE_AGENT
#define LDS_WAIT() asm volatile("s_waitcnt lgkmcnt(0)" ::: "memory")
#define VM_WAIT() asm volatile("s_waitcnt vmcnt(0)" ::: "memory")
__device__ __forceinline__ unsigned long long rt() { return __builtin_amdgcn_s_memrealtime(); }
__device__ __forceinline__ unsigned f2bf(float f) { unsigned u = __builtin_bit_cast(unsigned, f); return (u + 0x7fffu + ((u >> 16) & 1u)) >> 16; }
__device__ __forceinline__ unsigned pk2(float lo, float hi) { return f2bf(lo) | (f2bf(hi) << 16); }
#define XB_TMO      128
#define XB_XCNT(j)  (256  + 64 * (j))
#define XB_XSUB(j)  (1280 + 64 * (j))
#define XB_XGEN(j)  (2304 + 64 * (j))
#define XB_TOP      3328
#define XB_TOPGEN   3392
#define XCD_BAR_WORDS 3456
#define XB_SPIN_CAP (1u << 18)

__device__ __forceinline__ unsigned xb_ld(unsigned* p)              { return __hip_atomic_load(p, __ATOMIC_RELAXED, __HIP_MEMORY_SCOPE_AGENT); }
__device__ __forceinline__ unsigned xb_add(unsigned* p, unsigned v) { return __hip_atomic_fetch_add(p, v, __ATOMIC_RELAXED, __HIP_MEMORY_SCOPE_AGENT); }
__device__ __forceinline__ unsigned xb_xcc_id() { return (unsigned)__builtin_amdgcn_s_getreg((3 << 11) | 20) & 0xFu; }
#define XB_SPIN(cond, bar) do { unsigned _sp = 0; while (cond) { __builtin_amdgcn_s_sleep(1); \
    if ((++_sp & 255u) == 0u) { if (xb_ld(&(bar)[XB_TMO])) break; if (_sp > XB_SPIN_CAP) { atomicAdd(&(bar)[XB_TMO], 1u); break; } } } } while (0)

struct XcdBarrier {
    unsigned* bar; unsigned x;
    volatile LAS unsigned* st;
};

__device__ __forceinline__ XcdBarrier xcd_barrier_post(unsigned* bar, volatile LAS unsigned* st) {
    XcdBarrier b; b.bar = bar; b.x = xb_xcc_id(); b.st = st;
    if (threadIdx.x == 0) (void)xb_add(&bar[XB_XCNT(b.x)], 1u);
    return b;
}
__device__ __forceinline__ void xcd_barrier_complete(unsigned* bar, unsigned x, unsigned& nloc, unsigned& nx) {
    const unsigned G = gridDim.x * gridDim.y * gridDim.z;
    unsigned sum, cnt, mine, sp = 0u;
    for (;;) {
        sum = 0u; cnt = 0u; mine = 0u;
#pragma unroll
        for (unsigned j = 0; j < 16; ++j) { const unsigned c = xb_ld(&bar[XB_XCNT(j)]); sum += c; cnt += (c > 0u) ? 1u : 0u; mine = (j == x) ? c : mine; }
        if (sum == G) break;
        __builtin_amdgcn_s_sleep(1);
        if ((++sp & 255u) == 0u) { if (xb_ld(&bar[XB_TMO])) break; if (sp > XB_SPIN_CAP) { atomicAdd(&bar[XB_TMO], 1u); break; } }
    }
    nloc = mine > 0u ? mine : 1u; nx = cnt > 0u ? cnt : 1u;
}

__device__ __forceinline__ void xcd_barrier(const XcdBarrier& b) {
    asm volatile("s_waitcnt vmcnt(0)" ::: "memory");
    __syncthreads();
    if (threadIdx.x == 0) {
        unsigned* bar = b.bar;
        __builtin_amdgcn_s_waitcnt(0);
        unsigned nloc = b.st[0], nx = b.st[1];
        if (nloc == 0u) { xcd_barrier_complete(bar, b.x, nloc, nx); b.st[0] = nloc; b.st[1] = nx; }
        const unsigned old = xb_add(&bar[XB_XSUB(b.x)], 1u);
        const unsigned gen = old / nloc;
        if (old + 1u == (gen + 1u) * nloc) {
            __builtin_amdgcn_fence(__ATOMIC_RELEASE, "agent");
            asm volatile("s_waitcnt vmcnt(0)" ::: "memory");
            const unsigned og = xb_add(&bar[XB_TOP], 1u);
            const unsigned tg = og / nx;
            if (og + 1u == (tg + 1u) * nx) xb_add(&bar[XB_TOPGEN], 1u);
            else XB_SPIN(xb_ld(&bar[XB_TOPGEN]) == tg, bar);
            __builtin_amdgcn_fence(__ATOMIC_ACQUIRE, "agent");
            xb_add(&bar[XB_XGEN(b.x)], 1u);
            asm volatile("s_waitcnt vmcnt(0)" ::: "memory");
        } else {
            XB_SPIN(xb_ld(&bar[XB_XGEN(b.x)]) == gen, bar);
            __builtin_amdgcn_fence(__ATOMIC_ACQUIRE, "agent");
            asm volatile("s_waitcnt vmcnt(0)" ::: "memory");
        }
    }
    __syncthreads();
}
namespace fattn {
typedef unsigned short bf16;
typedef short bf16x8 __attribute__((ext_vector_type(8)));
typedef short s16x4 __attribute__((ext_vector_type(4)));
typedef float f32x16 __attribute__((ext_vector_type(16)));
typedef float f32x4 __attribute__((ext_vector_type(4)));
typedef unsigned u32x4 __attribute__((ext_vector_type(4)));
constexpr int D = 128, LD = 128, LDO = 1024, SEQ = 4096;
constexpr float THR = 8.f;
constexpr float SCALE = 0.08838834764831845f;
constexpr int NW = 8, QBLK = 32, KVBLK = 64, QB = NW * QBLK;
constexpr int SHM_V = KVBLK * D * 2, SHM_K = KVBLK * D * 2;
constexpr int OFF_WS = 2 * SHM_V + 2 * SHM_K, OFF_BIAS = OFF_WS + NW * 64 * 4, LDS_BYTES = OFF_BIAS + 2 * 64 * 4;

#define KSWZ(row, colB) ((row) * 256 + ((colB) ^ (((row) & 7) << 4)))
#define SBAR() __builtin_amdgcn_sched_barrier(0)
__device__ __forceinline__ int v_st(int k, int c) { const int kk = (k & ~0xC) | ((k & 4) << 1) | ((k & 8) >> 1); return ((kk >> 3) * 4 + (c >> 5)) * 512 + ((kk & 7) * 32 + (c & 31)) * 2; }
__device__ __forceinline__ int v_rd_base(int lane) { return ((lane & 3) << 3) | (((lane >> 2) & 3) << 6) | (((lane >> 4) & 1) << 5) | (((lane >> 5) & 1) << 8); }
constexpr int v_rd_off(int d0, int ks, int half) { return d0 * 512 + ks * 4096 + half * 2048; }
__device__ __forceinline__ int crow(int r, int hi) { return (r & 3) + 8 * (r >> 2) + 4 * hi; }
__device__ __forceinline__ unsigned cvtpk(float lo, float hi) { unsigned r; asm volatile("v_cvt_pk_bf16_f32 %0, %1, %2" : "=v"(r) : "v"(lo), "v"(hi)); return r; }
__device__ __forceinline__ bf16x8 load8(const bf16* p) { return *reinterpret_cast<const bf16x8*>(p); }
__device__ __forceinline__ void mask_tile(f32x16& p0, f32x16& p1, int dq) {
    const float NEG = -__builtin_inff();
#pragma unroll
    for (int r = 0; r < 16; ++r) {
        const int c = (r & 3) + 8 * (r >> 2);
        if (dq - c < 0) p0[r] = NEG;
        if (dq - c - 32 < 0) p1[r] = NEG;
    }
}
__device__ __forceinline__ void partialSM(f32x16& p0, f32x16& p1, float& m_reg, float& mn, float& alpha) {
    float pmax = p0[0]; for (int r = 1; r < 16; ++r) pmax = fmaxf(pmax, p0[r]); for (int r = 0; r < 16; ++r) pmax = fmaxf(pmax, p1[r]);
    { auto rr = __builtin_amdgcn_permlane32_swap(__float_as_uint(pmax), __float_as_uint(pmax), false, false);
      pmax = fmaxf(__uint_as_float(rr[0]), __uint_as_float(rr[1])); }
    constexpr float C2 = 1.4426950408889634f * SCALE;
    if (__builtin_expect(__all((pmax - m_reg) * SCALE <= THR), 1)) { mn = m_reg; alpha = 1.f; }
    else { mn = fmaxf(m_reg, pmax); alpha = __builtin_amdgcn_exp2f((m_reg - mn) * C2); m_reg = mn; }
    const float mnL = -mn * C2;
    for (int r = 0; r < 16; ++r) p0[r] = fmaf(p0[r], C2, mnL); for (int r = 0; r < 16; ++r) p1[r] = fmaf(p1[r], C2, mnL);
    for (int r = 0; r < 16; ++r) p0[r] = __builtin_amdgcn_exp2f(p0[r]);
}
__device__ __forceinline__ void finishSM(f32x16& p0, f32x16& p1, float alpha, float& l_reg, bf16x8& pa0, bf16x8& pa1, bf16x8& pa2, bf16x8& pa3) {
    for (int r = 0; r < 16; ++r) p1[r] = __builtin_amdgcn_exp2f(p1[r]);
    float ps = 0; for (int r = 0; r < 16; ++r) ps += p0[r]; for (int r = 0; r < 16; ++r) ps += p1[r];
    { auto rr = __builtin_amdgcn_permlane32_swap(__float_as_uint(ps), __float_as_uint(ps), false, false);
      ps = __uint_as_float(rr[0]) + __uint_as_float(rr[1]); }
    l_reg = l_reg * alpha + ps;
#define PK4(P, B_, OUT) do { unsigned a0 = cvtpk(P[B_+0], P[B_+1]), a1 = cvtpk(P[B_+2], P[B_+3]);                          \
        unsigned b0 = cvtpk(P[B_+4], P[B_+5]), b1 = cvtpk(P[B_+6], P[B_+7]);                                             \
        auto r0 = __builtin_amdgcn_permlane32_swap(a0, b0, false, false); auto r1 = __builtin_amdgcn_permlane32_swap(a1, b1, false, false); \
        u32x4 w = {r0[0], r1[0], r0[1], r1[1]}; OUT = *reinterpret_cast<bf16x8*>(&w); } while (0)
    PK4(p0, 0, pa0); PK4(p0, 8, pa1); PK4(p1, 0, pa2); PK4(p1, 8, pa3);
#undef PK4
}
template <int KB>
__device__ __forceinline__ void qkt(f32x16& p0, f32x16& p1, const char* K_lds, const char* Bias_lds, int r32, int hi, const bf16x8* qr) {
    { const f32x4* bb = reinterpret_cast<const f32x4*>(Bias_lds + KB * 256 + hi * 16);
      const f32x4 a0 = bb[0], a1 = bb[2], a2 = bb[4], a3 = bb[6], c0 = bb[8], c1 = bb[10], c2 = bb[12], c3 = bb[14];
      p0 = (f32x16){a0[0], a0[1], a0[2], a0[3], a1[0], a1[1], a1[2], a1[3], a2[0], a2[1], a2[2], a2[3], a3[0], a3[1], a3[2], a3[3]};
      p1 = (f32x16){c0[0], c0[1], c0[2], c0[3], c1[0], c1[1], c1[2], c1[3], c2[0], c2[1], c2[2], c2[3], c3[0], c3[1], c3[2], c3[3]}; }
    const char* kb[4];
#pragma unroll
    for (int dd = 0; dd < 4; ++dd) kb[dd] = K_lds + KB * SHM_K + KSWZ(r32, (dd * 16 + hi * 8) * 2);
#pragma unroll
    for (int d0 = 0; d0 < 8; ++d0) { const char* a = kb[d0 & 3] + (d0 >> 2) * 128;
        bf16x8 b0 = *reinterpret_cast<const bf16x8*>(a);
        bf16x8 b1 = *reinterpret_cast<const bf16x8*>(a + 32 * 256);
        p0 = __builtin_amdgcn_mfma_f32_32x32x16_bf16(b0, qr[d0], p0, 0, 0, 0);
        p1 = __builtin_amdgcn_mfma_f32_32x32x16_bf16(b1, qr[d0], p1, 0, 0, 0); }
}
template <int VB>
__device__ __forceinline__ void pv_tile(f32x16* o, int vb0, bf16x8 pa0, bf16x8 pa1, bf16x8 pa2, bf16x8 pa3) {
#define TRRD(dst, off) asm volatile("ds_read_b64_tr_b16 %0, %1 offset:%2" : "=&v"(dst) : "v"(vb0), "i"(off) : "memory")
#define PV_D0(d0) do { s16x4 l0, l1, l2, l3, h0, h1, h2, h3; constexpr int b_ = VB * SHM_V + v_rd_off(d0, 0, 0);   \
        TRRD(l0, b_); TRRD(h0, b_ + 2048); TRRD(l1, b_ + 4096); TRRD(h1, b_ + 6144); TRRD(l2, b_ + 8192); TRRD(h2, b_ + 10240); TRRD(l3, b_ + 12288); TRRD(h3, b_ + 14336); \
        asm volatile("s_waitcnt lgkmcnt(0)" ::: "memory"); SBAR();                                                    \
        o[d0] = __builtin_amdgcn_mfma_f32_32x32x16_bf16(pa0, (bf16x8){l0[0], l0[1], l0[2], l0[3], h0[0], h0[1], h0[2], h0[3]}, o[d0], 0, 0, 0);   \
        o[d0] = __builtin_amdgcn_mfma_f32_32x32x16_bf16(pa1, (bf16x8){l1[0], l1[1], l1[2], l1[3], h1[0], h1[1], h1[2], h1[3]}, o[d0], 0, 0, 0);   \
        o[d0] = __builtin_amdgcn_mfma_f32_32x32x16_bf16(pa2, (bf16x8){l2[0], l2[1], l2[2], l2[3], h2[0], h2[1], h2[2], h2[3]}, o[d0], 0, 0, 0);   \
        o[d0] = __builtin_amdgcn_mfma_f32_32x32x16_bf16(pa3, (bf16x8){l3[0], l3[1], l3[2], l3[3], h3[0], h3[1], h3[2], h3[3]}, o[d0], 0, 0, 0); } while (0)
    PV_D0(0); PV_D0(1); PV_D0(2); PV_D0(3);
#undef PV_D0
#undef TRRD
}

struct Bases { const bf16* Q; bf16* O; const bf16* K; const bf16* V; const float* CB; };
struct BlockRef { unsigned qo, oo, kvo, cbo; int P0, jlo; };
struct Seam { bf16x8 qr[8]; bf16x8 st_v0, st_v1, st_k0, st_k1; float st_b; };
#define ROW(p, k0, rr) ((p) + (unsigned)(((k0) + (rr)) * LD + sc))
#define VMW() asm volatile("s_waitcnt vmcnt(0)" ::: "memory")
#define VMWN(n) asm volatile("s_waitcnt vmcnt(%0)" :: "i"(n) : "memory")
#define SLOAD_H(Kp, Vp, CBp, k0) do { S.st_v0 = load8(ROW(Vp, k0, sr)); S.st_v1 = load8(ROW(Vp, k0, 32 + sr));              \
                         S.st_k0 = load8(ROW(Kp, k0, sr)); S.st_k1 = load8(ROW(Kp, k0, 32 + sr)); S.st_b = (CBp)[(unsigned)((k0) + lane)]; } while (0)
#define SWRITE_HK(bf, cref_) do { *(bf16x8*)(K_lds + (bf) * SHM_K + kws) = S.st_k0; *(bf16x8*)(K_lds + (bf) * SHM_K + kws + 32 * 256) = S.st_k1; \
                           if (wid == 0) *(float*)(B_lds + (bf) * 256 + lane * 4) = S.st_b; } while (0)
#define SWRITE_HV(bf) do { *(bf16x8*)(V_lds + (bf) * SHM_V + vst0) = S.st_v0; *(bf16x8*)(V_lds + (bf) * SHM_V + vst1) = S.st_v1; } while (0)
#define SWRITE_H(bf) do { SWRITE_HV(bf); SWRITE_HK(bf, cref); } while (0)
__device__ __forceinline__ void prime(const Bases& G, const BlockRef& cur, char* lds, Seam& S) {
    const int tid = threadIdx.x, wid = __builtin_amdgcn_readfirstlane(tid >> 6), lane = tid & 63, r32 = lane & 31, hi = lane >> 5;
    const int sr = tid >> 4, sc = (tid & 15) * 8, kws = KSWZ(sr, sc * 2); char* K_lds = lds + 2 * SHM_V; char* B_lds = lds + OFF_BIAS;
    for (int d0 = 0; d0 < 8; ++d0) S.qr[d0] = load8(G.Q + (cur.qo + (unsigned)((wid * QBLK + r32) * LD + d0 * 16 + hi * 8)));
    const float cref = 0.f; (void)cref;
    SLOAD_H(G.K + cur.kvo, G.V + cur.kvo, G.CB + cur.cbo, cur.jlo * KVBLK); VMW(); SWRITE_HK(0, cref);
    __syncthreads();
}
__device__ __forceinline__ void block(const Bases& G, const BlockRef& cur, const BlockRef& nxt, char* lds, Seam& S) {
    const int tid = threadIdx.x, wid = __builtin_amdgcn_readfirstlane(tid >> 6), lane = tid & 63, r32 = lane & 31, hi = lane >> 5;
    const int j_lo = cur.jlo, NT = (cur.P0 + QB - 1) / KVBLK + 1 - j_lo;
    const int qlo = cur.P0 + wid * QBLK, qm = qlo + r32 - 4 * hi;
    char* V_lds = lds; char* K_lds = lds + 2 * SHM_V; char* B_lds = lds + OFF_BIAS;
    float* ws = (float*)(lds + OFF_WS) + wid * 64; float* li_l = ws, * al_l = ws + 32;
    float m_reg = G.CB[cur.cbo + (unsigned)(cur.P0 + wid * QBLK + r32)], l_reg = 0; f32x16 o[4] = {};
    const int sr = tid >> 4, sc = (tid & 15) * 8, vst0 = v_st(sr, sc), vst1 = v_st(32 + sr, sc), kws = KSWZ(sr, sc * 2);
    const int vb0 = (int)(uintptr_t)V_lds + v_rd_base(lane);
    const bf16* Kh = G.K + cur.kvo; const bf16* Vh = G.V + cur.kvo; const float* CBh = G.CB + cur.cbo;
    const float cref = 0.f, crefn = 0.f; (void)cref; (void)crefn;
#define RESC(a) do { if (__any((a) < 1.f)) { if (hi == 0) al_l[r32] = (a); asm volatile("s_waitcnt lgkmcnt(0)" ::: "memory");              \
                     for (int d_ = 0; d_ < 4; ++d_) for (int r = 0; r < 16; ++r) o[d_][r] *= al_l[crow(r, hi)]; } } while (0)
#define KBASE(t) ((j_lo + (t)) * KVBLK)
#define MASKT(P0_, P1_, t) do { const int kb_ = KBASE(t); if (kb_ + KVBLK - 1 > qlo) mask_tile(P0_, P1_, qm - kb_); } while (0)
    constexpr int NQL = 8;
#define SEAM_K0() do { VMWN(NQL); SWRITE_HK(0, crefn); SBAR(); } while (0)
    f32x16 pA0, pA1, pB0, pB1; float mnA, mnB, alA, alB; bf16x8 pa0, pa1, pa2, pa3;
    SWRITE_HV(0); SBAR();
    if (NT > 1) { SLOAD_H(Kh, Vh, CBh, KBASE(1)); }
    SBAR(); qkt<0>(pA0, pA1, K_lds, B_lds, r32, hi, S.qr);
    MASKT(pA0, pA1, 0); partialSM(pA0, pA1, m_reg, mnA, alA);
    if (NT > 1) { VMW(); SWRITE_H(1); }
    __syncthreads();
#define HALF_STEP(PX0, PX1, mnX, alX, PY0, PY1, alY, t, KB, VB, SB) do {                                                      \
        SBAR(); qkt<KB>(PX0, PX1, K_lds, B_lds, r32, hi, S.qr);                                                                \
        finishSM(PY0, PY1, alY, l_reg, pa0, pa1, pa2, pa3); SBAR();                                                           \
        if ((t) + 1 < NT) { SLOAD_H(Kh, Vh, CBh, KBASE((t) + 1)); SBAR(); }                                              \
        pv_tile<VB>(o, vb0, pa0, pa1, pa2, pa3); MASKT(PX0, PX1, (t)); partialSM(PX0, PX1, m_reg, mnX, alX);                   \
        __syncthreads();                                                                                                      \
        if ((t) + 1 < NT) { VMW(); SWRITE_H(SB); }                                                                            \
        RESC(alX); __syncthreads(); } while (0)
    for (int t = 1; t + 1 < NT; t += 2) {
        HALF_STEP(pB0, pB1, mnB, alB, pA0, pA1, alA, t, 1, 0, 0);
        HALF_STEP(pA0, pA1, mnA, alA, pB0, pB1, alB, t + 1, 0, 1, 1);
    }
    constexpr bool even = true;
    if (even) { SBAR(); qkt<1>(pB0, pB1, K_lds, B_lds, r32, hi, S.qr); SBAR(); }
    { SLOAD_H(G.K + nxt.kvo, G.V + nxt.kvo, G.CB + nxt.cbo, nxt.jlo * KVBLK); SBAR();
#pragma unroll
      for (int d0 = 0; d0 < 8; ++d0) S.qr[d0] = load8(G.Q + (nxt.qo + (unsigned)((wid * QBLK + r32) * LD + d0 * 16 + hi * 8))); }
    SBAR();
    finishSM(pA0, pA1, alA, l_reg, pa0, pa1, pa2, pa3); SBAR();
    pv_tile<0>(o, vb0, pa0, pa1, pa2, pa3);
    if (even) { MASKT(pB0, pB1, NT - 1); partialSM(pB0, pB1, m_reg, mnB, alB); __syncthreads(); RESC(alB);
        finishSM(pB0, pB1, alB, l_reg, pa0, pa1, pa2, pa3); SBAR(); pv_tile<1>(o, vb0, pa0, pa1, pa2, pa3); }
    SBAR(); SEAM_K0();
    if (hi == 0) li_l[r32] = l_reg; asm volatile("s_waitcnt lgkmcnt(0)" ::: "memory");
    float rli[16];
#pragma unroll
    for (int r = 0; r < 16; ++r) rli[r] = __builtin_amdgcn_rcpf(li_l[crow(r, hi)]);
    bf16* Ow = G.O + (cur.oo + (unsigned)(wid * QBLK * LDO));
#pragma unroll
    for (int r = 0; r < 16; ++r) { const int orow = crow(r, hi);
#pragma unroll
        for (int d0 = 0; d0 < 4; ++d0) { const float v = o[d0][r] * rli[r];
            const float vn = __shfl_xor(v, 1);
            if ((r32 & 1) == 0) *(unsigned*)(Ow + (unsigned)(orow * LDO + d0 * 32 + r32)) = cvtpk(v, vn); } }
    __syncthreads();
#undef RESC
#undef KBASE
#undef MASKT
#undef SEAM_K0
#undef HALF_STEP
}
#undef ROW
#undef VMW
#undef VMWN
#undef SLOAD_H
#undef SWRITE_HK
#undef SWRITE_HV
#undef SWRITE_H
#undef KSWZ
#undef SBAR
}
constexpr int NB = 8, SEQ = 4096, T = NB * SEQ, DM = 1024, NH = 8, HD = 128, INW = 7176, NZ = 7168;
constexpr int NE = 32, DE = 512;
constexpr float EPS = 1e-6f;
constexpr int PMAX = 73728;
constexpr int NWAVES = 8;
constexpr size_t MiB = 1u << 20;
constexpr size_t WS_CTL = 0, CTL_ZERO_BYTES = 64 * 1024;
constexpr size_t WS_RS1 = 1 * MiB, WS_RS2 = 1 * MiB + 256 * 1024;
constexpr size_t WS_LF = 1 * MiB + 512 * 1024;
constexpr size_t WS_CB = 2 * MiB + 512 * 1024;
constexpr size_t WS_TOK = 3 * MiB + 512 * 1024;
constexpr size_t WS_LISTS = 5 * MiB;
constexpr size_t WS_WRT = 9 * MiB;
constexpr size_t WS_SRS = 9 * MiB + 512 * 1024, WS_SW = 10 * MiB;
constexpr size_t WS_WIN = 16 * MiB;
constexpr size_t WS_WA = 30 * MiB, WS_WL = 32 * MiB, WS_WO = 34 * MiB;
constexpr size_t WS_WRG = 36 * MiB;
constexpr size_t WS_XB = 40 * MiB;
constexpr size_t WS_XR = 104 * MiB;
constexpr size_t WS_GG = 168 * MiB;
constexpr size_t WS_Q = 232 * MiB, WS_K = 296 * MiB, WS_V = 360 * MiB;
constexpr size_t WS_W13 = 424 * MiB;
constexpr size_t WS_W2 = 392 * MiB;
constexpr size_t WS_XG = 168 * MiB;
constexpr size_t WS_HB = 296 * MiB;
constexpr size_t WS_END = 512 * MiB;
static_assert(WS_XG + (size_t)PMAX * 1024 <= WS_K && WS_HB + (size_t)PMAX * 1024 <= WS_W2 && WS_W2 + 32u * 1024 * 512 * 2 <= WS_W13 && WS_W13 + 64 * MiB <= WS_END, "d_ws map");
constexpr int CW_TMO = 0, CW_CODE = 1, CW_BAR = 4096, CW_CNT = 8192, CW_NORM = 8448, CW_QCTR = 12288;
constexpr int RING_OFF = 0, RING_BYTES = 131072;
constexpr int LDSCTL_OFF = RING_BYTES, MISC_OFF = LDSCTL_OFF + 320;
constexpr int TBL_OFF = RING_BYTES + 1024;
constexpr int TBL_PS = TBL_OFF, TBL_CN = TBL_OFF + 256, TBL_TE = TBL_OFF + 512;
constexpr int RG_TOT = RING_BYTES + 4096, RG_CAR = RG_TOT + 4096;
constexpr int LDS_BYTES = 147456;

#include <cmath>
using pg8::bf_lo; using pg8::bf_hi; using pg8::sigmoid_f;

struct Frame {
    LAS unsigned char* lds;
    int tid, lane, wave, vcu, G;
};
__device__ __forceinline__ float wave_sum(float v) {
#pragma unroll
    for (int o = 1; o < 64; o <<= 1) v += __shfl_xor(v, o);
    return v;
}
__device__ __forceinline__ void transpose_tile(const float* src, int ld, bf16* dst, int ldd, const float* kscale, LAS float* scr, int lane) {
    const int q = lane & 7, kr = lane >> 3;
    f32x4 v[8];
#pragma unroll
    for (int i = 0; i < 8; ++i) v[i] = __builtin_nontemporal_load((const f32x4*)(src + (size_t)(kr + 8 * i) * ld + 4 * q));
#pragma unroll
    for (int i = 0; i < 8; ++i) { const int kk = kr + 8 * i; const float sc = kscale ? kscale[kk] : 1.0f;
#pragma unroll
        for (int c = 0; c < 4; ++c) scr[kk * 33 + 4 * q + c] = v[i][c] * sc; }
    LDS_WAIT(); asm volatile("" ::: "memory");
    const int c = lane & 7;
#pragma unroll
    for (int j = 0; j < 4; ++j) { const int n = (lane >> 3) + 8 * j; const LAS float* s = scr + (8 * c) * 33 + n;
        v4u o; o.x = pk2(s[0 * 33], s[1 * 33]); o.y = pk2(s[2 * 33], s[3 * 33]); o.z = pk2(s[4 * 33], s[5 * 33]); o.w = pk2(s[6 * 33], s[7 * 33]);
        *(GAS v4u*)(dst + (size_t)n * ldd + 8 * c) = o; }
    LDS_WAIT(); asm volatile("" ::: "memory");
}

__device__ __forceinline__ void transpose_tile8(const float* src, int ld, unsigned char* dst, int ldd, const float* kscale, float scale, LAS float* scr, int lane) {
    const int q = lane & 7, kr = lane >> 3;
    f32x4 v[8];
#pragma unroll
    for (int i = 0; i < 8; ++i) v[i] = __builtin_nontemporal_load((const f32x4*)(src + (size_t)(kr + 8 * i) * ld + 4 * q));
#pragma unroll
    for (int i = 0; i < 8; ++i) { const int kk = kr + 8 * i; const float sc = kscale ? kscale[kk] * scale : scale;
#pragma unroll
        for (int c = 0; c < 4; ++c) scr[kk * 33 + 4 * q + c] = v[i][c] * sc; }
    LDS_WAIT(); asm volatile("" ::: "memory");
    const int c = lane & 3;
#pragma unroll
    for (int j = 0; j < 2; ++j) { const int n = (lane >> 2) + 16 * j; const LAS float* s = scr + (16 * c) * 33 + n;
        v4u o; o.x = pg8::pack4_fp8(s[0 * 33], s[1 * 33], s[2 * 33], s[3 * 33]); o.y = pg8::pack4_fp8(s[4 * 33], s[5 * 33], s[6 * 33], s[7 * 33]);
        o.z = pg8::pack4_fp8(s[8 * 33], s[9 * 33], s[10 * 33], s[11 * 33]); o.w = pg8::pack4_fp8(s[12 * 33], s[13 * 33], s[14 * 33], s[15 * 33]);
        *(GAS v4u*)(dst + (size_t)n * ldd + 16 * c) = o; }
    LDS_WAIT(); asm volatile("" ::: "memory");
}

struct P0Args { const float *x, *g_mix, *w_in, *w_rg_a, *w_rg_x, *b_forget, *w_lru_out, *w_attn_out, *w_out, *g_ffn, *w_rgrp, *w_rexp, *w_gate, *w_up;
                bf16 *Win, *Wl, *Wa, *Wo, *Wrg, *XB; unsigned char* W13; float *RS1, *LF, *WRT; };
struct TItem { const float* src; int ld; unsigned char* dst; int ldd; const float* ks; float scale; int f8; };
__device__ __forceinline__ void titem_load(const TItem& t, f32x4 (&v)[8], float (&sc)[8], int lane) {
    const int q = lane & 7, kr = lane >> 3;
#pragma unroll
    for (int i = 0; i < 8; ++i) { v[i] = __builtin_nontemporal_load((const f32x4*)(t.src + (size_t)(kr + 8 * i) * t.ld + 4 * q)); sc[i] = t.ks ? t.ks[kr + 8 * i] * t.scale : t.scale; }
}
__device__ __forceinline__ void titem_finish(const TItem& t, const f32x4 (&v)[8], const float (&sc)[8], LAS float* scr, int lane) {
    const int q = lane & 7, kr = lane >> 3;
#pragma unroll
    for (int i = 0; i < 8; ++i) { const int kk = kr + 8 * i;
#pragma unroll
        for (int c = 0; c < 4; ++c) scr[kk * 33 + 4 * q + c] = v[i][c] * sc[i]; }
    LDS_WAIT(); asm volatile("" ::: "memory");
    if (t.f8) { const int c = lane & 3;
#pragma unroll
        for (int j = 0; j < 2; ++j) { const int n = (lane >> 2) + 16 * j; const LAS float* s = scr + (16 * c) * 33 + n;
            v4u o; o.x = pg8::pack4_fp8(s[0 * 33], s[1 * 33], s[2 * 33], s[3 * 33]); o.y = pg8::pack4_fp8(s[4 * 33], s[5 * 33], s[6 * 33], s[7 * 33]);
            o.z = pg8::pack4_fp8(s[8 * 33], s[9 * 33], s[10 * 33], s[11 * 33]); o.w = pg8::pack4_fp8(s[12 * 33], s[13 * 33], s[14 * 33], s[15 * 33]);
            *(GAS v4u*)(t.dst + (size_t)n * t.ldd + 16 * c) = o; } }
    else { const int c = lane & 7;
#pragma unroll
        for (int j = 0; j < 4; ++j) { const int n = (lane >> 3) + 8 * j; const LAS float* s = scr + (8 * c) * 33 + n;
            v4u o; o.x = pk2(s[0 * 33], s[1 * 33]); o.y = pk2(s[2 * 33], s[3 * 33]); o.z = pk2(s[4 * 33], s[5 * 33]); o.w = pk2(s[6 * 33], s[7 * 33]);
            *(GAS v4u*)(t.dst + ((size_t)n * t.ldd + 8 * c) * 2) = o; } }
    LDS_WAIT(); asm volatile("" ::: "memory");
}
constexpr int P0_I_IN = 16 * 224, P0_I_SQ = 16 * 32, P0_I_RG = 2 * 4 * 4 * 8, P0_I_EX = 2 * 8192, P0_NITEMS = P0_I_IN + 3 * P0_I_SQ + P0_I_RG + P0_I_EX;
__device__ __forceinline__ void p0_items(const Frame& F, const P0Args& a, const int first, const int last, const int stride, const int offset) {
    LAS float* scr = (LAS float*)(F.lds + RING_OFF + F.wave * 16384);
    const float* const p_wl = a.w_lru_out; const float* const p_wa = a.w_attn_out; const float* const p_wo = a.w_out; const float* const p_rga = a.w_rg_a; const float* const p_rgx = a.w_rg_x;
    bf16* const q_wl = a.Wl; bf16* const q_wa = a.Wa; bf16* const q_wo = a.Wo;
    constexpr int I_IN = P0_I_IN, I_SQ = P0_I_SQ, I_EX = P0_I_EX, NITEMS = P0_NITEMS;
    const float* const p_gate = a.w_gate; const float* const p_up = a.w_up; const float* const p_win = a.w_in; const float* const p_gmix = a.g_mix; const float* const p_gffn = a.g_ffn;
    bf16* const q_win = a.Win; bf16* const q_wrg = a.Wrg; unsigned char* const q_w13 = a.W13;
#define P0_DECODE(it_, t_) do { int r = (it_); \
        if (r >= NITEMS - I_EX) { r -= NITEMS - I_EX;     \
            const int w = r >> 13, e = (r >> 8) & 31, kb = (r >> 4) & 15, nb = r & 15; const float* W = (w == 0 ? p_gate : p_up) + (size_t)e * DM * DE; \
            const int drow = e * 1024 + (nb >> 2) * 256 + (nb & 3) * 32 + (w == 1 ? 128 : 0); \
            t_.src = W + (size_t)(64 * kb) * DE + 32 * nb; t_.ld = DE; t_.dst = q_w13 + (size_t)drow * DM + 64 * kb; t_.ldd = DM; t_.ks = p_gffn + 64 * kb; t_.scale = pg8::W13_SCALE; t_.f8 = 1; } \
        else if (r < I_IN) { const int kb = r / 224, nb = r % 224, n0 = 32 * nb, sc_ = n0 < 5120 ? n0 : n0 + 8; \
            t_.src = p_win + (size_t)(64 * kb) * INW + sc_; t_.ld = INW; t_.dst = (unsigned char*)(q_win + (size_t)n0 * DM + 64 * kb); t_.ldd = DM; t_.ks = p_gmix + 64 * kb; t_.scale = 1.0f; t_.f8 = 0; } \
        else if (r < I_IN + 3 * I_SQ) { r -= I_IN; const int w = r / I_SQ, q = r % I_SQ, kb = q / 32, nb = q % 32; const float* W = w == 0 ? p_wl : (w == 1 ? p_wa : p_wo); bf16* Wt = w == 0 ? q_wl : (w == 1 ? q_wa : q_wo); \
            t_.src = W + (size_t)(64 * kb) * DM + 32 * nb; t_.ld = DM; t_.dst = (unsigned char*)(Wt + (size_t)(32 * nb) * DM + 64 * kb); t_.ldd = DM; t_.ks = nullptr; t_.scale = 1.0f; t_.f8 = 0; } \
        else { r -= I_IN + 3 * I_SQ; const int gb = r / 32, q = r % 32, kb = q / 8, nb = q % 8; const float* W = (gb < 4 ? p_rga : p_rgx) + (size_t)(gb & 3) * 65536; \
            t_.src = W + (size_t)(64 * kb) * 256 + 32 * nb; t_.ld = 256; t_.dst = (unsigned char*)(q_wrg + (size_t)gb * 65536 + (size_t)(32 * nb) * 256 + 64 * kb); t_.ldd = 256; t_.ks = nullptr; t_.scale = -1.4426950408889634f; t_.f8 = 0; }     } while (0)
    {
        int it = first + offset; TItem cur; f32x4 va[8]; float sa[8];
        if (it < last) { P0_DECODE(it, cur); titem_load(cur, va, sa, F.lane); }
        while (it < last) {
            const int nx = it + stride; TItem nt = cur; f32x4 vb[8]; float sb[8];
            if (nx < last) { P0_DECODE(nx, nt); titem_load(nt, vb, sb, F.lane); }
            titem_finish(cur, va, sa, scr, F.lane);
            if (nx < last) { cur = nt;
#pragma unroll
                for (int i = 0; i < 8; ++i) { va[i] = vb[i]; sa[i] = sb[i]; } }
            it = nx;
        }
    }
#undef P0_DECODE
}
__device__ __forceinline__ void p0_prologue(const Frame& F, const P0Args& a, const int part  ) {
    const int gw = F.vcu * NWAVES + F.wave, NGW = F.G * NWAVES;
    if (part != 2) p0_items(F, a, 0, P0_NITEMS, NGW, gw);
    if (part == 1) return;
    for (int i = (F.vcu * NWAVES + F.wave) * 64 + F.lane; i < 64 * DM; i += NGW * 64) { const int n = i >> 10, k = i & 1023;
        float v = 0.f; if (n < 32) v = a.w_rexp[k * 32 + n]; else if (n < 36) v = a.w_rgrp[k * 4 + (n - 32)];
        a.WRT[i] = v * a.g_ffn[k]; }
    LAS float* wfl = (LAS float*)(F.lds + RING_OFF);
    __syncthreads();
    for (int k = F.tid; k < DM; k += NWAVES * 64) { const float g = a.g_mix[k];
        const f32x4 w0 = *(const f32x4*)(a.w_in + (size_t)k * INW + 5120), w1 = *(const f32x4*)(a.w_in + (size_t)k * INW + 5124);
        *(LAS f32x4*)(wfl + k * 8) = w0 * g; *(LAS f32x4*)(wfl + k * 8 + 4) = w1 * g; }
    __syncthreads();
    float wf[4][4][8];
#pragma unroll
    for (int j = 0; j < 4; ++j)
#pragma unroll
        for (int i = 0; i < 4; ++i) { const int k = 256 * j + 4 * F.lane + i; const f32x4 w0 = *(const LAS f32x4*)(wfl + k * 8), w1 = *(const LAS f32x4*)(wfl + k * 8 + 4);
#pragma unroll
            for (int h = 0; h < 4; ++h) { wf[j][i][h] = w0[h]; wf[j][i][4 + h] = w1[h]; } }
    const float bfg = a.b_forget[F.lane & 7];
    f32x4 vn[4];
    if (gw < T) { const GAS f32x4* xr0 = (const GAS f32x4*)(a.x + (size_t)gw * DM) + F.lane;
#pragma unroll
        for (int j = 0; j < 4; ++j) vn[j] = __builtin_nontemporal_load((const f32x4*)xr0 + 64 * j); }
    for (int m = gw; m < T; m += NGW) {
        f32x4 v[4]; float s = 0.f, d[8] = {0.f, 0.f, 0.f, 0.f, 0.f, 0.f, 0.f, 0.f};
#pragma unroll
        for (int j = 0; j < 4; ++j) v[j] = vn[j];
        if (m + NGW < T) { const GAS f32x4* xr1 = (const GAS f32x4*)(a.x + (size_t)(m + NGW) * DM) + F.lane;
#pragma unroll
            for (int j = 0; j < 4; ++j) vn[j] = __builtin_nontemporal_load((const f32x4*)xr1 + 64 * j); }
#pragma unroll
        for (int j = 0; j < 4; ++j) { s += (v[j].x * v[j].x + v[j].y * v[j].y) + (v[j].z * v[j].z + v[j].w * v[j].w);
#pragma unroll
            for (int i = 0; i < 4; ++i)
#pragma unroll
                for (int h = 0; h < 8; ++h) d[h] = fmaf(v[j][i], wf[j][i][h], d[h]); }
        s = wave_sum(s);
#pragma unroll
        for (int h = 0; h < 8; ++h) d[h] = wave_sum(d[h]);
        const float rs = 1.0f / sqrtf(s * (1.0f / DM) + EPS);
        GAS unsigned long long* o8 = (GAS unsigned long long*)(a.XB + (size_t)m * DM) + F.lane;
#pragma unroll
        for (int j = 0; j < 4; ++j) o8[64 * j] = (unsigned long long)pk2(v[j].x * rs, v[j].y * rs) | ((unsigned long long)pk2(v[j].z * rs, v[j].w * rs) << 32);
        if (F.lane < 8) { const int h = F.lane; float dh = d[0]; dh = h == 1 ? d[1] : dh; dh = h == 2 ? d[2] : dh; dh = h == 3 ? d[3] : dh; dh = h == 4 ? d[4] : dh; dh = h == 5 ? d[5] : dh; dh = h == 6 ? d[6] : dh; dh = h == 7 ? d[7] : dh;
            const float fl = dh * rs + bfg; a.LF[(size_t)m * 8 + h] = fminf(fl, 0.f) - log1pf(expf(-fabsf(fl))); }
    }
}
__device__ __forceinline__ void cumsum_bias(const Frame& F, const float* LF, float* CB) {
    LAS float* wt = (LAS float*)(F.lds + RING_OFF);
    for (int bh = blockIdx.x; bh < NB * NH; bh += F.G) {
        const int b = bh >> 3, h = bh & 7, s0 = F.tid * 8;
        float v[8], run = 0.f;
#pragma unroll
        for (int j = 0; j < 8; ++j) { run += LF[((size_t)(b * SEQ + s0 + j)) * 8 + h]; v[j] = run; }
        float inc = run;
#pragma unroll
        for (int o = 1; o < 64; o <<= 1) { const float t = __shfl_up(inc, o); if (F.lane >= o) inc += t; }
        if (F.lane == 63) wt[F.wave] = inc;
        __syncthreads();
        float pre = inc - run;
        for (int w = 0; w < F.wave; ++w) pre += wt[w];
#pragma unroll
        for (int j = 0; j < 8; ++j) CB[(size_t)bh * SEQ + s0 + j] = -(pre + v[j]) * 11.313708498984761f;
        __syncthreads();
    }
}
struct RgArgs { const bf16* XC; const bf16* GG; bf16* GO; const bf16* Wrg; const float *b_a, *b_x, *lam; };
__device__ __forceinline__ float bfx(const v4u& v, int i) { const unsigned w = i < 2 ? v.x : (i < 4 ? v.y : (i < 6 ? v.z : v.w)); return (i & 1) ? bf_hi(w) : bf_lo(w); }
__device__ __forceinline__ unsigned cvtpk_bf16(float lo, float hi) { unsigned r; asm volatile("v_cvt_pk_bf16_f32 %0, %1, %2" : "=v"(r) : "v"(lo), "v"(hi)); return r; }
__device__ __forceinline__ void conv_prepass(const Frame& F, const bf16* XR, bf16* XC, const float* conv_w, const float* conv_b) {
    const int gw = F.vcu * NWAVES + F.wave, NGW = F.G * NWAVES;
    for (int it = gw; it < (T / 16) * 2; it += NGW) {
        const int r0 = (it >> 1) * 16, c0 = (it & 1) * 512 + 8 * F.lane, tq = r0 & (SEQ - 1);
        float cw[4][8], cbv[8];
#pragma unroll
        for (int j = 0; j < 4; ++j) { const f32x4 w0 = *(const f32x4*)(conv_w + j * DM + c0), w1 = *(const f32x4*)(conv_w + j * DM + c0 + 4);
#pragma unroll
            for (int i = 0; i < 4; ++i) { cw[j][i] = w0[i]; cw[j][4 + i] = w1[i]; } }
        { const f32x4 w0 = *(const f32x4*)(conv_b + c0), w1 = *(const f32x4*)(conv_b + c0 + 4);
#pragma unroll
          for (int i = 0; i < 4; ++i) { cbv[i] = w0[i]; cbv[4 + i] = w1[i]; } }
        v4u raw[19];
#pragma unroll
        for (int i = 0; i < 19; ++i) { const int rr = (i < 3 && tq == 0) ? r0 : r0 - 3 + i; const v4u w = __builtin_nontemporal_load((const v4u*)(XR + ((unsigned)rr * DM + c0)));
            const bool z = i < 3 && tq == 0; raw[i].x = z ? 0u : w.x; raw[i].y = z ? 0u : w.y; raw[i].z = z ? 0u : w.z; raw[i].w = z ? 0u : w.w; }
#pragma unroll
        for (int r = 0; r < 16; ++r) { float y[8];
#pragma unroll
            for (int i = 0; i < 8; ++i) { float sacc = cbv[i];
#pragma unroll
                for (int j = 0; j < 4; ++j) sacc = fmaf(cw[j][i], bfx(raw[r + j], i), sacc);
                y[i] = sacc; }
            v4u o; o.x = cvtpk_bf16(y[0], y[1]); o.y = cvtpk_bf16(y[2], y[3]); o.z = cvtpk_bf16(y[4], y[5]); o.w = cvtpk_bf16(y[6], y[7]);
            *(GAS v4u*)(XC + ((unsigned)(r0 + r) * DM + c0)) = o; }
    }
}
__device__ __forceinline__ void rglru_unit(const Frame& F, const RgArgs& a, int unit) {
    const int tid = F.tid, lane = F.lane, wid = F.wave, fr = lane & 15, fq = lane >> 4, rq = wid >> 1, cp = wid & 1;
    const int b = unit >> 5, n = (unit >> 3) & 3, g = unit & 7, cbase = 256 * n, cown = cbase + 32 * g;
    LAS unsigned char* A_l = F.lds + RING_OFF;
    LAS float* tot = (LAS float*)(F.lds + RG_TOT);
    bf16x8 bfr[2][8];
#pragma unroll
    for (int gt = 0; gt < 2; ++gt)
#pragma unroll
        for (int ks = 0; ks < 8; ++ks) bfr[gt][ks] = *(const GAS bf16x8*)(a.Wrg + ((size_t)((gt * 4 + n) * 256 + 32 * g + 16 * cp + fr)) * 256 + 32 * ks + 8 * fq);
    const int cl = 16 * cp + fr, cch = cown + cl;
    const float ba = -1.4426950408889634f * a.b_a[cch], bx = -1.4426950408889634f * a.b_x[cch], sp8 = 8.0f * log1pf(expf(-a.lam[cch])) * 1.4426950408889634f;
    const unsigned goff = (unsigned)(b * SEQ + 32 * rq + 4 * fq) * DM + cch;
    const __amdgpu_buffer_rsrc_t GGr = __builtin_amdgcn_make_buffer_rsrc((void*)a.GG, 0, (int)((size_t)T * DM * 2), 0x00020000);
    const __amdgpu_buffer_rsrc_t GOr = __builtin_amdgcn_make_buffer_rsrc((void*)a.GO, 0, (int)((size_t)T * DM * 2), 0x00020000);
    const int gvo = (int)(goff * 2u);
    const unsigned dbase = ((unsigned)(b * SEQ + 16 * wid + (lane >> 5)) * DM + cbase) * 2u;
    const char* const XCb = (const char*)a.XC;
#define RG_DMA(ci_, buf_) do { _Pragma("unroll") for (int i_ = 0; i_ < 8; ++i_) { const unsigned so_ = dbase + (unsigned)(2 * i_) * (DM * 2u) + ((((unsigned)lane & 31u) ^ (unsigned)((2 * i_ + (lane >> 5)) & 15)) << 4); \
        __builtin_amdgcn_global_load_lds((const unsigned*)(XCb + so_ + (unsigned)(ci_) * (128u * DM * 2u)), (LAS unsigned*)(A_l + (buf_) * 65536 + (8 * wid + i_) * 1024), 16, 0, 0); } } while (0)
    float hc = 0.f;
    const int kx = 32 * g + cl;
#pragma unroll
    for (int gt = 0; gt < 2; ++gt)
#pragma unroll
        for (int ks = 0; ks < 8; ++ks) asm volatile("" : "+v"(bfr[gt][ks]));
    RG_DMA(0, 0); asm volatile("s_waitcnt vmcnt(0)" ::: "memory");
#define RG_CHUNK(BUF_, ci_) do { const int ci = (ci_); const int t0 = 128 * ci; LAS unsigned char* const Ab = A_l + (BUF_) * 65536; \
        __builtin_amdgcn_s_barrier(); asm volatile("" ::: "memory"); \
        unsigned short ggv[2][4]; \
        _Pragma("unroll") \
        for (int mt = 0; mt < 2; ++mt) \
        _Pragma("unroll") \
            for (int j = 0; j < 4; ++j) ggv[mt][j] = __builtin_amdgcn_raw_buffer_load_b16(GGr, gvo, (t0 + 16 * mt + j) * (DM * 2), 0); \
        if (ci + 1 < SEQ / 128) RG_DMA(ci + 1, BUF_ ^ 1); \
 \
        f32x4 acc[2][2]; \
        _Pragma("unroll") \
        for (int mt = 0; mt < 2; ++mt) { acc[mt][0] = (f32x4){ba, ba, ba, ba}; acc[mt][1] = (f32x4){bx, bx, bx, bx}; } \
        _Pragma("unroll") \
        for (int ks = 0; ks < 8; ++ks) { const int ch = 4 * ks + fq; \
        _Pragma("unroll") \
            for (int mt = 0; mt < 2; ++mt) { const int arow = 32 * rq + 16 * mt + fr; \
                const bf16x8 af = *(const LAS bf16x8*)(Ab + arow * 512 + ((ch ^ (arow & 15)) << 4)); \
                acc[mt][0] = __builtin_amdgcn_mfma_f32_16x16x32_bf16(af, bfr[0][ks], acc[mt][0], 0, 0, 0); \
                acc[mt][1] = __builtin_amdgcn_mfma_f32_16x16x32_bf16(af, bfr[1][ks], acc[mt][1], 0, 0, 0); } } \
 \
        float av[2][4], bv[2][4], sA[2], sB[2]; \
        _Pragma("unroll") \
        for (int mt = 0; mt < 2; ++mt) { float A = 1.f, Bv = 0.f; \
        _Pragma("unroll") \
            for (int j = 0; j < 4; ++j) { const int row = 32 * rq + 16 * mt + 4 * fq + j; \
                const unsigned short xb16 = *(const LAS unsigned short*)(Ab + row * 512 + ((((kx >> 3) ^ (row & 15))) << 4) + (kx & 7) * 2); \
                const float xc = __builtin_bit_cast(float, (unsigned)xb16 << 16); \
                const float r_ = __builtin_amdgcn_rcpf(1.0f + __builtin_amdgcn_exp2f(acc[mt][0][j])), i_ = __builtin_amdgcn_rcpf(1.0f + __builtin_amdgcn_exp2f(acc[mt][1][j])); \
                const float aa = __builtin_amdgcn_exp2f(-sp8 * r_); \
                const float mult = __builtin_amdgcn_sqrtf(fmaxf(fmaf(-aa, aa, 1.0f), 0.f)); \
                av[mt][j] = aa; bv[mt][j] = mult * i_ * xc; \
                Bv = fmaf(aa, Bv, bv[mt][j]); A *= aa; } \
            sA[mt] = A; sB[mt] = Bv; } \
 \
        float eA[2], eB[2], tA[2], tB[2]; \
        _Pragma("unroll") \
        for (int mt = 0; mt < 2; ++mt) { float A = sA[mt], Bv = sB[mt]; \
            { const float pA = __shfl_up(A, 16), pB = __shfl_up(Bv, 16); if (fq >= 1) { Bv = fmaf(A, pB, Bv); A *= pA; } } \
            { const float pA = __shfl_up(A, 32), pB = __shfl_up(Bv, 32); if (fq >= 2) { Bv = fmaf(A, pB, Bv); A *= pA; } } \
            const float xA = __shfl_up(A, 16), xB = __shfl_up(Bv, 16); eA[mt] = fq >= 1 ? xA : 1.f; eB[mt] = fq >= 1 ? xB : 0.f; \
            tA[mt] = __shfl(A, 48 + fr); tB[mt] = __shfl(Bv, 48 + fr); } \
        const float wA = tA[0] * tA[1], wB = fmaf(tA[1], tB[0], tB[1]); \
        if (fq == 0) { tot[(rq * 32 + cl) * 2] = wA; tot[(rq * 32 + cl) * 2 + 1] = wB; } \
        asm volatile("s_waitcnt lgkmcnt(0)" ::: "memory"); __builtin_amdgcn_s_barrier(); asm volatile("" ::: "memory"); \
        float hin = hc, hnew = hc; \
        _Pragma("unroll") \
        for (int q = 0; q < 4; ++q) { const float qA = tot[(q * 32 + cl) * 2], qB = tot[(q * 32 + cl) * 2 + 1]; hnew = fmaf(qA, hnew, qB); if (q < rq) hin = hnew; } \
        hc = hnew; \
        _Pragma("unroll") \
        for (int mt = 0; mt < 2; ++mt) { float h = mt == 0 ? hin : fmaf(tA[0], hin, tB[0]); \
            h = fmaf(eA[mt], h, eB[mt]); \
        _Pragma("unroll") \
            for (int j = 0; j < 4; ++j) { h = fmaf(av[mt][j], h, bv[mt][j]); \
                const float gv = __builtin_bit_cast(float, (unsigned)ggv[mt][j] << 16); \
                __builtin_amdgcn_raw_buffer_store_b16((unsigned short)cvtpk_bf16(h * gv, 0.f), GOr, gvo, (t0 + 16 * mt + j) * (DM * 2), 0); } } \
        asm volatile("s_waitcnt lgkmcnt(0)" ::: "memory"); \
        asm volatile("s_waitcnt vmcnt(8)" ::: "memory"); \
    } while (0)
    for (int cc = 0; cc < SEQ / 128; cc += 2) { RG_CHUNK(0, cc); RG_CHUNK(1, cc + 1); }
#undef RG_CHUNK
#undef RG_DMA
    asm volatile("s_waitcnt vmcnt(0) lgkmcnt(0)" ::: "memory"); __builtin_amdgcn_s_barrier(); asm volatile("" ::: "memory");
}
constexpr float SKIP_LOG2 = 40.0f;
__device__ __forceinline__ int attn_jlo(const Frame& F, const float* CB, const unsigned* NORM, int bh, int qb) {
    float qs = 0.f, ks = 0.f;
#pragma unroll
    for (int w = 0; w < 4; ++w) { qs += __uint_as_float(NORM[(bh) * 4 + w]); ks += __uint_as_float(NORM[(64 + bh) * 4 + w]); }
    constexpr float C2 = 1.4426950408889634f * 0.08838834764831845f;
    const float th = SKIP_LOG2 + 2.0f * 1.02f * sqrtf(qs * ks) * C2 + 4.0f;
    const float ref = CB[(size_t)bh * SEQ + qb * 256], v = CB[(size_t)bh * SEQ + 64 * F.lane + 63];
    const unsigned long long m = __ballot(F.lane < 4 * qb && (ref - v) * C2 > th);
    int j = __builtin_popcountll(m); if (m != ((j >= 64) ? ~0ull : ((1ull << j) - 1ull))) j = 0;
    return j & ~1;
}
__device__ __forceinline__ fattn::BlockRef attn_ref(int bh, int qb, int jlo) {
    const int b = bh >> 3, h = bh & 7;
    fattn::BlockRef r; r.qo = ((unsigned)bh * SEQ + (unsigned)qb * 256u) * HD; r.oo = ((unsigned)b * SEQ + (unsigned)qb * 256u) * DM + h * HD; r.kvo = (unsigned)bh * SEQ * HD; r.cbo = (unsigned)bh * SEQ; r.P0 = qb * 256; r.jlo = jlo; return r;
}
__device__ __forceinline__ void attn_phase(const Frame& F, char* lds, const bf16* Qb, bf16* Ob, const bf16* Kb, const bf16* Vb, const float* CB, const int* JLO, gu32* QCTR) {
    constexpr int NBLK = 128;
    const int M = F.G >> 3; if ((F.G & 7) || M > 64 || M < 1) return;
    const int x = F.vcu / M, r = F.vcu % M;
    volatile LAS int* tk_l = (volatile LAS int*)(F.lds + MISC_OFF + 64);
    gu32* qc = QCTR + 64 * x;
    const fattn::Bases G{Qb, Ob, Kb, Vb, CB};
#define ATT_DEC(k_, bh_, qb_) do { const int i_ = (k_) & 7; bh_ = (i_ < 4 ? 4 * x + i_ : 32 + 4 * x + (i_ - 4)); qb_ = 15 - ((k_) >> 3); } while (0)
    int bh, qb; ATT_DEC(r, bh, qb);
    fattn::BlockRef cur = attn_ref(bh, qb, __builtin_amdgcn_readfirstlane(JLO[bh * 16 + qb]));
    ATT_DEC(r + M, bh, qb);
    fattn::BlockRef nxt = attn_ref(bh, qb, __builtin_amdgcn_readfirstlane(JLO[bh * 16 + qb])); bool nxt_ok = (r + M) < NBLK;
    fattn::Seam S;
    fattn::prime(G, cur, lds, S);
    bool more = true;
    for (;;) {
        unsigned tkt = 0u;
        if (more && F.tid == 0) tkt = __hip_atomic_fetch_add(qc, 1u, __ATOMIC_RELAXED, __HIP_MEMORY_SCOPE_AGENT);
        const bool last = !nxt_ok;
        fattn::block(G, cur, last ? cur : nxt, lds, S);
        if (last) break;
        if (F.tid == 0) tk_l[0] = more ? (int)tkt + 2 * M : NBLK;
        __syncthreads();
        const int k2 = __builtin_amdgcn_readfirstlane(tk_l[0]);
        __syncthreads();
        cur = nxt;
        if (k2 < NBLK) { ATT_DEC(k2, bh, qb); nxt = attn_ref(bh, qb, __builtin_amdgcn_readfirstlane(JLO[bh * 16 + qb])); nxt_ok = true; } else { nxt_ok = false; more = false; }
    }
#undef ATT_DEC
}
typedef float f32x16 __attribute__((ext_vector_type(16)));
struct P5Args { const float *X, *WRT, *b_rgrp, *b_rexp, *w_down; const bf16* DL; bf16* X1B; unsigned char *X8, *W2; float* RS2; int* LISTS; unsigned* TOK; gu32* CNT; };
__device__ __forceinline__ void p5_route(const Frame& F, const P5Args& a) {
    const int tid = F.tid, lane = F.lane, wid = F.wave, i16 = lane & 15, h4 = lane >> 4;
    constexpr int LDA = 132;
    LAS float* A_l = (LAS float*)(F.lds + RING_OFF) + wid * 16 * LDA;
    LAS float* B_l = (LAS float*)(F.lds + RING_OFF + 67584);
    LAS float* LG = (LAS float*)(F.lds + RING_OFF + 94208);
    LAS float* rs_l = (LAS float*)(F.lds + RING_OFF + 113664);
    LAS int* hist = (LAS int*)(F.lds + RING_OFF + 114176);
    LAS int* base_l = (LAS int*)(F.lds + RING_OFF + 114432);
    {
        LAS float* scr = (LAS float*)(F.lds + RING_OFF + wid * 8704);
        const int gw = F.vcu * NWAVES + wid, NGW = F.G * NWAVES;
        for (int it = gw; it < 8192; it += NGW) { const int e = it >> 8, kb = (it >> 5) & 7, nb = it & 31; const float* W = a.w_down + (size_t)e * DE * DM;
            transpose_tile8(W + (size_t)(64 * kb) * DM + 32 * nb, DM, a.W2 + (size_t)(e * 1024 + 32 * nb) * DE + 64 * kb, DE, nullptr, pg8::W2_SCALE, scr, lane); }
    }
    __syncthreads();
    for (int rb = blockIdx.x; rb < T / 128; rb += F.G) {
        const int R0 = rb * 128;
        if (tid < 32) hist[tid] = 0;
        const int ar = lane >> 5, ac = 4 * (lane & 31);
        const size_t xo = (size_t)(R0 + 16 * wid + ar) * DM + ac; const float* xsrc = a.X + xo; const bf16* dsrc = a.DL + xo; unsigned char* xdst = a.X8 + xo; bf16* bdst = a.X1B + xo;
        f32x4 areg[8], breg[3]; unsigned long long dreg[8];
#define P5_LOAD(kc_) do { _Pragma("unroll") for (int i_ = 0; i_ < 8; ++i_) { areg[i_] = __builtin_nontemporal_load((const f32x4*)(xsrc + (size_t)(2 * i_) * DM + (kc_) * 128)); dreg[i_] = __builtin_nontemporal_load((const unsigned long long*)(dsrc + (size_t)(2 * i_) * DM + (kc_) * 128)); } \
        _Pragma("unroll") for (int q_ = 0; q_ < 3; ++q_) { const int idx_ = tid + 512 * q_; breg[q_] = *(const f32x4*)(a.WRT + (size_t)(idx_ >> 5) * DM + (kc_) * 128 + 4 * (idx_ & 31)); } } while (0)
        P5_LOAD(0);
        f32x4 acc[3] = {{0.f, 0.f, 0.f, 0.f}, {0.f, 0.f, 0.f, 0.f}, {0.f, 0.f, 0.f, 0.f}}; float ss = 0.f;
        for (int kc = 0; kc < 8; ++kc) {
#pragma unroll
            for (int i = 0; i < 8; ++i) { const unsigned dl = (unsigned)dreg[i], dh = (unsigned)(dreg[i] >> 32);
                areg[i][0] += bf_lo(dl); areg[i][1] += bf_hi(dl); areg[i][2] += bf_lo(dh); areg[i][3] += bf_hi(dh);
                *(unsigned*)(xdst + (size_t)(2 * i) * DM + kc * 128) = pg8::pack4_fp8(areg[i][0], areg[i][1], areg[i][2], areg[i][3]);
                *(unsigned long long*)(bdst + (size_t)(2 * i) * DM + kc * 128) = (unsigned long long)pg8::cvt_pk_bf16(areg[i][0], areg[i][1]) | ((unsigned long long)pg8::cvt_pk_bf16(areg[i][2], areg[i][3]) << 32);
                *(LAS f32x4*)(A_l + (2 * i + ar) * LDA + ac) = areg[i]; }
#pragma unroll
            for (int q = 0; q < 3; ++q) { const int idx = tid + 512 * q; *(LAS f32x4*)(B_l + (idx >> 5) * LDA + 4 * (idx & 31)) = breg[q]; }
            __syncthreads();
            if (kc + 1 < 8) P5_LOAD(kc + 1);
#pragma unroll
            for (int jj = 0; jj < 8; ++jj) {
                const f32x4 af = *(const LAS f32x4*)(A_l + i16 * LDA + 16 * jj + 4 * h4);
                f32x4 bfv[3];
#pragma unroll
                for (int nt = 0; nt < 3; ++nt) bfv[nt] = *(const LAS f32x4*)(B_l + (16 * nt + i16) * LDA + 16 * jj + 4 * h4);
                ss += (af[0] * af[0] + af[1] * af[1]) + (af[2] * af[2] + af[3] * af[3]);
#pragma unroll
                for (int s = 0; s < 4; ++s)
#pragma unroll
                    for (int nt = 0; nt < 3; ++nt) acc[nt] = __builtin_amdgcn_mfma_f32_16x16x4f32(af[s], bfv[nt][s], acc[nt], 0, 0, 0);
            }
            __syncthreads();
        }
#undef P5_LOAD
        ss += __shfl_xor(ss, 16); ss += __shfl_xor(ss, 32);
        const float rs = 1.0f / sqrtf(ss * (1.0f / DM) + EPS);
        if (h4 == 0) { a.RS2[R0 + 16 * wid + i16] = rs; rs_l[16 * wid + i16] = rs; }
#pragma unroll
        for (int r = 0; r < 4; ++r) { const int rl = 16 * wid + 4 * h4 + r; LG[rl * 37 + i16] = acc[0][r]; LG[rl * 37 + 16 + i16] = acc[1][r]; if (i16 < 4) LG[rl * 37 + 32 + i16] = acc[2][r]; }
        __syncthreads();
        int e0 = 0, e1 = 0, k0 = 0, k1 = 0; float w0 = 0.f, w1 = 0.f;
        if (tid < 128) {
            const float rsv = rs_l[tid]; const LAS float* lg = LG + tid * 37;
            float gl[4];
#pragma unroll
            for (int q = 0; q < 4; ++q) gl[q] = lg[32 + q] * rsv + a.b_rgrp[q];
            int gs = 0; float gm = gl[0];
#pragma unroll
            for (int q = 1; q < 4; ++q) if (gl[q] > gm) { gm = gl[q]; gs = q; }
            float den = 0.f;
#pragma unroll
            for (int q = 0; q < 4; ++q) den += expf(gl[q] - gm);
            const float pg = 1.0f / den;
            float el[8];
#pragma unroll
            for (int q = 0; q < 8; ++q) el[q] = lg[8 * gs + q] * rsv + a.b_rexp[8 * gs + q];
            int i0 = 0; float v0 = el[0];
#pragma unroll
            for (int q = 1; q < 8; ++q) if (el[q] > v0) { v0 = el[q]; i0 = q; }
            int i1 = -1; float v1 = -INFINITY;
#pragma unroll
            for (int q = 0; q < 8; ++q) if (q != i0 && el[q] > v1) { v1 = el[q]; i1 = q; }
            const float ex = expf(v1 - v0);
            w0 = pg / (1.0f + ex); w1 = pg * ex / (1.0f + ex);
            e0 = 8 * gs + i0; e1 = 8 * gs + i1;
            k0 = atomicAdd((int*)(hist + e0), 1); k1 = atomicAdd((int*)(hist + e1), 1);
        }
        __syncthreads();
        if (tid < 32) base_l[tid] = (int)__hip_atomic_fetch_add(a.CNT + tid, (unsigned)hist[tid], __ATOMIC_RELAXED, __HIP_MEMORY_SCOPE_AGENT);
        __syncthreads();
        if (tid < 128) { const int tok = R0 + tid, s0 = base_l[e0] + k0, s1 = base_l[e1] + k1;
            a.LISTS[(size_t)e0 * T + s0] = tok; a.LISTS[(size_t)e1 * T + s1] = tok;
            v4u i0v = {(unsigned)e0, (unsigned)s0, (unsigned)e1, (unsigned)s1}, i1v = {__float_as_uint(w0), __float_as_uint(w1), 0u, 0u};
            *(GAS v4u*)(a.TOK + (size_t)tok * 8) = i0v; *(GAS v4u*)(a.TOK + (size_t)tok * 8 + 4) = i1v; }
        __syncthreads();
    }
}
__device__ __forceinline__ void build_tables(const Frame& F, const gu32* CNT) {
    LAS int* ps = (LAS int*)(F.lds + TBL_PS); LAS int* cn = (LAS int*)(F.lds + TBL_CN); LAS int* te = (LAS int*)(F.lds + TBL_TE);
    __syncthreads();
    if (F.tid < 32) { int c = (int)__hip_atomic_load(CNT + F.tid, __ATOMIC_RELAXED, __HIP_MEMORY_SCOPE_AGENT); c = c < 0 ? 0 : (c > T ? T : c); cn[F.tid] = c; }
    __syncthreads();
    if (F.tid == 0) { int run = 0; for (int e = 0; e < 32; ++e) { ps[e] = run; run += (cn[e] + 255) & ~255; } if (run > PMAX) run = PMAX; ps[32] = run; }
    __syncthreads();
    if (F.tid < 288) { const int p = F.tid * 256; int e = 0; for (int q = 1; q < 32; ++q) if (p >= ps[q]) e = q; te[F.tid] = e; }
    __syncthreads();
}
__device__ __forceinline__ void build_rowtab(const Frame& F, const pg8::GroupedOrder& S, const int* LISTS, const float* RS2, LAS int* rowtab) {
    const LAS int* ps = (const LAS int*)(F.lds + TBL_PS); const LAS int* cn = (const LAS int*)(F.lds + TBL_CN); const LAS int* te = (const LAS int*)(F.lds + TBL_TE);
    pg8::Unit u;
    for (int ui = 0; ui < 6 && S.next(ui, u); ++ui)
        if (F.tid < 256) { const int p = u.pm * 256 + F.tid, e = te[u.pm], local = p - ps[e]; const int tok = local < cn[e] ? LISTS[(size_t)e * T + local] : 0; rowtab[ui * 256 + F.tid] = tok; ((LAS float*)rowtab)[(6 + ui) * 256 + F.tid] = RS2[tok]; }
    __syncthreads();
}
__device__ __forceinline__ float fp8_f32(unsigned w, int i) { return i == 0 ? __builtin_amdgcn_cvt_f32_fp8(w, 0) : (i == 1 ? __builtin_amdgcn_cvt_f32_fp8(w, 1) : (i == 2 ? __builtin_amdgcn_cvt_f32_fp8(w, 2) : __builtin_amdgcn_cvt_f32_fp8(w, 3))); }
__device__ __forceinline__ void p9_final(const Frame& F, const bf16* X1B, float* OUT, const unsigned char* Y, const unsigned* TOK, const float* g_final) {
    const LAS int* ps = (const LAS int*)(F.lds + TBL_PS);
    const int gw = F.vcu * NWAVES + F.wave, NGW = F.G * NWAVES;
    f32x4 gf[4];
#pragma unroll
    for (int j = 0; j < 4; ++j) gf[j] = *((const f32x4*)g_final + F.lane + 64 * j);
    constexpr float YS = 1.0f / (pg8::HB_SCALE * pg8::W2_SCALE * pg8::Y_SCALE);
    v4u ia_n = {0u, 0u, 0u, 0u}, ib_n = {0u, 0u, 0u, 0u}, ia_c = ia_n, ib_c = ib_n; unsigned long long xw_n[4]; unsigned ya_n[4], yb_n[4];
#define P9_TOK(m_, ia_, ib_) do { ia_ = *(const GAS v4u*)(TOK + (size_t)(m_) * 8); ib_ = *(const GAS v4u*)(TOK + (size_t)(m_) * 8 + 4); } while (0)
#define P9_ROW(m_, ia_) do { const size_t p0_ = (size_t)(ps[(int)(ia_.x & 31u)] + (int)ia_.y), p1_ = (size_t)(ps[(int)(ia_.z & 31u)] + (int)ia_.w); \
        const GAS unsigned long long* xr_ = (const GAS unsigned long long*)(X1B + (size_t)(m_) * DM) + F.lane; \
        const GAS unsigned* y0_ = (const GAS unsigned*)(Y + p0_ * DM) + F.lane; const GAS unsigned* y1_ = (const GAS unsigned*)(Y + p1_ * DM) + F.lane; \
        _Pragma("unroll") for (int j = 0; j < 4; ++j) { xw_n[j] = __builtin_nontemporal_load((const unsigned long long*)xr_ + 64 * j); ya_n[j] = __builtin_nontemporal_load((const unsigned*)y0_ + 64 * j); yb_n[j] = __builtin_nontemporal_load((const unsigned*)y1_ + 64 * j); } } while (0)
    if (gw < T) { P9_TOK(gw, ia_c, ib_c); P9_ROW(gw, ia_c); if (gw + NGW < T) P9_TOK(gw + NGW, ia_n, ib_n); }
    for (int m = gw; m < T; m += NGW) {
        const float w0 = __uint_as_float(ib_c.x) * YS, w1 = __uint_as_float(ib_c.y) * YS;
        unsigned long long xw[4]; unsigned ya[4], yb[4];
#pragma unroll
        for (int j = 0; j < 4; ++j) { xw[j] = xw_n[j]; ya[j] = ya_n[j]; yb[j] = yb_n[j]; }
        if (m + NGW < T) { ia_c = ia_n; ib_c = ib_n; P9_ROW(m + NGW, ia_c); if (m + 2 * NGW < T) P9_TOK(m + 2 * NGW, ia_n, ib_n); }
        GAS f32x4* orow = (GAS f32x4*)(OUT + (size_t)m * DM) + F.lane;
        f32x4 v[4]; float s = 0.f;
#pragma unroll
        for (int j = 0; j < 4; ++j) { v[j] = (f32x4){bf_lo((unsigned)xw[j]), bf_hi((unsigned)xw[j]), bf_lo((unsigned)(xw[j] >> 32)), bf_hi((unsigned)(xw[j] >> 32))}; const unsigned a = ya[j], b = yb[j];
            v[j].x += w0 * fp8_f32(a, 0) + w1 * fp8_f32(b, 0); v[j].y += w0 * fp8_f32(a, 1) + w1 * fp8_f32(b, 1);
            v[j].z += w0 * fp8_f32(a, 2) + w1 * fp8_f32(b, 2); v[j].w += w0 * fp8_f32(a, 3) + w1 * fp8_f32(b, 3);
            s += (v[j].x * v[j].x + v[j].y * v[j].y) + (v[j].z * v[j].z + v[j].w * v[j].w); }
        s = wave_sum(s);
        const float rs = 1.0f / sqrtf(s * (1.0f / DM) + EPS);
#pragma unroll
        for (int j = 0; j < 4; ++j) orow[64 * j] = v[j] * rs * gf[j];
    }
#undef P9_TOK
#undef P9_ROW
}

constexpr int N_PHASES = 10;
#ifndef DUP_TRIVIAL
#define DUP_TRIVIAL 0
#endif
#ifndef DUP_PHASE
#define DUP_PHASE -1
#endif
typedef __attribute__((address_space(4))) const unsigned char* karg_ptr;
__device__ __forceinline__ const float* arg_in(int k) { karg_ptr base = (karg_ptr)__builtin_amdgcn_kernarg_segment_ptr(); const unsigned long long v = *(const unsigned long long volatile __attribute__((address_space(4)))*)(base + 8 * k); return (const float*)(const GAS float*)v; }
struct Args { const float* in[23]; float* out; unsigned char* ws; int ph_lo, ph_hi, mode, pad; };
__global__ void __launch_bounds__(NWAVES * 64, 2) fwd_kernel(Args args) {
    extern __shared__ __attribute__((aligned(16))) unsigned char lds[];
    Frame F;
    F.lds = (LAS unsigned char*)lds;
    F.wave = __builtin_amdgcn_readfirstlane((int)threadIdx.x >> 6); F.lane = pg8::lane_now(); F.tid = F.wave * 64 + F.lane;
    F.G = gridDim.x; { const int bx = blockIdx.x; F.vcu = (F.G % 8 == 0) ? (bx % 8) * (F.G / 8) + bx / 8 : bx; }
    unsigned char* ws = args.ws;
    gu32* ctl = (gu32*)(ws + WS_CTL);
    volatile LAS unsigned* MISC = (volatile LAS unsigned*)(F.lds + MISC_OFF);
    for (int u = F.tid; u < (LDS_BYTES - LDSCTL_OFF) / 4; u += NWAVES * 64) ((LAS unsigned*)(F.lds + LDSCTL_OFF))[u] = 0u;
    __syncthreads();
#if MK_ONE_LAUNCH
    XcdBarrier bar = xcd_barrier_post((unsigned*)(ctl + CW_BAR), MISC + 8);
#define GRID_BAR() xcd_barrier(bar)
#else
#define GRID_BAR() do { } while (0)
#endif
    const int lo = args.ph_lo, hi = args.ph_hi;
#ifndef PH_MASK
#define PH_MASK 0x3ff
#endif
#define IN(k) (((PH_MASK >> (k)) & 1) && lo <= (k) && (k) < hi)
#define BOTH(k) (IN(k) && IN((k) + 1))
    float* out = args.out;
    bf16* Win = (bf16*)(ws + WS_WIN); bf16* Wl = (bf16*)(ws + WS_WL); bf16* Wa = (bf16*)(ws + WS_WA); bf16* Wo = (bf16*)(ws + WS_WO); bf16* Wrg = (bf16*)(ws + WS_WRG);
    bf16* XB = (bf16*)(ws + WS_XB); bf16* XR = (bf16*)(ws + WS_XR); bf16* GG = (bf16*)(ws + WS_GG); bf16* Qb = (bf16*)(ws + WS_Q); bf16* Kb = (bf16*)(ws + WS_K); bf16* Vb = (bf16*)(ws + WS_V);
    bf16* SL = (bf16*)out; bf16* SA = (bf16*)out + pg8::SEGE;
    float* RS1 = (float*)(ws + WS_RS1); float* RS2 = (float*)(ws + WS_RS2); float* LF = (float*)(ws + WS_LF); float* CB = (float*)(ws + WS_CB);
    unsigned* TOK = (unsigned*)(ws + WS_TOK); int* LISTS = (int*)(ws + WS_LISTS); float* WRT = (float*)(ws + WS_WRT); int* JLO = (int*)(ws + WS_SRS);
    unsigned char* W13 = ws + WS_W13; unsigned char* W2 = ws + WS_W2; bf16* XG = (bf16*)(ws + WS_XG); unsigned char* HB = ws + WS_HB; unsigned char* X8 = ws + WS_XB;
    gu32* CNT = ctl + CW_CNT;

    if (IN(0)) { F.lane = pg8::lane_now(); F.tid = F.wave * 64 + F.lane;
        P0Args a{arg_in(0), arg_in(1), arg_in(2), arg_in(5), arg_in(7), arg_in(10), arg_in(11), arg_in(12), arg_in(13), arg_in(14), arg_in(15), arg_in(17), arg_in(19), arg_in(20), Win, Wl, Wa, Wo, Wrg, XB, W13, RS1, LF, WRT};
        p0_prologue(F, a, DUP_PHASE == 0 ? args.mode : 0);
        if (BOTH(0)) GRID_BAR();
    }
    if (IN(1)) { F.lane = pg8::lane_now(); F.tid = F.wave * 64 + F.lane;
        cumsum_bias(F, LF, CB);
        pg8::Gemm g{XB, Win, T, NZ, DM}; pg8::StaticOrder S; S.init(T, NZ, F.G, (int)blockIdx.x);
        pg8::EpiZ E{XR, SL, RS1, (unsigned*)(ctl + CW_NORM), args.mode};
        pg8::gemm_phase<pg8::EpiZ, pg8::StaticOrder, true, true>(F.lds + RING_OFF, g, S, E, F.wave);
        if (BOTH(1)) GRID_BAR();
    }
    if (IN(2)) { F.lane = pg8::lane_now(); F.tid = F.wave * 64 + F.lane;
        { const int gw = F.vcu * NWAVES + F.wave; if (gw < NB * NH * 16) { const int j = attn_jlo(F, CB, (const unsigned*)(ctl + CW_NORM), gw >> 4, gw & 15); if (F.lane == 0) JLO[gw] = j; } }
        conv_prepass(F, XR, XB, arg_in(3), arg_in(4));
        if (BOTH(2)) GRID_BAR();
    }
    if (IN(3)) { F.lane = pg8::lane_now(); F.tid = F.wave * 64 + F.lane;
        RgArgs ra{XB, GG, GG, Wrg, arg_in(6), arg_in(8), arg_in(9)};
#if DUP_PHASE >= 20
        const int mode = args.mode;
#else
        constexpr int mode = 0;
#endif
        if (mode != 2) { ra.GO = mode == 1 ? XR : GG; for (int u = F.vcu; u < 256; u += F.G) rglru_unit(F, ra, u); }
        if (mode != 1) attn_phase(F, (char*)lds + RING_OFF, Qb, XR, Kb, Vb, CB, JLO, ctl + CW_QCTR + (mode == 2 ? 1024 : 0));
        if (BOTH(3)) GRID_BAR();
    }
    if (IN(4)) { { F.lane = pg8::lane_now(); F.tid = F.wave * 64 + F.lane;
        static_assert(WS_GG - WS_XR == (size_t)128 * 256 * DM * 2 && WS_WL - WS_WA == (size_t)4 * 256 * DM * 2, "TwoGemmOrder: hg follows o by 128 row tiles, Wl follows Wa by 4 column tiles");
        pg8::Gemm g{XR, Wa, T, DM, DM}; pg8::TwoGemmOrder S; S.init(T, DM, F.G, (int)blockIdx.x);
        pg8::EpiGate2 E{SA, SL, XB};
        pg8::gemm_phase<pg8::EpiGate2, pg8::TwoGemmOrder, true, true>(F.lds + RING_OFF, g, S, E, F.wave); }
        if (BOTH(4)) GRID_BAR();
    }
    if (IN(5)) { F.lane = pg8::lane_now(); F.tid = F.wave * 64 + F.lane;
        pg8::Gemm g{XB, Wo, T, DM, DM}; pg8::StaticOrder S; S.init(T, DM, F.G, (int)blockIdx.x);
        pg8::EpiDelta E{(bf16*)out};
        pg8::gemm_phase<pg8::EpiDelta, pg8::StaticOrder, true, true>(F.lds + RING_OFF, g, S, E, F.wave);
        if (BOTH(5)) GRID_BAR();
    }
    if (IN(6)) { F.lane = pg8::lane_now(); F.tid = F.wave * 64 + F.lane;
        P5Args a{arg_in(0), WRT, arg_in(16), arg_in(18), arg_in(21), (const bf16*)out, XR, X8, W2, RS2, LISTS, TOK, args.mode ? CNT + 64 : CNT};
        p5_route(F, a);
        if (BOTH(6)) GRID_BAR();
    }
    if (IN(7)) { F.lane = pg8::lane_now(); F.tid = F.wave * 64 + F.lane;
        build_tables(F, CNT);
        const int ntiles = ((const LAS int*)(F.lds + TBL_PS))[32] >> 8;
        pg8::Gemm g{(const bf16*)X8, (const bf16*)W13, ntiles * 256, 32 * 1024, DM / 2}; pg8::GroupedOrder S{(const LAS int*)(F.lds + TBL_TE), ntiles * 4, F.G, F.vcu};
        LAS int* rowtab = (LAS int*)(F.lds + RG_TOT);
        build_rowtab(F, S, LISTS, RS2, rowtab);
        pg8::EpiSwiGLU E{HB};
        pg8::gemm_phase_gather<pg8::EpiSwiGLU, pg8::GroupedOrder, true>(F.lds + RING_OFF, g, S, E, rowtab, F.wave);
        if (BOTH(7)) GRID_BAR();
    }
    if (IN(8)) { F.lane = pg8::lane_now(); F.tid = F.wave * 64 + F.lane;
        build_tables(F, CNT);
        const int ntiles = ((const LAS int*)(F.lds + TBL_PS))[32] >> 8;
        pg8::Gemm g{(const bf16*)HB, (const bf16*)W2, ntiles * 256, 32 * 1024, DE / 2}; pg8::GroupedOrder S{(const LAS int*)(F.lds + TBL_TE), ntiles * 4, F.G, F.vcu};
        pg8::EpiY E{(unsigned char*)XG};
        pg8::gemm_phase<pg8::EpiY, pg8::GroupedOrder, true, true, true>(F.lds + RING_OFF, g, S, E, F.wave);
        if (BOTH(8)) GRID_BAR();
    }
    if (IN(9)) { F.lane = pg8::lane_now(); F.tid = F.wave * 64 + F.lane;
        build_tables(F, CNT);
        p9_final(F, XR, out, (const unsigned char*)XG, TOK, arg_in(22));
    }
#undef IN
#undef BOTH
}

extern "C" void kernel_launch(void* const* d_in, const int* in_sizes, int n_in, void* d_out, int out_size, void* d_ws, size_t ws_size, hipStream_t stream) {
    static int grid = 0;
    if (grid == 0) {
        if (n_in != 23 || in_sizes[0] != T * DM || out_size != T * DM || ws_size < WS_END) { fprintf(stderr, "kernel_launch: unexpected shapes (n_in %d, in0 %d, out %d, ws %zu); nothing launched\n", n_in, n_in > 0 ? in_sizes[0] : -1, out_size, ws_size); grid = -1; return; }
        int dev = 0, cus = 0;
        if (hipGetDevice(&dev) != hipSuccess || hipDeviceGetAttribute(&cus, hipDeviceAttributeMultiprocessorCount, dev) != hipSuccess) { grid = -1; return; }
        if (hipFuncSetAttribute((const void*)fwd_kernel, hipFuncAttributeMaxDynamicSharedMemorySize, LDS_BYTES) != hipSuccess) { fprintf(stderr, "kernel_launch: hipFuncSetAttribute failed\n"); grid = -1; return; }
        int per_cu = 0;
        if (hipOccupancyMaxActiveBlocksPerMultiprocessor(&per_cu, (const void*)fwd_kernel, NWAVES * 64, LDS_BYTES) != hipSuccess || per_cu < 1) { fprintf(stderr, "kernel_launch: occupancy query reports %d\n", per_cu); }
        (void)hipGetLastError();
        grid = cus;
    }
    if (grid < 0) return;
    if (hipMemsetAsync((char*)d_ws + WS_CTL, 0, CTL_ZERO_BYTES, stream) != hipSuccess) return;
    Args a{};
    for (int i = 0; i < 23; ++i) a.in[i] = (const float*)d_in[i];
    a.out = (float*)d_out; a.ws = (unsigned char*)d_ws;
#if MK_ONE_LAUNCH
    a.ph_lo = 0; a.ph_hi = N_PHASES;
    hipLaunchKernelGGL(fwd_kernel, dim3(grid), dim3(NWAVES * 64), LDS_BYTES, stream, a);
#else
    for (int ph = 0; ph < N_PHASES; ++ph) { a.ph_lo = ph; a.ph_hi = ph + 1;
        if (DUP_PHASE == ph || (ph == 3 && DUP_PHASE >= 20)) { a.mode = DUP_PHASE >= 20 ? DUP_PHASE - 19 : ((ph == 6 || (ph == 1 && DUP_TRIVIAL)) ? 1 : (ph == 0 ? DUP_TRIVIAL : 0)); hipLaunchKernelGGL(fwd_kernel, dim3(grid), dim3(NWAVES * 64), LDS_BYTES, stream, a); a.mode = 0; }
        hipLaunchKernelGGL(fwd_kernel, dim3(grid), dim3(NWAVES * 64), LDS_BYTES, stream, a); }
#endif
}
```

```cpp
#include <hip/hip_runtime.h>
#include <cstdio>
#include <cstdint>

#ifndef MK_ONE_LAUNCH
#define MK_ONE_LAUNCH 1
#endif
namespace pg8 {
#define PG8_LAS __attribute__((address_space(3)))
typedef unsigned short bf16_t;
typedef short bf16x8 __attribute__((ext_vector_type(8)));
typedef float f32x4 __attribute__((ext_vector_type(4)));
typedef unsigned u32x4 __attribute__((ext_vector_type(4)));
constexpr int BM = 256, BK = 64, HALF = 128, HTB = HALF * BK * 2  , STAGE_BYTES = 8 * HTB, NXCD = 8, WGM = 8;

__host__ __device__ __forceinline__ int lds_byte(int r, int c) { const int st = (r >> 4) * 2 + (c >> 5), rr = r & 15, cc = c & 31, ob = rr * 64 + cc * 2; return st * 1024 + (ob ^ (((ob >> 9) & 1) << 5)); }
__host__ __device__ __forceinline__ void stage_rc(int b, int& R, int& C) { const int st = b / 1024, sb = b % 1024, swz = sb ^ (((sb >> 9) & 1) << 5); R = (st >> 1) * 16 + swz / 64; C = (st & 1) * 32 + (swz % 64) / 2; }
__host__ __device__ __forceinline__ int perm32(int rho) { const int n = rho >> 4, i = rho & 15; return 8 * (i >> 2) + 4 * n + (i & 3); }

struct Unit { int pm, pn; };
struct Gemm { const bf16_t* A; const bf16_t* Bt; int M, N, K; };

struct StaticOrder {
    int nM, nN, nwg, G, c;
    __host__ __device__ void init(int M, int N, int G_, int c_) { nM = M / BM; nN = N / BM; nwg = nM * nN; G = G_; c = c_; }
    __host__ __device__ bool next(int i, Unit& u) const {
        const long L = (long)i * G + c; if (L >= nwg) return false;
        int wgid = (int)L; { const int q = nwg / NXCD, r = nwg % NXCD, xcd = wgid % NXCD, off = wgid / NXCD; wgid = (xcd < r ? xcd * (q + 1) : r * (q + 1) + (xcd - r) * q) + off; }
        const int nig = WGM * nN, gid = wgid / nig, fm = gid * WGM, gsz = (nM - fm) < WGM ? (nM - fm) : WGM;
        u.pm = fm + ((wgid % nig) % gsz); u.pn = (wgid % nig) / gsz; return true;
    }
    __device__ __forceinline__ void a_ready(const Unit&) const {}
    __device__ __forceinline__ void done(const Unit&) const {}
};

__device__ __forceinline__ unsigned cvt_pk_bf16(float lo, float hi) { unsigned r; asm volatile("v_cvt_pk_bf16_f32 %0, %1, %2" : "=v"(r) : "v"(lo), "v"(hi)); return r; }
typedef float f32x2 __attribute__((ext_vector_type(2)));
__device__ __forceinline__ int lane_now() { int l; asm volatile("v_mbcnt_lo_u32_b32 %0, -1, 0\n\tv_mbcnt_hi_u32_b32 %0, -1, %0" : "=v"(l)); return l; }
typedef int v4i_t __attribute__((ext_vector_type(4)));
typedef int v8i_t __attribute__((ext_vector_type(8)));
__device__ __forceinline__ v8i_t cat8(bf16x8 a, bf16x8 b) { const v4i_t x = __builtin_bit_cast(v4i_t, a), y = __builtin_bit_cast(v4i_t, b); return __builtin_shufflevector(x, y, 0, 1, 2, 3, 4, 5, 6, 7); }
__device__ __forceinline__ void glds_sv(const char* base, unsigned voff, unsigned lds_dst) { unsigned keep;
    asm volatile("s_mov_b32 %0, m0\n\ts_mov_b32 m0, %3\n\ts_nop 0\n\tglobal_load_lds_dwordx4 %1, %2\n\ts_mov_b32 m0, %0" : "=&s"(keep) : "v"(voff), "s"(base), "s"(lds_dst) : "memory"); }
__device__ __forceinline__ float sat8(float x) { return __builtin_amdgcn_fmed3f(x, -448.0f, 448.0f); }
__device__ __forceinline__ unsigned pack4_fp8(float a, float b, float c, float d) { unsigned w = 0u; w = __builtin_amdgcn_cvt_pk_fp8_f32(sat8(a), sat8(b), w, false); w = __builtin_amdgcn_cvt_pk_fp8_f32(sat8(c), sat8(d), w, true); return w; }
constexpr float W13_SCALE = 64.0f, HB_SCALE = 8.0f, W2_SCALE = 32.0f;
__device__ __forceinline__ float sigmoid_f(float x) { return __builtin_amdgcn_rcpf(1.0f + __builtin_amdgcn_exp2f(-1.4426950408889634f * x)); }
__device__ __forceinline__ float gelu_tanh_f(float x) { const float u = x * (1.0f + 0.044715f * x * x); return x * __builtin_amdgcn_rcpf(1.0f + __builtin_amdgcn_exp2f(-2.3022081981f * u)); }
__device__ __forceinline__ float bf_lo(unsigned w) { return __builtin_bit_cast(float, w << 16); }
__device__ __forceinline__ float bf_hi(unsigned w) { return __builtin_bit_cast(float, w & 0xffff0000u); }
constexpr size_t SEGE = (size_t)32768 * 1024;

struct EpiZ {
    static constexpr bool PERM = true, AFTER_DRAIN = false; static constexpr int NSTORES = 16;
    bf16_t* ws5; bf16_t* out2; const float* rs; unsigned* norm; int probe;
    __device__ __forceinline__ void operator()(const f32x4 (&acc)[2][2][4][2], const Unit& u, int wr, int wc, int fr, int fq) const {
        const int seg = probe ? 0 : (u.pn >> 2); float nm[2] = {0.f, 0.f};
        const int sgo = u.pn >> 2; bf16_t* O = sgo < 5 ? ws5 + (size_t)sgo * SEGE : out2 + (size_t)(sgo - 5) * SEGE;
        const int row0 = u.pm * BM + wr * 64 + fr, col0 = (u.pn & 3) * BM + wc * 32 + 8 * fq;
#pragma unroll
        for (int ai = 0; ai < 2; ++ai)
#pragma unroll
            for (int m = 0; m < 4; ++m) { const int row = row0 + ai * HALF + m * 16; bf16_t* rowp = O + (size_t)row * 1024 + col0;
                const bool hm = (sgo >= 2 && sgo <= 4); bf16_t* rowh = O + ((size_t)((row >> 12) * 8 + 2 * (u.pn & 3)) * 4096 + (row & 4095)) * 128 + wc * 32 + 8 * fq;
#pragma unroll
                for (int bj = 0; bj < 2; ++bj) { f32x4 v0 = acc[ai][bj][m][0], v1 = acc[ai][bj][m][1];
                    if (seg == 1) {
#pragma unroll
                        for (int i = 0; i < 4; ++i) { v0[i] = gelu_tanh_f(v0[i]); v1[i] = gelu_tanh_f(v1[i]); } }
                    else if (seg >= 5) {
#pragma unroll
                        for (int i = 0; i < 4; ++i) { v0[i] = sigmoid_f(v0[i]); v1[i] = sigmoid_f(v1[i]); } }
                    if (seg == 2 || seg == 3) { float q = (v0[0] * v0[0] + v0[1] * v0[1]) + (v0[2] * v0[2] + v0[3] * v0[3]) + (v1[0] * v1[0] + v1[1] * v1[1]) + (v1[2] * v1[2] + v1[3] * v1[3]);
                        q += __shfl_xor(q, 16); q += __shfl_xor(q, 32); nm[bj] = fmaxf(nm[bj], q); }
                    u32x4 w; w.x = cvt_pk_bf16(v0[0], v0[1]); w.y = cvt_pk_bf16(v0[2], v0[3]); w.z = cvt_pk_bf16(v1[0], v1[1]); w.w = cvt_pk_bf16(v1[2], v1[3]);
                    *(u32x4*)(hm ? rowh + (size_t)bj * 4096 * 128 : rowp + bj * HALF) = w; } }
        if (seg == 2 || seg == 3) {
#pragma unroll
            for (int bj = 0; bj < 2; ++bj) { float q = nm[bj];
#pragma unroll
                for (int o = 1; o < 16; o <<= 1) q = fmaxf(q, __shfl_xor(q, o));
                if (fr == 0 && fq == 0) atomicMax(norm + ((((seg - 2) * 8 + (u.pm >> 4)) * 8 + 2 * (u.pn & 3) + bj) * 4 + wc), __float_as_uint(q)); }
        }
    }
};
template <int MODE> struct EpiGate {
    static constexpr bool PERM = true, AFTER_DRAIN = false; static constexpr int NSTORES = 16;
    const bf16_t* G; bf16_t* O;
    __device__ __forceinline__ void operator()(const f32x4 (&acc)[2][2][4][2], const Unit& u, int wr, int wc, int fr, int fq) const {
        const int row0 = u.pm * BM + wr * 64 + fr, col0 = u.pn * BM + wc * 32 + 8 * fq;
        u32x4 gv[2][2][2], pv[2][2][2];
#define EG_LOAD(st_, b_) do { _Pragma("unroll") for (int mm = 0; mm < 2; ++mm) _Pragma("unroll") for (int bj = 0; bj < 2; ++bj) { \
            const size_t off_ = (size_t)(row0 + ((st_) >> 1) * HALF + (2 * ((st_) & 1) + mm) * 16) * 1024 + col0 + bj * HALF; gv[b_][mm][bj] = __builtin_nontemporal_load((const u32x4*)(G + off_)); if (MODE == 1) pv[b_][mm][bj] = __builtin_nontemporal_load((const u32x4*)(O + off_)); } } while (0)
#define EG_DO(st_, b_) do { _Pragma("unroll") for (int mm = 0; mm < 2; ++mm) _Pragma("unroll") for (int bj = 0; bj < 2; ++bj) { const int ai = (st_) >> 1, m = 2 * ((st_) & 1) + mm; \
            const size_t off_ = (size_t)(row0 + ai * HALF + m * 16) * 1024 + col0 + bj * HALF; const u32x4 g = gv[b_][mm][bj]; \
            f32x4 v0 = acc[ai][bj][m][0], v1 = acc[ai][bj][m][1]; \
            v0[0] *= bf_lo(g.x); v0[1] *= bf_hi(g.x); v0[2] *= bf_lo(g.y); v0[3] *= bf_hi(g.y); v1[0] *= bf_lo(g.z); v1[1] *= bf_hi(g.z); v1[2] *= bf_lo(g.w); v1[3] *= bf_hi(g.w); \
            if (MODE == 1) { const u32x4 p = pv[b_][mm][bj]; \
                v0[0] += bf_lo(p.x); v0[1] += bf_hi(p.x); v0[2] += bf_lo(p.y); v0[3] += bf_hi(p.y); v1[0] += bf_lo(p.z); v1[1] += bf_hi(p.z); v1[2] += bf_lo(p.w); v1[3] += bf_hi(p.w); } \
            u32x4 w; w.x = cvt_pk_bf16(v0[0], v0[1]); w.y = cvt_pk_bf16(v0[2], v0[3]); w.z = cvt_pk_bf16(v1[0], v1[1]); w.w = cvt_pk_bf16(v1[2], v1[3]); \
            *(u32x4*)(O + off_) = w; } } while (0)
        EG_LOAD(0, 0); EG_LOAD(1, 1); EG_DO(0, 0); EG_LOAD(2, 0); EG_DO(1, 1); EG_LOAD(3, 1); EG_DO(2, 0); EG_DO(3, 1);
#undef EG_LOAD
#undef EG_DO
    }
};
struct TwoGemmOrder {
    StaticOrder base; int n1;
    __device__ void init(int M, int N, int G_, int c_) { base.init(M, N, G_, c_); n1 = (base.nwg - c_ + G_ - 1) / G_; if (n1 < 0) n1 = 0; }
    __device__ __forceinline__ bool next(int i, Unit& u) const { if (i >= 2 * n1) return false; const bool second = i >= n1; base.next(second ? i - n1 : i, u); if (second) { u.pm += 128; u.pn += 4; } return true; }
    __device__ __forceinline__ void a_ready(const Unit&) const {}
    __device__ __forceinline__ void done(const Unit&) const {}
};
struct EpiGate2 {
    static constexpr bool PERM = true, AFTER_DRAIN = false; static constexpr int NSTORES = 16;
    const bf16_t* G0; const bf16_t* G1; bf16_t* O;
    __device__ __forceinline__ void operator()(const f32x4 (&acc)[2][2][4][2], const Unit& u, int wr, int wc, int fr, int fq) const {
        Unit v; v.pm = u.pm & 127; v.pn = u.pn & 3;
        if (u.pm >= 128) { EpiGate<1> e{G1, O}; e(acc, v, wr, wc, fr, fq); } else { EpiGate<0> e{G0, O}; e(acc, v, wr, wc, fr, fq); }
    }
};
struct EpiDelta {
    static constexpr bool PERM = true, AFTER_DRAIN = false; static constexpr int NSTORES = 16;
    bf16_t* O;
    __device__ __forceinline__ void operator()(const f32x4 (&acc)[2][2][4][2], const Unit& u, int wr, int wc, int fr, int fq) const {
        const int row0 = u.pm * BM + wr * 64 + fr, col0 = u.pn * BM + wc * 32 + 8 * fq;
#pragma unroll
        for (int ai = 0; ai < 2; ++ai)
#pragma unroll
            for (int m = 0; m < 4; ++m) { bf16_t* rowp = O + (size_t)(row0 + ai * HALF + m * 16) * 1024 + col0;
#pragma unroll
                for (int bj = 0; bj < 2; ++bj) { const f32x4 v0 = acc[ai][bj][m][0], v1 = acc[ai][bj][m][1];
                    u32x4 w; w.x = cvt_pk_bf16(v0[0], v0[1]); w.y = cvt_pk_bf16(v0[2], v0[3]); w.z = cvt_pk_bf16(v1[0], v1[1]); w.w = cvt_pk_bf16(v1[2], v1[3]);
                    *(u32x4*)(rowp + bj * HALF) = w; } }
    }
};
struct EpiSwiGLU {
    static constexpr bool PERM = true, AFTER_DRAIN = false; static constexpr int NSTORES = 8;
    unsigned char* HB;
    __device__ __forceinline__ void operator()(const f32x4 (&acc)[2][2][4][2], const Unit& u, int wr, int wc, int fr, int fq, const PG8_LAS int* rows) const {
        const int row0 = u.pm * BM + wr * 64 + fr, col0 = (u.pn & 3) * HALF + wc * 32 + 8 * fq;
        float sv[2][4];
#pragma unroll
        for (int ai = 0; ai < 2; ++ai)
#pragma unroll
            for (int m = 0; m < 4; ++m) sv[ai][m] = ((const PG8_LAS float*)rows)[6 * 256 + wr * 64 + fr + ai * HALF + m * 16] * (1.0f / W13_SCALE);
#pragma unroll
        for (int ai = 0; ai < 2; ++ai)
#pragma unroll
            for (int m = 0; m < 4; ++m) { const int row = row0 + ai * HALF + m * 16; const float s = sv[ai][m];
                float o[8];
#pragma unroll
                for (int n = 0; n < 2; ++n)
#pragma unroll
                    for (int i = 0; i < 4; ++i) { const float g = acc[ai][0][m][n][i] * s, uu = acc[ai][1][m][n][i] * s; o[n * 4 + i] = g * sigmoid_f(g) * uu * HB_SCALE; }
                unsigned long long w = (unsigned long long)pack4_fp8(o[0], o[1], o[2], o[3]) | ((unsigned long long)pack4_fp8(o[4], o[5], o[6], o[7]) << 32);
                *(unsigned long long*)(HB + (size_t)row * 512 + col0) = w; }
    }
};
constexpr float Y_SCALE = 0.25f;
struct EpiY {
    static constexpr bool PERM = true, AFTER_DRAIN = false; static constexpr int NSTORES = 16;
    unsigned char* Y;
    __device__ __forceinline__ void operator()(const f32x4 (&acc)[2][2][4][2], const Unit& u, int wr, int wc, int fr, int fq) const {
        const int row0 = u.pm * BM + wr * 64 + fr, col0 = (u.pn & 3) * BM + wc * 32 + 8 * fq;
#pragma unroll
        for (int ai = 0; ai < 2; ++ai)
#pragma unroll
            for (int m = 0; m < 4; ++m) { const int row = row0 + ai * HALF + m * 16; unsigned char* rowp = Y + (size_t)row * 1024 + col0;
#pragma unroll
                for (int bj = 0; bj < 2; ++bj) { const f32x4 v0 = acc[ai][bj][m][0] * Y_SCALE, v1 = acc[ai][bj][m][1] * Y_SCALE;
                    *(unsigned long long*)(rowp + bj * HALF) = (unsigned long long)pack4_fp8(v0[0], v0[1], v0[2], v0[3]) | ((unsigned long long)pack4_fp8(v1[0], v1[1], v1[2], v1[3]) << 32); } }
    }
};
struct GroupedOrder {
    const PG8_LAS int* tile_e; int nunits, G, c;
    __device__ __forceinline__ bool next(int i, Unit& u) const { const int L = i * G + c; if (L >= nunits) return false; u.pm = L >> 2; u.pn = __builtin_amdgcn_readfirstlane(tile_e[u.pm]) * 4 + (L & 3); return true; }
    __device__ __forceinline__ void a_ready(const Unit&) const {}
    __device__ __forceinline__ void done(const Unit&) const {}
};
template <class Epi, class Sched, bool ALIGN_EPI = false, bool SP2 = false, bool F8 = false>
__device__ __forceinline__ void gemm_phase(PG8_LAS unsigned char* lds, const Gemm g, const Sched& S, const Epi& E, const int wid) {
    const int lane = lane_now(), tid = wid * 64 + lane, wr = wid >> 2, wc = wid & 3, fr = lane & 15, fq = lane >> 4;
    const int K = g.K, nt = K / BK;
    unsigned voffA[2], voffB[2];
#pragma unroll
    for (int i = 0; i < 2; ++i) { int R, C; stage_rc(tid * 16 + i * 8192, R, C); const int Rb = Epi::PERM ? ((R & ~31) + perm32(R & 31)) : R;
        voffA[i] = (unsigned)(R * K + C) * 2u; voffB[i] = (unsigned)(Rb * K + C) * 2u; }
    const size_t kstep = (size_t)(BK * 2);
    const size_t hstep = (size_t)HALF * K * 2;
    const size_t tstep = 2 * hstep;
    const unsigned ldsw = (unsigned)wid * 1024u;
    const unsigned ldsbase = (unsigned)__builtin_amdgcn_readfirstlane((int)((unsigned)(uintptr_t)lds + ldsw));
    const int aoff = lds_byte(wr * 64 + fr, fq * 8), boff = lds_byte(wc * 32 + fr, fq * 8);
#define PG8_SA(b, h) (((b) * 2 + (h)) * HTB)
#define PG8_SB(b, h) ((4 + (b) * 2 + (h)) * HTB)
#define PG8_STAGE(bufoff, gbase, voff) do { _Pragma("unroll") for (int _i = 0; _i < 2; ++_i) { \
        if constexpr (F8) glds_sv((const char*)(gbase), (voff)[_i], ldsbase + (unsigned)((bufoff) + _i * 8192)); \
        else __builtin_amdgcn_global_load_lds((const unsigned*)((const char*)(gbase) + (voff)[_i]), (PG8_LAS unsigned*)(lds + (bufoff) + ldsw + _i * 8192), 16, 0, 0); } } while (0)
#define PG8_LDA(dst, b, h) do { _Pragma("unroll") for (int m = 0; m < 4; ++m) { \
        if constexpr (F8) { dst##8[m] = cat8(*(const PG8_LAS bf16x8*)(lds + PG8_SA(b, h) + aoff + m * 2048), *(const PG8_LAS bf16x8*)(lds + PG8_SA(b, h) + aoff + m * 2048 + 1024)); } \
        else { _Pragma("unroll") for (int k = 0; k < 2; ++k) dst[m][k] = *(const PG8_LAS bf16x8*)(lds + PG8_SA(b, h) + aoff + m * 2048 + k * 1024); } } } while (0)
#define PG8_LDB(dst, b, h) do { _Pragma("unroll") for (int n = 0; n < 2; ++n) { \
        if constexpr (F8) { dst##8[n] = cat8(*(const PG8_LAS bf16x8*)(lds + PG8_SB(b, h) + boff + n * 2048), *(const PG8_LAS bf16x8*)(lds + PG8_SB(b, h) + boff + n * 2048 + 1024)); } \
        else { _Pragma("unroll") for (int k = 0; k < 2; ++k) dst[n][k] = *(const PG8_LAS bf16x8*)(lds + PG8_SB(b, h) + boff + n * 2048 + k * 1024); } } } while (0)
#define PG8_MMA(ai, bj, At, Bt) do { __builtin_amdgcn_s_setprio(1); _Pragma("unroll") for (int m = 0; m < 4; ++m) _Pragma("unroll") for (int n = 0; n < 2; ++n) { \
        if constexpr (F8) { acc[ai][bj][m][n] = __builtin_amdgcn_mfma_scale_f32_16x16x128_f8f6f4(Bt##8[n], At##8[m], acc[ai][bj][m][n], 0, 0, 0, 0, 0, 0); } \
        else { _Pragma("unroll") for (int k = 0; k < 2; ++k) acc[ai][bj][m][n] = __builtin_amdgcn_mfma_f32_16x16x32_bf16(Bt[n][k], At[m][k], acc[ai][bj][m][n], 0, 0, 0); } } \
        __builtin_amdgcn_s_setprio(0); } while (0)
#define PG8_WAIT_V(n) asm volatile("s_waitcnt vmcnt(" #n ")" ::: "memory")
#define PG8_WAIT_L(n) asm volatile("s_waitcnt lgkmcnt(" #n ")" ::: "memory")
#define PG8_BAR __builtin_amdgcn_s_barrier()
#define PG8_SCHED __builtin_amdgcn_sched_barrier(0)
    Unit cur, nxt; int ui = 0;
    if (!S.next(0, cur)) return;
    f32x4 acc[2][2][4][2];
#pragma unroll
    for (int a = 0; a < 2; ++a)
#pragma unroll
        for (int b = 0; b < 2; ++b)
#pragma unroll
            for (int m = 0; m < 4; ++m)
#pragma unroll
                for (int n = 0; n < 2; ++n) acc[a][b][m][n] = (f32x4){0.f, 0.f, 0.f, 0.f};
    bf16x8 At[4][2], B0[2][2], B1[2][2]; v8i_t At8[4], B08[2], B18[2];
    const char* cA = (const char*)g.A + (size_t)cur.pm * tstep; const char* cB = (const char*)g.Bt + (size_t)cur.pn * tstep;
    S.a_ready(cur);
    if constexpr (SP2) {
        PG8_STAGE(PG8_SB(0, 0), cB, voffB); PG8_STAGE(PG8_SB(0, 1), cB + hstep, voffB); PG8_STAGE(PG8_SA(0, 0), cA, voffA); PG8_STAGE(PG8_SA(0, 1), cA + hstep, voffA);
        if (wr == 1) PG8_BAR;
        PG8_WAIT_V(2); PG8_BAR;
        PG8_STAGE(PG8_SB(1, 0), cB + kstep, voffB); PG8_STAGE(PG8_SA(1, 0), cA + kstep, voffA); PG8_STAGE(PG8_SB(1, 1), cB + hstep + kstep, voffB);
        PG8_WAIT_V(6); PG8_BAR;
    } else {
        PG8_STAGE(PG8_SB(0, 0), cB, voffB); PG8_STAGE(PG8_SA(0, 0), cA, voffA); PG8_STAGE(PG8_SB(0, 1), cB + hstep, voffB); PG8_STAGE(PG8_SA(0, 1), cA + hstep, voffA);
        if (wr == 1) PG8_BAR;
        PG8_WAIT_V(4); PG8_BAR;
        PG8_STAGE(PG8_SB(1, 0), cB + kstep, voffB); PG8_STAGE(PG8_SA(1, 0), cA + kstep, voffA); PG8_STAGE(PG8_SB(1, 1), cB + hstep + kstep, voffB);
        PG8_WAIT_V(6); PG8_BAR;
    }
    for (;;) {
        const bool has_next = S.next(ui + 1, nxt);
        const char* nA = has_next ? (const char*)g.A + (size_t)nxt.pm * tstep : cA; const char* nB = has_next ? (const char*)g.Bt + (size_t)nxt.pn * tstep : cB;
#pragma clang loop unroll(disable)
        for (int t = 0; t < nt; t += 2) {
            const bool last = (t == nt - 2);
            const char* a1 = cA + (size_t)(t + 1) * kstep;
            const char* a2 = last ? nA : cA + (size_t)(t + 2) * kstep; const char* b2 = last ? nB : cB + (size_t)(t + 2) * kstep;
            const char* a3 = a2 + kstep; const char* b3 = b2 + kstep;
            if (last && has_next) S.a_ready(nxt);
            if constexpr (SP2) {
            PG8_LDB(B0, 0, 0); PG8_LDB(B1, 0, 1); PG8_SCHED; PG8_LDA(At, 0, 0); PG8_STAGE(PG8_SA(1, 1), a1 + hstep, voffA);
            PG8_WAIT_V(8); PG8_WAIT_L(0); PG8_BAR; PG8_MMA(0, 0, At, B0); PG8_MMA(0, 1, At, B1); PG8_BAR; PG8_SCHED;
            PG8_LDA(At, 0, 1); PG8_STAGE(PG8_SB(0, 0), b2, voffB); PG8_STAGE(PG8_SB(0, 1), b2 + hstep, voffB); PG8_STAGE(PG8_SA(0, 0), a2, voffA);
            PG8_WAIT_V(8); PG8_WAIT_L(0); PG8_BAR; PG8_MMA(1, 0, At, B0); PG8_MMA(1, 1, At, B1); PG8_BAR; PG8_SCHED;
            PG8_LDB(B0, 1, 0); PG8_LDB(B1, 1, 1); PG8_SCHED; PG8_LDA(At, 1, 0); PG8_STAGE(PG8_SA(0, 1), a2 + hstep, voffA);
            PG8_WAIT_V(8); PG8_WAIT_L(0); PG8_BAR; PG8_MMA(0, 0, At, B0); PG8_MMA(0, 1, At, B1); PG8_BAR; PG8_SCHED;
            PG8_LDA(At, 1, 1); PG8_STAGE(PG8_SB(1, 0), b3, voffB); PG8_STAGE(PG8_SB(1, 1), b3 + hstep, voffB); PG8_STAGE(PG8_SA(1, 0), a3, voffA);
            PG8_WAIT_V(8); PG8_WAIT_L(0); PG8_BAR; PG8_MMA(1, 0, At, B0); PG8_MMA(1, 1, At, B1); PG8_BAR; PG8_SCHED;
            } else {
            PG8_LDB(B0, 0, 0); PG8_SCHED; PG8_LDA(At, 0, 0); PG8_STAGE(PG8_SA(1, 1), a1 + hstep, voffA);
            PG8_WAIT_L(8); PG8_BAR; PG8_WAIT_L(0); PG8_MMA(0, 0, At, B0); PG8_BAR; PG8_SCHED;
            PG8_LDB(B1, 0, 1); PG8_STAGE(PG8_SB(0, 0), b2, voffB);
            PG8_BAR; PG8_WAIT_L(0); PG8_MMA(0, 1, At, B1); PG8_BAR;
            PG8_LDA(At, 0, 1); PG8_STAGE(PG8_SA(0, 0), a2, voffA);
            PG8_BAR; PG8_WAIT_L(0); PG8_MMA(1, 0, At, B0); PG8_BAR; PG8_SCHED;
            PG8_STAGE(PG8_SB(0, 1), b2 + hstep, voffB);
            PG8_WAIT_V(6); PG8_BAR; PG8_MMA(1, 1, At, B1); PG8_BAR;
            PG8_LDB(B0, 1, 0); PG8_SCHED; PG8_LDA(At, 1, 0); PG8_STAGE(PG8_SA(0, 1), a2 + hstep, voffA);
            PG8_WAIT_L(8); PG8_BAR; PG8_WAIT_L(0); PG8_MMA(0, 0, At, B0); PG8_BAR; PG8_SCHED;
            PG8_LDB(B1, 1, 1); PG8_STAGE(PG8_SB(1, 0), b3, voffB);
            PG8_BAR; PG8_WAIT_L(0); PG8_MMA(0, 1, At, B1); PG8_BAR;
            PG8_LDA(At, 1, 1); PG8_STAGE(PG8_SA(1, 0), a3, voffA);
            PG8_BAR; PG8_WAIT_L(0); PG8_MMA(1, 0, At, B0); PG8_BAR; PG8_SCHED;
            PG8_STAGE(PG8_SB(1, 1), b3 + hstep, voffB);
            PG8_WAIT_V(6); PG8_BAR; PG8_MMA(1, 1, At, B1); PG8_BAR;
            }
        }
        if constexpr (ALIGN_EPI) { if (wr == 0) PG8_BAR; }
        if constexpr (!Epi::AFTER_DRAIN) { const int l2 = lane_now(); E(acc, cur, wr, wc, l2 & 15, l2 >> 4); S.done(cur); }
        if (!has_next) break;
#pragma unroll
        for (int a = 0; a < 2; ++a)
#pragma unroll
            for (int b = 0; b < 2; ++b)
#pragma unroll
                for (int m = 0; m < 4; ++m)
#pragma unroll
                    for (int n = 0; n < 2; ++n) acc[a][b][m][n] = (f32x4){0.f, 0.f, 0.f, 0.f};
        cur = nxt; cA = nA; cB = nB; ++ui;
        if constexpr (ALIGN_EPI) { if (wr == 1) PG8_BAR; }
    }
    PG8_WAIT_V(0);
    if constexpr (!ALIGN_EPI) { if (wr == 0) PG8_BAR; }
    PG8_BAR;
    if constexpr (Epi::AFTER_DRAIN) { E.fused(acc, cur, wr, wc, fr, fq, lds, wid, lane); S.done(cur); }
#undef PG8_SA
#undef PG8_SB
#undef PG8_STAGE
#undef PG8_LDA
#undef PG8_LDB
#undef PG8_MMA
#undef PG8_WAIT_V
#undef PG8_WAIT_L
#undef PG8_BAR
#undef PG8_SCHED
}
template <class Epi, class Sched, bool F8 = false>
__device__ __forceinline__ void gemm_phase_gather(PG8_LAS unsigned char* lds, const Gemm g, const Sched& S, const Epi& E, const PG8_LAS int* rowtab, const int wid) {
    constexpr bool ALIGN_EPI = true, SP2 = true;
    const int lane = lane_now(), tid = wid * 64 + lane, wr = wid >> 2, wc = wid & 3, fr = lane & 15, fq = lane >> 4;
    const int K = g.K, nt = K / BK;
    unsigned voffB[2], vAc[2][2];
#pragma unroll
    for (int i = 0; i < 2; ++i) { int R, C; stage_rc(tid * 16 + i * 8192, R, C); const int Rb = Epi::PERM ? ((R & ~31) + perm32(R & 31)) : R;
        voffB[i] = (unsigned)(Rb * K + C) * 2u; }
#define PG8_ROWS(dst, ui_) do { const int t_ = wid * 64 + lane_now(); _Pragma("unroll") for (int i_ = 0; i_ < 2; ++i_) { int R_, C_; stage_rc(t_ * 16 + i_ * 8192, R_, C_); \
        _Pragma("unroll") for (int h_ = 0; h_ < 2; ++h_) dst[h_][i_] = (unsigned)rowtab[(ui_) * 256 + h_ * HALF + R_] * (unsigned)(K * 2) + (unsigned)(C_ * 2); } } while (0)
#define PG8_STAGE_A(bufoff, v, kb) do { _Pragma("unroll") for (int _i = 0; _i < 2; ++_i) { \
        if constexpr (F8) glds_sv((const char*)g.A + (kb), (v)[_i], ldsbase + (unsigned)((bufoff) + _i * 8192)); \
        else __builtin_amdgcn_global_load_lds((const unsigned*)((const char*)g.A + (v)[_i] + (kb)), (PG8_LAS unsigned*)(lds + (bufoff) + ldsw + _i * 8192), 16, 0, 0); } } while (0)
    const size_t kstep = (size_t)(BK * 2);
    const size_t hstep = (size_t)HALF * K * 2;
    const size_t tstep = 2 * hstep;
    const unsigned ldsw = (unsigned)wid * 1024u;
    const unsigned ldsbase = (unsigned)__builtin_amdgcn_readfirstlane((int)((unsigned)(uintptr_t)lds + ldsw));
    const int aoff = lds_byte(wr * 64 + fr, fq * 8), boff = lds_byte(wc * 32 + fr, fq * 8);
#define PG8_SA(b, h) (((b) * 2 + (h)) * HTB)
#define PG8_SB(b, h) ((4 + (b) * 2 + (h)) * HTB)
#define PG8_STAGE(bufoff, gbase, voff) do { _Pragma("unroll") for (int _i = 0; _i < 2; ++_i) { \
        if constexpr (F8) glds_sv((const char*)(gbase), (voff)[_i], ldsbase + (unsigned)((bufoff) + _i * 8192)); \
        else __builtin_amdgcn_global_load_lds((const unsigned*)((const char*)(gbase) + (voff)[_i]), (PG8_LAS unsigned*)(lds + (bufoff) + ldsw + _i * 8192), 16, 0, 0); } } while (0)
#define PG8_LDA(dst, b, h) do { _Pragma("unroll") for (int m = 0; m < 4; ++m) { \
        if constexpr (F8) { dst##8[m] = cat8(*(const PG8_LAS bf16x8*)(lds + PG8_SA(b, h) + aoff + m * 2048), *(const PG8_LAS bf16x8*)(lds + PG8_SA(b, h) + aoff + m * 2048 + 1024)); } \
        else { _Pragma("unroll") for (int k = 0; k < 2; ++k) dst[m][k] = *(const PG8_LAS bf16x8*)(lds + PG8_SA(b, h) + aoff + m * 2048 + k * 1024); } } } while (0)
#define PG8_LDB(dst, b, h) do { _Pragma("unroll") for (int n = 0; n < 2; ++n) { \
        if constexpr (F8) { dst##8[n] = cat8(*(const PG8_LAS bf16x8*)(lds + PG8_SB(b, h) + boff + n * 2048), *(const PG8_LAS bf16x8*)(lds + PG8_SB(b, h) + boff + n * 2048 + 1024)); } \
        else { _Pragma("unroll") for (int k = 0; k < 2; ++k) dst[n][k] = *(const PG8_LAS bf16x8*)(lds + PG8_SB(b, h) + boff + n * 2048 + k * 1024); } } } while (0)
#define PG8_MMA(ai, bj, At, Bt) do { __builtin_amdgcn_s_setprio(1); _Pragma("unroll") for (int m = 0; m < 4; ++m) _Pragma("unroll") for (int n = 0; n < 2; ++n) { \
        if constexpr (F8) { acc[ai][bj][m][n] = __builtin_amdgcn_mfma_scale_f32_16x16x128_f8f6f4(Bt##8[n], At##8[m], acc[ai][bj][m][n], 0, 0, 0, 0, 0, 0); } \
        else { _Pragma("unroll") for (int k = 0; k < 2; ++k) acc[ai][bj][m][n] = __builtin_amdgcn_mfma_f32_16x16x32_bf16(Bt[n][k], At[m][k], acc[ai][bj][m][n], 0, 0, 0); } } \
        __builtin_amdgcn_s_setprio(0); } while (0)
#define PG8_WAIT_V(n) asm volatile("s_waitcnt vmcnt(" #n ")" ::: "memory")
#define PG8_WAIT_L(n) asm volatile("s_waitcnt lgkmcnt(" #n ")" ::: "memory")
#define PG8_BAR __builtin_amdgcn_s_barrier()
#define PG8_SCHED __builtin_amdgcn_sched_barrier(0)
    Unit cur, nxt; int ui = 0;
    if (!S.next(0, cur)) return;
    f32x4 acc[2][2][4][2];
#pragma unroll
    for (int a = 0; a < 2; ++a)
#pragma unroll
        for (int b = 0; b < 2; ++b)
#pragma unroll
            for (int m = 0; m < 4; ++m)
#pragma unroll
                for (int n = 0; n < 2; ++n) acc[a][b][m][n] = (f32x4){0.f, 0.f, 0.f, 0.f};
    bf16x8 At[4][2], B0[2][2], B1[2][2]; v8i_t At8[4], B08[2], B18[2];
    const char* cB = (const char*)g.Bt + (size_t)cur.pn * tstep;
    PG8_ROWS(vAc, 0);
    S.a_ready(cur);
    if constexpr (SP2) {
        PG8_STAGE(PG8_SB(0, 0), cB, voffB); PG8_STAGE(PG8_SB(0, 1), cB + hstep, voffB); PG8_STAGE_A(PG8_SA(0, 0), vAc[0], 0u); PG8_STAGE_A(PG8_SA(0, 1), vAc[1], 0u);
        if (wr == 1) PG8_BAR;
        PG8_WAIT_V(2); PG8_BAR;
        PG8_STAGE(PG8_SB(1, 0), cB + kstep, voffB); PG8_STAGE_A(PG8_SA(1, 0), vAc[0], (unsigned)kstep); PG8_STAGE(PG8_SB(1, 1), cB + hstep + kstep, voffB);
        PG8_WAIT_V(6); PG8_BAR;
    }
    for (;;) {
        const bool has_next = S.next(ui + 1, nxt);
        const char* nB = has_next ? (const char*)g.Bt + (size_t)nxt.pn * tstep : cB;
#pragma clang loop unroll(disable)
        for (int t = 0; t < nt; t += 2) {
            const bool last = (t == nt - 2);
            const unsigned k1 = (unsigned)((t + 1) * (int)kstep), k2 = last ? 0u : (unsigned)((t + 2) * (int)kstep), k3 = k2 + (unsigned)kstep;
            unsigned v2[2][2];
            if (last && has_next) { PG8_ROWS(v2, ui + 1); }
            else {
#pragma unroll
                for (int h_ = 0; h_ < 2; ++h_)
#pragma unroll
                    for (int i_ = 0; i_ < 2; ++i_) v2[h_][i_] = vAc[h_][i_]; }
            const char* b2 = last ? nB : cB + (size_t)(t + 2) * kstep; const char* b3 = b2 + kstep;
            if (last && has_next) S.a_ready(nxt);
            if constexpr (SP2) {
            PG8_LDB(B0, 0, 0); PG8_LDB(B1, 0, 1); PG8_SCHED; PG8_LDA(At, 0, 0); PG8_STAGE_A(PG8_SA(1, 1), vAc[1], k1);
            PG8_WAIT_V(8); PG8_WAIT_L(0); PG8_BAR; PG8_MMA(0, 0, At, B0); PG8_MMA(0, 1, At, B1); PG8_BAR; PG8_SCHED;
            PG8_LDA(At, 0, 1); PG8_STAGE(PG8_SB(0, 0), b2, voffB); PG8_STAGE(PG8_SB(0, 1), b2 + hstep, voffB); PG8_STAGE_A(PG8_SA(0, 0), v2[0], k2);
            PG8_WAIT_V(8); PG8_WAIT_L(0); PG8_BAR; PG8_MMA(1, 0, At, B0); PG8_MMA(1, 1, At, B1); PG8_BAR; PG8_SCHED;
            PG8_LDB(B0, 1, 0); PG8_LDB(B1, 1, 1); PG8_SCHED; PG8_LDA(At, 1, 0); PG8_STAGE_A(PG8_SA(0, 1), v2[1], k2);
            PG8_WAIT_V(8); PG8_WAIT_L(0); PG8_BAR; PG8_MMA(0, 0, At, B0); PG8_MMA(0, 1, At, B1); PG8_BAR; PG8_SCHED;
            PG8_LDA(At, 1, 1); PG8_STAGE(PG8_SB(1, 0), b3, voffB); PG8_STAGE(PG8_SB(1, 1), b3 + hstep, voffB); PG8_STAGE_A(PG8_SA(1, 0), v2[0], k3);
            PG8_WAIT_V(8); PG8_WAIT_L(0); PG8_BAR; PG8_MMA(1, 0, At, B0); PG8_MMA(1, 1, At, B1); PG8_BAR; PG8_SCHED;
            }
        }
        if constexpr (ALIGN_EPI) { if (wr == 0) PG8_BAR; }
        { const int l2 = lane_now(); E(acc, cur, wr, wc, l2 & 15, l2 >> 4, rowtab + ui * 256); } S.done(cur);
        if (!has_next) break;
#pragma unroll
        for (int a = 0; a < 2; ++a)
#pragma unroll
            for (int b = 0; b < 2; ++b)
#pragma unroll
                for (int m = 0; m < 4; ++m)
#pragma unroll
                    for (int n = 0; n < 2; ++n) acc[a][b][m][n] = (f32x4){0.f, 0.f, 0.f, 0.f};
        cur = nxt; cB = nB; ++ui;
        PG8_ROWS(vAc, ui);
        if constexpr (ALIGN_EPI) { if (wr == 1) PG8_BAR; }
    }
    PG8_WAIT_V(0);
    if constexpr (!ALIGN_EPI) { if (wr == 0) PG8_BAR; }
    PG8_BAR;
#undef PG8_ROWS
#undef PG8_STAGE_A
#undef PG8_SA
#undef PG8_SB
#undef PG8_STAGE
#undef PG8_LDA
#undef PG8_LDB
#undef PG8_MMA
#undef PG8_WAIT_V
#undef PG8_WAIT_L
#undef PG8_BAR
#undef PG8_SCHED
}
}
#define GAS __attribute__((address_space(1)))
#define LAS __attribute__((address_space(3)))
typedef unsigned short bf16;
typedef unsigned v4u __attribute__((ext_vector_type(4)));
typedef float f32x4 __attribute__((ext_vector_type(4)));
typedef short bf16x8 __attribute__((ext_vector_type(8)));
typedef GAS unsigned gu32;
typedef GAS unsigned long long gu64;
#define RLX_AGENT __ATOMIC_RELAXED, __HIP_MEMORY_SCOPE_AGENT
#define LDS_WAIT() asm volatile("s_waitcnt lgkmcnt(0)" ::: "memory")
#define VM_WAIT() asm volatile("s_waitcnt vmcnt(0)" ::: "memory")
__device__ __forceinline__ unsigned long long rt() { return __builtin_amdgcn_s_memrealtime(); }
__device__ __forceinline__ unsigned f2bf(float f) { unsigned u = __builtin_bit_cast(unsigned, f); return (u + 0x7fffu + ((u >> 16) & 1u)) >> 16; }
__device__ __forceinline__ unsigned pk2(float lo, float hi) { return f2bf(lo) | (f2bf(hi) << 16); }
#define XB_TMO      128
#define XB_XCNT(j)  (256  + 64 * (j))
#define XB_XSUB(j)  (1280 + 64 * (j))
#define XB_XGEN(j)  (2304 + 64 * (j))
#define XB_TOP      3328
#define XB_TOPGEN   3392
#define XCD_BAR_WORDS 3456
#define XB_SPIN_CAP (1u << 18)

__device__ __forceinline__ unsigned xb_ld(unsigned* p)              { return __hip_atomic_load(p, __ATOMIC_RELAXED, __HIP_MEMORY_SCOPE_AGENT); }
__device__ __forceinline__ unsigned xb_add(unsigned* p, unsigned v) { return __hip_atomic_fetch_add(p, v, __ATOMIC_RELAXED, __HIP_MEMORY_SCOPE_AGENT); }
__device__ __forceinline__ unsigned xb_xcc_id() { return (unsigned)__builtin_amdgcn_s_getreg((3 << 11) | 20) & 0xFu; }
#define XB_SPIN(cond, bar) do { unsigned _sp = 0; while (cond) { __builtin_amdgcn_s_sleep(1); \
    if ((++_sp & 255u) == 0u) { if (xb_ld(&(bar)[XB_TMO])) break; if (_sp > XB_SPIN_CAP) { atomicAdd(&(bar)[XB_TMO], 1u); break; } } } } while (0)

struct XcdBarrier {
    unsigned* bar; unsigned x;
    volatile LAS unsigned* st;
};

__device__ __forceinline__ XcdBarrier xcd_barrier_post(unsigned* bar, volatile LAS unsigned* st) {
    XcdBarrier b; b.bar = bar; b.x = xb_xcc_id(); b.st = st;
    if (threadIdx.x == 0) (void)xb_add(&bar[XB_XCNT(b.x)], 1u);
    return b;
}
__device__ __forceinline__ void xcd_barrier_complete(unsigned* bar, unsigned x, unsigned& nloc, unsigned& nx) {
    const unsigned G = gridDim.x * gridDim.y * gridDim.z;
    unsigned sum, cnt, mine, sp = 0u;
    for (;;) {
        sum = 0u; cnt = 0u; mine = 0u;
#pragma unroll
        for (unsigned j = 0; j < 16; ++j) { const unsigned c = xb_ld(&bar[XB_XCNT(j)]); sum += c; cnt += (c > 0u) ? 1u : 0u; mine = (j == x) ? c : mine; }
        if (sum == G) break;
        __builtin_amdgcn_s_sleep(1);
        if ((++sp & 255u) == 0u) { if (xb_ld(&bar[XB_TMO])) break; if (sp > XB_SPIN_CAP) { atomicAdd(&bar[XB_TMO], 1u); break; } }
    }
    nloc = mine > 0u ? mine : 1u; nx = cnt > 0u ? cnt : 1u;
}

__device__ __forceinline__ void xcd_barrier(const XcdBarrier& b) {
    asm volatile("s_waitcnt vmcnt(0)" ::: "memory");
    __syncthreads();
    if (threadIdx.x == 0) {
        unsigned* bar = b.bar;
        __builtin_amdgcn_s_waitcnt(0);
        unsigned nloc = b.st[0], nx = b.st[1];
        if (nloc == 0u) { xcd_barrier_complete(bar, b.x, nloc, nx); b.st[0] = nloc; b.st[1] = nx; }
        const unsigned old = xb_add(&bar[XB_XSUB(b.x)], 1u);
        const unsigned gen = old / nloc;
        if (old + 1u == (gen + 1u) * nloc) {
            __builtin_amdgcn_fence(__ATOMIC_RELEASE, "agent");
            asm volatile("s_waitcnt vmcnt(0)" ::: "memory");
            const unsigned og = xb_add(&bar[XB_TOP], 1u);
            const unsigned tg = og / nx;
            if (og + 1u == (tg + 1u) * nx) xb_add(&bar[XB_TOPGEN], 1u);
            else XB_SPIN(xb_ld(&bar[XB_TOPGEN]) == tg, bar);
            __builtin_amdgcn_fence(__ATOMIC_ACQUIRE, "agent");
            xb_add(&bar[XB_XGEN(b.x)], 1u);
            asm volatile("s_waitcnt vmcnt(0)" ::: "memory");
        } else {
            XB_SPIN(xb_ld(&bar[XB_XGEN(b.x)]) == gen, bar);
            __builtin_amdgcn_fence(__ATOMIC_ACQUIRE, "agent");
            asm volatile("s_waitcnt vmcnt(0)" ::: "memory");
        }
    }
    __syncthreads();
}
namespace fattn {
typedef unsigned short bf16;
typedef short bf16x8 __attribute__((ext_vector_type(8)));
typedef short s16x4 __attribute__((ext_vector_type(4)));
typedef float f32x16 __attribute__((ext_vector_type(16)));
typedef float f32x4 __attribute__((ext_vector_type(4)));
typedef unsigned u32x4 __attribute__((ext_vector_type(4)));
constexpr int D = 128, LD = 128, LDO = 1024, SEQ = 4096;
constexpr float THR = 8.f;
constexpr float SCALE = 0.08838834764831845f;
constexpr int NW = 8, QBLK = 32, KVBLK = 64, QB = NW * QBLK;
constexpr int SHM_V = KVBLK * D * 2, SHM_K = KVBLK * D * 2;
constexpr int OFF_WS = 2 * SHM_V + 2 * SHM_K, OFF_BIAS = OFF_WS + NW * 64 * 4, LDS_BYTES = OFF_BIAS + 2 * 64 * 4;

#define KSWZ(row, colB) ((row) * 256 + ((colB) ^ (((row) & 7) << 4)))
#define SBAR() __builtin_amdgcn_sched_barrier(0)
__device__ __forceinline__ int v_st(int k, int c) { const int kk = (k & ~0xC) | ((k & 4) << 1) | ((k & 8) >> 1); return ((kk >> 3) * 4 + (c >> 5)) * 512 + ((kk & 7) * 32 + (c & 31)) * 2; }
__device__ __forceinline__ int v_rd_base(int lane) { return ((lane & 3) << 3) | (((lane >> 2) & 3) << 6) | (((lane >> 4) & 1) << 5) | (((lane >> 5) & 1) << 8); }
constexpr int v_rd_off(int d0, int ks, int half) { return d0 * 512 + ks * 4096 + half * 2048; }
__device__ __forceinline__ int crow(int r, int hi) { return (r & 3) + 8 * (r >> 2) + 4 * hi; }
__device__ __forceinline__ unsigned cvtpk(float lo, float hi) { unsigned r; asm volatile("v_cvt_pk_bf16_f32 %0, %1, %2" : "=v"(r) : "v"(lo), "v"(hi)); return r; }
__device__ __forceinline__ bf16x8 load8(const bf16* p) { return *reinterpret_cast<const bf16x8*>(p); }
__device__ __forceinline__ void mask_tile(f32x16& p0, f32x16& p1, int dq) {
    const float NEG = -__builtin_inff();
#pragma unroll
    for (int r = 0; r < 16; ++r) {
        const int c = (r & 3) + 8 * (r >> 2);
        if (dq - c < 0) p0[r] = NEG;
        if (dq - c - 32 < 0) p1[r] = NEG;
    }
}
__device__ __forceinline__ void partialSM(f32x16& p0, f32x16& p1, float& m_reg, float& mn, float& alpha) {
    float pmax = p0[0]; for (int r = 1; r < 16; ++r) pmax = fmaxf(pmax, p0[r]); for (int r = 0; r < 16; ++r) pmax = fmaxf(pmax, p1[r]);
    { auto rr = __builtin_amdgcn_permlane32_swap(__float_as_uint(pmax), __float_as_uint(pmax), false, false);
      pmax = fmaxf(__uint_as_float(rr[0]), __uint_as_float(rr[1])); }
    constexpr float C2 = 1.4426950408889634f * SCALE;
    if (__builtin_expect(__all((pmax - m_reg) * SCALE <= THR), 1)) { mn = m_reg; alpha = 1.f; }
    else { mn = fmaxf(m_reg, pmax); alpha = __builtin_amdgcn_exp2f((m_reg - mn) * C2); m_reg = mn; }
    const float mnL = -mn * C2;
    for (int r = 0; r < 16; ++r) p0[r] = fmaf(p0[r], C2, mnL); for (int r = 0; r < 16; ++r) p1[r] = fmaf(p1[r], C2, mnL);
    for (int r = 0; r < 16; ++r) p0[r] = __builtin_amdgcn_exp2f(p0[r]);
}
__device__ __forceinline__ void finishSM(f32x16& p0, f32x16& p1, float alpha, float& l_reg, bf16x8& pa0, bf16x8& pa1, bf16x8& pa2, bf16x8& pa3) {
    for (int r = 0; r < 16; ++r) p1[r] = __builtin_amdgcn_exp2f(p1[r]);
    float ps = 0; for (int r = 0; r < 16; ++r) ps += p0[r]; for (int r = 0; r < 16; ++r) ps += p1[r];
    { auto rr = __builtin_amdgcn_permlane32_swap(__float_as_uint(ps), __float_as_uint(ps), false, false);
      ps = __uint_as_float(rr[0]) + __uint_as_float(rr[1]); }
    l_reg = l_reg * alpha + ps;
#define PK4(P, B_, OUT) do { unsigned a0 = cvtpk(P[B_+0], P[B_+1]), a1 = cvtpk(P[B_+2], P[B_+3]);                          \
        unsigned b0 = cvtpk(P[B_+4], P[B_+5]), b1 = cvtpk(P[B_+6], P[B_+7]);                                             \
        auto r0 = __builtin_amdgcn_permlane32_swap(a0, b0, false, false); auto r1 = __builtin_amdgcn_permlane32_swap(a1, b1, false, false); \
        u32x4 w = {r0[0], r1[0], r0[1], r1[1]}; OUT = *reinterpret_cast<bf16x8*>(&w); } while (0)
    PK4(p0, 0, pa0); PK4(p0, 8, pa1); PK4(p1, 0, pa2); PK4(p1, 8, pa3);
#undef PK4
}
template <int KB>
__device__ __forceinline__ void qkt(f32x16& p0, f32x16& p1, const char* K_lds, const char* Bias_lds, int r32, int hi, const bf16x8* qr) {
    { const f32x4* bb = reinterpret_cast<const f32x4*>(Bias_lds + KB * 256 + hi * 16);
      const f32x4 a0 = bb[0], a1 = bb[2], a2 = bb[4], a3 = bb[6], c0 = bb[8], c1 = bb[10], c2 = bb[12], c3 = bb[14];
      p0 = (f32x16){a0[0], a0[1], a0[2], a0[3], a1[0], a1[1], a1[2], a1[3], a2[0], a2[1], a2[2], a2[3], a3[0], a3[1], a3[2], a3[3]};
      p1 = (f32x16){c0[0], c0[1], c0[2], c0[3], c1[0], c1[1], c1[2], c1[3], c2[0], c2[1], c2[2], c2[3], c3[0], c3[1], c3[2], c3[3]}; }
    const char* kb[4];
#pragma unroll
    for (int dd = 0; dd < 4; ++dd) kb[dd] = K_lds + KB * SHM_K + KSWZ(r32, (dd * 16 + hi * 8) * 2);
#pragma unroll
    for (int d0 = 0; d0 < 8; ++d0) { const char* a = kb[d0 & 3] + (d0 >> 2) * 128;
        bf16x8 b0 = *reinterpret_cast<const bf16x8*>(a);
        bf16x8 b1 = *reinterpret_cast<const bf16x8*>(a + 32 * 256);
        p0 = __builtin_amdgcn_mfma_f32_32x32x16_bf16(b0, qr[d0], p0, 0, 0, 0);
        p1 = __builtin_amdgcn_mfma_f32_32x32x16_bf16(b1, qr[d0], p1, 0, 0, 0); }
}
template <int VB>
__device__ __forceinline__ void pv_tile(f32x16* o, int vb0, bf16x8 pa0, bf16x8 pa1, bf16x8 pa2, bf16x8 pa3) {
#define TRRD(dst, off) asm volatile("ds_read_b64_tr_b16 %0, %1 offset:%2" : "=&v"(dst) : "v"(vb0), "i"(off) : "memory")
#define PV_D0(d0) do { s16x4 l0, l1, l2, l3, h0, h1, h2, h3; constexpr int b_ = VB * SHM_V + v_rd_off(d0, 0, 0);   \
        TRRD(l0, b_); TRRD(h0, b_ + 2048); TRRD(l1, b_ + 4096); TRRD(h1, b_ + 6144); TRRD(l2, b_ + 8192); TRRD(h2, b_ + 10240); TRRD(l3, b_ + 12288); TRRD(h3, b_ + 14336); \
        asm volatile("s_waitcnt lgkmcnt(0)" ::: "memory"); SBAR();                                                    \
        o[d0] = __builtin_amdgcn_mfma_f32_32x32x16_bf16(pa0, (bf16x8){l0[0], l0[1], l0[2], l0[3], h0[0], h0[1], h0[2], h0[3]}, o[d0], 0, 0, 0);   \
        o[d0] = __builtin_amdgcn_mfma_f32_32x32x16_bf16(pa1, (bf16x8){l1[0], l1[1], l1[2], l1[3], h1[0], h1[1], h1[2], h1[3]}, o[d0], 0, 0, 0);   \
        o[d0] = __builtin_amdgcn_mfma_f32_32x32x16_bf16(pa2, (bf16x8){l2[0], l2[1], l2[2], l2[3], h2[0], h2[1], h2[2], h2[3]}, o[d0], 0, 0, 0);   \
        o[d0] = __builtin_amdgcn_mfma_f32_32x32x16_bf16(pa3, (bf16x8){l3[0], l3[1], l3[2], l3[3], h3[0], h3[1], h3[2], h3[3]}, o[d0], 0, 0, 0); } while (0)
    PV_D0(0); PV_D0(1); PV_D0(2); PV_D0(3);
#undef PV_D0
#undef TRRD
}

struct Bases { const bf16* Q; bf16* O; const bf16* K; const bf16* V; const float* CB; };
struct BlockRef { unsigned qo, oo, kvo, cbo; int P0, jlo; };
struct Seam { bf16x8 qr[8]; bf16x8 st_v0, st_v1, st_k0, st_k1; float st_b; };
#define ROW(p, k0, rr) ((p) + (unsigned)(((k0) + (rr)) * LD + sc))
#define VMW() asm volatile("s_waitcnt vmcnt(0)" ::: "memory")
#define VMWN(n) asm volatile("s_waitcnt vmcnt(%0)" :: "i"(n) : "memory")
#define SLOAD_H(Kp, Vp, CBp, k0) do { S.st_v0 = load8(ROW(Vp, k0, sr)); S.st_v1 = load8(ROW(Vp, k0, 32 + sr));              \
                         S.st_k0 = load8(ROW(Kp, k0, sr)); S.st_k1 = load8(ROW(Kp, k0, 32 + sr)); S.st_b = (CBp)[(unsigned)((k0) + lane)]; } while (0)
#define SWRITE_HK(bf, cref_) do { *(bf16x8*)(K_lds + (bf) * SHM_K + kws) = S.st_k0; *(bf16x8*)(K_lds + (bf) * SHM_K + kws + 32 * 256) = S.st_k1; \
                           if (wid == 0) *(float*)(B_lds + (bf) * 256 + lane * 4) = S.st_b; } while (0)
#define SWRITE_HV(bf) do { *(bf16x8*)(V_lds + (bf) * SHM_V + vst0) = S.st_v0; *(bf16x8*)(V_lds + (bf) * SHM_V + vst1) = S.st_v1; } while (0)
#define SWRITE_H(bf) do { SWRITE_HV(bf); SWRITE_HK(bf, cref); } while (0)
__device__ __forceinline__ void prime(const Bases& G, const BlockRef& cur, char* lds, Seam& S) {
    const int tid = threadIdx.x, wid = __builtin_amdgcn_readfirstlane(tid >> 6), lane = tid & 63, r32 = lane & 31, hi = lane >> 5;
    const int sr = tid >> 4, sc = (tid & 15) * 8, kws = KSWZ(sr, sc * 2); char* K_lds = lds + 2 * SHM_V; char* B_lds = lds + OFF_BIAS;
    for (int d0 = 0; d0 < 8; ++d0) S.qr[d0] = load8(G.Q + (cur.qo + (unsigned)((wid * QBLK + r32) * LD + d0 * 16 + hi * 8)));
    const float cref = 0.f; (void)cref;
    SLOAD_H(G.K + cur.kvo, G.V + cur.kvo, G.CB + cur.cbo, cur.jlo * KVBLK); VMW(); SWRITE_HK(0, cref);
    __syncthreads();
}
__device__ __forceinline__ void block(const Bases& G, const BlockRef& cur, const BlockRef& nxt, char* lds, Seam& S) {
    const int tid = threadIdx.x, wid = __builtin_amdgcn_readfirstlane(tid >> 6), lane = tid & 63, r32 = lane & 31, hi = lane >> 5;
    const int j_lo = cur.jlo, NT = (cur.P0 + QB - 1) / KVBLK + 1 - j_lo;
    const int qlo = cur.P0 + wid * QBLK, qm = qlo + r32 - 4 * hi;
    char* V_lds = lds; char* K_lds = lds + 2 * SHM_V; char* B_lds = lds + OFF_BIAS;
    float* ws = (float*)(lds + OFF_WS) + wid * 64; float* li_l = ws, * al_l = ws + 32;
    float m_reg = G.CB[cur.cbo + (unsigned)(cur.P0 + wid * QBLK + r32)], l_reg = 0; f32x16 o[4] = {};
    const int sr = tid >> 4, sc = (tid & 15) * 8, vst0 = v_st(sr, sc), vst1 = v_st(32 + sr, sc), kws = KSWZ(sr, sc * 2);
    const int vb0 = (int)(uintptr_t)V_lds + v_rd_base(lane);
    const bf16* Kh = G.K + cur.kvo; const bf16* Vh = G.V + cur.kvo; const float* CBh = G.CB + cur.cbo;
    const float cref = 0.f, crefn = 0.f; (void)cref; (void)crefn;
#define RESC(a) do { if (__any((a) < 1.f)) { if (hi == 0) al_l[r32] = (a); asm volatile("s_waitcnt lgkmcnt(0)" ::: "memory");              \
                     for (int d_ = 0; d_ < 4; ++d_) for (int r = 0; r < 16; ++r) o[d_][r] *= al_l[crow(r, hi)]; } } while (0)
#define KBASE(t) ((j_lo + (t)) * KVBLK)
#define MASKT(P0_, P1_, t) do { const int kb_ = KBASE(t); if (kb_ + KVBLK - 1 > qlo) mask_tile(P0_, P1_, qm - kb_); } while (0)
    constexpr int NQL = 8;
#define SEAM_K0() do { VMWN(NQL); SWRITE_HK(0, crefn); SBAR(); } while (0)
    f32x16 pA0, pA1, pB0, pB1; float mnA, mnB, alA, alB; bf16x8 pa0, pa1, pa2, pa3;
    SWRITE_HV(0); SBAR();
    if (NT > 1) { SLOAD_H(Kh, Vh, CBh, KBASE(1)); }
    SBAR(); qkt<0>(pA0, pA1, K_lds, B_lds, r32, hi, S.qr);
    MASKT(pA0, pA1, 0); partialSM(pA0, pA1, m_reg, mnA, alA);
    if (NT > 1) { VMW(); SWRITE_H(1); }
    __syncthreads();
#define HALF_STEP(PX0, PX1, mnX, alX, PY0, PY1, alY, t, KB, VB, SB) do {                                                      \
        SBAR(); if ((t) + 1 < NT) { SLOAD_H(Kh, Vh, CBh, KBASE((t) + 1)); SBAR(); }                                      \
        qkt<KB>(PX0, PX1, K_lds, B_lds, r32, hi, S.qr);                                                                        \
        finishSM(PY0, PY1, alY, l_reg, pa0, pa1, pa2, pa3); SBAR();                                                           \
        pv_tile<VB>(o, vb0, pa0, pa1, pa2, pa3); MASKT(PX0, PX1, (t)); partialSM(PX0, PX1, m_reg, mnX, alX);                   \
        __syncthreads();                                                                                                      \
        if ((t) + 1 < NT) { VMW(); SWRITE_H(SB); }                                                                            \
        RESC(alX); __syncthreads(); } while (0)
    for (int t = 1; t + 1 < NT; t += 2) {
        HALF_STEP(pB0, pB1, mnB, alB, pA0, pA1, alA, t, 1, 0, 0);
        HALF_STEP(pA0, pA1, mnA, alA, pB0, pB1, alB, t + 1, 0, 1, 1);
    }
    constexpr bool even = true;
    if (even) { SBAR(); qkt<1>(pB0, pB1, K_lds, B_lds, r32, hi, S.qr); SBAR(); }
    { SLOAD_H(G.K + nxt.kvo, G.V + nxt.kvo, G.CB + nxt.cbo, nxt.jlo * KVBLK); SBAR();
#pragma unroll
      for (int d0 = 0; d0 < 8; ++d0) S.qr[d0] = load8(G.Q + (nxt.qo + (unsigned)((wid * QBLK + r32) * LD + d0 * 16 + hi * 8))); }
    SBAR();
    finishSM(pA0, pA1, alA, l_reg, pa0, pa1, pa2, pa3); SBAR();
    pv_tile<0>(o, vb0, pa0, pa1, pa2, pa3);
    if (even) { MASKT(pB0, pB1, NT - 1); partialSM(pB0, pB1, m_reg, mnB, alB); __syncthreads(); RESC(alB);
        finishSM(pB0, pB1, alB, l_reg, pa0, pa1, pa2, pa3); SBAR(); pv_tile<1>(o, vb0, pa0, pa1, pa2, pa3); }
    SBAR(); SEAM_K0();
    if (hi == 0) li_l[r32] = l_reg; asm volatile("s_waitcnt lgkmcnt(0)" ::: "memory");
    float rli[16];
#pragma unroll
    for (int r = 0; r < 16; ++r) rli[r] = __builtin_amdgcn_rcpf(li_l[crow(r, hi)]);
    bf16* Ow = G.O + (cur.oo + (unsigned)(wid * QBLK * LDO));
#pragma unroll
    for (int r = 0; r < 16; ++r) { const int orow = crow(r, hi);
#pragma unroll
        for (int d0 = 0; d0 < 4; ++d0) { const float v = o[d0][r] * rli[r];
            const float vn = __shfl_xor(v, 1);
            if ((r32 & 1) == 0) *(unsigned*)(Ow + (unsigned)(orow * LDO + d0 * 32 + r32)) = cvtpk(v, vn); } }
    __syncthreads();
#undef RESC
#undef KBASE
#undef MASKT
#undef SEAM_K0
#undef HALF_STEP
}
#undef ROW
#undef VMW
#undef VMWN
#undef SLOAD_H
#undef SWRITE_HK
#undef SWRITE_HV
#undef SWRITE_H
#undef KSWZ
#undef SBAR
}
constexpr int NB = 8, SEQ = 4096, T = NB * SEQ, DM = 1024, NH = 8, HD = 128, INW = 7176, NZ = 7168;
constexpr int NE = 32, DE = 512;
constexpr float EPS = 1e-6f;
constexpr int PMAX = 73728;
constexpr int NWAVES = 8;
constexpr size_t MiB = 1u << 20;
constexpr size_t WS_CTL = 0, CTL_ZERO_BYTES = 64 * 1024;
constexpr size_t WS_RS1 = 1 * MiB, WS_RS2 = 1 * MiB + 256 * 1024;
constexpr size_t WS_LF = 1 * MiB + 512 * 1024;
constexpr size_t WS_CB = 2 * MiB + 512 * 1024;
constexpr size_t WS_TOK = 3 * MiB + 512 * 1024;
constexpr size_t WS_LISTS = 5 * MiB;
constexpr size_t WS_WRT = 9 * MiB;
constexpr size_t WS_SRS = 9 * MiB + 512 * 1024, WS_SW = 10 * MiB;
constexpr size_t WS_WIN = 16 * MiB;
constexpr size_t WS_WA = 30 * MiB, WS_WL = 32 * MiB, WS_WO = 34 * MiB;
constexpr size_t WS_WRG = 36 * MiB;
constexpr size_t WS_XB = 40 * MiB;
constexpr size_t WS_XR = 104 * MiB;
constexpr size_t WS_GG = 168 * MiB;
constexpr size_t WS_Q = 232 * MiB, WS_K = 296 * MiB, WS_V = 360 * MiB;
constexpr size_t WS_W13 = 424 * MiB;
constexpr size_t WS_W2 = 392 * MiB;
constexpr size_t WS_XG = 168 * MiB;
constexpr size_t WS_HB = 296 * MiB;
constexpr size_t WS_END = 512 * MiB;
static_assert(WS_XG + (size_t)PMAX * 1024 <= WS_K && WS_HB + (size_t)PMAX * 1024 <= WS_W2 && WS_W2 + 32u * 1024 * 512 * 2 <= WS_W13 && WS_W13 + 64 * MiB <= WS_END, "d_ws map");
constexpr int CW_TMO = 0, CW_CODE = 1, CW_BAR = 4096, CW_CNT = 8192, CW_NORM = 8448, CW_QCTR = 12288;
constexpr int RING_OFF = 0, RING_BYTES = 131072;
constexpr int LDSCTL_OFF = RING_BYTES, MISC_OFF = LDSCTL_OFF + 320;
constexpr int TBL_OFF = RING_BYTES + 1024;
constexpr int TBL_PS = TBL_OFF, TBL_CN = TBL_OFF + 256, TBL_TE = TBL_OFF + 512;
constexpr int RG_TOT = RING_BYTES + 4096, RG_CAR = RG_TOT + 4096;
constexpr int LDS_BYTES = 147456;

#include <cmath>
using pg8::bf_lo; using pg8::bf_hi; using pg8::sigmoid_f;

struct Frame {
    LAS unsigned char* lds;
    int tid, lane, wave, vcu, G;
};
__device__ __forceinline__ float wave_sum(float v) {
#pragma unroll
    for (int o = 1; o < 64; o <<= 1) v += __shfl_xor(v, o);
    return v;
}
__device__ __forceinline__ void transpose_tile(const float* src, int ld, bf16* dst, int ldd, const float* kscale, LAS float* scr, int lane) {
    const int q = lane & 7, kr = lane >> 3;
    f32x4 v[8];
#pragma unroll
    for (int i = 0; i < 8; ++i) v[i] = __builtin_nontemporal_load((const f32x4*)(src + (size_t)(kr + 8 * i) * ld + 4 * q));
#pragma unroll
    for (int i = 0; i < 8; ++i) { const int kk = kr + 8 * i; const float sc = kscale ? kscale[kk] : 1.0f;
#pragma unroll
        for (int c = 0; c < 4; ++c) scr[kk * 33 + 4 * q + c] = v[i][c] * sc; }
    LDS_WAIT(); asm volatile("" ::: "memory");
    const int c = lane & 7;
#pragma unroll
    for (int j = 0; j < 4; ++j) { const int n = (lane >> 3) + 8 * j; const LAS float* s = scr + (8 * c) * 33 + n;
        v4u o; o.x = pk2(s[0 * 33], s[1 * 33]); o.y = pk2(s[2 * 33], s[3 * 33]); o.z = pk2(s[4 * 33], s[5 * 33]); o.w = pk2(s[6 * 33], s[7 * 33]);
        *(GAS v4u*)(dst + (size_t)n * ldd + 8 * c) = o; }
    LDS_WAIT(); asm volatile("" ::: "memory");
}

__device__ __forceinline__ void transpose_tile8(const float* src, int ld, unsigned char* dst, int ldd, const float* kscale, float scale, LAS float* scr, int lane) {
    const int q = lane & 7, kr = lane >> 3;
    f32x4 v[8];
#pragma unroll
    for (int i = 0; i < 8; ++i) v[i] = __builtin_nontemporal_load((const f32x4*)(src + (size_t)(kr + 8 * i) * ld + 4 * q));
#pragma unroll
    for (int i = 0; i < 8; ++i) { const int kk = kr + 8 * i; const float sc = kscale ? kscale[kk] * scale : scale;
#pragma unroll
        for (int c = 0; c < 4; ++c) scr[kk * 33 + 4 * q + c] = v[i][c] * sc; }
    LDS_WAIT(); asm volatile("" ::: "memory");
    const int c = lane & 3;
#pragma unroll
    for (int j = 0; j < 2; ++j) { const int n = (lane >> 2) + 16 * j; const LAS float* s = scr + (16 * c) * 33 + n;
        v4u o; o.x = pg8::pack4_fp8(s[0 * 33], s[1 * 33], s[2 * 33], s[3 * 33]); o.y = pg8::pack4_fp8(s[4 * 33], s[5 * 33], s[6 * 33], s[7 * 33]);
        o.z = pg8::pack4_fp8(s[8 * 33], s[9 * 33], s[10 * 33], s[11 * 33]); o.w = pg8::pack4_fp8(s[12 * 33], s[13 * 33], s[14 * 33], s[15 * 33]);
        *(GAS v4u*)(dst + (size_t)n * ldd + 16 * c) = o; }
    LDS_WAIT(); asm volatile("" ::: "memory");
}

struct P0Args { const float *x, *g_mix, *w_in, *w_rg_a, *w_rg_x, *b_forget, *w_lru_out, *w_attn_out, *w_out, *g_ffn, *w_rgrp, *w_rexp, *w_gate, *w_up;
                bf16 *Win, *Wl, *Wa, *Wo, *Wrg, *XB; unsigned char* W13; float *RS1, *LF, *WRT; };
struct TItem { const float* src; int ld; unsigned char* dst; int ldd; const float* ks; float scale; int f8; };
__device__ __forceinline__ void titem_load(const TItem& t, f32x4 (&v)[8], float (&sc)[8], int lane) {
    const int q = lane & 7, kr = lane >> 3;
#pragma unroll
    for (int i = 0; i < 8; ++i) { v[i] = __builtin_nontemporal_load((const f32x4*)(t.src + (size_t)(kr + 8 * i) * t.ld + 4 * q)); sc[i] = t.ks ? t.ks[kr + 8 * i] * t.scale : t.scale; }
}
__device__ __forceinline__ void titem_finish(const TItem& t, const f32x4 (&v)[8], const float (&sc)[8], LAS float* scr, int lane) {
    const int q = lane & 7, kr = lane >> 3;
#pragma unroll
    for (int i = 0; i < 8; ++i) { const int kk = kr + 8 * i;
#pragma unroll
        for (int c = 0; c < 4; ++c) scr[kk * 33 + 4 * q + c] = v[i][c] * sc[i]; }
    LDS_WAIT(); asm volatile("" ::: "memory");
    if (t.f8) { const int c = lane & 3;
#pragma unroll
        for (int j = 0; j < 2; ++j) { const int n = (lane >> 2) + 16 * j; const LAS float* s = scr + (16 * c) * 33 + n;
            v4u o; o.x = pg8::pack4_fp8(s[0 * 33], s[1 * 33], s[2 * 33], s[3 * 33]); o.y = pg8::pack4_fp8(s[4 * 33], s[5 * 33], s[6 * 33], s[7 * 33]);
            o.z = pg8::pack4_fp8(s[8 * 33], s[9 * 33], s[10 * 33], s[11 * 33]); o.w = pg8::pack4_fp8(s[12 * 33], s[13 * 33], s[14 * 33], s[15 * 33]);
            *(GAS v4u*)(t.dst + (size_t)n * t.ldd + 16 * c) = o; } }
    else { const int c = lane & 7;
#pragma unroll
        for (int j = 0; j < 4; ++j) { const int n = (lane >> 3) + 8 * j; const LAS float* s = scr + (8 * c) * 33 + n;
            v4u o; o.x = pk2(s[0 * 33], s[1 * 33]); o.y = pk2(s[2 * 33], s[3 * 33]); o.z = pk2(s[4 * 33], s[5 * 33]); o.w = pk2(s[6 * 33], s[7 * 33]);
            *(GAS v4u*)(t.dst + ((size_t)n * t.ldd + 8 * c) * 2) = o; } }
    LDS_WAIT(); asm volatile("" ::: "memory");
}
constexpr int P0_I_IN = 16 * 224, P0_I_SQ = 16 * 32, P0_I_RG = 2 * 4 * 4 * 8, P0_I_EX = 2 * 8192, P0_NITEMS = P0_I_IN + 3 * P0_I_SQ + P0_I_RG + P0_I_EX;
__device__ __forceinline__ void p0_items(const Frame& F, const P0Args& a, const int first, const int last, const int stride, const int offset) {
    LAS float* scr = (LAS float*)(F.lds + RING_OFF + F.wave * 16384);
    const float* const p_wl = a.w_lru_out; const float* const p_wa = a.w_attn_out; const float* const p_wo = a.w_out; const float* const p_rga = a.w_rg_a; const float* const p_rgx = a.w_rg_x;
    bf16* const q_wl = a.Wl; bf16* const q_wa = a.Wa; bf16* const q_wo = a.Wo;
    constexpr int I_IN = P0_I_IN, I_SQ = P0_I_SQ, I_EX = P0_I_EX, NITEMS = P0_NITEMS;
    const float* const p_gate = a.w_gate; const float* const p_up = a.w_up; const float* const p_win = a.w_in; const float* const p_gmix = a.g_mix; const float* const p_gffn = a.g_ffn;
    bf16* const q_win = a.Win; bf16* const q_wrg = a.Wrg; unsigned char* const q_w13 = a.W13;
#define P0_DECODE(it_, t_) do { int r = (it_); \
        if (r >= NITEMS - I_EX) { r -= NITEMS - I_EX;     \
            const int w = r >> 13, e = (r >> 8) & 31, kb = (r >> 4) & 15, nb = r & 15; const float* W = (w == 0 ? p_gate : p_up) + (size_t)e * DM * DE; \
            const int drow = e * 1024 + (nb >> 2) * 256 + (nb & 3) * 32 + (w == 1 ? 128 : 0); \
            t_.src = W + (size_t)(64 * kb) * DE + 32 * nb; t_.ld = DE; t_.dst = q_w13 + (size_t)drow * DM + 64 * kb; t_.ldd = DM; t_.ks = p_gffn + 64 * kb; t_.scale = pg8::W13_SCALE; t_.f8 = 1; } \
        else if (r < I_IN) { const int kb = r / 224, nb = r % 224, n0 = 32 * nb, sc_ = n0 < 5120 ? n0 : n0 + 8; \
            t_.src = p_win + (size_t)(64 * kb) * INW + sc_; t_.ld = INW; t_.dst = (unsigned char*)(q_win + (size_t)n0 * DM + 64 * kb); t_.ldd = DM; t_.ks = p_gmix + 64 * kb; t_.scale = 1.0f; t_.f8 = 0; } \
        else if (r < I_IN + 3 * I_SQ) { r -= I_IN; const int w = r / I_SQ, q = r % I_SQ, kb = q / 32, nb = q % 32; const float* W = w == 0 ? p_wl : (w == 1 ? p_wa : p_wo); bf16* Wt = w == 0 ? q_wl : (w == 1 ? q_wa : q_wo); \
            t_.src = W + (size_t)(64 * kb) * DM + 32 * nb; t_.ld = DM; t_.dst = (unsigned char*)(Wt + (size_t)(32 * nb) * DM + 64 * kb); t_.ldd = DM; t_.ks = nullptr; t_.scale = 1.0f; t_.f8 = 0; } \
        else { r -= I_IN + 3 * I_SQ; const int gb = r / 32, q = r % 32, kb = q / 8, nb = q % 8; const float* W = (gb < 4 ? p_rga : p_rgx) + (size_t)(gb & 3) * 65536; \
            t_.src = W + (size_t)(64 * kb) * 256 + 32 * nb; t_.ld = 256; t_.dst = (unsigned char*)(q_wrg + (size_t)gb * 65536 + (size_t)(32 * nb) * 256 + 64 * kb); t_.ldd = 256; t_.ks = nullptr; t_.scale = -1.4426950408889634f; t_.f8 = 0; }     } while (0)
    {
        int it = first + offset; TItem cur; f32x4 va[8]; float sa[8];
        if (it < last) { P0_DECODE(it, cur); titem_load(cur, va, sa, F.lane); }
        while (it < last) {
            const int nx = it + stride; TItem nt = cur; f32x4 vb[8]; float sb[8];
            if (nx < last) { P0_DECODE(nx, nt); titem_load(nt, vb, sb, F.lane); }
            titem_finish(cur, va, sa, scr, F.lane);
            if (nx < last) { cur = nt;
#pragma unroll
                for (int i = 0; i < 8; ++i) { va[i] = vb[i]; sa[i] = sb[i]; } }
            it = nx;
        }
    }
#undef P0_DECODE
}
__device__ __forceinline__ void p0_prologue(const Frame& F, const P0Args& a, const int part  ) {
    const int gw = F.vcu * NWAVES + F.wave, NGW = F.G * NWAVES;
    if (part != 2) p0_items(F, a, 0, P0_NITEMS, NGW, gw);
    if (part == 1) return;
    for (int i = (F.vcu * NWAVES + F.wave) * 64 + F.lane; i < 64 * DM; i += NGW * 64) { const int n = i >> 10, k = i & 1023;
        float v = 0.f; if (n < 32) v = a.w_rexp[k * 32 + n]; else if (n < 36) v = a.w_rgrp[k * 4 + (n - 32)];
        a.WRT[i] = v * a.g_ffn[k]; }
    LAS float* wfl = (LAS float*)(F.lds + RING_OFF);
    __syncthreads();
    for (int k = F.tid; k < DM; k += NWAVES * 64) { const float g = a.g_mix[k];
        const f32x4 w0 = *(const f32x4*)(a.w_in + (size_t)k * INW + 5120), w1 = *(const f32x4*)(a.w_in + (size_t)k * INW + 5124);
        *(LAS f32x4*)(wfl + k * 8) = w0 * g; *(LAS f32x4*)(wfl + k * 8 + 4) = w1 * g; }
    __syncthreads();
    float wf[4][4][8];
#pragma unroll
    for (int j = 0; j < 4; ++j)
#pragma unroll
        for (int i = 0; i < 4; ++i) { const int k = 256 * j + 4 * F.lane + i; const f32x4 w0 = *(const LAS f32x4*)(wfl + k * 8), w1 = *(const LAS f32x4*)(wfl + k * 8 + 4);
#pragma unroll
            for (int h = 0; h < 4; ++h) { wf[j][i][h] = w0[h]; wf[j][i][4 + h] = w1[h]; } }
    const float bfg = a.b_forget[F.lane & 7];
    f32x4 vn[4];
    if (gw < T) { const GAS f32x4* xr0 = (const GAS f32x4*)(a.x + (size_t)gw * DM) + F.lane;
#pragma unroll
        for (int j = 0; j < 4; ++j) vn[j] = __builtin_nontemporal_load((const f32x4*)xr0 + 64 * j); }
    for (int m = gw; m < T; m += NGW) {
        f32x4 v[4]; float s = 0.f, d[8] = {0.f, 0.f, 0.f, 0.f, 0.f, 0.f, 0.f, 0.f};
#pragma unroll
        for (int j = 0; j < 4; ++j) v[j] = vn[j];
        if (m + NGW < T) { const GAS f32x4* xr1 = (const GAS f32x4*)(a.x + (size_t)(m + NGW) * DM) + F.lane;
#pragma unroll
            for (int j = 0; j < 4; ++j) vn[j] = __builtin_nontemporal_load((const f32x4*)xr1 + 64 * j); }
#pragma unroll
        for (int j = 0; j < 4; ++j) { s += (v[j].x * v[j].x + v[j].y * v[j].y) + (v[j].z * v[j].z + v[j].w * v[j].w);
#pragma unroll
            for (int i = 0; i < 4; ++i)
#pragma unroll
                for (int h = 0; h < 8; ++h) d[h] = fmaf(v[j][i], wf[j][i][h], d[h]); }
        s = wave_sum(s);
#pragma unroll
        for (int h = 0; h < 8; ++h) d[h] = wave_sum(d[h]);
        const float rs = 1.0f / sqrtf(s * (1.0f / DM) + EPS);
        GAS unsigned long long* o8 = (GAS unsigned long long*)(a.XB + (size_t)m * DM) + F.lane;
#pragma unroll
        for (int j = 0; j < 4; ++j) o8[64 * j] = (unsigned long long)pk2(v[j].x * rs, v[j].y * rs) | ((unsigned long long)pk2(v[j].z * rs, v[j].w * rs) << 32);
        if (F.lane < 8) { const int h = F.lane; float dh = d[0]; dh = h == 1 ? d[1] : dh; dh = h == 2 ? d[2] : dh; dh = h == 3 ? d[3] : dh; dh = h == 4 ? d[4] : dh; dh = h == 5 ? d[5] : dh; dh = h == 6 ? d[6] : dh; dh = h == 7 ? d[7] : dh;
            const float fl = dh * rs + bfg; a.LF[(size_t)m * 8 + h] = fminf(fl, 0.f) - log1pf(expf(-fabsf(fl))); }
    }
}
__device__ __forceinline__ void cumsum_bias(const Frame& F, const float* LF, float* CB) {
    LAS float* wt = (LAS float*)(F.lds + RING_OFF);
    for (int bh = blockIdx.x; bh < NB * NH; bh += F.G) {
        const int b = bh >> 3, h = bh & 7, s0 = F.tid * 8;
        float v[8], run = 0.f;
#pragma unroll
        for (int j = 0; j < 8; ++j) { run += LF[((size_t)(b * SEQ + s0 + j)) * 8 + h]; v[j] = run; }
        float inc = run;
#pragma unroll
        for (int o = 1; o < 64; o <<= 1) { const float t = __shfl_up(inc, o); if (F.lane >= o) inc += t; }
        if (F.lane == 63) wt[F.wave] = inc;
        __syncthreads();
        float pre = inc - run;
        for (int w = 0; w < F.wave; ++w) pre += wt[w];
#pragma unroll
        for (int j = 0; j < 8; ++j) CB[(size_t)bh * SEQ + s0 + j] = -(pre + v[j]) * 11.313708498984761f;
        __syncthreads();
    }
}
struct RgArgs { const bf16* XC; const bf16* GG; bf16* GO; const bf16* Wrg; const float *b_a, *b_x, *lam; };
__device__ __forceinline__ float bfx(const v4u& v, int i) { const unsigned w = i < 2 ? v.x : (i < 4 ? v.y : (i < 6 ? v.z : v.w)); return (i & 1) ? bf_hi(w) : bf_lo(w); }
__device__ __forceinline__ unsigned cvtpk_bf16(float lo, float hi) { unsigned r; asm volatile("v_cvt_pk_bf16_f32 %0, %1, %2" : "=v"(r) : "v"(lo), "v"(hi)); return r; }
__device__ __forceinline__ void conv_prepass(const Frame& F, const bf16* XR, bf16* XC, const float* conv_w, const float* conv_b) {
    const int gw = F.vcu * NWAVES + F.wave, NGW = F.G * NWAVES;
    for (int it = gw; it < (T / 16) * 2; it += NGW) {
        const int r0 = (it >> 1) * 16, c0 = (it & 1) * 512 + 8 * F.lane, tq = r0 & (SEQ - 1);
        float cw[4][8], cbv[8];
#pragma unroll
        for (int j = 0; j < 4; ++j) { const f32x4 w0 = *(const f32x4*)(conv_w + j * DM + c0), w1 = *(const f32x4*)(conv_w + j * DM + c0 + 4);
#pragma unroll
            for (int i = 0; i < 4; ++i) { cw[j][i] = w0[i]; cw[j][4 + i] = w1[i]; } }
        { const f32x4 w0 = *(const f32x4*)(conv_b + c0), w1 = *(const f32x4*)(conv_b + c0 + 4);
#pragma unroll
          for (int i = 0; i < 4; ++i) { cbv[i] = w0[i]; cbv[4 + i] = w1[i]; } }
        v4u raw[19];
#pragma unroll
        for (int i = 0; i < 19; ++i) { const int rr = (i < 3 && tq == 0) ? r0 : r0 - 3 + i; const v4u w = __builtin_nontemporal_load((const v4u*)(XR + ((unsigned)rr * DM + c0)));
            const bool z = i < 3 && tq == 0; raw[i].x = z ? 0u : w.x; raw[i].y = z ? 0u : w.y; raw[i].z = z ? 0u : w.z; raw[i].w = z ? 0u : w.w; }
#pragma unroll
        for (int r = 0; r < 16; ++r) { float y[8];
#pragma unroll
            for (int i = 0; i < 8; ++i) { float sacc = cbv[i];
#pragma unroll
                for (int j = 0; j < 4; ++j) sacc = fmaf(cw[j][i], bfx(raw[r + j], i), sacc);
                y[i] = sacc; }
            v4u o; o.x = cvtpk_bf16(y[0], y[1]); o.y = cvtpk_bf16(y[2], y[3]); o.z = cvtpk_bf16(y[4], y[5]); o.w = cvtpk_bf16(y[6], y[7]);
            *(GAS v4u*)(XC + ((unsigned)(r0 + r) * DM + c0)) = o; }
    }
}
__device__ __forceinline__ void rglru_unit(const Frame& F, const RgArgs& a, int unit) {
    const int tid = F.tid, lane = F.lane, wid = F.wave, fr = lane & 15, fq = lane >> 4, rq = wid >> 1, cp = wid & 1;
    const int b = unit >> 5, n = (unit >> 3) & 3, g = unit & 7, cbase = 256 * n, cown = cbase + 32 * g;
    LAS unsigned char* A_l = F.lds + RING_OFF;
    LAS float* tot = (LAS float*)(F.lds + RG_TOT);
    bf16x8 bfr[2][8];
#pragma unroll
    for (int gt = 0; gt < 2; ++gt)
#pragma unroll
        for (int ks = 0; ks < 8; ++ks) bfr[gt][ks] = *(const GAS bf16x8*)(a.Wrg + ((size_t)((gt * 4 + n) * 256 + 32 * g + 16 * cp + fr)) * 256 + 32 * ks + 8 * fq);
    const int cl = 16 * cp + fr, cch = cown + cl;
    const float ba = -1.4426950408889634f * a.b_a[cch], bx = -1.4426950408889634f * a.b_x[cch], sp8 = 8.0f * log1pf(expf(-a.lam[cch])) * 1.4426950408889634f;
    const unsigned goff = (unsigned)(b * SEQ + 32 * rq + 4 * fq) * DM + cch;
    const __amdgpu_buffer_rsrc_t GGr = __builtin_amdgcn_make_buffer_rsrc((void*)a.GG, 0, (int)((size_t)T * DM * 2), 0x00020000);
    const __amdgpu_buffer_rsrc_t GOr = __builtin_amdgcn_make_buffer_rsrc((void*)a.GO, 0, (int)((size_t)T * DM * 2), 0x00020000);
    const int gvo = (int)(goff * 2u);
    const unsigned dbase = ((unsigned)(b * SEQ + 16 * wid + (lane >> 5)) * DM + cbase) * 2u;
    const char* const XCb = (const char*)a.XC;
#define RG_DMA(ci_, buf_) do { _Pragma("unroll") for (int i_ = 0; i_ < 8; ++i_) { const unsigned so_ = dbase + (unsigned)(2 * i_) * (DM * 2u) + ((((unsigned)lane & 31u) ^ (unsigned)((2 * i_ + (lane >> 5)) & 15)) << 4); \
        __builtin_amdgcn_global_load_lds((const unsigned*)(XCb + so_ + (unsigned)(ci_) * (128u * DM * 2u)), (LAS unsigned*)(A_l + (buf_) * 65536 + (8 * wid + i_) * 1024), 16, 0, 0); } } while (0)
    float hc = 0.f;
    const int kx = 32 * g + cl;
#pragma unroll
    for (int gt = 0; gt < 2; ++gt)
#pragma unroll
        for (int ks = 0; ks < 8; ++ks) asm volatile("" : "+v"(bfr[gt][ks]));
    RG_DMA(0, 0); asm volatile("s_waitcnt vmcnt(0)" ::: "memory");
#define RG_CHUNK(BUF_, ci_) do { const int ci = (ci_); const int t0 = 128 * ci; LAS unsigned char* const Ab = A_l + (BUF_) * 65536; \
        __builtin_amdgcn_s_barrier(); asm volatile("" ::: "memory"); \
        unsigned short ggv[2][4]; \
        _Pragma("unroll") \
        for (int mt = 0; mt < 2; ++mt) \
        _Pragma("unroll") \
            for (int j = 0; j < 4; ++j) ggv[mt][j] = __builtin_amdgcn_raw_buffer_load_b16(GGr, gvo, (t0 + 16 * mt + j) * (DM * 2), 0); \
        if (ci + 1 < SEQ / 128) RG_DMA(ci + 1, BUF_ ^ 1); \
 \
        f32x4 acc[2][2]; \
        _Pragma("unroll") \
        for (int mt = 0; mt < 2; ++mt) { acc[mt][0] = (f32x4){ba, ba, ba, ba}; acc[mt][1] = (f32x4){bx, bx, bx, bx}; } \
        _Pragma("unroll") \
        for (int ks = 0; ks < 8; ++ks) { const int ch = 4 * ks + fq; \
        _Pragma("unroll") \
            for (int mt = 0; mt < 2; ++mt) { const int arow = 32 * rq + 16 * mt + fr; \
                const bf16x8 af = *(const LAS bf16x8*)(Ab + arow * 512 + ((ch ^ (arow & 15)) << 4)); \
                acc[mt][0] = __builtin_amdgcn_mfma_f32_16x16x32_bf16(af, bfr[0][ks], acc[mt][0], 0, 0, 0); \
                acc[mt][1] = __builtin_amdgcn_mfma_f32_16x16x32_bf16(af, bfr[1][ks], acc[mt][1], 0, 0, 0); } } \
 \
        float av[2][4], bv[2][4], sA[2], sB[2]; \
        _Pragma("unroll") \
        for (int mt = 0; mt < 2; ++mt) { float A = 1.f, Bv = 0.f; \
        _Pragma("unroll") \
            for (int j = 0; j < 4; ++j) { const int row = 32 * rq + 16 * mt + 4 * fq + j; \
                const unsigned short xb16 = *(const LAS unsigned short*)(Ab + row * 512 + ((((kx >> 3) ^ (row & 15))) << 4) + (kx & 7) * 2); \
                const float xc = __builtin_bit_cast(float, (unsigned)xb16 << 16); \
                const float r_ = __builtin_amdgcn_rcpf(1.0f + __builtin_amdgcn_exp2f(acc[mt][0][j])), i_ = __builtin_amdgcn_rcpf(1.0f + __builtin_amdgcn_exp2f(acc[mt][1][j])); \
                const float aa = __builtin_amdgcn_exp2f(-sp8 * r_); \
                const float mult = __builtin_amdgcn_sqrtf(fmaxf(fmaf(-aa, aa, 1.0f), 0.f)); \
                av[mt][j] = aa; bv[mt][j] = mult * i_ * xc; \
                Bv = fmaf(aa, Bv, bv[mt][j]); A *= aa; } \
            sA[mt] = A; sB[mt] = Bv; } \
 \
        float eA[2], eB[2], tA[2], tB[2]; \
        _Pragma("unroll") \
        for (int mt = 0; mt < 2; ++mt) { float A = sA[mt], Bv = sB[mt]; \
            { const float pA = __shfl_up(A, 16), pB = __shfl_up(Bv, 16); if (fq >= 1) { Bv = fmaf(A, pB, Bv); A *= pA; } } \
            { const float pA = __shfl_up(A, 32), pB = __shfl_up(Bv, 32); if (fq >= 2) { Bv = fmaf(A, pB, Bv); A *= pA; } } \
            const float xA = __shfl_up(A, 16), xB = __shfl_up(Bv, 16); eA[mt] = fq >= 1 ? xA : 1.f; eB[mt] = fq >= 1 ? xB : 0.f; \
            tA[mt] = __shfl(A, 48 + fr); tB[mt] = __shfl(Bv, 48 + fr); } \
        const float wA = tA[0] * tA[1], wB = fmaf(tA[1], tB[0], tB[1]); \
        if (fq == 0) { tot[(rq * 32 + cl) * 2] = wA; tot[(rq * 32 + cl) * 2 + 1] = wB; } \
        asm volatile("s_waitcnt lgkmcnt(0)" ::: "memory"); __builtin_amdgcn_s_barrier(); asm volatile("" ::: "memory"); \
        float hin = hc, hnew = hc; \
        _Pragma("unroll") \
        for (int q = 0; q < 4; ++q) { const float qA = tot[(q * 32 + cl) * 2], qB = tot[(q * 32 + cl) * 2 + 1]; hnew = fmaf(qA, hnew, qB); if (q < rq) hin = hnew; } \
        hc = hnew; \
        _Pragma("unroll") \
        for (int mt = 0; mt < 2; ++mt) { float h = mt == 0 ? hin : fmaf(tA[0], hin, tB[0]); \
            h = fmaf(eA[mt], h, eB[mt]); \
        _Pragma("unroll") \
            for (int j = 0; j < 4; ++j) { h = fmaf(av[mt][j], h, bv[mt][j]); \
                const float gv = __builtin_bit_cast(float, (unsigned)ggv[mt][j] << 16); \
                __builtin_amdgcn_raw_buffer_store_b16((unsigned short)cvtpk_bf16(h * gv, 0.f), GOr, gvo, (t0 + 16 * mt + j) * (DM * 2), 0); } } \
        asm volatile("s_waitcnt lgkmcnt(0)" ::: "memory"); \
        asm volatile("s_waitcnt vmcnt(8)" ::: "memory"); \
    } while (0)
    for (int cc = 0; cc < SEQ / 128; cc += 2) { RG_CHUNK(0, cc); RG_CHUNK(1, cc + 1); }
#undef RG_CHUNK
#undef RG_DMA
    asm volatile("s_waitcnt vmcnt(0) lgkmcnt(0)" ::: "memory"); __builtin_amdgcn_s_barrier(); asm volatile("" ::: "memory");
}
constexpr float SKIP_LOG2 = 40.0f;
__device__ __forceinline__ int attn_jlo(const Frame& F, const float* CB, const unsigned* NORM, int bh, int qb) {
    float qs = 0.f, ks = 0.f;
#pragma unroll
    for (int w = 0; w < 4; ++w) { qs += __uint_as_float(NORM[(bh) * 4 + w]); ks += __uint_as_float(NORM[(64 + bh) * 4 + w]); }
    constexpr float C2 = 1.4426950408889634f * 0.08838834764831845f;
    const float th = SKIP_LOG2 + 2.0f * 1.02f * sqrtf(qs * ks) * C2 + 4.0f;
    const float ref = CB[(size_t)bh * SEQ + qb * 256], v = CB[(size_t)bh * SEQ + 64 * F.lane + 63];
    const unsigned long long m = __ballot(F.lane < 4 * qb && (ref - v) * C2 > th);
    int j = __builtin_popcountll(m); if (m != ((j >= 64) ? ~0ull : ((1ull << j) - 1ull))) j = 0;
    return j & ~1;
}
__device__ __forceinline__ fattn::BlockRef attn_ref(int bh, int qb, int jlo) {
    const int b = bh >> 3, h = bh & 7;
    fattn::BlockRef r; r.qo = ((unsigned)bh * SEQ + (unsigned)qb * 256u) * HD; r.oo = ((unsigned)b * SEQ + (unsigned)qb * 256u) * DM + h * HD; r.kvo = (unsigned)bh * SEQ * HD; r.cbo = (unsigned)bh * SEQ; r.P0 = qb * 256; r.jlo = jlo; return r;
}
__device__ __forceinline__ void attn_phase(const Frame& F, char* lds, const bf16* Qb, bf16* Ob, const bf16* Kb, const bf16* Vb, const float* CB, const int* JLO, gu32* QCTR, const int probe = 0) {
#define ATT_JLO(bh_, qb_) (probe == 1 ? 4 * (qb_) : probe == 2 ? 0 : __builtin_amdgcn_readfirstlane(JLO[(bh_) * 16 + (qb_)]))
    constexpr int NBLK = 128;
    const int M = F.G >> 3; if ((F.G & 7) || M > 64 || M < 1) return;
    const int x = F.vcu / M, r = F.vcu % M;
    volatile LAS int* tk_l = (volatile LAS int*)(F.lds + MISC_OFF + 64);
    gu32* qc = QCTR + 64 * x;
    const fattn::Bases G{Qb, Ob, Kb, Vb, CB};
#define ATT_DEC(k_, bh_, qb_) do { const int i_ = (k_) & 7; bh_ = (i_ < 4 ? 4 * x + i_ : 32 + 4 * x + (i_ - 4)); qb_ = 15 - ((k_) >> 3); } while (0)
    int bh, qb; ATT_DEC(r, bh, qb);
    fattn::BlockRef cur = attn_ref(bh, qb, ATT_JLO(bh, qb));
    ATT_DEC(r + M, bh, qb);
    fattn::BlockRef nxt = attn_ref(bh, qb, ATT_JLO(bh, qb)); bool nxt_ok = (r + M) < NBLK;
    fattn::Seam S;
    fattn::prime(G, cur, lds, S);
    bool more = true;
    for (;;) {
        unsigned tkt = 0u;
        if (more && F.tid == 0) tkt = __hip_atomic_fetch_add(qc, 1u, __ATOMIC_RELAXED, __HIP_MEMORY_SCOPE_AGENT);
        const bool last = !nxt_ok;
        fattn::block(G, cur, last ? cur : nxt, lds, S);
        if (last) break;
        if (F.tid == 0) tk_l[0] = more ? (int)tkt + 2 * M : NBLK;
        __syncthreads();
        const int k2 = __builtin_amdgcn_readfirstlane(tk_l[0]);
        __syncthreads();
        cur = nxt;
        if (k2 < NBLK) { ATT_DEC(k2, bh, qb); nxt = attn_ref(bh, qb, ATT_JLO(bh, qb)); nxt_ok = true; } else { nxt_ok = false; more = false; }
    }
#undef ATT_DEC
#undef ATT_JLO
}
typedef float f32x16 __attribute__((ext_vector_type(16)));
struct P5Args { const float *X, *WRT, *b_rgrp, *b_rexp, *w_down; const bf16* DL; bf16* X1B; unsigned char *X8, *W2; float* RS2; int* LISTS; unsigned* TOK; gu32* CNT; };
__device__ __forceinline__ void p5_route(const Frame& F, const P5Args& a) {
    const int tid = F.tid, lane = F.lane, wid = F.wave, i16 = lane & 15, h4 = lane >> 4;
    constexpr int LDA = 132;
    LAS float* A_l = (LAS float*)(F.lds + RING_OFF) + wid * 16 * LDA;
    LAS float* B_l = (LAS float*)(F.lds + RING_OFF + 67584);
    LAS float* LG = (LAS float*)(F.lds + RING_OFF + 94208);
    LAS float* rs_l = (LAS float*)(F.lds + RING_OFF + 113664);
    LAS int* hist = (LAS int*)(F.lds + RING_OFF + 114176);
    LAS int* base_l = (LAS int*)(F.lds + RING_OFF + 114432);
    {
        LAS float* scr = (LAS float*)(F.lds + RING_OFF + wid * 8704);
        const int gw = F.vcu * NWAVES + wid, NGW = F.G * NWAVES;
        for (int it = gw; it < 8192; it += NGW) { const int e = it >> 8, kb = (it >> 5) & 7, nb = it & 31; const float* W = a.w_down + (size_t)e * DE * DM;
            transpose_tile8(W + (size_t)(64 * kb) * DM + 32 * nb, DM, a.W2 + (size_t)(e * 1024 + 32 * nb) * DE + 64 * kb, DE, nullptr, pg8::W2_SCALE, scr, lane); }
    }
    __syncthreads();
    for (int rb = blockIdx.x; rb < T / 128; rb += F.G) {
        const int R0 = rb * 128;
        if (tid < 32) hist[tid] = 0;
        const int ar = lane >> 5, ac = 4 * (lane & 31);
        const size_t xo = (size_t)(R0 + 16 * wid + ar) * DM + ac; const float* xsrc = a.X + xo; const bf16* dsrc = a.DL + xo; unsigned char* xdst = a.X8 + xo; bf16* bdst = a.X1B + xo;
        f32x4 areg[8], breg[3]; unsigned long long dreg[8];
#define P5_LOAD(kc_) do { _Pragma("unroll") for (int i_ = 0; i_ < 8; ++i_) { areg[i_] = __builtin_nontemporal_load((const f32x4*)(xsrc + (size_t)(2 * i_) * DM + (kc_) * 128)); dreg[i_] = __builtin_nontemporal_load((const unsigned long long*)(dsrc + (size_t)(2 * i_) * DM + (kc_) * 128)); } \
        _Pragma("unroll") for (int q_ = 0; q_ < 3; ++q_) { const int idx_ = tid + 512 * q_; breg[q_] = *(const f32x4*)(a.WRT + (size_t)(idx_ >> 5) * DM + (kc_) * 128 + 4 * (idx_ & 31)); } } while (0)
        P5_LOAD(0);
        f32x4 acc[3] = {{0.f, 0.f, 0.f, 0.f}, {0.f, 0.f, 0.f, 0.f}, {0.f, 0.f, 0.f, 0.f}}; float ss = 0.f;
        for (int kc = 0; kc < 8; ++kc) {
#pragma unroll
            for (int i = 0; i < 8; ++i) { const unsigned dl = (unsigned)dreg[i], dh = (unsigned)(dreg[i] >> 32);
                areg[i][0] += bf_lo(dl); areg[i][1] += bf_hi(dl); areg[i][2] += bf_lo(dh); areg[i][3] += bf_hi(dh);
                *(unsigned*)(xdst + (size_t)(2 * i) * DM + kc * 128) = pg8::pack4_fp8(areg[i][0], areg[i][1], areg[i][2], areg[i][3]);
                *(unsigned long long*)(bdst + (size_t)(2 * i) * DM + kc * 128) = (unsigned long long)pg8::cvt_pk_bf16(areg[i][0], areg[i][1]) | ((unsigned long long)pg8::cvt_pk_bf16(areg[i][2], areg[i][3]) << 32);
                *(LAS f32x4*)(A_l + (2 * i + ar) * LDA + ac) = areg[i]; }
#pragma unroll
            for (int q = 0; q < 3; ++q) { const int idx = tid + 512 * q; *(LAS f32x4*)(B_l + (idx >> 5) * LDA + 4 * (idx & 31)) = breg[q]; }
            __syncthreads();
            if (kc + 1 < 8) P5_LOAD(kc + 1);
#pragma unroll
            for (int jj = 0; jj < 8; ++jj) {
                const f32x4 af = *(const LAS f32x4*)(A_l + i16 * LDA + 16 * jj + 4 * h4);
                f32x4 bfv[3];
#pragma unroll
                for (int nt = 0; nt < 3; ++nt) bfv[nt] = *(const LAS f32x4*)(B_l + (16 * nt + i16) * LDA + 16 * jj + 4 * h4);
                ss += (af[0] * af[0] + af[1] * af[1]) + (af[2] * af[2] + af[3] * af[3]);
#pragma unroll
                for (int s = 0; s < 4; ++s)
#pragma unroll
                    for (int nt = 0; nt < 3; ++nt) acc[nt] = __builtin_amdgcn_mfma_f32_16x16x4f32(af[s], bfv[nt][s], acc[nt], 0, 0, 0);
            }
            __syncthreads();
        }
#undef P5_LOAD
        ss += __shfl_xor(ss, 16); ss += __shfl_xor(ss, 32);
        const float rs = 1.0f / sqrtf(ss * (1.0f / DM) + EPS);
        if (h4 == 0) { a.RS2[R0 + 16 * wid + i16] = rs; rs_l[16 * wid + i16] = rs; }
#pragma unroll
        for (int r = 0; r < 4; ++r) { const int rl = 16 * wid + 4 * h4 + r; LG[rl * 37 + i16] = acc[0][r]; LG[rl * 37 + 16 + i16] = acc[1][r]; if (i16 < 4) LG[rl * 37 + 32 + i16] = acc[2][r]; }
        __syncthreads();
        int e0 = 0, e1 = 0, k0 = 0, k1 = 0; float w0 = 0.f, w1 = 0.f;
        if (tid < 128) {
            const float rsv = rs_l[tid]; const LAS float* lg = LG + tid * 37;
            float gl[4];
#pragma unroll
            for (int q = 0; q < 4; ++q) gl[q] = lg[32 + q] * rsv + a.b_rgrp[q];
            int gs = 0; float gm = gl[0];
#pragma unroll
            for (int q = 1; q < 4; ++q) if (gl[q] > gm) { gm = gl[q]; gs = q; }
            float den = 0.f;
#pragma unroll
            for (int q = 0; q < 4; ++q) den += expf(gl[q] - gm);
            const float pg = 1.0f / den;
            float el[8];
#pragma unroll
            for (int q = 0; q < 8; ++q) el[q] = lg[8 * gs + q] * rsv + a.b_rexp[8 * gs + q];
            int i0 = 0; float v0 = el[0];
#pragma unroll
            for (int q = 1; q < 8; ++q) if (el[q] > v0) { v0 = el[q]; i0 = q; }
            int i1 = -1; float v1 = -INFINITY;
#pragma unroll
            for (int q = 0; q < 8; ++q) if (q != i0 && el[q] > v1) { v1 = el[q]; i1 = q; }
            const float ex = expf(v1 - v0);
            w0 = pg / (1.0f + ex); w1 = pg * ex / (1.0f + ex);
            e0 = 8 * gs + i0; e1 = 8 * gs + i1;
            k0 = atomicAdd((int*)(hist + e0), 1); k1 = atomicAdd((int*)(hist + e1), 1);
        }
        __syncthreads();
        if (tid < 32) base_l[tid] = (int)__hip_atomic_fetch_add(a.CNT + tid, (unsigned)hist[tid], __ATOMIC_RELAXED, __HIP_MEMORY_SCOPE_AGENT);
        __syncthreads();
        if (tid < 128) { const int tok = R0 + tid, s0 = base_l[e0] + k0, s1 = base_l[e1] + k1;
            a.LISTS[(size_t)e0 * T + s0] = tok; a.LISTS[(size_t)e1 * T + s1] = tok;
            v4u i0v = {(unsigned)e0, (unsigned)s0, (unsigned)e1, (unsigned)s1}, i1v = {__float_as_uint(w0), __float_as_uint(w1), 0u, 0u};
            *(GAS v4u*)(a.TOK + (size_t)tok * 8) = i0v; *(GAS v4u*)(a.TOK + (size_t)tok * 8 + 4) = i1v; }
        __syncthreads();
    }
}
__device__ __forceinline__ void build_tables(const Frame& F, const gu32* CNT) {
    LAS int* ps = (LAS int*)(F.lds + TBL_PS); LAS int* cn = (LAS int*)(F.lds + TBL_CN); LAS int* te = (LAS int*)(F.lds + TBL_TE);
    __syncthreads();
    if (F.tid < 32) { int c = (int)__hip_atomic_load(CNT + F.tid, __ATOMIC_RELAXED, __HIP_MEMORY_SCOPE_AGENT); c = c < 0 ? 0 : (c > T ? T : c); cn[F.tid] = c; }
    __syncthreads();
    if (F.tid == 0) { int run = 0; for (int e = 0; e < 32; ++e) { ps[e] = run; run += (cn[e] + 255) & ~255; } if (run > PMAX) run = PMAX; ps[32] = run; }
    __syncthreads();
    if (F.tid < 288) { const int p = F.tid * 256; int e = 0; for (int q = 1; q < 32; ++q) if (p >= ps[q]) e = q; te[F.tid] = e; }
    __syncthreads();
}
__device__ __forceinline__ void build_rowtab(const Frame& F, const pg8::GroupedOrder& S, const int* LISTS, const float* RS2, LAS int* rowtab) {
    const LAS int* ps = (const LAS int*)(F.lds + TBL_PS); const LAS int* cn = (const LAS int*)(F.lds + TBL_CN); const LAS int* te = (const LAS int*)(F.lds + TBL_TE);
    pg8::Unit u;
    for (int ui = 0; ui < 6 && S.next(ui, u); ++ui)
        if (F.tid < 256) { const int p = u.pm * 256 + F.tid, e = te[u.pm], local = p - ps[e]; const int tok = local < cn[e] ? LISTS[(size_t)e * T + local] : 0; rowtab[ui * 256 + F.tid] = tok; ((LAS float*)rowtab)[(6 + ui) * 256 + F.tid] = RS2[tok]; }
    __syncthreads();
}
__device__ __forceinline__ float fp8_f32(unsigned w, int i) { return i == 0 ? __builtin_amdgcn_cvt_f32_fp8(w, 0) : (i == 1 ? __builtin_amdgcn_cvt_f32_fp8(w, 1) : (i == 2 ? __builtin_amdgcn_cvt_f32_fp8(w, 2) : __builtin_amdgcn_cvt_f32_fp8(w, 3))); }
__device__ __forceinline__ void p9_final(const Frame& F, const bf16* X1B, float* OUT, const unsigned char* Y, const unsigned* TOK, const float* g_final) {
    const LAS int* ps = (const LAS int*)(F.lds + TBL_PS);
    const int gw = F.vcu * NWAVES + F.wave, NGW = F.G * NWAVES;
    f32x4 gf[4];
#pragma unroll
    for (int j = 0; j < 4; ++j) gf[j] = *((const f32x4*)g_final + F.lane + 64 * j);
    constexpr float YS = 1.0f / (pg8::HB_SCALE * pg8::W2_SCALE * pg8::Y_SCALE);
    v4u ia_n = {0u, 0u, 0u, 0u}, ib_n = {0u, 0u, 0u, 0u}, ia_c = ia_n, ib_c = ib_n; unsigned long long xw_n[4]; unsigned ya_n[4], yb_n[4];
#define P9_TOK(m_, ia_, ib_) do { ia_ = *(const GAS v4u*)(TOK + (size_t)(m_) * 8); ib_ = *(const GAS v4u*)(TOK + (size_t)(m_) * 8 + 4); } while (0)
#define P9_ROW(m_, ia_) do { const size_t p0_ = (size_t)(ps[(int)(ia_.x & 31u)] + (int)ia_.y), p1_ = (size_t)(ps[(int)(ia_.z & 31u)] + (int)ia_.w); \
        const GAS unsigned long long* xr_ = (const GAS unsigned long long*)(X1B + (size_t)(m_) * DM) + F.lane; \
        const GAS unsigned* y0_ = (const GAS unsigned*)(Y + p0_ * DM) + F.lane; const GAS unsigned* y1_ = (const GAS unsigned*)(Y + p1_ * DM) + F.lane; \
        _Pragma("unroll") for (int j = 0; j < 4; ++j) { xw_n[j] = __builtin_nontemporal_load((const unsigned long long*)xr_ + 64 * j); ya_n[j] = __builtin_nontemporal_load((const unsigned*)y0_ + 64 * j); yb_n[j] = __builtin_nontemporal_load((const unsigned*)y1_ + 64 * j); } } while (0)
    if (gw < T) { P9_TOK(gw, ia_c, ib_c); P9_ROW(gw, ia_c); if (gw + NGW < T) P9_TOK(gw + NGW, ia_n, ib_n); }
    for (int m = gw; m < T; m += NGW) {
        const float w0 = __uint_as_float(ib_c.x) * YS, w1 = __uint_as_float(ib_c.y) * YS;
        unsigned long long xw[4]; unsigned ya[4], yb[4];
#pragma unroll
        for (int j = 0; j < 4; ++j) { xw[j] = xw_n[j]; ya[j] = ya_n[j]; yb[j] = yb_n[j]; }
        if (m + NGW < T) { ia_c = ia_n; ib_c = ib_n; P9_ROW(m + NGW, ia_c); if (m + 2 * NGW < T) P9_TOK(m + 2 * NGW, ia_n, ib_n); }
        GAS f32x4* orow = (GAS f32x4*)(OUT + (size_t)m * DM) + F.lane;
        f32x4 v[4]; float s = 0.f;
#pragma unroll
        for (int j = 0; j < 4; ++j) { v[j] = (f32x4){bf_lo((unsigned)xw[j]), bf_hi((unsigned)xw[j]), bf_lo((unsigned)(xw[j] >> 32)), bf_hi((unsigned)(xw[j] >> 32))}; const unsigned a = ya[j], b = yb[j];
            v[j].x += w0 * fp8_f32(a, 0) + w1 * fp8_f32(b, 0); v[j].y += w0 * fp8_f32(a, 1) + w1 * fp8_f32(b, 1);
            v[j].z += w0 * fp8_f32(a, 2) + w1 * fp8_f32(b, 2); v[j].w += w0 * fp8_f32(a, 3) + w1 * fp8_f32(b, 3);
            s += (v[j].x * v[j].x + v[j].y * v[j].y) + (v[j].z * v[j].z + v[j].w * v[j].w); }
        s = wave_sum(s);
        const float rs = 1.0f / sqrtf(s * (1.0f / DM) + EPS);
#pragma unroll
        for (int j = 0; j < 4; ++j) orow[64 * j] = v[j] * rs * gf[j];
    }
#undef P9_TOK
#undef P9_ROW
}

constexpr int N_PHASES = 10;
#ifndef DUP_TRIVIAL
#define DUP_TRIVIAL 0
#endif
#ifndef DUP_PHASE
#define DUP_PHASE -1
#endif
typedef __attribute__((address_space(4))) const unsigned char* karg_ptr;
__device__ __forceinline__ const float* arg_in(int k) { karg_ptr base = (karg_ptr)__builtin_amdgcn_kernarg_segment_ptr(); const unsigned long long v = *(const unsigned long long volatile __attribute__((address_space(4)))*)(base + 8 * k); return (const float*)(const GAS float*)v; }
struct Args { const float* in[23]; float* out; unsigned char* ws; int ph_lo, ph_hi, mode, pad; };
__global__ void __launch_bounds__(NWAVES * 64, 2) fwd_kernel(Args args) {
    extern __shared__ __attribute__((aligned(16))) unsigned char lds[];
    Frame F;
    F.lds = (LAS unsigned char*)lds;
    F.wave = __builtin_amdgcn_readfirstlane((int)threadIdx.x >> 6); F.lane = pg8::lane_now(); F.tid = F.wave * 64 + F.lane;
    F.G = gridDim.x; { const int bx = blockIdx.x; F.vcu = (F.G % 8 == 0) ? (bx % 8) * (F.G / 8) + bx / 8 : bx; }
    unsigned char* ws = args.ws;
    gu32* ctl = (gu32*)(ws + WS_CTL);
    volatile LAS unsigned* MISC = (volatile LAS unsigned*)(F.lds + MISC_OFF);
    for (int u = F.tid; u < (LDS_BYTES - LDSCTL_OFF) / 4; u += NWAVES * 64) ((LAS unsigned*)(F.lds + LDSCTL_OFF))[u] = 0u;
    __syncthreads();
#if MK_ONE_LAUNCH
    XcdBarrier bar = xcd_barrier_post((unsigned*)(ctl + CW_BAR), MISC + 8);
#define GRID_BAR() xcd_barrier(bar)
#else
#define GRID_BAR() do { } while (0)
#endif
    const int lo = args.ph_lo, hi = args.ph_hi;
#ifndef PH_MASK
#define PH_MASK 0x3ff
#endif
#define IN(k) (((PH_MASK >> (k)) & 1) && lo <= (k) && (k) < hi)
#define BOTH(k) (IN(k) && IN((k) + 1))
    float* out = args.out;
    bf16* Win = (bf16*)(ws + WS_WIN); bf16* Wl = (bf16*)(ws + WS_WL); bf16* Wa = (bf16*)(ws + WS_WA); bf16* Wo = (bf16*)(ws + WS_WO); bf16* Wrg = (bf16*)(ws + WS_WRG);
    bf16* XB = (bf16*)(ws + WS_XB); bf16* XR = (bf16*)(ws + WS_XR); bf16* GG = (bf16*)(ws + WS_GG); bf16* Qb = (bf16*)(ws + WS_Q); bf16* Kb = (bf16*)(ws + WS_K); bf16* Vb = (bf16*)(ws + WS_V);
    bf16* SL = (bf16*)out; bf16* SA = (bf16*)out + pg8::SEGE;
    float* RS1 = (float*)(ws + WS_RS1); float* RS2 = (float*)(ws + WS_RS2); float* LF = (float*)(ws + WS_LF); float* CB = (float*)(ws + WS_CB);
    unsigned* TOK = (unsigned*)(ws + WS_TOK); int* LISTS = (int*)(ws + WS_LISTS); float* WRT = (float*)(ws + WS_WRT); int* JLO = (int*)(ws + WS_SRS);
    unsigned char* W13 = ws + WS_W13; unsigned char* W2 = ws + WS_W2; bf16* XG = (bf16*)(ws + WS_XG); unsigned char* HB = ws + WS_HB; unsigned char* X8 = ws + WS_XB;
    gu32* CNT = ctl + CW_CNT;

    if (IN(0)) { F.lane = pg8::lane_now(); F.tid = F.wave * 64 + F.lane;
        P0Args a{arg_in(0), arg_in(1), arg_in(2), arg_in(5), arg_in(7), arg_in(10), arg_in(11), arg_in(12), arg_in(13), arg_in(14), arg_in(15), arg_in(17), arg_in(19), arg_in(20), Win, Wl, Wa, Wo, Wrg, XB, W13, RS1, LF, WRT};
        p0_prologue(F, a, DUP_PHASE == 0 ? args.mode : 0);
        if (BOTH(0)) GRID_BAR();
    }
    if (IN(1)) { F.lane = pg8::lane_now(); F.tid = F.wave * 64 + F.lane;
        cumsum_bias(F, LF, CB);
        pg8::Gemm g{XB, Win, T, NZ, DM}; pg8::StaticOrder S; S.init(T, NZ, F.G, (int)blockIdx.x);
        pg8::EpiZ E{XR, SL, RS1, (unsigned*)(ctl + CW_NORM), args.mode};
        pg8::gemm_phase<pg8::EpiZ, pg8::StaticOrder, true, true>(F.lds + RING_OFF, g, S, E, F.wave);
        if (BOTH(1)) GRID_BAR();
    }
    if (IN(2)) { F.lane = pg8::lane_now(); F.tid = F.wave * 64 + F.lane;
        { const int gw = F.vcu * NWAVES + F.wave; if (gw < NB * NH * 16) { const int j = attn_jlo(F, CB, (const unsigned*)(ctl + CW_NORM), gw >> 4, gw & 15); if (F.lane == 0) JLO[gw] = j; } }
        conv_prepass(F, XR, XB, arg_in(3), arg_in(4));
        if (BOTH(2)) GRID_BAR();
    }
    if (IN(3)) { F.lane = pg8::lane_now(); F.tid = F.wave * 64 + F.lane;
        RgArgs ra{XB, GG, GG, Wrg, arg_in(6), arg_in(8), arg_in(9)};
#if DUP_PHASE >= 20
        const int mode = args.mode;
#else
        constexpr int mode = 0;
#endif
        if (mode < 2) { ra.GO = mode == 1 ? XR : GG; for (int u = F.vcu; u < 256; u += F.G) rglru_unit(F, ra, u); }
        if (mode != 1) attn_phase(F, (char*)lds + RING_OFF, Qb, XR, Kb, Vb, CB, JLO, ctl + CW_QCTR + (mode >= 2 ? 1024 : 0), mode >= 3 ? mode - 2 : 0);
        if (BOTH(3)) GRID_BAR();
    }
    if (IN(4)) { { F.lane = pg8::lane_now(); F.tid = F.wave * 64 + F.lane;
        static_assert(WS_GG - WS_XR == (size_t)128 * 256 * DM * 2 && WS_WL - WS_WA == (size_t)4 * 256 * DM * 2, "TwoGemmOrder: hg follows o by 128 row tiles, Wl follows Wa by 4 column tiles");
        pg8::Gemm g{XR, Wa, T, DM, DM}; pg8::TwoGemmOrder S; S.init(T, DM, F.G, (int)blockIdx.x);
        pg8::EpiGate2 E{SA, SL, XB};
        pg8::gemm_phase<pg8::EpiGate2, pg8::TwoGemmOrder, true, true>(F.lds + RING_OFF, g, S, E, F.wave); }
        if (BOTH(4)) GRID_BAR();
    }
    if (IN(5)) { F.lane = pg8::lane_now(); F.tid = F.wave * 64 + F.lane;
        pg8::Gemm g{XB, Wo, T, DM, DM}; pg8::StaticOrder S; S.init(T, DM, F.G, (int)blockIdx.x);
        pg8::EpiDelta E{(bf16*)out};
        pg8::gemm_phase<pg8::EpiDelta, pg8::StaticOrder, true, true>(F.lds + RING_OFF, g, S, E, F.wave);
        if (BOTH(5)) GRID_BAR();
    }
    if (IN(6)) { F.lane = pg8::lane_now(); F.tid = F.wave * 64 + F.lane;
        P5Args a{arg_in(0), WRT, arg_in(16), arg_in(18), arg_in(21), (const bf16*)out, XR, X8, W2, RS2, LISTS, TOK, args.mode ? CNT + 64 : CNT};
        p5_route(F, a);
        if (BOTH(6)) GRID_BAR();
    }
    if (IN(7)) { F.lane = pg8::lane_now(); F.tid = F.wave * 64 + F.lane;
        build_tables(F, CNT);
        const int ntiles = ((const LAS int*)(F.lds + TBL_PS))[32] >> 8;
        pg8::Gemm g{(const bf16*)X8, (const bf16*)W13, ntiles * 256, 32 * 1024, DM / 2}; pg8::GroupedOrder S{(const LAS int*)(F.lds + TBL_TE), ntiles * 4, F.G, F.vcu};
        LAS int* rowtab = (LAS int*)(F.lds + RG_TOT);
        build_rowtab(F, S, LISTS, RS2, rowtab);
        pg8::EpiSwiGLU E{HB};
        pg8::gemm_phase_gather<pg8::EpiSwiGLU, pg8::GroupedOrder, true>(F.lds + RING_OFF, g, S, E, rowtab, F.wave);
        if (BOTH(7)) GRID_BAR();
    }
    if (IN(8)) { F.lane = pg8::lane_now(); F.tid = F.wave * 64 + F.lane;
        build_tables(F, CNT);
        const int ntiles = ((const LAS int*)(F.lds + TBL_PS))[32] >> 8;
        pg8::Gemm g{(const bf16*)HB, (const bf16*)W2, ntiles * 256, 32 * 1024, DE / 2}; pg8::GroupedOrder S{(const LAS int*)(F.lds + TBL_TE), ntiles * 4, F.G, F.vcu};
        pg8::EpiY E{(unsigned char*)XG};
        pg8::gemm_phase<pg8::EpiY, pg8::GroupedOrder, true, true, true>(F.lds + RING_OFF, g, S, E, F.wave);
        if (BOTH(8)) GRID_BAR();
    }
    if (IN(9)) { F.lane = pg8::lane_now(); F.tid = F.wave * 64 + F.lane;
        build_tables(F, CNT);
        p9_final(F, XR, out, (const unsigned char*)XG, TOK, arg_in(22));
    }
#undef IN
#undef BOTH
}

extern "C" void kernel_launch(void* const* d_in, const int* in_sizes, int n_in, void* d_out, int out_size, void* d_ws, size_t ws_size, hipStream_t stream) {
    static int grid = 0;
    if (grid == 0) {
        if (n_in != 23 || in_sizes[0] != T * DM || out_size != T * DM || ws_size < WS_END) { fprintf(stderr, "kernel_launch: unexpected shapes (n_in %d, in0 %d, out %d, ws %zu); nothing launched\n", n_in, n_in > 0 ? in_sizes[0] : -1, out_size, ws_size); grid = -1; return; }
        int dev = 0, cus = 0;
        if (hipGetDevice(&dev) != hipSuccess || hipDeviceGetAttribute(&cus, hipDeviceAttributeMultiprocessorCount, dev) != hipSuccess) { grid = -1; return; }
        if (hipFuncSetAttribute((const void*)fwd_kernel, hipFuncAttributeMaxDynamicSharedMemorySize, LDS_BYTES) != hipSuccess) { fprintf(stderr, "kernel_launch: hipFuncSetAttribute failed\n"); grid = -1; return; }
        int per_cu = 0;
        if (hipOccupancyMaxActiveBlocksPerMultiprocessor(&per_cu, (const void*)fwd_kernel, NWAVES * 64, LDS_BYTES) != hipSuccess || per_cu < 1) { fprintf(stderr, "kernel_launch: occupancy query reports %d\n", per_cu); }
        (void)hipGetLastError();
        grid = cus;
    }
    if (grid < 0) return;
    if (hipMemsetAsync((char*)d_ws + WS_CTL, 0, CTL_ZERO_BYTES, stream) != hipSuccess) return;
    Args a{};
    for (int i = 0; i < 23; ++i) a.in[i] = (const float*)d_in[i];
    a.out = (float*)d_out; a.ws = (unsigned char*)d_ws;
#if MK_ONE_LAUNCH
    a.ph_lo = 0; a.ph_hi = N_PHASES;
    hipLaunchKernelGGL(fwd_kernel, dim3(grid), dim3(NWAVES * 64), LDS_BYTES, stream, a);
#else
    for (int ph = 0; ph < N_PHASES; ++ph) { a.ph_lo = ph; a.ph_hi = ph + 1;
        if (DUP_PHASE == ph || (ph == 3 && DUP_PHASE >= 20)) { a.mode = DUP_PHASE >= 20 ? DUP_PHASE - 19 : ((ph == 6 || (ph == 1 && DUP_TRIVIAL)) ? 1 : (ph == 0 ? DUP_TRIVIAL : 0)); hipLaunchKernelGGL(fwd_kernel, dim3(grid), dim3(NWAVES * 64), LDS_BYTES, stream, a); a.mode = 0; }
        hipLaunchKernelGGL(fwd_kernel, dim3(grid), dim3(NWAVES * 64), LDS_BYTES, stream, a); }
#endif
}
```

```cpp
#include <hip/hip_runtime.h>
#include <cstdio>
#include <cstdint>

#ifndef MK_ONE_LAUNCH
#define MK_ONE_LAUNCH 1
#endif
namespace pg8 {
#define PG8_LAS __attribute__((address_space(3)))
typedef unsigned short bf16_t;
typedef short bf16x8 __attribute__((ext_vector_type(8)));
typedef float f32x4 __attribute__((ext_vector_type(4)));
typedef unsigned u32x4 __attribute__((ext_vector_type(4)));
constexpr int BM = 256, BK = 64, HALF = 128, HTB = HALF * BK * 2  , STAGE_BYTES = 8 * HTB, NXCD = 8, WGM = 8;

__host__ __device__ __forceinline__ int lds_byte(int r, int c) { const int st = (r >> 4) * 2 + (c >> 5), rr = r & 15, cc = c & 31, ob = rr * 64 + cc * 2; return st * 1024 + (ob ^ (((ob >> 9) & 1) << 5)); }
__host__ __device__ __forceinline__ void stage_rc(int b, int& R, int& C) { const int st = b / 1024, sb = b % 1024, swz = sb ^ (((sb >> 9) & 1) << 5); R = (st >> 1) * 16 + swz / 64; C = (st & 1) * 32 + (swz % 64) / 2; }
__host__ __device__ __forceinline__ int perm32(int rho) { const int n = rho >> 4, i = rho & 15; return 8 * (i >> 2) + 4 * n + (i & 3); }

struct Unit { int pm, pn; };
struct Gemm { const bf16_t* A; const bf16_t* Bt; int M, N, K; };

struct StaticOrder {
    int nM, nN, nwg, G, c;
    __host__ __device__ void init(int M, int N, int G_, int c_) { nM = M / BM; nN = N / BM; nwg = nM * nN; G = G_; c = c_; }
    __host__ __device__ bool next(int i, Unit& u) const {
        const long L = (long)i * G + c; if (L >= nwg) return false;
        int wgid = (int)L; { const int q = nwg / NXCD, r = nwg % NXCD, xcd = wgid % NXCD, off = wgid / NXCD; wgid = (xcd < r ? xcd * (q + 1) : r * (q + 1) + (xcd - r) * q) + off; }
        const int nig = WGM * nN, gid = wgid / nig, fm = gid * WGM, gsz = (nM - fm) < WGM ? (nM - fm) : WGM;
        u.pm = fm + ((wgid % nig) % gsz); u.pn = (wgid % nig) / gsz; return true;
    }
    __device__ __forceinline__ void a_ready(const Unit&) const {}
    __device__ __forceinline__ void done(const Unit&) const {}
};

__device__ __forceinline__ unsigned cvt_pk_bf16(float lo, float hi) { unsigned r; asm volatile("v_cvt_pk_bf16_f32 %0, %1, %2" : "=v"(r) : "v"(lo), "v"(hi)); return r; }
typedef float f32x2 __attribute__((ext_vector_type(2)));
__device__ __forceinline__ int lane_now() { int l; asm volatile("v_mbcnt_lo_u32_b32 %0, -1, 0\n\tv_mbcnt_hi_u32_b32 %0, -1, %0" : "=v"(l)); return l; }
typedef int v4i_t __attribute__((ext_vector_type(4)));
typedef int v8i_t __attribute__((ext_vector_type(8)));
__device__ __forceinline__ v8i_t cat8(bf16x8 a, bf16x8 b) { const v4i_t x = __builtin_bit_cast(v4i_t, a), y = __builtin_bit_cast(v4i_t, b); return __builtin_shufflevector(x, y, 0, 1, 2, 3, 4, 5, 6, 7); }
__device__ __forceinline__ void glds_sv(const char* base, unsigned voff, unsigned lds_dst) { unsigned keep;
    asm volatile("s_mov_b32 %0, m0\n\ts_mov_b32 m0, %3\n\ts_nop 0\n\tglobal_load_lds_dwordx4 %1, %2\n\ts_mov_b32 m0, %0" : "=&s"(keep) : "v"(voff), "s"(base), "s"(lds_dst) : "memory"); }
__device__ __forceinline__ float sat8(float x) { return __builtin_amdgcn_fmed3f(x, -448.0f, 448.0f); }
__device__ __forceinline__ unsigned pack4_fp8(float a, float b, float c, float d) { unsigned w = 0u; w = __builtin_amdgcn_cvt_pk_fp8_f32(sat8(a), sat8(b), w, false); w = __builtin_amdgcn_cvt_pk_fp8_f32(sat8(c), sat8(d), w, true); return w; }
constexpr float W13_SCALE = 64.0f, HB_SCALE = 8.0f, W2_SCALE = 32.0f;
__device__ __forceinline__ float sigmoid_f(float x) { return __builtin_amdgcn_rcpf(1.0f + __builtin_amdgcn_exp2f(-1.4426950408889634f * x)); }
__device__ __forceinline__ float gelu_tanh_f(float x) { const float u = x * (1.0f + 0.044715f * x * x); return x * __builtin_amdgcn_rcpf(1.0f + __builtin_amdgcn_exp2f(-2.3022081981f * u)); }
__device__ __forceinline__ float bf_lo(unsigned w) { return __builtin_bit_cast(float, w << 16); }
__device__ __forceinline__ float bf_hi(unsigned w) { return __builtin_bit_cast(float, w & 0xffff0000u); }
constexpr size_t SEGE = (size_t)32768 * 1024;

struct EpiZ {
    static constexpr bool PERM = true, AFTER_DRAIN = false; static constexpr int NSTORES = 16;
    bf16_t* ws5; bf16_t* out2; const float* rs; unsigned* norm; int probe;
    __device__ __forceinline__ void operator()(const f32x4 (&acc)[2][2][4][2], const Unit& u, int wr, int wc, int fr, int fq) const {
        const int seg = probe ? 0 : (u.pn >> 2); float nm[2] = {0.f, 0.f};
        const int sgo = u.pn >> 2; bf16_t* O = sgo < 5 ? ws5 + (size_t)sgo * SEGE : out2 + (size_t)(sgo - 5) * SEGE;
        const int row0 = u.pm * BM + wr * 64 + fr, col0 = (u.pn & 3) * BM + wc * 32 + 8 * fq;
#pragma unroll
        for (int ai = 0; ai < 2; ++ai)
#pragma unroll
            for (int m = 0; m < 4; ++m) { const int row = row0 + ai * HALF + m * 16; bf16_t* rowp = O + (size_t)row * 1024 + col0;
                const bool hm = (sgo >= 2 && sgo <= 4); bf16_t* rowh = O + ((size_t)((row >> 12) * 8 + 2 * (u.pn & 3)) * 4096 + (row & 4095)) * 128 + wc * 32 + 8 * fq;
#pragma unroll
                for (int bj = 0; bj < 2; ++bj) { f32x4 v0 = acc[ai][bj][m][0], v1 = acc[ai][bj][m][1];
                    if (seg == 1) {
#pragma unroll
                        for (int i = 0; i < 4; ++i) { v0[i] = gelu_tanh_f(v0[i]); v1[i] = gelu_tanh_f(v1[i]); } }
                    else if (seg >= 5) {
#pragma unroll
                        for (int i = 0; i < 4; ++i) { v0[i] = sigmoid_f(v0[i]); v1[i] = sigmoid_f(v1[i]); } }
                    if (seg == 2 || seg == 3) { float q = (v0[0] * v0[0] + v0[1] * v0[1]) + (v0[2] * v0[2] + v0[3] * v0[3]) + (v1[0] * v1[0] + v1[1] * v1[1]) + (v1[2] * v1[2] + v1[3] * v1[3]);
                        q += __shfl_xor(q, 16); q += __shfl_xor(q, 32); nm[bj] = fmaxf(nm[bj], q); }
                    u32x4 w; w.x = cvt_pk_bf16(v0[0], v0[1]); w.y = cvt_pk_bf16(v0[2], v0[3]); w.z = cvt_pk_bf16(v1[0], v1[1]); w.w = cvt_pk_bf16(v1[2], v1[3]);
                    *(u32x4*)(hm ? rowh + (size_t)bj * 4096 * 128 : rowp + bj * HALF) = w; } }
        if (seg == 2 || seg == 3) {
#pragma unroll
            for (int bj = 0; bj < 2; ++bj) { float q = nm[bj];
#pragma unroll
                for (int o = 1; o < 16; o <<= 1) q = fmaxf(q, __shfl_xor(q, o));
                if (fr == 0 && fq == 0) atomicMax(norm + ((((seg - 2) * 8 + (u.pm >> 4)) * 8 + 2 * (u.pn & 3) + bj) * 4 + wc), __float_as_uint(q)); }
        }
    }
};
template <int MODE> struct EpiGate {
    static constexpr bool PERM = true, AFTER_DRAIN = false; static constexpr int NSTORES = 16;
    const bf16_t* G; bf16_t* O;
    __device__ __forceinline__ void operator()(const f32x4 (&acc)[2][2][4][2], const Unit& u, int wr, int wc, int fr, int fq) const {
        const int row0 = u.pm * BM + wr * 64 + fr, col0 = u.pn * BM + wc * 32 + 8 * fq;
        u32x4 gv[2][2][2], pv[2][2][2];
#define EG_LOAD(st_, b_) do { _Pragma("unroll") for (int mm = 0; mm < 2; ++mm) _Pragma("unroll") for (int bj = 0; bj < 2; ++bj) { \
            const size_t off_ = (size_t)(row0 + ((st_) >> 1) * HALF + (2 * ((st_) & 1) + mm) * 16) * 1024 + col0 + bj * HALF; gv[b_][mm][bj] = __builtin_nontemporal_load((const u32x4*)(G + off_)); if (MODE == 1) pv[b_][mm][bj] = __builtin_nontemporal_load((const u32x4*)(O + off_)); } } while (0)
#define EG_DO(st_, b_) do { _Pragma("unroll") for (int mm = 0; mm < 2; ++mm) _Pragma("unroll") for (int bj = 0; bj < 2; ++bj) { const int ai = (st_) >> 1, m = 2 * ((st_) & 1) + mm; \
            const size_t off_ = (size_t)(row0 + ai * HALF + m * 16) * 1024 + col0 + bj * HALF; const u32x4 g = gv[b_][mm][bj]; \
            f32x4 v0 = acc[ai][bj][m][0], v1 = acc[ai][bj][m][1]; \
            v0[0] *= bf_lo(g.x); v0[1] *= bf_hi(g.x); v0[2] *= bf_lo(g.y); v0[3] *= bf_hi(g.y); v1[0] *= bf_lo(g.z); v1[1] *= bf_hi(g.z); v1[2] *= bf_lo(g.w); v1[3] *= bf_hi(g.w); \
            if (MODE == 1) { const u32x4 p = pv[b_][mm][bj]; \
                v0[0] += bf_lo(p.x); v0[1] += bf_hi(p.x); v0[2] += bf_lo(p.y); v0[3] += bf_hi(p.y); v1[0] += bf_lo(p.z); v1[1] += bf_hi(p.z); v1[2] += bf_lo(p.w); v1[3] += bf_hi(p.w); } \
            u32x4 w; w.x = cvt_pk_bf16(v0[0], v0[1]); w.y = cvt_pk_bf16(v0[2], v0[3]); w.z = cvt_pk_bf16(v1[0], v1[1]); w.w = cvt_pk_bf16(v1[2], v1[3]); \
            *(u32x4*)(O + off_) = w; } } while (0)
        EG_LOAD(0, 0); EG_LOAD(1, 1); EG_DO(0, 0); EG_LOAD(2, 0); EG_DO(1, 1); EG_LOAD(3, 1); EG_DO(2, 0); EG_DO(3, 1);
#undef EG_LOAD
#undef EG_DO
    }
};
struct TwoGemmOrder {
    StaticOrder base; int n1;
    __device__ void init(int M, int N, int G_, int c_) { base.init(M, N, G_, c_); n1 = (base.nwg - c_ + G_ - 1) / G_; if (n1 < 0) n1 = 0; }
    __device__ __forceinline__ bool next(int i, Unit& u) const { if (i >= 2 * n1) return false; const bool second = i >= n1; base.next(second ? i - n1 : i, u); if (second) { u.pm += 128; u.pn += 4; } return true; }
    __device__ __forceinline__ void a_ready(const Unit&) const {}
    __device__ __forceinline__ void done(const Unit&) const {}
};
struct EpiGate2 {
    static constexpr bool PERM = true, AFTER_DRAIN = false; static constexpr int NSTORES = 16;
    const bf16_t* G0; const bf16_t* G1; bf16_t* O;
    __device__ __forceinline__ void operator()(const f32x4 (&acc)[2][2][4][2], const Unit& u, int wr, int wc, int fr, int fq) const {
        Unit v; v.pm = u.pm & 127; v.pn = u.pn & 3;
        if (u.pm >= 128) { EpiGate<1> e{G1, O}; e(acc, v, wr, wc, fr, fq); } else { EpiGate<0> e{G0, O}; e(acc, v, wr, wc, fr, fq); }
    }
};
struct EpiDelta {
    static constexpr bool PERM = true, AFTER_DRAIN = false; static constexpr int NSTORES = 16;
    bf16_t* O;
    __device__ __forceinline__ void operator()(const f32x4 (&acc)[2][2][4][2], const Unit& u, int wr, int wc, int fr, int fq) const {
        const int row0 = u.pm * BM + wr * 64 + fr, col0 = u.pn * BM + wc * 32 + 8 * fq;
#pragma unroll
        for (int ai = 0; ai < 2; ++ai)
#pragma unroll
            for (int m = 0; m < 4; ++m) { bf16_t* rowp = O + (size_t)(row0 + ai * HALF + m * 16) * 1024 + col0;
#pragma unroll
                for (int bj = 0; bj < 2; ++bj) { const f32x4 v0 = acc[ai][bj][m][0], v1 = acc[ai][bj][m][1];
                    u32x4 w; w.x = cvt_pk_bf16(v0[0], v0[1]); w.y = cvt_pk_bf16(v0[2], v0[3]); w.z = cvt_pk_bf16(v1[0], v1[1]); w.w = cvt_pk_bf16(v1[2], v1[3]);
                    *(u32x4*)(rowp + bj * HALF) = w; } }
    }
};
struct EpiSwiGLU {
    static constexpr bool PERM = true, AFTER_DRAIN = false; static constexpr int NSTORES = 8;
    unsigned char* HB;
    __device__ __forceinline__ void operator()(const f32x4 (&acc)[2][2][4][2], const Unit& u, int wr, int wc, int fr, int fq, const PG8_LAS int* rows) const {
        const int row0 = u.pm * BM + wr * 64 + fr, col0 = (u.pn & 3) * HALF + wc * 32 + 8 * fq;
        float sv[2][4];
#pragma unroll
        for (int ai = 0; ai < 2; ++ai)
#pragma unroll
            for (int m = 0; m < 4; ++m) sv[ai][m] = ((const PG8_LAS float*)rows)[6 * 256 + wr * 64 + fr + ai * HALF + m * 16] * (1.0f / W13_SCALE);
#pragma unroll
        for (int ai = 0; ai < 2; ++ai)
#pragma unroll
            for (int m = 0; m < 4; ++m) { const int row = row0 + ai * HALF + m * 16; const float s = sv[ai][m];
                float o[8];
#pragma unroll
                for (int n = 0; n < 2; ++n)
#pragma unroll
                    for (int i = 0; i < 4; ++i) { const float g = acc[ai][0][m][n][i] * s, uu = acc[ai][1][m][n][i] * s; o[n * 4 + i] = g * sigmoid_f(g) * uu * HB_SCALE; }
                unsigned long long w = (unsigned long long)pack4_fp8(o[0], o[1], o[2], o[3]) | ((unsigned long long)pack4_fp8(o[4], o[5], o[6], o[7]) << 32);
                *(unsigned long long*)(HB + (size_t)row * 512 + col0) = w; }
    }
};
constexpr float Y_SCALE = 0.25f;
struct EpiY {
    static constexpr bool PERM = true, AFTER_DRAIN = false; static constexpr int NSTORES = 16;
    unsigned char* Y;
    __device__ __forceinline__ void operator()(const f32x4 (&acc)[2][2][4][2], const Unit& u, int wr, int wc, int fr, int fq) const {
        const int row0 = u.pm * BM + wr * 64 + fr, col0 = (u.pn & 3) * BM + wc * 32 + 8 * fq;
#pragma unroll
        for (int ai = 0; ai < 2; ++ai)
#pragma unroll
            for (int m = 0; m < 4; ++m) { const int row = row0 + ai * HALF + m * 16; unsigned char* rowp = Y + (size_t)row * 1024 + col0;
#pragma unroll
                for (int bj = 0; bj < 2; ++bj) { const f32x4 v0 = acc[ai][bj][m][0] * Y_SCALE, v1 = acc[ai][bj][m][1] * Y_SCALE;
                    *(unsigned long long*)(rowp + bj * HALF) = (unsigned long long)pack4_fp8(v0[0], v0[1], v0[2], v0[3]) | ((unsigned long long)pack4_fp8(v1[0], v1[1], v1[2], v1[3]) << 32); } }
    }
};
struct GroupedOrder {
    const PG8_LAS int* tile_e; int nunits, G, c;
    __device__ __forceinline__ bool next(int i, Unit& u) const { const int L = i * G + c; if (L >= nunits) return false; u.pm = L >> 2; u.pn = __builtin_amdgcn_readfirstlane(tile_e[u.pm]) * 4 + (L & 3); return true; }
    __device__ __forceinline__ void a_ready(const Unit&) const {}
    __device__ __forceinline__ void done(const Unit&) const {}
};
template <class Epi, class Sched, bool ALIGN_EPI = false, bool SP2 = false, bool F8 = false>
__device__ __forceinline__ void gemm_phase(PG8_LAS unsigned char* lds, const Gemm g, const Sched& S, const Epi& E, const int wid) {
    const int lane = lane_now(), tid = wid * 64 + lane, wr = wid >> 2, wc = wid & 3, fr = lane & 15, fq = lane >> 4;
    const int K = g.K, nt = K / BK;
    unsigned voffA[2], voffB[2];
#pragma unroll
    for (int i = 0; i < 2; ++i) { int R, C; stage_rc(tid * 16 + i * 8192, R, C); const int Rb = Epi::PERM ? ((R & ~31) + perm32(R & 31)) : R;
        voffA[i] = (unsigned)(R * K + C) * 2u; voffB[i] = (unsigned)(Rb * K + C) * 2u; }
    const size_t kstep = (size_t)(BK * 2);
    const size_t hstep = (size_t)HALF * K * 2;
    const size_t tstep = 2 * hstep;
    const unsigned ldsw = (unsigned)wid * 1024u;
    const unsigned ldsbase = (unsigned)__builtin_amdgcn_readfirstlane((int)((unsigned)(uintptr_t)lds + ldsw));
    const int aoff = lds_byte(wr * 64 + fr, fq * 8), boff = lds_byte(wc * 32 + fr, fq * 8);
#define PG8_SA(b, h) (((b) * 2 + (h)) * HTB)
#define PG8_SB(b, h) ((4 + (b) * 2 + (h)) * HTB)
#define PG8_STAGE(bufoff, gbase, voff) do { _Pragma("unroll") for (int _i = 0; _i < 2; ++_i) { \
        if constexpr (F8) glds_sv((const char*)(gbase), (voff)[_i], ldsbase + (unsigned)((bufoff) + _i * 8192)); \
        else __builtin_amdgcn_global_load_lds((const unsigned*)((const char*)(gbase) + (voff)[_i]), (PG8_LAS unsigned*)(lds + (bufoff) + ldsw + _i * 8192), 16, 0, 0); } } while (0)
#define PG8_LDA(dst, b, h) do { _Pragma("unroll") for (int m = 0; m < 4; ++m) { \
        if constexpr (F8) { dst##8[m] = cat8(*(const PG8_LAS bf16x8*)(lds + PG8_SA(b, h) + aoff + m * 2048), *(const PG8_LAS bf16x8*)(lds + PG8_SA(b, h) + aoff + m * 2048 + 1024)); } \
        else { _Pragma("unroll") for (int k = 0; k < 2; ++k) dst[m][k] = *(const PG8_LAS bf16x8*)(lds + PG8_SA(b, h) + aoff + m * 2048 + k * 1024); } } } while (0)
#define PG8_LDB(dst, b, h) do { _Pragma("unroll") for (int n = 0; n < 2; ++n) { \
        if constexpr (F8) { dst##8[n] = cat8(*(const PG8_LAS bf16x8*)(lds + PG8_SB(b, h) + boff + n * 2048), *(const PG8_LAS bf16x8*)(lds + PG8_SB(b, h) + boff + n * 2048 + 1024)); } \
        else { _Pragma("unroll") for (int k = 0; k < 2; ++k) dst[n][k] = *(const PG8_LAS bf16x8*)(lds + PG8_SB(b, h) + boff + n * 2048 + k * 1024); } } } while (0)
#define PG8_MMA(ai, bj, At, Bt) do { __builtin_amdgcn_s_setprio(1); _Pragma("unroll") for (int m = 0; m < 4; ++m) _Pragma("unroll") for (int n = 0; n < 2; ++n) { \
        if constexpr (F8) { acc[ai][bj][m][n] = __builtin_amdgcn_mfma_scale_f32_16x16x128_f8f6f4(Bt##8[n], At##8[m], acc[ai][bj][m][n], 0, 0, 0, 0, 0, 0); } \
        else { _Pragma("unroll") for (int k = 0; k < 2; ++k) acc[ai][bj][m][n] = __builtin_amdgcn_mfma_f32_16x16x32_bf16(Bt[n][k], At[m][k], acc[ai][bj][m][n], 0, 0, 0); } } \
        __builtin_amdgcn_s_setprio(0); } while (0)
#define PG8_WAIT_V(n) asm volatile("s_waitcnt vmcnt(" #n ")" ::: "memory")
#define PG8_WAIT_L(n) asm volatile("s_waitcnt lgkmcnt(" #n ")" ::: "memory")
#define PG8_BAR __builtin_amdgcn_s_barrier()
#define PG8_SCHED __builtin_amdgcn_sched_barrier(0)
    Unit cur, nxt; int ui = 0;
    if (!S.next(0, cur)) return;
    f32x4 acc[2][2][4][2];
#pragma unroll
    for (int a = 0; a < 2; ++a)
#pragma unroll
        for (int b = 0; b < 2; ++b)
#pragma unroll
            for (int m = 0; m < 4; ++m)
#pragma unroll
                for (int n = 0; n < 2; ++n) acc[a][b][m][n] = (f32x4){0.f, 0.f, 0.f, 0.f};
    bf16x8 At[4][2], B0[2][2], B1[2][2]; v8i_t At8[4], B08[2], B18[2];
    const char* cA = (const char*)g.A + (size_t)cur.pm * tstep; const char* cB = (const char*)g.Bt + (size_t)cur.pn * tstep;
    S.a_ready(cur);
    if constexpr (SP2) {
        PG8_STAGE(PG8_SB(0, 0), cB, voffB); PG8_STAGE(PG8_SB(0, 1), cB + hstep, voffB); PG8_STAGE(PG8_SA(0, 0), cA, voffA); PG8_STAGE(PG8_SA(0, 1), cA + hstep, voffA);
        if (wr == 1) PG8_BAR;
        PG8_WAIT_V(2); PG8_BAR;
        PG8_STAGE(PG8_SB(1, 0), cB + kstep, voffB); PG8_STAGE(PG8_SA(1, 0), cA + kstep, voffA); PG8_STAGE(PG8_SB(1, 1), cB + hstep + kstep, voffB);
        PG8_WAIT_V(6); PG8_BAR;
    } else {
        PG8_STAGE(PG8_SB(0, 0), cB, voffB); PG8_STAGE(PG8_SA(0, 0), cA, voffA); PG8_STAGE(PG8_SB(0, 1), cB + hstep, voffB); PG8_STAGE(PG8_SA(0, 1), cA + hstep, voffA);
        if (wr == 1) PG8_BAR;
        PG8_WAIT_V(4); PG8_BAR;
        PG8_STAGE(PG8_SB(1, 0), cB + kstep, voffB); PG8_STAGE(PG8_SA(1, 0), cA + kstep, voffA); PG8_STAGE(PG8_SB(1, 1), cB + hstep + kstep, voffB);
        PG8_WAIT_V(6); PG8_BAR;
    }
    for (;;) {
        const bool has_next = S.next(ui + 1, nxt);
        const char* nA = has_next ? (const char*)g.A + (size_t)nxt.pm * tstep : cA; const char* nB = has_next ? (const char*)g.Bt + (size_t)nxt.pn * tstep : cB;
#pragma clang loop unroll(disable)
        for (int t = 0; t < nt; t += 2) {
            const bool last = (t == nt - 2);
            const char* a1 = cA + (size_t)(t + 1) * kstep;
            const char* a2 = last ? nA : cA + (size_t)(t + 2) * kstep; const char* b2 = last ? nB : cB + (size_t)(t + 2) * kstep;
            const char* a3 = a2 + kstep; const char* b3 = b2 + kstep;
            if (last && has_next) S.a_ready(nxt);
            if constexpr (SP2) {
            PG8_LDB(B0, 0, 0); PG8_LDB(B1, 0, 1); PG8_SCHED; PG8_LDA(At, 0, 0); PG8_STAGE(PG8_SA(1, 1), a1 + hstep, voffA);
            PG8_WAIT_V(8); PG8_WAIT_L(0); PG8_BAR; PG8_MMA(0, 0, At, B0); PG8_MMA(0, 1, At, B1); PG8_BAR; PG8_SCHED;
            PG8_LDA(At, 0, 1); PG8_STAGE(PG8_SB(0, 0), b2, voffB); PG8_STAGE(PG8_SB(0, 1), b2 + hstep, voffB); PG8_STAGE(PG8_SA(0, 0), a2, voffA);
            PG8_WAIT_V(8); PG8_WAIT_L(0); PG8_BAR; PG8_MMA(1, 0, At, B0); PG8_MMA(1, 1, At, B1); PG8_BAR; PG8_SCHED;
            PG8_LDB(B0, 1, 0); PG8_LDB(B1, 1, 1); PG8_SCHED; PG8_LDA(At, 1, 0); PG8_STAGE(PG8_SA(0, 1), a2 + hstep, voffA);
            PG8_WAIT_V(8); PG8_WAIT_L(0); PG8_BAR; PG8_MMA(0, 0, At, B0); PG8_MMA(0, 1, At, B1); PG8_BAR; PG8_SCHED;
            PG8_LDA(At, 1, 1); PG8_STAGE(PG8_SB(1, 0), b3, voffB); PG8_STAGE(PG8_SB(1, 1), b3 + hstep, voffB); PG8_STAGE(PG8_SA(1, 0), a3, voffA);
            PG8_WAIT_V(8); PG8_WAIT_L(0); PG8_BAR; PG8_MMA(1, 0, At, B0); PG8_MMA(1, 1, At, B1); PG8_BAR; PG8_SCHED;
            } else {
            PG8_LDB(B0, 0, 0); PG8_SCHED; PG8_LDA(At, 0, 0); PG8_STAGE(PG8_SA(1, 1), a1 + hstep, voffA);
            PG8_WAIT_L(8); PG8_BAR; PG8_WAIT_L(0); PG8_MMA(0, 0, At, B0); PG8_BAR; PG8_SCHED;
            PG8_LDB(B1, 0, 1); PG8_STAGE(PG8_SB(0, 0), b2, voffB);
            PG8_BAR; PG8_WAIT_L(0); PG8_MMA(0, 1, At, B1); PG8_BAR;
            PG8_LDA(At, 0, 1); PG8_STAGE(PG8_SA(0, 0), a2, voffA);
            PG8_BAR; PG8_WAIT_L(0); PG8_MMA(1, 0, At, B0); PG8_BAR; PG8_SCHED;
            PG8_STAGE(PG8_SB(0, 1), b2 + hstep, voffB);
            PG8_WAIT_V(6); PG8_BAR; PG8_MMA(1, 1, At, B1); PG8_BAR;
            PG8_LDB(B0, 1, 0); PG8_SCHED; PG8_LDA(At, 1, 0); PG8_STAGE(PG8_SA(0, 1), a2 + hstep, voffA);
            PG8_WAIT_L(8); PG8_BAR; PG8_WAIT_L(0); PG8_MMA(0, 0, At, B0); PG8_BAR; PG8_SCHED;
            PG8_LDB(B1, 1, 1); PG8_STAGE(PG8_SB(1, 0), b3, voffB);
            PG8_BAR; PG8_WAIT_L(0); PG8_MMA(0, 1, At, B1); PG8_BAR;
            PG8_LDA(At, 1, 1); PG8_STAGE(PG8_SA(1, 0), a3, voffA);
            PG8_BAR; PG8_WAIT_L(0); PG8_MMA(1, 0, At, B0); PG8_BAR; PG8_SCHED;
            PG8_STAGE(PG8_SB(1, 1), b3 + hstep, voffB);
            PG8_WAIT_V(6); PG8_BAR; PG8_MMA(1, 1, At, B1); PG8_BAR;
            }
        }
        if constexpr (ALIGN_EPI) { if (wr == 0) PG8_BAR; }
        if constexpr (!Epi::AFTER_DRAIN) { const int l2 = lane_now(); E(acc, cur, wr, wc, l2 & 15, l2 >> 4); S.done(cur); }
        if (!has_next) break;
#pragma unroll
        for (int a = 0; a < 2; ++a)
#pragma unroll
            for (int b = 0; b < 2; ++b)
#pragma unroll
                for (int m = 0; m < 4; ++m)
#pragma unroll
                    for (int n = 0; n < 2; ++n) acc[a][b][m][n] = (f32x4){0.f, 0.f, 0.f, 0.f};
        cur = nxt; cA = nA; cB = nB; ++ui;
        if constexpr (ALIGN_EPI) { if (wr == 1) PG8_BAR; }
    }
    PG8_WAIT_V(0);
    if constexpr (!ALIGN_EPI) { if (wr == 0) PG8_BAR; }
    PG8_BAR;
    if constexpr (Epi::AFTER_DRAIN) { E.fused(acc, cur, wr, wc, fr, fq, lds, wid, lane); S.done(cur); }
#undef PG8_SA
#undef PG8_SB
#undef PG8_STAGE
#undef PG8_LDA
#undef PG8_LDB
#undef PG8_MMA
#undef PG8_WAIT_V
#undef PG8_WAIT_L
#undef PG8_BAR
#undef PG8_SCHED
}
template <class Epi, class Sched, bool F8 = false>
__device__ __forceinline__ void gemm_phase_gather(PG8_LAS unsigned char* lds, const Gemm g, const Sched& S, const Epi& E, const PG8_LAS int* rowtab, const int wid) {
    constexpr bool ALIGN_EPI = true, SP2 = true;
    const int lane = lane_now(), tid = wid * 64 + lane, wr = wid >> 2, wc = wid & 3, fr = lane & 15, fq = lane >> 4;
    const int K = g.K, nt = K / BK;
    unsigned voffB[2], vAc[2][2];
#pragma unroll
    for (int i = 0; i < 2; ++i) { int R, C; stage_rc(tid * 16 + i * 8192, R, C); const int Rb = Epi::PERM ? ((R & ~31) + perm32(R & 31)) : R;
        voffB[i] = (unsigned)(Rb * K + C) * 2u; }
#define PG8_ROWS(dst, ui_) do { const int t_ = wid * 64 + lane_now(); _Pragma("unroll") for (int i_ = 0; i_ < 2; ++i_) { int R_, C_; stage_rc(t_ * 16 + i_ * 8192, R_, C_); \
        _Pragma("unroll") for (int h_ = 0; h_ < 2; ++h_) dst[h_][i_] = (unsigned)rowtab[(ui_) * 256 + h_ * HALF + R_] * (unsigned)(K * 2) + (unsigned)(C_ * 2); } } while (0)
#define PG8_STAGE_A(bufoff, v, kb) do { _Pragma("unroll") for (int _i = 0; _i < 2; ++_i) { \
        if constexpr (F8) glds_sv((const char*)g.A + (kb), (v)[_i], ldsbase + (unsigned)((bufoff) + _i * 8192)); \
        else __builtin_amdgcn_global_load_lds((const unsigned*)((const char*)g.A + (v)[_i] + (kb)), (PG8_LAS unsigned*)(lds + (bufoff) + ldsw + _i * 8192), 16, 0, 0); } } while (0)
    const size_t kstep = (size_t)(BK * 2);
    const size_t hstep = (size_t)HALF * K * 2;
    const size_t tstep = 2 * hstep;
    const unsigned ldsw = (unsigned)wid * 1024u;
    const unsigned ldsbase = (unsigned)__builtin_amdgcn_readfirstlane((int)((unsigned)(uintptr_t)lds + ldsw));
    const int aoff = lds_byte(wr * 64 + fr, fq * 8), boff = lds_byte(wc * 32 + fr, fq * 8);
#define PG8_SA(b, h) (((b) * 2 + (h)) * HTB)
#define PG8_SB(b, h) ((4 + (b) * 2 + (h)) * HTB)
#define PG8_STAGE(bufoff, gbase, voff) do { _Pragma("unroll") for (int _i = 0; _i < 2; ++_i) { \
        if constexpr (F8) glds_sv((const char*)(gbase), (voff)[_i], ldsbase + (unsigned)((bufoff) + _i * 8192)); \
        else __builtin_amdgcn_global_load_lds((const unsigned*)((const char*)(gbase) + (voff)[_i]), (PG8_LAS unsigned*)(lds + (bufoff) + ldsw + _i * 8192), 16, 0, 0); } } while (0)
#define PG8_LDA(dst, b, h) do { _Pragma("unroll") for (int m = 0; m < 4; ++m) { \
        if constexpr (F8) { dst##8[m] = cat8(*(const PG8_LAS bf16x8*)(lds + PG8_SA(b, h) + aoff + m * 2048), *(const PG8_LAS bf16x8*)(lds + PG8_SA(b, h) + aoff + m * 2048 + 1024)); } \
        else { _Pragma("unroll") for (int k = 0; k < 2; ++k) dst[m][k] = *(const PG8_LAS bf16x8*)(lds + PG8_SA(b, h) + aoff + m * 2048 + k * 1024); } } } while (0)
#define PG8_LDB(dst, b, h) do { _Pragma("unroll") for (int n = 0; n < 2; ++n) { \
        if constexpr (F8) { dst##8[n] = cat8(*(const PG8_LAS bf16x8*)(lds + PG8_SB(b, h) + boff + n * 2048), *(const PG8_LAS bf16x8*)(lds + PG8_SB(b, h) + boff + n * 2048 + 1024)); } \
        else { _Pragma("unroll") for (int k = 0; k < 2; ++k) dst[n][k] = *(const PG8_LAS bf16x8*)(lds + PG8_SB(b, h) + boff + n * 2048 + k * 1024); } } } while (0)
#define PG8_MMA(ai, bj, At, Bt) do { __builtin_amdgcn_s_setprio(1); _Pragma("unroll") for (int m = 0; m < 4; ++m) _Pragma("unroll") for (int n = 0; n < 2; ++n) { \
        if constexpr (F8) { acc[ai][bj][m][n] = __builtin_amdgcn_mfma_scale_f32_16x16x128_f8f6f4(Bt##8[n], At##8[m], acc[ai][bj][m][n], 0, 0, 0, 0, 0, 0); } \
        else { _Pragma("unroll") for (int k = 0; k < 2; ++k) acc[ai][bj][m][n] = __builtin_amdgcn_mfma_f32_16x16x32_bf16(Bt[n][k], At[m][k], acc[ai][bj][m][n], 0, 0, 0); } } \
        __builtin_amdgcn_s_setprio(0); } while (0)
#define PG8_WAIT_V(n) asm volatile("s_waitcnt vmcnt(" #n ")" ::: "memory")
#define PG8_WAIT_L(n) asm volatile("s_waitcnt lgkmcnt(" #n ")" ::: "memory")
#define PG8_BAR __builtin_amdgcn_s_barrier()
#define PG8_SCHED __builtin_amdgcn_sched_barrier(0)
    Unit cur, nxt; int ui = 0;
    if (!S.next(0, cur)) return;
    f32x4 acc[2][2][4][2];
#pragma unroll
    for (int a = 0; a < 2; ++a)
#pragma unroll
        for (int b = 0; b < 2; ++b)
#pragma unroll
            for (int m = 0; m < 4; ++m)
#pragma unroll
                for (int n = 0; n < 2; ++n) acc[a][b][m][n] = (f32x4){0.f, 0.f, 0.f, 0.f};
    bf16x8 At[4][2], B0[2][2], B1[2][2]; v8i_t At8[4], B08[2], B18[2];
    const char* cB = (const char*)g.Bt + (size_t)cur.pn * tstep;
    PG8_ROWS(vAc, 0);
    S.a_ready(cur);
    if constexpr (SP2) {
        PG8_STAGE(PG8_SB(0, 0), cB, voffB); PG8_STAGE(PG8_SB(0, 1), cB + hstep, voffB); PG8_STAGE_A(PG8_SA(0, 0), vAc[0], 0u); PG8_STAGE_A(PG8_SA(0, 1), vAc[1], 0u);
        if (wr == 1) PG8_BAR;
        PG8_WAIT_V(2); PG8_BAR;
        PG8_STAGE(PG8_SB(1, 0), cB + kstep, voffB); PG8_STAGE_A(PG8_SA(1, 0), vAc[0], (unsigned)kstep); PG8_STAGE(PG8_SB(1, 1), cB + hstep + kstep, voffB);
        PG8_WAIT_V(6); PG8_BAR;
    }
    for (;;) {
        const bool has_next = S.next(ui + 1, nxt);
        const char* nB = has_next ? (const char*)g.Bt + (size_t)nxt.pn * tstep : cB;
#pragma clang loop unroll(disable)
        for (int t = 0; t < nt; t += 2) {
            const bool last = (t == nt - 2);
            const unsigned k1 = (unsigned)((t + 1) * (int)kstep), k2 = last ? 0u : (unsigned)((t + 2) * (int)kstep), k3 = k2 + (unsigned)kstep;
            unsigned v2[2][2];
            if (last && has_next) { PG8_ROWS(v2, ui + 1); }
            else {
#pragma unroll
                for (int h_ = 0; h_ < 2; ++h_)
#pragma unroll
                    for (int i_ = 0; i_ < 2; ++i_) v2[h_][i_] = vAc[h_][i_]; }
            const char* b2 = last ? nB : cB + (size_t)(t + 2) * kstep; const char* b3 = b2 + kstep;
            if (last && has_next) S.a_ready(nxt);
            if constexpr (SP2) {
            PG8_LDB(B0, 0, 0); PG8_LDB(B1, 0, 1); PG8_SCHED; PG8_LDA(At, 0, 0); PG8_STAGE_A(PG8_SA(1, 1), vAc[1], k1);
            PG8_WAIT_V(8); PG8_WAIT_L(0); PG8_BAR; PG8_MMA(0, 0, At, B0); PG8_MMA(0, 1, At, B1); PG8_BAR; PG8_SCHED;
            PG8_LDA(At, 0, 1); PG8_STAGE(PG8_SB(0, 0), b2, voffB); PG8_STAGE(PG8_SB(0, 1), b2 + hstep, voffB); PG8_STAGE_A(PG8_SA(0, 0), v2[0], k2);
            PG8_WAIT_V(8); PG8_WAIT_L(0); PG8_BAR; PG8_MMA(1, 0, At, B0); PG8_MMA(1, 1, At, B1); PG8_BAR; PG8_SCHED;
            PG8_LDB(B0, 1, 0); PG8_LDB(B1, 1, 1); PG8_SCHED; PG8_LDA(At, 1, 0); PG8_STAGE_A(PG8_SA(0, 1), v2[1], k2);
            PG8_WAIT_V(8); PG8_WAIT_L(0); PG8_BAR; PG8_MMA(0, 0, At, B0); PG8_MMA(0, 1, At, B1); PG8_BAR; PG8_SCHED;
            PG8_LDA(At, 1, 1); PG8_STAGE(PG8_SB(1, 0), b3, voffB); PG8_STAGE(PG8_SB(1, 1), b3 + hstep, voffB); PG8_STAGE_A(PG8_SA(1, 0), v2[0], k3);
            PG8_WAIT_V(8); PG8_WAIT_L(0); PG8_BAR; PG8_MMA(1, 0, At, B0); PG8_MMA(1, 1, At, B1); PG8_BAR; PG8_SCHED;
            }
        }
        if constexpr (ALIGN_EPI) { if (wr == 0) PG8_BAR; }
        { const int l2 = lane_now(); E(acc, cur, wr, wc, l2 & 15, l2 >> 4, rowtab + ui * 256); } S.done(cur);
        if (!has_next) break;
#pragma unroll
        for (int a = 0; a < 2; ++a)
#pragma unroll
            for (int b = 0; b < 2; ++b)
#pragma unroll
                for (int m = 0; m < 4; ++m)
#pragma unroll
                    for (int n = 0; n < 2; ++n) acc[a][b][m][n] = (f32x4){0.f, 0.f, 0.f, 0.f};
        cur = nxt; cB = nB; ++ui;
        PG8_ROWS(vAc, ui);
        if constexpr (ALIGN_EPI) { if (wr == 1) PG8_BAR; }
    }
    PG8_WAIT_V(0);
    if constexpr (!ALIGN_EPI) { if (wr == 0) PG8_BAR; }
    PG8_BAR;
#undef PG8_ROWS
#undef PG8_STAGE_A
#undef PG8_SA
#undef PG8_SB
#undef PG8_STAGE
#undef PG8_LDA
#undef PG8_LDB
#undef PG8_MMA
#undef PG8_WAIT_V
#undef PG8_WAIT_L
#undef PG8_BAR
#undef PG8_SCHED
}
}
#define GAS __attribute__((address_space(1)))
#define LAS __attribute__((address_space(3)))
typedef unsigned short bf16;
typedef unsigned v4u __attribute__((ext_vector_type(4)));
typedef float f32x4 __attribute__((ext_vector_type(4)));
typedef short bf16x8 __attribute__((ext_vector_type(8)));
typedef GAS unsigned gu32;
typedef GAS unsigned long long gu64;
#define RLX_AGENT __ATOMIC_RELAXED, __HIP_MEMORY_SCOPE_AGENT
#define LDS_WAIT() asm volatile("s_waitcnt lgkmcnt(0)" ::: "memory")
#define VM_WAIT() asm volatile("s_waitcnt vmcnt(0)" ::: "memory")
__device__ __forceinline__ unsigned long long rt() { return __builtin_amdgcn_s_memrealtime(); }
__device__ __forceinline__ unsigned f2bf(float f) { unsigned u = __builtin_bit_cast(unsigned, f); return (u + 0x7fffu + ((u >> 16) & 1u)) >> 16; }
__device__ __forceinline__ unsigned pk2(float lo, float hi) { return f2bf(lo) | (f2bf(hi) << 16); }
#define XB_TMO      128
#define XB_XCNT(j)  (256  + 64 * (j))
#define XB_XSUB(j)  (1280 + 64 * (j))
#define XB_XGEN(j)  (2304 + 64 * (j))
#define XB_TOP      3328
#define XB_TOPGEN   3392
#define XCD_BAR_WORDS 3456
#define XB_SPIN_CAP (1u << 18)

__device__ __forceinline__ unsigned xb_ld(unsigned* p)              { return __hip_atomic_load(p, __ATOMIC_RELAXED, __HIP_MEMORY_SCOPE_AGENT); }
__device__ __forceinline__ unsigned xb_add(unsigned* p, unsigned v) { return __hip_atomic_fetch_add(p, v, __ATOMIC_RELAXED, __HIP_MEMORY_SCOPE_AGENT); }
__device__ __forceinline__ unsigned xb_xcc_id() { return (unsigned)__builtin_amdgcn_s_getreg((3 << 11) | 20) & 0xFu; }
#define XB_SPIN(cond, bar) do { unsigned _sp = 0; while (cond) { __builtin_amdgcn_s_sleep(1); \
    if ((++_sp & 255u) == 0u) { if (xb_ld(&(bar)[XB_TMO])) break; if (_sp > XB_SPIN_CAP) { atomicAdd(&(bar)[XB_TMO], 1u); break; } } } } while (0)

struct XcdBarrier {
    unsigned* bar; unsigned x;
    volatile LAS unsigned* st;
};

__device__ __forceinline__ XcdBarrier xcd_barrier_post(unsigned* bar, volatile LAS unsigned* st) {
    XcdBarrier b; b.bar = bar; b.x = xb_xcc_id(); b.st = st;
    if (threadIdx.x == 0) (void)xb_add(&bar[XB_XCNT(b.x)], 1u);
    return b;
}
__device__ __forceinline__ void xcd_barrier_complete(unsigned* bar, unsigned x, unsigned& nloc, unsigned& nx) {
    const unsigned G = gridDim.x * gridDim.y * gridDim.z;
    unsigned sum, cnt, mine, sp = 0u;
    for (;;) {
        sum = 0u; cnt = 0u; mine = 0u;
#pragma unroll
        for (unsigned j = 0; j < 16; ++j) { const unsigned c = xb_ld(&bar[XB_XCNT(j)]); sum += c; cnt += (c > 0u) ? 1u : 0u; mine = (j == x) ? c : mine; }
        if (sum == G) break;
        __builtin_amdgcn_s_sleep(1);
        if ((++sp & 255u) == 0u) { if (xb_ld(&bar[XB_TMO])) break; if (sp > XB_SPIN_CAP) { atomicAdd(&bar[XB_TMO], 1u); break; } }
    }
    nloc = mine > 0u ? mine : 1u; nx = cnt > 0u ? cnt : 1u;
}

__device__ __forceinline__ void xcd_barrier(const XcdBarrier& b) {
    asm volatile("s_waitcnt vmcnt(0)" ::: "memory");
    __syncthreads();
    if (threadIdx.x == 0) {
        unsigned* bar = b.bar;
        __builtin_amdgcn_s_waitcnt(0);
        unsigned nloc = b.st[0], nx = b.st[1];
        if (nloc == 0u) { xcd_barrier_complete(bar, b.x, nloc, nx); b.st[0] = nloc; b.st[1] = nx; }
        const unsigned old = xb_add(&bar[XB_XSUB(b.x)], 1u);
        const unsigned gen = old / nloc;
        if (old + 1u == (gen + 1u) * nloc) {
            __builtin_amdgcn_fence(__ATOMIC_RELEASE, "agent");
            asm volatile("s_waitcnt vmcnt(0)" ::: "memory");
            const unsigned og = xb_add(&bar[XB_TOP], 1u);
            const unsigned tg = og / nx;
            if (og + 1u == (tg + 1u) * nx) xb_add(&bar[XB_TOPGEN], 1u);
            else XB_SPIN(xb_ld(&bar[XB_TOPGEN]) == tg, bar);
            __builtin_amdgcn_fence(__ATOMIC_ACQUIRE, "agent");
            xb_add(&bar[XB_XGEN(b.x)], 1u);
            asm volatile("s_waitcnt vmcnt(0)" ::: "memory");
        } else {
            XB_SPIN(xb_ld(&bar[XB_XGEN(b.x)]) == gen, bar);
            __builtin_amdgcn_fence(__ATOMIC_ACQUIRE, "agent");
            asm volatile("s_waitcnt vmcnt(0)" ::: "memory");
        }
    }
    __syncthreads();
}
namespace fattn {
typedef unsigned short bf16;
typedef short bf16x8 __attribute__((ext_vector_type(8)));
typedef short s16x4 __attribute__((ext_vector_type(4)));
typedef float f32x16 __attribute__((ext_vector_type(16)));
typedef float f32x4 __attribute__((ext_vector_type(4)));
typedef unsigned u32x4 __attribute__((ext_vector_type(4)));
constexpr int D = 128, LD = 128, LDO = 1024, SEQ = 4096;
constexpr float THR = 8.f;
constexpr float SCALE = 0.08838834764831845f;
constexpr int NW = 8, QBLK = 32, KVBLK = 64, QB = NW * QBLK;
constexpr int SHM_V = KVBLK * D * 2, SHM_K = KVBLK * D * 2;
constexpr int OFF_WS = 2 * SHM_V + 2 * SHM_K, OFF_BIAS = OFF_WS + NW * 64 * 4, LDS_BYTES = OFF_BIAS + 2 * 64 * 4;

#define KSWZ(row, colB) ((row) * 256 + ((colB) ^ (((row) & 7) << 4)))
#define SBAR() __builtin_amdgcn_sched_barrier(0)
__device__ __forceinline__ int v_st(int k, int c) { const int kk = (k & ~0xC) | ((k & 4) << 1) | ((k & 8) >> 1); return ((kk >> 3) * 4 + (c >> 5)) * 512 + ((kk & 7) * 32 + (c & 31)) * 2; }
__device__ __forceinline__ int v_rd_base(int lane) { return ((lane & 3) << 3) | (((lane >> 2) & 3) << 6) | (((lane >> 4) & 1) << 5) | (((lane >> 5) & 1) << 8); }
constexpr int v_rd_off(int d0, int ks, int half) { return d0 * 512 + ks * 4096 + half * 2048; }
__device__ __forceinline__ int crow(int r, int hi) { return (r & 3) + 8 * (r >> 2) + 4 * hi; }
__device__ __forceinline__ unsigned cvtpk(float lo, float hi) { unsigned r; asm volatile("v_cvt_pk_bf16_f32 %0, %1, %2" : "=v"(r) : "v"(lo), "v"(hi)); return r; }
__device__ __forceinline__ bf16x8 load8(const bf16* p) { return *reinterpret_cast<const bf16x8*>(p); }
__device__ __forceinline__ void mask_tile(f32x16& p0, f32x16& p1, int dq) {
    const float NEG = -__builtin_inff();
#pragma unroll
    for (int r = 0; r < 16; ++r) {
        const int c = (r & 3) + 8 * (r >> 2);
        if (dq - c < 0) p0[r] = NEG;
        if (dq - c - 32 < 0) p1[r] = NEG;
    }
}
__device__ __forceinline__ void partialSM(f32x16& p0, f32x16& p1, float& m_reg, float& mn, float& alpha) {
    float pmax = p0[0]; for (int r = 1; r < 16; ++r) pmax = fmaxf(pmax, p0[r]); for (int r = 0; r < 16; ++r) pmax = fmaxf(pmax, p1[r]);
    { auto rr = __builtin_amdgcn_permlane32_swap(__float_as_uint(pmax), __float_as_uint(pmax), false, false);
      pmax = fmaxf(__uint_as_float(rr[0]), __uint_as_float(rr[1])); }
    constexpr float C2 = 1.4426950408889634f * SCALE;
    if (__builtin_expect(__all((pmax - m_reg) * SCALE <= THR), 1)) { mn = m_reg; alpha = 1.f; }
    else { mn = fmaxf(m_reg, pmax); alpha = __builtin_amdgcn_exp2f((m_reg - mn) * C2); m_reg = mn; }
    const float mnL = -mn * C2;
    for (int r = 0; r < 16; ++r) p0[r] = fmaf(p0[r], C2, mnL); for (int r = 0; r < 16; ++r) p1[r] = fmaf(p1[r], C2, mnL);
    for (int r = 0; r < 16; ++r) p0[r] = __builtin_amdgcn_exp2f(p0[r]);
}
__device__ __forceinline__ void finishSM(f32x16& p0, f32x16& p1, float alpha, float& l_reg, bf16x8& pa0, bf16x8& pa1, bf16x8& pa2, bf16x8& pa3) {
    for (int r = 0; r < 16; ++r) p1[r] = __builtin_amdgcn_exp2f(p1[r]);
    float ps = 0; for (int r = 0; r < 16; ++r) ps += p0[r]; for (int r = 0; r < 16; ++r) ps += p1[r];
    { auto rr = __builtin_amdgcn_permlane32_swap(__float_as_uint(ps), __float_as_uint(ps), false, false);
      ps = __uint_as_float(rr[0]) + __uint_as_float(rr[1]); }
    l_reg = l_reg * alpha + ps;
#define PK4(P, B_, OUT) do { unsigned a0 = cvtpk(P[B_+0], P[B_+1]), a1 = cvtpk(P[B_+2], P[B_+3]);                          \
        unsigned b0 = cvtpk(P[B_+4], P[B_+5]), b1 = cvtpk(P[B_+6], P[B_+7]);                                             \
        auto r0 = __builtin_amdgcn_permlane32_swap(a0, b0, false, false); auto r1 = __builtin_amdgcn_permlane32_swap(a1, b1, false, false); \
        u32x4 w = {r0[0], r1[0], r0[1], r1[1]}; OUT = *reinterpret_cast<bf16x8*>(&w); } while (0)
    PK4(p0, 0, pa0); PK4(p0, 8, pa1); PK4(p1, 0, pa2); PK4(p1, 8, pa3);
#undef PK4
}
template <int KB>
__device__ __forceinline__ void qkt(f32x16& p0, f32x16& p1, const char* K_lds, const char* Bias_lds, int r32, int hi, const bf16x8* qr) {
    { const f32x4* bb = reinterpret_cast<const f32x4*>(Bias_lds + KB * 256 + hi * 16);
      const f32x4 a0 = bb[0], a1 = bb[2], a2 = bb[4], a3 = bb[6], c0 = bb[8], c1 = bb[10], c2 = bb[12], c3 = bb[14];
      p0 = (f32x16){a0[0], a0[1], a0[2], a0[3], a1[0], a1[1], a1[2], a1[3], a2[0], a2[1], a2[2], a2[3], a3[0], a3[1], a3[2], a3[3]};
      p1 = (f32x16){c0[0], c0[1], c0[2], c0[3], c1[0], c1[1], c1[2], c1[3], c2[0], c2[1], c2[2], c2[3], c3[0], c3[1], c3[2], c3[3]}; }
    const char* kb[4];
#pragma unroll
    for (int dd = 0; dd < 4; ++dd) kb[dd] = K_lds + KB * SHM_K + KSWZ(r32, (dd * 16 + hi * 8) * 2);
#pragma unroll
    for (int d0 = 0; d0 < 8; ++d0) { const char* a = kb[d0 & 3] + (d0 >> 2) * 128;
        bf16x8 b0 = *reinterpret_cast<const bf16x8*>(a);
        bf16x8 b1 = *reinterpret_cast<const bf16x8*>(a + 32 * 256);
        p0 = __builtin_amdgcn_mfma_f32_32x32x16_bf16(b0, qr[d0], p0, 0, 0, 0);
        p1 = __builtin_amdgcn_mfma_f32_32x32x16_bf16(b1, qr[d0], p1, 0, 0, 0); }
}
template <int VB>
__device__ __forceinline__ void pv_tile(f32x16* o, int vb0, bf16x8 pa0, bf16x8 pa1, bf16x8 pa2, bf16x8 pa3) {
#define TRRD(dst, off) asm volatile("ds_read_b64_tr_b16 %0, %1 offset:%2" : "=&v"(dst) : "v"(vb0), "i"(off) : "memory")
#define PV_D0(d0) do { s16x4 l0, l1, l2, l3, h0, h1, h2, h3; constexpr int b_ = VB * SHM_V + v_rd_off(d0, 0, 0);   \
        TRRD(l0, b_); TRRD(h0, b_ + 2048); TRRD(l1, b_ + 4096); TRRD(h1, b_ + 6144); TRRD(l2, b_ + 8192); TRRD(h2, b_ + 10240); TRRD(l3, b_ + 12288); TRRD(h3, b_ + 14336); \
        asm volatile("s_waitcnt lgkmcnt(0)" ::: "memory"); SBAR();                                                    \
        o[d0] = __builtin_amdgcn_mfma_f32_32x32x16_bf16(pa0, (bf16x8){l0[0], l0[1], l0[2], l0[3], h0[0], h0[1], h0[2], h0[3]}, o[d0], 0, 0, 0);   \
        o[d0] = __builtin_amdgcn_mfma_f32_32x32x16_bf16(pa1, (bf16x8){l1[0], l1[1], l1[2], l1[3], h1[0], h1[1], h1[2], h1[3]}, o[d0], 0, 0, 0);   \
        o[d0] = __builtin_amdgcn_mfma_f32_32x32x16_bf16(pa2, (bf16x8){l2[0], l2[1], l2[2], l2[3], h2[0], h2[1], h2[2], h2[3]}, o[d0], 0, 0, 0);   \
        o[d0] = __builtin_amdgcn_mfma_f32_32x32x16_bf16(pa3, (bf16x8){l3[0], l3[1], l3[2], l3[3], h3[0], h3[1], h3[2], h3[3]}, o[d0], 0, 0, 0); } while (0)
    PV_D0(0); PV_D0(1); PV_D0(2); PV_D0(3);
#undef PV_D0
#undef TRRD
}

struct Bases { const bf16* Q; bf16* O; const bf16* K; const bf16* V; const float* CB; };
struct BlockRef { unsigned qo, oo, kvo, cbo; int P0, jlo; };
struct Seam { bf16x8 qr[8]; };
#define VMW() asm volatile("s_waitcnt vmcnt(0)" ::: "memory")
#define VMWN(n) asm volatile("s_waitcnt vmcnt(%0)" :: "i"(n) : "memory")
#define LBAR() do { asm volatile("s_waitcnt lgkmcnt(0)" ::: "memory"); __builtin_amdgcn_s_barrier(); asm volatile("" ::: "memory"); } while (0)
#define ATT_SRC() \
    unsigned ksrc0, ksrc1, vsrc0, vsrc1; \
    { const int rw0 = 8 * wid + (lane >> 4), rw1 = rw0 + 4, p_ = lane & 15; ksrc0 = (unsigned)(rw0 * 256 + ((p_ ^ (rw0 & 7)) << 4)); ksrc1 = (unsigned)(rw1 * 256 + ((p_ ^ (rw1 & 7)) << 4)); \
      const int L0 = 128 * wid + lane, L1 = L0 + 64; \
      const int kk0 = ((L0 >> 7) << 3) | ((L0 >> 2) & 7), kk1 = ((L1 >> 7) << 3) | ((L1 >> 2) & 7); \
      const int k0_ = (kk0 & ~0xC) | ((kk0 & 4) << 1) | ((kk0 & 8) >> 1), k1_ = (kk1 & ~0xC) | ((kk1 & 4) << 1) | ((kk1 & 8) >> 1); \
      vsrc0 = (unsigned)(k0_ * 256 + ((((L0 >> 5) & 3) * 4 + (L0 & 3)) << 4)); vsrc1 = (unsigned)(k1_ * 256 + ((((L1 >> 5) & 3) * 4 + (L1 & 3)) << 4)); }
#define DMA_K(Kp, CBp, k0, bf) do { const char* kp_ = (const char*)(Kp) + (unsigned)(k0) * 256u; \
        __builtin_amdgcn_global_load_lds((const unsigned*)(kp_ + ksrc0), (LAS unsigned*)(ldsa + 2 * SHM_V + (bf) * SHM_K + (2 * wid) * 1024), 16, 0, 0); \
        __builtin_amdgcn_global_load_lds((const unsigned*)(kp_ + ksrc1), (LAS unsigned*)(ldsa + 2 * SHM_V + (bf) * SHM_K + (2 * wid + 1) * 1024), 16, 0, 0); \
        if (wid == 0) __builtin_amdgcn_global_load_lds((const unsigned*)((CBp) + (unsigned)((k0) + lane)), (LAS unsigned*)(ldsa + OFF_BIAS + (bf) * 256), 4, 0, 0); } while (0)
#define DMA_V(Vp, k0, bf) do { const char* vp_ = (const char*)(Vp) + (unsigned)(k0) * 256u; \
        __builtin_amdgcn_global_load_lds((const unsigned*)(vp_ + vsrc0), (LAS unsigned*)(ldsa + (bf) * SHM_V + (2 * wid) * 1024), 16, 0, 0); \
        __builtin_amdgcn_global_load_lds((const unsigned*)(vp_ + vsrc1), (LAS unsigned*)(ldsa + (bf) * SHM_V + (2 * wid + 1) * 1024), 16, 0, 0); } while (0)
__device__ __forceinline__ void prime(const Bases& G, const BlockRef& cur, char* lds, LAS unsigned char* ldsa, Seam& S) {
    const int tid = threadIdx.x, wid = __builtin_amdgcn_readfirstlane(tid >> 6), lane = tid & 63, r32 = lane & 31, hi = lane >> 5;
    ATT_SRC();
    for (int d0 = 0; d0 < 8; ++d0) S.qr[d0] = load8(G.Q + (cur.qo + (unsigned)((wid * QBLK + r32) * LD + d0 * 16 + hi * 8)));
    DMA_K(G.K + cur.kvo, G.CB + cur.cbo, cur.jlo * KVBLK, 0); DMA_V(G.V + cur.kvo, cur.jlo * KVBLK, 0);
    VMW(); LBAR();
}
__device__ __forceinline__ void block(const Bases& G, const BlockRef& cur, const BlockRef& nxt, char* lds, LAS unsigned char* ldsa, Seam& S) {
    const int tid = threadIdx.x, wid = __builtin_amdgcn_readfirstlane(tid >> 6), lane = tid & 63, r32 = lane & 31, hi = lane >> 5;
    const int j_lo = cur.jlo, NT = (cur.P0 + QB - 1) / KVBLK + 1 - j_lo;
    const int qlo = cur.P0 + wid * QBLK, qm = qlo + r32 - 4 * hi;
    char* V_lds = lds; char* K_lds = lds + 2 * SHM_V; char* B_lds = lds + OFF_BIAS;
    float* ws = (float*)(lds + OFF_WS) + wid * 64; float* li_l = ws, * al_l = ws + 32;
    float m_reg = G.CB[cur.cbo + (unsigned)(cur.P0 + wid * QBLK + r32)], l_reg = 0; f32x16 o[4] = {};
    const int vb0 = (int)(uintptr_t)V_lds + v_rd_base(lane);
    const bf16* Kh = G.K + cur.kvo; const bf16* Vh = G.V + cur.kvo; const float* CBh = G.CB + cur.cbo;
    ATT_SRC();
#define RESC(a) do { if (__any((a) < 1.f)) { if (hi == 0) al_l[r32] = (a); asm volatile("s_waitcnt lgkmcnt(0)" ::: "memory");              \
                     for (int d_ = 0; d_ < 4; ++d_) for (int r = 0; r < 16; ++r) o[d_][r] *= al_l[crow(r, hi)]; } } while (0)
#define KBASE(t) ((j_lo + (t)) * KVBLK)
#define MASKT(P0_, P1_, t) do { const int kb_ = KBASE(t); if (kb_ + KVBLK - 1 > qlo) mask_tile(P0_, P1_, qm - kb_); } while (0)
    f32x16 pA0, pA1, pB0, pB1; float mnA, mnB, alA, alB; bf16x8 pa0, pa1, pa2, pa3;
    DMA_K(Kh, CBh, KBASE(1), 1); DMA_V(Vh, KBASE(1), 1);
    SBAR(); qkt<0>(pA0, pA1, K_lds, B_lds, r32, hi, S.qr);
    MASKT(pA0, pA1, 0); partialSM(pA0, pA1, m_reg, mnA, alA);
    VMW(); LBAR();
#define HALF_STEP(PX0, PX1, mnX, alX, PY0, PY1, alY, t, KB, VB, SB) do {                                                      \
        SBAR(); if ((t) + 1 < NT) { DMA_K(Kh, CBh, KBASE((t) + 1), SB); SBAR(); }                                            \
        qkt<KB>(PX0, PX1, K_lds, B_lds, r32, hi, S.qr);                                                                        \
        finishSM(PY0, PY1, alY, l_reg, pa0, pa1, pa2, pa3); SBAR();                                                           \
        pv_tile<VB>(o, vb0, pa0, pa1, pa2, pa3); MASKT(PX0, PX1, (t)); partialSM(PX0, PX1, m_reg, mnX, alX);                   \
        LBAR();                                                                                                               \
        if ((t) + 1 < NT) { DMA_V(Vh, KBASE((t) + 1), SB); }                                                                  \
        RESC(alX); VMWN(2); LBAR(); } while (0)
    for (int t = 1; t + 1 < NT; t += 2) {
        HALF_STEP(pB0, pB1, mnB, alB, pA0, pA1, alA, t, 1, 0, 0);
        HALF_STEP(pA0, pA1, mnA, alA, pB0, pB1, alB, t + 1, 0, 1, 1);
    }
    SBAR(); qkt<1>(pB0, pB1, K_lds, B_lds, r32, hi, S.qr); SBAR();
    DMA_K(G.K + nxt.kvo, G.CB + nxt.cbo, nxt.jlo * KVBLK, 0); SBAR();
#pragma unroll
    for (int d0 = 0; d0 < 8; ++d0) S.qr[d0] = load8(G.Q + (nxt.qo + (unsigned)((wid * QBLK + r32) * LD + d0 * 16 + hi * 8)));
    SBAR();
    finishSM(pA0, pA1, alA, l_reg, pa0, pa1, pa2, pa3); SBAR();
    pv_tile<0>(o, vb0, pa0, pa1, pa2, pa3);
    MASKT(pB0, pB1, NT - 1); partialSM(pB0, pB1, m_reg, mnB, alB);
    VMWN(10); LBAR();
    DMA_V(G.V + nxt.kvo, nxt.jlo * KVBLK, 0);
    RESC(alB);
    finishSM(pB0, pB1, alB, l_reg, pa0, pa1, pa2, pa3); SBAR(); pv_tile<1>(o, vb0, pa0, pa1, pa2, pa3);
    SBAR();
    if (hi == 0) li_l[r32] = l_reg; asm volatile("s_waitcnt lgkmcnt(0)" ::: "memory");
    float rli[16];
#pragma unroll
    for (int r = 0; r < 16; ++r) rli[r] = __builtin_amdgcn_rcpf(li_l[crow(r, hi)]);
    bf16* Ow = G.O + (cur.oo + (unsigned)(wid * QBLK * LDO));
#pragma unroll
    for (int r = 0; r < 16; ++r) { const int orow = crow(r, hi);
#pragma unroll
        for (int d0 = 0; d0 < 4; ++d0) { const float v = o[d0][r] * rli[r];
            const float vn = __shfl_xor(v, 1);
            if ((r32 & 1) == 0) *(unsigned*)(Ow + (unsigned)(orow * LDO + d0 * 32 + r32)) = cvtpk(v, vn); } }
    VMW(); LBAR();
#undef RESC
#undef KBASE
#undef MASKT
#undef HALF_STEP
}
#undef VMW
#undef VMWN
#undef LBAR
#undef ATT_SRC
#undef DMA_K
#undef DMA_V
#undef KSWZ
#undef SBAR
}
constexpr int NB = 8, SEQ = 4096, T = NB * SEQ, DM = 1024, NH = 8, HD = 128, INW = 7176, NZ = 7168;
constexpr int NE = 32, DE = 512;
constexpr float EPS = 1e-6f;
constexpr int PMAX = 73728;
constexpr int NWAVES = 8;
constexpr size_t MiB = 1u << 20;
constexpr size_t WS_CTL = 0, CTL_ZERO_BYTES = 64 * 1024;
constexpr size_t WS_RS1 = 1 * MiB, WS_RS2 = 1 * MiB + 256 * 1024;
constexpr size_t WS_LF = 1 * MiB + 512 * 1024;
constexpr size_t WS_CB = 2 * MiB + 512 * 1024;
constexpr size_t WS_TOK = 3 * MiB + 512 * 1024;
constexpr size_t WS_LISTS = 5 * MiB;
constexpr size_t WS_WRT = 9 * MiB;
constexpr size_t WS_SRS = 9 * MiB + 512 * 1024, WS_SW = 10 * MiB;
constexpr size_t WS_WIN = 16 * MiB;
constexpr size_t WS_WA = 30 * MiB, WS_WL = 32 * MiB, WS_WO = 34 * MiB;
constexpr size_t WS_WRG = 36 * MiB;
constexpr size_t WS_XB = 40 * MiB;
constexpr size_t WS_XR = 104 * MiB;
constexpr size_t WS_GG = 168 * MiB;
constexpr size_t WS_Q = 232 * MiB, WS_K = 296 * MiB, WS_V = 360 * MiB;
constexpr size_t WS_W13 = 424 * MiB;
constexpr size_t WS_W2 = 392 * MiB;
constexpr size_t WS_XG = 168 * MiB;
constexpr size_t WS_HB = 296 * MiB;
constexpr size_t WS_END = 512 * MiB;
static_assert(WS_XG + (size_t)PMAX * 1024 <= WS_K && WS_HB + (size_t)PMAX * 1024 <= WS_W2 && WS_W2 + 32u * 1024 * 512 * 2 <= WS_W13 && WS_W13 + 64 * MiB <= WS_END, "d_ws map");
constexpr int CW_TMO = 0, CW_CODE = 1, CW_BAR = 4096, CW_CNT = 8192, CW_NORM = 8448, CW_QCTR = 12288;
constexpr int RING_OFF = 0, RING_BYTES = 131072;
constexpr int LDSCTL_OFF = RING_BYTES, MISC_OFF = LDSCTL_OFF + 320;
constexpr int TBL_OFF = RING_BYTES + 1024;
constexpr int TBL_PS = TBL_OFF, TBL_CN = TBL_OFF + 256, TBL_TE = TBL_OFF + 512;
constexpr int RG_TOT = RING_BYTES + 4096, RG_CAR = RG_TOT + 4096;
constexpr int LDS_BYTES = 147456;

#include <cmath>
using pg8::bf_lo; using pg8::bf_hi; using pg8::sigmoid_f;

struct Frame {
    LAS unsigned char* lds;
    int tid, lane, wave, vcu, G;
};
__device__ __forceinline__ float wave_sum(float v) {
#pragma unroll
    for (int o = 1; o < 64; o <<= 1) v += __shfl_xor(v, o);
    return v;
}
__device__ __forceinline__ void transpose_tile(const float* src, int ld, bf16* dst, int ldd, const float* kscale, LAS float* scr, int lane) {
    const int q = lane & 7, kr = lane >> 3;
    f32x4 v[8];
#pragma unroll
    for (int i = 0; i < 8; ++i) v[i] = __builtin_nontemporal_load((const f32x4*)(src + (size_t)(kr + 8 * i) * ld + 4 * q));
#pragma unroll
    for (int i = 0; i < 8; ++i) { const int kk = kr + 8 * i; const float sc = kscale ? kscale[kk] : 1.0f;
#pragma unroll
        for (int c = 0; c < 4; ++c) scr[kk * 33 + 4 * q + c] = v[i][c] * sc; }
    LDS_WAIT(); asm volatile("" ::: "memory");
    const int c = lane & 7;
#pragma unroll
    for (int j = 0; j < 4; ++j) { const int n = (lane >> 3) + 8 * j; const LAS float* s = scr + (8 * c) * 33 + n;
        v4u o; o.x = pk2(s[0 * 33], s[1 * 33]); o.y = pk2(s[2 * 33], s[3 * 33]); o.z = pk2(s[4 * 33], s[5 * 33]); o.w = pk2(s[6 * 33], s[7 * 33]);
        *(GAS v4u*)(dst + (size_t)n * ldd + 8 * c) = o; }
    LDS_WAIT(); asm volatile("" ::: "memory");
}

__device__ __forceinline__ void transpose_tile8(const float* src, int ld, unsigned char* dst, int ldd, const float* kscale, float scale, LAS float* scr, int lane) {
    const int q = lane & 7, kr = lane >> 3;
    f32x4 v[8];
#pragma unroll
    for (int i = 0; i < 8; ++i) v[i] = __builtin_nontemporal_load((const f32x4*)(src + (size_t)(kr + 8 * i) * ld + 4 * q));
#pragma unroll
    for (int i = 0; i < 8; ++i) { const int kk = kr + 8 * i; const float sc = kscale ? kscale[kk] * scale : scale;
#pragma unroll
        for (int c = 0; c < 4; ++c) scr[kk * 33 + 4 * q + c] = v[i][c] * sc; }
    LDS_WAIT(); asm volatile("" ::: "memory");
    const int c = lane & 3;
#pragma unroll
    for (int j = 0; j < 2; ++j) { const int n = (lane >> 2) + 16 * j; const LAS float* s = scr + (16 * c) * 33 + n;
        v4u o; o.x = pg8::pack4_fp8(s[0 * 33], s[1 * 33], s[2 * 33], s[3 * 33]); o.y = pg8::pack4_fp8(s[4 * 33], s[5 * 33], s[6 * 33], s[7 * 33]);
        o.z = pg8::pack4_fp8(s[8 * 33], s[9 * 33], s[10 * 33], s[11 * 33]); o.w = pg8::pack4_fp8(s[12 * 33], s[13 * 33], s[14 * 33], s[15 * 33]);
        *(GAS v4u*)(dst + (size_t)n * ldd + 16 * c) = o; }
    LDS_WAIT(); asm volatile("" ::: "memory");
}

struct P0Args { const float *x, *g_mix, *w_in, *w_rg_a, *w_rg_x, *b_forget, *w_lru_out, *w_attn_out, *w_out, *g_ffn, *w_rgrp, *w_rexp, *w_gate, *w_up;
                bf16 *Win, *Wl, *Wa, *Wo, *Wrg, *XB; unsigned char* W13; float *RS1, *LF, *WRT; };
struct TItem { const float* src; int ld; unsigned char* dst; int ldd; const float* ks; float scale; int f8; };
__device__ __forceinline__ void titem_load(const TItem& t, f32x4 (&v)[8], float (&sc)[8], int lane) {
    const int q = lane & 7, kr = lane >> 3;
#pragma unroll
    for (int i = 0; i < 8; ++i) { v[i] = __builtin_nontemporal_load((const f32x4*)(t.src + (size_t)(kr + 8 * i) * t.ld + 4 * q)); sc[i] = t.ks ? t.ks[kr + 8 * i] * t.scale : t.scale; }
}
__device__ __forceinline__ void titem_finish(const TItem& t, const f32x4 (&v)[8], const float (&sc)[8], LAS float* scr, int lane) {
    const int q = lane & 7, kr = lane >> 3;
#pragma unroll
    for (int i = 0; i < 8; ++i) { const int kk = kr + 8 * i;
#pragma unroll
        for (int c = 0; c < 4; ++c) scr[kk * 33 + 4 * q + c] = v[i][c] * sc[i]; }
    LDS_WAIT(); asm volatile("" ::: "memory");
    if (t.f8) { const int c = lane & 3;
#pragma unroll
        for (int j = 0; j < 2; ++j) { const int n = (lane >> 2) + 16 * j; const LAS float* s = scr + (16 * c) * 33 + n;
            v4u o; o.x = pg8::pack4_fp8(s[0 * 33], s[1 * 33], s[2 * 33], s[3 * 33]); o.y = pg8::pack4_fp8(s[4 * 33], s[5 * 33], s[6 * 33], s[7 * 33]);
            o.z = pg8::pack4_fp8(s[8 * 33], s[9 * 33], s[10 * 33], s[11 * 33]); o.w = pg8::pack4_fp8(s[12 * 33], s[13 * 33], s[14 * 33], s[15 * 33]);
            *(GAS v4u*)(t.dst + (size_t)n * t.ldd + 16 * c) = o; } }
    else { const int c = lane & 7;
#pragma unroll
        for (int j = 0; j < 4; ++j) { const int n = (lane >> 3) + 8 * j; const LAS float* s = scr + (8 * c) * 33 + n;
            v4u o; o.x = pk2(s[0 * 33], s[1 * 33]); o.y = pk2(s[2 * 33], s[3 * 33]); o.z = pk2(s[4 * 33], s[5 * 33]); o.w = pk2(s[6 * 33], s[7 * 33]);
            *(GAS v4u*)(t.dst + ((size_t)n * t.ldd + 8 * c) * 2) = o; } }
    LDS_WAIT(); asm volatile("" ::: "memory");
}
constexpr int P0_I_IN = 16 * 224, P0_I_SQ = 16 * 32, P0_I_RG = 2 * 4 * 4 * 8, P0_I_EX = 2 * 8192, P0_NITEMS = P0_I_IN + 3 * P0_I_SQ + P0_I_RG + P0_I_EX;
__device__ __forceinline__ void p0_items(const Frame& F, const P0Args& a, const int first, const int last, const int stride, const int offset) {
    LAS float* scr = (LAS float*)(F.lds + RING_OFF + F.wave * 16384);
    const float* const p_wl = a.w_lru_out; const float* const p_wa = a.w_attn_out; const float* const p_wo = a.w_out; const float* const p_rga = a.w_rg_a; const float* const p_rgx = a.w_rg_x;
    bf16* const q_wl = a.Wl; bf16* const q_wa = a.Wa; bf16* const q_wo = a.Wo;
    constexpr int I_IN = P0_I_IN, I_SQ = P0_I_SQ, I_EX = P0_I_EX, NITEMS = P0_NITEMS;
    const float* const p_gate = a.w_gate; const float* const p_up = a.w_up; const float* const p_win = a.w_in; const float* const p_gmix = a.g_mix; const float* const p_gffn = a.g_ffn;
    bf16* const q_win = a.Win; bf16* const q_wrg = a.Wrg; unsigned char* const q_w13 = a.W13;
#define P0_DECODE(it_, t_) do { int r = (it_); \
        if (r >= NITEMS - I_EX) { r -= NITEMS - I_EX;     \
            const int w = r >> 13, e = (r >> 8) & 31, kb = (r >> 4) & 15, nb = r & 15; const float* W = (w == 0 ? p_gate : p_up) + (size_t)e * DM * DE; \
            const int drow = e * 1024 + (nb >> 2) * 256 + (nb & 3) * 32 + (w == 1 ? 128 : 0); \
            t_.src = W + (size_t)(64 * kb) * DE + 32 * nb; t_.ld = DE; t_.dst = q_w13 + (size_t)drow * DM + 64 * kb; t_.ldd = DM; t_.ks = p_gffn + 64 * kb; t_.scale = pg8::W13_SCALE; t_.f8 = 1; } \
        else if (r < I_IN) { const int kb = r / 224, nb = r % 224, n0 = 32 * nb, sc_ = n0 < 5120 ? n0 : n0 + 8; \
            t_.src = p_win + (size_t)(64 * kb) * INW + sc_; t_.ld = INW; t_.dst = (unsigned char*)(q_win + (size_t)n0 * DM + 64 * kb); t_.ldd = DM; t_.ks = p_gmix + 64 * kb; t_.scale = 1.0f; t_.f8 = 0; } \
        else if (r < I_IN + 3 * I_SQ) { r -= I_IN; const int w = r / I_SQ, q = r % I_SQ, kb = q / 32, nb = q % 32; const float* W = w == 0 ? p_wl : (w == 1 ? p_wa : p_wo); bf16* Wt = w == 0 ? q_wl : (w == 1 ? q_wa : q_wo); \
            t_.src = W + (size_t)(64 * kb) * DM + 32 * nb; t_.ld = DM; t_.dst = (unsigned char*)(Wt + (size_t)(32 * nb) * DM + 64 * kb); t_.ldd = DM; t_.ks = nullptr; t_.scale = 1.0f; t_.f8 = 0; } \
        else { r -= I_IN + 3 * I_SQ; const int gb = r / 32, q = r % 32, kb = q / 8, nb = q % 8; const float* W = (gb < 4 ? p_rga : p_rgx) + (size_t)(gb & 3) * 65536; \
            t_.src = W + (size_t)(64 * kb) * 256 + 32 * nb; t_.ld = 256; t_.dst = (unsigned char*)(q_wrg + (size_t)gb * 65536 + (size_t)(32 * nb) * 256 + 64 * kb); t_.ldd = 256; t_.ks = nullptr; t_.scale = -1.4426950408889634f; t_.f8 = 0; }     } while (0)
    {
        int it = first + offset; TItem cur; f32x4 va[8]; float sa[8];
        if (it < last) { P0_DECODE(it, cur); titem_load(cur, va, sa, F.lane); }
        while (it < last) {
            const int nx = it + stride; TItem nt = cur; f32x4 vb[8]; float sb[8];
            if (nx < last) { P0_DECODE(nx, nt); titem_load(nt, vb, sb, F.lane); }
            titem_finish(cur, va, sa, scr, F.lane);
            if (nx < last) { cur = nt;
#pragma unroll
                for (int i = 0; i < 8; ++i) { va[i] = vb[i]; sa[i] = sb[i]; } }
            it = nx;
        }
    }
#undef P0_DECODE
}
__device__ __forceinline__ void p0_prologue(const Frame& F, const P0Args& a, const int part  ) {
    const int gw = F.vcu * NWAVES + F.wave, NGW = F.G * NWAVES;
    if (part != 2) p0_items(F, a, 0, P0_NITEMS, NGW, gw);
    if (part == 1) return;
    for (int i = (F.vcu * NWAVES + F.wave) * 64 + F.lane; i < 64 * DM; i += NGW * 64) { const int n = i >> 10, k = i & 1023;
        float v = 0.f; if (n < 32) v = a.w_rexp[k * 32 + n]; else if (n < 36) v = a.w_rgrp[k * 4 + (n - 32)];
        a.WRT[i] = v * a.g_ffn[k]; }
    LAS float* wfl = (LAS float*)(F.lds + RING_OFF);
    __syncthreads();
    for (int k = F.tid; k < DM; k += NWAVES * 64) { const float g = a.g_mix[k];
        const f32x4 w0 = *(const f32x4*)(a.w_in + (size_t)k * INW + 5120), w1 = *(const f32x4*)(a.w_in + (size_t)k * INW + 5124);
        *(LAS f32x4*)(wfl + k * 8) = w0 * g; *(LAS f32x4*)(wfl + k * 8 + 4) = w1 * g; }
    __syncthreads();
    float wf[4][4][8];
#pragma unroll
    for (int j = 0; j < 4; ++j)
#pragma unroll
        for (int i = 0; i < 4; ++i) { const int k = 256 * j + 4 * F.lane + i; const f32x4 w0 = *(const LAS f32x4*)(wfl + k * 8), w1 = *(const LAS f32x4*)(wfl + k * 8 + 4);
#pragma unroll
            for (int h = 0; h < 4; ++h) { wf[j][i][h] = w0[h]; wf[j][i][4 + h] = w1[h]; } }
    const float bfg = a.b_forget[F.lane & 7];
    f32x4 vn[4];
    if (gw < T) { const GAS f32x4* xr0 = (const GAS f32x4*)(a.x + (size_t)gw * DM) + F.lane;
#pragma unroll
        for (int j = 0; j < 4; ++j) vn[j] = __builtin_nontemporal_load((const f32x4*)xr0 + 64 * j); }
    for (int m = gw; m < T; m += NGW) {
        f32x4 v[4]; float s = 0.f, d[8] = {0.f, 0.f, 0.f, 0.f, 0.f, 0.f, 0.f, 0.f};
#pragma unroll
        for (int j = 0; j < 4; ++j) v[j] = vn[j];
        if (m + NGW < T) { const GAS f32x4* xr1 = (const GAS f32x4*)(a.x + (size_t)(m + NGW) * DM) + F.lane;
#pragma unroll
            for (int j = 0; j < 4; ++j) vn[j] = __builtin_nontemporal_load((const f32x4*)xr1 + 64 * j); }
#pragma unroll
        for (int j = 0; j < 4; ++j) { s += (v[j].x * v[j].x + v[j].y * v[j].y) + (v[j].z * v[j].z + v[j].w * v[j].w);
#pragma unroll
            for (int i = 0; i < 4; ++i)
#pragma unroll
                for (int h = 0; h < 8; ++h) d[h] = fmaf(v[j][i], wf[j][i][h], d[h]); }
        s = wave_sum(s);
#pragma unroll
        for (int h = 0; h < 8; ++h) d[h] = wave_sum(d[h]);
        const float rs = 1.0f / sqrtf(s * (1.0f / DM) + EPS);
        GAS unsigned long long* o8 = (GAS unsigned long long*)(a.XB + (size_t)m * DM) + F.lane;
#pragma unroll
        for (int j = 0; j < 4; ++j) o8[64 * j] = (unsigned long long)pk2(v[j].x * rs, v[j].y * rs) | ((unsigned long long)pk2(v[j].z * rs, v[j].w * rs) << 32);
        if (F.lane < 8) { const int h = F.lane; float dh = d[0]; dh = h == 1 ? d[1] : dh; dh = h == 2 ? d[2] : dh; dh = h == 3 ? d[3] : dh; dh = h == 4 ? d[4] : dh; dh = h == 5 ? d[5] : dh; dh = h == 6 ? d[6] : dh; dh = h == 7 ? d[7] : dh;
            const float fl = dh * rs + bfg; a.LF[(size_t)m * 8 + h] = fminf(fl, 0.f) - log1pf(expf(-fabsf(fl))); }
    }
}
__device__ __forceinline__ void cumsum_bias(const Frame& F, const float* LF, float* CB) {
    LAS float* wt = (LAS float*)(F.lds + RING_OFF);
    for (int bh = blockIdx.x; bh < NB * NH; bh += F.G) {
        const int b = bh >> 3, h = bh & 7, s0 = F.tid * 8;
        float v[8], run = 0.f;
#pragma unroll
        for (int j = 0; j < 8; ++j) { run += LF[((size_t)(b * SEQ + s0 + j)) * 8 + h]; v[j] = run; }
        float inc = run;
#pragma unroll
        for (int o = 1; o < 64; o <<= 1) { const float t = __shfl_up(inc, o); if (F.lane >= o) inc += t; }
        if (F.lane == 63) wt[F.wave] = inc;
        __syncthreads();
        float pre = inc - run;
        for (int w = 0; w < F.wave; ++w) pre += wt[w];
#pragma unroll
        for (int j = 0; j < 8; ++j) CB[(size_t)bh * SEQ + s0 + j] = -(pre + v[j]) * 11.313708498984761f;
        __syncthreads();
    }
}
struct RgArgs { const bf16* XC; const bf16* GG; bf16* GO; const bf16* Wrg; const float *b_a, *b_x, *lam; };
__device__ __forceinline__ float bfx(const v4u& v, int i) { const unsigned w = i < 2 ? v.x : (i < 4 ? v.y : (i < 6 ? v.z : v.w)); return (i & 1) ? bf_hi(w) : bf_lo(w); }
__device__ __forceinline__ unsigned cvtpk_bf16(float lo, float hi) { unsigned r; asm volatile("v_cvt_pk_bf16_f32 %0, %1, %2" : "=v"(r) : "v"(lo), "v"(hi)); return r; }
__device__ __forceinline__ void conv_prepass(const Frame& F, const bf16* XR, bf16* XC, const float* conv_w, const float* conv_b) {
    const int gw = F.vcu * NWAVES + F.wave, NGW = F.G * NWAVES;
    for (int it = gw; it < (T / 16) * 2; it += NGW) {
        const int r0 = (it >> 1) * 16, c0 = (it & 1) * 512 + 8 * F.lane, tq = r0 & (SEQ - 1);
        float cw[4][8], cbv[8];
#pragma unroll
        for (int j = 0; j < 4; ++j) { const f32x4 w0 = *(const f32x4*)(conv_w + j * DM + c0), w1 = *(const f32x4*)(conv_w + j * DM + c0 + 4);
#pragma unroll
            for (int i = 0; i < 4; ++i) { cw[j][i] = w0[i]; cw[j][4 + i] = w1[i]; } }
        { const f32x4 w0 = *(const f32x4*)(conv_b + c0), w1 = *(const f32x4*)(conv_b + c0 + 4);
#pragma unroll
          for (int i = 0; i < 4; ++i) { cbv[i] = w0[i]; cbv[4 + i] = w1[i]; } }
        v4u raw[19];
#pragma unroll
        for (int i = 0; i < 19; ++i) { const int rr = (i < 3 && tq == 0) ? r0 : r0 - 3 + i; const v4u w = __builtin_nontemporal_load((const v4u*)(XR + ((unsigned)rr * DM + c0)));
            const bool z = i < 3 && tq == 0; raw[i].x = z ? 0u : w.x; raw[i].y = z ? 0u : w.y; raw[i].z = z ? 0u : w.z; raw[i].w = z ? 0u : w.w; }
#pragma unroll
        for (int r = 0; r < 16; ++r) { float y[8];
#pragma unroll
            for (int i = 0; i < 8; ++i) { float sacc = cbv[i];
#pragma unroll
                for (int j = 0; j < 4; ++j) sacc = fmaf(cw[j][i], bfx(raw[r + j], i), sacc);
                y[i] = sacc; }
            v4u o; o.x = cvtpk_bf16(y[0], y[1]); o.y = cvtpk_bf16(y[2], y[3]); o.z = cvtpk_bf16(y[4], y[5]); o.w = cvtpk_bf16(y[6], y[7]);
            *(GAS v4u*)(XC + ((unsigned)(r0 + r) * DM + c0)) = o; }
    }
}
__device__ __forceinline__ void rglru_unit(const Frame& F, const RgArgs& a, int unit) {
    const int tid = F.tid, lane = F.lane, wid = F.wave, fr = lane & 15, fq = lane >> 4, rq = wid >> 1, cp = wid & 1;
    const int b = unit >> 5, n = (unit >> 3) & 3, g = unit & 7, cbase = 256 * n, cown = cbase + 32 * g;
    LAS unsigned char* A_l = F.lds + RING_OFF;
    LAS float* tot = (LAS float*)(F.lds + RG_TOT);
    bf16x8 bfr[2][8];
#pragma unroll
    for (int gt = 0; gt < 2; ++gt)
#pragma unroll
        for (int ks = 0; ks < 8; ++ks) bfr[gt][ks] = *(const GAS bf16x8*)(a.Wrg + ((size_t)((gt * 4 + n) * 256 + 32 * g + 16 * cp + fr)) * 256 + 32 * ks + 8 * fq);
    const int cl = 16 * cp + fr, cch = cown + cl;
    const float ba = -1.4426950408889634f * a.b_a[cch], bx = -1.4426950408889634f * a.b_x[cch], sp8 = 8.0f * log1pf(expf(-a.lam[cch])) * 1.4426950408889634f;
    const unsigned goff = (unsigned)(b * SEQ + 32 * rq + 4 * fq) * DM + cch;
    const __amdgpu_buffer_rsrc_t GGr = __builtin_amdgcn_make_buffer_rsrc((void*)a.GG, 0, (int)((size_t)T * DM * 2), 0x00020000);
    const __amdgpu_buffer_rsrc_t GOr = __builtin_amdgcn_make_buffer_rsrc((void*)a.GO, 0, (int)((size_t)T * DM * 2), 0x00020000);
    const int gvo = (int)(goff * 2u);
    const unsigned dbase = ((unsigned)(b * SEQ + 16 * wid + (lane >> 5)) * DM + cbase) * 2u;
    const char* const XCb = (const char*)a.XC;
#define RG_DMA(ci_, buf_) do { _Pragma("unroll") for (int i_ = 0; i_ < 8; ++i_) { const unsigned so_ = dbase + (unsigned)(2 * i_) * (DM * 2u) + ((((unsigned)lane & 31u) ^ (unsigned)((2 * i_ + (lane >> 5)) & 15)) << 4); \
        __builtin_amdgcn_global_load_lds((const unsigned*)(XCb + so_ + (unsigned)(ci_) * (128u * DM * 2u)), (LAS unsigned*)(A_l + (buf_) * 65536 + (8 * wid + i_) * 1024), 16, 0, 0); } } while (0)
    float hc = 0.f;
    const int kx = 32 * g + cl;
#pragma unroll
    for (int gt = 0; gt < 2; ++gt)
#pragma unroll
        for (int ks = 0; ks < 8; ++ks) asm volatile("" : "+v"(bfr[gt][ks]));
    RG_DMA(0, 0); asm volatile("s_waitcnt vmcnt(0)" ::: "memory");
#define RG_CHUNK(BUF_, ci_) do { const int ci = (ci_); const int t0 = 128 * ci; LAS unsigned char* const Ab = A_l + (BUF_) * 65536; \
        __builtin_amdgcn_s_barrier(); asm volatile("" ::: "memory"); \
        unsigned short ggv[2][4]; \
        _Pragma("unroll") \
        for (int mt = 0; mt < 2; ++mt) \
        _Pragma("unroll") \
            for (int j = 0; j < 4; ++j) ggv[mt][j] = __builtin_amdgcn_raw_buffer_load_b16(GGr, gvo, (t0 + 16 * mt + j) * (DM * 2), 0); \
        if (ci + 1 < SEQ / 128) RG_DMA(ci + 1, BUF_ ^ 1); \
 \
        f32x4 acc[2][2]; \
        _Pragma("unroll") \
        for (int mt = 0; mt < 2; ++mt) { acc[mt][0] = (f32x4){ba, ba, ba, ba}; acc[mt][1] = (f32x4){bx, bx, bx, bx}; } \
        _Pragma("unroll") \
        for (int ks = 0; ks < 8; ++ks) { const int ch = 4 * ks + fq; \
        _Pragma("unroll") \
            for (int mt = 0; mt < 2; ++mt) { const int arow = 32 * rq + 16 * mt + fr; \
                const bf16x8 af = *(const LAS bf16x8*)(Ab + arow * 512 + ((ch ^ (arow & 15)) << 4)); \
                acc[mt][0] = __builtin_amdgcn_mfma_f32_16x16x32_bf16(af, bfr[0][ks], acc[mt][0], 0, 0, 0); \
                acc[mt][1] = __builtin_amdgcn_mfma_f32_16x16x32_bf16(af, bfr[1][ks], acc[mt][1], 0, 0, 0); } } \
 \
        float av[2][4], bv[2][4], sA[2], sB[2]; \
        _Pragma("unroll") \
        for (int mt = 0; mt < 2; ++mt) { float A = 1.f, Bv = 0.f; \
        _Pragma("unroll") \
            for (int j = 0; j < 4; ++j) { const int row = 32 * rq + 16 * mt + 4 * fq + j; \
                const unsigned short xb16 = *(const LAS unsigned short*)(Ab + row * 512 + ((((kx >> 3) ^ (row & 15))) << 4) + (kx & 7) * 2); \
                const float xc = __builtin_bit_cast(float, (unsigned)xb16 << 16); \
                const float r_ = __builtin_amdgcn_rcpf(1.0f + __builtin_amdgcn_exp2f(acc[mt][0][j])), i_ = __builtin_amdgcn_rcpf(1.0f + __builtin_amdgcn_exp2f(acc[mt][1][j])); \
                const float aa = __builtin_amdgcn_exp2f(-sp8 * r_); \
                const float mult = __builtin_amdgcn_sqrtf(fmaxf(fmaf(-aa, aa, 1.0f), 0.f)); \
                av[mt][j] = aa; bv[mt][j] = mult * i_ * xc; \
                Bv = fmaf(aa, Bv, bv[mt][j]); A *= aa; } \
            sA[mt] = A; sB[mt] = Bv; } \
 \
        float eA[2], eB[2], tA[2], tB[2]; \
        _Pragma("unroll") \
        for (int mt = 0; mt < 2; ++mt) { float A = sA[mt], Bv = sB[mt]; \
            { const float pA = __shfl_up(A, 16), pB = __shfl_up(Bv, 16); if (fq >= 1) { Bv = fmaf(A, pB, Bv); A *= pA; } } \
            { const float pA = __shfl_up(A, 32), pB = __shfl_up(Bv, 32); if (fq >= 2) { Bv = fmaf(A, pB, Bv); A *= pA; } } \
            const float xA = __shfl_up(A, 16), xB = __shfl_up(Bv, 16); eA[mt] = fq >= 1 ? xA : 1.f; eB[mt] = fq >= 1 ? xB : 0.f; \
            tA[mt] = __shfl(A, 48 + fr); tB[mt] = __shfl(Bv, 48 + fr); } \
        const float wA = tA[0] * tA[1], wB = fmaf(tA[1], tB[0], tB[1]); \
        if (fq == 0) { tot[(rq * 32 + cl) * 2] = wA; tot[(rq * 32 + cl) * 2 + 1] = wB; } \
        asm volatile("s_waitcnt lgkmcnt(0)" ::: "memory"); __builtin_amdgcn_s_barrier(); asm volatile("" ::: "memory"); \
        float hin = hc, hnew = hc; \
        _Pragma("unroll") \
        for (int q = 0; q < 4; ++q) { const float qA = tot[(q * 32 + cl) * 2], qB = tot[(q * 32 + cl) * 2 + 1]; hnew = fmaf(qA, hnew, qB); if (q < rq) hin = hnew; } \
        hc = hnew; \
        _Pragma("unroll") \
        for (int mt = 0; mt < 2; ++mt) { float h = mt == 0 ? hin : fmaf(tA[0], hin, tB[0]); \
            h = fmaf(eA[mt], h, eB[mt]); \
        _Pragma("unroll") \
            for (int j = 0; j < 4; ++j) { h = fmaf(av[mt][j], h, bv[mt][j]); \
                const float gv = __builtin_bit_cast(float, (unsigned)ggv[mt][j] << 16); \
                __builtin_amdgcn_raw_buffer_store_b16((unsigned short)cvtpk_bf16(h * gv, 0.f), GOr, gvo, (t0 + 16 * mt + j) * (DM * 2), 0); } } \
        asm volatile("s_waitcnt lgkmcnt(0)" ::: "memory"); \
        asm volatile("s_waitcnt vmcnt(8)" ::: "memory"); \
    } while (0)
    for (int cc = 0; cc < SEQ / 128; cc += 2) { RG_CHUNK(0, cc); RG_CHUNK(1, cc + 1); }
#undef RG_CHUNK
#undef RG_DMA
    asm volatile("s_waitcnt vmcnt(0) lgkmcnt(0)" ::: "memory"); __builtin_amdgcn_s_barrier(); asm volatile("" ::: "memory");
}
constexpr float SKIP_LOG2 = 40.0f;
__device__ __forceinline__ int attn_jlo(const Frame& F, const float* CB, const unsigned* NORM, int bh, int qb) {
    float qs = 0.f, ks = 0.f;
#pragma unroll
    for (int w = 0; w < 4; ++w) { qs += __uint_as_float(NORM[(bh) * 4 + w]); ks += __uint_as_float(NORM[(64 + bh) * 4 + w]); }
    constexpr float C2 = 1.4426950408889634f * 0.08838834764831845f;
    const float th = SKIP_LOG2 + 2.0f * 1.02f * sqrtf(qs * ks) * C2 + 4.0f;
    const float ref = CB[(size_t)bh * SEQ + qb * 256], v = CB[(size_t)bh * SEQ + 64 * F.lane + 63];
    const unsigned long long m = __ballot(F.lane < 4 * qb && (ref - v) * C2 > th);
    int j = __builtin_popcountll(m); if (m != ((j >= 64) ? ~0ull : ((1ull << j) - 1ull))) j = 0;
    return j & ~1;
}
__device__ __forceinline__ fattn::BlockRef attn_ref(int bh, int qb, int jlo) {
    const int b = bh >> 3, h = bh & 7;
    fattn::BlockRef r; r.qo = ((unsigned)bh * SEQ + (unsigned)qb * 256u) * HD; r.oo = ((unsigned)b * SEQ + (unsigned)qb * 256u) * DM + h * HD; r.kvo = (unsigned)bh * SEQ * HD; r.cbo = (unsigned)bh * SEQ; r.P0 = qb * 256; r.jlo = jlo; return r;
}
__device__ __forceinline__ void attn_phase(const Frame& F, char* lds, const bf16* Qb, bf16* Ob, const bf16* Kb, const bf16* Vb, const float* CB, const int* JLO, gu32* QCTR, const int probe = 0) {
#define ATT_JLO(bh_, qb_) (probe == 1 ? 4 * (qb_) : probe == 2 ? 0 : __builtin_amdgcn_readfirstlane(JLO[(bh_) * 16 + (qb_)]))
    constexpr int NBLK = 128;
    const int M = F.G >> 3; if ((F.G & 7) || M > 64 || M < 1) return;
    const int x = F.vcu / M, r = F.vcu % M;
    volatile LAS int* tk_l = (volatile LAS int*)(F.lds + MISC_OFF + 64);
    gu32* qc = QCTR + 64 * x;
    const fattn::Bases G{Qb, Ob, Kb, Vb, CB}; LAS unsigned char* const ldsa = F.lds + RING_OFF;
#define ATT_DEC(k_, bh_, qb_) do { const int i_ = (k_) & 7; bh_ = (i_ < 4 ? 4 * x + i_ : 32 + 4 * x + (i_ - 4)); qb_ = 15 - ((k_) >> 3); } while (0)
    int bh, qb; ATT_DEC(r, bh, qb);
    fattn::BlockRef cur = attn_ref(bh, qb, ATT_JLO(bh, qb));
    ATT_DEC(r + M, bh, qb);
    fattn::BlockRef nxt = attn_ref(bh, qb, ATT_JLO(bh, qb)); bool nxt_ok = (r + M) < NBLK;
    fattn::Seam S;
    fattn::prime(G, cur, lds, ldsa, S);
    bool more = true;
    for (;;) {
        unsigned tkt = 0u;
        if (more && F.tid == 0) tkt = __hip_atomic_fetch_add(qc, 1u, __ATOMIC_RELAXED, __HIP_MEMORY_SCOPE_AGENT);
        const bool last = !nxt_ok;
        fattn::block(G, cur, last ? cur : nxt, lds, ldsa, S);
        if (last) break;
        if (F.tid == 0) tk_l[0] = more ? (int)tkt + 2 * M : NBLK;
        __syncthreads();
        const int k2 = __builtin_amdgcn_readfirstlane(tk_l[0]);
        __syncthreads();
        cur = nxt;
        if (k2 < NBLK) { ATT_DEC(k2, bh, qb); nxt = attn_ref(bh, qb, ATT_JLO(bh, qb)); nxt_ok = true; } else { nxt_ok = false; more = false; }
    }
#undef ATT_DEC
#undef ATT_JLO
}
typedef float f32x16 __attribute__((ext_vector_type(16)));
struct P5Args { const float *X, *WRT, *b_rgrp, *b_rexp, *w_down; const bf16* DL; bf16* X1B; unsigned char *X8, *W2; float* RS2; int* LISTS; unsigned* TOK; gu32* CNT; };
__device__ __forceinline__ void p5_route(const Frame& F, const P5Args& a) {
    const int tid = F.tid, lane = F.lane, wid = F.wave, i16 = lane & 15, h4 = lane >> 4;
    constexpr int LDA = 132;
    LAS float* A_l = (LAS float*)(F.lds + RING_OFF) + wid * 16 * LDA;
    LAS float* B_l = (LAS float*)(F.lds + RING_OFF + 67584);
    LAS float* LG = (LAS float*)(F.lds + RING_OFF + 94208);
    LAS float* rs_l = (LAS float*)(F.lds + RING_OFF + 113664);
    LAS int* hist = (LAS int*)(F.lds + RING_OFF + 114176);
    LAS int* base_l = (LAS int*)(F.lds + RING_OFF + 114432);
    {
        LAS float* scr = (LAS float*)(F.lds + RING_OFF + wid * 8704);
        const int gw = F.vcu * NWAVES + wid, NGW = F.G * NWAVES;
        for (int it = gw; it < 8192; it += NGW) { const int e = it >> 8, kb = (it >> 5) & 7, nb = it & 31; const float* W = a.w_down + (size_t)e * DE * DM;
            transpose_tile8(W + (size_t)(64 * kb) * DM + 32 * nb, DM, a.W2 + (size_t)(e * 1024 + 32 * nb) * DE + 64 * kb, DE, nullptr, pg8::W2_SCALE, scr, lane); }
    }
    __syncthreads();
    for (int rb = blockIdx.x; rb < T / 128; rb += F.G) {
        const int R0 = rb * 128;
        if (tid < 32) hist[tid] = 0;
        const int ar = lane >> 5, ac = 4 * (lane & 31);
        const size_t xo = (size_t)(R0 + 16 * wid + ar) * DM + ac; const float* xsrc = a.X + xo; const bf16* dsrc = a.DL + xo; unsigned char* xdst = a.X8 + xo; bf16* bdst = a.X1B + xo;
        f32x4 areg[8], breg[3]; unsigned long long dreg[8];
#define P5_LOAD(kc_) do { _Pragma("unroll") for (int i_ = 0; i_ < 8; ++i_) { areg[i_] = __builtin_nontemporal_load((const f32x4*)(xsrc + (size_t)(2 * i_) * DM + (kc_) * 128)); dreg[i_] = __builtin_nontemporal_load((const unsigned long long*)(dsrc + (size_t)(2 * i_) * DM + (kc_) * 128)); } \
        _Pragma("unroll") for (int q_ = 0; q_ < 3; ++q_) { const int idx_ = tid + 512 * q_; breg[q_] = *(const f32x4*)(a.WRT + (size_t)(idx_ >> 5) * DM + (kc_) * 128 + 4 * (idx_ & 31)); } } while (0)
        P5_LOAD(0);
        f32x4 acc[3] = {{0.f, 0.f, 0.f, 0.f}, {0.f, 0.f, 0.f, 0.f}, {0.f, 0.f, 0.f, 0.f}}; float ss = 0.f;
        for (int kc = 0; kc < 8; ++kc) {
#pragma unroll
            for (int i = 0; i < 8; ++i) { const unsigned dl = (unsigned)dreg[i], dh = (unsigned)(dreg[i] >> 32);
                areg[i][0] += bf_lo(dl); areg[i][1] += bf_hi(dl); areg[i][2] += bf_lo(dh); areg[i][3] += bf_hi(dh);
                *(unsigned*)(xdst + (size_t)(2 * i) * DM + kc * 128) = pg8::pack4_fp8(areg[i][0], areg[i][1], areg[i][2], areg[i][3]);
                *(unsigned long long*)(bdst + (size_t)(2 * i) * DM + kc * 128) = (unsigned long long)pg8::cvt_pk_bf16(areg[i][0], areg[i][1]) | ((unsigned long long)pg8::cvt_pk_bf16(areg[i][2], areg[i][3]) << 32);
                *(LAS f32x4*)(A_l + (2 * i + ar) * LDA + ac) = areg[i]; }
#pragma unroll
            for (int q = 0; q < 3; ++q) { const int idx = tid + 512 * q; *(LAS f32x4*)(B_l + (idx >> 5) * LDA + 4 * (idx & 31)) = breg[q]; }
            __syncthreads();
            if (kc + 1 < 8) P5_LOAD(kc + 1);
#pragma unroll
            for (int jj = 0; jj < 8; ++jj) {
                const f32x4 af = *(const LAS f32x4*)(A_l + i16 * LDA + 16 * jj + 4 * h4);
                f32x4 bfv[3];
#pragma unroll
                for (int nt = 0; nt < 3; ++nt) bfv[nt] = *(const LAS f32x4*)(B_l + (16 * nt + i16) * LDA + 16 * jj + 4 * h4);
                ss += (af[0] * af[0] + af[1] * af[1]) + (af[2] * af[2] + af[3] * af[3]);
#pragma unroll
                for (int s = 0; s < 4; ++s)
#pragma unroll
                    for (int nt = 0; nt < 3; ++nt) acc[nt] = __builtin_amdgcn_mfma_f32_16x16x4f32(af[s], bfv[nt][s], acc[nt], 0, 0, 0);
            }
            __syncthreads();
        }
#undef P5_LOAD
        ss += __shfl_xor(ss, 16); ss += __shfl_xor(ss, 32);
        const float rs = 1.0f / sqrtf(ss * (1.0f / DM) + EPS);
        if (h4 == 0) { a.RS2[R0 + 16 * wid + i16] = rs; rs_l[16 * wid + i16] = rs; }
#pragma unroll
        for (int r = 0; r < 4; ++r) { const int rl = 16 * wid + 4 * h4 + r; LG[rl * 37 + i16] = acc[0][r]; LG[rl * 37 + 16 + i16] = acc[1][r]; if (i16 < 4) LG[rl * 37 + 32 + i16] = acc[2][r]; }
        __syncthreads();
        int e0 = 0, e1 = 0, k0 = 0, k1 = 0; float w0 = 0.f, w1 = 0.f;
        if (tid < 128) {
            const float rsv = rs_l[tid]; const LAS float* lg = LG + tid * 37;
            float gl[4];
#pragma unroll
            for (int q = 0; q < 4; ++q) gl[q] = lg[32 + q] * rsv + a.b_rgrp[q];
            int gs = 0; float gm = gl[0];
#pragma unroll
            for (int q = 1; q < 4; ++q) if (gl[q] > gm) { gm = gl[q]; gs = q; }
            float den = 0.f;
#pragma unroll
            for (int q = 0; q < 4; ++q) den += expf(gl[q] - gm);
            const float pg = 1.0f / den;
            float el[8];
#pragma unroll
            for (int q = 0; q < 8; ++q) el[q] = lg[8 * gs + q] * rsv + a.b_rexp[8 * gs + q];
            int i0 = 0; float v0 = el[0];
#pragma unroll
            for (int q = 1; q < 8; ++q) if (el[q] > v0) { v0 = el[q]; i0 = q; }
            int i1 = -1; float v1 = -INFINITY;
#pragma unroll
            for (int q = 0; q < 8; ++q) if (q != i0 && el[q] > v1) { v1 = el[q]; i1 = q; }
            const float ex = expf(v1 - v0);
            w0 = pg / (1.0f + ex); w1 = pg * ex / (1.0f + ex);
            e0 = 8 * gs + i0; e1 = 8 * gs + i1;
            k0 = atomicAdd((int*)(hist + e0), 1); k1 = atomicAdd((int*)(hist + e1), 1);
        }
        __syncthreads();
        if (tid < 32) base_l[tid] = (int)__hip_atomic_fetch_add(a.CNT + tid, (unsigned)hist[tid], __ATOMIC_RELAXED, __HIP_MEMORY_SCOPE_AGENT);
        __syncthreads();
        if (tid < 128) { const int tok = R0 + tid, s0 = base_l[e0] + k0, s1 = base_l[e1] + k1;
            a.LISTS[(size_t)e0 * T + s0] = tok; a.LISTS[(size_t)e1 * T + s1] = tok;
            v4u i0v = {(unsigned)e0, (unsigned)s0, (unsigned)e1, (unsigned)s1}, i1v = {__float_as_uint(w0), __float_as_uint(w1), 0u, 0u};
            *(GAS v4u*)(a.TOK + (size_t)tok * 8) = i0v; *(GAS v4u*)(a.TOK + (size_t)tok * 8 + 4) = i1v; }
        __syncthreads();
    }
}
__device__ __forceinline__ void build_tables(const Frame& F, const gu32* CNT) {
    LAS int* ps = (LAS int*)(F.lds + TBL_PS); LAS int* cn = (LAS int*)(F.lds + TBL_CN); LAS int* te = (LAS int*)(F.lds + TBL_TE);
    __syncthreads();
    if (F.tid < 32) { int c = (int)__hip_atomic_load(CNT + F.tid, __ATOMIC_RELAXED, __HIP_MEMORY_SCOPE_AGENT); c = c < 0 ? 0 : (c > T ? T : c); cn[F.tid] = c; }
    __syncthreads();
    if (F.tid == 0) { int run = 0; for (int e = 0; e < 32; ++e) { ps[e] = run; run += (cn[e] + 255) & ~255; } if (run > PMAX) run = PMAX; ps[32] = run; }
    __syncthreads();
    if (F.tid < 288) { const int p = F.tid * 256; int e = 0; for (int q = 1; q < 32; ++q) if (p >= ps[q]) e = q; te[F.tid] = e; }
    __syncthreads();
}
__device__ __forceinline__ void build_rowtab(const Frame& F, const pg8::GroupedOrder& S, const int* LISTS, const float* RS2, LAS int* rowtab) {
    const LAS int* ps = (const LAS int*)(F.lds + TBL_PS); const LAS int* cn = (const LAS int*)(F.lds + TBL_CN); const LAS int* te = (const LAS int*)(F.lds + TBL_TE);
    pg8::Unit u;
    for (int ui = 0; ui < 6 && S.next(ui, u); ++ui)
        if (F.tid < 256) { const int p = u.pm * 256 + F.tid, e = te[u.pm], local = p - ps[e]; const int tok = local < cn[e] ? LISTS[(size_t)e * T + local] : 0; rowtab[ui * 256 + F.tid] = tok; ((LAS float*)rowtab)[(6 + ui) * 256 + F.tid] = RS2[tok]; }
    __syncthreads();
}
__device__ __forceinline__ float fp8_f32(unsigned w, int i) { return i == 0 ? __builtin_amdgcn_cvt_f32_fp8(w, 0) : (i == 1 ? __builtin_amdgcn_cvt_f32_fp8(w, 1) : (i == 2 ? __builtin_amdgcn_cvt_f32_fp8(w, 2) : __builtin_amdgcn_cvt_f32_fp8(w, 3))); }
__device__ __forceinline__ void p9_final(const Frame& F, const bf16* X1B, float* OUT, const unsigned char* Y, const unsigned* TOK, const float* g_final) {
    const LAS int* ps = (const LAS int*)(F.lds + TBL_PS);
    const int gw = F.vcu * NWAVES + F.wave, NGW = F.G * NWAVES;
    f32x4 gf[4];
#pragma unroll
    for (int j = 0; j < 4; ++j) gf[j] = *((const f32x4*)g_final + F.lane + 64 * j);
    constexpr float YS = 1.0f / (pg8::HB_SCALE * pg8::W2_SCALE * pg8::Y_SCALE);
    v4u ia_n = {0u, 0u, 0u, 0u}, ib_n = {0u, 0u, 0u, 0u}, ia_c = ia_n, ib_c = ib_n; unsigned long long xw_n[4]; unsigned ya_n[4], yb_n[4];
#define P9_TOK(m_, ia_, ib_) do { ia_ = *(const GAS v4u*)(TOK + (size_t)(m_) * 8); ib_ = *(const GAS v4u*)(TOK + (size_t)(m_) * 8 + 4); } while (0)
#define P9_ROW(m_, ia_) do { const size_t p0_ = (size_t)(ps[(int)(ia_.x & 31u)] + (int)ia_.y), p1_ = (size_t)(ps[(int)(ia_.z & 31u)] + (int)ia_.w); \
        const GAS unsigned long long* xr_ = (const GAS unsigned long long*)(X1B + (size_t)(m_) * DM) + F.lane; \
        const GAS unsigned* y0_ = (const GAS unsigned*)(Y + p0_ * DM) + F.lane; const GAS unsigned* y1_ = (const GAS unsigned*)(Y + p1_ * DM) + F.lane; \
        _Pragma("unroll") for (int j = 0; j < 4; ++j) { xw_n[j] = __builtin_nontemporal_load((const unsigned long long*)xr_ + 64 * j); ya_n[j] = __builtin_nontemporal_load((const unsigned*)y0_ + 64 * j); yb_n[j] = __builtin_nontemporal_load((const unsigned*)y1_ + 64 * j); } } while (0)
    if (gw < T) { P9_TOK(gw, ia_c, ib_c); P9_ROW(gw, ia_c); if (gw + NGW < T) P9_TOK(gw + NGW, ia_n, ib_n); }
    for (int m = gw; m < T; m += NGW) {
        const float w0 = __uint_as_float(ib_c.x) * YS, w1 = __uint_as_float(ib_c.y) * YS;
        unsigned long long xw[4]; unsigned ya[4], yb[4];
#pragma unroll
        for (int j = 0; j < 4; ++j) { xw[j] = xw_n[j]; ya[j] = ya_n[j]; yb[j] = yb_n[j]; }
        if (m + NGW < T) { ia_c = ia_n; ib_c = ib_n; P9_ROW(m + NGW, ia_c); if (m + 2 * NGW < T) P9_TOK(m + 2 * NGW, ia_n, ib_n); }
        GAS f32x4* orow = (GAS f32x4*)(OUT + (size_t)m * DM) + F.lane;
        f32x4 v[4]; float s = 0.f;
#pragma unroll
        for (int j = 0; j < 4; ++j) { v[j] = (f32x4){bf_lo((unsigned)xw[j]), bf_hi((unsigned)xw[j]), bf_lo((unsigned)(xw[j] >> 32)), bf_hi((unsigned)(xw[j] >> 32))}; const unsigned a = ya[j], b = yb[j];
            v[j].x += w0 * fp8_f32(a, 0) + w1 * fp8_f32(b, 0); v[j].y += w0 * fp8_f32(a, 1) + w1 * fp8_f32(b, 1);
            v[j].z += w0 * fp8_f32(a, 2) + w1 * fp8_f32(b, 2); v[j].w += w0 * fp8_f32(a, 3) + w1 * fp8_f32(b, 3);
            s += (v[j].x * v[j].x + v[j].y * v[j].y) + (v[j].z * v[j].z + v[j].w * v[j].w); }
        s = wave_sum(s);
        const float rs = 1.0f / sqrtf(s * (1.0f / DM) + EPS);
#pragma unroll
        for (int j = 0; j < 4; ++j) orow[64 * j] = v[j] * rs * gf[j];
    }
#undef P9_TOK
#undef P9_ROW
}

constexpr int N_PHASES = 10;
#ifndef DUP_TRIVIAL
#define DUP_TRIVIAL 0
#endif
#ifndef DUP_PHASE
#define DUP_PHASE -1
#endif
typedef __attribute__((address_space(4))) const unsigned char* karg_ptr;
__device__ __forceinline__ const float* arg_in(int k) { karg_ptr base = (karg_ptr)__builtin_amdgcn_kernarg_segment_ptr(); const unsigned long long v = *(const unsigned long long volatile __attribute__((address_space(4)))*)(base + 8 * k); return (const float*)(const GAS float*)v; }
struct Args { const float* in[23]; float* out; unsigned char* ws; int ph_lo, ph_hi, mode, pad; };
__global__ void __launch_bounds__(NWAVES * 64, 2) fwd_kernel(Args args) {
    extern __shared__ __attribute__((aligned(16))) unsigned char lds[];
    Frame F;
    F.lds = (LAS unsigned char*)lds;
    F.wave = __builtin_amdgcn_readfirstlane((int)threadIdx.x >> 6); F.lane = pg8::lane_now(); F.tid = F.wave * 64 + F.lane;
    F.G = gridDim.x; { const int bx = blockIdx.x; F.vcu = (F.G % 8 == 0) ? (bx % 8) * (F.G / 8) + bx / 8 : bx; }
    unsigned char* ws = args.ws;
    gu32* ctl = (gu32*)(ws + WS_CTL);
    volatile LAS unsigned* MISC = (volatile LAS unsigned*)(F.lds + MISC_OFF);
    for (int u = F.tid; u < (LDS_BYTES - LDSCTL_OFF) / 4; u += NWAVES * 64) ((LAS unsigned*)(F.lds + LDSCTL_OFF))[u] = 0u;
    __syncthreads();
#if MK_ONE_LAUNCH
    XcdBarrier bar = xcd_barrier_post((unsigned*)(ctl + CW_BAR), MISC + 8);
#define GRID_BAR() xcd_barrier(bar)
#else
#define GRID_BAR() do { } while (0)
#endif
    const int lo = args.ph_lo, hi = args.ph_hi;
#ifndef PH_MASK
#define PH_MASK 0x3ff
#endif
#define IN(k) (((PH_MASK >> (k)) & 1) && lo <= (k) && (k) < hi)
#define BOTH(k) (IN(k) && IN((k) + 1))
    float* out = args.out;
    bf16* Win = (bf16*)(ws + WS_WIN); bf16* Wl = (bf16*)(ws + WS_WL); bf16* Wa = (bf16*)(ws + WS_WA); bf16* Wo = (bf16*)(ws + WS_WO); bf16* Wrg = (bf16*)(ws + WS_WRG);
    bf16* XB = (bf16*)(ws + WS_XB); bf16* XR = (bf16*)(ws + WS_XR); bf16* GG = (bf16*)(ws + WS_GG); bf16* Qb = (bf16*)(ws + WS_Q); bf16* Kb = (bf16*)(ws + WS_K); bf16* Vb = (bf16*)(ws + WS_V);
    bf16* SL = (bf16*)out; bf16* SA = (bf16*)out + pg8::SEGE;
    float* RS1 = (float*)(ws + WS_RS1); float* RS2 = (float*)(ws + WS_RS2); float* LF = (float*)(ws + WS_LF); float* CB = (float*)(ws + WS_CB);
    unsigned* TOK = (unsigned*)(ws + WS_TOK); int* LISTS = (int*)(ws + WS_LISTS); float* WRT = (float*)(ws + WS_WRT); int* JLO = (int*)(ws + WS_SRS);
    unsigned char* W13 = ws + WS_W13; unsigned char* W2 = ws + WS_W2; bf16* XG = (bf16*)(ws + WS_XG); unsigned char* HB = ws + WS_HB; unsigned char* X8 = ws + WS_XB;
    gu32* CNT = ctl + CW_CNT;

    if (IN(0)) { F.lane = pg8::lane_now(); F.tid = F.wave * 64 + F.lane;
        P0Args a{arg_in(0), arg_in(1), arg_in(2), arg_in(5), arg_in(7), arg_in(10), arg_in(11), arg_in(12), arg_in(13), arg_in(14), arg_in(15), arg_in(17), arg_in(19), arg_in(20), Win, Wl, Wa, Wo, Wrg, XB, W13, RS1, LF, WRT};
        p0_prologue(F, a, DUP_PHASE == 0 ? args.mode : 0);
        if (BOTH(0)) GRID_BAR();
    }
    if (IN(1)) { F.lane = pg8::lane_now(); F.tid = F.wave * 64 + F.lane;
        cumsum_bias(F, LF, CB);
        pg8::Gemm g{XB, Win, T, NZ, DM}; pg8::StaticOrder S; S.init(T, NZ, F.G, (int)blockIdx.x);
        pg8::EpiZ E{XR, SL, RS1, (unsigned*)(ctl + CW_NORM), args.mode};
        pg8::gemm_phase<pg8::EpiZ, pg8::StaticOrder, true, true>(F.lds + RING_OFF, g, S, E, F.wave);
        if (BOTH(1)) GRID_BAR();
    }
    if (IN(2)) { F.lane = pg8::lane_now(); F.tid = F.wave * 64 + F.lane;
        { const int gw = F.vcu * NWAVES + F.wave; if (gw < NB * NH * 16) { const int j = attn_jlo(F, CB, (const unsigned*)(ctl + CW_NORM), gw >> 4, gw & 15); if (F.lane == 0) JLO[gw] = j; } }
        conv_prepass(F, XR, XB, arg_in(3), arg_in(4));
        if (BOTH(2)) GRID_BAR();
    }
    if (IN(3)) { F.lane = pg8::lane_now(); F.tid = F.wave * 64 + F.lane;
        RgArgs ra{XB, GG, GG, Wrg, arg_in(6), arg_in(8), arg_in(9)};
#if DUP_PHASE >= 20
        const int mode = args.mode;
#else
        constexpr int mode = 0;
#endif
        if (mode < 2) { ra.GO = mode == 1 ? XR : GG; for (int u = F.vcu; u < 256; u += F.G) rglru_unit(F, ra, u); }
        if (mode != 1) attn_phase(F, (char*)lds + RING_OFF, Qb, XR, Kb, Vb, CB, JLO, ctl + CW_QCTR + (mode >= 2 ? 1024 : 0), mode >= 3 ? mode - 2 : 0);
        if (BOTH(3)) GRID_BAR();
    }
    if (IN(4)) { { F.lane = pg8::lane_now(); F.tid = F.wave * 64 + F.lane;
        static_assert(WS_GG - WS_XR == (size_t)128 * 256 * DM * 2 && WS_WL - WS_WA == (size_t)4 * 256 * DM * 2, "TwoGemmOrder: hg follows o by 128 row tiles, Wl follows Wa by 4 column tiles");
        pg8::Gemm g{XR, Wa, T, DM, DM}; pg8::TwoGemmOrder S; S.init(T, DM, F.G, (int)blockIdx.x);
        pg8::EpiGate2 E{SA, SL, XB};
        pg8::gemm_phase<pg8::EpiGate2, pg8::TwoGemmOrder, true, true>(F.lds + RING_OFF, g, S, E, F.wave); }
        if (BOTH(4)) GRID_BAR();
    }
    if (IN(5)) { F.lane = pg8::lane_now(); F.tid = F.wave * 64 + F.lane;
        pg8::Gemm g{XB, Wo, T, DM, DM}; pg8::StaticOrder S; S.init(T, DM, F.G, (int)blockIdx.x);
        pg8::EpiDelta E{(bf16*)out};
        pg8::gemm_phase<pg8::EpiDelta, pg8::StaticOrder, true, true>(F.lds + RING_OFF, g, S, E, F.wave);
        if (BOTH(5)) GRID_BAR();
    }
    if (IN(6)) { F.lane = pg8::lane_now(); F.tid = F.wave * 64 + F.lane;
        P5Args a{arg_in(0), WRT, arg_in(16), arg_in(18), arg_in(21), (const bf16*)out, XR, X8, W2, RS2, LISTS, TOK, args.mode ? CNT + 64 : CNT};
        p5_route(F, a);
        if (BOTH(6)) GRID_BAR();
    }
    if (IN(7)) { F.lane = pg8::lane_now(); F.tid = F.wave * 64 + F.lane;
        build_tables(F, CNT);
        const int ntiles = ((const LAS int*)(F.lds + TBL_PS))[32] >> 8;
        pg8::Gemm g{(const bf16*)X8, (const bf16*)W13, ntiles * 256, 32 * 1024, DM / 2}; pg8::GroupedOrder S{(const LAS int*)(F.lds + TBL_TE), ntiles * 4, F.G, F.vcu};
        LAS int* rowtab = (LAS int*)(F.lds + RG_TOT);
        build_rowtab(F, S, LISTS, RS2, rowtab);
        pg8::EpiSwiGLU E{HB};
        pg8::gemm_phase_gather<pg8::EpiSwiGLU, pg8::GroupedOrder, true>(F.lds + RING_OFF, g, S, E, rowtab, F.wave);
        if (BOTH(7)) GRID_BAR();
    }
    if (IN(8)) { F.lane = pg8::lane_now(); F.tid = F.wave * 64 + F.lane;
        build_tables(F, CNT);
        const int ntiles = ((const LAS int*)(F.lds + TBL_PS))[32] >> 8;
        pg8::Gemm g{(const bf16*)HB, (const bf16*)W2, ntiles * 256, 32 * 1024, DE / 2}; pg8::GroupedOrder S{(const LAS int*)(F.lds + TBL_TE), ntiles * 4, F.G, F.vcu};
        pg8::EpiY E{(unsigned char*)XG};
        pg8::gemm_phase<pg8::EpiY, pg8::GroupedOrder, true, true, true>(F.lds + RING_OFF, g, S, E, F.wave);
        if (BOTH(8)) GRID_BAR();
    }
    if (IN(9)) { F.lane = pg8::lane_now(); F.tid = F.wave * 64 + F.lane;
        build_tables(F, CNT);
        p9_final(F, XR, out, (const unsigned char*)XG, TOK, arg_in(22));
    }
#undef IN
#undef BOTH
}

extern "C" void kernel_launch(void* const* d_in, const int* in_sizes, int n_in, void* d_out, int out_size, void* d_ws, size_t ws_size, hipStream_t stream) {
    static int grid = 0;
    if (grid == 0) {
        if (n_in != 23 || in_sizes[0] != T * DM || out_size != T * DM || ws_size < WS_END) { fprintf(stderr, "kernel_launch: unexpected shapes (n_in %d, in0 %d, out %d, ws %zu); nothing launched\n", n_in, n_in > 0 ? in_sizes[0] : -1, out_size, ws_size); grid = -1; return; }
        int dev = 0, cus = 0;
        if (hipGetDevice(&dev) != hipSuccess || hipDeviceGetAttribute(&cus, hipDeviceAttributeMultiprocessorCount, dev) != hipSuccess) { grid = -1; return; }
        if (hipFuncSetAttribute((const void*)fwd_kernel, hipFuncAttributeMaxDynamicSharedMemorySize, LDS_BYTES) != hipSuccess) { fprintf(stderr, "kernel_launch: hipFuncSetAttribute failed\n"); grid = -1; return; }
        int per_cu = 0;
        if (hipOccupancyMaxActiveBlocksPerMultiprocessor(&per_cu, (const void*)fwd_kernel, NWAVES * 64, LDS_BYTES) != hipSuccess || per_cu < 1) { fprintf(stderr, "kernel_launch: occupancy query reports %d\n", per_cu); }
        (void)hipGetLastError();
        grid = cus;
    }
    if (grid < 0) return;
    if (hipMemsetAsync((char*)d_ws + WS_CTL, 0, CTL_ZERO_BYTES, stream) != hipSuccess) return;
    Args a{};
    for (int i = 0; i < 23; ++i) a.in[i] = (const float*)d_in[i];
    a.out = (float*)d_out; a.ws = (unsigned char*)d_ws;
#if MK_ONE_LAUNCH
    a.ph_lo = 0; a.ph_hi = N_PHASES;
    hipLaunchKernelGGL(fwd_kernel, dim3(grid), dim3(NWAVES * 64), LDS_BYTES, stream, a);
#else
    for (int ph = 0; ph < N_PHASES; ++ph) { a.ph_lo = ph; a.ph_hi = ph + 1;
        if (DUP_PHASE == ph || (ph == 3 && DUP_PHASE >= 20)) { a.mode = DUP_PHASE >= 20 ? DUP_PHASE - 19 : ((ph == 6 || (ph == 1 && DUP_TRIVIAL)) ? 1 : (ph == 0 ? DUP_TRIVIAL : 0)); hipLaunchKernelGGL(fwd_kernel, dim3(grid), dim3(NWAVES * 64), LDS_BYTES, stream, a); a.mode = 0; }
        hipLaunchKernelGGL(fwd_kernel, dim3(grid), dim3(NWAVES * 64), LDS_BYTES, stream, a); }
#endif
}
```

```cpp
#include <hip/hip_runtime.h>
#include <cstdio>
#include <cstdint>

#ifndef MK_ONE_LAUNCH
#define MK_ONE_LAUNCH 1
#endif
namespace pg8 {
#define PG8_LAS __attribute__((address_space(3)))
typedef unsigned short bf16_t;
typedef short bf16x8 __attribute__((ext_vector_type(8)));
typedef float f32x4 __attribute__((ext_vector_type(4)));
typedef unsigned u32x4 __attribute__((ext_vector_type(4)));
constexpr int BM = 256, BK = 64, HALF = 128, HTB = HALF * BK * 2  , STAGE_BYTES = 8 * HTB, NXCD = 8, WGM = 8;

__host__ __device__ __forceinline__ int lds_byte(int r, int c) { const int st = (r >> 4) * 2 + (c >> 5), rr = r & 15, cc = c & 31, ob = rr * 64 + cc * 2; return st * 1024 + (ob ^ (((ob >> 9) & 1) << 5)); }
__host__ __device__ __forceinline__ void stage_rc(int b, int& R, int& C) { const int st = b / 1024, sb = b % 1024, swz = sb ^ (((sb >> 9) & 1) << 5); R = (st >> 1) * 16 + swz / 64; C = (st & 1) * 32 + (swz % 64) / 2; }
__host__ __device__ __forceinline__ int perm32(int rho) { const int n = rho >> 4, i = rho & 15; return 8 * (i >> 2) + 4 * n + (i & 3); }

struct Unit { int pm, pn; };
struct Gemm { const bf16_t* A; const bf16_t* Bt; int M, N, K; };

struct StaticOrder {
    int nM, nN, nwg, G, c;
    __host__ __device__ void init(int M, int N, int G_, int c_) { nM = M / BM; nN = N / BM; nwg = nM * nN; G = G_; c = c_; }
    __host__ __device__ bool next(int i, Unit& u) const {
        const long L = (long)i * G + c; if (L >= nwg) return false;
        int wgid = (int)L; { const int q = nwg / NXCD, r = nwg % NXCD, xcd = wgid % NXCD, off = wgid / NXCD; wgid = (xcd < r ? xcd * (q + 1) : r * (q + 1) + (xcd - r) * q) + off; }
        const int nig = WGM * nN, gid = wgid / nig, fm = gid * WGM, gsz = (nM - fm) < WGM ? (nM - fm) : WGM;
        u.pm = fm + ((wgid % nig) % gsz); u.pn = (wgid % nig) / gsz; return true;
    }
    __device__ __forceinline__ void a_ready(const Unit&) const {}
    __device__ __forceinline__ void done(const Unit&) const {}
};

__device__ __forceinline__ unsigned cvt_pk_bf16(float lo, float hi) { unsigned r; asm volatile("v_cvt_pk_bf16_f32 %0, %1, %2" : "=v"(r) : "v"(lo), "v"(hi)); return r; }
typedef float f32x2 __attribute__((ext_vector_type(2)));
__device__ __forceinline__ int lane_now() { int l; asm volatile("v_mbcnt_lo_u32_b32 %0, -1, 0\n\tv_mbcnt_hi_u32_b32 %0, -1, %0" : "=v"(l)); return l; }
typedef int v4i_t __attribute__((ext_vector_type(4)));
typedef int v8i_t __attribute__((ext_vector_type(8)));
__device__ __forceinline__ v8i_t cat8(bf16x8 a, bf16x8 b) { const v4i_t x = __builtin_bit_cast(v4i_t, a), y = __builtin_bit_cast(v4i_t, b); return __builtin_shufflevector(x, y, 0, 1, 2, 3, 4, 5, 6, 7); }
__device__ __forceinline__ void glds_sv(const char* base, unsigned voff, unsigned lds_dst) { unsigned keep;
    asm volatile("s_mov_b32 %0, m0\n\ts_mov_b32 m0, %3\n\ts_nop 0\n\tglobal_load_lds_dwordx4 %1, %2\n\ts_mov_b32 m0, %0" : "=&s"(keep) : "v"(voff), "s"(base), "s"(lds_dst) : "memory"); }
__device__ __forceinline__ float sat8(float x) { return __builtin_amdgcn_fmed3f(x, -448.0f, 448.0f); }
__device__ __forceinline__ unsigned pack4_fp8(float a, float b, float c, float d) { unsigned w = 0u; w = __builtin_amdgcn_cvt_pk_fp8_f32(sat8(a), sat8(b), w, false); w = __builtin_amdgcn_cvt_pk_fp8_f32(sat8(c), sat8(d), w, true); return w; }
constexpr float W13_SCALE = 64.0f, HB_SCALE = 8.0f, W2_SCALE = 32.0f, XS_SCALE = 16.0f, WIN_SCALE = 64.0f;
__device__ __forceinline__ float sigmoid_f(float x) { return __builtin_amdgcn_rcpf(1.0f + __builtin_amdgcn_exp2f(-1.4426950408889634f * x)); }
__device__ __forceinline__ float gelu_tanh_f(float x) { const float u = x * (1.0f + 0.044715f * x * x); return x * __builtin_amdgcn_rcpf(1.0f + __builtin_amdgcn_exp2f(-2.3022081981f * u)); }
__device__ __forceinline__ float bf_lo(unsigned w) { return __builtin_bit_cast(float, w << 16); }
__device__ __forceinline__ float bf_hi(unsigned w) { return __builtin_bit_cast(float, w & 0xffff0000u); }
constexpr size_t SEGE = (size_t)32768 * 1024;

struct EpiZ {
    static constexpr bool PERM = true, AFTER_DRAIN = false; static constexpr int NSTORES = 16;
    bf16_t* ws5; bf16_t* out2; const float* rs; unsigned* norm; int probe; unsigned smap; float sc;
    __device__ __forceinline__ void operator()(const f32x4 (&acc)[2][2][4][2], const Unit& u, int wr, int wc, int fr, int fq) const {
        const int sgo = (int)((smap >> (4 * (u.pn >> 2))) & 15u); const int seg = probe ? 0 : sgo; float nm[2] = {0.f, 0.f}; bf16_t* O = sgo < 5 ? ws5 + (size_t)sgo * SEGE : out2 + (size_t)(sgo - 5) * SEGE;
        const int row0 = u.pm * BM + wr * 64 + fr, col0 = (u.pn & 3) * BM + wc * 32 + 8 * fq;
#pragma unroll
        for (int ai = 0; ai < 2; ++ai)
#pragma unroll
            for (int m = 0; m < 4; ++m) { const int row = row0 + ai * HALF + m * 16; bf16_t* rowp = O + (size_t)row * 1024 + col0;
                const bool hm = (sgo >= 2 && sgo <= 4); bf16_t* rowh = O + ((size_t)((row >> 12) * 8 + 2 * (u.pn & 3)) * 4096 + (row & 4095)) * 128 + wc * 32 + 8 * fq;
#pragma unroll
                for (int bj = 0; bj < 2; ++bj) { f32x4 v0 = acc[ai][bj][m][0] * sc, v1 = acc[ai][bj][m][1] * sc;
                    if (seg == 1) {
#pragma unroll
                        for (int i = 0; i < 4; ++i) { v0[i] = gelu_tanh_f(v0[i]); v1[i] = gelu_tanh_f(v1[i]); } }
                    else if (seg >= 5) {
#pragma unroll
                        for (int i = 0; i < 4; ++i) { v0[i] = sigmoid_f(v0[i]); v1[i] = sigmoid_f(v1[i]); } }
                    if (seg == 2 || seg == 3) { float q = (v0[0] * v0[0] + v0[1] * v0[1]) + (v0[2] * v0[2] + v0[3] * v0[3]) + (v1[0] * v1[0] + v1[1] * v1[1]) + (v1[2] * v1[2] + v1[3] * v1[3]);
                        q += __shfl_xor(q, 16); q += __shfl_xor(q, 32); nm[bj] = fmaxf(nm[bj], q); }
                    u32x4 w; w.x = cvt_pk_bf16(v0[0], v0[1]); w.y = cvt_pk_bf16(v0[2], v0[3]); w.z = cvt_pk_bf16(v1[0], v1[1]); w.w = cvt_pk_bf16(v1[2], v1[3]);
                    *(u32x4*)(hm ? rowh + (size_t)bj * 4096 * 128 : rowp + bj * HALF) = w; } }
        if (seg == 2 || seg == 3) {
#pragma unroll
            for (int bj = 0; bj < 2; ++bj) { float q = nm[bj];
#pragma unroll
                for (int o = 1; o < 16; o <<= 1) q = fmaxf(q, __shfl_xor(q, o));
                if (fr == 0 && fq == 0) atomicMax(norm + ((((seg - 2) * 8 + (u.pm >> 4)) * 8 + 2 * (u.pn & 3) + bj) * 4 + wc), __float_as_uint(q)); }
        }
    }
};
template <int MODE> struct EpiGate {
    static constexpr bool PERM = true, AFTER_DRAIN = false; static constexpr int NSTORES = 16;
    const bf16_t* G; bf16_t* O;
    __device__ __forceinline__ void operator()(const f32x4 (&acc)[2][2][4][2], const Unit& u, int wr, int wc, int fr, int fq) const {
        const int row0 = u.pm * BM + wr * 64 + fr, col0 = u.pn * BM + wc * 32 + 8 * fq;
        u32x4 gv[2][2][2], pv[2][2][2];
#define EG_LOAD(st_, b_) do { _Pragma("unroll") for (int mm = 0; mm < 2; ++mm) _Pragma("unroll") for (int bj = 0; bj < 2; ++bj) { \
            const size_t off_ = (size_t)(row0 + ((st_) >> 1) * HALF + (2 * ((st_) & 1) + mm) * 16) * 1024 + col0 + bj * HALF; gv[b_][mm][bj] = __builtin_nontemporal_load((const u32x4*)(G + off_)); if (MODE == 1) pv[b_][mm][bj] = __builtin_nontemporal_load((const u32x4*)(O + off_)); } } while (0)
#define EG_DO(st_, b_) do { _Pragma("unroll") for (int mm = 0; mm < 2; ++mm) _Pragma("unroll") for (int bj = 0; bj < 2; ++bj) { const int ai = (st_) >> 1, m = 2 * ((st_) & 1) + mm; \
            const size_t off_ = (size_t)(row0 + ai * HALF + m * 16) * 1024 + col0 + bj * HALF; const u32x4 g = gv[b_][mm][bj]; \
            f32x4 v0 = acc[ai][bj][m][0], v1 = acc[ai][bj][m][1]; \
            v0[0] *= bf_lo(g.x); v0[1] *= bf_hi(g.x); v0[2] *= bf_lo(g.y); v0[3] *= bf_hi(g.y); v1[0] *= bf_lo(g.z); v1[1] *= bf_hi(g.z); v1[2] *= bf_lo(g.w); v1[3] *= bf_hi(g.w); \
            if (MODE == 1) { const u32x4 p = pv[b_][mm][bj]; \
                v0[0] += bf_lo(p.x); v0[1] += bf_hi(p.x); v0[2] += bf_lo(p.y); v0[3] += bf_hi(p.y); v1[0] += bf_lo(p.z); v1[1] += bf_hi(p.z); v1[2] += bf_lo(p.w); v1[3] += bf_hi(p.w); } \
            u32x4 w; w.x = cvt_pk_bf16(v0[0], v0[1]); w.y = cvt_pk_bf16(v0[2], v0[3]); w.z = cvt_pk_bf16(v1[0], v1[1]); w.w = cvt_pk_bf16(v1[2], v1[3]); \
            *(u32x4*)(O + off_) = w; } } while (0)
        EG_LOAD(0, 0); EG_LOAD(1, 1); EG_DO(0, 0); EG_LOAD(2, 0); EG_DO(1, 1); EG_LOAD(3, 1); EG_DO(2, 0); EG_DO(3, 1);
#undef EG_LOAD
#undef EG_DO
    }
};
struct TwoGemmOrder {
    StaticOrder base; int n1;
    __device__ void init(int M, int N, int G_, int c_) { base.init(M, N, G_, c_); n1 = (base.nwg - c_ + G_ - 1) / G_; if (n1 < 0) n1 = 0; }
    __device__ __forceinline__ bool next(int i, Unit& u) const { if (i >= 2 * n1) return false; const bool second = i >= n1; base.next(second ? i - n1 : i, u); if (second) { u.pm += 128; u.pn += 4; } return true; }
    __device__ __forceinline__ void a_ready(const Unit&) const {}
    __device__ __forceinline__ void done(const Unit&) const {}
};
struct EpiGate2 {
    static constexpr bool PERM = true, AFTER_DRAIN = false; static constexpr int NSTORES = 16;
    const bf16_t* G0; const bf16_t* G1; bf16_t* O;
    __device__ __forceinline__ void operator()(const f32x4 (&acc)[2][2][4][2], const Unit& u, int wr, int wc, int fr, int fq) const {
        Unit v; v.pm = u.pm & 127; v.pn = u.pn & 3;
        if (u.pm >= 128) { EpiGate<1> e{G1, O}; e(acc, v, wr, wc, fr, fq); } else { EpiGate<0> e{G0, O}; e(acc, v, wr, wc, fr, fq); }
    }
};
struct EpiDelta {
    static constexpr bool PERM = true, AFTER_DRAIN = false; static constexpr int NSTORES = 16;
    bf16_t* O;
    __device__ __forceinline__ void operator()(const f32x4 (&acc)[2][2][4][2], const Unit& u, int wr, int wc, int fr, int fq) const {
        const int row0 = u.pm * BM + wr * 64 + fr, col0 = u.pn * BM + wc * 32 + 8 * fq;
#pragma unroll
        for (int ai = 0; ai < 2; ++ai)
#pragma unroll
            for (int m = 0; m < 4; ++m) { bf16_t* rowp = O + (size_t)(row0 + ai * HALF + m * 16) * 1024 + col0;
#pragma unroll
                for (int bj = 0; bj < 2; ++bj) { const f32x4 v0 = acc[ai][bj][m][0], v1 = acc[ai][bj][m][1];
                    u32x4 w; w.x = cvt_pk_bf16(v0[0], v0[1]); w.y = cvt_pk_bf16(v0[2], v0[3]); w.z = cvt_pk_bf16(v1[0], v1[1]); w.w = cvt_pk_bf16(v1[2], v1[3]);
                    *(u32x4*)(rowp + bj * HALF) = w; } }
    }
};
struct EpiSwiGLU {
    static constexpr bool PERM = true, AFTER_DRAIN = false; static constexpr int NSTORES = 8;
    unsigned char* HB;
    __device__ __forceinline__ void operator()(const f32x4 (&acc)[2][2][4][2], const Unit& u, int wr, int wc, int fr, int fq, const PG8_LAS int* rows) const {
        const int row0 = u.pm * BM + wr * 64 + fr, col0 = (u.pn & 3) * HALF + wc * 32 + 8 * fq;
        float sv[2][4];
#pragma unroll
        for (int ai = 0; ai < 2; ++ai)
#pragma unroll
            for (int m = 0; m < 4; ++m) sv[ai][m] = ((const PG8_LAS float*)rows)[6 * 256 + wr * 64 + fr + ai * HALF + m * 16] * (1.0f / W13_SCALE);
#pragma unroll
        for (int ai = 0; ai < 2; ++ai)
#pragma unroll
            for (int m = 0; m < 4; ++m) { const int row = row0 + ai * HALF + m * 16; const float s = sv[ai][m];
                float o[8];
#pragma unroll
                for (int n = 0; n < 2; ++n)
#pragma unroll
                    for (int i = 0; i < 4; ++i) { const float g = acc[ai][0][m][n][i] * s, uu = acc[ai][1][m][n][i] * s; o[n * 4 + i] = g * sigmoid_f(g) * uu * HB_SCALE; }
                unsigned long long w = (unsigned long long)pack4_fp8(o[0], o[1], o[2], o[3]) | ((unsigned long long)pack4_fp8(o[4], o[5], o[6], o[7]) << 32);
                *(unsigned long long*)(HB + (size_t)row * 512 + col0) = w; }
    }
};
constexpr float Y_SCALE = 0.25f;
struct EpiY {
    static constexpr bool PERM = true, AFTER_DRAIN = false; static constexpr int NSTORES = 16;
    unsigned char* Y;
    __device__ __forceinline__ void operator()(const f32x4 (&acc)[2][2][4][2], const Unit& u, int wr, int wc, int fr, int fq) const {
        const int row0 = u.pm * BM + wr * 64 + fr, col0 = (u.pn & 3) * BM + wc * 32 + 8 * fq;
#pragma unroll
        for (int ai = 0; ai < 2; ++ai)
#pragma unroll
            for (int m = 0; m < 4; ++m) { const int row = row0 + ai * HALF + m * 16; unsigned char* rowp = Y + (size_t)row * 1024 + col0;
#pragma unroll
                for (int bj = 0; bj < 2; ++bj) { const f32x4 v0 = acc[ai][bj][m][0] * Y_SCALE, v1 = acc[ai][bj][m][1] * Y_SCALE;
                    *(unsigned long long*)(rowp + bj * HALF) = (unsigned long long)pack4_fp8(v0[0], v0[1], v0[2], v0[3]) | ((unsigned long long)pack4_fp8(v1[0], v1[1], v1[2], v1[3]) << 32); } }
    }
};
struct GroupedOrder {
    const PG8_LAS int* tile_e; int nunits, G, c;
    __device__ __forceinline__ bool next(int i, Unit& u) const { const int L = i * G + c; if (L >= nunits) return false; u.pm = L >> 2; u.pn = __builtin_amdgcn_readfirstlane(tile_e[u.pm]) * 4 + (L & 3); return true; }
    __device__ __forceinline__ void a_ready(const Unit&) const {}
    __device__ __forceinline__ void done(const Unit&) const {}
};
template <class Epi, class Sched, bool ALIGN_EPI = false, bool SP2 = false, bool F8 = false>
__device__ __forceinline__ void gemm_phase(PG8_LAS unsigned char* lds, const Gemm g, const Sched& S, const Epi& E, const int wid) {
    const int lane = lane_now(), tid = wid * 64 + lane, wr = wid >> 2, wc = wid & 3, fr = lane & 15, fq = lane >> 4;
    const int K = g.K, nt = K / BK;
    unsigned voffA[2], voffB[2];
#pragma unroll
    for (int i = 0; i < 2; ++i) { int R, C; stage_rc(tid * 16 + i * 8192, R, C); const int Rb = Epi::PERM ? ((R & ~31) + perm32(R & 31)) : R;
        voffA[i] = (unsigned)(R * K + C) * 2u; voffB[i] = (unsigned)(Rb * K + C) * 2u; }
    const size_t kstep = (size_t)(BK * 2);
    const size_t hstep = (size_t)HALF * K * 2;
    const size_t tstep = 2 * hstep;
    const unsigned ldsw = (unsigned)wid * 1024u;
    const unsigned ldsbase = (unsigned)__builtin_amdgcn_readfirstlane((int)((unsigned)(uintptr_t)lds + ldsw));
    const int aoff = lds_byte(wr * 64 + fr, fq * 8), boff = lds_byte(wc * 32 + fr, fq * 8);
#define PG8_SA(b, h) (((b) * 2 + (h)) * HTB)
#define PG8_SB(b, h) ((4 + (b) * 2 + (h)) * HTB)
#define PG8_STAGE(bufoff, gbase, voff) do { _Pragma("unroll") for (int _i = 0; _i < 2; ++_i) { \
        if constexpr (F8) glds_sv((const char*)(gbase), (voff)[_i], ldsbase + (unsigned)((bufoff) + _i * 8192)); \
        else __builtin_amdgcn_global_load_lds((const unsigned*)((const char*)(gbase) + (voff)[_i]), (PG8_LAS unsigned*)(lds + (bufoff) + ldsw + _i * 8192), 16, 0, 0); } } while (0)
#define PG8_LDA(dst, b, h) do { _Pragma("unroll") for (int m = 0; m < 4; ++m) { \
        if constexpr (F8) { dst##8[m] = cat8(*(const PG8_LAS bf16x8*)(lds + PG8_SA(b, h) + aoff + m * 2048), *(const PG8_LAS bf16x8*)(lds + PG8_SA(b, h) + aoff + m * 2048 + 1024)); } \
        else { _Pragma("unroll") for (int k = 0; k < 2; ++k) dst[m][k] = *(const PG8_LAS bf16x8*)(lds + PG8_SA(b, h) + aoff + m * 2048 + k * 1024); } } } while (0)
#define PG8_LDB(dst, b, h) do { _Pragma("unroll") for (int n = 0; n < 2; ++n) { \
        if constexpr (F8) { dst##8[n] = cat8(*(const PG8_LAS bf16x8*)(lds + PG8_SB(b, h) + boff + n * 2048), *(const PG8_LAS bf16x8*)(lds + PG8_SB(b, h) + boff + n * 2048 + 1024)); } \
        else { _Pragma("unroll") for (int k = 0; k < 2; ++k) dst[n][k] = *(const PG8_LAS bf16x8*)(lds + PG8_SB(b, h) + boff + n * 2048 + k * 1024); } } } while (0)
#define PG8_MMA(ai, bj, At, Bt) do { __builtin_amdgcn_s_setprio(1); _Pragma("unroll") for (int m = 0; m < 4; ++m) _Pragma("unroll") for (int n = 0; n < 2; ++n) { \
        if constexpr (F8) { acc[ai][bj][m][n] = __builtin_amdgcn_mfma_scale_f32_16x16x128_f8f6f4(Bt##8[n], At##8[m], acc[ai][bj][m][n], 0, 0, 0, 0, 0, 0); } \
        else { _Pragma("unroll") for (int k = 0; k < 2; ++k) acc[ai][bj][m][n] = __builtin_amdgcn_mfma_f32_16x16x32_bf16(Bt[n][k], At[m][k], acc[ai][bj][m][n], 0, 0, 0); } } \
        __builtin_amdgcn_s_setprio(0); } while (0)
#define PG8_WAIT_V(n) asm volatile("s_waitcnt vmcnt(" #n ")" ::: "memory")
#define PG8_WAIT_L(n) asm volatile("s_waitcnt lgkmcnt(" #n ")" ::: "memory")
#define PG8_BAR __builtin_amdgcn_s_barrier()
#define PG8_SCHED __builtin_amdgcn_sched_barrier(0)
    Unit cur, nxt; int ui = 0;
    if (!S.next(0, cur)) return;
    f32x4 acc[2][2][4][2];
#pragma unroll
    for (int a = 0; a < 2; ++a)
#pragma unroll
        for (int b = 0; b < 2; ++b)
#pragma unroll
            for (int m = 0; m < 4; ++m)
#pragma unroll
                for (int n = 0; n < 2; ++n) acc[a][b][m][n] = (f32x4){0.f, 0.f, 0.f, 0.f};
    bf16x8 At[4][2], B0[2][2], B1[2][2]; v8i_t At8[4], B08[2], B18[2];
    const char* cA = (const char*)g.A + (size_t)cur.pm * tstep; const char* cB = (const char*)g.Bt + (size_t)cur.pn * tstep;
    S.a_ready(cur);
    if constexpr (SP2) {
        PG8_STAGE(PG8_SB(0, 0), cB, voffB); PG8_STAGE(PG8_SB(0, 1), cB + hstep, voffB); PG8_STAGE(PG8_SA(0, 0), cA, voffA); PG8_STAGE(PG8_SA(0, 1), cA + hstep, voffA);
        if (wr == 1) PG8_BAR;
        PG8_WAIT_V(2); PG8_BAR;
        PG8_STAGE(PG8_SB(1, 0), cB + kstep, voffB); PG8_STAGE(PG8_SA(1, 0), cA + kstep, voffA); PG8_STAGE(PG8_SB(1, 1), cB + hstep + kstep, voffB);
        PG8_WAIT_V(6); PG8_BAR;
    } else {
        PG8_STAGE(PG8_SB(0, 0), cB, voffB); PG8_STAGE(PG8_SA(0, 0), cA, voffA); PG8_STAGE(PG8_SB(0, 1), cB + hstep, voffB); PG8_STAGE(PG8_SA(0, 1), cA + hstep, voffA);
        if (wr == 1) PG8_BAR;
        PG8_WAIT_V(4); PG8_BAR;
        PG8_STAGE(PG8_SB(1, 0), cB + kstep, voffB); PG8_STAGE(PG8_SA(1, 0), cA + kstep, voffA); PG8_STAGE(PG8_SB(1, 1), cB + hstep + kstep, voffB);
        PG8_WAIT_V(6); PG8_BAR;
    }
    for (;;) {
        const bool has_next = S.next(ui + 1, nxt);
        const char* nA = has_next ? (const char*)g.A + (size_t)nxt.pm * tstep : cA; const char* nB = has_next ? (const char*)g.Bt + (size_t)nxt.pn * tstep : cB;
#pragma clang loop unroll(disable)
        for (int t = 0; t < nt; t += 2) {
            const bool last = (t == nt - 2);
            const char* a1 = cA + (size_t)(t + 1) * kstep;
            const char* a2 = last ? nA : cA + (size_t)(t + 2) * kstep; const char* b2 = last ? nB : cB + (size_t)(t + 2) * kstep;
            const char* a3 = a2 + kstep; const char* b3 = b2 + kstep;
            if (last && has_next) S.a_ready(nxt);
            if constexpr (SP2) {
            PG8_LDB(B0, 0, 0); PG8_LDB(B1, 0, 1); PG8_SCHED; PG8_LDA(At, 0, 0); PG8_STAGE(PG8_SA(1, 1), a1 + hstep, voffA);
            PG8_WAIT_V(8); PG8_WAIT_L(0); PG8_BAR; PG8_MMA(0, 0, At, B0); PG8_MMA(0, 1, At, B1); PG8_BAR; PG8_SCHED;
            PG8_LDA(At, 0, 1); PG8_STAGE(PG8_SB(0, 0), b2, voffB); PG8_STAGE(PG8_SB(0, 1), b2 + hstep, voffB); PG8_STAGE(PG8_SA(0, 0), a2, voffA);
            PG8_WAIT_V(8); PG8_WAIT_L(0); PG8_BAR; PG8_MMA(1, 0, At, B0); PG8_MMA(1, 1, At, B1); PG8_BAR; PG8_SCHED;
            PG8_LDB(B0, 1, 0); PG8_LDB(B1, 1, 1); PG8_SCHED; PG8_LDA(At, 1, 0); PG8_STAGE(PG8_SA(0, 1), a2 + hstep, voffA);
            PG8_WAIT_V(8); PG8_WAIT_L(0); PG8_BAR; PG8_MMA(0, 0, At, B0); PG8_MMA(0, 1, At, B1); PG8_BAR; PG8_SCHED;
            PG8_LDA(At, 1, 1); PG8_STAGE(PG8_SB(1, 0), b3, voffB); PG8_STAGE(PG8_SB(1, 1), b3 + hstep, voffB); PG8_STAGE(PG8_SA(1, 0), a3, voffA);
            PG8_WAIT_V(8); PG8_WAIT_L(0); PG8_BAR; PG8_MMA(1, 0, At, B0); PG8_MMA(1, 1, At, B1); PG8_BAR; PG8_SCHED;
            } else {
            PG8_LDB(B0, 0, 0); PG8_SCHED; PG8_LDA(At, 0, 0); PG8_STAGE(PG8_SA(1, 1), a1 + hstep, voffA);
            PG8_WAIT_L(8); PG8_BAR; PG8_WAIT_L(0); PG8_MMA(0, 0, At, B0); PG8_BAR; PG8_SCHED;
            PG8_LDB(B1, 0, 1); PG8_STAGE(PG8_SB(0, 0), b2, voffB);
            PG8_BAR; PG8_WAIT_L(0); PG8_MMA(0, 1, At, B1); PG8_BAR;
            PG8_LDA(At, 0, 1); PG8_STAGE(PG8_SA(0, 0), a2, voffA);
            PG8_BAR; PG8_WAIT_L(0); PG8_MMA(1, 0, At, B0); PG8_BAR; PG8_SCHED;
            PG8_STAGE(PG8_SB(0, 1), b2 + hstep, voffB);
            PG8_WAIT_V(6); PG8_BAR; PG8_MMA(1, 1, At, B1); PG8_BAR;
            PG8_LDB(B0, 1, 0); PG8_SCHED; PG8_LDA(At, 1, 0); PG8_STAGE(PG8_SA(0, 1), a2 + hstep, voffA);
            PG8_WAIT_L(8); PG8_BAR; PG8_WAIT_L(0); PG8_MMA(0, 0, At, B0); PG8_BAR; PG8_SCHED;
            PG8_LDB(B1, 1, 1); PG8_STAGE(PG8_SB(1, 0), b3, voffB);
            PG8_BAR; PG8_WAIT_L(0); PG8_MMA(0, 1, At, B1); PG8_BAR;
            PG8_LDA(At, 1, 1); PG8_STAGE(PG8_SA(1, 0), a3, voffA);
            PG8_BAR; PG8_WAIT_L(0); PG8_MMA(1, 0, At, B0); PG8_BAR; PG8_SCHED;
            PG8_STAGE(PG8_SB(1, 1), b3 + hstep, voffB);
            PG8_WAIT_V(6); PG8_BAR; PG8_MMA(1, 1, At, B1); PG8_BAR;
            }
        }
        if constexpr (ALIGN_EPI) { if (wr == 0) PG8_BAR; }
        if constexpr (!Epi::AFTER_DRAIN) { const int l2 = lane_now(); E(acc, cur, wr, wc, l2 & 15, l2 >> 4); S.done(cur); }
        if (!has_next) break;
#pragma unroll
        for (int a = 0; a < 2; ++a)
#pragma unroll
            for (int b = 0; b < 2; ++b)
#pragma unroll
                for (int m = 0; m < 4; ++m)
#pragma unroll
                    for (int n = 0; n < 2; ++n) acc[a][b][m][n] = (f32x4){0.f, 0.f, 0.f, 0.f};
        cur = nxt; cA = nA; cB = nB; ++ui;
        if constexpr (ALIGN_EPI) { if (wr == 1) PG8_BAR; }
    }
    PG8_WAIT_V(0);
    if constexpr (!ALIGN_EPI) { if (wr == 0) PG8_BAR; }
    PG8_BAR;
    if constexpr (Epi::AFTER_DRAIN) { E.fused(acc, cur, wr, wc, fr, fq, lds, wid, lane); S.done(cur); }
#undef PG8_SA
#undef PG8_SB
#undef PG8_STAGE
#undef PG8_LDA
#undef PG8_LDB
#undef PG8_MMA
#undef PG8_WAIT_V
#undef PG8_WAIT_L
#undef PG8_BAR
#undef PG8_SCHED
}
template <class Epi, class Sched, bool F8 = false>
__device__ __forceinline__ void gemm_phase_gather(PG8_LAS unsigned char* lds, const Gemm g, const Sched& S, const Epi& E, const PG8_LAS int* rowtab, const int wid) {
    constexpr bool ALIGN_EPI = true, SP2 = true;
    const int lane = lane_now(), tid = wid * 64 + lane, wr = wid >> 2, wc = wid & 3, fr = lane & 15, fq = lane >> 4;
    const int K = g.K, nt = K / BK;
    unsigned voffB[2], vAc[2][2];
#pragma unroll
    for (int i = 0; i < 2; ++i) { int R, C; stage_rc(tid * 16 + i * 8192, R, C); const int Rb = Epi::PERM ? ((R & ~31) + perm32(R & 31)) : R;
        voffB[i] = (unsigned)(Rb * K + C) * 2u; }
#define PG8_ROWS(dst, ui_) do { const int t_ = wid * 64 + lane_now(); _Pragma("unroll") for (int i_ = 0; i_ < 2; ++i_) { int R_, C_; stage_rc(t_ * 16 + i_ * 8192, R_, C_); \
        _Pragma("unroll") for (int h_ = 0; h_ < 2; ++h_) dst[h_][i_] = (unsigned)rowtab[(ui_) * 256 + h_ * HALF + R_] * (unsigned)(K * 2) + (unsigned)(C_ * 2); } } while (0)
#define PG8_STAGE_A(bufoff, v, kb) do { _Pragma("unroll") for (int _i = 0; _i < 2; ++_i) { \
        if constexpr (F8) glds_sv((const char*)g.A + (kb), (v)[_i], ldsbase + (unsigned)((bufoff) + _i * 8192)); \
        else __builtin_amdgcn_global_load_lds((const unsigned*)((const char*)g.A + (v)[_i] + (kb)), (PG8_LAS unsigned*)(lds + (bufoff) + ldsw + _i * 8192), 16, 0, 0); } } while (0)
    const size_t kstep = (size_t)(BK * 2);
    const size_t hstep = (size_t)HALF * K * 2;
    const size_t tstep = 2 * hstep;
    const unsigned ldsw = (unsigned)wid * 1024u;
    const unsigned ldsbase = (unsigned)__builtin_amdgcn_readfirstlane((int)((unsigned)(uintptr_t)lds + ldsw));
    const int aoff = lds_byte(wr * 64 + fr, fq * 8), boff = lds_byte(wc * 32 + fr, fq * 8);
#define PG8_SA(b, h) (((b) * 2 + (h)) * HTB)
#define PG8_SB(b, h) ((4 + (b) * 2 + (h)) * HTB)
#define PG8_STAGE(bufoff, gbase, voff) do { _Pragma("unroll") for (int _i = 0; _i < 2; ++_i) { \
        if constexpr (F8) glds_sv((const char*)(gbase), (voff)[_i], ldsbase + (unsigned)((bufoff) + _i * 8192)); \
        else __builtin_amdgcn_global_load_lds((const unsigned*)((const char*)(gbase) + (voff)[_i]), (PG8_LAS unsigned*)(lds + (bufoff) + ldsw + _i * 8192), 16, 0, 0); } } while (0)
#define PG8_LDA(dst, b, h) do { _Pragma("unroll") for (int m = 0; m < 4; ++m) { \
        if constexpr (F8) { dst##8[m] = cat8(*(const PG8_LAS bf16x8*)(lds + PG8_SA(b, h) + aoff + m * 2048), *(const PG8_LAS bf16x8*)(lds + PG8_SA(b, h) + aoff + m * 2048 + 1024)); } \
        else { _Pragma("unroll") for (int k = 0; k < 2; ++k) dst[m][k] = *(const PG8_LAS bf16x8*)(lds + PG8_SA(b, h) + aoff + m * 2048 + k * 1024); } } } while (0)
#define PG8_LDB(dst, b, h) do { _Pragma("unroll") for (int n = 0; n < 2; ++n) { \
        if constexpr (F8) { dst##8[n] = cat8(*(const PG8_LAS bf16x8*)(lds + PG8_SB(b, h) + boff + n * 2048), *(const PG8_LAS bf16x8*)(lds + PG8_SB(b, h) + boff + n * 2048 + 1024)); } \
        else { _Pragma("unroll") for (int k = 0; k < 2; ++k) dst[n][k] = *(const PG8_LAS bf16x8*)(lds + PG8_SB(b, h) + boff + n * 2048 + k * 1024); } } } while (0)
#define PG8_MMA(ai, bj, At, Bt) do { __builtin_amdgcn_s_setprio(1); _Pragma("unroll") for (int m = 0; m < 4; ++m) _Pragma("unroll") for (int n = 0; n < 2; ++n) { \
        if constexpr (F8) { acc[ai][bj][m][n] = __builtin_amdgcn_mfma_scale_f32_16x16x128_f8f6f4(Bt##8[n], At##8[m], acc[ai][bj][m][n], 0, 0, 0, 0, 0, 0); } \
        else { _Pragma("unroll") for (int k = 0; k < 2; ++k) acc[ai][bj][m][n] = __builtin_amdgcn_mfma_f32_16x16x32_bf16(Bt[n][k], At[m][k], acc[ai][bj][m][n], 0, 0, 0); } } \
        __builtin_amdgcn_s_setprio(0); } while (0)
#define PG8_WAIT_V(n) asm volatile("s_waitcnt vmcnt(" #n ")" ::: "memory")
#define PG8_WAIT_L(n) asm volatile("s_waitcnt lgkmcnt(" #n ")" ::: "memory")
#define PG8_BAR __builtin_amdgcn_s_barrier()
#define PG8_SCHED __builtin_amdgcn_sched_barrier(0)
    Unit cur, nxt; int ui = 0;
    if (!S.next(0, cur)) return;
    f32x4 acc[2][2][4][2];
#pragma unroll
    for (int a = 0; a < 2; ++a)
#pragma unroll
        for (int b = 0; b < 2; ++b)
#pragma unroll
            for (int m = 0; m < 4; ++m)
#pragma unroll
                for (int n = 0; n < 2; ++n) acc[a][b][m][n] = (f32x4){0.f, 0.f, 0.f, 0.f};
    bf16x8 At[4][2], B0[2][2], B1[2][2]; v8i_t At8[4], B08[2], B18[2];
    const char* cB = (const char*)g.Bt + (size_t)cur.pn * tstep;
    PG8_ROWS(vAc, 0);
    S.a_ready(cur);
    if constexpr (SP2) {
        PG8_STAGE(PG8_SB(0, 0), cB, voffB); PG8_STAGE(PG8_SB(0, 1), cB + hstep, voffB); PG8_STAGE_A(PG8_SA(0, 0), vAc[0], 0u); PG8_STAGE_A(PG8_SA(0, 1), vAc[1], 0u);
        if (wr == 1) PG8_BAR;
        PG8_WAIT_V(2); PG8_BAR;
        PG8_STAGE(PG8_SB(1, 0), cB + kstep, voffB); PG8_STAGE_A(PG8_SA(1, 0), vAc[0], (unsigned)kstep); PG8_STAGE(PG8_SB(1, 1), cB + hstep + kstep, voffB);
        PG8_WAIT_V(6); PG8_BAR;
    }
    for (;;) {
        const bool has_next = S.next(ui + 1, nxt);
        const char* nB = has_next ? (const char*)g.Bt + (size_t)nxt.pn * tstep : cB;
#pragma clang loop unroll(disable)
        for (int t = 0; t < nt; t += 2) {
            const bool last = (t == nt - 2);
            const unsigned k1 = (unsigned)((t + 1) * (int)kstep), k2 = last ? 0u : (unsigned)((t + 2) * (int)kstep), k3 = k2 + (unsigned)kstep;
            unsigned v2[2][2];
            if (last && has_next) { PG8_ROWS(v2, ui + 1); }
            else {
#pragma unroll
                for (int h_ = 0; h_ < 2; ++h_)
#pragma unroll
                    for (int i_ = 0; i_ < 2; ++i_) v2[h_][i_] = vAc[h_][i_]; }
            const char* b2 = last ? nB : cB + (size_t)(t + 2) * kstep; const char* b3 = b2 + kstep;
            if (last && has_next) S.a_ready(nxt);
            if constexpr (SP2) {
            PG8_LDB(B0, 0, 0); PG8_LDB(B1, 0, 1); PG8_SCHED; PG8_LDA(At, 0, 0); PG8_STAGE_A(PG8_SA(1, 1), vAc[1], k1);
            PG8_WAIT_V(8); PG8_WAIT_L(0); PG8_BAR; PG8_MMA(0, 0, At, B0); PG8_MMA(0, 1, At, B1); PG8_BAR; PG8_SCHED;
            PG8_LDA(At, 0, 1); PG8_STAGE(PG8_SB(0, 0), b2, voffB); PG8_STAGE(PG8_SB(0, 1), b2 + hstep, voffB); PG8_STAGE_A(PG8_SA(0, 0), v2[0], k2);
            PG8_WAIT_V(8); PG8_WAIT_L(0); PG8_BAR; PG8_MMA(1, 0, At, B0); PG8_MMA(1, 1, At, B1); PG8_BAR; PG8_SCHED;
            PG8_LDB(B0, 1, 0); PG8_LDB(B1, 1, 1); PG8_SCHED; PG8_LDA(At, 1, 0); PG8_STAGE_A(PG8_SA(0, 1), v2[1], k2);
            PG8_WAIT_V(8); PG8_WAIT_L(0); PG8_BAR; PG8_MMA(0, 0, At, B0); PG8_MMA(0, 1, At, B1); PG8_BAR; PG8_SCHED;
            PG8_LDA(At, 1, 1); PG8_STAGE(PG8_SB(1, 0), b3, voffB); PG8_STAGE(PG8_SB(1, 1), b3 + hstep, voffB); PG8_STAGE_A(PG8_SA(1, 0), v2[0], k3);
            PG8_WAIT_V(8); PG8_WAIT_L(0); PG8_BAR; PG8_MMA(1, 0, At, B0); PG8_MMA(1, 1, At, B1); PG8_BAR; PG8_SCHED;
            }
        }
        if constexpr (ALIGN_EPI) { if (wr == 0) PG8_BAR; }
        { const int l2 = lane_now(); E(acc, cur, wr, wc, l2 & 15, l2 >> 4, rowtab + ui * 256); } S.done(cur);
        if (!has_next) break;
#pragma unroll
        for (int a = 0; a < 2; ++a)
#pragma unroll
            for (int b = 0; b < 2; ++b)
#pragma unroll
                for (int m = 0; m < 4; ++m)
#pragma unroll
                    for (int n = 0; n < 2; ++n) acc[a][b][m][n] = (f32x4){0.f, 0.f, 0.f, 0.f};
        cur = nxt; cB = nB; ++ui;
        PG8_ROWS(vAc, ui);
        if constexpr (ALIGN_EPI) { if (wr == 1) PG8_BAR; }
    }
    PG8_WAIT_V(0);
    if constexpr (!ALIGN_EPI) { if (wr == 0) PG8_BAR; }
    PG8_BAR;
#undef PG8_ROWS
#undef PG8_STAGE_A
#undef PG8_SA
#undef PG8_SB
#undef PG8_STAGE
#undef PG8_LDA
#undef PG8_LDB
#undef PG8_MMA
#undef PG8_WAIT_V
#undef PG8_WAIT_L
#undef PG8_BAR
#undef PG8_SCHED
}
}
#define GAS __attribute__((address_space(1)))
#define LAS __attribute__((address_space(3)))
typedef unsigned short bf16;
typedef unsigned v4u __attribute__((ext_vector_type(4)));
typedef float f32x4 __attribute__((ext_vector_type(4)));
typedef short bf16x8 __attribute__((ext_vector_type(8)));
typedef GAS unsigned gu32;
typedef GAS unsigned long long gu64;
#define RLX_AGENT __ATOMIC_RELAXED, __HIP_MEMORY_SCOPE_AGENT
#define LDS_WAIT() asm volatile("s_waitcnt lgkmcnt(0)" ::: "memory")
#define VM_WAIT() asm volatile("s_waitcnt vmcnt(0)" ::: "memory")
__device__ __forceinline__ unsigned long long rt() { return __builtin_amdgcn_s_memrealtime(); }
__device__ __forceinline__ unsigned f2bf(float f) { unsigned u = __builtin_bit_cast(unsigned, f); return (u + 0x7fffu + ((u >> 16) & 1u)) >> 16; }
__device__ __forceinline__ unsigned pk2(float lo, float hi) { return f2bf(lo) | (f2bf(hi) << 16); }
#define XB_TMO      128
#define XB_XCNT(j)  (256  + 64 * (j))
#define XB_XSUB(j)  (1280 + 64 * (j))
#define XB_XGEN(j)  (2304 + 64 * (j))
#define XB_TOP      3328
#define XB_TOPGEN   3392
#define XCD_BAR_WORDS 3456
#define XB_SPIN_CAP (1u << 18)

__device__ __forceinline__ unsigned xb_ld(unsigned* p)              { return __hip_atomic_load(p, __ATOMIC_RELAXED, __HIP_MEMORY_SCOPE_AGENT); }
__device__ __forceinline__ unsigned xb_add(unsigned* p, unsigned v) { return __hip_atomic_fetch_add(p, v, __ATOMIC_RELAXED, __HIP_MEMORY_SCOPE_AGENT); }
__device__ __forceinline__ unsigned xb_xcc_id() { return (unsigned)__builtin_amdgcn_s_getreg((3 << 11) | 20) & 0xFu; }
#define XB_SPIN(cond, bar) do { unsigned _sp = 0; while (cond) { __builtin_amdgcn_s_sleep(1); \
    if ((++_sp & 255u) == 0u) { if (xb_ld(&(bar)[XB_TMO])) break; if (_sp > XB_SPIN_CAP) { atomicAdd(&(bar)[XB_TMO], 1u); break; } } } } while (0)

struct XcdBarrier {
    unsigned* bar; unsigned x;
    volatile LAS unsigned* st;
};

__device__ __forceinline__ XcdBarrier xcd_barrier_post(unsigned* bar, volatile LAS unsigned* st) {
    XcdBarrier b; b.bar = bar; b.x = xb_xcc_id(); b.st = st;
    if (threadIdx.x == 0) (void)xb_add(&bar[XB_XCNT(b.x)], 1u);
    return b;
}
__device__ __forceinline__ void xcd_barrier_complete(unsigned* bar, unsigned x, unsigned& nloc, unsigned& nx) {
    const unsigned G = gridDim.x * gridDim.y * gridDim.z;
    unsigned sum, cnt, mine, sp = 0u;
    for (;;) {
        sum = 0u; cnt = 0u; mine = 0u;
#pragma unroll
        for (unsigned j = 0; j < 16; ++j) { const unsigned c = xb_ld(&bar[XB_XCNT(j)]); sum += c; cnt += (c > 0u) ? 1u : 0u; mine = (j == x) ? c : mine; }
        if (sum == G) break;
        __builtin_amdgcn_s_sleep(1);
        if ((++sp & 255u) == 0u) { if (xb_ld(&bar[XB_TMO])) break; if (sp > XB_SPIN_CAP) { atomicAdd(&bar[XB_TMO], 1u); break; } }
    }
    nloc = mine > 0u ? mine : 1u; nx = cnt > 0u ? cnt : 1u;
}

__device__ __forceinline__ void xcd_barrier(const XcdBarrier& b) {
    asm volatile("s_waitcnt vmcnt(0)" ::: "memory");
    __syncthreads();
    if (threadIdx.x == 0) {
        unsigned* bar = b.bar;
        __builtin_amdgcn_s_waitcnt(0);
        unsigned nloc = b.st[0], nx = b.st[1];
        if (nloc == 0u) { xcd_barrier_complete(bar, b.x, nloc, nx); b.st[0] = nloc; b.st[1] = nx; }
        const unsigned old = xb_add(&bar[XB_XSUB(b.x)], 1u);
        const unsigned gen = old / nloc;
        if (old + 1u == (gen + 1u) * nloc) {
            __builtin_amdgcn_fence(__ATOMIC_RELEASE, "agent");
            asm volatile("s_waitcnt vmcnt(0)" ::: "memory");
            const unsigned og = xb_add(&bar[XB_TOP], 1u);
            const unsigned tg = og / nx;
            if (og + 1u == (tg + 1u) * nx) xb_add(&bar[XB_TOPGEN], 1u);
            else XB_SPIN(xb_ld(&bar[XB_TOPGEN]) == tg, bar);
            __builtin_amdgcn_fence(__ATOMIC_ACQUIRE, "agent");
            xb_add(&bar[XB_XGEN(b.x)], 1u);
            asm volatile("s_waitcnt vmcnt(0)" ::: "memory");
        } else {
            XB_SPIN(xb_ld(&bar[XB_XGEN(b.x)]) == gen, bar);
            __builtin_amdgcn_fence(__ATOMIC_ACQUIRE, "agent");
            asm volatile("s_waitcnt vmcnt(0)" ::: "memory");
        }
    }
    __syncthreads();
}
namespace fattn {
typedef unsigned short bf16;
typedef short bf16x8 __attribute__((ext_vector_type(8)));
typedef short s16x4 __attribute__((ext_vector_type(4)));
typedef float f32x16 __attribute__((ext_vector_type(16)));
typedef float f32x4 __attribute__((ext_vector_type(4)));
typedef unsigned u32x4 __attribute__((ext_vector_type(4)));
constexpr int D = 128, LD = 128, LDO = 1024, SEQ = 4096;
constexpr float THR = 8.f;
constexpr float SCALE = 0.08838834764831845f;
constexpr int NW = 8, QBLK = 32, KVBLK = 64, QB = NW * QBLK;
constexpr int SHM_V = KVBLK * D * 2, SHM_K = KVBLK * D * 2;
constexpr int OFF_WS = 2 * SHM_V + 2 * SHM_K, OFF_BIAS = OFF_WS + NW * 64 * 4, LDS_BYTES = OFF_BIAS + 2 * 64 * 4;

#define KSWZ(row, colB) ((row) * 256 + ((colB) ^ (((row) & 7) << 4)))
#define SBAR() __builtin_amdgcn_sched_barrier(0)
__device__ __forceinline__ int v_st(int k, int c) { const int kk = (k & ~0xC) | ((k & 4) << 1) | ((k & 8) >> 1); return ((kk >> 3) * 4 + (c >> 5)) * 512 + ((kk & 7) * 32 + (c & 31)) * 2; }
__device__ __forceinline__ int v_rd_base(int lane) { return ((lane & 3) << 3) | (((lane >> 2) & 3) << 6) | (((lane >> 4) & 1) << 5) | (((lane >> 5) & 1) << 8); }
constexpr int v_rd_off(int d0, int ks, int half) { return d0 * 512 + ks * 4096 + half * 2048; }
__device__ __forceinline__ int crow(int r, int hi) { return (r & 3) + 8 * (r >> 2) + 4 * hi; }
__device__ __forceinline__ unsigned cvtpk(float lo, float hi) { unsigned r; asm volatile("v_cvt_pk_bf16_f32 %0, %1, %2" : "=v"(r) : "v"(lo), "v"(hi)); return r; }
__device__ __forceinline__ bf16x8 load8(const bf16* p) { return *reinterpret_cast<const bf16x8*>(p); }
__device__ __forceinline__ void mask_tile(f32x16& p0, f32x16& p1, int dq) {
    const float NEG = -__builtin_inff();
#pragma unroll
    for (int r = 0; r < 16; ++r) {
        const int c = (r & 3) + 8 * (r >> 2);
        if (dq - c < 0) p0[r] = NEG;
        if (dq - c - 32 < 0) p1[r] = NEG;
    }
}
__device__ __forceinline__ void partialSM(f32x16& p0, f32x16& p1, float& m_reg, float& mn, float& alpha) {
    float pmax = p0[0]; for (int r = 1; r < 16; ++r) pmax = fmaxf(pmax, p0[r]); for (int r = 0; r < 16; ++r) pmax = fmaxf(pmax, p1[r]);
    { auto rr = __builtin_amdgcn_permlane32_swap(__float_as_uint(pmax), __float_as_uint(pmax), false, false);
      pmax = fmaxf(__uint_as_float(rr[0]), __uint_as_float(rr[1])); }
    constexpr float C2 = 1.4426950408889634f * SCALE;
    if (__builtin_expect(__all((pmax - m_reg) * SCALE <= THR), 1)) { mn = m_reg; alpha = 1.f; }
    else { mn = fmaxf(m_reg, pmax); alpha = __builtin_amdgcn_exp2f((m_reg - mn) * C2); m_reg = mn; }
    const float mnL = -mn * C2;
    for (int r = 0; r < 16; ++r) p0[r] = fmaf(p0[r], C2, mnL); for (int r = 0; r < 16; ++r) p1[r] = fmaf(p1[r], C2, mnL);
    for (int r = 0; r < 16; ++r) p0[r] = __builtin_amdgcn_exp2f(p0[r]);
}
__device__ __forceinline__ void finishSM(f32x16& p0, f32x16& p1, float alpha, float& l_reg, bf16x8& pa0, bf16x8& pa1, bf16x8& pa2, bf16x8& pa3) {
    for (int r = 0; r < 16; ++r) p1[r] = __builtin_amdgcn_exp2f(p1[r]);
    float ps = 0; for (int r = 0; r < 16; ++r) ps += p0[r]; for (int r = 0; r < 16; ++r) ps += p1[r];
    { auto rr = __builtin_amdgcn_permlane32_swap(__float_as_uint(ps), __float_as_uint(ps), false, false);
      ps = __uint_as_float(rr[0]) + __uint_as_float(rr[1]); }
    l_reg = l_reg * alpha + ps;
#define PK4(P, B_, OUT) do { unsigned a0 = cvtpk(P[B_+0], P[B_+1]), a1 = cvtpk(P[B_+2], P[B_+3]);                          \
        unsigned b0 = cvtpk(P[B_+4], P[B_+5]), b1 = cvtpk(P[B_+6], P[B_+7]);                                             \
        auto r0 = __builtin_amdgcn_permlane32_swap(a0, b0, false, false); auto r1 = __builtin_amdgcn_permlane32_swap(a1, b1, false, false); \
        u32x4 w = {r0[0], r1[0], r0[1], r1[1]}; OUT = *reinterpret_cast<bf16x8*>(&w); } while (0)
    PK4(p0, 0, pa0); PK4(p0, 8, pa1); PK4(p1, 0, pa2); PK4(p1, 8, pa3);
#undef PK4
}
template <int KB>
__device__ __forceinline__ void qkt(f32x16& p0, f32x16& p1, const char* K_lds, const char* Bias_lds, int r32, int hi, const bf16x8* qr) {
    { const f32x4* bb = reinterpret_cast<const f32x4*>(Bias_lds + KB * 256 + hi * 16);
      const f32x4 a0 = bb[0], a1 = bb[2], a2 = bb[4], a3 = bb[6], c0 = bb[8], c1 = bb[10], c2 = bb[12], c3 = bb[14];
      p0 = (f32x16){a0[0], a0[1], a0[2], a0[3], a1[0], a1[1], a1[2], a1[3], a2[0], a2[1], a2[2], a2[3], a3[0], a3[1], a3[2], a3[3]};
      p1 = (f32x16){c0[0], c0[1], c0[2], c0[3], c1[0], c1[1], c1[2], c1[3], c2[0], c2[1], c2[2], c2[3], c3[0], c3[1], c3[2], c3[3]}; }
    const char* kb[4];
#pragma unroll
    for (int dd = 0; dd < 4; ++dd) kb[dd] = K_lds + KB * SHM_K + KSWZ(r32, (dd * 16 + hi * 8) * 2);
#pragma unroll
    for (int d0 = 0; d0 < 8; ++d0) { const char* a = kb[d0 & 3] + (d0 >> 2) * 128;
        bf16x8 b0 = *reinterpret_cast<const bf16x8*>(a);
        bf16x8 b1 = *reinterpret_cast<const bf16x8*>(a + 32 * 256);
        p0 = __builtin_amdgcn_mfma_f32_32x32x16_bf16(b0, qr[d0], p0, 0, 0, 0);
        p1 = __builtin_amdgcn_mfma_f32_32x32x16_bf16(b1, qr[d0], p1, 0, 0, 0); }
}
template <int VB>
__device__ __forceinline__ void pv_tile(f32x16* o, int vb0, bf16x8 pa0, bf16x8 pa1, bf16x8 pa2, bf16x8 pa3) {
#define TRRD(dst, off) asm volatile("ds_read_b64_tr_b16 %0, %1 offset:%2" : "=&v"(dst) : "v"(vb0), "i"(off) : "memory")
#define PV_D0(d0) do { s16x4 l0, l1, l2, l3, h0, h1, h2, h3; constexpr int b_ = VB * SHM_V + v_rd_off(d0, 0, 0);   \
        TRRD(l0, b_); TRRD(h0, b_ + 2048); TRRD(l1, b_ + 4096); TRRD(h1, b_ + 6144); TRRD(l2, b_ + 8192); TRRD(h2, b_ + 10240); TRRD(l3, b_ + 12288); TRRD(h3, b_ + 14336); \
        asm volatile("s_waitcnt lgkmcnt(0)" ::: "memory"); SBAR();                                                    \
        o[d0] = __builtin_amdgcn_mfma_f32_32x32x16_bf16(pa0, (bf16x8){l0[0], l0[1], l0[2], l0[3], h0[0], h0[1], h0[2], h0[3]}, o[d0], 0, 0, 0);   \
        o[d0] = __builtin_amdgcn_mfma_f32_32x32x16_bf16(pa1, (bf16x8){l1[0], l1[1], l1[2], l1[3], h1[0], h1[1], h1[2], h1[3]}, o[d0], 0, 0, 0);   \
        o[d0] = __builtin_amdgcn_mfma_f32_32x32x16_bf16(pa2, (bf16x8){l2[0], l2[1], l2[2], l2[3], h2[0], h2[1], h2[2], h2[3]}, o[d0], 0, 0, 0);   \
        o[d0] = __builtin_amdgcn_mfma_f32_32x32x16_bf16(pa3, (bf16x8){l3[0], l3[1], l3[2], l3[3], h3[0], h3[1], h3[2], h3[3]}, o[d0], 0, 0, 0); } while (0)
    PV_D0(0); PV_D0(1); PV_D0(2); PV_D0(3);
#undef PV_D0
#undef TRRD
}

struct Bases { const bf16* Q; bf16* O; const bf16* K; const bf16* V; const float* CB; };
struct BlockRef { unsigned qo, oo, kvo, cbo; int P0, jlo; };
struct Seam { bf16x8 qr[8]; };
#define VMW() asm volatile("s_waitcnt vmcnt(0)" ::: "memory")
#define VMWN(n) asm volatile("s_waitcnt vmcnt(%0)" :: "i"(n) : "memory")
#define LBAR() do { asm volatile("s_waitcnt lgkmcnt(0)" ::: "memory"); __builtin_amdgcn_s_barrier(); asm volatile("" ::: "memory"); } while (0)
#define ATT_SRC() \
    unsigned ksrc0, ksrc1, vsrc0, vsrc1; \
    { const int rw0 = 8 * wid + (lane >> 4), rw1 = rw0 + 4, p_ = lane & 15; ksrc0 = (unsigned)(rw0 * 256 + ((p_ ^ (rw0 & 7)) << 4)); ksrc1 = (unsigned)(rw1 * 256 + ((p_ ^ (rw1 & 7)) << 4)); \
      const int L0 = 128 * wid + lane, L1 = L0 + 64; \
      const int kk0 = ((L0 >> 7) << 3) | ((L0 >> 2) & 7), kk1 = ((L1 >> 7) << 3) | ((L1 >> 2) & 7); \
      const int k0_ = (kk0 & ~0xC) | ((kk0 & 4) << 1) | ((kk0 & 8) >> 1), k1_ = (kk1 & ~0xC) | ((kk1 & 4) << 1) | ((kk1 & 8) >> 1); \
      vsrc0 = (unsigned)(k0_ * 256 + ((((L0 >> 5) & 3) * 4 + (L0 & 3)) << 4)); vsrc1 = (unsigned)(k1_ * 256 + ((((L1 >> 5) & 3) * 4 + (L1 & 3)) << 4)); }
#define DMA_K(Kp, CBp, k0, bf) do { const char* kp_ = (const char*)(Kp) + (unsigned)(k0) * 256u; \
        __builtin_amdgcn_global_load_lds((const unsigned*)(kp_ + ksrc0), (LAS unsigned*)(ldsa + 2 * SHM_V + (bf) * SHM_K + (2 * wid) * 1024), 16, 0, 0); \
        __builtin_amdgcn_global_load_lds((const unsigned*)(kp_ + ksrc1), (LAS unsigned*)(ldsa + 2 * SHM_V + (bf) * SHM_K + (2 * wid + 1) * 1024), 16, 0, 0); \
        if (wid == 0) __builtin_amdgcn_global_load_lds((const unsigned*)((CBp) + (unsigned)((k0) + lane)), (LAS unsigned*)(ldsa + OFF_BIAS + (bf) * 256), 4, 0, 0); } while (0)
#define DMA_V(Vp, k0, bf) do { const char* vp_ = (const char*)(Vp) + (unsigned)(k0) * 256u; \
        __builtin_amdgcn_global_load_lds((const unsigned*)(vp_ + vsrc0), (LAS unsigned*)(ldsa + (bf) * SHM_V + (2 * wid) * 1024), 16, 0, 0); \
        __builtin_amdgcn_global_load_lds((const unsigned*)(vp_ + vsrc1), (LAS unsigned*)(ldsa + (bf) * SHM_V + (2 * wid + 1) * 1024), 16, 0, 0); } while (0)
__device__ __forceinline__ void prime(const Bases& G, const BlockRef& cur, char* lds, LAS unsigned char* ldsa, Seam& S) {
    const int tid = threadIdx.x, wid = __builtin_amdgcn_readfirstlane(tid >> 6), lane = tid & 63, r32 = lane & 31, hi = lane >> 5;
    ATT_SRC();
    for (int d0 = 0; d0 < 8; ++d0) S.qr[d0] = load8(G.Q + (cur.qo + (unsigned)((wid * QBLK + r32) * LD + d0 * 16 + hi * 8)));
    DMA_K(G.K + cur.kvo, G.CB + cur.cbo, cur.jlo * KVBLK, 0); DMA_V(G.V + cur.kvo, cur.jlo * KVBLK, 0);
    VMW(); LBAR();
}
__device__ __forceinline__ void block(const Bases& G, const BlockRef& cur, const BlockRef& nxt, char* lds, LAS unsigned char* ldsa, Seam& S) {
    const int tid = threadIdx.x, wid = __builtin_amdgcn_readfirstlane(tid >> 6), lane = tid & 63, r32 = lane & 31, hi = lane >> 5;
    const int j_lo = cur.jlo, NT = (cur.P0 + QB - 1) / KVBLK + 1 - j_lo;
    const int qlo = cur.P0 + wid * QBLK, qm = qlo + r32 - 4 * hi;
    char* V_lds = lds; char* K_lds = lds + 2 * SHM_V; char* B_lds = lds + OFF_BIAS;
    float* ws = (float*)(lds + OFF_WS) + wid * 64; float* li_l = ws, * al_l = ws + 32;
    float m_reg = G.CB[cur.cbo + (unsigned)(cur.P0 + wid * QBLK + r32)], l_reg = 0; f32x16 o[4] = {};
    const int vb0 = (int)(uintptr_t)V_lds + v_rd_base(lane);
    const bf16* Kh = G.K + cur.kvo; const bf16* Vh = G.V + cur.kvo; const float* CBh = G.CB + cur.cbo;
    ATT_SRC();
#define RESC(a) do { if (__any((a) < 1.f)) { if (hi == 0) al_l[r32] = (a); asm volatile("s_waitcnt lgkmcnt(0)" ::: "memory");              \
                     for (int d_ = 0; d_ < 4; ++d_) for (int r = 0; r < 16; ++r) o[d_][r] *= al_l[crow(r, hi)]; } } while (0)
#define KBASE(t) ((j_lo + (t)) * KVBLK)
#define MASKT(P0_, P1_, t) do { const int kb_ = KBASE(t); if (kb_ + KVBLK - 1 > qlo) mask_tile(P0_, P1_, qm - kb_); } while (0)
    f32x16 pA0, pA1, pB0, pB1; float mnA, mnB, alA, alB; bf16x8 pa0, pa1, pa2, pa3;
    DMA_K(Kh, CBh, KBASE(1), 1); DMA_V(Vh, KBASE(1), 1);
    SBAR(); qkt<0>(pA0, pA1, K_lds, B_lds, r32, hi, S.qr);
    MASKT(pA0, pA1, 0); partialSM(pA0, pA1, m_reg, mnA, alA);
    VMW(); LBAR();
#define HALF_STEP(PX0, PX1, mnX, alX, PY0, PY1, alY, t, KB, VB, SB) do {                                                      \
        SBAR(); if ((t) + 1 < NT) { DMA_K(Kh, CBh, KBASE((t) + 1), SB); SBAR(); }                                            \
        qkt<KB>(PX0, PX1, K_lds, B_lds, r32, hi, S.qr);                                                                        \
        finishSM(PY0, PY1, alY, l_reg, pa0, pa1, pa2, pa3); SBAR();                                                           \
        pv_tile<VB>(o, vb0, pa0, pa1, pa2, pa3); MASKT(PX0, PX1, (t)); partialSM(PX0, PX1, m_reg, mnX, alX);                   \
        LBAR();                                                                                                               \
        if ((t) + 1 < NT) { DMA_V(Vh, KBASE((t) + 1), SB); }                                                                  \
        RESC(alX); VMWN(2); LBAR(); } while (0)
    for (int t = 1; t + 1 < NT; t += 2) {
        HALF_STEP(pB0, pB1, mnB, alB, pA0, pA1, alA, t, 1, 0, 0);
        HALF_STEP(pA0, pA1, mnA, alA, pB0, pB1, alB, t + 1, 0, 1, 1);
    }
    SBAR(); qkt<1>(pB0, pB1, K_lds, B_lds, r32, hi, S.qr); SBAR();
    DMA_K(G.K + nxt.kvo, G.CB + nxt.cbo, nxt.jlo * KVBLK, 0); SBAR();
#pragma unroll
    for (int d0 = 0; d0 < 8; ++d0) S.qr[d0] = load8(G.Q + (nxt.qo + (unsigned)((wid * QBLK + r32) * LD + d0 * 16 + hi * 8)));
    SBAR();
    finishSM(pA0, pA1, alA, l_reg, pa0, pa1, pa2, pa3); SBAR();
    pv_tile<0>(o, vb0, pa0, pa1, pa2, pa3);
    MASKT(pB0, pB1, NT - 1); partialSM(pB0, pB1, m_reg, mnB, alB);
    VMWN(10); LBAR();
    DMA_V(G.V + nxt.kvo, nxt.jlo * KVBLK, 0);
    RESC(alB);
    finishSM(pB0, pB1, alB, l_reg, pa0, pa1, pa2, pa3); SBAR(); pv_tile<1>(o, vb0, pa0, pa1, pa2, pa3);
    SBAR();
    if (hi == 0) li_l[r32] = l_reg; asm volatile("s_waitcnt lgkmcnt(0)" ::: "memory");
    float rli[16];
#pragma unroll
    for (int r = 0; r < 16; ++r) rli[r] = __builtin_amdgcn_rcpf(li_l[crow(r, hi)]);
    bf16* Ow = G.O + (cur.oo + (unsigned)(wid * QBLK * LDO));
#pragma unroll
    for (int r = 0; r < 16; ++r) { const int orow = crow(r, hi);
#pragma unroll
        for (int d0 = 0; d0 < 4; ++d0) { const float v = o[d0][r] * rli[r];
            const float vn = __shfl_xor(v, 1);
            if ((r32 & 1) == 0) *(unsigned*)(Ow + (unsigned)(orow * LDO + d0 * 32 + r32)) = cvtpk(v, vn); } }
    VMW(); LBAR();
#undef RESC
#undef KBASE
#undef MASKT
#undef HALF_STEP
}
#undef VMW
#undef VMWN
#undef LBAR
#undef ATT_SRC
#undef DMA_K
#undef DMA_V
#undef KSWZ
#undef SBAR
}
constexpr int NB = 8, SEQ = 4096, T = NB * SEQ, DM = 1024, NH = 8, HD = 128, INW = 7176, NZ = 7168;
constexpr int NE = 32, DE = 512;
constexpr float EPS = 1e-6f;
constexpr int PMAX = 73728;
constexpr int NWAVES = 8;
constexpr size_t MiB = 1u << 20;
constexpr size_t WS_CTL = 0, CTL_ZERO_BYTES = 64 * 1024;
constexpr size_t WS_RS1 = 1 * MiB, WS_RS2 = 1 * MiB + 256 * 1024;
constexpr size_t WS_LF = 1 * MiB + 512 * 1024;
constexpr size_t WS_CB = 2 * MiB + 512 * 1024;
constexpr size_t WS_TOK = 3 * MiB + 512 * 1024;
constexpr size_t WS_LISTS = 5 * MiB;
constexpr size_t WS_WRT = 9 * MiB;
constexpr size_t WS_SRS = 9 * MiB + 512 * 1024, WS_SW = 10 * MiB;
constexpr size_t WS_WIN = 16 * MiB;
constexpr size_t WS_WA = 30 * MiB, WS_WL = 32 * MiB, WS_WO = 34 * MiB;
constexpr size_t WS_WRG = 36 * MiB;
constexpr size_t WS_XB = 40 * MiB;
constexpr size_t WS_XR = 104 * MiB;
constexpr size_t WS_GG = 168 * MiB;
constexpr size_t WS_Q = 232 * MiB, WS_K = 296 * MiB, WS_V = 360 * MiB;
constexpr size_t WS_W13 = 424 * MiB;
constexpr size_t WS_W2 = 392 * MiB;
constexpr size_t WS_XG = 168 * MiB;
constexpr size_t WS_HB = 296 * MiB;
constexpr size_t WS_WIN8 = 37 * MiB;
constexpr size_t WS_X8P = 456 * MiB;
constexpr size_t WS_END = 512 * MiB;
static_assert(WS_XG + (size_t)PMAX * 1024 <= WS_K && WS_HB + (size_t)PMAX * 1024 <= WS_W2 && WS_W2 + 32u * 1024 * 512 * 2 <= WS_W13 && WS_W13 + 64 * MiB <= WS_END, "d_ws map");
constexpr int CW_TMO = 0, CW_CODE = 1, CW_BAR = 4096, CW_CNT = 8192, CW_NORM = 8448, CW_QCTR = 12288;
constexpr int RING_OFF = 0, RING_BYTES = 131072;
constexpr int LDSCTL_OFF = RING_BYTES, MISC_OFF = LDSCTL_OFF + 320;
constexpr int TBL_OFF = RING_BYTES + 1024;
constexpr int TBL_PS = TBL_OFF, TBL_CN = TBL_OFF + 256, TBL_TE = TBL_OFF + 512;
constexpr int RG_TOT = RING_BYTES + 4096, RG_CAR = RG_TOT + 4096;
constexpr int LDS_BYTES = 147456;

#include <cmath>
using pg8::bf_lo; using pg8::bf_hi; using pg8::sigmoid_f;

struct Frame {
    LAS unsigned char* lds;
    int tid, lane, wave, vcu, G;
};
__device__ __forceinline__ float wave_sum(float v) {
#pragma unroll
    for (int o = 1; o < 64; o <<= 1) v += __shfl_xor(v, o);
    return v;
}
__device__ __forceinline__ void transpose_tile(const float* src, int ld, bf16* dst, int ldd, const float* kscale, LAS float* scr, int lane) {
    const int q = lane & 7, kr = lane >> 3;
    f32x4 v[8];
#pragma unroll
    for (int i = 0; i < 8; ++i) v[i] = __builtin_nontemporal_load((const f32x4*)(src + (size_t)(kr + 8 * i) * ld + 4 * q));
#pragma unroll
    for (int i = 0; i < 8; ++i) { const int kk = kr + 8 * i; const float sc = kscale ? kscale[kk] : 1.0f;
#pragma unroll
        for (int c = 0; c < 4; ++c) scr[kk * 33 + 4 * q + c] = v[i][c] * sc; }
    LDS_WAIT(); asm volatile("" ::: "memory");
    const int c = lane & 7;
#pragma unroll
    for (int j = 0; j < 4; ++j) { const int n = (lane >> 3) + 8 * j; const LAS float* s = scr + (8 * c) * 33 + n;
        v4u o; o.x = pk2(s[0 * 33], s[1 * 33]); o.y = pk2(s[2 * 33], s[3 * 33]); o.z = pk2(s[4 * 33], s[5 * 33]); o.w = pk2(s[6 * 33], s[7 * 33]);
        *(GAS v4u*)(dst + (size_t)n * ldd + 8 * c) = o; }
    LDS_WAIT(); asm volatile("" ::: "memory");
}

__device__ __forceinline__ void transpose_tile8(const float* src, int ld, unsigned char* dst, int ldd, const float* kscale, float scale, LAS float* scr, int lane) {
    const int q = lane & 7, kr = lane >> 3;
    f32x4 v[8];
#pragma unroll
    for (int i = 0; i < 8; ++i) v[i] = __builtin_nontemporal_load((const f32x4*)(src + (size_t)(kr + 8 * i) * ld + 4 * q));
#pragma unroll
    for (int i = 0; i < 8; ++i) { const int kk = kr + 8 * i; const float sc = kscale ? kscale[kk] * scale : scale;
#pragma unroll
        for (int c = 0; c < 4; ++c) scr[kk * 33 + 4 * q + c] = v[i][c] * sc; }
    LDS_WAIT(); asm volatile("" ::: "memory");
    const int c = lane & 3;
#pragma unroll
    for (int j = 0; j < 2; ++j) { const int n = (lane >> 2) + 16 * j; const LAS float* s = scr + (16 * c) * 33 + n;
        v4u o; o.x = pg8::pack4_fp8(s[0 * 33], s[1 * 33], s[2 * 33], s[3 * 33]); o.y = pg8::pack4_fp8(s[4 * 33], s[5 * 33], s[6 * 33], s[7 * 33]);
        o.z = pg8::pack4_fp8(s[8 * 33], s[9 * 33], s[10 * 33], s[11 * 33]); o.w = pg8::pack4_fp8(s[12 * 33], s[13 * 33], s[14 * 33], s[15 * 33]);
        *(GAS v4u*)(dst + (size_t)n * ldd + 16 * c) = o; }
    LDS_WAIT(); asm volatile("" ::: "memory");
}

struct P0Args { const float *x, *g_mix, *w_in, *w_rg_a, *w_rg_x, *b_forget, *w_lru_out, *w_attn_out, *w_out, *g_ffn, *w_rgrp, *w_rexp, *w_gate, *w_up;
                bf16 *Win, *Wl, *Wa, *Wo, *Wrg, *XB; unsigned char* W13; float *RS1, *LF, *WRT; unsigned char *Win8, *X8P; };
struct TItem { const float* src; int ld; unsigned char* dst; int ldd; const float* ks; float scale; int f8; };
__device__ __forceinline__ void titem_load(const TItem& t, f32x4 (&v)[8], float (&sc)[8], int lane) {
    const int q = lane & 7, kr = lane >> 3;
#pragma unroll
    for (int i = 0; i < 8; ++i) { v[i] = __builtin_nontemporal_load((const f32x4*)(t.src + (size_t)(kr + 8 * i) * t.ld + 4 * q)); sc[i] = t.ks ? t.ks[kr + 8 * i] * t.scale : t.scale; }
}
__device__ __forceinline__ void titem_finish(const TItem& t, const f32x4 (&v)[8], const float (&sc)[8], LAS float* scr, int lane) {
    const int q = lane & 7, kr = lane >> 3;
#pragma unroll
    for (int i = 0; i < 8; ++i) { const int kk = kr + 8 * i;
#pragma unroll
        for (int c = 0; c < 4; ++c) scr[kk * 33 + 4 * q + c] = v[i][c] * sc[i]; }
    LDS_WAIT(); asm volatile("" ::: "memory");
    if (t.f8) { const int c = lane & 3;
#pragma unroll
        for (int j = 0; j < 2; ++j) { const int n = (lane >> 2) + 16 * j; const LAS float* s = scr + (16 * c) * 33 + n;
            v4u o; o.x = pg8::pack4_fp8(s[0 * 33], s[1 * 33], s[2 * 33], s[3 * 33]); o.y = pg8::pack4_fp8(s[4 * 33], s[5 * 33], s[6 * 33], s[7 * 33]);
            o.z = pg8::pack4_fp8(s[8 * 33], s[9 * 33], s[10 * 33], s[11 * 33]); o.w = pg8::pack4_fp8(s[12 * 33], s[13 * 33], s[14 * 33], s[15 * 33]);
            *(GAS v4u*)(t.dst + (size_t)n * t.ldd + 16 * c) = o; } }
    else { const int c = lane & 7;
#pragma unroll
        for (int j = 0; j < 4; ++j) { const int n = (lane >> 3) + 8 * j; const LAS float* s = scr + (8 * c) * 33 + n;
            v4u o; o.x = pk2(s[0 * 33], s[1 * 33]); o.y = pk2(s[2 * 33], s[3 * 33]); o.z = pk2(s[4 * 33], s[5 * 33]); o.w = pk2(s[6 * 33], s[7 * 33]);
            *(GAS v4u*)(t.dst + ((size_t)n * t.ldd + 8 * c) * 2) = o; } }
    LDS_WAIT(); asm volatile("" ::: "memory");
}
constexpr int P0_I_IN = 16 * 224, P0_I_SQ = 16 * 32, P0_I_RG = 2 * 4 * 4 * 8, P0_I_EX = 2 * 8192, P0_NITEMS = P0_I_IN + 3 * P0_I_SQ + P0_I_RG + P0_I_EX;
__device__ __forceinline__ void p0_items(const Frame& F, const P0Args& a, const int first, const int last, const int stride, const int offset) {
    LAS float* scr = (LAS float*)(F.lds + RING_OFF + F.wave * 16384);
    const float* const p_wl = a.w_lru_out; const float* const p_wa = a.w_attn_out; const float* const p_wo = a.w_out; const float* const p_rga = a.w_rg_a; const float* const p_rgx = a.w_rg_x;
    bf16* const q_wl = a.Wl; bf16* const q_wa = a.Wa; bf16* const q_wo = a.Wo;
    constexpr int I_IN = P0_I_IN, I_SQ = P0_I_SQ, I_EX = P0_I_EX, NITEMS = P0_NITEMS;
    const float* const p_gate = a.w_gate; const float* const p_up = a.w_up; const float* const p_win = a.w_in; const float* const p_gmix = a.g_mix; const float* const p_gffn = a.g_ffn;
    bf16* const q_win = a.Win; bf16* const q_wrg = a.Wrg; unsigned char* const q_w13 = a.W13; unsigned char* const q_win8 = a.Win8;
#define P0_DECODE(it_, t_) do { int r = (it_); \
        if (r >= NITEMS - I_EX) { r -= NITEMS - I_EX;     \
            const int w = r >> 13, e = (r >> 8) & 31, kb = (r >> 4) & 15, nb = r & 15; const float* W = (w == 0 ? p_gate : p_up) + (size_t)e * DM * DE; \
            const int drow = e * 1024 + (nb >> 2) * 256 + (nb & 3) * 32 + (w == 1 ? 128 : 0); \
            t_.src = W + (size_t)(64 * kb) * DE + 32 * nb; t_.ld = DE; t_.dst = q_w13 + (size_t)drow * DM + 64 * kb; t_.ldd = DM; t_.ks = p_gffn + 64 * kb; t_.scale = pg8::W13_SCALE; t_.f8 = 1; } \
        else if (r < I_IN) { const int kb = r / 224, nb = r % 224, n0 = 32 * nb, sc_ = n0 < 5120 ? n0 : n0 + 8; \
            t_.src = p_win + (size_t)(64 * kb) * INW + sc_; t_.ld = INW; t_.ldd = DM; t_.ks = p_gmix + 64 * kb; \
            if (n0 >= 5120) { t_.dst = q_win8 + (size_t)(n0 - 5120) * DM + 64 * kb; t_.scale = pg8::WIN_SCALE; t_.f8 = 1; }     \
            else { t_.dst = (unsigned char*)(q_win + (size_t)n0 * DM + 64 * kb); t_.scale = 1.0f; t_.f8 = 0; } } \
        else if (r < I_IN + 3 * I_SQ) { r -= I_IN; const int w = r / I_SQ, q = r % I_SQ, kb = q / 32, nb = q % 32; const float* W = w == 0 ? p_wl : (w == 1 ? p_wa : p_wo); bf16* Wt = w == 0 ? q_wl : (w == 1 ? q_wa : q_wo); \
            t_.src = W + (size_t)(64 * kb) * DM + 32 * nb; t_.ld = DM; t_.dst = (unsigned char*)(Wt + (size_t)(32 * nb) * DM + 64 * kb); t_.ldd = DM; t_.ks = nullptr; t_.scale = 1.0f; t_.f8 = 0; } \
        else { r -= I_IN + 3 * I_SQ; const int gb = r / 32, q = r % 32, kb = q / 8, nb = q % 8; const float* W = (gb < 4 ? p_rga : p_rgx) + (size_t)(gb & 3) * 65536; \
            t_.src = W + (size_t)(64 * kb) * 256 + 32 * nb; t_.ld = 256; t_.dst = (unsigned char*)(q_wrg + (size_t)gb * 65536 + (size_t)(32 * nb) * 256 + 64 * kb); t_.ldd = 256; t_.ks = nullptr; t_.scale = -1.4426950408889634f; t_.f8 = 0; }     } while (0)
    {
        int it = first + offset; TItem cur; f32x4 va[8]; float sa[8];
        if (it < last) { P0_DECODE(it, cur); titem_load(cur, va, sa, F.lane); }
        while (it < last) {
            const int nx = it + stride; TItem nt = cur; f32x4 vb[8]; float sb[8];
            if (nx < last) { P0_DECODE(nx, nt); titem_load(nt, vb, sb, F.lane); }
            titem_finish(cur, va, sa, scr, F.lane);
            if (nx < last) { cur = nt;
#pragma unroll
                for (int i = 0; i < 8; ++i) { va[i] = vb[i]; sa[i] = sb[i]; } }
            it = nx;
        }
    }
#undef P0_DECODE
}
__device__ __forceinline__ void p0_prologue(const Frame& F, const P0Args& a, const int part  ) {
    const int gw = F.vcu * NWAVES + F.wave, NGW = F.G * NWAVES;
    if (part != 2) p0_items(F, a, 0, P0_NITEMS, NGW, gw);
    if (part == 1) return;
    for (int i = (F.vcu * NWAVES + F.wave) * 64 + F.lane; i < 64 * DM; i += NGW * 64) { const int n = i >> 10, k = i & 1023;
        float v = 0.f; if (n < 32) v = a.w_rexp[k * 32 + n]; else if (n < 36) v = a.w_rgrp[k * 4 + (n - 32)];
        a.WRT[i] = v * a.g_ffn[k]; }
    LAS float* wfl = (LAS float*)(F.lds + RING_OFF);
    __syncthreads();
    for (int k = F.tid; k < DM; k += NWAVES * 64) { const float g = a.g_mix[k];
        const f32x4 w0 = *(const f32x4*)(a.w_in + (size_t)k * INW + 5120), w1 = *(const f32x4*)(a.w_in + (size_t)k * INW + 5124);
        *(LAS f32x4*)(wfl + k * 8) = w0 * g; *(LAS f32x4*)(wfl + k * 8 + 4) = w1 * g; }
    __syncthreads();
    float wf[4][4][8];
#pragma unroll
    for (int j = 0; j < 4; ++j)
#pragma unroll
        for (int i = 0; i < 4; ++i) { const int k = 256 * j + 4 * F.lane + i; const f32x4 w0 = *(const LAS f32x4*)(wfl + k * 8), w1 = *(const LAS f32x4*)(wfl + k * 8 + 4);
#pragma unroll
            for (int h = 0; h < 4; ++h) { wf[j][i][h] = w0[h]; wf[j][i][4 + h] = w1[h]; } }
    const float bfg = a.b_forget[F.lane & 7];
    f32x4 vn[4];
    if (gw < T) { const GAS f32x4* xr0 = (const GAS f32x4*)(a.x + (size_t)gw * DM) + F.lane;
#pragma unroll
        for (int j = 0; j < 4; ++j) vn[j] = __builtin_nontemporal_load((const f32x4*)xr0 + 64 * j); }
    for (int m = gw; m < T; m += NGW) {
        f32x4 v[4]; float s = 0.f, d[8] = {0.f, 0.f, 0.f, 0.f, 0.f, 0.f, 0.f, 0.f};
#pragma unroll
        for (int j = 0; j < 4; ++j) v[j] = vn[j];
        if (m + NGW < T) { const GAS f32x4* xr1 = (const GAS f32x4*)(a.x + (size_t)(m + NGW) * DM) + F.lane;
#pragma unroll
            for (int j = 0; j < 4; ++j) vn[j] = __builtin_nontemporal_load((const f32x4*)xr1 + 64 * j); }
#pragma unroll
        for (int j = 0; j < 4; ++j) { s += (v[j].x * v[j].x + v[j].y * v[j].y) + (v[j].z * v[j].z + v[j].w * v[j].w);
#pragma unroll
            for (int i = 0; i < 4; ++i)
#pragma unroll
                for (int h = 0; h < 8; ++h) d[h] = fmaf(v[j][i], wf[j][i][h], d[h]); }
        s = wave_sum(s);
#pragma unroll
        for (int h = 0; h < 8; ++h) d[h] = wave_sum(d[h]);
        const float rs = 1.0f / sqrtf(s * (1.0f / DM) + EPS);
        GAS unsigned long long* o8 = (GAS unsigned long long*)(a.XB + (size_t)m * DM) + F.lane;
#pragma unroll
        for (int j = 0; j < 4; ++j) o8[64 * j] = (unsigned long long)pk2(v[j].x * rs, v[j].y * rs) | ((unsigned long long)pk2(v[j].z * rs, v[j].w * rs) << 32);
        { GAS unsigned* o4 = (GAS unsigned*)(a.X8P + (size_t)m * DM) + F.lane; const float r8 = rs * pg8::XS_SCALE;
#pragma unroll
          for (int j = 0; j < 4; ++j) o4[64 * j] = pg8::pack4_fp8(v[j].x * r8, v[j].y * r8, v[j].z * r8, v[j].w * r8); }
        if (F.lane < 8) { const int h = F.lane; float dh = d[0]; dh = h == 1 ? d[1] : dh; dh = h == 2 ? d[2] : dh; dh = h == 3 ? d[3] : dh; dh = h == 4 ? d[4] : dh; dh = h == 5 ? d[5] : dh; dh = h == 6 ? d[6] : dh; dh = h == 7 ? d[7] : dh;
            const float fl = dh * rs + bfg; a.LF[(size_t)m * 8 + h] = fminf(fl, 0.f) - log1pf(expf(-fabsf(fl))); }
    }
}
__device__ __forceinline__ void cumsum_bias(const Frame& F, const float* LF, float* CB) {
    LAS float* wt = (LAS float*)(F.lds + RING_OFF);
    for (int bh = blockIdx.x; bh < NB * NH; bh += F.G) {
        const int b = bh >> 3, h = bh & 7, s0 = F.tid * 8;
        float v[8], run = 0.f;
#pragma unroll
        for (int j = 0; j < 8; ++j) { run += LF[((size_t)(b * SEQ + s0 + j)) * 8 + h]; v[j] = run; }
        float inc = run;
#pragma unroll
        for (int o = 1; o < 64; o <<= 1) { const float t = __shfl_up(inc, o); if (F.lane >= o) inc += t; }
        if (F.lane == 63) wt[F.wave] = inc;
        __syncthreads();
        float pre = inc - run;
        for (int w = 0; w < F.wave; ++w) pre += wt[w];
#pragma unroll
        for (int j = 0; j < 8; ++j) CB[(size_t)bh * SEQ + s0 + j] = -(pre + v[j]) * 11.313708498984761f;
        __syncthreads();
    }
}
struct RgArgs { const bf16* XC; const bf16* GG; bf16* GO; const bf16* Wrg; const float *b_a, *b_x, *lam; };
__device__ __forceinline__ float bfx(const v4u& v, int i) { const unsigned w = i < 2 ? v.x : (i < 4 ? v.y : (i < 6 ? v.z : v.w)); return (i & 1) ? bf_hi(w) : bf_lo(w); }
__device__ __forceinline__ unsigned cvtpk_bf16(float lo, float hi) { unsigned r; asm volatile("v_cvt_pk_bf16_f32 %0, %1, %2" : "=v"(r) : "v"(lo), "v"(hi)); return r; }
__device__ __forceinline__ void conv_prepass(const Frame& F, const bf16* XR, bf16* XC, const float* conv_w, const float* conv_b) {
    const int gw = F.vcu * NWAVES + F.wave, NGW = F.G * NWAVES;
    for (int it = gw; it < (T / 16) * 2; it += NGW) {
        const int r0 = (it >> 1) * 16, c0 = (it & 1) * 512 + 8 * F.lane, tq = r0 & (SEQ - 1);
        float cw[4][8], cbv[8];
#pragma unroll
        for (int j = 0; j < 4; ++j) { const f32x4 w0 = *(const f32x4*)(conv_w + j * DM + c0), w1 = *(const f32x4*)(conv_w + j * DM + c0 + 4);
#pragma unroll
            for (int i = 0; i < 4; ++i) { cw[j][i] = w0[i]; cw[j][4 + i] = w1[i]; } }
        { const f32x4 w0 = *(const f32x4*)(conv_b + c0), w1 = *(const f32x4*)(conv_b + c0 + 4);
#pragma unroll
          for (int i = 0; i < 4; ++i) { cbv[i] = w0[i]; cbv[4 + i] = w1[i]; } }
        v4u raw[19];
#pragma unroll
        for (int i = 0; i < 19; ++i) { const int rr = (i < 3 && tq == 0) ? r0 : r0 - 3 + i; const v4u w = __builtin_nontemporal_load((const v4u*)(XR + ((unsigned)rr * DM + c0)));
            const bool z = i < 3 && tq == 0; raw[i].x = z ? 0u : w.x; raw[i].y = z ? 0u : w.y; raw[i].z = z ? 0u : w.z; raw[i].w = z ? 0u : w.w; }
#pragma unroll
        for (int r = 0; r < 16; ++r) { float y[8];
#pragma unroll
            for (int i = 0; i < 8; ++i) { float sacc = cbv[i];
#pragma unroll
                for (int j = 0; j < 4; ++j) sacc = fmaf(cw[j][i], bfx(raw[r + j], i), sacc);
                y[i] = sacc; }
            v4u o; o.x = cvtpk_bf16(y[0], y[1]); o.y = cvtpk_bf16(y[2], y[3]); o.z = cvtpk_bf16(y[4], y[5]); o.w = cvtpk_bf16(y[6], y[7]);
            *(GAS v4u*)(XC + ((unsigned)(r0 + r) * DM + c0)) = o; }
    }
}
__device__ __forceinline__ void rglru_unit(const Frame& F, const RgArgs& a, int unit) {
    const int tid = F.tid, lane = F.lane, wid = F.wave, fr = lane & 15, fq = lane >> 4, rq = wid >> 1, cp = wid & 1;
    const int b = unit >> 5, n = (unit >> 3) & 3, g = unit & 7, cbase = 256 * n, cown = cbase + 32 * g;
    LAS unsigned char* A_l = F.lds + RING_OFF;
    LAS float* tot = (LAS float*)(F.lds + RG_TOT);
    bf16x8 bfr[2][8];
#pragma unroll
    for (int gt = 0; gt < 2; ++gt)
#pragma unroll
        for (int ks = 0; ks < 8; ++ks) bfr[gt][ks] = *(const GAS bf16x8*)(a.Wrg + ((size_t)((gt * 4 + n) * 256 + 32 * g + 16 * cp + fr)) * 256 + 32 * ks + 8 * fq);
    const int cl = 16 * cp + fr, cch = cown + cl;
    const float ba = -1.4426950408889634f * a.b_a[cch], bx = -1.4426950408889634f * a.b_x[cch], sp8 = 8.0f * log1pf(expf(-a.lam[cch])) * 1.4426950408889634f;
    const unsigned goff = (unsigned)(b * SEQ + 32 * rq + 4 * fq) * DM + cch;
    const __amdgpu_buffer_rsrc_t GGr = __builtin_amdgcn_make_buffer_rsrc((void*)a.GG, 0, (int)((size_t)T * DM * 2), 0x00020000);
    const __amdgpu_buffer_rsrc_t GOr = __builtin_amdgcn_make_buffer_rsrc((void*)a.GO, 0, (int)((size_t)T * DM * 2), 0x00020000);
    const int gvo = (int)(goff * 2u);
    const unsigned dbase = ((unsigned)(b * SEQ + 16 * wid + (lane >> 5)) * DM + cbase) * 2u;
    const char* const XCb = (const char*)a.XC;
#define RG_DMA(ci_, buf_) do { _Pragma("unroll") for (int i_ = 0; i_ < 8; ++i_) { const unsigned so_ = dbase + (unsigned)(2 * i_) * (DM * 2u) + ((((unsigned)lane & 31u) ^ (unsigned)((2 * i_ + (lane >> 5)) & 15)) << 4); \
        __builtin_amdgcn_global_load_lds((const unsigned*)(XCb + so_ + (unsigned)(ci_) * (128u * DM * 2u)), (LAS unsigned*)(A_l + (buf_) * 65536 + (8 * wid + i_) * 1024), 16, 0, 0); } } while (0)
    float hc = 0.f;
    const int kx = 32 * g + cl;
#pragma unroll
    for (int gt = 0; gt < 2; ++gt)
#pragma unroll
        for (int ks = 0; ks < 8; ++ks) asm volatile("" : "+v"(bfr[gt][ks]));
    RG_DMA(0, 0); asm volatile("s_waitcnt vmcnt(0)" ::: "memory");
#define RG_CHUNK(BUF_, ci_) do { const int ci = (ci_); const int t0 = 128 * ci; LAS unsigned char* const Ab = A_l + (BUF_) * 65536; \
        __builtin_amdgcn_s_barrier(); asm volatile("" ::: "memory"); \
        unsigned short ggv[2][4]; \
        _Pragma("unroll") \
        for (int mt = 0; mt < 2; ++mt) \
        _Pragma("unroll") \
            for (int j = 0; j < 4; ++j) ggv[mt][j] = __builtin_amdgcn_raw_buffer_load_b16(GGr, gvo, (t0 + 16 * mt + j) * (DM * 2), 0); \
        if (ci + 1 < SEQ / 128) RG_DMA(ci + 1, BUF_ ^ 1); \
 \
        f32x4 acc[2][2]; \
        _Pragma("unroll") \
        for (int mt = 0; mt < 2; ++mt) { acc[mt][0] = (f32x4){ba, ba, ba, ba}; acc[mt][1] = (f32x4){bx, bx, bx, bx}; } \
        _Pragma("unroll") \
        for (int ks = 0; ks < 8; ++ks) { const int ch = 4 * ks + fq; \
        _Pragma("unroll") \
            for (int mt = 0; mt < 2; ++mt) { const int arow = 32 * rq + 16 * mt + fr; \
                const bf16x8 af = *(const LAS bf16x8*)(Ab + arow * 512 + ((ch ^ (arow & 15)) << 4)); \
                acc[mt][0] = __builtin_amdgcn_mfma_f32_16x16x32_bf16(af, bfr[0][ks], acc[mt][0], 0, 0, 0); \
                acc[mt][1] = __builtin_amdgcn_mfma_f32_16x16x32_bf16(af, bfr[1][ks], acc[mt][1], 0, 0, 0); } } \
 \
        float av[2][4], bv[2][4], sA[2], sB[2]; \
        _Pragma("unroll") \
        for (int mt = 0; mt < 2; ++mt) { float A = 1.f, Bv = 0.f; \
        _Pragma("unroll") \
            for (int j = 0; j < 4; ++j) { const int row = 32 * rq + 16 * mt + 4 * fq + j; \
                const unsigned short xb16 = *(const LAS unsigned short*)(Ab + row * 512 + ((((kx >> 3) ^ (row & 15))) << 4) + (kx & 7) * 2); \
                const float xc = __builtin_bit_cast(float, (unsigned)xb16 << 16); \
                const float r_ = __builtin_amdgcn_rcpf(1.0f + __builtin_amdgcn_exp2f(acc[mt][0][j])), i_ = __builtin_amdgcn_rcpf(1.0f + __builtin_amdgcn_exp2f(acc[mt][1][j])); \
                const float aa = __builtin_amdgcn_exp2f(-sp8 * r_); \
                const float mult = __builtin_amdgcn_sqrtf(fmaxf(fmaf(-aa, aa, 1.0f), 0.f)); \
                av[mt][j] = aa; bv[mt][j] = mult * i_ * xc; \
                Bv = fmaf(aa, Bv, bv[mt][j]); A *= aa; } \
            sA[mt] = A; sB[mt] = Bv; } \
 \
        float eA[2], eB[2], tA[2], tB[2]; \
        _Pragma("unroll") \
        for (int mt = 0; mt < 2; ++mt) { float A = sA[mt], Bv = sB[mt]; \
            { const float pA = __shfl_up(A, 16), pB = __shfl_up(Bv, 16); if (fq >= 1) { Bv = fmaf(A, pB, Bv); A *= pA; } } \
            { const float pA = __shfl_up(A, 32), pB = __shfl_up(Bv, 32); if (fq >= 2) { Bv = fmaf(A, pB, Bv); A *= pA; } } \
            const float xA = __shfl_up(A, 16), xB = __shfl_up(Bv, 16); eA[mt] = fq >= 1 ? xA : 1.f; eB[mt] = fq >= 1 ? xB : 0.f; \
            tA[mt] = __shfl(A, 48 + fr); tB[mt] = __shfl(Bv, 48 + fr); } \
        const float wA = tA[0] * tA[1], wB = fmaf(tA[1], tB[0], tB[1]); \
        if (fq == 0) { tot[(rq * 32 + cl) * 2] = wA; tot[(rq * 32 + cl) * 2 + 1] = wB; } \
        asm volatile("s_waitcnt lgkmcnt(0)" ::: "memory"); __builtin_amdgcn_s_barrier(); asm volatile("" ::: "memory"); \
        float hin = hc, hnew = hc; \
        _Pragma("unroll") \
        for (int q = 0; q < 4; ++q) { const float qA = tot[(q * 32 + cl) * 2], qB = tot[(q * 32 + cl) * 2 + 1]; hnew = fmaf(qA, hnew, qB); if (q < rq) hin = hnew; } \
        hc = hnew; \
        _Pragma("unroll") \
        for (int mt = 0; mt < 2; ++mt) { float h = mt == 0 ? hin : fmaf(tA[0], hin, tB[0]); \
            h = fmaf(eA[mt], h, eB[mt]); \
        _Pragma("unroll") \
            for (int j = 0; j < 4; ++j) { h = fmaf(av[mt][j], h, bv[mt][j]); \
                const float gv = __builtin_bit_cast(float, (unsigned)ggv[mt][j] << 16); \
                __builtin_amdgcn_raw_buffer_store_b16((unsigned short)cvtpk_bf16(h * gv, 0.f), GOr, gvo, (t0 + 16 * mt + j) * (DM * 2), 0); } } \
        asm volatile("s_waitcnt lgkmcnt(0)" ::: "memory"); \
        asm volatile("s_waitcnt vmcnt(8)" ::: "memory"); \
    } while (0)
    for (int cc = 0; cc < SEQ / 128; cc += 2) { RG_CHUNK(0, cc); RG_CHUNK(1, cc + 1); }
#undef RG_CHUNK
#undef RG_DMA
    asm volatile("s_waitcnt vmcnt(0) lgkmcnt(0)" ::: "memory"); __builtin_amdgcn_s_barrier(); asm volatile("" ::: "memory");
}
constexpr float SKIP_LOG2 = 40.0f;
__device__ __forceinline__ int attn_jlo(const Frame& F, const float* CB, const unsigned* NORM, int bh, int qb) {
    float qs = 0.f, ks = 0.f;
#pragma unroll
    for (int w = 0; w < 4; ++w) { qs += __uint_as_float(NORM[(bh) * 4 + w]); ks += __uint_as_float(NORM[(64 + bh) * 4 + w]); }
    constexpr float C2 = 1.4426950408889634f * 0.08838834764831845f;
    const float th = SKIP_LOG2 + 2.0f * 1.02f * sqrtf(qs * ks) * C2 + 4.0f;
    const float ref = CB[(size_t)bh * SEQ + qb * 256], v = CB[(size_t)bh * SEQ + 64 * F.lane + 63];
    const unsigned long long m = __ballot(F.lane < 4 * qb && (ref - v) * C2 > th);
    int j = __builtin_popcountll(m); if (m != ((j >= 64) ? ~0ull : ((1ull << j) - 1ull))) j = 0;
    return j & ~1;
}
__device__ __forceinline__ fattn::BlockRef attn_ref(int bh, int qb, int jlo) {
    const int b = bh >> 3, h = bh & 7;
    fattn::BlockRef r; r.qo = ((unsigned)bh * SEQ + (unsigned)qb * 256u) * HD; r.oo = ((unsigned)b * SEQ + (unsigned)qb * 256u) * DM + h * HD; r.kvo = (unsigned)bh * SEQ * HD; r.cbo = (unsigned)bh * SEQ; r.P0 = qb * 256; r.jlo = jlo; return r;
}
__device__ __forceinline__ void attn_phase(const Frame& F, char* lds, const bf16* Qb, bf16* Ob, const bf16* Kb, const bf16* Vb, const float* CB, const int* JLO, gu32* QCTR, const int probe = 0) {
#define ATT_JLO(bh_, qb_) (probe == 1 ? 4 * (qb_) : probe == 2 ? 0 : __builtin_amdgcn_readfirstlane(JLO[(bh_) * 16 + (qb_)]))
    constexpr int NBLK = 128;
    const int M = F.G >> 3; if ((F.G & 7) || M > 64 || M < 1) return;
    const int x = F.vcu / M, r = F.vcu % M;
    volatile LAS int* tk_l = (volatile LAS int*)(F.lds + MISC_OFF + 64);
    gu32* qc = QCTR + 64 * x;
    const fattn::Bases G{Qb, Ob, Kb, Vb, CB}; LAS unsigned char* const ldsa = F.lds + RING_OFF;
#define ATT_DEC(k_, bh_, qb_) do { const int i_ = (k_) & 7; bh_ = (i_ < 4 ? 4 * x + i_ : 32 + 4 * x + (i_ - 4)); qb_ = 15 - ((k_) >> 3); } while (0)
    int bh, qb; ATT_DEC(r, bh, qb);
    fattn::BlockRef cur = attn_ref(bh, qb, ATT_JLO(bh, qb));
    ATT_DEC(r + M, bh, qb);
    fattn::BlockRef nxt = attn_ref(bh, qb, ATT_JLO(bh, qb)); bool nxt_ok = (r + M) < NBLK;
    fattn::Seam S;
    fattn::prime(G, cur, lds, ldsa, S);
    bool more = true;
    for (;;) {
        unsigned tkt = 0u;
        if (more && F.tid == 0) tkt = __hip_atomic_fetch_add(qc, 1u, __ATOMIC_RELAXED, __HIP_MEMORY_SCOPE_AGENT);
        const bool last = !nxt_ok;
        fattn::block(G, cur, last ? cur : nxt, lds, ldsa, S);
        if (last) break;
        if (F.tid == 0) tk_l[0] = more ? (int)tkt + 2 * M : NBLK;
        __syncthreads();
        const int k2 = __builtin_amdgcn_readfirstlane(tk_l[0]);
        __syncthreads();
        cur = nxt;
        if (k2 < NBLK) { ATT_DEC(k2, bh, qb); nxt = attn_ref(bh, qb, ATT_JLO(bh, qb)); nxt_ok = true; } else { nxt_ok = false; more = false; }
    }
#undef ATT_DEC
#undef ATT_JLO
}
typedef float f32x16 __attribute__((ext_vector_type(16)));
struct P5Args { const float *X, *WRT, *b_rgrp, *b_rexp, *w_down; const bf16* DL; bf16* X1B; unsigned char *X8, *W2; float* RS2; int* LISTS; unsigned* TOK; gu32* CNT; };
__device__ __forceinline__ void p5_route(const Frame& F, const P5Args& a) {
    const int tid = F.tid, lane = F.lane, wid = F.wave, i16 = lane & 15, h4 = lane >> 4;
    constexpr int LDA = 132;
    LAS float* A_l = (LAS float*)(F.lds + RING_OFF) + wid * 16 * LDA;
    LAS float* B_l = (LAS float*)(F.lds + RING_OFF + 67584);
    LAS float* LG = (LAS float*)(F.lds + RING_OFF + 94208);
    LAS float* rs_l = (LAS float*)(F.lds + RING_OFF + 113664);
    LAS int* hist = (LAS int*)(F.lds + RING_OFF + 114176);
    LAS int* base_l = (LAS int*)(F.lds + RING_OFF + 114432);
    {
        LAS float* scr = (LAS float*)(F.lds + RING_OFF + wid * 8704);
        const int gw = F.vcu * NWAVES + wid, NGW = F.G * NWAVES;
        for (int it = gw; it < 8192; it += NGW) { const int e = it >> 8, kb = (it >> 5) & 7, nb = it & 31; const float* W = a.w_down + (size_t)e * DE * DM;
            transpose_tile8(W + (size_t)(64 * kb) * DM + 32 * nb, DM, a.W2 + (size_t)(e * 1024 + 32 * nb) * DE + 64 * kb, DE, nullptr, pg8::W2_SCALE, scr, lane); }
    }
    __syncthreads();
    for (int rb = blockIdx.x; rb < T / 128; rb += F.G) {
        const int R0 = rb * 128;
        if (tid < 32) hist[tid] = 0;
        const int ar = lane >> 5, ac = 4 * (lane & 31);
        const size_t xo = (size_t)(R0 + 16 * wid + ar) * DM + ac; const float* xsrc = a.X + xo; const bf16* dsrc = a.DL + xo; unsigned char* xdst = a.X8 + xo; bf16* bdst = a.X1B + xo;
        f32x4 areg[8], breg[3]; unsigned long long dreg[8];
#define P5_LOAD(kc_) do { _Pragma("unroll") for (int i_ = 0; i_ < 8; ++i_) { areg[i_] = __builtin_nontemporal_load((const f32x4*)(xsrc + (size_t)(2 * i_) * DM + (kc_) * 128)); dreg[i_] = __builtin_nontemporal_load((const unsigned long long*)(dsrc + (size_t)(2 * i_) * DM + (kc_) * 128)); } \
        _Pragma("unroll") for (int q_ = 0; q_ < 3; ++q_) { const int idx_ = tid + 512 * q_; breg[q_] = *(const f32x4*)(a.WRT + (size_t)(idx_ >> 5) * DM + (kc_) * 128 + 4 * (idx_ & 31)); } } while (0)
        P5_LOAD(0);
        f32x4 acc[3] = {{0.f, 0.f, 0.f, 0.f}, {0.f, 0.f, 0.f, 0.f}, {0.f, 0.f, 0.f, 0.f}}; float ss = 0.f;
        for (int kc = 0; kc < 8; ++kc) {
#pragma unroll
            for (int i = 0; i < 8; ++i) { const unsigned dl = (unsigned)dreg[i], dh = (unsigned)(dreg[i] >> 32);
                areg[i][0] += bf_lo(dl); areg[i][1] += bf_hi(dl); areg[i][2] += bf_lo(dh); areg[i][3] += bf_hi(dh);
                *(unsigned*)(xdst + (size_t)(2 * i) * DM + kc * 128) = pg8::pack4_fp8(areg[i][0], areg[i][1], areg[i][2], areg[i][3]);
                *(unsigned long long*)(bdst + (size_t)(2 * i) * DM + kc * 128) = (unsigned long long)pg8::cvt_pk_bf16(areg[i][0], areg[i][1]) | ((unsigned long long)pg8::cvt_pk_bf16(areg[i][2], areg[i][3]) << 32);
                *(LAS f32x4*)(A_l + (2 * i + ar) * LDA + ac) = areg[i]; }
#pragma unroll
            for (int q = 0; q < 3; ++q) { const int idx = tid + 512 * q; *(LAS f32x4*)(B_l + (idx >> 5) * LDA + 4 * (idx & 31)) = breg[q]; }
            __syncthreads();
            if (kc + 1 < 8) P5_LOAD(kc + 1);
#pragma unroll
            for (int jj = 0; jj < 8; ++jj) {
                const f32x4 af = *(const LAS f32x4*)(A_l + i16 * LDA + 16 * jj + 4 * h4);
                f32x4 bfv[3];
#pragma unroll
                for (int nt = 0; nt < 3; ++nt) bfv[nt] = *(const LAS f32x4*)(B_l + (16 * nt + i16) * LDA + 16 * jj + 4 * h4);
                ss += (af[0] * af[0] + af[1] * af[1]) + (af[2] * af[2] + af[3] * af[3]);
#pragma unroll
                for (int s = 0; s < 4; ++s)
#pragma unroll
                    for (int nt = 0; nt < 3; ++nt) acc[nt] = __builtin_amdgcn_mfma_f32_16x16x4f32(af[s], bfv[nt][s], acc[nt], 0, 0, 0);
            }
            __syncthreads();
        }
#undef P5_LOAD
        ss += __shfl_xor(ss, 16); ss += __shfl_xor(ss, 32);
        const float rs = 1.0f / sqrtf(ss * (1.0f / DM) + EPS);
        if (h4 == 0) { a.RS2[R0 + 16 * wid + i16] = rs; rs_l[16 * wid + i16] = rs; }
#pragma unroll
        for (int r = 0; r < 4; ++r) { const int rl = 16 * wid + 4 * h4 + r; LG[rl * 37 + i16] = acc[0][r]; LG[rl * 37 + 16 + i16] = acc[1][r]; if (i16 < 4) LG[rl * 37 + 32 + i16] = acc[2][r]; }
        __syncthreads();
        int e0 = 0, e1 = 0, k0 = 0, k1 = 0; float w0 = 0.f, w1 = 0.f;
        if (tid < 128) {
            const float rsv = rs_l[tid]; const LAS float* lg = LG + tid * 37;
            float gl[4];
#pragma unroll
            for (int q = 0; q < 4; ++q) gl[q] = lg[32 + q] * rsv + a.b_rgrp[q];
            int gs = 0; float gm = gl[0];
#pragma unroll
            for (int q = 1; q < 4; ++q) if (gl[q] > gm) { gm = gl[q]; gs = q; }
            float den = 0.f;
#pragma unroll
            for (int q = 0; q < 4; ++q) den += expf(gl[q] - gm);
            const float pg = 1.0f / den;
            float el[8];
#pragma unroll
            for (int q = 0; q < 8; ++q) el[q] = lg[8 * gs + q] * rsv + a.b_rexp[8 * gs + q];
            int i0 = 0; float v0 = el[0];
#pragma unroll
            for (int q = 1; q < 8; ++q) if (el[q] > v0) { v0 = el[q]; i0 = q; }
            int i1 = -1; float v1 = -INFINITY;
#pragma unroll
            for (int q = 0; q < 8; ++q) if (q != i0 && el[q] > v1) { v1 = el[q]; i1 = q; }
            const float ex = expf(v1 - v0);
            w0 = pg / (1.0f + ex); w1 = pg * ex / (1.0f + ex);
            e0 = 8 * gs + i0; e1 = 8 * gs + i1;
            k0 = atomicAdd((int*)(hist + e0), 1); k1 = atomicAdd((int*)(hist + e1), 1);
        }
        __syncthreads();
        if (tid < 32) base_l[tid] = (int)__hip_atomic_fetch_add(a.CNT + tid, (unsigned)hist[tid], __ATOMIC_RELAXED, __HIP_MEMORY_SCOPE_AGENT);
        __syncthreads();
        if (tid < 128) { const int tok = R0 + tid, s0 = base_l[e0] + k0, s1 = base_l[e1] + k1;
            a.LISTS[(size_t)e0 * T + s0] = tok; a.LISTS[(size_t)e1 * T + s1] = tok;
            v4u i0v = {(unsigned)e0, (unsigned)s0, (unsigned)e1, (unsigned)s1}, i1v = {__float_as_uint(w0), __float_as_uint(w1), 0u, 0u};
            *(GAS v4u*)(a.TOK + (size_t)tok * 8) = i0v; *(GAS v4u*)(a.TOK + (size_t)tok * 8 + 4) = i1v; }
        __syncthreads();
    }
}
__device__ __forceinline__ void build_tables(const Frame& F, const gu32* CNT) {
    LAS int* ps = (LAS int*)(F.lds + TBL_PS); LAS int* cn = (LAS int*)(F.lds + TBL_CN); LAS int* te = (LAS int*)(F.lds + TBL_TE);
    __syncthreads();
    if (F.tid < 32) { int c = (int)__hip_atomic_load(CNT + F.tid, __ATOMIC_RELAXED, __HIP_MEMORY_SCOPE_AGENT); c = c < 0 ? 0 : (c > T ? T : c); cn[F.tid] = c; }
    __syncthreads();
    if (F.tid == 0) { int run = 0; for (int e = 0; e < 32; ++e) { ps[e] = run; run += (cn[e] + 255) & ~255; } if (run > PMAX) run = PMAX; ps[32] = run; }
    __syncthreads();
    if (F.tid < 288) { const int p = F.tid * 256; int e = 0; for (int q = 1; q < 32; ++q) if (p >= ps[q]) e = q; te[F.tid] = e; }
    __syncthreads();
}
__device__ __forceinline__ void build_rowtab(const Frame& F, const pg8::GroupedOrder& S, const int* LISTS, const float* RS2, LAS int* rowtab) {
    const LAS int* ps = (const LAS int*)(F.lds + TBL_PS); const LAS int* cn = (const LAS int*)(F.lds + TBL_CN); const LAS int* te = (const LAS int*)(F.lds + TBL_TE);
    pg8::Unit u;
    for (int ui = 0; ui < 6 && S.next(ui, u); ++ui)
        if (F.tid < 256) { const int p = u.pm * 256 + F.tid, e = te[u.pm], local = p - ps[e]; const int tok = local < cn[e] ? LISTS[(size_t)e * T + local] : 0; rowtab[ui * 256 + F.tid] = tok; ((LAS float*)rowtab)[(6 + ui) * 256 + F.tid] = RS2[tok]; }
    __syncthreads();
}
__device__ __forceinline__ float fp8_f32(unsigned w, int i) { return i == 0 ? __builtin_amdgcn_cvt_f32_fp8(w, 0) : (i == 1 ? __builtin_amdgcn_cvt_f32_fp8(w, 1) : (i == 2 ? __builtin_amdgcn_cvt_f32_fp8(w, 2) : __builtin_amdgcn_cvt_f32_fp8(w, 3))); }
__device__ __forceinline__ void p9_final(const Frame& F, const bf16* X1B, float* OUT, const unsigned char* Y, const unsigned* TOK, const float* g_final) {
    const LAS int* ps = (const LAS int*)(F.lds + TBL_PS);
    const int gw = F.vcu * NWAVES + F.wave, NGW = F.G * NWAVES;
    f32x4 gf[4];
#pragma unroll
    for (int j = 0; j < 4; ++j) gf[j] = *((const f32x4*)g_final + F.lane + 64 * j);
    constexpr float YS = 1.0f / (pg8::HB_SCALE * pg8::W2_SCALE * pg8::Y_SCALE);
    v4u ia_n = {0u, 0u, 0u, 0u}, ib_n = {0u, 0u, 0u, 0u}, ia_c = ia_n, ib_c = ib_n; unsigned long long xw_n[4]; unsigned ya_n[4], yb_n[4];
#define P9_TOK(m_, ia_, ib_) do { ia_ = *(const GAS v4u*)(TOK + (size_t)(m_) * 8); ib_ = *(const GAS v4u*)(TOK + (size_t)(m_) * 8 + 4); } while (0)
#define P9_ROW(m_, ia_) do { const size_t p0_ = (size_t)(ps[(int)(ia_.x & 31u)] + (int)ia_.y), p1_ = (size_t)(ps[(int)(ia_.z & 31u)] + (int)ia_.w); \
        const GAS unsigned long long* xr_ = (const GAS unsigned long long*)(X1B + (size_t)(m_) * DM) + F.lane; \
        const GAS unsigned* y0_ = (const GAS unsigned*)(Y + p0_ * DM) + F.lane; const GAS unsigned* y1_ = (const GAS unsigned*)(Y + p1_ * DM) + F.lane; \
        _Pragma("unroll") for (int j = 0; j < 4; ++j) { xw_n[j] = __builtin_nontemporal_load((const unsigned long long*)xr_ + 64 * j); ya_n[j] = __builtin_nontemporal_load((const unsigned*)y0_ + 64 * j); yb_n[j] = __builtin_nontemporal_load((const unsigned*)y1_ + 64 * j); } } while (0)
    if (gw < T) { P9_TOK(gw, ia_c, ib_c); P9_ROW(gw, ia_c); if (gw + NGW < T) P9_TOK(gw + NGW, ia_n, ib_n); }
    for (int m = gw; m < T; m += NGW) {
        const float w0 = __uint_as_float(ib_c.x) * YS, w1 = __uint_as_float(ib_c.y) * YS;
        unsigned long long xw[4]; unsigned ya[4], yb[4];
#pragma unroll
        for (int j = 0; j < 4; ++j) { xw[j] = xw_n[j]; ya[j] = ya_n[j]; yb[j] = yb_n[j]; }
        if (m + NGW < T) { ia_c = ia_n; ib_c = ib_n; P9_ROW(m + NGW, ia_c); if (m + 2 * NGW < T) P9_TOK(m + 2 * NGW, ia_n, ib_n); }
        GAS f32x4* orow = (GAS f32x4*)(OUT + (size_t)m * DM) + F.lane;
        f32x4 v[4]; float s = 0.f;
#pragma unroll
        for (int j = 0; j < 4; ++j) { v[j] = (f32x4){bf_lo((unsigned)xw[j]), bf_hi((unsigned)xw[j]), bf_lo((unsigned)(xw[j] >> 32)), bf_hi((unsigned)(xw[j] >> 32))}; const unsigned a = ya[j], b = yb[j];
            v[j].x += w0 * fp8_f32(a, 0) + w1 * fp8_f32(b, 0); v[j].y += w0 * fp8_f32(a, 1) + w1 * fp8_f32(b, 1);
            v[j].z += w0 * fp8_f32(a, 2) + w1 * fp8_f32(b, 2); v[j].w += w0 * fp8_f32(a, 3) + w1 * fp8_f32(b, 3);
            s += (v[j].x * v[j].x + v[j].y * v[j].y) + (v[j].z * v[j].z + v[j].w * v[j].w); }
        s = wave_sum(s);
        const float rs = 1.0f / sqrtf(s * (1.0f / DM) + EPS);
#pragma unroll
        for (int j = 0; j < 4; ++j) orow[64 * j] = v[j] * rs * gf[j];
    }
#undef P9_TOK
#undef P9_ROW
}

constexpr int N_PHASES = 10;
#ifndef DUP_TRIVIAL
#define DUP_TRIVIAL 0
#endif
#ifndef DUP_PHASE
#define DUP_PHASE -1
#endif
typedef __attribute__((address_space(4))) const unsigned char* karg_ptr;
__device__ __forceinline__ const float* arg_in(int k) { karg_ptr base = (karg_ptr)__builtin_amdgcn_kernarg_segment_ptr(); const unsigned long long v = *(const unsigned long long volatile __attribute__((address_space(4)))*)(base + 8 * k); return (const float*)(const GAS float*)v; }
struct Args { const float* in[23]; float* out; unsigned char* ws; int ph_lo, ph_hi, mode, pad; };
__global__ void __launch_bounds__(NWAVES * 64, 2) fwd_kernel(Args args) {
    extern __shared__ __attribute__((aligned(16))) unsigned char lds[];
    Frame F;
    F.lds = (LAS unsigned char*)lds;
    F.wave = __builtin_amdgcn_readfirstlane((int)threadIdx.x >> 6); F.lane = pg8::lane_now(); F.tid = F.wave * 64 + F.lane;
    F.G = gridDim.x; { const int bx = blockIdx.x; F.vcu = (F.G % 8 == 0) ? (bx % 8) * (F.G / 8) + bx / 8 : bx; }
    unsigned char* ws = args.ws;
    gu32* ctl = (gu32*)(ws + WS_CTL);
    volatile LAS unsigned* MISC = (volatile LAS unsigned*)(F.lds + MISC_OFF);
    for (int u = F.tid; u < (LDS_BYTES - LDSCTL_OFF) / 4; u += NWAVES * 64) ((LAS unsigned*)(F.lds + LDSCTL_OFF))[u] = 0u;
    __syncthreads();
#if MK_ONE_LAUNCH
    XcdBarrier bar = xcd_barrier_post((unsigned*)(ctl + CW_BAR), MISC + 8);
#define GRID_BAR() xcd_barrier(bar)
#else
#define GRID_BAR() do { } while (0)
#endif
    const int lo = args.ph_lo, hi = args.ph_hi;
#ifndef PH_MASK
#define PH_MASK 0x3ff
#endif
#define IN(k) (((PH_MASK >> (k)) & 1) && lo <= (k) && (k) < hi)
#define BOTH(k) (IN(k) && IN((k) + 1))
    float* out = args.out;
    bf16* Win = (bf16*)(ws + WS_WIN); bf16* Wl = (bf16*)(ws + WS_WL); bf16* Wa = (bf16*)(ws + WS_WA); bf16* Wo = (bf16*)(ws + WS_WO); bf16* Wrg = (bf16*)(ws + WS_WRG);
    bf16* XB = (bf16*)(ws + WS_XB); bf16* XR = (bf16*)(ws + WS_XR); bf16* GG = (bf16*)(ws + WS_GG); bf16* Qb = (bf16*)(ws + WS_Q); bf16* Kb = (bf16*)(ws + WS_K); bf16* Vb = (bf16*)(ws + WS_V);
    bf16* SL = (bf16*)out; bf16* SA = (bf16*)out + pg8::SEGE;
    float* RS1 = (float*)(ws + WS_RS1); float* RS2 = (float*)(ws + WS_RS2); float* LF = (float*)(ws + WS_LF); float* CB = (float*)(ws + WS_CB);
    unsigned* TOK = (unsigned*)(ws + WS_TOK); int* LISTS = (int*)(ws + WS_LISTS); float* WRT = (float*)(ws + WS_WRT); int* JLO = (int*)(ws + WS_SRS);
    unsigned char* W13 = ws + WS_W13; unsigned char* W2 = ws + WS_W2; bf16* XG = (bf16*)(ws + WS_XG); unsigned char* HB = ws + WS_HB; unsigned char* X8 = ws + WS_XB;
    gu32* CNT = ctl + CW_CNT;

    if (IN(0)) { F.lane = pg8::lane_now(); F.tid = F.wave * 64 + F.lane;
        P0Args a{arg_in(0), arg_in(1), arg_in(2), arg_in(5), arg_in(7), arg_in(10), arg_in(11), arg_in(12), arg_in(13), arg_in(14), arg_in(15), arg_in(17), arg_in(19), arg_in(20), Win, Wl, Wa, Wo, Wrg, XB, W13, RS1, LF, WRT, ws + WS_WIN8, ws + WS_X8P};
        p0_prologue(F, a, DUP_PHASE == 0 ? args.mode : 0);
        if (BOTH(0)) GRID_BAR();
    }
    if (IN(1)) { F.lane = pg8::lane_now(); F.tid = F.wave * 64 + F.lane;
        cumsum_bias(F, LF, CB);
        { pg8::Gemm g{XB, Win, T, 5120, DM}; pg8::StaticOrder S; S.init(T, 5120, F.G, (int)blockIdx.x);
          pg8::EpiZ E{XR, SL, RS1, (unsigned*)(ctl + CW_NORM), args.mode, 0x43210u, 1.0f};
          pg8::gemm_phase<pg8::EpiZ, pg8::StaticOrder, true, true>(F.lds + RING_OFF, g, S, E, F.wave); }
        __syncthreads();
        { pg8::Gemm g{(const bf16*)(ws + WS_X8P), (const bf16*)(ws + WS_WIN8), T, 2048, DM / 2}; pg8::StaticOrder S; S.init(T, 2048, F.G, (int)blockIdx.x);
          pg8::EpiZ E{XR, SL, RS1, (unsigned*)(ctl + CW_NORM), args.mode, 0x65u, 1.0f / (pg8::XS_SCALE * pg8::WIN_SCALE)};
          pg8::gemm_phase<pg8::EpiZ, pg8::StaticOrder, true, true, true>(F.lds + RING_OFF, g, S, E, F.wave); }
        if (BOTH(1)) GRID_BAR();
    }
    if (IN(2)) { F.lane = pg8::lane_now(); F.tid = F.wave * 64 + F.lane;
        { const int gw = F.vcu * NWAVES + F.wave; if (gw < NB * NH * 16) { const int j = attn_jlo(F, CB, (const unsigned*)(ctl + CW_NORM), gw >> 4, gw & 15); if (F.lane == 0) JLO[gw] = j; } }
        conv_prepass(F, XR, XB, arg_in(3), arg_in(4));
        if (BOTH(2)) GRID_BAR();
    }
    if (IN(3)) { F.lane = pg8::lane_now(); F.tid = F.wave * 64 + F.lane;
        RgArgs ra{XB, GG, GG, Wrg, arg_in(6), arg_in(8), arg_in(9)};
#if DUP_PHASE >= 20
        const int mode = args.mode;
#else
        constexpr int mode = 0;
#endif
        if (mode < 2) { ra.GO = mode == 1 ? XR : GG; for (int u = F.vcu; u < 256; u += F.G) rglru_unit(F, ra, u); }
        if (mode != 1) attn_phase(F, (char*)lds + RING_OFF, Qb, XR, Kb, Vb, CB, JLO, ctl + CW_QCTR + (mode >= 2 ? 1024 : 0), mode >= 3 ? mode - 2 : 0);
        if (BOTH(3)) GRID_BAR();
    }
    if (IN(4)) { { F.lane = pg8::lane_now(); F.tid = F.wave * 64 + F.lane;
        static_assert(WS_GG - WS_XR == (size_t)128 * 256 * DM * 2 && WS_WL - WS_WA == (size_t)4 * 256 * DM * 2, "TwoGemmOrder: hg follows o by 128 row tiles, Wl follows Wa by 4 column tiles");
        pg8::Gemm g{XR, Wa, T, DM, DM}; pg8::TwoGemmOrder S; S.init(T, DM, F.G, (int)blockIdx.x);
        pg8::EpiGate2 E{SA, SL, XB};
        pg8::gemm_phase<pg8::EpiGate2, pg8::TwoGemmOrder, true, true>(F.lds + RING_OFF, g, S, E, F.wave); }
        if (BOTH(4)) GRID_BAR();
    }
    if (IN(5)) { F.lane = pg8::lane_now(); F.tid = F.wave * 64 + F.lane;
        pg8::Gemm g{XB, Wo, T, DM, DM}; pg8::StaticOrder S; S.init(T, DM, F.G, (int)blockIdx.x);
        pg8::EpiDelta E{(bf16*)out};
        pg8::gemm_phase<pg8::EpiDelta, pg8::StaticOrder, true, true>(F.lds + RING_OFF, g, S, E, F.wave);
        if (BOTH(5)) GRID_BAR();
    }
    if (IN(6)) { F.lane = pg8::lane_now(); F.tid = F.wave * 64 + F.lane;
        P5Args a{arg_in(0), WRT, arg_in(16), arg_in(18), arg_in(21), (const bf16*)out, XR, X8, W2, RS2, LISTS, TOK, args.mode ? CNT + 64 : CNT};
        p5_route(F, a);
        if (BOTH(6)) GRID_BAR();
    }
    if (IN(7)) { F.lane = pg8::lane_now(); F.tid = F.wave * 64 + F.lane;
        build_tables(F, CNT);
        const int ntiles = ((const LAS int*)(F.lds + TBL_PS))[32] >> 8;
        pg8::Gemm g{(const bf16*)X8, (const bf16*)W13, ntiles * 256, 32 * 1024, DM / 2}; pg8::GroupedOrder S{(const LAS int*)(F.lds + TBL_TE), ntiles * 4, F.G, F.vcu};
        LAS int* rowtab = (LAS int*)(F.lds + RG_TOT);
        build_rowtab(F, S, LISTS, RS2, rowtab);
        pg8::EpiSwiGLU E{HB};
        pg8::gemm_phase_gather<pg8::EpiSwiGLU, pg8::GroupedOrder, true>(F.lds + RING_OFF, g, S, E, rowtab, F.wave);
        if (BOTH(7)) GRID_BAR();
    }
    if (IN(8)) { F.lane = pg8::lane_now(); F.tid = F.wave * 64 + F.lane;
        build_tables(F, CNT);
        const int ntiles = ((const LAS int*)(F.lds + TBL_PS))[32] >> 8;
        pg8::Gemm g{(const bf16*)HB, (const bf16*)W2, ntiles * 256, 32 * 1024, DE / 2}; pg8::GroupedOrder S{(const LAS int*)(F.lds + TBL_TE), ntiles * 4, F.G, F.vcu};
        pg8::EpiY E{(unsigned char*)XG};
        pg8::gemm_phase<pg8::EpiY, pg8::GroupedOrder, true, true, true>(F.lds + RING_OFF, g, S, E, F.wave);
        if (BOTH(8)) GRID_BAR();
    }
    if (IN(9)) { F.lane = pg8::lane_now(); F.tid = F.wave * 64 + F.lane;
        build_tables(F, CNT);
        p9_final(F, XR, out, (const unsigned char*)XG, TOK, arg_in(22));
    }
#undef IN
#undef BOTH
}

extern "C" void kernel_launch(void* const* d_in, const int* in_sizes, int n_in, void* d_out, int out_size, void* d_ws, size_t ws_size, hipStream_t stream) {
    static int grid = 0;
    if (grid == 0) {
        if (n_in != 23 || in_sizes[0] != T * DM || out_size != T * DM || ws_size < WS_END) { fprintf(stderr, "kernel_launch: unexpected shapes (n_in %d, in0 %d, out %d, ws %zu); nothing launched\n", n_in, n_in > 0 ? in_sizes[0] : -1, out_size, ws_size); grid = -1; return; }
        int dev = 0, cus = 0;
        if (hipGetDevice(&dev) != hipSuccess || hipDeviceGetAttribute(&cus, hipDeviceAttributeMultiprocessorCount, dev) != hipSuccess) { grid = -1; return; }
        if (hipFuncSetAttribute((const void*)fwd_kernel, hipFuncAttributeMaxDynamicSharedMemorySize, LDS_BYTES) != hipSuccess) { fprintf(stderr, "kernel_launch: hipFuncSetAttribute failed\n"); grid = -1; return; }
        int per_cu = 0;
        if (hipOccupancyMaxActiveBlocksPerMultiprocessor(&per_cu, (const void*)fwd_kernel, NWAVES * 64, LDS_BYTES) != hipSuccess || per_cu < 1) { fprintf(stderr, "kernel_launch: occupancy query reports %d\n", per_cu); }
        (void)hipGetLastError();
        grid = cus;
    }
    if (grid < 0) return;
    if (hipMemsetAsync((char*)d_ws + WS_CTL, 0, CTL_ZERO_BYTES, stream) != hipSuccess) return;
    Args a{};
    for (int i = 0; i < 23; ++i) a.in[i] = (const float*)d_in[i];
    a.out = (float*)d_out; a.ws = (unsigned char*)d_ws;
#if MK_ONE_LAUNCH
    a.ph_lo = 0; a.ph_hi = N_PHASES;
    hipLaunchKernelGGL(fwd_kernel, dim3(grid), dim3(NWAVES * 64), LDS_BYTES, stream, a);
#else
    for (int ph = 0; ph < N_PHASES; ++ph) { a.ph_lo = ph; a.ph_hi = ph + 1;
        if (DUP_PHASE == ph || (ph == 3 && DUP_PHASE >= 20)) { a.mode = DUP_PHASE >= 20 ? DUP_PHASE - 19 : ((ph == 6 || (ph == 1 && DUP_TRIVIAL)) ? 1 : (ph == 0 ? DUP_TRIVIAL : 0)); hipLaunchKernelGGL(fwd_kernel, dim3(grid), dim3(NWAVES * 64), LDS_BYTES, stream, a); a.mode = 0; }
        hipLaunchKernelGGL(fwd_kernel, dim3(grid), dim3(NWAVES * 64), LDS_BYTES, stream, a); }
#endif
}
```

```cpp
#include <hip/hip_runtime.h>
#include <cstdio>
#include <cstdint>

#ifndef MK_ONE_LAUNCH
#define MK_ONE_LAUNCH 1
#endif
namespace pg8 {
#define PG8_LAS __attribute__((address_space(3)))
typedef unsigned short bf16_t;
typedef short bf16x8 __attribute__((ext_vector_type(8)));
typedef float f32x4 __attribute__((ext_vector_type(4)));
typedef unsigned u32x4 __attribute__((ext_vector_type(4)));
constexpr int BM = 256, BK = 64, HALF = 128, HTB = HALF * BK * 2  , STAGE_BYTES = 8 * HTB, NXCD = 8, WGM = 8;

__host__ __device__ __forceinline__ int lds_byte(int r, int c) { const int st = (r >> 4) * 2 + (c >> 5), rr = r & 15, cc = c & 31, ob = rr * 64 + cc * 2; return st * 1024 + (ob ^ (((ob >> 9) & 1) << 5)); }
__host__ __device__ __forceinline__ void stage_rc(int b, int& R, int& C) { const int st = b / 1024, sb = b % 1024, swz = sb ^ (((sb >> 9) & 1) << 5); R = (st >> 1) * 16 + swz / 64; C = (st & 1) * 32 + (swz % 64) / 2; }
__host__ __device__ __forceinline__ int perm32(int rho) { const int n = rho >> 4, i = rho & 15; return 8 * (i >> 2) + 4 * n + (i & 3); }

struct Unit { int pm, pn; };
struct Gemm { const bf16_t* A; const bf16_t* Bt; int M, N, K; };

struct StaticOrder {
    int nM, nN, nwg, G, c;
    __host__ __device__ void init(int M, int N, int G_, int c_) { nM = M / BM; nN = N / BM; nwg = nM * nN; G = G_; c = c_; }
    __host__ __device__ bool next(int i, Unit& u) const {
        const long L = (long)i * G + c; if (L >= nwg) return false;
        int wgid = (int)L; { const int q = nwg / NXCD, r = nwg % NXCD, xcd = wgid % NXCD, off = wgid / NXCD; wgid = (xcd < r ? xcd * (q + 1) : r * (q + 1) + (xcd - r) * q) + off; }
        const int nig = WGM * nN, gid = wgid / nig, fm = gid * WGM, gsz = (nM - fm) < WGM ? (nM - fm) : WGM;
        u.pm = fm + ((wgid % nig) % gsz); u.pn = (wgid % nig) / gsz; return true;
    }
    __device__ __forceinline__ void a_ready(const Unit&) const {}
    __device__ __forceinline__ void done(const Unit&) const {}
};

__device__ __forceinline__ unsigned cvt_pk_bf16(float lo, float hi) { unsigned r; asm volatile("v_cvt_pk_bf16_f32 %0, %1, %2" : "=v"(r) : "v"(lo), "v"(hi)); return r; }
typedef float f32x2 __attribute__((ext_vector_type(2)));
__device__ __forceinline__ int lane_now() { int l; asm volatile("v_mbcnt_lo_u32_b32 %0, -1, 0\n\tv_mbcnt_hi_u32_b32 %0, -1, %0" : "=v"(l)); return l; }
typedef int v4i_t __attribute__((ext_vector_type(4)));
typedef int v8i_t __attribute__((ext_vector_type(8)));
__device__ __forceinline__ v8i_t cat8(bf16x8 a, bf16x8 b) { const v4i_t x = __builtin_bit_cast(v4i_t, a), y = __builtin_bit_cast(v4i_t, b); return __builtin_shufflevector(x, y, 0, 1, 2, 3, 4, 5, 6, 7); }
__device__ __forceinline__ void glds_sv(const char* base, unsigned voff, unsigned lds_dst) { unsigned keep;
    asm volatile("s_mov_b32 %0, m0\n\ts_mov_b32 m0, %3\n\ts_nop 0\n\tglobal_load_lds_dwordx4 %1, %2\n\ts_mov_b32 m0, %0" : "=&s"(keep) : "v"(voff), "s"(base), "s"(lds_dst) : "memory"); }
__device__ __forceinline__ float sat8(float x) { return __builtin_amdgcn_fmed3f(x, -448.0f, 448.0f); }
__device__ __forceinline__ unsigned pack4_fp8(float a, float b, float c, float d) { unsigned w = 0u; w = __builtin_amdgcn_cvt_pk_fp8_f32(sat8(a), sat8(b), w, false); w = __builtin_amdgcn_cvt_pk_fp8_f32(sat8(c), sat8(d), w, true); return w; }
constexpr float W13_SCALE = 64.0f, HB_SCALE = 8.0f, W2_SCALE = 32.0f, XS_SCALE = 16.0f, WIN_SCALE = 64.0f;
__device__ __forceinline__ float sigmoid_f(float x) { return __builtin_amdgcn_rcpf(1.0f + __builtin_amdgcn_exp2f(-1.4426950408889634f * x)); }
__device__ __forceinline__ float gelu_tanh_f(float x) { const float u = x * (1.0f + 0.044715f * x * x); return x * __builtin_amdgcn_rcpf(1.0f + __builtin_amdgcn_exp2f(-2.3022081981f * u)); }
__device__ __forceinline__ float bf_lo(unsigned w) { return __builtin_bit_cast(float, w << 16); }
__device__ __forceinline__ float bf_hi(unsigned w) { return __builtin_bit_cast(float, w & 0xffff0000u); }
constexpr size_t SEGE = (size_t)32768 * 1024;

struct EpiZ {
    static constexpr bool PERM = true, AFTER_DRAIN = false; static constexpr int NSTORES = 16;
    bf16_t* ws5; bf16_t* out2; const float* rs; unsigned* norm; int probe; unsigned smap; float sc;
    __device__ __forceinline__ void operator()(const f32x4 (&acc)[2][2][4][2], const Unit& u, int wr, int wc, int fr, int fq) const {
        const int sgo = (int)((smap >> (4 * (u.pn >> 2))) & 15u); const int seg = probe ? 0 : sgo; float nm[2] = {0.f, 0.f}; bf16_t* O = sgo < 5 ? ws5 + (size_t)sgo * SEGE : out2 + (size_t)(sgo - 5) * SEGE;
        const int row0 = u.pm * BM + wr * 64 + fr, col0 = (u.pn & 3) * BM + wc * 32 + 8 * fq;
#pragma unroll
        for (int ai = 0; ai < 2; ++ai)
#pragma unroll
            for (int m = 0; m < 4; ++m) { const int row = row0 + ai * HALF + m * 16; bf16_t* rowp = O + (size_t)row * 1024 + col0;
                const bool hm = (sgo >= 2 && sgo <= 4); bf16_t* rowh = O + ((size_t)((row >> 12) * 8 + 2 * (u.pn & 3)) * 4096 + (row & 4095)) * 128 + wc * 32 + 8 * fq;
#pragma unroll
                for (int bj = 0; bj < 2; ++bj) { f32x4 v0 = acc[ai][bj][m][0] * sc, v1 = acc[ai][bj][m][1] * sc;
                    if (seg == 1) {
#pragma unroll
                        for (int i = 0; i < 4; ++i) { v0[i] = gelu_tanh_f(v0[i]); v1[i] = gelu_tanh_f(v1[i]); } }
                    else if (seg >= 5) {
#pragma unroll
                        for (int i = 0; i < 4; ++i) { v0[i] = sigmoid_f(v0[i]); v1[i] = sigmoid_f(v1[i]); } }
                    if (seg == 2 || seg == 3) { float q = (v0[0] * v0[0] + v0[1] * v0[1]) + (v0[2] * v0[2] + v0[3] * v0[3]) + (v1[0] * v1[0] + v1[1] * v1[1]) + (v1[2] * v1[2] + v1[3] * v1[3]);
                        q += __shfl_xor(q, 16); q += __shfl_xor(q, 32); nm[bj] = fmaxf(nm[bj], q); }
                    u32x4 w; w.x = cvt_pk_bf16(v0[0], v0[1]); w.y = cvt_pk_bf16(v0[2], v0[3]); w.z = cvt_pk_bf16(v1[0], v1[1]); w.w = cvt_pk_bf16(v1[2], v1[3]);
                    *(u32x4*)(hm ? rowh + (size_t)bj * 4096 * 128 : rowp + bj * HALF) = w; } }
        if (seg == 2 || seg == 3) {
#pragma unroll
            for (int bj = 0; bj < 2; ++bj) { float q = nm[bj];
#pragma unroll
                for (int o = 1; o < 16; o <<= 1) q = fmaxf(q, __shfl_xor(q, o));
                if (fr == 0 && fq == 0) atomicMax(norm + ((((seg - 2) * 8 + (u.pm >> 4)) * 8 + 2 * (u.pn & 3) + bj) * 4 + wc), __float_as_uint(q)); }
        }
    }
};
template <int MODE> struct EpiGate {
    static constexpr bool PERM = true, AFTER_DRAIN = false; static constexpr int NSTORES = 16;
    const bf16_t* G; bf16_t* O;
    __device__ __forceinline__ void operator()(const f32x4 (&acc)[2][2][4][2], const Unit& u, int wr, int wc, int fr, int fq) const {
        const int row0 = u.pm * BM + wr * 64 + fr, col0 = u.pn * BM + wc * 32 + 8 * fq;
        u32x4 gv[2][2][2], pv[2][2][2];
#define EG_LOAD(st_, b_) do { _Pragma("unroll") for (int mm = 0; mm < 2; ++mm) _Pragma("unroll") for (int bj = 0; bj < 2; ++bj) { \
            const size_t off_ = (size_t)(row0 + ((st_) >> 1) * HALF + (2 * ((st_) & 1) + mm) * 16) * 1024 + col0 + bj * HALF; gv[b_][mm][bj] = __builtin_nontemporal_load((const u32x4*)(G + off_)); if (MODE == 1) pv[b_][mm][bj] = __builtin_nontemporal_load((const u32x4*)(O + off_)); } } while (0)
#define EG_DO(st_, b_) do { _Pragma("unroll") for (int mm = 0; mm < 2; ++mm) _Pragma("unroll") for (int bj = 0; bj < 2; ++bj) { const int ai = (st_) >> 1, m = 2 * ((st_) & 1) + mm; \
            const size_t off_ = (size_t)(row0 + ai * HALF + m * 16) * 1024 + col0 + bj * HALF; const u32x4 g = gv[b_][mm][bj]; \
            f32x4 v0 = acc[ai][bj][m][0], v1 = acc[ai][bj][m][1]; \
            v0[0] *= bf_lo(g.x); v0[1] *= bf_hi(g.x); v0[2] *= bf_lo(g.y); v0[3] *= bf_hi(g.y); v1[0] *= bf_lo(g.z); v1[1] *= bf_hi(g.z); v1[2] *= bf_lo(g.w); v1[3] *= bf_hi(g.w); \
            if (MODE == 1) { const u32x4 p = pv[b_][mm][bj]; \
                v0[0] += bf_lo(p.x); v0[1] += bf_hi(p.x); v0[2] += bf_lo(p.y); v0[3] += bf_hi(p.y); v1[0] += bf_lo(p.z); v1[1] += bf_hi(p.z); v1[2] += bf_lo(p.w); v1[3] += bf_hi(p.w); } \
            u32x4 w; w.x = cvt_pk_bf16(v0[0], v0[1]); w.y = cvt_pk_bf16(v0[2], v0[3]); w.z = cvt_pk_bf16(v1[0], v1[1]); w.w = cvt_pk_bf16(v1[2], v1[3]); \
            *(u32x4*)(O + off_) = w; } } while (0)
        EG_LOAD(0, 0); EG_LOAD(1, 1); EG_DO(0, 0); EG_LOAD(2, 0); EG_DO(1, 1); EG_LOAD(3, 1); EG_DO(2, 0); EG_DO(3, 1);
#undef EG_LOAD
#undef EG_DO
    }
};
struct TwoGemmOrder {
    StaticOrder base; int n1;
    __device__ void init(int M, int N, int G_, int c_) { base.init(M, N, G_, c_); n1 = (base.nwg - c_ + G_ - 1) / G_; if (n1 < 0) n1 = 0; }
    __device__ __forceinline__ bool next(int i, Unit& u) const { if (i >= 2 * n1) return false; const bool second = i >= n1; base.next(second ? i - n1 : i, u); if (second) { u.pm += 128; u.pn += 4; } return true; }
    __device__ __forceinline__ void a_ready(const Unit&) const {}
    __device__ __forceinline__ void done(const Unit&) const {}
};
struct EpiGate2 {
    static constexpr bool PERM = true, AFTER_DRAIN = false; static constexpr int NSTORES = 16;
    const bf16_t* G0; const bf16_t* G1; bf16_t* O;
    __device__ __forceinline__ void operator()(const f32x4 (&acc)[2][2][4][2], const Unit& u, int wr, int wc, int fr, int fq) const {
        Unit v; v.pm = u.pm & 127; v.pn = u.pn & 3;
        if (u.pm >= 128) { EpiGate<1> e{G1, O}; e(acc, v, wr, wc, fr, fq); } else { EpiGate<0> e{G0, O}; e(acc, v, wr, wc, fr, fq); }
    }
};
struct EpiDelta {
    static constexpr bool PERM = true, AFTER_DRAIN = false; static constexpr int NSTORES = 16;
    bf16_t* O;
    __device__ __forceinline__ void operator()(const f32x4 (&acc)[2][2][4][2], const Unit& u, int wr, int wc, int fr, int fq) const {
        const int row0 = u.pm * BM + wr * 64 + fr, col0 = u.pn * BM + wc * 32 + 8 * fq;
#pragma unroll
        for (int ai = 0; ai < 2; ++ai)
#pragma unroll
            for (int m = 0; m < 4; ++m) { bf16_t* rowp = O + (size_t)(row0 + ai * HALF + m * 16) * 1024 + col0;
#pragma unroll
                for (int bj = 0; bj < 2; ++bj) { const f32x4 v0 = acc[ai][bj][m][0], v1 = acc[ai][bj][m][1];
                    u32x4 w; w.x = cvt_pk_bf16(v0[0], v0[1]); w.y = cvt_pk_bf16(v0[2], v0[3]); w.z = cvt_pk_bf16(v1[0], v1[1]); w.w = cvt_pk_bf16(v1[2], v1[3]);
                    *(u32x4*)(rowp + bj * HALF) = w; } }
    }
};
template <int HOOK> struct GroupedOrderT {
    const PG8_LAS int* tile_e; int nunits, G, c; unsigned* rdy; int wid; unsigned* tmo;
    __device__ __forceinline__ bool next(int i, Unit& u) const { const int L = i * G + c; if (L >= nunits) return false; u.pm = L >> 2; u.pn = __builtin_amdgcn_readfirstlane(tile_e[u.pm]) * 4 + (L & 3); return true; }
    __device__ __forceinline__ void a_ready(const Unit& u) const {
        if constexpr (HOOK == 2) {
            if (wid == 0) { unsigned sp = 0u;
                while ((unsigned)__builtin_amdgcn_readfirstlane(__hip_atomic_load(rdy + 8 * u.pm, __ATOMIC_RELAXED, __HIP_MEMORY_SCOPE_AGENT)) < 32u) {
                    __builtin_amdgcn_s_sleep(2);
                    if ((++sp & 1023u) == 0u) { if (__builtin_amdgcn_readfirstlane(__hip_atomic_load(tmo, __ATOMIC_RELAXED, __HIP_MEMORY_SCOPE_AGENT)) != 0u) break;
                        if (sp > (1u << 20)) { if (lane_now() == 0) __hip_atomic_store(tmo, 1u, __ATOMIC_RELAXED, __HIP_MEMORY_SCOPE_AGENT); break; } } }
                __builtin_amdgcn_fence(__ATOMIC_ACQUIRE, "agent");
                asm volatile("s_waitcnt vmcnt(0)" ::: "memory"); }
            asm volatile("" ::: "memory"); __builtin_amdgcn_s_barrier(); asm volatile("" ::: "memory");
        }
    }
    mutable int pend = -1;
    __device__ __forceinline__ void done(const Unit& u) const { if constexpr (HOOK == 1) pend = u.pm; }
    __device__ __forceinline__ void pre() const {
        if constexpr (HOOK == 1) { if (pend >= 0) { asm volatile("s_waitcnt vmcnt(24)" ::: "memory");
            if (lane_now() == 0) (void)__hip_atomic_fetch_add(rdy + 8 * pend, 1u, __ATOMIC_RELAXED, __HIP_MEMORY_SCOPE_AGENT); pend = -1; } }
    }
    __device__ __forceinline__ void fin() const {
        if constexpr (HOOK == 1) { if (pend >= 0) { asm volatile("s_waitcnt vmcnt(0)" ::: "memory");
            if (lane_now() == 0) (void)__hip_atomic_fetch_add(rdy + 8 * pend, 1u, __ATOMIC_RELAXED, __HIP_MEMORY_SCOPE_AGENT); pend = -1; } }
    }
};
using GroupedOrder = GroupedOrderT<0>;
struct EpiSwiGLU {
    static constexpr bool PERM = true, AFTER_DRAIN = false; static constexpr int NSTORES = 8;
    unsigned char* HB;
    __device__ __forceinline__ void operator()(const f32x4 (&acc)[2][2][4][2], const Unit& u, int wr, int wc, int fr, int fq, const PG8_LAS int* rows) const {
        const int row0 = u.pm * BM + wr * 64 + fr, col0 = (u.pn & 3) * HALF + wc * 32 + 8 * fq;
        float sv[2][4];
#pragma unroll
        for (int ai = 0; ai < 2; ++ai)
#pragma unroll
            for (int m = 0; m < 4; ++m) sv[ai][m] = ((const PG8_LAS float*)rows)[6 * 256 + wr * 64 + fr + ai * HALF + m * 16] * (1.0f / W13_SCALE);
#pragma unroll
        for (int ai = 0; ai < 2; ++ai)
#pragma unroll
            for (int m = 0; m < 4; ++m) { const int row = row0 + ai * HALF + m * 16; const float s = sv[ai][m];
                float o[8];
#pragma unroll
                for (int n = 0; n < 2; ++n)
#pragma unroll
                    for (int i = 0; i < 4; ++i) { const float g = acc[ai][0][m][n][i] * s, uu = acc[ai][1][m][n][i] * s; o[n * 4 + i] = g * sigmoid_f(g) * uu * HB_SCALE; }
                unsigned long long w = (unsigned long long)pack4_fp8(o[0], o[1], o[2], o[3]) | ((unsigned long long)pack4_fp8(o[4], o[5], o[6], o[7]) << 32);
                asm volatile("global_store_dwordx2 %0, %1, off sc1" :: "v"((unsigned long long*)(HB + (size_t)row * 512 + col0)), "v"(w) : "memory"); }
    }
};
constexpr float Y_SCALE = 0.25f;
struct EpiY {
    static constexpr bool PERM = true, AFTER_DRAIN = false; static constexpr int NSTORES = 16;
    unsigned char* Y;
    __device__ __forceinline__ void operator()(const f32x4 (&acc)[2][2][4][2], const Unit& u, int wr, int wc, int fr, int fq) const {
        const int row0 = u.pm * BM + wr * 64 + fr, col0 = (u.pn & 3) * BM + wc * 32 + 8 * fq;
#pragma unroll
        for (int ai = 0; ai < 2; ++ai)
#pragma unroll
            for (int m = 0; m < 4; ++m) { const int row = row0 + ai * HALF + m * 16; unsigned char* rowp = Y + (size_t)row * 1024 + col0;
#pragma unroll
                for (int bj = 0; bj < 2; ++bj) { const f32x4 v0 = acc[ai][bj][m][0] * Y_SCALE, v1 = acc[ai][bj][m][1] * Y_SCALE;
                    *(unsigned long long*)(rowp + bj * HALF) = (unsigned long long)pack4_fp8(v0[0], v0[1], v0[2], v0[3]) | ((unsigned long long)pack4_fp8(v1[0], v1[1], v1[2], v1[3]) << 32); } }
    }
};
template <class Epi, class Sched, bool ALIGN_EPI = false, bool SP2 = false, bool F8 = false>
__device__ __forceinline__ void gemm_phase(PG8_LAS unsigned char* lds, const Gemm g, const Sched& S, const Epi& E, const int wid) {
    const int lane = lane_now(), tid = wid * 64 + lane, wr = wid >> 2, wc = wid & 3, fr = lane & 15, fq = lane >> 4;
    const int K = g.K, nt = K / BK;
    unsigned voffA[2], voffB[2];
#pragma unroll
    for (int i = 0; i < 2; ++i) { int R, C; stage_rc(tid * 16 + i * 8192, R, C); const int Rb = Epi::PERM ? ((R & ~31) + perm32(R & 31)) : R;
        voffA[i] = (unsigned)(R * K + C) * 2u; voffB[i] = (unsigned)(Rb * K + C) * 2u; }
    const size_t kstep = (size_t)(BK * 2);
    const size_t hstep = (size_t)HALF * K * 2;
    const size_t tstep = 2 * hstep;
    const unsigned ldsw = (unsigned)wid * 1024u;
    const unsigned ldsbase = (unsigned)__builtin_amdgcn_readfirstlane((int)((unsigned)(uintptr_t)lds + ldsw));
    const int aoff = lds_byte(wr * 64 + fr, fq * 8), boff = lds_byte(wc * 32 + fr, fq * 8);
#define PG8_SA(b, h) (((b) * 2 + (h)) * HTB)
#define PG8_SB(b, h) ((4 + (b) * 2 + (h)) * HTB)
#define PG8_STAGE(bufoff, gbase, voff) do { _Pragma("unroll") for (int _i = 0; _i < 2; ++_i) { \
        if constexpr (F8) glds_sv((const char*)(gbase), (voff)[_i], ldsbase + (unsigned)((bufoff) + _i * 8192)); \
        else __builtin_amdgcn_global_load_lds((const unsigned*)((const char*)(gbase) + (voff)[_i]), (PG8_LAS unsigned*)(lds + (bufoff) + ldsw + _i * 8192), 16, 0, 0); } } while (0)
#define PG8_LDA(dst, b, h) do { _Pragma("unroll") for (int m = 0; m < 4; ++m) { \
        if constexpr (F8) { dst##8[m] = cat8(*(const PG8_LAS bf16x8*)(lds + PG8_SA(b, h) + aoff + m * 2048), *(const PG8_LAS bf16x8*)(lds + PG8_SA(b, h) + aoff + m * 2048 + 1024)); } \
        else { _Pragma("unroll") for (int k = 0; k < 2; ++k) dst[m][k] = *(const PG8_LAS bf16x8*)(lds + PG8_SA(b, h) + aoff + m * 2048 + k * 1024); } } } while (0)
#define PG8_LDB(dst, b, h) do { _Pragma("unroll") for (int n = 0; n < 2; ++n) { \
        if constexpr (F8) { dst##8[n] = cat8(*(const PG8_LAS bf16x8*)(lds + PG8_SB(b, h) + boff + n * 2048), *(const PG8_LAS bf16x8*)(lds + PG8_SB(b, h) + boff + n * 2048 + 1024)); } \
        else { _Pragma("unroll") for (int k = 0; k < 2; ++k) dst[n][k] = *(const PG8_LAS bf16x8*)(lds + PG8_SB(b, h) + boff + n * 2048 + k * 1024); } } } while (0)
#define PG8_MMA(ai, bj, At, Bt) do { __builtin_amdgcn_s_setprio(1); _Pragma("unroll") for (int m = 0; m < 4; ++m) _Pragma("unroll") for (int n = 0; n < 2; ++n) { \
        if constexpr (F8) { acc[ai][bj][m][n] = __builtin_amdgcn_mfma_scale_f32_16x16x128_f8f6f4(Bt##8[n], At##8[m], acc[ai][bj][m][n], 0, 0, 0, 0, 0, 0); } \
        else { _Pragma("unroll") for (int k = 0; k < 2; ++k) acc[ai][bj][m][n] = __builtin_amdgcn_mfma_f32_16x16x32_bf16(Bt[n][k], At[m][k], acc[ai][bj][m][n], 0, 0, 0); } } \
        __builtin_amdgcn_s_setprio(0); } while (0)
#define PG8_WAIT_V(n) asm volatile("s_waitcnt vmcnt(" #n ")" ::: "memory")
#define PG8_WAIT_L(n) asm volatile("s_waitcnt lgkmcnt(" #n ")" ::: "memory")
#define PG8_BAR __builtin_amdgcn_s_barrier()
#define PG8_SCHED __builtin_amdgcn_sched_barrier(0)
    Unit cur, nxt; int ui = 0;
    if (!S.next(0, cur)) return;
    f32x4 acc[2][2][4][2];
#pragma unroll
    for (int a = 0; a < 2; ++a)
#pragma unroll
        for (int b = 0; b < 2; ++b)
#pragma unroll
            for (int m = 0; m < 4; ++m)
#pragma unroll
                for (int n = 0; n < 2; ++n) acc[a][b][m][n] = (f32x4){0.f, 0.f, 0.f, 0.f};
    bf16x8 At[4][2], B0[2][2], B1[2][2]; v8i_t At8[4], B08[2], B18[2];
    const char* cA = (const char*)g.A + (size_t)cur.pm * tstep; const char* cB = (const char*)g.Bt + (size_t)cur.pn * tstep;
    S.a_ready(cur);
    if constexpr (SP2) {
        PG8_STAGE(PG8_SB(0, 0), cB, voffB); PG8_STAGE(PG8_SB(0, 1), cB + hstep, voffB); PG8_STAGE(PG8_SA(0, 0), cA, voffA); PG8_STAGE(PG8_SA(0, 1), cA + hstep, voffA);
        if (wr == 1) PG8_BAR;
        PG8_WAIT_V(2); PG8_BAR;
        PG8_STAGE(PG8_SB(1, 0), cB + kstep, voffB); PG8_STAGE(PG8_SA(1, 0), cA + kstep, voffA); PG8_STAGE(PG8_SB(1, 1), cB + hstep + kstep, voffB);
        PG8_WAIT_V(6); PG8_BAR;
    } else {
        PG8_STAGE(PG8_SB(0, 0), cB, voffB); PG8_STAGE(PG8_SA(0, 0), cA, voffA); PG8_STAGE(PG8_SB(0, 1), cB + hstep, voffB); PG8_STAGE(PG8_SA(0, 1), cA + hstep, voffA);
        if (wr == 1) PG8_BAR;
        PG8_WAIT_V(4); PG8_BAR;
        PG8_STAGE(PG8_SB(1, 0), cB + kstep, voffB); PG8_STAGE(PG8_SA(1, 0), cA + kstep, voffA); PG8_STAGE(PG8_SB(1, 1), cB + hstep + kstep, voffB);
        PG8_WAIT_V(6); PG8_BAR;
    }
    for (;;) {
        const bool has_next = S.next(ui + 1, nxt);
        const char* nA = has_next ? (const char*)g.A + (size_t)nxt.pm * tstep : cA; const char* nB = has_next ? (const char*)g.Bt + (size_t)nxt.pn * tstep : cB;
#pragma clang loop unroll(disable)
        for (int t = 0; t < nt; t += 2) {
            const bool last = (t == nt - 2);
            const char* a1 = cA + (size_t)(t + 1) * kstep;
            const char* a2 = last ? nA : cA + (size_t)(t + 2) * kstep; const char* b2 = last ? nB : cB + (size_t)(t + 2) * kstep;
            const char* a3 = a2 + kstep; const char* b3 = b2 + kstep;
            if (last && has_next) S.a_ready(nxt);
            if constexpr (SP2) {
            PG8_LDB(B0, 0, 0); PG8_LDB(B1, 0, 1); PG8_SCHED; PG8_LDA(At, 0, 0); PG8_STAGE(PG8_SA(1, 1), a1 + hstep, voffA);
            PG8_WAIT_V(8); PG8_WAIT_L(0); PG8_BAR; PG8_MMA(0, 0, At, B0); PG8_MMA(0, 1, At, B1); PG8_BAR; PG8_SCHED;
            PG8_LDA(At, 0, 1); PG8_STAGE(PG8_SB(0, 0), b2, voffB); PG8_STAGE(PG8_SB(0, 1), b2 + hstep, voffB); PG8_STAGE(PG8_SA(0, 0), a2, voffA);
            PG8_WAIT_V(8); PG8_WAIT_L(0); PG8_BAR; PG8_MMA(1, 0, At, B0); PG8_MMA(1, 1, At, B1); PG8_BAR; PG8_SCHED;
            PG8_LDB(B0, 1, 0); PG8_LDB(B1, 1, 1); PG8_SCHED; PG8_LDA(At, 1, 0); PG8_STAGE(PG8_SA(0, 1), a2 + hstep, voffA);
            PG8_WAIT_V(8); PG8_WAIT_L(0); PG8_BAR; PG8_MMA(0, 0, At, B0); PG8_MMA(0, 1, At, B1); PG8_BAR; PG8_SCHED;
            PG8_LDA(At, 1, 1); PG8_STAGE(PG8_SB(1, 0), b3, voffB); PG8_STAGE(PG8_SB(1, 1), b3 + hstep, voffB); PG8_STAGE(PG8_SA(1, 0), a3, voffA);
            PG8_WAIT_V(8); PG8_WAIT_L(0); PG8_BAR; PG8_MMA(1, 0, At, B0); PG8_MMA(1, 1, At, B1); PG8_BAR; PG8_SCHED;
            } else {
            PG8_LDB(B0, 0, 0); PG8_SCHED; PG8_LDA(At, 0, 0); PG8_STAGE(PG8_SA(1, 1), a1 + hstep, voffA);
            PG8_WAIT_L(8); PG8_BAR; PG8_WAIT_L(0); PG8_MMA(0, 0, At, B0); PG8_BAR; PG8_SCHED;
            PG8_LDB(B1, 0, 1); PG8_STAGE(PG8_SB(0, 0), b2, voffB);
            PG8_BAR; PG8_WAIT_L(0); PG8_MMA(0, 1, At, B1); PG8_BAR;
            PG8_LDA(At, 0, 1); PG8_STAGE(PG8_SA(0, 0), a2, voffA);
            PG8_BAR; PG8_WAIT_L(0); PG8_MMA(1, 0, At, B0); PG8_BAR; PG8_SCHED;
            PG8_STAGE(PG8_SB(0, 1), b2 + hstep, voffB);
            PG8_WAIT_V(6); PG8_BAR; PG8_MMA(1, 1, At, B1); PG8_BAR;
            PG8_LDB(B0, 1, 0); PG8_SCHED; PG8_LDA(At, 1, 0); PG8_STAGE(PG8_SA(0, 1), a2 + hstep, voffA);
            PG8_WAIT_L(8); PG8_BAR; PG8_WAIT_L(0); PG8_MMA(0, 0, At, B0); PG8_BAR; PG8_SCHED;
            PG8_LDB(B1, 1, 1); PG8_STAGE(PG8_SB(1, 0), b3, voffB);
            PG8_BAR; PG8_WAIT_L(0); PG8_MMA(0, 1, At, B1); PG8_BAR;
            PG8_LDA(At, 1, 1); PG8_STAGE(PG8_SA(1, 0), a3, voffA);
            PG8_BAR; PG8_WAIT_L(0); PG8_MMA(1, 0, At, B0); PG8_BAR; PG8_SCHED;
            PG8_STAGE(PG8_SB(1, 1), b3 + hstep, voffB);
            PG8_WAIT_V(6); PG8_BAR; PG8_MMA(1, 1, At, B1); PG8_BAR;
            }
        }
        if constexpr (ALIGN_EPI) { if (wr == 0) PG8_BAR; }
        if constexpr (!Epi::AFTER_DRAIN) { const int l2 = lane_now(); E(acc, cur, wr, wc, l2 & 15, l2 >> 4); S.done(cur); }
        if (!has_next) break;
#pragma unroll
        for (int a = 0; a < 2; ++a)
#pragma unroll
            for (int b = 0; b < 2; ++b)
#pragma unroll
                for (int m = 0; m < 4; ++m)
#pragma unroll
                    for (int n = 0; n < 2; ++n) acc[a][b][m][n] = (f32x4){0.f, 0.f, 0.f, 0.f};
        cur = nxt; cA = nA; cB = nB; ++ui;
        if constexpr (ALIGN_EPI) { if (wr == 1) PG8_BAR; }
    }
    PG8_WAIT_V(0);
    if constexpr (!ALIGN_EPI) { if (wr == 0) PG8_BAR; }
    PG8_BAR;
    if constexpr (Epi::AFTER_DRAIN) { E.fused(acc, cur, wr, wc, fr, fq, lds, wid, lane); S.done(cur); }
#undef PG8_SA
#undef PG8_SB
#undef PG8_STAGE
#undef PG8_LDA
#undef PG8_LDB
#undef PG8_MMA
#undef PG8_WAIT_V
#undef PG8_WAIT_L
#undef PG8_BAR
#undef PG8_SCHED
}
template <class Epi, class Sched, bool F8 = false>
__device__ __forceinline__ void gemm_phase_gather(PG8_LAS unsigned char* lds, const Gemm g, const Sched& S, const Epi& E, const PG8_LAS int* rowtab, const int wid) {
    constexpr bool ALIGN_EPI = true, SP2 = true;
    const int lane = lane_now(), tid = wid * 64 + lane, wr = wid >> 2, wc = wid & 3, fr = lane & 15, fq = lane >> 4;
    const int K = g.K, nt = K / BK;
    unsigned voffB[2], vAc[2][2];
#pragma unroll
    for (int i = 0; i < 2; ++i) { int R, C; stage_rc(tid * 16 + i * 8192, R, C); const int Rb = Epi::PERM ? ((R & ~31) + perm32(R & 31)) : R;
        voffB[i] = (unsigned)(Rb * K + C) * 2u; }
#define PG8_ROWS(dst, ui_) do { const int t_ = wid * 64 + lane_now(); _Pragma("unroll") for (int i_ = 0; i_ < 2; ++i_) { int R_, C_; stage_rc(t_ * 16 + i_ * 8192, R_, C_); \
        _Pragma("unroll") for (int h_ = 0; h_ < 2; ++h_) dst[h_][i_] = (unsigned)rowtab[(ui_) * 256 + h_ * HALF + R_] * (unsigned)(K * 2) + (unsigned)(C_ * 2); } } while (0)
#define PG8_STAGE_A(bufoff, v, kb) do { _Pragma("unroll") for (int _i = 0; _i < 2; ++_i) { \
        if constexpr (F8) glds_sv((const char*)g.A + (kb), (v)[_i], ldsbase + (unsigned)((bufoff) + _i * 8192)); \
        else __builtin_amdgcn_global_load_lds((const unsigned*)((const char*)g.A + (v)[_i] + (kb)), (PG8_LAS unsigned*)(lds + (bufoff) + ldsw + _i * 8192), 16, 0, 0); } } while (0)
    const size_t kstep = (size_t)(BK * 2);
    const size_t hstep = (size_t)HALF * K * 2;
    const size_t tstep = 2 * hstep;
    const unsigned ldsw = (unsigned)wid * 1024u;
    const unsigned ldsbase = (unsigned)__builtin_amdgcn_readfirstlane((int)((unsigned)(uintptr_t)lds + ldsw));
    const int aoff = lds_byte(wr * 64 + fr, fq * 8), boff = lds_byte(wc * 32 + fr, fq * 8);
#define PG8_SA(b, h) (((b) * 2 + (h)) * HTB)
#define PG8_SB(b, h) ((4 + (b) * 2 + (h)) * HTB)
#define PG8_STAGE(bufoff, gbase, voff) do { _Pragma("unroll") for (int _i = 0; _i < 2; ++_i) { \
        if constexpr (F8) glds_sv((const char*)(gbase), (voff)[_i], ldsbase + (unsigned)((bufoff) + _i * 8192)); \
        else __builtin_amdgcn_global_load_lds((const unsigned*)((const char*)(gbase) + (voff)[_i]), (PG8_LAS unsigned*)(lds + (bufoff) + ldsw + _i * 8192), 16, 0, 0); } } while (0)
#define PG8_LDA(dst, b, h) do { _Pragma("unroll") for (int m = 0; m < 4; ++m) { \
        if constexpr (F8) { dst##8[m] = cat8(*(const PG8_LAS bf16x8*)(lds + PG8_SA(b, h) + aoff + m * 2048), *(const PG8_LAS bf16x8*)(lds + PG8_SA(b, h) + aoff + m * 2048 + 1024)); } \
        else { _Pragma("unroll") for (int k = 0; k < 2; ++k) dst[m][k] = *(const PG8_LAS bf16x8*)(lds + PG8_SA(b, h) + aoff + m * 2048 + k * 1024); } } } while (0)
#define PG8_LDB(dst, b, h) do { _Pragma("unroll") for (int n = 0; n < 2; ++n) { \
        if constexpr (F8) { dst##8[n] = cat8(*(const PG8_LAS bf16x8*)(lds + PG8_SB(b, h) + boff + n * 2048), *(const PG8_LAS bf16x8*)(lds + PG8_SB(b, h) + boff + n * 2048 + 1024)); } \
        else { _Pragma("unroll") for (int k = 0; k < 2; ++k) dst[n][k] = *(const PG8_LAS bf16x8*)(lds + PG8_SB(b, h) + boff + n * 2048 + k * 1024); } } } while (0)
#define PG8_MMA(ai, bj, At, Bt) do { __builtin_amdgcn_s_setprio(1); _Pragma("unroll") for (int m = 0; m < 4; ++m) _Pragma("unroll") for (int n = 0; n < 2; ++n) { \
        if constexpr (F8) { acc[ai][bj][m][n] = __builtin_amdgcn_mfma_scale_f32_16x16x128_f8f6f4(Bt##8[n], At##8[m], acc[ai][bj][m][n], 0, 0, 0, 0, 0, 0); } \
        else { _Pragma("unroll") for (int k = 0; k < 2; ++k) acc[ai][bj][m][n] = __builtin_amdgcn_mfma_f32_16x16x32_bf16(Bt[n][k], At[m][k], acc[ai][bj][m][n], 0, 0, 0); } } \
        __builtin_amdgcn_s_setprio(0); } while (0)
#define PG8_WAIT_V(n) asm volatile("s_waitcnt vmcnt(" #n ")" ::: "memory")
#define PG8_WAIT_L(n) asm volatile("s_waitcnt lgkmcnt(" #n ")" ::: "memory")
#define PG8_BAR __builtin_amdgcn_s_barrier()
#define PG8_SCHED __builtin_amdgcn_sched_barrier(0)
    Unit cur, nxt; int ui = 0;
    if (!S.next(0, cur)) return;
    f32x4 acc[2][2][4][2];
#pragma unroll
    for (int a = 0; a < 2; ++a)
#pragma unroll
        for (int b = 0; b < 2; ++b)
#pragma unroll
            for (int m = 0; m < 4; ++m)
#pragma unroll
                for (int n = 0; n < 2; ++n) acc[a][b][m][n] = (f32x4){0.f, 0.f, 0.f, 0.f};
    bf16x8 At[4][2], B0[2][2], B1[2][2]; v8i_t At8[4], B08[2], B18[2];
    const char* cB = (const char*)g.Bt + (size_t)cur.pn * tstep;
    PG8_ROWS(vAc, 0);
    S.a_ready(cur);
    if constexpr (SP2) {
        PG8_STAGE(PG8_SB(0, 0), cB, voffB); PG8_STAGE(PG8_SB(0, 1), cB + hstep, voffB); PG8_STAGE_A(PG8_SA(0, 0), vAc[0], 0u); PG8_STAGE_A(PG8_SA(0, 1), vAc[1], 0u);
        if (wr == 1) PG8_BAR;
        PG8_WAIT_V(2); PG8_BAR;
        PG8_STAGE(PG8_SB(1, 0), cB + kstep, voffB); PG8_STAGE_A(PG8_SA(1, 0), vAc[0], (unsigned)kstep); PG8_STAGE(PG8_SB(1, 1), cB + hstep + kstep, voffB);
        PG8_WAIT_V(6); PG8_BAR;
    }
    for (;;) {
        const bool has_next = S.next(ui + 1, nxt);
        const char* nB = has_next ? (const char*)g.Bt + (size_t)nxt.pn * tstep : cB;
#pragma clang loop unroll(disable)
        for (int t = 0; t < nt; t += 2) {
            const bool last = (t == nt - 2);
            const unsigned k1 = (unsigned)((t + 1) * (int)kstep), k2 = last ? 0u : (unsigned)((t + 2) * (int)kstep), k3 = k2 + (unsigned)kstep;
            unsigned v2[2][2];
            if (last && has_next) { PG8_ROWS(v2, ui + 1); }
            else {
#pragma unroll
                for (int h_ = 0; h_ < 2; ++h_)
#pragma unroll
                    for (int i_ = 0; i_ < 2; ++i_) v2[h_][i_] = vAc[h_][i_]; }
            const char* b2 = last ? nB : cB + (size_t)(t + 2) * kstep; const char* b3 = b2 + kstep;
            if (last && has_next) S.a_ready(nxt);
            if constexpr (SP2) {
            PG8_LDB(B0, 0, 0); PG8_LDB(B1, 0, 1); PG8_SCHED; PG8_LDA(At, 0, 0); PG8_STAGE_A(PG8_SA(1, 1), vAc[1], k1);
            PG8_WAIT_V(8); PG8_WAIT_L(0); PG8_BAR; PG8_MMA(0, 0, At, B0); PG8_MMA(0, 1, At, B1); PG8_BAR; PG8_SCHED;
            PG8_LDA(At, 0, 1); PG8_STAGE(PG8_SB(0, 0), b2, voffB); PG8_STAGE(PG8_SB(0, 1), b2 + hstep, voffB); PG8_STAGE_A(PG8_SA(0, 0), v2[0], k2);
            PG8_WAIT_V(8); PG8_WAIT_L(0); PG8_BAR; PG8_MMA(1, 0, At, B0); PG8_MMA(1, 1, At, B1); PG8_BAR; PG8_SCHED;
            PG8_LDB(B0, 1, 0); PG8_LDB(B1, 1, 1); PG8_SCHED; PG8_LDA(At, 1, 0); PG8_STAGE_A(PG8_SA(0, 1), v2[1], k2);
            PG8_WAIT_V(8); PG8_WAIT_L(0); PG8_BAR; PG8_MMA(0, 0, At, B0); PG8_MMA(0, 1, At, B1); PG8_BAR; PG8_SCHED;
            PG8_LDA(At, 1, 1); PG8_STAGE(PG8_SB(1, 0), b3, voffB); PG8_STAGE(PG8_SB(1, 1), b3 + hstep, voffB); PG8_STAGE_A(PG8_SA(1, 0), v2[0], k3);
            PG8_WAIT_V(8); PG8_WAIT_L(0); PG8_BAR; PG8_MMA(1, 0, At, B0); PG8_MMA(1, 1, At, B1); PG8_BAR; PG8_SCHED;
            }
        }
        if constexpr (ALIGN_EPI) { if (wr == 0) PG8_BAR; }
        S.pre(); { const int l2 = lane_now(); E(acc, cur, wr, wc, l2 & 15, l2 >> 4, rowtab + ui * 256); } S.done(cur);
        if (!has_next) break;
#pragma unroll
        for (int a = 0; a < 2; ++a)
#pragma unroll
            for (int b = 0; b < 2; ++b)
#pragma unroll
                for (int m = 0; m < 4; ++m)
#pragma unroll
                    for (int n = 0; n < 2; ++n) acc[a][b][m][n] = (f32x4){0.f, 0.f, 0.f, 0.f};
        cur = nxt; cB = nB; ++ui;
        PG8_ROWS(vAc, ui);
        if constexpr (ALIGN_EPI) { if (wr == 1) PG8_BAR; }
    }
    PG8_WAIT_V(0);
    S.fin();
    if constexpr (!ALIGN_EPI) { if (wr == 0) PG8_BAR; }
    PG8_BAR;
#undef PG8_ROWS
#undef PG8_STAGE_A
#undef PG8_SA
#undef PG8_SB
#undef PG8_STAGE
#undef PG8_LDA
#undef PG8_LDB
#undef PG8_MMA
#undef PG8_WAIT_V
#undef PG8_WAIT_L
#undef PG8_BAR
#undef PG8_SCHED
}
}
#define GAS __attribute__((address_space(1)))
#define LAS __attribute__((address_space(3)))
typedef unsigned short bf16;
typedef unsigned v4u __attribute__((ext_vector_type(4)));
typedef float f32x4 __attribute__((ext_vector_type(4)));
typedef short bf16x8 __attribute__((ext_vector_type(8)));
typedef GAS unsigned gu32;
typedef GAS unsigned long long gu64;
#define RLX_AGENT __ATOMIC_RELAXED, __HIP_MEMORY_SCOPE_AGENT
#define LDS_WAIT() asm volatile("s_waitcnt lgkmcnt(0)" ::: "memory")
#define VM_WAIT() asm volatile("s_waitcnt vmcnt(0)" ::: "memory")
__device__ __forceinline__ unsigned long long rt() { return __builtin_amdgcn_s_memrealtime(); }
__device__ __forceinline__ unsigned f2bf(float f) { unsigned u = __builtin_bit_cast(unsigned, f); return (u + 0x7fffu + ((u >> 16) & 1u)) >> 16; }
__device__ __forceinline__ unsigned pk2(float lo, float hi) { return f2bf(lo) | (f2bf(hi) << 16); }
#define XB_TMO      128
#define XB_XCNT(j)  (256  + 64 * (j))
#define XB_XSUB(j)  (1280 + 64 * (j))
#define XB_XGEN(j)  (2304 + 64 * (j))
#define XB_TOP      3328
#define XB_TOPGEN   3392
#define XCD_BAR_WORDS 3456
#define XB_SPIN_CAP (1u << 18)

__device__ __forceinline__ unsigned xb_ld(unsigned* p)              { return __hip_atomic_load(p, __ATOMIC_RELAXED, __HIP_MEMORY_SCOPE_AGENT); }
__device__ __forceinline__ unsigned xb_add(unsigned* p, unsigned v) { return __hip_atomic_fetch_add(p, v, __ATOMIC_RELAXED, __HIP_MEMORY_SCOPE_AGENT); }
__device__ __forceinline__ unsigned xb_xcc_id() { return (unsigned)__builtin_amdgcn_s_getreg((3 << 11) | 20) & 0xFu; }
#define XB_SPIN(cond, bar) do { unsigned _sp = 0; while (cond) { __builtin_amdgcn_s_sleep(1); \
    if ((++_sp & 255u) == 0u) { if (xb_ld(&(bar)[XB_TMO])) break; if (_sp > XB_SPIN_CAP) { atomicAdd(&(bar)[XB_TMO], 1u); break; } } } } while (0)

struct XcdBarrier {
    unsigned* bar; unsigned x;
    volatile LAS unsigned* st;
};

__device__ __forceinline__ XcdBarrier xcd_barrier_post(unsigned* bar, volatile LAS unsigned* st) {
    XcdBarrier b; b.bar = bar; b.x = xb_xcc_id(); b.st = st;
    if (threadIdx.x == 0) (void)xb_add(&bar[XB_XCNT(b.x)], 1u);
    return b;
}
__device__ __forceinline__ void xcd_barrier_complete(unsigned* bar, unsigned x, unsigned& nloc, unsigned& nx) {
    const unsigned G = gridDim.x * gridDim.y * gridDim.z;
    unsigned sum, cnt, mine, sp = 0u;
    for (;;) {
        sum = 0u; cnt = 0u; mine = 0u;
#pragma unroll
        for (unsigned j = 0; j < 16; ++j) { const unsigned c = xb_ld(&bar[XB_XCNT(j)]); sum += c; cnt += (c > 0u) ? 1u : 0u; mine = (j == x) ? c : mine; }
        if (sum == G) break;
        __builtin_amdgcn_s_sleep(1);
        if ((++sp & 255u) == 0u) { if (xb_ld(&bar[XB_TMO])) break; if (sp > XB_SPIN_CAP) { atomicAdd(&bar[XB_TMO], 1u); break; } }
    }
    nloc = mine > 0u ? mine : 1u; nx = cnt > 0u ? cnt : 1u;
}

__device__ __forceinline__ void xcd_barrier(const XcdBarrier& b) {
    asm volatile("s_waitcnt vmcnt(0)" ::: "memory");
    __syncthreads();
    if (threadIdx.x == 0) {
        unsigned* bar = b.bar;
        __builtin_amdgcn_s_waitcnt(0);
        unsigned nloc = b.st[0], nx = b.st[1];
        if (nloc == 0u) { xcd_barrier_complete(bar, b.x, nloc, nx); b.st[0] = nloc; b.st[1] = nx; }
        const unsigned old = xb_add(&bar[XB_XSUB(b.x)], 1u);
        const unsigned gen = old / nloc;
        if (old + 1u == (gen + 1u) * nloc) {
            __builtin_amdgcn_fence(__ATOMIC_RELEASE, "agent");
            asm volatile("s_waitcnt vmcnt(0)" ::: "memory");
            const unsigned og = xb_add(&bar[XB_TOP], 1u);
            const unsigned tg = og / nx;
            if (og + 1u == (tg + 1u) * nx) xb_add(&bar[XB_TOPGEN], 1u);
            else XB_SPIN(xb_ld(&bar[XB_TOPGEN]) == tg, bar);
            __builtin_amdgcn_fence(__ATOMIC_ACQUIRE, "agent");
            xb_add(&bar[XB_XGEN(b.x)], 1u);
            asm volatile("s_waitcnt vmcnt(0)" ::: "memory");
        } else {
            XB_SPIN(xb_ld(&bar[XB_XGEN(b.x)]) == gen, bar);
            __builtin_amdgcn_fence(__ATOMIC_ACQUIRE, "agent");
            asm volatile("s_waitcnt vmcnt(0)" ::: "memory");
        }
    }
    __syncthreads();
}
namespace fattn {
typedef unsigned short bf16;
typedef short bf16x8 __attribute__((ext_vector_type(8)));
typedef short s16x4 __attribute__((ext_vector_type(4)));
typedef float f32x16 __attribute__((ext_vector_type(16)));
typedef float f32x4 __attribute__((ext_vector_type(4)));
typedef unsigned u32x4 __attribute__((ext_vector_type(4)));
constexpr int D = 128, LD = 128, LDO = 1024, SEQ = 4096;
constexpr float THR = 8.f;
constexpr float SCALE = 0.08838834764831845f;
constexpr int NW = 8, QBLK = 32, KVBLK = 64, QB = NW * QBLK;
constexpr int SHM_V = KVBLK * D * 2, SHM_K = KVBLK * D * 2;
constexpr int OFF_WS = 2 * SHM_V + 2 * SHM_K, OFF_BIAS = OFF_WS + NW * 64 * 4, LDS_BYTES = OFF_BIAS + 2 * 64 * 4;

#define KSWZ(row, colB) ((row) * 256 + ((colB) ^ (((row) & 7) << 4)))
#define SBAR() __builtin_amdgcn_sched_barrier(0)
__device__ __forceinline__ int v_st(int k, int c) { const int kk = (k & ~0xC) | ((k & 4) << 1) | ((k & 8) >> 1); return ((kk >> 3) * 4 + (c >> 5)) * 512 + ((kk & 7) * 32 + (c & 31)) * 2; }
__device__ __forceinline__ int v_rd_base(int lane) { return ((lane & 3) << 3) | (((lane >> 2) & 3) << 6) | (((lane >> 4) & 1) << 5) | (((lane >> 5) & 1) << 8); }
constexpr int v_rd_off(int d0, int ks, int half) { return d0 * 512 + ks * 4096 + half * 2048; }
__device__ __forceinline__ int crow(int r, int hi) { return (r & 3) + 8 * (r >> 2) + 4 * hi; }
__device__ __forceinline__ unsigned cvtpk(float lo, float hi) { unsigned r; asm volatile("v_cvt_pk_bf16_f32 %0, %1, %2" : "=v"(r) : "v"(lo), "v"(hi)); return r; }
__device__ __forceinline__ bf16x8 load8(const bf16* p) { return *reinterpret_cast<const bf16x8*>(p); }
__device__ __forceinline__ void mask_tile(f32x16& p0, f32x16& p1, int dq) {
    const float NEG = -__builtin_inff();
#pragma unroll
    for (int r = 0; r < 16; ++r) {
        const int c = (r & 3) + 8 * (r >> 2);
        if (dq - c < 0) p0[r] = NEG;
        if (dq - c - 32 < 0) p1[r] = NEG;
    }
}
__device__ __forceinline__ void partialSM(f32x16& p0, f32x16& p1, float& m_reg, float& mn, float& alpha) {
    float pmax = p0[0]; for (int r = 1; r < 16; ++r) pmax = fmaxf(pmax, p0[r]); for (int r = 0; r < 16; ++r) pmax = fmaxf(pmax, p1[r]);
    { auto rr = __builtin_amdgcn_permlane32_swap(__float_as_uint(pmax), __float_as_uint(pmax), false, false);
      pmax = fmaxf(__uint_as_float(rr[0]), __uint_as_float(rr[1])); }
    constexpr float C2 = 1.4426950408889634f * SCALE;
    if (__builtin_expect(__all((pmax - m_reg) * SCALE <= THR), 1)) { mn = m_reg; alpha = 1.f; }
    else { mn = fmaxf(m_reg, pmax); alpha = __builtin_amdgcn_exp2f((m_reg - mn) * C2); m_reg = mn; }
    const float mnL = -mn * C2;
    for (int r = 0; r < 16; ++r) p0[r] = fmaf(p0[r], C2, mnL); for (int r = 0; r < 16; ++r) p1[r] = fmaf(p1[r], C2, mnL);
    for (int r = 0; r < 16; ++r) p0[r] = __builtin_amdgcn_exp2f(p0[r]);
}
__device__ __forceinline__ void finishSM(f32x16& p0, f32x16& p1, float alpha, float& l_reg, bf16x8& pa0, bf16x8& pa1, bf16x8& pa2, bf16x8& pa3) {
    for (int r = 0; r < 16; ++r) p1[r] = __builtin_amdgcn_exp2f(p1[r]);
    float ps = 0; for (int r = 0; r < 16; ++r) ps += p0[r]; for (int r = 0; r < 16; ++r) ps += p1[r];
    { auto rr = __builtin_amdgcn_permlane32_swap(__float_as_uint(ps), __float_as_uint(ps), false, false);
      ps = __uint_as_float(rr[0]) + __uint_as_float(rr[1]); }
    l_reg = l_reg * alpha + ps;
#define PK4(P, B_, OUT) do { unsigned a0 = cvtpk(P[B_+0], P[B_+1]), a1 = cvtpk(P[B_+2], P[B_+3]);                          \
        unsigned b0 = cvtpk(P[B_+4], P[B_+5]), b1 = cvtpk(P[B_+6], P[B_+7]);                                             \
        auto r0 = __builtin_amdgcn_permlane32_swap(a0, b0, false, false); auto r1 = __builtin_amdgcn_permlane32_swap(a1, b1, false, false); \
        u32x4 w = {r0[0], r1[0], r0[1], r1[1]}; OUT = *reinterpret_cast<bf16x8*>(&w); } while (0)
    PK4(p0, 0, pa0); PK4(p0, 8, pa1); PK4(p1, 0, pa2); PK4(p1, 8, pa3);
#undef PK4
}
template <int KB>
__device__ __forceinline__ void qkt(f32x16& p0, f32x16& p1, const char* K_lds, const char* Bias_lds, int r32, int hi, const bf16x8* qr) {
    { const f32x4* bb = reinterpret_cast<const f32x4*>(Bias_lds + KB * 256 + hi * 16);
      const f32x4 a0 = bb[0], a1 = bb[2], a2 = bb[4], a3 = bb[6], c0 = bb[8], c1 = bb[10], c2 = bb[12], c3 = bb[14];
      p0 = (f32x16){a0[0], a0[1], a0[2], a0[3], a1[0], a1[1], a1[2], a1[3], a2[0], a2[1], a2[2], a2[3], a3[0], a3[1], a3[2], a3[3]};
      p1 = (f32x16){c0[0], c0[1], c0[2], c0[3], c1[0], c1[1], c1[2], c1[3], c2[0], c2[1], c2[2], c2[3], c3[0], c3[1], c3[2], c3[3]}; }
    const char* kb[4];
#pragma unroll
    for (int dd = 0; dd < 4; ++dd) kb[dd] = K_lds + KB * SHM_K + KSWZ(r32, (dd * 16 + hi * 8) * 2);
#pragma unroll
    for (int d0 = 0; d0 < 8; ++d0) { const char* a = kb[d0 & 3] + (d0 >> 2) * 128;
        bf16x8 b0 = *reinterpret_cast<const bf16x8*>(a);
        bf16x8 b1 = *reinterpret_cast<const bf16x8*>(a + 32 * 256);
        p0 = __builtin_amdgcn_mfma_f32_32x32x16_bf16(b0, qr[d0], p0, 0, 0, 0);
        p1 = __builtin_amdgcn_mfma_f32_32x32x16_bf16(b1, qr[d0], p1, 0, 0, 0); }
}
template <int VB>
__device__ __forceinline__ void pv_tile(f32x16* o, int vb0, bf16x8 pa0, bf16x8 pa1, bf16x8 pa2, bf16x8 pa3) {
#define TRRD(dst, off) asm volatile("ds_read_b64_tr_b16 %0, %1 offset:%2" : "=&v"(dst) : "v"(vb0), "i"(off) : "memory")
#define PV_D0(d0) do { s16x4 l0, l1, l2, l3, h0, h1, h2, h3; constexpr int b_ = VB * SHM_V + v_rd_off(d0, 0, 0);   \
        TRRD(l0, b_); TRRD(h0, b_ + 2048); TRRD(l1, b_ + 4096); TRRD(h1, b_ + 6144); TRRD(l2, b_ + 8192); TRRD(h2, b_ + 10240); TRRD(l3, b_ + 12288); TRRD(h3, b_ + 14336); \
        asm volatile("s_waitcnt lgkmcnt(0)" ::: "memory"); SBAR();                                                    \
        o[d0] = __builtin_amdgcn_mfma_f32_32x32x16_bf16(pa0, (bf16x8){l0[0], l0[1], l0[2], l0[3], h0[0], h0[1], h0[2], h0[3]}, o[d0], 0, 0, 0);   \
        o[d0] = __builtin_amdgcn_mfma_f32_32x32x16_bf16(pa1, (bf16x8){l1[0], l1[1], l1[2], l1[3], h1[0], h1[1], h1[2], h1[3]}, o[d0], 0, 0, 0);   \
        o[d0] = __builtin_amdgcn_mfma_f32_32x32x16_bf16(pa2, (bf16x8){l2[0], l2[1], l2[2], l2[3], h2[0], h2[1], h2[2], h2[3]}, o[d0], 0, 0, 0);   \
        o[d0] = __builtin_amdgcn_mfma_f32_32x32x16_bf16(pa3, (bf16x8){l3[0], l3[1], l3[2], l3[3], h3[0], h3[1], h3[2], h3[3]}, o[d0], 0, 0, 0); } while (0)
    PV_D0(0); PV_D0(1); PV_D0(2); PV_D0(3);
#undef PV_D0
#undef TRRD
}

struct Bases { const bf16* Q; bf16* O; const bf16* K; const bf16* V; const float* CB; };
struct BlockRef { unsigned qo, oo, kvo, cbo; int P0, jlo; };
struct Seam { bf16x8 qr[8]; };
#define VMW() asm volatile("s_waitcnt vmcnt(0)" ::: "memory")
#define VMWN(n) asm volatile("s_waitcnt vmcnt(%0)" :: "i"(n) : "memory")
#define LBAR() do { asm volatile("s_waitcnt lgkmcnt(0)" ::: "memory"); __builtin_amdgcn_s_barrier(); asm volatile("" ::: "memory"); } while (0)
#define ATT_SRC() \
    unsigned ksrc0, ksrc1, vsrc0, vsrc1; \
    { const int rw0 = 8 * wid + (lane >> 4), rw1 = rw0 + 4, p_ = lane & 15; ksrc0 = (unsigned)(rw0 * 256 + ((p_ ^ (rw0 & 7)) << 4)); ksrc1 = (unsigned)(rw1 * 256 + ((p_ ^ (rw1 & 7)) << 4)); \
      const int L0 = 128 * wid + lane, L1 = L0 + 64; \
      const int kk0 = ((L0 >> 7) << 3) | ((L0 >> 2) & 7), kk1 = ((L1 >> 7) << 3) | ((L1 >> 2) & 7); \
      const int k0_ = (kk0 & ~0xC) | ((kk0 & 4) << 1) | ((kk0 & 8) >> 1), k1_ = (kk1 & ~0xC) | ((kk1 & 4) << 1) | ((kk1 & 8) >> 1); \
      vsrc0 = (unsigned)(k0_ * 256 + ((((L0 >> 5) & 3) * 4 + (L0 & 3)) << 4)); vsrc1 = (unsigned)(k1_ * 256 + ((((L1 >> 5) & 3) * 4 + (L1 & 3)) << 4)); }
#define DMA_K(Kp, CBp, k0, bf) do { const char* kp_ = (const char*)(Kp) + (unsigned)(k0) * 256u; \
        __builtin_amdgcn_global_load_lds((const unsigned*)(kp_ + ksrc0), (LAS unsigned*)(ldsa + 2 * SHM_V + (bf) * SHM_K + (2 * wid) * 1024), 16, 0, 0); \
        __builtin_amdgcn_global_load_lds((const unsigned*)(kp_ + ksrc1), (LAS unsigned*)(ldsa + 2 * SHM_V + (bf) * SHM_K + (2 * wid + 1) * 1024), 16, 0, 0); \
        if (wid == 0) __builtin_amdgcn_global_load_lds((const unsigned*)((CBp) + (unsigned)((k0) + lane)), (LAS unsigned*)(ldsa + OFF_BIAS + (bf) * 256), 4, 0, 0); } while (0)
#define DMA_V(Vp, k0, bf) do { const char* vp_ = (const char*)(Vp) + (unsigned)(k0) * 256u; \
        __builtin_amdgcn_global_load_lds((const unsigned*)(vp_ + vsrc0), (LAS unsigned*)(ldsa + (bf) * SHM_V + (2 * wid) * 1024), 16, 0, 0); \
        __builtin_amdgcn_global_load_lds((const unsigned*)(vp_ + vsrc1), (LAS unsigned*)(ldsa + (bf) * SHM_V + (2 * wid + 1) * 1024), 16, 0, 0); } while (0)
__device__ __forceinline__ void prime(const Bases& G, const BlockRef& cur, char* lds, LAS unsigned char* ldsa, Seam& S) {
    const int tid = threadIdx.x, wid = __builtin_amdgcn_readfirstlane(tid >> 6), lane = tid & 63, r32 = lane & 31, hi = lane >> 5;
    ATT_SRC();
    for (int d0 = 0; d0 < 8; ++d0) S.qr[d0] = load8(G.Q + (cur.qo + (unsigned)((wid * QBLK + r32) * LD + d0 * 16 + hi * 8)));
    DMA_K(G.K + cur.kvo, G.CB + cur.cbo, cur.jlo * KVBLK, 0); DMA_V(G.V + cur.kvo, cur.jlo * KVBLK, 0);
    VMW(); LBAR();
}
__device__ __forceinline__ void block(const Bases& G, const BlockRef& cur, const BlockRef& nxt, char* lds, LAS unsigned char* ldsa, Seam& S) {
    const int tid = threadIdx.x, wid = __builtin_amdgcn_readfirstlane(tid >> 6), lane = tid & 63, r32 = lane & 31, hi = lane >> 5;
    const int j_lo = cur.jlo, NT = (cur.P0 + QB - 1) / KVBLK + 1 - j_lo;
    const int qlo = cur.P0 + wid * QBLK, qm = qlo + r32 - 4 * hi;
    char* V_lds = lds; char* K_lds = lds + 2 * SHM_V; char* B_lds = lds + OFF_BIAS;
    float* ws = (float*)(lds + OFF_WS) + wid * 64; float* li_l = ws, * al_l = ws + 32;
    float m_reg = G.CB[cur.cbo + (unsigned)(cur.P0 + wid * QBLK + r32)], l_reg = 0; f32x16 o[4] = {};
    const int vb0 = (int)(uintptr_t)V_lds + v_rd_base(lane);
    const bf16* Kh = G.K + cur.kvo; const bf16* Vh = G.V + cur.kvo; const float* CBh = G.CB + cur.cbo;
    ATT_SRC();
#define RESC(a) do { if (__any((a) < 1.f)) { if (hi == 0) al_l[r32] = (a); asm volatile("s_waitcnt lgkmcnt(0)" ::: "memory");              \
                     for (int d_ = 0; d_ < 4; ++d_) for (int r = 0; r < 16; ++r) o[d_][r] *= al_l[crow(r, hi)]; } } while (0)
#define KBASE(t) ((j_lo + (t)) * KVBLK)
#define MASKT(P0_, P1_, t) do { const int kb_ = KBASE(t); if (kb_ + KVBLK - 1 > qlo) mask_tile(P0_, P1_, qm - kb_); } while (0)
    f32x16 pA0, pA1, pB0, pB1; float mnA, mnB, alA, alB; bf16x8 pa0, pa1, pa2, pa3;
    DMA_K(Kh, CBh, KBASE(1), 1); DMA_V(Vh, KBASE(1), 1);
    SBAR(); qkt<0>(pA0, pA1, K_lds, B_lds, r32, hi, S.qr);
    MASKT(pA0, pA1, 0); partialSM(pA0, pA1, m_reg, mnA, alA);
    VMW(); LBAR();
#define HALF_STEP(PX0, PX1, mnX, alX, PY0, PY1, alY, t, KB, VB, SB) do {                                                      \
        SBAR(); if ((t) + 1 < NT) { DMA_K(Kh, CBh, KBASE((t) + 1), SB); SBAR(); }                                            \
        qkt<KB>(PX0, PX1, K_lds, B_lds, r32, hi, S.qr);                                                                        \
        finishSM(PY0, PY1, alY, l_reg, pa0, pa1, pa2, pa3); SBAR();                                                           \
        pv_tile<VB>(o, vb0, pa0, pa1, pa2, pa3); MASKT(PX0, PX1, (t)); partialSM(PX0, PX1, m_reg, mnX, alX);                   \
        LBAR();                                                                                                               \
        if ((t) + 1 < NT) { DMA_V(Vh, KBASE((t) + 1), SB); }                                                                  \
        RESC(alX); VMWN(2); LBAR(); } while (0)
    for (int t = 1; t + 1 < NT; t += 2) {
        HALF_STEP(pB0, pB1, mnB, alB, pA0, pA1, alA, t, 1, 0, 0);
        HALF_STEP(pA0, pA1, mnA, alA, pB0, pB1, alB, t + 1, 0, 1, 1);
    }
    SBAR(); qkt<1>(pB0, pB1, K_lds, B_lds, r32, hi, S.qr); SBAR();
    DMA_K(G.K + nxt.kvo, G.CB + nxt.cbo, nxt.jlo * KVBLK, 0); SBAR();
#pragma unroll
    for (int d0 = 0; d0 < 8; ++d0) S.qr[d0] = load8(G.Q + (nxt.qo + (unsigned)((wid * QBLK + r32) * LD + d0 * 16 + hi * 8)));
    SBAR();
    finishSM(pA0, pA1, alA, l_reg, pa0, pa1, pa2, pa3); SBAR();
    pv_tile<0>(o, vb0, pa0, pa1, pa2, pa3);
    MASKT(pB0, pB1, NT - 1); partialSM(pB0, pB1, m_reg, mnB, alB);
    VMWN(10); LBAR();
    DMA_V(G.V + nxt.kvo, nxt.jlo * KVBLK, 0);
    RESC(alB);
    finishSM(pB0, pB1, alB, l_reg, pa0, pa1, pa2, pa3); SBAR(); pv_tile<1>(o, vb0, pa0, pa1, pa2, pa3);
    SBAR();
    if (hi == 0) li_l[r32] = l_reg; asm volatile("s_waitcnt lgkmcnt(0)" ::: "memory");
    float rli[16];
#pragma unroll
    for (int r = 0; r < 16; ++r) rli[r] = __builtin_amdgcn_rcpf(li_l[crow(r, hi)]);
    bf16* Ow = G.O + (cur.oo + (unsigned)(wid * QBLK * LDO));
#pragma unroll
    for (int r = 0; r < 16; ++r) { const int orow = crow(r, hi);
#pragma unroll
        for (int d0 = 0; d0 < 4; ++d0) { const float v = o[d0][r] * rli[r];
            const float vn = __shfl_xor(v, 1);
            if ((r32 & 1) == 0) *(unsigned*)(Ow + (unsigned)(orow * LDO + d0 * 32 + r32)) = cvtpk(v, vn); } }
    VMW(); LBAR();
#undef RESC
#undef KBASE
#undef MASKT
#undef HALF_STEP
}
#undef VMW
#undef VMWN
#undef LBAR
#undef ATT_SRC
#undef DMA_K
#undef DMA_V
#undef KSWZ
#undef SBAR
}
constexpr int NB = 8, SEQ = 4096, T = NB * SEQ, DM = 1024, NH = 8, HD = 128, INW = 7176, NZ = 7168;
constexpr int NE = 32, DE = 512;
constexpr float EPS = 1e-6f;
constexpr int PMAX = 73728;
constexpr int NWAVES = 8;
constexpr size_t MiB = 1u << 20;
constexpr size_t WS_CTL = 0, CTL_ZERO_BYTES = 64 * 1024;
constexpr size_t WS_RS1 = 1 * MiB, WS_RS2 = 1 * MiB + 256 * 1024;
constexpr size_t WS_LF = 1 * MiB + 512 * 1024;
constexpr size_t WS_CB = 2 * MiB + 512 * 1024;
constexpr size_t WS_TOK = 3 * MiB + 512 * 1024;
constexpr size_t WS_LISTS = 5 * MiB;
constexpr size_t WS_WRT = 9 * MiB;
constexpr size_t WS_SRS = 9 * MiB + 512 * 1024, WS_SW = 10 * MiB;
constexpr size_t WS_WIN = 16 * MiB;
constexpr size_t WS_WA = 30 * MiB, WS_WL = 32 * MiB, WS_WO = 34 * MiB;
constexpr size_t WS_WRG = 36 * MiB;
constexpr size_t WS_XB = 40 * MiB;
constexpr size_t WS_XR = 104 * MiB;
constexpr size_t WS_GG = 168 * MiB;
constexpr size_t WS_Q = 232 * MiB, WS_K = 296 * MiB, WS_V = 360 * MiB;
constexpr size_t WS_W13 = 424 * MiB;
constexpr size_t WS_W2 = 392 * MiB;
constexpr size_t WS_XG = 168 * MiB;
constexpr size_t WS_HB = 296 * MiB;
constexpr size_t WS_WIN8 = 37 * MiB;
constexpr size_t WS_X8P = 456 * MiB;
constexpr size_t WS_END = 512 * MiB;
static_assert(WS_XG + (size_t)PMAX * 1024 <= WS_K && WS_HB + (size_t)PMAX * 1024 <= WS_W2 && WS_W2 + 32u * 1024 * 512 * 2 <= WS_W13 && WS_W13 + 64 * MiB <= WS_END, "d_ws map");
constexpr int CW_TMO = 0, CW_CODE = 1, CW_BAR = 4096, CW_CNT = 8192, CW_NORM = 8448, CW_QCTR = 12288, CW_RDY = 14000;
constexpr int RING_OFF = 0, RING_BYTES = 131072;
constexpr int LDSCTL_OFF = RING_BYTES, MISC_OFF = LDSCTL_OFF + 320;
constexpr int TBL_OFF = RING_BYTES + 1024;
constexpr int TBL_PS = TBL_OFF, TBL_CN = TBL_OFF + 256, TBL_TE = TBL_OFF + 512;
constexpr int RG_TOT = RING_BYTES + 4096, RG_CAR = RG_TOT + 4096;
constexpr int LDS_BYTES = 147456;

#include <cmath>
using pg8::bf_lo; using pg8::bf_hi; using pg8::sigmoid_f;

struct Frame {
    LAS unsigned char* lds;
    int tid, lane, wave, vcu, G;
};
__device__ __forceinline__ float wave_sum(float v) {
#pragma unroll
    for (int o = 1; o < 64; o <<= 1) v += __shfl_xor(v, o);
    return v;
}
__device__ __forceinline__ void transpose_tile(const float* src, int ld, bf16* dst, int ldd, const float* kscale, LAS float* scr, int lane) {
    const int q = lane & 7, kr = lane >> 3;
    f32x4 v[8];
#pragma unroll
    for (int i = 0; i < 8; ++i) v[i] = __builtin_nontemporal_load((const f32x4*)(src + (size_t)(kr + 8 * i) * ld + 4 * q));
#pragma unroll
    for (int i = 0; i < 8; ++i) { const int kk = kr + 8 * i; const float sc = kscale ? kscale[kk] : 1.0f;
#pragma unroll
        for (int c = 0; c < 4; ++c) scr[kk * 33 + 4 * q + c] = v[i][c] * sc; }
    LDS_WAIT(); asm volatile("" ::: "memory");
    const int c = lane & 7;
#pragma unroll
    for (int j = 0; j < 4; ++j) { const int n = (lane >> 3) + 8 * j; const LAS float* s = scr + (8 * c) * 33 + n;
        v4u o; o.x = pk2(s[0 * 33], s[1 * 33]); o.y = pk2(s[2 * 33], s[3 * 33]); o.z = pk2(s[4 * 33], s[5 * 33]); o.w = pk2(s[6 * 33], s[7 * 33]);
        *(GAS v4u*)(dst + (size_t)n * ldd + 8 * c) = o; }
    LDS_WAIT(); asm volatile("" ::: "memory");
}

__device__ __forceinline__ void transpose_tile8(const float* src, int ld, unsigned char* dst, int ldd, const float* kscale, float scale, LAS float* scr, int lane) {
    const int q = lane & 7, kr = lane >> 3;
    f32x4 v[8];
#pragma unroll
    for (int i = 0; i < 8; ++i) v[i] = __builtin_nontemporal_load((const f32x4*)(src + (size_t)(kr + 8 * i) * ld + 4 * q));
#pragma unroll
    for (int i = 0; i < 8; ++i) { const int kk = kr + 8 * i; const float sc = kscale ? kscale[kk] * scale : scale;
#pragma unroll
        for (int c = 0; c < 4; ++c) scr[kk * 33 + 4 * q + c] = v[i][c] * sc; }
    LDS_WAIT(); asm volatile("" ::: "memory");
    const int c = lane & 3;
#pragma unroll
    for (int j = 0; j < 2; ++j) { const int n = (lane >> 2) + 16 * j; const LAS float* s = scr + (16 * c) * 33 + n;
        v4u o; o.x = pg8::pack4_fp8(s[0 * 33], s[1 * 33], s[2 * 33], s[3 * 33]); o.y = pg8::pack4_fp8(s[4 * 33], s[5 * 33], s[6 * 33], s[7 * 33]);
        o.z = pg8::pack4_fp8(s[8 * 33], s[9 * 33], s[10 * 33], s[11 * 33]); o.w = pg8::pack4_fp8(s[12 * 33], s[13 * 33], s[14 * 33], s[15 * 33]);
        *(GAS v4u*)(dst + (size_t)n * ldd + 16 * c) = o; }
    LDS_WAIT(); asm volatile("" ::: "memory");
}

struct P0Args { const float *x, *g_mix, *w_in, *w_rg_a, *w_rg_x, *b_forget, *w_lru_out, *w_attn_out, *w_out, *g_ffn, *w_rgrp, *w_rexp, *w_gate, *w_up;
                bf16 *Win, *Wl, *Wa, *Wo, *Wrg, *XB; unsigned char* W13; float *RS1, *LF, *WRT; unsigned char *Win8, *X8P; };
struct TItem { const float* src; int ld; unsigned char* dst; int ldd; const float* ks; float scale; int f8; };
__device__ __forceinline__ void titem_load(const TItem& t, f32x4 (&v)[8], float (&sc)[8], int lane) {
    const int q = lane & 7, kr = lane >> 3;
#pragma unroll
    for (int i = 0; i < 8; ++i) { v[i] = __builtin_nontemporal_load((const f32x4*)(t.src + (size_t)(kr + 8 * i) * t.ld + 4 * q)); sc[i] = t.ks ? t.ks[kr + 8 * i] * t.scale : t.scale; }
}
__device__ __forceinline__ void titem_finish(const TItem& t, const f32x4 (&v)[8], const float (&sc)[8], LAS float* scr, int lane) {
    const int q = lane & 7, kr = lane >> 3;
#pragma unroll
    for (int i = 0; i < 8; ++i) { const int kk = kr + 8 * i;
#pragma unroll
        for (int c = 0; c < 4; ++c) scr[kk * 33 + 4 * q + c] = v[i][c] * sc[i]; }
    LDS_WAIT(); asm volatile("" ::: "memory");
    if (t.f8) { const int c = lane & 3;
#pragma unroll
        for (int j = 0; j < 2; ++j) { const int n = (lane >> 2) + 16 * j; const LAS float* s = scr + (16 * c) * 33 + n;
            v4u o; o.x = pg8::pack4_fp8(s[0 * 33], s[1 * 33], s[2 * 33], s[3 * 33]); o.y = pg8::pack4_fp8(s[4 * 33], s[5 * 33], s[6 * 33], s[7 * 33]);
            o.z = pg8::pack4_fp8(s[8 * 33], s[9 * 33], s[10 * 33], s[11 * 33]); o.w = pg8::pack4_fp8(s[12 * 33], s[13 * 33], s[14 * 33], s[15 * 33]);
            *(GAS v4u*)(t.dst + (size_t)n * t.ldd + 16 * c) = o; } }
    else { const int c = lane & 7;
#pragma unroll
        for (int j = 0; j < 4; ++j) { const int n = (lane >> 3) + 8 * j; const LAS float* s = scr + (8 * c) * 33 + n;
            v4u o; o.x = pk2(s[0 * 33], s[1 * 33]); o.y = pk2(s[2 * 33], s[3 * 33]); o.z = pk2(s[4 * 33], s[5 * 33]); o.w = pk2(s[6 * 33], s[7 * 33]);
            *(GAS v4u*)(t.dst + ((size_t)n * t.ldd + 8 * c) * 2) = o; } }
    LDS_WAIT(); asm volatile("" ::: "memory");
}
constexpr int P0_I_IN = 16 * 224, P0_I_SQ = 16 * 32, P0_I_RG = 2 * 4 * 4 * 8, P0_I_EX = 2 * 8192, P0_NITEMS = P0_I_IN + 3 * P0_I_SQ + P0_I_RG + P0_I_EX;
__device__ __forceinline__ void p0_items(const Frame& F, const P0Args& a, const int first, const int last, const int stride, const int offset) {
    LAS float* scr = (LAS float*)(F.lds + RING_OFF + F.wave * 16384);
    const float* const p_wl = a.w_lru_out; const float* const p_wa = a.w_attn_out; const float* const p_wo = a.w_out; const float* const p_rga = a.w_rg_a; const float* const p_rgx = a.w_rg_x;
    bf16* const q_wl = a.Wl; bf16* const q_wa = a.Wa; bf16* const q_wo = a.Wo;
    constexpr int I_IN = P0_I_IN, I_SQ = P0_I_SQ, I_EX = P0_I_EX, NITEMS = P0_NITEMS;
    const float* const p_gate = a.w_gate; const float* const p_up = a.w_up; const float* const p_win = a.w_in; const float* const p_gmix = a.g_mix; const float* const p_gffn = a.g_ffn;
    bf16* const q_win = a.Win; bf16* const q_wrg = a.Wrg; unsigned char* const q_w13 = a.W13; unsigned char* const q_win8 = a.Win8;
#define P0_DECODE(it_, t_) do { int r = (it_); \
        if (r >= NITEMS - I_EX) { r -= NITEMS - I_EX;     \
            const int w = r >> 13, e = (r >> 8) & 31, kb = (r >> 4) & 15, nb = r & 15; const float* W = (w == 0 ? p_gate : p_up) + (size_t)e * DM * DE; \
            const int drow = e * 1024 + (nb >> 2) * 256 + (nb & 3) * 32 + (w == 1 ? 128 : 0); \
            t_.src = W + (size_t)(64 * kb) * DE + 32 * nb; t_.ld = DE; t_.dst = q_w13 + (size_t)drow * DM + 64 * kb; t_.ldd = DM; t_.ks = p_gffn + 64 * kb; t_.scale = pg8::W13_SCALE; t_.f8 = 1; } \
        else if (r < I_IN) { const int kb = r / 224, nb = r % 224, n0 = 32 * nb, sc_ = n0 < 5120 ? n0 : n0 + 8; \
            t_.src = p_win + (size_t)(64 * kb) * INW + sc_; t_.ld = INW; t_.ldd = DM; t_.ks = p_gmix + 64 * kb; \
            if (n0 >= 5120) { t_.dst = q_win8 + (size_t)(n0 - 5120) * DM + 64 * kb; t_.scale = pg8::WIN_SCALE; t_.f8 = 1; }     \
            else { t_.dst = (unsigned char*)(q_win + (size_t)n0 * DM + 64 * kb); t_.scale = 1.0f; t_.f8 = 0; } } \
        else if (r < I_IN + 3 * I_SQ) { r -= I_IN; const int w = r / I_SQ, q = r % I_SQ, kb = q / 32, nb = q % 32; const float* W = w == 0 ? p_wl : (w == 1 ? p_wa : p_wo); bf16* Wt = w == 0 ? q_wl : (w == 1 ? q_wa : q_wo); \
            t_.src = W + (size_t)(64 * kb) * DM + 32 * nb; t_.ld = DM; t_.dst = (unsigned char*)(Wt + (size_t)(32 * nb) * DM + 64 * kb); t_.ldd = DM; t_.ks = nullptr; t_.scale = 1.0f; t_.f8 = 0; } \
        else { r -= I_IN + 3 * I_SQ; const int gb = r / 32, q = r % 32, kb = q / 8, nb = q % 8; const float* W = (gb < 4 ? p_rga : p_rgx) + (size_t)(gb & 3) * 65536; \
            t_.src = W + (size_t)(64 * kb) * 256 + 32 * nb; t_.ld = 256; t_.dst = (unsigned char*)(q_wrg + (size_t)gb * 65536 + (size_t)(32 * nb) * 256 + 64 * kb); t_.ldd = 256; t_.ks = nullptr; t_.scale = -1.4426950408889634f; t_.f8 = 0; }     } while (0)
    {
        int it = first + offset; TItem cur; f32x4 va[8]; float sa[8];
        if (it < last) { P0_DECODE(it, cur); titem_load(cur, va, sa, F.lane); }
        while (it < last) {
            const int nx = it + stride; TItem nt = cur; f32x4 vb[8]; float sb[8];
            if (nx < last) { P0_DECODE(nx, nt); titem_load(nt, vb, sb, F.lane); }
            titem_finish(cur, va, sa, scr, F.lane);
            if (nx < last) { cur = nt;
#pragma unroll
                for (int i = 0; i < 8; ++i) { va[i] = vb[i]; sa[i] = sb[i]; } }
            it = nx;
        }
    }
#undef P0_DECODE
}
__device__ __forceinline__ void p0_prologue(const Frame& F, const P0Args& a, const int part  ) {
    const int gw = F.vcu * NWAVES + F.wave, NGW = F.G * NWAVES;
    if (part != 2) p0_items(F, a, 0, P0_NITEMS, NGW, gw);
    if (part == 1) return;
    for (int i = (F.vcu * NWAVES + F.wave) * 64 + F.lane; i < 64 * DM; i += NGW * 64) { const int n = i >> 10, k = i & 1023;
        float v = 0.f; if (n < 32) v = a.w_rexp[k * 32 + n]; else if (n < 36) v = a.w_rgrp[k * 4 + (n - 32)];
        a.WRT[i] = v * a.g_ffn[k]; }
    LAS float* wfl = (LAS float*)(F.lds + RING_OFF);
    __syncthreads();
    for (int k = F.tid; k < DM; k += NWAVES * 64) { const float g = a.g_mix[k];
        const f32x4 w0 = *(const f32x4*)(a.w_in + (size_t)k * INW + 5120), w1 = *(const f32x4*)(a.w_in + (size_t)k * INW + 5124);
        *(LAS f32x4*)(wfl + k * 8) = w0 * g; *(LAS f32x4*)(wfl + k * 8 + 4) = w1 * g; }
    __syncthreads();
    float wf[4][4][8];
#pragma unroll
    for (int j = 0; j < 4; ++j)
#pragma unroll
        for (int i = 0; i < 4; ++i) { const int k = 256 * j + 4 * F.lane + i; const f32x4 w0 = *(const LAS f32x4*)(wfl + k * 8), w1 = *(const LAS f32x4*)(wfl + k * 8 + 4);
#pragma unroll
            for (int h = 0; h < 4; ++h) { wf[j][i][h] = w0[h]; wf[j][i][4 + h] = w1[h]; } }
    const float bfg = a.b_forget[F.lane & 7];
    f32x4 vn[4];
    if (gw < T) { const GAS f32x4* xr0 = (const GAS f32x4*)(a.x + (size_t)gw * DM) + F.lane;
#pragma unroll
        for (int j = 0; j < 4; ++j) vn[j] = __builtin_nontemporal_load((const f32x4*)xr0 + 64 * j); }
    for (int m = gw; m < T; m += NGW) {
        f32x4 v[4]; float s = 0.f, d[8] = {0.f, 0.f, 0.f, 0.f, 0.f, 0.f, 0.f, 0.f};
#pragma unroll
        for (int j = 0; j < 4; ++j) v[j] = vn[j];
        if (m + NGW < T) { const GAS f32x4* xr1 = (const GAS f32x4*)(a.x + (size_t)(m + NGW) * DM) + F.lane;
#pragma unroll
            for (int j = 0; j < 4; ++j) vn[j] = __builtin_nontemporal_load((const f32x4*)xr1 + 64 * j); }
#pragma unroll
        for (int j = 0; j < 4; ++j) { s += (v[j].x * v[j].x + v[j].y * v[j].y) + (v[j].z * v[j].z + v[j].w * v[j].w);
#pragma unroll
            for (int i = 0; i < 4; ++i)
#pragma unroll
                for (int h = 0; h < 8; ++h) d[h] = fmaf(v[j][i], wf[j][i][h], d[h]); }
        s = wave_sum(s);
#pragma unroll
        for (int h = 0; h < 8; ++h) d[h] = wave_sum(d[h]);
        const float rs = 1.0f / sqrtf(s * (1.0f / DM) + EPS);
        GAS unsigned long long* o8 = (GAS unsigned long long*)(a.XB + (size_t)m * DM) + F.lane;
#pragma unroll
        for (int j = 0; j < 4; ++j) o8[64 * j] = (unsigned long long)pk2(v[j].x * rs, v[j].y * rs) | ((unsigned long long)pk2(v[j].z * rs, v[j].w * rs) << 32);
        { GAS unsigned* o4 = (GAS unsigned*)(a.X8P + (size_t)m * DM) + F.lane; const float r8 = rs * pg8::XS_SCALE;
#pragma unroll
          for (int j = 0; j < 4; ++j) o4[64 * j] = pg8::pack4_fp8(v[j].x * r8, v[j].y * r8, v[j].z * r8, v[j].w * r8); }
        if (F.lane < 8) { const int h = F.lane; float dh = d[0]; dh = h == 1 ? d[1] : dh; dh = h == 2 ? d[2] : dh; dh = h == 3 ? d[3] : dh; dh = h == 4 ? d[4] : dh; dh = h == 5 ? d[5] : dh; dh = h == 6 ? d[6] : dh; dh = h == 7 ? d[7] : dh;
            const float fl = dh * rs + bfg; a.LF[(size_t)m * 8 + h] = fminf(fl, 0.f) - log1pf(expf(-fabsf(fl))); }
    }
}
__device__ __forceinline__ void cumsum_bias(const Frame& F, const float* LF, float* CB) {
    LAS float* wt = (LAS float*)(F.lds + RING_OFF);
    for (int bh = blockIdx.x; bh < NB * NH; bh += F.G) {
        const int b = bh >> 3, h = bh & 7, s0 = F.tid * 8;
        float v[8], run = 0.f;
#pragma unroll
        for (int j = 0; j < 8; ++j) { run += LF[((size_t)(b * SEQ + s0 + j)) * 8 + h]; v[j] = run; }
        float inc = run;
#pragma unroll
        for (int o = 1; o < 64; o <<= 1) { const float t = __shfl_up(inc, o); if (F.lane >= o) inc += t; }
        if (F.lane == 63) wt[F.wave] = inc;
        __syncthreads();
        float pre = inc - run;
        for (int w = 0; w < F.wave; ++w) pre += wt[w];
#pragma unroll
        for (int j = 0; j < 8; ++j) CB[(size_t)bh * SEQ + s0 + j] = -(pre + v[j]) * 11.313708498984761f;
        __syncthreads();
    }
}
struct RgArgs { const bf16* XC; const bf16* GG; bf16* GO; const bf16* Wrg; const float *b_a, *b_x, *lam; };
__device__ __forceinline__ float bfx(const v4u& v, int i) { const unsigned w = i < 2 ? v.x : (i < 4 ? v.y : (i < 6 ? v.z : v.w)); return (i & 1) ? bf_hi(w) : bf_lo(w); }
__device__ __forceinline__ unsigned cvtpk_bf16(float lo, float hi) { unsigned r; asm volatile("v_cvt_pk_bf16_f32 %0, %1, %2" : "=v"(r) : "v"(lo), "v"(hi)); return r; }
__device__ __forceinline__ void conv_prepass(const Frame& F, const bf16* XR, bf16* XC, const float* conv_w, const float* conv_b) {
    const int gw = F.vcu * NWAVES + F.wave, NGW = F.G * NWAVES;
    for (int it = gw; it < (T / 16) * 2; it += NGW) {
        const int r0 = (it >> 1) * 16, c0 = (it & 1) * 512 + 8 * F.lane, tq = r0 & (SEQ - 1);
        float cw[4][8], cbv[8];
#pragma unroll
        for (int j = 0; j < 4; ++j) { const f32x4 w0 = *(const f32x4*)(conv_w + j * DM + c0), w1 = *(const f32x4*)(conv_w + j * DM + c0 + 4);
#pragma unroll
            for (int i = 0; i < 4; ++i) { cw[j][i] = w0[i]; cw[j][4 + i] = w1[i]; } }
        { const f32x4 w0 = *(const f32x4*)(conv_b + c0), w1 = *(const f32x4*)(conv_b + c0 + 4);
#pragma unroll
          for (int i = 0; i < 4; ++i) { cbv[i] = w0[i]; cbv[4 + i] = w1[i]; } }
        v4u raw[19];
#pragma unroll
        for (int i = 0; i < 19; ++i) { const int rr = (i < 3 && tq == 0) ? r0 : r0 - 3 + i; const v4u w = __builtin_nontemporal_load((const v4u*)(XR + ((unsigned)rr * DM + c0)));
            const bool z = i < 3 && tq == 0; raw[i].x = z ? 0u : w.x; raw[i].y = z ? 0u : w.y; raw[i].z = z ? 0u : w.z; raw[i].w = z ? 0u : w.w; }
#pragma unroll
        for (int r = 0; r < 16; ++r) { float y[8];
#pragma unroll
            for (int i = 0; i < 8; ++i) { float sacc = cbv[i];
#pragma unroll
                for (int j = 0; j < 4; ++j) sacc = fmaf(cw[j][i], bfx(raw[r + j], i), sacc);
                y[i] = sacc; }
            v4u o; o.x = cvtpk_bf16(y[0], y[1]); o.y = cvtpk_bf16(y[2], y[3]); o.z = cvtpk_bf16(y[4], y[5]); o.w = cvtpk_bf16(y[6], y[7]);
            *(GAS v4u*)(XC + ((unsigned)(r0 + r) * DM + c0)) = o; }
    }
}
__device__ __forceinline__ void rglru_unit(const Frame& F, const RgArgs& a, int unit) {
    const int tid = F.tid, lane = F.lane, wid = F.wave, fr = lane & 15, fq = lane >> 4, rq = wid >> 1, cp = wid & 1;
    const int b = unit >> 5, n = (unit >> 3) & 3, g = unit & 7, cbase = 256 * n, cown = cbase + 32 * g;
    LAS unsigned char* A_l = F.lds + RING_OFF;
    LAS float* tot = (LAS float*)(F.lds + RG_TOT);
    bf16x8 bfr[2][8];
#pragma unroll
    for (int gt = 0; gt < 2; ++gt)
#pragma unroll
        for (int ks = 0; ks < 8; ++ks) bfr[gt][ks] = *(const GAS bf16x8*)(a.Wrg + ((size_t)((gt * 4 + n) * 256 + 32 * g + 16 * cp + fr)) * 256 + 32 * ks + 8 * fq);
    const int cl = 16 * cp + fr, cch = cown + cl;
    const float ba = -1.4426950408889634f * a.b_a[cch], bx = -1.4426950408889634f * a.b_x[cch], sp8 = 8.0f * log1pf(expf(-a.lam[cch])) * 1.4426950408889634f;
    const unsigned goff = (unsigned)(b * SEQ + 32 * rq + 4 * fq) * DM + cch;
    const __amdgpu_buffer_rsrc_t GGr = __builtin_amdgcn_make_buffer_rsrc((void*)a.GG, 0, (int)((size_t)T * DM * 2), 0x00020000);
    const __amdgpu_buffer_rsrc_t GOr = __builtin_amdgcn_make_buffer_rsrc((void*)a.GO, 0, (int)((size_t)T * DM * 2), 0x00020000);
    const int gvo = (int)(goff * 2u);
    const unsigned dbase = ((unsigned)(b * SEQ + 16 * wid + (lane >> 5)) * DM + cbase) * 2u;
    const char* const XCb = (const char*)a.XC;
#define RG_DMA(ci_, buf_) do { _Pragma("unroll") for (int i_ = 0; i_ < 8; ++i_) { const unsigned so_ = dbase + (unsigned)(2 * i_) * (DM * 2u) + ((((unsigned)lane & 31u) ^ (unsigned)((2 * i_ + (lane >> 5)) & 15)) << 4); \
        __builtin_amdgcn_global_load_lds((const unsigned*)(XCb + so_ + (unsigned)(ci_) * (128u * DM * 2u)), (LAS unsigned*)(A_l + (buf_) * 65536 + (8 * wid + i_) * 1024), 16, 0, 0); } } while (0)
    float hc = 0.f;
    const int kx = 32 * g + cl;
#pragma unroll
    for (int gt = 0; gt < 2; ++gt)
#pragma unroll
        for (int ks = 0; ks < 8; ++ks) asm volatile("" : "+v"(bfr[gt][ks]));
    RG_DMA(0, 0); asm volatile("s_waitcnt vmcnt(0)" ::: "memory");
#define RG_CHUNK(BUF_, ci_) do { const int ci = (ci_); const int t0 = 128 * ci; LAS unsigned char* const Ab = A_l + (BUF_) * 65536; \
        __builtin_amdgcn_s_barrier(); asm volatile("" ::: "memory"); \
        unsigned short ggv[2][4]; \
        _Pragma("unroll") \
        for (int mt = 0; mt < 2; ++mt) \
        _Pragma("unroll") \
            for (int j = 0; j < 4; ++j) ggv[mt][j] = __builtin_amdgcn_raw_buffer_load_b16(GGr, gvo, (t0 + 16 * mt + j) * (DM * 2), 0); \
        if (ci + 1 < SEQ / 128) RG_DMA(ci + 1, BUF_ ^ 1); \
 \
        f32x4 acc[2][2]; \
        _Pragma("unroll") \
        for (int mt = 0; mt < 2; ++mt) { acc[mt][0] = (f32x4){ba, ba, ba, ba}; acc[mt][1] = (f32x4){bx, bx, bx, bx}; } \
        _Pragma("unroll") \
        for (int ks = 0; ks < 8; ++ks) { const int ch = 4 * ks + fq; \
        _Pragma("unroll") \
            for (int mt = 0; mt < 2; ++mt) { const int arow = 32 * rq + 16 * mt + fr; \
                const bf16x8 af = *(const LAS bf16x8*)(Ab + arow * 512 + ((ch ^ (arow & 15)) << 4)); \
                acc[mt][0] = __builtin_amdgcn_mfma_f32_16x16x32_bf16(af, bfr[0][ks], acc[mt][0], 0, 0, 0); \
                acc[mt][1] = __builtin_amdgcn_mfma_f32_16x16x32_bf16(af, bfr[1][ks], acc[mt][1], 0, 0, 0); } } \
 \
        float av[2][4], bv[2][4], sA[2], sB[2]; \
        _Pragma("unroll") \
        for (int mt = 0; mt < 2; ++mt) { float A = 1.f, Bv = 0.f; \
        _Pragma("unroll") \
            for (int j = 0; j < 4; ++j) { const int row = 32 * rq + 16 * mt + 4 * fq + j; \
                const unsigned short xb16 = *(const LAS unsigned short*)(Ab + row * 512 + ((((kx >> 3) ^ (row & 15))) << 4) + (kx & 7) * 2); \
                const float xc = __builtin_bit_cast(float, (unsigned)xb16 << 16); \
                const float r_ = __builtin_amdgcn_rcpf(1.0f + __builtin_amdgcn_exp2f(acc[mt][0][j])), i_ = __builtin_amdgcn_rcpf(1.0f + __builtin_amdgcn_exp2f(acc[mt][1][j])); \
                const float aa = __builtin_amdgcn_exp2f(-sp8 * r_); \
                const float mult = __builtin_amdgcn_sqrtf(fmaxf(fmaf(-aa, aa, 1.0f), 0.f)); \
                av[mt][j] = aa; bv[mt][j] = mult * i_ * xc; \
                Bv = fmaf(aa, Bv, bv[mt][j]); A *= aa; } \
            sA[mt] = A; sB[mt] = Bv; } \
 \
        float eA[2], eB[2], tA[2], tB[2]; \
        _Pragma("unroll") \
        for (int mt = 0; mt < 2; ++mt) { float A = sA[mt], Bv = sB[mt]; \
            { const float pA = __shfl_up(A, 16), pB = __shfl_up(Bv, 16); if (fq >= 1) { Bv = fmaf(A, pB, Bv); A *= pA; } } \
            { const float pA = __shfl_up(A, 32), pB = __shfl_up(Bv, 32); if (fq >= 2) { Bv = fmaf(A, pB, Bv); A *= pA; } } \
            const float xA = __shfl_up(A, 16), xB = __shfl_up(Bv, 16); eA[mt] = fq >= 1 ? xA : 1.f; eB[mt] = fq >= 1 ? xB : 0.f; \
            tA[mt] = __shfl(A, 48 + fr); tB[mt] = __shfl(Bv, 48 + fr); } \
        const float wA = tA[0] * tA[1], wB = fmaf(tA[1], tB[0], tB[1]); \
        if (fq == 0) { tot[(rq * 32 + cl) * 2] = wA; tot[(rq * 32 + cl) * 2 + 1] = wB; } \
        asm volatile("s_waitcnt lgkmcnt(0)" ::: "memory"); __builtin_amdgcn_s_barrier(); asm volatile("" ::: "memory"); \
        float hin = hc, hnew = hc; \
        _Pragma("unroll") \
        for (int q = 0; q < 4; ++q) { const float qA = tot[(q * 32 + cl) * 2], qB = tot[(q * 32 + cl) * 2 + 1]; hnew = fmaf(qA, hnew, qB); if (q < rq) hin = hnew; } \
        hc = hnew; \
        _Pragma("unroll") \
        for (int mt = 0; mt < 2; ++mt) { float h = mt == 0 ? hin : fmaf(tA[0], hin, tB[0]); \
            h = fmaf(eA[mt], h, eB[mt]); \
        _Pragma("unroll") \
            for (int j = 0; j < 4; ++j) { h = fmaf(av[mt][j], h, bv[mt][j]); \
                const float gv = __builtin_bit_cast(float, (unsigned)ggv[mt][j] << 16); \
                __builtin_amdgcn_raw_buffer_store_b16((unsigned short)cvtpk_bf16(h * gv, 0.f), GOr, gvo, (t0 + 16 * mt + j) * (DM * 2), 0); } } \
        asm volatile("s_waitcnt lgkmcnt(0)" ::: "memory"); \
        asm volatile("s_waitcnt vmcnt(8)" ::: "memory"); \
    } while (0)
    for (int cc = 0; cc < SEQ / 128; cc += 2) { RG_CHUNK(0, cc); RG_CHUNK(1, cc + 1); }
#undef RG_CHUNK
#undef RG_DMA
    asm volatile("s_waitcnt vmcnt(0) lgkmcnt(0)" ::: "memory"); __builtin_amdgcn_s_barrier(); asm volatile("" ::: "memory");
}
constexpr float SKIP_LOG2 = 40.0f;
__device__ __forceinline__ int attn_jlo(const Frame& F, const float* CB, const unsigned* NORM, int bh, int qb) {
    float qs = 0.f, ks = 0.f;
#pragma unroll
    for (int w = 0; w < 4; ++w) { qs += __uint_as_float(NORM[(bh) * 4 + w]); ks += __uint_as_float(NORM[(64 + bh) * 4 + w]); }
    constexpr float C2 = 1.4426950408889634f * 0.08838834764831845f;
    const float th = SKIP_LOG2 + 2.0f * 1.02f * sqrtf(qs * ks) * C2 + 4.0f;
    const float ref = CB[(size_t)bh * SEQ + qb * 256], v = CB[(size_t)bh * SEQ + 64 * F.lane + 63];
    const unsigned long long m = __ballot(F.lane < 4 * qb && (ref - v) * C2 > th);
    int j = __builtin_popcountll(m); if (m != ((j >= 64) ? ~0ull : ((1ull << j) - 1ull))) j = 0;
    return j & ~1;
}
__device__ __forceinline__ fattn::BlockRef attn_ref(int bh, int qb, int jlo) {
    const int b = bh >> 3, h = bh & 7;
    fattn::BlockRef r; r.qo = ((unsigned)bh * SEQ + (unsigned)qb * 256u) * HD; r.oo = ((unsigned)b * SEQ + (unsigned)qb * 256u) * DM + h * HD; r.kvo = (unsigned)bh * SEQ * HD; r.cbo = (unsigned)bh * SEQ; r.P0 = qb * 256; r.jlo = jlo; return r;
}
__device__ __forceinline__ void attn_phase(const Frame& F, char* lds, const bf16* Qb, bf16* Ob, const bf16* Kb, const bf16* Vb, const float* CB, const int* JLO, gu32* QCTR, const int probe = 0) {
#define ATT_JLO(bh_, qb_) (probe == 1 ? 4 * (qb_) : probe == 2 ? 0 : __builtin_amdgcn_readfirstlane(JLO[(bh_) * 16 + (qb_)]))
    constexpr int NBLK = 128;
    const int M = F.G >> 3; if ((F.G & 7) || M > 64 || M < 1) return;
    const int x = F.vcu / M, r = F.vcu % M;
    volatile LAS int* tk_l = (volatile LAS int*)(F.lds + MISC_OFF + 64);
    gu32* qc = QCTR + 64 * x;
    const fattn::Bases G{Qb, Ob, Kb, Vb, CB}; LAS unsigned char* const ldsa = F.lds + RING_OFF;
#define ATT_DEC(k_, bh_, qb_) do { const int i_ = (k_) & 7; bh_ = (i_ < 4 ? 4 * x + i_ : 32 + 4 * x + (i_ - 4)); qb_ = 15 - ((k_) >> 3); } while (0)
    int bh, qb; ATT_DEC(r, bh, qb);
    fattn::BlockRef cur = attn_ref(bh, qb, ATT_JLO(bh, qb));
    ATT_DEC(r + M, bh, qb);
    fattn::BlockRef nxt = attn_ref(bh, qb, ATT_JLO(bh, qb)); bool nxt_ok = (r + M) < NBLK;
    fattn::Seam S;
    fattn::prime(G, cur, lds, ldsa, S);
    bool more = true;
    for (;;) {
        unsigned tkt = 0u;
        if (more && F.tid == 0) tkt = __hip_atomic_fetch_add(qc, 1u, __ATOMIC_RELAXED, __HIP_MEMORY_SCOPE_AGENT);
        const bool last = !nxt_ok;
        fattn::block(G, cur, last ? cur : nxt, lds, ldsa, S);
        if (last) break;
        if (F.tid == 0) tk_l[0] = more ? (int)tkt + 2 * M : NBLK;
        __syncthreads();
        const int k2 = __builtin_amdgcn_readfirstlane(tk_l[0]);
        __syncthreads();
        cur = nxt;
        if (k2 < NBLK) { ATT_DEC(k2, bh, qb); nxt = attn_ref(bh, qb, ATT_JLO(bh, qb)); nxt_ok = true; } else { nxt_ok = false; more = false; }
    }
#undef ATT_DEC
#undef ATT_JLO
}
typedef float f32x16 __attribute__((ext_vector_type(16)));
struct P5Args { const float *X, *WRT, *b_rgrp, *b_rexp, *w_down; const bf16* DL; bf16* X1B; unsigned char *X8, *W2; float* RS2; int* LISTS; unsigned* TOK; gu32* CNT; };
__device__ __forceinline__ void p5_route(const Frame& F, const P5Args& a) {
    const int tid = F.tid, lane = F.lane, wid = F.wave, i16 = lane & 15, h4 = lane >> 4;
    constexpr int LDA = 132;
    LAS float* A_l = (LAS float*)(F.lds + RING_OFF) + wid * 16 * LDA;
    LAS float* B_l = (LAS float*)(F.lds + RING_OFF + 67584);
    LAS float* LG = (LAS float*)(F.lds + RING_OFF + 94208);
    LAS float* rs_l = (LAS float*)(F.lds + RING_OFF + 113664);
    LAS int* hist = (LAS int*)(F.lds + RING_OFF + 114176);
    LAS int* base_l = (LAS int*)(F.lds + RING_OFF + 114432);
    {
        LAS float* scr = (LAS float*)(F.lds + RING_OFF + wid * 8704);
        const int gw = F.vcu * NWAVES + wid, NGW = F.G * NWAVES;
        for (int it = gw; it < 8192; it += NGW) { const int e = it >> 8, kb = (it >> 5) & 7, nb = it & 31; const float* W = a.w_down + (size_t)e * DE * DM;
            transpose_tile8(W + (size_t)(64 * kb) * DM + 32 * nb, DM, a.W2 + (size_t)(e * 1024 + 32 * nb) * DE + 64 * kb, DE, nullptr, pg8::W2_SCALE, scr, lane); }
    }
    __syncthreads();
    for (int rb = blockIdx.x; rb < T / 128; rb += F.G) {
        const int R0 = rb * 128;
        if (tid < 32) hist[tid] = 0;
        const int ar = lane >> 5, ac = 4 * (lane & 31);
        const size_t xo = (size_t)(R0 + 16 * wid + ar) * DM + ac; const float* xsrc = a.X + xo; const bf16* dsrc = a.DL + xo; unsigned char* xdst = a.X8 + xo; bf16* bdst = a.X1B + xo;
        f32x4 areg[8], breg[3]; unsigned long long dreg[8];
#define P5_LOAD(kc_) do { _Pragma("unroll") for (int i_ = 0; i_ < 8; ++i_) { areg[i_] = __builtin_nontemporal_load((const f32x4*)(xsrc + (size_t)(2 * i_) * DM + (kc_) * 128)); dreg[i_] = __builtin_nontemporal_load((const unsigned long long*)(dsrc + (size_t)(2 * i_) * DM + (kc_) * 128)); } \
        _Pragma("unroll") for (int q_ = 0; q_ < 3; ++q_) { const int idx_ = tid + 512 * q_; breg[q_] = *(const f32x4*)(a.WRT + (size_t)(idx_ >> 5) * DM + (kc_) * 128 + 4 * (idx_ & 31)); } } while (0)
        P5_LOAD(0);
        f32x4 acc[3] = {{0.f, 0.f, 0.f, 0.f}, {0.f, 0.f, 0.f, 0.f}, {0.f, 0.f, 0.f, 0.f}}; float ss = 0.f;
        for (int kc = 0; kc < 8; ++kc) {
#pragma unroll
            for (int i = 0; i < 8; ++i) { const unsigned dl = (unsigned)dreg[i], dh = (unsigned)(dreg[i] >> 32);
                areg[i][0] += bf_lo(dl); areg[i][1] += bf_hi(dl); areg[i][2] += bf_lo(dh); areg[i][3] += bf_hi(dh);
                *(unsigned*)(xdst + (size_t)(2 * i) * DM + kc * 128) = pg8::pack4_fp8(areg[i][0], areg[i][1], areg[i][2], areg[i][3]);
                *(unsigned long long*)(bdst + (size_t)(2 * i) * DM + kc * 128) = (unsigned long long)pg8::cvt_pk_bf16(areg[i][0], areg[i][1]) | ((unsigned long long)pg8::cvt_pk_bf16(areg[i][2], areg[i][3]) << 32);
                *(LAS f32x4*)(A_l + (2 * i + ar) * LDA + ac) = areg[i]; }
#pragma unroll
            for (int q = 0; q < 3; ++q) { const int idx = tid + 512 * q; *(LAS f32x4*)(B_l + (idx >> 5) * LDA + 4 * (idx & 31)) = breg[q]; }
            __syncthreads();
            if (kc + 1 < 8) P5_LOAD(kc + 1);
#pragma unroll
            for (int jj = 0; jj < 8; ++jj) {
                const f32x4 af = *(const LAS f32x4*)(A_l + i16 * LDA + 16 * jj + 4 * h4);
                f32x4 bfv[3];
#pragma unroll
                for (int nt = 0; nt < 3; ++nt) bfv[nt] = *(const LAS f32x4*)(B_l + (16 * nt + i16) * LDA + 16 * jj + 4 * h4);
                ss += (af[0] * af[0] + af[1] * af[1]) + (af[2] * af[2] + af[3] * af[3]);
#pragma unroll
                for (int s = 0; s < 4; ++s)
#pragma unroll
                    for (int nt = 0; nt < 3; ++nt) acc[nt] = __builtin_amdgcn_mfma_f32_16x16x4f32(af[s], bfv[nt][s], acc[nt], 0, 0, 0);
            }
            __syncthreads();
        }
#undef P5_LOAD
        ss += __shfl_xor(ss, 16); ss += __shfl_xor(ss, 32);
        const float rs = 1.0f / sqrtf(ss * (1.0f / DM) + EPS);
        if (h4 == 0) { a.RS2[R0 + 16 * wid + i16] = rs; rs_l[16 * wid + i16] = rs; }
#pragma unroll
        for (int r = 0; r < 4; ++r) { const int rl = 16 * wid + 4 * h4 + r; LG[rl * 37 + i16] = acc[0][r]; LG[rl * 37 + 16 + i16] = acc[1][r]; if (i16 < 4) LG[rl * 37 + 32 + i16] = acc[2][r]; }
        __syncthreads();
        int e0 = 0, e1 = 0, k0 = 0, k1 = 0; float w0 = 0.f, w1 = 0.f;
        if (tid < 128) {
            const float rsv = rs_l[tid]; const LAS float* lg = LG + tid * 37;
            float gl[4];
#pragma unroll
            for (int q = 0; q < 4; ++q) gl[q] = lg[32 + q] * rsv + a.b_rgrp[q];
            int gs = 0; float gm = gl[0];
#pragma unroll
            for (int q = 1; q < 4; ++q) if (gl[q] > gm) { gm = gl[q]; gs = q; }
            float den = 0.f;
#pragma unroll
            for (int q = 0; q < 4; ++q) den += expf(gl[q] - gm);
            const float pg = 1.0f / den;
            float el[8];
#pragma unroll
            for (int q = 0; q < 8; ++q) el[q] = lg[8 * gs + q] * rsv + a.b_rexp[8 * gs + q];
            int i0 = 0; float v0 = el[0];
#pragma unroll
            for (int q = 1; q < 8; ++q) if (el[q] > v0) { v0 = el[q]; i0 = q; }
            int i1 = -1; float v1 = -INFINITY;
#pragma unroll
            for (int q = 0; q < 8; ++q) if (q != i0 && el[q] > v1) { v1 = el[q]; i1 = q; }
            const float ex = expf(v1 - v0);
            w0 = pg / (1.0f + ex); w1 = pg * ex / (1.0f + ex);
            e0 = 8 * gs + i0; e1 = 8 * gs + i1;
            k0 = atomicAdd((int*)(hist + e0), 1); k1 = atomicAdd((int*)(hist + e1), 1);
        }
        __syncthreads();
        if (tid < 32) base_l[tid] = (int)__hip_atomic_fetch_add(a.CNT + tid, (unsigned)hist[tid], __ATOMIC_RELAXED, __HIP_MEMORY_SCOPE_AGENT);
        __syncthreads();
        if (tid < 128) { const int tok = R0 + tid, s0 = base_l[e0] + k0, s1 = base_l[e1] + k1;
            a.LISTS[(size_t)e0 * T + s0] = tok; a.LISTS[(size_t)e1 * T + s1] = tok;
            v4u i0v = {(unsigned)e0, (unsigned)s0, (unsigned)e1, (unsigned)s1}, i1v = {__float_as_uint(w0), __float_as_uint(w1), 0u, 0u};
            *(GAS v4u*)(a.TOK + (size_t)tok * 8) = i0v; *(GAS v4u*)(a.TOK + (size_t)tok * 8 + 4) = i1v; }
        __syncthreads();
    }
}
__device__ __forceinline__ void build_tables(const Frame& F, const gu32* CNT) {
    LAS int* ps = (LAS int*)(F.lds + TBL_PS); LAS int* cn = (LAS int*)(F.lds + TBL_CN); LAS int* te = (LAS int*)(F.lds + TBL_TE);
    __syncthreads();
    if (F.tid < 32) { int c = (int)__hip_atomic_load(CNT + F.tid, __ATOMIC_RELAXED, __HIP_MEMORY_SCOPE_AGENT); c = c < 0 ? 0 : (c > T ? T : c); cn[F.tid] = c; }
    __syncthreads();
    if (F.tid == 0) { int run = 0; for (int e = 0; e < 32; ++e) { ps[e] = run; run += (cn[e] + 255) & ~255; } if (run > PMAX) run = PMAX; ps[32] = run; }
    __syncthreads();
    if (F.tid < 288) { const int p = F.tid * 256; int e = 0; for (int q = 1; q < 32; ++q) if (p >= ps[q]) e = q; te[F.tid] = e; }
    __syncthreads();
}
template <class Ord> __device__ __forceinline__ void build_rowtab(const Frame& F, const Ord& S, const int* LISTS, const float* RS2, LAS int* rowtab) {
    const LAS int* ps = (const LAS int*)(F.lds + TBL_PS); const LAS int* cn = (const LAS int*)(F.lds + TBL_CN); const LAS int* te = (const LAS int*)(F.lds + TBL_TE);
    pg8::Unit u;
    for (int ui = 0; ui < 6 && S.next(ui, u); ++ui)
        if (F.tid < 256) { const int p = u.pm * 256 + F.tid, e = te[u.pm], local = p - ps[e]; const int tok = local < cn[e] ? LISTS[(size_t)e * T + local] : 0; rowtab[ui * 256 + F.tid] = tok; ((LAS float*)rowtab)[(6 + ui) * 256 + F.tid] = RS2[tok]; }
    __syncthreads();
}
__device__ __forceinline__ float fp8_f32(unsigned w, int i) { return i == 0 ? __builtin_amdgcn_cvt_f32_fp8(w, 0) : (i == 1 ? __builtin_amdgcn_cvt_f32_fp8(w, 1) : (i == 2 ? __builtin_amdgcn_cvt_f32_fp8(w, 2) : __builtin_amdgcn_cvt_f32_fp8(w, 3))); }
__device__ __forceinline__ void p9_final(const Frame& F, const bf16* X1B, float* OUT, const unsigned char* Y, const unsigned* TOK, const float* g_final) {
    const LAS int* ps = (const LAS int*)(F.lds + TBL_PS);
    const int gw = F.vcu * NWAVES + F.wave, NGW = F.G * NWAVES;
    f32x4 gf[4];
#pragma unroll
    for (int j = 0; j < 4; ++j) gf[j] = *((const f32x4*)g_final + F.lane + 64 * j);
    constexpr float YS = 1.0f / (pg8::HB_SCALE * pg8::W2_SCALE * pg8::Y_SCALE);
    v4u ia_n = {0u, 0u, 0u, 0u}, ib_n = {0u, 0u, 0u, 0u}, ia_c = ia_n, ib_c = ib_n; unsigned long long xw_n[4]; unsigned ya_n[4], yb_n[4];
#define P9_TOK(m_, ia_, ib_) do { ia_ = *(const GAS v4u*)(TOK + (size_t)(m_) * 8); ib_ = *(const GAS v4u*)(TOK + (size_t)(m_) * 8 + 4); } while (0)
#define P9_ROW(m_, ia_) do { const size_t p0_ = (size_t)(ps[(int)(ia_.x & 31u)] + (int)ia_.y), p1_ = (size_t)(ps[(int)(ia_.z & 31u)] + (int)ia_.w); \
        const GAS unsigned long long* xr_ = (const GAS unsigned long long*)(X1B + (size_t)(m_) * DM) + F.lane; \
        const GAS unsigned* y0_ = (const GAS unsigned*)(Y + p0_ * DM) + F.lane; const GAS unsigned* y1_ = (const GAS unsigned*)(Y + p1_ * DM) + F.lane; \
        _Pragma("unroll") for (int j = 0; j < 4; ++j) { xw_n[j] = __builtin_nontemporal_load((const unsigned long long*)xr_ + 64 * j); ya_n[j] = __builtin_nontemporal_load((const unsigned*)y0_ + 64 * j); yb_n[j] = __builtin_nontemporal_load((const unsigned*)y1_ + 64 * j); } } while (0)
    if (gw < T) { P9_TOK(gw, ia_c, ib_c); P9_ROW(gw, ia_c); if (gw + NGW < T) P9_TOK(gw + NGW, ia_n, ib_n); }
    for (int m = gw; m < T; m += NGW) {
        const float w0 = __uint_as_float(ib_c.x) * YS, w1 = __uint_as_float(ib_c.y) * YS;
        unsigned long long xw[4]; unsigned ya[4], yb[4];
#pragma unroll
        for (int j = 0; j < 4; ++j) { xw[j] = xw_n[j]; ya[j] = ya_n[j]; yb[j] = yb_n[j]; }
        if (m + NGW < T) { ia_c = ia_n; ib_c = ib_n; P9_ROW(m + NGW, ia_c); if (m + 2 * NGW < T) P9_TOK(m + 2 * NGW, ia_n, ib_n); }
        GAS f32x4* orow = (GAS f32x4*)(OUT + (size_t)m * DM) + F.lane;
        f32x4 v[4]; float s = 0.f;
#pragma unroll
        for (int j = 0; j < 4; ++j) { v[j] = (f32x4){bf_lo((unsigned)xw[j]), bf_hi((unsigned)xw[j]), bf_lo((unsigned)(xw[j] >> 32)), bf_hi((unsigned)(xw[j] >> 32))}; const unsigned a = ya[j], b = yb[j];
            v[j].x += w0 * fp8_f32(a, 0) + w1 * fp8_f32(b, 0); v[j].y += w0 * fp8_f32(a, 1) + w1 * fp8_f32(b, 1);
            v[j].z += w0 * fp8_f32(a, 2) + w1 * fp8_f32(b, 2); v[j].w += w0 * fp8_f32(a, 3) + w1 * fp8_f32(b, 3);
            s += (v[j].x * v[j].x + v[j].y * v[j].y) + (v[j].z * v[j].z + v[j].w * v[j].w); }
        s = wave_sum(s);
        const float rs = 1.0f / sqrtf(s * (1.0f / DM) + EPS);
#pragma unroll
        for (int j = 0; j < 4; ++j) orow[64 * j] = v[j] * rs * gf[j];
    }
#undef P9_TOK
#undef P9_ROW
}

constexpr int N_PHASES = 10;
#ifndef DUP_TRIVIAL
#define DUP_TRIVIAL 0
#endif
#ifndef DUP_PHASE
#define DUP_PHASE -1
#endif
typedef __attribute__((address_space(4))) const unsigned char* karg_ptr;
__device__ __forceinline__ const float* arg_in(int k) { karg_ptr base = (karg_ptr)__builtin_amdgcn_kernarg_segment_ptr(); const unsigned long long v = *(const unsigned long long volatile __attribute__((address_space(4)))*)(base + 8 * k); return (const float*)(const GAS float*)v; }
struct Args { const float* in[23]; float* out; unsigned char* ws; int ph_lo, ph_hi, mode, pad; };
__global__ void __launch_bounds__(NWAVES * 64, 2) fwd_kernel(Args args) {
    extern __shared__ __attribute__((aligned(16))) unsigned char lds[];
    Frame F;
    F.lds = (LAS unsigned char*)lds;
    F.wave = __builtin_amdgcn_readfirstlane((int)threadIdx.x >> 6); F.lane = pg8::lane_now(); F.tid = F.wave * 64 + F.lane;
    F.G = gridDim.x; { const int bx = blockIdx.x; F.vcu = (F.G % 8 == 0) ? (bx % 8) * (F.G / 8) + bx / 8 : bx; }
    unsigned char* ws = args.ws;
    gu32* ctl = (gu32*)(ws + WS_CTL);
    volatile LAS unsigned* MISC = (volatile LAS unsigned*)(F.lds + MISC_OFF);
    for (int u = F.tid; u < (LDS_BYTES - LDSCTL_OFF) / 4; u += NWAVES * 64) ((LAS unsigned*)(F.lds + LDSCTL_OFF))[u] = 0u;
    __syncthreads();
#if MK_ONE_LAUNCH
    XcdBarrier bar = xcd_barrier_post((unsigned*)(ctl + CW_BAR), MISC + 8);
#define GRID_BAR() xcd_barrier(bar)
#else
#define GRID_BAR() do { } while (0)
#endif
    const int lo = args.ph_lo, hi = args.ph_hi;
#ifndef PH_MASK
#define PH_MASK 0x3ff
#endif
#define IN(k) (((PH_MASK >> (k)) & 1) && lo <= (k) && (k) < hi)
#define BOTH(k) (IN(k) && IN((k) + 1))
    float* out = args.out;
    bf16* Win = (bf16*)(ws + WS_WIN); bf16* Wl = (bf16*)(ws + WS_WL); bf16* Wa = (bf16*)(ws + WS_WA); bf16* Wo = (bf16*)(ws + WS_WO); bf16* Wrg = (bf16*)(ws + WS_WRG);
    bf16* XB = (bf16*)(ws + WS_XB); bf16* XR = (bf16*)(ws + WS_XR); bf16* GG = (bf16*)(ws + WS_GG); bf16* Qb = (bf16*)(ws + WS_Q); bf16* Kb = (bf16*)(ws + WS_K); bf16* Vb = (bf16*)(ws + WS_V);
    bf16* SL = (bf16*)out; bf16* SA = (bf16*)out + pg8::SEGE;
    float* RS1 = (float*)(ws + WS_RS1); float* RS2 = (float*)(ws + WS_RS2); float* LF = (float*)(ws + WS_LF); float* CB = (float*)(ws + WS_CB);
    unsigned* TOK = (unsigned*)(ws + WS_TOK); int* LISTS = (int*)(ws + WS_LISTS); float* WRT = (float*)(ws + WS_WRT); int* JLO = (int*)(ws + WS_SRS);
    unsigned char* W13 = ws + WS_W13; unsigned char* W2 = ws + WS_W2; bf16* XG = (bf16*)(ws + WS_XG); unsigned char* HB = ws + WS_HB; unsigned char* X8 = ws + WS_XB;
    gu32* CNT = ctl + CW_CNT;

    if (IN(0)) { F.lane = pg8::lane_now(); F.tid = F.wave * 64 + F.lane;
        P0Args a{arg_in(0), arg_in(1), arg_in(2), arg_in(5), arg_in(7), arg_in(10), arg_in(11), arg_in(12), arg_in(13), arg_in(14), arg_in(15), arg_in(17), arg_in(19), arg_in(20), Win, Wl, Wa, Wo, Wrg, XB, W13, RS1, LF, WRT, ws + WS_WIN8, ws + WS_X8P};
        p0_prologue(F, a, DUP_PHASE == 0 ? args.mode : 0);
        if (BOTH(0)) GRID_BAR();
    }
    if (IN(1)) { F.lane = pg8::lane_now(); F.tid = F.wave * 64 + F.lane;
        cumsum_bias(F, LF, CB);
        { pg8::Gemm g{XB, Win, T, 5120, DM}; pg8::StaticOrder S; S.init(T, 5120, F.G, (int)blockIdx.x);
          pg8::EpiZ E{XR, SL, RS1, (unsigned*)(ctl + CW_NORM), args.mode, 0x43210u, 1.0f};
          pg8::gemm_phase<pg8::EpiZ, pg8::StaticOrder, true, true>(F.lds + RING_OFF, g, S, E, F.wave); }
        __syncthreads();
        { pg8::Gemm g{(const bf16*)(ws + WS_X8P), (const bf16*)(ws + WS_WIN8), T, 2048, DM / 2}; pg8::StaticOrder S; S.init(T, 2048, F.G, (int)blockIdx.x);
          pg8::EpiZ E{XR, SL, RS1, (unsigned*)(ctl + CW_NORM), args.mode, 0x65u, 1.0f / (pg8::XS_SCALE * pg8::WIN_SCALE)};
          pg8::gemm_phase<pg8::EpiZ, pg8::StaticOrder, true, true, true>(F.lds + RING_OFF, g, S, E, F.wave); }
        if (BOTH(1)) GRID_BAR();
    }
    if (IN(2)) { F.lane = pg8::lane_now(); F.tid = F.wave * 64 + F.lane;
        { const int gw = F.vcu * NWAVES + F.wave; if (gw < NB * NH * 16) { const int j = attn_jlo(F, CB, (const unsigned*)(ctl + CW_NORM), gw >> 4, gw & 15); if (F.lane == 0) JLO[gw] = j; } }
        conv_prepass(F, XR, XB, arg_in(3), arg_in(4));
        if (BOTH(2)) GRID_BAR();
    }
    if (IN(3)) { F.lane = pg8::lane_now(); F.tid = F.wave * 64 + F.lane;
        RgArgs ra{XB, GG, GG, Wrg, arg_in(6), arg_in(8), arg_in(9)};
#if DUP_PHASE >= 20
        const int mode = args.mode;
#else
        constexpr int mode = 0;
#endif
        if (mode < 2) { ra.GO = mode == 1 ? XR : GG; for (int u = F.vcu; u < 256; u += F.G) rglru_unit(F, ra, u); }
        if (mode != 1) attn_phase(F, (char*)lds + RING_OFF, Qb, XR, Kb, Vb, CB, JLO, ctl + CW_QCTR + (mode >= 2 ? 1024 : 0), mode >= 3 ? mode - 2 : 0);
        if (BOTH(3)) GRID_BAR();
    }
    if (IN(4)) { { F.lane = pg8::lane_now(); F.tid = F.wave * 64 + F.lane;
        static_assert(WS_GG - WS_XR == (size_t)128 * 256 * DM * 2 && WS_WL - WS_WA == (size_t)4 * 256 * DM * 2, "TwoGemmOrder: hg follows o by 128 row tiles, Wl follows Wa by 4 column tiles");
        pg8::Gemm g{XR, Wa, T, DM, DM}; pg8::TwoGemmOrder S; S.init(T, DM, F.G, (int)blockIdx.x);
        pg8::EpiGate2 E{SA, SL, XB};
        pg8::gemm_phase<pg8::EpiGate2, pg8::TwoGemmOrder, true, true>(F.lds + RING_OFF, g, S, E, F.wave); }
        if (BOTH(4)) GRID_BAR();
    }
    if (IN(5)) { F.lane = pg8::lane_now(); F.tid = F.wave * 64 + F.lane;
        pg8::Gemm g{XB, Wo, T, DM, DM}; pg8::StaticOrder S; S.init(T, DM, F.G, (int)blockIdx.x);
        pg8::EpiDelta E{(bf16*)out};
        pg8::gemm_phase<pg8::EpiDelta, pg8::StaticOrder, true, true>(F.lds + RING_OFF, g, S, E, F.wave);
        if (BOTH(5)) GRID_BAR();
    }
    if (IN(6)) { F.lane = pg8::lane_now(); F.tid = F.wave * 64 + F.lane;
        P5Args a{arg_in(0), WRT, arg_in(16), arg_in(18), arg_in(21), (const bf16*)out, XR, X8, W2, RS2, LISTS, TOK, args.mode ? CNT + 64 : CNT};
        p5_route(F, a);
        if (BOTH(6)) GRID_BAR();
    }
    if (IN(7)) { F.lane = pg8::lane_now(); F.tid = F.wave * 64 + F.lane;
        build_tables(F, CNT);
        const int ntiles = ((const LAS int*)(F.lds + TBL_PS))[32] >> 8;
        pg8::Gemm g{(const bf16*)X8, (const bf16*)W13, ntiles * 256, 32 * 1024, DM / 2}; pg8::GroupedOrderT<1> S{(const LAS int*)(F.lds + TBL_TE), ntiles * 4, F.G, F.vcu, (unsigned*)(ctl + CW_RDY), F.wave, (unsigned*)(ctl + CW_TMO)};
        LAS int* rowtab = (LAS int*)(F.lds + RG_TOT);
        build_rowtab(F, S, LISTS, RS2, rowtab);
        pg8::EpiSwiGLU E{HB};
        pg8::gemm_phase_gather<pg8::EpiSwiGLU, pg8::GroupedOrderT<1>, true>(F.lds + RING_OFF, g, S, E, rowtab, F.wave);
    }
    if (IN(8)) { F.lane = pg8::lane_now(); F.tid = F.wave * 64 + F.lane;
        build_tables(F, CNT);
        const int ntiles = ((const LAS int*)(F.lds + TBL_PS))[32] >> 8;
        const int c8 = (F.vcu + F.G - (ntiles * 4) % F.G) % F.G;
        pg8::Gemm g{(const bf16*)HB, (const bf16*)W2, ntiles * 256, 32 * 1024, DE / 2}; pg8::GroupedOrderT<2> S{(const LAS int*)(F.lds + TBL_TE), ntiles * 4, F.G, c8, (unsigned*)(ctl + CW_RDY), F.wave, (unsigned*)(ctl + CW_TMO)};
        pg8::EpiY E{(unsigned char*)XG};
        pg8::gemm_phase<pg8::EpiY, pg8::GroupedOrderT<2>, true, true, true>(F.lds + RING_OFF, g, S, E, F.wave);
        if (BOTH(8)) GRID_BAR();
    }
    if (IN(9)) { F.lane = pg8::lane_now(); F.tid = F.wave * 64 + F.lane;
        build_tables(F, CNT);
        p9_final(F, XR, out, (const unsigned char*)XG, TOK, arg_in(22));
    }
#undef IN
#undef BOTH
}

extern "C" void kernel_launch(void* const* d_in, const int* in_sizes, int n_in, void* d_out, int out_size, void* d_ws, size_t ws_size, hipStream_t stream) {
    static int grid = 0;
    if (grid == 0) {
        if (n_in != 23 || in_sizes[0] != T * DM || out_size != T * DM || ws_size < WS_END) { fprintf(stderr, "kernel_launch: unexpected shapes (n_in %d, in0 %d, out %d, ws %zu); nothing launched\n", n_in, n_in > 0 ? in_sizes[0] : -1, out_size, ws_size); grid = -1; return; }
        int dev = 0, cus = 0;
        if (hipGetDevice(&dev) != hipSuccess || hipDeviceGetAttribute(&cus, hipDeviceAttributeMultiprocessorCount, dev) != hipSuccess) { grid = -1; return; }
        if (hipFuncSetAttribute((const void*)fwd_kernel, hipFuncAttributeMaxDynamicSharedMemorySize, LDS_BYTES) != hipSuccess) { fprintf(stderr, "kernel_launch: hipFuncSetAttribute failed\n"); grid = -1; return; }
        int per_cu = 0;
        if (hipOccupancyMaxActiveBlocksPerMultiprocessor(&per_cu, (const void*)fwd_kernel, NWAVES * 64, LDS_BYTES) != hipSuccess || per_cu < 1) { fprintf(stderr, "kernel_launch: occupancy query reports %d\n", per_cu); }
        (void)hipGetLastError();
        grid = cus;
    }
    if (grid < 0) return;
    if (hipMemsetAsync((char*)d_ws + WS_CTL, 0, CTL_ZERO_BYTES, stream) != hipSuccess) return;
    Args a{};
    for (int i = 0; i < 23; ++i) a.in[i] = (const float*)d_in[i];
    a.out = (float*)d_out; a.ws = (unsigned char*)d_ws;
#if MK_ONE_LAUNCH
    a.ph_lo = 0; a.ph_hi = N_PHASES;
    hipLaunchKernelGGL(fwd_kernel, dim3(grid), dim3(NWAVES * 64), LDS_BYTES, stream, a);
#else
    for (int ph = 0; ph < N_PHASES; ++ph) { a.ph_lo = ph; a.ph_hi = ph + 1;
        if (DUP_PHASE == ph || (ph == 3 && DUP_PHASE >= 20)) { a.mode = DUP_PHASE >= 20 ? DUP_PHASE - 19 : ((ph == 6 || (ph == 1 && DUP_TRIVIAL)) ? 1 : (ph == 0 ? DUP_TRIVIAL : 0)); hipLaunchKernelGGL(fwd_kernel, dim3(grid), dim3(NWAVES * 64), LDS_BYTES, stream, a); a.mode = 0; }
        hipLaunchKernelGGL(fwd_kernel, dim3(grid), dim3(NWAVES * 64), LDS_BYTES, stream, a); }
#endif
}
```

```cpp
#include <hip/hip_runtime.h>
#include <cstdio>
#include <cstdint>

#ifndef MK_ONE_LAUNCH
#define MK_ONE_LAUNCH 1
#endif
namespace pg8 {
#define PG8_LAS __attribute__((address_space(3)))
typedef unsigned short bf16_t;
typedef short bf16x8 __attribute__((ext_vector_type(8)));
typedef float f32x4 __attribute__((ext_vector_type(4)));
typedef unsigned u32x4 __attribute__((ext_vector_type(4)));
constexpr int BM = 256, BK = 64, HALF = 128, HTB = HALF * BK * 2  , STAGE_BYTES = 8 * HTB, NXCD = 8, WGM = 8;

__host__ __device__ __forceinline__ int lds_byte(int r, int c) { const int st = (r >> 4) * 2 + (c >> 5), rr = r & 15, cc = c & 31, ob = rr * 64 + cc * 2; return st * 1024 + (ob ^ (((ob >> 9) & 1) << 5)); }
__host__ __device__ __forceinline__ void stage_rc(int b, int& R, int& C) { const int st = b / 1024, sb = b % 1024, swz = sb ^ (((sb >> 9) & 1) << 5); R = (st >> 1) * 16 + swz / 64; C = (st & 1) * 32 + (swz % 64) / 2; }
__host__ __device__ __forceinline__ int perm32(int rho) { const int n = rho >> 4, i = rho & 15; return 8 * (i >> 2) + 4 * n + (i & 3); }

struct Unit { int pm, pn; };
struct Gemm { const bf16_t* A; const bf16_t* Bt; int M, N, K; };

struct StaticOrder {
    int nM, nN, nwg, G, c;
    __host__ __device__ void init(int M, int N, int G_, int c_) { nM = M / BM; nN = N / BM; nwg = nM * nN; G = G_; c = c_; }
    __host__ __device__ bool next(int i, Unit& u) const {
        const long L = (long)i * G + c; if (L >= nwg) return false;
        int wgid = (int)L; { const int q = nwg / NXCD, r = nwg % NXCD, xcd = wgid % NXCD, off = wgid / NXCD; wgid = (xcd < r ? xcd * (q + 1) : r * (q + 1) + (xcd - r) * q) + off; }
        const int nig = WGM * nN, gid = wgid / nig, fm = gid * WGM, gsz = (nM - fm) < WGM ? (nM - fm) : WGM;
        u.pm = fm + ((wgid % nig) % gsz); u.pn = (wgid % nig) / gsz; return true;
    }
    __device__ __forceinline__ void a_ready(const Unit&) const {}
    __device__ __forceinline__ void done(const Unit&) const {}
};

__device__ __forceinline__ unsigned cvt_pk_bf16(float lo, float hi) { unsigned r; asm volatile("v_cvt_pk_bf16_f32 %0, %1, %2" : "=v"(r) : "v"(lo), "v"(hi)); return r; }
typedef float f32x2 __attribute__((ext_vector_type(2)));
__device__ __forceinline__ int lane_now() { int l; asm volatile("v_mbcnt_lo_u32_b32 %0, -1, 0\n\tv_mbcnt_hi_u32_b32 %0, -1, %0" : "=v"(l)); return l; }
typedef int v4i_t __attribute__((ext_vector_type(4)));
typedef int v8i_t __attribute__((ext_vector_type(8)));
__device__ __forceinline__ v8i_t cat8(bf16x8 a, bf16x8 b) { const v4i_t x = __builtin_bit_cast(v4i_t, a), y = __builtin_bit_cast(v4i_t, b); return __builtin_shufflevector(x, y, 0, 1, 2, 3, 4, 5, 6, 7); }
__device__ __forceinline__ void glds_sv(const char* base, unsigned voff, unsigned lds_dst) { unsigned keep;
    asm volatile("s_mov_b32 %0, m0\n\ts_mov_b32 m0, %3\n\ts_nop 0\n\tglobal_load_lds_dwordx4 %1, %2\n\ts_mov_b32 m0, %0" : "=&s"(keep) : "v"(voff), "s"(base), "s"(lds_dst) : "memory"); }
__device__ __forceinline__ float sat8(float x) { return __builtin_amdgcn_fmed3f(x, -448.0f, 448.0f); }
__device__ __forceinline__ unsigned pack4_fp8(float a, float b, float c, float d) { unsigned w = 0u; w = __builtin_amdgcn_cvt_pk_fp8_f32(sat8(a), sat8(b), w, false); w = __builtin_amdgcn_cvt_pk_fp8_f32(sat8(c), sat8(d), w, true); return w; }
constexpr float W13_SCALE = 64.0f, HB_SCALE = 8.0f, W2_SCALE = 32.0f, XS_SCALE = 16.0f, WIN_SCALE = 64.0f;
__device__ __forceinline__ float sigmoid_f(float x) { return __builtin_amdgcn_rcpf(1.0f + __builtin_amdgcn_exp2f(-1.4426950408889634f * x)); }
__device__ __forceinline__ float gelu_tanh_f(float x) { const float u = x * (1.0f + 0.044715f * x * x); return x * __builtin_amdgcn_rcpf(1.0f + __builtin_amdgcn_exp2f(-2.3022081981f * u)); }
__device__ __forceinline__ float bf_lo(unsigned w) { return __builtin_bit_cast(float, w << 16); }
__device__ __forceinline__ float bf_hi(unsigned w) { return __builtin_bit_cast(float, w & 0xffff0000u); }
constexpr size_t SEGE = (size_t)32768 * 1024;

struct EpiZ {
    static constexpr bool PERM = true, AFTER_DRAIN = false; static constexpr int NSTORES = 16;
    bf16_t* ws5; bf16_t* out2; const float* rs; unsigned* norm; int probe; unsigned smap; float sc;
    __device__ __forceinline__ void operator()(const f32x4 (&acc)[2][2][4][2], const Unit& u, int wr, int wc, int fr, int fq) const {
        const int sgo = (int)((smap >> (4 * (u.pn >> 2))) & 15u); const int seg = probe ? 0 : sgo; float nm[2] = {0.f, 0.f}; bf16_t* O = sgo < 5 ? ws5 + (size_t)sgo * SEGE : out2 + (size_t)(sgo - 5) * SEGE;
        const int row0 = u.pm * BM + wr * 64 + fr, col0 = (u.pn & 3) * BM + wc * 32 + 8 * fq;
#pragma unroll
        for (int ai = 0; ai < 2; ++ai)
#pragma unroll
            for (int m = 0; m < 4; ++m) { const int row = row0 + ai * HALF + m * 16; bf16_t* rowp = O + (size_t)row * 1024 + col0;
                const bool hm = (sgo >= 2 && sgo <= 4); bf16_t* rowh = O + ((size_t)((row >> 12) * 8 + 2 * (u.pn & 3)) * 4096 + (row & 4095)) * 128 + wc * 32 + 8 * fq;
#pragma unroll
                for (int bj = 0; bj < 2; ++bj) { f32x4 v0 = acc[ai][bj][m][0] * sc, v1 = acc[ai][bj][m][1] * sc;
                    if (seg == 1) {
#pragma unroll
                        for (int i = 0; i < 4; ++i) { v0[i] = gelu_tanh_f(v0[i]); v1[i] = gelu_tanh_f(v1[i]); } }
                    else if (seg >= 5) {
#pragma unroll
                        for (int i = 0; i < 4; ++i) { v0[i] = sigmoid_f(v0[i]); v1[i] = sigmoid_f(v1[i]); } }
                    if (seg == 2 || seg == 3) { float q = (v0[0] * v0[0] + v0[1] * v0[1]) + (v0[2] * v0[2] + v0[3] * v0[3]) + (v1[0] * v1[0] + v1[1] * v1[1]) + (v1[2] * v1[2] + v1[3] * v1[3]);
                        q += __shfl_xor(q, 16); q += __shfl_xor(q, 32); nm[bj] = fmaxf(nm[bj], q); }
                    u32x4 w; w.x = cvt_pk_bf16(v0[0], v0[1]); w.y = cvt_pk_bf16(v0[2], v0[3]); w.z = cvt_pk_bf16(v1[0], v1[1]); w.w = cvt_pk_bf16(v1[2], v1[3]);
                    *(u32x4*)(hm ? rowh + (size_t)bj * 4096 * 128 : rowp + bj * HALF) = w; } }
        if (seg == 2 || seg == 3) {
#pragma unroll
            for (int bj = 0; bj < 2; ++bj) { float q = nm[bj];
#pragma unroll
                for (int o = 1; o < 16; o <<= 1) q = fmaxf(q, __shfl_xor(q, o));
                if (fr == 0 && fq == 0) atomicMax(norm + ((((seg - 2) * 8 + (u.pm >> 4)) * 8 + 2 * (u.pn & 3) + bj) * 4 + wc), __float_as_uint(q)); }
        }
    }
};
template <int MODE> struct EpiGate {
    static constexpr bool PERM = true, AFTER_DRAIN = false; static constexpr int NSTORES = 16;
    const bf16_t* G; bf16_t* O;
    __device__ __forceinline__ void operator()(const f32x4 (&acc)[2][2][4][2], const Unit& u, int wr, int wc, int fr, int fq) const {
        const int row0 = u.pm * BM + wr * 64 + fr, col0 = u.pn * BM + wc * 32 + 8 * fq;
        u32x4 gv[2][2][2], pv[2][2][2];
#define EG_LOAD(st_, b_) do { _Pragma("unroll") for (int mm = 0; mm < 2; ++mm) _Pragma("unroll") for (int bj = 0; bj < 2; ++bj) { \
            const size_t off_ = (size_t)(row0 + ((st_) >> 1) * HALF + (2 * ((st_) & 1) + mm) * 16) * 1024 + col0 + bj * HALF; gv[b_][mm][bj] = __builtin_nontemporal_load((const u32x4*)(G + off_)); if (MODE == 1) pv[b_][mm][bj] = __builtin_nontemporal_load((const u32x4*)(O + off_)); } } while (0)
#define EG_DO(st_, b_) do { _Pragma("unroll") for (int mm = 0; mm < 2; ++mm) _Pragma("unroll") for (int bj = 0; bj < 2; ++bj) { const int ai = (st_) >> 1, m = 2 * ((st_) & 1) + mm; \
            const size_t off_ = (size_t)(row0 + ai * HALF + m * 16) * 1024 + col0 + bj * HALF; const u32x4 g = gv[b_][mm][bj]; \
            f32x4 v0 = acc[ai][bj][m][0], v1 = acc[ai][bj][m][1]; \
            v0[0] *= bf_lo(g.x); v0[1] *= bf_hi(g.x); v0[2] *= bf_lo(g.y); v0[3] *= bf_hi(g.y); v1[0] *= bf_lo(g.z); v1[1] *= bf_hi(g.z); v1[2] *= bf_lo(g.w); v1[3] *= bf_hi(g.w); \
            if (MODE == 1) { const u32x4 p = pv[b_][mm][bj]; \
                v0[0] += bf_lo(p.x); v0[1] += bf_hi(p.x); v0[2] += bf_lo(p.y); v0[3] += bf_hi(p.y); v1[0] += bf_lo(p.z); v1[1] += bf_hi(p.z); v1[2] += bf_lo(p.w); v1[3] += bf_hi(p.w); } \
            u32x4 w; w.x = cvt_pk_bf16(v0[0], v0[1]); w.y = cvt_pk_bf16(v0[2], v0[3]); w.z = cvt_pk_bf16(v1[0], v1[1]); w.w = cvt_pk_bf16(v1[2], v1[3]); \
            *(u32x4*)(O + off_) = w; } } while (0)
        EG_LOAD(0, 0); EG_LOAD(1, 1); EG_DO(0, 0); EG_LOAD(2, 0); EG_DO(1, 1); EG_LOAD(3, 1); EG_DO(2, 0); EG_DO(3, 1);
#undef EG_LOAD
#undef EG_DO
    }
};
struct TwoGemmOrder {
    StaticOrder base; int n1;
    __device__ void init(int M, int N, int G_, int c_) { base.init(M, N, G_, c_); n1 = (base.nwg - c_ + G_ - 1) / G_; if (n1 < 0) n1 = 0; }
    __device__ __forceinline__ bool next(int i, Unit& u) const { if (i >= 2 * n1) return false; const bool second = i >= n1; base.next(second ? i - n1 : i, u); if (second) { u.pm += 128; u.pn += 4; } return true; }
    __device__ __forceinline__ void a_ready(const Unit&) const {}
    __device__ __forceinline__ void done(const Unit&) const {}
};
struct EpiGate2 {
    static constexpr bool PERM = true, AFTER_DRAIN = false; static constexpr int NSTORES = 16;
    const bf16_t* G0; const bf16_t* G1; bf16_t* O;
    __device__ __forceinline__ void operator()(const f32x4 (&acc)[2][2][4][2], const Unit& u, int wr, int wc, int fr, int fq) const {
        Unit v; v.pm = u.pm & 127; v.pn = u.pn & 3;
        if (u.pm >= 128) { EpiGate<1> e{G1, O}; e(acc, v, wr, wc, fr, fq); } else { EpiGate<0> e{G0, O}; e(acc, v, wr, wc, fr, fq); }
    }
};
struct EpiDelta {
    static constexpr bool PERM = true, AFTER_DRAIN = false; static constexpr int NSTORES = 16;
    bf16_t* O;
    __device__ __forceinline__ void operator()(const f32x4 (&acc)[2][2][4][2], const Unit& u, int wr, int wc, int fr, int fq) const {
        const int row0 = u.pm * BM + wr * 64 + fr, col0 = u.pn * BM + wc * 32 + 8 * fq;
#pragma unroll
        for (int ai = 0; ai < 2; ++ai)
#pragma unroll
            for (int m = 0; m < 4; ++m) { bf16_t* rowp = O + (size_t)(row0 + ai * HALF + m * 16) * 1024 + col0;
#pragma unroll
                for (int bj = 0; bj < 2; ++bj) { const f32x4 v0 = acc[ai][bj][m][0], v1 = acc[ai][bj][m][1];
                    u32x4 w; w.x = cvt_pk_bf16(v0[0], v0[1]); w.y = cvt_pk_bf16(v0[2], v0[3]); w.z = cvt_pk_bf16(v1[0], v1[1]); w.w = cvt_pk_bf16(v1[2], v1[3]);
                    *(u32x4*)(rowp + bj * HALF) = w; } }
    }
};
template <int HOOK> struct GroupedOrderT {
    const PG8_LAS int* tile_e; int nunits, G, c; unsigned* rdy; int wid; unsigned* tmo;
    __device__ __forceinline__ bool next(int i, Unit& u) const { const int L = i * G + c; if (L >= nunits) return false; u.pm = L >> 2; u.pn = __builtin_amdgcn_readfirstlane(tile_e[u.pm]) * 4 + (L & 3); return true; }
    __device__ __forceinline__ void a_ready(const Unit& u) const {
        if constexpr (HOOK == 2) {
            if (wid == 0) { unsigned sp = 0u;
                while ((unsigned)__builtin_amdgcn_readfirstlane(__hip_atomic_load(rdy + 8 * u.pm, __ATOMIC_RELAXED, __HIP_MEMORY_SCOPE_AGENT)) < 32u) {
                    __builtin_amdgcn_s_sleep(2);
                    if ((++sp & 1023u) == 0u) { if (__builtin_amdgcn_readfirstlane(__hip_atomic_load(tmo, __ATOMIC_RELAXED, __HIP_MEMORY_SCOPE_AGENT)) != 0u) break;
                        if (sp > (1u << 20)) { if (lane_now() == 0) __hip_atomic_store(tmo, 1u, __ATOMIC_RELAXED, __HIP_MEMORY_SCOPE_AGENT); break; } } }
                __builtin_amdgcn_fence(__ATOMIC_ACQUIRE, "agent");
                asm volatile("s_waitcnt vmcnt(0)" ::: "memory"); }
            asm volatile("" ::: "memory"); __builtin_amdgcn_s_barrier(); asm volatile("" ::: "memory");
        }
    }
    mutable int pend = -1;
    __device__ __forceinline__ void done(const Unit& u) const { if constexpr (HOOK == 1) pend = u.pm; }
    __device__ __forceinline__ void pre() const {
        if constexpr (HOOK == 1) { if (pend >= 0) { asm volatile("s_waitcnt vmcnt(24)" ::: "memory");
            if (lane_now() == 0) (void)__hip_atomic_fetch_add(rdy + 8 * pend, 1u, __ATOMIC_RELAXED, __HIP_MEMORY_SCOPE_AGENT); pend = -1; } }
    }
    __device__ __forceinline__ void fin() const {
        if constexpr (HOOK == 1) { if (pend >= 0) { asm volatile("s_waitcnt vmcnt(0)" ::: "memory");
            if (lane_now() == 0) (void)__hip_atomic_fetch_add(rdy + 8 * pend, 1u, __ATOMIC_RELAXED, __HIP_MEMORY_SCOPE_AGENT); pend = -1; } }
    }
};
using GroupedOrder = GroupedOrderT<0>;
struct EpiSwiGLU {
    static constexpr bool PERM = true, AFTER_DRAIN = false; static constexpr int NSTORES = 8;
    unsigned char* HB;
    __device__ __forceinline__ void operator()(const f32x4 (&acc)[2][2][4][2], const Unit& u, int wr, int wc, int fr, int fq, const PG8_LAS int* rows) const {
        const int row0 = u.pm * BM + wr * 64 + fr, col0 = (u.pn & 3) * HALF + wc * 32 + 8 * fq;
        float sv[2][4];
#pragma unroll
        for (int ai = 0; ai < 2; ++ai)
#pragma unroll
            for (int m = 0; m < 4; ++m) sv[ai][m] = ((const PG8_LAS float*)rows)[6 * 256 + wr * 64 + fr + ai * HALF + m * 16] * (1.0f / W13_SCALE);
#pragma unroll
        for (int ai = 0; ai < 2; ++ai)
#pragma unroll
            for (int m = 0; m < 4; ++m) { const int row = row0 + ai * HALF + m * 16; const float s = sv[ai][m];
                float o[8];
#pragma unroll
                for (int n = 0; n < 2; ++n)
#pragma unroll
                    for (int i = 0; i < 4; ++i) { const float g = acc[ai][0][m][n][i] * s, uu = acc[ai][1][m][n][i] * s; o[n * 4 + i] = g * sigmoid_f(g) * uu * HB_SCALE; }
                unsigned long long w = (unsigned long long)pack4_fp8(o[0], o[1], o[2], o[3]) | ((unsigned long long)pack4_fp8(o[4], o[5], o[6], o[7]) << 32);
                asm volatile("global_store_dwordx2 %0, %1, off sc1" :: "v"((unsigned long long*)(HB + (size_t)row * 512 + col0)), "v"(w) : "memory"); }
    }
};
constexpr float Y_SCALE = 0.25f;
struct EpiY {
    static constexpr bool PERM = true, AFTER_DRAIN = false; static constexpr int NSTORES = 16;
    unsigned char* Y; int skip;
    __device__ __forceinline__ void operator()(const f32x4 (&acc)[2][2][4][2], const Unit& u, int wr, int wc, int fr, int fq) const {
        if (skip == 1) return;
        const int row0 = u.pm * BM + wr * 64 + fr, col0 = (u.pn & 3) * BM + wc * 32 + 8 * fq;
#pragma unroll
        for (int ai = 0; ai < 2; ++ai)
#pragma unroll
            for (int m = 0; m < 4; ++m) { const int row = row0 + ai * HALF + m * 16; unsigned char* rowp = Y + (size_t)row * 1024 + col0;
#pragma unroll
                for (int bj = 0; bj < 2; ++bj) {
                    if (skip == 2) { *(unsigned long long*)(rowp + bj * HALF) = (unsigned long long)__float_as_uint(acc[ai][bj][m][0][0]) | ((unsigned long long)__float_as_uint(acc[ai][bj][m][1][0]) << 32); continue; }
                    const f32x4 v0 = acc[ai][bj][m][0] * Y_SCALE, v1 = acc[ai][bj][m][1] * Y_SCALE;
                    const unsigned long long w = (unsigned long long)pack4_fp8(v0[0], v0[1], v0[2], v0[3]) | ((unsigned long long)pack4_fp8(v1[0], v1[1], v1[2], v1[3]) << 32);
                    if (skip == 3) { asm volatile("" :: "v"(w)); continue; }
                    *(unsigned long long*)(rowp + bj * HALF) = w; } }
    }
};
template <class Epi, class Sched, bool ALIGN_EPI = false, bool SP2 = false, bool F8 = false>
__device__ __forceinline__ void gemm_phase(PG8_LAS unsigned char* lds, const Gemm g, const Sched& S, const Epi& E, const int wid) {
    const int lane = lane_now(), tid = wid * 64 + lane, wr = wid >> 2, wc = wid & 3, fr = lane & 15, fq = lane >> 4;
    const int K = g.K, nt = K / BK;
    unsigned voffA[2], voffB[2];
#pragma unroll
    for (int i = 0; i < 2; ++i) { int R, C; stage_rc(tid * 16 + i * 8192, R, C); const int Rb = Epi::PERM ? ((R & ~31) + perm32(R & 31)) : R;
        voffA[i] = (unsigned)(R * K + C) * 2u; voffB[i] = (unsigned)(Rb * K + C) * 2u; }
    const size_t kstep = (size_t)(BK * 2);
    const size_t hstep = (size_t)HALF * K * 2;
    const size_t tstep = 2 * hstep;
    const unsigned ldsw = (unsigned)wid * 1024u;
    const unsigned ldsbase = (unsigned)__builtin_amdgcn_readfirstlane((int)((unsigned)(uintptr_t)lds + ldsw));
    const int aoff = lds_byte(wr * 64 + fr, fq * 8), boff = lds_byte(wc * 32 + fr, fq * 8);
#define PG8_SA(b, h) (((b) * 2 + (h)) * HTB)
#define PG8_SB(b, h) ((4 + (b) * 2 + (h)) * HTB)
#define PG8_STAGE(bufoff, gbase, voff) do { _Pragma("unroll") for (int _i = 0; _i < 2; ++_i) { \
        if constexpr (F8) glds_sv((const char*)(gbase), (voff)[_i], ldsbase + (unsigned)((bufoff) + _i * 8192)); \
        else __builtin_amdgcn_global_load_lds((const unsigned*)((const char*)(gbase) + (voff)[_i]), (PG8_LAS unsigned*)(lds + (bufoff) + ldsw + _i * 8192), 16, 0, 0); } } while (0)
#define PG8_LDA(dst, b, h) do { _Pragma("unroll") for (int m = 0; m < 4; ++m) { \
        if constexpr (F8) { dst##8[m] = cat8(*(const PG8_LAS bf16x8*)(lds + PG8_SA(b, h) + aoff + m * 2048), *(const PG8_LAS bf16x8*)(lds + PG8_SA(b, h) + aoff + m * 2048 + 1024)); } \
        else { _Pragma("unroll") for (int k = 0; k < 2; ++k) dst[m][k] = *(const PG8_LAS bf16x8*)(lds + PG8_SA(b, h) + aoff + m * 2048 + k * 1024); } } } while (0)
#define PG8_LDB(dst, b, h) do { _Pragma("unroll") for (int n = 0; n < 2; ++n) { \
        if constexpr (F8) { dst##8[n] = cat8(*(const PG8_LAS bf16x8*)(lds + PG8_SB(b, h) + boff + n * 2048), *(const PG8_LAS bf16x8*)(lds + PG8_SB(b, h) + boff + n * 2048 + 1024)); } \
        else { _Pragma("unroll") for (int k = 0; k < 2; ++k) dst[n][k] = *(const PG8_LAS bf16x8*)(lds + PG8_SB(b, h) + boff + n * 2048 + k * 1024); } } } while (0)
#define PG8_MMA(ai, bj, At, Bt) do { __builtin_amdgcn_s_setprio(1); _Pragma("unroll") for (int m = 0; m < 4; ++m) _Pragma("unroll") for (int n = 0; n < 2; ++n) { \
        if constexpr (F8) { acc[ai][bj][m][n] = __builtin_amdgcn_mfma_scale_f32_16x16x128_f8f6f4(Bt##8[n], At##8[m], acc[ai][bj][m][n], 0, 0, 0, 0, 0, 0); } \
        else { _Pragma("unroll") for (int k = 0; k < 2; ++k) acc[ai][bj][m][n] = __builtin_amdgcn_mfma_f32_16x16x32_bf16(Bt[n][k], At[m][k], acc[ai][bj][m][n], 0, 0, 0); } } \
        __builtin_amdgcn_s_setprio(0); } while (0)
#define PG8_WAIT_V(n) asm volatile("s_waitcnt vmcnt(" #n ")" ::: "memory")
#define PG8_WAIT_L(n) asm volatile("s_waitcnt lgkmcnt(" #n ")" ::: "memory")
#define PG8_BAR __builtin_amdgcn_s_barrier()
#define PG8_SCHED __builtin_amdgcn_sched_barrier(0)
    Unit cur, nxt; int ui = 0;
    if (!S.next(0, cur)) return;
    f32x4 acc[2][2][4][2];
#pragma unroll
    for (int a = 0; a < 2; ++a)
#pragma unroll
        for (int b = 0; b < 2; ++b)
#pragma unroll
            for (int m = 0; m < 4; ++m)
#pragma unroll
                for (int n = 0; n < 2; ++n) acc[a][b][m][n] = (f32x4){0.f, 0.f, 0.f, 0.f};
    bf16x8 At[4][2], B0[2][2], B1[2][2]; v8i_t At8[4], B08[2], B18[2];
    const char* cA = (const char*)g.A + (size_t)cur.pm * tstep; const char* cB = (const char*)g.Bt + (size_t)cur.pn * tstep;
    S.a_ready(cur);
    if constexpr (SP2) {
        PG8_STAGE(PG8_SB(0, 0), cB, voffB); PG8_STAGE(PG8_SB(0, 1), cB + hstep, voffB); PG8_STAGE(PG8_SA(0, 0), cA, voffA); PG8_STAGE(PG8_SA(0, 1), cA + hstep, voffA);
        if (wr == 1) PG8_BAR;
        PG8_WAIT_V(2); PG8_BAR;
        PG8_STAGE(PG8_SB(1, 0), cB + kstep, voffB); PG8_STAGE(PG8_SA(1, 0), cA + kstep, voffA); PG8_STAGE(PG8_SB(1, 1), cB + hstep + kstep, voffB);
        PG8_WAIT_V(6); PG8_BAR;
    } else {
        PG8_STAGE(PG8_SB(0, 0), cB, voffB); PG8_STAGE(PG8_SA(0, 0), cA, voffA); PG8_STAGE(PG8_SB(0, 1), cB + hstep, voffB); PG8_STAGE(PG8_SA(0, 1), cA + hstep, voffA);
        if (wr == 1) PG8_BAR;
        PG8_WAIT_V(4); PG8_BAR;
        PG8_STAGE(PG8_SB(1, 0), cB + kstep, voffB); PG8_STAGE(PG8_SA(1, 0), cA + kstep, voffA); PG8_STAGE(PG8_SB(1, 1), cB + hstep + kstep, voffB);
        PG8_WAIT_V(6); PG8_BAR;
    }
    for (;;) {
        const bool has_next = S.next(ui + 1, nxt);
        const char* nA = has_next ? (const char*)g.A + (size_t)nxt.pm * tstep : cA; const char* nB = has_next ? (const char*)g.Bt + (size_t)nxt.pn * tstep : cB;
#pragma clang loop unroll(disable)
        for (int t = 0; t < nt; t += 2) {
            const bool last = (t == nt - 2);
            const char* a1 = cA + (size_t)(t + 1) * kstep;
            const char* a2 = last ? nA : cA + (size_t)(t + 2) * kstep; const char* b2 = last ? nB : cB + (size_t)(t + 2) * kstep;
            const char* a3 = a2 + kstep; const char* b3 = b2 + kstep;
            if (last && has_next) S.a_ready(nxt);
            if constexpr (SP2) {
            PG8_LDB(B0, 0, 0); PG8_LDB(B1, 0, 1); PG8_SCHED; PG8_LDA(At, 0, 0); PG8_STAGE(PG8_SA(1, 1), a1 + hstep, voffA);
            PG8_WAIT_V(8); PG8_WAIT_L(0); PG8_BAR; PG8_MMA(0, 0, At, B0); PG8_MMA(0, 1, At, B1); PG8_BAR; PG8_SCHED;
            PG8_LDA(At, 0, 1); PG8_STAGE(PG8_SB(0, 0), b2, voffB); PG8_STAGE(PG8_SB(0, 1), b2 + hstep, voffB); PG8_STAGE(PG8_SA(0, 0), a2, voffA);
            PG8_WAIT_V(8); PG8_WAIT_L(0); PG8_BAR; PG8_MMA(1, 0, At, B0); PG8_MMA(1, 1, At, B1); PG8_BAR; PG8_SCHED;
            PG8_LDB(B0, 1, 0); PG8_LDB(B1, 1, 1); PG8_SCHED; PG8_LDA(At, 1, 0); PG8_STAGE(PG8_SA(0, 1), a2 + hstep, voffA);
            PG8_WAIT_V(8); PG8_WAIT_L(0); PG8_BAR; PG8_MMA(0, 0, At, B0); PG8_MMA(0, 1, At, B1); PG8_BAR; PG8_SCHED;
            PG8_LDA(At, 1, 1); PG8_STAGE(PG8_SB(1, 0), b3, voffB); PG8_STAGE(PG8_SB(1, 1), b3 + hstep, voffB); PG8_STAGE(PG8_SA(1, 0), a3, voffA);
            PG8_WAIT_V(8); PG8_WAIT_L(0); PG8_BAR; PG8_MMA(1, 0, At, B0); PG8_MMA(1, 1, At, B1); PG8_BAR; PG8_SCHED;
            } else {
            PG8_LDB(B0, 0, 0); PG8_SCHED; PG8_LDA(At, 0, 0); PG8_STAGE(PG8_SA(1, 1), a1 + hstep, voffA);
            PG8_WAIT_L(8); PG8_BAR; PG8_WAIT_L(0); PG8_MMA(0, 0, At, B0); PG8_BAR; PG8_SCHED;
            PG8_LDB(B1, 0, 1); PG8_STAGE(PG8_SB(0, 0), b2, voffB);
            PG8_BAR; PG8_WAIT_L(0); PG8_MMA(0, 1, At, B1); PG8_BAR;
            PG8_LDA(At, 0, 1); PG8_STAGE(PG8_SA(0, 0), a2, voffA);
            PG8_BAR; PG8_WAIT_L(0); PG8_MMA(1, 0, At, B0); PG8_BAR; PG8_SCHED;
            PG8_STAGE(PG8_SB(0, 1), b2 + hstep, voffB);
            PG8_WAIT_V(6); PG8_BAR; PG8_MMA(1, 1, At, B1); PG8_BAR;
            PG8_LDB(B0, 1, 0); PG8_SCHED; PG8_LDA(At, 1, 0); PG8_STAGE(PG8_SA(0, 1), a2 + hstep, voffA);
            PG8_WAIT_L(8); PG8_BAR; PG8_WAIT_L(0); PG8_MMA(0, 0, At, B0); PG8_BAR; PG8_SCHED;
            PG8_LDB(B1, 1, 1); PG8_STAGE(PG8_SB(1, 0), b3, voffB);
            PG8_BAR; PG8_WAIT_L(0); PG8_MMA(0, 1, At, B1); PG8_BAR;
            PG8_LDA(At, 1, 1); PG8_STAGE(PG8_SA(1, 0), a3, voffA);
            PG8_BAR; PG8_WAIT_L(0); PG8_MMA(1, 0, At, B0); PG8_BAR; PG8_SCHED;
            PG8_STAGE(PG8_SB(1, 1), b3 + hstep, voffB);
            PG8_WAIT_V(6); PG8_BAR; PG8_MMA(1, 1, At, B1); PG8_BAR;
            }
        }
        if constexpr (ALIGN_EPI) { if (wr == 0) PG8_BAR; }
        if constexpr (!Epi::AFTER_DRAIN) { const int l2 = lane_now(); E(acc, cur, wr, wc, l2 & 15, l2 >> 4); S.done(cur); }
        if (!has_next) break;
#pragma unroll
        for (int a = 0; a < 2; ++a)
#pragma unroll
            for (int b = 0; b < 2; ++b)
#pragma unroll
                for (int m = 0; m < 4; ++m)
#pragma unroll
                    for (int n = 0; n < 2; ++n) acc[a][b][m][n] = (f32x4){0.f, 0.f, 0.f, 0.f};
        cur = nxt; cA = nA; cB = nB; ++ui;
        if constexpr (ALIGN_EPI) { if (wr == 1) PG8_BAR; }
    }
    PG8_WAIT_V(0);
    if constexpr (!ALIGN_EPI) { if (wr == 0) PG8_BAR; }
    PG8_BAR;
    if constexpr (Epi::AFTER_DRAIN) { E.fused(acc, cur, wr, wc, fr, fq, lds, wid, lane); S.done(cur); }
#undef PG8_SA
#undef PG8_SB
#undef PG8_STAGE
#undef PG8_LDA
#undef PG8_LDB
#undef PG8_MMA
#undef PG8_WAIT_V
#undef PG8_WAIT_L
#undef PG8_BAR
#undef PG8_SCHED
}
template <class Epi, class Sched, bool F8 = false>
__device__ __forceinline__ void gemm_phase_gather(PG8_LAS unsigned char* lds, const Gemm g, const Sched& S, const Epi& E, const PG8_LAS int* rowtab, const int wid) {
    constexpr bool ALIGN_EPI = true, SP2 = true;
    const int lane = lane_now(), tid = wid * 64 + lane, wr = wid >> 2, wc = wid & 3, fr = lane & 15, fq = lane >> 4;
    const int K = g.K, nt = K / BK;
    unsigned voffB[2], vAc[2][2];
#pragma unroll
    for (int i = 0; i < 2; ++i) { int R, C; stage_rc(tid * 16 + i * 8192, R, C); const int Rb = Epi::PERM ? ((R & ~31) + perm32(R & 31)) : R;
        voffB[i] = (unsigned)(Rb * K + C) * 2u; }
#define PG8_ROWS(dst, ui_) do { const int t_ = wid * 64 + lane_now(); _Pragma("unroll") for (int i_ = 0; i_ < 2; ++i_) { int R_, C_; stage_rc(t_ * 16 + i_ * 8192, R_, C_); \
        _Pragma("unroll") for (int h_ = 0; h_ < 2; ++h_) dst[h_][i_] = (unsigned)rowtab[(ui_) * 256 + h_ * HALF + R_] * (unsigned)(K * 2) + (unsigned)(C_ * 2); } } while (0)
#define PG8_STAGE_A(bufoff, v, kb) do { _Pragma("unroll") for (int _i = 0; _i < 2; ++_i) { \
        if constexpr (F8) glds_sv((const char*)g.A + (kb), (v)[_i], ldsbase + (unsigned)((bufoff) + _i * 8192)); \
        else __builtin_amdgcn_global_load_lds((const unsigned*)((const char*)g.A + (v)[_i] + (kb)), (PG8_LAS unsigned*)(lds + (bufoff) + ldsw + _i * 8192), 16, 0, 0); } } while (0)
    const size_t kstep = (size_t)(BK * 2);
    const size_t hstep = (size_t)HALF * K * 2;
    const size_t tstep = 2 * hstep;
    const unsigned ldsw = (unsigned)wid * 1024u;
    const unsigned ldsbase = (unsigned)__builtin_amdgcn_readfirstlane((int)((unsigned)(uintptr_t)lds + ldsw));
    const int aoff = lds_byte(wr * 64 + fr, fq * 8), boff = lds_byte(wc * 32 + fr, fq * 8);
#define PG8_SA(b, h) (((b) * 2 + (h)) * HTB)
#define PG8_SB(b, h) ((4 + (b) * 2 + (h)) * HTB)
#define PG8_STAGE(bufoff, gbase, voff) do { _Pragma("unroll") for (int _i = 0; _i < 2; ++_i) { \
        if constexpr (F8) glds_sv((const char*)(gbase), (voff)[_i], ldsbase + (unsigned)((bufoff) + _i * 8192)); \
        else __builtin_amdgcn_global_load_lds((const unsigned*)((const char*)(gbase) + (voff)[_i]), (PG8_LAS unsigned*)(lds + (bufoff) + ldsw + _i * 8192), 16, 0, 0); } } while (0)
#define PG8_LDA(dst, b, h) do { _Pragma("unroll") for (int m = 0; m < 4; ++m) { \
        if constexpr (F8) { dst##8[m] = cat8(*(const PG8_LAS bf16x8*)(lds + PG8_SA(b, h) + aoff + m * 2048), *(const PG8_LAS bf16x8*)(lds + PG8_SA(b, h) + aoff + m * 2048 + 1024)); } \
        else { _Pragma("unroll") for (int k = 0; k < 2; ++k) dst[m][k] = *(const PG8_LAS bf16x8*)(lds + PG8_SA(b, h) + aoff + m * 2048 + k * 1024); } } } while (0)
#define PG8_LDB(dst, b, h) do { _Pragma("unroll") for (int n = 0; n < 2; ++n) { \
        if constexpr (F8) { dst##8[n] = cat8(*(const PG8_LAS bf16x8*)(lds + PG8_SB(b, h) + boff + n * 2048), *(const PG8_LAS bf16x8*)(lds + PG8_SB(b, h) + boff + n * 2048 + 1024)); } \
        else { _Pragma("unroll") for (int k = 0; k < 2; ++k) dst[n][k] = *(const PG8_LAS bf16x8*)(lds + PG8_SB(b, h) + boff + n * 2048 + k * 1024); } } } while (0)
#define PG8_MMA(ai, bj, At, Bt) do { __builtin_amdgcn_s_setprio(1); _Pragma("unroll") for (int m = 0; m < 4; ++m) _Pragma("unroll") for (int n = 0; n < 2; ++n) { \
        if constexpr (F8) { acc[ai][bj][m][n] = __builtin_amdgcn_mfma_scale_f32_16x16x128_f8f6f4(Bt##8[n], At##8[m], acc[ai][bj][m][n], 0, 0, 0, 0, 0, 0); } \
        else { _Pragma("unroll") for (int k = 0; k < 2; ++k) acc[ai][bj][m][n] = __builtin_amdgcn_mfma_f32_16x16x32_bf16(Bt[n][k], At[m][k], acc[ai][bj][m][n], 0, 0, 0); } } \
        __builtin_amdgcn_s_setprio(0); } while (0)
#define PG8_WAIT_V(n) asm volatile("s_waitcnt vmcnt(" #n ")" ::: "memory")
#define PG8_WAIT_L(n) asm volatile("s_waitcnt lgkmcnt(" #n ")" ::: "memory")
#define PG8_BAR __builtin_amdgcn_s_barrier()
#define PG8_SCHED __builtin_amdgcn_sched_barrier(0)
    Unit cur, nxt; int ui = 0;
    if (!S.next(0, cur)) return;
    f32x4 acc[2][2][4][2];
#pragma unroll
    for (int a = 0; a < 2; ++a)
#pragma unroll
        for (int b = 0; b < 2; ++b)
#pragma unroll
            for (int m = 0; m < 4; ++m)
#pragma unroll
                for (int n = 0; n < 2; ++n) acc[a][b][m][n] = (f32x4){0.f, 0.f, 0.f, 0.f};
    bf16x8 At[4][2], B0[2][2], B1[2][2]; v8i_t At8[4], B08[2], B18[2];
    const char* cB = (const char*)g.Bt + (size_t)cur.pn * tstep;
    PG8_ROWS(vAc, 0);
    S.a_ready(cur);
    if constexpr (SP2) {
        PG8_STAGE(PG8_SB(0, 0), cB, voffB); PG8_STAGE(PG8_SB(0, 1), cB + hstep, voffB); PG8_STAGE_A(PG8_SA(0, 0), vAc[0], 0u); PG8_STAGE_A(PG8_SA(0, 1), vAc[1], 0u);
        if (wr == 1) PG8_BAR;
        PG8_WAIT_V(2); PG8_BAR;
        PG8_STAGE(PG8_SB(1, 0), cB + kstep, voffB); PG8_STAGE_A(PG8_SA(1, 0), vAc[0], (unsigned)kstep); PG8_STAGE(PG8_SB(1, 1), cB + hstep + kstep, voffB);
        PG8_WAIT_V(6); PG8_BAR;
    }
    for (;;) {
        const bool has_next = S.next(ui + 1, nxt);
        const char* nB = has_next ? (const char*)g.Bt + (size_t)nxt.pn * tstep : cB;
#pragma clang loop unroll(disable)
        for (int t = 0; t < nt; t += 2) {
            const bool last = (t == nt - 2);
            const unsigned k1 = (unsigned)((t + 1) * (int)kstep), k2 = last ? 0u : (unsigned)((t + 2) * (int)kstep), k3 = k2 + (unsigned)kstep;
            unsigned v2[2][2];
            if (last && has_next) { PG8_ROWS(v2, ui + 1); }
            else {
#pragma unroll
                for (int h_ = 0; h_ < 2; ++h_)
#pragma unroll
                    for (int i_ = 0; i_ < 2; ++i_) v2[h_][i_] = vAc[h_][i_]; }
            const char* b2 = last ? nB : cB + (size_t)(t + 2) * kstep; const char* b3 = b2 + kstep;
            if (last && has_next) S.a_ready(nxt);
            if constexpr (SP2) {
            PG8_LDB(B0, 0, 0); PG8_LDB(B1, 0, 1); PG8_SCHED; PG8_LDA(At, 0, 0); PG8_STAGE_A(PG8_SA(1, 1), vAc[1], k1);
            PG8_WAIT_V(8); PG8_WAIT_L(0); PG8_BAR; PG8_MMA(0, 0, At, B0); PG8_MMA(0, 1, At, B1); PG8_BAR; PG8_SCHED;
            PG8_LDA(At, 0, 1); PG8_STAGE(PG8_SB(0, 0), b2, voffB); PG8_STAGE(PG8_SB(0, 1), b2 + hstep, voffB); PG8_STAGE_A(PG8_SA(0, 0), v2[0], k2);
            PG8_WAIT_V(8); PG8_WAIT_L(0); PG8_BAR; PG8_MMA(1, 0, At, B0); PG8_MMA(1, 1, At, B1); PG8_BAR; PG8_SCHED;
            PG8_LDB(B0, 1, 0); PG8_LDB(B1, 1, 1); PG8_SCHED; PG8_LDA(At, 1, 0); PG8_STAGE_A(PG8_SA(0, 1), v2[1], k2);
            PG8_WAIT_V(8); PG8_WAIT_L(0); PG8_BAR; PG8_MMA(0, 0, At, B0); PG8_MMA(0, 1, At, B1); PG8_BAR; PG8_SCHED;
            PG8_LDA(At, 1, 1); PG8_STAGE(PG8_SB(1, 0), b3, voffB); PG8_STAGE(PG8_SB(1, 1), b3 + hstep, voffB); PG8_STAGE_A(PG8_SA(1, 0), v2[0], k3);
            PG8_WAIT_V(8); PG8_WAIT_L(0); PG8_BAR; PG8_MMA(1, 0, At, B0); PG8_MMA(1, 1, At, B1); PG8_BAR; PG8_SCHED;
            }
        }
        if constexpr (ALIGN_EPI) { if (wr == 0) PG8_BAR; }
        S.pre(); { const int l2 = lane_now(); E(acc, cur, wr, wc, l2 & 15, l2 >> 4, rowtab + ui * 256); } S.done(cur);
        if (!has_next) break;
#pragma unroll
        for (int a = 0; a < 2; ++a)
#pragma unroll
            for (int b = 0; b < 2; ++b)
#pragma unroll
                for (int m = 0; m < 4; ++m)
#pragma unroll
                    for (int n = 0; n < 2; ++n) acc[a][b][m][n] = (f32x4){0.f, 0.f, 0.f, 0.f};
        cur = nxt; cB = nB; ++ui;
        PG8_ROWS(vAc, ui);
        if constexpr (ALIGN_EPI) { if (wr == 1) PG8_BAR; }
    }
    PG8_WAIT_V(0);
    S.fin();
    if constexpr (!ALIGN_EPI) { if (wr == 0) PG8_BAR; }
    PG8_BAR;
#undef PG8_ROWS
#undef PG8_STAGE_A
#undef PG8_SA
#undef PG8_SB
#undef PG8_STAGE
#undef PG8_LDA
#undef PG8_LDB
#undef PG8_MMA
#undef PG8_WAIT_V
#undef PG8_WAIT_L
#undef PG8_BAR
#undef PG8_SCHED
}
}
#define GAS __attribute__((address_space(1)))
#define LAS __attribute__((address_space(3)))
typedef unsigned short bf16;
typedef unsigned v4u __attribute__((ext_vector_type(4)));
typedef float f32x4 __attribute__((ext_vector_type(4)));
typedef short bf16x8 __attribute__((ext_vector_type(8)));
typedef GAS unsigned gu32;
typedef GAS unsigned long long gu64;
#define RLX_AGENT __ATOMIC_RELAXED, __HIP_MEMORY_SCOPE_AGENT
#define LDS_WAIT() asm volatile("s_waitcnt lgkmcnt(0)" ::: "memory")
#define VM_WAIT() asm volatile("s_waitcnt vmcnt(0)" ::: "memory")
__device__ __forceinline__ unsigned long long rt() { return __builtin_amdgcn_s_memrealtime(); }
__device__ __forceinline__ unsigned f2bf(float f) { unsigned u = __builtin_bit_cast(unsigned, f); return (u + 0x7fffu + ((u >> 16) & 1u)) >> 16; }
__device__ __forceinline__ unsigned pk2(float lo, float hi) { return f2bf(lo) | (f2bf(hi) << 16); }
#define XB_TMO      128
#define XB_XCNT(j)  (256  + 64 * (j))
#define XB_XSUB(j)  (1280 + 64 * (j))
#define XB_XGEN(j)  (2304 + 64 * (j))
#define XB_TOP      3328
#define XB_TOPGEN   3392
#define XCD_BAR_WORDS 3456
#define XB_SPIN_CAP (1u << 18)

__device__ __forceinline__ unsigned xb_ld(unsigned* p)              { return __hip_atomic_load(p, __ATOMIC_RELAXED, __HIP_MEMORY_SCOPE_AGENT); }
__device__ __forceinline__ unsigned xb_add(unsigned* p, unsigned v) { return __hip_atomic_fetch_add(p, v, __ATOMIC_RELAXED, __HIP_MEMORY_SCOPE_AGENT); }
__device__ __forceinline__ unsigned xb_xcc_id() { return (unsigned)__builtin_amdgcn_s_getreg((3 << 11) | 20) & 0xFu; }
#define XB_SPIN(cond, bar) do { unsigned _sp = 0; while (cond) { __builtin_amdgcn_s_sleep(1); \
    if ((++_sp & 255u) == 0u) { if (xb_ld(&(bar)[XB_TMO])) break; if (_sp > XB_SPIN_CAP) { atomicAdd(&(bar)[XB_TMO], 1u); break; } } } } while (0)

struct XcdBarrier {
    unsigned* bar; unsigned x;
    volatile LAS unsigned* st;
};

__device__ __forceinline__ XcdBarrier xcd_barrier_post(unsigned* bar, volatile LAS unsigned* st) {
    XcdBarrier b; b.bar = bar; b.x = xb_xcc_id(); b.st = st;
    if (threadIdx.x == 0) (void)xb_add(&bar[XB_XCNT(b.x)], 1u);
    return b;
}
__device__ __forceinline__ void xcd_barrier_complete(unsigned* bar, unsigned x, unsigned& nloc, unsigned& nx) {
    const unsigned G = gridDim.x * gridDim.y * gridDim.z;
    unsigned sum, cnt, mine, sp = 0u;
    for (;;) {
        sum = 0u; cnt = 0u; mine = 0u;
#pragma unroll
        for (unsigned j = 0; j < 16; ++j) { const unsigned c = xb_ld(&bar[XB_XCNT(j)]); sum += c; cnt += (c > 0u) ? 1u : 0u; mine = (j == x) ? c : mine; }
        if (sum == G) break;
        __builtin_amdgcn_s_sleep(1);
        if ((++sp & 255u) == 0u) { if (xb_ld(&bar[XB_TMO])) break; if (sp > XB_SPIN_CAP) { atomicAdd(&bar[XB_TMO], 1u); break; } }
    }
    nloc = mine > 0u ? mine : 1u; nx = cnt > 0u ? cnt : 1u;
}

__device__ __forceinline__ void xcd_barrier(const XcdBarrier& b) {
    asm volatile("s_waitcnt vmcnt(0)" ::: "memory");
    __syncthreads();
    if (threadIdx.x == 0) {
        unsigned* bar = b.bar;
        __builtin_amdgcn_s_waitcnt(0);
        unsigned nloc = b.st[0], nx = b.st[1];
        if (nloc == 0u) { xcd_barrier_complete(bar, b.x, nloc, nx); b.st[0] = nloc; b.st[1] = nx; }
        const unsigned old = xb_add(&bar[XB_XSUB(b.x)], 1u);
        const unsigned gen = old / nloc;
        if (old + 1u == (gen + 1u) * nloc) {
            __builtin_amdgcn_fence(__ATOMIC_RELEASE, "agent");
            asm volatile("s_waitcnt vmcnt(0)" ::: "memory");
            const unsigned og = xb_add(&bar[XB_TOP], 1u);
            const unsigned tg = og / nx;
            if (og + 1u == (tg + 1u) * nx) xb_add(&bar[XB_TOPGEN], 1u);
            else XB_SPIN(xb_ld(&bar[XB_TOPGEN]) == tg, bar);
            __builtin_amdgcn_fence(__ATOMIC_ACQUIRE, "agent");
            xb_add(&bar[XB_XGEN(b.x)], 1u);
            asm volatile("s_waitcnt vmcnt(0)" ::: "memory");
        } else {
            XB_SPIN(xb_ld(&bar[XB_XGEN(b.x)]) == gen, bar);
            __builtin_amdgcn_fence(__ATOMIC_ACQUIRE, "agent");
            asm volatile("s_waitcnt vmcnt(0)" ::: "memory");
        }
    }
    __syncthreads();
}
namespace fattn {
typedef unsigned short bf16;
typedef short bf16x8 __attribute__((ext_vector_type(8)));
typedef short s16x4 __attribute__((ext_vector_type(4)));
typedef float f32x16 __attribute__((ext_vector_type(16)));
typedef float f32x4 __attribute__((ext_vector_type(4)));
typedef unsigned u32x4 __attribute__((ext_vector_type(4)));
constexpr int D = 128, LD = 128, LDO = 1024, SEQ = 4096;
constexpr float THR = 8.f;
constexpr float SCALE = 0.08838834764831845f;
constexpr int NW = 8, QBLK = 32, KVBLK = 64, QB = NW * QBLK;
constexpr int SHM_V = KVBLK * D * 2, SHM_K = KVBLK * D * 2;
constexpr int OFF_WS = 2 * SHM_V + 2 * SHM_K, OFF_BIAS = OFF_WS + NW * 64 * 4, LDS_BYTES = OFF_BIAS + 2 * 64 * 4;

#define KSWZ(row, colB) ((row) * 256 + ((colB) ^ (((row) & 7) << 4)))
#define SBAR() __builtin_amdgcn_sched_barrier(0)
__device__ __forceinline__ int v_st(int k, int c) { const int kk = (k & ~0xC) | ((k & 4) << 1) | ((k & 8) >> 1); return ((kk >> 3) * 4 + (c >> 5)) * 512 + ((kk & 7) * 32 + (c & 31)) * 2; }
__device__ __forceinline__ int v_rd_base(int lane) { return ((lane & 3) << 3) | (((lane >> 2) & 3) << 6) | (((lane >> 4) & 1) << 5) | (((lane >> 5) & 1) << 8); }
constexpr int v_rd_off(int d0, int ks, int half) { return d0 * 512 + ks * 4096 + half * 2048; }
__device__ __forceinline__ int crow(int r, int hi) { return (r & 3) + 8 * (r >> 2) + 4 * hi; }
__device__ __forceinline__ unsigned cvtpk(float lo, float hi) { unsigned r; asm volatile("v_cvt_pk_bf16_f32 %0, %1, %2" : "=v"(r) : "v"(lo), "v"(hi)); return r; }
__device__ __forceinline__ bf16x8 load8(const bf16* p) { return *reinterpret_cast<const bf16x8*>(p); }
__device__ __forceinline__ void mask_tile(f32x16& p0, f32x16& p1, int dq) {
    const float NEG = -__builtin_inff();
#pragma unroll
    for (int r = 0; r < 16; ++r) {
        const int c = (r & 3) + 8 * (r >> 2);
        if (dq - c < 0) p0[r] = NEG;
        if (dq - c - 32 < 0) p1[r] = NEG;
    }
}
__device__ __forceinline__ void partialSM(f32x16& p0, f32x16& p1, float& m_reg, float& mn, float& alpha) {
    float pmax = p0[0]; for (int r = 1; r < 16; ++r) pmax = fmaxf(pmax, p0[r]); for (int r = 0; r < 16; ++r) pmax = fmaxf(pmax, p1[r]);
    { auto rr = __builtin_amdgcn_permlane32_swap(__float_as_uint(pmax), __float_as_uint(pmax), false, false);
      pmax = fmaxf(__uint_as_float(rr[0]), __uint_as_float(rr[1])); }
    constexpr float C2 = 1.4426950408889634f * SCALE;
    if (__builtin_expect(__all((pmax - m_reg) * SCALE <= THR), 1)) { mn = m_reg; alpha = 1.f; }
    else { mn = fmaxf(m_reg, pmax); alpha = __builtin_amdgcn_exp2f((m_reg - mn) * C2); m_reg = mn; }
    const float mnL = -mn * C2;
    for (int r = 0; r < 16; ++r) p0[r] = fmaf(p0[r], C2, mnL); for (int r = 0; r < 16; ++r) p1[r] = fmaf(p1[r], C2, mnL);
    for (int r = 0; r < 16; ++r) p0[r] = __builtin_amdgcn_exp2f(p0[r]);
}
__device__ __forceinline__ void finishSM(f32x16& p0, f32x16& p1, float alpha, float& l_reg, bf16x8& pa0, bf16x8& pa1, bf16x8& pa2, bf16x8& pa3) {
    for (int r = 0; r < 16; ++r) p1[r] = __builtin_amdgcn_exp2f(p1[r]);
    float ps = 0; for (int r = 0; r < 16; ++r) ps += p0[r]; for (int r = 0; r < 16; ++r) ps += p1[r];
    { auto rr = __builtin_amdgcn_permlane32_swap(__float_as_uint(ps), __float_as_uint(ps), false, false);
      ps = __uint_as_float(rr[0]) + __uint_as_float(rr[1]); }
    l_reg = l_reg * alpha + ps;
#define PK4(P, B_, OUT) do { unsigned a0 = cvtpk(P[B_+0], P[B_+1]), a1 = cvtpk(P[B_+2], P[B_+3]);                          \
        unsigned b0 = cvtpk(P[B_+4], P[B_+5]), b1 = cvtpk(P[B_+6], P[B_+7]);                                             \
        auto r0 = __builtin_amdgcn_permlane32_swap(a0, b0, false, false); auto r1 = __builtin_amdgcn_permlane32_swap(a1, b1, false, false); \
        u32x4 w = {r0[0], r1[0], r0[1], r1[1]}; OUT = *reinterpret_cast<bf16x8*>(&w); } while (0)
    PK4(p0, 0, pa0); PK4(p0, 8, pa1); PK4(p1, 0, pa2); PK4(p1, 8, pa3);
#undef PK4
}
template <int KB>
__device__ __forceinline__ void qkt(f32x16& p0, f32x16& p1, const char* K_lds, const char* Bias_lds, int r32, int hi, const bf16x8* qr) {
    { const f32x4* bb = reinterpret_cast<const f32x4*>(Bias_lds + KB * 256 + hi * 16);
      const f32x4 a0 = bb[0], a1 = bb[2], a2 = bb[4], a3 = bb[6], c0 = bb[8], c1 = bb[10], c2 = bb[12], c3 = bb[14];
      p0 = (f32x16){a0[0], a0[1], a0[2], a0[3], a1[0], a1[1], a1[2], a1[3], a2[0], a2[1], a2[2], a2[3], a3[0], a3[1], a3[2], a3[3]};
      p1 = (f32x16){c0[0], c0[1], c0[2], c0[3], c1[0], c1[1], c1[2], c1[3], c2[0], c2[1], c2[2], c2[3], c3[0], c3[1], c3[2], c3[3]}; }
    const char* kb[4];
#pragma unroll
    for (int dd = 0; dd < 4; ++dd) kb[dd] = K_lds + KB * SHM_K + KSWZ(r32, (dd * 16 + hi * 8) * 2);
#pragma unroll
    for (int d0 = 0; d0 < 8; ++d0) { const char* a = kb[d0 & 3] + (d0 >> 2) * 128;
        bf16x8 b0 = *reinterpret_cast<const bf16x8*>(a);
        bf16x8 b1 = *reinterpret_cast<const bf16x8*>(a + 32 * 256);
        p0 = __builtin_amdgcn_mfma_f32_32x32x16_bf16(b0, qr[d0], p0, 0, 0, 0);
        p1 = __builtin_amdgcn_mfma_f32_32x32x16_bf16(b1, qr[d0], p1, 0, 0, 0); }
}
template <int VB>
__device__ __forceinline__ void pv_tile(f32x16* o, int vb0, bf16x8 pa0, bf16x8 pa1, bf16x8 pa2, bf16x8 pa3) {
#define TRRD(dst, off) asm volatile("ds_read_b64_tr_b16 %0, %1 offset:%2" : "=&v"(dst) : "v"(vb0), "i"(off) : "memory")
#define PV_D0(d0) do { s16x4 l0, l1, l2, l3, h0, h1, h2, h3; constexpr int b_ = VB * SHM_V + v_rd_off(d0, 0, 0);   \
        TRRD(l0, b_); TRRD(h0, b_ + 2048); TRRD(l1, b_ + 4096); TRRD(h1, b_ + 6144); TRRD(l2, b_ + 8192); TRRD(h2, b_ + 10240); TRRD(l3, b_ + 12288); TRRD(h3, b_ + 14336); \
        asm volatile("s_waitcnt lgkmcnt(0)" ::: "memory"); SBAR();                                                    \
        o[d0] = __builtin_amdgcn_mfma_f32_32x32x16_bf16(pa0, (bf16x8){l0[0], l0[1], l0[2], l0[3], h0[0], h0[1], h0[2], h0[3]}, o[d0], 0, 0, 0);   \
        o[d0] = __builtin_amdgcn_mfma_f32_32x32x16_bf16(pa1, (bf16x8){l1[0], l1[1], l1[2], l1[3], h1[0], h1[1], h1[2], h1[3]}, o[d0], 0, 0, 0);   \
        o[d0] = __builtin_amdgcn_mfma_f32_32x32x16_bf16(pa2, (bf16x8){l2[0], l2[1], l2[2], l2[3], h2[0], h2[1], h2[2], h2[3]}, o[d0], 0, 0, 0);   \
        o[d0] = __builtin_amdgcn_mfma_f32_32x32x16_bf16(pa3, (bf16x8){l3[0], l3[1], l3[2], l3[3], h3[0], h3[1], h3[2], h3[3]}, o[d0], 0, 0, 0); } while (0)
    PV_D0(0); PV_D0(1); PV_D0(2); PV_D0(3);
#undef PV_D0
#undef TRRD
}

struct Bases { const bf16* Q; bf16* O; const bf16* K; const bf16* V; const float* CB; };
struct BlockRef { unsigned qo, oo, kvo, cbo; int P0, jlo; };
struct Seam { bf16x8 qr[8]; };
#define VMW() asm volatile("s_waitcnt vmcnt(0)" ::: "memory")
#define VMWN(n) asm volatile("s_waitcnt vmcnt(%0)" :: "i"(n) : "memory")
#define LBAR() do { asm volatile("s_waitcnt lgkmcnt(0)" ::: "memory"); __builtin_amdgcn_s_barrier(); asm volatile("" ::: "memory"); } while (0)
#define ATT_SRC() \
    unsigned ksrc0, ksrc1, vsrc0, vsrc1; \
    { const int rw0 = 8 * wid + (lane >> 4), rw1 = rw0 + 4, p_ = lane & 15; ksrc0 = (unsigned)(rw0 * 256 + ((p_ ^ (rw0 & 7)) << 4)); ksrc1 = (unsigned)(rw1 * 256 + ((p_ ^ (rw1 & 7)) << 4)); \
      const int L0 = 128 * wid + lane, L1 = L0 + 64; \
      const int kk0 = ((L0 >> 7) << 3) | ((L0 >> 2) & 7), kk1 = ((L1 >> 7) << 3) | ((L1 >> 2) & 7); \
      const int k0_ = (kk0 & ~0xC) | ((kk0 & 4) << 1) | ((kk0 & 8) >> 1), k1_ = (kk1 & ~0xC) | ((kk1 & 4) << 1) | ((kk1 & 8) >> 1); \
      vsrc0 = (unsigned)(k0_ * 256 + ((((L0 >> 5) & 3) * 4 + (L0 & 3)) << 4)); vsrc1 = (unsigned)(k1_ * 256 + ((((L1 >> 5) & 3) * 4 + (L1 & 3)) << 4)); }
#define DMA_K(Kp, CBp, k0, bf) do { const char* kp_ = (const char*)(Kp) + (unsigned)(k0) * 256u; \
        __builtin_amdgcn_global_load_lds((const unsigned*)(kp_ + ksrc0), (LAS unsigned*)(ldsa + 2 * SHM_V + (bf) * SHM_K + (2 * wid) * 1024), 16, 0, 0); \
        __builtin_amdgcn_global_load_lds((const unsigned*)(kp_ + ksrc1), (LAS unsigned*)(ldsa + 2 * SHM_V + (bf) * SHM_K + (2 * wid + 1) * 1024), 16, 0, 0); \
        if (wid == 0) __builtin_amdgcn_global_load_lds((const unsigned*)((CBp) + (unsigned)((k0) + lane)), (LAS unsigned*)(ldsa + OFF_BIAS + (bf) * 256), 4, 0, 0); } while (0)
#define DMA_V(Vp, k0, bf) do { const char* vp_ = (const char*)(Vp) + (unsigned)(k0) * 256u; \
        __builtin_amdgcn_global_load_lds((const unsigned*)(vp_ + vsrc0), (LAS unsigned*)(ldsa + (bf) * SHM_V + (2 * wid) * 1024), 16, 0, 0); \
        __builtin_amdgcn_global_load_lds((const unsigned*)(vp_ + vsrc1), (LAS unsigned*)(ldsa + (bf) * SHM_V + (2 * wid + 1) * 1024), 16, 0, 0); } while (0)
__device__ __forceinline__ void prime(const Bases& G, const BlockRef& cur, char* lds, LAS unsigned char* ldsa, Seam& S) {
    const int tid = threadIdx.x, wid = __builtin_amdgcn_readfirstlane(tid >> 6), lane = tid & 63, r32 = lane & 31, hi = lane >> 5;
    ATT_SRC();
    for (int d0 = 0; d0 < 8; ++d0) S.qr[d0] = load8(G.Q + (cur.qo + (unsigned)((wid * QBLK + r32) * LD + d0 * 16 + hi * 8)));
    DMA_K(G.K + cur.kvo, G.CB + cur.cbo, cur.jlo * KVBLK, 0); DMA_V(G.V + cur.kvo, cur.jlo * KVBLK, 0);
    VMW(); LBAR();
}
__device__ __forceinline__ void block(const Bases& G, const BlockRef& cur, const BlockRef& nxt, char* lds, LAS unsigned char* ldsa, Seam& S) {
    const int tid = threadIdx.x, wid = __builtin_amdgcn_readfirstlane(tid >> 6), lane = tid & 63, r32 = lane & 31, hi = lane >> 5;
    const int j_lo = cur.jlo, NT = (cur.P0 + QB - 1) / KVBLK + 1 - j_lo;
    const int qlo = cur.P0 + wid * QBLK, qm = qlo + r32 - 4 * hi;
    char* V_lds = lds; char* K_lds = lds + 2 * SHM_V; char* B_lds = lds + OFF_BIAS;
    float* ws = (float*)(lds + OFF_WS) + wid * 64; float* li_l = ws, * al_l = ws + 32;
    float m_reg = G.CB[cur.cbo + (unsigned)(cur.P0 + wid * QBLK + r32)], l_reg = 0; f32x16 o[4] = {};
    const int vb0 = (int)(uintptr_t)V_lds + v_rd_base(lane);
    const bf16* Kh = G.K + cur.kvo; const bf16* Vh = G.V + cur.kvo; const float* CBh = G.CB + cur.cbo;
    ATT_SRC();
#define RESC(a) do { if (__any((a) < 1.f)) { if (hi == 0) al_l[r32] = (a); asm volatile("s_waitcnt lgkmcnt(0)" ::: "memory");              \
                     for (int d_ = 0; d_ < 4; ++d_) for (int r = 0; r < 16; ++r) o[d_][r] *= al_l[crow(r, hi)]; } } while (0)
#define KBASE(t) ((j_lo + (t)) * KVBLK)
#define MASKT(P0_, P1_, t) do { const int kb_ = KBASE(t); if (kb_ + KVBLK - 1 > qlo) mask_tile(P0_, P1_, qm - kb_); } while (0)
    f32x16 pA0, pA1, pB0, pB1; float mnA, mnB, alA, alB; bf16x8 pa0, pa1, pa2, pa3;
    DMA_K(Kh, CBh, KBASE(1), 1); DMA_V(Vh, KBASE(1), 1);
    SBAR(); qkt<0>(pA0, pA1, K_lds, B_lds, r32, hi, S.qr);
    MASKT(pA0, pA1, 0); partialSM(pA0, pA1, m_reg, mnA, alA);
    VMW(); LBAR();
#define HALF_STEP(PX0, PX1, mnX, alX, PY0, PY1, alY, t, KB, VB, SB) do {                                                      \
        SBAR(); if ((t) + 1 < NT) { DMA_K(Kh, CBh, KBASE((t) + 1), SB); SBAR(); }                                            \
        qkt<KB>(PX0, PX1, K_lds, B_lds, r32, hi, S.qr);                                                                        \
        finishSM(PY0, PY1, alY, l_reg, pa0, pa1, pa2, pa3); SBAR();                                                           \
        pv_tile<VB>(o, vb0, pa0, pa1, pa2, pa3); MASKT(PX0, PX1, (t)); partialSM(PX0, PX1, m_reg, mnX, alX);                   \
        LBAR();                                                                                                               \
        if ((t) + 1 < NT) { DMA_V(Vh, KBASE((t) + 1), SB); }                                                                  \
        RESC(alX); VMWN(2); LBAR(); } while (0)
    for (int t = 1; t + 1 < NT; t += 2) {
        HALF_STEP(pB0, pB1, mnB, alB, pA0, pA1, alA, t, 1, 0, 0);
        HALF_STEP(pA0, pA1, mnA, alA, pB0, pB1, alB, t + 1, 0, 1, 1);
    }
    SBAR(); qkt<1>(pB0, pB1, K_lds, B_lds, r32, hi, S.qr); SBAR();
    DMA_K(G.K + nxt.kvo, G.CB + nxt.cbo, nxt.jlo * KVBLK, 0); SBAR();
#pragma unroll
    for (int d0 = 0; d0 < 8; ++d0) S.qr[d0] = load8(G.Q + (nxt.qo + (unsigned)((wid * QBLK + r32) * LD + d0 * 16 + hi * 8)));
    SBAR();
    finishSM(pA0, pA1, alA, l_reg, pa0, pa1, pa2, pa3); SBAR();
    pv_tile<0>(o, vb0, pa0, pa1, pa2, pa3);
    MASKT(pB0, pB1, NT - 1); partialSM(pB0, pB1, m_reg, mnB, alB);
    VMWN(10); LBAR();
    DMA_V(G.V + nxt.kvo, nxt.jlo * KVBLK, 0);
    RESC(alB);
    finishSM(pB0, pB1, alB, l_reg, pa0, pa1, pa2, pa3); SBAR(); pv_tile<1>(o, vb0, pa0, pa1, pa2, pa3);
    SBAR();
    if (hi == 0) li_l[r32] = l_reg; asm volatile("s_waitcnt lgkmcnt(0)" ::: "memory");
    float rli[16];
#pragma unroll
    for (int r = 0; r < 16; ++r) rli[r] = __builtin_amdgcn_rcpf(li_l[crow(r, hi)]);
    bf16* Ow = G.O + (cur.oo + (unsigned)(wid * QBLK * LDO));
#pragma unroll
    for (int r = 0; r < 16; ++r) { const int orow = crow(r, hi);
#pragma unroll
        for (int d0 = 0; d0 < 4; ++d0) { const float v = o[d0][r] * rli[r];
            const float vn = __shfl_xor(v, 1);
            if ((r32 & 1) == 0) *(unsigned*)(Ow + (unsigned)(orow * LDO + d0 * 32 + r32)) = cvtpk(v, vn); } }
    VMW(); LBAR();
#undef RESC
#undef KBASE
#undef MASKT
#undef HALF_STEP
}
#undef VMW
#undef VMWN
#undef LBAR
#undef ATT_SRC
#undef DMA_K
#undef DMA_V
#undef KSWZ
#undef SBAR
}
constexpr int NB = 8, SEQ = 4096, T = NB * SEQ, DM = 1024, NH = 8, HD = 128, INW = 7176, NZ = 7168;
constexpr int NE = 32, DE = 512;
constexpr float EPS = 1e-6f;
constexpr int PMAX = 73728;
constexpr int NWAVES = 8;
constexpr size_t MiB = 1u << 20;
constexpr size_t WS_CTL = 0, CTL_ZERO_BYTES = 64 * 1024;
constexpr size_t WS_RS1 = 1 * MiB, WS_RS2 = 1 * MiB + 256 * 1024;
constexpr size_t WS_LF = 1 * MiB + 512 * 1024;
constexpr size_t WS_CB = 2 * MiB + 512 * 1024;
constexpr size_t WS_TOK = 3 * MiB + 512 * 1024;
constexpr size_t WS_LISTS = 5 * MiB;
constexpr size_t WS_WRT = 9 * MiB;
constexpr size_t WS_SRS = 9 * MiB + 512 * 1024, WS_SW = 10 * MiB;
constexpr size_t WS_WIN = 16 * MiB;
constexpr size_t WS_WA = 30 * MiB, WS_WL = 32 * MiB, WS_WO = 34 * MiB;
constexpr size_t WS_WRG = 36 * MiB;
constexpr size_t WS_XB = 40 * MiB;
constexpr size_t WS_XR = 104 * MiB;
constexpr size_t WS_GG = 168 * MiB;
constexpr size_t WS_Q = 232 * MiB, WS_K = 296 * MiB, WS_V = 360 * MiB;
constexpr size_t WS_W13 = 424 * MiB;
constexpr size_t WS_W2 = 392 * MiB;
constexpr size_t WS_XG = 168 * MiB;
constexpr size_t WS_HB = 296 * MiB;
constexpr size_t WS_WIN8 = 488 * MiB;
constexpr unsigned SEG8_MASK = 0x7Cu;
__host__ __device__ constexpr int seg_row(int sg) { int r = 0; for (int t = 0; t < sg; ++t) if (((SEG8_MASK >> t) & 1u) == ((SEG8_MASK >> sg) & 1u)) ++r; return r; }
__host__ __device__ constexpr unsigned seg_map(bool f8) { unsigned m = 0; int j = 0; for (int t = 0; t < 7; ++t) if ((((SEG8_MASK >> t) & 1u) != 0u) == f8) { m |= (unsigned)t << (4 * j); ++j; } return m; }
__host__ __device__ constexpr int seg_cnt(bool f8) { int j = 0; for (int t = 0; t < 7; ++t) if ((((SEG8_MASK >> t) & 1u) != 0u) == f8) ++j; return j; }
constexpr size_t WS_X8P = 456 * MiB;
constexpr size_t WS_END = 512 * MiB;
static_assert(WS_XG + (size_t)PMAX * 1024 <= WS_K && WS_HB + (size_t)PMAX * 1024 <= WS_W2 && WS_W2 + 32u * 1024 * 512 * 2 <= WS_W13 && WS_W13 + 64 * MiB <= WS_END, "d_ws map");
constexpr int CW_TMO = 0, CW_CODE = 1, CW_BAR = 4096, CW_CNT = 8192, CW_NORM = 8448, CW_QCTR = 12288, CW_RDY = 14000;
constexpr int RING_OFF = 0, RING_BYTES = 131072;
constexpr int LDSCTL_OFF = RING_BYTES, MISC_OFF = LDSCTL_OFF + 320;
constexpr int TBL_OFF = RING_BYTES + 1024;
constexpr int TBL_PS = TBL_OFF, TBL_CN = TBL_OFF + 256, TBL_TE = TBL_OFF + 512;
constexpr int RG_TOT = RING_BYTES + 4096, RG_CAR = RG_TOT + 4096;
constexpr int LDS_BYTES = 147456;

#include <cmath>
using pg8::bf_lo; using pg8::bf_hi; using pg8::sigmoid_f;

struct Frame {
    LAS unsigned char* lds;
    int tid, lane, wave, vcu, G;
};
__device__ __forceinline__ float wave_sum(float v) {
#pragma unroll
    for (int o = 1; o < 64; o <<= 1) v += __shfl_xor(v, o);
    return v;
}
__device__ __forceinline__ void transpose_tile(const float* src, int ld, bf16* dst, int ldd, const float* kscale, LAS float* scr, int lane) {
    const int q = lane & 7, kr = lane >> 3;
    f32x4 v[8];
#pragma unroll
    for (int i = 0; i < 8; ++i) v[i] = __builtin_nontemporal_load((const f32x4*)(src + (size_t)(kr + 8 * i) * ld + 4 * q));
#pragma unroll
    for (int i = 0; i < 8; ++i) { const int kk = kr + 8 * i; const float sc = kscale ? kscale[kk] : 1.0f;
#pragma unroll
        for (int c = 0; c < 4; ++c) scr[kk * 33 + 4 * q + c] = v[i][c] * sc; }
    LDS_WAIT(); asm volatile("" ::: "memory");
    const int c = lane & 7;
#pragma unroll
    for (int j = 0; j < 4; ++j) { const int n = (lane >> 3) + 8 * j; const LAS float* s = scr + (8 * c) * 33 + n;
        v4u o; o.x = pk2(s[0 * 33], s[1 * 33]); o.y = pk2(s[2 * 33], s[3 * 33]); o.z = pk2(s[4 * 33], s[5 * 33]); o.w = pk2(s[6 * 33], s[7 * 33]);
        *(GAS v4u*)(dst + (size_t)n * ldd + 8 * c) = o; }
    LDS_WAIT(); asm volatile("" ::: "memory");
}

__device__ __forceinline__ void transpose_tile8(const float* src, int ld, unsigned char* dst, int ldd, const float* kscale, float scale, LAS float* scr, int lane) {
    const int q = lane & 7, kr = lane >> 3;
    f32x4 v[8];
#pragma unroll
    for (int i = 0; i < 8; ++i) v[i] = __builtin_nontemporal_load((const f32x4*)(src + (size_t)(kr + 8 * i) * ld + 4 * q));
#pragma unroll
    for (int i = 0; i < 8; ++i) { const int kk = kr + 8 * i; const float sc = kscale ? kscale[kk] * scale : scale;
#pragma unroll
        for (int c = 0; c < 4; ++c) scr[kk * 33 + 4 * q + c] = v[i][c] * sc; }
    LDS_WAIT(); asm volatile("" ::: "memory");
    const int c = lane & 3;
#pragma unroll
    for (int j = 0; j < 2; ++j) { const int n = (lane >> 2) + 16 * j; const LAS float* s = scr + (16 * c) * 33 + n;
        v4u o; o.x = pg8::pack4_fp8(s[0 * 33], s[1 * 33], s[2 * 33], s[3 * 33]); o.y = pg8::pack4_fp8(s[4 * 33], s[5 * 33], s[6 * 33], s[7 * 33]);
        o.z = pg8::pack4_fp8(s[8 * 33], s[9 * 33], s[10 * 33], s[11 * 33]); o.w = pg8::pack4_fp8(s[12 * 33], s[13 * 33], s[14 * 33], s[15 * 33]);
        *(GAS v4u*)(dst + (size_t)n * ldd + 16 * c) = o; }
    LDS_WAIT(); asm volatile("" ::: "memory");
}

struct P0Args { const float *x, *g_mix, *w_in, *w_rg_a, *w_rg_x, *b_forget, *w_lru_out, *w_attn_out, *w_out, *g_ffn, *w_rgrp, *w_rexp, *w_gate, *w_up;
                bf16 *Win, *Wl, *Wa, *Wo, *Wrg, *XB; unsigned char* W13; float *RS1, *LF, *WRT; unsigned char *Win8, *X8P; };
struct TItem { const float* src; int ld; unsigned char* dst; int ldd; const float* ks; float scale; int f8; };
__device__ __forceinline__ void titem_load(const TItem& t, f32x4 (&v)[8], float (&sc)[8], int lane) {
    const int q = lane & 7, kr = lane >> 3;
#pragma unroll
    for (int i = 0; i < 8; ++i) { v[i] = __builtin_nontemporal_load((const f32x4*)(t.src + (size_t)(kr + 8 * i) * t.ld + 4 * q)); sc[i] = t.ks ? t.ks[kr + 8 * i] * t.scale : t.scale; }
}
__device__ __forceinline__ void titem_finish(const TItem& t, const f32x4 (&v)[8], const float (&sc)[8], LAS float* scr, int lane) {
    const int q = lane & 7, kr = lane >> 3;
#pragma unroll
    for (int i = 0; i < 8; ++i) { const int kk = kr + 8 * i;
#pragma unroll
        for (int c = 0; c < 4; ++c) scr[kk * 33 + 4 * q + c] = v[i][c] * sc[i]; }
    LDS_WAIT(); asm volatile("" ::: "memory");
    if (t.f8) { const int c = lane & 3;
#pragma unroll
        for (int j = 0; j < 2; ++j) { const int n = (lane >> 2) + 16 * j; const LAS float* s = scr + (16 * c) * 33 + n;
            v4u o; o.x = pg8::pack4_fp8(s[0 * 33], s[1 * 33], s[2 * 33], s[3 * 33]); o.y = pg8::pack4_fp8(s[4 * 33], s[5 * 33], s[6 * 33], s[7 * 33]);
            o.z = pg8::pack4_fp8(s[8 * 33], s[9 * 33], s[10 * 33], s[11 * 33]); o.w = pg8::pack4_fp8(s[12 * 33], s[13 * 33], s[14 * 33], s[15 * 33]);
            *(GAS v4u*)(t.dst + (size_t)n * t.ldd + 16 * c) = o; } }
    else { const int c = lane & 7;
#pragma unroll
        for (int j = 0; j < 4; ++j) { const int n = (lane >> 3) + 8 * j; const LAS float* s = scr + (8 * c) * 33 + n;
            v4u o; o.x = pk2(s[0 * 33], s[1 * 33]); o.y = pk2(s[2 * 33], s[3 * 33]); o.z = pk2(s[4 * 33], s[5 * 33]); o.w = pk2(s[6 * 33], s[7 * 33]);
            *(GAS v4u*)(t.dst + ((size_t)n * t.ldd + 8 * c) * 2) = o; } }
    LDS_WAIT(); asm volatile("" ::: "memory");
}
constexpr int P0_I_IN = 16 * 224, P0_I_SQ = 16 * 32, P0_I_RG = 2 * 4 * 4 * 8, P0_I_EX = 2 * 8192, P0_NITEMS = P0_I_IN + 3 * P0_I_SQ + P0_I_RG + P0_I_EX;
__device__ __forceinline__ void p0_items(const Frame& F, const P0Args& a, const int first, const int last, const int stride, const int offset) {
    LAS float* scr = (LAS float*)(F.lds + RING_OFF + F.wave * 16384);
    const float* const p_wl = a.w_lru_out; const float* const p_wa = a.w_attn_out; const float* const p_wo = a.w_out; const float* const p_rga = a.w_rg_a; const float* const p_rgx = a.w_rg_x;
    bf16* const q_wl = a.Wl; bf16* const q_wa = a.Wa; bf16* const q_wo = a.Wo;
    constexpr int I_IN = P0_I_IN, I_SQ = P0_I_SQ, I_EX = P0_I_EX, NITEMS = P0_NITEMS;
    const float* const p_gate = a.w_gate; const float* const p_up = a.w_up; const float* const p_win = a.w_in; const float* const p_gmix = a.g_mix; const float* const p_gffn = a.g_ffn;
    bf16* const q_win = a.Win; bf16* const q_wrg = a.Wrg; unsigned char* const q_w13 = a.W13; unsigned char* const q_win8 = a.Win8;
#define P0_DECODE(it_, t_) do { int r = (it_); \
        if (r >= NITEMS - I_EX) { r -= NITEMS - I_EX;     \
            const int w = r >> 13, e = (r >> 8) & 31, kb = (r >> 4) & 15, nb = r & 15; const float* W = (w == 0 ? p_gate : p_up) + (size_t)e * DM * DE; \
            const int drow = e * 1024 + (nb >> 2) * 256 + (nb & 3) * 32 + (w == 1 ? 128 : 0); \
            t_.src = W + (size_t)(64 * kb) * DE + 32 * nb; t_.ld = DE; t_.dst = q_w13 + (size_t)drow * DM + 64 * kb; t_.ldd = DM; t_.ks = p_gffn + 64 * kb; t_.scale = pg8::W13_SCALE; t_.f8 = 1; } \
        else if (r < I_IN) { const int kb = r / 224, nb = r % 224, n0 = 32 * nb, sc_ = n0 < 5120 ? n0 : n0 + 8; \
            t_.src = p_win + (size_t)(64 * kb) * INW + sc_; t_.ld = INW; t_.ldd = DM; t_.ks = p_gmix + 64 * kb; \
            const int sg_ = n0 >> 10; int sr_ = 0; for (int t2 = 0; t2 < 7; ++t2) if (t2 < sg_ && (((SEG8_MASK >> t2) & 1u) == ((SEG8_MASK >> sg_) & 1u))) ++sr_;     \
            const int nr_ = sr_ * 1024 + (n0 & 1023); \
            if ((SEG8_MASK >> sg_) & 1u) { t_.dst = q_win8 + (size_t)nr_ * DM + 64 * kb; t_.scale = pg8::WIN_SCALE; t_.f8 = 1; }     \
            else { t_.dst = (unsigned char*)(q_win + (size_t)nr_ * DM + 64 * kb); t_.scale = 1.0f; t_.f8 = 0; } } \
        else if (r < I_IN + 3 * I_SQ) { r -= I_IN; const int w = r / I_SQ, q = r % I_SQ, kb = q / 32, nb = q % 32; const float* W = w == 0 ? p_wl : (w == 1 ? p_wa : p_wo); bf16* Wt = w == 0 ? q_wl : (w == 1 ? q_wa : q_wo); \
            t_.src = W + (size_t)(64 * kb) * DM + 32 * nb; t_.ld = DM; t_.dst = (unsigned char*)(Wt + (size_t)(32 * nb) * DM + 64 * kb); t_.ldd = DM; t_.ks = nullptr; t_.scale = 1.0f; t_.f8 = 0; } \
        else { r -= I_IN + 3 * I_SQ; const int gb = r / 32, q = r % 32, kb = q / 8, nb = q % 8; const float* W = (gb < 4 ? p_rga : p_rgx) + (size_t)(gb & 3) * 65536; \
            t_.src = W + (size_t)(64 * kb) * 256 + 32 * nb; t_.ld = 256; t_.dst = (unsigned char*)(q_wrg + (size_t)gb * 65536 + (size_t)(32 * nb) * 256 + 64 * kb); t_.ldd = 256; t_.ks = nullptr; t_.scale = -1.4426950408889634f; t_.f8 = 0; }     } while (0)
    {
        int it = first + offset; TItem cur; f32x4 va[8]; float sa[8];
        if (it < last) { P0_DECODE(it, cur); titem_load(cur, va, sa, F.lane); }
        while (it < last) {
            const int nx = it + stride; TItem nt = cur; f32x4 vb[8]; float sb[8];
            if (nx < last) { P0_DECODE(nx, nt); titem_load(nt, vb, sb, F.lane); }
            titem_finish(cur, va, sa, scr, F.lane);
            if (nx < last) { cur = nt;
#pragma unroll
                for (int i = 0; i < 8; ++i) { va[i] = vb[i]; sa[i] = sb[i]; } }
            it = nx;
        }
    }
#undef P0_DECODE
}
__device__ __forceinline__ void p0_prologue(const Frame& F, const P0Args& a, const int part  ) {
    const int gw = F.vcu * NWAVES + F.wave, NGW = F.G * NWAVES;
    if (part != 2) p0_items(F, a, 0, P0_NITEMS, NGW, gw);
    if (part == 1) return;
    for (int i = (F.vcu * NWAVES + F.wave) * 64 + F.lane; i < 64 * DM; i += NGW * 64) { const int n = i >> 10, k = i & 1023;
        float v = 0.f; if (n < 32) v = a.w_rexp[k * 32 + n]; else if (n < 36) v = a.w_rgrp[k * 4 + (n - 32)];
        a.WRT[i] = v * a.g_ffn[k]; }
    LAS float* wfl = (LAS float*)(F.lds + RING_OFF);
    __syncthreads();
    for (int k = F.tid; k < DM; k += NWAVES * 64) { const float g = a.g_mix[k];
        const f32x4 w0 = *(const f32x4*)(a.w_in + (size_t)k * INW + 5120), w1 = *(const f32x4*)(a.w_in + (size_t)k * INW + 5124);
        *(LAS f32x4*)(wfl + k * 8) = w0 * g; *(LAS f32x4*)(wfl + k * 8 + 4) = w1 * g; }
    __syncthreads();
    float wf[4][4][8];
#pragma unroll
    for (int j = 0; j < 4; ++j)
#pragma unroll
        for (int i = 0; i < 4; ++i) { const int k = 256 * j + 4 * F.lane + i; const f32x4 w0 = *(const LAS f32x4*)(wfl + k * 8), w1 = *(const LAS f32x4*)(wfl + k * 8 + 4);
#pragma unroll
            for (int h = 0; h < 4; ++h) { wf[j][i][h] = w0[h]; wf[j][i][4 + h] = w1[h]; } }
    const float bfg = a.b_forget[F.lane & 7];
    f32x4 vn[4];
    if (gw < T) { const GAS f32x4* xr0 = (const GAS f32x4*)(a.x + (size_t)gw * DM) + F.lane;
#pragma unroll
        for (int j = 0; j < 4; ++j) vn[j] = __builtin_nontemporal_load((const f32x4*)xr0 + 64 * j); }
    for (int m = gw; m < T; m += NGW) {
        f32x4 v[4]; float s = 0.f, d[8] = {0.f, 0.f, 0.f, 0.f, 0.f, 0.f, 0.f, 0.f};
#pragma unroll
        for (int j = 0; j < 4; ++j) v[j] = vn[j];
        if (m + NGW < T) { const GAS f32x4* xr1 = (const GAS f32x4*)(a.x + (size_t)(m + NGW) * DM) + F.lane;
#pragma unroll
            for (int j = 0; j < 4; ++j) vn[j] = __builtin_nontemporal_load((const f32x4*)xr1 + 64 * j); }
#pragma unroll
        for (int j = 0; j < 4; ++j) { s += (v[j].x * v[j].x + v[j].y * v[j].y) + (v[j].z * v[j].z + v[j].w * v[j].w);
#pragma unroll
            for (int i = 0; i < 4; ++i)
#pragma unroll
                for (int h = 0; h < 8; ++h) d[h] = fmaf(v[j][i], wf[j][i][h], d[h]); }
        s = wave_sum(s);
#pragma unroll
        for (int h = 0; h < 8; ++h) d[h] = wave_sum(d[h]);
        const float rs = 1.0f / sqrtf(s * (1.0f / DM) + EPS);
        GAS unsigned long long* o8 = (GAS unsigned long long*)(a.XB + (size_t)m * DM) + F.lane;
#pragma unroll
        for (int j = 0; j < 4; ++j) o8[64 * j] = (unsigned long long)pk2(v[j].x * rs, v[j].y * rs) | ((unsigned long long)pk2(v[j].z * rs, v[j].w * rs) << 32);
        { GAS unsigned* o4 = (GAS unsigned*)(a.X8P + (size_t)m * DM) + F.lane; const float r8 = rs * pg8::XS_SCALE;
#pragma unroll
          for (int j = 0; j < 4; ++j) o4[64 * j] = pg8::pack4_fp8(v[j].x * r8, v[j].y * r8, v[j].z * r8, v[j].w * r8); }
        if (F.lane < 8) { const int h = F.lane; float dh = d[0]; dh = h == 1 ? d[1] : dh; dh = h == 2 ? d[2] : dh; dh = h == 3 ? d[3] : dh; dh = h == 4 ? d[4] : dh; dh = h == 5 ? d[5] : dh; dh = h == 6 ? d[6] : dh; dh = h == 7 ? d[7] : dh;
            const float fl = dh * rs + bfg; a.LF[(size_t)m * 8 + h] = fminf(fl, 0.f) - log1pf(expf(-fabsf(fl))); }
    }
}
__device__ __forceinline__ void cumsum_bias(const Frame& F, const float* LF, float* CB) {
    LAS float* wt = (LAS float*)(F.lds + RING_OFF);
    for (int bh = blockIdx.x; bh < NB * NH; bh += F.G) {
        const int b = bh >> 3, h = bh & 7, s0 = F.tid * 8;
        float v[8], run = 0.f;
#pragma unroll
        for (int j = 0; j < 8; ++j) { run += LF[((size_t)(b * SEQ + s0 + j)) * 8 + h]; v[j] = run; }
        float inc = run;
#pragma unroll
        for (int o = 1; o < 64; o <<= 1) { const float t = __shfl_up(inc, o); if (F.lane >= o) inc += t; }
        if (F.lane == 63) wt[F.wave] = inc;
        __syncthreads();
        float pre = inc - run;
        for (int w = 0; w < F.wave; ++w) pre += wt[w];
#pragma unroll
        for (int j = 0; j < 8; ++j) CB[(size_t)bh * SEQ + s0 + j] = -(pre + v[j]) * 11.313708498984761f;
        __syncthreads();
    }
}
struct RgArgs { const bf16* XC; const bf16* GG; bf16* GO; const bf16* Wrg; const float *b_a, *b_x, *lam; };
__device__ __forceinline__ float bfx(const v4u& v, int i) { const unsigned w = i < 2 ? v.x : (i < 4 ? v.y : (i < 6 ? v.z : v.w)); return (i & 1) ? bf_hi(w) : bf_lo(w); }
__device__ __forceinline__ unsigned cvtpk_bf16(float lo, float hi) { unsigned r; asm volatile("v_cvt_pk_bf16_f32 %0, %1, %2" : "=v"(r) : "v"(lo), "v"(hi)); return r; }
__device__ __forceinline__ void conv_prepass(const Frame& F, const bf16* XR, bf16* XC, const float* conv_w, const float* conv_b) {
    const int gw = F.vcu * NWAVES + F.wave, NGW = F.G * NWAVES;
    for (int it = gw; it < (T / 16) * 2; it += NGW) {
        const int r0 = (it >> 1) * 16, c0 = (it & 1) * 512 + 8 * F.lane, tq = r0 & (SEQ - 1);
        float cw[4][8], cbv[8];
#pragma unroll
        for (int j = 0; j < 4; ++j) { const f32x4 w0 = *(const f32x4*)(conv_w + j * DM + c0), w1 = *(const f32x4*)(conv_w + j * DM + c0 + 4);
#pragma unroll
            for (int i = 0; i < 4; ++i) { cw[j][i] = w0[i]; cw[j][4 + i] = w1[i]; } }
        { const f32x4 w0 = *(const f32x4*)(conv_b + c0), w1 = *(const f32x4*)(conv_b + c0 + 4);
#pragma unroll
          for (int i = 0; i < 4; ++i) { cbv[i] = w0[i]; cbv[4 + i] = w1[i]; } }
        v4u raw[19];
#pragma unroll
        for (int i = 0; i < 19; ++i) { const int rr = (i < 3 && tq == 0) ? r0 : r0 - 3 + i; const v4u w = __builtin_nontemporal_load((const v4u*)(XR + ((unsigned)rr * DM + c0)));
            const bool z = i < 3 && tq == 0; raw[i].x = z ? 0u : w.x; raw[i].y = z ? 0u : w.y; raw[i].z = z ? 0u : w.z; raw[i].w = z ? 0u : w.w; }
#pragma unroll
        for (int r = 0; r < 16; ++r) { float y[8];
#pragma unroll
            for (int i = 0; i < 8; ++i) { float sacc = cbv[i];
#pragma unroll
                for (int j = 0; j < 4; ++j) sacc = fmaf(cw[j][i], bfx(raw[r + j], i), sacc);
                y[i] = sacc; }
            v4u o; o.x = cvtpk_bf16(y[0], y[1]); o.y = cvtpk_bf16(y[2], y[3]); o.z = cvtpk_bf16(y[4], y[5]); o.w = cvtpk_bf16(y[6], y[7]);
            *(GAS v4u*)(XC + ((unsigned)(r0 + r) * DM + c0)) = o; }
    }
}
__device__ __forceinline__ void rglru_unit(const Frame& F, const RgArgs& a, int unit) {
    const int tid = F.tid, lane = F.lane, wid = F.wave, fr = lane & 15, fq = lane >> 4, rq = wid >> 1, cp = wid & 1;
    const int b = unit >> 5, n = (unit >> 3) & 3, g = unit & 7, cbase = 256 * n, cown = cbase + 32 * g;
    LAS unsigned char* A_l = F.lds + RING_OFF;
    LAS float* tot = (LAS float*)(F.lds + RG_TOT);
    bf16x8 bfr[2][8];
#pragma unroll
    for (int gt = 0; gt < 2; ++gt)
#pragma unroll
        for (int ks = 0; ks < 8; ++ks) bfr[gt][ks] = *(const GAS bf16x8*)(a.Wrg + ((size_t)((gt * 4 + n) * 256 + 32 * g + 16 * cp + fr)) * 256 + 32 * ks + 8 * fq);
    const int cl = 16 * cp + fr, cch = cown + cl;
    const float ba = -1.4426950408889634f * a.b_a[cch], bx = -1.4426950408889634f * a.b_x[cch], sp8 = 8.0f * log1pf(expf(-a.lam[cch])) * 1.4426950408889634f;
    const unsigned goff = (unsigned)(b * SEQ + 32 * rq + 4 * fq) * DM + cch;
    const __amdgpu_buffer_rsrc_t GGr = __builtin_amdgcn_make_buffer_rsrc((void*)a.GG, 0, (int)((size_t)T * DM * 2), 0x00020000);
    const __amdgpu_buffer_rsrc_t GOr = __builtin_amdgcn_make_buffer_rsrc((void*)a.GO, 0, (int)((size_t)T * DM * 2), 0x00020000);
    const int gvo = (int)(goff * 2u);
    const unsigned dbase = ((unsigned)(b * SEQ + 16 * wid + (lane >> 5)) * DM + cbase) * 2u;
    const char* const XCb = (const char*)a.XC;
#define RG_DMA(ci_, buf_) do { _Pragma("unroll") for (int i_ = 0; i_ < 8; ++i_) { const unsigned so_ = dbase + (unsigned)(2 * i_) * (DM * 2u) + ((((unsigned)lane & 31u) ^ (unsigned)((2 * i_ + (lane >> 5)) & 15)) << 4); \
        __builtin_amdgcn_global_load_lds((const unsigned*)(XCb + so_ + (unsigned)(ci_) * (128u * DM * 2u)), (LAS unsigned*)(A_l + (buf_) * 65536 + (8 * wid + i_) * 1024), 16, 0, 0); } } while (0)
    float hc = 0.f;
    const int kx = 32 * g + cl;
#pragma unroll
    for (int gt = 0; gt < 2; ++gt)
#pragma unroll
        for (int ks = 0; ks < 8; ++ks) asm volatile("" : "+v"(bfr[gt][ks]));
    RG_DMA(0, 0); asm volatile("s_waitcnt vmcnt(0)" ::: "memory");
#define RG_CHUNK(BUF_, ci_) do { const int ci = (ci_); const int t0 = 128 * ci; LAS unsigned char* const Ab = A_l + (BUF_) * 65536; \
        __builtin_amdgcn_s_barrier(); asm volatile("" ::: "memory"); \
        unsigned short ggv[2][4]; \
        _Pragma("unroll") \
        for (int mt = 0; mt < 2; ++mt) \
        _Pragma("unroll") \
            for (int j = 0; j < 4; ++j) ggv[mt][j] = __builtin_amdgcn_raw_buffer_load_b16(GGr, gvo, (t0 + 16 * mt + j) * (DM * 2), 0); \
        if (ci + 1 < SEQ / 128) RG_DMA(ci + 1, BUF_ ^ 1); \
 \
        f32x4 acc[2][2]; \
        _Pragma("unroll") \
        for (int mt = 0; mt < 2; ++mt) { acc[mt][0] = (f32x4){ba, ba, ba, ba}; acc[mt][1] = (f32x4){bx, bx, bx, bx}; } \
        _Pragma("unroll") \
        for (int ks = 0; ks < 8; ++ks) { const int ch = 4 * ks + fq; \
        _Pragma("unroll") \
            for (int mt = 0; mt < 2; ++mt) { const int arow = 32 * rq + 16 * mt + fr; \
                const bf16x8 af = *(const LAS bf16x8*)(Ab + arow * 512 + ((ch ^ (arow & 15)) << 4)); \
                acc[mt][0] = __builtin_amdgcn_mfma_f32_16x16x32_bf16(af, bfr[0][ks], acc[mt][0], 0, 0, 0); \
                acc[mt][1] = __builtin_amdgcn_mfma_f32_16x16x32_bf16(af, bfr[1][ks], acc[mt][1], 0, 0, 0); } } \
 \
        float av[2][4], bv[2][4], sA[2], sB[2]; \
        _Pragma("unroll") \
        for (int mt = 0; mt < 2; ++mt) { float A = 1.f, Bv = 0.f; \
        _Pragma("unroll") \
            for (int j = 0; j < 4; ++j) { const int row = 32 * rq + 16 * mt + 4 * fq + j; \
                const unsigned short xb16 = *(const LAS unsigned short*)(Ab + row * 512 + ((((kx >> 3) ^ (row & 15))) << 4) + (kx & 7) * 2); \
                const float xc = __builtin_bit_cast(float, (unsigned)xb16 << 16); \
                const float r_ = __builtin_amdgcn_rcpf(1.0f + __builtin_amdgcn_exp2f(acc[mt][0][j])), i_ = __builtin_amdgcn_rcpf(1.0f + __builtin_amdgcn_exp2f(acc[mt][1][j])); \
                const float aa = __builtin_amdgcn_exp2f(-sp8 * r_); \
                const float mult = __builtin_amdgcn_sqrtf(fmaxf(fmaf(-aa, aa, 1.0f), 0.f)); \
                av[mt][j] = aa; bv[mt][j] = mult * i_ * xc; \
                Bv = fmaf(aa, Bv, bv[mt][j]); A *= aa; } \
            sA[mt] = A; sB[mt] = Bv; } \
 \
        float eA[2], eB[2], tA[2], tB[2]; \
        _Pragma("unroll") \
        for (int mt = 0; mt < 2; ++mt) { float A = sA[mt], Bv = sB[mt]; \
            { const float pA = __shfl_up(A, 16), pB = __shfl_up(Bv, 16); if (fq >= 1) { Bv = fmaf(A, pB, Bv); A *= pA; } } \
            { const float pA = __shfl_up(A, 32), pB = __shfl_up(Bv, 32); if (fq >= 2) { Bv = fmaf(A, pB, Bv); A *= pA; } } \
            const float xA = __shfl_up(A, 16), xB = __shfl_up(Bv, 16); eA[mt] = fq >= 1 ? xA : 1.f; eB[mt] = fq >= 1 ? xB : 0.f; \
            tA[mt] = __shfl(A, 48 + fr); tB[mt] = __shfl(Bv, 48 + fr); } \
        const float wA = tA[0] * tA[1], wB = fmaf(tA[1], tB[0], tB[1]); \
        if (fq == 0) { tot[(rq * 32 + cl) * 2] = wA; tot[(rq * 32 + cl) * 2 + 1] = wB; } \
        asm volatile("s_waitcnt lgkmcnt(0)" ::: "memory"); __builtin_amdgcn_s_barrier(); asm volatile("" ::: "memory"); \
        float hin = hc, hnew = hc; \
        _Pragma("unroll") \
        for (int q = 0; q < 4; ++q) { const float qA = tot[(q * 32 + cl) * 2], qB = tot[(q * 32 + cl) * 2 + 1]; hnew = fmaf(qA, hnew, qB); if (q < rq) hin = hnew; } \
        hc = hnew; \
        _Pragma("unroll") \
        for (int mt = 0; mt < 2; ++mt) { float h = mt == 0 ? hin : fmaf(tA[0], hin, tB[0]); \
            h = fmaf(eA[mt], h, eB[mt]); \
        _Pragma("unroll") \
            for (int j = 0; j < 4; ++j) { h = fmaf(av[mt][j], h, bv[mt][j]); \
                const float gv = __builtin_bit_cast(float, (unsigned)ggv[mt][j] << 16); \
                __builtin_amdgcn_raw_buffer_store_b16((unsigned short)cvtpk_bf16(h * gv, 0.f), GOr, gvo, (t0 + 16 * mt + j) * (DM * 2), 0); } } \
        asm volatile("s_waitcnt lgkmcnt(0)" ::: "memory"); \
        asm volatile("s_waitcnt vmcnt(8)" ::: "memory"); \
    } while (0)
    for (int cc = 0; cc < SEQ / 128; cc += 2) { RG_CHUNK(0, cc); RG_CHUNK(1, cc + 1); }
#undef RG_CHUNK
#undef RG_DMA
    asm volatile("s_waitcnt vmcnt(0) lgkmcnt(0)" ::: "memory"); __builtin_amdgcn_s_barrier(); asm volatile("" ::: "memory");
}
constexpr float SKIP_LOG2 = 40.0f;
__device__ __forceinline__ int attn_jlo(const Frame& F, const float* CB, const unsigned* NORM, int bh, int qb) {
    float qs = 0.f, ks = 0.f;
#pragma unroll
    for (int w = 0; w < 4; ++w) { qs += __uint_as_float(NORM[(bh) * 4 + w]); ks += __uint_as_float(NORM[(64 + bh) * 4 + w]); }
    constexpr float C2 = 1.4426950408889634f * 0.08838834764831845f;
    const float th = SKIP_LOG2 + 2.0f * 1.02f * sqrtf(qs * ks) * C2 + 4.0f;
    const float ref = CB[(size_t)bh * SEQ + qb * 256], v = CB[(size_t)bh * SEQ + 64 * F.lane + 63];
    const unsigned long long m = __ballot(F.lane < 4 * qb && (ref - v) * C2 > th);
    int j = __builtin_popcountll(m); if (m != ((j >= 64) ? ~0ull : ((1ull << j) - 1ull))) j = 0;
    return j & ~1;
}
__device__ __forceinline__ fattn::BlockRef attn_ref(int bh, int qb, int jlo) {
    const int b = bh >> 3, h = bh & 7;
    fattn::BlockRef r; r.qo = ((unsigned)bh * SEQ + (unsigned)qb * 256u) * HD; r.oo = ((unsigned)b * SEQ + (unsigned)qb * 256u) * DM + h * HD; r.kvo = (unsigned)bh * SEQ * HD; r.cbo = (unsigned)bh * SEQ; r.P0 = qb * 256; r.jlo = jlo; return r;
}
__device__ __forceinline__ void attn_phase(const Frame& F, char* lds, const bf16* Qb, bf16* Ob, const bf16* Kb, const bf16* Vb, const float* CB, const int* JLO, gu32* QCTR, const int probe = 0) {
#define ATT_JLO(bh_, qb_) (probe == 1 ? 4 * (qb_) : probe == 2 ? 0 : __builtin_amdgcn_readfirstlane(JLO[(bh_) * 16 + (qb_)]))
    constexpr int NBLK = 128;
    const int M = F.G >> 3; if ((F.G & 7) || M > 64 || M < 1) return;
    const int x = F.vcu / M, r = F.vcu % M;
    volatile LAS int* tk_l = (volatile LAS int*)(F.lds + MISC_OFF + 64);
    gu32* qc = QCTR + 64 * x;
    const fattn::Bases G{Qb, Ob, Kb, Vb, CB}; LAS unsigned char* const ldsa = F.lds + RING_OFF;
#define ATT_DEC(k_, bh_, qb_) do { const int i_ = (k_) & 7; bh_ = (i_ < 4 ? 4 * x + i_ : 32 + 4 * x + (i_ - 4)); qb_ = 15 - ((k_) >> 3); } while (0)
    int bh, qb; ATT_DEC(r, bh, qb);
    fattn::BlockRef cur = attn_ref(bh, qb, ATT_JLO(bh, qb));
    ATT_DEC(r + M, bh, qb);
    fattn::BlockRef nxt = attn_ref(bh, qb, ATT_JLO(bh, qb)); bool nxt_ok = (r + M) < NBLK;
    fattn::Seam S;
    fattn::prime(G, cur, lds, ldsa, S);
    bool more = true;
    for (;;) {
        unsigned tkt = 0u;
        if (more && F.tid == 0) tkt = __hip_atomic_fetch_add(qc, 1u, __ATOMIC_RELAXED, __HIP_MEMORY_SCOPE_AGENT);
        const bool last = !nxt_ok;
        fattn::block(G, cur, last ? cur : nxt, lds, ldsa, S);
        if (last) break;
        if (F.tid == 0) tk_l[0] = more ? (int)tkt + 2 * M : NBLK;
        __syncthreads();
        const int k2 = __builtin_amdgcn_readfirstlane(tk_l[0]);
        __syncthreads();
        cur = nxt;
        if (k2 < NBLK) { ATT_DEC(k2, bh, qb); nxt = attn_ref(bh, qb, ATT_JLO(bh, qb)); nxt_ok = true; } else { nxt_ok = false; more = false; }
    }
#undef ATT_DEC
#undef ATT_JLO
}
typedef float f32x16 __attribute__((ext_vector_type(16)));
struct P5Args { const float *X, *WRT, *b_rgrp, *b_rexp, *w_down; const bf16* DL; bf16* X1B; unsigned char *X8, *W2; float* RS2; int* LISTS; unsigned* TOK; gu32* CNT; };
__device__ __forceinline__ void p5_route(const Frame& F, const P5Args& a) {
    const int tid = F.tid, lane = F.lane, wid = F.wave, i16 = lane & 15, h4 = lane >> 4;
    constexpr int LDA = 132;
    LAS float* A_l = (LAS float*)(F.lds + RING_OFF) + wid * 16 * LDA;
    LAS float* B_l = (LAS float*)(F.lds + RING_OFF + 67584);
    LAS float* LG = (LAS float*)(F.lds + RING_OFF + 94208);
    LAS float* rs_l = (LAS float*)(F.lds + RING_OFF + 113664);
    LAS int* hist = (LAS int*)(F.lds + RING_OFF + 114176);
    LAS int* base_l = (LAS int*)(F.lds + RING_OFF + 114432);
    {
        LAS float* scr = (LAS float*)(F.lds + RING_OFF + wid * 8704);
        const int gw = F.vcu * NWAVES + wid, NGW = F.G * NWAVES;
        for (int it = gw; it < 8192; it += NGW) { const int e = it >> 8, kb = (it >> 5) & 7, nb = it & 31; const float* W = a.w_down + (size_t)e * DE * DM;
            transpose_tile8(W + (size_t)(64 * kb) * DM + 32 * nb, DM, a.W2 + (size_t)(e * 1024 + 32 * nb) * DE + 64 * kb, DE, nullptr, pg8::W2_SCALE, scr, lane); }
    }
    __syncthreads();
    for (int rb = blockIdx.x; rb < T / 128; rb += F.G) {
        const int R0 = rb * 128;
        if (tid < 32) hist[tid] = 0;
        const int ar = lane >> 5, ac = 4 * (lane & 31);
        const size_t xo = (size_t)(R0 + 16 * wid + ar) * DM + ac; const float* xsrc = a.X + xo; const bf16* dsrc = a.DL + xo; unsigned char* xdst = a.X8 + xo; bf16* bdst = a.X1B + xo;
        f32x4 areg[8], breg[3]; unsigned long long dreg[8];
#define P5_LOAD(kc_) do { _Pragma("unroll") for (int i_ = 0; i_ < 8; ++i_) { areg[i_] = __builtin_nontemporal_load((const f32x4*)(xsrc + (size_t)(2 * i_) * DM + (kc_) * 128)); dreg[i_] = __builtin_nontemporal_load((const unsigned long long*)(dsrc + (size_t)(2 * i_) * DM + (kc_) * 128)); } \
        _Pragma("unroll") for (int q_ = 0; q_ < 3; ++q_) { const int idx_ = tid + 512 * q_; breg[q_] = *(const f32x4*)(a.WRT + (size_t)(idx_ >> 5) * DM + (kc_) * 128 + 4 * (idx_ & 31)); } } while (0)
        P5_LOAD(0);
        f32x4 acc[3] = {{0.f, 0.f, 0.f, 0.f}, {0.f, 0.f, 0.f, 0.f}, {0.f, 0.f, 0.f, 0.f}}; float ss = 0.f;
        for (int kc = 0; kc < 8; ++kc) {
#pragma unroll
            for (int i = 0; i < 8; ++i) { const unsigned dl = (unsigned)dreg[i], dh = (unsigned)(dreg[i] >> 32);
                areg[i][0] += bf_lo(dl); areg[i][1] += bf_hi(dl); areg[i][2] += bf_lo(dh); areg[i][3] += bf_hi(dh);
                *(unsigned*)(xdst + (size_t)(2 * i) * DM + kc * 128) = pg8::pack4_fp8(areg[i][0], areg[i][1], areg[i][2], areg[i][3]);
                *(unsigned long long*)(bdst + (size_t)(2 * i) * DM + kc * 128) = (unsigned long long)pg8::cvt_pk_bf16(areg[i][0], areg[i][1]) | ((unsigned long long)pg8::cvt_pk_bf16(areg[i][2], areg[i][3]) << 32);
                *(LAS f32x4*)(A_l + (2 * i + ar) * LDA + ac) = areg[i]; }
#pragma unroll
            for (int q = 0; q < 3; ++q) { const int idx = tid + 512 * q; *(LAS f32x4*)(B_l + (idx >> 5) * LDA + 4 * (idx & 31)) = breg[q]; }
            __syncthreads();
            if (kc + 1 < 8) P5_LOAD(kc + 1);
#pragma unroll
            for (int jj = 0; jj < 8; ++jj) {
                const f32x4 af = *(const LAS f32x4*)(A_l + i16 * LDA + 16 * jj + 4 * h4);
                f32x4 bfv[3];
#pragma unroll
                for (int nt = 0; nt < 3; ++nt) bfv[nt] = *(const LAS f32x4*)(B_l + (16 * nt + i16) * LDA + 16 * jj + 4 * h4);
                ss += (af[0] * af[0] + af[1] * af[1]) + (af[2] * af[2] + af[3] * af[3]);
#pragma unroll
                for (int s = 0; s < 4; ++s)
#pragma unroll
                    for (int nt = 0; nt < 3; ++nt) acc[nt] = __builtin_amdgcn_mfma_f32_16x16x4f32(af[s], bfv[nt][s], acc[nt], 0, 0, 0);
            }
            __syncthreads();
        }
#undef P5_LOAD
        ss += __shfl_xor(ss, 16); ss += __shfl_xor(ss, 32);
        const float rs = 1.0f / sqrtf(ss * (1.0f / DM) + EPS);
        if (h4 == 0) { a.RS2[R0 + 16 * wid + i16] = rs; rs_l[16 * wid + i16] = rs; }
#pragma unroll
        for (int r = 0; r < 4; ++r) { const int rl = 16 * wid + 4 * h4 + r; LG[rl * 37 + i16] = acc[0][r]; LG[rl * 37 + 16 + i16] = acc[1][r]; if (i16 < 4) LG[rl * 37 + 32 + i16] = acc[2][r]; }
        __syncthreads();
        int e0 = 0, e1 = 0, k0 = 0, k1 = 0; float w0 = 0.f, w1 = 0.f;
        if (tid < 128) {
            const float rsv = rs_l[tid]; const LAS float* lg = LG + tid * 37;
            float gl[4];
#pragma unroll
            for (int q = 0; q < 4; ++q) gl[q] = lg[32 + q] * rsv + a.b_rgrp[q];
            int gs = 0; float gm = gl[0];
#pragma unroll
            for (int q = 1; q < 4; ++q) if (gl[q] > gm) { gm = gl[q]; gs = q; }
            float den = 0.f;
#pragma unroll
            for (int q = 0; q < 4; ++q) den += expf(gl[q] - gm);
            const float pg = 1.0f / den;
            float el[8];
#pragma unroll
            for (int q = 0; q < 8; ++q) el[q] = lg[8 * gs + q] * rsv + a.b_rexp[8 * gs + q];
            int i0 = 0; float v0 = el[0];
#pragma unroll
            for (int q = 1; q < 8; ++q) if (el[q] > v0) { v0 = el[q]; i0 = q; }
            int i1 = -1; float v1 = -INFINITY;
#pragma unroll
            for (int q = 0; q < 8; ++q) if (q != i0 && el[q] > v1) { v1 = el[q]; i1 = q; }
            const float ex = expf(v1 - v0);
            w0 = pg / (1.0f + ex); w1 = pg * ex / (1.0f + ex);
            e0 = 8 * gs + i0; e1 = 8 * gs + i1;
            k0 = atomicAdd((int*)(hist + e0), 1); k1 = atomicAdd((int*)(hist + e1), 1);
        }
        __syncthreads();
        if (tid < 32) base_l[tid] = (int)__hip_atomic_fetch_add(a.CNT + tid, (unsigned)hist[tid], __ATOMIC_RELAXED, __HIP_MEMORY_SCOPE_AGENT);
        __syncthreads();
        if (tid < 128) { const int tok = R0 + tid, s0 = base_l[e0] + k0, s1 = base_l[e1] + k1;
            a.LISTS[(size_t)e0 * T + s0] = tok; a.LISTS[(size_t)e1 * T + s1] = tok;
            v4u i0v = {(unsigned)e0, (unsigned)s0, (unsigned)e1, (unsigned)s1}, i1v = {__float_as_uint(w0), __float_as_uint(w1), 0u, 0u};
            *(GAS v4u*)(a.TOK + (size_t)tok * 8) = i0v; *(GAS v4u*)(a.TOK + (size_t)tok * 8 + 4) = i1v; }
        __syncthreads();
    }
}
__device__ __forceinline__ void build_tables(const Frame& F, const gu32* CNT) {
    LAS int* ps = (LAS int*)(F.lds + TBL_PS); LAS int* cn = (LAS int*)(F.lds + TBL_CN); LAS int* te = (LAS int*)(F.lds + TBL_TE);
    __syncthreads();
    if (F.tid < 32) { int c = (int)__hip_atomic_load(CNT + F.tid, __ATOMIC_RELAXED, __HIP_MEMORY_SCOPE_AGENT); c = c < 0 ? 0 : (c > T ? T : c); cn[F.tid] = c; }
    __syncthreads();
    if (F.tid == 0) { int run = 0; for (int e = 0; e < 32; ++e) { ps[e] = run; run += (cn[e] + 255) & ~255; } if (run > PMAX) run = PMAX; ps[32] = run; }
    __syncthreads();
    if (F.tid < 288) { const int p = F.tid * 256; int e = 0; for (int q = 1; q < 32; ++q) if (p >= ps[q]) e = q; te[F.tid] = e; }
    __syncthreads();
}
template <class Ord> __device__ __forceinline__ void build_rowtab(const Frame& F, const Ord& S, const int* LISTS, const float* RS2, LAS int* rowtab) {
    const LAS int* ps = (const LAS int*)(F.lds + TBL_PS); const LAS int* cn = (const LAS int*)(F.lds + TBL_CN); const LAS int* te = (const LAS int*)(F.lds + TBL_TE);
    pg8::Unit u;
    for (int ui = 0; ui < 6 && S.next(ui, u); ++ui)
        if (F.tid < 256) { const int p = u.pm * 256 + F.tid, e = te[u.pm], local = p - ps[e]; const int tok = local < cn[e] ? LISTS[(size_t)e * T + local] : 0; rowtab[ui * 256 + F.tid] = tok; ((LAS float*)rowtab)[(6 + ui) * 256 + F.tid] = RS2[tok]; }
    __syncthreads();
}
__device__ __forceinline__ float fp8_f32(unsigned w, int i) { return i == 0 ? __builtin_amdgcn_cvt_f32_fp8(w, 0) : (i == 1 ? __builtin_amdgcn_cvt_f32_fp8(w, 1) : (i == 2 ? __builtin_amdgcn_cvt_f32_fp8(w, 2) : __builtin_amdgcn_cvt_f32_fp8(w, 3))); }
__device__ __forceinline__ void p9_final(const Frame& F, const bf16* X1B, float* OUT, const unsigned char* Y, const unsigned* TOK, const float* g_final) {
    const LAS int* ps = (const LAS int*)(F.lds + TBL_PS);
    const int gw = F.vcu * NWAVES + F.wave, NGW = F.G * NWAVES;
    f32x4 gf[4];
#pragma unroll
    for (int j = 0; j < 4; ++j) gf[j] = *((const f32x4*)g_final + F.lane + 64 * j);
    constexpr float YS = 1.0f / (pg8::HB_SCALE * pg8::W2_SCALE * pg8::Y_SCALE);
    v4u ia_n = {0u, 0u, 0u, 0u}, ib_n = {0u, 0u, 0u, 0u}, ia_c = ia_n, ib_c = ib_n; unsigned long long xw_n[4]; unsigned ya_n[4], yb_n[4];
#define P9_TOK(m_, ia_, ib_) do { ia_ = *(const GAS v4u*)(TOK + (size_t)(m_) * 8); ib_ = *(const GAS v4u*)(TOK + (size_t)(m_) * 8 + 4); } while (0)
#define P9_ROW(m_, ia_) do { const size_t p0_ = (size_t)(ps[(int)(ia_.x & 31u)] + (int)ia_.y), p1_ = (size_t)(ps[(int)(ia_.z & 31u)] + (int)ia_.w); \
        const GAS unsigned long long* xr_ = (const GAS unsigned long long*)(X1B + (size_t)(m_) * DM) + F.lane; \
        const GAS unsigned* y0_ = (const GAS unsigned*)(Y + p0_ * DM) + F.lane; const GAS unsigned* y1_ = (const GAS unsigned*)(Y + p1_ * DM) + F.lane; \
        _Pragma("unroll") for (int j = 0; j < 4; ++j) { xw_n[j] = __builtin_nontemporal_load((const unsigned long long*)xr_ + 64 * j); ya_n[j] = __builtin_nontemporal_load((const unsigned*)y0_ + 64 * j); yb_n[j] = __builtin_nontemporal_load((const unsigned*)y1_ + 64 * j); } } while (0)
    if (gw < T) { P9_TOK(gw, ia_c, ib_c); P9_ROW(gw, ia_c); if (gw + NGW < T) P9_TOK(gw + NGW, ia_n, ib_n); }
    for (int m = gw; m < T; m += NGW) {
        const float w0 = __uint_as_float(ib_c.x) * YS, w1 = __uint_as_float(ib_c.y) * YS;
        unsigned long long xw[4]; unsigned ya[4], yb[4];
#pragma unroll
        for (int j = 0; j < 4; ++j) { xw[j] = xw_n[j]; ya[j] = ya_n[j]; yb[j] = yb_n[j]; }
        if (m + NGW < T) { ia_c = ia_n; ib_c = ib_n; P9_ROW(m + NGW, ia_c); if (m + 2 * NGW < T) P9_TOK(m + 2 * NGW, ia_n, ib_n); }
        GAS f32x4* orow = (GAS f32x4*)(OUT + (size_t)m * DM) + F.lane;
        f32x4 v[4]; float s = 0.f;
#pragma unroll
        for (int j = 0; j < 4; ++j) { v[j] = (f32x4){bf_lo((unsigned)xw[j]), bf_hi((unsigned)xw[j]), bf_lo((unsigned)(xw[j] >> 32)), bf_hi((unsigned)(xw[j] >> 32))}; const unsigned a = ya[j], b = yb[j];
            v[j].x += w0 * fp8_f32(a, 0) + w1 * fp8_f32(b, 0); v[j].y += w0 * fp8_f32(a, 1) + w1 * fp8_f32(b, 1);
            v[j].z += w0 * fp8_f32(a, 2) + w1 * fp8_f32(b, 2); v[j].w += w0 * fp8_f32(a, 3) + w1 * fp8_f32(b, 3);
            s += (v[j].x * v[j].x + v[j].y * v[j].y) + (v[j].z * v[j].z + v[j].w * v[j].w); }
        s = wave_sum(s);
        const float rs = 1.0f / sqrtf(s * (1.0f / DM) + EPS);
#pragma unroll
        for (int j = 0; j < 4; ++j) orow[64 * j] = v[j] * rs * gf[j];
    }
#undef P9_TOK
#undef P9_ROW
}

constexpr int N_PHASES = 10;
#ifndef DUP_TRIVIAL
#define DUP_TRIVIAL 0
#endif
#ifndef P8_HOOK
#define P8_HOOK 2
#endif
#ifndef DUP_PHASE
#define DUP_PHASE -1
#endif
typedef __attribute__((address_space(4))) const unsigned char* karg_ptr;
__device__ __forceinline__ const float* arg_in(int k) { karg_ptr base = (karg_ptr)__builtin_amdgcn_kernarg_segment_ptr(); const unsigned long long v = *(const unsigned long long volatile __attribute__((address_space(4)))*)(base + 8 * k); return (const float*)(const GAS float*)v; }
struct Args { const float* in[23]; float* out; unsigned char* ws; int ph_lo, ph_hi, mode, pad; };
__global__ void __launch_bounds__(NWAVES * 64, 2) fwd_kernel(Args args) {
    extern __shared__ __attribute__((aligned(16))) unsigned char lds[];
    Frame F;
    F.lds = (LAS unsigned char*)lds;
    F.wave = __builtin_amdgcn_readfirstlane((int)threadIdx.x >> 6); F.lane = pg8::lane_now(); F.tid = F.wave * 64 + F.lane;
    F.G = gridDim.x; { const int bx = blockIdx.x; F.vcu = (F.G % 8 == 0) ? (bx % 8) * (F.G / 8) + bx / 8 : bx; }
    unsigned char* ws = args.ws;
    gu32* ctl = (gu32*)(ws + WS_CTL);
    volatile LAS unsigned* MISC = (volatile LAS unsigned*)(F.lds + MISC_OFF);
    for (int u = F.tid; u < (LDS_BYTES - LDSCTL_OFF) / 4; u += NWAVES * 64) ((LAS unsigned*)(F.lds + LDSCTL_OFF))[u] = 0u;
    __syncthreads();
#if MK_ONE_LAUNCH
    XcdBarrier bar = xcd_barrier_post((unsigned*)(ctl + CW_BAR), MISC + 8);
#define GRID_BAR() xcd_barrier(bar)
#else
#define GRID_BAR() do { } while (0)
#endif
    const int lo = args.ph_lo, hi = args.ph_hi;
#ifndef PH_MASK
#define PH_MASK 0x3ff
#endif
#define IN(k) (((PH_MASK >> (k)) & 1) && lo <= (k) && (k) < hi)
#define BOTH(k) (IN(k) && IN((k) + 1))
    float* out = args.out;
    bf16* Win = (bf16*)(ws + WS_WIN); bf16* Wl = (bf16*)(ws + WS_WL); bf16* Wa = (bf16*)(ws + WS_WA); bf16* Wo = (bf16*)(ws + WS_WO); bf16* Wrg = (bf16*)(ws + WS_WRG);
    bf16* XB = (bf16*)(ws + WS_XB); bf16* XR = (bf16*)(ws + WS_XR); bf16* GG = (bf16*)(ws + WS_GG); bf16* Qb = (bf16*)(ws + WS_Q); bf16* Kb = (bf16*)(ws + WS_K); bf16* Vb = (bf16*)(ws + WS_V);
    bf16* SL = (bf16*)out; bf16* SA = (bf16*)out + pg8::SEGE;
    float* RS1 = (float*)(ws + WS_RS1); float* RS2 = (float*)(ws + WS_RS2); float* LF = (float*)(ws + WS_LF); float* CB = (float*)(ws + WS_CB);
    unsigned* TOK = (unsigned*)(ws + WS_TOK); int* LISTS = (int*)(ws + WS_LISTS); float* WRT = (float*)(ws + WS_WRT); int* JLO = (int*)(ws + WS_SRS);
    unsigned char* W13 = ws + WS_W13; unsigned char* W2 = ws + WS_W2; bf16* XG = (bf16*)(ws + WS_XG); unsigned char* HB = ws + WS_HB; unsigned char* X8 = ws + WS_XB;
    gu32* CNT = ctl + CW_CNT;

    if (IN(0)) { F.lane = pg8::lane_now(); F.tid = F.wave * 64 + F.lane;
        P0Args a{arg_in(0), arg_in(1), arg_in(2), arg_in(5), arg_in(7), arg_in(10), arg_in(11), arg_in(12), arg_in(13), arg_in(14), arg_in(15), arg_in(17), arg_in(19), arg_in(20), Win, Wl, Wa, Wo, Wrg, XB, W13, RS1, LF, WRT, ws + WS_WIN8, ws + WS_X8P};
        p0_prologue(F, a, DUP_PHASE == 0 ? args.mode : 0);
        if (BOTH(0)) GRID_BAR();
    }
    if (IN(1)) { F.lane = pg8::lane_now(); F.tid = F.wave * 64 + F.lane;
        cumsum_bias(F, LF, CB);
        { constexpr int NB16 = seg_cnt(false) * 1024;
          pg8::Gemm g{XB, Win, T, NB16, DM}; pg8::StaticOrder S; S.init(T, NB16, F.G, (int)blockIdx.x);
          pg8::EpiZ E{XR, SL, RS1, (unsigned*)(ctl + CW_NORM), args.mode, seg_map(false), 1.0f};
          pg8::gemm_phase<pg8::EpiZ, pg8::StaticOrder, true, true>(F.lds + RING_OFF, g, S, E, F.wave); }
        __syncthreads();
        { constexpr int NF8 = seg_cnt(true) * 1024;
          pg8::Gemm g{(const bf16*)(ws + WS_X8P), (const bf16*)(ws + WS_WIN8), T, NF8, DM / 2}; pg8::StaticOrder S; S.init(T, NF8, F.G, (int)blockIdx.x);
          pg8::EpiZ E{XR, SL, RS1, (unsigned*)(ctl + CW_NORM), args.mode, seg_map(true), 1.0f / (pg8::XS_SCALE * pg8::WIN_SCALE)};
          pg8::gemm_phase<pg8::EpiZ, pg8::StaticOrder, true, true, true>(F.lds + RING_OFF, g, S, E, F.wave); }
        if (BOTH(1)) GRID_BAR();
    }
    if (IN(2)) { F.lane = pg8::lane_now(); F.tid = F.wave * 64 + F.lane;
        { const int gw = F.vcu * NWAVES + F.wave; if (gw < NB * NH * 16) { const int j = attn_jlo(F, CB, (const unsigned*)(ctl + CW_NORM), gw >> 4, gw & 15); if (F.lane == 0) JLO[gw] = j; } }
        conv_prepass(F, XR, XB, arg_in(3), arg_in(4));
        if (BOTH(2)) GRID_BAR();
    }
    if (IN(3)) { F.lane = pg8::lane_now(); F.tid = F.wave * 64 + F.lane;
        RgArgs ra{XB, GG, GG, Wrg, arg_in(6), arg_in(8), arg_in(9)};
#if DUP_PHASE >= 20
        const int mode = args.mode;
#else
        constexpr int mode = 0;
#endif
        if (mode < 2) { ra.GO = mode == 1 ? XR : GG; for (int u = F.vcu; u < 256; u += F.G) rglru_unit(F, ra, u); }
        if (mode != 1) attn_phase(F, (char*)lds + RING_OFF, Qb, XR, Kb, Vb, CB, JLO, ctl + CW_QCTR + (mode >= 2 ? 1024 : 0), mode >= 3 ? mode - 2 : 0);
        if (BOTH(3)) GRID_BAR();
    }
    if (IN(4)) { { F.lane = pg8::lane_now(); F.tid = F.wave * 64 + F.lane;
        static_assert(WS_GG - WS_XR == (size_t)128 * 256 * DM * 2 && WS_WL - WS_WA == (size_t)4 * 256 * DM * 2, "TwoGemmOrder: hg follows o by 128 row tiles, Wl follows Wa by 4 column tiles");
        pg8::Gemm g{XR, Wa, T, DM, DM}; pg8::TwoGemmOrder S; S.init(T, DM, F.G, (int)blockIdx.x);
        pg8::EpiGate2 E{SA, SL, XB};
        pg8::gemm_phase<pg8::EpiGate2, pg8::TwoGemmOrder, true, true>(F.lds + RING_OFF, g, S, E, F.wave); }
        if (BOTH(4)) GRID_BAR();
    }
    if (IN(5)) { F.lane = pg8::lane_now(); F.tid = F.wave * 64 + F.lane;
        pg8::Gemm g{XB, Wo, T, DM, DM}; pg8::StaticOrder S; S.init(T, DM, F.G, (int)blockIdx.x);
        pg8::EpiDelta E{(bf16*)out};
        pg8::gemm_phase<pg8::EpiDelta, pg8::StaticOrder, true, true>(F.lds + RING_OFF, g, S, E, F.wave);
        if (BOTH(5)) GRID_BAR();
    }
    if (IN(6)) { F.lane = pg8::lane_now(); F.tid = F.wave * 64 + F.lane;
        P5Args a{arg_in(0), WRT, arg_in(16), arg_in(18), arg_in(21), (const bf16*)out, XR, X8, W2, RS2, LISTS, TOK, args.mode ? CNT + 64 : CNT};
        p5_route(F, a);
        if (BOTH(6)) GRID_BAR();
    }
    if (IN(7)) { F.lane = pg8::lane_now(); F.tid = F.wave * 64 + F.lane;
        build_tables(F, CNT);
        const int ntiles = ((const LAS int*)(F.lds + TBL_PS))[32] >> 8;
        pg8::Gemm g{(const bf16*)X8, (const bf16*)W13, ntiles * 256, 32 * 1024, DM / 2}; pg8::GroupedOrderT<1> S{(const LAS int*)(F.lds + TBL_TE), ntiles * 4, F.G, F.vcu, (unsigned*)(ctl + CW_RDY), F.wave, (unsigned*)(ctl + CW_TMO)};
        LAS int* rowtab = (LAS int*)(F.lds + RG_TOT);
        build_rowtab(F, S, LISTS, RS2, rowtab);
        pg8::EpiSwiGLU E{HB};
        pg8::gemm_phase_gather<pg8::EpiSwiGLU, pg8::GroupedOrderT<1>, true>(F.lds + RING_OFF, g, S, E, rowtab, F.wave);
    }
    if (IN(8)) { F.lane = pg8::lane_now(); F.tid = F.wave * 64 + F.lane;
        build_tables(F, CNT);
        const int ntiles = ((const LAS int*)(F.lds + TBL_PS))[32] >> 8;
        const int c8 = (F.vcu + F.G - (ntiles * 4) % F.G) % F.G;
        pg8::Gemm g{(const bf16*)HB, (const bf16*)W2, ntiles * 256, 32 * 1024, DE / 2}; pg8::GroupedOrderT<P8_HOOK> S{(const LAS int*)(F.lds + TBL_TE), ntiles * 4, F.G, c8, (unsigned*)(ctl + CW_RDY), F.wave, (unsigned*)(ctl + CW_TMO)};
        pg8::EpiY E{(unsigned char*)XG, args.mode};
        pg8::gemm_phase<pg8::EpiY, pg8::GroupedOrderT<P8_HOOK>, true, true, true>(F.lds + RING_OFF, g, S, E, F.wave);
        if (BOTH(8)) GRID_BAR();
    }
    if (IN(9)) { F.lane = pg8::lane_now(); F.tid = F.wave * 64 + F.lane;
        build_tables(F, CNT);
        p9_final(F, XR, out, (const unsigned char*)XG, TOK, arg_in(22));
    }
#undef IN
#undef BOTH
}

extern "C" void kernel_launch(void* const* d_in, const int* in_sizes, int n_in, void* d_out, int out_size, void* d_ws, size_t ws_size, hipStream_t stream) {
    static int grid = 0;
    if (grid == 0) {
        if (n_in != 23 || in_sizes[0] != T * DM || out_size != T * DM || ws_size < WS_END) { fprintf(stderr, "kernel_launch: unexpected shapes (n_in %d, in0 %d, out %d, ws %zu); nothing launched\n", n_in, n_in > 0 ? in_sizes[0] : -1, out_size, ws_size); grid = -1; return; }
        int dev = 0, cus = 0;
        if (hipGetDevice(&dev) != hipSuccess || hipDeviceGetAttribute(&cus, hipDeviceAttributeMultiprocessorCount, dev) != hipSuccess) { grid = -1; return; }
        if (hipFuncSetAttribute((const void*)fwd_kernel, hipFuncAttributeMaxDynamicSharedMemorySize, LDS_BYTES) != hipSuccess) { fprintf(stderr, "kernel_launch: hipFuncSetAttribute failed\n"); grid = -1; return; }
        int per_cu = 0;
        if (hipOccupancyMaxActiveBlocksPerMultiprocessor(&per_cu, (const void*)fwd_kernel, NWAVES * 64, LDS_BYTES) != hipSuccess || per_cu < 1) { fprintf(stderr, "kernel_launch: occupancy query reports %d\n", per_cu); }
        (void)hipGetLastError();
        grid = cus;
    }
    if (grid < 0) return;
    if (hipMemsetAsync((char*)d_ws + WS_CTL, 0, CTL_ZERO_BYTES, stream) != hipSuccess) return;
    Args a{};
    for (int i = 0; i < 23; ++i) a.in[i] = (const float*)d_in[i];
    a.out = (float*)d_out; a.ws = (unsigned char*)d_ws;
#if MK_ONE_LAUNCH
    a.ph_lo = 0; a.ph_hi = N_PHASES;
    hipLaunchKernelGGL(fwd_kernel, dim3(grid), dim3(NWAVES * 64), LDS_BYTES, stream, a);
#else
    for (int ph = 0; ph < N_PHASES; ++ph) { a.ph_lo = ph; a.ph_hi = ph + 1;
        if (DUP_PHASE == ph || (ph == 3 && DUP_PHASE >= 20)) { a.mode = DUP_PHASE >= 20 ? DUP_PHASE - 19 : (ph == 8 ? DUP_TRIVIAL : (ph == 6 || (ph == 1 && DUP_TRIVIAL)) ? 1 : (ph == 0 ? DUP_TRIVIAL : 0)); hipLaunchKernelGGL(fwd_kernel, dim3(grid), dim3(NWAVES * 64), LDS_BYTES, stream, a); a.mode = 0; }
        hipLaunchKernelGGL(fwd_kernel, dim3(grid), dim3(NWAVES * 64), LDS_BYTES, stream, a); }
#endif
}
```

```cpp
#include <hip/hip_runtime.h>
#include <cstdio>
#include <cstdint>

#ifndef MK_ONE_LAUNCH
#define MK_ONE_LAUNCH 1
#endif
namespace pg8 {
#define PG8_LAS __attribute__((address_space(3)))
typedef unsigned short bf16_t;
typedef short bf16x8 __attribute__((ext_vector_type(8)));
typedef float f32x4 __attribute__((ext_vector_type(4)));
typedef unsigned u32x4 __attribute__((ext_vector_type(4)));
constexpr int BM = 256, BK = 64, HALF = 128, HTB = HALF * BK * 2  , STAGE_BYTES = 8 * HTB, NXCD = 8, WGM = 8;

__host__ __device__ __forceinline__ int lds_byte(int r, int c) { const int st = (r >> 4) * 2 + (c >> 5), rr = r & 15, cc = c & 31, ob = rr * 64 + cc * 2; return st * 1024 + (ob ^ (((ob >> 9) & 1) << 5)); }
__host__ __device__ __forceinline__ void stage_rc(int b, int& R, int& C) { const int st = b / 1024, sb = b % 1024, swz = sb ^ (((sb >> 9) & 1) << 5); R = (st >> 1) * 16 + swz / 64; C = (st & 1) * 32 + (swz % 64) / 2; }
__host__ __device__ __forceinline__ int perm32(int rho) { const int n = rho >> 4, i = rho & 15; return 8 * (i >> 2) + 4 * n + (i & 3); }

struct Unit { int pm, pn; };
struct Gemm { const bf16_t* A; const bf16_t* Bt; int M, N, K; };

struct StaticOrder {
    int nM, nN, nwg, G, c;
    __host__ __device__ void init(int M, int N, int G_, int c_) { nM = M / BM; nN = N / BM; nwg = nM * nN; G = G_; c = c_; }
    __host__ __device__ bool next(int i, Unit& u) const {
        const long L = (long)i * G + c; if (L >= nwg) return false;
        int wgid = (int)L; { const int q = nwg / NXCD, r = nwg % NXCD, xcd = wgid % NXCD, off = wgid / NXCD; wgid = (xcd < r ? xcd * (q + 1) : r * (q + 1) + (xcd - r) * q) + off; }
        const int nig = WGM * nN, gid = wgid / nig, fm = gid * WGM, gsz = (nM - fm) < WGM ? (nM - fm) : WGM;
        u.pm = fm + ((wgid % nig) % gsz); u.pn = (wgid % nig) / gsz; return true;
    }
    __device__ __forceinline__ void a_ready(const Unit&) const {}
    __device__ __forceinline__ void done(const Unit&) const {}
};

__device__ __forceinline__ unsigned cvt_pk_bf16(float lo, float hi) { unsigned r; asm volatile("v_cvt_pk_bf16_f32 %0, %1, %2" : "=v"(r) : "v"(lo), "v"(hi)); return r; }
typedef float f32x2 __attribute__((ext_vector_type(2)));
__device__ __forceinline__ int lane_now() { int l; asm volatile("v_mbcnt_lo_u32_b32 %0, -1, 0\n\tv_mbcnt_hi_u32_b32 %0, -1, %0" : "=v"(l)); return l; }
typedef int v4i_t __attribute__((ext_vector_type(4)));
typedef int v8i_t __attribute__((ext_vector_type(8)));
__device__ __forceinline__ v8i_t cat8(bf16x8 a, bf16x8 b) { const v4i_t x = __builtin_bit_cast(v4i_t, a), y = __builtin_bit_cast(v4i_t, b); return __builtin_shufflevector(x, y, 0, 1, 2, 3, 4, 5, 6, 7); }
__device__ __forceinline__ void glds_sv(const char* base, unsigned voff, unsigned lds_dst) { unsigned keep;
    asm volatile("s_mov_b32 %0, m0\n\ts_mov_b32 m0, %3\n\ts_nop 0\n\tglobal_load_lds_dwordx4 %1, %2\n\ts_mov_b32 m0, %0" : "=&s"(keep) : "v"(voff), "s"(base), "s"(lds_dst) : "memory"); }
__device__ __forceinline__ float sat8(float x) { return __builtin_amdgcn_fmed3f(x, -448.0f, 448.0f); }
__device__ __forceinline__ unsigned pack4_fp8(float a, float b, float c, float d) { unsigned w = 0u; w = __builtin_amdgcn_cvt_pk_fp8_f32(sat8(a), sat8(b), w, false); w = __builtin_amdgcn_cvt_pk_fp8_f32(sat8(c), sat8(d), w, true); return w; }
constexpr float W13_SCALE = 64.0f, HB_SCALE = 8.0f, W2_SCALE = 32.0f, XS_SCALE = 16.0f, WIN_SCALE = 64.0f;
__device__ __forceinline__ float sigmoid_f(float x) { return __builtin_amdgcn_rcpf(1.0f + __builtin_amdgcn_exp2f(-1.4426950408889634f * x)); }
__device__ __forceinline__ float gelu_tanh_f(float x) { const float u = x * (1.0f + 0.044715f * x * x); return x * __builtin_amdgcn_rcpf(1.0f + __builtin_amdgcn_exp2f(-2.3022081981f * u)); }
__device__ __forceinline__ float bf_lo(unsigned w) { return __builtin_bit_cast(float, w << 16); }
__device__ __forceinline__ float bf_hi(unsigned w) { return __builtin_bit_cast(float, w & 0xffff0000u); }
constexpr size_t SEGE = (size_t)32768 * 1024;

struct EpiZ {
    static constexpr bool PERM = true, AFTER_DRAIN = false; static constexpr int NSTORES = 16;
    bf16_t* ws5; bf16_t* out2; const float* rs; unsigned* norm; int probe; unsigned smap; float sc;
    __device__ __forceinline__ void operator()(const f32x4 (&acc)[2][2][4][2], const Unit& u, int wr, int wc, int fr, int fq) const {
        const int sgo = (int)((smap >> (4 * (u.pn >> 2))) & 15u); const int seg = probe ? 0 : sgo; float nm[2] = {0.f, 0.f}; bf16_t* O = sgo < 5 ? ws5 + (size_t)sgo * SEGE : out2 + (size_t)(sgo - 5) * SEGE;
        const int row0 = u.pm * BM + wr * 64 + fr, col0 = (u.pn & 3) * BM + wc * 32 + 8 * fq;
#pragma unroll
        for (int ai = 0; ai < 2; ++ai)
#pragma unroll
            for (int m = 0; m < 4; ++m) { const int row = row0 + ai * HALF + m * 16; bf16_t* rowp = O + (size_t)row * 1024 + col0;
                const bool hm = (sgo >= 2 && sgo <= 4); bf16_t* rowh = O + ((size_t)((row >> 12) * 8 + 2 * (u.pn & 3)) * 4096 + (row & 4095)) * 128 + wc * 32 + 8 * fq;
#pragma unroll
                for (int bj = 0; bj < 2; ++bj) { f32x4 v0 = acc[ai][bj][m][0] * sc, v1 = acc[ai][bj][m][1] * sc;
                    if (seg == 1) {
#pragma unroll
                        for (int i = 0; i < 4; ++i) { v0[i] = gelu_tanh_f(v0[i]); v1[i] = gelu_tanh_f(v1[i]); } }
                    else if (seg >= 5) {
#pragma unroll
                        for (int i = 0; i < 4; ++i) { v0[i] = sigmoid_f(v0[i]); v1[i] = sigmoid_f(v1[i]); } }
                    if (seg == 2 || seg == 3) { float q = (v0[0] * v0[0] + v0[1] * v0[1]) + (v0[2] * v0[2] + v0[3] * v0[3]) + (v1[0] * v1[0] + v1[1] * v1[1]) + (v1[2] * v1[2] + v1[3] * v1[3]);
                        q += __shfl_xor(q, 16); q += __shfl_xor(q, 32); nm[bj] = fmaxf(nm[bj], q); }
                    u32x4 w; w.x = cvt_pk_bf16(v0[0], v0[1]); w.y = cvt_pk_bf16(v0[2], v0[3]); w.z = cvt_pk_bf16(v1[0], v1[1]); w.w = cvt_pk_bf16(v1[2], v1[3]);
                    *(u32x4*)(hm ? rowh + (size_t)bj * 4096 * 128 : rowp + bj * HALF) = w; } }
        if (seg == 2 || seg == 3) {
#pragma unroll
            for (int bj = 0; bj < 2; ++bj) { float q = nm[bj];
#pragma unroll
                for (int o = 1; o < 16; o <<= 1) q = fmaxf(q, __shfl_xor(q, o));
                if (fr == 0 && fq == 0) atomicMax(norm + ((((seg - 2) * 8 + (u.pm >> 4)) * 8 + 2 * (u.pn & 3) + bj) * 4 + wc), __float_as_uint(q)); }
        }
    }
};
template <int MODE> struct EpiGate {
    static constexpr bool PERM = true, AFTER_DRAIN = false; static constexpr int NSTORES = 16;
    const bf16_t* G; bf16_t* O;
    __device__ __forceinline__ void operator()(const f32x4 (&acc)[2][2][4][2], const Unit& u, int wr, int wc, int fr, int fq) const {
        const int row0 = u.pm * BM + wr * 64 + fr, col0 = u.pn * BM + wc * 32 + 8 * fq;
        u32x4 gv[2][2][2], pv[2][2][2];
#define EG_LOAD(st_, b_) do { _Pragma("unroll") for (int mm = 0; mm < 2; ++mm) _Pragma("unroll") for (int bj = 0; bj < 2; ++bj) { \
            const size_t off_ = (size_t)(row0 + ((st_) >> 1) * HALF + (2 * ((st_) & 1) + mm) * 16) * 1024 + col0 + bj * HALF; gv[b_][mm][bj] = __builtin_nontemporal_load((const u32x4*)(G + off_)); if (MODE == 1) pv[b_][mm][bj] = __builtin_nontemporal_load((const u32x4*)(O + off_)); } } while (0)
#define EG_DO(st_, b_) do { _Pragma("unroll") for (int mm = 0; mm < 2; ++mm) _Pragma("unroll") for (int bj = 0; bj < 2; ++bj) { const int ai = (st_) >> 1, m = 2 * ((st_) & 1) + mm; \
            const size_t off_ = (size_t)(row0 + ai * HALF + m * 16) * 1024 + col0 + bj * HALF; const u32x4 g = gv[b_][mm][bj]; \
            f32x4 v0 = acc[ai][bj][m][0], v1 = acc[ai][bj][m][1]; \
            v0[0] *= bf_lo(g.x); v0[1] *= bf_hi(g.x); v0[2] *= bf_lo(g.y); v0[3] *= bf_hi(g.y); v1[0] *= bf_lo(g.z); v1[1] *= bf_hi(g.z); v1[2] *= bf_lo(g.w); v1[3] *= bf_hi(g.w); \
            if (MODE == 1) { const u32x4 p = pv[b_][mm][bj]; \
                v0[0] += bf_lo(p.x); v0[1] += bf_hi(p.x); v0[2] += bf_lo(p.y); v0[3] += bf_hi(p.y); v1[0] += bf_lo(p.z); v1[1] += bf_hi(p.z); v1[2] += bf_lo(p.w); v1[3] += bf_hi(p.w); } \
            u32x4 w; w.x = cvt_pk_bf16(v0[0], v0[1]); w.y = cvt_pk_bf16(v0[2], v0[3]); w.z = cvt_pk_bf16(v1[0], v1[1]); w.w = cvt_pk_bf16(v1[2], v1[3]); \
            *(u32x4*)(O + off_) = w; } } while (0)
        EG_LOAD(0, 0); EG_LOAD(1, 1); EG_DO(0, 0); EG_LOAD(2, 0); EG_DO(1, 1); EG_LOAD(3, 1); EG_DO(2, 0); EG_DO(3, 1);
#undef EG_LOAD
#undef EG_DO
    }
};
struct TwoGemmOrder {
    StaticOrder base; int n1;
    __device__ void init(int M, int N, int G_, int c_) { base.init(M, N, G_, c_); n1 = (base.nwg - c_ + G_ - 1) / G_; if (n1 < 0) n1 = 0; }
    __device__ __forceinline__ bool next(int i, Unit& u) const { if (i >= 2 * n1) return false; const bool second = i >= n1; base.next(second ? i - n1 : i, u); if (second) { u.pm += 128; u.pn += 4; } return true; }
    __device__ __forceinline__ void a_ready(const Unit&) const {}
    __device__ __forceinline__ void done(const Unit&) const {}
};
struct EpiGate2 {
    static constexpr bool PERM = true, AFTER_DRAIN = false; static constexpr int NSTORES = 16;
    const bf16_t* G0; const bf16_t* G1; bf16_t* O;
    __device__ __forceinline__ void operator()(const f32x4 (&acc)[2][2][4][2], const Unit& u, int wr, int wc, int fr, int fq) const {
        Unit v; v.pm = u.pm & 127; v.pn = u.pn & 3;
        if (u.pm >= 128) { EpiGate<1> e{G1, O}; e(acc, v, wr, wc, fr, fq); } else { EpiGate<0> e{G0, O}; e(acc, v, wr, wc, fr, fq); }
    }
};
struct EpiDelta {
    static constexpr bool PERM = true, AFTER_DRAIN = false; static constexpr int NSTORES = 16;
    bf16_t* O;
    __device__ __forceinline__ void operator()(const f32x4 (&acc)[2][2][4][2], const Unit& u, int wr, int wc, int fr, int fq) const {
        const int row0 = u.pm * BM + wr * 64 + fr, col0 = u.pn * BM + wc * 32 + 8 * fq;
#pragma unroll
        for (int ai = 0; ai < 2; ++ai)
#pragma unroll
            for (int m = 0; m < 4; ++m) { bf16_t* rowp = O + (size_t)(row0 + ai * HALF + m * 16) * 1024 + col0;
#pragma unroll
                for (int bj = 0; bj < 2; ++bj) { const f32x4 v0 = acc[ai][bj][m][0], v1 = acc[ai][bj][m][1];
                    u32x4 w; w.x = cvt_pk_bf16(v0[0], v0[1]); w.y = cvt_pk_bf16(v0[2], v0[3]); w.z = cvt_pk_bf16(v1[0], v1[1]); w.w = cvt_pk_bf16(v1[2], v1[3]);
                    *(u32x4*)(rowp + bj * HALF) = w; } }
    }
};
template <int HOOK> struct GroupedOrderT {
    const PG8_LAS int* tile_e; int nunits, G, c; unsigned* rdy; int wid; unsigned* tmo;
    __device__ __forceinline__ int unit_index(int i) const {
        if constexpr (HOOK != 3) { const int L = i * G + c; return L < nunits ? L : -1; }
        else { constexpr int K0 = 2; const int rem = nunits % G, poolA = nunits - rem, E = G - rem;
            if (c < rem) { if (i == 0) return poolA + c; const int k = i - 1 + K0; const int L = k * E + (k - K0) * rem + E + c; return L < poolA ? L : -1; }
            const int k = i, L = k * E + (k > K0 ? k - K0 : 0) * rem + (c - rem); return L < poolA ? L : -1; }
    }
    __device__ __forceinline__ bool next(int i, Unit& u) const { const int L = unit_index(i); if (L < 0) return false; u.pm = L >> 2; u.pn = __builtin_amdgcn_readfirstlane(tile_e[u.pm]) * 4 + (L & 3); return true; }
    __device__ __forceinline__ void a_ready(const Unit& u) const {
        if constexpr (HOOK == 2) {
            if (wid == 0) { unsigned sp = 0u;
                while ((unsigned)__builtin_amdgcn_readfirstlane(__hip_atomic_load(rdy + 8 * u.pm, __ATOMIC_RELAXED, __HIP_MEMORY_SCOPE_AGENT)) < 32u) {
                    __builtin_amdgcn_s_sleep(2);
                    if ((++sp & 1023u) == 0u) { if (__builtin_amdgcn_readfirstlane(__hip_atomic_load(tmo, __ATOMIC_RELAXED, __HIP_MEMORY_SCOPE_AGENT)) != 0u) break;
                        if (sp > (1u << 20)) { if (lane_now() == 0) __hip_atomic_store(tmo, 1u, __ATOMIC_RELAXED, __HIP_MEMORY_SCOPE_AGENT); break; } } }
                __builtin_amdgcn_fence(__ATOMIC_ACQUIRE, "agent");
                asm volatile("s_waitcnt vmcnt(0)" ::: "memory"); }
            asm volatile("" ::: "memory"); __builtin_amdgcn_s_barrier(); asm volatile("" ::: "memory");
        }
    }
    mutable int pend = -1;
    __device__ __forceinline__ void done(const Unit& u) const { if constexpr (HOOK == 1) pend = u.pm; }
    __device__ __forceinline__ void pre() const {
        if constexpr (HOOK == 1) { if (pend >= 0) { asm volatile("s_waitcnt vmcnt(24)" ::: "memory");
            if (lane_now() == 0) (void)__hip_atomic_fetch_add(rdy + 8 * pend, 1u, __ATOMIC_RELAXED, __HIP_MEMORY_SCOPE_AGENT); pend = -1; } }
    }
    __device__ __forceinline__ void fin() const {
        if constexpr (HOOK == 1) { if (pend >= 0) { asm volatile("s_waitcnt vmcnt(0)" ::: "memory");
            if (lane_now() == 0) (void)__hip_atomic_fetch_add(rdy + 8 * pend, 1u, __ATOMIC_RELAXED, __HIP_MEMORY_SCOPE_AGENT); pend = -1; } }
    }
};
using GroupedOrder = GroupedOrderT<0>;
struct EpiSwiGLU {
    static constexpr bool PERM = true, AFTER_DRAIN = false; static constexpr int NSTORES = 8;
    unsigned char* HB;
    __device__ __forceinline__ void operator()(const f32x4 (&acc)[2][2][4][2], const Unit& u, int wr, int wc, int fr, int fq, const PG8_LAS int* rows) const {
        const int row0 = u.pm * BM + wr * 64 + fr, col0 = (u.pn & 3) * HALF + wc * 32 + 8 * fq;
        float sv[2][4];
#pragma unroll
        for (int ai = 0; ai < 2; ++ai)
#pragma unroll
            for (int m = 0; m < 4; ++m) sv[ai][m] = ((const PG8_LAS float*)rows)[6 * 256 + wr * 64 + fr + ai * HALF + m * 16] * (1.0f / W13_SCALE);
#pragma unroll
        for (int ai = 0; ai < 2; ++ai)
#pragma unroll
            for (int m = 0; m < 4; ++m) { const int row = row0 + ai * HALF + m * 16; const float s = sv[ai][m];
                float o[8];
#pragma unroll
                for (int n = 0; n < 2; ++n)
#pragma unroll
                    for (int i = 0; i < 4; ++i) { const float g = acc[ai][0][m][n][i] * s, uu = acc[ai][1][m][n][i] * s; o[n * 4 + i] = g * sigmoid_f(g) * uu * HB_SCALE; }
                unsigned long long w = (unsigned long long)pack4_fp8(o[0], o[1], o[2], o[3]) | ((unsigned long long)pack4_fp8(o[4], o[5], o[6], o[7]) << 32);
                asm volatile("global_store_dwordx2 %0, %1, off sc1" :: "v"((unsigned long long*)(HB + (size_t)row * 512 + col0)), "v"(w) : "memory"); }
    }
};
constexpr float Y_SCALE = 0.25f;
struct EpiY {
    static constexpr bool PERM = true, AFTER_DRAIN = false; static constexpr int NSTORES = 16;
    unsigned char* Y; int skip;
    __device__ __forceinline__ void operator()(const f32x4 (&acc)[2][2][4][2], const Unit& u, int wr, int wc, int fr, int fq) const {
        if (skip == 1) return;
        const int row0 = u.pm * BM + wr * 64 + fr, col0 = (u.pn & 3) * BM + wc * 32 + 8 * fq;
#pragma unroll
        for (int ai = 0; ai < 2; ++ai)
#pragma unroll
            for (int m = 0; m < 4; ++m) { const int row = row0 + ai * HALF + m * 16; unsigned char* rowp = Y + (size_t)row * 1024 + col0;
#pragma unroll
                for (int bj = 0; bj < 2; ++bj) {
                    if (skip == 2) { *(unsigned long long*)(rowp + bj * HALF) = (unsigned long long)__float_as_uint(acc[ai][bj][m][0][0]) | ((unsigned long long)__float_as_uint(acc[ai][bj][m][1][0]) << 32); continue; }
                    const f32x4 v0 = acc[ai][bj][m][0] * Y_SCALE, v1 = acc[ai][bj][m][1] * Y_SCALE;
                    const unsigned long long w = (unsigned long long)pack4_fp8(v0[0], v0[1], v0[2], v0[3]) | ((unsigned long long)pack4_fp8(v1[0], v1[1], v1[2], v1[3]) << 32);
                    if (skip == 3) { asm volatile("" :: "v"(w)); continue; }
                    *(unsigned long long*)(rowp + bj * HALF) = w; } }
    }
};
template <class Epi, class Sched, bool ALIGN_EPI = false, bool SP2 = false, bool F8 = false>
__device__ __forceinline__ void gemm_phase(PG8_LAS unsigned char* lds, const Gemm g, const Sched& S, const Epi& E, const int wid) {
    const int lane = lane_now(), tid = wid * 64 + lane, wr = wid >> 2, wc = wid & 3, fr = lane & 15, fq = lane >> 4;
    const int K = g.K, nt = K / BK;
    unsigned voffA[2], voffB[2];
#pragma unroll
    for (int i = 0; i < 2; ++i) { int R, C; stage_rc(tid * 16 + i * 8192, R, C); const int Rb = Epi::PERM ? ((R & ~31) + perm32(R & 31)) : R;
        voffA[i] = (unsigned)(R * K + C) * 2u; voffB[i] = (unsigned)(Rb * K + C) * 2u; }
    const size_t kstep = (size_t)(BK * 2);
    const size_t hstep = (size_t)HALF * K * 2;
    const size_t tstep = 2 * hstep;
    const unsigned ldsw = (unsigned)wid * 1024u;
    const unsigned ldsbase = (unsigned)__builtin_amdgcn_readfirstlane((int)((unsigned)(uintptr_t)lds + ldsw));
    const int aoff = lds_byte(wr * 64 + fr, fq * 8), boff = lds_byte(wc * 32 + fr, fq * 8);
#define PG8_SA(b, h) (((b) * 2 + (h)) * HTB)
#define PG8_SB(b, h) ((4 + (b) * 2 + (h)) * HTB)
#define PG8_STAGE(bufoff, gbase, voff) do { _Pragma("unroll") for (int _i = 0; _i < 2; ++_i) { \
        if constexpr (F8) glds_sv((const char*)(gbase), (voff)[_i], ldsbase + (unsigned)((bufoff) + _i * 8192)); \
        else __builtin_amdgcn_global_load_lds((const unsigned*)((const char*)(gbase) + (voff)[_i]), (PG8_LAS unsigned*)(lds + (bufoff) + ldsw + _i * 8192), 16, 0, 0); } } while (0)
#define PG8_LDA(dst, b, h) do { _Pragma("unroll") for (int m = 0; m < 4; ++m) { \
        if constexpr (F8) { dst##8[m] = cat8(*(const PG8_LAS bf16x8*)(lds + PG8_SA(b, h) + aoff + m * 2048), *(const PG8_LAS bf16x8*)(lds + PG8_SA(b, h) + aoff + m * 2048 + 1024)); } \
        else { _Pragma("unroll") for (int k = 0; k < 2; ++k) dst[m][k] = *(const PG8_LAS bf16x8*)(lds + PG8_SA(b, h) + aoff + m * 2048 + k * 1024); } } } while (0)
#define PG8_LDB(dst, b, h) do { _Pragma("unroll") for (int n = 0; n < 2; ++n) { \
        if constexpr (F8) { dst##8[n] = cat8(*(const PG8_LAS bf16x8*)(lds + PG8_SB(b, h) + boff + n * 2048), *(const PG8_LAS bf16x8*)(lds + PG8_SB(b, h) + boff + n * 2048 + 1024)); } \
        else { _Pragma("unroll") for (int k = 0; k < 2; ++k) dst[n][k] = *(const PG8_LAS bf16x8*)(lds + PG8_SB(b, h) + boff + n * 2048 + k * 1024); } } } while (0)
#define PG8_MMA(ai, bj, At, Bt) do { __builtin_amdgcn_s_setprio(1); _Pragma("unroll") for (int m = 0; m < 4; ++m) _Pragma("unroll") for (int n = 0; n < 2; ++n) { \
        if constexpr (F8) { acc[ai][bj][m][n] = __builtin_amdgcn_mfma_scale_f32_16x16x128_f8f6f4(Bt##8[n], At##8[m], acc[ai][bj][m][n], 0, 0, 0, 0, 0, 0); } \
        else { _Pragma("unroll") for (int k = 0; k < 2; ++k) acc[ai][bj][m][n] = __builtin_amdgcn_mfma_f32_16x16x32_bf16(Bt[n][k], At[m][k], acc[ai][bj][m][n], 0, 0, 0); } } \
        __builtin_amdgcn_s_setprio(0); } while (0)
#define PG8_WAIT_V(n) asm volatile("s_waitcnt vmcnt(" #n ")" ::: "memory")
#define PG8_WAIT_L(n) asm volatile("s_waitcnt lgkmcnt(" #n ")" ::: "memory")
#define PG8_BAR __builtin_amdgcn_s_barrier()
#define PG8_SCHED __builtin_amdgcn_sched_barrier(0)
    Unit cur, nxt; int ui = 0;
    if (!S.next(0, cur)) return;
    f32x4 acc[2][2][4][2];
#pragma unroll
    for (int a = 0; a < 2; ++a)
#pragma unroll
        for (int b = 0; b < 2; ++b)
#pragma unroll
            for (int m = 0; m < 4; ++m)
#pragma unroll
                for (int n = 0; n < 2; ++n) acc[a][b][m][n] = (f32x4){0.f, 0.f, 0.f, 0.f};
    bf16x8 At[4][2], B0[2][2], B1[2][2]; v8i_t At8[4], B08[2], B18[2];
    const char* cA = (const char*)g.A + (size_t)cur.pm * tstep; const char* cB = (const char*)g.Bt + (size_t)cur.pn * tstep;
    S.a_ready(cur);
    if constexpr (SP2) {
        PG8_STAGE(PG8_SB(0, 0), cB, voffB); PG8_STAGE(PG8_SB(0, 1), cB + hstep, voffB); PG8_STAGE(PG8_SA(0, 0), cA, voffA); PG8_STAGE(PG8_SA(0, 1), cA + hstep, voffA);
        if (wr == 1) PG8_BAR;
        PG8_WAIT_V(2); PG8_BAR;
        PG8_STAGE(PG8_SB(1, 0), cB + kstep, voffB); PG8_STAGE(PG8_SA(1, 0), cA + kstep, voffA); PG8_STAGE(PG8_SB(1, 1), cB + hstep + kstep, voffB);
        PG8_WAIT_V(6); PG8_BAR;
    } else {
        PG8_STAGE(PG8_SB(0, 0), cB, voffB); PG8_STAGE(PG8_SA(0, 0), cA, voffA); PG8_STAGE(PG8_SB(0, 1), cB + hstep, voffB); PG8_STAGE(PG8_SA(0, 1), cA + hstep, voffA);
        if (wr == 1) PG8_BAR;
        PG8_WAIT_V(4); PG8_BAR;
        PG8_STAGE(PG8_SB(1, 0), cB + kstep, voffB); PG8_STAGE(PG8_SA(1, 0), cA + kstep, voffA); PG8_STAGE(PG8_SB(1, 1), cB + hstep + kstep, voffB);
        PG8_WAIT_V(6); PG8_BAR;
    }
    for (;;) {
        const bool has_next = S.next(ui + 1, nxt);
        const char* nA = has_next ? (const char*)g.A + (size_t)nxt.pm * tstep : cA; const char* nB = has_next ? (const char*)g.Bt + (size_t)nxt.pn * tstep : cB;
#pragma clang loop unroll(disable)
        for (int t = 0; t < nt; t += 2) {
            const bool last = (t == nt - 2);
            const char* a1 = cA + (size_t)(t + 1) * kstep;
            const char* a2 = last ? nA : cA + (size_t)(t + 2) * kstep; const char* b2 = last ? nB : cB + (size_t)(t + 2) * kstep;
            const char* a3 = a2 + kstep; const char* b3 = b2 + kstep;
            if (last && has_next) S.a_ready(nxt);
            if constexpr (SP2) {
            PG8_LDB(B0, 0, 0); PG8_LDB(B1, 0, 1); PG8_SCHED; PG8_LDA(At, 0, 0); PG8_STAGE(PG8_SA(1, 1), a1 + hstep, voffA);
            PG8_WAIT_V(8); PG8_WAIT_L(0); PG8_BAR; PG8_MMA(0, 0, At, B0); PG8_MMA(0, 1, At, B1); PG8_BAR; PG8_SCHED;
            PG8_LDA(At, 0, 1); PG8_STAGE(PG8_SB(0, 0), b2, voffB); PG8_STAGE(PG8_SB(0, 1), b2 + hstep, voffB); PG8_STAGE(PG8_SA(0, 0), a2, voffA);
            PG8_WAIT_V(8); PG8_WAIT_L(0); PG8_BAR; PG8_MMA(1, 0, At, B0); PG8_MMA(1, 1, At, B1); PG8_BAR; PG8_SCHED;
            PG8_LDB(B0, 1, 0); PG8_LDB(B1, 1, 1); PG8_SCHED; PG8_LDA(At, 1, 0); PG8_STAGE(PG8_SA(0, 1), a2 + hstep, voffA);
            PG8_WAIT_V(8); PG8_WAIT_L(0); PG8_BAR; PG8_MMA(0, 0, At, B0); PG8_MMA(0, 1, At, B1); PG8_BAR; PG8_SCHED;
            PG8_LDA(At, 1, 1); PG8_STAGE(PG8_SB(1, 0), b3, voffB); PG8_STAGE(PG8_SB(1, 1), b3 + hstep, voffB); PG8_STAGE(PG8_SA(1, 0), a3, voffA);
            PG8_WAIT_V(8); PG8_WAIT_L(0); PG8_BAR; PG8_MMA(1, 0, At, B0); PG8_MMA(1, 1, At, B1); PG8_BAR; PG8_SCHED;
            } else {
            PG8_LDB(B0, 0, 0); PG8_SCHED; PG8_LDA(At, 0, 0); PG8_STAGE(PG8_SA(1, 1), a1 + hstep, voffA);
            PG8_WAIT_L(8); PG8_BAR; PG8_WAIT_L(0); PG8_MMA(0, 0, At, B0); PG8_BAR; PG8_SCHED;
            PG8_LDB(B1, 0, 1); PG8_STAGE(PG8_SB(0, 0), b2, voffB);
            PG8_BAR; PG8_WAIT_L(0); PG8_MMA(0, 1, At, B1); PG8_BAR;
            PG8_LDA(At, 0, 1); PG8_STAGE(PG8_SA(0, 0), a2, voffA);
            PG8_BAR; PG8_WAIT_L(0); PG8_MMA(1, 0, At, B0); PG8_BAR; PG8_SCHED;
            PG8_STAGE(PG8_SB(0, 1), b2 + hstep, voffB);
            PG8_WAIT_V(6); PG8_BAR; PG8_MMA(1, 1, At, B1); PG8_BAR;
            PG8_LDB(B0, 1, 0); PG8_SCHED; PG8_LDA(At, 1, 0); PG8_STAGE(PG8_SA(0, 1), a2 + hstep, voffA);
            PG8_WAIT_L(8); PG8_BAR; PG8_WAIT_L(0); PG8_MMA(0, 0, At, B0); PG8_BAR; PG8_SCHED;
            PG8_LDB(B1, 1, 1); PG8_STAGE(PG8_SB(1, 0), b3, voffB);
            PG8_BAR; PG8_WAIT_L(0); PG8_MMA(0, 1, At, B1); PG8_BAR;
            PG8_LDA(At, 1, 1); PG8_STAGE(PG8_SA(1, 0), a3, voffA);
            PG8_BAR; PG8_WAIT_L(0); PG8_MMA(1, 0, At, B0); PG8_BAR; PG8_SCHED;
            PG8_STAGE(PG8_SB(1, 1), b3 + hstep, voffB);
            PG8_WAIT_V(6); PG8_BAR; PG8_MMA(1, 1, At, B1); PG8_BAR;
            }
        }
        if constexpr (ALIGN_EPI) { if (wr == 0) PG8_BAR; }
        if constexpr (!Epi::AFTER_DRAIN) { const int l2 = lane_now(); E(acc, cur, wr, wc, l2 & 15, l2 >> 4); S.done(cur); }
        if (!has_next) break;
#pragma unroll
        for (int a = 0; a < 2; ++a)
#pragma unroll
            for (int b = 0; b < 2; ++b)
#pragma unroll
                for (int m = 0; m < 4; ++m)
#pragma unroll
                    for (int n = 0; n < 2; ++n) acc[a][b][m][n] = (f32x4){0.f, 0.f, 0.f, 0.f};
        cur = nxt; cA = nA; cB = nB; ++ui;
        if constexpr (ALIGN_EPI) { if (wr == 1) PG8_BAR; }
    }
    PG8_WAIT_V(0);
    if constexpr (!ALIGN_EPI) { if (wr == 0) PG8_BAR; }
    PG8_BAR;
    if constexpr (Epi::AFTER_DRAIN) { E.fused(acc, cur, wr, wc, fr, fq, lds, wid, lane); S.done(cur); }
#undef PG8_SA
#undef PG8_SB
#undef PG8_STAGE
#undef PG8_LDA
#undef PG8_LDB
#undef PG8_MMA
#undef PG8_WAIT_V
#undef PG8_WAIT_L
#undef PG8_BAR
#undef PG8_SCHED
}
template <class Epi, class Sched, bool F8 = false>
__device__ __forceinline__ void gemm_phase_gather(PG8_LAS unsigned char* lds, const Gemm g, const Sched& S, const Epi& E, const PG8_LAS int* rowtab, const int wid) {
    constexpr bool ALIGN_EPI = true, SP2 = true;
    const int lane = lane_now(), tid = wid * 64 + lane, wr = wid >> 2, wc = wid & 3, fr = lane & 15, fq = lane >> 4;
    const int K = g.K, nt = K / BK;
    unsigned voffB[2], vAc[2][2];
#pragma unroll
    for (int i = 0; i < 2; ++i) { int R, C; stage_rc(tid * 16 + i * 8192, R, C); const int Rb = Epi::PERM ? ((R & ~31) + perm32(R & 31)) : R;
        voffB[i] = (unsigned)(Rb * K + C) * 2u; }
#define PG8_ROWS(dst, ui_) do { const int t_ = wid * 64 + lane_now(); _Pragma("unroll") for (int i_ = 0; i_ < 2; ++i_) { int R_, C_; stage_rc(t_ * 16 + i_ * 8192, R_, C_); \
        _Pragma("unroll") for (int h_ = 0; h_ < 2; ++h_) dst[h_][i_] = (unsigned)rowtab[(ui_) * 256 + h_ * HALF + R_] * (unsigned)(K * 2) + (unsigned)(C_ * 2); } } while (0)
#define PG8_STAGE_A(bufoff, v, kb) do { _Pragma("unroll") for (int _i = 0; _i < 2; ++_i) { \
        if constexpr (F8) glds_sv((const char*)g.A + (kb), (v)[_i], ldsbase + (unsigned)((bufoff) + _i * 8192)); \
        else __builtin_amdgcn_global_load_lds((const unsigned*)((const char*)g.A + (v)[_i] + (kb)), (PG8_LAS unsigned*)(lds + (bufoff) + ldsw + _i * 8192), 16, 0, 0); } } while (0)
    const size_t kstep = (size_t)(BK * 2);
    const size_t hstep = (size_t)HALF * K * 2;
    const size_t tstep = 2 * hstep;
    const unsigned ldsw = (unsigned)wid * 1024u;
    const unsigned ldsbase = (unsigned)__builtin_amdgcn_readfirstlane((int)((unsigned)(uintptr_t)lds + ldsw));
    const int aoff = lds_byte(wr * 64 + fr, fq * 8), boff = lds_byte(wc * 32 + fr, fq * 8);
#define PG8_SA(b, h) (((b) * 2 + (h)) * HTB)
#define PG8_SB(b, h) ((4 + (b) * 2 + (h)) * HTB)
#define PG8_STAGE(bufoff, gbase, voff) do { _Pragma("unroll") for (int _i = 0; _i < 2; ++_i) { \
        if constexpr (F8) glds_sv((const char*)(gbase), (voff)[_i], ldsbase + (unsigned)((bufoff) + _i * 8192)); \
        else __builtin_amdgcn_global_load_lds((const unsigned*)((const char*)(gbase) + (voff)[_i]), (PG8_LAS unsigned*)(lds + (bufoff) + ldsw + _i * 8192), 16, 0, 0); } } while (0)
#define PG8_LDA(dst, b, h) do { _Pragma("unroll") for (int m = 0; m < 4; ++m) { \
        if constexpr (F8) { dst##8[m] = cat8(*(const PG8_LAS bf16x8*)(lds + PG8_SA(b, h) + aoff + m * 2048), *(const PG8_LAS bf16x8*)(lds + PG8_SA(b, h) + aoff + m * 2048 + 1024)); } \
        else { _Pragma("unroll") for (int k = 0; k < 2; ++k) dst[m][k] = *(const PG8_LAS bf16x8*)(lds + PG8_SA(b, h) + aoff + m * 2048 + k * 1024); } } } while (0)
#define PG8_LDB(dst, b, h) do { _Pragma("unroll") for (int n = 0; n < 2; ++n) { \
        if constexpr (F8) { dst##8[n] = cat8(*(const PG8_LAS bf16x8*)(lds + PG8_SB(b, h) + boff + n * 2048), *(const PG8_LAS bf16x8*)(lds + PG8_SB(b, h) + boff + n * 2048 + 1024)); } \
        else { _Pragma("unroll") for (int k = 0; k < 2; ++k) dst[n][k] = *(const PG8_LAS bf16x8*)(lds + PG8_SB(b, h) + boff + n * 2048 + k * 1024); } } } while (0)
#define PG8_MMA(ai, bj, At, Bt) do { __builtin_amdgcn_s_setprio(1); _Pragma("unroll") for (int m = 0; m < 4; ++m) _Pragma("unroll") for (int n = 0; n < 2; ++n) { \
        if constexpr (F8) { acc[ai][bj][m][n] = __builtin_amdgcn_mfma_scale_f32_16x16x128_f8f6f4(Bt##8[n], At##8[m], acc[ai][bj][m][n], 0, 0, 0, 0, 0, 0); } \
        else { _Pragma("unroll") for (int k = 0; k < 2; ++k) acc[ai][bj][m][n] = __builtin_amdgcn_mfma_f32_16x16x32_bf16(Bt[n][k], At[m][k], acc[ai][bj][m][n], 0, 0, 0); } } \
        __builtin_amdgcn_s_setprio(0); } while (0)
#define PG8_WAIT_V(n) asm volatile("s_waitcnt vmcnt(" #n ")" ::: "memory")
#define PG8_WAIT_L(n) asm volatile("s_waitcnt lgkmcnt(" #n ")" ::: "memory")
#define PG8_BAR __builtin_amdgcn_s_barrier()
#define PG8_SCHED __builtin_amdgcn_sched_barrier(0)
    Unit cur, nxt; int ui = 0;
    if (!S.next(0, cur)) return;
    f32x4 acc[2][2][4][2];
#pragma unroll
    for (int a = 0; a < 2; ++a)
#pragma unroll
        for (int b = 0; b < 2; ++b)
#pragma unroll
            for (int m = 0; m < 4; ++m)
#pragma unroll
                for (int n = 0; n < 2; ++n) acc[a][b][m][n] = (f32x4){0.f, 0.f, 0.f, 0.f};
    bf16x8 At[4][2], B0[2][2], B1[2][2]; v8i_t At8[4], B08[2], B18[2];
    const char* cB = (const char*)g.Bt + (size_t)cur.pn * tstep;
    PG8_ROWS(vAc, 0);
    S.a_ready(cur);
    if constexpr (SP2) {
        PG8_STAGE(PG8_SB(0, 0), cB, voffB); PG8_STAGE(PG8_SB(0, 1), cB + hstep, voffB); PG8_STAGE_A(PG8_SA(0, 0), vAc[0], 0u); PG8_STAGE_A(PG8_SA(0, 1), vAc[1], 0u);
        if (wr == 1) PG8_BAR;
        PG8_WAIT_V(2); PG8_BAR;
        PG8_STAGE(PG8_SB(1, 0), cB + kstep, voffB); PG8_STAGE_A(PG8_SA(1, 0), vAc[0], (unsigned)kstep); PG8_STAGE(PG8_SB(1, 1), cB + hstep + kstep, voffB);
        PG8_WAIT_V(6); PG8_BAR;
    }
    for (;;) {
        const bool has_next = S.next(ui + 1, nxt);
        const char* nB = has_next ? (const char*)g.Bt + (size_t)nxt.pn * tstep : cB;
#pragma clang loop unroll(disable)
        for (int t = 0; t < nt; t += 2) {
            const bool last = (t == nt - 2);
            const unsigned k1 = (unsigned)((t + 1) * (int)kstep), k2 = last ? 0u : (unsigned)((t + 2) * (int)kstep), k3 = k2 + (unsigned)kstep;
            unsigned v2[2][2];
            if (last && has_next) { PG8_ROWS(v2, ui + 1); }
            else {
#pragma unroll
                for (int h_ = 0; h_ < 2; ++h_)
#pragma unroll
                    for (int i_ = 0; i_ < 2; ++i_) v2[h_][i_] = vAc[h_][i_]; }
            const char* b2 = last ? nB : cB + (size_t)(t + 2) * kstep; const char* b3 = b2 + kstep;
            if (last && has_next) S.a_ready(nxt);
            if constexpr (SP2) {
            PG8_LDB(B0, 0, 0); PG8_LDB(B1, 0, 1); PG8_SCHED; PG8_LDA(At, 0, 0); PG8_STAGE_A(PG8_SA(1, 1), vAc[1], k1);
            PG8_WAIT_V(8); PG8_WAIT_L(0); PG8_BAR; PG8_MMA(0, 0, At, B0); PG8_MMA(0, 1, At, B1); PG8_BAR; PG8_SCHED;
            PG8_LDA(At, 0, 1); PG8_STAGE(PG8_SB(0, 0), b2, voffB); PG8_STAGE(PG8_SB(0, 1), b2 + hstep, voffB); PG8_STAGE_A(PG8_SA(0, 0), v2[0], k2);
            PG8_WAIT_V(8); PG8_WAIT_L(0); PG8_BAR; PG8_MMA(1, 0, At, B0); PG8_MMA(1, 1, At, B1); PG8_BAR; PG8_SCHED;
            PG8_LDB(B0, 1, 0); PG8_LDB(B1, 1, 1); PG8_SCHED; PG8_LDA(At, 1, 0); PG8_STAGE_A(PG8_SA(0, 1), v2[1], k2);
            PG8_WAIT_V(8); PG8_WAIT_L(0); PG8_BAR; PG8_MMA(0, 0, At, B0); PG8_MMA(0, 1, At, B1); PG8_BAR; PG8_SCHED;
            PG8_LDA(At, 1, 1); PG8_STAGE(PG8_SB(1, 0), b3, voffB); PG8_STAGE(PG8_SB(1, 1), b3 + hstep, voffB); PG8_STAGE_A(PG8_SA(1, 0), v2[0], k3);
            PG8_WAIT_V(8); PG8_WAIT_L(0); PG8_BAR; PG8_MMA(1, 0, At, B0); PG8_MMA(1, 1, At, B1); PG8_BAR; PG8_SCHED;
            }
        }
        if constexpr (ALIGN_EPI) { if (wr == 0) PG8_BAR; }
        S.pre(); { const int l2 = lane_now(); E(acc, cur, wr, wc, l2 & 15, l2 >> 4, rowtab + ui * 256); } S.done(cur);
        if (!has_next) break;
#pragma unroll
        for (int a = 0; a < 2; ++a)
#pragma unroll
            for (int b = 0; b < 2; ++b)
#pragma unroll
                for (int m = 0; m < 4; ++m)
#pragma unroll
                    for (int n = 0; n < 2; ++n) acc[a][b][m][n] = (f32x4){0.f, 0.f, 0.f, 0.f};
        cur = nxt; cB = nB; ++ui;
        PG8_ROWS(vAc, ui);
        if constexpr (ALIGN_EPI) { if (wr == 1) PG8_BAR; }
    }
    PG8_WAIT_V(0);
    S.fin();
    if constexpr (!ALIGN_EPI) { if (wr == 0) PG8_BAR; }
    PG8_BAR;
#undef PG8_ROWS
#undef PG8_STAGE_A
#undef PG8_SA
#undef PG8_SB
#undef PG8_STAGE
#undef PG8_LDA
#undef PG8_LDB
#undef PG8_MMA
#undef PG8_WAIT_V
#undef PG8_WAIT_L
#undef PG8_BAR
#undef PG8_SCHED
}
}
#define GAS __attribute__((address_space(1)))
#define LAS __attribute__((address_space(3)))
typedef unsigned short bf16;
typedef unsigned v4u __attribute__((ext_vector_type(4)));
typedef float f32x4 __attribute__((ext_vector_type(4)));
typedef short bf16x8 __attribute__((ext_vector_type(8)));
typedef GAS unsigned gu32;
typedef GAS unsigned long long gu64;
#define RLX_AGENT __ATOMIC_RELAXED, __HIP_MEMORY_SCOPE_AGENT
#define LDS_WAIT() asm volatile("s_waitcnt lgkmcnt(0)" ::: "memory")
#define VM_WAIT() asm volatile("s_waitcnt vmcnt(0)" ::: "memory")
__device__ __forceinline__ unsigned long long rt() { return __builtin_amdgcn_s_memrealtime(); }
__device__ __forceinline__ unsigned f2bf(float f) { unsigned u = __builtin_bit_cast(unsigned, f); return (u + 0x7fffu + ((u >> 16) & 1u)) >> 16; }
__device__ __forceinline__ unsigned pk2(float lo, float hi) { return f2bf(lo) | (f2bf(hi) << 16); }
#define XB_TMO      128
#define XB_XCNT(j)  (256  + 64 * (j))
#define XB_XSUB(j)  (1280 + 64 * (j))
#define XB_XGEN(j)  (2304 + 64 * (j))
#define XB_TOP      3328
#define XB_TOPGEN   3392
#define XCD_BAR_WORDS 3456
#define XB_SPIN_CAP (1u << 18)

__device__ __forceinline__ unsigned xb_ld(unsigned* p)              { return __hip_atomic_load(p, __ATOMIC_RELAXED, __HIP_MEMORY_SCOPE_AGENT); }
__device__ __forceinline__ unsigned xb_add(unsigned* p, unsigned v) { return __hip_atomic_fetch_add(p, v, __ATOMIC_RELAXED, __HIP_MEMORY_SCOPE_AGENT); }
__device__ __forceinline__ unsigned xb_xcc_id() { return (unsigned)__builtin_amdgcn_s_getreg((3 << 11) | 20) & 0xFu; }
#define XB_SPIN(cond, bar) do { unsigned _sp = 0; while (cond) { __builtin_amdgcn_s_sleep(1); \
    if ((++_sp & 255u) == 0u) { if (xb_ld(&(bar)[XB_TMO])) break; if (_sp > XB_SPIN_CAP) { atomicAdd(&(bar)[XB_TMO], 1u); break; } } } } while (0)

struct XcdBarrier {
    unsigned* bar; unsigned x;
    volatile LAS unsigned* st;
};

__device__ __forceinline__ XcdBarrier xcd_barrier_post(unsigned* bar, volatile LAS unsigned* st) {
    XcdBarrier b; b.bar = bar; b.x = xb_xcc_id(); b.st = st;
    if (threadIdx.x == 0) (void)xb_add(&bar[XB_XCNT(b.x)], 1u);
    return b;
}
__device__ __forceinline__ void xcd_barrier_complete(unsigned* bar, unsigned x, unsigned& nloc, unsigned& nx) {
    const unsigned G = gridDim.x * gridDim.y * gridDim.z;
    unsigned sum, cnt, mine, sp = 0u;
    for (;;) {
        sum = 0u; cnt = 0u; mine = 0u;
#pragma unroll
        for (unsigned j = 0; j < 16; ++j) { const unsigned c = xb_ld(&bar[XB_XCNT(j)]); sum += c; cnt += (c > 0u) ? 1u : 0u; mine = (j == x) ? c : mine; }
        if (sum == G) break;
        __builtin_amdgcn_s_sleep(1);
        if ((++sp & 255u) == 0u) { if (xb_ld(&bar[XB_TMO])) break; if (sp > XB_SPIN_CAP) { atomicAdd(&bar[XB_TMO], 1u); break; } }
    }
    nloc = mine > 0u ? mine : 1u; nx = cnt > 0u ? cnt : 1u;
}

__device__ __forceinline__ void xcd_barrier(const XcdBarrier& b) {
    asm volatile("s_waitcnt vmcnt(0)" ::: "memory");
    __syncthreads();
    if (threadIdx.x == 0) {
        unsigned* bar = b.bar;
        __builtin_amdgcn_s_waitcnt(0);
        unsigned nloc = b.st[0], nx = b.st[1];
        if (nloc == 0u) { xcd_barrier_complete(bar, b.x, nloc, nx); b.st[0] = nloc; b.st[1] = nx; }
        const unsigned old = xb_add(&bar[XB_XSUB(b.x)], 1u);
        const unsigned gen = old / nloc;
        if (old + 1u == (gen + 1u) * nloc) {
            __builtin_amdgcn_fence(__ATOMIC_RELEASE, "agent");
            asm volatile("s_waitcnt vmcnt(0)" ::: "memory");
            const unsigned og = xb_add(&bar[XB_TOP], 1u);
            const unsigned tg = og / nx;
            if (og + 1u == (tg + 1u) * nx) xb_add(&bar[XB_TOPGEN], 1u);
            else XB_SPIN(xb_ld(&bar[XB_TOPGEN]) == tg, bar);
            __builtin_amdgcn_fence(__ATOMIC_ACQUIRE, "agent");
            xb_add(&bar[XB_XGEN(b.x)], 1u);
            asm volatile("s_waitcnt vmcnt(0)" ::: "memory");
        } else {
            XB_SPIN(xb_ld(&bar[XB_XGEN(b.x)]) == gen, bar);
            __builtin_amdgcn_fence(__ATOMIC_ACQUIRE, "agent");
            asm volatile("s_waitcnt vmcnt(0)" ::: "memory");
        }
    }
    __syncthreads();
}
namespace fattn {
typedef unsigned short bf16;
typedef short bf16x8 __attribute__((ext_vector_type(8)));
typedef short s16x4 __attribute__((ext_vector_type(4)));
typedef float f32x16 __attribute__((ext_vector_type(16)));
typedef float f32x4 __attribute__((ext_vector_type(4)));
typedef unsigned u32x4 __attribute__((ext_vector_type(4)));
constexpr int D = 128, LD = 128, LDO = 1024, SEQ = 4096;
constexpr float THR = 8.f;
constexpr float SCALE = 0.08838834764831845f;
constexpr int NW = 8, QBLK = 32, KVBLK = 64, QB = NW * QBLK;
constexpr int SHM_V = KVBLK * D * 2, SHM_K = KVBLK * D * 2;
constexpr int OFF_WS = 2 * SHM_V + 2 * SHM_K, OFF_BIAS = OFF_WS + NW * 64 * 4, LDS_BYTES = OFF_BIAS + 2 * 64 * 4;

#define KSWZ(row, colB) ((row) * 256 + ((colB) ^ (((row) & 7) << 4)))
#define SBAR() __builtin_amdgcn_sched_barrier(0)
__device__ __forceinline__ int v_st(int k, int c) { const int kk = (k & ~0xC) | ((k & 4) << 1) | ((k & 8) >> 1); return ((kk >> 3) * 4 + (c >> 5)) * 512 + ((kk & 7) * 32 + (c & 31)) * 2; }
__device__ __forceinline__ int v_rd_base(int lane) { return ((lane & 3) << 3) | (((lane >> 2) & 3) << 6) | (((lane >> 4) & 1) << 5) | (((lane >> 5) & 1) << 8); }
constexpr int v_rd_off(int d0, int ks, int half) { return d0 * 512 + ks * 4096 + half * 2048; }
__device__ __forceinline__ int crow(int r, int hi) { return (r & 3) + 8 * (r >> 2) + 4 * hi; }
__device__ __forceinline__ unsigned cvtpk(float lo, float hi) { unsigned r; asm volatile("v_cvt_pk_bf16_f32 %0, %1, %2" : "=v"(r) : "v"(lo), "v"(hi)); return r; }
__device__ __forceinline__ bf16x8 load8(const bf16* p) { return *reinterpret_cast<const bf16x8*>(p); }
__device__ __forceinline__ void mask_tile(f32x16& p0, f32x16& p1, int dq) {
    const float NEG = -__builtin_inff();
#pragma unroll
    for (int r = 0; r < 16; ++r) {
        const int c = (r & 3) + 8 * (r >> 2);
        if (dq - c < 0) p0[r] = NEG;
        if (dq - c - 32 < 0) p1[r] = NEG;
    }
}
__device__ __forceinline__ void partialSM(f32x16& p0, f32x16& p1, float& m_reg, float& mn, float& alpha) {
    float pmax = p0[0]; for (int r = 1; r < 16; ++r) pmax = fmaxf(pmax, p0[r]); for (int r = 0; r < 16; ++r) pmax = fmaxf(pmax, p1[r]);
    { auto rr = __builtin_amdgcn_permlane32_swap(__float_as_uint(pmax), __float_as_uint(pmax), false, false);
      pmax = fmaxf(__uint_as_float(rr[0]), __uint_as_float(rr[1])); }
    constexpr float C2 = 1.4426950408889634f * SCALE;
    if (__builtin_expect(__all((pmax - m_reg) * SCALE <= THR), 1)) { mn = m_reg; alpha = 1.f; }
    else { mn = fmaxf(m_reg, pmax); alpha = __builtin_amdgcn_exp2f((m_reg - mn) * C2); m_reg = mn; }
    const float mnL = -mn * C2;
    for (int r = 0; r < 16; ++r) p0[r] = fmaf(p0[r], C2, mnL); for (int r = 0; r < 16; ++r) p1[r] = fmaf(p1[r], C2, mnL);
    for (int r = 0; r < 16; ++r) p0[r] = __builtin_amdgcn_exp2f(p0[r]);
}
__device__ __forceinline__ void finishSM(f32x16& p0, f32x16& p1, float alpha, float& l_reg, bf16x8& pa0, bf16x8& pa1, bf16x8& pa2, bf16x8& pa3) {
    for (int r = 0; r < 16; ++r) p1[r] = __builtin_amdgcn_exp2f(p1[r]);
    float ps = 0; for (int r = 0; r < 16; ++r) ps += p0[r]; for (int r = 0; r < 16; ++r) ps += p1[r];
    { auto rr = __builtin_amdgcn_permlane32_swap(__float_as_uint(ps), __float_as_uint(ps), false, false);
      ps = __uint_as_float(rr[0]) + __uint_as_float(rr[1]); }
    l_reg = l_reg * alpha + ps;
#define PK4(P, B_, OUT) do { unsigned a0 = cvtpk(P[B_+0], P[B_+1]), a1 = cvtpk(P[B_+2], P[B_+3]);                          \
        unsigned b0 = cvtpk(P[B_+4], P[B_+5]), b1 = cvtpk(P[B_+6], P[B_+7]);                                             \
        auto r0 = __builtin_amdgcn_permlane32_swap(a0, b0, false, false); auto r1 = __builtin_amdgcn_permlane32_swap(a1, b1, false, false); \
        u32x4 w = {r0[0], r1[0], r0[1], r1[1]}; OUT = *reinterpret_cast<bf16x8*>(&w); } while (0)
    PK4(p0, 0, pa0); PK4(p0, 8, pa1); PK4(p1, 0, pa2); PK4(p1, 8, pa3);
#undef PK4
}
template <int KB>
__device__ __forceinline__ void qkt(f32x16& p0, f32x16& p1, const char* K_lds, const char* Bias_lds, int r32, int hi, const bf16x8* qr) {
    { const f32x4* bb = reinterpret_cast<const f32x4*>(Bias_lds + KB * 256 + hi * 16);
      const f32x4 a0 = bb[0], a1 = bb[2], a2 = bb[4], a3 = bb[6], c0 = bb[8], c1 = bb[10], c2 = bb[12], c3 = bb[14];
      p0 = (f32x16){a0[0], a0[1], a0[2], a0[3], a1[0], a1[1], a1[2], a1[3], a2[0], a2[1], a2[2], a2[3], a3[0], a3[1], a3[2], a3[3]};
      p1 = (f32x16){c0[0], c0[1], c0[2], c0[3], c1[0], c1[1], c1[2], c1[3], c2[0], c2[1], c2[2], c2[3], c3[0], c3[1], c3[2], c3[3]}; }
    const char* kb[4];
#pragma unroll
    for (int dd = 0; dd < 4; ++dd) kb[dd] = K_lds + KB * SHM_K + KSWZ(r32, (dd * 16 + hi * 8) * 2);
#pragma unroll
    for (int d0 = 0; d0 < 8; ++d0) { const char* a = kb[d0 & 3] + (d0 >> 2) * 128;
        bf16x8 b0 = *reinterpret_cast<const bf16x8*>(a);
        bf16x8 b1 = *reinterpret_cast<const bf16x8*>(a + 32 * 256);
        p0 = __builtin_amdgcn_mfma_f32_32x32x16_bf16(b0, qr[d0], p0, 0, 0, 0);
        p1 = __builtin_amdgcn_mfma_f32_32x32x16_bf16(b1, qr[d0], p1, 0, 0, 0); }
}
template <int VB>
__device__ __forceinline__ void pv_tile(f32x16* o, int vb0, bf16x8 pa0, bf16x8 pa1, bf16x8 pa2, bf16x8 pa3) {
#define TRRD(dst, off) asm volatile("ds_read_b64_tr_b16 %0, %1 offset:%2" : "=&v"(dst) : "v"(vb0), "i"(off) : "memory")
#define PV_D0(d0) do { s16x4 l0, l1, l2, l3, h0, h1, h2, h3; constexpr int b_ = VB * SHM_V + v_rd_off(d0, 0, 0);   \
        TRRD(l0, b_); TRRD(h0, b_ + 2048); TRRD(l1, b_ + 4096); TRRD(h1, b_ + 6144); TRRD(l2, b_ + 8192); TRRD(h2, b_ + 10240); TRRD(l3, b_ + 12288); TRRD(h3, b_ + 14336); \
        asm volatile("s_waitcnt lgkmcnt(0)" ::: "memory"); SBAR();                                                    \
        o[d0] = __builtin_amdgcn_mfma_f32_32x32x16_bf16(pa0, (bf16x8){l0[0], l0[1], l0[2], l0[3], h0[0], h0[1], h0[2], h0[3]}, o[d0], 0, 0, 0);   \
        o[d0] = __builtin_amdgcn_mfma_f32_32x32x16_bf16(pa1, (bf16x8){l1[0], l1[1], l1[2], l1[3], h1[0], h1[1], h1[2], h1[3]}, o[d0], 0, 0, 0);   \
        o[d0] = __builtin_amdgcn_mfma_f32_32x32x16_bf16(pa2, (bf16x8){l2[0], l2[1], l2[2], l2[3], h2[0], h2[1], h2[2], h2[3]}, o[d0], 0, 0, 0);   \
        o[d0] = __builtin_amdgcn_mfma_f32_32x32x16_bf16(pa3, (bf16x8){l3[0], l3[1], l3[2], l3[3], h3[0], h3[1], h3[2], h3[3]}, o[d0], 0, 0, 0); } while (0)
    PV_D0(0); PV_D0(1); PV_D0(2); PV_D0(3);
#undef PV_D0
#undef TRRD
}

struct Bases { const bf16* Q; bf16* O; const bf16* K; const bf16* V; const float* CB; };
struct BlockRef { unsigned qo, oo, kvo, cbo; int P0, jlo; };
struct Seam { bf16x8 qr[8]; };
#define VMW() asm volatile("s_waitcnt vmcnt(0)" ::: "memory")
#define VMWN(n) asm volatile("s_waitcnt vmcnt(%0)" :: "i"(n) : "memory")
#define LBAR() do { asm volatile("s_waitcnt lgkmcnt(0)" ::: "memory"); __builtin_amdgcn_s_barrier(); asm volatile("" ::: "memory"); } while (0)
#define ATT_SRC() \
    unsigned ksrc0, ksrc1, vsrc0, vsrc1; \
    { const int rw0 = 8 * wid + (lane >> 4), rw1 = rw0 + 4, p_ = lane & 15; ksrc0 = (unsigned)(rw0 * 256 + ((p_ ^ (rw0 & 7)) << 4)); ksrc1 = (unsigned)(rw1 * 256 + ((p_ ^ (rw1 & 7)) << 4)); \
      const int L0 = 128 * wid + lane, L1 = L0 + 64; \
      const int kk0 = ((L0 >> 7) << 3) | ((L0 >> 2) & 7), kk1 = ((L1 >> 7) << 3) | ((L1 >> 2) & 7); \
      const int k0_ = (kk0 & ~0xC) | ((kk0 & 4) << 1) | ((kk0 & 8) >> 1), k1_ = (kk1 & ~0xC) | ((kk1 & 4) << 1) | ((kk1 & 8) >> 1); \
      vsrc0 = (unsigned)(k0_ * 256 + ((((L0 >> 5) & 3) * 4 + (L0 & 3)) << 4)); vsrc1 = (unsigned)(k1_ * 256 + ((((L1 >> 5) & 3) * 4 + (L1 & 3)) << 4)); }
#define DMA_K(Kp, CBp, k0, bf) do { const char* kp_ = (const char*)(Kp) + (unsigned)(k0) * 256u; \
        __builtin_amdgcn_global_load_lds((const unsigned*)(kp_ + ksrc0), (LAS unsigned*)(ldsa + 2 * SHM_V + (bf) * SHM_K + (2 * wid) * 1024), 16, 0, 0); \
        __builtin_amdgcn_global_load_lds((const unsigned*)(kp_ + ksrc1), (LAS unsigned*)(ldsa + 2 * SHM_V + (bf) * SHM_K + (2 * wid + 1) * 1024), 16, 0, 0); \
        if (wid == 0) __builtin_amdgcn_global_load_lds((const unsigned*)((CBp) + (unsigned)((k0) + lane)), (LAS unsigned*)(ldsa + OFF_BIAS + (bf) * 256), 4, 0, 0); } while (0)
#define DMA_V(Vp, k0, bf) do { const char* vp_ = (const char*)(Vp) + (unsigned)(k0) * 256u; \
        __builtin_amdgcn_global_load_lds((const unsigned*)(vp_ + vsrc0), (LAS unsigned*)(ldsa + (bf) * SHM_V + (2 * wid) * 1024), 16, 0, 0); \
        __builtin_amdgcn_global_load_lds((const unsigned*)(vp_ + vsrc1), (LAS unsigned*)(ldsa + (bf) * SHM_V + (2 * wid + 1) * 1024), 16, 0, 0); } while (0)
__device__ __forceinline__ void prime(const Bases& G, const BlockRef& cur, char* lds, LAS unsigned char* ldsa, Seam& S) {
    const int tid = threadIdx.x, wid = __builtin_amdgcn_readfirstlane(tid >> 6), lane = tid & 63, r32 = lane & 31, hi = lane >> 5;
    ATT_SRC();
    for (int d0 = 0; d0 < 8; ++d0) S.qr[d0] = load8(G.Q + (cur.qo + (unsigned)((wid * QBLK + r32) * LD + d0 * 16 + hi * 8)));
    DMA_K(G.K + cur.kvo, G.CB + cur.cbo, cur.jlo * KVBLK, 0); DMA_V(G.V + cur.kvo, cur.jlo * KVBLK, 0);
    VMW(); LBAR();
}
__device__ __forceinline__ void block(const Bases& G, const BlockRef& cur, const BlockRef& nxt, char* lds, LAS unsigned char* ldsa, Seam& S) {
    const int tid = threadIdx.x, wid = __builtin_amdgcn_readfirstlane(tid >> 6), lane = tid & 63, r32 = lane & 31, hi = lane >> 5;
    const int j_lo = cur.jlo, NT = (cur.P0 + QB - 1) / KVBLK + 1 - j_lo;
    const int qlo = cur.P0 + wid * QBLK, qm = qlo + r32 - 4 * hi;
    char* V_lds = lds; char* K_lds = lds + 2 * SHM_V; char* B_lds = lds + OFF_BIAS;
    float* ws = (float*)(lds + OFF_WS) + wid * 64; float* li_l = ws, * al_l = ws + 32;
    float m_reg = G.CB[cur.cbo + (unsigned)(cur.P0 + wid * QBLK + r32)], l_reg = 0; f32x16 o[4] = {};
    const int vb0 = (int)(uintptr_t)V_lds + v_rd_base(lane);
    const bf16* Kh = G.K + cur.kvo; const bf16* Vh = G.V + cur.kvo; const float* CBh = G.CB + cur.cbo;
    ATT_SRC();
#define RESC(a) do { if (__any((a) < 1.f)) { if (hi == 0) al_l[r32] = (a); asm volatile("s_waitcnt lgkmcnt(0)" ::: "memory");              \
                     for (int d_ = 0; d_ < 4; ++d_) for (int r = 0; r < 16; ++r) o[d_][r] *= al_l[crow(r, hi)]; } } while (0)
#define KBASE(t) ((j_lo + (t)) * KVBLK)
#define MASKT(P0_, P1_, t) do { const int kb_ = KBASE(t); if (kb_ + KVBLK - 1 > qlo) mask_tile(P0_, P1_, qm - kb_); } while (0)
    f32x16 pA0, pA1, pB0, pB1; float mnA, mnB, alA, alB; bf16x8 pa0, pa1, pa2, pa3;
    DMA_K(Kh, CBh, KBASE(1), 1); DMA_V(Vh, KBASE(1), 1);
    SBAR(); qkt<0>(pA0, pA1, K_lds, B_lds, r32, hi, S.qr);
    MASKT(pA0, pA1, 0); partialSM(pA0, pA1, m_reg, mnA, alA);
    VMW(); LBAR();
#define HALF_STEP(PX0, PX1, mnX, alX, PY0, PY1, alY, t, KB, VB, SB) do {                                                      \
        SBAR(); if ((t) + 1 < NT) { DMA_K(Kh, CBh, KBASE((t) + 1), SB); SBAR(); }                                            \
        qkt<KB>(PX0, PX1, K_lds, B_lds, r32, hi, S.qr);                                                                        \
        finishSM(PY0, PY1, alY, l_reg, pa0, pa1, pa2, pa3); SBAR();                                                           \
        pv_tile<VB>(o, vb0, pa0, pa1, pa2, pa3); MASKT(PX0, PX1, (t)); partialSM(PX0, PX1, m_reg, mnX, alX);                   \
        LBAR();                                                                                                               \
        if ((t) + 1 < NT) { DMA_V(Vh, KBASE((t) + 1), SB); }                                                                  \
        RESC(alX); VMWN(2); LBAR(); } while (0)
    for (int t = 1; t + 1 < NT; t += 2) {
        HALF_STEP(pB0, pB1, mnB, alB, pA0, pA1, alA, t, 1, 0, 0);
        HALF_STEP(pA0, pA1, mnA, alA, pB0, pB1, alB, t + 1, 0, 1, 1);
    }
    SBAR(); qkt<1>(pB0, pB1, K_lds, B_lds, r32, hi, S.qr); SBAR();
    DMA_K(G.K + nxt.kvo, G.CB + nxt.cbo, nxt.jlo * KVBLK, 0); SBAR();
#pragma unroll
    for (int d0 = 0; d0 < 8; ++d0) S.qr[d0] = load8(G.Q + (nxt.qo + (unsigned)((wid * QBLK + r32) * LD + d0 * 16 + hi * 8)));
    SBAR();
    finishSM(pA0, pA1, alA, l_reg, pa0, pa1, pa2, pa3); SBAR();
    pv_tile<0>(o, vb0, pa0, pa1, pa2, pa3);
    MASKT(pB0, pB1, NT - 1); partialSM(pB0, pB1, m_reg, mnB, alB);
    VMWN(10); LBAR();
    DMA_V(G.V + nxt.kvo, nxt.jlo * KVBLK, 0);
    RESC(alB);
    finishSM(pB0, pB1, alB, l_reg, pa0, pa1, pa2, pa3); SBAR(); pv_tile<1>(o, vb0, pa0, pa1, pa2, pa3);
    SBAR();
    if (hi == 0) li_l[r32] = l_reg; asm volatile("s_waitcnt lgkmcnt(0)" ::: "memory");
    float rli[16];
#pragma unroll
    for (int r = 0; r < 16; ++r) rli[r] = __builtin_amdgcn_rcpf(li_l[crow(r, hi)]);
    bf16* Ow = G.O + (cur.oo + (unsigned)(wid * QBLK * LDO));
#pragma unroll
    for (int r = 0; r < 16; ++r) { const int orow = crow(r, hi);
#pragma unroll
        for (int d0 = 0; d0 < 4; ++d0) { const float v = o[d0][r] * rli[r];
            const float vn = __shfl_xor(v, 1);
            if ((r32 & 1) == 0) *(unsigned*)(Ow + (unsigned)(orow * LDO + d0 * 32 + r32)) = cvtpk(v, vn); } }
    VMW(); LBAR();
#undef RESC
#undef KBASE
#undef MASKT
#undef HALF_STEP
}
#undef VMW
#undef VMWN
#undef LBAR
#undef ATT_SRC
#undef DMA_K
#undef DMA_V
#undef KSWZ
#undef SBAR
}
constexpr int NB = 8, SEQ = 4096, T = NB * SEQ, DM = 1024, NH = 8, HD = 128, INW = 7176, NZ = 7168;
constexpr int NE = 32, DE = 512;
constexpr float EPS = 1e-6f;
constexpr int PMAX = 73728;
constexpr int NWAVES = 8;
constexpr size_t MiB = 1u << 20;
constexpr size_t WS_CTL = 0, CTL_ZERO_BYTES = 64 * 1024;
constexpr size_t WS_RS1 = 1 * MiB, WS_RS2 = 1 * MiB + 256 * 1024;
constexpr size_t WS_LF = 1 * MiB + 512 * 1024;
constexpr size_t WS_CB = 2 * MiB + 512 * 1024;
constexpr size_t WS_TOK = 3 * MiB + 512 * 1024;
constexpr size_t WS_LISTS = 5 * MiB;
constexpr size_t WS_WRT = 9 * MiB;
constexpr size_t WS_SRS = 9 * MiB + 512 * 1024, WS_SW = 10 * MiB;
constexpr size_t WS_WIN = 16 * MiB;
constexpr size_t WS_WA = 30 * MiB, WS_WL = 32 * MiB, WS_WO = 34 * MiB;
constexpr size_t WS_WRG = 36 * MiB;
constexpr size_t WS_XB = 40 * MiB;
constexpr size_t WS_XR = 104 * MiB;
constexpr size_t WS_GG = 168 * MiB;
constexpr size_t WS_Q = 232 * MiB, WS_K = 296 * MiB, WS_V = 360 * MiB;
constexpr size_t WS_W13 = 424 * MiB;
constexpr size_t WS_W2 = 392 * MiB;
constexpr size_t WS_XG = 168 * MiB;
constexpr size_t WS_HB = 296 * MiB;
constexpr size_t WS_WIN8 = 488 * MiB;
constexpr unsigned SEG8_MASK = 0x7Cu;
__host__ __device__ constexpr int seg_row(int sg) { int r = 0; for (int t = 0; t < sg; ++t) if (((SEG8_MASK >> t) & 1u) == ((SEG8_MASK >> sg) & 1u)) ++r; return r; }
__host__ __device__ constexpr unsigned seg_map(bool f8) { unsigned m = 0; int j = 0; for (int t = 0; t < 7; ++t) if ((((SEG8_MASK >> t) & 1u) != 0u) == f8) { m |= (unsigned)t << (4 * j); ++j; } return m; }
__host__ __device__ constexpr int seg_cnt(bool f8) { int j = 0; for (int t = 0; t < 7; ++t) if ((((SEG8_MASK >> t) & 1u) != 0u) == f8) ++j; return j; }
constexpr size_t WS_X8P = 456 * MiB;
constexpr size_t WS_END = 512 * MiB;
static_assert(WS_XG + (size_t)PMAX * 1024 <= WS_K && WS_HB + (size_t)PMAX * 1024 <= WS_W2 && WS_W2 + 32u * 1024 * 512 * 2 <= WS_W13 && WS_W13 + 64 * MiB <= WS_END, "d_ws map");
constexpr int CW_TMO = 0, CW_CODE = 1, CW_BAR = 4096, CW_CNT = 8192, CW_NORM = 8448, CW_QCTR = 12288, CW_RDY = 14000;
constexpr int RING_OFF = 0, RING_BYTES = 131072;
constexpr int LDSCTL_OFF = RING_BYTES, MISC_OFF = LDSCTL_OFF + 320;
constexpr int TBL_OFF = RING_BYTES + 1024;
constexpr int TBL_PS = TBL_OFF, TBL_CN = TBL_OFF + 256, TBL_TE = TBL_OFF + 512;
constexpr int RG_TOT = RING_BYTES + 4096, RG_CAR = RG_TOT + 4096;
constexpr int LDS_BYTES = 147456;

#include <cmath>
using pg8::bf_lo; using pg8::bf_hi; using pg8::sigmoid_f;

struct Frame {
    LAS unsigned char* lds;
    int tid, lane, wave, vcu, G;
};
__device__ __forceinline__ float wave_sum(float v) {
#pragma unroll
    for (int o = 1; o < 64; o <<= 1) v += __shfl_xor(v, o);
    return v;
}
__device__ __forceinline__ void transpose_tile(const float* src, int ld, bf16* dst, int ldd, const float* kscale, LAS float* scr, int lane) {
    const int q = lane & 7, kr = lane >> 3;
    f32x4 v[8];
#pragma unroll
    for (int i = 0; i < 8; ++i) v[i] = __builtin_nontemporal_load((const f32x4*)(src + (size_t)(kr + 8 * i) * ld + 4 * q));
#pragma unroll
    for (int i = 0; i < 8; ++i) { const int kk = kr + 8 * i; const float sc = kscale ? kscale[kk] : 1.0f;
#pragma unroll
        for (int c = 0; c < 4; ++c) scr[kk * 33 + 4 * q + c] = v[i][c] * sc; }
    LDS_WAIT(); asm volatile("" ::: "memory");
    const int c = lane & 7;
#pragma unroll
    for (int j = 0; j < 4; ++j) { const int n = (lane >> 3) + 8 * j; const LAS float* s = scr + (8 * c) * 33 + n;
        v4u o; o.x = pk2(s[0 * 33], s[1 * 33]); o.y = pk2(s[2 * 33], s[3 * 33]); o.z = pk2(s[4 * 33], s[5 * 33]); o.w = pk2(s[6 * 33], s[7 * 33]);
        *(GAS v4u*)(dst + (size_t)n * ldd + 8 * c) = o; }
    LDS_WAIT(); asm volatile("" ::: "memory");
}

__device__ __forceinline__ void transpose_tile8(const float* src, int ld, unsigned char* dst, int ldd, const float* kscale, float scale, LAS float* scr, int lane) {
    const int q = lane & 7, kr = lane >> 3;
    f32x4 v[8];
#pragma unroll
    for (int i = 0; i < 8; ++i) v[i] = __builtin_nontemporal_load((const f32x4*)(src + (size_t)(kr + 8 * i) * ld + 4 * q));
#pragma unroll
    for (int i = 0; i < 8; ++i) { const int kk = kr + 8 * i; const float sc = kscale ? kscale[kk] * scale : scale;
#pragma unroll
        for (int c = 0; c < 4; ++c) scr[kk * 33 + 4 * q + c] = v[i][c] * sc; }
    LDS_WAIT(); asm volatile("" ::: "memory");
    const int c = lane & 3;
#pragma unroll
    for (int j = 0; j < 2; ++j) { const int n = (lane >> 2) + 16 * j; const LAS float* s = scr + (16 * c) * 33 + n;
        v4u o; o.x = pg8::pack4_fp8(s[0 * 33], s[1 * 33], s[2 * 33], s[3 * 33]); o.y = pg8::pack4_fp8(s[4 * 33], s[5 * 33], s[6 * 33], s[7 * 33]);
        o.z = pg8::pack4_fp8(s[8 * 33], s[9 * 33], s[10 * 33], s[11 * 33]); o.w = pg8::pack4_fp8(s[12 * 33], s[13 * 33], s[14 * 33], s[15 * 33]);
        *(GAS v4u*)(dst + (size_t)n * ldd + 16 * c) = o; }
    LDS_WAIT(); asm volatile("" ::: "memory");
}

struct P0Args { const float *x, *g_mix, *w_in, *w_rg_a, *w_rg_x, *b_forget, *w_lru_out, *w_attn_out, *w_out, *g_ffn, *w_rgrp, *w_rexp, *w_gate, *w_up;
                bf16 *Win, *Wl, *Wa, *Wo, *Wrg, *XB; unsigned char* W13; float *RS1, *LF, *WRT; unsigned char *Win8, *X8P; };
struct TItem { const float* src; int ld; unsigned char* dst; int ldd; const float* ks; float scale; int f8; };
__device__ __forceinline__ void titem_load(const TItem& t, f32x4 (&v)[8], float (&sc)[8], int lane) {
    const int q = lane & 7, kr = lane >> 3;
#pragma unroll
    for (int i = 0; i < 8; ++i) { v[i] = __builtin_nontemporal_load((const f32x4*)(t.src + (size_t)(kr + 8 * i) * t.ld + 4 * q)); sc[i] = t.ks ? t.ks[kr + 8 * i] * t.scale : t.scale; }
}
__device__ __forceinline__ void titem_finish(const TItem& t, const f32x4 (&v)[8], const float (&sc)[8], LAS float* scr, int lane) {
    const int q = lane & 7, kr = lane >> 3;
#pragma unroll
    for (int i = 0; i < 8; ++i) { const int kk = kr + 8 * i;
#pragma unroll
        for (int c = 0; c < 4; ++c) scr[kk * 33 + 4 * q + c] = v[i][c] * sc[i]; }
    LDS_WAIT(); asm volatile("" ::: "memory");
    if (t.f8) { const int c = lane & 3;
#pragma unroll
        for (int j = 0; j < 2; ++j) { const int n = (lane >> 2) + 16 * j; const LAS float* s = scr + (16 * c) * 33 + n;
            v4u o; o.x = pg8::pack4_fp8(s[0 * 33], s[1 * 33], s[2 * 33], s[3 * 33]); o.y = pg8::pack4_fp8(s[4 * 33], s[5 * 33], s[6 * 33], s[7 * 33]);
            o.z = pg8::pack4_fp8(s[8 * 33], s[9 * 33], s[10 * 33], s[11 * 33]); o.w = pg8::pack4_fp8(s[12 * 33], s[13 * 33], s[14 * 33], s[15 * 33]);
            *(GAS v4u*)(t.dst + (size_t)n * t.ldd + 16 * c) = o; } }
    else { const int c = lane & 7;
#pragma unroll
        for (int j = 0; j < 4; ++j) { const int n = (lane >> 3) + 8 * j; const LAS float* s = scr + (8 * c) * 33 + n;
            v4u o; o.x = pk2(s[0 * 33], s[1 * 33]); o.y = pk2(s[2 * 33], s[3 * 33]); o.z = pk2(s[4 * 33], s[5 * 33]); o.w = pk2(s[6 * 33], s[7 * 33]);
            *(GAS v4u*)(t.dst + ((size_t)n * t.ldd + 8 * c) * 2) = o; } }
    LDS_WAIT(); asm volatile("" ::: "memory");
}
constexpr int P0_I_IN = 16 * 224, P0_I_SQ = 16 * 32, P0_I_RG = 2 * 4 * 4 * 8, P0_I_EX = 2 * 8192, P0_NITEMS = P0_I_IN + 3 * P0_I_SQ + P0_I_RG + P0_I_EX;
__device__ __forceinline__ void p0_items(const Frame& F, const P0Args& a, const int first, const int last, const int stride, const int offset) {
    LAS float* scr = (LAS float*)(F.lds + RING_OFF + F.wave * 16384);
    const float* const p_wl = a.w_lru_out; const float* const p_wa = a.w_attn_out; const float* const p_wo = a.w_out; const float* const p_rga = a.w_rg_a; const float* const p_rgx = a.w_rg_x;
    bf16* const q_wl = a.Wl; bf16* const q_wa = a.Wa; bf16* const q_wo = a.Wo;
    constexpr int I_IN = P0_I_IN, I_SQ = P0_I_SQ, I_EX = P0_I_EX, NITEMS = P0_NITEMS;
    const float* const p_gate = a.w_gate; const float* const p_up = a.w_up; const float* const p_win = a.w_in; const float* const p_gmix = a.g_mix; const float* const p_gffn = a.g_ffn;
    bf16* const q_win = a.Win; bf16* const q_wrg = a.Wrg; unsigned char* const q_w13 = a.W13; unsigned char* const q_win8 = a.Win8;
#define P0_DECODE(it_, t_) do { int r = (it_); \
        if (r >= NITEMS - I_EX) { r -= NITEMS - I_EX;     \
            const int w = r >> 13, e = (r >> 8) & 31, kb = (r >> 4) & 15, nb = r & 15; const float* W = (w == 0 ? p_gate : p_up) + (size_t)e * DM * DE; \
            const int drow = e * 1024 + (nb >> 2) * 256 + (nb & 3) * 32 + (w == 1 ? 128 : 0); \
            t_.src = W + (size_t)(64 * kb) * DE + 32 * nb; t_.ld = DE; t_.dst = q_w13 + (size_t)drow * DM + 64 * kb; t_.ldd = DM; t_.ks = p_gffn + 64 * kb; t_.scale = pg8::W13_SCALE; t_.f8 = 1; } \
        else if (r < I_IN) { const int kb = r / 224, nb = r % 224, n0 = 32 * nb, sc_ = n0 < 5120 ? n0 : n0 + 8; \
            t_.src = p_win + (size_t)(64 * kb) * INW + sc_; t_.ld = INW; t_.ldd = DM; t_.ks = p_gmix + 64 * kb; \
            const int sg_ = n0 >> 10; int sr_ = 0; for (int t2 = 0; t2 < 7; ++t2) if (t2 < sg_ && (((SEG8_MASK >> t2) & 1u) == ((SEG8_MASK >> sg_) & 1u))) ++sr_;     \
            const int nr_ = sr_ * 1024 + (n0 & 1023); \
            if ((SEG8_MASK >> sg_) & 1u) { t_.dst = q_win8 + (size_t)nr_ * DM + 64 * kb; t_.scale = pg8::WIN_SCALE; t_.f8 = 1; }     \
            else { t_.dst = (unsigned char*)(q_win + (size_t)nr_ * DM + 64 * kb); t_.scale = 1.0f; t_.f8 = 0; } } \
        else if (r < I_IN + 3 * I_SQ) { r -= I_IN; const int w = r / I_SQ, q = r % I_SQ, kb = q / 32, nb = q % 32; const float* W = w == 0 ? p_wl : (w == 1 ? p_wa : p_wo); bf16* Wt = w == 0 ? q_wl : (w == 1 ? q_wa : q_wo); \
            t_.src = W + (size_t)(64 * kb) * DM + 32 * nb; t_.ld = DM; t_.dst = (unsigned char*)(Wt + (size_t)(32 * nb) * DM + 64 * kb); t_.ldd = DM; t_.ks = nullptr; t_.scale = 1.0f; t_.f8 = 0; } \
        else { r -= I_IN + 3 * I_SQ; const int gb = r / 32, q = r % 32, kb = q / 8, nb = q % 8; const float* W = (gb < 4 ? p_rga : p_rgx) + (size_t)(gb & 3) * 65536; \
            t_.src = W + (size_t)(64 * kb) * 256 + 32 * nb; t_.ld = 256; t_.dst = (unsigned char*)(q_wrg + (size_t)gb * 65536 + (size_t)(32 * nb) * 256 + 64 * kb); t_.ldd = 256; t_.ks = nullptr; t_.scale = -1.4426950408889634f; t_.f8 = 0; }     } while (0)
    {
        int it = first + offset; TItem cur; f32x4 va[8]; float sa[8];
        if (it < last) { P0_DECODE(it, cur); titem_load(cur, va, sa, F.lane); }
        while (it < last) {
            const int nx = it + stride; TItem nt = cur; f32x4 vb[8]; float sb[8];
            if (nx < last) { P0_DECODE(nx, nt); titem_load(nt, vb, sb, F.lane); }
            titem_finish(cur, va, sa, scr, F.lane);
            if (nx < last) { cur = nt;
#pragma unroll
                for (int i = 0; i < 8; ++i) { va[i] = vb[i]; sa[i] = sb[i]; } }
            it = nx;
        }
    }
#undef P0_DECODE
}
__device__ __forceinline__ void p0_prologue(const Frame& F, const P0Args& a, const int part  ) {
    const int gw = F.vcu * NWAVES + F.wave, NGW = F.G * NWAVES;
    if (part != 2) p0_items(F, a, 0, P0_NITEMS, NGW, gw);
    if (part == 1) return;
    for (int i = (F.vcu * NWAVES + F.wave) * 64 + F.lane; i < 64 * DM; i += NGW * 64) { const int n = i >> 10, k = i & 1023;
        float v = 0.f; if (n < 32) v = a.w_rexp[k * 32 + n]; else if (n < 36) v = a.w_rgrp[k * 4 + (n - 32)];
        a.WRT[i] = v * a.g_ffn[k]; }
    LAS float* wfl = (LAS float*)(F.lds + RING_OFF);
    __syncthreads();
    for (int k = F.tid; k < DM; k += NWAVES * 64) { const float g = a.g_mix[k];
        const f32x4 w0 = *(const f32x4*)(a.w_in + (size_t)k * INW + 5120), w1 = *(const f32x4*)(a.w_in + (size_t)k * INW + 5124);
        *(LAS f32x4*)(wfl + k * 8) = w0 * g; *(LAS f32x4*)(wfl + k * 8 + 4) = w1 * g; }
    __syncthreads();
    float wf[4][4][8];
#pragma unroll
    for (int j = 0; j < 4; ++j)
#pragma unroll
        for (int i = 0; i < 4; ++i) { const int k = 256 * j + 4 * F.lane + i; const f32x4 w0 = *(const LAS f32x4*)(wfl + k * 8), w1 = *(const LAS f32x4*)(wfl + k * 8 + 4);
#pragma unroll
            for (int h = 0; h < 4; ++h) { wf[j][i][h] = w0[h]; wf[j][i][4 + h] = w1[h]; } }
    const float bfg = a.b_forget[F.lane & 7];
    f32x4 vn[4];
    if (gw < T) { const GAS f32x4* xr0 = (const GAS f32x4*)(a.x + (size_t)gw * DM) + F.lane;
#pragma unroll
        for (int j = 0; j < 4; ++j) vn[j] = __builtin_nontemporal_load((const f32x4*)xr0 + 64 * j); }
    for (int m = gw; m < T; m += NGW) {
        f32x4 v[4]; float s = 0.f, d[8] = {0.f, 0.f, 0.f, 0.f, 0.f, 0.f, 0.f, 0.f};
#pragma unroll
        for (int j = 0; j < 4; ++j) v[j] = vn[j];
        if (m + NGW < T) { const GAS f32x4* xr1 = (const GAS f32x4*)(a.x + (size_t)(m + NGW) * DM) + F.lane;
#pragma unroll
            for (int j = 0; j < 4; ++j) vn[j] = __builtin_nontemporal_load((const f32x4*)xr1 + 64 * j); }
#pragma unroll
        for (int j = 0; j < 4; ++j) { s += (v[j].x * v[j].x + v[j].y * v[j].y) + (v[j].z * v[j].z + v[j].w * v[j].w);
#pragma unroll
            for (int i = 0; i < 4; ++i)
#pragma unroll
                for (int h = 0; h < 8; ++h) d[h] = fmaf(v[j][i], wf[j][i][h], d[h]); }
        s = wave_sum(s);
#pragma unroll
        for (int h = 0; h < 8; ++h) d[h] = wave_sum(d[h]);
        const float rs = 1.0f / sqrtf(s * (1.0f / DM) + EPS);
        GAS unsigned long long* o8 = (GAS unsigned long long*)(a.XB + (size_t)m * DM) + F.lane;
#pragma unroll
        for (int j = 0; j < 4; ++j) o8[64 * j] = (unsigned long long)pk2(v[j].x * rs, v[j].y * rs) | ((unsigned long long)pk2(v[j].z * rs, v[j].w * rs) << 32);
        { GAS unsigned* o4 = (GAS unsigned*)(a.X8P + (size_t)m * DM) + F.lane; const float r8 = rs * pg8::XS_SCALE;
#pragma unroll
          for (int j = 0; j < 4; ++j) o4[64 * j] = pg8::pack4_fp8(v[j].x * r8, v[j].y * r8, v[j].z * r8, v[j].w * r8); }
        if (F.lane < 8) { const int h = F.lane; float dh = d[0]; dh = h == 1 ? d[1] : dh; dh = h == 2 ? d[2] : dh; dh = h == 3 ? d[3] : dh; dh = h == 4 ? d[4] : dh; dh = h == 5 ? d[5] : dh; dh = h == 6 ? d[6] : dh; dh = h == 7 ? d[7] : dh;
            const float fl = dh * rs + bfg; a.LF[(size_t)m * 8 + h] = fminf(fl, 0.f) - log1pf(expf(-fabsf(fl))); }
    }
}
__device__ __forceinline__ void cumsum_bias(const Frame& F, const float* LF, float* CB) {
    LAS float* wt = (LAS float*)(F.lds + RING_OFF);
    for (int bh = blockIdx.x; bh < NB * NH; bh += F.G) {
        const int b = bh >> 3, h = bh & 7, s0 = F.tid * 8;
        float v[8], run = 0.f;
#pragma unroll
        for (int j = 0; j < 8; ++j) { run += LF[((size_t)(b * SEQ + s0 + j)) * 8 + h]; v[j] = run; }
        float inc = run;
#pragma unroll
        for (int o = 1; o < 64; o <<= 1) { const float t = __shfl_up(inc, o); if (F.lane >= o) inc += t; }
        if (F.lane == 63) wt[F.wave] = inc;
        __syncthreads();
        float pre = inc - run;
        for (int w = 0; w < F.wave; ++w) pre += wt[w];
#pragma unroll
        for (int j = 0; j < 8; ++j) CB[(size_t)bh * SEQ + s0 + j] = -(pre + v[j]) * 11.313708498984761f;
        __syncthreads();
    }
}
struct RgArgs { const bf16* XC; const bf16* GG; bf16* GO; const bf16* Wrg; const float *b_a, *b_x, *lam; };
__device__ __forceinline__ float bfx(const v4u& v, int i) { const unsigned w = i < 2 ? v.x : (i < 4 ? v.y : (i < 6 ? v.z : v.w)); return (i & 1) ? bf_hi(w) : bf_lo(w); }
__device__ __forceinline__ unsigned cvtpk_bf16(float lo, float hi) { unsigned r; asm volatile("v_cvt_pk_bf16_f32 %0, %1, %2" : "=v"(r) : "v"(lo), "v"(hi)); return r; }
__device__ __forceinline__ void conv_prepass(const Frame& F, const bf16* XR, bf16* XC, const float* conv_w, const float* conv_b) {
    const int gw = F.vcu * NWAVES + F.wave, NGW = F.G * NWAVES;
    for (int it = gw; it < (T / 16) * 2; it += NGW) {
        const int r0 = (it >> 1) * 16, c0 = (it & 1) * 512 + 8 * F.lane, tq = r0 & (SEQ - 1);
        float cw[4][8], cbv[8];
#pragma unroll
        for (int j = 0; j < 4; ++j) { const f32x4 w0 = *(const f32x4*)(conv_w + j * DM + c0), w1 = *(const f32x4*)(conv_w + j * DM + c0 + 4);
#pragma unroll
            for (int i = 0; i < 4; ++i) { cw[j][i] = w0[i]; cw[j][4 + i] = w1[i]; } }
        { const f32x4 w0 = *(const f32x4*)(conv_b + c0), w1 = *(const f32x4*)(conv_b + c0 + 4);
#pragma unroll
          for (int i = 0; i < 4; ++i) { cbv[i] = w0[i]; cbv[4 + i] = w1[i]; } }
        v4u raw[19];
#pragma unroll
        for (int i = 0; i < 19; ++i) { const int rr = (i < 3 && tq == 0) ? r0 : r0 - 3 + i; const v4u w = __builtin_nontemporal_load((const v4u*)(XR + ((unsigned)rr * DM + c0)));
            const bool z = i < 3 && tq == 0; raw[i].x = z ? 0u : w.x; raw[i].y = z ? 0u : w.y; raw[i].z = z ? 0u : w.z; raw[i].w = z ? 0u : w.w; }
#pragma unroll
        for (int r = 0; r < 16; ++r) { float y[8];
#pragma unroll
            for (int i = 0; i < 8; ++i) { float sacc = cbv[i];
#pragma unroll
                for (int j = 0; j < 4; ++j) sacc = fmaf(cw[j][i], bfx(raw[r + j], i), sacc);
                y[i] = sacc; }
            v4u o; o.x = cvtpk_bf16(y[0], y[1]); o.y = cvtpk_bf16(y[2], y[3]); o.z = cvtpk_bf16(y[4], y[5]); o.w = cvtpk_bf16(y[6], y[7]);
            *(GAS v4u*)(XC + ((unsigned)(r0 + r) * DM + c0)) = o; }
    }
}
__device__ __forceinline__ void rglru_unit(const Frame& F, const RgArgs& a, int unit) {
    const int tid = F.tid, lane = F.lane, wid = F.wave, fr = lane & 15, fq = lane >> 4, rq = wid >> 1, cp = wid & 1;
    const int b = unit >> 5, n = (unit >> 3) & 3, g = unit & 7, cbase = 256 * n, cown = cbase + 32 * g;
    LAS unsigned char* A_l = F.lds + RING_OFF;
    LAS float* tot = (LAS float*)(F.lds + RG_TOT);
    bf16x8 bfr[2][8];
#pragma unroll
    for (int gt = 0; gt < 2; ++gt)
#pragma unroll
        for (int ks = 0; ks < 8; ++ks) bfr[gt][ks] = *(const GAS bf16x8*)(a.Wrg + ((size_t)((gt * 4 + n) * 256 + 32 * g + 16 * cp + fr)) * 256 + 32 * ks + 8 * fq);
    const int cl = 16 * cp + fr, cch = cown + cl;
    const float ba = -1.4426950408889634f * a.b_a[cch], bx = -1.4426950408889634f * a.b_x[cch], sp8 = 8.0f * log1pf(expf(-a.lam[cch])) * 1.4426950408889634f;
    const unsigned goff = (unsigned)(b * SEQ + 32 * rq + 4 * fq) * DM + cch;
    const __amdgpu_buffer_rsrc_t GGr = __builtin_amdgcn_make_buffer_rsrc((void*)a.GG, 0, (int)((size_t)T * DM * 2), 0x00020000);
    const __amdgpu_buffer_rsrc_t GOr = __builtin_amdgcn_make_buffer_rsrc((void*)a.GO, 0, (int)((size_t)T * DM * 2), 0x00020000);
    const int gvo = (int)(goff * 2u);
    const unsigned dbase = ((unsigned)(b * SEQ + 16 * wid + (lane >> 5)) * DM + cbase) * 2u;
    const char* const XCb = (const char*)a.XC;
#define RG_DMA(ci_, buf_) do { _Pragma("unroll") for (int i_ = 0; i_ < 8; ++i_) { const unsigned so_ = dbase + (unsigned)(2 * i_) * (DM * 2u) + ((((unsigned)lane & 31u) ^ (unsigned)((2 * i_ + (lane >> 5)) & 15)) << 4); \
        __builtin_amdgcn_global_load_lds((const unsigned*)(XCb + so_ + (unsigned)(ci_) * (128u * DM * 2u)), (LAS unsigned*)(A_l + (buf_) * 65536 + (8 * wid + i_) * 1024), 16, 0, 0); } } while (0)
    float hc = 0.f;
    const int kx = 32 * g + cl;
#pragma unroll
    for (int gt = 0; gt < 2; ++gt)
#pragma unroll
        for (int ks = 0; ks < 8; ++ks) asm volatile("" : "+v"(bfr[gt][ks]));
    RG_DMA(0, 0); asm volatile("s_waitcnt vmcnt(0)" ::: "memory");
#define RG_CHUNK(BUF_, ci_) do { const int ci = (ci_); const int t0 = 128 * ci; LAS unsigned char* const Ab = A_l + (BUF_) * 65536; \
        __builtin_amdgcn_s_barrier(); asm volatile("" ::: "memory"); \
        unsigned short ggv[2][4]; \
        _Pragma("unroll") \
        for (int mt = 0; mt < 2; ++mt) \
        _Pragma("unroll") \
            for (int j = 0; j < 4; ++j) ggv[mt][j] = __builtin_amdgcn_raw_buffer_load_b16(GGr, gvo, (t0 + 16 * mt + j) * (DM * 2), 0); \
        if (ci + 1 < SEQ / 128) RG_DMA(ci + 1, BUF_ ^ 1); \
 \
        f32x4 acc[2][2]; \
        _Pragma("unroll") \
        for (int mt = 0; mt < 2; ++mt) { acc[mt][0] = (f32x4){ba, ba, ba, ba}; acc[mt][1] = (f32x4){bx, bx, bx, bx}; } \
        _Pragma("unroll") \
        for (int ks = 0; ks < 8; ++ks) { const int ch = 4 * ks + fq; \
        _Pragma("unroll") \
            for (int mt = 0; mt < 2; ++mt) { const int arow = 32 * rq + 16 * mt + fr; \
                const bf16x8 af = *(const LAS bf16x8*)(Ab + arow * 512 + ((ch ^ (arow & 15)) << 4)); \
                acc[mt][0] = __builtin_amdgcn_mfma_f32_16x16x32_bf16(af, bfr[0][ks], acc[mt][0], 0, 0, 0); \
                acc[mt][1] = __builtin_amdgcn_mfma_f32_16x16x32_bf16(af, bfr[1][ks], acc[mt][1], 0, 0, 0); } } \
 \
        float av[2][4], bv[2][4], sA[2], sB[2]; \
        _Pragma("unroll") \
        for (int mt = 0; mt < 2; ++mt) { float A = 1.f, Bv = 0.f; \
        _Pragma("unroll") \
            for (int j = 0; j < 4; ++j) { const int row = 32 * rq + 16 * mt + 4 * fq + j; \
                const unsigned short xb16 = *(const LAS unsigned short*)(Ab + row * 512 + ((((kx >> 3) ^ (row & 15))) << 4) + (kx & 7) * 2); \
                const float xc = __builtin_bit_cast(float, (unsigned)xb16 << 16); \
                const float r_ = __builtin_amdgcn_rcpf(1.0f + __builtin_amdgcn_exp2f(acc[mt][0][j])), i_ = __builtin_amdgcn_rcpf(1.0f + __builtin_amdgcn_exp2f(acc[mt][1][j])); \
                const float aa = __builtin_amdgcn_exp2f(-sp8 * r_); \
                const float mult = __builtin_amdgcn_sqrtf(fmaxf(fmaf(-aa, aa, 1.0f), 0.f)); \
                av[mt][j] = aa; bv[mt][j] = mult * i_ * xc; \
                Bv = fmaf(aa, Bv, bv[mt][j]); A *= aa; } \
            sA[mt] = A; sB[mt] = Bv; } \
 \
        float eA[2], eB[2], tA[2], tB[2]; \
        _Pragma("unroll") \
        for (int mt = 0; mt < 2; ++mt) { float A = sA[mt], Bv = sB[mt]; \
            { const float pA = __shfl_up(A, 16), pB = __shfl_up(Bv, 16); if (fq >= 1) { Bv = fmaf(A, pB, Bv); A *= pA; } } \
            { const float pA = __shfl_up(A, 32), pB = __shfl_up(Bv, 32); if (fq >= 2) { Bv = fmaf(A, pB, Bv); A *= pA; } } \
            const float xA = __shfl_up(A, 16), xB = __shfl_up(Bv, 16); eA[mt] = fq >= 1 ? xA : 1.f; eB[mt] = fq >= 1 ? xB : 0.f; \
            tA[mt] = __shfl(A, 48 + fr); tB[mt] = __shfl(Bv, 48 + fr); } \
        const float wA = tA[0] * tA[1], wB = fmaf(tA[1], tB[0], tB[1]); \
        if (fq == 0) { tot[(rq * 32 + cl) * 2] = wA; tot[(rq * 32 + cl) * 2 + 1] = wB; } \
        asm volatile("s_waitcnt lgkmcnt(0)" ::: "memory"); __builtin_amdgcn_s_barrier(); asm volatile("" ::: "memory"); \
        float hin = hc, hnew = hc; \
        _Pragma("unroll") \
        for (int q = 0; q < 4; ++q) { const float qA = tot[(q * 32 + cl) * 2], qB = tot[(q * 32 + cl) * 2 + 1]; hnew = fmaf(qA, hnew, qB); if (q < rq) hin = hnew; } \
        hc = hnew; \
        _Pragma("unroll") \
        for (int mt = 0; mt < 2; ++mt) { float h = mt == 0 ? hin : fmaf(tA[0], hin, tB[0]); \
            h = fmaf(eA[mt], h, eB[mt]); \
        _Pragma("unroll") \
            for (int j = 0; j < 4; ++j) { h = fmaf(av[mt][j], h, bv[mt][j]); \
                const float gv = __builtin_bit_cast(float, (unsigned)ggv[mt][j] << 16); \
                __builtin_amdgcn_raw_buffer_store_b16((unsigned short)cvtpk_bf16(h * gv, 0.f), GOr, gvo, (t0 + 16 * mt + j) * (DM * 2), 0); } } \
        asm volatile("s_waitcnt lgkmcnt(0)" ::: "memory"); \
        asm volatile("s_waitcnt vmcnt(8)" ::: "memory"); \
    } while (0)
    for (int cc = 0; cc < SEQ / 128; cc += 2) { RG_CHUNK(0, cc); RG_CHUNK(1, cc + 1); }
#undef RG_CHUNK
#undef RG_DMA
    asm volatile("s_waitcnt vmcnt(0) lgkmcnt(0)" ::: "memory"); __builtin_amdgcn_s_barrier(); asm volatile("" ::: "memory");
}
constexpr float SKIP_LOG2 = 40.0f;
__device__ __forceinline__ int attn_jlo(const Frame& F, const float* CB, const unsigned* NORM, int bh, int qb) {
    float qs = 0.f, ks = 0.f;
#pragma unroll
    for (int w = 0; w < 4; ++w) { qs += __uint_as_float(NORM[(bh) * 4 + w]); ks += __uint_as_float(NORM[(64 + bh) * 4 + w]); }
    constexpr float C2 = 1.4426950408889634f * 0.08838834764831845f;
    const float th = SKIP_LOG2 + 2.0f * 1.02f * sqrtf(qs * ks) * C2 + 4.0f;
    const float ref = CB[(size_t)bh * SEQ + qb * 256], v = CB[(size_t)bh * SEQ + 64 * F.lane + 63];
    const unsigned long long m = __ballot(F.lane < 4 * qb && (ref - v) * C2 > th);
    int j = __builtin_popcountll(m); if (m != ((j >= 64) ? ~0ull : ((1ull << j) - 1ull))) j = 0;
    return j & ~1;
}
__device__ __forceinline__ fattn::BlockRef attn_ref(int bh, int qb, int jlo) {
    const int b = bh >> 3, h = bh & 7;
    fattn::BlockRef r; r.qo = ((unsigned)bh * SEQ + (unsigned)qb * 256u) * HD; r.oo = ((unsigned)b * SEQ + (unsigned)qb * 256u) * DM + h * HD; r.kvo = (unsigned)bh * SEQ * HD; r.cbo = (unsigned)bh * SEQ; r.P0 = qb * 256; r.jlo = jlo; return r;
}
__device__ __forceinline__ void attn_phase(const Frame& F, char* lds, const bf16* Qb, bf16* Ob, const bf16* Kb, const bf16* Vb, const float* CB, const int* JLO, gu32* QCTR, const int probe = 0) {
#define ATT_JLO(bh_, qb_) (probe == 1 ? 4 * (qb_) : probe == 2 ? 0 : __builtin_amdgcn_readfirstlane(JLO[(bh_) * 16 + (qb_)]))
    constexpr int NBLK = 128;
    const int M = F.G >> 3; if ((F.G & 7) || M > 64 || M < 1) return;
    const int x = F.vcu / M, r = F.vcu % M;
    volatile LAS int* tk_l = (volatile LAS int*)(F.lds + MISC_OFF + 64);
    gu32* qc = QCTR + 64 * x;
    const fattn::Bases G{Qb, Ob, Kb, Vb, CB}; LAS unsigned char* const ldsa = F.lds + RING_OFF;
#define ATT_DEC(k_, bh_, qb_) do { const int i_ = (k_) & 7; bh_ = (i_ < 4 ? 4 * x + i_ : 32 + 4 * x + (i_ - 4)); qb_ = 15 - ((k_) >> 3); } while (0)
    int bh, qb; ATT_DEC(r, bh, qb);
    fattn::BlockRef cur = attn_ref(bh, qb, ATT_JLO(bh, qb));
    ATT_DEC(r + M, bh, qb);
    fattn::BlockRef nxt = attn_ref(bh, qb, ATT_JLO(bh, qb)); bool nxt_ok = (r + M) < NBLK;
    fattn::Seam S;
    fattn::prime(G, cur, lds, ldsa, S);
    bool more = true;
    for (;;) {
        unsigned tkt = 0u;
        if (more && F.tid == 0) tkt = __hip_atomic_fetch_add(qc, 1u, __ATOMIC_RELAXED, __HIP_MEMORY_SCOPE_AGENT);
        const bool last = !nxt_ok;
        fattn::block(G, cur, last ? cur : nxt, lds, ldsa, S);
        if (last) break;
        if (F.tid == 0) tk_l[0] = more ? (int)tkt + 2 * M : NBLK;
        __syncthreads();
        const int k2 = __builtin_amdgcn_readfirstlane(tk_l[0]);
        __syncthreads();
        cur = nxt;
        if (k2 < NBLK) { ATT_DEC(k2, bh, qb); nxt = attn_ref(bh, qb, ATT_JLO(bh, qb)); nxt_ok = true; } else { nxt_ok = false; more = false; }
    }
#undef ATT_DEC
#undef ATT_JLO
}
typedef float f32x16 __attribute__((ext_vector_type(16)));
struct P5Args { const float *X, *WRT, *b_rgrp, *b_rexp, *w_down; const bf16* DL; bf16* X1B; unsigned char *X8, *W2; float* RS2; int* LISTS; unsigned* TOK; gu32* CNT; };
__device__ __forceinline__ void p5_route(const Frame& F, const P5Args& a) {
    const int tid = F.tid, lane = F.lane, wid = F.wave, i16 = lane & 15, h4 = lane >> 4;
    constexpr int LDA = 132;
    LAS float* A_l = (LAS float*)(F.lds + RING_OFF) + wid * 16 * LDA;
    LAS float* B_l = (LAS float*)(F.lds + RING_OFF + 67584);
    LAS float* LG = (LAS float*)(F.lds + RING_OFF + 94208);
    LAS float* rs_l = (LAS float*)(F.lds + RING_OFF + 113664);
    LAS int* hist = (LAS int*)(F.lds + RING_OFF + 114176);
    LAS int* base_l = (LAS int*)(F.lds + RING_OFF + 114432);
    {
        LAS float* scr = (LAS float*)(F.lds + RING_OFF + wid * 8704);
        const int gw = F.vcu * NWAVES + wid, NGW = F.G * NWAVES;
        for (int it = gw; it < 8192; it += NGW) { const int e = it >> 8, kb = (it >> 5) & 7, nb = it & 31; const float* W = a.w_down + (size_t)e * DE * DM;
            transpose_tile8(W + (size_t)(64 * kb) * DM + 32 * nb, DM, a.W2 + (size_t)(e * 1024 + 32 * nb) * DE + 64 * kb, DE, nullptr, pg8::W2_SCALE, scr, lane); }
    }
    __syncthreads();
    for (int rb = blockIdx.x; rb < T / 128; rb += F.G) {
        const int R0 = rb * 128;
        if (tid < 32) hist[tid] = 0;
        const int ar = lane >> 5, ac = 4 * (lane & 31);
        const size_t xo = (size_t)(R0 + 16 * wid + ar) * DM + ac; const float* xsrc = a.X + xo; const bf16* dsrc = a.DL + xo; unsigned char* xdst = a.X8 + xo; bf16* bdst = a.X1B + xo;
        f32x4 areg[8], breg[3]; unsigned long long dreg[8];
#define P5_LOAD(kc_) do { _Pragma("unroll") for (int i_ = 0; i_ < 8; ++i_) { areg[i_] = __builtin_nontemporal_load((const f32x4*)(xsrc + (size_t)(2 * i_) * DM + (kc_) * 128)); dreg[i_] = __builtin_nontemporal_load((const unsigned long long*)(dsrc + (size_t)(2 * i_) * DM + (kc_) * 128)); } \
        _Pragma("unroll") for (int q_ = 0; q_ < 3; ++q_) { const int idx_ = tid + 512 * q_; breg[q_] = *(const f32x4*)(a.WRT + (size_t)(idx_ >> 5) * DM + (kc_) * 128 + 4 * (idx_ & 31)); } } while (0)
        P5_LOAD(0);
        f32x4 acc[3] = {{0.f, 0.f, 0.f, 0.f}, {0.f, 0.f, 0.f, 0.f}, {0.f, 0.f, 0.f, 0.f}}; float ss = 0.f;
        for (int kc = 0; kc < 8; ++kc) {
#pragma unroll
            for (int i = 0; i < 8; ++i) { const unsigned dl = (unsigned)dreg[i], dh = (unsigned)(dreg[i] >> 32);
                areg[i][0] += bf_lo(dl); areg[i][1] += bf_hi(dl); areg[i][2] += bf_lo(dh); areg[i][3] += bf_hi(dh);
                *(unsigned*)(xdst + (size_t)(2 * i) * DM + kc * 128) = pg8::pack4_fp8(areg[i][0], areg[i][1], areg[i][2], areg[i][3]);
                *(unsigned long long*)(bdst + (size_t)(2 * i) * DM + kc * 128) = (unsigned long long)pg8::cvt_pk_bf16(areg[i][0], areg[i][1]) | ((unsigned long long)pg8::cvt_pk_bf16(areg[i][2], areg[i][3]) << 32);
                *(LAS f32x4*)(A_l + (2 * i + ar) * LDA + ac) = areg[i]; }
#pragma unroll
            for (int q = 0; q < 3; ++q) { const int idx = tid + 512 * q; *(LAS f32x4*)(B_l + (idx >> 5) * LDA + 4 * (idx & 31)) = breg[q]; }
            __syncthreads();
            if (kc + 1 < 8) P5_LOAD(kc + 1);
#pragma unroll
            for (int jj = 0; jj < 8; ++jj) {
                const f32x4 af = *(const LAS f32x4*)(A_l + i16 * LDA + 16 * jj + 4 * h4);
                f32x4 bfv[3];
#pragma unroll
                for (int nt = 0; nt < 3; ++nt) bfv[nt] = *(const LAS f32x4*)(B_l + (16 * nt + i16) * LDA + 16 * jj + 4 * h4);
                ss += (af[0] * af[0] + af[1] * af[1]) + (af[2] * af[2] + af[3] * af[3]);
#pragma unroll
                for (int s = 0; s < 4; ++s)
#pragma unroll
                    for (int nt = 0; nt < 3; ++nt) acc[nt] = __builtin_amdgcn_mfma_f32_16x16x4f32(af[s], bfv[nt][s], acc[nt], 0, 0, 0);
            }
            __syncthreads();
        }
#undef P5_LOAD
        ss += __shfl_xor(ss, 16); ss += __shfl_xor(ss, 32);
        const float rs = 1.0f / sqrtf(ss * (1.0f / DM) + EPS);
        if (h4 == 0) { a.RS2[R0 + 16 * wid + i16] = rs; rs_l[16 * wid + i16] = rs; }
#pragma unroll
        for (int r = 0; r < 4; ++r) { const int rl = 16 * wid + 4 * h4 + r; LG[rl * 37 + i16] = acc[0][r]; LG[rl * 37 + 16 + i16] = acc[1][r]; if (i16 < 4) LG[rl * 37 + 32 + i16] = acc[2][r]; }
        __syncthreads();
        int e0 = 0, e1 = 0, k0 = 0, k1 = 0; float w0 = 0.f, w1 = 0.f;
        if (tid < 128) {
            const float rsv = rs_l[tid]; const LAS float* lg = LG + tid * 37;
            float gl[4];
#pragma unroll
            for (int q = 0; q < 4; ++q) gl[q] = lg[32 + q] * rsv + a.b_rgrp[q];
            int gs = 0; float gm = gl[0];
#pragma unroll
            for (int q = 1; q < 4; ++q) if (gl[q] > gm) { gm = gl[q]; gs = q; }
            float den = 0.f;
#pragma unroll
            for (int q = 0; q < 4; ++q) den += expf(gl[q] - gm);
            const float pg = 1.0f / den;
            float el[8];
#pragma unroll
            for (int q = 0; q < 8; ++q) el[q] = lg[8 * gs + q] * rsv + a.b_rexp[8 * gs + q];
            int i0 = 0; float v0 = el[0];
#pragma unroll
            for (int q = 1; q < 8; ++q) if (el[q] > v0) { v0 = el[q]; i0 = q; }
            int i1 = -1; float v1 = -INFINITY;
#pragma unroll
            for (int q = 0; q < 8; ++q) if (q != i0 && el[q] > v1) { v1 = el[q]; i1 = q; }
            const float ex = expf(v1 - v0);
            w0 = pg / (1.0f + ex); w1 = pg * ex / (1.0f + ex);
            e0 = 8 * gs + i0; e1 = 8 * gs + i1;
            k0 = atomicAdd((int*)(hist + e0), 1); k1 = atomicAdd((int*)(hist + e1), 1);
        }
        __syncthreads();
        if (tid < 32) base_l[tid] = (int)__hip_atomic_fetch_add(a.CNT + tid, (unsigned)hist[tid], __ATOMIC_RELAXED, __HIP_MEMORY_SCOPE_AGENT);
        __syncthreads();
        if (tid < 128) { const int tok = R0 + tid, s0 = base_l[e0] + k0, s1 = base_l[e1] + k1;
            a.LISTS[(size_t)e0 * T + s0] = tok; a.LISTS[(size_t)e1 * T + s1] = tok;
            v4u i0v = {(unsigned)e0, (unsigned)s0, (unsigned)e1, (unsigned)s1}, i1v = {__float_as_uint(w0), __float_as_uint(w1), 0u, 0u};
            *(GAS v4u*)(a.TOK + (size_t)tok * 8) = i0v; *(GAS v4u*)(a.TOK + (size_t)tok * 8 + 4) = i1v; }
        __syncthreads();
    }
}
__device__ __forceinline__ void build_tables(const Frame& F, const gu32* CNT) {
    LAS int* ps = (LAS int*)(F.lds + TBL_PS); LAS int* cn = (LAS int*)(F.lds + TBL_CN); LAS int* te = (LAS int*)(F.lds + TBL_TE);
    __syncthreads();
    if (F.tid < 32) { int c = (int)__hip_atomic_load(CNT + F.tid, __ATOMIC_RELAXED, __HIP_MEMORY_SCOPE_AGENT); c = c < 0 ? 0 : (c > T ? T : c); cn[F.tid] = c; }
    __syncthreads();
    if (F.tid == 0) { int run = 0; for (int e = 0; e < 32; ++e) { ps[e] = run; run += (cn[e] + 255) & ~255; } if (run > PMAX) run = PMAX; ps[32] = run; }
    __syncthreads();
    if (F.tid < 288) { const int p = F.tid * 256; int e = 0; for (int q = 1; q < 32; ++q) if (p >= ps[q]) e = q; te[F.tid] = e; }
    __syncthreads();
}
template <class Ord> __device__ __forceinline__ void build_rowtab(const Frame& F, const Ord& S, const int* LISTS, const float* RS2, LAS int* rowtab) {
    const LAS int* ps = (const LAS int*)(F.lds + TBL_PS); const LAS int* cn = (const LAS int*)(F.lds + TBL_CN); const LAS int* te = (const LAS int*)(F.lds + TBL_TE);
    pg8::Unit u;
    for (int ui = 0; ui < 6 && S.next(ui, u); ++ui)
        if (F.tid < 256) { const int p = u.pm * 256 + F.tid, e = te[u.pm], local = p - ps[e]; const int tok = local < cn[e] ? LISTS[(size_t)e * T + local] : 0; rowtab[ui * 256 + F.tid] = tok; ((LAS float*)rowtab)[(6 + ui) * 256 + F.tid] = RS2[tok]; }
    __syncthreads();
}
__device__ __forceinline__ float fp8_f32(unsigned w, int i) { return i == 0 ? __builtin_amdgcn_cvt_f32_fp8(w, 0) : (i == 1 ? __builtin_amdgcn_cvt_f32_fp8(w, 1) : (i == 2 ? __builtin_amdgcn_cvt_f32_fp8(w, 2) : __builtin_amdgcn_cvt_f32_fp8(w, 3))); }
__device__ __forceinline__ void p9_final(const Frame& F, const bf16* X1B, float* OUT, const unsigned char* Y, const unsigned* TOK, const float* g_final) {
    const LAS int* ps = (const LAS int*)(F.lds + TBL_PS);
    const int gw = F.vcu * NWAVES + F.wave, NGW = F.G * NWAVES;
    f32x4 gf[4];
#pragma unroll
    for (int j = 0; j < 4; ++j) gf[j] = *((const f32x4*)g_final + F.lane + 64 * j);
    constexpr float YS = 1.0f / (pg8::HB_SCALE * pg8::W2_SCALE * pg8::Y_SCALE);
    v4u ia_n = {0u, 0u, 0u, 0u}, ib_n = {0u, 0u, 0u, 0u}, ia_c = ia_n, ib_c = ib_n; unsigned long long xw_n[4]; unsigned ya_n[4], yb_n[4];
#define P9_TOK(m_, ia_, ib_) do { ia_ = *(const GAS v4u*)(TOK + (size_t)(m_) * 8); ib_ = *(const GAS v4u*)(TOK + (size_t)(m_) * 8 + 4); } while (0)
#define P9_ROW(m_, ia_) do { const size_t p0_ = (size_t)(ps[(int)(ia_.x & 31u)] + (int)ia_.y), p1_ = (size_t)(ps[(int)(ia_.z & 31u)] + (int)ia_.w); \
        const GAS unsigned long long* xr_ = (const GAS unsigned long long*)(X1B + (size_t)(m_) * DM) + F.lane; \
        const GAS unsigned* y0_ = (const GAS unsigned*)(Y + p0_ * DM) + F.lane; const GAS unsigned* y1_ = (const GAS unsigned*)(Y + p1_ * DM) + F.lane; \
        _Pragma("unroll") for (int j = 0; j < 4; ++j) { xw_n[j] = __builtin_nontemporal_load((const unsigned long long*)xr_ + 64 * j); ya_n[j] = __builtin_nontemporal_load((const unsigned*)y0_ + 64 * j); yb_n[j] = __builtin_nontemporal_load((const unsigned*)y1_ + 64 * j); } } while (0)
    if (gw < T) { P9_TOK(gw, ia_c, ib_c); P9_ROW(gw, ia_c); if (gw + NGW < T) P9_TOK(gw + NGW, ia_n, ib_n); }
    for (int m = gw; m < T; m += NGW) {
        const float w0 = __uint_as_float(ib_c.x) * YS, w1 = __uint_as_float(ib_c.y) * YS;
        unsigned long long xw[4]; unsigned ya[4], yb[4];
#pragma unroll
        for (int j = 0; j < 4; ++j) { xw[j] = xw_n[j]; ya[j] = ya_n[j]; yb[j] = yb_n[j]; }
        if (m + NGW < T) { ia_c = ia_n; ib_c = ib_n; P9_ROW(m + NGW, ia_c); if (m + 2 * NGW < T) P9_TOK(m + 2 * NGW, ia_n, ib_n); }
        GAS f32x4* orow = (GAS f32x4*)(OUT + (size_t)m * DM) + F.lane;
        f32x4 v[4]; float s = 0.f;
#pragma unroll
        for (int j = 0; j < 4; ++j) { v[j] = (f32x4){bf_lo((unsigned)xw[j]), bf_hi((unsigned)xw[j]), bf_lo((unsigned)(xw[j] >> 32)), bf_hi((unsigned)(xw[j] >> 32))}; const unsigned a = ya[j], b = yb[j];
            v[j].x += w0 * fp8_f32(a, 0) + w1 * fp8_f32(b, 0); v[j].y += w0 * fp8_f32(a, 1) + w1 * fp8_f32(b, 1);
            v[j].z += w0 * fp8_f32(a, 2) + w1 * fp8_f32(b, 2); v[j].w += w0 * fp8_f32(a, 3) + w1 * fp8_f32(b, 3);
            s += (v[j].x * v[j].x + v[j].y * v[j].y) + (v[j].z * v[j].z + v[j].w * v[j].w); }
        s = wave_sum(s);
        const float rs = 1.0f / sqrtf(s * (1.0f / DM) + EPS);
#pragma unroll
        for (int j = 0; j < 4; ++j) orow[64 * j] = v[j] * rs * gf[j];
    }
#undef P9_TOK
#undef P9_ROW
}

constexpr int N_PHASES = 10;
#ifndef DUP_TRIVIAL
#define DUP_TRIVIAL 0
#endif
#ifndef P8_HOOK
#define P8_HOOK 3
#endif
#ifndef DUP_PHASE
#define DUP_PHASE -1
#endif
typedef __attribute__((address_space(4))) const unsigned char* karg_ptr;
__device__ __forceinline__ const float* arg_in(int k) { karg_ptr base = (karg_ptr)__builtin_amdgcn_kernarg_segment_ptr(); const unsigned long long v = *(const unsigned long long volatile __attribute__((address_space(4)))*)(base + 8 * k); return (const float*)(const GAS float*)v; }
struct Args { const float* in[23]; float* out; unsigned char* ws; int ph_lo, ph_hi, mode, pad; };
__global__ void __launch_bounds__(NWAVES * 64, 2) fwd_kernel(Args args) {
    extern __shared__ __attribute__((aligned(16))) unsigned char lds[];
    Frame F;
    F.lds = (LAS unsigned char*)lds;
    F.wave = __builtin_amdgcn_readfirstlane((int)threadIdx.x >> 6); F.lane = pg8::lane_now(); F.tid = F.wave * 64 + F.lane;
    F.G = gridDim.x; { const int bx = blockIdx.x; F.vcu = (F.G % 8 == 0) ? (bx % 8) * (F.G / 8) + bx / 8 : bx; }
    unsigned char* ws = args.ws;
    gu32* ctl = (gu32*)(ws + WS_CTL);
    volatile LAS unsigned* MISC = (volatile LAS unsigned*)(F.lds + MISC_OFF);
    for (int u = F.tid; u < (LDS_BYTES - LDSCTL_OFF) / 4; u += NWAVES * 64) ((LAS unsigned*)(F.lds + LDSCTL_OFF))[u] = 0u;
    __syncthreads();
#if MK_ONE_LAUNCH
    XcdBarrier bar = xcd_barrier_post((unsigned*)(ctl + CW_BAR), MISC + 8);
#define GRID_BAR() xcd_barrier(bar)
#else
#define GRID_BAR() do { } while (0)
#endif
    const int lo = args.ph_lo, hi = args.ph_hi;
#ifndef PH_MASK
#define PH_MASK 0x3ff
#endif
#define IN(k) (((PH_MASK >> (k)) & 1) && lo <= (k) && (k) < hi)
#define BOTH(k) (IN(k) && IN((k) + 1))
    float* out = args.out;
    bf16* Win = (bf16*)(ws + WS_WIN); bf16* Wl = (bf16*)(ws + WS_WL); bf16* Wa = (bf16*)(ws + WS_WA); bf16* Wo = (bf16*)(ws + WS_WO); bf16* Wrg = (bf16*)(ws + WS_WRG);
    bf16* XB = (bf16*)(ws + WS_XB); bf16* XR = (bf16*)(ws + WS_XR); bf16* GG = (bf16*)(ws + WS_GG); bf16* Qb = (bf16*)(ws + WS_Q); bf16* Kb = (bf16*)(ws + WS_K); bf16* Vb = (bf16*)(ws + WS_V);
    bf16* SL = (bf16*)out; bf16* SA = (bf16*)out + pg8::SEGE;
    float* RS1 = (float*)(ws + WS_RS1); float* RS2 = (float*)(ws + WS_RS2); float* LF = (float*)(ws + WS_LF); float* CB = (float*)(ws + WS_CB);
    unsigned* TOK = (unsigned*)(ws + WS_TOK); int* LISTS = (int*)(ws + WS_LISTS); float* WRT = (float*)(ws + WS_WRT); int* JLO = (int*)(ws + WS_SRS);
    unsigned char* W13 = ws + WS_W13; unsigned char* W2 = ws + WS_W2; bf16* XG = (bf16*)(ws + WS_XG); unsigned char* HB = ws + WS_HB; unsigned char* X8 = ws + WS_XB;
    gu32* CNT = ctl + CW_CNT;

    if (IN(0)) { F.lane = pg8::lane_now(); F.tid = F.wave * 64 + F.lane;
        P0Args a{arg_in(0), arg_in(1), arg_in(2), arg_in(5), arg_in(7), arg_in(10), arg_in(11), arg_in(12), arg_in(13), arg_in(14), arg_in(15), arg_in(17), arg_in(19), arg_in(20), Win, Wl, Wa, Wo, Wrg, XB, W13, RS1, LF, WRT, ws + WS_WIN8, ws + WS_X8P};
        p0_prologue(F, a, DUP_PHASE == 0 ? args.mode : 0);
        if (BOTH(0)) GRID_BAR();
    }
    if (IN(1)) { F.lane = pg8::lane_now(); F.tid = F.wave * 64 + F.lane;
        cumsum_bias(F, LF, CB);
        { constexpr int NB16 = seg_cnt(false) * 1024;
          pg8::Gemm g{XB, Win, T, NB16, DM}; pg8::StaticOrder S; S.init(T, NB16, F.G, (int)blockIdx.x);
          pg8::EpiZ E{XR, SL, RS1, (unsigned*)(ctl + CW_NORM), args.mode, seg_map(false), 1.0f};
          pg8::gemm_phase<pg8::EpiZ, pg8::StaticOrder, true, true>(F.lds + RING_OFF, g, S, E, F.wave); }
        __syncthreads();
        { constexpr int NF8 = seg_cnt(true) * 1024;
          pg8::Gemm g{(const bf16*)(ws + WS_X8P), (const bf16*)(ws + WS_WIN8), T, NF8, DM / 2}; pg8::StaticOrder S; S.init(T, NF8, F.G, (int)blockIdx.x);
          pg8::EpiZ E{XR, SL, RS1, (unsigned*)(ctl + CW_NORM), args.mode, seg_map(true), 1.0f / (pg8::XS_SCALE * pg8::WIN_SCALE)};
          pg8::gemm_phase<pg8::EpiZ, pg8::StaticOrder, true, true, true>(F.lds + RING_OFF, g, S, E, F.wave); }
        if (BOTH(1)) GRID_BAR();
    }
    if (IN(2)) { F.lane = pg8::lane_now(); F.tid = F.wave * 64 + F.lane;
        { const int gw = F.vcu * NWAVES + F.wave; if (gw < NB * NH * 16) { const int j = attn_jlo(F, CB, (const unsigned*)(ctl + CW_NORM), gw >> 4, gw & 15); if (F.lane == 0) JLO[gw] = j; } }
        conv_prepass(F, XR, XB, arg_in(3), arg_in(4));
        if (BOTH(2)) GRID_BAR();
    }
    if (IN(3)) { F.lane = pg8::lane_now(); F.tid = F.wave * 64 + F.lane;
        RgArgs ra{XB, GG, GG, Wrg, arg_in(6), arg_in(8), arg_in(9)};
#if DUP_PHASE >= 20
        const int mode = args.mode;
#else
        constexpr int mode = 0;
#endif
        if (mode < 2) { ra.GO = mode == 1 ? XR : GG; for (int u = F.vcu; u < 256; u += F.G) rglru_unit(F, ra, u); }
        if (mode != 1) attn_phase(F, (char*)lds + RING_OFF, Qb, XR, Kb, Vb, CB, JLO, ctl + CW_QCTR + (mode >= 2 ? 1024 : 0), mode >= 3 ? mode - 2 : 0);
        if (BOTH(3)) GRID_BAR();
    }
    if (IN(4)) { { F.lane = pg8::lane_now(); F.tid = F.wave * 64 + F.lane;
        static_assert(WS_GG - WS_XR == (size_t)128 * 256 * DM * 2 && WS_WL - WS_WA == (size_t)4 * 256 * DM * 2, "TwoGemmOrder: hg follows o by 128 row tiles, Wl follows Wa by 4 column tiles");
        pg8::Gemm g{XR, Wa, T, DM, DM}; pg8::TwoGemmOrder S; S.init(T, DM, F.G, (int)blockIdx.x);
        pg8::EpiGate2 E{SA, SL, XB};
        pg8::gemm_phase<pg8::EpiGate2, pg8::TwoGemmOrder, true, true>(F.lds + RING_OFF, g, S, E, F.wave); }
        if (BOTH(4)) GRID_BAR();
    }
    if (IN(5)) { F.lane = pg8::lane_now(); F.tid = F.wave * 64 + F.lane;
        pg8::Gemm g{XB, Wo, T, DM, DM}; pg8::StaticOrder S; S.init(T, DM, F.G, (int)blockIdx.x);
        pg8::EpiDelta E{(bf16*)out};
        pg8::gemm_phase<pg8::EpiDelta, pg8::StaticOrder, true, true>(F.lds + RING_OFF, g, S, E, F.wave);
        if (BOTH(5)) GRID_BAR();
    }
    if (IN(6)) { F.lane = pg8::lane_now(); F.tid = F.wave * 64 + F.lane;
        P5Args a{arg_in(0), WRT, arg_in(16), arg_in(18), arg_in(21), (const bf16*)out, XR, X8, W2, RS2, LISTS, TOK, args.mode ? CNT + 64 : CNT};
        p5_route(F, a);
        if (BOTH(6)) GRID_BAR();
    }
    if (IN(7)) { F.lane = pg8::lane_now(); F.tid = F.wave * 64 + F.lane;
        build_tables(F, CNT);
        const int ntiles = ((const LAS int*)(F.lds + TBL_PS))[32] >> 8;
        pg8::Gemm g{(const bf16*)X8, (const bf16*)W13, ntiles * 256, 32 * 1024, DM / 2}; pg8::GroupedOrderT<1> S{(const LAS int*)(F.lds + TBL_TE), ntiles * 4, F.G, F.vcu, (unsigned*)(ctl + CW_RDY), F.wave, (unsigned*)(ctl + CW_TMO)};
        LAS int* rowtab = (LAS int*)(F.lds + RG_TOT);
        build_rowtab(F, S, LISTS, RS2, rowtab);
        pg8::EpiSwiGLU E{HB};
        pg8::gemm_phase_gather<pg8::EpiSwiGLU, pg8::GroupedOrderT<1>, true>(F.lds + RING_OFF, g, S, E, rowtab, F.wave);
    }
    if (IN(8)) { F.lane = pg8::lane_now(); F.tid = F.wave * 64 + F.lane;
        build_tables(F, CNT);
        const int ntiles = ((const LAS int*)(F.lds + TBL_PS))[32] >> 8;
        pg8::Gemm g{(const bf16*)HB, (const bf16*)W2, ntiles * 256, 32 * 1024, DE / 2}; pg8::GroupedOrderT<P8_HOOK> S{(const LAS int*)(F.lds + TBL_TE), ntiles * 4, F.G, F.vcu, (unsigned*)(ctl + CW_RDY), F.wave, (unsigned*)(ctl + CW_TMO)};
#if P8_HOOK == 3
        if (F.wave == 0) { unsigned sp = 0u; const int Lu = F.lane < 32 ? S.unit_index(F.lane) : -1; const unsigned* rp = (const unsigned*)(ctl + CW_RDY) + 8 * (Lu < 0 ? 0 : (Lu >> 2));
            for (;;) { const unsigned v = Lu < 0 ? 32u : __hip_atomic_load(rp, __ATOMIC_RELAXED, __HIP_MEMORY_SCOPE_AGENT);
                if (__all(v >= 32u)) break;
                __builtin_amdgcn_s_sleep(2);
                if ((++sp & 1023u) == 0u) { if (__hip_atomic_load((const unsigned*)(ctl + CW_TMO), __ATOMIC_RELAXED, __HIP_MEMORY_SCOPE_AGENT) != 0u) break;
                    if (sp > (1u << 20)) { if (F.lane == 0) __hip_atomic_store((unsigned*)(ctl + CW_TMO), 1u, __ATOMIC_RELAXED, __HIP_MEMORY_SCOPE_AGENT); break; } } }
            __builtin_amdgcn_fence(__ATOMIC_ACQUIRE, "agent");
            asm volatile("s_waitcnt vmcnt(0)" ::: "memory"); }
        __syncthreads();
#endif
        pg8::EpiY E{(unsigned char*)XG, args.mode};
        pg8::gemm_phase<pg8::EpiY, pg8::GroupedOrderT<P8_HOOK>, true, true, true>(F.lds + RING_OFF, g, S, E, F.wave);
        if (BOTH(8)) GRID_BAR();
    }
    if (IN(9)) { F.lane = pg8::lane_now(); F.tid = F.wave * 64 + F.lane;
        build_tables(F, CNT);
        p9_final(F, XR, out, (const unsigned char*)XG, TOK, arg_in(22));
    }
#undef IN
#undef BOTH
}

extern "C" void kernel_launch(void* const* d_in, const int* in_sizes, int n_in, void* d_out, int out_size, void* d_ws, size_t ws_size, hipStream_t stream) {
    static int grid = 0;
    if (grid == 0) {
        if (n_in != 23 || in_sizes[0] != T * DM || out_size != T * DM || ws_size < WS_END) { fprintf(stderr, "kernel_launch: unexpected shapes (n_in %d, in0 %d, out %d, ws %zu); nothing launched\n", n_in, n_in > 0 ? in_sizes[0] : -1, out_size, ws_size); grid = -1; return; }
        int dev = 0, cus = 0;
        if (hipGetDevice(&dev) != hipSuccess || hipDeviceGetAttribute(&cus, hipDeviceAttributeMultiprocessorCount, dev) != hipSuccess) { grid = -1; return; }
        if (hipFuncSetAttribute((const void*)fwd_kernel, hipFuncAttributeMaxDynamicSharedMemorySize, LDS_BYTES) != hipSuccess) { fprintf(stderr, "kernel_launch: hipFuncSetAttribute failed\n"); grid = -1; return; }
        int per_cu = 0;
        if (hipOccupancyMaxActiveBlocksPerMultiprocessor(&per_cu, (const void*)fwd_kernel, NWAVES * 64, LDS_BYTES) != hipSuccess || per_cu < 1) { fprintf(stderr, "kernel_launch: occupancy query reports %d\n", per_cu); }
        (void)hipGetLastError();
        grid = cus;
    }
    if (grid < 0) return;
    if (hipMemsetAsync((char*)d_ws + WS_CTL, 0, CTL_ZERO_BYTES, stream) != hipSuccess) return;
    Args a{};
    for (int i = 0; i < 23; ++i) a.in[i] = (const float*)d_in[i];
    a.out = (float*)d_out; a.ws = (unsigned char*)d_ws;
#if MK_ONE_LAUNCH
    a.ph_lo = 0; a.ph_hi = N_PHASES;
    hipLaunchKernelGGL(fwd_kernel, dim3(grid), dim3(NWAVES * 64), LDS_BYTES, stream, a);
#else
    for (int ph = 0; ph < N_PHASES; ++ph) { a.ph_lo = ph; a.ph_hi = ph + 1;
        if (DUP_PHASE == ph || (ph == 3 && DUP_PHASE >= 20)) { a.mode = DUP_PHASE >= 20 ? DUP_PHASE - 19 : (ph == 8 ? DUP_TRIVIAL : (ph == 6 || (ph == 1 && DUP_TRIVIAL)) ? 1 : (ph == 0 ? DUP_TRIVIAL : 0)); hipLaunchKernelGGL(fwd_kernel, dim3(grid), dim3(NWAVES * 64), LDS_BYTES, stream, a); a.mode = 0; }
        hipLaunchKernelGGL(fwd_kernel, dim3(grid), dim3(NWAVES * 64), LDS_BYTES, stream, a); }
#endif
}
```

```cpp
#include <hip/hip_runtime.h>
#include <cstdio>
#include <cstdint>

#ifndef MK_ONE_LAUNCH
#define MK_ONE_LAUNCH 1
#endif
namespace pg8 {
#define PG8_LAS __attribute__((address_space(3)))
typedef unsigned short bf16_t;
typedef short bf16x8 __attribute__((ext_vector_type(8)));
typedef float f32x4 __attribute__((ext_vector_type(4)));
typedef unsigned u32x4 __attribute__((ext_vector_type(4)));
constexpr int BM = 256, BK = 64, HALF = 128, HTB = HALF * BK * 2  , STAGE_BYTES = 8 * HTB, NXCD = 8, WGM = 8;

__host__ __device__ __forceinline__ int lds_byte(int r, int c) { const int st = (r >> 4) * 2 + (c >> 5), rr = r & 15, cc = c & 31, ob = rr * 64 + cc * 2; return st * 1024 + (ob ^ (((ob >> 9) & 1) << 5)); }
__host__ __device__ __forceinline__ void stage_rc(int b, int& R, int& C) { const int st = b / 1024, sb = b % 1024, swz = sb ^ (((sb >> 9) & 1) << 5); R = (st >> 1) * 16 + swz / 64; C = (st & 1) * 32 + (swz % 64) / 2; }
__host__ __device__ __forceinline__ int perm32(int rho) { const int n = rho >> 4, i = rho & 15; return 8 * (i >> 2) + 4 * n + (i & 3); }

struct Unit { int pm, pn; };
struct Gemm { const bf16_t* A; const bf16_t* Bt; int M, N, K; };

struct StaticOrder {
    int nM, nN, nwg, G, c;
    __host__ __device__ void init(int M, int N, int G_, int c_) { nM = M / BM; nN = N / BM; nwg = nM * nN; G = G_; c = c_; }
    __host__ __device__ bool next(int i, Unit& u) const {
        const long L = (long)i * G + c; if (L >= nwg) return false;
        int wgid = (int)L; { const int q = nwg / NXCD, r = nwg % NXCD, xcd = wgid % NXCD, off = wgid / NXCD; wgid = (xcd < r ? xcd * (q + 1) : r * (q + 1) + (xcd - r) * q) + off; }
        const int nig = WGM * nN, gid = wgid / nig, fm = gid * WGM, gsz = (nM - fm) < WGM ? (nM - fm) : WGM;
        u.pm = fm + ((wgid % nig) % gsz); u.pn = (wgid % nig) / gsz; return true;
    }
    __device__ __forceinline__ void a_ready(const Unit&) const {}
    __device__ __forceinline__ void done(const Unit&) const {}
};

__device__ __forceinline__ unsigned cvt_pk_bf16(float lo, float hi) { unsigned r; asm volatile("v_cvt_pk_bf16_f32 %0, %1, %2" : "=v"(r) : "v"(lo), "v"(hi)); return r; }
typedef float f32x2 __attribute__((ext_vector_type(2)));
__device__ __forceinline__ int lane_now() { int l; asm volatile("v_mbcnt_lo_u32_b32 %0, -1, 0\n\tv_mbcnt_hi_u32_b32 %0, -1, %0" : "=v"(l)); return l; }
typedef int v4i_t __attribute__((ext_vector_type(4)));
typedef int v8i_t __attribute__((ext_vector_type(8)));
__device__ __forceinline__ v8i_t cat8(bf16x8 a, bf16x8 b) { const v4i_t x = __builtin_bit_cast(v4i_t, a), y = __builtin_bit_cast(v4i_t, b); return __builtin_shufflevector(x, y, 0, 1, 2, 3, 4, 5, 6, 7); }
__device__ __forceinline__ void glds_sv(const char* base, unsigned voff, unsigned lds_dst) { unsigned keep;
    asm volatile("s_mov_b32 %0, m0\n\ts_mov_b32 m0, %3\n\ts_nop 0\n\tglobal_load_lds_dwordx4 %1, %2\n\ts_mov_b32 m0, %0" : "=&s"(keep) : "v"(voff), "s"(base), "s"(lds_dst) : "memory"); }
__device__ __forceinline__ float sat8(float x) { return __builtin_amdgcn_fmed3f(x, -448.0f, 448.0f); }
__device__ __forceinline__ unsigned pack4_fp8(float a, float b, float c, float d) { unsigned w = 0u; w = __builtin_amdgcn_cvt_pk_fp8_f32(sat8(a), sat8(b), w, false); w = __builtin_amdgcn_cvt_pk_fp8_f32(sat8(c), sat8(d), w, true); return w; }
constexpr float W13_SCALE = 64.0f, HB_SCALE = 8.0f, W2_SCALE = 32.0f, XS_SCALE = 16.0f, WIN_SCALE = 64.0f;
__device__ __forceinline__ float sigmoid_f(float x) { return __builtin_amdgcn_rcpf(1.0f + __builtin_amdgcn_exp2f(-1.4426950408889634f * x)); }
__device__ __forceinline__ float gelu_tanh_f(float x) { const float u = x * (1.0f + 0.044715f * x * x); return x * __builtin_amdgcn_rcpf(1.0f + __builtin_amdgcn_exp2f(-2.3022081981f * u)); }
__device__ __forceinline__ float bf_lo(unsigned w) { return __builtin_bit_cast(float, w << 16); }
__device__ __forceinline__ float bf_hi(unsigned w) { return __builtin_bit_cast(float, w & 0xffff0000u); }
constexpr size_t SEGE = (size_t)32768 * 1024;

struct EpiZ {
    static constexpr bool PERM = true, AFTER_DRAIN = false; static constexpr int NSTORES = 16;
    bf16_t* ws5; bf16_t* out2; const float* rs; unsigned* norm; int probe; unsigned smap; float sc;
    __device__ __forceinline__ void operator()(const f32x4 (&acc)[2][2][4][2], const Unit& u, int wr, int wc, int fr, int fq) const {
        const int sgo = (int)((smap >> (4 * (u.pn >> 2))) & 15u); const int seg = probe ? 0 : sgo; float nm[2] = {0.f, 0.f}; bf16_t* O = sgo < 5 ? ws5 + (size_t)sgo * SEGE : out2 + (size_t)(sgo - 5) * SEGE;
        const int row0 = u.pm * BM + wr * 64 + fr, col0 = (u.pn & 3) * BM + wc * 32 + 8 * fq;
#pragma unroll
        for (int ai = 0; ai < 2; ++ai)
#pragma unroll
            for (int m = 0; m < 4; ++m) { const int row = row0 + ai * HALF + m * 16; bf16_t* rowp = O + (size_t)row * 1024 + col0;
                const bool hm = (sgo >= 2 && sgo <= 4); bf16_t* rowh = O + ((size_t)((row >> 12) * 8 + 2 * (u.pn & 3)) * 4096 + (row & 4095)) * 128 + wc * 32 + 8 * fq;
#pragma unroll
                for (int bj = 0; bj < 2; ++bj) { f32x4 v0 = acc[ai][bj][m][0] * sc, v1 = acc[ai][bj][m][1] * sc;
                    if (seg == 1) {
#pragma unroll
                        for (int i = 0; i < 4; ++i) { v0[i] = gelu_tanh_f(v0[i]); v1[i] = gelu_tanh_f(v1[i]); } }
                    else if (seg >= 5) {
#pragma unroll
                        for (int i = 0; i < 4; ++i) { v0[i] = sigmoid_f(v0[i]); v1[i] = sigmoid_f(v1[i]); } }
                    if (seg == 2 || seg == 3) { float q = (v0[0] * v0[0] + v0[1] * v0[1]) + (v0[2] * v0[2] + v0[3] * v0[3]) + (v1[0] * v1[0] + v1[1] * v1[1]) + (v1[2] * v1[2] + v1[3] * v1[3]);
                        q += __shfl_xor(q, 16); q += __shfl_xor(q, 32); nm[bj] = fmaxf(nm[bj], q); }
                    u32x4 w; w.x = cvt_pk_bf16(v0[0], v0[1]); w.y = cvt_pk_bf16(v0[2], v0[3]); w.z = cvt_pk_bf16(v1[0], v1[1]); w.w = cvt_pk_bf16(v1[2], v1[3]);
                    *(u32x4*)(hm ? rowh + (size_t)bj * 4096 * 128 : rowp + bj * HALF) = w; } }
        if (seg == 2 || seg == 3) {
#pragma unroll
            for (int bj = 0; bj < 2; ++bj) { float q = nm[bj];
#pragma unroll
                for (int o = 1; o < 16; o <<= 1) q = fmaxf(q, __shfl_xor(q, o));
                if (fr == 0 && fq == 0) atomicMax(norm + ((((seg - 2) * 8 + (u.pm >> 4)) * 8 + 2 * (u.pn & 3) + bj) * 4 + wc), __float_as_uint(q)); }
        }
    }
};
template <int MODE> struct EpiGate {
    static constexpr bool PERM = true, AFTER_DRAIN = false; static constexpr int NSTORES = 16;
    const bf16_t* G; bf16_t* O;
    __device__ __forceinline__ void operator()(const f32x4 (&acc)[2][2][4][2], const Unit& u, int wr, int wc, int fr, int fq) const {
        const int row0 = u.pm * BM + wr * 64 + fr, col0 = u.pn * BM + wc * 32 + 8 * fq;
        u32x4 gv[2][2][2], pv[2][2][2];
#define EG_LOAD(st_, b_) do { _Pragma("unroll") for (int mm = 0; mm < 2; ++mm) _Pragma("unroll") for (int bj = 0; bj < 2; ++bj) { \
            const size_t off_ = (size_t)(row0 + ((st_) >> 1) * HALF + (2 * ((st_) & 1) + mm) * 16) * 1024 + col0 + bj * HALF; gv[b_][mm][bj] = __builtin_nontemporal_load((const u32x4*)(G + off_)); if (MODE == 1) pv[b_][mm][bj] = __builtin_nontemporal_load((const u32x4*)(O + off_)); } } while (0)
#define EG_DO(st_, b_) do { _Pragma("unroll") for (int mm = 0; mm < 2; ++mm) _Pragma("unroll") for (int bj = 0; bj < 2; ++bj) { const int ai = (st_) >> 1, m = 2 * ((st_) & 1) + mm; \
            const size_t off_ = (size_t)(row0 + ai * HALF + m * 16) * 1024 + col0 + bj * HALF; const u32x4 g = gv[b_][mm][bj]; \
            f32x4 v0 = acc[ai][bj][m][0], v1 = acc[ai][bj][m][1]; \
            v0[0] *= bf_lo(g.x); v0[1] *= bf_hi(g.x); v0[2] *= bf_lo(g.y); v0[3] *= bf_hi(g.y); v1[0] *= bf_lo(g.z); v1[1] *= bf_hi(g.z); v1[2] *= bf_lo(g.w); v1[3] *= bf_hi(g.w); \
            if (MODE == 1) { const u32x4 p = pv[b_][mm][bj]; \
                v0[0] += bf_lo(p.x); v0[1] += bf_hi(p.x); v0[2] += bf_lo(p.y); v0[3] += bf_hi(p.y); v1[0] += bf_lo(p.z); v1[1] += bf_hi(p.z); v1[2] += bf_lo(p.w); v1[3] += bf_hi(p.w); } \
            u32x4 w; w.x = cvt_pk_bf16(v0[0], v0[1]); w.y = cvt_pk_bf16(v0[2], v0[3]); w.z = cvt_pk_bf16(v1[0], v1[1]); w.w = cvt_pk_bf16(v1[2], v1[3]); \
            *(u32x4*)(O + off_) = w; } } while (0)
        EG_LOAD(0, 0); EG_LOAD(1, 1); EG_DO(0, 0); EG_LOAD(2, 0); EG_DO(1, 1); EG_LOAD(3, 1); EG_DO(2, 0); EG_DO(3, 1);
#undef EG_LOAD
#undef EG_DO
    }
};
struct TwoGemmOrder {
    StaticOrder base; int n1;
    __device__ void init(int M, int N, int G_, int c_) { base.init(M, N, G_, c_); n1 = (base.nwg - c_ + G_ - 1) / G_; if (n1 < 0) n1 = 0; }
    __device__ __forceinline__ bool next(int i, Unit& u) const { if (i >= 2 * n1) return false; const bool second = i >= n1; base.next(second ? i - n1 : i, u); if (second) { u.pm += 128; u.pn += 4; } return true; }
    __device__ __forceinline__ void a_ready(const Unit&) const {}
    __device__ __forceinline__ void done(const Unit&) const {}
};
struct EpiGate2 {
    static constexpr bool PERM = true, AFTER_DRAIN = false; static constexpr int NSTORES = 16;
    const bf16_t* G0; const bf16_t* G1; bf16_t* O;
    __device__ __forceinline__ void operator()(const f32x4 (&acc)[2][2][4][2], const Unit& u, int wr, int wc, int fr, int fq) const {
        Unit v; v.pm = u.pm & 127; v.pn = u.pn & 3;
        if (u.pm >= 128) { EpiGate<1> e{G1, O}; e(acc, v, wr, wc, fr, fq); } else { EpiGate<0> e{G0, O}; e(acc, v, wr, wc, fr, fq); }
    }
};
struct EpiDelta {
    static constexpr bool PERM = true, AFTER_DRAIN = false; static constexpr int NSTORES = 16;
    bf16_t* O;
    __device__ __forceinline__ void operator()(const f32x4 (&acc)[2][2][4][2], const Unit& u, int wr, int wc, int fr, int fq) const {
        const int row0 = u.pm * BM + wr * 64 + fr, col0 = u.pn * BM + wc * 32 + 8 * fq;
#pragma unroll
        for (int ai = 0; ai < 2; ++ai)
#pragma unroll
            for (int m = 0; m < 4; ++m) { bf16_t* rowp = O + (size_t)(row0 + ai * HALF + m * 16) * 1024 + col0;
#pragma unroll
                for (int bj = 0; bj < 2; ++bj) { const f32x4 v0 = acc[ai][bj][m][0], v1 = acc[ai][bj][m][1];
                    u32x4 w; w.x = cvt_pk_bf16(v0[0], v0[1]); w.y = cvt_pk_bf16(v0[2], v0[3]); w.z = cvt_pk_bf16(v1[0], v1[1]); w.w = cvt_pk_bf16(v1[2], v1[3]);
                    *(u32x4*)(rowp + bj * HALF) = w; } }
    }
};
template <int HOOK> struct GroupedOrderT {
    const PG8_LAS int* tile_e; int nunits, G, c; unsigned* rdy; int wid; unsigned* tmo;
    __device__ __forceinline__ int unit_index(int i) const {
        if constexpr (HOOK != 3) { const int L = i * G + c; return L < nunits ? L : -1; }
        else { constexpr int K0 = 2; const int rem = nunits % G, poolA = nunits - rem, E = G - rem;
            if (c < rem) { if (i == 0) return poolA + c; const int k = i - 1 + K0; const int L = k * E + (k - K0) * rem + E + c; return L < poolA ? L : -1; }
            const int k = i, L = k * E + (k > K0 ? k - K0 : 0) * rem + (c - rem); return L < poolA ? L : -1; }
    }
    __device__ __forceinline__ bool next(int i, Unit& u) const { const int L = unit_index(i); if (L < 0) return false; u.pm = L >> 2; u.pn = __builtin_amdgcn_readfirstlane(tile_e[u.pm]) * 4 + (L & 3); return true; }
    __device__ __forceinline__ void a_ready(const Unit& u) const {
        if constexpr (HOOK == 2) {
            if (wid == 0) { unsigned sp = 0u;
                while ((unsigned)__builtin_amdgcn_readfirstlane(__hip_atomic_load(rdy + 8 * u.pm, __ATOMIC_RELAXED, __HIP_MEMORY_SCOPE_AGENT)) < 32u) {
                    __builtin_amdgcn_s_sleep(2);
                    if ((++sp & 1023u) == 0u) { if (__builtin_amdgcn_readfirstlane(__hip_atomic_load(tmo, __ATOMIC_RELAXED, __HIP_MEMORY_SCOPE_AGENT)) != 0u) break;
                        if (sp > (1u << 20)) { if (lane_now() == 0) __hip_atomic_store(tmo, 1u, __ATOMIC_RELAXED, __HIP_MEMORY_SCOPE_AGENT); break; } } }
                __builtin_amdgcn_fence(__ATOMIC_ACQUIRE, "agent");
                asm volatile("s_waitcnt vmcnt(0)" ::: "memory"); }
            asm volatile("" ::: "memory"); __builtin_amdgcn_s_barrier(); asm volatile("" ::: "memory");
        }
    }
    mutable int pend = -1;
    __device__ __forceinline__ void done(const Unit& u) const { if constexpr (HOOK == 1) pend = u.pm; }
    __device__ __forceinline__ void pre() const {
        if constexpr (HOOK == 1) { if (pend >= 0) { asm volatile("s_waitcnt vmcnt(24)" ::: "memory");
            if (lane_now() == 0) (void)__hip_atomic_fetch_add(rdy + 8 * pend, 1u, __ATOMIC_RELAXED, __HIP_MEMORY_SCOPE_AGENT); pend = -1; } }
    }
    __device__ __forceinline__ void fin() const {
        if constexpr (HOOK == 1) { if (pend >= 0) { asm volatile("s_waitcnt vmcnt(0)" ::: "memory");
            if (lane_now() == 0) (void)__hip_atomic_fetch_add(rdy + 8 * pend, 1u, __ATOMIC_RELAXED, __HIP_MEMORY_SCOPE_AGENT); pend = -1; } }
    }
};
using GroupedOrder = GroupedOrderT<0>;
struct EpiSwiGLU {
    static constexpr bool PERM = true, AFTER_DRAIN = false; static constexpr int NSTORES = 8;
    unsigned char* HB;
    __device__ __forceinline__ void operator()(const f32x4 (&acc)[2][2][4][2], const Unit& u, int wr, int wc, int fr, int fq, const PG8_LAS int* rows) const {
        const int row0 = u.pm * BM + wr * 64 + fr, col0 = (u.pn & 3) * HALF + wc * 32 + 8 * fq;
        float sv[2][4];
#pragma unroll
        for (int ai = 0; ai < 2; ++ai)
#pragma unroll
            for (int m = 0; m < 4; ++m) sv[ai][m] = ((const PG8_LAS float*)rows)[6 * 256 + wr * 64 + fr + ai * HALF + m * 16] * (1.0f / W13_SCALE);
#pragma unroll
        for (int ai = 0; ai < 2; ++ai)
#pragma unroll
            for (int m = 0; m < 4; ++m) { const int row = row0 + ai * HALF + m * 16; const float s = sv[ai][m];
                float o[8];
#pragma unroll
                for (int n = 0; n < 2; ++n)
#pragma unroll
                    for (int i = 0; i < 4; ++i) { const float g = acc[ai][0][m][n][i] * s, uu = acc[ai][1][m][n][i] * s; o[n * 4 + i] = g * sigmoid_f(g) * uu * HB_SCALE; }
                unsigned long long w = (unsigned long long)pack4_fp8(o[0], o[1], o[2], o[3]) | ((unsigned long long)pack4_fp8(o[4], o[5], o[6], o[7]) << 32);
                asm volatile("global_store_dwordx2 %0, %1, off sc1" :: "v"((unsigned long long*)(HB + (size_t)row * 512 + col0)), "v"(w) : "memory"); }
    }
};
constexpr float Y_SCALE = 0.25f;
struct EpiY {
    static constexpr bool PERM = true, AFTER_DRAIN = false; static constexpr int NSTORES = 8;
    unsigned char* Y; int skip;
    __device__ __forceinline__ void operator()(const f32x4 (&acc)[2][2][4][2], const Unit& u, int wr, int wc, int fr, int fq) const {
        if (skip) return;
        const int row0 = u.pm * BM + wr * 64 + fr, col0 = (u.pn & 3) * BM + wc * 64 + 16 * fq;
#pragma unroll
        for (int ai = 0; ai < 2; ++ai)
#pragma unroll
            for (int m = 0; m < 4; ++m) { const int row = row0 + ai * HALF + m * 16;
                const f32x4 a0 = acc[ai][0][m][0] * Y_SCALE, a1 = acc[ai][0][m][1] * Y_SCALE, b0 = acc[ai][1][m][0] * Y_SCALE, b1 = acc[ai][1][m][1] * Y_SCALE;
                unsigned al = pack4_fp8(a0[0], a0[1], a0[2], a0[3]), ah = pack4_fp8(a1[0], a1[1], a1[2], a1[3]), bl = pack4_fp8(b0[0], b0[1], b0[2], b0[3]), bh = pack4_fp8(b1[0], b1[1], b1[2], b1[3]);
                { auto r = __builtin_amdgcn_permlane32_swap(al, bl, false, false); al = r[0]; bl = r[1]; } { auto r = __builtin_amdgcn_permlane32_swap(ah, bh, false, false); ah = r[0]; bh = r[1]; }
                { auto r = __builtin_amdgcn_permlane16_swap(al, bl, false, false); al = r[0]; bl = r[1]; } { auto r = __builtin_amdgcn_permlane16_swap(ah, bh, false, false); ah = r[0]; bh = r[1]; }
                u32x4 w; w.x = al; w.y = ah; w.z = bl; w.w = bh;
                *(u32x4*)(Y + (size_t)row * 1024 + col0) = w; }
    }
};
template <class Epi, class Sched, bool ALIGN_EPI = false, bool SP2 = false, bool F8 = false>
__device__ __forceinline__ void gemm_phase(PG8_LAS unsigned char* lds, const Gemm g, const Sched& S, const Epi& E, const int wid) {
    const int lane = lane_now(), tid = wid * 64 + lane, wr = wid >> 2, wc = wid & 3, fr = lane & 15, fq = lane >> 4;
    const int K = g.K, nt = K / BK;
    unsigned voffA[2], voffB[2];
#pragma unroll
    for (int i = 0; i < 2; ++i) { int R, C; stage_rc(tid * 16 + i * 8192, R, C); const int Rb = Epi::PERM ? ((R & ~31) + perm32(R & 31)) : R;
        voffA[i] = (unsigned)(R * K + C) * 2u; voffB[i] = (unsigned)(Rb * K + C) * 2u; }
    const size_t kstep = (size_t)(BK * 2);
    const size_t hstep = (size_t)HALF * K * 2;
    const size_t tstep = 2 * hstep;
    const unsigned ldsw = (unsigned)wid * 1024u;
    const unsigned ldsbase = (unsigned)__builtin_amdgcn_readfirstlane((int)((unsigned)(uintptr_t)lds + ldsw));
    const int aoff = lds_byte(wr * 64 + fr, fq * 8), boff = lds_byte(wc * 32 + fr, fq * 8);
#define PG8_SA(b, h) (((b) * 2 + (h)) * HTB)
#define PG8_SB(b, h) ((4 + (b) * 2 + (h)) * HTB)
#define PG8_STAGE(bufoff, gbase, voff) do { _Pragma("unroll") for (int _i = 0; _i < 2; ++_i) { \
        if constexpr (F8) glds_sv((const char*)(gbase), (voff)[_i], ldsbase + (unsigned)((bufoff) + _i * 8192)); \
        else __builtin_amdgcn_global_load_lds((const unsigned*)((const char*)(gbase) + (voff)[_i]), (PG8_LAS unsigned*)(lds + (bufoff) + ldsw + _i * 8192), 16, 0, 0); } } while (0)
#define PG8_LDA(dst, b, h) do { _Pragma("unroll") for (int m = 0; m < 4; ++m) { \
        if constexpr (F8) { dst##8[m] = cat8(*(const PG8_LAS bf16x8*)(lds + PG8_SA(b, h) + aoff + m * 2048), *(const PG8_LAS bf16x8*)(lds + PG8_SA(b, h) + aoff + m * 2048 + 1024)); } \
        else { _Pragma("unroll") for (int k = 0; k < 2; ++k) dst[m][k] = *(const PG8_LAS bf16x8*)(lds + PG8_SA(b, h) + aoff + m * 2048 + k * 1024); } } } while (0)
#define PG8_LDB(dst, b, h) do { _Pragma("unroll") for (int n = 0; n < 2; ++n) { \
        if constexpr (F8) { dst##8[n] = cat8(*(const PG8_LAS bf16x8*)(lds + PG8_SB(b, h) + boff + n * 2048), *(const PG8_LAS bf16x8*)(lds + PG8_SB(b, h) + boff + n * 2048 + 1024)); } \
        else { _Pragma("unroll") for (int k = 0; k < 2; ++k) dst[n][k] = *(const PG8_LAS bf16x8*)(lds + PG8_SB(b, h) + boff + n * 2048 + k * 1024); } } } while (0)
#define PG8_MMA(ai, bj, At, Bt) do { __builtin_amdgcn_s_setprio(1); _Pragma("unroll") for (int m = 0; m < 4; ++m) _Pragma("unroll") for (int n = 0; n < 2; ++n) { \
        if constexpr (F8) { acc[ai][bj][m][n] = __builtin_amdgcn_mfma_scale_f32_16x16x128_f8f6f4(Bt##8[n], At##8[m], acc[ai][bj][m][n], 0, 0, 0, 0, 0, 0); } \
        else { _Pragma("unroll") for (int k = 0; k < 2; ++k) acc[ai][bj][m][n] = __builtin_amdgcn_mfma_f32_16x16x32_bf16(Bt[n][k], At[m][k], acc[ai][bj][m][n], 0, 0, 0); } } \
        __builtin_amdgcn_s_setprio(0); } while (0)
#define PG8_WAIT_V(n) asm volatile("s_waitcnt vmcnt(" #n ")" ::: "memory")
#define PG8_WAIT_L(n) asm volatile("s_waitcnt lgkmcnt(" #n ")" ::: "memory")
#define PG8_BAR __builtin_amdgcn_s_barrier()
#define PG8_SCHED __builtin_amdgcn_sched_barrier(0)
    Unit cur, nxt; int ui = 0;
    if (!S.next(0, cur)) return;
    f32x4 acc[2][2][4][2];
#pragma unroll
    for (int a = 0; a < 2; ++a)
#pragma unroll
        for (int b = 0; b < 2; ++b)
#pragma unroll
            for (int m = 0; m < 4; ++m)
#pragma unroll
                for (int n = 0; n < 2; ++n) acc[a][b][m][n] = (f32x4){0.f, 0.f, 0.f, 0.f};
    bf16x8 At[4][2], B0[2][2], B1[2][2]; v8i_t At8[4], B08[2], B18[2];
    const char* cA = (const char*)g.A + (size_t)cur.pm * tstep; const char* cB = (const char*)g.Bt + (size_t)cur.pn * tstep;
    S.a_ready(cur);
    if constexpr (SP2) {
        PG8_STAGE(PG8_SB(0, 0), cB, voffB); PG8_STAGE(PG8_SB(0, 1), cB + hstep, voffB); PG8_STAGE(PG8_SA(0, 0), cA, voffA); PG8_STAGE(PG8_SA(0, 1), cA + hstep, voffA);
        if (wr == 1) PG8_BAR;
        PG8_WAIT_V(2); PG8_BAR;
        PG8_STAGE(PG8_SB(1, 0), cB + kstep, voffB); PG8_STAGE(PG8_SA(1, 0), cA + kstep, voffA); PG8_STAGE(PG8_SB(1, 1), cB + hstep + kstep, voffB);
        PG8_WAIT_V(6); PG8_BAR;
    } else {
        PG8_STAGE(PG8_SB(0, 0), cB, voffB); PG8_STAGE(PG8_SA(0, 0), cA, voffA); PG8_STAGE(PG8_SB(0, 1), cB + hstep, voffB); PG8_STAGE(PG8_SA(0, 1), cA + hstep, voffA);
        if (wr == 1) PG8_BAR;
        PG8_WAIT_V(4); PG8_BAR;
        PG8_STAGE(PG8_SB(1, 0), cB + kstep, voffB); PG8_STAGE(PG8_SA(1, 0), cA + kstep, voffA); PG8_STAGE(PG8_SB(1, 1), cB + hstep + kstep, voffB);
        PG8_WAIT_V(6); PG8_BAR;
    }
    for (;;) {
        const bool has_next = S.next(ui + 1, nxt);
        const char* nA = has_next ? (const char*)g.A + (size_t)nxt.pm * tstep : cA; const char* nB = has_next ? (const char*)g.Bt + (size_t)nxt.pn * tstep : cB;
#pragma clang loop unroll(disable)
        for (int t = 0; t < nt; t += 2) {
            const bool last = (t == nt - 2);
            const char* a1 = cA + (size_t)(t + 1) * kstep;
            const char* a2 = last ? nA : cA + (size_t)(t + 2) * kstep; const char* b2 = last ? nB : cB + (size_t)(t + 2) * kstep;
            const char* a3 = a2 + kstep; const char* b3 = b2 + kstep;
            if (last && has_next) S.a_ready(nxt);
            if constexpr (SP2) {
            PG8_LDB(B0, 0, 0); PG8_LDB(B1, 0, 1); PG8_SCHED; PG8_LDA(At, 0, 0); PG8_STAGE(PG8_SA(1, 1), a1 + hstep, voffA);
            PG8_WAIT_V(8); PG8_WAIT_L(0); PG8_BAR; PG8_MMA(0, 0, At, B0); PG8_MMA(0, 1, At, B1); PG8_BAR; PG8_SCHED;
            PG8_LDA(At, 0, 1); PG8_STAGE(PG8_SB(0, 0), b2, voffB); PG8_STAGE(PG8_SB(0, 1), b2 + hstep, voffB); PG8_STAGE(PG8_SA(0, 0), a2, voffA);
            PG8_WAIT_V(8); PG8_WAIT_L(0); PG8_BAR; PG8_MMA(1, 0, At, B0); PG8_MMA(1, 1, At, B1); PG8_BAR; PG8_SCHED;
            PG8_LDB(B0, 1, 0); PG8_LDB(B1, 1, 1); PG8_SCHED; PG8_LDA(At, 1, 0); PG8_STAGE(PG8_SA(0, 1), a2 + hstep, voffA);
            PG8_WAIT_V(8); PG8_WAIT_L(0); PG8_BAR; PG8_MMA(0, 0, At, B0); PG8_MMA(0, 1, At, B1); PG8_BAR; PG8_SCHED;
            PG8_LDA(At, 1, 1); PG8_STAGE(PG8_SB(1, 0), b3, voffB); PG8_STAGE(PG8_SB(1, 1), b3 + hstep, voffB); PG8_STAGE(PG8_SA(1, 0), a3, voffA);
            PG8_WAIT_V(8); PG8_WAIT_L(0); PG8_BAR; PG8_MMA(1, 0, At, B0); PG8_MMA(1, 1, At, B1); PG8_BAR; PG8_SCHED;
            } else {
            PG8_LDB(B0, 0, 0); PG8_SCHED; PG8_LDA(At, 0, 0); PG8_STAGE(PG8_SA(1, 1), a1 + hstep, voffA);
            PG8_WAIT_L(8); PG8_BAR; PG8_WAIT_L(0); PG8_MMA(0, 0, At, B0); PG8_BAR; PG8_SCHED;
            PG8_LDB(B1, 0, 1); PG8_STAGE(PG8_SB(0, 0), b2, voffB);
            PG8_BAR; PG8_WAIT_L(0); PG8_MMA(0, 1, At, B1); PG8_BAR;
            PG8_LDA(At, 0, 1); PG8_STAGE(PG8_SA(0, 0), a2, voffA);
            PG8_BAR; PG8_WAIT_L(0); PG8_MMA(1, 0, At, B0); PG8_BAR; PG8_SCHED;
            PG8_STAGE(PG8_SB(0, 1), b2 + hstep, voffB);
            PG8_WAIT_V(6); PG8_BAR; PG8_MMA(1, 1, At, B1); PG8_BAR;
            PG8_LDB(B0, 1, 0); PG8_SCHED; PG8_LDA(At, 1, 0); PG8_STAGE(PG8_SA(0, 1), a2 + hstep, voffA);
            PG8_WAIT_L(8); PG8_BAR; PG8_WAIT_L(0); PG8_MMA(0, 0, At, B0); PG8_BAR; PG8_SCHED;
            PG8_LDB(B1, 1, 1); PG8_STAGE(PG8_SB(1, 0), b3, voffB);
            PG8_BAR; PG8_WAIT_L(0); PG8_MMA(0, 1, At, B1); PG8_BAR;
            PG8_LDA(At, 1, 1); PG8_STAGE(PG8_SA(1, 0), a3, voffA);
            PG8_BAR; PG8_WAIT_L(0); PG8_MMA(1, 0, At, B0); PG8_BAR; PG8_SCHED;
            PG8_STAGE(PG8_SB(1, 1), b3 + hstep, voffB);
            PG8_WAIT_V(6); PG8_BAR; PG8_MMA(1, 1, At, B1); PG8_BAR;
            }
        }
        if constexpr (ALIGN_EPI) { if (wr == 0) PG8_BAR; }
        if constexpr (!Epi::AFTER_DRAIN) { const int l2 = lane_now(); E(acc, cur, wr, wc, l2 & 15, l2 >> 4); S.done(cur); }
        if (!has_next) break;
#pragma unroll
        for (int a = 0; a < 2; ++a)
#pragma unroll
            for (int b = 0; b < 2; ++b)
#pragma unroll
                for (int m = 0; m < 4; ++m)
#pragma unroll
                    for (int n = 0; n < 2; ++n) acc[a][b][m][n] = (f32x4){0.f, 0.f, 0.f, 0.f};
        cur = nxt; cA = nA; cB = nB; ++ui;
        if constexpr (ALIGN_EPI) { if (wr == 1) PG8_BAR; }
    }
    PG8_WAIT_V(0);
    if constexpr (!ALIGN_EPI) { if (wr == 0) PG8_BAR; }
    PG8_BAR;
    if constexpr (Epi::AFTER_DRAIN) { E.fused(acc, cur, wr, wc, fr, fq, lds, wid, lane); S.done(cur); }
#undef PG8_SA
#undef PG8_SB
#undef PG8_STAGE
#undef PG8_LDA
#undef PG8_LDB
#undef PG8_MMA
#undef PG8_WAIT_V
#undef PG8_WAIT_L
#undef PG8_BAR
#undef PG8_SCHED
}
template <class Epi, class Sched, bool F8 = false>
__device__ __forceinline__ void gemm_phase_gather(PG8_LAS unsigned char* lds, const Gemm g, const Sched& S, const Epi& E, const PG8_LAS int* rowtab, const int wid) {
    constexpr bool ALIGN_EPI = true, SP2 = true;
    const int lane = lane_now(), tid = wid * 64 + lane, wr = wid >> 2, wc = wid & 3, fr = lane & 15, fq = lane >> 4;
    const int K = g.K, nt = K / BK;
    unsigned voffB[2], vAc[2][2];
#pragma unroll
    for (int i = 0; i < 2; ++i) { int R, C; stage_rc(tid * 16 + i * 8192, R, C); const int Rb = Epi::PERM ? ((R & ~31) + perm32(R & 31)) : R;
        voffB[i] = (unsigned)(Rb * K + C) * 2u; }
#define PG8_ROWS(dst, ui_) do { const int t_ = wid * 64 + lane_now(); _Pragma("unroll") for (int i_ = 0; i_ < 2; ++i_) { int R_, C_; stage_rc(t_ * 16 + i_ * 8192, R_, C_); \
        _Pragma("unroll") for (int h_ = 0; h_ < 2; ++h_) dst[h_][i_] = (unsigned)rowtab[(ui_) * 256 + h_ * HALF + R_] * (unsigned)(K * 2) + (unsigned)(C_ * 2); } } while (0)
#define PG8_STAGE_A(bufoff, v, kb) do { _Pragma("unroll") for (int _i = 0; _i < 2; ++_i) { \
        if constexpr (F8) glds_sv((const char*)g.A + (kb), (v)[_i], ldsbase + (unsigned)((bufoff) + _i * 8192)); \
        else __builtin_amdgcn_global_load_lds((const unsigned*)((const char*)g.A + (v)[_i] + (kb)), (PG8_LAS unsigned*)(lds + (bufoff) + ldsw + _i * 8192), 16, 0, 0); } } while (0)
    const size_t kstep = (size_t)(BK * 2);
    const size_t hstep = (size_t)HALF * K * 2;
    const size_t tstep = 2 * hstep;
    const unsigned ldsw = (unsigned)wid * 1024u;
    const unsigned ldsbase = (unsigned)__builtin_amdgcn_readfirstlane((int)((unsigned)(uintptr_t)lds + ldsw));
    const int aoff = lds_byte(wr * 64 + fr, fq * 8), boff = lds_byte(wc * 32 + fr, fq * 8);
#define PG8_SA(b, h) (((b) * 2 + (h)) * HTB)
#define PG8_SB(b, h) ((4 + (b) * 2 + (h)) * HTB)
#define PG8_STAGE(bufoff, gbase, voff) do { _Pragma("unroll") for (int _i = 0; _i < 2; ++_i) { \
        if constexpr (F8) glds_sv((const char*)(gbase), (voff)[_i], ldsbase + (unsigned)((bufoff) + _i * 8192)); \
        else __builtin_amdgcn_global_load_lds((const unsigned*)((const char*)(gbase) + (voff)[_i]), (PG8_LAS unsigned*)(lds + (bufoff) + ldsw + _i * 8192), 16, 0, 0); } } while (0)
#define PG8_LDA(dst, b, h) do { _Pragma("unroll") for (int m = 0; m < 4; ++m) { \
        if constexpr (F8) { dst##8[m] = cat8(*(const PG8_LAS bf16x8*)(lds + PG8_SA(b, h) + aoff + m * 2048), *(const PG8_LAS bf16x8*)(lds + PG8_SA(b, h) + aoff + m * 2048 + 1024)); } \
        else { _Pragma("unroll") for (int k = 0; k < 2; ++k) dst[m][k] = *(const PG8_LAS bf16x8*)(lds + PG8_SA(b, h) + aoff + m * 2048 + k * 1024); } } } while (0)
#define PG8_LDB(dst, b, h) do { _Pragma("unroll") for (int n = 0; n < 2; ++n) { \
        if constexpr (F8) { dst##8[n] = cat8(*(const PG8_LAS bf16x8*)(lds + PG8_SB(b, h) + boff + n * 2048), *(const PG8_LAS bf16x8*)(lds + PG8_SB(b, h) + boff + n * 2048 + 1024)); } \
        else { _Pragma("unroll") for (int k = 0; k < 2; ++k) dst[n][k] = *(const PG8_LAS bf16x8*)(lds + PG8_SB(b, h) + boff + n * 2048 + k * 1024); } } } while (0)
#define PG8_MMA(ai, bj, At, Bt) do { __builtin_amdgcn_s_setprio(1); _Pragma("unroll") for (int m = 0; m < 4; ++m) _Pragma("unroll") for (int n = 0; n < 2; ++n) { \
        if constexpr (F8) { acc[ai][bj][m][n] = __builtin_amdgcn_mfma_scale_f32_16x16x128_f8f6f4(Bt##8[n], At##8[m], acc[ai][bj][m][n], 0, 0, 0, 0, 0, 0); } \
        else { _Pragma("unroll") for (int k = 0; k < 2; ++k) acc[ai][bj][m][n] = __builtin_amdgcn_mfma_f32_16x16x32_bf16(Bt[n][k], At[m][k], acc[ai][bj][m][n], 0, 0, 0); } } \
        __builtin_amdgcn_s_setprio(0); } while (0)
#define PG8_WAIT_V(n) asm volatile("s_waitcnt vmcnt(" #n ")" ::: "memory")
#define PG8_WAIT_L(n) asm volatile("s_waitcnt lgkmcnt(" #n ")" ::: "memory")
#define PG8_BAR __builtin_amdgcn_s_barrier()
#define PG8_SCHED __builtin_amdgcn_sched_barrier(0)
    Unit cur, nxt; int ui = 0;
    if (!S.next(0, cur)) return;
    f32x4 acc[2][2][4][2];
#pragma unroll
    for (int a = 0; a < 2; ++a)
#pragma unroll
        for (int b = 0; b < 2; ++b)
#pragma unroll
            for (int m = 0; m < 4; ++m)
#pragma unroll
                for (int n = 0; n < 2; ++n) acc[a][b][m][n] = (f32x4){0.f, 0.f, 0.f, 0.f};
    bf16x8 At[4][2], B0[2][2], B1[2][2]; v8i_t At8[4], B08[2], B18[2];
    const char* cB = (const char*)g.Bt + (size_t)cur.pn * tstep;
    PG8_ROWS(vAc, 0);
    S.a_ready(cur);
    if constexpr (SP2) {
        PG8_STAGE(PG8_SB(0, 0), cB, voffB); PG8_STAGE(PG8_SB(0, 1), cB + hstep, voffB); PG8_STAGE_A(PG8_SA(0, 0), vAc[0], 0u); PG8_STAGE_A(PG8_SA(0, 1), vAc[1], 0u);
        if (wr == 1) PG8_BAR;
        PG8_WAIT_V(2); PG8_BAR;
        PG8_STAGE(PG8_SB(1, 0), cB + kstep, voffB); PG8_STAGE_A(PG8_SA(1, 0), vAc[0], (unsigned)kstep); PG8_STAGE(PG8_SB(1, 1), cB + hstep + kstep, voffB);
        PG8_WAIT_V(6); PG8_BAR;
    }
    for (;;) {
        const bool has_next = S.next(ui + 1, nxt);
        const char* nB = has_next ? (const char*)g.Bt + (size_t)nxt.pn * tstep : cB;
#pragma clang loop unroll(disable)
        for (int t = 0; t < nt; t += 2) {
            const bool last = (t == nt - 2);
            const unsigned k1 = (unsigned)((t + 1) * (int)kstep), k2 = last ? 0u : (unsigned)((t + 2) * (int)kstep), k3 = k2 + (unsigned)kstep;
            unsigned v2[2][2];
            if (last && has_next) { PG8_ROWS(v2, ui + 1); }
            else {
#pragma unroll
                for (int h_ = 0; h_ < 2; ++h_)
#pragma unroll
                    for (int i_ = 0; i_ < 2; ++i_) v2[h_][i_] = vAc[h_][i_]; }
            const char* b2 = last ? nB : cB + (size_t)(t + 2) * kstep; const char* b3 = b2 + kstep;
            if (last && has_next) S.a_ready(nxt);
            if constexpr (SP2) {
            PG8_LDB(B0, 0, 0); PG8_LDB(B1, 0, 1); PG8_SCHED; PG8_LDA(At, 0, 0); PG8_STAGE_A(PG8_SA(1, 1), vAc[1], k1);
            PG8_WAIT_V(8); PG8_WAIT_L(0); PG8_BAR; PG8_MMA(0, 0, At, B0); PG8_MMA(0, 1, At, B1); PG8_BAR; PG8_SCHED;
            PG8_LDA(At, 0, 1); PG8_STAGE(PG8_SB(0, 0), b2, voffB); PG8_STAGE(PG8_SB(0, 1), b2 + hstep, voffB); PG8_STAGE_A(PG8_SA(0, 0), v2[0], k2);
            PG8_WAIT_V(8); PG8_WAIT_L(0); PG8_BAR; PG8_MMA(1, 0, At, B0); PG8_MMA(1, 1, At, B1); PG8_BAR; PG8_SCHED;
            PG8_LDB(B0, 1, 0); PG8_LDB(B1, 1, 1); PG8_SCHED; PG8_LDA(At, 1, 0); PG8_STAGE_A(PG8_SA(0, 1), v2[1], k2);
            PG8_WAIT_V(8); PG8_WAIT_L(0); PG8_BAR; PG8_MMA(0, 0, At, B0); PG8_MMA(0, 1, At, B1); PG8_BAR; PG8_SCHED;
            PG8_LDA(At, 1, 1); PG8_STAGE(PG8_SB(1, 0), b3, voffB); PG8_STAGE(PG8_SB(1, 1), b3 + hstep, voffB); PG8_STAGE_A(PG8_SA(1, 0), v2[0], k3);
            PG8_WAIT_V(8); PG8_WAIT_L(0); PG8_BAR; PG8_MMA(1, 0, At, B0); PG8_MMA(1, 1, At, B1); PG8_BAR; PG8_SCHED;
            }
        }
        if constexpr (ALIGN_EPI) { if (wr == 0) PG8_BAR; }
        S.pre(); { const int l2 = lane_now(); E(acc, cur, wr, wc, l2 & 15, l2 >> 4, rowtab + ui * 256); } S.done(cur);
        if (!has_next) break;
#pragma unroll
        for (int a = 0; a < 2; ++a)
#pragma unroll
            for (int b = 0; b < 2; ++b)
#pragma unroll
                for (int m = 0; m < 4; ++m)
#pragma unroll
                    for (int n = 0; n < 2; ++n) acc[a][b][m][n] = (f32x4){0.f, 0.f, 0.f, 0.f};
        cur = nxt; cB = nB; ++ui;
        PG8_ROWS(vAc, ui);
        if constexpr (ALIGN_EPI) { if (wr == 1) PG8_BAR; }
    }
    PG8_WAIT_V(0);
    S.fin();
    if constexpr (!ALIGN_EPI) { if (wr == 0) PG8_BAR; }
    PG8_BAR;
#undef PG8_ROWS
#undef PG8_STAGE_A
#undef PG8_SA
#undef PG8_SB
#undef PG8_STAGE
#undef PG8_LDA
#undef PG8_LDB
#undef PG8_MMA
#undef PG8_WAIT_V
#undef PG8_WAIT_L
#undef PG8_BAR
#undef PG8_SCHED
}
}
#define GAS __attribute__((address_space(1)))
#define LAS __attribute__((address_space(3)))
typedef unsigned short bf16;
typedef unsigned v4u __attribute__((ext_vector_type(4)));
typedef float f32x4 __attribute__((ext_vector_type(4)));
typedef short bf16x8 __attribute__((ext_vector_type(8)));
typedef GAS unsigned gu32;
typedef GAS unsigned long long gu64;
#define RLX_AGENT __ATOMIC_RELAXED, __HIP_MEMORY_SCOPE_AGENT
#define LDS_WAIT() asm volatile("s_waitcnt lgkmcnt(0)" ::: "memory")
#define VM_WAIT() asm volatile("s_waitcnt vmcnt(0)" ::: "memory")
__device__ __forceinline__ unsigned long long rt() { return __builtin_amdgcn_s_memrealtime(); }
__device__ __forceinline__ unsigned f2bf(float f) { unsigned u = __builtin_bit_cast(unsigned, f); return (u + 0x7fffu + ((u >> 16) & 1u)) >> 16; }
__device__ __forceinline__ unsigned pk2(float lo, float hi) { return f2bf(lo) | (f2bf(hi) << 16); }
#define XB_TMO      128
#define XB_XCNT(j)  (256  + 64 * (j))
#define XB_XSUB(j)  (1280 + 64 * (j))
#define XB_XGEN(j)  (2304 + 64 * (j))
#define XB_TOP      3328
#define XB_TOPGEN   3392
#define XCD_BAR_WORDS 3456
#define XB_SPIN_CAP (1u << 18)

__device__ __forceinline__ unsigned xb_ld(unsigned* p)              { return __hip_atomic_load(p, __ATOMIC_RELAXED, __HIP_MEMORY_SCOPE_AGENT); }
__device__ __forceinline__ unsigned xb_add(unsigned* p, unsigned v) { return __hip_atomic_fetch_add(p, v, __ATOMIC_RELAXED, __HIP_MEMORY_SCOPE_AGENT); }
__device__ __forceinline__ unsigned xb_xcc_id() { return (unsigned)__builtin_amdgcn_s_getreg((3 << 11) | 20) & 0xFu; }
#define XB_SPIN(cond, bar) do { unsigned _sp = 0; while (cond) { __builtin_amdgcn_s_sleep(1); \
    if ((++_sp & 255u) == 0u) { if (xb_ld(&(bar)[XB_TMO])) break; if (_sp > XB_SPIN_CAP) { atomicAdd(&(bar)[XB_TMO], 1u); break; } } } } while (0)

struct XcdBarrier {
    unsigned* bar; unsigned x;
    volatile LAS unsigned* st;
};

__device__ __forceinline__ XcdBarrier xcd_barrier_post(unsigned* bar, volatile LAS unsigned* st) {
    XcdBarrier b; b.bar = bar; b.x = xb_xcc_id(); b.st = st;
    if (threadIdx.x == 0) (void)xb_add(&bar[XB_XCNT(b.x)], 1u);
    return b;
}
__device__ __forceinline__ void xcd_barrier_complete(unsigned* bar, unsigned x, unsigned& nloc, unsigned& nx) {
    const unsigned G = gridDim.x * gridDim.y * gridDim.z;
    unsigned sum, cnt, mine, sp = 0u;
    for (;;) {
        sum = 0u; cnt = 0u; mine = 0u;
#pragma unroll
        for (unsigned j = 0; j < 16; ++j) { const unsigned c = xb_ld(&bar[XB_XCNT(j)]); sum += c; cnt += (c > 0u) ? 1u : 0u; mine = (j == x) ? c : mine; }
        if (sum == G) break;
        __builtin_amdgcn_s_sleep(1);
        if ((++sp & 255u) == 0u) { if (xb_ld(&bar[XB_TMO])) break; if (sp > XB_SPIN_CAP) { atomicAdd(&bar[XB_TMO], 1u); break; } }
    }
    nloc = mine > 0u ? mine : 1u; nx = cnt > 0u ? cnt : 1u;
}

__device__ __forceinline__ void xcd_barrier(const XcdBarrier& b) {
    asm volatile("s_waitcnt vmcnt(0)" ::: "memory");
    __syncthreads();
    if (threadIdx.x == 0) {
        unsigned* bar = b.bar;
        __builtin_amdgcn_s_waitcnt(0);
        unsigned nloc = b.st[0], nx = b.st[1];
        if (nloc == 0u) { xcd_barrier_complete(bar, b.x, nloc, nx); b.st[0] = nloc; b.st[1] = nx; }
        const unsigned old = xb_add(&bar[XB_XSUB(b.x)], 1u);
        const unsigned gen = old / nloc;
        if (old + 1u == (gen + 1u) * nloc) {
            __builtin_amdgcn_fence(__ATOMIC_RELEASE, "agent");
            asm volatile("s_waitcnt vmcnt(0)" ::: "memory");
            const unsigned og = xb_add(&bar[XB_TOP], 1u);
            const unsigned tg = og / nx;
            if (og + 1u == (tg + 1u) * nx) xb_add(&bar[XB_TOPGEN], 1u);
            else XB_SPIN(xb_ld(&bar[XB_TOPGEN]) == tg, bar);
            __builtin_amdgcn_fence(__ATOMIC_ACQUIRE, "agent");
            xb_add(&bar[XB_XGEN(b.x)], 1u);
            asm volatile("s_waitcnt vmcnt(0)" ::: "memory");
        } else {
            XB_SPIN(xb_ld(&bar[XB_XGEN(b.x)]) == gen, bar);
            __builtin_amdgcn_fence(__ATOMIC_ACQUIRE, "agent");
            asm volatile("s_waitcnt vmcnt(0)" ::: "memory");
        }
    }
    __syncthreads();
}
namespace fattn {
typedef unsigned short bf16;
typedef short bf16x8 __attribute__((ext_vector_type(8)));
typedef short s16x4 __attribute__((ext_vector_type(4)));
typedef float f32x16 __attribute__((ext_vector_type(16)));
typedef float f32x4 __attribute__((ext_vector_type(4)));
typedef unsigned u32x4 __attribute__((ext_vector_type(4)));
constexpr int D = 128, LD = 128, LDO = 1024, SEQ = 4096;
constexpr float THR = 8.f;
constexpr float SCALE = 0.08838834764831845f;
constexpr int NW = 8, QBLK = 32, KVBLK = 64, QB = NW * QBLK;
constexpr int SHM_V = KVBLK * D * 2, SHM_K = KVBLK * D * 2;
constexpr int OFF_WS = 2 * SHM_V + 2 * SHM_K, OFF_BIAS = OFF_WS + NW * 64 * 4, LDS_BYTES = OFF_BIAS + 2 * 64 * 4;

#define KSWZ(row, colB) ((row) * 256 + ((colB) ^ (((row) & 7) << 4)))
#define SBAR() __builtin_amdgcn_sched_barrier(0)
__device__ __forceinline__ int v_st(int k, int c) { const int kk = (k & ~0xC) | ((k & 4) << 1) | ((k & 8) >> 1); return ((kk >> 3) * 4 + (c >> 5)) * 512 + ((kk & 7) * 32 + (c & 31)) * 2; }
__device__ __forceinline__ int v_rd_base(int lane) { return ((lane & 3) << 3) | (((lane >> 2) & 3) << 6) | (((lane >> 4) & 1) << 5) | (((lane >> 5) & 1) << 8); }
constexpr int v_rd_off(int d0, int ks, int half) { return d0 * 512 + ks * 4096 + half * 2048; }
__device__ __forceinline__ int crow(int r, int hi) { return (r & 3) + 8 * (r >> 2) + 4 * hi; }
__device__ __forceinline__ unsigned cvtpk(float lo, float hi) { unsigned r; asm volatile("v_cvt_pk_bf16_f32 %0, %1, %2" : "=v"(r) : "v"(lo), "v"(hi)); return r; }
__device__ __forceinline__ bf16x8 load8(const bf16* p) { return *reinterpret_cast<const bf16x8*>(p); }
__device__ __forceinline__ void mask_tile(f32x16& p0, f32x16& p1, int dq) {
    const float NEG = -__builtin_inff();
#pragma unroll
    for (int r = 0; r < 16; ++r) {
        const int c = (r & 3) + 8 * (r >> 2);
        if (dq - c < 0) p0[r] = NEG;
        if (dq - c - 32 < 0) p1[r] = NEG;
    }
}
__device__ __forceinline__ void partialSM(f32x16& p0, f32x16& p1, float& m_reg, float& mn, float& alpha) {
    float pmax = p0[0]; for (int r = 1; r < 16; ++r) pmax = fmaxf(pmax, p0[r]); for (int r = 0; r < 16; ++r) pmax = fmaxf(pmax, p1[r]);
    { auto rr = __builtin_amdgcn_permlane32_swap(__float_as_uint(pmax), __float_as_uint(pmax), false, false);
      pmax = fmaxf(__uint_as_float(rr[0]), __uint_as_float(rr[1])); }
    constexpr float C2 = 1.4426950408889634f * SCALE;
    if (__builtin_expect(__all((pmax - m_reg) * SCALE <= THR), 1)) { mn = m_reg; alpha = 1.f; }
    else { mn = fmaxf(m_reg, pmax); alpha = __builtin_amdgcn_exp2f((m_reg - mn) * C2); m_reg = mn; }
    const float mnL = -mn * C2;
    for (int r = 0; r < 16; ++r) p0[r] = fmaf(p0[r], C2, mnL); for (int r = 0; r < 16; ++r) p1[r] = fmaf(p1[r], C2, mnL);
    for (int r = 0; r < 16; ++r) p0[r] = __builtin_amdgcn_exp2f(p0[r]);
}
__device__ __forceinline__ void finishSM(f32x16& p0, f32x16& p1, float alpha, float& l_reg, bf16x8& pa0, bf16x8& pa1, bf16x8& pa2, bf16x8& pa3) {
    for (int r = 0; r < 16; ++r) p1[r] = __builtin_amdgcn_exp2f(p1[r]);
    float ps = 0; for (int r = 0; r < 16; ++r) ps += p0[r]; for (int r = 0; r < 16; ++r) ps += p1[r];
    { auto rr = __builtin_amdgcn_permlane32_swap(__float_as_uint(ps), __float_as_uint(ps), false, false);
      ps = __uint_as_float(rr[0]) + __uint_as_float(rr[1]); }
    l_reg = l_reg * alpha + ps;
#define PK4(P, B_, OUT) do { unsigned a0 = cvtpk(P[B_+0], P[B_+1]), a1 = cvtpk(P[B_+2], P[B_+3]);                          \
        unsigned b0 = cvtpk(P[B_+4], P[B_+5]), b1 = cvtpk(P[B_+6], P[B_+7]);                                             \
        auto r0 = __builtin_amdgcn_permlane32_swap(a0, b0, false, false); auto r1 = __builtin_amdgcn_permlane32_swap(a1, b1, false, false); \
        u32x4 w = {r0[0], r1[0], r0[1], r1[1]}; OUT = *reinterpret_cast<bf16x8*>(&w); } while (0)
    PK4(p0, 0, pa0); PK4(p0, 8, pa1); PK4(p1, 0, pa2); PK4(p1, 8, pa3);
#undef PK4
}
template <int KB>
__device__ __forceinline__ void qkt(f32x16& p0, f32x16& p1, const char* K_lds, const char* Bias_lds, int r32, int hi, const bf16x8* qr) {
    { const f32x4* bb = reinterpret_cast<const f32x4*>(Bias_lds + KB * 256 + hi * 16);
      const f32x4 a0 = bb[0], a1 = bb[2], a2 = bb[4], a3 = bb[6], c0 = bb[8], c1 = bb[10], c2 = bb[12], c3 = bb[14];
      p0 = (f32x16){a0[0], a0[1], a0[2], a0[3], a1[0], a1[1], a1[2], a1[3], a2[0], a2[1], a2[2], a2[3], a3[0], a3[1], a3[2], a3[3]};
      p1 = (f32x16){c0[0], c0[1], c0[2], c0[3], c1[0], c1[1], c1[2], c1[3], c2[0], c2[1], c2[2], c2[3], c3[0], c3[1], c3[2], c3[3]}; }
    const char* kb[4];
#pragma unroll
    for (int dd = 0; dd < 4; ++dd) kb[dd] = K_lds + KB * SHM_K + KSWZ(r32, (dd * 16 + hi * 8) * 2);
#pragma unroll
    for (int d0 = 0; d0 < 8; ++d0) { const char* a = kb[d0 & 3] + (d0 >> 2) * 128;
        bf16x8 b0 = *reinterpret_cast<const bf16x8*>(a);
        bf16x8 b1 = *reinterpret_cast<const bf16x8*>(a + 32 * 256);
        p0 = __builtin_amdgcn_mfma_f32_32x32x16_bf16(b0, qr[d0], p0, 0, 0, 0);
        p1 = __builtin_amdgcn_mfma_f32_32x32x16_bf16(b1, qr[d0], p1, 0, 0, 0); }
}
template <int VB>
__device__ __forceinline__ void pv_tile(f32x16* o, int vb0, bf16x8 pa0, bf16x8 pa1, bf16x8 pa2, bf16x8 pa3) {
#define TRRD(dst, off) asm volatile("ds_read_b64_tr_b16 %0, %1 offset:%2" : "=&v"(dst) : "v"(vb0), "i"(off) : "memory")
#define PV_D0(d0) do { s16x4 l0, l1, l2, l3, h0, h1, h2, h3; constexpr int b_ = VB * SHM_V + v_rd_off(d0, 0, 0);   \
        TRRD(l0, b_); TRRD(h0, b_ + 2048); TRRD(l1, b_ + 4096); TRRD(h1, b_ + 6144); TRRD(l2, b_ + 8192); TRRD(h2, b_ + 10240); TRRD(l3, b_ + 12288); TRRD(h3, b_ + 14336); \
        asm volatile("s_waitcnt lgkmcnt(0)" ::: "memory"); SBAR();                                                    \
        o[d0] = __builtin_amdgcn_mfma_f32_32x32x16_bf16(pa0, (bf16x8){l0[0], l0[1], l0[2], l0[3], h0[0], h0[1], h0[2], h0[3]}, o[d0], 0, 0, 0);   \
        o[d0] = __builtin_amdgcn_mfma_f32_32x32x16_bf16(pa1, (bf16x8){l1[0], l1[1], l1[2], l1[3], h1[0], h1[1], h1[2], h1[3]}, o[d0], 0, 0, 0);   \
        o[d0] = __builtin_amdgcn_mfma_f32_32x32x16_bf16(pa2, (bf16x8){l2[0], l2[1], l2[2], l2[3], h2[0], h2[1], h2[2], h2[3]}, o[d0], 0, 0, 0);   \
        o[d0] = __builtin_amdgcn_mfma_f32_32x32x16_bf16(pa3, (bf16x8){l3[0], l3[1], l3[2], l3[3], h3[0], h3[1], h3[2], h3[3]}, o[d0], 0, 0, 0); } while (0)
    PV_D0(0); PV_D0(1); PV_D0(2); PV_D0(3);
#undef PV_D0
#undef TRRD
}

struct Bases { const bf16* Q; bf16* O; const bf16* K; const bf16* V; const float* CB; };
struct BlockRef { unsigned qo, oo, kvo, cbo; int P0, jlo; };
struct Seam { bf16x8 qr[8]; };
#define VMW() asm volatile("s_waitcnt vmcnt(0)" ::: "memory")
#define VMWN(n) asm volatile("s_waitcnt vmcnt(%0)" :: "i"(n) : "memory")
#define LBAR() do { asm volatile("s_waitcnt lgkmcnt(0)" ::: "memory"); __builtin_amdgcn_s_barrier(); asm volatile("" ::: "memory"); } while (0)
#define ATT_SRC() \
    unsigned ksrc0, ksrc1, vsrc0, vsrc1; \
    { const int rw0 = 8 * wid + (lane >> 4), rw1 = rw0 + 4, p_ = lane & 15; ksrc0 = (unsigned)(rw0 * 256 + ((p_ ^ (rw0 & 7)) << 4)); ksrc1 = (unsigned)(rw1 * 256 + ((p_ ^ (rw1 & 7)) << 4)); \
      const int L0 = 128 * wid + lane, L1 = L0 + 64; \
      const int kk0 = ((L0 >> 7) << 3) | ((L0 >> 2) & 7), kk1 = ((L1 >> 7) << 3) | ((L1 >> 2) & 7); \
      const int k0_ = (kk0 & ~0xC) | ((kk0 & 4) << 1) | ((kk0 & 8) >> 1), k1_ = (kk1 & ~0xC) | ((kk1 & 4) << 1) | ((kk1 & 8) >> 1); \
      vsrc0 = (unsigned)(k0_ * 256 + ((((L0 >> 5) & 3) * 4 + (L0 & 3)) << 4)); vsrc1 = (unsigned)(k1_ * 256 + ((((L1 >> 5) & 3) * 4 + (L1 & 3)) << 4)); }
#define DMA_K(Kp, CBp, k0, bf) do { const char* kp_ = (const char*)(Kp) + (unsigned)(k0) * 256u; \
        __builtin_amdgcn_global_load_lds((const unsigned*)(kp_ + ksrc0), (LAS unsigned*)(ldsa + 2 * SHM_V + (bf) * SHM_K + (2 * wid) * 1024), 16, 0, 0); \
        __builtin_amdgcn_global_load_lds((const unsigned*)(kp_ + ksrc1), (LAS unsigned*)(ldsa + 2 * SHM_V + (bf) * SHM_K + (2 * wid + 1) * 1024), 16, 0, 0); \
        if (wid == 0) __builtin_amdgcn_global_load_lds((const unsigned*)((CBp) + (unsigned)((k0) + lane)), (LAS unsigned*)(ldsa + OFF_BIAS + (bf) * 256), 4, 0, 0); } while (0)
#define DMA_V(Vp, k0, bf) do { const char* vp_ = (const char*)(Vp) + (unsigned)(k0) * 256u; \
        __builtin_amdgcn_global_load_lds((const unsigned*)(vp_ + vsrc0), (LAS unsigned*)(ldsa + (bf) * SHM_V + (2 * wid) * 1024), 16, 0, 0); \
        __builtin_amdgcn_global_load_lds((const unsigned*)(vp_ + vsrc1), (LAS unsigned*)(ldsa + (bf) * SHM_V + (2 * wid + 1) * 1024), 16, 0, 0); } while (0)
__device__ __forceinline__ void prime(const Bases& G, const BlockRef& cur, char* lds, LAS unsigned char* ldsa, Seam& S) {
    const int tid = threadIdx.x, wid = __builtin_amdgcn_readfirstlane(tid >> 6), lane = tid & 63, r32 = lane & 31, hi = lane >> 5;
    ATT_SRC();
    for (int d0 = 0; d0 < 8; ++d0) S.qr[d0] = load8(G.Q + (cur.qo + (unsigned)((wid * QBLK + r32) * LD + d0 * 16 + hi * 8)));
    DMA_K(G.K + cur.kvo, G.CB + cur.cbo, cur.jlo * KVBLK, 0); DMA_V(G.V + cur.kvo, cur.jlo * KVBLK, 0);
    VMW(); LBAR();
}
__device__ __forceinline__ void block(const Bases& G, const BlockRef& cur, const BlockRef& nxt, char* lds, LAS unsigned char* ldsa, Seam& S) {
    const int tid = threadIdx.x, wid = __builtin_amdgcn_readfirstlane(tid >> 6), lane = tid & 63, r32 = lane & 31, hi = lane >> 5;
    const int j_lo = cur.jlo, NT = (cur.P0 + QB - 1) / KVBLK + 1 - j_lo;
    const int qlo = cur.P0 + wid * QBLK, qm = qlo + r32 - 4 * hi;
    char* V_lds = lds; char* K_lds = lds + 2 * SHM_V; char* B_lds = lds + OFF_BIAS;
    float* ws = (float*)(lds + OFF_WS) + wid * 64; float* li_l = ws, * al_l = ws + 32;
    float m_reg = G.CB[cur.cbo + (unsigned)(cur.P0 + wid * QBLK + r32)], l_reg = 0; f32x16 o[4] = {};
    const int vb0 = (int)(uintptr_t)V_lds + v_rd_base(lane);
    const bf16* Kh = G.K + cur.kvo; const bf16* Vh = G.V + cur.kvo; const float* CBh = G.CB + cur.cbo;
    ATT_SRC();
#define RESC(a) do { if (__any((a) < 1.f)) { if (hi == 0) al_l[r32] = (a); asm volatile("s_waitcnt lgkmcnt(0)" ::: "memory");              \
                     for (int d_ = 0; d_ < 4; ++d_) for (int r = 0; r < 16; ++r) o[d_][r] *= al_l[crow(r, hi)]; } } while (0)
#define KBASE(t) ((j_lo + (t)) * KVBLK)
#define MASKT(P0_, P1_, t) do { const int kb_ = KBASE(t); if (kb_ + KVBLK - 1 > qlo) mask_tile(P0_, P1_, qm - kb_); } while (0)
    f32x16 pA0, pA1, pB0, pB1; float mnA, mnB, alA, alB; bf16x8 pa0, pa1, pa2, pa3;
    DMA_K(Kh, CBh, KBASE(1), 1); DMA_V(Vh, KBASE(1), 1);
    SBAR(); qkt<0>(pA0, pA1, K_lds, B_lds, r32, hi, S.qr);
    MASKT(pA0, pA1, 0); partialSM(pA0, pA1, m_reg, mnA, alA);
    VMW(); LBAR();
#define HALF_STEP(PX0, PX1, mnX, alX, PY0, PY1, alY, t, KB, VB, SB) do {                                                      \
        SBAR(); if ((t) + 1 < NT) { DMA_K(Kh, CBh, KBASE((t) + 1), SB); SBAR(); }                                            \
        qkt<KB>(PX0, PX1, K_lds, B_lds, r32, hi, S.qr);                                                                        \
        finishSM(PY0, PY1, alY, l_reg, pa0, pa1, pa2, pa3); SBAR();                                                           \
        pv_tile<VB>(o, vb0, pa0, pa1, pa2, pa3); MASKT(PX0, PX1, (t)); partialSM(PX0, PX1, m_reg, mnX, alX);                   \
        LBAR();                                                                                                               \
        if ((t) + 1 < NT) { DMA_V(Vh, KBASE((t) + 1), SB); }                                                                  \
        RESC(alX); VMWN(2); LBAR(); } while (0)
    for (int t = 1; t + 1 < NT; t += 2) {
        HALF_STEP(pB0, pB1, mnB, alB, pA0, pA1, alA, t, 1, 0, 0);
        HALF_STEP(pA0, pA1, mnA, alA, pB0, pB1, alB, t + 1, 0, 1, 1);
    }
    SBAR(); qkt<1>(pB0, pB1, K_lds, B_lds, r32, hi, S.qr); SBAR();
    DMA_K(G.K + nxt.kvo, G.CB + nxt.cbo, nxt.jlo * KVBLK, 0); SBAR();
#pragma unroll
    for (int d0 = 0; d0 < 8; ++d0) S.qr[d0] = load8(G.Q + (nxt.qo + (unsigned)((wid * QBLK + r32) * LD + d0 * 16 + hi * 8)));
    SBAR();
    finishSM(pA0, pA1, alA, l_reg, pa0, pa1, pa2, pa3); SBAR();
    pv_tile<0>(o, vb0, pa0, pa1, pa2, pa3);
    MASKT(pB0, pB1, NT - 1); partialSM(pB0, pB1, m_reg, mnB, alB);
    VMWN(10); LBAR();
    DMA_V(G.V + nxt.kvo, nxt.jlo * KVBLK, 0);
    RESC(alB);
    finishSM(pB0, pB1, alB, l_reg, pa0, pa1, pa2, pa3); SBAR(); pv_tile<1>(o, vb0, pa0, pa1, pa2, pa3);
    SBAR();
    if (hi == 0) li_l[r32] = l_reg; asm volatile("s_waitcnt lgkmcnt(0)" ::: "memory");
    float rli[16];
#pragma unroll
    for (int r = 0; r < 16; ++r) rli[r] = __builtin_amdgcn_rcpf(li_l[crow(r, hi)]);
    bf16* Ow = G.O + (cur.oo + (unsigned)(wid * QBLK * LDO));
#pragma unroll
    for (int r = 0; r < 16; ++r) { const int orow = crow(r, hi);
#pragma unroll
        for (int d0 = 0; d0 < 4; ++d0) { const float v = o[d0][r] * rli[r];
            const float vn = __shfl_xor(v, 1);
            if ((r32 & 1) == 0) *(unsigned*)(Ow + (unsigned)(orow * LDO + d0 * 32 + r32)) = cvtpk(v, vn); } }
    VMW(); LBAR();
#undef RESC
#undef KBASE
#undef MASKT
#undef HALF_STEP
}
#undef VMW
#undef VMWN
#undef LBAR
#undef ATT_SRC
#undef DMA_K
#undef DMA_V
#undef KSWZ
#undef SBAR
}
constexpr int NB = 8, SEQ = 4096, T = NB * SEQ, DM = 1024, NH = 8, HD = 128, INW = 7176, NZ = 7168;
constexpr int NE = 32, DE = 512;
constexpr float EPS = 1e-6f;
constexpr int PMAX = 73728;
constexpr int NWAVES = 8;
constexpr size_t MiB = 1u << 20;
constexpr size_t WS_CTL = 0, CTL_ZERO_BYTES = 64 * 1024;
constexpr size_t WS_RS1 = 1 * MiB, WS_RS2 = 1 * MiB + 256 * 1024;
constexpr size_t WS_LF = 1 * MiB + 512 * 1024;
constexpr size_t WS_CB = 2 * MiB + 512 * 1024;
constexpr size_t WS_TOK = 3 * MiB + 512 * 1024;
constexpr size_t WS_LISTS = 5 * MiB;
constexpr size_t WS_WRT = 9 * MiB;
constexpr size_t WS_SRS = 9 * MiB + 512 * 1024, WS_SW = 10 * MiB;
constexpr size_t WS_WIN = 16 * MiB;
constexpr size_t WS_WA = 30 * MiB, WS_WL = 32 * MiB, WS_WO = 34 * MiB;
constexpr size_t WS_WRG = 36 * MiB;
constexpr size_t WS_XB = 40 * MiB;
constexpr size_t WS_XR = 104 * MiB;
constexpr size_t WS_GG = 168 * MiB;
constexpr size_t WS_Q = 232 * MiB, WS_K = 296 * MiB, WS_V = 360 * MiB;
constexpr size_t WS_W13 = 424 * MiB;
constexpr size_t WS_W2 = 392 * MiB;
constexpr size_t WS_XG = 168 * MiB;
constexpr size_t WS_HB = 296 * MiB;
constexpr size_t WS_WIN8 = 488 * MiB;
constexpr unsigned SEG8_MASK = 0x7Cu;
__host__ __device__ constexpr int seg_row(int sg) { int r = 0; for (int t = 0; t < sg; ++t) if (((SEG8_MASK >> t) & 1u) == ((SEG8_MASK >> sg) & 1u)) ++r; return r; }
__host__ __device__ constexpr unsigned seg_map(bool f8) { unsigned m = 0; int j = 0; for (int t = 0; t < 7; ++t) if ((((SEG8_MASK >> t) & 1u) != 0u) == f8) { m |= (unsigned)t << (4 * j); ++j; } return m; }
__host__ __device__ constexpr int seg_cnt(bool f8) { int j = 0; for (int t = 0; t < 7; ++t) if ((((SEG8_MASK >> t) & 1u) != 0u) == f8) ++j; return j; }
constexpr size_t WS_X8P = 456 * MiB;
constexpr size_t WS_END = 512 * MiB;
static_assert(WS_XG + (size_t)PMAX * 1024 <= WS_K && WS_HB + (size_t)PMAX * 1024 <= WS_W2 && WS_W2 + 32u * 1024 * 512 * 2 <= WS_W13 && WS_W13 + 64 * MiB <= WS_END, "d_ws map");
constexpr int CW_TMO = 0, CW_CODE = 1, CW_BAR = 4096, CW_CNT = 8192, CW_NORM = 8448, CW_QCTR = 12288, CW_RDY = 14000;
constexpr int RING_OFF = 0, RING_BYTES = 131072;
constexpr int LDSCTL_OFF = RING_BYTES, MISC_OFF = LDSCTL_OFF + 320;
constexpr int TBL_OFF = RING_BYTES + 1024;
constexpr int TBL_PS = TBL_OFF, TBL_CN = TBL_OFF + 256, TBL_TE = TBL_OFF + 512;
constexpr int RG_TOT = RING_BYTES + 4096, RG_CAR = RG_TOT + 4096;
constexpr int LDS_BYTES = 147456;

#include <cmath>
using pg8::bf_lo; using pg8::bf_hi; using pg8::sigmoid_f;

struct Frame {
    LAS unsigned char* lds;
    int tid, lane, wave, vcu, G;
};
__device__ __forceinline__ float wave_sum(float v) {
#pragma unroll
    for (int o = 1; o < 64; o <<= 1) v += __shfl_xor(v, o);
    return v;
}
__device__ __forceinline__ void transpose_tile(const float* src, int ld, bf16* dst, int ldd, const float* kscale, LAS float* scr, int lane) {
    const int q = lane & 7, kr = lane >> 3;
    f32x4 v[8];
#pragma unroll
    for (int i = 0; i < 8; ++i) v[i] = __builtin_nontemporal_load((const f32x4*)(src + (size_t)(kr + 8 * i) * ld + 4 * q));
#pragma unroll
    for (int i = 0; i < 8; ++i) { const int kk = kr + 8 * i; const float sc = kscale ? kscale[kk] : 1.0f;
#pragma unroll
        for (int c = 0; c < 4; ++c) scr[kk * 33 + 4 * q + c] = v[i][c] * sc; }
    LDS_WAIT(); asm volatile("" ::: "memory");
    const int c = lane & 7;
#pragma unroll
    for (int j = 0; j < 4; ++j) { const int n = (lane >> 3) + 8 * j; const LAS float* s = scr + (8 * c) * 33 + n;
        v4u o; o.x = pk2(s[0 * 33], s[1 * 33]); o.y = pk2(s[2 * 33], s[3 * 33]); o.z = pk2(s[4 * 33], s[5 * 33]); o.w = pk2(s[6 * 33], s[7 * 33]);
        *(GAS v4u*)(dst + (size_t)n * ldd + 8 * c) = o; }
    LDS_WAIT(); asm volatile("" ::: "memory");
}

__device__ __forceinline__ void transpose_tile8(const float* src, int ld, unsigned char* dst, int ldd, const float* kscale, float scale, LAS float* scr, int lane) {
    const int q = lane & 7, kr = lane >> 3;
    f32x4 v[8];
#pragma unroll
    for (int i = 0; i < 8; ++i) v[i] = __builtin_nontemporal_load((const f32x4*)(src + (size_t)(kr + 8 * i) * ld + 4 * q));
#pragma unroll
    for (int i = 0; i < 8; ++i) { const int kk = kr + 8 * i; const float sc = kscale ? kscale[kk] * scale : scale;
#pragma unroll
        for (int c = 0; c < 4; ++c) scr[kk * 33 + 4 * q + c] = v[i][c] * sc; }
    LDS_WAIT(); asm volatile("" ::: "memory");
    const int c = lane & 3;
#pragma unroll
    for (int j = 0; j < 2; ++j) { const int n = (lane >> 2) + 16 * j; const LAS float* s = scr + (16 * c) * 33 + n;
        v4u o; o.x = pg8::pack4_fp8(s[0 * 33], s[1 * 33], s[2 * 33], s[3 * 33]); o.y = pg8::pack4_fp8(s[4 * 33], s[5 * 33], s[6 * 33], s[7 * 33]);
        o.z = pg8::pack4_fp8(s[8 * 33], s[9 * 33], s[10 * 33], s[11 * 33]); o.w = pg8::pack4_fp8(s[12 * 33], s[13 * 33], s[14 * 33], s[15 * 33]);
        *(GAS v4u*)(dst + (size_t)n * ldd + 16 * c) = o; }
    LDS_WAIT(); asm volatile("" ::: "memory");
}

struct P0Args { const float *x, *g_mix, *w_in, *w_rg_a, *w_rg_x, *b_forget, *w_lru_out, *w_attn_out, *w_out, *g_ffn, *w_rgrp, *w_rexp, *w_gate, *w_up;
                bf16 *Win, *Wl, *Wa, *Wo, *Wrg, *XB; unsigned char* W13; float *RS1, *LF, *WRT; unsigned char *Win8, *X8P; };
struct TItem { const float* src; int ld; unsigned char* dst; int ldd; const float* ks; float scale; int f8; };
__device__ __forceinline__ void titem_load(const TItem& t, f32x4 (&v)[8], float (&sc)[8], int lane) {
    const int q = lane & 7, kr = lane >> 3;
#pragma unroll
    for (int i = 0; i < 8; ++i) { v[i] = __builtin_nontemporal_load((const f32x4*)(t.src + (size_t)(kr + 8 * i) * t.ld + 4 * q)); sc[i] = t.ks ? t.ks[kr + 8 * i] * t.scale : t.scale; }
}
__device__ __forceinline__ void titem_finish(const TItem& t, const f32x4 (&v)[8], const float (&sc)[8], LAS float* scr, int lane) {
    const int q = lane & 7, kr = lane >> 3;
#pragma unroll
    for (int i = 0; i < 8; ++i) { const int kk = kr + 8 * i;
#pragma unroll
        for (int c = 0; c < 4; ++c) scr[kk * 33 + 4 * q + c] = v[i][c] * sc[i]; }
    LDS_WAIT(); asm volatile("" ::: "memory");
    if (t.f8) { const int c = lane & 3;
#pragma unroll
        for (int j = 0; j < 2; ++j) { const int n = (lane >> 2) + 16 * j; const LAS float* s = scr + (16 * c) * 33 + n;
            v4u o; o.x = pg8::pack4_fp8(s[0 * 33], s[1 * 33], s[2 * 33], s[3 * 33]); o.y = pg8::pack4_fp8(s[4 * 33], s[5 * 33], s[6 * 33], s[7 * 33]);
            o.z = pg8::pack4_fp8(s[8 * 33], s[9 * 33], s[10 * 33], s[11 * 33]); o.w = pg8::pack4_fp8(s[12 * 33], s[13 * 33], s[14 * 33], s[15 * 33]);
            *(GAS v4u*)(t.dst + (size_t)n * t.ldd + 16 * c) = o; } }
    else { const int c = lane & 7;
#pragma unroll
        for (int j = 0; j < 4; ++j) { const int n = (lane >> 3) + 8 * j; const LAS float* s = scr + (8 * c) * 33 + n;
            v4u o; o.x = pk2(s[0 * 33], s[1 * 33]); o.y = pk2(s[2 * 33], s[3 * 33]); o.z = pk2(s[4 * 33], s[5 * 33]); o.w = pk2(s[6 * 33], s[7 * 33]);
            *(GAS v4u*)(t.dst + ((size_t)n * t.ldd + 8 * c) * 2) = o; } }
    LDS_WAIT(); asm volatile("" ::: "memory");
}
constexpr int P0_I_IN = 16 * 224, P0_I_SQ = 16 * 32, P0_I_RG = 2 * 4 * 4 * 8, P0_I_EX = 2 * 8192, P0_NITEMS = P0_I_IN + 3 * P0_I_SQ + P0_I_RG + P0_I_EX;
__device__ __forceinline__ void p0_items(const Frame& F, const P0Args& a, const int first, const int last, const int stride, const int offset) {
    LAS float* scr = (LAS float*)(F.lds + RING_OFF + F.wave * 16384);
    const float* const p_wl = a.w_lru_out; const float* const p_wa = a.w_attn_out; const float* const p_wo = a.w_out; const float* const p_rga = a.w_rg_a; const float* const p_rgx = a.w_rg_x;
    bf16* const q_wl = a.Wl; bf16* const q_wa = a.Wa; bf16* const q_wo = a.Wo;
    constexpr int I_IN = P0_I_IN, I_SQ = P0_I_SQ, I_EX = P0_I_EX, NITEMS = P0_NITEMS;
    const float* const p_gate = a.w_gate; const float* const p_up = a.w_up; const float* const p_win = a.w_in; const float* const p_gmix = a.g_mix; const float* const p_gffn = a.g_ffn;
    bf16* const q_win = a.Win; bf16* const q_wrg = a.Wrg; unsigned char* const q_w13 = a.W13; unsigned char* const q_win8 = a.Win8;
#define P0_DECODE(it_, t_) do { int r = (it_); \
        if (r >= NITEMS - I_EX) { r -= NITEMS - I_EX;     \
            const int w = r >> 13, e = (r >> 8) & 31, kb = (r >> 4) & 15, nb = r & 15; const float* W = (w == 0 ? p_gate : p_up) + (size_t)e * DM * DE; \
            const int drow = e * 1024 + (nb >> 2) * 256 + (nb & 3) * 32 + (w == 1 ? 128 : 0); \
            t_.src = W + (size_t)(64 * kb) * DE + 32 * nb; t_.ld = DE; t_.dst = q_w13 + (size_t)drow * DM + 64 * kb; t_.ldd = DM; t_.ks = p_gffn + 64 * kb; t_.scale = pg8::W13_SCALE; t_.f8 = 1; } \
        else if (r < I_IN) { const int kb = r / 224, nb = r % 224, n0 = 32 * nb, sc_ = n0 < 5120 ? n0 : n0 + 8; \
            t_.src = p_win + (size_t)(64 * kb) * INW + sc_; t_.ld = INW; t_.ldd = DM; t_.ks = p_gmix + 64 * kb; \
            const int sg_ = n0 >> 10; int sr_ = 0; for (int t2 = 0; t2 < 7; ++t2) if (t2 < sg_ && (((SEG8_MASK >> t2) & 1u) == ((SEG8_MASK >> sg_) & 1u))) ++sr_;     \
            const int nr_ = sr_ * 1024 + (n0 & 1023); \
            if ((SEG8_MASK >> sg_) & 1u) { t_.dst = q_win8 + (size_t)nr_ * DM + 64 * kb; t_.scale = pg8::WIN_SCALE; t_.f8 = 1; }     \
            else { t_.dst = (unsigned char*)(q_win + (size_t)nr_ * DM + 64 * kb); t_.scale = 1.0f; t_.f8 = 0; } } \
        else if (r < I_IN + 3 * I_SQ) { r -= I_IN; const int w = r / I_SQ, q = r % I_SQ, kb = q / 32, nb = q % 32; const float* W = w == 0 ? p_wl : (w == 1 ? p_wa : p_wo); bf16* Wt = w == 0 ? q_wl : (w == 1 ? q_wa : q_wo); \
            t_.src = W + (size_t)(64 * kb) * DM + 32 * nb; t_.ld = DM; t_.dst = (unsigned char*)(Wt + (size_t)(32 * nb) * DM + 64 * kb); t_.ldd = DM; t_.ks = nullptr; t_.scale = 1.0f; t_.f8 = 0; } \
        else { r -= I_IN + 3 * I_SQ; const int gb = r / 32, q = r % 32, kb = q / 8, nb = q % 8; const float* W = (gb < 4 ? p_rga : p_rgx) + (size_t)(gb & 3) * 65536; \
            t_.src = W + (size_t)(64 * kb) * 256 + 32 * nb; t_.ld = 256; t_.dst = (unsigned char*)(q_wrg + (size_t)gb * 65536 + (size_t)(32 * nb) * 256 + 64 * kb); t_.ldd = 256; t_.ks = nullptr; t_.scale = -1.4426950408889634f; t_.f8 = 0; }     } while (0)
    {
        int it = first + offset; TItem cur; f32x4 va[8]; float sa[8];
        if (it < last) { P0_DECODE(it, cur); titem_load(cur, va, sa, F.lane); }
        while (it < last) {
            const int nx = it + stride; TItem nt = cur; f32x4 vb[8]; float sb[8];
            if (nx < last) { P0_DECODE(nx, nt); titem_load(nt, vb, sb, F.lane); }
            titem_finish(cur, va, sa, scr, F.lane);
            if (nx < last) { cur = nt;
#pragma unroll
                for (int i = 0; i < 8; ++i) { va[i] = vb[i]; sa[i] = sb[i]; } }
            it = nx;
        }
    }
#undef P0_DECODE
}
__device__ __forceinline__ void p0_prologue(const Frame& F, const P0Args& a, const int part  ) {
    const int gw = F.vcu * NWAVES + F.wave, NGW = F.G * NWAVES;
    if (part != 2) p0_items(F, a, 0, P0_NITEMS, NGW, gw);
    if (part == 1) return;
    for (int i = (F.vcu * NWAVES + F.wave) * 64 + F.lane; i < 64 * DM; i += NGW * 64) { const int n = i >> 10, k = i & 1023;
        float v = 0.f; if (n < 32) v = a.w_rexp[k * 32 + n]; else if (n < 36) v = a.w_rgrp[k * 4 + (n - 32)];
        a.WRT[i] = v * a.g_ffn[k]; }
    LAS float* wfl = (LAS float*)(F.lds + RING_OFF);
    __syncthreads();
    for (int k = F.tid; k < DM; k += NWAVES * 64) { const float g = a.g_mix[k];
        const f32x4 w0 = *(const f32x4*)(a.w_in + (size_t)k * INW + 5120), w1 = *(const f32x4*)(a.w_in + (size_t)k * INW + 5124);
        *(LAS f32x4*)(wfl + k * 8) = w0 * g; *(LAS f32x4*)(wfl + k * 8 + 4) = w1 * g; }
    __syncthreads();
    float wf[4][4][8];
#pragma unroll
    for (int j = 0; j < 4; ++j)
#pragma unroll
        for (int i = 0; i < 4; ++i) { const int k = 256 * j + 4 * F.lane + i; const f32x4 w0 = *(const LAS f32x4*)(wfl + k * 8), w1 = *(const LAS f32x4*)(wfl + k * 8 + 4);
#pragma unroll
            for (int h = 0; h < 4; ++h) { wf[j][i][h] = w0[h]; wf[j][i][4 + h] = w1[h]; } }
    const float bfg = a.b_forget[F.lane & 7];
    f32x4 vn[4];
    if (gw < T) { const GAS f32x4* xr0 = (const GAS f32x4*)(a.x + (size_t)gw * DM) + F.lane;
#pragma unroll
        for (int j = 0; j < 4; ++j) vn[j] = __builtin_nontemporal_load((const f32x4*)xr0 + 64 * j); }
    for (int m = gw; m < T; m += NGW) {
        f32x4 v[4]; float s = 0.f, d[8] = {0.f, 0.f, 0.f, 0.f, 0.f, 0.f, 0.f, 0.f};
#pragma unroll
        for (int j = 0; j < 4; ++j) v[j] = vn[j];
        if (m + NGW < T) { const GAS f32x4* xr1 = (const GAS f32x4*)(a.x + (size_t)(m + NGW) * DM) + F.lane;
#pragma unroll
            for (int j = 0; j < 4; ++j) vn[j] = __builtin_nontemporal_load((const f32x4*)xr1 + 64 * j); }
#pragma unroll
        for (int j = 0; j < 4; ++j) { s += (v[j].x * v[j].x + v[j].y * v[j].y) + (v[j].z * v[j].z + v[j].w * v[j].w);
#pragma unroll
            for (int i = 0; i < 4; ++i)
#pragma unroll
                for (int h = 0; h < 8; ++h) d[h] = fmaf(v[j][i], wf[j][i][h], d[h]); }
        s = wave_sum(s);
#pragma unroll
        for (int h = 0; h < 8; ++h) d[h] = wave_sum(d[h]);
        const float rs = 1.0f / sqrtf(s * (1.0f / DM) + EPS);
        GAS unsigned long long* o8 = (GAS unsigned long long*)(a.XB + (size_t)m * DM) + F.lane;
#pragma unroll
        for (int j = 0; j < 4; ++j) o8[64 * j] = (unsigned long long)pk2(v[j].x * rs, v[j].y * rs) | ((unsigned long long)pk2(v[j].z * rs, v[j].w * rs) << 32);
        { GAS unsigned* o4 = (GAS unsigned*)(a.X8P + (size_t)m * DM) + F.lane; const float r8 = rs * pg8::XS_SCALE;
#pragma unroll
          for (int j = 0; j < 4; ++j) o4[64 * j] = pg8::pack4_fp8(v[j].x * r8, v[j].y * r8, v[j].z * r8, v[j].w * r8); }
        if (F.lane < 8) { const int h = F.lane; float dh = d[0]; dh = h == 1 ? d[1] : dh; dh = h == 2 ? d[2] : dh; dh = h == 3 ? d[3] : dh; dh = h == 4 ? d[4] : dh; dh = h == 5 ? d[5] : dh; dh = h == 6 ? d[6] : dh; dh = h == 7 ? d[7] : dh;
            const float fl = dh * rs + bfg; a.LF[(size_t)m * 8 + h] = fminf(fl, 0.f) - log1pf(expf(-fabsf(fl))); }
    }
}
__device__ __forceinline__ void cumsum_bias(const Frame& F, const float* LF, float* CB) {
    LAS float* wt = (LAS float*)(F.lds + RING_OFF);
    for (int bh = blockIdx.x; bh < NB * NH; bh += F.G) {
        const int b = bh >> 3, h = bh & 7, s0 = F.tid * 8;
        float v[8], run = 0.f;
#pragma unroll
        for (int j = 0; j < 8; ++j) { run += LF[((size_t)(b * SEQ + s0 + j)) * 8 + h]; v[j] = run; }
        float inc = run;
#pragma unroll
        for (int o = 1; o < 64; o <<= 1) { const float t = __shfl_up(inc, o); if (F.lane >= o) inc += t; }
        if (F.lane == 63) wt[F.wave] = inc;
        __syncthreads();
        float pre = inc - run;
        for (int w = 0; w < F.wave; ++w) pre += wt[w];
#pragma unroll
        for (int j = 0; j < 8; ++j) CB[(size_t)bh * SEQ + s0 + j] = -(pre + v[j]) * 11.313708498984761f;
        __syncthreads();
    }
}
struct RgArgs { const bf16* XC; const bf16* GG; bf16* GO; const bf16* Wrg; const float *b_a, *b_x, *lam; };
__device__ __forceinline__ float bfx(const v4u& v, int i) { const unsigned w = i < 2 ? v.x : (i < 4 ? v.y : (i < 6 ? v.z : v.w)); return (i & 1) ? bf_hi(w) : bf_lo(w); }
__device__ __forceinline__ unsigned cvtpk_bf16(float lo, float hi) { unsigned r; asm volatile("v_cvt_pk_bf16_f32 %0, %1, %2" : "=v"(r) : "v"(lo), "v"(hi)); return r; }
__device__ __forceinline__ void conv_prepass(const Frame& F, const bf16* XR, bf16* XC, const float* conv_w, const float* conv_b) {
    const int gw = F.vcu * NWAVES + F.wave, NGW = F.G * NWAVES;
    for (int it = gw; it < (T / 16) * 2; it += NGW) {
        const int r0 = (it >> 1) * 16, c0 = (it & 1) * 512 + 8 * F.lane, tq = r0 & (SEQ - 1);
        float cw[4][8], cbv[8];
#pragma unroll
        for (int j = 0; j < 4; ++j) { const f32x4 w0 = *(const f32x4*)(conv_w + j * DM + c0), w1 = *(const f32x4*)(conv_w + j * DM + c0 + 4);
#pragma unroll
            for (int i = 0; i < 4; ++i) { cw[j][i] = w0[i]; cw[j][4 + i] = w1[i]; } }
        { const f32x4 w0 = *(const f32x4*)(conv_b + c0), w1 = *(const f32x4*)(conv_b + c0 + 4);
#pragma unroll
          for (int i = 0; i < 4; ++i) { cbv[i] = w0[i]; cbv[4 + i] = w1[i]; } }
        v4u raw[19];
#pragma unroll
        for (int i = 0; i < 19; ++i) { const int rr = (i < 3 && tq == 0) ? r0 : r0 - 3 + i; const v4u w = __builtin_nontemporal_load((const v4u*)(XR + ((unsigned)rr * DM + c0)));
            const bool z = i < 3 && tq == 0; raw[i].x = z ? 0u : w.x; raw[i].y = z ? 0u : w.y; raw[i].z = z ? 0u : w.z; raw[i].w = z ? 0u : w.w; }
#pragma unroll
        for (int r = 0; r < 16; ++r) { float y[8];
#pragma unroll
            for (int i = 0; i < 8; ++i) { float sacc = cbv[i];
#pragma unroll
                for (int j = 0; j < 4; ++j) sacc = fmaf(cw[j][i], bfx(raw[r + j], i), sacc);
                y[i] = sacc; }
            v4u o; o.x = cvtpk_bf16(y[0], y[1]); o.y = cvtpk_bf16(y[2], y[3]); o.z = cvtpk_bf16(y[4], y[5]); o.w = cvtpk_bf16(y[6], y[7]);
            *(GAS v4u*)(XC + ((unsigned)(r0 + r) * DM + c0)) = o; }
    }
}
__device__ __forceinline__ void rglru_unit(const Frame& F, const RgArgs& a, int unit) {
    const int tid = F.tid, lane = F.lane, wid = F.wave, fr = lane & 15, fq = lane >> 4, rq = wid >> 1, cp = wid & 1;
    const int b = unit >> 5, n = (unit >> 3) & 3, g = unit & 7, cbase = 256 * n, cown = cbase + 32 * g;
    LAS unsigned char* A_l = F.lds + RING_OFF;
    LAS float* tot = (LAS float*)(F.lds + RG_TOT);
    bf16x8 bfr[2][8];
#pragma unroll
    for (int gt = 0; gt < 2; ++gt)
#pragma unroll
        for (int ks = 0; ks < 8; ++ks) bfr[gt][ks] = *(const GAS bf16x8*)(a.Wrg + ((size_t)((gt * 4 + n) * 256 + 32 * g + 16 * cp + fr)) * 256 + 32 * ks + 8 * fq);
    const int cl = 16 * cp + fr, cch = cown + cl;
    const float ba = -1.4426950408889634f * a.b_a[cch], bx = -1.4426950408889634f * a.b_x[cch], sp8 = 8.0f * log1pf(expf(-a.lam[cch])) * 1.4426950408889634f;
    const unsigned goff = (unsigned)(b * SEQ + 32 * rq + 4 * fq) * DM + cch;
    const __amdgpu_buffer_rsrc_t GGr = __builtin_amdgcn_make_buffer_rsrc((void*)a.GG, 0, (int)((size_t)T * DM * 2), 0x00020000);
    const __amdgpu_buffer_rsrc_t GOr = __builtin_amdgcn_make_buffer_rsrc((void*)a.GO, 0, (int)((size_t)T * DM * 2), 0x00020000);
    const int gvo = (int)(goff * 2u);
    const unsigned dbase = ((unsigned)(b * SEQ + 16 * wid + (lane >> 5)) * DM + cbase) * 2u;
    const char* const XCb = (const char*)a.XC;
#define RG_DMA(ci_, buf_) do { _Pragma("unroll") for (int i_ = 0; i_ < 8; ++i_) { const unsigned so_ = dbase + (unsigned)(2 * i_) * (DM * 2u) + ((((unsigned)lane & 31u) ^ (unsigned)((2 * i_ + (lane >> 5)) & 15)) << 4); \
        __builtin_amdgcn_global_load_lds((const unsigned*)(XCb + so_ + (unsigned)(ci_) * (128u * DM * 2u)), (LAS unsigned*)(A_l + (buf_) * 65536 + (8 * wid + i_) * 1024), 16, 0, 0); } } while (0)
    float hc = 0.f;
    const int kx = 32 * g + cl;
#pragma unroll
    for (int gt = 0; gt < 2; ++gt)
#pragma unroll
        for (int ks = 0; ks < 8; ++ks) asm volatile("" : "+v"(bfr[gt][ks]));
    RG_DMA(0, 0); asm volatile("s_waitcnt vmcnt(0)" ::: "memory");
#define RG_CHUNK(BUF_, ci_) do { const int ci = (ci_); const int t0 = 128 * ci; LAS unsigned char* const Ab = A_l + (BUF_) * 65536; \
        __builtin_amdgcn_s_barrier(); asm volatile("" ::: "memory"); \
        unsigned short ggv[2][4]; \
        _Pragma("unroll") \
        for (int mt = 0; mt < 2; ++mt) \
        _Pragma("unroll") \
            for (int j = 0; j < 4; ++j) ggv[mt][j] = __builtin_amdgcn_raw_buffer_load_b16(GGr, gvo, (t0 + 16 * mt + j) * (DM * 2), 0); \
        if (ci + 1 < SEQ / 128) RG_DMA(ci + 1, BUF_ ^ 1); \
 \
        f32x4 acc[2][2]; \
        _Pragma("unroll") \
        for (int mt = 0; mt < 2; ++mt) { acc[mt][0] = (f32x4){ba, ba, ba, ba}; acc[mt][1] = (f32x4){bx, bx, bx, bx}; } \
        _Pragma("unroll") \
        for (int ks = 0; ks < 8; ++ks) { const int ch = 4 * ks + fq; \
        _Pragma("unroll") \
            for (int mt = 0; mt < 2; ++mt) { const int arow = 32 * rq + 16 * mt + fr; \
                const bf16x8 af = *(const LAS bf16x8*)(Ab + arow * 512 + ((ch ^ (arow & 15)) << 4)); \
                acc[mt][0] = __builtin_amdgcn_mfma_f32_16x16x32_bf16(af, bfr[0][ks], acc[mt][0], 0, 0, 0); \
                acc[mt][1] = __builtin_amdgcn_mfma_f32_16x16x32_bf16(af, bfr[1][ks], acc[mt][1], 0, 0, 0); } } \
 \
        float av[2][4], bv[2][4], sA[2], sB[2]; \
        _Pragma("unroll") \
        for (int mt = 0; mt < 2; ++mt) { float A = 1.f, Bv = 0.f; \
        _Pragma("unroll") \
            for (int j = 0; j < 4; ++j) { const int row = 32 * rq + 16 * mt + 4 * fq + j; \
                const unsigned short xb16 = *(const LAS unsigned short*)(Ab + row * 512 + ((((kx >> 3) ^ (row & 15))) << 4) + (kx & 7) * 2); \
                const float xc = __builtin_bit_cast(float, (unsigned)xb16 << 16); \
                const float r_ = __builtin_amdgcn_rcpf(1.0f + __builtin_amdgcn_exp2f(acc[mt][0][j])), i_ = __builtin_amdgcn_rcpf(1.0f + __builtin_amdgcn_exp2f(acc[mt][1][j])); \
                const float aa = __builtin_amdgcn_exp2f(-sp8 * r_); \
                const float mult = __builtin_amdgcn_sqrtf(fmaxf(fmaf(-aa, aa, 1.0f), 0.f)); \
                av[mt][j] = aa; bv[mt][j] = mult * i_ * xc; \
                Bv = fmaf(aa, Bv, bv[mt][j]); A *= aa; } \
            sA[mt] = A; sB[mt] = Bv; } \
 \
        float eA[2], eB[2], tA[2], tB[2]; \
        _Pragma("unroll") \
        for (int mt = 0; mt < 2; ++mt) { float A = sA[mt], Bv = sB[mt]; \
            { const float pA = __shfl_up(A, 16), pB = __shfl_up(Bv, 16); if (fq >= 1) { Bv = fmaf(A, pB, Bv); A *= pA; } } \
            { const float pA = __shfl_up(A, 32), pB = __shfl_up(Bv, 32); if (fq >= 2) { Bv = fmaf(A, pB, Bv); A *= pA; } } \
            const float xA = __shfl_up(A, 16), xB = __shfl_up(Bv, 16); eA[mt] = fq >= 1 ? xA : 1.f; eB[mt] = fq >= 1 ? xB : 0.f; \
            tA[mt] = __shfl(A, 48 + fr); tB[mt] = __shfl(Bv, 48 + fr); } \
        const float wA = tA[0] * tA[1], wB = fmaf(tA[1], tB[0], tB[1]); \
        if (fq == 0) { tot[(rq * 32 + cl) * 2] = wA; tot[(rq * 32 + cl) * 2 + 1] = wB; } \
        asm volatile("s_waitcnt lgkmcnt(0)" ::: "memory"); __builtin_amdgcn_s_barrier(); asm volatile("" ::: "memory"); \
        float hin = hc, hnew = hc; \
        _Pragma("unroll") \
        for (int q = 0; q < 4; ++q) { const float qA = tot[(q * 32 + cl) * 2], qB = tot[(q * 32 + cl) * 2 + 1]; hnew = fmaf(qA, hnew, qB); if (q < rq) hin = hnew; } \
        hc = hnew; \
        _Pragma("unroll") \
        for (int mt = 0; mt < 2; ++mt) { float h = mt == 0 ? hin : fmaf(tA[0], hin, tB[0]); \
            h = fmaf(eA[mt], h, eB[mt]); \
        _Pragma("unroll") \
            for (int j = 0; j < 4; ++j) { h = fmaf(av[mt][j], h, bv[mt][j]); \
                const float gv = __builtin_bit_cast(float, (unsigned)ggv[mt][j] << 16); \
                __builtin_amdgcn_raw_buffer_store_b16((unsigned short)cvtpk_bf16(h * gv, 0.f), GOr, gvo, (t0 + 16 * mt + j) * (DM * 2), 0); } } \
        asm volatile("s_waitcnt lgkmcnt(0)" ::: "memory"); \
        asm volatile("s_waitcnt vmcnt(8)" ::: "memory"); \
    } while (0)
    for (int cc = 0; cc < SEQ / 128; cc += 2) { RG_CHUNK(0, cc); RG_CHUNK(1, cc + 1); }
#undef RG_CHUNK
#undef RG_DMA
    asm volatile("s_waitcnt vmcnt(0) lgkmcnt(0)" ::: "memory"); __builtin_amdgcn_s_barrier(); asm volatile("" ::: "memory");
}
constexpr float SKIP_LOG2 = 40.0f;
__device__ __forceinline__ int attn_jlo(const Frame& F, const float* CB, const unsigned* NORM, int bh, int qb) {
    float qs = 0.f, ks = 0.f;
#pragma unroll
    for (int w = 0; w < 4; ++w) { qs += __uint_as_float(NORM[(bh) * 4 + w]); ks += __uint_as_float(NORM[(64 + bh) * 4 + w]); }
    constexpr float C2 = 1.4426950408889634f * 0.08838834764831845f;
    const float th = SKIP_LOG2 + 2.0f * 1.02f * sqrtf(qs * ks) * C2 + 4.0f;
    const float ref = CB[(size_t)bh * SEQ + qb * 256], v = CB[(size_t)bh * SEQ + 64 * F.lane + 63];
    const unsigned long long m = __ballot(F.lane < 4 * qb && (ref - v) * C2 > th);
    int j = __builtin_popcountll(m); if (m != ((j >= 64) ? ~0ull : ((1ull << j) - 1ull))) j = 0;
    return j & ~1;
}
__device__ __forceinline__ fattn::BlockRef attn_ref(int bh, int qb, int jlo) {
    const int b = bh >> 3, h = bh & 7;
    fattn::BlockRef r; r.qo = ((unsigned)bh * SEQ + (unsigned)qb * 256u) * HD; r.oo = ((unsigned)b * SEQ + (unsigned)qb * 256u) * DM + h * HD; r.kvo = (unsigned)bh * SEQ * HD; r.cbo = (unsigned)bh * SEQ; r.P0 = qb * 256; r.jlo = jlo; return r;
}
__device__ __forceinline__ void attn_phase(const Frame& F, char* lds, const bf16* Qb, bf16* Ob, const bf16* Kb, const bf16* Vb, const float* CB, const int* JLO, gu32* QCTR, const int probe = 0) {
#define ATT_JLO(bh_, qb_) (probe == 1 ? 4 * (qb_) : probe == 2 ? 0 : __builtin_amdgcn_readfirstlane(JLO[(bh_) * 16 + (qb_)]))
    constexpr int NBLK = 128;
    const int M = F.G >> 3; if ((F.G & 7) || M > 64 || M < 1) return;
    const int x = F.vcu / M, r = F.vcu % M;
    volatile LAS int* tk_l = (volatile LAS int*)(F.lds + MISC_OFF + 64);
    gu32* qc = QCTR + 64 * x;
    const fattn::Bases G{Qb, Ob, Kb, Vb, CB}; LAS unsigned char* const ldsa = F.lds + RING_OFF;
#define ATT_DEC(k_, bh_, qb_) do { const int i_ = (k_) & 7; bh_ = (i_ < 4 ? 4 * x + i_ : 32 + 4 * x + (i_ - 4)); qb_ = 15 - ((k_) >> 3); } while (0)
    int bh, qb; ATT_DEC(r, bh, qb);
    fattn::BlockRef cur = attn_ref(bh, qb, ATT_JLO(bh, qb));
    ATT_DEC(r + M, bh, qb);
    fattn::BlockRef nxt = attn_ref(bh, qb, ATT_JLO(bh, qb)); bool nxt_ok = (r + M) < NBLK;
    fattn::Seam S;
    fattn::prime(G, cur, lds, ldsa, S);
    bool more = true;
    for (;;) {
        unsigned tkt = 0u;
        if (more && F.tid == 0) tkt = __hip_atomic_fetch_add(qc, 1u, __ATOMIC_RELAXED, __HIP_MEMORY_SCOPE_AGENT);
        const bool last = !nxt_ok;
        fattn::block(G, cur, last ? cur : nxt, lds, ldsa, S);
        if (last) break;
        if (F.tid == 0) tk_l[0] = more ? (int)tkt + 2 * M : NBLK;
        __syncthreads();
        const int k2 = __builtin_amdgcn_readfirstlane(tk_l[0]);
        __syncthreads();
        cur = nxt;
        if (k2 < NBLK) { ATT_DEC(k2, bh, qb); nxt = attn_ref(bh, qb, ATT_JLO(bh, qb)); nxt_ok = true; } else { nxt_ok = false; more = false; }
    }
#undef ATT_DEC
#undef ATT_JLO
}
typedef float f32x16 __attribute__((ext_vector_type(16)));
struct P5Args { const float *X, *WRT, *b_rgrp, *b_rexp, *w_down; const bf16* DL; bf16* X1B; unsigned char *X8, *W2; float* RS2; int* LISTS; unsigned* TOK; gu32* CNT; };
__device__ __forceinline__ void p5_route(const Frame& F, const P5Args& a) {
    const int tid = F.tid, lane = F.lane, wid = F.wave, i16 = lane & 15, h4 = lane >> 4;
    constexpr int LDA = 132;
    LAS float* A_l = (LAS float*)(F.lds + RING_OFF) + wid * 16 * LDA;
    LAS float* B_l = (LAS float*)(F.lds + RING_OFF + 67584);
    LAS float* LG = (LAS float*)(F.lds + RING_OFF + 94208);
    LAS float* rs_l = (LAS float*)(F.lds + RING_OFF + 113664);
    LAS int* hist = (LAS int*)(F.lds + RING_OFF + 114176);
    LAS int* base_l = (LAS int*)(F.lds + RING_OFF + 114432);
    {
        LAS float* scr = (LAS float*)(F.lds + RING_OFF + wid * 8704);
        const int gw = F.vcu * NWAVES + wid, NGW = F.G * NWAVES;
        for (int it = gw; it < 8192; it += NGW) { const int e = it >> 8, kb = (it >> 5) & 7, nb = it & 31; const float* W = a.w_down + (size_t)e * DE * DM;
            const int drow = e * 1024 + (nb >> 3) * 256 + (nb & 1) * 128 + ((nb & 7) >> 1) * 32;
            transpose_tile8(W + (size_t)(64 * kb) * DM + 32 * nb, DM, a.W2 + (size_t)drow * DE + 64 * kb, DE, nullptr, pg8::W2_SCALE, scr, lane); }
    }
    __syncthreads();
    for (int rb = blockIdx.x; rb < T / 128; rb += F.G) {
        const int R0 = rb * 128;
        if (tid < 32) hist[tid] = 0;
        const int ar = lane >> 5, ac = 4 * (lane & 31);
        const size_t xo = (size_t)(R0 + 16 * wid + ar) * DM + ac; const float* xsrc = a.X + xo; const bf16* dsrc = a.DL + xo; unsigned char* xdst = a.X8 + xo; bf16* bdst = a.X1B + xo;
        f32x4 areg[8], breg[3]; unsigned long long dreg[8];
#define P5_LOAD(kc_) do { _Pragma("unroll") for (int i_ = 0; i_ < 8; ++i_) { areg[i_] = __builtin_nontemporal_load((const f32x4*)(xsrc + (size_t)(2 * i_) * DM + (kc_) * 128)); dreg[i_] = __builtin_nontemporal_load((const unsigned long long*)(dsrc + (size_t)(2 * i_) * DM + (kc_) * 128)); } \
        _Pragma("unroll") for (int q_ = 0; q_ < 3; ++q_) { const int idx_ = tid + 512 * q_; breg[q_] = *(const f32x4*)(a.WRT + (size_t)(idx_ >> 5) * DM + (kc_) * 128 + 4 * (idx_ & 31)); } } while (0)
        P5_LOAD(0);
        f32x4 acc[3] = {{0.f, 0.f, 0.f, 0.f}, {0.f, 0.f, 0.f, 0.f}, {0.f, 0.f, 0.f, 0.f}}; float ss = 0.f;
        for (int kc = 0; kc < 8; ++kc) {
#pragma unroll
            for (int i = 0; i < 8; ++i) { const unsigned dl = (unsigned)dreg[i], dh = (unsigned)(dreg[i] >> 32);
                areg[i][0] += bf_lo(dl); areg[i][1] += bf_hi(dl); areg[i][2] += bf_lo(dh); areg[i][3] += bf_hi(dh);
                *(unsigned*)(xdst + (size_t)(2 * i) * DM + kc * 128) = pg8::pack4_fp8(areg[i][0], areg[i][1], areg[i][2], areg[i][3]);
                *(unsigned long long*)(bdst + (size_t)(2 * i) * DM + kc * 128) = (unsigned long long)pg8::cvt_pk_bf16(areg[i][0], areg[i][1]) | ((unsigned long long)pg8::cvt_pk_bf16(areg[i][2], areg[i][3]) << 32);
                *(LAS f32x4*)(A_l + (2 * i + ar) * LDA + ac) = areg[i]; }
#pragma unroll
            for (int q = 0; q < 3; ++q) { const int idx = tid + 512 * q; *(LAS f32x4*)(B_l + (idx >> 5) * LDA + 4 * (idx & 31)) = breg[q]; }
            __syncthreads();
            if (kc + 1 < 8) P5_LOAD(kc + 1);
#pragma unroll
            for (int jj = 0; jj < 8; ++jj) {
                const f32x4 af = *(const LAS f32x4*)(A_l + i16 * LDA + 16 * jj + 4 * h4);
                f32x4 bfv[3];
#pragma unroll
                for (int nt = 0; nt < 3; ++nt) bfv[nt] = *(const LAS f32x4*)(B_l + (16 * nt + i16) * LDA + 16 * jj + 4 * h4);
                ss += (af[0] * af[0] + af[1] * af[1]) + (af[2] * af[2] + af[3] * af[3]);
#pragma unroll
                for (int s = 0; s < 4; ++s)
#pragma unroll
                    for (int nt = 0; nt < 3; ++nt) acc[nt] = __builtin_amdgcn_mfma_f32_16x16x4f32(af[s], bfv[nt][s], acc[nt], 0, 0, 0);
            }
            __syncthreads();
        }
#undef P5_LOAD
        ss += __shfl_xor(ss, 16); ss += __shfl_xor(ss, 32);
        const float rs = 1.0f / sqrtf(ss * (1.0f / DM) + EPS);
        if (h4 == 0) { a.RS2[R0 + 16 * wid + i16] = rs; rs_l[16 * wid + i16] = rs; }
#pragma unroll
        for (int r = 0; r < 4; ++r) { const int rl = 16 * wid + 4 * h4 + r; LG[rl * 37 + i16] = acc[0][r]; LG[rl * 37 + 16 + i16] = acc[1][r]; if (i16 < 4) LG[rl * 37 + 32 + i16] = acc[2][r]; }
        __syncthreads();
        int e0 = 0, e1 = 0, k0 = 0, k1 = 0; float w0 = 0.f, w1 = 0.f;
        if (tid < 128) {
            const float rsv = rs_l[tid]; const LAS float* lg = LG + tid * 37;
            float gl[4];
#pragma unroll
            for (int q = 0; q < 4; ++q) gl[q] = lg[32 + q] * rsv + a.b_rgrp[q];
            int gs = 0; float gm = gl[0];
#pragma unroll
            for (int q = 1; q < 4; ++q) if (gl[q] > gm) { gm = gl[q]; gs = q; }
            float den = 0.f;
#pragma unroll
            for (int q = 0; q < 4; ++q) den += expf(gl[q] - gm);
            const float pg = 1.0f / den;
            float el[8];
#pragma unroll
            for (int q = 0; q < 8; ++q) el[q] = lg[8 * gs + q] * rsv + a.b_rexp[8 * gs + q];
            int i0 = 0; float v0 = el[0];
#pragma unroll
            for (int q = 1; q < 8; ++q) if (el[q] > v0) { v0 = el[q]; i0 = q; }
            int i1 = -1; float v1 = -INFINITY;
#pragma unroll
            for (int q = 0; q < 8; ++q) if (q != i0 && el[q] > v1) { v1 = el[q]; i1 = q; }
            const float ex = expf(v1 - v0);
            w0 = pg / (1.0f + ex); w1 = pg * ex / (1.0f + ex);
            e0 = 8 * gs + i0; e1 = 8 * gs + i1;
            k0 = atomicAdd((int*)(hist + e0), 1); k1 = atomicAdd((int*)(hist + e1), 1);
        }
        __syncthreads();
        if (tid < 32) base_l[tid] = (int)__hip_atomic_fetch_add(a.CNT + tid, (unsigned)hist[tid], __ATOMIC_RELAXED, __HIP_MEMORY_SCOPE_AGENT);
        __syncthreads();
        if (tid < 128) { const int tok = R0 + tid, s0 = base_l[e0] + k0, s1 = base_l[e1] + k1;
            a.LISTS[(size_t)e0 * T + s0] = tok; a.LISTS[(size_t)e1 * T + s1] = tok;
            v4u i0v = {(unsigned)e0, (unsigned)s0, (unsigned)e1, (unsigned)s1}, i1v = {__float_as_uint(w0), __float_as_uint(w1), 0u, 0u};
            *(GAS v4u*)(a.TOK + (size_t)tok * 8) = i0v; *(GAS v4u*)(a.TOK + (size_t)tok * 8 + 4) = i1v; }
        __syncthreads();
    }
}
__device__ __forceinline__ void build_tables(const Frame& F, const gu32* CNT) {
    LAS int* ps = (LAS int*)(F.lds + TBL_PS); LAS int* cn = (LAS int*)(F.lds + TBL_CN); LAS int* te = (LAS int*)(F.lds + TBL_TE);
    __syncthreads();
    if (F.tid < 32) { int c = (int)__hip_atomic_load(CNT + F.tid, __ATOMIC_RELAXED, __HIP_MEMORY_SCOPE_AGENT); c = c < 0 ? 0 : (c > T ? T : c); cn[F.tid] = c; }
    __syncthreads();
    if (F.tid == 0) { int run = 0; for (int e = 0; e < 32; ++e) { ps[e] = run; run += (cn[e] + 255) & ~255; } if (run > PMAX) run = PMAX; ps[32] = run; }
    __syncthreads();
    if (F.tid < 288) { const int p = F.tid * 256; int e = 0; for (int q = 1; q < 32; ++q) if (p >= ps[q]) e = q; te[F.tid] = e; }
    __syncthreads();
}
template <class Ord> __device__ __forceinline__ void build_rowtab(const Frame& F, const Ord& S, const int* LISTS, const float* RS2, LAS int* rowtab) {
    const LAS int* ps = (const LAS int*)(F.lds + TBL_PS); const LAS int* cn = (const LAS int*)(F.lds + TBL_CN); const LAS int* te = (const LAS int*)(F.lds + TBL_TE);
    pg8::Unit u;
    for (int ui = 0; ui < 6 && S.next(ui, u); ++ui)
        if (F.tid < 256) { const int p = u.pm * 256 + F.tid, e = te[u.pm], local = p - ps[e]; const int tok = local < cn[e] ? LISTS[(size_t)e * T + local] : 0; rowtab[ui * 256 + F.tid] = tok; ((LAS float*)rowtab)[(6 + ui) * 256 + F.tid] = RS2[tok]; }
    __syncthreads();
}
__device__ __forceinline__ float fp8_f32(unsigned w, int i) { return i == 0 ? __builtin_amdgcn_cvt_f32_fp8(w, 0) : (i == 1 ? __builtin_amdgcn_cvt_f32_fp8(w, 1) : (i == 2 ? __builtin_amdgcn_cvt_f32_fp8(w, 2) : __builtin_amdgcn_cvt_f32_fp8(w, 3))); }
__device__ __forceinline__ void p9_final(const Frame& F, const bf16* X1B, float* OUT, const unsigned char* Y, const unsigned* TOK, const float* g_final) {
    const LAS int* ps = (const LAS int*)(F.lds + TBL_PS);
    const int gw = F.vcu * NWAVES + F.wave, NGW = F.G * NWAVES;
    f32x4 gf[4];
#pragma unroll
    for (int j = 0; j < 4; ++j) gf[j] = *((const f32x4*)g_final + F.lane + 64 * j);
    constexpr float YS = 1.0f / (pg8::HB_SCALE * pg8::W2_SCALE * pg8::Y_SCALE);
    v4u ia_n = {0u, 0u, 0u, 0u}, ib_n = {0u, 0u, 0u, 0u}, ia_c = ia_n, ib_c = ib_n; unsigned long long xw_n[4]; unsigned ya_n[4], yb_n[4];
#define P9_TOK(m_, ia_, ib_) do { ia_ = *(const GAS v4u*)(TOK + (size_t)(m_) * 8); ib_ = *(const GAS v4u*)(TOK + (size_t)(m_) * 8 + 4); } while (0)
#define P9_ROW(m_, ia_) do { const size_t p0_ = (size_t)(ps[(int)(ia_.x & 31u)] + (int)ia_.y), p1_ = (size_t)(ps[(int)(ia_.z & 31u)] + (int)ia_.w); \
        const GAS unsigned long long* xr_ = (const GAS unsigned long long*)(X1B + (size_t)(m_) * DM) + F.lane; \
        const GAS unsigned* y0_ = (const GAS unsigned*)(Y + p0_ * DM) + F.lane; const GAS unsigned* y1_ = (const GAS unsigned*)(Y + p1_ * DM) + F.lane; \
        _Pragma("unroll") for (int j = 0; j < 4; ++j) { xw_n[j] = __builtin_nontemporal_load((const unsigned long long*)xr_ + 64 * j); ya_n[j] = __builtin_nontemporal_load((const unsigned*)y0_ + 64 * j); yb_n[j] = __builtin_nontemporal_load((const unsigned*)y1_ + 64 * j); } } while (0)
    if (gw < T) { P9_TOK(gw, ia_c, ib_c); P9_ROW(gw, ia_c); if (gw + NGW < T) P9_TOK(gw + NGW, ia_n, ib_n); }
    for (int m = gw; m < T; m += NGW) {
        const float w0 = __uint_as_float(ib_c.x) * YS, w1 = __uint_as_float(ib_c.y) * YS;
        unsigned long long xw[4]; unsigned ya[4], yb[4];
#pragma unroll
        for (int j = 0; j < 4; ++j) { xw[j] = xw_n[j]; ya[j] = ya_n[j]; yb[j] = yb_n[j]; }
        if (m + NGW < T) { ia_c = ia_n; ib_c = ib_n; P9_ROW(m + NGW, ia_c); if (m + 2 * NGW < T) P9_TOK(m + 2 * NGW, ia_n, ib_n); }
        GAS f32x4* orow = (GAS f32x4*)(OUT + (size_t)m * DM) + F.lane;
        f32x4 v[4]; float s = 0.f;
#pragma unroll
        for (int j = 0; j < 4; ++j) { v[j] = (f32x4){bf_lo((unsigned)xw[j]), bf_hi((unsigned)xw[j]), bf_lo((unsigned)(xw[j] >> 32)), bf_hi((unsigned)(xw[j] >> 32))}; const unsigned a = ya[j], b = yb[j];
            v[j].x += w0 * fp8_f32(a, 0) + w1 * fp8_f32(b, 0); v[j].y += w0 * fp8_f32(a, 1) + w1 * fp8_f32(b, 1);
            v[j].z += w0 * fp8_f32(a, 2) + w1 * fp8_f32(b, 2); v[j].w += w0 * fp8_f32(a, 3) + w1 * fp8_f32(b, 3);
            s += (v[j].x * v[j].x + v[j].y * v[j].y) + (v[j].z * v[j].z + v[j].w * v[j].w); }
        s = wave_sum(s);
        const float rs = 1.0f / sqrtf(s * (1.0f / DM) + EPS);
#pragma unroll
        for (int j = 0; j < 4; ++j) orow[64 * j] = v[j] * rs * gf[j];
    }
#undef P9_TOK
#undef P9_ROW
}

constexpr int N_PHASES = 10;
#ifndef DUP_TRIVIAL
#define DUP_TRIVIAL 0
#endif
#ifndef P8_HOOK
#define P8_HOOK 3
#endif
#ifndef DUP_PHASE
#define DUP_PHASE -1
#endif
typedef __attribute__((address_space(4))) const unsigned char* karg_ptr;
__device__ __forceinline__ const float* arg_in(int k) { karg_ptr base = (karg_ptr)__builtin_amdgcn_kernarg_segment_ptr(); const unsigned long long v = *(const unsigned long long volatile __attribute__((address_space(4)))*)(base + 8 * k); return (const float*)(const GAS float*)v; }
struct Args { const float* in[23]; float* out; unsigned char* ws; int ph_lo, ph_hi, mode, pad; };
__global__ void __launch_bounds__(NWAVES * 64, 2) fwd_kernel(Args args) {
    extern __shared__ __attribute__((aligned(16))) unsigned char lds[];
    Frame F;
    F.lds = (LAS unsigned char*)lds;
    F.wave = __builtin_amdgcn_readfirstlane((int)threadIdx.x >> 6); F.lane = pg8::lane_now(); F.tid = F.wave * 64 + F.lane;
    F.G = gridDim.x; { const int bx = blockIdx.x; F.vcu = (F.G % 8 == 0) ? (bx % 8) * (F.G / 8) + bx / 8 : bx; }
    unsigned char* ws = args.ws;
    gu32* ctl = (gu32*)(ws + WS_CTL);
    volatile LAS unsigned* MISC = (volatile LAS unsigned*)(F.lds + MISC_OFF);
    for (int u = F.tid; u < (LDS_BYTES - LDSCTL_OFF) / 4; u += NWAVES * 64) ((LAS unsigned*)(F.lds + LDSCTL_OFF))[u] = 0u;
    __syncthreads();
#if MK_ONE_LAUNCH
    XcdBarrier bar = xcd_barrier_post((unsigned*)(ctl + CW_BAR), MISC + 8);
#define GRID_BAR() xcd_barrier(bar)
#else
#define GRID_BAR() do { } while (0)
#endif
    const int lo = args.ph_lo, hi = args.ph_hi;
#ifndef PH_MASK
#define PH_MASK 0x3ff
#endif
#define IN(k) (((PH_MASK >> (k)) & 1) && lo <= (k) && (k) < hi)
#define BOTH(k) (IN(k) && IN((k) + 1))
    float* out = args.out;
    bf16* Win = (bf16*)(ws + WS_WIN); bf16* Wl = (bf16*)(ws + WS_WL); bf16* Wa = (bf16*)(ws + WS_WA); bf16* Wo = (bf16*)(ws + WS_WO); bf16* Wrg = (bf16*)(ws + WS_WRG);
    bf16* XB = (bf16*)(ws + WS_XB); bf16* XR = (bf16*)(ws + WS_XR); bf16* GG = (bf16*)(ws + WS_GG); bf16* Qb = (bf16*)(ws + WS_Q); bf16* Kb = (bf16*)(ws + WS_K); bf16* Vb = (bf16*)(ws + WS_V);
    bf16* SL = (bf16*)out; bf16* SA = (bf16*)out + pg8::SEGE;
    float* RS1 = (float*)(ws + WS_RS1); float* RS2 = (float*)(ws + WS_RS2); float* LF = (float*)(ws + WS_LF); float* CB = (float*)(ws + WS_CB);
    unsigned* TOK = (unsigned*)(ws + WS_TOK); int* LISTS = (int*)(ws + WS_LISTS); float* WRT = (float*)(ws + WS_WRT); int* JLO = (int*)(ws + WS_SRS);
    unsigned char* W13 = ws + WS_W13; unsigned char* W2 = ws + WS_W2; bf16* XG = (bf16*)(ws + WS_XG); unsigned char* HB = ws + WS_HB; unsigned char* X8 = ws + WS_XB;
    gu32* CNT = ctl + CW_CNT;

    if (IN(0)) { F.lane = pg8::lane_now(); F.tid = F.wave * 64 + F.lane;
        P0Args a{arg_in(0), arg_in(1), arg_in(2), arg_in(5), arg_in(7), arg_in(10), arg_in(11), arg_in(12), arg_in(13), arg_in(14), arg_in(15), arg_in(17), arg_in(19), arg_in(20), Win, Wl, Wa, Wo, Wrg, XB, W13, RS1, LF, WRT, ws + WS_WIN8, ws + WS_X8P};
        p0_prologue(F, a, DUP_PHASE == 0 ? args.mode : 0);
        if (BOTH(0)) GRID_BAR();
    }
    if (IN(1)) { F.lane = pg8::lane_now(); F.tid = F.wave * 64 + F.lane;
        cumsum_bias(F, LF, CB);
        { constexpr int NB16 = seg_cnt(false) * 1024;
          pg8::Gemm g{XB, Win, T, NB16, DM}; pg8::StaticOrder S; S.init(T, NB16, F.G, (int)blockIdx.x);
          pg8::EpiZ E{XR, SL, RS1, (unsigned*)(ctl + CW_NORM), args.mode, seg_map(false), 1.0f};
          pg8::gemm_phase<pg8::EpiZ, pg8::StaticOrder, true, true>(F.lds + RING_OFF, g, S, E, F.wave); }
        __syncthreads();
        { constexpr int NF8 = seg_cnt(true) * 1024;
          pg8::Gemm g{(const bf16*)(ws + WS_X8P), (const bf16*)(ws + WS_WIN8), T, NF8, DM / 2}; pg8::StaticOrder S; S.init(T, NF8, F.G, (int)blockIdx.x);
          pg8::EpiZ E{XR, SL, RS1, (unsigned*)(ctl + CW_NORM), args.mode, seg_map(true), 1.0f / (pg8::XS_SCALE * pg8::WIN_SCALE)};
          pg8::gemm_phase<pg8::EpiZ, pg8::StaticOrder, true, true, true>(F.lds + RING_OFF, g, S, E, F.wave); }
        if (BOTH(1)) GRID_BAR();
    }
    if (IN(2)) { F.lane = pg8::lane_now(); F.tid = F.wave * 64 + F.lane;
        { const int gw = F.vcu * NWAVES + F.wave; if (gw < NB * NH * 16) { const int j = attn_jlo(F, CB, (const unsigned*)(ctl + CW_NORM), gw >> 4, gw & 15); if (F.lane == 0) JLO[gw] = j; } }
        conv_prepass(F, XR, XB, arg_in(3), arg_in(4));
        if (BOTH(2)) GRID_BAR();
    }
    if (IN(3)) { F.lane = pg8::lane_now(); F.tid = F.wave * 64 + F.lane;
        RgArgs ra{XB, GG, GG, Wrg, arg_in(6), arg_in(8), arg_in(9)};
#if DUP_PHASE >= 20
        const int mode = args.mode;
#else
        constexpr int mode = 0;
#endif
        if (mode < 2) { ra.GO = mode == 1 ? XR : GG; for (int u = F.vcu; u < 256; u += F.G) rglru_unit(F, ra, u); }
        if (mode != 1) attn_phase(F, (char*)lds + RING_OFF, Qb, XR, Kb, Vb, CB, JLO, ctl + CW_QCTR + (mode >= 2 ? 1024 : 0), mode >= 3 ? mode - 2 : 0);
        if (BOTH(3)) GRID_BAR();
    }
    if (IN(4)) { { F.lane = pg8::lane_now(); F.tid = F.wave * 64 + F.lane;
        static_assert(WS_GG - WS_XR == (size_t)128 * 256 * DM * 2 && WS_WL - WS_WA == (size_t)4 * 256 * DM * 2, "TwoGemmOrder: hg follows o by 128 row tiles, Wl follows Wa by 4 column tiles");
        pg8::Gemm g{XR, Wa, T, DM, DM}; pg8::TwoGemmOrder S; S.init(T, DM, F.G, (int)blockIdx.x);
        pg8::EpiGate2 E{SA, SL, XB};
        pg8::gemm_phase<pg8::EpiGate2, pg8::TwoGemmOrder, true, true>(F.lds + RING_OFF, g, S, E, F.wave); }
        if (BOTH(4)) GRID_BAR();
    }
    if (IN(5)) { F.lane = pg8::lane_now(); F.tid = F.wave * 64 + F.lane;
        pg8::Gemm g{XB, Wo, T, DM, DM}; pg8::StaticOrder S; S.init(T, DM, F.G, (int)blockIdx.x);
        pg8::EpiDelta E{(bf16*)out};
        pg8::gemm_phase<pg8::EpiDelta, pg8::StaticOrder, true, true>(F.lds + RING_OFF, g, S, E, F.wave);
        if (BOTH(5)) GRID_BAR();
    }
    if (IN(6)) { F.lane = pg8::lane_now(); F.tid = F.wave * 64 + F.lane;
        P5Args a{arg_in(0), WRT, arg_in(16), arg_in(18), arg_in(21), (const bf16*)out, XR, X8, W2, RS2, LISTS, TOK, args.mode ? CNT + 64 : CNT};
        p5_route(F, a);
        if (BOTH(6)) GRID_BAR();
    }
    if (IN(7)) { F.lane = pg8::lane_now(); F.tid = F.wave * 64 + F.lane;
        build_tables(F, CNT);
        const int ntiles = ((const LAS int*)(F.lds + TBL_PS))[32] >> 8;
        pg8::Gemm g{(const bf16*)X8, (const bf16*)W13, ntiles * 256, 32 * 1024, DM / 2}; pg8::GroupedOrderT<1> S{(const LAS int*)(F.lds + TBL_TE), ntiles * 4, F.G, F.vcu, (unsigned*)(ctl + CW_RDY), F.wave, (unsigned*)(ctl + CW_TMO)};
        LAS int* rowtab = (LAS int*)(F.lds + RG_TOT);
        build_rowtab(F, S, LISTS, RS2, rowtab);
        pg8::EpiSwiGLU E{HB};
        pg8::gemm_phase_gather<pg8::EpiSwiGLU, pg8::GroupedOrderT<1>, true>(F.lds + RING_OFF, g, S, E, rowtab, F.wave);
    }
    if (IN(8)) { F.lane = pg8::lane_now(); F.tid = F.wave * 64 + F.lane;
        build_tables(F, CNT);
        const int ntiles = ((const LAS int*)(F.lds + TBL_PS))[32] >> 8;
        pg8::Gemm g{(const bf16*)HB, (const bf16*)W2, ntiles * 256, 32 * 1024, DE / 2}; pg8::GroupedOrderT<P8_HOOK> S{(const LAS int*)(F.lds + TBL_TE), ntiles * 4, F.G, F.vcu, (unsigned*)(ctl + CW_RDY), F.wave, (unsigned*)(ctl + CW_TMO)};
#if P8_HOOK == 3
        if (F.wave == 0) { unsigned sp = 0u; const int Lu = F.lane < 32 ? S.unit_index(F.lane) : -1; const unsigned* rp = (const unsigned*)(ctl + CW_RDY) + 8 * (Lu < 0 ? 0 : (Lu >> 2));
            for (;;) { const unsigned v = Lu < 0 ? 32u : __hip_atomic_load(rp, __ATOMIC_RELAXED, __HIP_MEMORY_SCOPE_AGENT);
                if (__all(v >= 32u)) break;
                __builtin_amdgcn_s_sleep(2);
                if ((++sp & 1023u) == 0u) { if (__hip_atomic_load((const unsigned*)(ctl + CW_TMO), __ATOMIC_RELAXED, __HIP_MEMORY_SCOPE_AGENT) != 0u) break;
                    if (sp > (1u << 20)) { if (F.lane == 0) __hip_atomic_store((unsigned*)(ctl + CW_TMO), 1u, __ATOMIC_RELAXED, __HIP_MEMORY_SCOPE_AGENT); break; } } }
            __builtin_amdgcn_fence(__ATOMIC_ACQUIRE, "agent");
            asm volatile("s_waitcnt vmcnt(0)" ::: "memory"); }
        __syncthreads();
#endif
        pg8::EpiY E{(unsigned char*)XG, args.mode};
        pg8::gemm_phase<pg8::EpiY, pg8::GroupedOrderT<P8_HOOK>, true, true, true>(F.lds + RING_OFF, g, S, E, F.wave);
        if (BOTH(8)) GRID_BAR();
    }
    if (IN(9)) { F.lane = pg8::lane_now(); F.tid = F.wave * 64 + F.lane;
        build_tables(F, CNT);
        p9_final(F, XR, out, (const unsigned char*)XG, TOK, arg_in(22));
    }
#undef IN
#undef BOTH
}

extern "C" void kernel_launch(void* const* d_in, const int* in_sizes, int n_in, void* d_out, int out_size, void* d_ws, size_t ws_size, hipStream_t stream) {
    static int grid = 0;
    if (grid == 0) {
        if (n_in != 23 || in_sizes[0] != T * DM || out_size != T * DM || ws_size < WS_END) { fprintf(stderr, "kernel_launch: unexpected shapes (n_in %d, in0 %d, out %d, ws %zu); nothing launched\n", n_in, n_in > 0 ? in_sizes[0] : -1, out_size, ws_size); grid = -1; return; }
        int dev = 0, cus = 0;
        if (hipGetDevice(&dev) != hipSuccess || hipDeviceGetAttribute(&cus, hipDeviceAttributeMultiprocessorCount, dev) != hipSuccess) { grid = -1; return; }
        if (hipFuncSetAttribute((const void*)fwd_kernel, hipFuncAttributeMaxDynamicSharedMemorySize, LDS_BYTES) != hipSuccess) { fprintf(stderr, "kernel_launch: hipFuncSetAttribute failed\n"); grid = -1; return; }
        int per_cu = 0;
        if (hipOccupancyMaxActiveBlocksPerMultiprocessor(&per_cu, (const void*)fwd_kernel, NWAVES * 64, LDS_BYTES) != hipSuccess || per_cu < 1) { fprintf(stderr, "kernel_launch: occupancy query reports %d\n", per_cu); }
        (void)hipGetLastError();
        grid = cus;
    }
    if (grid < 0) return;
    if (hipMemsetAsync((char*)d_ws + WS_CTL, 0, CTL_ZERO_BYTES, stream) != hipSuccess) return;
    Args a{};
    for (int i = 0; i < 23; ++i) a.in[i] = (const float*)d_in[i];
    a.out = (float*)d_out; a.ws = (unsigned char*)d_ws;
#if MK_ONE_LAUNCH
    a.ph_lo = 0; a.ph_hi = N_PHASES;
    hipLaunchKernelGGL(fwd_kernel, dim3(grid), dim3(NWAVES * 64), LDS_BYTES, stream, a);
#else
    for (int ph = 0; ph < N_PHASES; ++ph) { a.ph_lo = ph; a.ph_hi = ph + 1;
        if (DUP_PHASE == ph || (ph == 3 && DUP_PHASE >= 20)) { a.mode = DUP_PHASE >= 20 ? DUP_PHASE - 19 : (ph == 8 ? DUP_TRIVIAL : (ph == 6 || (ph == 1 && DUP_TRIVIAL)) ? 1 : (ph == 0 ? DUP_TRIVIAL : 0)); hipLaunchKernelGGL(fwd_kernel, dim3(grid), dim3(NWAVES * 64), LDS_BYTES, stream, a); a.mode = 0; }
        hipLaunchKernelGGL(fwd_kernel, dim3(grid), dim3(NWAVES * 64), LDS_BYTES, stream, a); }
#endif
}
```

```cpp
#include <hip/hip_runtime.h>
#include <cstdio>
#include <cstdint>

#ifndef MK_ONE_LAUNCH
#define MK_ONE_LAUNCH 1
#endif
namespace pg8 {
#define PG8_LAS __attribute__((address_space(3)))
typedef unsigned short bf16_t;
typedef short bf16x8 __attribute__((ext_vector_type(8)));
typedef float f32x4 __attribute__((ext_vector_type(4)));
typedef unsigned u32x4 __attribute__((ext_vector_type(4)));
constexpr int BM = 256, BK = 64, HALF = 128, HTB = HALF * BK * 2  , STAGE_BYTES = 8 * HTB, NXCD = 8, WGM = 8;

__host__ __device__ __forceinline__ int lds_byte(int r, int c) { const int st = (r >> 4) * 2 + (c >> 5), rr = r & 15, cc = c & 31, ob = rr * 64 + cc * 2; return st * 1024 + (ob ^ (((ob >> 9) & 1) << 5)); }
__host__ __device__ __forceinline__ void stage_rc(int b, int& R, int& C) { const int st = b / 1024, sb = b % 1024, swz = sb ^ (((sb >> 9) & 1) << 5); R = (st >> 1) * 16 + swz / 64; C = (st & 1) * 32 + (swz % 64) / 2; }
__host__ __device__ __forceinline__ int perm32(int rho) { const int n = rho >> 4, i = rho & 15; return 8 * (i >> 2) + 4 * n + (i & 3); }

struct Unit { int pm, pn; };
struct Gemm { const bf16_t* A; const bf16_t* Bt; int M, N, K; };

struct StaticOrder {
    int nM, nN, nwg, G, c;
    __host__ __device__ void init(int M, int N, int G_, int c_) { nM = M / BM; nN = N / BM; nwg = nM * nN; G = G_; c = c_; }
    __host__ __device__ bool next(int i, Unit& u) const {
        const long L = (long)i * G + c; if (L >= nwg) return false;
        int wgid = (int)L; { const int q = nwg / NXCD, r = nwg % NXCD, xcd = wgid % NXCD, off = wgid / NXCD; wgid = (xcd < r ? xcd * (q + 1) : r * (q + 1) + (xcd - r) * q) + off; }
        const int nig = WGM * nN, gid = wgid / nig, fm = gid * WGM, gsz = (nM - fm) < WGM ? (nM - fm) : WGM;
        u.pm = fm + ((wgid % nig) % gsz); u.pn = (wgid % nig) / gsz; return true;
    }
    __device__ __forceinline__ void a_ready(const Unit&) const {}
    __device__ __forceinline__ void done(const Unit&) const {}
};

__device__ __forceinline__ unsigned cvt_pk_bf16(float lo, float hi) { unsigned r; asm volatile("v_cvt_pk_bf16_f32 %0, %1, %2" : "=v"(r) : "v"(lo), "v"(hi)); return r; }
typedef float f32x2 __attribute__((ext_vector_type(2)));
__device__ __forceinline__ int lane_now() { int l; asm volatile("v_mbcnt_lo_u32_b32 %0, -1, 0\n\tv_mbcnt_hi_u32_b32 %0, -1, %0" : "=v"(l)); return l; }
typedef int v4i_t __attribute__((ext_vector_type(4)));
typedef int v8i_t __attribute__((ext_vector_type(8)));
__device__ __forceinline__ v8i_t cat8(bf16x8 a, bf16x8 b) { const v4i_t x = __builtin_bit_cast(v4i_t, a), y = __builtin_bit_cast(v4i_t, b); return __builtin_shufflevector(x, y, 0, 1, 2, 3, 4, 5, 6, 7); }
__device__ __forceinline__ void glds_sv(const char* base, unsigned voff, unsigned lds_dst) { unsigned keep;
    asm volatile("s_mov_b32 %0, m0\n\ts_mov_b32 m0, %3\n\ts_nop 0\n\tglobal_load_lds_dwordx4 %1, %2\n\ts_mov_b32 m0, %0" : "=&s"(keep) : "v"(voff), "s"(base), "s"(lds_dst) : "memory"); }
__device__ __forceinline__ float sat8(float x) { return __builtin_amdgcn_fmed3f(x, -448.0f, 448.0f); }
__device__ __forceinline__ unsigned pack4_fp8(float a, float b, float c, float d) { unsigned w = 0u; w = __builtin_amdgcn_cvt_pk_fp8_f32(sat8(a), sat8(b), w, false); w = __builtin_amdgcn_cvt_pk_fp8_f32(sat8(c), sat8(d), w, true); return w; }
constexpr float W13_SCALE = 64.0f, HB_SCALE = 8.0f, W2_SCALE = 32.0f, XS_SCALE = 16.0f, WIN_SCALE = 64.0f;
__device__ __forceinline__ float sigmoid_f(float x) { return __builtin_amdgcn_rcpf(1.0f + __builtin_amdgcn_exp2f(-1.4426950408889634f * x)); }
__device__ __forceinline__ float gelu_tanh_f(float x) { const float u = x * (1.0f + 0.044715f * x * x); return x * __builtin_amdgcn_rcpf(1.0f + __builtin_amdgcn_exp2f(-2.3022081981f * u)); }
__device__ __forceinline__ float bf_lo(unsigned w) { return __builtin_bit_cast(float, w << 16); }
__device__ __forceinline__ float bf_hi(unsigned w) { return __builtin_bit_cast(float, w & 0xffff0000u); }
constexpr size_t SEGE = (size_t)32768 * 1024;

template <unsigned SMAP_, bool F8_> struct EpiZT {
    static constexpr bool PERM = true, AFTER_DRAIN = false; static constexpr int NSTORES = 16;
    static constexpr unsigned smap = SMAP_; static constexpr float sc = F8_ ? 1.0f / (XS_SCALE * WIN_SCALE) : 1.0f;
    bf16_t* ws5; bf16_t* out2; const float* rs; unsigned* norm; int probe; const float* conv_w; const float* conv_b; float* side; PG8_LAS float* halo;
    static __device__ __forceinline__ void conv0(const f32x4 (&acc)[2][2][4][2], const Unit& u, int wr, int wc, int fr, int fq, bf16_t* O, int row0, int col0, const float sc, const float* const conv_w, const float* const conv_b, float* const side, PG8_LAS float* const halo) {
#pragma unroll
        for (int ai = 0; ai < 2; ++ai)
#pragma unroll
            for (int bj = 0; bj < 2; ++bj) { const f32x4 a0 = acc[ai][bj][3][0] * sc, a1 = acc[ai][bj][3][1] * sc;
                if (fr >= 13) { PG8_LAS float* h = halo + ((((ai * 2 + wr) * 4 + wc) * 3 + (fr - 13)) * 64 + bj * 32 + 8 * fq); *(PG8_LAS f32x4*)h = a0; *(PG8_LAS f32x4*)(h + 4) = a1; }
                if (ai == 1 && wr == 1 && fr >= 13) { float* sp = side + ((size_t)u.pm * 6 + 3 + (fr - 13)) * 1024 + col0 + bj * HALF; *(f32x4*)sp = a0; *(f32x4*)(sp + 4) = a1; }
                if (ai == 0 && wr == 0 && fr <= 2) { const f32x4 b0 = acc[0][bj][0][0] * sc, b1 = acc[0][bj][0][1] * sc; float* sp = side + ((size_t)u.pm * 6 + fr) * 1024 + col0 + bj * HALF; *(f32x4*)sp = b0; *(f32x4*)(sp + 4) = b1; } }
        asm volatile("s_waitcnt lgkmcnt(0)" ::: "memory"); __builtin_amdgcn_s_barrier(); asm volatile("" ::: "memory");
        const bool seq0 = (u.pm & 15) == 0;
#pragma unroll
        for (int bj = 0; bj < 2; ++bj) {
            float cw[4][8], cb[8];
#pragma unroll
            for (int j = 0; j < 4; ++j) { const f32x4 w0 = *(const f32x4*)(conv_w + j * 1024 + col0 + bj * HALF), w1 = *(const f32x4*)(conv_w + j * 1024 + col0 + bj * HALF + 4);
#pragma unroll
                for (int i = 0; i < 4; ++i) { cw[j][i] = w0[i]; cw[j][4 + i] = w1[i]; } }
            { const f32x4 w0 = *(const f32x4*)(conv_b + col0 + bj * HALF), w1 = *(const f32x4*)(conv_b + col0 + bj * HALF + 4);
#pragma unroll
              for (int i = 0; i < 4; ++i) { cb[i] = w0[i]; cb[4 + i] = w1[i]; } }
#pragma unroll
            for (int ai = 0; ai < 2; ++ai) { const int blk = ai * 2 + wr;
                float xm1[8];
                { const int hr = fr >= 13 ? fr - 13 : 0; const PG8_LAS float* h = halo + ((((blk > 0 ? blk - 1 : 0) * 4 + wc) * 3 + hr) * 64 + bj * 32 + 8 * fq);
                  const f32x4 p0 = *(const PG8_LAS f32x4*)h, p1 = *(const PG8_LAS f32x4*)(h + 4); const bool zero = blk == 0;
#pragma unroll
                  for (int i = 0; i < 4; ++i) { xm1[i] = zero ? 0.f : p0[i]; xm1[4 + i] = zero ? 0.f : p1[i]; } }
#pragma unroll
                for (int m = 0; m < 4; ++m) { float x0[8], y[8];
                    { const f32x4 a0 = acc[ai][bj][m][0] * sc, a1 = acc[ai][bj][m][1] * sc;
#pragma unroll
                      for (int i = 0; i < 4; ++i) { x0[i] = a0[i]; x0[4 + i] = a1[i]; } }
#pragma unroll
                    for (int i = 0; i < 8; ++i) { float v = fmaf(cw[3][i], x0[i], cb[i]);
                        asm volatile("s_nop 1\n\t"
                                     "v_fmac_f32_dpp %0, %1, %3 row_shr:1 row_mask:0xf bank_mask:0xf bound_ctrl:1\n\t"
                                     "v_fmac_f32_dpp %0, %2, %3 row_shl:15 row_mask:0xf bank_mask:0xf bound_ctrl:1\n\t"
                                     "v_fmac_f32_dpp %0, %1, %4 row_shr:2 row_mask:0xf bank_mask:0xf bound_ctrl:1\n\t"
                                     "v_fmac_f32_dpp %0, %2, %4 row_shl:14 row_mask:0xf bank_mask:0xf bound_ctrl:1\n\t"
                                     "v_fmac_f32_dpp %0, %1, %5 row_shr:3 row_mask:0xf bank_mask:0xf bound_ctrl:1\n\t"
                                     "v_fmac_f32_dpp %0, %2, %5 row_shl:13 row_mask:0xf bank_mask:0xf bound_ctrl:1"
                                     : "+v"(v) : "v"(x0[i]), "v"(xm1[i]), "v"(cw[2][i]), "v"(cw[1][i]), "v"(cw[0][i]));
                        y[i] = v; }
#pragma unroll
                    for (int i = 0; i < 8; ++i) xm1[i] = x0[i];
                    u32x4 w; w.x = cvt_pk_bf16(y[0], y[1]); w.y = cvt_pk_bf16(y[2], y[3]); w.z = cvt_pk_bf16(y[4], y[5]); w.w = cvt_pk_bf16(y[6], y[7]);
                    *(u32x4*)(O + (size_t)(row0 + ai * HALF + m * 16) * 1024 + col0 + bj * HALF) = w; } }
        }
        (void)seq0;
    }
    __device__ __forceinline__ void operator()(const f32x4 (&acc)[2][2][4][2], const Unit& u, int wr, int wc, int fr, int fq) const {
        const int sgo = (int)((smap >> (4 * (u.pn >> 2))) & 15u); const int seg = probe ? 0 : sgo; float nm[2] = {0.f, 0.f}; bf16_t* O = sgo < 5 ? ws5 + (size_t)sgo * SEGE : out2 + (size_t)(sgo - 5) * SEGE;
        const int row0 = u.pm * BM + wr * 64 + fr, col0 = (u.pn & 3) * BM + wc * 32 + 8 * fq;
        if (seg == 0 && !probe) { const float sc_ = sc; const float* const cw_ = conv_w; const float* const cb_ = conv_b; float* const sd_ = side; PG8_LAS float* const hl_ = halo; conv0(acc, u, wr, wc, fr, fq, O, row0, col0, sc_, cw_, cb_, sd_, hl_); return; }
#pragma unroll
        for (int ai = 0; ai < 2; ++ai)
#pragma unroll
            for (int m = 0; m < 4; ++m) { const int row = row0 + ai * HALF + m * 16; bf16_t* rowp = O + (size_t)row * 1024 + col0;
                const bool hm = (sgo >= 2 && sgo <= 4); bf16_t* rowh = O + ((size_t)((row >> 12) * 8 + 2 * (u.pn & 3)) * 4096 + (row & 4095)) * 128 + wc * 32 + 8 * fq;
#pragma unroll
                for (int bj = 0; bj < 2; ++bj) { f32x4 v0 = acc[ai][bj][m][0] * sc, v1 = acc[ai][bj][m][1] * sc;
                    if (seg == 1) {
#pragma unroll
                        for (int i = 0; i < 4; ++i) { v0[i] = gelu_tanh_f(v0[i]); v1[i] = gelu_tanh_f(v1[i]); } }
                    else if (seg >= 5) {
#pragma unroll
                        for (int i = 0; i < 4; ++i) { v0[i] = sigmoid_f(v0[i]); v1[i] = sigmoid_f(v1[i]); } }
                    if (seg == 2 || seg == 3) { float q = (v0[0] * v0[0] + v0[1] * v0[1]) + (v0[2] * v0[2] + v0[3] * v0[3]) + (v1[0] * v1[0] + v1[1] * v1[1]) + (v1[2] * v1[2] + v1[3] * v1[3]);
                        q += __shfl_xor(q, 16); q += __shfl_xor(q, 32); nm[bj] = fmaxf(nm[bj], q); }
                    u32x4 w; w.x = cvt_pk_bf16(v0[0], v0[1]); w.y = cvt_pk_bf16(v0[2], v0[3]); w.z = cvt_pk_bf16(v1[0], v1[1]); w.w = cvt_pk_bf16(v1[2], v1[3]);
                    u32x4* const dp_ = (u32x4*)(hm ? rowh + (size_t)bj * 4096 * 128 : rowp + bj * HALF);
                    *dp_ = w; } }
        if (seg == 2 || seg == 3) {
#pragma unroll
            for (int bj = 0; bj < 2; ++bj) { float q = nm[bj];
#pragma unroll
                for (int o = 1; o < 16; o <<= 1) q = fmaxf(q, __shfl_xor(q, o));
                if (fr == 0 && fq == 0) atomicMax(norm + ((((seg - 2) * 8 + (u.pm >> 4)) * 8 + 2 * (u.pn & 3) + bj) * 4 + wc), __float_as_uint(q)); }
        }
    }
};
template <int MODE> struct EpiGate {
    static constexpr bool PERM = true, AFTER_DRAIN = false; static constexpr int NSTORES = 16;
    const bf16_t* G; bf16_t* O;
    __device__ __forceinline__ void operator()(const f32x4 (&acc)[2][2][4][2], const Unit& u, int wr, int wc, int fr, int fq) const {
        const int row0 = u.pm * BM + wr * 64 + fr, col0 = u.pn * BM + wc * 32 + 8 * fq;
        u32x4 gv[2][2][2], pv[2][2][2];
#define EG_LOAD(st_, b_) do { _Pragma("unroll") for (int mm = 0; mm < 2; ++mm) _Pragma("unroll") for (int bj = 0; bj < 2; ++bj) { \
            const size_t off_ = (size_t)(row0 + ((st_) >> 1) * HALF + (2 * ((st_) & 1) + mm) * 16) * 1024 + col0 + bj * HALF; gv[b_][mm][bj] = __builtin_nontemporal_load((const u32x4*)(G + off_)); if (MODE == 1) pv[b_][mm][bj] = __builtin_nontemporal_load((const u32x4*)(O + off_)); } } while (0)
#define EG_DO(st_, b_) do { _Pragma("unroll") for (int mm = 0; mm < 2; ++mm) _Pragma("unroll") for (int bj = 0; bj < 2; ++bj) { const int ai = (st_) >> 1, m = 2 * ((st_) & 1) + mm; \
            const size_t off_ = (size_t)(row0 + ai * HALF + m * 16) * 1024 + col0 + bj * HALF; const u32x4 g = gv[b_][mm][bj]; \
            f32x4 v0 = acc[ai][bj][m][0], v1 = acc[ai][bj][m][1]; \
            v0[0] *= bf_lo(g.x); v0[1] *= bf_hi(g.x); v0[2] *= bf_lo(g.y); v0[3] *= bf_hi(g.y); v1[0] *= bf_lo(g.z); v1[1] *= bf_hi(g.z); v1[2] *= bf_lo(g.w); v1[3] *= bf_hi(g.w); \
            if (MODE == 1) { const u32x4 p = pv[b_][mm][bj]; \
                v0[0] += bf_lo(p.x); v0[1] += bf_hi(p.x); v0[2] += bf_lo(p.y); v0[3] += bf_hi(p.y); v1[0] += bf_lo(p.z); v1[1] += bf_hi(p.z); v1[2] += bf_lo(p.w); v1[3] += bf_hi(p.w); } \
            u32x4 w; w.x = cvt_pk_bf16(v0[0], v0[1]); w.y = cvt_pk_bf16(v0[2], v0[3]); w.z = cvt_pk_bf16(v1[0], v1[1]); w.w = cvt_pk_bf16(v1[2], v1[3]); \
            *(u32x4*)(O + off_) = w; } } while (0)
        EG_LOAD(0, 0); EG_LOAD(1, 1); EG_DO(0, 0); EG_LOAD(2, 0); EG_DO(1, 1); EG_LOAD(3, 1); EG_DO(2, 0); EG_DO(3, 1);
#undef EG_LOAD
#undef EG_DO
    }
};
struct SplitOrder {
    StaticOrder a, b; int na;
    __device__ void init(int M, int Na, int Nb, int G_, int c_) { a.init(M, Na, G_, c_); b.init(M, Nb, G_, c_); na = (a.nwg - c_ + G_ - 1) / G_; if (na < 0) na = 0; }
    __device__ __forceinline__ bool next(int i, Unit& u) const { if (i < na) { a.next(i, u); u.pn += b.nN; return true; } return b.next(i - na, u); }
    __device__ __forceinline__ void a_ready(const Unit&) const {}
    __device__ __forceinline__ void done(const Unit&) const {}
};
struct TwoGemmOrder {
    StaticOrder base; int n1;
    __device__ void init(int M, int N, int G_, int c_) { base.init(M, N, G_, c_); n1 = (base.nwg - c_ + G_ - 1) / G_; if (n1 < 0) n1 = 0; }
    __device__ __forceinline__ bool next(int i, Unit& u) const { if (i >= 2 * n1) return false; const bool second = i >= n1; base.next(second ? i - n1 : i, u); if (second) { u.pm += 256; u.pn += 4; } return true; }
    __device__ __forceinline__ void a_ready(const Unit&) const {}
    __device__ __forceinline__ void done(const Unit&) const {}
};
struct EpiGate2 {
    static constexpr bool PERM = true, AFTER_DRAIN = false; static constexpr int NSTORES = 16;
    const bf16_t* G0; const bf16_t* G1; bf16_t* O;
    __device__ __forceinline__ void operator()(const f32x4 (&acc)[2][2][4][2], const Unit& u, int wr, int wc, int fr, int fq) const {
        Unit v; v.pm = u.pm & 127; v.pn = u.pn & 3;
        if (u.pm >= 128) { EpiGate<1> e{G1, O}; e(acc, v, wr, wc, fr, fq); } else { EpiGate<0> e{G0, O}; e(acc, v, wr, wc, fr, fq); }
    }
};
struct EpiDelta {
    static constexpr bool PERM = true, AFTER_DRAIN = false; static constexpr int NSTORES = 16;
    bf16_t* O;
    __device__ __forceinline__ void operator()(const f32x4 (&acc)[2][2][4][2], const Unit& u, int wr, int wc, int fr, int fq) const {
        const int row0 = u.pm * BM + wr * 64 + fr, col0 = u.pn * BM + wc * 32 + 8 * fq;
#pragma unroll
        for (int ai = 0; ai < 2; ++ai)
#pragma unroll
            for (int m = 0; m < 4; ++m) { bf16_t* rowp = O + (size_t)(row0 + ai * HALF + m * 16) * 1024 + col0;
#pragma unroll
                for (int bj = 0; bj < 2; ++bj) { const f32x4 v0 = acc[ai][bj][m][0], v1 = acc[ai][bj][m][1];
                    u32x4 w; w.x = cvt_pk_bf16(v0[0], v0[1]); w.y = cvt_pk_bf16(v0[2], v0[3]); w.z = cvt_pk_bf16(v1[0], v1[1]); w.w = cvt_pk_bf16(v1[2], v1[3]);
                    *(u32x4*)(rowp + bj * HALF) = w; } }
    }
};
template <int HOOK> struct GroupedOrderT {
    const PG8_LAS int* tile_e; int nunits, G, c; unsigned* rdy; int wid; unsigned* tmo;
    __device__ __forceinline__ int unit_index(int i) const {
        if constexpr (HOOK != 3) { const int L = i * G + c; return L < nunits ? L : -1; }
        else { constexpr int K0 = 2; const int rem = nunits % G, poolA = nunits - rem, E = G - rem;
            if (c < rem) { if (i == 0) return poolA + c; const int k = i - 1 + K0; const int L = k * E + (k - K0) * rem + E + c; return L < poolA ? L : -1; }
            const int k = i, L = k * E + (k > K0 ? k - K0 : 0) * rem + (c - rem); return L < poolA ? L : -1; }
    }
    __device__ __forceinline__ bool next(int i, Unit& u) const { const int L = unit_index(i); if (L < 0) return false; u.pm = L >> 2; u.pn = __builtin_amdgcn_readfirstlane(tile_e[u.pm]) * 4 + (L & 3); return true; }
    __device__ __forceinline__ void a_ready(const Unit& u) const {
        if constexpr (HOOK == 2) {
            if (wid == 0) { unsigned sp = 0u;
                while ((unsigned)__builtin_amdgcn_readfirstlane(__hip_atomic_load(rdy + 8 * u.pm, __ATOMIC_RELAXED, __HIP_MEMORY_SCOPE_AGENT)) < 32u) {
                    __builtin_amdgcn_s_sleep(2);
                    if ((++sp & 1023u) == 0u) { if (__builtin_amdgcn_readfirstlane(__hip_atomic_load(tmo, __ATOMIC_RELAXED, __HIP_MEMORY_SCOPE_AGENT)) != 0u) break;
                        if (sp > (1u << 20)) { if (lane_now() == 0) __hip_atomic_store(tmo, 1u, __ATOMIC_RELAXED, __HIP_MEMORY_SCOPE_AGENT); break; } } }
                __builtin_amdgcn_fence(__ATOMIC_ACQUIRE, "agent");
                asm volatile("s_waitcnt vmcnt(0)" ::: "memory"); }
            asm volatile("" ::: "memory"); __builtin_amdgcn_s_barrier(); asm volatile("" ::: "memory");
        }
    }
    mutable int pend = -1;
    __device__ __forceinline__ void done(const Unit& u) const { if constexpr (HOOK == 1) pend = u.pm; }
    __device__ __forceinline__ void pre() const {
        if constexpr (HOOK == 1) { if (pend >= 0) { asm volatile("s_waitcnt vmcnt(24)" ::: "memory");
            if (lane_now() == 0) (void)__hip_atomic_fetch_add(rdy + 8 * pend, 1u, __ATOMIC_RELAXED, __HIP_MEMORY_SCOPE_AGENT); pend = -1; } }
    }
    __device__ __forceinline__ void fin() const {
        if constexpr (HOOK == 1) { if (pend >= 0) { asm volatile("s_waitcnt vmcnt(0)" ::: "memory");
            if (lane_now() == 0) (void)__hip_atomic_fetch_add(rdy + 8 * pend, 1u, __ATOMIC_RELAXED, __HIP_MEMORY_SCOPE_AGENT); pend = -1; } }
    }
};
using GroupedOrder = GroupedOrderT<0>;
struct EpiSwiGLU {
    static constexpr bool PERM = true, AFTER_DRAIN = false; static constexpr int NSTORES = 8;
    unsigned char* HB;
    __device__ __forceinline__ void operator()(const f32x4 (&acc)[2][2][4][2], const Unit& u, int wr, int wc, int fr, int fq, const PG8_LAS int* rows) const {
        const int row0 = u.pm * BM + wr * 64 + fr, col0 = (u.pn & 3) * HALF + wc * 32 + 8 * fq;
        float sv[2][4];
#pragma unroll
        for (int ai = 0; ai < 2; ++ai)
#pragma unroll
            for (int m = 0; m < 4; ++m) sv[ai][m] = ((const PG8_LAS float*)rows)[6 * 256 + wr * 64 + fr + ai * HALF + m * 16] * (1.0f / W13_SCALE);
#pragma unroll
        for (int ai = 0; ai < 2; ++ai)
#pragma unroll
            for (int m = 0; m < 4; ++m) { const int row = row0 + ai * HALF + m * 16; const float s = sv[ai][m];
                float o[8];
#pragma unroll
                for (int n = 0; n < 2; ++n)
#pragma unroll
                    for (int i = 0; i < 4; ++i) { const float g = acc[ai][0][m][n][i] * s, uu = acc[ai][1][m][n][i] * s; o[n * 4 + i] = g * sigmoid_f(g) * uu * HB_SCALE; }
                unsigned long long w = (unsigned long long)pack4_fp8(o[0], o[1], o[2], o[3]) | ((unsigned long long)pack4_fp8(o[4], o[5], o[6], o[7]) << 32);
                asm volatile("global_store_dwordx2 %0, %1, off sc1" :: "v"((unsigned long long*)(HB + (size_t)row * 512 + col0)), "v"(w) : "memory"); }
    }
};
constexpr float Y_SCALE = 0.25f;
struct EpiY {
    static constexpr bool PERM = true, AFTER_DRAIN = false; static constexpr int NSTORES = 8;
    unsigned char* Y; int skip;
    __device__ __forceinline__ void operator()(const f32x4 (&acc)[2][2][4][2], const Unit& u, int wr, int wc, int fr, int fq) const {
        if (skip) return;
        const int row0 = u.pm * BM + wr * 64 + fr, col0 = (u.pn & 3) * BM + wc * 64 + 16 * fq;
#pragma unroll
        for (int ai = 0; ai < 2; ++ai)
#pragma unroll
            for (int m = 0; m < 4; ++m) { const int row = row0 + ai * HALF + m * 16;
                const f32x4 a0 = acc[ai][0][m][0] * Y_SCALE, a1 = acc[ai][0][m][1] * Y_SCALE, b0 = acc[ai][1][m][0] * Y_SCALE, b1 = acc[ai][1][m][1] * Y_SCALE;
                unsigned al = pack4_fp8(a0[0], a0[1], a0[2], a0[3]), ah = pack4_fp8(a1[0], a1[1], a1[2], a1[3]), bl = pack4_fp8(b0[0], b0[1], b0[2], b0[3]), bh = pack4_fp8(b1[0], b1[1], b1[2], b1[3]);
                { auto r = __builtin_amdgcn_permlane32_swap(al, bl, false, false); al = r[0]; bl = r[1]; } { auto r = __builtin_amdgcn_permlane32_swap(ah, bh, false, false); ah = r[0]; bh = r[1]; }
                { auto r = __builtin_amdgcn_permlane16_swap(al, bl, false, false); al = r[0]; bl = r[1]; } { auto r = __builtin_amdgcn_permlane16_swap(ah, bh, false, false); ah = r[0]; bh = r[1]; }
                u32x4 w; w.x = al; w.y = ah; w.z = bl; w.w = bh;
                *(u32x4*)(Y + (size_t)row * 1024 + col0) = w; }
    }
};
template <class Epi, class Sched, bool ALIGN_EPI = false, bool SP2 = false, bool F8 = false>
__device__ __forceinline__ void gemm_phase(PG8_LAS unsigned char* lds, const Gemm g, const Sched& S, const Epi& E, const int wid) {
    const int lane = lane_now(), tid = wid * 64 + lane, wr = wid >> 2, wc = wid & 3, fr = lane & 15, fq = lane >> 4;
    const int K = g.K, nt = K / BK;
    unsigned voffA[2], voffB[2];
#pragma unroll
    for (int i = 0; i < 2; ++i) { int R, C; stage_rc(tid * 16 + i * 8192, R, C); const int Rb = Epi::PERM ? ((R & ~31) + perm32(R & 31)) : R;
        voffA[i] = (unsigned)(R * K + C) * 2u; voffB[i] = (unsigned)(Rb * K + C) * 2u; }
    const size_t kstep = (size_t)(BK * 2);
    const size_t hstep = (size_t)HALF * K * 2;
    const size_t tstep = 2 * hstep;
    const unsigned ldsw = (unsigned)wid * 1024u;
    const unsigned ldsbase = (unsigned)__builtin_amdgcn_readfirstlane((int)((unsigned)(uintptr_t)lds + ldsw));
    const int aoff = lds_byte(wr * 64 + fr, fq * 8), boff = lds_byte(wc * 32 + fr, fq * 8);
#define PG8_SA(b, h) (((b) * 2 + (h)) * HTB)
#define PG8_SB(b, h) ((4 + (b) * 2 + (h)) * HTB)
#define PG8_STAGE(bufoff, gbase, voff) do { _Pragma("unroll") for (int _i = 0; _i < 2; ++_i) { \
        if constexpr (F8) glds_sv((const char*)(gbase), (voff)[_i], ldsbase + (unsigned)((bufoff) + _i * 8192)); \
        else __builtin_amdgcn_global_load_lds((const unsigned*)((const char*)(gbase) + (voff)[_i]), (PG8_LAS unsigned*)(lds + (bufoff) + ldsw + _i * 8192), 16, 0, 0); } } while (0)
#define PG8_LDA(dst, b, h) do { _Pragma("unroll") for (int m = 0; m < 4; ++m) { \
        if constexpr (F8) { dst##8[m] = cat8(*(const PG8_LAS bf16x8*)(lds + PG8_SA(b, h) + aoff + m * 2048), *(const PG8_LAS bf16x8*)(lds + PG8_SA(b, h) + aoff + m * 2048 + 1024)); } \
        else { _Pragma("unroll") for (int k = 0; k < 2; ++k) dst[m][k] = *(const PG8_LAS bf16x8*)(lds + PG8_SA(b, h) + aoff + m * 2048 + k * 1024); } } } while (0)
#define PG8_LDB(dst, b, h) do { _Pragma("unroll") for (int n = 0; n < 2; ++n) { \
        if constexpr (F8) { dst##8[n] = cat8(*(const PG8_LAS bf16x8*)(lds + PG8_SB(b, h) + boff + n * 2048), *(const PG8_LAS bf16x8*)(lds + PG8_SB(b, h) + boff + n * 2048 + 1024)); } \
        else { _Pragma("unroll") for (int k = 0; k < 2; ++k) dst[n][k] = *(const PG8_LAS bf16x8*)(lds + PG8_SB(b, h) + boff + n * 2048 + k * 1024); } } } while (0)
#define PG8_MMA(ai, bj, At, Bt) do { __builtin_amdgcn_s_setprio(1); _Pragma("unroll") for (int m = 0; m < 4; ++m) _Pragma("unroll") for (int n = 0; n < 2; ++n) { \
        if constexpr (F8) { acc[ai][bj][m][n] = __builtin_amdgcn_mfma_scale_f32_16x16x128_f8f6f4(Bt##8[n], At##8[m], acc[ai][bj][m][n], 0, 0, 0, 0, 0, 0); } \
        else { _Pragma("unroll") for (int k = 0; k < 2; ++k) acc[ai][bj][m][n] = __builtin_amdgcn_mfma_f32_16x16x32_bf16(Bt[n][k], At[m][k], acc[ai][bj][m][n], 0, 0, 0); } } \
        __builtin_amdgcn_s_setprio(0); } while (0)
#define PG8_WAIT_V(n) asm volatile("s_waitcnt vmcnt(" #n ")" ::: "memory")
#define PG8_WAIT_L(n) asm volatile("s_waitcnt lgkmcnt(" #n ")" ::: "memory")
#define PG8_BAR __builtin_amdgcn_s_barrier()
#define PG8_SCHED __builtin_amdgcn_sched_barrier(0)
    Unit cur, nxt; int ui = 0;
    if (!S.next(0, cur)) return;
    f32x4 acc[2][2][4][2];
#pragma unroll
    for (int a = 0; a < 2; ++a)
#pragma unroll
        for (int b = 0; b < 2; ++b)
#pragma unroll
            for (int m = 0; m < 4; ++m)
#pragma unroll
                for (int n = 0; n < 2; ++n) acc[a][b][m][n] = (f32x4){0.f, 0.f, 0.f, 0.f};
    bf16x8 At[4][2], B0[2][2], B1[2][2]; v8i_t At8[4], B08[2], B18[2];
    const char* cA = (const char*)g.A + (size_t)cur.pm * tstep; const char* cB = (const char*)g.Bt + (size_t)cur.pn * tstep;
    S.a_ready(cur);
    if constexpr (SP2) {
        PG8_STAGE(PG8_SB(0, 0), cB, voffB); PG8_STAGE(PG8_SB(0, 1), cB + hstep, voffB); PG8_STAGE(PG8_SA(0, 0), cA, voffA); PG8_STAGE(PG8_SA(0, 1), cA + hstep, voffA);
        if (wr == 1) PG8_BAR;
        PG8_WAIT_V(2); PG8_BAR;
        PG8_STAGE(PG8_SB(1, 0), cB + kstep, voffB); PG8_STAGE(PG8_SA(1, 0), cA + kstep, voffA); PG8_STAGE(PG8_SB(1, 1), cB + hstep + kstep, voffB);
        PG8_WAIT_V(6); PG8_BAR;
    } else {
        PG8_STAGE(PG8_SB(0, 0), cB, voffB); PG8_STAGE(PG8_SA(0, 0), cA, voffA); PG8_STAGE(PG8_SB(0, 1), cB + hstep, voffB); PG8_STAGE(PG8_SA(0, 1), cA + hstep, voffA);
        if (wr == 1) PG8_BAR;
        PG8_WAIT_V(4); PG8_BAR;
        PG8_STAGE(PG8_SB(1, 0), cB + kstep, voffB); PG8_STAGE(PG8_SA(1, 0), cA + kstep, voffA); PG8_STAGE(PG8_SB(1, 1), cB + hstep + kstep, voffB);
        PG8_WAIT_V(6); PG8_BAR;
    }
    for (;;) {
        const bool has_next = S.next(ui + 1, nxt);
        const char* nA = has_next ? (const char*)g.A + (size_t)nxt.pm * tstep : cA; const char* nB = has_next ? (const char*)g.Bt + (size_t)nxt.pn * tstep : cB;
#pragma clang loop unroll(disable)
        for (int t = 0; t < nt; t += 2) {
            const bool last = (t == nt - 2);
            const char* a1 = cA + (size_t)(t + 1) * kstep;
            const char* a2 = last ? nA : cA + (size_t)(t + 2) * kstep; const char* b2 = last ? nB : cB + (size_t)(t + 2) * kstep;
            const char* a3 = a2 + kstep; const char* b3 = b2 + kstep;
            if (last && has_next) S.a_ready(nxt);
            if constexpr (SP2) {
            PG8_LDB(B0, 0, 0); PG8_LDB(B1, 0, 1); PG8_SCHED; PG8_LDA(At, 0, 0); PG8_STAGE(PG8_SA(1, 1), a1 + hstep, voffA);
            PG8_WAIT_V(8); PG8_WAIT_L(0); PG8_BAR; PG8_MMA(0, 0, At, B0); PG8_MMA(0, 1, At, B1); PG8_BAR; PG8_SCHED;
            PG8_LDA(At, 0, 1); PG8_STAGE(PG8_SB(0, 0), b2, voffB); PG8_STAGE(PG8_SB(0, 1), b2 + hstep, voffB); PG8_STAGE(PG8_SA(0, 0), a2, voffA);
            PG8_WAIT_V(8); PG8_WAIT_L(0); PG8_BAR; PG8_MMA(1, 0, At, B0); PG8_MMA(1, 1, At, B1); PG8_BAR; PG8_SCHED;
            PG8_LDB(B0, 1, 0); PG8_LDB(B1, 1, 1); PG8_SCHED; PG8_LDA(At, 1, 0); PG8_STAGE(PG8_SA(0, 1), a2 + hstep, voffA);
            PG8_WAIT_V(8); PG8_WAIT_L(0); PG8_BAR; PG8_MMA(0, 0, At, B0); PG8_MMA(0, 1, At, B1); PG8_BAR; PG8_SCHED;
            PG8_LDA(At, 1, 1); PG8_STAGE(PG8_SB(1, 0), b3, voffB); PG8_STAGE(PG8_SB(1, 1), b3 + hstep, voffB); PG8_STAGE(PG8_SA(1, 0), a3, voffA);
            PG8_WAIT_V(8); PG8_WAIT_L(0); PG8_BAR; PG8_MMA(1, 0, At, B0); PG8_MMA(1, 1, At, B1); PG8_BAR; PG8_SCHED;
            } else {
            PG8_LDB(B0, 0, 0); PG8_SCHED; PG8_LDA(At, 0, 0); PG8_STAGE(PG8_SA(1, 1), a1 + hstep, voffA);
            PG8_WAIT_L(8); PG8_BAR; PG8_WAIT_L(0); PG8_MMA(0, 0, At, B0); PG8_BAR; PG8_SCHED;
            PG8_LDB(B1, 0, 1); PG8_STAGE(PG8_SB(0, 0), b2, voffB);
            PG8_BAR; PG8_WAIT_L(0); PG8_MMA(0, 1, At, B1); PG8_BAR;
            PG8_LDA(At, 0, 1); PG8_STAGE(PG8_SA(0, 0), a2, voffA);
            PG8_BAR; PG8_WAIT_L(0); PG8_MMA(1, 0, At, B0); PG8_BAR; PG8_SCHED;
            PG8_STAGE(PG8_SB(0, 1), b2 + hstep, voffB);
            PG8_WAIT_V(6); PG8_BAR; PG8_MMA(1, 1, At, B1); PG8_BAR;
            PG8_LDB(B0, 1, 0); PG8_SCHED; PG8_LDA(At, 1, 0); PG8_STAGE(PG8_SA(0, 1), a2 + hstep, voffA);
            PG8_WAIT_L(8); PG8_BAR; PG8_WAIT_L(0); PG8_MMA(0, 0, At, B0); PG8_BAR; PG8_SCHED;
            PG8_LDB(B1, 1, 1); PG8_STAGE(PG8_SB(1, 0), b3, voffB);
            PG8_BAR; PG8_WAIT_L(0); PG8_MMA(0, 1, At, B1); PG8_BAR;
            PG8_LDA(At, 1, 1); PG8_STAGE(PG8_SA(1, 0), a3, voffA);
            PG8_BAR; PG8_WAIT_L(0); PG8_MMA(1, 0, At, B0); PG8_BAR; PG8_SCHED;
            PG8_STAGE(PG8_SB(1, 1), b3 + hstep, voffB);
            PG8_WAIT_V(6); PG8_BAR; PG8_MMA(1, 1, At, B1); PG8_BAR;
            }
        }
        if constexpr (ALIGN_EPI) { if (wr == 0) PG8_BAR; }
        if constexpr (!Epi::AFTER_DRAIN) { const int l2 = lane_now(); E(acc, cur, wr, wc, l2 & 15, l2 >> 4); S.done(cur); }
        if (!has_next) break;
#pragma unroll
        for (int a = 0; a < 2; ++a)
#pragma unroll
            for (int b = 0; b < 2; ++b)
#pragma unroll
                for (int m = 0; m < 4; ++m)
#pragma unroll
                    for (int n = 0; n < 2; ++n) acc[a][b][m][n] = (f32x4){0.f, 0.f, 0.f, 0.f};
        cur = nxt; cA = nA; cB = nB; ++ui;
        if constexpr (ALIGN_EPI) { if (wr == 1) PG8_BAR; }
    }
    PG8_WAIT_V(0);
    if constexpr (!ALIGN_EPI) { if (wr == 0) PG8_BAR; }
    PG8_BAR;
    if constexpr (Epi::AFTER_DRAIN) { E.fused(acc, cur, wr, wc, fr, fq, lds, wid, lane); S.done(cur); }
#undef PG8_SA
#undef PG8_SB
#undef PG8_STAGE
#undef PG8_LDA
#undef PG8_LDB
#undef PG8_MMA
#undef PG8_WAIT_V
#undef PG8_WAIT_L
#undef PG8_BAR
#undef PG8_SCHED
}
template <class Epi, class Sched, bool F8 = false>
__device__ __forceinline__ void gemm_phase_gather(PG8_LAS unsigned char* lds, const Gemm g, const Sched& S, const Epi& E, const PG8_LAS int* rowtab, const int wid) {
    constexpr bool ALIGN_EPI = true, SP2 = true;
    const int lane = lane_now(), tid = wid * 64 + lane, wr = wid >> 2, wc = wid & 3, fr = lane & 15, fq = lane >> 4;
    const int K = g.K, nt = K / BK;
    unsigned voffB[2], vAc[2][2];
#pragma unroll
    for (int i = 0; i < 2; ++i) { int R, C; stage_rc(tid * 16 + i * 8192, R, C); const int Rb = Epi::PERM ? ((R & ~31) + perm32(R & 31)) : R;
        voffB[i] = (unsigned)(Rb * K + C) * 2u; }
#define PG8_ROWS(dst, ui_) do { const int t_ = wid * 64 + lane_now(); _Pragma("unroll") for (int i_ = 0; i_ < 2; ++i_) { int R_, C_; stage_rc(t_ * 16 + i_ * 8192, R_, C_); \
        _Pragma("unroll") for (int h_ = 0; h_ < 2; ++h_) dst[h_][i_] = (unsigned)rowtab[(ui_) * 256 + h_ * HALF + R_] * (unsigned)(K * 2) + (unsigned)(C_ * 2); } } while (0)
#define PG8_STAGE_A(bufoff, v, kb) do { _Pragma("unroll") for (int _i = 0; _i < 2; ++_i) { \
        if constexpr (F8) glds_sv((const char*)g.A + (kb), (v)[_i], ldsbase + (unsigned)((bufoff) + _i * 8192)); \
        else __builtin_amdgcn_global_load_lds((const unsigned*)((const char*)g.A + (v)[_i] + (kb)), (PG8_LAS unsigned*)(lds + (bufoff) + ldsw + _i * 8192), 16, 0, 0); } } while (0)
    const size_t kstep = (size_t)(BK * 2);
    const size_t hstep = (size_t)HALF * K * 2;
    const size_t tstep = 2 * hstep;
    const unsigned ldsw = (unsigned)wid * 1024u;
    const unsigned ldsbase = (unsigned)__builtin_amdgcn_readfirstlane((int)((unsigned)(uintptr_t)lds + ldsw));
    const int aoff = lds_byte(wr * 64 + fr, fq * 8), boff = lds_byte(wc * 32 + fr, fq * 8);
#define PG8_SA(b, h) (((b) * 2 + (h)) * HTB)
#define PG8_SB(b, h) ((4 + (b) * 2 + (h)) * HTB)
#define PG8_STAGE(bufoff, gbase, voff) do { _Pragma("unroll") for (int _i = 0; _i < 2; ++_i) { \
        if constexpr (F8) glds_sv((const char*)(gbase), (voff)[_i], ldsbase + (unsigned)((bufoff) + _i * 8192)); \
        else __builtin_amdgcn_global_load_lds((const unsigned*)((const char*)(gbase) + (voff)[_i]), (PG8_LAS unsigned*)(lds + (bufoff) + ldsw + _i * 8192), 16, 0, 0); } } while (0)
#define PG8_LDA(dst, b, h) do { _Pragma("unroll") for (int m = 0; m < 4; ++m) { \
        if constexpr (F8) { dst##8[m] = cat8(*(const PG8_LAS bf16x8*)(lds + PG8_SA(b, h) + aoff + m * 2048), *(const PG8_LAS bf16x8*)(lds + PG8_SA(b, h) + aoff + m * 2048 + 1024)); } \
        else { _Pragma("unroll") for (int k = 0; k < 2; ++k) dst[m][k] = *(const PG8_LAS bf16x8*)(lds + PG8_SA(b, h) + aoff + m * 2048 + k * 1024); } } } while (0)
#define PG8_LDB(dst, b, h) do { _Pragma("unroll") for (int n = 0; n < 2; ++n) { \
        if constexpr (F8) { dst##8[n] = cat8(*(const PG8_LAS bf16x8*)(lds + PG8_SB(b, h) + boff + n * 2048), *(const PG8_LAS bf16x8*)(lds + PG8_SB(b, h) + boff + n * 2048 + 1024)); } \
        else { _Pragma("unroll") for (int k = 0; k < 2; ++k) dst[n][k] = *(const PG8_LAS bf16x8*)(lds + PG8_SB(b, h) + boff + n * 2048 + k * 1024); } } } while (0)
#define PG8_MMA(ai, bj, At, Bt) do { __builtin_amdgcn_s_setprio(1); _Pragma("unroll") for (int m = 0; m < 4; ++m) _Pragma("unroll") for (int n = 0; n < 2; ++n) { \
        if constexpr (F8) { acc[ai][bj][m][n] = __builtin_amdgcn_mfma_scale_f32_16x16x128_f8f6f4(Bt##8[n], At##8[m], acc[ai][bj][m][n], 0, 0, 0, 0, 0, 0); } \
        else { _Pragma("unroll") for (int k = 0; k < 2; ++k) acc[ai][bj][m][n] = __builtin_amdgcn_mfma_f32_16x16x32_bf16(Bt[n][k], At[m][k], acc[ai][bj][m][n], 0, 0, 0); } } \
        __builtin_amdgcn_s_setprio(0); } while (0)
#define PG8_WAIT_V(n) asm volatile("s_waitcnt vmcnt(" #n ")" ::: "memory")
#define PG8_WAIT_L(n) asm volatile("s_waitcnt lgkmcnt(" #n ")" ::: "memory")
#define PG8_BAR __builtin_amdgcn_s_barrier()
#define PG8_SCHED __builtin_amdgcn_sched_barrier(0)
    Unit cur, nxt; int ui = 0;
    if (!S.next(0, cur)) return;
    f32x4 acc[2][2][4][2];
#pragma unroll
    for (int a = 0; a < 2; ++a)
#pragma unroll
        for (int b = 0; b < 2; ++b)
#pragma unroll
            for (int m = 0; m < 4; ++m)
#pragma unroll
                for (int n = 0; n < 2; ++n) acc[a][b][m][n] = (f32x4){0.f, 0.f, 0.f, 0.f};
    bf16x8 At[4][2], B0[2][2], B1[2][2]; v8i_t At8[4], B08[2], B18[2];
    const char* cB = (const char*)g.Bt + (size_t)cur.pn * tstep;
    PG8_ROWS(vAc, 0);
    S.a_ready(cur);
    if constexpr (SP2) {
        PG8_STAGE(PG8_SB(0, 0), cB, voffB); PG8_STAGE(PG8_SB(0, 1), cB + hstep, voffB); PG8_STAGE_A(PG8_SA(0, 0), vAc[0], 0u); PG8_STAGE_A(PG8_SA(0, 1), vAc[1], 0u);
        if (wr == 1) PG8_BAR;
        PG8_WAIT_V(2); PG8_BAR;
        PG8_STAGE(PG8_SB(1, 0), cB + kstep, voffB); PG8_STAGE_A(PG8_SA(1, 0), vAc[0], (unsigned)kstep); PG8_STAGE(PG8_SB(1, 1), cB + hstep + kstep, voffB);
        PG8_WAIT_V(6); PG8_BAR;
    }
    for (;;) {
        const bool has_next = S.next(ui + 1, nxt);
        const char* nB = has_next ? (const char*)g.Bt + (size_t)nxt.pn * tstep : cB;
#pragma clang loop unroll(disable)
        for (int t = 0; t < nt; t += 2) {
            const bool last = (t == nt - 2);
            const unsigned k1 = (unsigned)((t + 1) * (int)kstep), k2 = last ? 0u : (unsigned)((t + 2) * (int)kstep), k3 = k2 + (unsigned)kstep;
            unsigned v2[2][2];
            if (last && has_next) { PG8_ROWS(v2, ui + 1); }
            else {
#pragma unroll
                for (int h_ = 0; h_ < 2; ++h_)
#pragma unroll
                    for (int i_ = 0; i_ < 2; ++i_) v2[h_][i_] = vAc[h_][i_]; }
            const char* b2 = last ? nB : cB + (size_t)(t + 2) * kstep; const char* b3 = b2 + kstep;
            if (last && has_next) S.a_ready(nxt);
            if constexpr (SP2) {
            PG8_LDB(B0, 0, 0); PG8_LDB(B1, 0, 1); PG8_SCHED; PG8_LDA(At, 0, 0); PG8_STAGE_A(PG8_SA(1, 1), vAc[1], k1);
            PG8_WAIT_V(8); PG8_WAIT_L(0); PG8_BAR; PG8_MMA(0, 0, At, B0); PG8_MMA(0, 1, At, B1); PG8_BAR; PG8_SCHED;
            PG8_LDA(At, 0, 1); PG8_STAGE(PG8_SB(0, 0), b2, voffB); PG8_STAGE(PG8_SB(0, 1), b2 + hstep, voffB); PG8_STAGE_A(PG8_SA(0, 0), v2[0], k2);
            PG8_WAIT_V(8); PG8_WAIT_L(0); PG8_BAR; PG8_MMA(1, 0, At, B0); PG8_MMA(1, 1, At, B1); PG8_BAR; PG8_SCHED;
            PG8_LDB(B0, 1, 0); PG8_LDB(B1, 1, 1); PG8_SCHED; PG8_LDA(At, 1, 0); PG8_STAGE_A(PG8_SA(0, 1), v2[1], k2);
            PG8_WAIT_V(8); PG8_WAIT_L(0); PG8_BAR; PG8_MMA(0, 0, At, B0); PG8_MMA(0, 1, At, B1); PG8_BAR; PG8_SCHED;
            PG8_LDA(At, 1, 1); PG8_STAGE(PG8_SB(1, 0), b3, voffB); PG8_STAGE(PG8_SB(1, 1), b3 + hstep, voffB); PG8_STAGE_A(PG8_SA(1, 0), v2[0], k3);
            PG8_WAIT_V(8); PG8_WAIT_L(0); PG8_BAR; PG8_MMA(1, 0, At, B0); PG8_MMA(1, 1, At, B1); PG8_BAR; PG8_SCHED;
            }
        }
        if constexpr (ALIGN_EPI) { if (wr == 0) PG8_BAR; }
        S.pre(); { const int l2 = lane_now(); E(acc, cur, wr, wc, l2 & 15, l2 >> 4, rowtab + ui * 256); } S.done(cur);
        if (!has_next) break;
#pragma unroll
        for (int a = 0; a < 2; ++a)
#pragma unroll
            for (int b = 0; b < 2; ++b)
#pragma unroll
                for (int m = 0; m < 4; ++m)
#pragma unroll
                    for (int n = 0; n < 2; ++n) acc[a][b][m][n] = (f32x4){0.f, 0.f, 0.f, 0.f};
        cur = nxt; cB = nB; ++ui;
        PG8_ROWS(vAc, ui);
        if constexpr (ALIGN_EPI) { if (wr == 1) PG8_BAR; }
    }
    PG8_WAIT_V(0);
    S.fin();
    if constexpr (!ALIGN_EPI) { if (wr == 0) PG8_BAR; }
    PG8_BAR;
#undef PG8_ROWS
#undef PG8_STAGE_A
#undef PG8_SA
#undef PG8_SB
#undef PG8_STAGE
#undef PG8_LDA
#undef PG8_LDB
#undef PG8_MMA
#undef PG8_WAIT_V
#undef PG8_WAIT_L
#undef PG8_BAR
#undef PG8_SCHED
}
}
#define GAS __attribute__((address_space(1)))
#define LAS __attribute__((address_space(3)))
typedef unsigned short bf16;
typedef unsigned v4u __attribute__((ext_vector_type(4)));
typedef float f32x4 __attribute__((ext_vector_type(4)));
typedef short bf16x8 __attribute__((ext_vector_type(8)));
typedef GAS unsigned gu32;
typedef GAS unsigned long long gu64;
#define RLX_AGENT __ATOMIC_RELAXED, __HIP_MEMORY_SCOPE_AGENT
#define LDS_WAIT() asm volatile("s_waitcnt lgkmcnt(0)" ::: "memory")
#define VM_WAIT() asm volatile("s_waitcnt vmcnt(0)" ::: "memory")
__device__ __forceinline__ unsigned long long rt() { return __builtin_amdgcn_s_memrealtime(); }
__device__ __forceinline__ unsigned f2bf(float f) { unsigned u = __builtin_bit_cast(unsigned, f); return (u + 0x7fffu + ((u >> 16) & 1u)) >> 16; }
__device__ __forceinline__ unsigned pk2(float lo, float hi) { return f2bf(lo) | (f2bf(hi) << 16); }
#define XB_TMO      128
#define XB_XCNT(j)  (256  + 64 * (j))
#define XB_XSUB(j)  (1280 + 64 * (j))
#define XB_XGEN(j)  (2304 + 64 * (j))
#define XB_TOP      3328
#define XB_TOPGEN   3392
#define XCD_BAR_WORDS 3456
#define XB_SPIN_CAP (1u << 18)

__device__ __forceinline__ unsigned xb_ld(unsigned* p)              { return __hip_atomic_load(p, __ATOMIC_RELAXED, __HIP_MEMORY_SCOPE_AGENT); }
__device__ __forceinline__ unsigned xb_add(unsigned* p, unsigned v) { return __hip_atomic_fetch_add(p, v, __ATOMIC_RELAXED, __HIP_MEMORY_SCOPE_AGENT); }
__device__ __forceinline__ unsigned xb_xcc_id() { return (unsigned)__builtin_amdgcn_s_getreg((3 << 11) | 20) & 0xFu; }
#define XB_SPIN(cond, bar) do { unsigned _sp = 0; while (cond) { __builtin_amdgcn_s_sleep(1); \
    if ((++_sp & 255u) == 0u) { if (xb_ld(&(bar)[XB_TMO])) break; if (_sp > XB_SPIN_CAP) { atomicAdd(&(bar)[XB_TMO], 1u); break; } } } } while (0)

struct XcdBarrier {
    unsigned* bar; unsigned x;
    volatile LAS unsigned* st;
};

__device__ __forceinline__ XcdBarrier xcd_barrier_post(unsigned* bar, volatile LAS unsigned* st) {
    XcdBarrier b; b.bar = bar; b.x = xb_xcc_id(); b.st = st;
    if (threadIdx.x == 0) (void)xb_add(&bar[XB_XCNT(b.x)], 1u);
    return b;
}
__device__ __forceinline__ void xcd_barrier_complete(unsigned* bar, unsigned x, unsigned& nloc, unsigned& nx) {
    const unsigned G = gridDim.x * gridDim.y * gridDim.z;
    unsigned sum, cnt, mine, sp = 0u;
    for (;;) {
        sum = 0u; cnt = 0u; mine = 0u;
#pragma unroll
        for (unsigned j = 0; j < 16; ++j) { const unsigned c = xb_ld(&bar[XB_XCNT(j)]); sum += c; cnt += (c > 0u) ? 1u : 0u; mine = (j == x) ? c : mine; }
        if (sum == G) break;
        __builtin_amdgcn_s_sleep(1);
        if ((++sp & 255u) == 0u) { if (xb_ld(&bar[XB_TMO])) break; if (sp > XB_SPIN_CAP) { atomicAdd(&bar[XB_TMO], 1u); break; } }
    }
    nloc = mine > 0u ? mine : 1u; nx = cnt > 0u ? cnt : 1u;
}

__device__ __forceinline__ void xcd_barrier(const XcdBarrier& b) {
    asm volatile("s_waitcnt vmcnt(0)" ::: "memory");
    __syncthreads();
    if (threadIdx.x == 0) {
        unsigned* bar = b.bar;
        __builtin_amdgcn_s_waitcnt(0);
        unsigned nloc = b.st[0], nx = b.st[1];
        if (nloc == 0u) { xcd_barrier_complete(bar, b.x, nloc, nx); b.st[0] = nloc; b.st[1] = nx; }
        const unsigned old = xb_add(&bar[XB_XSUB(b.x)], 1u);
        const unsigned gen = old / nloc;
        if (old + 1u == (gen + 1u) * nloc) {
            __builtin_amdgcn_fence(__ATOMIC_RELEASE, "agent");
            asm volatile("s_waitcnt vmcnt(0)" ::: "memory");
            const unsigned og = xb_add(&bar[XB_TOP], 1u);
            const unsigned tg = og / nx;
            if (og + 1u == (tg + 1u) * nx) xb_add(&bar[XB_TOPGEN], 1u);
            else XB_SPIN(xb_ld(&bar[XB_TOPGEN]) == tg, bar);
            __builtin_amdgcn_fence(__ATOMIC_ACQUIRE, "agent");
            xb_add(&bar[XB_XGEN(b.x)], 1u);
            asm volatile("s_waitcnt vmcnt(0)" ::: "memory");
        } else {
            XB_SPIN(xb_ld(&bar[XB_XGEN(b.x)]) == gen, bar);
            __builtin_amdgcn_fence(__ATOMIC_ACQUIRE, "agent");
            asm volatile("s_waitcnt vmcnt(0)" ::: "memory");
        }
    }
    __syncthreads();
}
namespace fattn {
typedef unsigned short bf16;
typedef short bf16x8 __attribute__((ext_vector_type(8)));
typedef short s16x4 __attribute__((ext_vector_type(4)));
typedef float f32x16 __attribute__((ext_vector_type(16)));
typedef float f32x4 __attribute__((ext_vector_type(4)));
typedef unsigned u32x4 __attribute__((ext_vector_type(4)));
constexpr int D = 128, LD = 128, LDO = 1024, SEQ = 4096;
constexpr float THR = 8.f;
constexpr float SCALE = 0.08838834764831845f;
constexpr int NW = 8, QBLK = 32, KVBLK = 64, QB = NW * QBLK;
constexpr int SHM_V = KVBLK * D * 2, SHM_K = KVBLK * D * 2;
constexpr int OFF_WS = 2 * SHM_V + 2 * SHM_K, OFF_BIAS = OFF_WS + NW * 64 * 4, LDS_BYTES = OFF_BIAS + 2 * 64 * 4;
constexpr int OFF_OST = 69632, OST_PITCH = 144, OST_WAVE = 32 * OST_PITCH;
static_assert(LDS_BYTES <= OFF_OST && OFF_OST + NW * OST_WAVE <= 128 * 1024, "attention LDS map");

#define KSWZ(row, colB) ((row) * 256 + ((colB) ^ (((row) & 7) << 4)))
#define SBAR() __builtin_amdgcn_sched_barrier(0)
__device__ __forceinline__ int v_st(int k, int c) { const int kk = (k & ~0xC) | ((k & 4) << 1) | ((k & 8) >> 1); return ((kk >> 3) * 4 + (c >> 5)) * 512 + ((kk & 7) * 32 + (c & 31)) * 2; }
__device__ __forceinline__ int v_rd_base(int lane) { return ((lane & 3) << 3) | (((lane >> 2) & 3) << 6) | (((lane >> 4) & 1) << 5) | (((lane >> 5) & 1) << 8); }
constexpr int v_rd_off(int d0, int ks, int half) { return d0 * 512 + ks * 4096 + half * 2048; }
__device__ __forceinline__ int crow(int r, int hi) { return (r & 3) + 8 * (r >> 2) + 4 * hi; }
__device__ __forceinline__ unsigned cvtpk(float lo, float hi) { unsigned r; asm volatile("v_cvt_pk_bf16_f32 %0, %1, %2" : "=v"(r) : "v"(lo), "v"(hi)); return r; }
__device__ __forceinline__ bf16x8 load8(const bf16* p) { return *reinterpret_cast<const bf16x8*>(p); }
__device__ __forceinline__ void mask_tile(f32x16& p0, f32x16& p1, int dq) {
    const float NEG = -__builtin_inff();
#pragma unroll
    for (int r = 0; r < 16; ++r) {
        const int c = (r & 3) + 8 * (r >> 2);
        if (dq - c < 0) p0[r] = NEG;
        if (dq - c - 32 < 0) p1[r] = NEG;
    }
}
__device__ __forceinline__ void partialSM(f32x16& p0, f32x16& p1, float& m_reg, float& mn, float& alpha) {
    float pmax = p0[0]; for (int r = 1; r < 16; ++r) pmax = fmaxf(pmax, p0[r]); for (int r = 0; r < 16; ++r) pmax = fmaxf(pmax, p1[r]);
    { auto rr = __builtin_amdgcn_permlane32_swap(__float_as_uint(pmax), __float_as_uint(pmax), false, false);
      pmax = fmaxf(__uint_as_float(rr[0]), __uint_as_float(rr[1])); }
    constexpr float C2 = 1.4426950408889634f * SCALE;
    if (__builtin_expect(__all((pmax - m_reg) * SCALE <= THR), 1)) { mn = m_reg; alpha = 1.f; }
    else { mn = fmaxf(m_reg, pmax); alpha = __builtin_amdgcn_exp2f((m_reg - mn) * C2); m_reg = mn; }
    const float mnL = -mn * C2;
    for (int r = 0; r < 16; ++r) p0[r] = fmaf(p0[r], C2, mnL); for (int r = 0; r < 16; ++r) p1[r] = fmaf(p1[r], C2, mnL);
    for (int r = 0; r < 16; ++r) p0[r] = __builtin_amdgcn_exp2f(p0[r]);
}
__device__ __forceinline__ void finishSM(f32x16& p0, f32x16& p1, float alpha, float& l_reg, bf16x8& pa0, bf16x8& pa1, bf16x8& pa2, bf16x8& pa3) {
    for (int r = 0; r < 16; ++r) p1[r] = __builtin_amdgcn_exp2f(p1[r]);
    float ps = 0; for (int r = 0; r < 16; ++r) ps += p0[r]; for (int r = 0; r < 16; ++r) ps += p1[r];
    { auto rr = __builtin_amdgcn_permlane32_swap(__float_as_uint(ps), __float_as_uint(ps), false, false);
      ps = __uint_as_float(rr[0]) + __uint_as_float(rr[1]); }
    l_reg = l_reg * alpha + ps;
#define PK4(P, B_, OUT) do { unsigned a0 = cvtpk(P[B_+0], P[B_+1]), a1 = cvtpk(P[B_+2], P[B_+3]);                          \
        unsigned b0 = cvtpk(P[B_+4], P[B_+5]), b1 = cvtpk(P[B_+6], P[B_+7]);                                             \
        auto r0 = __builtin_amdgcn_permlane32_swap(a0, b0, false, false); auto r1 = __builtin_amdgcn_permlane32_swap(a1, b1, false, false); \
        u32x4 w = {r0[0], r1[0], r0[1], r1[1]}; OUT = *reinterpret_cast<bf16x8*>(&w); } while (0)
    PK4(p0, 0, pa0); PK4(p0, 8, pa1); PK4(p1, 0, pa2); PK4(p1, 8, pa3);
#undef PK4
}
template <int KB>
__device__ __forceinline__ void qkt(f32x16& p0, f32x16& p1, const char* K_lds, const char* Bias_lds, int r32, int hi, const bf16x8* qr) {
    { const f32x4* bb = reinterpret_cast<const f32x4*>(Bias_lds + KB * 256 + hi * 16);
      const f32x4 a0 = bb[0], a1 = bb[2], a2 = bb[4], a3 = bb[6], c0 = bb[8], c1 = bb[10], c2 = bb[12], c3 = bb[14];
      p0 = (f32x16){a0[0], a0[1], a0[2], a0[3], a1[0], a1[1], a1[2], a1[3], a2[0], a2[1], a2[2], a2[3], a3[0], a3[1], a3[2], a3[3]};
      p1 = (f32x16){c0[0], c0[1], c0[2], c0[3], c1[0], c1[1], c1[2], c1[3], c2[0], c2[1], c2[2], c2[3], c3[0], c3[1], c3[2], c3[3]}; }
    const char* kb[4];
#pragma unroll
    for (int dd = 0; dd < 4; ++dd) kb[dd] = K_lds + KB * SHM_K + KSWZ(r32, (dd * 16 + hi * 8) * 2);
#pragma unroll
    for (int d0 = 0; d0 < 8; ++d0) { const char* a = kb[d0 & 3] + (d0 >> 2) * 128;
        bf16x8 b0 = *reinterpret_cast<const bf16x8*>(a);
        bf16x8 b1 = *reinterpret_cast<const bf16x8*>(a + 32 * 256);
        p0 = __builtin_amdgcn_mfma_f32_32x32x16_bf16(b0, qr[d0], p0, 0, 0, 0);
        p1 = __builtin_amdgcn_mfma_f32_32x32x16_bf16(b1, qr[d0], p1, 0, 0, 0); }
}
template <int VB>
__device__ __forceinline__ void pv_tile(f32x16* o, int vb0, bf16x8 pa0, bf16x8 pa1, bf16x8 pa2, bf16x8 pa3) {
#define TRRD(dst, off) asm volatile("ds_read_b64_tr_b16 %0, %1 offset:%2" : "=&v"(dst) : "v"(vb0), "i"(off) : "memory")
#define PV_D0(d0) do { s16x4 l0, l1, l2, l3, h0, h1, h2, h3; constexpr int b_ = VB * SHM_V + v_rd_off(d0, 0, 0);   \
        TRRD(l0, b_); TRRD(h0, b_ + 2048); TRRD(l1, b_ + 4096); TRRD(h1, b_ + 6144); TRRD(l2, b_ + 8192); TRRD(h2, b_ + 10240); TRRD(l3, b_ + 12288); TRRD(h3, b_ + 14336); \
        asm volatile("s_waitcnt lgkmcnt(0)" ::: "memory"); SBAR();                                                    \
        o[d0] = __builtin_amdgcn_mfma_f32_32x32x16_bf16(pa0, (bf16x8){l0[0], l0[1], l0[2], l0[3], h0[0], h0[1], h0[2], h0[3]}, o[d0], 0, 0, 0);   \
        o[d0] = __builtin_amdgcn_mfma_f32_32x32x16_bf16(pa1, (bf16x8){l1[0], l1[1], l1[2], l1[3], h1[0], h1[1], h1[2], h1[3]}, o[d0], 0, 0, 0);   \
        o[d0] = __builtin_amdgcn_mfma_f32_32x32x16_bf16(pa2, (bf16x8){l2[0], l2[1], l2[2], l2[3], h2[0], h2[1], h2[2], h2[3]}, o[d0], 0, 0, 0);   \
        o[d0] = __builtin_amdgcn_mfma_f32_32x32x16_bf16(pa3, (bf16x8){l3[0], l3[1], l3[2], l3[3], h3[0], h3[1], h3[2], h3[3]}, o[d0], 0, 0, 0); } while (0)
    PV_D0(0); PV_D0(1); PV_D0(2); PV_D0(3);
#undef PV_D0
#undef TRRD
}

struct Bases { const bf16* Q; bf16* O; const bf16* K; const bf16* V; const float* CB; };
struct BlockRef { unsigned qo, oo, kvo, cbo; int P0, jlo; };
struct Seam { bf16x8 qr[8]; };
#define VMW() asm volatile("s_waitcnt vmcnt(0)" ::: "memory")
#define VMWN(n) asm volatile("s_waitcnt vmcnt(%0)" :: "i"(n) : "memory")
#define LBAR() do { asm volatile("s_waitcnt lgkmcnt(0)" ::: "memory"); __builtin_amdgcn_s_barrier(); asm volatile("" ::: "memory"); } while (0)
#define ATT_SRC() \
    unsigned ksrc0, ksrc1, vsrc0, vsrc1; \
    { const int rw0 = 8 * wid + (lane >> 4), rw1 = rw0 + 4, p_ = lane & 15; ksrc0 = (unsigned)(rw0 * 256 + ((p_ ^ (rw0 & 7)) << 4)); ksrc1 = (unsigned)(rw1 * 256 + ((p_ ^ (rw1 & 7)) << 4)); \
      const int L0 = 128 * wid + lane, L1 = L0 + 64; \
      const int kk0 = ((L0 >> 7) << 3) | ((L0 >> 2) & 7), kk1 = ((L1 >> 7) << 3) | ((L1 >> 2) & 7); \
      const int k0_ = (kk0 & ~0xC) | ((kk0 & 4) << 1) | ((kk0 & 8) >> 1), k1_ = (kk1 & ~0xC) | ((kk1 & 4) << 1) | ((kk1 & 8) >> 1); \
      vsrc0 = (unsigned)(k0_ * 256 + ((((L0 >> 5) & 3) * 4 + (L0 & 3)) << 4)); vsrc1 = (unsigned)(k1_ * 256 + ((((L1 >> 5) & 3) * 4 + (L1 & 3)) << 4)); }
#define DMA_K(Kp, CBp, k0, bf) do { const char* kp_ = (const char*)(Kp) + (unsigned)(k0) * 256u; \
        __builtin_amdgcn_global_load_lds((const unsigned*)(kp_ + ksrc0), (LAS unsigned*)(ldsa + 2 * SHM_V + (bf) * SHM_K + (2 * wid) * 1024), 16, 0, 0); \
        __builtin_amdgcn_global_load_lds((const unsigned*)(kp_ + ksrc1), (LAS unsigned*)(ldsa + 2 * SHM_V + (bf) * SHM_K + (2 * wid + 1) * 1024), 16, 0, 0); \
        if (wid == 0) __builtin_amdgcn_global_load_lds((const unsigned*)((CBp) + (unsigned)((k0) + lane)), (LAS unsigned*)(ldsa + OFF_BIAS + (bf) * 256), 4, 0, 0); } while (0)
#define DMA_V(Vp, k0, bf) do { const char* vp_ = (const char*)(Vp) + (unsigned)(k0) * 256u; \
        __builtin_amdgcn_global_load_lds((const unsigned*)(vp_ + vsrc0), (LAS unsigned*)(ldsa + (bf) * SHM_V + (2 * wid) * 1024), 16, 0, 0); \
        __builtin_amdgcn_global_load_lds((const unsigned*)(vp_ + vsrc1), (LAS unsigned*)(ldsa + (bf) * SHM_V + (2 * wid + 1) * 1024), 16, 0, 0); } while (0)
__device__ __forceinline__ void prime(const Bases& G, const BlockRef& cur, char* lds, LAS unsigned char* ldsa, Seam& S) {
    const int tid = threadIdx.x, wid = __builtin_amdgcn_readfirstlane(tid >> 6), lane = tid & 63, r32 = lane & 31, hi = lane >> 5;
    ATT_SRC();
    for (int d0 = 0; d0 < 8; ++d0) S.qr[d0] = load8(G.Q + (cur.qo + (unsigned)((wid * QBLK + r32) * LD + d0 * 16 + hi * 8)));
    DMA_K(G.K + cur.kvo, G.CB + cur.cbo, cur.jlo * KVBLK, 0); DMA_V(G.V + cur.kvo, cur.jlo * KVBLK, 0);
    VMW(); LBAR();
}
__device__ __forceinline__ void block(const Bases& G, const BlockRef& cur, const BlockRef& nxt, char* lds, LAS unsigned char* ldsa, Seam& S) {
    const int tid = threadIdx.x, wid = __builtin_amdgcn_readfirstlane(tid >> 6), lane = tid & 63, r32 = lane & 31, hi = lane >> 5;
    const int j_lo = cur.jlo, NT = (cur.P0 + QB - 1) / KVBLK + 1 - j_lo;
    const int qlo = cur.P0 + wid * QBLK, qm = qlo + r32 - 4 * hi;
    char* V_lds = lds; char* K_lds = lds + 2 * SHM_V; char* B_lds = lds + OFF_BIAS;
    float* ws = (float*)(lds + OFF_WS) + wid * 64; float* li_l = ws, * al_l = ws + 32;
    float m_reg = G.CB[cur.cbo + (unsigned)(cur.P0 + wid * QBLK + r32)], l_reg = 0; f32x16 o[4] = {};
    const int vb0 = (int)(uintptr_t)V_lds + v_rd_base(lane);
    const bf16* Kh = G.K + cur.kvo; const bf16* Vh = G.V + cur.kvo; const float* CBh = G.CB + cur.cbo;
    ATT_SRC();
#define RESC(a) do { if (__any((a) < 1.f)) { if (hi == 0) al_l[r32] = (a); asm volatile("s_waitcnt lgkmcnt(0)" ::: "memory");              \
                     for (int d_ = 0; d_ < 4; ++d_) for (int r = 0; r < 16; ++r) o[d_][r] *= al_l[crow(r, hi)]; } } while (0)
#define KBASE(t) ((j_lo + (t)) * KVBLK)
#define MASKT(P0_, P1_, t) do { const int kb_ = KBASE(t); if (kb_ + KVBLK - 1 > qlo) mask_tile(P0_, P1_, qm - kb_); } while (0)
    f32x16 pA0, pA1, pB0, pB1; float mnA, mnB, alA, alB; bf16x8 pa0, pa1, pa2, pa3;
    DMA_K(Kh, CBh, KBASE(1), 1); DMA_V(Vh, KBASE(1), 1);
    SBAR(); qkt<0>(pA0, pA1, K_lds, B_lds, r32, hi, S.qr);
    MASKT(pA0, pA1, 0); partialSM(pA0, pA1, m_reg, mnA, alA);
    VMW(); LBAR();
#define HALF_STEP(PX0, PX1, mnX, alX, PY0, PY1, alY, t, KB, VB, SB) do {                                                      \
        SBAR(); if ((t) + 1 < NT) { DMA_K(Kh, CBh, KBASE((t) + 1), SB); SBAR(); }                                            \
        qkt<KB>(PX0, PX1, K_lds, B_lds, r32, hi, S.qr);                                                                        \
        finishSM(PY0, PY1, alY, l_reg, pa0, pa1, pa2, pa3); SBAR();                                                           \
        pv_tile<VB>(o, vb0, pa0, pa1, pa2, pa3); MASKT(PX0, PX1, (t)); partialSM(PX0, PX1, m_reg, mnX, alX);                   \
        LBAR();                                                                                                               \
        if ((t) + 1 < NT) { DMA_V(Vh, KBASE((t) + 1), SB); }                                                                  \
        RESC(alX); VMWN(2); LBAR(); } while (0)
    for (int t = 1; t + 1 < NT; t += 2) {
        HALF_STEP(pB0, pB1, mnB, alB, pA0, pA1, alA, t, 1, 0, 0);
        HALF_STEP(pA0, pA1, mnA, alA, pB0, pB1, alB, t + 1, 0, 1, 1);
    }
    const bool at2 = wid >= 4, at3 = wid >= 6;
    SBAR(); if (at3) qkt<1>(pB0, pB1, K_lds, B_lds, r32, hi, S.qr); SBAR();
    DMA_K(G.K + nxt.kvo, G.CB + nxt.cbo, nxt.jlo * KVBLK, 0); SBAR();
#pragma unroll
    for (int d0 = 0; d0 < 8; ++d0) S.qr[d0] = load8(G.Q + (nxt.qo + (unsigned)((wid * QBLK + r32) * LD + d0 * 16 + hi * 8)));
    SBAR();
    if (at2) { finishSM(pA0, pA1, alA, l_reg, pa0, pa1, pa2, pa3); SBAR();
        pv_tile<0>(o, vb0, pa0, pa1, pa2, pa3); }
    if (at3) { MASKT(pB0, pB1, NT - 1); partialSM(pB0, pB1, m_reg, mnB, alB); }
    VMWN(10); LBAR();
    DMA_V(G.V + nxt.kvo, nxt.jlo * KVBLK, 0);
    if (at3) { RESC(alB);
        finishSM(pB0, pB1, alB, l_reg, pa0, pa1, pa2, pa3); SBAR(); pv_tile<1>(o, vb0, pa0, pa1, pa2, pa3); }
    SBAR();
    if (hi == 0) li_l[r32] = l_reg; asm volatile("s_waitcnt lgkmcnt(0)" ::: "memory");
    float rli[16];
#pragma unroll
    for (int r = 0; r < 16; ++r) rli[r] = __builtin_amdgcn_rcpf(li_l[crow(r, hi)]);
    bf16* Ow = G.O + (cur.oo + (unsigned)(wid * QBLK * LDO));
    char* const ost = lds + OFF_OST + wid * OST_WAVE;
    const int odd = r32 & 1;
#pragma unroll
    for (int half = 0; half < 2; ++half) {
#pragma unroll
        for (int dd = 0; dd < 2; ++dd)
#pragma unroll
            for (int k = 0; k < 8; ++k) { const int d0 = 2 * half + dd;
                const float ve = o[d0][2 * k] * rli[2 * k], vo = o[d0][2 * k + 1] * rli[2 * k + 1];
                const float rcv = __shfl_xor(odd ? ve : vo, 1);
                const unsigned w = odd ? cvtpk(rcv, vo) : cvtpk(ve, rcv);
                *(unsigned*)(ost + crow(2 * k + odd, hi) * OST_PITCH + (dd * 16 + (r32 >> 1)) * 4) = w; }
        asm volatile("s_waitcnt lgkmcnt(0)" ::: "memory");
#pragma unroll
        for (int q = 0; q < 4; ++q) { const int row = 8 * q + (lane >> 3), c16 = lane & 7;
            const u32x4 v = *(const u32x4*)(ost + row * OST_PITCH + c16 * 16);
            *(u32x4*)(Ow + (unsigned)(row * LDO + half * 64 + c16 * 8)) = v; }
        asm volatile("s_waitcnt lgkmcnt(0)" ::: "memory");
    }
    VMW(); LBAR();
#undef RESC
#undef KBASE
#undef MASKT
#undef HALF_STEP
}
#undef VMW
#undef VMWN
#undef LBAR
#undef ATT_SRC
#undef DMA_K
#undef DMA_V
#undef KSWZ
#undef SBAR
}
constexpr int NB = 8, SEQ = 4096, T = NB * SEQ, DM = 1024, NH = 8, HD = 128, INW = 7176, NZ = 7168;
constexpr int NE = 32, DE = 512;
constexpr float EPS = 1e-6f;
constexpr int PMAX = 73728;
constexpr int NWAVES = 8;
constexpr size_t MiB = 1u << 20;
constexpr size_t WS_CTL = 0, CTL_ZERO_BYTES = 64 * 1024;
constexpr size_t WS_RS1 = 1 * MiB, WS_RS2 = 1 * MiB + 256 * 1024;
constexpr size_t WS_LF = 1 * MiB + 512 * 1024;
constexpr size_t WS_CB = 2 * MiB + 512 * 1024;
constexpr size_t WS_TOK = 3 * MiB + 512 * 1024;
constexpr size_t WS_LISTS = 5 * MiB;
constexpr size_t WS_WRT = 9 * MiB;
constexpr size_t WS_SRS = 9 * MiB + 512 * 1024, WS_SW = 10 * MiB;
constexpr size_t WS_SIDE = 11 * MiB;
constexpr size_t WS_WIN = 16 * MiB;
constexpr size_t WS_WA = 30 * MiB, WS_WL = 32 * MiB, WS_WO = 34 * MiB;
constexpr size_t WS_WRG = 36 * MiB;
constexpr size_t WS_XB = 40 * MiB;
constexpr size_t WS_XR = 104 * MiB;
constexpr size_t WS_GG = 168 * MiB;
constexpr size_t WS_Q = 232 * MiB, WS_K = 296 * MiB, WS_V = 360 * MiB;
constexpr size_t WS_W13 = 424 * MiB;
constexpr size_t WS_W2 = 392 * MiB;
constexpr size_t WS_XG = 168 * MiB;
constexpr size_t WS_HB = 296 * MiB;
constexpr size_t WS_WIN8 = 488 * MiB;
constexpr unsigned SEG8_MASK = 0x7Fu;
__host__ __device__ constexpr int seg_row(int sg) { int r = 0; for (int t = 0; t < sg; ++t) if (((SEG8_MASK >> t) & 1u) == ((SEG8_MASK >> sg) & 1u)) ++r; return r; }
__host__ __device__ constexpr unsigned seg_map(bool f8) { unsigned m = 0; int j = 0; for (int t = 0; t < 7; ++t) if ((((SEG8_MASK >> t) & 1u) != 0u) == f8) { m |= (unsigned)t << (4 * j); ++j; } return m; }
__host__ __device__ constexpr int seg_cnt(bool f8) { int j = 0; for (int t = 0; t < 7; ++t) if ((((SEG8_MASK >> t) & 1u) != 0u) == f8) ++j; return j; }
constexpr size_t WS_X8P = 456 * MiB;
constexpr size_t WS_END = 512 * MiB;
static_assert(WS_XG + (size_t)PMAX * 1024 <= WS_K && WS_HB + (size_t)PMAX * 1024 <= WS_W2 && WS_W2 + 32u * 1024 * 512 * 2 <= WS_W13 && WS_W13 + 64 * MiB <= WS_END, "d_ws map");
constexpr int CW_TMO = 0, CW_CODE = 1, CW_BAR = 4096, CW_CNT = 8192, CW_NORM = 8448, CW_QCTR = 12288, CW_RDY = 14000;
constexpr int RING_OFF = 0, RING_BYTES = 131072;
constexpr int LDSCTL_OFF = RING_BYTES, MISC_OFF = LDSCTL_OFF + 320;
constexpr int TBL_OFF = RING_BYTES + 1024;
constexpr int TBL_PS = TBL_OFF, TBL_CN = TBL_OFF + 256, TBL_TE = TBL_OFF + 512;
constexpr int RG_TOT = RING_BYTES + 4096, RG_CAR = RG_TOT + 4096;
constexpr int LDS_BYTES = 147456;

#include <cmath>
using pg8::bf_lo; using pg8::bf_hi; using pg8::sigmoid_f;

struct Frame {
    LAS unsigned char* lds;
    int tid, lane, wave, vcu, G;
};
__device__ __forceinline__ float wave_sum(float v) {
#pragma unroll
    for (int o = 1; o < 64; o <<= 1) v += __shfl_xor(v, o);
    return v;
}
__device__ __forceinline__ void transpose_tile(const float* src, int ld, bf16* dst, int ldd, const float* kscale, LAS float* scr, int lane) {
    const int q = lane & 7, kr = lane >> 3;
    f32x4 v[8];
#pragma unroll
    for (int i = 0; i < 8; ++i) v[i] = __builtin_nontemporal_load((const f32x4*)(src + (size_t)(kr + 8 * i) * ld + 4 * q));
#pragma unroll
    for (int i = 0; i < 8; ++i) { const int kk = kr + 8 * i; const float sc = kscale ? kscale[kk] : 1.0f;
#pragma unroll
        for (int c = 0; c < 4; ++c) scr[kk * 33 + 4 * q + c] = v[i][c] * sc; }
    LDS_WAIT(); asm volatile("" ::: "memory");
    const int c = lane & 7;
#pragma unroll
    for (int j = 0; j < 4; ++j) { const int n = (lane >> 3) + 8 * j; const LAS float* s = scr + (8 * c) * 33 + n;
        v4u o; o.x = pk2(s[0 * 33], s[1 * 33]); o.y = pk2(s[2 * 33], s[3 * 33]); o.z = pk2(s[4 * 33], s[5 * 33]); o.w = pk2(s[6 * 33], s[7 * 33]);
        *(GAS v4u*)(dst + (size_t)n * ldd + 8 * c) = o; }
    LDS_WAIT(); asm volatile("" ::: "memory");
}

__device__ __forceinline__ void transpose_tile8(const float* src, int ld, unsigned char* dst, int ldd, const float* kscale, float scale, LAS float* scr, int lane) {
    const int q = lane & 7, kr = lane >> 3;
    f32x4 v[8];
#pragma unroll
    for (int i = 0; i < 8; ++i) v[i] = __builtin_nontemporal_load((const f32x4*)(src + (size_t)(kr + 8 * i) * ld + 4 * q));
#pragma unroll
    for (int i = 0; i < 8; ++i) { const int kk = kr + 8 * i; const float sc = kscale ? kscale[kk] * scale : scale;
#pragma unroll
        for (int c = 0; c < 4; ++c) scr[kk * 33 + 4 * q + c] = v[i][c] * sc; }
    LDS_WAIT(); asm volatile("" ::: "memory");
    const int c = lane & 3;
#pragma unroll
    for (int j = 0; j < 2; ++j) { const int n = (lane >> 2) + 16 * j; const LAS float* s = scr + (16 * c) * 33 + n;
        v4u o; o.x = pg8::pack4_fp8(s[0 * 33], s[1 * 33], s[2 * 33], s[3 * 33]); o.y = pg8::pack4_fp8(s[4 * 33], s[5 * 33], s[6 * 33], s[7 * 33]);
        o.z = pg8::pack4_fp8(s[8 * 33], s[9 * 33], s[10 * 33], s[11 * 33]); o.w = pg8::pack4_fp8(s[12 * 33], s[13 * 33], s[14 * 33], s[15 * 33]);
        *(GAS v4u*)(dst + (size_t)n * ldd + 16 * c) = o; }
    LDS_WAIT(); asm volatile("" ::: "memory");
}

struct P0Args { const float *x, *g_mix, *w_in, *w_rg_a, *w_rg_x, *b_forget, *w_lru_out, *w_attn_out, *w_out, *g_ffn, *w_rgrp, *w_rexp, *w_gate, *w_up;
                bf16 *Win, *Wl, *Wa, *Wo, *Wrg, *XB; unsigned char* W13; float *RS1, *LF, *WRT; unsigned char *Win8, *X8P; };
struct TItem { const float* src; int ld; unsigned char* dst; int ldd; const float* ks; float scale; int f8; };
__device__ __forceinline__ void titem_load(const TItem& t, f32x4 (&v)[8], float (&sc)[8], int lane) {
    const int q = lane & 7, kr = lane >> 3;
#pragma unroll
    for (int i = 0; i < 8; ++i) { v[i] = __builtin_nontemporal_load((const f32x4*)(t.src + (size_t)(kr + 8 * i) * t.ld + 4 * q)); sc[i] = t.ks ? t.ks[kr + 8 * i] * t.scale : t.scale; }
}
__device__ __forceinline__ void titem_finish(const TItem& t, const f32x4 (&v)[8], const float (&sc)[8], LAS float* scr, int lane) {
    const int q = lane & 7, kr = lane >> 3;
#pragma unroll
    for (int i = 0; i < 8; ++i) { const int kk = kr + 8 * i;
#pragma unroll
        for (int c = 0; c < 4; ++c) scr[kk * 33 + 4 * q + c] = v[i][c] * sc[i]; }
    LDS_WAIT(); asm volatile("" ::: "memory");
    if (t.f8) { const int c = lane & 3;
#pragma unroll
        for (int j = 0; j < 2; ++j) { const int n = (lane >> 2) + 16 * j; const LAS float* s = scr + (16 * c) * 33 + n;
            v4u o; o.x = pg8::pack4_fp8(s[0 * 33], s[1 * 33], s[2 * 33], s[3 * 33]); o.y = pg8::pack4_fp8(s[4 * 33], s[5 * 33], s[6 * 33], s[7 * 33]);
            o.z = pg8::pack4_fp8(s[8 * 33], s[9 * 33], s[10 * 33], s[11 * 33]); o.w = pg8::pack4_fp8(s[12 * 33], s[13 * 33], s[14 * 33], s[15 * 33]);
            *(GAS v4u*)(t.dst + (size_t)n * t.ldd + 16 * c) = o; } }
    else { const int c = lane & 7;
#pragma unroll
        for (int j = 0; j < 4; ++j) { const int n = (lane >> 3) + 8 * j; const LAS float* s = scr + (8 * c) * 33 + n;
            v4u o; o.x = pk2(s[0 * 33], s[1 * 33]); o.y = pk2(s[2 * 33], s[3 * 33]); o.z = pk2(s[4 * 33], s[5 * 33]); o.w = pk2(s[6 * 33], s[7 * 33]);
            *(GAS v4u*)(t.dst + ((size_t)n * t.ldd + 8 * c) * 2) = o; } }
    LDS_WAIT(); asm volatile("" ::: "memory");
}
constexpr int P0_I_IN = 16 * 224, P0_I_SQ = 16 * 32, P0_I_RG = 2 * 4 * 4 * 8, P0_I_EX = 2 * 8192, P0_NITEMS = P0_I_IN + 3 * P0_I_SQ + P0_I_RG + P0_I_EX;
__device__ __forceinline__ void p0_items(const Frame& F, const P0Args& a, const int first, const int last, const int stride, const int offset) {
    LAS float* scr = (LAS float*)(F.lds + RING_OFF + F.wave * 16384);
    const float* const p_wl = a.w_lru_out; const float* const p_wa = a.w_attn_out; const float* const p_wo = a.w_out; const float* const p_rga = a.w_rg_a; const float* const p_rgx = a.w_rg_x;
    bf16* const q_wl = a.Wl; bf16* const q_wa = a.Wa; bf16* const q_wo = a.Wo;
    constexpr int I_IN = P0_I_IN, I_SQ = P0_I_SQ, I_EX = P0_I_EX, NITEMS = P0_NITEMS;
    const float* const p_gate = a.w_gate; const float* const p_up = a.w_up; const float* const p_win = a.w_in; const float* const p_gmix = a.g_mix; const float* const p_gffn = a.g_ffn;
    bf16* const q_win = a.Win; bf16* const q_wrg = a.Wrg; unsigned char* const q_w13 = a.W13; unsigned char* const q_win8 = a.Win8;
#define P0_DECODE(it_, t_) do { int r = (it_); \
        if (r >= NITEMS - I_EX) { r -= NITEMS - I_EX;     \
            const int w = r >> 13, e = (r >> 8) & 31, kb = (r >> 4) & 15, nb = r & 15; const float* W = (w == 0 ? p_gate : p_up) + (size_t)e * DM * DE; \
            const int drow = e * 1024 + (nb >> 2) * 256 + (nb & 3) * 32 + (w == 1 ? 128 : 0); \
            t_.src = W + (size_t)(64 * kb) * DE + 32 * nb; t_.ld = DE; t_.dst = q_w13 + (size_t)drow * DM + 64 * kb; t_.ldd = DM; t_.ks = p_gffn + 64 * kb; t_.scale = pg8::W13_SCALE; t_.f8 = 1; } \
        else if (r < I_IN) { const int kb = r / 224, nb = r % 224, n0 = 32 * nb, sc_ = n0 < 5120 ? n0 : n0 + 8; \
            t_.src = p_win + (size_t)(64 * kb) * INW + sc_; t_.ld = INW; t_.ldd = DM; t_.ks = p_gmix + 64 * kb; \
            const int sg_ = n0 >> 10; int sr_ = 0; for (int t2 = 0; t2 < 7; ++t2) if (t2 < sg_ && (((SEG8_MASK >> t2) & 1u) == ((SEG8_MASK >> sg_) & 1u))) ++sr_;     \
            const int nr_ = sr_ * 1024 + (n0 & 1023); \
            if ((SEG8_MASK >> sg_) & 1u) { t_.dst = q_win8 + (size_t)nr_ * DM + 64 * kb; t_.scale = pg8::WIN_SCALE; t_.f8 = 1; }     \
            else { t_.dst = (unsigned char*)(q_win + (size_t)nr_ * DM + 64 * kb); t_.scale = 1.0f; t_.f8 = 0; } } \
        else if (r < I_IN + 3 * I_SQ) { r -= I_IN; const int w = r / I_SQ, q = r % I_SQ, kb = q / 32, nb = q % 32; const float* W = w == 0 ? p_wl : (w == 1 ? p_wa : p_wo); bf16* Wt = w == 0 ? q_wl : (w == 1 ? q_wa : q_wo); \
            t_.src = W + (size_t)(64 * kb) * DM + 32 * nb; t_.ld = DM; t_.dst = (unsigned char*)(Wt + (size_t)(32 * nb) * DM + 64 * kb); t_.ldd = DM; t_.ks = nullptr; t_.scale = 1.0f; t_.f8 = 0; } \
        else { r -= I_IN + 3 * I_SQ; const int gb = r / 32, q = r % 32, kb = q / 8, nb = q % 8; const float* W = (gb < 4 ? p_rga : p_rgx) + (size_t)(gb & 3) * 65536; \
            t_.src = W + (size_t)(64 * kb) * 256 + 32 * nb; t_.ld = 256; t_.dst = (unsigned char*)(q_wrg + (size_t)gb * 65536 + (size_t)(32 * nb) * 256 + 64 * kb); t_.ldd = 256; t_.ks = nullptr; t_.scale = -1.4426950408889634f; t_.f8 = 0; }     } while (0)
    {
        int it = first + offset; TItem cur; f32x4 va[8]; float sa[8];
        if (it < last) { P0_DECODE(it, cur); titem_load(cur, va, sa, F.lane); }
        while (it < last) {
            const int nx = it + stride; TItem nt = cur; f32x4 vb[8]; float sb[8];
            if (nx < last) { P0_DECODE(nx, nt); titem_load(nt, vb, sb, F.lane); }
            titem_finish(cur, va, sa, scr, F.lane);
            if (nx < last) { cur = nt;
#pragma unroll
                for (int i = 0; i < 8; ++i) { va[i] = vb[i]; sa[i] = sb[i]; } }
            it = nx;
        }
    }
#undef P0_DECODE
}
__device__ __forceinline__ void p0_prologue(const Frame& F, const P0Args& a, const int part  ) {
    const int gw = F.vcu * NWAVES + F.wave, NGW = F.G * NWAVES;
    if (part != 2) p0_items(F, a, 0, P0_NITEMS - P0_I_EX, NGW, gw);
    if (part == 1) return;
    for (int i = (F.vcu * NWAVES + F.wave) * 64 + F.lane; i < 64 * DM; i += NGW * 64) { const int n = i >> 10, k = i & 1023;
        float v = 0.f; if (n < 32) v = a.w_rexp[k * 32 + n]; else if (n < 36) v = a.w_rgrp[k * 4 + (n - 32)];
        a.WRT[i] = v * a.g_ffn[k]; }
    LAS float* wfl = (LAS float*)(F.lds + RING_OFF);
    __syncthreads();
    for (int k = F.tid; k < DM; k += NWAVES * 64) { const float g = a.g_mix[k];
        const f32x4 w0 = *(const f32x4*)(a.w_in + (size_t)k * INW + 5120), w1 = *(const f32x4*)(a.w_in + (size_t)k * INW + 5124);
        *(LAS f32x4*)(wfl + k * 8) = w0 * g; *(LAS f32x4*)(wfl + k * 8 + 4) = w1 * g; }
    __syncthreads();
    float wf[4][4][8];
#pragma unroll
    for (int j = 0; j < 4; ++j)
#pragma unroll
        for (int i = 0; i < 4; ++i) { const int k = 256 * j + 4 * F.lane + i; const f32x4 w0 = *(const LAS f32x4*)(wfl + k * 8), w1 = *(const LAS f32x4*)(wfl + k * 8 + 4);
#pragma unroll
            for (int h = 0; h < 4; ++h) { wf[j][i][h] = w0[h]; wf[j][i][4 + h] = w1[h]; } }
    const float bfg = a.b_forget[F.lane & 7];
    f32x4 vn[4];
    if (gw < T) { const GAS f32x4* xr0 = (const GAS f32x4*)(a.x + (size_t)gw * DM) + F.lane;
#pragma unroll
        for (int j = 0; j < 4; ++j) vn[j] = __builtin_nontemporal_load((const f32x4*)xr0 + 64 * j); }
    for (int m = gw; m < T; m += NGW) {
        f32x4 v[4]; float s = 0.f, d[8] = {0.f, 0.f, 0.f, 0.f, 0.f, 0.f, 0.f, 0.f};
#pragma unroll
        for (int j = 0; j < 4; ++j) v[j] = vn[j];
        if (m + NGW < T) { const GAS f32x4* xr1 = (const GAS f32x4*)(a.x + (size_t)(m + NGW) * DM) + F.lane;
#pragma unroll
            for (int j = 0; j < 4; ++j) vn[j] = __builtin_nontemporal_load((const f32x4*)xr1 + 64 * j); }
#pragma unroll
        for (int j = 0; j < 4; ++j) { s += (v[j].x * v[j].x + v[j].y * v[j].y) + (v[j].z * v[j].z + v[j].w * v[j].w);
#pragma unroll
            for (int i = 0; i < 4; ++i)
#pragma unroll
                for (int h = 0; h < 8; ++h) d[h] = fmaf(v[j][i], wf[j][i][h], d[h]); }
        s = wave_sum(s);
#pragma unroll
        for (int h = 0; h < 8; ++h) d[h] = wave_sum(d[h]);
        const float rs = 1.0f / sqrtf(s * (1.0f / DM) + EPS);
        GAS unsigned long long* o8 = (GAS unsigned long long*)(a.XB + (size_t)m * DM) + F.lane;
        if constexpr (seg_cnt(false) > 0)
#pragma unroll
        for (int j = 0; j < 4; ++j) __builtin_nontemporal_store((unsigned long long)pk2(v[j].x * rs, v[j].y * rs) | ((unsigned long long)pk2(v[j].z * rs, v[j].w * rs) << 32), (unsigned long long*)o8 + 64 * j);
        { GAS unsigned* o4 = (GAS unsigned*)(a.X8P + (size_t)m * DM) + F.lane; const float r8 = rs * pg8::XS_SCALE;
#pragma unroll
          for (int j = 0; j < 4; ++j) o4[64 * j] = pg8::pack4_fp8(v[j].x * r8, v[j].y * r8, v[j].z * r8, v[j].w * r8); }
        if (F.lane < 8) { const int h = F.lane; float dh = d[0]; dh = h == 1 ? d[1] : dh; dh = h == 2 ? d[2] : dh; dh = h == 3 ? d[3] : dh; dh = h == 4 ? d[4] : dh; dh = h == 5 ? d[5] : dh; dh = h == 6 ? d[6] : dh; dh = h == 7 ? d[7] : dh;
            const float fl = dh * rs + bfg; a.LF[(size_t)m * 8 + h] = fminf(fl, 0.f) - log1pf(expf(-fabsf(fl))); }
    }
}
__device__ __forceinline__ void w13_copies(const Frame& F, const float* g_ffn, const float* w_gate, const float* w_up, unsigned char* W13) {
    LAS float* scr = (LAS float*)(F.lds + RING_OFF + F.wave * 16384);
#define EX_DECODE(it_, t_) do { const int r = (it_); const int w = r >> 13, e = (r >> 8) & 31, kb = (r >> 4) & 15, nb = r & 15; const float* W = (w == 0 ? w_gate : w_up) + (size_t)e * DM * DE; \
        const int drow = e * 1024 + (nb >> 2) * 256 + (nb & 3) * 32 + (w == 1 ? 128 : 0); \
        t_.src = W + (size_t)(64 * kb) * DE + 32 * nb; t_.ld = DE; t_.dst = W13 + (size_t)drow * DM + 64 * kb; t_.ldd = DM; t_.ks = g_ffn + 64 * kb; t_.scale = pg8::W13_SCALE; t_.f8 = 1; } while (0)
    const int stride = F.G * NWAVES;
    int it = F.vcu * NWAVES + F.wave; TItem cur; f32x4 va[8]; float sa[8];
    if (it < P0_I_EX) { EX_DECODE(it, cur); titem_load(cur, va, sa, F.lane); }
    while (it < P0_I_EX) {
        const int nx = it + stride; TItem nt = cur; f32x4 vb[8]; float sb[8];
        if (nx < P0_I_EX) { EX_DECODE(nx, nt); titem_load(nt, vb, sb, F.lane); }
        titem_finish(cur, va, sa, scr, F.lane);
        if (nx < P0_I_EX) { cur = nt;
#pragma unroll
            for (int i = 0; i < 8; ++i) { va[i] = vb[i]; sa[i] = sb[i]; } }
        it = nx;
    }
#undef EX_DECODE
    __syncthreads();
}
__device__ __forceinline__ void cumsum_bias(const Frame& F, const float* LF, float* CB) {
    LAS float* wt = (LAS float*)(F.lds + RING_OFF);
    for (int bh = blockIdx.x; bh < NB * NH; bh += F.G) {
        const int b = bh >> 3, h = bh & 7, s0 = F.tid * 8;
        float v[8], run = 0.f;
#pragma unroll
        for (int j = 0; j < 8; ++j) { run += LF[((size_t)(b * SEQ + s0 + j)) * 8 + h]; v[j] = run; }
        float inc = run;
#pragma unroll
        for (int o = 1; o < 64; o <<= 1) { const float t = __shfl_up(inc, o); if (F.lane >= o) inc += t; }
        if (F.lane == 63) wt[F.wave] = inc;
        __syncthreads();
        float pre = inc - run;
        for (int w = 0; w < F.wave; ++w) pre += wt[w];
#pragma unroll
        for (int j = 0; j < 8; ++j) CB[(size_t)bh * SEQ + s0 + j] = -(pre + v[j]) * 11.313708498984761f;
        __syncthreads();
    }
}
struct RgArgs { const bf16* XC; const bf16* GG; bf16* GO; const bf16* Wrg; const float *b_a, *b_x, *lam; };
__device__ __forceinline__ float bfx(const v4u& v, int i) { const unsigned w = i < 2 ? v.x : (i < 4 ? v.y : (i < 6 ? v.z : v.w)); return (i & 1) ? bf_hi(w) : bf_lo(w); }
__device__ __forceinline__ unsigned cvtpk_bf16(float lo, float hi) { unsigned r; asm volatile("v_cvt_pk_bf16_f32 %0, %1, %2" : "=v"(r) : "v"(lo), "v"(hi)); return r; }
__device__ __forceinline__ void conv_fixup(const Frame& F, const float* SIDE, bf16* XC, const float* conv_w, const float* conv_b) {
    const int gw = F.vcu * NWAVES + F.wave, NGW = F.G * NWAVES;
    for (int it = gw; it < (T / 256) * 2; it += NGW) {
        const int pm = it >> 1, c0 = (it & 1) * 512 + 8 * F.lane; const bool seq0 = (pm & 15) == 0;
        float cw[4][8], cbv[8], x[6][8];
#pragma unroll
        for (int j = 0; j < 4; ++j) { const f32x4 w0 = *(const f32x4*)(conv_w + j * DM + c0), w1 = *(const f32x4*)(conv_w + j * DM + c0 + 4);
#pragma unroll
            for (int i = 0; i < 4; ++i) { cw[j][i] = w0[i]; cw[j][4 + i] = w1[i]; } }
        { const f32x4 w0 = *(const f32x4*)(conv_b + c0), w1 = *(const f32x4*)(conv_b + c0 + 4);
#pragma unroll
          for (int i = 0; i < 4; ++i) { cbv[i] = w0[i]; cbv[4 + i] = w1[i]; } }
#pragma unroll
        for (int q = 0; q < 6; ++q) { const float* sp = q < 3 ? SIDE + ((size_t)(seq0 ? pm : pm - 1) * 6 + 3 + q) * DM + c0 : SIDE + ((size_t)pm * 6 + (q - 3)) * DM + c0;
            const f32x4 w0 = *(const f32x4*)sp, w1 = *(const f32x4*)(sp + 4); const bool z = q < 3 && seq0;
#pragma unroll
            for (int i = 0; i < 4; ++i) { x[q][i] = z ? 0.f : w0[i]; x[q][4 + i] = z ? 0.f : w1[i]; } }
#pragma unroll
        for (int r = 0; r < 3; ++r) { float y[8];
#pragma unroll
            for (int i = 0; i < 8; ++i) { float sacc = cbv[i];
#pragma unroll
                for (int j = 0; j < 4; ++j) sacc = fmaf(cw[j][i], x[r + j][i], sacc);
                y[i] = sacc; }
            v4u o; o.x = cvtpk_bf16(y[0], y[1]); o.y = cvtpk_bf16(y[2], y[3]); o.z = cvtpk_bf16(y[4], y[5]); o.w = cvtpk_bf16(y[6], y[7]);
            *(GAS v4u*)(XC + ((unsigned)(pm * 256 + r) * DM + c0)) = o; }
    }
}
__device__ __forceinline__ void rglru_unit(const Frame& F, const RgArgs& a, int unit) {
    const int tid = F.tid, lane = F.lane, wid = F.wave, fr = lane & 15, fq = lane >> 4, rq = wid >> 1, cp = wid & 1;
    const int b = unit >> 5, n = (unit >> 3) & 3, g = unit & 7, cbase = 256 * n, cown = cbase + 32 * g;
    LAS unsigned char* A_l = F.lds + RING_OFF;
    LAS float* tot = (LAS float*)(F.lds + RG_TOT);
    bf16x8 bfr[2][8];
#pragma unroll
    for (int gt = 0; gt < 2; ++gt)
#pragma unroll
        for (int ks = 0; ks < 8; ++ks) bfr[gt][ks] = *(const GAS bf16x8*)(a.Wrg + ((size_t)((gt * 4 + n) * 256 + 32 * g + 16 * cp + fr)) * 256 + 32 * ks + 8 * fq);
    const int cl = 16 * cp + fr, cch = cown + cl;
    const float ba = -1.4426950408889634f * a.b_a[cch], bx = -1.4426950408889634f * a.b_x[cch], sp8 = 8.0f * log1pf(expf(-a.lam[cch])) * 1.4426950408889634f;
    const unsigned goff = (unsigned)(b * SEQ + 32 * rq + 4 * fq) * DM + cch;
    const __amdgpu_buffer_rsrc_t GGr = __builtin_amdgcn_make_buffer_rsrc((void*)a.GG, 0, (int)((size_t)T * DM * 2), 0x00020000);
    const __amdgpu_buffer_rsrc_t GOr = __builtin_amdgcn_make_buffer_rsrc((void*)a.GO, 0, (int)((size_t)T * DM * 2), 0x00020000);
    const int gvo = (int)(goff * 2u);
    const unsigned dbase = ((unsigned)(b * SEQ + 16 * wid + (lane >> 5)) * DM + cbase) * 2u;
    const char* const XCb = (const char*)a.XC;
#define RG_DMA(ci_, buf_) do { _Pragma("unroll") for (int i_ = 0; i_ < 8; ++i_) { const unsigned so_ = dbase + (unsigned)(2 * i_) * (DM * 2u) + ((((unsigned)lane & 31u) ^ (unsigned)((2 * i_ + (lane >> 5)) & 15)) << 4); \
        __builtin_amdgcn_global_load_lds((const unsigned*)(XCb + so_ + (unsigned)(ci_) * (128u * DM * 2u)), (LAS unsigned*)(A_l + (buf_) * 65536 + (8 * wid + i_) * 1024), 16, 0, 0); } } while (0)
    float hc = 0.f;
    const int kx = 32 * g + cl;
#pragma unroll
    for (int gt = 0; gt < 2; ++gt)
#pragma unroll
        for (int ks = 0; ks < 8; ++ks) asm volatile("" : "+v"(bfr[gt][ks]));
    RG_DMA(0, 0); asm volatile("s_waitcnt vmcnt(0)" ::: "memory");
#define RG_CHUNK(BUF_, ci_) do { const int ci = (ci_); const int t0 = 128 * ci; LAS unsigned char* const Ab = A_l + (BUF_) * 65536; \
        __builtin_amdgcn_s_barrier(); asm volatile("" ::: "memory"); \
        unsigned short ggv[2][4]; \
        _Pragma("unroll") \
        for (int mt = 0; mt < 2; ++mt) \
        _Pragma("unroll") \
            for (int j = 0; j < 4; ++j) ggv[mt][j] = __builtin_amdgcn_raw_buffer_load_b16(GGr, gvo, (t0 + 16 * mt + j) * (DM * 2), 0); \
        if (ci + 1 < SEQ / 128) RG_DMA(ci + 1, BUF_ ^ 1); \
 \
        f32x4 acc[2][2]; \
        _Pragma("unroll") \
        for (int mt = 0; mt < 2; ++mt) { acc[mt][0] = (f32x4){ba, ba, ba, ba}; acc[mt][1] = (f32x4){bx, bx, bx, bx}; } \
        _Pragma("unroll") \
        for (int ks = 0; ks < 8; ++ks) { const int ch = 4 * ks + fq; \
        _Pragma("unroll") \
            for (int mt = 0; mt < 2; ++mt) { const int arow = 32 * rq + 16 * mt + fr; \
                const bf16x8 af = *(const LAS bf16x8*)(Ab + arow * 512 + ((ch ^ (arow & 15)) << 4)); \
                acc[mt][0] = __builtin_amdgcn_mfma_f32_16x16x32_bf16(af, bfr[0][ks], acc[mt][0], 0, 0, 0); \
                acc[mt][1] = __builtin_amdgcn_mfma_f32_16x16x32_bf16(af, bfr[1][ks], acc[mt][1], 0, 0, 0); } } \
 \
        float av[2][4], bv[2][4], sA[2], sB[2]; \
        _Pragma("unroll") \
        for (int mt = 0; mt < 2; ++mt) { float A = 1.f, Bv = 0.f; \
        _Pragma("unroll") \
            for (int j = 0; j < 4; ++j) { const int row = 32 * rq + 16 * mt + 4 * fq + j; \
                const unsigned short xb16 = *(const LAS unsigned short*)(Ab + row * 512 + ((((kx >> 3) ^ (row & 15))) << 4) + (kx & 7) * 2); \
                const float xc = __builtin_bit_cast(float, (unsigned)xb16 << 16); \
                const float r_ = __builtin_amdgcn_rcpf(1.0f + __builtin_amdgcn_exp2f(acc[mt][0][j])), i_ = __builtin_amdgcn_rcpf(1.0f + __builtin_amdgcn_exp2f(acc[mt][1][j])); \
                const float aa = __builtin_amdgcn_exp2f(-sp8 * r_); \
                const float mult = __builtin_amdgcn_sqrtf(fmaxf(fmaf(-aa, aa, 1.0f), 0.f)); \
                av[mt][j] = aa; bv[mt][j] = mult * i_ * xc; \
                Bv = fmaf(aa, Bv, bv[mt][j]); A *= aa; } \
            sA[mt] = A; sB[mt] = Bv; } \
 \
        float eA[2], eB[2], tA[2], tB[2]; \
        _Pragma("unroll") \
        for (int mt = 0; mt < 2; ++mt) { float A = sA[mt], Bv = sB[mt]; \
            { const float pA = __shfl_up(A, 16), pB = __shfl_up(Bv, 16); if (fq >= 1) { Bv = fmaf(A, pB, Bv); A *= pA; } } \
            { const float pA = __shfl_up(A, 32), pB = __shfl_up(Bv, 32); if (fq >= 2) { Bv = fmaf(A, pB, Bv); A *= pA; } } \
            const float xA = __shfl_up(A, 16), xB = __shfl_up(Bv, 16); eA[mt] = fq >= 1 ? xA : 1.f; eB[mt] = fq >= 1 ? xB : 0.f; \
            tA[mt] = __shfl(A, 48 + fr); tB[mt] = __shfl(Bv, 48 + fr); } \
        const float wA = tA[0] * tA[1], wB = fmaf(tA[1], tB[0], tB[1]); \
        if (fq == 0) { tot[(rq * 32 + cl) * 2] = wA; tot[(rq * 32 + cl) * 2 + 1] = wB; } \
        asm volatile("s_waitcnt lgkmcnt(0)" ::: "memory"); __builtin_amdgcn_s_barrier(); asm volatile("" ::: "memory"); \
        float hin = hc, hnew = hc; \
        _Pragma("unroll") \
        for (int q = 0; q < 4; ++q) { const float qA = tot[(q * 32 + cl) * 2], qB = tot[(q * 32 + cl) * 2 + 1]; hnew = fmaf(qA, hnew, qB); if (q < rq) hin = hnew; } \
        hc = hnew; \
        _Pragma("unroll") \
        for (int mt = 0; mt < 2; ++mt) { float h = mt == 0 ? hin : fmaf(tA[0], hin, tB[0]); \
            h = fmaf(eA[mt], h, eB[mt]); \
        _Pragma("unroll") \
            for (int j = 0; j < 4; ++j) { h = fmaf(av[mt][j], h, bv[mt][j]); \
                const float gv = __builtin_bit_cast(float, (unsigned)ggv[mt][j] << 16); \
                __builtin_amdgcn_raw_buffer_store_b16((unsigned short)cvtpk_bf16(h * gv, 0.f), GOr, gvo, (t0 + 16 * mt + j) * (DM * 2), 0); } } \
        asm volatile("s_waitcnt lgkmcnt(0)" ::: "memory"); \
        asm volatile("s_waitcnt vmcnt(8)" ::: "memory"); \
    } while (0)
    for (int cc = 0; cc < SEQ / 128; cc += 2) { RG_CHUNK(0, cc); RG_CHUNK(1, cc + 1); }
#undef RG_CHUNK
#undef RG_DMA
    asm volatile("s_waitcnt vmcnt(0) lgkmcnt(0)" ::: "memory"); __builtin_amdgcn_s_barrier(); asm volatile("" ::: "memory");
}
constexpr float SKIP_LOG2 = 34.0f;
__device__ __forceinline__ int attn_jlo(const Frame& F, const float* CB, const unsigned* NORM, int bh, int qb) {
    float qk = 0.f;
#pragma unroll
    for (int w = 0; w < 4; ++w) qk += sqrtf(__uint_as_float(NORM[(bh) * 4 + w]) * __uint_as_float(NORM[(64 + bh) * 4 + w]));
    constexpr float C2 = 1.4426950408889634f * 0.08838834764831845f;
    const float base = 2.0f * 1.02f * qk * C2, th1 = SKIP_LOG2 - 1.0f + base, th2 = SKIP_LOG2 + 5.0f + base;
    const float ref = CB[(size_t)bh * SEQ + qb * 256], v = CB[(size_t)bh * SEQ + 64 * F.lane + 63];
    const float d = (ref - v) * C2;
    const unsigned long long m1 = __ballot(F.lane < 4 * qb && d > th1), m2 = __ballot(F.lane < 4 * qb && d > th2);
    int j1 = __builtin_popcountll(m1); if (m1 != ((j1 >= 64) ? ~0ull : ((1ull << j1) - 1ull))) j1 = 0;
    int j2 = __builtin_popcountll(m2); if (m2 != ((j2 >= 64) ? ~0ull : ((1ull << j2) - 1ull))) j1 = 0;
    const int j = j1 < j2 + 1 ? j1 : j2 + 1;
    return j & ~1;
}
__device__ __forceinline__ fattn::BlockRef attn_ref(int bh, int qb, int jlo) {
    const int b = bh >> 3, h = bh & 7;
    fattn::BlockRef r; r.qo = ((unsigned)bh * SEQ + (unsigned)qb * 256u) * HD; r.oo = ((unsigned)b * SEQ + (unsigned)qb * 256u) * DM + h * HD; r.kvo = (unsigned)bh * SEQ * HD; r.cbo = (unsigned)bh * SEQ; r.P0 = qb * 256; r.jlo = jlo; return r;
}
__device__ __forceinline__ void attn_phase(const Frame& F, char* lds, const bf16* Qb, bf16* Ob, const bf16* Kb, const bf16* Vb, const float* CB, const int* JLO, gu32* QCTR, const int probe = 0) {
#define ATT_JLO(bh_, qb_) (probe == 1 ? 4 * (qb_) : probe == 2 ? 0 : __builtin_amdgcn_readfirstlane(JLO[(bh_) * 16 + (qb_)]))
    constexpr int NBLK = 128;
    const int M = F.G >> 3; if ((F.G & 7) || M > 64 || M < 1) return;
    const int x = F.vcu / M, r = F.vcu % M;
    volatile LAS int* tk_l = (volatile LAS int*)(F.lds + MISC_OFF + 64);
    gu32* qc = QCTR + 64 * x;
    const fattn::Bases G{Qb, Ob, Kb, Vb, CB}; LAS unsigned char* const ldsa = F.lds + RING_OFF;
#define ATT_DEC(k_, bh_, qb_) do { const int i_ = (k_) & 7; bh_ = (i_ < 4 ? 4 * x + i_ : 32 + 4 * x + (i_ - 4)); qb_ = 15 - ((k_) >> 3); } while (0)
    int bh, qb; ATT_DEC(r, bh, qb);
    fattn::BlockRef cur = attn_ref(bh, qb, ATT_JLO(bh, qb));
    ATT_DEC(r + M, bh, qb);
    fattn::BlockRef nxt = attn_ref(bh, qb, ATT_JLO(bh, qb)); bool nxt_ok = (r + M) < NBLK;
    fattn::Seam S;
    fattn::prime(G, cur, lds, ldsa, S);
    bool more = true;
    for (;;) {
        unsigned tkt = 0u;
        if (more && F.tid == 0) tkt = __hip_atomic_fetch_add(qc, 1u, __ATOMIC_RELAXED, __HIP_MEMORY_SCOPE_AGENT);
        const bool last = !nxt_ok;
        fattn::block(G, cur, last ? cur : nxt, lds, ldsa, S);
        if (last) break;
        if (F.tid == 0) tk_l[0] = more ? (int)tkt + 2 * M : NBLK;
        __syncthreads();
        const int k2 = __builtin_amdgcn_readfirstlane(tk_l[0]);
        __syncthreads();
        cur = nxt;
        if (k2 < NBLK) { ATT_DEC(k2, bh, qb); nxt = attn_ref(bh, qb, ATT_JLO(bh, qb)); nxt_ok = true; } else { nxt_ok = false; more = false; }
    }
#undef ATT_DEC
#undef ATT_JLO
}
typedef float f32x16 __attribute__((ext_vector_type(16)));
struct P5Args { const float *X, *WRT, *b_rgrp, *b_rexp, *w_down; const bf16* DL; bf16* X1B; unsigned char *X8, *W2; float* RS2; int* LISTS; unsigned* TOK; gu32* CNT; };
__device__ __forceinline__ void p5_route(const Frame& F, const P5Args& a) {
    const int tid = F.tid, lane = F.lane, wid = F.wave, i16 = lane & 15, h4 = lane >> 4;
    constexpr int LDA = 132;
    LAS float* A_l = (LAS float*)(F.lds + RING_OFF) + wid * 16 * LDA;
    LAS float* B_l = (LAS float*)(F.lds + RING_OFF + 67584);
    LAS float* LG = (LAS float*)(F.lds + RING_OFF + 94208);
    LAS float* rs_l = (LAS float*)(F.lds + RING_OFF + 113664);
    LAS int* hist = (LAS int*)(F.lds + RING_OFF + 114176);
    LAS int* base_l = (LAS int*)(F.lds + RING_OFF + 114432);
    {
        LAS float* scr = (LAS float*)(F.lds + RING_OFF + wid * 8704);
        const int gw = F.vcu * NWAVES + wid, NGW = F.G * NWAVES;
#define W2_DECODE(it_, t_) do { const int e = (it_) >> 8, kb = ((it_) >> 5) & 7, nb = (it_) & 31; const float* W = a.w_down + (size_t)e * DE * DM; \
            const int drow = e * 1024 + (nb >> 3) * 256 + (nb & 1) * 128 + ((nb & 7) >> 1) * 32;     \
            t_.src = W + (size_t)(64 * kb) * DM + 32 * nb; t_.ld = DM; t_.dst = a.W2 + (size_t)drow * DE + 64 * kb; t_.ldd = DE; t_.ks = nullptr; t_.scale = pg8::W2_SCALE; t_.f8 = 1; } while (0)
        { int it = gw; TItem cur; f32x4 va[8]; float sa[8];
          if (it < 8192) { W2_DECODE(it, cur); titem_load(cur, va, sa, lane); }
          while (it < 8192) { const int nx = it + NGW; TItem nt = cur; f32x4 vb[8]; float sb[8];
              if (nx < 8192) { W2_DECODE(nx, nt); titem_load(nt, vb, sb, lane); }
              titem_finish(cur, va, sa, scr, lane);
              if (nx < 8192) { cur = nt;
#pragma unroll
                  for (int i = 0; i < 8; ++i) { va[i] = vb[i]; sa[i] = sb[i]; } }
              it = nx; } }
#undef W2_DECODE
    }
    __syncthreads();
    for (int rb = blockIdx.x; rb < T / 128; rb += F.G) {
        const int R0 = rb * 128;
        if (tid < 32) hist[tid] = 0;
        const int ar = lane >> 5, ac = 4 * (lane & 31);
        const size_t xo = (size_t)(R0 + 16 * wid + ar) * DM + ac; const float* xsrc = a.X + xo; const bf16* dsrc = a.DL + xo; unsigned char* xdst = a.X8 + xo; bf16* bdst = a.X1B + xo;
        f32x4 areg[8], breg[3]; unsigned long long dreg[8];
#define P5_LOAD(kc_) do { _Pragma("unroll") for (int i_ = 0; i_ < 8; ++i_) { areg[i_] = __builtin_nontemporal_load((const f32x4*)(xsrc + (size_t)(2 * i_) * DM + (kc_) * 128)); dreg[i_] = __builtin_nontemporal_load((const unsigned long long*)(dsrc + (size_t)(2 * i_) * DM + (kc_) * 128)); } \
        _Pragma("unroll") for (int q_ = 0; q_ < 3; ++q_) { const int idx_ = tid + 512 * q_; breg[q_] = *(const f32x4*)(a.WRT + (size_t)(idx_ >> 5) * DM + (kc_) * 128 + 4 * (idx_ & 31)); } } while (0)
        P5_LOAD(0);
        f32x4 acc[3] = {{0.f, 0.f, 0.f, 0.f}, {0.f, 0.f, 0.f, 0.f}, {0.f, 0.f, 0.f, 0.f}}; float ss = 0.f;
        for (int kc = 0; kc < 8; ++kc) {
#pragma unroll
            for (int i = 0; i < 8; ++i) { const unsigned dl = (unsigned)dreg[i], dh = (unsigned)(dreg[i] >> 32);
                areg[i][0] += bf_lo(dl); areg[i][1] += bf_hi(dl); areg[i][2] += bf_lo(dh); areg[i][3] += bf_hi(dh);
                *(unsigned*)(xdst + (size_t)(2 * i) * DM + kc * 128) = pg8::pack4_fp8(areg[i][0], areg[i][1], areg[i][2], areg[i][3]);
                __builtin_nontemporal_store((unsigned long long)pg8::cvt_pk_bf16(areg[i][0], areg[i][1]) | ((unsigned long long)pg8::cvt_pk_bf16(areg[i][2], areg[i][3]) << 32), (unsigned long long*)(bdst + (size_t)(2 * i) * DM + kc * 128));
                *(LAS f32x4*)(A_l + (2 * i + ar) * LDA + ac) = areg[i]; }
#pragma unroll
            for (int q = 0; q < 3; ++q) { const int idx = tid + 512 * q; *(LAS f32x4*)(B_l + (idx >> 5) * LDA + 4 * (idx & 31)) = breg[q]; }
            __syncthreads();
            if (kc + 1 < 8) P5_LOAD(kc + 1);
#define P5_SPLIT(x0_, x1_, hi_, lo_) do { v4u h_, l_; h_.x = pg8::cvt_pk_bf16(x0_[0], x0_[1]); h_.y = pg8::cvt_pk_bf16(x0_[2], x0_[3]); h_.z = pg8::cvt_pk_bf16(x1_[0], x1_[1]); h_.w = pg8::cvt_pk_bf16(x1_[2], x1_[3]); \
                l_.x = pg8::cvt_pk_bf16(x0_[0] - pg8::bf_lo(h_.x), x0_[1] - pg8::bf_hi(h_.x)); l_.y = pg8::cvt_pk_bf16(x0_[2] - pg8::bf_lo(h_.y), x0_[3] - pg8::bf_hi(h_.y)); \
                l_.z = pg8::cvt_pk_bf16(x1_[0] - pg8::bf_lo(h_.z), x1_[1] - pg8::bf_hi(h_.z)); l_.w = pg8::cvt_pk_bf16(x1_[2] - pg8::bf_lo(h_.w), x1_[3] - pg8::bf_hi(h_.w)); \
                hi_ = __builtin_bit_cast(bf16x8, h_); lo_ = __builtin_bit_cast(bf16x8, l_); } while (0)
#pragma unroll
            for (int jj = 0; jj < 4; ++jj) {
                const f32x4 a0 = *(const LAS f32x4*)(A_l + i16 * LDA + 32 * jj + 8 * h4), a1 = *(const LAS f32x4*)(A_l + i16 * LDA + 32 * jj + 8 * h4 + 4);
                ss += ((a0[0] * a0[0] + a0[1] * a0[1]) + (a0[2] * a0[2] + a0[3] * a0[3])) + ((a1[0] * a1[0] + a1[1] * a1[1]) + (a1[2] * a1[2] + a1[3] * a1[3]));
                bf16x8 ah, al; P5_SPLIT(a0, a1, ah, al);
#pragma unroll
                for (int nt = 0; nt < 3; ++nt) { const f32x4 b0 = *(const LAS f32x4*)(B_l + (16 * nt + i16) * LDA + 32 * jj + 8 * h4), b1 = *(const LAS f32x4*)(B_l + (16 * nt + i16) * LDA + 32 * jj + 8 * h4 + 4);
                    bf16x8 bh, bl; P5_SPLIT(b0, b1, bh, bl);
                    acc[nt] = __builtin_amdgcn_mfma_f32_16x16x32_bf16(al, bh, acc[nt], 0, 0, 0);
                    acc[nt] = __builtin_amdgcn_mfma_f32_16x16x32_bf16(ah, bl, acc[nt], 0, 0, 0);
                    acc[nt] = __builtin_amdgcn_mfma_f32_16x16x32_bf16(ah, bh, acc[nt], 0, 0, 0); }
            }
#undef P5_SPLIT
            __syncthreads();
        }
#undef P5_LOAD
        ss += __shfl_xor(ss, 16); ss += __shfl_xor(ss, 32);
        const float rs = 1.0f / sqrtf(ss * (1.0f / DM) + EPS);
        if (h4 == 0) { a.RS2[R0 + 16 * wid + i16] = rs; rs_l[16 * wid + i16] = rs; }
#pragma unroll
        for (int r = 0; r < 4; ++r) { const int rl = 16 * wid + 4 * h4 + r; LG[rl * 37 + i16] = acc[0][r]; LG[rl * 37 + 16 + i16] = acc[1][r]; if (i16 < 4) LG[rl * 37 + 32 + i16] = acc[2][r]; }
        __syncthreads();
        int e0 = 0, e1 = 0, k0 = 0, k1 = 0; float w0 = 0.f, w1 = 0.f;
        if (tid < 128) {
            const float rsv = rs_l[tid]; const LAS float* lg = LG + tid * 37;
            float gl[4];
#pragma unroll
            for (int q = 0; q < 4; ++q) gl[q] = lg[32 + q] * rsv + a.b_rgrp[q];
            int gs = 0; float gm = gl[0];
#pragma unroll
            for (int q = 1; q < 4; ++q) if (gl[q] > gm) { gm = gl[q]; gs = q; }
            float den = 0.f;
#pragma unroll
            for (int q = 0; q < 4; ++q) den += expf(gl[q] - gm);
            const float pg = 1.0f / den;
            float el[8];
#pragma unroll
            for (int q = 0; q < 8; ++q) el[q] = lg[8 * gs + q] * rsv + a.b_rexp[8 * gs + q];
            int i0 = 0; float v0 = el[0];
#pragma unroll
            for (int q = 1; q < 8; ++q) if (el[q] > v0) { v0 = el[q]; i0 = q; }
            int i1 = -1; float v1 = -INFINITY;
#pragma unroll
            for (int q = 0; q < 8; ++q) if (q != i0 && el[q] > v1) { v1 = el[q]; i1 = q; }
            const float ex = expf(v1 - v0);
            w0 = pg / (1.0f + ex); w1 = pg * ex / (1.0f + ex);
            e0 = 8 * gs + i0; e1 = 8 * gs + i1;
            k0 = atomicAdd((int*)(hist + e0), 1); k1 = atomicAdd((int*)(hist + e1), 1);
        }
        __syncthreads();
        if (tid < 32) base_l[tid] = (int)__hip_atomic_fetch_add(a.CNT + tid, (unsigned)hist[tid], __ATOMIC_RELAXED, __HIP_MEMORY_SCOPE_AGENT);
        __syncthreads();
        if (tid < 128) { const int tok = R0 + tid, s0 = base_l[e0] + k0, s1 = base_l[e1] + k1;
            a.LISTS[(size_t)e0 * T + s0] = tok; a.LISTS[(size_t)e1 * T + s1] = tok;
            v4u i0v = {(unsigned)e0, (unsigned)s0, (unsigned)e1, (unsigned)s1}, i1v = {__float_as_uint(w0), __float_as_uint(w1), 0u, 0u};
            *(GAS v4u*)(a.TOK + (size_t)tok * 8) = i0v; *(GAS v4u*)(a.TOK + (size_t)tok * 8 + 4) = i1v; }
        __syncthreads();
    }
}
__device__ __forceinline__ void build_tables(const Frame& F, const gu32* CNT) {
    LAS int* ps = (LAS int*)(F.lds + TBL_PS); LAS int* cn = (LAS int*)(F.lds + TBL_CN); LAS int* te = (LAS int*)(F.lds + TBL_TE);
    __syncthreads();
    if (F.tid < 32) { int c = (int)__hip_atomic_load(CNT + F.tid, __ATOMIC_RELAXED, __HIP_MEMORY_SCOPE_AGENT); c = c < 0 ? 0 : (c > T ? T : c); cn[F.tid] = c; }
    __syncthreads();
    if (F.tid == 0) { int run = 0; for (int e = 0; e < 32; ++e) { ps[e] = run; run += (cn[e] + 255) & ~255; } if (run > PMAX) run = PMAX; ps[32] = run; }
    __syncthreads();
    if (F.tid < 288) { const int p = F.tid * 256; int e = 0; for (int q = 1; q < 32; ++q) if (p >= ps[q]) e = q; te[F.tid] = e; }
    __syncthreads();
}
template <class Ord> __device__ __forceinline__ void build_rowtab(const Frame& F, const Ord& S, const int* LISTS, const float* RS2, LAS int* rowtab) {
    const LAS int* ps = (const LAS int*)(F.lds + TBL_PS); const LAS int* cn = (const LAS int*)(F.lds + TBL_CN); const LAS int* te = (const LAS int*)(F.lds + TBL_TE);
    pg8::Unit u;
    for (int ui = 0; ui < 6 && S.next(ui, u); ++ui)
        if (F.tid < 256) { const int p = u.pm * 256 + F.tid, e = te[u.pm], local = p - ps[e]; const int tok = local < cn[e] ? LISTS[(size_t)e * T + local] : 0; rowtab[ui * 256 + F.tid] = tok; ((LAS float*)rowtab)[(6 + ui) * 256 + F.tid] = RS2[tok]; }
    __syncthreads();
}
__device__ __forceinline__ float fp8_f32(unsigned w, int i) { return i == 0 ? __builtin_amdgcn_cvt_f32_fp8(w, 0) : (i == 1 ? __builtin_amdgcn_cvt_f32_fp8(w, 1) : (i == 2 ? __builtin_amdgcn_cvt_f32_fp8(w, 2) : __builtin_amdgcn_cvt_f32_fp8(w, 3))); }
__device__ __forceinline__ void p9_final(const Frame& F, const bf16* X1B, float* OUT, const unsigned char* Y, const unsigned* TOK, const float* g_final) {
    const LAS int* ps = (const LAS int*)(F.lds + TBL_PS);
    const int gw = F.vcu * NWAVES + F.wave, NGW = F.G * NWAVES;
    f32x4 gf[4];
#pragma unroll
    for (int j = 0; j < 4; ++j) gf[j] = *((const f32x4*)g_final + F.lane + 64 * j);
    constexpr float YS = 1.0f / (pg8::HB_SCALE * pg8::W2_SCALE * pg8::Y_SCALE);
    v4u ia_n = {0u, 0u, 0u, 0u}, ib_n = {0u, 0u, 0u, 0u}, ia_c = ia_n, ib_c = ib_n; unsigned long long xw_n[4]; unsigned ya_n[4], yb_n[4];
#define P9_TOK(m_, ia_, ib_) do { ia_ = *(const GAS v4u*)(TOK + (size_t)(m_) * 8); ib_ = *(const GAS v4u*)(TOK + (size_t)(m_) * 8 + 4); } while (0)
#define P9_ROW(m_, ia_) do { const size_t p0_ = (size_t)(ps[(int)(ia_.x & 31u)] + (int)ia_.y), p1_ = (size_t)(ps[(int)(ia_.z & 31u)] + (int)ia_.w); \
        const GAS unsigned long long* xr_ = (const GAS unsigned long long*)(X1B + (size_t)(m_) * DM) + F.lane; \
        const GAS unsigned* y0_ = (const GAS unsigned*)(Y + p0_ * DM) + F.lane; const GAS unsigned* y1_ = (const GAS unsigned*)(Y + p1_ * DM) + F.lane; \
        _Pragma("unroll") for (int j = 0; j < 4; ++j) { xw_n[j] = __builtin_nontemporal_load((const unsigned long long*)xr_ + 64 * j); ya_n[j] = __builtin_nontemporal_load((const unsigned*)y0_ + 64 * j); yb_n[j] = __builtin_nontemporal_load((const unsigned*)y1_ + 64 * j); } } while (0)
    if (gw < T) { P9_TOK(gw, ia_c, ib_c); P9_ROW(gw, ia_c); if (gw + NGW < T) P9_TOK(gw + NGW, ia_n, ib_n); }
    for (int m = gw; m < T; m += NGW) {
        const float w0 = __uint_as_float(ib_c.x) * YS, w1 = __uint_as_float(ib_c.y) * YS;
        unsigned long long xw[4]; unsigned ya[4], yb[4];
#pragma unroll
        for (int j = 0; j < 4; ++j) { xw[j] = xw_n[j]; ya[j] = ya_n[j]; yb[j] = yb_n[j]; }
        if (m + NGW < T) { ia_c = ia_n; ib_c = ib_n; P9_ROW(m + NGW, ia_c); if (m + 2 * NGW < T) P9_TOK(m + 2 * NGW, ia_n, ib_n); }
        GAS f32x4* orow = (GAS f32x4*)(OUT + (size_t)m * DM) + F.lane;
        f32x4 v[4]; float s = 0.f;
#pragma unroll
        for (int j = 0; j < 4; ++j) { v[j] = (f32x4){bf_lo((unsigned)xw[j]), bf_hi((unsigned)xw[j]), bf_lo((unsigned)(xw[j] >> 32)), bf_hi((unsigned)(xw[j] >> 32))}; const unsigned a = ya[j], b = yb[j];
            v[j].x += w0 * fp8_f32(a, 0) + w1 * fp8_f32(b, 0); v[j].y += w0 * fp8_f32(a, 1) + w1 * fp8_f32(b, 1);
            v[j].z += w0 * fp8_f32(a, 2) + w1 * fp8_f32(b, 2); v[j].w += w0 * fp8_f32(a, 3) + w1 * fp8_f32(b, 3);
            s += (v[j].x * v[j].x + v[j].y * v[j].y) + (v[j].z * v[j].z + v[j].w * v[j].w); }
        s = wave_sum(s);
        const float rs = 1.0f / sqrtf(s * (1.0f / DM) + EPS);
#pragma unroll
        for (int j = 0; j < 4; ++j) __builtin_nontemporal_store(v[j] * rs * gf[j], (f32x4*)orow + 64 * j);
    }
#undef P9_TOK
#undef P9_ROW
}

constexpr int N_PHASES = 10;
#ifndef DUP_TRIVIAL
#define DUP_TRIVIAL 0
#endif
#ifndef P8_HOOK
#define P8_HOOK 3
#endif
#ifndef DUP_PHASE
#define DUP_PHASE -1
#endif
typedef __attribute__((address_space(4))) const unsigned char* karg_ptr;
__device__ __forceinline__ const float* arg_in(int k) { karg_ptr base = (karg_ptr)__builtin_amdgcn_kernarg_segment_ptr(); const unsigned long long v = *(const unsigned long long volatile __attribute__((address_space(4)))*)(base + 8 * k); return (const float*)(const GAS float*)v; }
struct Args { const float* in[23]; float* out; unsigned char* ws; int ph_lo, ph_hi, mode, pad; };
__global__ void __launch_bounds__(NWAVES * 64, 2) fwd_kernel(Args args) {
    extern __shared__ __attribute__((aligned(16))) unsigned char lds[];
    Frame F;
    F.lds = (LAS unsigned char*)lds;
    F.wave = __builtin_amdgcn_readfirstlane((int)threadIdx.x >> 6); F.lane = pg8::lane_now(); F.tid = F.wave * 64 + F.lane;
    F.G = gridDim.x; { const int bx = blockIdx.x; F.vcu = (F.G % 8 == 0) ? (bx % 8) * (F.G / 8) + bx / 8 : bx; }
    unsigned char* ws = args.ws;
    gu32* ctl = (gu32*)(ws + WS_CTL);
    volatile LAS unsigned* MISC = (volatile LAS unsigned*)(F.lds + MISC_OFF);
    for (int u = F.tid; u < (LDS_BYTES - LDSCTL_OFF) / 4; u += NWAVES * 64) ((LAS unsigned*)(F.lds + LDSCTL_OFF))[u] = 0u;
    __syncthreads();
#if MK_ONE_LAUNCH
    XcdBarrier bar = xcd_barrier_post((unsigned*)(ctl + CW_BAR), MISC + 8);
#define GRID_BAR() xcd_barrier(bar)
#else
#define GRID_BAR() do { } while (0)
#endif
    const int lo = args.ph_lo, hi = args.ph_hi;
#ifndef PH_MASK
#define PH_MASK 0x3ff
#endif
#define IN(k) (((PH_MASK >> (k)) & 1) && lo <= (k) && (k) < hi)
#define BOTH(k) (IN(k) && IN((k) + 1))
    float* out = args.out;
    bf16* Win = (bf16*)(ws + WS_WIN); bf16* Wl = (bf16*)(ws + WS_WL); bf16* Wa = (bf16*)(ws + WS_WA); bf16* Wo = (bf16*)(ws + WS_WO); bf16* Wrg = (bf16*)(ws + WS_WRG);
    bf16* XB = (bf16*)(ws + WS_XB); bf16* XR = (bf16*)(ws + WS_XR); bf16* GG = (bf16*)(ws + WS_GG); bf16* Qb = (bf16*)(ws + WS_Q); bf16* Kb = (bf16*)(ws + WS_K); bf16* Vb = (bf16*)(ws + WS_V);
    bf16* SL = (bf16*)out; bf16* SA = (bf16*)out + pg8::SEGE;
    float* RS1 = (float*)(ws + WS_RS1); float* RS2 = (float*)(ws + WS_RS2); float* LF = (float*)(ws + WS_LF); float* CB = (float*)(ws + WS_CB);
    unsigned* TOK = (unsigned*)(ws + WS_TOK); int* LISTS = (int*)(ws + WS_LISTS); float* WRT = (float*)(ws + WS_WRT); int* JLO = (int*)(ws + WS_SRS);
    unsigned char* W13 = ws + WS_W13; unsigned char* W2 = ws + WS_W2; bf16* XG = (bf16*)(ws + WS_XG); unsigned char* HB = ws + WS_HB; unsigned char* X8 = ws + WS_XB;
    gu32* CNT = ctl + CW_CNT;

    if (IN(0)) { F.lane = pg8::lane_now(); F.tid = F.wave * 64 + F.lane;
        P0Args a{arg_in(0), arg_in(1), arg_in(2), arg_in(5), arg_in(7), arg_in(10), arg_in(11), arg_in(12), arg_in(13), arg_in(14), arg_in(15), arg_in(17), arg_in(19), arg_in(20), Win, Wl, Wa, Wo, Wrg, XB, W13, RS1, LF, WRT, ws + WS_WIN8, ws + WS_X8P};
        p0_prologue(F, a, DUP_PHASE == 0 ? args.mode : 0);
        if (BOTH(0)) GRID_BAR();
    }
    if (IN(1)) { F.lane = pg8::lane_now(); F.tid = F.wave * 64 + F.lane;
        cumsum_bias(F, LF, CB);
        if constexpr (SEG8_MASK == 0x7Fu) {
          { pg8::Gemm g{(const bf16*)(ws + WS_X8P), (const bf16*)(ws + WS_WIN8), T, 7 * 1024, DM / 2}; pg8::SplitOrder S; S.init(T, 5 * 1024, 2 * 1024, F.G, (int)blockIdx.x);
            typedef pg8::EpiZT<seg_map(true), true> EpiZ8; EpiZ8 E{XR, SL, RS1, (unsigned*)(ctl + CW_NORM), args.mode, arg_in(3), arg_in(4), (float*)(ws + WS_SIDE), (LAS float*)(F.lds + RG_TOT)};
            pg8::gemm_phase<EpiZ8, pg8::SplitOrder, true, true, true>(F.lds + RING_OFF, g, S, E, F.wave); }
        } else
        { constexpr int NF8 = seg_cnt(true) * 1024;
          pg8::Gemm g{(const bf16*)(ws + WS_X8P), (const bf16*)(ws + WS_WIN8), T, NF8, DM / 2}; pg8::StaticOrder S; S.init(T, NF8, F.G, (int)blockIdx.x);
          typedef pg8::EpiZT<seg_map(true), true> EpiZ8; EpiZ8 E{XR, SL, RS1, (unsigned*)(ctl + CW_NORM), args.mode, arg_in(3), arg_in(4), (float*)(ws + WS_SIDE), (LAS float*)(F.lds + RG_TOT)};
          pg8::gemm_phase<EpiZ8, pg8::StaticOrder, true, true, true>(F.lds + RING_OFF, g, S, E, F.wave); }
        __syncthreads();
        if constexpr (seg_cnt(false) > 0) { constexpr int NB16 = seg_cnt(false) * 1024;
          pg8::Gemm g{XB, Win, T, NB16, DM}; pg8::StaticOrder S; S.init(T, NB16, F.G, (int)blockIdx.x);
          typedef pg8::EpiZT<seg_map(false), false> EpiZ16; EpiZ16 E{XR, SL, RS1, (unsigned*)(ctl + CW_NORM), args.mode, arg_in(3), arg_in(4), (float*)(ws + WS_SIDE), (LAS float*)(F.lds + RG_TOT)};
          pg8::gemm_phase<EpiZ16, pg8::StaticOrder, true, true>(F.lds + RING_OFF, g, S, E, F.wave); }
        if (BOTH(1)) GRID_BAR();
    }
    if (IN(2)) { F.lane = pg8::lane_now(); F.tid = F.wave * 64 + F.lane;
        { const int gw = F.vcu * NWAVES + F.wave; if (gw < NB * NH * 16) { const int j = attn_jlo(F, CB, (const unsigned*)(ctl + CW_NORM), gw >> 4, gw & 15); if (F.lane == 0) JLO[gw] = j; } }
        conv_fixup(F, (const float*)(ws + WS_SIDE), XR, arg_in(3), arg_in(4));
        if (BOTH(2)) GRID_BAR();
    }
    if (IN(3)) { F.lane = pg8::lane_now(); F.tid = F.wave * 64 + F.lane;
        RgArgs ra{XR, GG, GG, Wrg, arg_in(6), arg_in(8), arg_in(9)};
#if DUP_PHASE >= 20
        const int mode = args.mode;
#else
        constexpr int mode = 0;
#endif
        if (mode < 2) { ra.GO = mode == 1 ? XB : GG; for (int u = F.vcu; u < 256; u += F.G) rglru_unit(F, ra, u); }
        if (mode != 1) attn_phase(F, (char*)lds + RING_OFF, Qb, XB, Kb, Vb, CB, JLO, ctl + CW_QCTR + (mode >= 2 ? 1024 : 0), mode >= 3 ? mode - 2 : 0);
        if (BOTH(3)) GRID_BAR();
    }
    if (IN(4)) { { F.lane = pg8::lane_now(); F.tid = F.wave * 64 + F.lane;
        static_assert(WS_GG - WS_XB == (size_t)256 * 256 * DM * 2 && WS_WL - WS_WA == (size_t)4 * 256 * DM * 2, "TwoGemmOrder: hg follows o by 256 row tiles, Wl follows Wa by 4 column tiles");
        pg8::Gemm g{XB, Wa, T, DM, DM}; pg8::TwoGemmOrder S; S.init(T, DM, F.G, (int)blockIdx.x);
        pg8::EpiGate2 E{SA, SL, XR};
        pg8::gemm_phase<pg8::EpiGate2, pg8::TwoGemmOrder, true, true>(F.lds + RING_OFF, g, S, E, F.wave); }
        if (BOTH(4)) GRID_BAR();
    }
    if (IN(5)) { F.lane = pg8::lane_now(); F.tid = F.wave * 64 + F.lane;
        pg8::Gemm g{XR, Wo, T, DM, DM}; pg8::StaticOrder S; S.init(T, DM, F.G, (int)blockIdx.x);
        pg8::EpiDelta E{(bf16*)out};
        pg8::gemm_phase<pg8::EpiDelta, pg8::StaticOrder, true, true>(F.lds + RING_OFF, g, S, E, F.wave);
        if (BOTH(5)) GRID_BAR();
    }
    if (IN(6)) { F.lane = pg8::lane_now(); F.tid = F.wave * 64 + F.lane;
        P5Args a{arg_in(0), WRT, arg_in(16), arg_in(18), arg_in(21), (const bf16*)out, XR, X8, W2, RS2, LISTS, TOK, args.mode ? CNT + 64 : CNT};
        w13_copies(F, arg_in(14), arg_in(19), arg_in(20), W13);
        p5_route(F, a);
        if (BOTH(6)) GRID_BAR();
    }
    if (IN(7)) { F.lane = pg8::lane_now(); F.tid = F.wave * 64 + F.lane;
        build_tables(F, CNT);
        const int ntiles = ((const LAS int*)(F.lds + TBL_PS))[32] >> 8;
        pg8::Gemm g{(const bf16*)X8, (const bf16*)W13, ntiles * 256, 32 * 1024, DM / 2}; pg8::GroupedOrderT<1> S{(const LAS int*)(F.lds + TBL_TE), ntiles * 4, F.G, F.vcu, (unsigned*)(ctl + CW_RDY), F.wave, (unsigned*)(ctl + CW_TMO)};
        LAS int* rowtab = (LAS int*)(F.lds + RG_TOT);
        build_rowtab(F, S, LISTS, RS2, rowtab);
        pg8::EpiSwiGLU E{HB};
        pg8::gemm_phase_gather<pg8::EpiSwiGLU, pg8::GroupedOrderT<1>, true>(F.lds + RING_OFF, g, S, E, rowtab, F.wave);
    }
    if (IN(8)) { F.lane = pg8::lane_now(); F.tid = F.wave * 64 + F.lane;
        if (!IN(7)) build_tables(F, CNT);
        const int ntiles = ((const LAS int*)(F.lds + TBL_PS))[32] >> 8;
        pg8::Gemm g{(const bf16*)HB, (const bf16*)W2, ntiles * 256, 32 * 1024, DE / 2}; pg8::GroupedOrderT<P8_HOOK> S{(const LAS int*)(F.lds + TBL_TE), ntiles * 4, F.G, F.vcu, (unsigned*)(ctl + CW_RDY), F.wave, (unsigned*)(ctl + CW_TMO)};
#if P8_HOOK == 3
        if (F.wave == 0) { unsigned sp = 0u; const int Lu = F.lane < 32 ? S.unit_index(F.lane) : -1; const unsigned* rp = (const unsigned*)(ctl + CW_RDY) + 8 * (Lu < 0 ? 0 : (Lu >> 2));
            for (;;) { const unsigned v = Lu < 0 ? 32u : __hip_atomic_load(rp, __ATOMIC_RELAXED, __HIP_MEMORY_SCOPE_AGENT);
                if (__all(v >= 32u)) break;
                __builtin_amdgcn_s_sleep(2);
                if ((++sp & 1023u) == 0u) { if (__hip_atomic_load((const unsigned*)(ctl + CW_TMO), __ATOMIC_RELAXED, __HIP_MEMORY_SCOPE_AGENT) != 0u) break;
                    if (sp > (1u << 20)) { if (F.lane == 0) __hip_atomic_store((unsigned*)(ctl + CW_TMO), 1u, __ATOMIC_RELAXED, __HIP_MEMORY_SCOPE_AGENT); break; } } }
            __builtin_amdgcn_fence(__ATOMIC_ACQUIRE, "agent");
            asm volatile("s_waitcnt vmcnt(0)" ::: "memory"); }
        __syncthreads();
#endif
        pg8::EpiY E{(unsigned char*)XG, args.mode};
        pg8::gemm_phase<pg8::EpiY, pg8::GroupedOrderT<P8_HOOK>, true, true, true>(F.lds + RING_OFF, g, S, E, F.wave);
        if (BOTH(8)) GRID_BAR();
    }
    if (IN(9)) { F.lane = pg8::lane_now(); F.tid = F.wave * 64 + F.lane;
        if (!IN(7)) build_tables(F, CNT);
        p9_final(F, XR, out, (const unsigned char*)XG, TOK, arg_in(22));
    }
#undef IN
#undef BOTH
}

extern "C" void kernel_launch(void* const* d_in, const int* in_sizes, int n_in, void* d_out, int out_size, void* d_ws, size_t ws_size, hipStream_t stream) {
    static int grid = 0;
    if (grid == 0) {
        if (n_in != 23 || in_sizes[0] != T * DM || out_size != T * DM || ws_size < WS_END) { fprintf(stderr, "kernel_launch: unexpected shapes (n_in %d, in0 %d, out %d, ws %zu); nothing launched\n", n_in, n_in > 0 ? in_sizes[0] : -1, out_size, ws_size); grid = -1; return; }
        int dev = 0, cus = 0;
        if (hipGetDevice(&dev) != hipSuccess || hipDeviceGetAttribute(&cus, hipDeviceAttributeMultiprocessorCount, dev) != hipSuccess) { grid = -1; return; }
        if (hipFuncSetAttribute((const void*)fwd_kernel, hipFuncAttributeMaxDynamicSharedMemorySize, LDS_BYTES) != hipSuccess) { fprintf(stderr, "kernel_launch: hipFuncSetAttribute failed\n"); grid = -1; return; }
        int per_cu = 0;
        if (hipOccupancyMaxActiveBlocksPerMultiprocessor(&per_cu, (const void*)fwd_kernel, NWAVES * 64, LDS_BYTES) != hipSuccess || per_cu < 1) { fprintf(stderr, "kernel_launch: occupancy query reports %d\n", per_cu); }
        (void)hipGetLastError();
        grid = cus;
    }
    if (grid < 0) return;
    if (hipMemsetAsync((char*)d_ws + WS_CTL, 0, CTL_ZERO_BYTES, stream) != hipSuccess) return;
    Args a{};
    for (int i = 0; i < 23; ++i) a.in[i] = (const float*)d_in[i];
    a.out = (float*)d_out; a.ws = (unsigned char*)d_ws;
#if MK_ONE_LAUNCH
    a.ph_lo = 0; a.ph_hi = N_PHASES;
    hipLaunchKernelGGL(fwd_kernel, dim3(grid), dim3(NWAVES * 64), LDS_BYTES, stream, a);
#else
    for (int ph = 0; ph < N_PHASES; ++ph) { a.ph_lo = ph; a.ph_hi = ph + 1;
        if (DUP_PHASE == ph || (ph == 3 && DUP_PHASE >= 20)) { a.mode = DUP_PHASE >= 20 ? DUP_PHASE - 19 : (ph == 8 ? DUP_TRIVIAL : (ph == 6 || (ph == 1 && DUP_TRIVIAL)) ? 1 : (ph == 0 ? DUP_TRIVIAL : 0)); hipLaunchKernelGGL(fwd_kernel, dim3(grid), dim3(NWAVES * 64), LDS_BYTES, stream, a); a.mode = 0; }
        hipLaunchKernelGGL(fwd_kernel, dim3(grid), dim3(NWAVES * 64), LDS_BYTES, stream, a); }
#endif
}
```
